# Optimizing an MI355X kernel written in HIP

```python
import jax
import jax.numpy as jnp
from jax import lax
import numpy as np

D_MODEL = 1024
BATCH = 8
SEQ = 2048
DEPTH = 1
DEC_BATCH = 32
DEC_SEQ = 32
PAST_LEN = 1024

CHUNK = 64
HEAD_DIM = 64
ATT_WIDTH = D_MODEL // 2
N_HEADS = ATT_WIDTH // HEAD_DIM
N_KV_HEADS = N_HEADS // 2
GQA_GROUP = N_HEADS // N_KV_HEADS
ROT_DIM = HEAD_DIM // 4
ROPE_THETA = 500000.0
IDX_HEADS = 8
IDX_DIM = 64
TOPK_MAX = 256
RWKV_WIDTH = D_MODEL - ATT_WIDTH
RWKV_HEADS = RWKV_WIDTH // HEAD_DIM
W_LORA = 32
A_LORA = 32
G_LORA = 96
SHIFT_WIDTH = 3 * RWKV_WIDTH + W_LORA + A_LORA + G_LORA
PROJ_WIDTH = N_HEADS * HEAD_DIM + 2 * N_KV_HEADS * HEAD_DIM + IDX_HEADS * IDX_DIM + IDX_DIM + IDX_HEADS + SHIFT_WIDTH
D_FF = 4 * D_MODEL
NORM_EPS = 1e-6
GN_EPS = 64e-5
L2_EPS = 1e-12

kernel_name = 'hybrid_dsa_rwkv7_stream_step'


def _split(z, sizes):
    offs = np.cumsum(np.array(sizes))[:-1].tolist()
    return jnp.split(z, offs, axis=-1)


def rms_norm(x, g):
    xf = x.astype(jnp.float32)
    y = xf * lax.rsqrt(jnp.mean(xf * xf, axis=-1, keepdims=True) + NORM_EPS)
    return (y * g.astype(jnp.float32)).astype(x.dtype)


def layer_norm(x, g, b):
    xf = x.astype(jnp.float32)
    mu = jnp.mean(xf, axis=-1, keepdims=True)
    var = jnp.mean(jnp.square(xf - mu), axis=-1, keepdims=True)
    y = (xf - mu) * lax.rsqrt(var + NORM_EPS)
    return (y * g.astype(jnp.float32) + b.astype(jnp.float32)).astype(x.dtype)


def rope_partial(x, pos):
    half = ROT_DIM // 2
    inv = ROPE_THETA ** (-jnp.arange(0, ROT_DIM, 2, dtype=jnp.float32) / ROT_DIM)
    ang = pos.astype(jnp.float32)[:, None] * inv[None, :]
    cos = jnp.cos(ang)[:, None, :]
    sin = jnp.sin(ang)[:, None, :]
    xf = x.astype(jnp.float32)
    x1 = xf[..., :half]
    x2 = xf[..., half:ROT_DIM]
    out = jnp.concatenate([x1 * cos - x2 * sin, x2 * cos + x1 * sin, xf[..., ROT_DIM:]], axis=-1)
    return out.astype(x.dtype)


def dsa_block(q, qi, wi, qpos, k_all, v_all, ki_all, topk):
    B, Tq = q.shape[0], q.shape[1]
    L = k_all.shape[1]
    limit = (qpos // CHUNK + 1) * CHUNK
    admissible = jnp.arange(L)[None, :] < limit[:, None]
    dots = jnp.einsum('bthd,bsd->bths', qi.astype(jnp.float32), ki_all.astype(jnp.float32)) * (IDX_DIM ** -0.5)
    score = jnp.einsum('bths,bth->bts', jax.nn.relu(dots), wi.astype(jnp.float32))
    score = jnp.where(admissible[None], score, -jnp.inf)
    _, idx = lax.top_k(score, topk)
    valid = idx < limit[None, :, None]
    kg = jax.vmap(lambda kb, ib: kb[ib])(k_all, idx)
    vg = jax.vmap(lambda vb, ib: vb[ib])(v_all, idx)
    qg = q.reshape(B, Tq, N_KV_HEADS, GQA_GROUP, HEAD_DIM)
    s = jnp.einsum('btkgd,btskd->btkgs', qg.astype(jnp.float32), kg.astype(jnp.float32)) * (HEAD_DIM ** -0.5)
    s = jnp.where(valid[:, :, None, None, :], s, -jnp.inf)
    p = jax.nn.softmax(s, axis=-1)
    o = jnp.einsum('btkgs,btskd->btkgd', p.astype(vg.dtype), vg)
    return o.reshape(B, Tq, N_HEADS * HEAD_DIM).astype(q.dtype)


def dsa_attention(q, qi, wi, pos, k_all, v_all, ki_all):
    B, T = q.shape[0], q.shape[1]
    L = k_all.shape[1]
    topk = min(TOPK_MAX, L // 4)
    qblk = min(T, CHUNK)
    nblk = T // qblk

    def blocks(a):
        return jnp.swapaxes(a.reshape((B, nblk, qblk) + a.shape[2:]), 0, 1)

    def one_block(args):
        qb, qib, wib, pb = args
        return dsa_block(qb, qib, wib, pb, k_all, v_all, ki_all, topk)

    o = lax.map(one_block, (blocks(q), blocks(qi), blocks(wi), pos.reshape(nblk, qblk)))
    return jnp.swapaxes(o, 0, 1).reshape(B, T, N_HEADS * HEAD_DIM)


def rwkv7_time_mix(zs, shift0, wkv0, mu_shift, w0, w2, a0, a2, g2, k_k, k_a, r_k, ln_x_g, ln_x_b):
    B, T = zs.shape[0], zs.shape[1]
    f32 = jnp.float32
    prev = jnp.concatenate([shift0.astype(zs.dtype), zs[:, :-1]], axis=1)
    zm = zs + mu_shift * (prev - zs)
    r, k, v, zw, za, zg = _split(zm, (RWKV_WIDTH, RWKV_WIDTH, RWKV_WIDTH, W_LORA, A_LORA, G_LORA))
    log_w = -jax.nn.softplus(-(w0 + jnp.tanh(zw) @ w2).astype(f32)) - 0.5
    decay = jnp.exp(-jnp.exp(log_w))
    a = jax.nn.sigmoid((a0 + za @ a2).astype(f32))
    g = (jax.nn.sigmoid(zg) @ g2).astype(f32)

    def heads(t):
        return t.astype(f32).reshape(B, T, RWKV_HEADS, HEAD_DIM)

    r_h, k_h, v_h, a_h, w_h = heads(r), heads(k), heads(v), heads(a), heads(decay)
    kk = k_h * k_k.astype(f32).reshape(RWKV_HEADS, HEAD_DIM)
    kk = kk / jnp.maximum(jnp.sqrt(jnp.sum(kk * kk, axis=-1, keepdims=True)), L2_EPS)
    k_h = k_h * (1.0 + (a_h - 1.0) * k_a.astype(f32).reshape(RWKV_HEADS, HEAD_DIM))

    def step(S, inp):
        r_t, w_t, k_t, v_t, kk_t, b_t = inp
        s_kk = jnp.einsum('bhvk,bhk->bhv', S, kk_t)
        S = S * w_t[:, :, None, :] - s_kk[..., None] * b_t[:, :, None, :] + v_t[..., None] * k_t[:, :, None, :]
        return S, jnp.einsum('bhvk,bhk->bhv', S, r_t)

    def tm(t):
        return jnp.swapaxes(t, 0, 1)

    s_fin, y = lax.scan(step, wkv0.astype(f32), (tm(r_h), tm(w_h), tm(k_h), tm(v_h), tm(kk), tm(kk * a_h)))
    y = tm(y)
    mu = jnp.mean(y, axis=-1, keepdims=True)
    var = jnp.mean(jnp.square(y - mu), axis=-1, keepdims=True)
    y = ((y - mu) * lax.rsqrt(var + GN_EPS)).reshape(B, T, RWKV_WIDTH) * ln_x_g.astype(f32) + ln_x_b.astype(f32)
    bonus = jnp.sum(r_h * k_h * r_k.astype(f32), axis=-1, keepdims=True) * v_h
    o = (y + bonus.reshape(B, T, RWKV_WIDTH)) * g
    return o.astype(zs.dtype), s_fin


def hybrid_layer(x, pos, k_past, v_past, ki_past, wkv0, shift0,
                 norm_mix, w_in, q_gain, k_gain, kidx_ln_g, kidx_ln_b, mu_shift,
                 w0, w2, a0, a2, g2, k_k, k_a, r_k, ln_x_g, ln_x_b, w_out,
                 norm_ffn, w_ff1, w_ff2):
    B, T = x.shape[0], x.shape[1]
    dt = x.dtype
    xn = rms_norm(x, norm_mix)
    zq, zk, zv, ziq, zik, ziw, zs = _split(
        xn @ w_in,
        (N_HEADS * HEAD_DIM, N_KV_HEADS * HEAD_DIM, N_KV_HEADS * HEAD_DIM,
         IDX_HEADS * IDX_DIM, IDX_DIM, IDX_HEADS, SHIFT_WIDTH))
    q = rope_partial(rms_norm(zq.reshape(B, T, N_HEADS, HEAD_DIM), q_gain), pos)
    k = rope_partial(rms_norm(zk.reshape(B, T, N_KV_HEADS, HEAD_DIM), k_gain), pos)
    v = zv.reshape(B, T, N_KV_HEADS, HEAD_DIM)
    qi = rope_partial(ziq.reshape(B, T, IDX_HEADS, IDX_DIM), pos)
    ki = rope_partial(layer_norm(zik, kidx_ln_g, kidx_ln_b)[:, :, None, :], pos)[:, :, 0, :]
    wi = ziw * (IDX_HEADS ** -0.5)
    k_all = jnp.concatenate([k_past.astype(k.dtype), k], axis=1)
    v_all = jnp.concatenate([v_past.astype(v.dtype), v], axis=1)
    ki_all = jnp.concatenate([ki_past.astype(ki.dtype), ki], axis=1)
    o_att = dsa_attention(q, qi, wi, pos, k_all, v_all, ki_all)
    o_rwkv, wkv_new = rwkv7_time_mix(zs, shift0, wkv0, mu_shift, w0, w2, a0, a2, g2,
                                     k_k, k_a, r_k, ln_x_g, ln_x_b)
    h = x + (jnp.concatenate([o_att, o_rwkv.astype(o_att.dtype)], axis=-1) @ w_out).astype(dt)
    hn = rms_norm(h, norm_ffn)
    y = h + (jnp.square(jax.nn.relu(hn @ w_ff1)) @ w_ff2).astype(dt)
    return y, k, v, ki, wkv_new.astype(dt), zs[:, -1:]


def setup_inputs(seed: int = 0) -> dict:
    key = jax.random.key(seed)
    ks = iter(jax.random.split(key, 40))

    def nrm(shape, scale):
        return jax.random.normal(next(ks), shape, jnp.float32) * scale

    L = DEPTH
    return {
        'x_prompt': nrm((BATCH, SEQ, D_MODEL), 1.0),
        'x_sample': nrm((DEC_BATCH, DEC_SEQ, D_MODEL), 1.0),
        'cache_k': nrm((L, DEC_BATCH, PAST_LEN, N_KV_HEADS, HEAD_DIM), 1.0),
        'cache_v': nrm((L, DEC_BATCH, PAST_LEN, N_KV_HEADS, HEAD_DIM), 1.0),
        'cache_kidx': nrm((L, DEC_BATCH, PAST_LEN, IDX_DIM), 1.0),
        'state_wkv': nrm((L, DEC_BATCH, RWKV_HEADS, HEAD_DIM, HEAD_DIM), 0.3),
        'state_shift': nrm((L, DEC_BATCH, 1, SHIFT_WIDTH), 1.0),
        'norm_mix': 1.0 + nrm((L, D_MODEL), 0.02),
        'w_in': nrm((L, D_MODEL, PROJ_WIDTH), D_MODEL ** -0.5),
        'q_gain': 1.0 + nrm((L, HEAD_DIM), 0.02),
        'k_gain': 1.0 + nrm((L, HEAD_DIM), 0.02),
        'kidx_ln_g': 1.0 + nrm((L, IDX_DIM), 0.02),
        'kidx_ln_b': nrm((L, IDX_DIM), 0.02),
        'mu_shift': jax.random.uniform(next(ks), (L, SHIFT_WIDTH), jnp.float32),
        'w0': nrm((L, RWKV_WIDTH), 0.5),
        'w2': nrm((L, W_LORA, RWKV_WIDTH), 0.5 * W_LORA ** -0.5),
        'a0': nrm((L, RWKV_WIDTH), 0.1),
        'a2': nrm((L, A_LORA, RWKV_WIDTH), 0.5 * A_LORA ** -0.5),
        'g2': nrm((L, G_LORA, RWKV_WIDTH), G_LORA ** -0.5),
        'k_k': 0.85 + nrm((L, RWKV_WIDTH), 0.05),
        'k_a': 1.0 + nrm((L, RWKV_WIDTH), 0.05),
        'r_k': nrm((L, RWKV_HEADS, HEAD_DIM), 0.1),
        'ln_x_g': 1.0 + nrm((L, RWKV_WIDTH), 0.02),
        'ln_x_b': nrm((L, RWKV_WIDTH), 0.02),
        'w_out': nrm((L, D_MODEL, D_MODEL), D_MODEL ** -0.5),
        'norm_ffn': 1.0 + nrm((L, D_MODEL), 0.02),
        'w_ff1': nrm((L, D_MODEL, D_FF), D_MODEL ** -0.5),
        'w_ff2': nrm((L, D_FF, D_MODEL), D_FF ** -0.5),
    }


def reference(x_prompt, x_sample, cache_k, cache_v, cache_kidx, state_wkv, state_shift,
              norm_mix, w_in, q_gain, k_gain, kidx_ln_g, kidx_ln_b, mu_shift,
              w0, w2, a0, a2, g2, k_k, k_a, r_k, ln_x_g, ln_x_b, w_out,
              norm_ffn, w_ff1, w_ff2):
    B, T = x_prompt.shape[0], x_prompt.shape[1]
    dt = x_prompt.dtype
    pos_p = jnp.arange(T, dtype=jnp.int32)
    pos_s = cache_k.shape[2] + jnp.arange(x_sample.shape[1], dtype=jnp.int32)
    no_k = jnp.zeros((B, 0, N_KV_HEADS, HEAD_DIM), dt)
    no_ki = jnp.zeros((B, 0, IDX_DIM), dt)
    wkv_zero = jnp.zeros((B, RWKV_HEADS, HEAD_DIM, HEAD_DIM), jnp.float32)
    shift_zero = jnp.zeros((B, 1, SHIFT_WIDTH), dt)

    y_p, y_s = x_prompt, x_sample
    kp, vp, kip, sp, shp = [], [], [], [], []
    ks_, vs_, kis, ss, shs = [], [], [], [], []
    for l in range(DEPTH):
        wl = (norm_mix[l], w_in[l], q_gain[l], k_gain[l], kidx_ln_g[l], kidx_ln_b[l], mu_shift[l],
              w0[l], w2[l], a0[l], a2[l], g2[l], k_k[l], k_a[l], r_k[l], ln_x_g[l], ln_x_b[l],
              w_out[l], norm_ffn[l], w_ff1[l], w_ff2[l])
        y_p, k1, v1, ki1, s1, sh1 = hybrid_layer(y_p, pos_p, no_k, no_k, no_ki, wkv_zero, shift_zero, *wl)
        y_s, k2, v2, ki2, s2, sh2 = hybrid_layer(y_s, pos_s, cache_k[l], cache_v[l], cache_kidx[l],
                                                 state_wkv[l], state_shift[l], *wl)
        kp.append(k1); vp.append(v1); kip.append(ki1); sp.append(s1); shp.append(sh1)
        ks_.append(k2); vs_.append(v2); kis.append(ki2); ss.append(s2); shs.append(sh2)
    return (y_p, y_s,
            jnp.stack(kp), jnp.stack(vp), jnp.stack(kip), jnp.stack(sp), jnp.stack(shp),
            jnp.stack(ks_), jnp.stack(vs_), jnp.stack(kis), jnp.stack(ss), jnp.stack(shs))
```

```cpp
#include <hip/hip_runtime.h>
#include <hip/hip_cooperative_groups.h>
#include <cstdio>
#include <cstdint>
namespace cg = cooperative_groups;
namespace pg8 {
#define PG8_LAS __attribute__((address_space(3)))
typedef unsigned short bf16_t;
typedef short bf16x8 __attribute__((ext_vector_type(8)));
typedef float f32x4 __attribute__((ext_vector_type(4)));
typedef unsigned u32x4 __attribute__((ext_vector_type(4)));
constexpr int BM = 256, BK = 64, HALF = 128, HTB = HALF * BK * 2  , STAGE_BYTES = 8 * HTB, NXCD = 8, WGM = 8;

__host__ __device__ __forceinline__ int lds_byte(int r, int c) { const int st = (r >> 4) * 2 + (c >> 5), rr = r & 15, cc = c & 31, ob = rr * 64 + cc * 2; return st * 1024 + (ob ^ (((ob >> 9) & 1) << 5)); }
__host__ __device__ __forceinline__ void stage_rc(int b, int& R, int& C) { const int st = b / 1024, sb = b % 1024, swz = sb ^ (((sb >> 9) & 1) << 5); R = (st >> 1) * 16 + swz / 64; C = (st & 1) * 32 + (swz % 64) / 2; }
__host__ __device__ __forceinline__ int perm32(int rho) { const int n = rho >> 4, i = rho & 15; return 8 * (i >> 2) + 4 * n + (i & 3); }

struct Unit { int pm, pn; };
struct Gemm { const bf16_t* A; const bf16_t* Bt; int M, N, K; };

struct StaticOrder {
    int nM, nN, nwg, G, c;
    __host__ __device__ void init(int M, int N, int G_, int c_) { nM = M / BM; nN = N / BM; nwg = nM * nN; G = G_; c = c_; }
    __host__ __device__ bool next(int i, Unit& u) const {
        const long L = (long)i * G + c; if (L >= nwg) return false;
        int wgid = (int)L; { const int q = nwg / NXCD, r = nwg % NXCD, xcd = wgid % NXCD, off = wgid / NXCD; wgid = (xcd < r ? xcd * (q + 1) : r * (q + 1) + (xcd - r) * q) + off; }
        const int nig = WGM * nN, gid = wgid / nig, fm = gid * WGM, gsz = (nM - fm) < WGM ? (nM - fm) : WGM;
        u.pm = fm + ((wgid % nig) % gsz); u.pn = (wgid % nig) / gsz; return true;
    }
    __device__ __forceinline__ void a_ready(const Unit&) const {}
    __device__ __forceinline__ void done(const Unit&) const {}
};


__device__ __forceinline__ unsigned cvt_pk_bf16(float lo, float hi) { unsigned r; asm volatile("v_cvt_pk_bf16_f32 %0, %1, %2" : "=v"(r) : "v"(lo), "v"(hi)); return r; }

constexpr int E_MP = 16384;
constexpr int E_ZRW = 1632, E_ZSW = 1696;

struct EpiZ {
    static constexpr bool PERM = true, AFTER_DRAIN = false;
    bf16_t* ZR; bf16_t* ZS;
    __device__ __forceinline__ void operator()(const f32x4 (&acc)[2][2][4][2], const Unit& u, int wr, int wc, int fr, int fq) const {
        const int row0 = u.pm * BM + wr * 64 + fr, c0 = u.pn * BM + wc * 32 + 8 * fq;
#pragma unroll
        for (int ai = 0; ai < 2; ++ai)
#pragma unroll
            for (int m = 0; m < 4; ++m) { const size_t row = (size_t)(row0 + ai * HALF + m * 16);
#pragma unroll
                for (int bj = 0; bj < 2; ++bj) { const int c = c0 + bj * HALF; bf16_t* dst;
                    if (c < 1600) dst = ZR + row * E_ZRW + c; else if (c < 3296) dst = ZS + row * E_ZSW + (c - 1600); else if (c == 3296) dst = ZR + row * E_ZRW + 1600; else continue;
                    const f32x4 v0 = acc[ai][bj][m][0], v1 = acc[ai][bj][m][1]; u32x4 w;
                    w.x = cvt_pk_bf16(v0[0], v0[1]); w.y = cvt_pk_bf16(v0[2], v0[3]); w.z = cvt_pk_bf16(v1[0], v1[1]); w.w = cvt_pk_bf16(v1[2], v1[3]);
                    *(u32x4*)dst = w; } }
    }
};
struct EpiH {
    static constexpr bool PERM = false, AFTER_DRAIN = false;
    const float* xp; const float* xs; float* H;
    __device__ __forceinline__ void operator()(const f32x4 (&acc)[2][2][4][2], const Unit& u, int wr, int wc, int fr, int fq) const {
        const int row0 = u.pm * BM + wr * 64 + fr, col0 = u.pn * BM + wc * 32 + 4 * fq;
#pragma unroll
        for (int ai = 0; ai < 2; ++ai)
#pragma unroll
            for (int m = 0; m < 4; ++m) { const int row = row0 + ai * HALF + m * 16;
                const float* xr = (row < E_MP ? xp + (size_t)row * 1024 : xs + (size_t)(row - E_MP) * 1024) + col0; float* hr = H + (size_t)row * 1024 + col0;
#pragma unroll
                for (int bj = 0; bj < 2; ++bj)
#pragma unroll
                    for (int n = 0; n < 2; ++n) *(f32x4*)(hr + bj * HALF + n * 16) = *(const f32x4*)(xr + bj * HALF + n * 16) + acc[ai][bj][m][n]; }
    }
};
struct EpiAct {
    static constexpr bool PERM = true, AFTER_DRAIN = false;
    bf16_t* O; int ldc;
    __device__ __forceinline__ void operator()(const f32x4 (&acc)[2][2][4][2], const Unit& u, int wr, int wc, int fr, int fq) const {
        const int row0 = u.pm * BM + wr * 64 + fr, c0 = u.pn * BM + wc * 32 + 8 * fq;
#pragma unroll
        for (int ai = 0; ai < 2; ++ai)
#pragma unroll
            for (int m = 0; m < 4; ++m) { bf16_t* rowp = O + (size_t)(row0 + ai * HALF + m * 16) * ldc + c0;
#pragma unroll
                for (int bj = 0; bj < 2; ++bj) { f32x4 v0 = acc[ai][bj][m][0], v1 = acc[ai][bj][m][1];
#pragma unroll
                    for (int e = 0; e < 4; ++e) { const float a = fmaxf(v0[e], 0.f), b = fmaxf(v1[e], 0.f); v0[e] = a * a; v1[e] = b * b; }
                    u32x4 w; w.x = cvt_pk_bf16(v0[0], v0[1]); w.y = cvt_pk_bf16(v0[2], v0[3]); w.z = cvt_pk_bf16(v1[0], v1[1]); w.w = cvt_pk_bf16(v1[2], v1[3]);
                    *(u32x4*)(rowp + bj * HALF) = w; } }
    }
};
struct EpiY {
    static constexpr bool PERM = false, AFTER_DRAIN = false;
    float* Y;
    __device__ __forceinline__ void operator()(const f32x4 (&acc)[2][2][4][2], const Unit& u, int wr, int wc, int fr, int fq) const {
        const int row0 = u.pm * BM + wr * 64 + fr, col0 = u.pn * BM + wc * 32 + 4 * fq;
#pragma unroll
        for (int ai = 0; ai < 2; ++ai)
#pragma unroll
            for (int m = 0; m < 4; ++m) { float* yr = Y + (size_t)(row0 + ai * HALF + m * 16) * 1024 + col0;
#pragma unroll
                for (int bj = 0; bj < 2; ++bj)
#pragma unroll
                    for (int n = 0; n < 2; ++n) { f32x4* p = (f32x4*)(yr + bj * HALF + n * 16); *p = *p + acc[ai][bj][m][n]; } }
    }
};

template <class Epi, class Sched, bool ALIGN_EPI = false, bool SP2 = false>
__device__ __forceinline__ void gemm_phase(PG8_LAS unsigned char* lds, const Gemm g, const Sched& S, const Epi& E) {
    const int tid = threadIdx.x, wid = __builtin_amdgcn_readfirstlane(tid >> 6), lane = tid & 63, wr = wid >> 2, wc = wid & 3, fr = lane & 15, fq = lane >> 4;
    const int K = g.K, nt = K / BK;
    unsigned voffA[2], voffB[2];
#pragma unroll
    for (int i = 0; i < 2; ++i) { int R, C; stage_rc(tid * 16 + i * 8192, R, C); const int Rb = Epi::PERM ? ((R & ~31) + perm32(R & 31)) : R;
        voffA[i] = (unsigned)(R * K + C) * 2u; voffB[i] = (unsigned)(Rb * K + C) * 2u; }
    const size_t kstep = (size_t)(BK * 2);
    const size_t hstep = (size_t)HALF * K * 2;
    const size_t tstep = 2 * hstep;
    const unsigned ldsw = (unsigned)wid * 1024u;
    const int aoff = lds_byte(wr * 64 + fr, fq * 8), boff = lds_byte(wc * 32 + fr, fq * 8);
#define PG8_SA(b, h) (((b) * 2 + (h)) * HTB)
#define PG8_SB(b, h) ((4 + (b) * 2 + (h)) * HTB)
#define PG8_STAGE(bufoff, gbase, voff) do { _Pragma("unroll") for (int _i = 0; _i < 2; ++_i) \
        __builtin_amdgcn_global_load_lds((const unsigned*)((const char*)(gbase) + (voff)[_i]), (PG8_LAS unsigned*)(lds + (bufoff) + ldsw + _i * 8192), 16, 0, 0); } while (0)
#define PG8_LDA(dst, b, h) do { _Pragma("unroll") for (int m = 0; m < 4; ++m) _Pragma("unroll") for (int k = 0; k < 2; ++k) dst[m][k] = *(const PG8_LAS bf16x8*)(lds + PG8_SA(b, h) + aoff + m * 2048 + k * 1024); } while (0)
#define PG8_LDB(dst, b, h) do { _Pragma("unroll") for (int n = 0; n < 2; ++n) _Pragma("unroll") for (int k = 0; k < 2; ++k) dst[n][k] = *(const PG8_LAS bf16x8*)(lds + PG8_SB(b, h) + boff + n * 2048 + k * 1024); } while (0)
#define PG8_MMA(ai, bj, At, Bt) do { __builtin_amdgcn_s_setprio(1); _Pragma("unroll") for (int m = 0; m < 4; ++m) _Pragma("unroll") for (int n = 0; n < 2; ++n) _Pragma("unroll") for (int k = 0; k < 2; ++k) \
        acc[ai][bj][m][n] = __builtin_amdgcn_mfma_f32_16x16x32_bf16(Bt[n][k], At[m][k], acc[ai][bj][m][n], 0, 0, 0); __builtin_amdgcn_s_setprio(0); } while (0)
#define PG8_WAIT_V(n) asm volatile("s_waitcnt vmcnt(" #n ")" ::: "memory")
#define PG8_WAIT_L(n) asm volatile("s_waitcnt lgkmcnt(" #n ")" ::: "memory")
#define PG8_BAR __builtin_amdgcn_s_barrier()
#define PG8_SCHED __builtin_amdgcn_sched_barrier(0)
    Unit cur, nxt; int ui = 0;
    if (!S.next(0, cur)) return;
    f32x4 acc[2][2][4][2];
#pragma unroll
    for (int a = 0; a < 2; ++a)
#pragma unroll
        for (int b = 0; b < 2; ++b)
#pragma unroll
            for (int m = 0; m < 4; ++m)
#pragma unroll
                for (int n = 0; n < 2; ++n) acc[a][b][m][n] = (f32x4){0.f, 0.f, 0.f, 0.f};
    bf16x8 At[4][2], B0[2][2], B1[2][2];
    const char* cA = (const char*)g.A + (size_t)cur.pm * tstep; const char* cB = (const char*)g.Bt + (size_t)cur.pn * tstep;
    S.a_ready(cur);
    if constexpr (SP2) {
        PG8_STAGE(PG8_SB(0, 0), cB, voffB); PG8_STAGE(PG8_SB(0, 1), cB + hstep, voffB); PG8_STAGE(PG8_SA(0, 0), cA, voffA); PG8_STAGE(PG8_SA(0, 1), cA + hstep, voffA);
        if (wr == 1) PG8_BAR;
        PG8_WAIT_V(2); PG8_BAR;
        PG8_STAGE(PG8_SB(1, 0), cB + kstep, voffB); PG8_STAGE(PG8_SA(1, 0), cA + kstep, voffA); PG8_STAGE(PG8_SB(1, 1), cB + hstep + kstep, voffB);
        PG8_WAIT_V(6); PG8_BAR;
    } else {
        PG8_STAGE(PG8_SB(0, 0), cB, voffB); PG8_STAGE(PG8_SA(0, 0), cA, voffA); PG8_STAGE(PG8_SB(0, 1), cB + hstep, voffB); PG8_STAGE(PG8_SA(0, 1), cA + hstep, voffA);
        if (wr == 1) PG8_BAR;
        PG8_WAIT_V(4); PG8_BAR;
        PG8_STAGE(PG8_SB(1, 0), cB + kstep, voffB); PG8_STAGE(PG8_SA(1, 0), cA + kstep, voffA); PG8_STAGE(PG8_SB(1, 1), cB + hstep + kstep, voffB);
        PG8_WAIT_V(6); PG8_BAR;
    }
    for (;;) {
        const bool has_next = S.next(ui + 1, nxt);
        const char* nA = has_next ? (const char*)g.A + (size_t)nxt.pm * tstep : cA; const char* nB = has_next ? (const char*)g.Bt + (size_t)nxt.pn * tstep : cB;
        for (int t = 0; t < nt; t += 2) {
            const bool last = (t == nt - 2);
            const char* a1 = cA + (size_t)(t + 1) * kstep;
            const char* a2 = last ? nA : cA + (size_t)(t + 2) * kstep; const char* b2 = last ? nB : cB + (size_t)(t + 2) * kstep;
            const char* a3 = a2 + kstep; const char* b3 = b2 + kstep;
            if (last && has_next) S.a_ready(nxt);
            if constexpr (SP2) {
            PG8_LDB(B0, 0, 0); PG8_LDB(B1, 0, 1); PG8_SCHED; PG8_LDA(At, 0, 0); PG8_STAGE(PG8_SA(1, 1), a1 + hstep, voffA);
            PG8_WAIT_V(8); PG8_WAIT_L(0); PG8_BAR; PG8_MMA(0, 0, At, B0); PG8_MMA(0, 1, At, B1); PG8_BAR; PG8_SCHED;
            PG8_LDA(At, 0, 1); PG8_STAGE(PG8_SB(0, 0), b2, voffB); PG8_STAGE(PG8_SB(0, 1), b2 + hstep, voffB); PG8_STAGE(PG8_SA(0, 0), a2, voffA);
            PG8_WAIT_V(8); PG8_WAIT_L(0); PG8_BAR; PG8_MMA(1, 0, At, B0); PG8_MMA(1, 1, At, B1); PG8_BAR; PG8_SCHED;
            PG8_LDB(B0, 1, 0); PG8_LDB(B1, 1, 1); PG8_SCHED; PG8_LDA(At, 1, 0); PG8_STAGE(PG8_SA(0, 1), a2 + hstep, voffA);
            PG8_WAIT_V(8); PG8_WAIT_L(0); PG8_BAR; PG8_MMA(0, 0, At, B0); PG8_MMA(0, 1, At, B1); PG8_BAR; PG8_SCHED;
            PG8_LDA(At, 1, 1); PG8_STAGE(PG8_SB(1, 0), b3, voffB); PG8_STAGE(PG8_SB(1, 1), b3 + hstep, voffB); PG8_STAGE(PG8_SA(1, 0), a3, voffA);
            PG8_WAIT_V(8); PG8_WAIT_L(0); PG8_BAR; PG8_MMA(1, 0, At, B0); PG8_MMA(1, 1, At, B1); PG8_BAR; PG8_SCHED;
            } else {
            PG8_LDB(B0, 0, 0); PG8_SCHED; PG8_LDA(At, 0, 0); PG8_STAGE(PG8_SA(1, 1), a1 + hstep, voffA);
            PG8_WAIT_L(8); PG8_BAR; PG8_WAIT_L(0); PG8_MMA(0, 0, At, B0); PG8_BAR; PG8_SCHED;
            PG8_LDB(B1, 0, 1); PG8_STAGE(PG8_SB(0, 0), b2, voffB);
            PG8_BAR; PG8_WAIT_L(0); PG8_MMA(0, 1, At, B1); PG8_BAR;
            PG8_LDA(At, 0, 1); PG8_STAGE(PG8_SA(0, 0), a2, voffA);
            PG8_BAR; PG8_WAIT_L(0); PG8_MMA(1, 0, At, B0); PG8_BAR; PG8_SCHED;
            PG8_STAGE(PG8_SB(0, 1), b2 + hstep, voffB);
            PG8_WAIT_V(6); PG8_BAR; PG8_MMA(1, 1, At, B1); PG8_BAR;
            PG8_LDB(B0, 1, 0); PG8_SCHED; PG8_LDA(At, 1, 0); PG8_STAGE(PG8_SA(0, 1), a2 + hstep, voffA);
            PG8_WAIT_L(8); PG8_BAR; PG8_WAIT_L(0); PG8_MMA(0, 0, At, B0); PG8_BAR; PG8_SCHED;
            PG8_LDB(B1, 1, 1); PG8_STAGE(PG8_SB(1, 0), b3, voffB);
            PG8_BAR; PG8_WAIT_L(0); PG8_MMA(0, 1, At, B1); PG8_BAR;
            PG8_LDA(At, 1, 1); PG8_STAGE(PG8_SA(1, 0), a3, voffA);
            PG8_BAR; PG8_WAIT_L(0); PG8_MMA(1, 0, At, B0); PG8_BAR; PG8_SCHED;
            PG8_STAGE(PG8_SB(1, 1), b3 + hstep, voffB);
            PG8_WAIT_V(6); PG8_BAR; PG8_MMA(1, 1, At, B1); PG8_BAR;
            }
        }
        if constexpr (ALIGN_EPI) { if (wr == 0) PG8_BAR; }
        if constexpr (!Epi::AFTER_DRAIN) { E(acc, cur, wr, wc, fr, fq); S.done(cur); }
        if (!has_next) break;
#pragma unroll
        for (int a = 0; a < 2; ++a)
#pragma unroll
            for (int b = 0; b < 2; ++b)
#pragma unroll
                for (int m = 0; m < 4; ++m)
#pragma unroll
                    for (int n = 0; n < 2; ++n) acc[a][b][m][n] = (f32x4){0.f, 0.f, 0.f, 0.f};
        cur = nxt; cA = nA; cB = nB; ++ui;
        if constexpr (ALIGN_EPI) { if (wr == 1) PG8_BAR; }
    }
    PG8_WAIT_V(0);
    if constexpr (!ALIGN_EPI) { if (wr == 0) PG8_BAR; }
    PG8_BAR;
    if constexpr (Epi::AFTER_DRAIN) { E.fused(acc, cur, wr, wc, fr, fq, lds, wid, lane); S.done(cur); }
#undef PG8_SA
#undef PG8_SB
#undef PG8_STAGE
#undef PG8_LDA
#undef PG8_LDB
#undef PG8_MMA
#undef PG8_WAIT_V
#undef PG8_WAIT_L
#undef PG8_BAR
#undef PG8_SCHED
}
}


constexpr int DM = 1024, NB_P = 8, T_P = 2048, NB_S = 32, T_S = 32, PAST = 1024;
constexpr int MP = NB_P * T_P, MS = NB_S * T_S, MT = MP + MS;
constexpr int LS = PAST + T_S;
constexpr int SHIFTW = 1696, NZ = 3328, ZRW = 1632, DFF = 4096;
constexpr float QSCALE = 0.125f * 1.4426950408889634f;
constexpr float WISCALE = 0.35355339059327373f * 0.125f;
constexpr size_t OFF_Y = 0, OFF_KP = 17825792, OFF_VP = OFF_KP + 4194304, OFF_KIP = OFF_VP + 4194304, OFF_WKVP = OFF_KIP + 1048576, OFF_SHP = OFF_WKVP + 262144,
                 OFF_KS = OFF_SHP + 13568, OFF_VS = OFF_KS + 262144, OFF_KIS = OFF_VS + 262144, OFF_WKVS = OFF_KIS + 65536, OFF_SHS = OFF_WKVS + 1048576, OUT_TOTAL = OFF_SHS + 54272;
constexpr size_t MiB = 1u << 20;
constexpr size_t WS_CTL = 0, CTL_BYTES = 1 * MiB;
constexpr size_t WS_WIN = 1 * MiB, WS_WOUT = 8 * MiB, WS_W1 = 10 * MiB, WS_W2 = 18 * MiB;
constexpr size_t WS_W2T = 26 * MiB, WS_A2T = WS_W2T + 32768, WS_G2T = WS_A2T + 32768, WS_WI = 27 * MiB, WS_BONUS = 28 * MiB;
constexpr size_t WS_XB = 30 * MiB;
constexpr size_t WS_ZS = 66 * MiB;
constexpr size_t WS_R = 123 * MiB;
constexpr size_t WS_ZR = WS_R, WS_KBP = 178 * MiB, WS_VTP = 186 * MiB, WS_KIP = 194 * MiB, WS_KBS = 196 * MiB, WS_VTS = 213 * MiB, WS_KIS = 230 * MiB;
constexpr size_t WS_OW = WS_R, WS_OKK = 157 * MiB, WS_OB = 174 * MiB, WS_OKM = 191 * MiB, WS_OR = 208 * MiB, WS_OV = 225 * MiB;
constexpr size_t WS_ACT = 66 * MiB, WS_HB = 202 * MiB, WS_END = 256 * MiB;
static_assert(WS_ZS + (size_t)MT * SHIFTW * 2 <= WS_R && WS_ZR + (size_t)MT * ZRW * 2 <= WS_KBP && WS_KBS + (size_t)NB_S * LS * 256 * 2 <= WS_VTS && WS_VTS + (size_t)NB_S * 256 * LS * 2 <= WS_KIS &&
              WS_KIS + (size_t)NB_S * LS * 64 * 2 <= WS_END && WS_OV + (size_t)MT * 512 * 2 <= WS_END && WS_ACT + (size_t)MT * DFF * 2 <= WS_HB && WS_HB + (size_t)MT * DM * 2 <= WS_END, "d_ws map");
constexpr size_t SC_Q = 0, SC_QI = (size_t)MT * 512 / 2, SC_Y = 0, SC_G = (size_t)MT * 512;
constexpr int CW_QATT = 64;

typedef unsigned short bf16;
typedef short bf16x8 __attribute__((ext_vector_type(8)));
typedef float f32x4 __attribute__((ext_vector_type(4)));
typedef float f32x16 __attribute__((ext_vector_type(16)));
typedef unsigned u32x4 __attribute__((ext_vector_type(4)));
typedef unsigned u32x2 __attribute__((ext_vector_type(2)));

__device__ __forceinline__ unsigned f2bf(float f) { unsigned u = __float_as_uint(f); return (u + 0x7fffu + ((u >> 16) & 1u)) >> 16; }
__device__ __forceinline__ unsigned pk2(float lo, float hi) { return f2bf(lo) | (f2bf(hi) << 16); }
__device__ __forceinline__ float bflo(unsigned w) { return __uint_as_float(w << 16); }
__device__ __forceinline__ float bfhi(unsigned w) { return __uint_as_float(w & 0xffff0000u); }
__device__ __forceinline__ float bf1(bf16 b) { return __uint_as_float((unsigned)b << 16); }
__device__ __forceinline__ void unpack8(const u32x4 w, float* x) { x[0] = bflo(w.x); x[1] = bfhi(w.x); x[2] = bflo(w.y); x[3] = bfhi(w.y); x[4] = bflo(w.z); x[5] = bfhi(w.z); x[6] = bflo(w.w); x[7] = bfhi(w.w); }
__device__ __forceinline__ u32x4 pack8(const float* x) { u32x4 w; w.x = pk2(x[0], x[1]); w.y = pk2(x[2], x[3]); w.z = pk2(x[4], x[5]); w.w = pk2(x[6], x[7]); return w; }
__device__ __forceinline__ float wave_sum(float v) {
#pragma unroll
    for (int o = 1; o < 64; o <<= 1) v += __shfl_xor(v, o);
    return v;
}
template <int CTRL> __device__ __forceinline__ float dppmov(float x) { return __builtin_bit_cast(float, __builtin_amdgcn_update_dpp(0, __builtin_bit_cast(int, x), CTRL, 0xf, 0xf, true)); }
__device__ __forceinline__ float sum16(float x) {
    x += dppmov<0xB1>(x); x += dppmov<0x4E>(x); x += dppmov<0x141>(x); x += dppmov<0x140>(x); return x;
}
__device__ __forceinline__ int crow(int r, int hi) { return (r & 3) + 8 * (r >> 2) + 4 * hi; }

struct Args { const float* in[28]; float* out; unsigned char* ws; int ph_lo, ph_hi; };

__device__ __forceinline__ void tr_item(const float* W, int K, int N, const float* gain, bf16* WT, int jr0, int c0, int nvalid, int k0, float* scr, int lane) {
#pragma unroll 8
    for (int i = 0; i < 32; ++i) { const int kk = 2 * i + (lane >> 5), n = lane & 31;
        float v = (n < nvalid) ? W[(size_t)(k0 + kk) * N + c0 + n] : 0.f; if (gain) v *= gain[k0 + kk]; scr[kk * 33 + n] = v; }
    __builtin_amdgcn_s_waitcnt(0xC07F); asm volatile("" ::: "memory");
    const int c = lane & 7;
#pragma unroll
    for (int j = 0; j < 4; ++j) { const int n = (lane >> 3) + 8 * j; const float* s = scr + (8 * c) * 33 + n;
        u32x4 o; o.x = pk2(s[0 * 33], s[1 * 33]); o.y = pk2(s[2 * 33], s[3 * 33]); o.z = pk2(s[4 * 33], s[5 * 33]); o.w = pk2(s[6 * 33], s[7 * 33]);
        *(u32x4*)(WT + (size_t)(jr0 + n) * K + k0 + 8 * c) = o; }
    __builtin_amdgcn_s_waitcnt(0xC07F); asm volatile("" ::: "memory");
}
__device__ __forceinline__ void p0_prologue(const Args& a, unsigned char* lds, int tid) {
    const int lane = tid & 63, wave = tid >> 6, gw = blockIdx.x * 8 + wave, NGW = gridDim.x * 8;
    float* scr = (float*)(lds + wave * 17408);
    unsigned char* ws = a.ws;
    constexpr int I_IN = (NZ / 32) * (DM / 64), I_OUT = (DM / 32) * (DM / 64), I_F1 = (DFF / 32) * (DM / 64), I_F2 = (DM / 32) * (DFF / 64);
    for (int it = gw; it < I_IN + I_OUT + I_F1 + I_F2; it += NGW) {
        int r = it;
        if (r < I_IN) { const int jb = r % (NZ / 32), kb = r / (NZ / 32), j0 = jb * 32; int c0, nv;
            if (j0 < 1600) { c0 = j0; nv = 32; } else if (j0 < 3296) { c0 = 1608 + (j0 - 1600); nv = 32; } else { c0 = 1600; nv = 8; }
            tr_item(a.in[8], DM, 3304, a.in[7], (bf16*)(ws + WS_WIN), j0, c0, nv, kb * 64, scr, lane); continue; }
        r -= I_IN;
        if (r < I_OUT) { const int jb = r % (DM / 32), kb = r / (DM / 32); tr_item(a.in[24], DM, DM, nullptr, (bf16*)(ws + WS_WOUT), jb * 32, jb * 32, 32, kb * 64, scr, lane); continue; }
        r -= I_OUT;
        if (r < I_F1) { const int jb = r % (DFF / 32), kb = r / (DFF / 32); tr_item(a.in[26], DM, DFF, a.in[25], (bf16*)(ws + WS_W1), jb * 32, jb * 32, 32, kb * 64, scr, lane); continue; }
        r -= I_F1;
        { const int jb = r % (DM / 32), kb = r / (DM / 32); tr_item(a.in[27], DFF, DM, nullptr, (bf16*)(ws + WS_W2), jb * 32, jb * 32, 32, kb * 64, scr, lane); }
    }
    { const int gt = blockIdx.x * 512 + tid, NT = gridDim.x * 512;
      bf16* w2t = (bf16*)(ws + WS_W2T); bf16* a2t = (bf16*)(ws + WS_A2T); bf16* g2t = (bf16*)(ws + WS_G2T);
      for (int i = gt; i < 512 * 32; i += NT) { const int n = i >> 5, k = i & 31; w2t[i] = (bf16)f2bf(a.in[15][k * 512 + n]); a2t[i] = (bf16)f2bf(a.in[17][k * 512 + n]); }
      for (int i = gt; i < 512 * 96; i += NT) { const int n = i / 96, k = i % 96; g2t[i] = (bf16)f2bf(a.in[18][k * 512 + n]); } }
    for (int m = gw; m < MT; m += NGW) {
        const float* xrow = (m < MP) ? a.in[0] + (size_t)m * DM : a.in[1] + (size_t)(m - MP) * DM;
        const f32x4* xr = (const f32x4*)xrow + lane; f32x4 v[4]; float s = 0.f;
#pragma unroll
        for (int j = 0; j < 4; ++j) { v[j] = xr[64 * j]; s += (v[j].x * v[j].x + v[j].y * v[j].y) + (v[j].z * v[j].z + v[j].w * v[j].w); }
        const float rs = rsqrtf(wave_sum(s) * (1.f / DM) + 1e-6f);
        u32x2* o8 = (u32x2*)((bf16*)(ws + WS_XB) + (size_t)m * DM) + lane;
#pragma unroll
        for (int j = 0; j < 4; ++j) { u32x2 o; o.x = pk2(v[j].x * rs, v[j].y * rs); o.y = pk2(v[j].z * rs, v[j].w * rs); o8[64 * j] = o; }
    }
    for (int rix = gw; rix < NB_S * PAST; rix += NGW) {
        const int b = rix >> 10, p = rix & 1023; const f32x4 v = ((const f32x4*)(a.in[2] + (size_t)rix * 256))[lane];
        u32x2 o; o.x = pk2(v.x, v.y); o.y = pk2(v.z, v.w); ((u32x2*)((bf16*)(ws + WS_KBS) + ((size_t)b * LS + p) * 256))[lane] = o;
    }
    for (int r4 = gw; r4 < NB_S * PAST / 4; r4 += NGW) {
        const int rix = r4 * 4 + (lane >> 4), b = rix >> 10, p = rix & 1023; const f32x4 v = ((const f32x4*)(a.in[4] + (size_t)rix * 64))[lane & 15];
        u32x2 o; o.x = pk2(v.x, v.y); o.y = pk2(v.z, v.w); ((u32x2*)((bf16*)(ws + WS_KIS) + ((size_t)b * LS + p) * 64))[lane & 15] = o;
    }
    for (int it = gw; it < NB_S * 4 * 16; it += NGW) {
        const int kb = it & 15, g = (it >> 4) & 3, b = it >> 6;
        const float* src = a.in[3] + ((size_t)b * PAST + kb * 64) * 256 + g * 64;
#pragma unroll 8
        for (int i = 0; i < 64; ++i) scr[i * 65 + lane] = src[(size_t)i * 256 + lane];
        __builtin_amdgcn_s_waitcnt(0xC07F); asm volatile("" ::: "memory");
        bf16* dst = (bf16*)(ws + WS_VTS) + ((size_t)(b * 4 + g) * 64) * LS + kb * 64 + lane;
#pragma unroll 8
        for (int d = 0; d < 64; ++d) dst[(size_t)d * LS] = (bf16)f2bf(scr[lane * 65 + d]);
        __builtin_amdgcn_s_waitcnt(0xC07F); asm volatile("" ::: "memory");
    }
}

__device__ __forceinline__ void p2_post(const Args& a, unsigned char* lds, int tid) {
    unsigned char* ws = a.ws; float* out = a.out;
    const bf16* ZR = (const bf16*)(ws + WS_ZR); const bf16* ZS = (const bf16*)(ws + WS_ZS);
    bf16* Q = (bf16*)(out + SC_Q); bf16* QI = (bf16*)(out + SC_QI);
    float* cs = (float*)lds;
    bf16* vt = (bf16*)(lds + 4096);
    const int g8 = tid >> 3, sub = tid & 7;
    const float* qg = a.in[9]; const float* kg = a.in[10]; const float* lng = a.in[11]; const float* lnb = a.in[12];
    for (int tile = blockIdx.x; tile < MT / 64; tile += gridDim.x) {
        const int m0 = tile * 64;
        { const int m = m0 + g8, pos = (m < MP) ? (m & (T_P - 1)) : (PAST + ((m - MP) & (T_S - 1)));
          const float inv = powf(500000.0f, -(float)sub * 0.125f); const float ang = (float)pos * inv; float s, c; sincosf(ang, &s, &c);
          cs[g8 * 16 + sub] = c; cs[g8 * 16 + 8 + sub] = s; }
        __syncthreads();
        const int m = m0 + g8;
        const bool isp = m < MP; const int ms = m - MP;
        float cc[8], ss[8];
#pragma unroll
        for (int j = 0; j < 8; ++j) { cc[j] = cs[g8 * 16 + j]; ss[j] = cs[g8 * 16 + 8 + j]; }
        const size_t kvrow = isp ? (size_t)m : ((size_t)(ms >> 5) * LS + PAST + (ms & 31));
        bf16* KB = (bf16*)(ws + (isp ? WS_KBP : WS_KBS)); bf16* KIb = (bf16*)(ws + (isp ? WS_KIP : WS_KIS));
        for (int hb = 0; hb < 25; ++hb) {
            float x[8]; unpack8(*(const u32x4*)(ZR + (size_t)m * ZRW + hb * 64 + 8 * sub), x);
            if (hb < 12) {
                float s2 = 0.f;
#pragma unroll
                for (int j = 0; j < 8; ++j) s2 += x[j] * x[j];
                s2 += __shfl_xor(s2, 1); s2 += __shfl_xor(s2, 2); s2 += __shfl_xor(s2, 4);
                const float rinv = rsqrtf(s2 * (1.f / 64.f) + 1e-6f); const float* gn = (hb < 8 ? qg : kg) + 8 * sub;
                float y[8], o[8];
#pragma unroll
                for (int j = 0; j < 8; ++j) y[j] = x[j] * rinv * gn[j];
#pragma unroll
                for (int j = 0; j < 8; ++j) { const float p = __shfl_xor(y[j], 1); o[j] = sub == 0 ? y[j] * cc[j] - p * ss[j] : (sub == 1 ? y[j] * cc[j] + p * ss[j] : y[j]); }
                if (hb < 8) {
#pragma unroll
                    for (int j = 0; j < 8; ++j) o[j] *= QSCALE;
                    *(u32x4*)(Q + (size_t)m * 512 + hb * 64 + 8 * sub) = pack8(o);
                } else { const int g = hb - 8;
                    float* ko = out + (isp ? OFF_KP + (size_t)m * 256 : OFF_KS + (size_t)ms * 256) + g * 64 + 8 * sub;
                    *(f32x4*)ko = (f32x4){o[0], o[1], o[2], o[3]}; *(f32x4*)(ko + 4) = (f32x4){o[4], o[5], o[6], o[7]};
                    *(u32x4*)(KB + kvrow * 256 + g * 64 + 8 * sub) = pack8(o); }
            } else if (hb < 16) { const int g = hb - 12;
                float* vo = out + (isp ? OFF_VP + (size_t)m * 256 : OFF_VS + (size_t)ms * 256) + g * 64 + 8 * sub;
                *(f32x4*)vo = (f32x4){x[0], x[1], x[2], x[3]}; *(f32x4*)(vo + 4) = (f32x4){x[4], x[5], x[6], x[7]};
                unsigned* vd = (unsigned*)(vt + g8 * 258 + g * 64 + 8 * sub);
                vd[0] = pk2(x[0], x[1]); vd[1] = pk2(x[2], x[3]); vd[2] = pk2(x[4], x[5]); vd[3] = pk2(x[6], x[7]);
            } else if (hb < 24) {
                float o[8];
#pragma unroll
                for (int j = 0; j < 8; ++j) { const float p = __shfl_xor(x[j], 1); o[j] = sub == 0 ? x[j] * cc[j] - p * ss[j] : (sub == 1 ? x[j] * cc[j] + p * ss[j] : x[j]); }
                *(u32x4*)(QI + (size_t)m * 512 + (hb - 16) * 64 + 8 * sub) = pack8(o);
            } else {
                float s1 = 0.f;
#pragma unroll
                for (int j = 0; j < 8; ++j) s1 += x[j];
                s1 += __shfl_xor(s1, 1); s1 += __shfl_xor(s1, 2); s1 += __shfl_xor(s1, 4);
                const float mu = s1 * (1.f / 64.f); float s2 = 0.f;
#pragma unroll
                for (int j = 0; j < 8; ++j) { const float d = x[j] - mu; s2 += d * d; }
                s2 += __shfl_xor(s2, 1); s2 += __shfl_xor(s2, 2); s2 += __shfl_xor(s2, 4);
                const float rinv = rsqrtf(s2 * (1.f / 64.f) + 1e-6f); float y[8], o[8];
#pragma unroll
                for (int j = 0; j < 8; ++j) y[j] = (x[j] - mu) * rinv * lng[8 * sub + j] + lnb[8 * sub + j];
#pragma unroll
                for (int j = 0; j < 8; ++j) { const float p = __shfl_xor(y[j], 1); o[j] = sub == 0 ? y[j] * cc[j] - p * ss[j] : (sub == 1 ? y[j] * cc[j] + p * ss[j] : y[j]); }
                float* ko = out + (isp ? OFF_KIP + (size_t)m * 64 : OFF_KIS + (size_t)ms * 64) + 8 * sub;
                *(f32x4*)ko = (f32x4){o[0], o[1], o[2], o[3]}; *(f32x4*)(ko + 4) = (f32x4){o[4], o[5], o[6], o[7]};
                *(u32x4*)(KIb + kvrow * 64 + 8 * sub) = pack8(o);
            }
        }
        ((float*)(ws + WS_WI))[(size_t)m * 8 + sub] = bf1(ZR[(size_t)m * ZRW + 1600 + sub]) * WISCALE;
        __syncthreads();
        { const int r = tid >> 1, half = tid & 1; unsigned wv[16];
#pragma unroll
          for (int j = 0; j < 16; ++j) wv[j] = (unsigned)vt[(32 * half + 2 * j) * 258 + r] | ((unsigned)vt[(32 * half + 2 * j + 1) * 258 + r] << 16);
          bf16* dst;
          if (m0 < MP) dst = (bf16*)(ws + WS_VTP) + ((size_t)(m0 >> 11) * 256 + r) * T_P + (m0 & (T_P - 1)) + 32 * half;
          else { const int b = ((m0 - MP) >> 5) + half; dst = (bf16*)(ws + WS_VTS) + ((size_t)b * 256 + r) * LS + PAST; }
#pragma unroll
          for (int j = 0; j < 4; ++j) ((u32x4*)dst)[j] = (u32x4){wv[4 * j], wv[4 * j + 1], wv[4 * j + 2], wv[4 * j + 3]}; }
        if (m0 < MP) { if ((m0 & (T_P - 1)) == T_P - 64) { const int b = m0 >> 11; const bf16* zr = ZS + (size_t)(m0 + 63) * SHIFTW;
                for (int c = tid; c < SHIFTW; c += 512) out[OFF_SHP + (size_t)b * SHIFTW + c] = bf1(zr[c]); } }
        else { for (int h2 = 0; h2 < 2; ++h2) { const int b = ((m0 - MP) >> 5) + h2; const bf16* zr = ZS + (size_t)(m0 + 32 * h2 + 31) * SHIFTW;
                for (int c = tid; c < SHIFTW; c += 512) out[OFF_SHS + (size_t)b * SHIFTW + c] = bf1(zr[c]); } }
        __syncthreads();
    }
}

constexpr int ATT_UNITS = 544;
constexpr int MASK_PITCH = 65;
#define MFMA32(a, b, c) __builtin_amdgcn_mfma_f32_32x32x16_bf16((a), (b), (c), 0, 0, 0)

__device__ __forceinline__ float half_sum32(float v) { v += __shfl_xor(v, 1); v += __shfl_xor(v, 2); v += __shfl_xor(v, 4); v += __shfl_xor(v, 8); v += __shfl_xor(v, 16); return v; }
__device__ __forceinline__ float half_min32(float v) { v = fminf(v, __shfl_xor(v, 1)); v = fminf(v, __shfl_xor(v, 2)); v = fminf(v, __shfl_xor(v, 4)); v = fminf(v, __shfl_xor(v, 8)); v = fminf(v, __shfl_xor(v, 16)); return v; }
__device__ __forceinline__ float half_max32(float v) { v = fmaxf(v, __shfl_xor(v, 1)); v = fmaxf(v, __shfl_xor(v, 2)); v = fmaxf(v, __shfl_xor(v, 4)); v = fmaxf(v, __shfl_xor(v, 8)); v = fmaxf(v, __shfl_xor(v, 16)); return v; }
__device__ __forceinline__ int half_sum32i(int v) { v += __shfl_xor(v, 1); v += __shfl_xor(v, 2); v += __shfl_xor(v, 4); v += __shfl_xor(v, 8); v += __shfl_xor(v, 16); return v; }

__device__ __forceinline__ void p3_attention(const Args& a, unsigned char* lds, int tid) {
    unsigned char* ws = a.ws; float* out = a.out;
    const bf16* Q = (const bf16*)(out + SC_Q); const bf16* QI = (const bf16*)(out + SC_QI); const float* WI = (const float*)(ws + WS_WI);
    bf16* O = (bf16*)(ws + WS_XB);
    unsigned* maskw = (unsigned*)lds;
    float* lsum = (float*)(lds + 32 * MASK_PITCH * 4);
    int* s_unit = (int*)(lds + 32 * MASK_PITCH * 4 + 1024);
    typedef float f32x2_t __attribute__((ext_vector_type(2)));
    f32x2_t* scl = (f32x2_t*)(lds + 10240) + (size_t)(tid >> 6) * 2048 + (tid & 63);
    unsigned* qctr = (unsigned*)(ws + WS_CTL) + CW_QATT;
    const int l = tid & 63, w = __builtin_amdgcn_readfirstlane(tid >> 6), rho = l & 31, hi = l >> 5;
    for (;;) {
        if (tid == 0) *s_unit = (int)atomicAdd(qctr, 1u);
        __syncthreads();
        const int p = *s_unit;
        __syncthreads();
        if (p >= ATT_UNITS) break;
        int m0, nkt, vpitch; const bf16 *KB, *VT, *KI; bool need_idx;
        { int c = -1, b, half = 0;
          if (p < 256) { c = 31 - (p >> 4); b = (p & 15) >> 1; half = p & 1; }
          else if (p < 288) { b = p - 256; }
          else { const int pp = p - 288; c = 15 - (pp >> 4); b = (pp & 15) >> 1; half = pp & 1; }
          if (c >= 0) { m0 = b * T_P + 64 * c + 32 * half; nkt = 2 * (c + 1); vpitch = T_P; need_idx = c >= 4;
              KB = (const bf16*)(ws + WS_KBP) + (size_t)b * T_P * 256; VT = (const bf16*)(ws + WS_VTP) + (size_t)b * 256 * T_P; KI = (const bf16*)(ws + WS_KIP) + (size_t)b * T_P * 64; }
          else { m0 = MP + 32 * b; nkt = LS / 32; vpitch = LS; need_idx = true;
              KB = (const bf16*)(ws + WS_KBS) + (size_t)b * LS * 256; VT = (const bf16*)(ws + WS_VTS) + (size_t)b * 256 * LS; KI = (const bf16*)(ws + WS_KIS) + (size_t)b * LS * 64; } }
        if (need_idx) {
            const int tokA = 4 * w + 2 * ((rho >> 2) & 1) + (rho >> 4), headA = (rho & 3) + 4 * ((rho >> 3) & 1);
            bf16x8 qa[4];
#pragma unroll
            for (int ks = 0; ks < 4; ++ks) qa[ks] = *(const bf16x8*)(QI + (size_t)(m0 + tokA) * 512 + headA * 64 + 16 * ks + 8 * hi);
            float wv[16];
#pragma unroll
            for (int r = 0; r < 16; ++r) wv[r] = WI[(size_t)(m0 + 4 * w + 2 * hi + (r >> 3)) * 8 + (r & 7)];
            float sc0[32], sc1[32];
            bf16x8 kb[4];
            const bf16* kip = KI + (size_t)rho * 64 + 8 * hi;
#pragma unroll
            for (int ks = 0; ks < 4; ++ks) kb[ks] = *(const bf16x8*)(kip + 16 * ks);
#pragma unroll
            for (int kt = 0; kt < 64; ++kt) {
                if (kt < nkt) {
                    f32x16 acc = {0.f, 0.f, 0.f, 0.f, 0.f, 0.f, 0.f, 0.f, 0.f, 0.f, 0.f, 0.f, 0.f, 0.f, 0.f, 0.f};
#pragma unroll
                    for (int ks = 0; ks < 4; ++ks) acc = MFMA32(qa[ks], kb[ks], acc);
                    if (kt + 1 < nkt) {
#pragma unroll
                        for (int ks = 0; ks < 4; ++ks) kb[ks] = *(const bf16x8*)(kip + (size_t)(kt + 1) * 32 * 64 + 16 * ks);
                    }
                    float s0 = 0.f, s1 = 0.f;
#pragma unroll
                    for (int r = 0; r < 8; ++r) { s0 += wv[r] * fmaxf(acc[r], 0.f); s1 += wv[8 + r] * fmaxf(acc[8 + r], 0.f); }
                    if (kt < 32) { sc0[kt & 31] = s0; sc1[kt & 31] = s1; } else scl[(kt - 32) * 64] = (f32x2_t){s0, s1};
                } else if (kt < 32) { sc0[kt & 31] = -3.0e38f; sc1[kt & 31] = -3.0e38f; }
            }
            float mn0 = 3.0e38f, mx0 = -3.0e38f, mn1 = 3.0e38f, mx1 = -3.0e38f;
#pragma unroll
            for (int kt = 0; kt < 64; ++kt) if (kt < nkt) { float v0, v1; if (kt < 32) { v0 = sc0[kt & 31]; v1 = sc1[kt & 31]; } else { const f32x2_t t2 = scl[(kt - 32) * 64]; v0 = t2.x; v1 = t2.y; }
                mn0 = fminf(mn0, v0); mx0 = fmaxf(mx0, v0); mn1 = fminf(mn1, v1); mx1 = fmaxf(mx1, v1); }
            mn0 = half_min32(mn0); mx0 = half_max32(mx0); mn1 = half_min32(mn1); mx1 = half_max32(mx1);
            float lo0 = mn0 - 1.0f, hi0 = mx0, lo1 = mn1 - 1.0f, hi1 = mx1, thr0 = 0.f, thr1 = 0.f; int ch0 = 0, ch1 = 0, nt0 = 0, nt1 = 0; bool fin0 = false, fin1 = false;
            for (int iter = 0; iter < 200; ++iter) {
                const float mid0 = lo0 + 0.5f * (hi0 - lo0), mid1 = lo1 + 0.5f * (hi1 - lo1);
                int c0 = 0, c1 = 0;
#pragma unroll
                for (int g = 0; g < 4; ++g) if (8 * g < nkt) {
#pragma unroll
                    for (int k8 = 0; k8 < 8; ++k8) { c0 += sc0[8 * g + k8] > mid0 ? 1 : 0; c1 += sc1[8 * g + k8] > mid1 ? 1 : 0; } }
                for (int kt = 32; kt < nkt; ++kt) { const f32x2_t t2 = scl[(kt - 32) * 64]; c0 += t2.x > mid0 ? 1 : 0; c1 += t2.y > mid1 ? 1 : 0; }
                c0 = half_sum32i(c0); c1 = half_sum32i(c1);
                if (!fin0) { if (!(mid0 > lo0 && mid0 < hi0)) { fin0 = true; thr0 = hi0; nt0 = 256 - ch0; }
                             else if (c0 == 256) { fin0 = true; thr0 = mid0; nt0 = 0; } else if (c0 > 256) lo0 = mid0; else { hi0 = mid0; ch0 = c0; } }
                if (!fin1) { if (!(mid1 > lo1 && mid1 < hi1)) { fin1 = true; thr1 = hi1; nt1 = 256 - ch1; }
                             else if (c1 == 256) { fin1 = true; thr1 = mid1; nt1 = 0; } else if (c1 > 256) lo1 = mid1; else { hi1 = mid1; ch1 = c1; } }
                if (__all(fin0 && fin1)) break;
            }
            const bool any_tie = __any(nt0 > 0 || nt1 > 0);
            int run0 = 0, run1 = 0; const unsigned below = (1u << rho) - 1u;
#pragma unroll
            for (int kt = 0; kt < 64; ++kt) if (kt < nkt) {
                float v0, v1; if (kt < 32) { v0 = sc0[kt & 31]; v1 = sc1[kt & 31]; } else { const f32x2_t t2 = scl[(kt - 32) * 64]; v0 = t2.x; v1 = t2.y; }
                bool p0 = v0 > thr0, p1 = v1 > thr1;
                if (any_tie) {
                    const bool e0 = nt0 > 0 && v0 == thr0, e1 = nt1 > 0 && v1 == thr1;
                    const unsigned long long be0 = __ballot(e0), be1 = __ballot(e1);
                    const unsigned h0 = (unsigned)(be0 >> (32 * hi)), h1 = (unsigned)(be1 >> (32 * hi));
                    p0 = p0 || (e0 && (run0 + __popc(h0 & below)) < nt0); p1 = p1 || (e1 && (run1 + __popc(h1 & below)) < nt1);
                    run0 += __popc(h0); run1 += __popc(h1);
                }
                const unsigned long long b0 = __ballot(p0), b1 = __ballot(p1);
                if (l == 0) { maskw[(4 * w + 0) * MASK_PITCH + kt] = (unsigned)b0; maskw[(4 * w + 1) * MASK_PITCH + kt] = (unsigned)b1; }
                if (l == 32) { maskw[(4 * w + 2) * MASK_PITCH + kt] = (unsigned)(b0 >> 32); maskw[(4 * w + 3) * MASK_PITCH + kt] = (unsigned)(b1 >> 32); }
            }
        }
        __syncthreads();
        {
            const int g = w >> 1;
            bf16x8 qb[4];
#pragma unroll
            for (int ks = 0; ks < 4; ++ks) qb[ks] = *(const bf16x8*)(Q + (size_t)(m0 + rho) * 512 + w * 64 + 16 * ks + 8 * hi);
            const bf16* Kp = KB + (size_t)rho * 256 + g * 64 + 8 * hi;
            const bf16* Vp = VT + ((size_t)g * 64 + rho) * vpitch + 4 * hi;
            f32x16 o0 = {0.f, 0.f, 0.f, 0.f, 0.f, 0.f, 0.f, 0.f, 0.f, 0.f, 0.f, 0.f, 0.f, 0.f, 0.f, 0.f}, o1 = o0; float psum = 0.f;
            bf16x8 ka[2][4]; u32x2 vb[2][2][2][2];
#define ATT_LOAD(buf, kt_) do { _Pragma("unroll") for (int ks = 0; ks < 4; ++ks) ka[buf][ks] = *(const bf16x8*)(Kp + (size_t)(kt_) * 32 * 256 + 16 * ks); \
            _Pragma("unroll") for (int s = 0; s < 2; ++s) _Pragma("unroll") for (int dt = 0; dt < 2; ++dt) { const bf16* vp_ = Vp + (size_t)dt * 32 * vpitch + (kt_) * 32 + 16 * s; \
                vb[buf][s][dt][0] = *(const u32x2*)vp_; vb[buf][s][dt][1] = *(const u32x2*)(vp_ + 8); } } while (0)
#define ATT_COMPUTE(buf, kt_) do { f32x16 st = {0.f, 0.f, 0.f, 0.f, 0.f, 0.f, 0.f, 0.f, 0.f, 0.f, 0.f, 0.f, 0.f, 0.f, 0.f, 0.f}; \
            _Pragma("unroll") for (int ks = 0; ks < 4; ++ks) st = MFMA32(ka[buf][ks], qb[ks], st); \
            unsigned word = need_idx ? maskw[rho * MASK_PITCH + (kt_)] : 0xffffffffu; word >>= 4 * hi; float pr[16]; \
            _Pragma("unroll") for (int r = 0; r < 16; ++r) { const float e = __builtin_amdgcn_exp2f(st[r]); pr[r] = ((word >> ((r & 3) + 8 * (r >> 2))) & 1u) ? e : 0.f; psum += pr[r]; } \
            union { u32x4 u; bf16x8 v; } pa0, pa1; pa0.u = (u32x4){pk2(pr[0], pr[1]), pk2(pr[2], pr[3]), pk2(pr[4], pr[5]), pk2(pr[6], pr[7])}; pa1.u = (u32x4){pk2(pr[8], pr[9]), pk2(pr[10], pr[11]), pk2(pr[12], pr[13]), pk2(pr[14], pr[15])}; \
            union { u32x4 u; bf16x8 v; } v00, v01, v10, v11; v00.u = (u32x4){vb[buf][0][0][0].x, vb[buf][0][0][0].y, vb[buf][0][0][1].x, vb[buf][0][0][1].y}; v01.u = (u32x4){vb[buf][0][1][0].x, vb[buf][0][1][0].y, vb[buf][0][1][1].x, vb[buf][0][1][1].y}; \
            v10.u = (u32x4){vb[buf][1][0][0].x, vb[buf][1][0][0].y, vb[buf][1][0][1].x, vb[buf][1][0][1].y}; v11.u = (u32x4){vb[buf][1][1][0].x, vb[buf][1][1][0].y, vb[buf][1][1][1].x, vb[buf][1][1][1].y}; \
            o0 = MFMA32(pa0.v, v00.v, o0); o0 = MFMA32(pa1.v, v10.v, o0); o1 = MFMA32(pa0.v, v01.v, o1); o1 = MFMA32(pa1.v, v11.v, o1); } while (0)
            ATT_LOAD(0, 0);
            for (int kt = 0; kt < nkt; kt += 2) {
                if (kt + 1 < nkt) ATT_LOAD(1, kt + 1);
                ATT_COMPUTE(0, kt);
                if (kt + 1 < nkt) { if (kt + 2 < nkt) ATT_LOAD(0, kt + 2); ATT_COMPUTE(1, kt + 1); }
            }
#undef ATT_LOAD
#undef ATT_COMPUTE
            psum += __shfl_xor(psum, 32);
            if (hi == 0) lsum[w * 32 + rho] = psum;
            __syncthreads();
#pragma unroll
            for (int r = 0; r < 16; ++r) { const int qr = crow(r, hi); const float inv = 1.0f / lsum[w * 32 + qr];
                bf16* op = O + (size_t)(m0 + qr) * DM + w * 64 + rho;
                op[0] = (bf16)f2bf(o0[r] * inv); op[32] = (bf16)f2bf(o1[r] * inv); }
        }
        __syncthreads();
    }
}

constexpr int XS_PITCH = 168;
__device__ __forceinline__ void p4_rwkv_prep(const Args& a, unsigned char* lds, int tid) {
    unsigned char* ws = a.ws; float* out = a.out;
    const bf16* ZS = (const bf16*)(ws + WS_ZS);
    const bf16* w2t = (const bf16*)(ws + WS_W2T); const bf16* a2t = (const bf16*)(ws + WS_A2T); const bf16* g2t = (const bf16*)(ws + WS_G2T);
    float* OW = (float*)(ws + WS_OW); bf16* OKK = (bf16*)(ws + WS_OKK); bf16* OB = (bf16*)(ws + WS_OB); bf16* OKM = (bf16*)(ws + WS_OKM); bf16* OR_ = (bf16*)(ws + WS_OR); bf16* OV = (bf16*)(ws + WS_OV);
    bf16* G = (bf16*)(out + SC_G); float* BON = (float*)(ws + WS_BONUS);
    const float* mu = a.in[13]; const float* w0 = a.in[14]; const float* a0 = a.in[16]; const float* k_k = a.in[19]; const float* k_a = a.in[20]; const float* r_k = a.in[21]; const float* sh0 = a.in[6];
    bf16* xs = (bf16*)lds;
    const int l = tid & 63, h = __builtin_amdgcn_readfirstlane(tid >> 6), rho = l & 31, hi = l >> 5;
    for (int tile = blockIdx.x; tile < MT / 32; tile += gridDim.x) {
        const int m0 = tile * 32; const bool smp = m0 >= MP;
        const bool tile_first = smp || (m0 & (T_P - 1)) == 0;
        { const int tk = tid >> 4, c0 = (tid & 15) * 10, m = m0 + tk; const bool first = tile_first && tk == 0;
          const bf16* zc = ZS + (size_t)m * SHIFTW + 1536 + c0; const bf16* zp = first ? zc : zc - SHIFTW;
          const float* shp = sh0 + (size_t)(smp ? ((m0 - MP) >> 5) : 0) * SHIFTW + 1536 + c0;
#pragma unroll
          for (int e = 0; e < 10; ++e) { const int c = c0 + e; const float cur = bf1(zc[e]); float prev = bf1(zp[e]);
              if (first) prev = smp ? shp[e] : 0.f;
              const float zm = cur + mu[1536 + c] * (prev - cur);
              const float f = __frcp_rn(1.0f + __expf(c < 32 ? -2.0f * zm : -zm));
              const float v = c < 32 ? 2.0f * f - 1.0f : (c < 64 ? zm : f);
              xs[tk * XS_PITCH + c] = (bf16)f2bf(v); } }
        __syncthreads();
        const int m = m0 + rho; const bool first = tile_first && rho == 0;
        const bf16* zc = ZS + (size_t)m * SHIFTW + 64 * h + 4 * hi; const bf16* zp = first ? zc : zc - SHIFTW;
        const float* shp = sh0 + (size_t)(smp ? ((m0 - MP) >> 5) : 0) * SHIFTW + 64 * h + 4 * hi;
        const float* mu_l = mu + 64 * h + 4 * hi;
        const int pofs = 64 * h + 4 * hi;
#define ZMIX4(dst, co) do { const u32x2 cw = *(const u32x2*)(zc + (co)); const u32x2 pw = *(const u32x2*)(zp + (co)); const f32x4 mu4 = *(const f32x4*)(mu_l + (co)); \
            const float cu[4] = {bflo(cw.x), bfhi(cw.x), bflo(cw.y), bfhi(cw.y)}; float pv[4] = {bflo(pw.x), bfhi(pw.x), bflo(pw.y), bfhi(pw.y)}; \
            if (tile_first) { f32x4 s4 = {0.f, 0.f, 0.f, 0.f}; if (smp) s4 = *(const f32x4*)(shp + (co)); if (first) { pv[0] = s4.x; pv[1] = s4.y; pv[2] = s4.z; pv[3] = s4.w; } } \
            _Pragma("unroll") for (int e = 0; e < 4; ++e) dst[e] = cu[e] + mu4[e] * (pv[e] - cu[e]); } while (0)
        float n2 = 0.f;
#pragma unroll
        for (int ct = 0; ct < 2; ++ct)
#pragma unroll
            for (int grp = 0; grp < 4; ++grp) { const int co = 32 * ct + 8 * grp; float zk[4]; ZMIX4(zk, 512 + co); const f32x4 kk4 = *(const f32x4*)(k_k + pofs + co);
#pragma unroll
                for (int e = 0; e < 4; ++e) { const float kr = zk[e] * kk4[e]; n2 += kr * kr; } }
        n2 += __shfl_xor(n2, 32);
        const float invn = 1.0f / fmaxf(sqrtf(n2), 1e-12f);
        float bon = 0.f;
        asm volatile("" ::: "memory");
#pragma unroll
        for (int ct = 0; ct < 2; ++ct) {
            const f32x16 z16 = {0.f, 0.f, 0.f, 0.f, 0.f, 0.f, 0.f, 0.f, 0.f, 0.f, 0.f, 0.f, 0.f, 0.f, 0.f, 0.f}; f32x16 Dw = z16, Da = z16, Dg = z16;
            const int n = 64 * h + 32 * ct + rho;
            const bf16* xrow = xs + rho * XS_PITCH + 8 * hi;
#pragma unroll
            for (int ks = 0; ks < 2; ++ks) {
                Dw = MFMA32(*(const bf16x8*)(w2t + n * 32 + 16 * ks + 8 * hi), *(const bf16x8*)(xrow + 16 * ks), Dw);
                Da = MFMA32(*(const bf16x8*)(a2t + n * 32 + 16 * ks + 8 * hi), *(const bf16x8*)(xrow + 32 + 16 * ks), Da); }
#pragma unroll
            for (int ks = 0; ks < 6; ++ks) Dg = MFMA32(*(const bf16x8*)(g2t + n * 96 + 16 * ks + 8 * hi), *(const bf16x8*)(xrow + 64 + 16 * ks), Dg);
#pragma unroll
            for (int grp = 0; grp < 4; ++grp) {
                const int co = 32 * ct + 8 * grp;
                float zr[4], zk[4], zv[4]; ZMIX4(zr, co); ZMIX4(zk, 512 + co); ZMIX4(zv, 1024 + co);
                const f32x4 w04 = *(const f32x4*)(w0 + pofs + co), a04 = *(const f32x4*)(a0 + pofs + co), kk4 = *(const f32x4*)(k_k + pofs + co), ka4 = *(const f32x4*)(k_a + pofs + co), rk4 = *(const f32x4*)(r_k + pofs + co);
                float dec[4], km[4], gg[4], kk[4], bb[4];
#pragma unroll
                for (int e = 0; e < 4; ++e) { const int r = 4 * grp + e;
                    const float sg = __frcp_rn(1.0f + __expf(-(w04[e] + Dw[r])));
                    dec[e] = __expf(-0.6065306597126334f * sg);
                    const float aa = __frcp_rn(1.0f + __expf(-(a04[e] + Da[r])));
                    gg[e] = Dg[r];
                    kk[e] = zk[e] * kk4[e] * invn; bb[e] = kk[e] * aa;
                    km[e] = zk[e] * (1.0f + (aa - 1.0f) * ka4[e]);
                    bon += zr[e] * km[e] * rk4[e]; }
                const size_t o = (size_t)m * 512 + pofs + co;
                *(f32x4*)(OW + o) = (f32x4){dec[0], dec[1], dec[2], dec[3]};
                *(u32x2*)(OKK + o) = (u32x2){pk2(kk[0], kk[1]), pk2(kk[2], kk[3])};
                *(u32x2*)(OB + o) = (u32x2){pk2(bb[0], bb[1]), pk2(bb[2], bb[3])};
                *(u32x2*)(OKM + o) = (u32x2){pk2(km[0], km[1]), pk2(km[2], km[3])};
                *(u32x2*)(OR_ + o) = (u32x2){pk2(zr[0], zr[1]), pk2(zr[2], zr[3])};
                *(u32x2*)(OV + o) = (u32x2){pk2(zv[0], zv[1]), pk2(zv[2], zv[3])};
                *(u32x2*)(G + o) = (u32x2){pk2(gg[0], gg[1]), pk2(gg[2], gg[3])};
                asm volatile("" ::: "memory");
            }
        }
#undef ZMIX4
        bon += __shfl_xor(bon, 32);
        if (hi == 0) BON[(size_t)m * 8 + h] = bon;
        __syncthreads();
    }
}

struct ScanOp { f32x4 w; u32x2 kk, b, km, r; bf16 v; };
struct ScanPtr { const float* OW; const bf16 *OKK, *OB, *OKM, *OR_, *OV; };
__device__ __forceinline__ void scan_load(ScanOp& o, const ScanPtr& p, int step, int ks4, int row) {
    const int so = step * 512;
    o.w = *(const f32x4*)(p.OW + so + ks4); o.kk = *(const u32x2*)(p.OKK + so + ks4); o.b = *(const u32x2*)(p.OB + so + ks4);
    o.km = *(const u32x2*)(p.OKM + so + ks4); o.r = *(const u32x2*)(p.OR_ + so + ks4); o.v = p.OV[so + row];
}
__device__ __forceinline__ void scan_step(f32x4& S, const ScanOp& o, float* yp, bool st) {
    const float k0 = bflo(o.kk.x), k1 = bfhi(o.kk.x), k2 = bflo(o.kk.y), k3 = bfhi(o.kk.y);
    float d = (S.x * k0 + S.y * k1) + (S.z * k2 + S.w * k3); d = sum16(d);
    const float v = bf1(o.v);
    S.x = S.x * o.w.x + (v * bflo(o.km.x) - d * bflo(o.b.x)); S.y = S.y * o.w.y + (v * bfhi(o.km.x) - d * bfhi(o.b.x));
    S.z = S.z * o.w.z + (v * bflo(o.km.y) - d * bflo(o.b.y)); S.w = S.w * o.w.w + (v * bfhi(o.km.y) - d * bfhi(o.b.y));
    float y = (S.x * bflo(o.r.x) + S.y * bfhi(o.r.x)) + (S.z * bflo(o.r.y) + S.w * bfhi(o.r.y)); y = sum16(y);
    if (st) *yp = y;
}
__device__ __forceinline__ void scan_run(const unsigned char* ws, float* Y, size_t mrow0, int h, int row, int ks, int nsteps, f32x4& S) {
    const size_t base0 = mrow0 * 512 + (size_t)h * 64;
    ScanPtr p{(const float*)(ws + WS_OW) + base0, (const bf16*)(ws + WS_OKK) + base0, (const bf16*)(ws + WS_OB) + base0, (const bf16*)(ws + WS_OKM) + base0,
              (const bf16*)(ws + WS_OR) + base0, (const bf16*)(ws + WS_OV) + base0};
    float* yp = Y + base0; const bool st = ks == 0; const int ks4 = 4 * ks;
    ScanOp A[4];
#pragma unroll
    for (int i = 0; i < 4; ++i) scan_load(A[i], p, i, ks4, row);
    for (int t0 = 0; t0 < nsteps; t0 += 4) {
        const bool more = t0 + 4 < nsteps;
#pragma unroll
        for (int i = 0; i < 4; ++i) { const ScanOp cur = A[i];
            if (more) scan_load(A[i], p, 4 + i, ks4, row);
            scan_step(S, cur, yp + i * 512 + row, st); }
        p.OW += 4 * 512; p.OKK += 4 * 512; p.OB += 4 * 512; p.OKM += 4 * 512; p.OR_ += 4 * 512; p.OV += 4 * 512; yp += 4 * 512;
    }
}
__device__ __forceinline__ void p5_rwkv_scan(const Args& a, int tid) {
    const unsigned char* ws = a.ws; float* out = a.out; float* Y = out + SC_Y;
    const int l = tid & 63, w = __builtin_amdgcn_readfirstlane(tid >> 6), ks = l & 15, rl = l >> 4;
    for (int it = blockIdx.x; it < 256; it += gridDim.x) {
        if (w < 4) {
            const int bh = it >> 2, b = bh >> 3, h = bh & 7, row = 16 * (it & 3) + 4 * w + rl;
            f32x4 S = {0.f, 0.f, 0.f, 0.f};
            scan_run(ws, Y, (size_t)b * T_P, h, row, ks, T_P, S);
            *(f32x4*)(out + OFF_WKVP + ((size_t)bh * 64 + row) * 64 + 4 * ks) = S;
        } else {
            const int b = it >> 3, h = it & 7;
            for (int pass = 0; pass < 4; ++pass) { const int row = 16 * (w - 4) + 4 * pass + rl;
                f32x4 S = *(const f32x4*)(a.in[5] + ((size_t)it * 64 + row) * 64 + 4 * ks);
                scan_run(ws, Y, (size_t)MP + (size_t)b * T_S, h, row, ks, T_S, S);
                *(f32x4*)(out + OFF_WKVS + ((size_t)it * 64 + row) * 64 + 4 * ks) = S; }
        }
    }
}

__device__ __forceinline__ void p6_rwkv_out(const Args& a, int tid) {
    const unsigned char* ws = a.ws; const float* out = a.out; const float* Y = out + SC_Y; const bf16* G = (const bf16*)(out + SC_G);
    const bf16* OV = (const bf16*)(ws + WS_OV); const float* BON = (const float*)(ws + WS_BONUS); bf16* O = (bf16*)(a.ws + WS_XB);
    const float* lg = a.in[22]; const float* lb = a.in[23];
    const int sub = tid & 7;
    for (size_t it = (size_t)blockIdx.x * 64 + (tid >> 3); it < (size_t)MT * 8; it += (size_t)gridDim.x * 64) {
        const size_t m = it >> 3; const int h = (int)(it & 7); const size_t o = m * 512 + h * 64 + 8 * sub;
        const f32x4 y0 = *(const f32x4*)(Y + o), y1 = *(const f32x4*)(Y + o + 4); float y[8] = {y0.x, y0.y, y0.z, y0.w, y1.x, y1.y, y1.z, y1.w};
        float s1 = 0.f;
#pragma unroll
        for (int j = 0; j < 8; ++j) s1 += y[j];
        s1 += __shfl_xor(s1, 1); s1 += __shfl_xor(s1, 2); s1 += __shfl_xor(s1, 4);
        const float mean = s1 * (1.f / 64.f); float s2 = 0.f;
#pragma unroll
        for (int j = 0; j < 8; ++j) { const float d = y[j] - mean; s2 += d * d; }
        s2 += __shfl_xor(s2, 1); s2 += __shfl_xor(s2, 2); s2 += __shfl_xor(s2, 4);
        const float rinv = rsqrtf(s2 * (1.f / 64.f) + 64e-5f);
        float v[8], g[8]; unpack8(*(const u32x4*)(OV + o), v); unpack8(*(const u32x4*)(G + o), g);
        const float bon = BON[it]; float r[8];
#pragma unroll
        for (int j = 0; j < 8; ++j) { const int c = h * 64 + 8 * sub + j; r[j] = ((y[j] - mean) * rinv * lg[c] + lb[c] + bon * v[j]) * g[j]; }
        *(u32x4*)(O + m * DM + 512 + h * 64 + 8 * sub) = pack8(r);
    }
}

__device__ __forceinline__ void p8_hnorm(const Args& a, int tid) {
    const int lane = tid & 63, gw = blockIdx.x * 8 + (tid >> 6), NGW = gridDim.x * 8;
    for (int m = gw; m < MT; m += NGW) {
        const f32x4* xr = (const f32x4*)(a.out + OFF_Y + (size_t)m * DM) + lane; f32x4 v[4]; float s = 0.f;
#pragma unroll
        for (int j = 0; j < 4; ++j) { v[j] = xr[64 * j]; s += (v[j].x * v[j].x + v[j].y * v[j].y) + (v[j].z * v[j].z + v[j].w * v[j].w); }
        const float rs = rsqrtf(wave_sum(s) * (1.f / DM) + 1e-6f);
        u32x2* o8 = (u32x2*)((bf16*)(a.ws + WS_HB) + (size_t)m * DM) + lane;
#pragma unroll
        for (int j = 0; j < 4; ++j) { u32x2 o; o.x = pk2(v[j].x * rs, v[j].y * rs); o.y = pk2(v[j].z * rs, v[j].w * rs); o8[64 * j] = o; }
    }
}

constexpr int LDS_BYTES = 147456;
constexpr int N_PHASES = 11;
template <int PH> __device__ __forceinline__ void run_phase(const Args& args, unsigned char* lds, int tid) {
    unsigned char* ws = args.ws;
    if constexpr (PH == 0) p0_prologue(args, lds, tid);
    if constexpr (PH == 1) { pg8::Gemm g{(const pg8::bf16_t*)(ws + WS_XB), (const pg8::bf16_t*)(ws + WS_WIN), MT, NZ, DM}; pg8::StaticOrder S; S.init(MT, NZ, gridDim.x, blockIdx.x);
        pg8::EpiZ E{(pg8::bf16_t*)(ws + WS_ZR), (pg8::bf16_t*)(ws + WS_ZS)};
        pg8::gemm_phase<pg8::EpiZ, pg8::StaticOrder, true, true>((PG8_LAS unsigned char*)lds, g, S, E); }
    if constexpr (PH == 2) p2_post(args, lds, tid);
    if constexpr (PH == 3) p3_attention(args, lds, tid);
    if constexpr (PH == 4) p4_rwkv_prep(args, lds, tid);
    if constexpr (PH == 5) p5_rwkv_scan(args, tid);
    if constexpr (PH == 6) p6_rwkv_out(args, tid);
    if constexpr (PH == 7) { pg8::Gemm g{(const pg8::bf16_t*)(ws + WS_XB), (const pg8::bf16_t*)(ws + WS_WOUT), MT, DM, DM}; pg8::StaticOrder S; S.init(MT, DM, gridDim.x, blockIdx.x);
        pg8::EpiH E{args.in[0], args.in[1], args.out + OFF_Y};
        pg8::gemm_phase<pg8::EpiH, pg8::StaticOrder, true, true>((PG8_LAS unsigned char*)lds, g, S, E); }
    if constexpr (PH == 8) p8_hnorm(args, tid);
    if constexpr (PH == 9) { pg8::Gemm g{(const pg8::bf16_t*)(ws + WS_HB), (const pg8::bf16_t*)(ws + WS_W1), MT, DFF, DM}; pg8::StaticOrder S; S.init(MT, DFF, gridDim.x, blockIdx.x);
        pg8::EpiAct E{(pg8::bf16_t*)(ws + WS_ACT), DFF};
        pg8::gemm_phase<pg8::EpiAct, pg8::StaticOrder, true, true>((PG8_LAS unsigned char*)lds, g, S, E); }
    if constexpr (PH == 10) { pg8::Gemm g{(const pg8::bf16_t*)(ws + WS_ACT), (const pg8::bf16_t*)(ws + WS_W2), MT, DM, DFF}; pg8::StaticOrder S; S.init(MT, DM, gridDim.x, blockIdx.x);
        pg8::EpiY E{args.out + OFF_Y};
        pg8::gemm_phase<pg8::EpiY, pg8::StaticOrder, true, true>((PG8_LAS unsigned char*)lds, g, S, E); }
}
#ifndef MK_ONE_LAUNCH
#define MK_ONE_LAUNCH 0
#endif
#if MK_ONE_LAUNCH
__global__ void __launch_bounds__(512, 2) mk_fwd(Args args) {
    extern __shared__ __attribute__((aligned(16))) unsigned char lds[];
    const int tid = threadIdx.x;
#define PHASE(k) do { if (args.ph_lo <= (k) && (k) < args.ph_hi) { if ((k) > args.ph_lo) { __syncthreads(); cg::this_grid().sync(); } run_phase<k>(args, lds, tid); } } while (0)
    PHASE(0); PHASE(1); PHASE(2); PHASE(3); PHASE(4); PHASE(5); PHASE(6); PHASE(7); PHASE(8); PHASE(9); PHASE(10);
#undef PHASE
}
#else
template <int PH> __global__ void __launch_bounds__(512, 2) mk_phase(Args args) {
    extern __shared__ __attribute__((aligned(16))) unsigned char lds[];
    run_phase<PH>(args, lds, threadIdx.x);
}
#endif

extern "C" void kernel_launch(void* const* d_in, const int* in_sizes, int n_in, void* d_out, int out_size, void* d_ws, size_t ws_size, hipStream_t stream) {
    static int grid = 0;
    if (grid == 0) {
        if (n_in != 28 || out_size != (int)OUT_TOTAL || ws_size < WS_END) { fprintf(stderr, "kernel_launch: unexpected shapes (n_in %d, out %d, ws %zu)\n", n_in, out_size, ws_size); grid = -1; return; }
        int dev = 0, cus = 0, per_cu = 0;
        (void)hipGetDevice(&dev); (void)hipDeviceGetAttribute(&cus, hipDeviceAttributeMultiprocessorCount, dev);
#if MK_ONE_LAUNCH
        if (hipFuncSetAttribute((const void*)mk_fwd, hipFuncAttributeMaxDynamicSharedMemorySize, LDS_BYTES) != hipSuccess) { fprintf(stderr, "kernel_launch: hipFuncSetAttribute failed\n"); grid = -1; return; }
        (void)hipOccupancyMaxActiveBlocksPerMultiprocessor(&per_cu, (const void*)mk_fwd, 512, LDS_BYTES);
        (void)hipGetLastError();
        if (per_cu < 1) { fprintf(stderr, "kernel_launch: occupancy query says %d blocks per CU\n", per_cu); per_cu = 1; }
#else
#define SETATTR(k) (void)hipFuncSetAttribute((const void*)mk_phase<k>, hipFuncAttributeMaxDynamicSharedMemorySize, LDS_BYTES)
        SETATTR(0); SETATTR(1); SETATTR(2); SETATTR(3); SETATTR(4); SETATTR(5); SETATTR(6); SETATTR(7); SETATTR(8); SETATTR(9); SETATTR(10);
#undef SETATTR
        (void)per_cu;
#endif
        grid = cus;
    }
    if (grid < 0) return;
    (void)hipMemsetAsync((char*)d_ws + WS_CTL, 0, CTL_BYTES, stream);
    Args a{};
    for (int i = 0; i < 28; ++i) a.in[i] = (const float*)d_in[i];
    a.out = (float*)d_out; a.ws = (unsigned char*)d_ws;
#if MK_ONE_LAUNCH
    a.ph_lo = 0; a.ph_hi = N_PHASES;
    void* kargs[] = {&a};
    hipError_t e = hipLaunchCooperativeKernel((const void*)mk_fwd, dim3(grid), dim3(512), kargs, LDS_BYTES, stream);
    if (e != hipSuccess) fprintf(stderr, "kernel_launch: cooperative launch failed: %s (grid %d)\n", hipGetErrorString(e), grid);
#else
#define LAUNCH(k) hipLaunchKernelGGL(mk_phase<k>, dim3(grid), dim3(512), LDS_BYTES, stream, a)
    a.ph_lo = 0; a.ph_hi = N_PHASES;
    LAUNCH(0); LAUNCH(1); LAUNCH(2); LAUNCH(3); LAUNCH(4); LAUNCH(5); LAUNCH(6); LAUNCH(7); LAUNCH(8); LAUNCH(9); LAUNCH(10);
#undef LAUNCH
#endif
}
```

```cpp
#include <hip/hip_runtime.h>
#include <hip/hip_cooperative_groups.h>
#include <cstdio>
#include <cstdint>
namespace cg = cooperative_groups;
namespace pg8 {
#define PG8_LAS __attribute__((address_space(3)))
typedef unsigned short bf16_t;
typedef short bf16x8 __attribute__((ext_vector_type(8)));
typedef float f32x4 __attribute__((ext_vector_type(4)));
typedef unsigned u32x4 __attribute__((ext_vector_type(4)));
constexpr int BM = 256, BK = 64, HALF = 128, HTB = HALF * BK * 2  , STAGE_BYTES = 8 * HTB, NXCD = 8, WGM = 8;

__host__ __device__ __forceinline__ int lds_byte(int r, int c) { const int st = (r >> 4) * 2 + (c >> 5), rr = r & 15, cc = c & 31, ob = rr * 64 + cc * 2; return st * 1024 + (ob ^ (((ob >> 9) & 1) << 5)); }
__host__ __device__ __forceinline__ void stage_rc(int b, int& R, int& C) { const int st = b / 1024, sb = b % 1024, swz = sb ^ (((sb >> 9) & 1) << 5); R = (st >> 1) * 16 + swz / 64; C = (st & 1) * 32 + (swz % 64) / 2; }
__host__ __device__ __forceinline__ int perm32(int rho) { const int n = rho >> 4, i = rho & 15; return 8 * (i >> 2) + 4 * n + (i & 3); }

struct Unit { int pm, pn; };
struct Gemm { const bf16_t* A; const bf16_t* Bt; int M, N, K; };

struct StaticOrder {
    int nM, nN, nwg, G, c;
    __host__ __device__ void init(int M, int N, int G_, int c_) { nM = M / BM; nN = N / BM; nwg = nM * nN; G = G_; c = c_; }
    __host__ __device__ bool next(int i, Unit& u) const {
        const long L = (long)i * G + c; if (L >= nwg) return false;
        int wgid = (int)L; { const int q = nwg / NXCD, r = nwg % NXCD, xcd = wgid % NXCD, off = wgid / NXCD; wgid = (xcd < r ? xcd * (q + 1) : r * (q + 1) + (xcd - r) * q) + off; }
        const int nig = WGM * nN, gid = wgid / nig, fm = gid * WGM, gsz = (nM - fm) < WGM ? (nM - fm) : WGM;
        u.pm = fm + ((wgid % nig) % gsz); u.pn = (wgid % nig) / gsz; return true;
    }
    __device__ __forceinline__ void a_ready(const Unit&) const {}
    __device__ __forceinline__ void done(const Unit&) const {}
};


__device__ __forceinline__ unsigned cvt_pk_bf16(float lo, float hi) { unsigned r; asm volatile("v_cvt_pk_bf16_f32 %0, %1, %2" : "=v"(r) : "v"(lo), "v"(hi)); return r; }

constexpr int E_MP = 16384;
constexpr int E_ZRW = 1632, E_ZSW = 1696;

struct EpiZ {
    static constexpr bool PERM = true, AFTER_DRAIN = false;
    bf16_t* ZR; bf16_t* ZS;
    __device__ __forceinline__ void operator()(const f32x4 (&acc)[2][2][4][2], const Unit& u, int wr, int wc, int fr, int fq) const {
        const int row0 = u.pm * BM + wr * 64 + fr, c0 = u.pn * BM + wc * 32 + 8 * fq;
#pragma unroll
        for (int ai = 0; ai < 2; ++ai)
#pragma unroll
            for (int m = 0; m < 4; ++m) { const size_t row = (size_t)(row0 + ai * HALF + m * 16);
#pragma unroll
                for (int bj = 0; bj < 2; ++bj) { const int c = c0 + bj * HALF; bf16_t* dst;
                    if (c < 1600) dst = ZR + row * E_ZRW + c; else if (c < 3296) dst = ZS + row * E_ZSW + (c - 1600); else if (c == 3296) dst = ZR + row * E_ZRW + 1600; else continue;
                    const f32x4 v0 = acc[ai][bj][m][0], v1 = acc[ai][bj][m][1]; u32x4 w;
                    w.x = cvt_pk_bf16(v0[0], v0[1]); w.y = cvt_pk_bf16(v0[2], v0[3]); w.z = cvt_pk_bf16(v1[0], v1[1]); w.w = cvt_pk_bf16(v1[2], v1[3]);
                    *(u32x4*)dst = w; } }
    }
};
struct EpiH {
    static constexpr bool PERM = false, AFTER_DRAIN = false;
    const float* xp; const float* xs; float* H;
    __device__ __forceinline__ void operator()(const f32x4 (&acc)[2][2][4][2], const Unit& u, int wr, int wc, int fr, int fq) const {
        const int row0 = u.pm * BM + wr * 64 + fr, col0 = u.pn * BM + wc * 32 + 4 * fq;
#pragma unroll
        for (int ai = 0; ai < 2; ++ai)
#pragma unroll
            for (int m = 0; m < 4; ++m) { const int row = row0 + ai * HALF + m * 16;
                const float* xr = (row < E_MP ? xp + (size_t)row * 1024 : xs + (size_t)(row - E_MP) * 1024) + col0; float* hr = H + (size_t)row * 1024 + col0;
#pragma unroll
                for (int bj = 0; bj < 2; ++bj)
#pragma unroll
                    for (int n = 0; n < 2; ++n) *(f32x4*)(hr + bj * HALF + n * 16) = *(const f32x4*)(xr + bj * HALF + n * 16) + acc[ai][bj][m][n]; }
    }
};
struct EpiAct {
    static constexpr bool PERM = true, AFTER_DRAIN = false;
    bf16_t* O; int ldc;
    __device__ __forceinline__ void operator()(const f32x4 (&acc)[2][2][4][2], const Unit& u, int wr, int wc, int fr, int fq) const {
        const int row0 = u.pm * BM + wr * 64 + fr, c0 = u.pn * BM + wc * 32 + 8 * fq;
#pragma unroll
        for (int ai = 0; ai < 2; ++ai)
#pragma unroll
            for (int m = 0; m < 4; ++m) { bf16_t* rowp = O + (size_t)(row0 + ai * HALF + m * 16) * ldc + c0;
#pragma unroll
                for (int bj = 0; bj < 2; ++bj) { f32x4 v0 = acc[ai][bj][m][0], v1 = acc[ai][bj][m][1];
#pragma unroll
                    for (int e = 0; e < 4; ++e) { const float a = fmaxf(v0[e], 0.f), b = fmaxf(v1[e], 0.f); v0[e] = a * a; v1[e] = b * b; }
                    u32x4 w; w.x = cvt_pk_bf16(v0[0], v0[1]); w.y = cvt_pk_bf16(v0[2], v0[3]); w.z = cvt_pk_bf16(v1[0], v1[1]); w.w = cvt_pk_bf16(v1[2], v1[3]);
                    *(u32x4*)(rowp + bj * HALF) = w; } }
    }
};
struct EpiY {
    static constexpr bool PERM = false, AFTER_DRAIN = false;
    float* Y;
    __device__ __forceinline__ void operator()(const f32x4 (&acc)[2][2][4][2], const Unit& u, int wr, int wc, int fr, int fq) const {
        const int row0 = u.pm * BM + wr * 64 + fr, col0 = u.pn * BM + wc * 32 + 4 * fq;
#pragma unroll
        for (int ai = 0; ai < 2; ++ai)
#pragma unroll
            for (int m = 0; m < 4; ++m) { float* yr = Y + (size_t)(row0 + ai * HALF + m * 16) * 1024 + col0;
#pragma unroll
                for (int bj = 0; bj < 2; ++bj)
#pragma unroll
                    for (int n = 0; n < 2; ++n) { f32x4* p = (f32x4*)(yr + bj * HALF + n * 16); *p = *p + acc[ai][bj][m][n]; } }
    }
};

template <class Epi, class Sched, bool ALIGN_EPI = false, bool SP2 = false>
__device__ __forceinline__ void gemm_phase(PG8_LAS unsigned char* lds, const Gemm g, const Sched& S, const Epi& E) {
    const int tid = threadIdx.x, wid = __builtin_amdgcn_readfirstlane(tid >> 6), lane = tid & 63, wr = wid >> 2, wc = wid & 3, fr = lane & 15, fq = lane >> 4;
    const int K = g.K, nt = K / BK;
    unsigned voffA[2], voffB[2];
#pragma unroll
    for (int i = 0; i < 2; ++i) { int R, C; stage_rc(tid * 16 + i * 8192, R, C); const int Rb = Epi::PERM ? ((R & ~31) + perm32(R & 31)) : R;
        voffA[i] = (unsigned)(R * K + C) * 2u; voffB[i] = (unsigned)(Rb * K + C) * 2u; }
    const size_t kstep = (size_t)(BK * 2);
    const size_t hstep = (size_t)HALF * K * 2;
    const size_t tstep = 2 * hstep;
    const unsigned ldsw = (unsigned)wid * 1024u;
    const int aoff = lds_byte(wr * 64 + fr, fq * 8), boff = lds_byte(wc * 32 + fr, fq * 8);
#define PG8_SA(b, h) (((b) * 2 + (h)) * HTB)
#define PG8_SB(b, h) ((4 + (b) * 2 + (h)) * HTB)
#define PG8_STAGE(bufoff, gbase, voff) do { _Pragma("unroll") for (int _i = 0; _i < 2; ++_i) \
        __builtin_amdgcn_global_load_lds((const unsigned*)((const char*)(gbase) + (voff)[_i]), (PG8_LAS unsigned*)(lds + (bufoff) + ldsw + _i * 8192), 16, 0, 0); } while (0)
#define PG8_LDA(dst, b, h) do { _Pragma("unroll") for (int m = 0; m < 4; ++m) _Pragma("unroll") for (int k = 0; k < 2; ++k) dst[m][k] = *(const PG8_LAS bf16x8*)(lds + PG8_SA(b, h) + aoff + m * 2048 + k * 1024); } while (0)
#define PG8_LDB(dst, b, h) do { _Pragma("unroll") for (int n = 0; n < 2; ++n) _Pragma("unroll") for (int k = 0; k < 2; ++k) dst[n][k] = *(const PG8_LAS bf16x8*)(lds + PG8_SB(b, h) + boff + n * 2048 + k * 1024); } while (0)
#define PG8_MMA(ai, bj, At, Bt) do { __builtin_amdgcn_s_setprio(1); _Pragma("unroll") for (int m = 0; m < 4; ++m) _Pragma("unroll") for (int n = 0; n < 2; ++n) _Pragma("unroll") for (int k = 0; k < 2; ++k) \
        acc[ai][bj][m][n] = __builtin_amdgcn_mfma_f32_16x16x32_bf16(Bt[n][k], At[m][k], acc[ai][bj][m][n], 0, 0, 0); __builtin_amdgcn_s_setprio(0); } while (0)
#define PG8_WAIT_V(n) asm volatile("s_waitcnt vmcnt(" #n ")" ::: "memory")
#define PG8_WAIT_L(n) asm volatile("s_waitcnt lgkmcnt(" #n ")" ::: "memory")
#define PG8_BAR __builtin_amdgcn_s_barrier()
#define PG8_SCHED __builtin_amdgcn_sched_barrier(0)
    Unit cur, nxt; int ui = 0;
    if (!S.next(0, cur)) return;
    f32x4 acc[2][2][4][2];
#pragma unroll
    for (int a = 0; a < 2; ++a)
#pragma unroll
        for (int b = 0; b < 2; ++b)
#pragma unroll
            for (int m = 0; m < 4; ++m)
#pragma unroll
                for (int n = 0; n < 2; ++n) acc[a][b][m][n] = (f32x4){0.f, 0.f, 0.f, 0.f};
    bf16x8 At[4][2], B0[2][2], B1[2][2];
    const char* cA = (const char*)g.A + (size_t)cur.pm * tstep; const char* cB = (const char*)g.Bt + (size_t)cur.pn * tstep;
    S.a_ready(cur);
    if constexpr (SP2) {
        PG8_STAGE(PG8_SB(0, 0), cB, voffB); PG8_STAGE(PG8_SB(0, 1), cB + hstep, voffB); PG8_STAGE(PG8_SA(0, 0), cA, voffA); PG8_STAGE(PG8_SA(0, 1), cA + hstep, voffA);
        if (wr == 1) PG8_BAR;
        PG8_WAIT_V(2); PG8_BAR;
        PG8_STAGE(PG8_SB(1, 0), cB + kstep, voffB); PG8_STAGE(PG8_SA(1, 0), cA + kstep, voffA); PG8_STAGE(PG8_SB(1, 1), cB + hstep + kstep, voffB);
        PG8_WAIT_V(6); PG8_BAR;
    } else {
        PG8_STAGE(PG8_SB(0, 0), cB, voffB); PG8_STAGE(PG8_SA(0, 0), cA, voffA); PG8_STAGE(PG8_SB(0, 1), cB + hstep, voffB); PG8_STAGE(PG8_SA(0, 1), cA + hstep, voffA);
        if (wr == 1) PG8_BAR;
        PG8_WAIT_V(4); PG8_BAR;
        PG8_STAGE(PG8_SB(1, 0), cB + kstep, voffB); PG8_STAGE(PG8_SA(1, 0), cA + kstep, voffA); PG8_STAGE(PG8_SB(1, 1), cB + hstep + kstep, voffB);
        PG8_WAIT_V(6); PG8_BAR;
    }
    for (;;) {
        const bool has_next = S.next(ui + 1, nxt);
        const char* nA = has_next ? (const char*)g.A + (size_t)nxt.pm * tstep : cA; const char* nB = has_next ? (const char*)g.Bt + (size_t)nxt.pn * tstep : cB;
        for (int t = 0; t < nt; t += 2) {
            const bool last = (t == nt - 2);
            const char* a1 = cA + (size_t)(t + 1) * kstep;
            const char* a2 = last ? nA : cA + (size_t)(t + 2) * kstep; const char* b2 = last ? nB : cB + (size_t)(t + 2) * kstep;
            const char* a3 = a2 + kstep; const char* b3 = b2 + kstep;
            if (last && has_next) S.a_ready(nxt);
            if constexpr (SP2) {
            PG8_LDB(B0, 0, 0); PG8_LDB(B1, 0, 1); PG8_SCHED; PG8_LDA(At, 0, 0); PG8_STAGE(PG8_SA(1, 1), a1 + hstep, voffA);
            PG8_WAIT_V(8); PG8_WAIT_L(0); PG8_BAR; PG8_MMA(0, 0, At, B0); PG8_MMA(0, 1, At, B1); PG8_BAR; PG8_SCHED;
            PG8_LDA(At, 0, 1); PG8_STAGE(PG8_SB(0, 0), b2, voffB); PG8_STAGE(PG8_SB(0, 1), b2 + hstep, voffB); PG8_STAGE(PG8_SA(0, 0), a2, voffA);
            PG8_WAIT_V(8); PG8_WAIT_L(0); PG8_BAR; PG8_MMA(1, 0, At, B0); PG8_MMA(1, 1, At, B1); PG8_BAR; PG8_SCHED;
            PG8_LDB(B0, 1, 0); PG8_LDB(B1, 1, 1); PG8_SCHED; PG8_LDA(At, 1, 0); PG8_STAGE(PG8_SA(0, 1), a2 + hstep, voffA);
            PG8_WAIT_V(8); PG8_WAIT_L(0); PG8_BAR; PG8_MMA(0, 0, At, B0); PG8_MMA(0, 1, At, B1); PG8_BAR; PG8_SCHED;
            PG8_LDA(At, 1, 1); PG8_STAGE(PG8_SB(1, 0), b3, voffB); PG8_STAGE(PG8_SB(1, 1), b3 + hstep, voffB); PG8_STAGE(PG8_SA(1, 0), a3, voffA);
            PG8_WAIT_V(8); PG8_WAIT_L(0); PG8_BAR; PG8_MMA(1, 0, At, B0); PG8_MMA(1, 1, At, B1); PG8_BAR; PG8_SCHED;
            } else {
            PG8_LDB(B0, 0, 0); PG8_SCHED; PG8_LDA(At, 0, 0); PG8_STAGE(PG8_SA(1, 1), a1 + hstep, voffA);
            PG8_WAIT_L(8); PG8_BAR; PG8_WAIT_L(0); PG8_MMA(0, 0, At, B0); PG8_BAR; PG8_SCHED;
            PG8_LDB(B1, 0, 1); PG8_STAGE(PG8_SB(0, 0), b2, voffB);
            PG8_BAR; PG8_WAIT_L(0); PG8_MMA(0, 1, At, B1); PG8_BAR;
            PG8_LDA(At, 0, 1); PG8_STAGE(PG8_SA(0, 0), a2, voffA);
            PG8_BAR; PG8_WAIT_L(0); PG8_MMA(1, 0, At, B0); PG8_BAR; PG8_SCHED;
            PG8_STAGE(PG8_SB(0, 1), b2 + hstep, voffB);
            PG8_WAIT_V(6); PG8_BAR; PG8_MMA(1, 1, At, B1); PG8_BAR;
            PG8_LDB(B0, 1, 0); PG8_SCHED; PG8_LDA(At, 1, 0); PG8_STAGE(PG8_SA(0, 1), a2 + hstep, voffA);
            PG8_WAIT_L(8); PG8_BAR; PG8_WAIT_L(0); PG8_MMA(0, 0, At, B0); PG8_BAR; PG8_SCHED;
            PG8_LDB(B1, 1, 1); PG8_STAGE(PG8_SB(1, 0), b3, voffB);
            PG8_BAR; PG8_WAIT_L(0); PG8_MMA(0, 1, At, B1); PG8_BAR;
            PG8_LDA(At, 1, 1); PG8_STAGE(PG8_SA(1, 0), a3, voffA);
            PG8_BAR; PG8_WAIT_L(0); PG8_MMA(1, 0, At, B0); PG8_BAR; PG8_SCHED;
            PG8_STAGE(PG8_SB(1, 1), b3 + hstep, voffB);
            PG8_WAIT_V(6); PG8_BAR; PG8_MMA(1, 1, At, B1); PG8_BAR;
            }
        }
        if constexpr (ALIGN_EPI) { if (wr == 0) PG8_BAR; }
        if constexpr (!Epi::AFTER_DRAIN) { E(acc, cur, wr, wc, fr, fq); S.done(cur); }
        if (!has_next) break;
#pragma unroll
        for (int a = 0; a < 2; ++a)
#pragma unroll
            for (int b = 0; b < 2; ++b)
#pragma unroll
                for (int m = 0; m < 4; ++m)
#pragma unroll
                    for (int n = 0; n < 2; ++n) acc[a][b][m][n] = (f32x4){0.f, 0.f, 0.f, 0.f};
        cur = nxt; cA = nA; cB = nB; ++ui;
        if constexpr (ALIGN_EPI) { if (wr == 1) PG8_BAR; }
    }
    PG8_WAIT_V(0);
    if constexpr (!ALIGN_EPI) { if (wr == 0) PG8_BAR; }
    PG8_BAR;
    if constexpr (Epi::AFTER_DRAIN) { E.fused(acc, cur, wr, wc, fr, fq, lds, wid, lane); S.done(cur); }
#undef PG8_SA
#undef PG8_SB
#undef PG8_STAGE
#undef PG8_LDA
#undef PG8_LDB
#undef PG8_MMA
#undef PG8_WAIT_V
#undef PG8_WAIT_L
#undef PG8_BAR
#undef PG8_SCHED
}
}


constexpr int DM = 1024, NB_P = 8, T_P = 2048, NB_S = 32, T_S = 32, PAST = 1024;
constexpr int MP = NB_P * T_P, MS = NB_S * T_S, MT = MP + MS;
constexpr int LS = PAST + T_S;
constexpr int SHIFTW = 1696, NZ = 3328, ZRW = 1632, DFF = 4096;
constexpr float QSCALE = 0.125f * 1.4426950408889634f;
constexpr float WISCALE = 0.35355339059327373f * 0.125f;
constexpr size_t OFF_Y = 0, OFF_KP = 17825792, OFF_VP = OFF_KP + 4194304, OFF_KIP = OFF_VP + 4194304, OFF_WKVP = OFF_KIP + 1048576, OFF_SHP = OFF_WKVP + 262144,
                 OFF_KS = OFF_SHP + 13568, OFF_VS = OFF_KS + 262144, OFF_KIS = OFF_VS + 262144, OFF_WKVS = OFF_KIS + 65536, OFF_SHS = OFF_WKVS + 1048576, OUT_TOTAL = OFF_SHS + 54272;
constexpr size_t MiB = 1u << 20;
constexpr size_t WS_CTL = 0, CTL_BYTES = 1 * MiB;
constexpr size_t WS_WIN = 1 * MiB, WS_WOUT = 8 * MiB, WS_W1 = 10 * MiB, WS_W2 = 18 * MiB;
constexpr size_t WS_W2T = 26 * MiB, WS_A2T = WS_W2T + 32768, WS_G2T = WS_A2T + 32768, WS_WI = 27 * MiB, WS_BONUS = 28 * MiB;
constexpr size_t WS_XB = 30 * MiB;
constexpr size_t WS_ZS = 66 * MiB;
constexpr size_t WS_R = 123 * MiB;
constexpr size_t WS_ZR = WS_R, WS_KBP = 178 * MiB, WS_VTP = 186 * MiB, WS_KIP = 194 * MiB, WS_KBS = 196 * MiB, WS_VTS = 213 * MiB, WS_KIS = 230 * MiB;
constexpr size_t WS_OW = WS_R, WS_OKK = 157 * MiB, WS_OB = 174 * MiB, WS_OKM = 191 * MiB, WS_OR = 208 * MiB, WS_OV = 225 * MiB;
constexpr size_t WS_ACT = 66 * MiB, WS_HB = 202 * MiB, WS_END = 256 * MiB;
static_assert(WS_ZS + (size_t)MT * SHIFTW * 2 <= WS_R && WS_ZR + (size_t)MT * ZRW * 2 <= WS_KBP && WS_KBS + (size_t)NB_S * LS * 256 * 2 <= WS_VTS && WS_VTS + (size_t)NB_S * 256 * LS * 2 <= WS_KIS &&
              WS_KIS + (size_t)NB_S * LS * 64 * 2 <= WS_END && WS_OV + (size_t)MT * 512 * 2 <= WS_END && WS_ACT + (size_t)MT * DFF * 2 <= WS_HB && WS_HB + (size_t)MT * DM * 2 <= WS_END, "d_ws map");
constexpr size_t SC_Q = 0, SC_QI = (size_t)MT * 512 / 2, SC_Y = 0, SC_G = (size_t)MT * 512;
constexpr int CW_QATT = 64;

typedef unsigned short bf16;
typedef short bf16x8 __attribute__((ext_vector_type(8)));
typedef float f32x4 __attribute__((ext_vector_type(4)));
typedef float f32x16 __attribute__((ext_vector_type(16)));
typedef unsigned u32x4 __attribute__((ext_vector_type(4)));
typedef unsigned u32x2 __attribute__((ext_vector_type(2)));

__device__ __forceinline__ unsigned f2bf(float f) { unsigned u = __float_as_uint(f); return (u + 0x7fffu + ((u >> 16) & 1u)) >> 16; }
__device__ __forceinline__ unsigned pk2(float lo, float hi) { return f2bf(lo) | (f2bf(hi) << 16); }
__device__ __forceinline__ float bflo(unsigned w) { return __uint_as_float(w << 16); }
__device__ __forceinline__ float bfhi(unsigned w) { return __uint_as_float(w & 0xffff0000u); }
__device__ __forceinline__ float bf1(bf16 b) { return __uint_as_float((unsigned)b << 16); }
__device__ __forceinline__ void unpack8(const u32x4 w, float* x) { x[0] = bflo(w.x); x[1] = bfhi(w.x); x[2] = bflo(w.y); x[3] = bfhi(w.y); x[4] = bflo(w.z); x[5] = bfhi(w.z); x[6] = bflo(w.w); x[7] = bfhi(w.w); }
__device__ __forceinline__ u32x4 pack8(const float* x) { u32x4 w; w.x = pk2(x[0], x[1]); w.y = pk2(x[2], x[3]); w.z = pk2(x[4], x[5]); w.w = pk2(x[6], x[7]); return w; }
__device__ __forceinline__ float wave_sum(float v) {
#pragma unroll
    for (int o = 1; o < 64; o <<= 1) v += __shfl_xor(v, o);
    return v;
}
template <int CTRL> __device__ __forceinline__ float dppmov(float x) { return __builtin_bit_cast(float, __builtin_amdgcn_update_dpp(0, __builtin_bit_cast(int, x), CTRL, 0xf, 0xf, true)); }
__device__ __forceinline__ float sum16(float x) {
    x += dppmov<0xB1>(x); x += dppmov<0x4E>(x); x += dppmov<0x141>(x); x += dppmov<0x140>(x); return x;
}
__device__ __forceinline__ int crow(int r, int hi) { return (r & 3) + 8 * (r >> 2) + 4 * hi; }

struct Args { const float* in[28]; float* out; unsigned char* ws; int ph_lo, ph_hi; };

__device__ __forceinline__ void tr_item(const float* W, int K, int N, const float* gain, bf16* WT, int jr0, int c0, int nvalid, int k0, float* scr, int lane) {
#pragma unroll 8
    for (int i = 0; i < 32; ++i) { const int kk = 2 * i + (lane >> 5), n = lane & 31;
        float v = (n < nvalid) ? W[(size_t)(k0 + kk) * N + c0 + n] : 0.f; if (gain) v *= gain[k0 + kk]; scr[kk * 33 + n] = v; }
    __builtin_amdgcn_s_waitcnt(0xC07F); asm volatile("" ::: "memory");
    const int c = lane & 7;
#pragma unroll
    for (int j = 0; j < 4; ++j) { const int n = (lane >> 3) + 8 * j; const float* s = scr + (8 * c) * 33 + n;
        u32x4 o; o.x = pk2(s[0 * 33], s[1 * 33]); o.y = pk2(s[2 * 33], s[3 * 33]); o.z = pk2(s[4 * 33], s[5 * 33]); o.w = pk2(s[6 * 33], s[7 * 33]);
        *(u32x4*)(WT + (size_t)(jr0 + n) * K + k0 + 8 * c) = o; }
    __builtin_amdgcn_s_waitcnt(0xC07F); asm volatile("" ::: "memory");
}
__device__ __forceinline__ void p0_prologue(const Args& a, unsigned char* lds, int tid) {
    const int lane = tid & 63, wave = tid >> 6, gw = blockIdx.x * 8 + wave, NGW = gridDim.x * 8;
    float* scr = (float*)(lds + wave * 17408);
    unsigned char* ws = a.ws;
    constexpr int I_IN = (NZ / 32) * (DM / 64), I_OUT = (DM / 32) * (DM / 64), I_F1 = (DFF / 32) * (DM / 64), I_F2 = (DM / 32) * (DFF / 64);
    for (int it = gw; it < I_IN + I_OUT + I_F1 + I_F2; it += NGW) {
        int r = it;
        if (r < I_IN) { const int jb = r % (NZ / 32), kb = r / (NZ / 32), j0 = jb * 32; int c0, nv;
            if (j0 < 1600) { c0 = j0; nv = 32; } else if (j0 < 3296) { c0 = 1608 + (j0 - 1600); nv = 32; } else { c0 = 1600; nv = 8; }
            tr_item(a.in[8], DM, 3304, a.in[7], (bf16*)(ws + WS_WIN), j0, c0, nv, kb * 64, scr, lane); continue; }
        r -= I_IN;
        if (r < I_OUT) { const int jb = r % (DM / 32), kb = r / (DM / 32); tr_item(a.in[24], DM, DM, nullptr, (bf16*)(ws + WS_WOUT), jb * 32, jb * 32, 32, kb * 64, scr, lane); continue; }
        r -= I_OUT;
        if (r < I_F1) { const int jb = r % (DFF / 32), kb = r / (DFF / 32); tr_item(a.in[26], DM, DFF, a.in[25], (bf16*)(ws + WS_W1), jb * 32, jb * 32, 32, kb * 64, scr, lane); continue; }
        r -= I_F1;
        { const int jb = r % (DM / 32), kb = r / (DM / 32); tr_item(a.in[27], DFF, DM, nullptr, (bf16*)(ws + WS_W2), jb * 32, jb * 32, 32, kb * 64, scr, lane); }
    }
    { const int gt = blockIdx.x * 512 + tid, NT = gridDim.x * 512;
      bf16* w2t = (bf16*)(ws + WS_W2T); bf16* a2t = (bf16*)(ws + WS_A2T); bf16* g2t = (bf16*)(ws + WS_G2T);
      for (int i = gt; i < 512 * 32; i += NT) { const int n = i >> 5, k = i & 31; w2t[i] = (bf16)f2bf(a.in[15][k * 512 + n]); a2t[i] = (bf16)f2bf(a.in[17][k * 512 + n]); }
      for (int i = gt; i < 512 * 96; i += NT) { const int n = i / 96, k = i % 96; g2t[i] = (bf16)f2bf(a.in[18][k * 512 + n]); } }
    for (int m = gw; m < MT; m += NGW) {
        const float* xrow = (m < MP) ? a.in[0] + (size_t)m * DM : a.in[1] + (size_t)(m - MP) * DM;
        const f32x4* xr = (const f32x4*)xrow + lane; f32x4 v[4]; float s = 0.f;
#pragma unroll
        for (int j = 0; j < 4; ++j) { v[j] = xr[64 * j]; s += (v[j].x * v[j].x + v[j].y * v[j].y) + (v[j].z * v[j].z + v[j].w * v[j].w); }
        const float rs = rsqrtf(wave_sum(s) * (1.f / DM) + 1e-6f);
        u32x2* o8 = (u32x2*)((bf16*)(ws + WS_XB) + (size_t)m * DM) + lane;
#pragma unroll
        for (int j = 0; j < 4; ++j) { u32x2 o; o.x = pk2(v[j].x * rs, v[j].y * rs); o.y = pk2(v[j].z * rs, v[j].w * rs); o8[64 * j] = o; }
    }
    for (int rix = gw; rix < NB_S * PAST; rix += NGW) {
        const int b = rix >> 10, p = rix & 1023; const f32x4 v = ((const f32x4*)(a.in[2] + (size_t)rix * 256))[lane];
        u32x2 o; o.x = pk2(v.x, v.y); o.y = pk2(v.z, v.w); ((u32x2*)((bf16*)(ws + WS_KBS) + ((size_t)b * LS + p) * 256))[lane] = o;
    }
    for (int r4 = gw; r4 < NB_S * PAST / 4; r4 += NGW) {
        const int rix = r4 * 4 + (lane >> 4), b = rix >> 10, p = rix & 1023; const f32x4 v = ((const f32x4*)(a.in[4] + (size_t)rix * 64))[lane & 15];
        u32x2 o; o.x = pk2(v.x, v.y); o.y = pk2(v.z, v.w); ((u32x2*)((bf16*)(ws + WS_KIS) + ((size_t)b * LS + p) * 64))[lane & 15] = o;
    }
    for (int it = gw; it < NB_S * 4 * 16; it += NGW) {
        const int kb = it & 15, g = (it >> 4) & 3, b = it >> 6;
        const float* src = a.in[3] + ((size_t)b * PAST + kb * 64) * 256 + g * 64;
#pragma unroll 8
        for (int i = 0; i < 64; ++i) scr[i * 65 + lane] = src[(size_t)i * 256 + lane];
        __builtin_amdgcn_s_waitcnt(0xC07F); asm volatile("" ::: "memory");
        bf16* dst = (bf16*)(ws + WS_VTS) + ((size_t)(b * 4 + g) * 64) * LS + kb * 64 + lane;
#pragma unroll 8
        for (int d = 0; d < 64; ++d) dst[(size_t)d * LS] = (bf16)f2bf(scr[lane * 65 + d]);
        __builtin_amdgcn_s_waitcnt(0xC07F); asm volatile("" ::: "memory");
    }
}

__device__ __forceinline__ void p2_post(const Args& a, unsigned char* lds, int tid) {
    unsigned char* ws = a.ws; float* out = a.out;
    const bf16* ZR = (const bf16*)(ws + WS_ZR); const bf16* ZS = (const bf16*)(ws + WS_ZS);
    bf16* Q = (bf16*)(out + SC_Q); bf16* QI = (bf16*)(out + SC_QI);
    float* cs = (float*)lds;
    bf16* vt = (bf16*)(lds + 4096);
    const int g8 = tid >> 3, sub = tid & 7;
    const float* qg = a.in[9]; const float* kg = a.in[10]; const float* lng = a.in[11]; const float* lnb = a.in[12];
    for (int tile = blockIdx.x; tile < MT / 64; tile += gridDim.x) {
        const int m0 = tile * 64;
        { const int m = m0 + g8, pos = (m < MP) ? (m & (T_P - 1)) : (PAST + ((m - MP) & (T_S - 1)));
          const float inv = powf(500000.0f, -(float)sub * 0.125f); const float ang = (float)pos * inv; float s, c; sincosf(ang, &s, &c);
          cs[g8 * 16 + sub] = c; cs[g8 * 16 + 8 + sub] = s; }
        __syncthreads();
        const int m = m0 + g8;
        const bool isp = m < MP; const int ms = m - MP;
        float cc[8], ss[8];
#pragma unroll
        for (int j = 0; j < 8; ++j) { cc[j] = cs[g8 * 16 + j]; ss[j] = cs[g8 * 16 + 8 + j]; }
        const size_t kvrow = isp ? (size_t)m : ((size_t)(ms >> 5) * LS + PAST + (ms & 31));
        bf16* KB = (bf16*)(ws + (isp ? WS_KBP : WS_KBS)); bf16* KIb = (bf16*)(ws + (isp ? WS_KIP : WS_KIS));
        for (int hb = 0; hb < 25; ++hb) {
            float x[8]; unpack8(*(const u32x4*)(ZR + (size_t)m * ZRW + hb * 64 + 8 * sub), x);
            if (hb < 12) {
                float s2 = 0.f;
#pragma unroll
                for (int j = 0; j < 8; ++j) s2 += x[j] * x[j];
                s2 += __shfl_xor(s2, 1); s2 += __shfl_xor(s2, 2); s2 += __shfl_xor(s2, 4);
                const float rinv = rsqrtf(s2 * (1.f / 64.f) + 1e-6f); const float* gn = (hb < 8 ? qg : kg) + 8 * sub;
                float y[8], o[8];
#pragma unroll
                for (int j = 0; j < 8; ++j) y[j] = x[j] * rinv * gn[j];
#pragma unroll
                for (int j = 0; j < 8; ++j) { const float p = __shfl_xor(y[j], 1); o[j] = sub == 0 ? y[j] * cc[j] - p * ss[j] : (sub == 1 ? y[j] * cc[j] + p * ss[j] : y[j]); }
                if (hb < 8) {
#pragma unroll
                    for (int j = 0; j < 8; ++j) o[j] *= QSCALE;
                    *(u32x4*)(Q + (size_t)m * 512 + hb * 64 + 8 * sub) = pack8(o);
                } else { const int g = hb - 8;
                    float* ko = out + (isp ? OFF_KP + (size_t)m * 256 : OFF_KS + (size_t)ms * 256) + g * 64 + 8 * sub;
                    *(f32x4*)ko = (f32x4){o[0], o[1], o[2], o[3]}; *(f32x4*)(ko + 4) = (f32x4){o[4], o[5], o[6], o[7]};
                    *(u32x4*)(KB + kvrow * 256 + g * 64 + 8 * sub) = pack8(o); }
            } else if (hb < 16) { const int g = hb - 12;
                float* vo = out + (isp ? OFF_VP + (size_t)m * 256 : OFF_VS + (size_t)ms * 256) + g * 64 + 8 * sub;
                *(f32x4*)vo = (f32x4){x[0], x[1], x[2], x[3]}; *(f32x4*)(vo + 4) = (f32x4){x[4], x[5], x[6], x[7]};
                unsigned* vd = (unsigned*)(vt + g8 * 258 + g * 64 + 8 * sub);
                vd[0] = pk2(x[0], x[1]); vd[1] = pk2(x[2], x[3]); vd[2] = pk2(x[4], x[5]); vd[3] = pk2(x[6], x[7]);
            } else if (hb < 24) {
                float o[8];
#pragma unroll
                for (int j = 0; j < 8; ++j) { const float p = __shfl_xor(x[j], 1); o[j] = sub == 0 ? x[j] * cc[j] - p * ss[j] : (sub == 1 ? x[j] * cc[j] + p * ss[j] : x[j]); }
                *(u32x4*)(QI + (size_t)m * 512 + (hb - 16) * 64 + 8 * sub) = pack8(o);
            } else {
                float s1 = 0.f;
#pragma unroll
                for (int j = 0; j < 8; ++j) s1 += x[j];
                s1 += __shfl_xor(s1, 1); s1 += __shfl_xor(s1, 2); s1 += __shfl_xor(s1, 4);
                const float mu = s1 * (1.f / 64.f); float s2 = 0.f;
#pragma unroll
                for (int j = 0; j < 8; ++j) { const float d = x[j] - mu; s2 += d * d; }
                s2 += __shfl_xor(s2, 1); s2 += __shfl_xor(s2, 2); s2 += __shfl_xor(s2, 4);
                const float rinv = rsqrtf(s2 * (1.f / 64.f) + 1e-6f); float y[8], o[8];
#pragma unroll
                for (int j = 0; j < 8; ++j) y[j] = (x[j] - mu) * rinv * lng[8 * sub + j] + lnb[8 * sub + j];
#pragma unroll
                for (int j = 0; j < 8; ++j) { const float p = __shfl_xor(y[j], 1); o[j] = sub == 0 ? y[j] * cc[j] - p * ss[j] : (sub == 1 ? y[j] * cc[j] + p * ss[j] : y[j]); }
                float* ko = out + (isp ? OFF_KIP + (size_t)m * 64 : OFF_KIS + (size_t)ms * 64) + 8 * sub;
                *(f32x4*)ko = (f32x4){o[0], o[1], o[2], o[3]}; *(f32x4*)(ko + 4) = (f32x4){o[4], o[5], o[6], o[7]};
                *(u32x4*)(KIb + kvrow * 64 + 8 * sub) = pack8(o);
            }
        }
        ((float*)(ws + WS_WI))[(size_t)m * 8 + sub] = bf1(ZR[(size_t)m * ZRW + 1600 + sub]) * WISCALE;
        __syncthreads();
        { const int r = tid >> 1, half = tid & 1; unsigned wv[16];
#pragma unroll
          for (int j = 0; j < 16; ++j) wv[j] = (unsigned)vt[(32 * half + 2 * j) * 258 + r] | ((unsigned)vt[(32 * half + 2 * j + 1) * 258 + r] << 16);
          bf16* dst;
          if (m0 < MP) dst = (bf16*)(ws + WS_VTP) + ((size_t)(m0 >> 11) * 256 + r) * T_P + (m0 & (T_P - 1)) + 32 * half;
          else { const int b = ((m0 - MP) >> 5) + half; dst = (bf16*)(ws + WS_VTS) + ((size_t)b * 256 + r) * LS + PAST; }
#pragma unroll
          for (int j = 0; j < 4; ++j) ((u32x4*)dst)[j] = (u32x4){wv[4 * j], wv[4 * j + 1], wv[4 * j + 2], wv[4 * j + 3]}; }
        if (m0 < MP) { if ((m0 & (T_P - 1)) == T_P - 64) { const int b = m0 >> 11; const bf16* zr = ZS + (size_t)(m0 + 63) * SHIFTW;
                for (int c = tid; c < SHIFTW; c += 512) out[OFF_SHP + (size_t)b * SHIFTW + c] = bf1(zr[c]); } }
        else { for (int h2 = 0; h2 < 2; ++h2) { const int b = ((m0 - MP) >> 5) + h2; const bf16* zr = ZS + (size_t)(m0 + 32 * h2 + 31) * SHIFTW;
                for (int c = tid; c < SHIFTW; c += 512) out[OFF_SHS + (size_t)b * SHIFTW + c] = bf1(zr[c]); } }
        __syncthreads();
    }
}

constexpr int ATT_UNITS = 544;
constexpr int MASK_PITCH = 65;
#define MFMA32(a, b, c) __builtin_amdgcn_mfma_f32_32x32x16_bf16((a), (b), (c), 0, 0, 0)

__device__ __forceinline__ float half_sum32(float v) { v += __shfl_xor(v, 1); v += __shfl_xor(v, 2); v += __shfl_xor(v, 4); v += __shfl_xor(v, 8); v += __shfl_xor(v, 16); return v; }
__device__ __forceinline__ float half_min32(float v) { v = fminf(v, __shfl_xor(v, 1)); v = fminf(v, __shfl_xor(v, 2)); v = fminf(v, __shfl_xor(v, 4)); v = fminf(v, __shfl_xor(v, 8)); v = fminf(v, __shfl_xor(v, 16)); return v; }
__device__ __forceinline__ float half_max32(float v) { v = fmaxf(v, __shfl_xor(v, 1)); v = fmaxf(v, __shfl_xor(v, 2)); v = fmaxf(v, __shfl_xor(v, 4)); v = fmaxf(v, __shfl_xor(v, 8)); v = fmaxf(v, __shfl_xor(v, 16)); return v; }
__device__ __forceinline__ int half_sum32i(int v) { v += __shfl_xor(v, 1); v += __shfl_xor(v, 2); v += __shfl_xor(v, 4); v += __shfl_xor(v, 8); v += __shfl_xor(v, 16); return v; }

__device__ __forceinline__ void p3_attention(const Args& a, unsigned char* lds, int tid) {
    unsigned char* ws = a.ws; float* out = a.out;
    const bf16* Q = (const bf16*)(out + SC_Q); const bf16* QI = (const bf16*)(out + SC_QI); const float* WI = (const float*)(ws + WS_WI);
    bf16* O = (bf16*)(ws + WS_XB);
    unsigned* maskw = (unsigned*)lds;
    float* lsum = (float*)(lds + 32 * MASK_PITCH * 4);
    int* s_unit = (int*)(lds + 32 * MASK_PITCH * 4 + 1024);
    typedef float f32x2_t __attribute__((ext_vector_type(2)));
    f32x2_t* scl = (f32x2_t*)(lds + 10240) + (size_t)(tid >> 6) * 2048 + (tid & 63);
    unsigned* qctr = (unsigned*)(ws + WS_CTL) + CW_QATT;
    const int l = tid & 63, w = __builtin_amdgcn_readfirstlane(tid >> 6), rho = l & 31, hi = l >> 5;
    for (;;) {
        if (tid == 0) *s_unit = (int)atomicAdd(qctr, 1u);
        __syncthreads();
        const int p = *s_unit;
        __syncthreads();
        if (p >= ATT_UNITS) break;
        int m0, nkt, vpitch; const bf16 *KB, *VT, *KI; bool need_idx;
        { int c = -1, b, half = 0;
          if (p < 256) { c = 31 - (p >> 4); b = (p & 15) >> 1; half = p & 1; }
          else if (p < 288) { b = p - 256; }
          else { const int pp = p - 288; c = 15 - (pp >> 4); b = (pp & 15) >> 1; half = pp & 1; }
          if (c >= 0) { m0 = b * T_P + 64 * c + 32 * half; nkt = 2 * (c + 1); vpitch = T_P; need_idx = c >= 4;
              KB = (const bf16*)(ws + WS_KBP) + (size_t)b * T_P * 256; VT = (const bf16*)(ws + WS_VTP) + (size_t)b * 256 * T_P; KI = (const bf16*)(ws + WS_KIP) + (size_t)b * T_P * 64; }
          else { m0 = MP + 32 * b; nkt = LS / 32; vpitch = LS; need_idx = true;
              KB = (const bf16*)(ws + WS_KBS) + (size_t)b * LS * 256; VT = (const bf16*)(ws + WS_VTS) + (size_t)b * 256 * LS; KI = (const bf16*)(ws + WS_KIS) + (size_t)b * LS * 64; } }
        if (need_idx) {
            const int tokA = 4 * w + 2 * ((rho >> 2) & 1) + (rho >> 4), headA = (rho & 3) + 4 * ((rho >> 3) & 1);
            bf16x8 qa[4];
#pragma unroll
            for (int ks = 0; ks < 4; ++ks) qa[ks] = *(const bf16x8*)(QI + (size_t)(m0 + tokA) * 512 + headA * 64 + 16 * ks + 8 * hi);
            float wv[16];
#pragma unroll
            for (int r = 0; r < 16; ++r) wv[r] = WI[(size_t)(m0 + 4 * w + 2 * hi + (r >> 3)) * 8 + (r & 7)];
            float sc0[32], sc1[32];
            bf16x8 kb[4];
            const bf16* kip = KI + (size_t)rho * 64 + 8 * hi;
#pragma unroll
            for (int ks = 0; ks < 4; ++ks) kb[ks] = *(const bf16x8*)(kip + 16 * ks);
#pragma unroll
            for (int kt = 0; kt < 64; ++kt) {
                if (kt < nkt) {
                    f32x16 acc = {0.f, 0.f, 0.f, 0.f, 0.f, 0.f, 0.f, 0.f, 0.f, 0.f, 0.f, 0.f, 0.f, 0.f, 0.f, 0.f};
#pragma unroll
                    for (int ks = 0; ks < 4; ++ks) acc = MFMA32(qa[ks], kb[ks], acc);
                    if (kt + 1 < nkt) {
#pragma unroll
                        for (int ks = 0; ks < 4; ++ks) kb[ks] = *(const bf16x8*)(kip + (size_t)(kt + 1) * 32 * 64 + 16 * ks);
                    }
                    float s0 = 0.f, s1 = 0.f;
#pragma unroll
                    for (int r = 0; r < 8; ++r) { s0 += wv[r] * fmaxf(acc[r], 0.f); s1 += wv[8 + r] * fmaxf(acc[8 + r], 0.f); }
                    if (kt < 32) { sc0[kt & 31] = s0; sc1[kt & 31] = s1; } else scl[(kt - 32) * 64] = (f32x2_t){s0, s1};
                } else if (kt < 32) { sc0[kt & 31] = -3.0e38f; sc1[kt & 31] = -3.0e38f; }
            }
            float mn0 = 3.0e38f, mx0 = -3.0e38f, mn1 = 3.0e38f, mx1 = -3.0e38f;
#pragma unroll
            for (int kt = 0; kt < 64; ++kt) if (kt < nkt) { float v0, v1; if (kt < 32) { v0 = sc0[kt & 31]; v1 = sc1[kt & 31]; } else { const f32x2_t t2 = scl[(kt - 32) * 64]; v0 = t2.x; v1 = t2.y; }
                mn0 = fminf(mn0, v0); mx0 = fmaxf(mx0, v0); mn1 = fminf(mn1, v1); mx1 = fmaxf(mx1, v1); }
            mn0 = half_min32(mn0); mx0 = half_max32(mx0); mn1 = half_min32(mn1); mx1 = half_max32(mx1);
            float lo0 = mn0 - 1.0f, hi0 = mx0, lo1 = mn1 - 1.0f, hi1 = mx1, thr0 = 0.f, thr1 = 0.f; int ch0 = 0, ch1 = 0, nt0 = 0, nt1 = 0; bool fin0 = false, fin1 = false;
            for (int iter = 0; iter < 200; ++iter) {
                const float mid0 = lo0 + 0.5f * (hi0 - lo0), mid1 = lo1 + 0.5f * (hi1 - lo1);
                int c0 = 0, c1 = 0;
#pragma unroll
                for (int g = 0; g < 4; ++g) if (8 * g < nkt) {
#pragma unroll
                    for (int k8 = 0; k8 < 8; ++k8) { c0 += sc0[8 * g + k8] > mid0 ? 1 : 0; c1 += sc1[8 * g + k8] > mid1 ? 1 : 0; } }
                for (int kt = 32; kt < nkt; ++kt) { const f32x2_t t2 = scl[(kt - 32) * 64]; c0 += t2.x > mid0 ? 1 : 0; c1 += t2.y > mid1 ? 1 : 0; }
                c0 = half_sum32i(c0); c1 = half_sum32i(c1);
                if (!fin0) { if (!(mid0 > lo0 && mid0 < hi0)) { fin0 = true; thr0 = hi0; nt0 = 256 - ch0; }
                             else if (c0 == 256) { fin0 = true; thr0 = mid0; nt0 = 0; } else if (c0 > 256) lo0 = mid0; else { hi0 = mid0; ch0 = c0; } }
                if (!fin1) { if (!(mid1 > lo1 && mid1 < hi1)) { fin1 = true; thr1 = hi1; nt1 = 256 - ch1; }
                             else if (c1 == 256) { fin1 = true; thr1 = mid1; nt1 = 0; } else if (c1 > 256) lo1 = mid1; else { hi1 = mid1; ch1 = c1; } }
                if (__all(fin0 && fin1)) break;
            }
            const bool any_tie = __any(nt0 > 0 || nt1 > 0);
            int run0 = 0, run1 = 0; const unsigned below = (1u << rho) - 1u;
#pragma unroll
            for (int kt = 0; kt < 64; ++kt) if (kt < nkt) {
                float v0, v1; if (kt < 32) { v0 = sc0[kt & 31]; v1 = sc1[kt & 31]; } else { const f32x2_t t2 = scl[(kt - 32) * 64]; v0 = t2.x; v1 = t2.y; }
                bool p0 = v0 > thr0, p1 = v1 > thr1;
                if (any_tie) {
                    const bool e0 = nt0 > 0 && v0 == thr0, e1 = nt1 > 0 && v1 == thr1;
                    const unsigned long long be0 = __ballot(e0), be1 = __ballot(e1);
                    const unsigned h0 = (unsigned)(be0 >> (32 * hi)), h1 = (unsigned)(be1 >> (32 * hi));
                    p0 = p0 || (e0 && (run0 + __popc(h0 & below)) < nt0); p1 = p1 || (e1 && (run1 + __popc(h1 & below)) < nt1);
                    run0 += __popc(h0); run1 += __popc(h1);
                }
                const unsigned long long b0 = __ballot(p0), b1 = __ballot(p1);
                if (l == 0) { maskw[(4 * w + 0) * MASK_PITCH + kt] = (unsigned)b0; maskw[(4 * w + 1) * MASK_PITCH + kt] = (unsigned)b1; }
                if (l == 32) { maskw[(4 * w + 2) * MASK_PITCH + kt] = (unsigned)(b0 >> 32); maskw[(4 * w + 3) * MASK_PITCH + kt] = (unsigned)(b1 >> 32); }
            }
        }
        __syncthreads();
        {
            const int g = w >> 1;
            bf16x8 qb[4];
#pragma unroll
            for (int ks = 0; ks < 4; ++ks) qb[ks] = *(const bf16x8*)(Q + (size_t)(m0 + rho) * 512 + w * 64 + 16 * ks + 8 * hi);
            const bf16* Kp = KB + (size_t)rho * 256 + g * 64 + 8 * hi;
            const bf16* Vp = VT + ((size_t)g * 64 + rho) * vpitch + 4 * hi;
            f32x16 o0 = {0.f, 0.f, 0.f, 0.f, 0.f, 0.f, 0.f, 0.f, 0.f, 0.f, 0.f, 0.f, 0.f, 0.f, 0.f, 0.f}, o1 = o0; float psum = 0.f;
            bf16x8 ka[2][4]; u32x2 vb[2][2][2][2];
#define ATT_LOAD(buf, kt_) do { _Pragma("unroll") for (int ks = 0; ks < 4; ++ks) ka[buf][ks] = *(const bf16x8*)(Kp + (size_t)(kt_) * 32 * 256 + 16 * ks); \
            _Pragma("unroll") for (int s = 0; s < 2; ++s) _Pragma("unroll") for (int dt = 0; dt < 2; ++dt) { const bf16* vp_ = Vp + (size_t)dt * 32 * vpitch + (kt_) * 32 + 16 * s; \
                vb[buf][s][dt][0] = *(const u32x2*)vp_; vb[buf][s][dt][1] = *(const u32x2*)(vp_ + 8); } } while (0)
#define ATT_COMPUTE(buf, kt_) do { f32x16 st = {0.f, 0.f, 0.f, 0.f, 0.f, 0.f, 0.f, 0.f, 0.f, 0.f, 0.f, 0.f, 0.f, 0.f, 0.f, 0.f}; \
            _Pragma("unroll") for (int ks = 0; ks < 4; ++ks) st = MFMA32(ka[buf][ks], qb[ks], st); \
            unsigned word = need_idx ? maskw[rho * MASK_PITCH + (kt_)] : 0xffffffffu; word >>= 4 * hi; float pr[16]; \
            _Pragma("unroll") for (int r = 0; r < 16; ++r) { const float e = __builtin_amdgcn_exp2f(st[r]); pr[r] = ((word >> ((r & 3) + 8 * (r >> 2))) & 1u) ? e : 0.f; psum += pr[r]; } \
            union { u32x4 u; bf16x8 v; } pa0, pa1; pa0.u = (u32x4){pk2(pr[0], pr[1]), pk2(pr[2], pr[3]), pk2(pr[4], pr[5]), pk2(pr[6], pr[7])}; pa1.u = (u32x4){pk2(pr[8], pr[9]), pk2(pr[10], pr[11]), pk2(pr[12], pr[13]), pk2(pr[14], pr[15])}; \
            union { u32x4 u; bf16x8 v; } v00, v01, v10, v11; v00.u = (u32x4){vb[buf][0][0][0].x, vb[buf][0][0][0].y, vb[buf][0][0][1].x, vb[buf][0][0][1].y}; v01.u = (u32x4){vb[buf][0][1][0].x, vb[buf][0][1][0].y, vb[buf][0][1][1].x, vb[buf][0][1][1].y}; \
            v10.u = (u32x4){vb[buf][1][0][0].x, vb[buf][1][0][0].y, vb[buf][1][0][1].x, vb[buf][1][0][1].y}; v11.u = (u32x4){vb[buf][1][1][0].x, vb[buf][1][1][0].y, vb[buf][1][1][1].x, vb[buf][1][1][1].y}; \
            o0 = MFMA32(pa0.v, v00.v, o0); o0 = MFMA32(pa1.v, v10.v, o0); o1 = MFMA32(pa0.v, v01.v, o1); o1 = MFMA32(pa1.v, v11.v, o1); } while (0)
            ATT_LOAD(0, 0);
            for (int kt = 0; kt < nkt; kt += 2) {
                if (kt + 1 < nkt) ATT_LOAD(1, kt + 1);
                ATT_COMPUTE(0, kt);
                if (kt + 1 < nkt) { if (kt + 2 < nkt) ATT_LOAD(0, kt + 2); ATT_COMPUTE(1, kt + 1); }
            }
#undef ATT_LOAD
#undef ATT_COMPUTE
            psum += __shfl_xor(psum, 32);
            if (hi == 0) lsum[w * 32 + rho] = psum;
            __syncthreads();
#pragma unroll
            for (int r = 0; r < 16; ++r) { const int qr = crow(r, hi); const float inv = 1.0f / lsum[w * 32 + qr];
                bf16* op = O + (size_t)(m0 + qr) * DM + w * 64 + rho;
                op[0] = (bf16)f2bf(o0[r] * inv); op[32] = (bf16)f2bf(o1[r] * inv); }
        }
        __syncthreads();
    }
}

constexpr int XS_PITCH = 168;
__device__ __forceinline__ void p4_rwkv_prep(const Args& a, unsigned char* lds, int tid) {
    unsigned char* ws = a.ws; float* out = a.out;
    const bf16* ZS = (const bf16*)(ws + WS_ZS);
    const bf16* w2t = (const bf16*)(ws + WS_W2T); const bf16* a2t = (const bf16*)(ws + WS_A2T); const bf16* g2t = (const bf16*)(ws + WS_G2T);
    float* OW = (float*)(ws + WS_OW); bf16* OKK = (bf16*)(ws + WS_OKK); bf16* OB = (bf16*)(ws + WS_OB); bf16* OKM = (bf16*)(ws + WS_OKM); bf16* OR_ = (bf16*)(ws + WS_OR); bf16* OV = (bf16*)(ws + WS_OV);
    bf16* G = (bf16*)(out + SC_G); float* BON = (float*)(ws + WS_BONUS);
    const float* mu = a.in[13]; const float* w0 = a.in[14]; const float* a0 = a.in[16]; const float* k_k = a.in[19]; const float* k_a = a.in[20]; const float* r_k = a.in[21]; const float* sh0 = a.in[6];
    bf16* xs = (bf16*)lds;
    const int l = tid & 63, h = __builtin_amdgcn_readfirstlane(tid >> 6), rho = l & 31, hi = l >> 5;
    for (int tile = blockIdx.x; tile < MT / 32; tile += gridDim.x) {
        const int m0 = tile * 32; const bool smp = m0 >= MP;
        const bool tile_first = smp || (m0 & (T_P - 1)) == 0;
        { const int tk = tid >> 4, c0 = (tid & 15) * 10, m = m0 + tk; const bool first = tile_first && tk == 0;
          const bf16* zc = ZS + (size_t)m * SHIFTW + 1536 + c0; const bf16* zp = first ? zc : zc - SHIFTW;
          const float* shp = sh0 + (size_t)(smp ? ((m0 - MP) >> 5) : 0) * SHIFTW + 1536 + c0;
#pragma unroll
          for (int e = 0; e < 10; ++e) { const int c = c0 + e; const float cur = bf1(zc[e]); float prev = bf1(zp[e]);
              if (first) prev = smp ? shp[e] : 0.f;
              const float zm = cur + mu[1536 + c] * (prev - cur);
              const float f = __frcp_rn(1.0f + __expf(c < 32 ? -2.0f * zm : -zm));
              const float v = c < 32 ? 2.0f * f - 1.0f : (c < 64 ? zm : f);
              xs[tk * XS_PITCH + c] = (bf16)f2bf(v); } }
        __syncthreads();
        const int m = m0 + rho; const bool first = tile_first && rho == 0;
        const bf16* zc = ZS + (size_t)m * SHIFTW + 64 * h + 4 * hi; const bf16* zp = first ? zc : zc - SHIFTW;
        const float* shp = sh0 + (size_t)(smp ? ((m0 - MP) >> 5) : 0) * SHIFTW + 64 * h + 4 * hi;
        const float* mu_l = mu + 64 * h + 4 * hi;
        const int pofs = 64 * h + 4 * hi;
#define ZMIX4(dst, co) do { const u32x2 cw = *(const u32x2*)(zc + (co)); const u32x2 pw = *(const u32x2*)(zp + (co)); const f32x4 mu4 = *(const f32x4*)(mu_l + (co)); \
            const float cu[4] = {bflo(cw.x), bfhi(cw.x), bflo(cw.y), bfhi(cw.y)}; float pv[4] = {bflo(pw.x), bfhi(pw.x), bflo(pw.y), bfhi(pw.y)}; \
            if (tile_first) { f32x4 s4 = {0.f, 0.f, 0.f, 0.f}; if (smp) s4 = *(const f32x4*)(shp + (co)); if (first) { pv[0] = s4.x; pv[1] = s4.y; pv[2] = s4.z; pv[3] = s4.w; } } \
            _Pragma("unroll") for (int e = 0; e < 4; ++e) dst[e] = cu[e] + mu4[e] * (pv[e] - cu[e]); } while (0)
        float n2 = 0.f;
#pragma unroll
        for (int ct = 0; ct < 2; ++ct)
#pragma unroll
            for (int grp = 0; grp < 4; ++grp) { const int co = 32 * ct + 8 * grp; float zk[4]; ZMIX4(zk, 512 + co); const f32x4 kk4 = *(const f32x4*)(k_k + pofs + co);
#pragma unroll
                for (int e = 0; e < 4; ++e) { const float kr = zk[e] * kk4[e]; n2 += kr * kr; } }
        n2 += __shfl_xor(n2, 32);
        const float invn = 1.0f / fmaxf(sqrtf(n2), 1e-12f);
        float bon = 0.f;
        asm volatile("" ::: "memory");
#pragma unroll
        for (int ct = 0; ct < 2; ++ct) {
            const f32x16 z16 = {0.f, 0.f, 0.f, 0.f, 0.f, 0.f, 0.f, 0.f, 0.f, 0.f, 0.f, 0.f, 0.f, 0.f, 0.f, 0.f}; f32x16 Dw = z16, Da = z16, Dg = z16;
            const int n = 64 * h + 32 * ct + rho;
            const bf16* xrow = xs + rho * XS_PITCH + 8 * hi;
#pragma unroll
            for (int ks = 0; ks < 2; ++ks) {
                Dw = MFMA32(*(const bf16x8*)(w2t + n * 32 + 16 * ks + 8 * hi), *(const bf16x8*)(xrow + 16 * ks), Dw);
                Da = MFMA32(*(const bf16x8*)(a2t + n * 32 + 16 * ks + 8 * hi), *(const bf16x8*)(xrow + 32 + 16 * ks), Da); }
#pragma unroll
            for (int ks = 0; ks < 6; ++ks) Dg = MFMA32(*(const bf16x8*)(g2t + n * 96 + 16 * ks + 8 * hi), *(const bf16x8*)(xrow + 64 + 16 * ks), Dg);
#pragma unroll
            for (int grp = 0; grp < 4; ++grp) {
                const int co = 32 * ct + 8 * grp;
                float zr[4], zk[4], zv[4]; ZMIX4(zr, co); ZMIX4(zk, 512 + co); ZMIX4(zv, 1024 + co);
                const f32x4 w04 = *(const f32x4*)(w0 + pofs + co), a04 = *(const f32x4*)(a0 + pofs + co), kk4 = *(const f32x4*)(k_k + pofs + co), ka4 = *(const f32x4*)(k_a + pofs + co), rk4 = *(const f32x4*)(r_k + pofs + co);
                float dec[4], km[4], gg[4], kk[4], bb[4];
#pragma unroll
                for (int e = 0; e < 4; ++e) { const int r = 4 * grp + e;
                    const float sg = __frcp_rn(1.0f + __expf(-(w04[e] + Dw[r])));
                    dec[e] = __expf(-0.6065306597126334f * sg);
                    const float aa = __frcp_rn(1.0f + __expf(-(a04[e] + Da[r])));
                    gg[e] = Dg[r];
                    kk[e] = zk[e] * kk4[e] * invn; bb[e] = kk[e] * aa;
                    km[e] = zk[e] * (1.0f + (aa - 1.0f) * ka4[e]);
                    bon += zr[e] * km[e] * rk4[e]; }
                const size_t o = (size_t)m * 512 + pofs + co;
                *(f32x4*)(OW + o) = (f32x4){dec[0], dec[1], dec[2], dec[3]};
                *(u32x2*)(OKK + o) = (u32x2){pk2(kk[0], kk[1]), pk2(kk[2], kk[3])};
                *(u32x2*)(OB + o) = (u32x2){pk2(bb[0], bb[1]), pk2(bb[2], bb[3])};
                *(u32x2*)(OKM + o) = (u32x2){pk2(km[0], km[1]), pk2(km[2], km[3])};
                *(u32x2*)(OR_ + o) = (u32x2){pk2(zr[0], zr[1]), pk2(zr[2], zr[3])};
                *(u32x2*)(OV + o) = (u32x2){pk2(zv[0], zv[1]), pk2(zv[2], zv[3])};
                *(u32x2*)(G + o) = (u32x2){pk2(gg[0], gg[1]), pk2(gg[2], gg[3])};
                asm volatile("" ::: "memory");
            }
        }
#undef ZMIX4
        bon += __shfl_xor(bon, 32);
        if (hi == 0) BON[(size_t)m * 8 + h] = bon;
        __syncthreads();
    }
}

struct ScanOp { f32x4 w; u32x2 kk, b, km, r; bf16 v; };
struct ScanPtr { const float* OW; const bf16 *OKK, *OB, *OKM, *OR_, *OV; };
__device__ __forceinline__ void scan_load(ScanOp& o, const ScanPtr& p, int step, int ks4, int row) {
    const int so = step * 512;
    o.w = *(const f32x4*)(p.OW + so + ks4); o.kk = *(const u32x2*)(p.OKK + so + ks4); o.b = *(const u32x2*)(p.OB + so + ks4);
    o.km = *(const u32x2*)(p.OKM + so + ks4); o.r = *(const u32x2*)(p.OR_ + so + ks4); o.v = p.OV[so + row];
}
__device__ __forceinline__ void scan_step(f32x4& S, const ScanOp& o, float* yp, bool st) {
    const float k0 = bflo(o.kk.x), k1 = bfhi(o.kk.x), k2 = bflo(o.kk.y), k3 = bfhi(o.kk.y);
    float d = (S.x * k0 + S.y * k1) + (S.z * k2 + S.w * k3); d = sum16(d);
    const float v = bf1(o.v);
    S.x = S.x * o.w.x + (v * bflo(o.km.x) - d * bflo(o.b.x)); S.y = S.y * o.w.y + (v * bfhi(o.km.x) - d * bfhi(o.b.x));
    S.z = S.z * o.w.z + (v * bflo(o.km.y) - d * bflo(o.b.y)); S.w = S.w * o.w.w + (v * bfhi(o.km.y) - d * bfhi(o.b.y));
    float y = (S.x * bflo(o.r.x) + S.y * bfhi(o.r.x)) + (S.z * bflo(o.r.y) + S.w * bfhi(o.r.y)); y = sum16(y);
    if (st) *yp = y;
}
__device__ __forceinline__ void scan_run(const unsigned char* ws, float* Y, size_t mrow0, int h, int row, int ks, int nsteps, f32x4& S) {
    const size_t base0 = mrow0 * 512 + (size_t)h * 64;
    ScanPtr p{(const float*)(ws + WS_OW) + base0, (const bf16*)(ws + WS_OKK) + base0, (const bf16*)(ws + WS_OB) + base0, (const bf16*)(ws + WS_OKM) + base0,
              (const bf16*)(ws + WS_OR) + base0, (const bf16*)(ws + WS_OV) + base0};
    float* yp = Y + base0; const bool st = ks == 0; const int ks4 = 4 * ks;
    ScanOp A[4];
#pragma unroll
    for (int i = 0; i < 4; ++i) scan_load(A[i], p, i, ks4, row);
    for (int t0 = 0; t0 < nsteps; t0 += 4) {
        const bool more = t0 + 4 < nsteps;
#pragma unroll
        for (int i = 0; i < 4; ++i) { const ScanOp cur = A[i];
            if (more) scan_load(A[i], p, 4 + i, ks4, row);
            scan_step(S, cur, yp + i * 512 + row, st); }
        p.OW += 4 * 512; p.OKK += 4 * 512; p.OB += 4 * 512; p.OKM += 4 * 512; p.OR_ += 4 * 512; p.OV += 4 * 512; yp += 4 * 512;
    }
}
__device__ __forceinline__ void p5_rwkv_scan(const Args& a, int tid) {
    const unsigned char* ws = a.ws; float* out = a.out; float* Y = out + SC_Y;
    const int l = tid & 63, w = __builtin_amdgcn_readfirstlane(tid >> 6), ks = l & 15, rl = l >> 4;
    for (int it = blockIdx.x; it < 256; it += gridDim.x) {
        if (w < 4) {
            const int bh = it >> 2, b = bh >> 3, h = bh & 7, row = 16 * (it & 3) + 4 * w + rl;
            f32x4 S = {0.f, 0.f, 0.f, 0.f};
            scan_run(ws, Y, (size_t)b * T_P, h, row, ks, T_P, S);
            *(f32x4*)(out + OFF_WKVP + ((size_t)bh * 64 + row) * 64 + 4 * ks) = S;
        } else {
            const int b = it >> 3, h = it & 7;
            for (int pass = 0; pass < 4; ++pass) { const int row = 16 * (w - 4) + 4 * pass + rl;
                f32x4 S = *(const f32x4*)(a.in[5] + ((size_t)it * 64 + row) * 64 + 4 * ks);
                scan_run(ws, Y, (size_t)MP + (size_t)b * T_S, h, row, ks, T_S, S);
                *(f32x4*)(out + OFF_WKVS + ((size_t)it * 64 + row) * 64 + 4 * ks) = S; }
        }
    }
}

__device__ __forceinline__ void p6_rwkv_out(const Args& a, int tid) {
    const unsigned char* ws = a.ws; const float* out = a.out; const float* Y = out + SC_Y; const bf16* G = (const bf16*)(out + SC_G);
    const bf16* OV = (const bf16*)(ws + WS_OV); const float* BON = (const float*)(ws + WS_BONUS); bf16* O = (bf16*)(a.ws + WS_XB);
    const float* lg = a.in[22]; const float* lb = a.in[23];
    const int sub = tid & 7;
    for (size_t it = (size_t)blockIdx.x * 64 + (tid >> 3); it < (size_t)MT * 8; it += (size_t)gridDim.x * 64) {
        const size_t m = it >> 3; const int h = (int)(it & 7); const size_t o = m * 512 + h * 64 + 8 * sub;
        const f32x4 y0 = *(const f32x4*)(Y + o), y1 = *(const f32x4*)(Y + o + 4); float y[8] = {y0.x, y0.y, y0.z, y0.w, y1.x, y1.y, y1.z, y1.w};
        float s1 = 0.f;
#pragma unroll
        for (int j = 0; j < 8; ++j) s1 += y[j];
        s1 += __shfl_xor(s1, 1); s1 += __shfl_xor(s1, 2); s1 += __shfl_xor(s1, 4);
        const float mean = s1 * (1.f / 64.f); float s2 = 0.f;
#pragma unroll
        for (int j = 0; j < 8; ++j) { const float d = y[j] - mean; s2 += d * d; }
        s2 += __shfl_xor(s2, 1); s2 += __shfl_xor(s2, 2); s2 += __shfl_xor(s2, 4);
        const float rinv = rsqrtf(s2 * (1.f / 64.f) + 64e-5f);
        float v[8], g[8]; unpack8(*(const u32x4*)(OV + o), v); unpack8(*(const u32x4*)(G + o), g);
        const float bon = BON[it]; float r[8];
#pragma unroll
        for (int j = 0; j < 8; ++j) { const int c = h * 64 + 8 * sub + j; r[j] = ((y[j] - mean) * rinv * lg[c] + lb[c] + bon * v[j]) * g[j]; }
        *(u32x4*)(O + m * DM + 512 + h * 64 + 8 * sub) = pack8(r);
    }
}

__device__ __forceinline__ void p8_hnorm(const Args& a, int tid) {
    const int lane = tid & 63, gw = blockIdx.x * 8 + (tid >> 6), NGW = gridDim.x * 8;
    for (int m = gw; m < MT; m += NGW) {
        const f32x4* xr = (const f32x4*)(a.out + OFF_Y + (size_t)m * DM) + lane; f32x4 v[4]; float s = 0.f;
#pragma unroll
        for (int j = 0; j < 4; ++j) { v[j] = xr[64 * j]; s += (v[j].x * v[j].x + v[j].y * v[j].y) + (v[j].z * v[j].z + v[j].w * v[j].w); }
        const float rs = rsqrtf(wave_sum(s) * (1.f / DM) + 1e-6f);
        u32x2* o8 = (u32x2*)((bf16*)(a.ws + WS_HB) + (size_t)m * DM) + lane;
#pragma unroll
        for (int j = 0; j < 4; ++j) { u32x2 o; o.x = pk2(v[j].x * rs, v[j].y * rs); o.y = pk2(v[j].z * rs, v[j].w * rs); o8[64 * j] = o; }
    }
}

constexpr int LDS_BYTES = 147456;
constexpr int N_PHASES = 11;
template <int PH> __device__ __forceinline__ void run_phase(const Args& args, unsigned char* lds, int tid) {
    unsigned char* ws = args.ws;
    if constexpr (PH == 0) p0_prologue(args, lds, tid);
    if constexpr (PH == 1) { pg8::Gemm g{(const pg8::bf16_t*)(ws + WS_XB), (const pg8::bf16_t*)(ws + WS_WIN), MT, NZ, DM}; pg8::StaticOrder S; S.init(MT, NZ, gridDim.x, blockIdx.x);
        pg8::EpiZ E{(pg8::bf16_t*)(ws + WS_ZR), (pg8::bf16_t*)(ws + WS_ZS)};
        pg8::gemm_phase<pg8::EpiZ, pg8::StaticOrder, true, true>((PG8_LAS unsigned char*)lds, g, S, E); }
    if constexpr (PH == 2) p2_post(args, lds, tid);
    if constexpr (PH == 3) p3_attention(args, lds, tid);
    if constexpr (PH == 4) p4_rwkv_prep(args, lds, tid);
    if constexpr (PH == 5) p5_rwkv_scan(args, tid);
    if constexpr (PH == 6) p6_rwkv_out(args, tid);
    if constexpr (PH == 7) { pg8::Gemm g{(const pg8::bf16_t*)(ws + WS_XB), (const pg8::bf16_t*)(ws + WS_WOUT), MT, DM, DM}; pg8::StaticOrder S; S.init(MT, DM, gridDim.x, blockIdx.x);
        pg8::EpiH E{args.in[0], args.in[1], args.out + OFF_Y};
        pg8::gemm_phase<pg8::EpiH, pg8::StaticOrder, true, true>((PG8_LAS unsigned char*)lds, g, S, E); }
    if constexpr (PH == 8) p8_hnorm(args, tid);
    if constexpr (PH == 9) { pg8::Gemm g{(const pg8::bf16_t*)(ws + WS_HB), (const pg8::bf16_t*)(ws + WS_W1), MT, DFF, DM}; pg8::StaticOrder S; S.init(MT, DFF, gridDim.x, blockIdx.x);
        pg8::EpiAct E{(pg8::bf16_t*)(ws + WS_ACT), DFF};
        pg8::gemm_phase<pg8::EpiAct, pg8::StaticOrder, true, true>((PG8_LAS unsigned char*)lds, g, S, E); }
    if constexpr (PH == 10) { pg8::Gemm g{(const pg8::bf16_t*)(ws + WS_ACT), (const pg8::bf16_t*)(ws + WS_W2), MT, DM, DFF}; pg8::StaticOrder S; S.init(MT, DM, gridDim.x, blockIdx.x);
        pg8::EpiY E{args.out + OFF_Y};
        pg8::gemm_phase<pg8::EpiY, pg8::StaticOrder, true, true>((PG8_LAS unsigned char*)lds, g, S, E); }
}
#ifndef MK_ONE_LAUNCH
#define MK_ONE_LAUNCH 1
#endif
#if MK_ONE_LAUNCH
__global__ void __launch_bounds__(512, 2) mk_fwd(Args args) {
    extern __shared__ __attribute__((aligned(16))) unsigned char lds[];
    const int tid = threadIdx.x;
#define PHASE(k) do { if (args.ph_lo <= (k) && (k) < args.ph_hi) { if ((k) > args.ph_lo) { __syncthreads(); cg::this_grid().sync(); } run_phase<k>(args, lds, tid); } } while (0)
    PHASE(0); PHASE(1); PHASE(2); PHASE(3); PHASE(4); PHASE(5); PHASE(6); PHASE(7); PHASE(8); PHASE(9); PHASE(10);
#undef PHASE
}
#else
template <int PH> __global__ void __launch_bounds__(512, 2) mk_phase(Args args) {
    extern __shared__ __attribute__((aligned(16))) unsigned char lds[];
    run_phase<PH>(args, lds, threadIdx.x);
}
#endif

extern "C" void kernel_launch(void* const* d_in, const int* in_sizes, int n_in, void* d_out, int out_size, void* d_ws, size_t ws_size, hipStream_t stream) {
    static int grid = 0;
    if (grid == 0) {
        if (n_in != 28 || out_size != (int)OUT_TOTAL || ws_size < WS_END) { fprintf(stderr, "kernel_launch: unexpected shapes (n_in %d, out %d, ws %zu)\n", n_in, out_size, ws_size); grid = -1; return; }
        int dev = 0, cus = 0, per_cu = 0;
        (void)hipGetDevice(&dev); (void)hipDeviceGetAttribute(&cus, hipDeviceAttributeMultiprocessorCount, dev);
#if MK_ONE_LAUNCH
        if (hipFuncSetAttribute((const void*)mk_fwd, hipFuncAttributeMaxDynamicSharedMemorySize, LDS_BYTES) != hipSuccess) { fprintf(stderr, "kernel_launch: hipFuncSetAttribute failed\n"); grid = -1; return; }
        (void)hipOccupancyMaxActiveBlocksPerMultiprocessor(&per_cu, (const void*)mk_fwd, 512, LDS_BYTES);
        (void)hipGetLastError();
        if (per_cu < 1) { fprintf(stderr, "kernel_launch: occupancy query says %d blocks per CU\n", per_cu); per_cu = 1; }
#else
#define SETATTR(k) (void)hipFuncSetAttribute((const void*)mk_phase<k>, hipFuncAttributeMaxDynamicSharedMemorySize, LDS_BYTES)
        SETATTR(0); SETATTR(1); SETATTR(2); SETATTR(3); SETATTR(4); SETATTR(5); SETATTR(6); SETATTR(7); SETATTR(8); SETATTR(9); SETATTR(10);
#undef SETATTR
        (void)per_cu;
#endif
        grid = cus;
    }
    if (grid < 0) return;
    (void)hipMemsetAsync((char*)d_ws + WS_CTL, 0, CTL_BYTES, stream);
    Args a{};
    for (int i = 0; i < 28; ++i) a.in[i] = (const float*)d_in[i];
    a.out = (float*)d_out; a.ws = (unsigned char*)d_ws;
#if MK_ONE_LAUNCH
    a.ph_lo = 0; a.ph_hi = N_PHASES;
    void* kargs[] = {&a};
    hipError_t e = hipLaunchCooperativeKernel((const void*)mk_fwd, dim3(grid), dim3(512), kargs, LDS_BYTES, stream);
    if (e != hipSuccess) fprintf(stderr, "kernel_launch: cooperative launch failed: %s (grid %d)\n", hipGetErrorString(e), grid);
#else
#define LAUNCH(k) hipLaunchKernelGGL(mk_phase<k>, dim3(grid), dim3(512), LDS_BYTES, stream, a)
    a.ph_lo = 0; a.ph_hi = N_PHASES;
    LAUNCH(0); LAUNCH(1); LAUNCH(2); LAUNCH(3); LAUNCH(4); LAUNCH(5); LAUNCH(6); LAUNCH(7); LAUNCH(8); LAUNCH(9); LAUNCH(10);
#undef LAUNCH
#endif
}
```

```cpp
#include <hip/hip_runtime.h>
#include <hip/hip_cooperative_groups.h>
#include <cstdio>
#include <cstdint>
namespace cg = cooperative_groups;
namespace pg8 {
#define PG8_LAS __attribute__((address_space(3)))
typedef unsigned short bf16_t;
typedef short bf16x8 __attribute__((ext_vector_type(8)));
typedef float f32x4 __attribute__((ext_vector_type(4)));
typedef unsigned u32x4 __attribute__((ext_vector_type(4)));
constexpr int BM = 256, BK = 64, HALF = 128, HTB = HALF * BK * 2  , STAGE_BYTES = 8 * HTB, NXCD = 8, WGM = 8;

__host__ __device__ __forceinline__ int lds_byte(int r, int c) { const int st = (r >> 4) * 2 + (c >> 5), rr = r & 15, cc = c & 31, ob = rr * 64 + cc * 2; return st * 1024 + (ob ^ (((ob >> 9) & 1) << 5)); }
__host__ __device__ __forceinline__ void stage_rc(int b, int& R, int& C) { const int st = b / 1024, sb = b % 1024, swz = sb ^ (((sb >> 9) & 1) << 5); R = (st >> 1) * 16 + swz / 64; C = (st & 1) * 32 + (swz % 64) / 2; }
__host__ __device__ __forceinline__ int perm32(int rho) { const int n = rho >> 4, i = rho & 15; return 8 * (i >> 2) + 4 * n + (i & 3); }

struct Unit { int pm, pn; };
struct Gemm { const bf16_t* A; const bf16_t* Bt; int M, N, K; };

struct StaticOrder {
    int nM, nN, nwg, G, c;
    __host__ __device__ void init(int M, int N, int G_, int c_) { nM = M / BM; nN = N / BM; nwg = nM * nN; G = G_; c = c_; }
    __host__ __device__ bool next(int i, Unit& u) const {
        const long L = (long)i * G + c; if (L >= nwg) return false;
        int wgid = (int)L; { const int q = nwg / NXCD, r = nwg % NXCD, xcd = wgid % NXCD, off = wgid / NXCD; wgid = (xcd < r ? xcd * (q + 1) : r * (q + 1) + (xcd - r) * q) + off; }
        const int nig = WGM * nN, gid = wgid / nig, fm = gid * WGM, gsz = (nM - fm) < WGM ? (nM - fm) : WGM;
        u.pm = fm + ((wgid % nig) % gsz); u.pn = (wgid % nig) / gsz; return true;
    }
    __device__ __forceinline__ void a_ready(const Unit&) const {}
    __device__ __forceinline__ void done(const Unit&) const {}
};


__device__ __forceinline__ unsigned cvt_pk_bf16(float lo, float hi) { unsigned r; asm volatile("v_cvt_pk_bf16_f32 %0, %1, %2" : "=v"(r) : "v"(lo), "v"(hi)); return r; }

constexpr int E_MP = 16384;
constexpr int E_ZRW = 1632, E_ZSW = 1696;

struct EpiZ {
    static constexpr bool PERM = true, AFTER_DRAIN = false;
    bf16_t* ZR; bf16_t* ZS;
    __device__ __forceinline__ void operator()(const f32x4 (&acc)[2][2][4][2], const Unit& u, int wr, int wc, int fr, int fq) const {
        const int row0 = u.pm * BM + wr * 64 + fr, c0 = u.pn * BM + wc * 32 + 8 * fq;
#pragma unroll
        for (int ai = 0; ai < 2; ++ai)
#pragma unroll
            for (int m = 0; m < 4; ++m) { const size_t row = (size_t)(row0 + ai * HALF + m * 16);
#pragma unroll
                for (int bj = 0; bj < 2; ++bj) { const int c = c0 + bj * HALF; bf16_t* dst;
                    if (c < 1600) dst = ZR + row * E_ZRW + c; else if (c < 3296) dst = ZS + row * E_ZSW + (c - 1600); else if (c == 3296) dst = ZR + row * E_ZRW + 1600; else continue;
                    const f32x4 v0 = acc[ai][bj][m][0], v1 = acc[ai][bj][m][1]; u32x4 w;
                    w.x = cvt_pk_bf16(v0[0], v0[1]); w.y = cvt_pk_bf16(v0[2], v0[3]); w.z = cvt_pk_bf16(v1[0], v1[1]); w.w = cvt_pk_bf16(v1[2], v1[3]);
                    *(u32x4*)dst = w; } }
    }
};
struct EpiH {
    static constexpr bool PERM = false, AFTER_DRAIN = false;
    const float* xp; const float* xs; float* H;
    __device__ __forceinline__ void operator()(const f32x4 (&acc)[2][2][4][2], const Unit& u, int wr, int wc, int fr, int fq) const {
        const int row0 = u.pm * BM + wr * 64 + fr, col0 = u.pn * BM + wc * 32 + 4 * fq;
#pragma unroll
        for (int ai = 0; ai < 2; ++ai)
#pragma unroll
            for (int m = 0; m < 4; ++m) { const int row = row0 + ai * HALF + m * 16;
                const float* xr = (row < E_MP ? xp + (size_t)row * 1024 : xs + (size_t)(row - E_MP) * 1024) + col0; float* hr = H + (size_t)row * 1024 + col0;
#pragma unroll
                for (int bj = 0; bj < 2; ++bj)
#pragma unroll
                    for (int n = 0; n < 2; ++n) *(f32x4*)(hr + bj * HALF + n * 16) = *(const f32x4*)(xr + bj * HALF + n * 16) + acc[ai][bj][m][n]; }
    }
};
struct EpiAct {
    static constexpr bool PERM = true, AFTER_DRAIN = false;
    bf16_t* O; int ldc;
    __device__ __forceinline__ void operator()(const f32x4 (&acc)[2][2][4][2], const Unit& u, int wr, int wc, int fr, int fq) const {
        const int row0 = u.pm * BM + wr * 64 + fr, c0 = u.pn * BM + wc * 32 + 8 * fq;
#pragma unroll
        for (int ai = 0; ai < 2; ++ai)
#pragma unroll
            for (int m = 0; m < 4; ++m) { bf16_t* rowp = O + (size_t)(row0 + ai * HALF + m * 16) * ldc + c0;
#pragma unroll
                for (int bj = 0; bj < 2; ++bj) { f32x4 v0 = acc[ai][bj][m][0], v1 = acc[ai][bj][m][1];
#pragma unroll
                    for (int e = 0; e < 4; ++e) { const float a = fmaxf(v0[e], 0.f), b = fmaxf(v1[e], 0.f); v0[e] = a * a; v1[e] = b * b; }
                    u32x4 w; w.x = cvt_pk_bf16(v0[0], v0[1]); w.y = cvt_pk_bf16(v0[2], v0[3]); w.z = cvt_pk_bf16(v1[0], v1[1]); w.w = cvt_pk_bf16(v1[2], v1[3]);
                    *(u32x4*)(rowp + bj * HALF) = w; } }
    }
};
struct EpiY {
    static constexpr bool PERM = false, AFTER_DRAIN = false;
    float* Y;
    __device__ __forceinline__ void operator()(const f32x4 (&acc)[2][2][4][2], const Unit& u, int wr, int wc, int fr, int fq) const {
        const int row0 = u.pm * BM + wr * 64 + fr, col0 = u.pn * BM + wc * 32 + 4 * fq;
#pragma unroll
        for (int ai = 0; ai < 2; ++ai)
#pragma unroll
            for (int m = 0; m < 4; ++m) { float* yr = Y + (size_t)(row0 + ai * HALF + m * 16) * 1024 + col0;
#pragma unroll
                for (int bj = 0; bj < 2; ++bj)
#pragma unroll
                    for (int n = 0; n < 2; ++n) { f32x4* p = (f32x4*)(yr + bj * HALF + n * 16); *p = *p + acc[ai][bj][m][n]; } }
    }
};

template <class Epi, class Sched, bool ALIGN_EPI = false, bool SP2 = false>
__device__ __forceinline__ void gemm_phase(PG8_LAS unsigned char* lds, const Gemm g, const Sched& S, const Epi& E) {
    const int tid = threadIdx.x, wid = __builtin_amdgcn_readfirstlane(tid >> 6), lane = tid & 63, wr = wid >> 2, wc = wid & 3, fr = lane & 15, fq = lane >> 4;
    const int K = g.K, nt = K / BK;
    unsigned voffA[2], voffB[2];
#pragma unroll
    for (int i = 0; i < 2; ++i) { int R, C; stage_rc(tid * 16 + i * 8192, R, C); const int Rb = Epi::PERM ? ((R & ~31) + perm32(R & 31)) : R;
        voffA[i] = (unsigned)(R * K + C) * 2u; voffB[i] = (unsigned)(Rb * K + C) * 2u; }
    const size_t kstep = (size_t)(BK * 2);
    const size_t hstep = (size_t)HALF * K * 2;
    const size_t tstep = 2 * hstep;
    const unsigned ldsw = (unsigned)wid * 1024u;
    const int aoff = lds_byte(wr * 64 + fr, fq * 8), boff = lds_byte(wc * 32 + fr, fq * 8);
#define PG8_SA(b, h) (((b) * 2 + (h)) * HTB)
#define PG8_SB(b, h) ((4 + (b) * 2 + (h)) * HTB)
#define PG8_STAGE(bufoff, gbase, voff) do { _Pragma("unroll") for (int _i = 0; _i < 2; ++_i) \
        __builtin_amdgcn_global_load_lds((const unsigned*)((const char*)(gbase) + (voff)[_i]), (PG8_LAS unsigned*)(lds + (bufoff) + ldsw + _i * 8192), 16, 0, 0); } while (0)
#define PG8_LDA(dst, b, h) do { _Pragma("unroll") for (int m = 0; m < 4; ++m) _Pragma("unroll") for (int k = 0; k < 2; ++k) dst[m][k] = *(const PG8_LAS bf16x8*)(lds + PG8_SA(b, h) + aoff + m * 2048 + k * 1024); } while (0)
#define PG8_LDB(dst, b, h) do { _Pragma("unroll") for (int n = 0; n < 2; ++n) _Pragma("unroll") for (int k = 0; k < 2; ++k) dst[n][k] = *(const PG8_LAS bf16x8*)(lds + PG8_SB(b, h) + boff + n * 2048 + k * 1024); } while (0)
#define PG8_MMA(ai, bj, At, Bt) do { __builtin_amdgcn_s_setprio(1); _Pragma("unroll") for (int m = 0; m < 4; ++m) _Pragma("unroll") for (int n = 0; n < 2; ++n) _Pragma("unroll") for (int k = 0; k < 2; ++k) \
        acc[ai][bj][m][n] = __builtin_amdgcn_mfma_f32_16x16x32_bf16(Bt[n][k], At[m][k], acc[ai][bj][m][n], 0, 0, 0); __builtin_amdgcn_s_setprio(0); } while (0)
#define PG8_WAIT_V(n) asm volatile("s_waitcnt vmcnt(" #n ")" ::: "memory")
#define PG8_WAIT_L(n) asm volatile("s_waitcnt lgkmcnt(" #n ")" ::: "memory")
#define PG8_BAR __builtin_amdgcn_s_barrier()
#define PG8_SCHED __builtin_amdgcn_sched_barrier(0)
    Unit cur, nxt; int ui = 0;
    if (!S.next(0, cur)) return;
    f32x4 acc[2][2][4][2];
#pragma unroll
    for (int a = 0; a < 2; ++a)
#pragma unroll
        for (int b = 0; b < 2; ++b)
#pragma unroll
            for (int m = 0; m < 4; ++m)
#pragma unroll
                for (int n = 0; n < 2; ++n) acc[a][b][m][n] = (f32x4){0.f, 0.f, 0.f, 0.f};
    bf16x8 At[4][2], B0[2][2], B1[2][2];
    const char* cA = (const char*)g.A + (size_t)cur.pm * tstep; const char* cB = (const char*)g.Bt + (size_t)cur.pn * tstep;
    S.a_ready(cur);
    if constexpr (SP2) {
        PG8_STAGE(PG8_SB(0, 0), cB, voffB); PG8_STAGE(PG8_SB(0, 1), cB + hstep, voffB); PG8_STAGE(PG8_SA(0, 0), cA, voffA); PG8_STAGE(PG8_SA(0, 1), cA + hstep, voffA);
        if (wr == 1) PG8_BAR;
        PG8_WAIT_V(2); PG8_BAR;
        PG8_STAGE(PG8_SB(1, 0), cB + kstep, voffB); PG8_STAGE(PG8_SA(1, 0), cA + kstep, voffA); PG8_STAGE(PG8_SB(1, 1), cB + hstep + kstep, voffB);
        PG8_WAIT_V(6); PG8_BAR;
    } else {
        PG8_STAGE(PG8_SB(0, 0), cB, voffB); PG8_STAGE(PG8_SA(0, 0), cA, voffA); PG8_STAGE(PG8_SB(0, 1), cB + hstep, voffB); PG8_STAGE(PG8_SA(0, 1), cA + hstep, voffA);
        if (wr == 1) PG8_BAR;
        PG8_WAIT_V(4); PG8_BAR;
        PG8_STAGE(PG8_SB(1, 0), cB + kstep, voffB); PG8_STAGE(PG8_SA(1, 0), cA + kstep, voffA); PG8_STAGE(PG8_SB(1, 1), cB + hstep + kstep, voffB);
        PG8_WAIT_V(6); PG8_BAR;
    }
    for (;;) {
        const bool has_next = S.next(ui + 1, nxt);
        const char* nA = has_next ? (const char*)g.A + (size_t)nxt.pm * tstep : cA; const char* nB = has_next ? (const char*)g.Bt + (size_t)nxt.pn * tstep : cB;
        for (int t = 0; t < nt; t += 2) {
            const bool last = (t == nt - 2);
            const char* a1 = cA + (size_t)(t + 1) * kstep;
            const char* a2 = last ? nA : cA + (size_t)(t + 2) * kstep; const char* b2 = last ? nB : cB + (size_t)(t + 2) * kstep;
            const char* a3 = a2 + kstep; const char* b3 = b2 + kstep;
            if (last && has_next) S.a_ready(nxt);
            if constexpr (SP2) {
            PG8_LDB(B0, 0, 0); PG8_LDB(B1, 0, 1); PG8_SCHED; PG8_LDA(At, 0, 0); PG8_STAGE(PG8_SA(1, 1), a1 + hstep, voffA);
            PG8_WAIT_V(8); PG8_WAIT_L(0); PG8_BAR; PG8_MMA(0, 0, At, B0); PG8_MMA(0, 1, At, B1); PG8_BAR; PG8_SCHED;
            PG8_LDA(At, 0, 1); PG8_STAGE(PG8_SB(0, 0), b2, voffB); PG8_STAGE(PG8_SB(0, 1), b2 + hstep, voffB); PG8_STAGE(PG8_SA(0, 0), a2, voffA);
            PG8_WAIT_V(8); PG8_WAIT_L(0); PG8_BAR; PG8_MMA(1, 0, At, B0); PG8_MMA(1, 1, At, B1); PG8_BAR; PG8_SCHED;
            PG8_LDB(B0, 1, 0); PG8_LDB(B1, 1, 1); PG8_SCHED; PG8_LDA(At, 1, 0); PG8_STAGE(PG8_SA(0, 1), a2 + hstep, voffA);
            PG8_WAIT_V(8); PG8_WAIT_L(0); PG8_BAR; PG8_MMA(0, 0, At, B0); PG8_MMA(0, 1, At, B1); PG8_BAR; PG8_SCHED;
            PG8_LDA(At, 1, 1); PG8_STAGE(PG8_SB(1, 0), b3, voffB); PG8_STAGE(PG8_SB(1, 1), b3 + hstep, voffB); PG8_STAGE(PG8_SA(1, 0), a3, voffA);
            PG8_WAIT_V(8); PG8_WAIT_L(0); PG8_BAR; PG8_MMA(1, 0, At, B0); PG8_MMA(1, 1, At, B1); PG8_BAR; PG8_SCHED;
            } else {
            PG8_LDB(B0, 0, 0); PG8_SCHED; PG8_LDA(At, 0, 0); PG8_STAGE(PG8_SA(1, 1), a1 + hstep, voffA);
            PG8_WAIT_L(8); PG8_BAR; PG8_WAIT_L(0); PG8_MMA(0, 0, At, B0); PG8_BAR; PG8_SCHED;
            PG8_LDB(B1, 0, 1); PG8_STAGE(PG8_SB(0, 0), b2, voffB);
            PG8_BAR; PG8_WAIT_L(0); PG8_MMA(0, 1, At, B1); PG8_BAR;
            PG8_LDA(At, 0, 1); PG8_STAGE(PG8_SA(0, 0), a2, voffA);
            PG8_BAR; PG8_WAIT_L(0); PG8_MMA(1, 0, At, B0); PG8_BAR; PG8_SCHED;
            PG8_STAGE(PG8_SB(0, 1), b2 + hstep, voffB);
            PG8_WAIT_V(6); PG8_BAR; PG8_MMA(1, 1, At, B1); PG8_BAR;
            PG8_LDB(B0, 1, 0); PG8_SCHED; PG8_LDA(At, 1, 0); PG8_STAGE(PG8_SA(0, 1), a2 + hstep, voffA);
            PG8_WAIT_L(8); PG8_BAR; PG8_WAIT_L(0); PG8_MMA(0, 0, At, B0); PG8_BAR; PG8_SCHED;
            PG8_LDB(B1, 1, 1); PG8_STAGE(PG8_SB(1, 0), b3, voffB);
            PG8_BAR; PG8_WAIT_L(0); PG8_MMA(0, 1, At, B1); PG8_BAR;
            PG8_LDA(At, 1, 1); PG8_STAGE(PG8_SA(1, 0), a3, voffA);
            PG8_BAR; PG8_WAIT_L(0); PG8_MMA(1, 0, At, B0); PG8_BAR; PG8_SCHED;
            PG8_STAGE(PG8_SB(1, 1), b3 + hstep, voffB);
            PG8_WAIT_V(6); PG8_BAR; PG8_MMA(1, 1, At, B1); PG8_BAR;
            }
        }
        if constexpr (ALIGN_EPI) { if (wr == 0) PG8_BAR; }
        if constexpr (!Epi::AFTER_DRAIN) { E(acc, cur, wr, wc, fr, fq); S.done(cur); }
        if (!has_next) break;
#pragma unroll
        for (int a = 0; a < 2; ++a)
#pragma unroll
            for (int b = 0; b < 2; ++b)
#pragma unroll
                for (int m = 0; m < 4; ++m)
#pragma unroll
                    for (int n = 0; n < 2; ++n) acc[a][b][m][n] = (f32x4){0.f, 0.f, 0.f, 0.f};
        cur = nxt; cA = nA; cB = nB; ++ui;
        if constexpr (ALIGN_EPI) { if (wr == 1) PG8_BAR; }
    }
    PG8_WAIT_V(0);
    if constexpr (!ALIGN_EPI) { if (wr == 0) PG8_BAR; }
    PG8_BAR;
    if constexpr (Epi::AFTER_DRAIN) { E.fused(acc, cur, wr, wc, fr, fq, lds, wid, lane); S.done(cur); }
#undef PG8_SA
#undef PG8_SB
#undef PG8_STAGE
#undef PG8_LDA
#undef PG8_LDB
#undef PG8_MMA
#undef PG8_WAIT_V
#undef PG8_WAIT_L
#undef PG8_BAR
#undef PG8_SCHED
}
}


constexpr int DM = 1024, NB_P = 8, T_P = 2048, NB_S = 32, T_S = 32, PAST = 1024;
constexpr int MP = NB_P * T_P, MS = NB_S * T_S, MT = MP + MS;
constexpr int LS = PAST + T_S;
constexpr int SHIFTW = 1696, NZ = 3328, ZRW = 1632, DFF = 4096;
constexpr float QSCALE = 0.125f * 1.4426950408889634f;
constexpr float WISCALE = 0.35355339059327373f * 0.125f;
constexpr size_t OFF_Y = 0, OFF_KP = 17825792, OFF_VP = OFF_KP + 4194304, OFF_KIP = OFF_VP + 4194304, OFF_WKVP = OFF_KIP + 1048576, OFF_SHP = OFF_WKVP + 262144,
                 OFF_KS = OFF_SHP + 13568, OFF_VS = OFF_KS + 262144, OFF_KIS = OFF_VS + 262144, OFF_WKVS = OFF_KIS + 65536, OFF_SHS = OFF_WKVS + 1048576, OUT_TOTAL = OFF_SHS + 54272;
constexpr size_t MiB = 1u << 20;
constexpr size_t WS_CTL = 0, CTL_BYTES = 1 * MiB;
constexpr size_t WS_WIN = 1 * MiB, WS_WOUT = 8 * MiB, WS_W1 = 10 * MiB, WS_W2 = 18 * MiB;
constexpr size_t WS_W2T = 26 * MiB, WS_A2T = WS_W2T + 32768, WS_G2T = WS_A2T + 32768, WS_WI = 27 * MiB, WS_BONUS = 28 * MiB;
constexpr size_t WS_XB = 30 * MiB;
constexpr size_t WS_ZS = 66 * MiB;
constexpr size_t WS_R = 123 * MiB;
constexpr size_t WS_ZR = WS_R, WS_KBP = 178 * MiB, WS_VTP = 186 * MiB, WS_KIP = 194 * MiB, WS_KBS = 196 * MiB, WS_VTS = 213 * MiB, WS_KIS = 230 * MiB;
constexpr size_t WS_OW = WS_R, WS_OKK = 157 * MiB, WS_OB = 174 * MiB, WS_OKM = 191 * MiB, WS_OR = 208 * MiB, WS_OV = 225 * MiB;
constexpr size_t WS_ACT = 66 * MiB, WS_HB = 202 * MiB, WS_END = 256 * MiB;
static_assert(WS_ZS + (size_t)MT * SHIFTW * 2 <= WS_R && WS_ZR + (size_t)MT * ZRW * 2 <= WS_KBP && WS_KBS + (size_t)NB_S * LS * 256 * 2 <= WS_VTS && WS_VTS + (size_t)NB_S * 256 * LS * 2 <= WS_KIS &&
              WS_KIS + (size_t)NB_S * LS * 64 * 2 <= WS_END && WS_OV + (size_t)MT * 512 * 2 <= WS_END && WS_ACT + (size_t)MT * DFF * 2 <= WS_HB && WS_HB + (size_t)MT * DM * 2 <= WS_END, "d_ws map");
constexpr size_t SC_Q = 0, SC_QI = (size_t)MT * 512 / 2, SC_Y = 0, SC_G = (size_t)MT * 512;
constexpr int CW_QATT = 64;

typedef unsigned short bf16;
typedef short bf16x8 __attribute__((ext_vector_type(8)));
typedef float f32x4 __attribute__((ext_vector_type(4)));
typedef float f32x16 __attribute__((ext_vector_type(16)));
typedef unsigned u32x4 __attribute__((ext_vector_type(4)));
typedef unsigned u32x2 __attribute__((ext_vector_type(2)));

__device__ __forceinline__ unsigned f2bf(float f) { unsigned u = __float_as_uint(f); return (u + 0x7fffu + ((u >> 16) & 1u)) >> 16; }
__device__ __forceinline__ unsigned pk2(float lo, float hi) { return f2bf(lo) | (f2bf(hi) << 16); }
__device__ __forceinline__ float bflo(unsigned w) { return __uint_as_float(w << 16); }
__device__ __forceinline__ float bfhi(unsigned w) { return __uint_as_float(w & 0xffff0000u); }
__device__ __forceinline__ float bf1(bf16 b) { return __uint_as_float((unsigned)b << 16); }
__device__ __forceinline__ void unpack8(const u32x4 w, float* x) { x[0] = bflo(w.x); x[1] = bfhi(w.x); x[2] = bflo(w.y); x[3] = bfhi(w.y); x[4] = bflo(w.z); x[5] = bfhi(w.z); x[6] = bflo(w.w); x[7] = bfhi(w.w); }
__device__ __forceinline__ u32x4 pack8(const float* x) { u32x4 w; w.x = pk2(x[0], x[1]); w.y = pk2(x[2], x[3]); w.z = pk2(x[4], x[5]); w.w = pk2(x[6], x[7]); return w; }
__device__ __forceinline__ float wave_sum(float v) {
#pragma unroll
    for (int o = 1; o < 64; o <<= 1) v += __shfl_xor(v, o);
    return v;
}
template <int CTRL> __device__ __forceinline__ float dppmov(float x) { return __builtin_bit_cast(float, __builtin_amdgcn_update_dpp(0, __builtin_bit_cast(int, x), CTRL, 0xf, 0xf, true)); }
__device__ __forceinline__ float sum16(float x) {
    x += dppmov<0xB1>(x); x += dppmov<0x4E>(x); x += dppmov<0x141>(x); x += dppmov<0x140>(x); return x;
}
__device__ __forceinline__ int crow(int r, int hi) { return (r & 3) + 8 * (r >> 2) + 4 * hi; }

struct Args { const float* in[28]; float* out; unsigned char* ws; int ph_lo, ph_hi; };

__device__ __forceinline__ void tr_item(const float* W, int K, int N, const float* gain, bf16* WT, int jr0, int c0, int nvalid, int k0, float* scr, int lane) {
#pragma unroll 8
    for (int i = 0; i < 32; ++i) { const int kk = 2 * i + (lane >> 5), n = lane & 31;
        float v = (n < nvalid) ? W[(size_t)(k0 + kk) * N + c0 + n] : 0.f; if (gain) v *= gain[k0 + kk]; scr[kk * 33 + n] = v; }
    __builtin_amdgcn_s_waitcnt(0xC07F); asm volatile("" ::: "memory");
    const int c = lane & 7;
#pragma unroll
    for (int j = 0; j < 4; ++j) { const int n = (lane >> 3) + 8 * j; const float* s = scr + (8 * c) * 33 + n;
        u32x4 o; o.x = pk2(s[0 * 33], s[1 * 33]); o.y = pk2(s[2 * 33], s[3 * 33]); o.z = pk2(s[4 * 33], s[5 * 33]); o.w = pk2(s[6 * 33], s[7 * 33]);
        *(u32x4*)(WT + (size_t)(jr0 + n) * K + k0 + 8 * c) = o; }
    __builtin_amdgcn_s_waitcnt(0xC07F); asm volatile("" ::: "memory");
}
__device__ __forceinline__ void p0_prologue(const Args& a, unsigned char* lds, int tid) {
    const int lane = tid & 63, wave = tid >> 6, gw = blockIdx.x * 8 + wave, NGW = gridDim.x * 8;
    float* scr = (float*)(lds + wave * 17408);
    unsigned char* ws = a.ws;
    constexpr int I_IN = (NZ / 32) * (DM / 64), I_OUT = (DM / 32) * (DM / 64), I_F1 = (DFF / 32) * (DM / 64), I_F2 = (DM / 32) * (DFF / 64);
    for (int it = gw; it < I_IN + I_OUT + I_F1 + I_F2; it += NGW) {
        int r = it;
        if (r < I_IN) { const int jb = r % (NZ / 32), kb = r / (NZ / 32), j0 = jb * 32; int c0, nv;
            if (j0 < 1600) { c0 = j0; nv = 32; } else if (j0 < 3296) { c0 = 1608 + (j0 - 1600); nv = 32; } else { c0 = 1600; nv = 8; }
            tr_item(a.in[8], DM, 3304, a.in[7], (bf16*)(ws + WS_WIN), j0, c0, nv, kb * 64, scr, lane); continue; }
        r -= I_IN;
        if (r < I_OUT) { const int jb = r % (DM / 32), kb = r / (DM / 32); tr_item(a.in[24], DM, DM, nullptr, (bf16*)(ws + WS_WOUT), jb * 32, jb * 32, 32, kb * 64, scr, lane); continue; }
        r -= I_OUT;
        if (r < I_F1) { const int jb = r % (DFF / 32), kb = r / (DFF / 32); tr_item(a.in[26], DM, DFF, a.in[25], (bf16*)(ws + WS_W1), jb * 32, jb * 32, 32, kb * 64, scr, lane); continue; }
        r -= I_F1;
        { const int jb = r % (DM / 32), kb = r / (DM / 32); tr_item(a.in[27], DFF, DM, nullptr, (bf16*)(ws + WS_W2), jb * 32, jb * 32, 32, kb * 64, scr, lane); }
    }
    { const int gt = blockIdx.x * 512 + tid, NT = gridDim.x * 512;
      bf16* w2t = (bf16*)(ws + WS_W2T); bf16* a2t = (bf16*)(ws + WS_A2T); bf16* g2t = (bf16*)(ws + WS_G2T);
      for (int i = gt; i < 512 * 32; i += NT) { const int n = i >> 5, k = i & 31; w2t[i] = (bf16)f2bf(a.in[15][k * 512 + n]); a2t[i] = (bf16)f2bf(a.in[17][k * 512 + n]); }
      for (int i = gt; i < 512 * 96; i += NT) { const int n = i / 96, k = i % 96; g2t[i] = (bf16)f2bf(a.in[18][k * 512 + n]); } }
    for (int m = gw; m < MT; m += NGW) {
        const float* xrow = (m < MP) ? a.in[0] + (size_t)m * DM : a.in[1] + (size_t)(m - MP) * DM;
        const f32x4* xr = (const f32x4*)xrow + lane; f32x4 v[4]; float s = 0.f;
#pragma unroll
        for (int j = 0; j < 4; ++j) { v[j] = xr[64 * j]; s += (v[j].x * v[j].x + v[j].y * v[j].y) + (v[j].z * v[j].z + v[j].w * v[j].w); }
        const float rs = rsqrtf(wave_sum(s) * (1.f / DM) + 1e-6f);
        u32x2* o8 = (u32x2*)((bf16*)(ws + WS_XB) + (size_t)m * DM) + lane;
#pragma unroll
        for (int j = 0; j < 4; ++j) { u32x2 o; o.x = pk2(v[j].x * rs, v[j].y * rs); o.y = pk2(v[j].z * rs, v[j].w * rs); o8[64 * j] = o; }
    }
    for (int rix = gw; rix < NB_S * PAST; rix += NGW) {
        const int b = rix >> 10, p = rix & 1023; const f32x4 v = ((const f32x4*)(a.in[2] + (size_t)rix * 256))[lane];
        u32x2 o; o.x = pk2(v.x, v.y); o.y = pk2(v.z, v.w); ((u32x2*)((bf16*)(ws + WS_KBS) + ((size_t)b * LS + p) * 256))[lane] = o;
    }
    for (int r4 = gw; r4 < NB_S * PAST / 4; r4 += NGW) {
        const int rix = r4 * 4 + (lane >> 4), b = rix >> 10, p = rix & 1023; const f32x4 v = ((const f32x4*)(a.in[4] + (size_t)rix * 64))[lane & 15];
        u32x2 o; o.x = pk2(v.x, v.y); o.y = pk2(v.z, v.w); ((u32x2*)((bf16*)(ws + WS_KIS) + ((size_t)b * LS + p) * 64))[lane & 15] = o;
    }
    for (int it = gw; it < NB_S * 4 * 16; it += NGW) {
        const int kb = it & 15, g = (it >> 4) & 3, b = it >> 6;
        const float* src = a.in[3] + ((size_t)b * PAST + kb * 64) * 256 + g * 64;
#pragma unroll 8
        for (int i = 0; i < 64; ++i) scr[i * 65 + lane] = src[(size_t)i * 256 + lane];
        __builtin_amdgcn_s_waitcnt(0xC07F); asm volatile("" ::: "memory");
        bf16* dst = (bf16*)(ws + WS_VTS) + ((size_t)(b * 4 + g) * 64) * LS + kb * 64 + lane;
#pragma unroll 8
        for (int d = 0; d < 64; ++d) dst[(size_t)d * LS] = (bf16)f2bf(scr[lane * 65 + d]);
        __builtin_amdgcn_s_waitcnt(0xC07F); asm volatile("" ::: "memory");
    }
}

__device__ __forceinline__ void p2_post(const Args& a, unsigned char* lds, int tid) {
    unsigned char* ws = a.ws; float* out = a.out;
    const bf16* ZR = (const bf16*)(ws + WS_ZR); const bf16* ZS = (const bf16*)(ws + WS_ZS);
    bf16* Q = (bf16*)(out + SC_Q); bf16* QI = (bf16*)(out + SC_QI);
    float* cs = (float*)lds;
    bf16* vt = (bf16*)(lds + 4096);
    const int g8 = tid >> 3, sub = tid & 7;
    const float* qg = a.in[9]; const float* kg = a.in[10]; const float* lng = a.in[11]; const float* lnb = a.in[12];
    for (int tile = blockIdx.x; tile < MT / 64; tile += gridDim.x) {
        const int m0 = tile * 64;
        { const int m = m0 + g8, pos = (m < MP) ? (m & (T_P - 1)) : (PAST + ((m - MP) & (T_S - 1)));
          const float inv = powf(500000.0f, -(float)sub * 0.125f); const float ang = (float)pos * inv; float s, c; sincosf(ang, &s, &c);
          cs[g8 * 16 + sub] = c; cs[g8 * 16 + 8 + sub] = s; }
        __syncthreads();
        const int m = m0 + g8;
        const bool isp = m < MP; const int ms = m - MP;
        float cc[8], ss[8];
#pragma unroll
        for (int j = 0; j < 8; ++j) { cc[j] = cs[g8 * 16 + j]; ss[j] = cs[g8 * 16 + 8 + j]; }
        const size_t kvrow = isp ? (size_t)m : ((size_t)(ms >> 5) * LS + PAST + (ms & 31));
        bf16* KB = (bf16*)(ws + (isp ? WS_KBP : WS_KBS)); bf16* KIb = (bf16*)(ws + (isp ? WS_KIP : WS_KIS));
        for (int hb = 0; hb < 25; ++hb) {
            float x[8]; unpack8(*(const u32x4*)(ZR + (size_t)m * ZRW + hb * 64 + 8 * sub), x);
            if (hb < 12) {
                float s2 = 0.f;
#pragma unroll
                for (int j = 0; j < 8; ++j) s2 += x[j] * x[j];
                s2 += __shfl_xor(s2, 1); s2 += __shfl_xor(s2, 2); s2 += __shfl_xor(s2, 4);
                const float rinv = rsqrtf(s2 * (1.f / 64.f) + 1e-6f); const float* gn = (hb < 8 ? qg : kg) + 8 * sub;
                float y[8], o[8];
#pragma unroll
                for (int j = 0; j < 8; ++j) y[j] = x[j] * rinv * gn[j];
#pragma unroll
                for (int j = 0; j < 8; ++j) { const float p = __shfl_xor(y[j], 1); o[j] = sub == 0 ? y[j] * cc[j] - p * ss[j] : (sub == 1 ? y[j] * cc[j] + p * ss[j] : y[j]); }
                if (hb < 8) {
#pragma unroll
                    for (int j = 0; j < 8; ++j) o[j] *= QSCALE;
                    *(u32x4*)(Q + (size_t)m * 512 + hb * 64 + 8 * sub) = pack8(o);
                } else { const int g = hb - 8;
                    float* ko = out + (isp ? OFF_KP + (size_t)m * 256 : OFF_KS + (size_t)ms * 256) + g * 64 + 8 * sub;
                    *(f32x4*)ko = (f32x4){o[0], o[1], o[2], o[3]}; *(f32x4*)(ko + 4) = (f32x4){o[4], o[5], o[6], o[7]};
                    *(u32x4*)(KB + kvrow * 256 + g * 64 + 8 * sub) = pack8(o); }
            } else if (hb < 16) { const int g = hb - 12;
                float* vo = out + (isp ? OFF_VP + (size_t)m * 256 : OFF_VS + (size_t)ms * 256) + g * 64 + 8 * sub;
                *(f32x4*)vo = (f32x4){x[0], x[1], x[2], x[3]}; *(f32x4*)(vo + 4) = (f32x4){x[4], x[5], x[6], x[7]};
                unsigned* vd = (unsigned*)(vt + g8 * 258 + g * 64 + 8 * sub);
                vd[0] = pk2(x[0], x[1]); vd[1] = pk2(x[2], x[3]); vd[2] = pk2(x[4], x[5]); vd[3] = pk2(x[6], x[7]);
            } else if (hb < 24) {
                float o[8];
#pragma unroll
                for (int j = 0; j < 8; ++j) { const float p = __shfl_xor(x[j], 1); o[j] = sub == 0 ? x[j] * cc[j] - p * ss[j] : (sub == 1 ? x[j] * cc[j] + p * ss[j] : x[j]); }
                *(u32x4*)(QI + (size_t)m * 512 + (hb - 16) * 64 + 8 * sub) = pack8(o);
            } else {
                float s1 = 0.f;
#pragma unroll
                for (int j = 0; j < 8; ++j) s1 += x[j];
                s1 += __shfl_xor(s1, 1); s1 += __shfl_xor(s1, 2); s1 += __shfl_xor(s1, 4);
                const float mu = s1 * (1.f / 64.f); float s2 = 0.f;
#pragma unroll
                for (int j = 0; j < 8; ++j) { const float d = x[j] - mu; s2 += d * d; }
                s2 += __shfl_xor(s2, 1); s2 += __shfl_xor(s2, 2); s2 += __shfl_xor(s2, 4);
                const float rinv = rsqrtf(s2 * (1.f / 64.f) + 1e-6f); float y[8], o[8];
#pragma unroll
                for (int j = 0; j < 8; ++j) y[j] = (x[j] - mu) * rinv * lng[8 * sub + j] + lnb[8 * sub + j];
#pragma unroll
                for (int j = 0; j < 8; ++j) { const float p = __shfl_xor(y[j], 1); o[j] = sub == 0 ? y[j] * cc[j] - p * ss[j] : (sub == 1 ? y[j] * cc[j] + p * ss[j] : y[j]); }
                float* ko = out + (isp ? OFF_KIP + (size_t)m * 64 : OFF_KIS + (size_t)ms * 64) + 8 * sub;
                *(f32x4*)ko = (f32x4){o[0], o[1], o[2], o[3]}; *(f32x4*)(ko + 4) = (f32x4){o[4], o[5], o[6], o[7]};
                *(u32x4*)(KIb + kvrow * 64 + 8 * sub) = pack8(o);
            }
        }
        ((float*)(ws + WS_WI))[(size_t)m * 8 + sub] = bf1(ZR[(size_t)m * ZRW + 1600 + sub]) * WISCALE;
        __syncthreads();
        { const int r = tid >> 1, half = tid & 1; unsigned wv[16];
#pragma unroll
          for (int j = 0; j < 16; ++j) wv[j] = (unsigned)vt[(32 * half + 2 * j) * 258 + r] | ((unsigned)vt[(32 * half + 2 * j + 1) * 258 + r] << 16);
          bf16* dst;
          if (m0 < MP) dst = (bf16*)(ws + WS_VTP) + ((size_t)(m0 >> 11) * 256 + r) * T_P + (m0 & (T_P - 1)) + 32 * half;
          else { const int b = ((m0 - MP) >> 5) + half; dst = (bf16*)(ws + WS_VTS) + ((size_t)b * 256 + r) * LS + PAST; }
#pragma unroll
          for (int j = 0; j < 4; ++j) ((u32x4*)dst)[j] = (u32x4){wv[4 * j], wv[4 * j + 1], wv[4 * j + 2], wv[4 * j + 3]}; }
        if (m0 < MP) { if ((m0 & (T_P - 1)) == T_P - 64) { const int b = m0 >> 11; const bf16* zr = ZS + (size_t)(m0 + 63) * SHIFTW;
                for (int c = tid; c < SHIFTW; c += 512) out[OFF_SHP + (size_t)b * SHIFTW + c] = bf1(zr[c]); } }
        else { for (int h2 = 0; h2 < 2; ++h2) { const int b = ((m0 - MP) >> 5) + h2; const bf16* zr = ZS + (size_t)(m0 + 32 * h2 + 31) * SHIFTW;
                for (int c = tid; c < SHIFTW; c += 512) out[OFF_SHS + (size_t)b * SHIFTW + c] = bf1(zr[c]); } }
        __syncthreads();
    }
}

constexpr int ATT_UNITS = 544;
constexpr int MASK_PITCH = 65;
#define MFMA32(a, b, c) __builtin_amdgcn_mfma_f32_32x32x16_bf16((a), (b), (c), 0, 0, 0)

__device__ __forceinline__ float half_sum32(float v) { v += __shfl_xor(v, 1); v += __shfl_xor(v, 2); v += __shfl_xor(v, 4); v += __shfl_xor(v, 8); v += __shfl_xor(v, 16); return v; }
__device__ __forceinline__ float half_min32(float v) { v = fminf(v, __shfl_xor(v, 1)); v = fminf(v, __shfl_xor(v, 2)); v = fminf(v, __shfl_xor(v, 4)); v = fminf(v, __shfl_xor(v, 8)); v = fminf(v, __shfl_xor(v, 16)); return v; }
__device__ __forceinline__ float half_max32(float v) { v = fmaxf(v, __shfl_xor(v, 1)); v = fmaxf(v, __shfl_xor(v, 2)); v = fmaxf(v, __shfl_xor(v, 4)); v = fmaxf(v, __shfl_xor(v, 8)); v = fmaxf(v, __shfl_xor(v, 16)); return v; }
__device__ __forceinline__ int half_sum32i(int v) { v += __shfl_xor(v, 1); v += __shfl_xor(v, 2); v += __shfl_xor(v, 4); v += __shfl_xor(v, 8); v += __shfl_xor(v, 16); return v; }

#define LAS3 __attribute__((address_space(3)))
constexpr int A_RING1 = 0, A_SCL = 24576, A_RING2 = 24576, A_MASK = 0, A_LSUM = 8320, A_UNIT = 9344;
__device__ __forceinline__ void p3_attention(const Args& a, unsigned char* lds, int tid, int rep) {
    unsigned char* ws = a.ws; float* out = a.out;
    const bf16* Q = (const bf16*)(out + SC_Q); const bf16* QI = (const bf16*)(out + SC_QI); const float* WI = (const float*)(ws + WS_WI);
    bf16* O = (bf16*)(ws + WS_XB);
    unsigned* maskw = (unsigned*)(lds + A_MASK);
    float* lsum = (float*)(lds + A_LSUM);
    int* s_unit = (int*)(lds + A_UNIT);
    typedef float f32x2_t __attribute__((ext_vector_type(2)));
    f32x2_t* scl = (f32x2_t*)(lds + A_SCL) + (size_t)(tid >> 6) * 2048 + (tid & 63);
    unsigned* qctr = (unsigned*)(ws + WS_CTL) + CW_QATT + 64 * rep;
    const int l = tid & 63, w = __builtin_amdgcn_readfirstlane(tid >> 6), rho = l & 31, hi = l >> 5;
    LAS3 unsigned char* ldsb = (LAS3 unsigned char*)lds;
    for (;;) {
        if (tid == 0) *s_unit = (int)atomicAdd(qctr, 1u);
        __syncthreads();
        const int p = *s_unit;
        __syncthreads();
        if (p >= ATT_UNITS) break;
        int m0, nkt, vpitch; const bf16 *KB, *VT, *KI; bool need_idx;
        { int c = -1, b, half = 0;
          if (p < 256) { c = 31 - (p >> 4); b = (p & 15) >> 1; half = p & 1; }
          else if (p < 288) { b = p - 256; }
          else { const int pp = p - 288; c = 15 - (pp >> 4); b = (pp & 15) >> 1; half = pp & 1; }
          if (c >= 0) { m0 = b * T_P + 64 * c + 32 * half; nkt = 2 * (c + 1); vpitch = T_P; need_idx = c >= 4;
              KB = (const bf16*)(ws + WS_KBP) + (size_t)b * T_P * 256; VT = (const bf16*)(ws + WS_VTP) + (size_t)b * 256 * T_P; KI = (const bf16*)(ws + WS_KIP) + (size_t)b * T_P * 64; }
          else { m0 = MP + 32 * b; nkt = LS / 32; vpitch = LS; need_idx = true;
              KB = (const bf16*)(ws + WS_KBS) + (size_t)b * LS * 256; VT = (const bf16*)(ws + WS_VTS) + (size_t)b * 256 * LS; KI = (const bf16*)(ws + WS_KIS) + (size_t)b * LS * 64; } }
        if (need_idx) {
            const int tokA = 4 * w + 2 * ((rho >> 2) & 1) + (rho >> 4), headA = (rho & 3) + 4 * ((rho >> 3) & 1);
            bf16x8 qa[4];
#pragma unroll
            for (int ks = 0; ks < 4; ++ks) qa[ks] = *(const bf16x8*)(QI + (size_t)(m0 + tokA) * 512 + headA * 64 + 16 * ks + 8 * hi);
            float wv[16];
#pragma unroll
            for (int r = 0; r < 16; ++r) wv[r] = WI[(size_t)(m0 + 4 * w + 2 * hi + (r >> 3)) * 8 + (r & 7)];
            asm volatile("" :: "v"(qa[0]), "v"(qa[1]), "v"(qa[2]), "v"(qa[3]));
#pragma unroll
            for (int r = 0; r < 16; ++r) asm volatile("" :: "v"(wv[r]));
            asm volatile("s_waitcnt vmcnt(0)" ::: "memory");
            float sc0[32], sc1[32];
            const int nb = (nkt + 1) >> 1;
            const int sr = 8 * w + (l >> 3), scn = (l & 7) ^ ((sr >> 1) & 7);
            const unsigned char* ksrc = (const unsigned char*)KI + (size_t)sr * 128 + 16 * scn;
#define KI_STAGE(it_) __builtin_amdgcn_global_load_lds((const unsigned*)(ksrc + (size_t)(it_) * 8192), (LAS3 unsigned*)(ldsb + A_RING1 + ((it_) % 3) * 8192 + w * 1024), 16, 0, 0)
            KI_STAGE(0); if (1 < nb) KI_STAGE(1);
#pragma unroll
            for (int it = 0; it < 32; ++it) {
                if (it < nb) {
                    if (it + 1 < nb) asm volatile("s_waitcnt vmcnt(1) lgkmcnt(0)\n\ts_barrier" ::: "memory"); else asm volatile("s_waitcnt vmcnt(0) lgkmcnt(0)\n\ts_barrier" ::: "memory");
                    if (it + 2 < nb) KI_STAGE(it + 2);
                    const unsigned char* tb = lds + A_RING1 + (it % 3) * 8192;
#pragma unroll
                    for (int k2 = 0; k2 < 2; ++k2) { const int kt = 2 * it + k2;
                        if (kt < nkt) {
                            const int r = 32 * k2 + rho; const unsigned char* rowp = tb + r * 128; const int sw = (r >> 1) & 7;
                            f32x16 acc = {0.f, 0.f, 0.f, 0.f, 0.f, 0.f, 0.f, 0.f, 0.f, 0.f, 0.f, 0.f, 0.f, 0.f, 0.f, 0.f};
#pragma unroll
                            for (int ks = 0; ks < 4; ++ks) acc = MFMA32(qa[ks], *(const bf16x8*)(rowp + 16 * ((2 * ks + hi) ^ sw)), acc);
                            float s0 = 0.f, s1 = 0.f;
#pragma unroll
                            for (int r2 = 0; r2 < 8; ++r2) { s0 += wv[r2] * fmaxf(acc[r2], 0.f); s1 += wv[8 + r2] * fmaxf(acc[8 + r2], 0.f); }
                            if (kt < 32) { sc0[kt & 31] = s0; sc1[kt & 31] = s1; } else scl[(kt - 32) * 64] = (f32x2_t){s0, s1};
                        } else if (kt < 32) { sc0[kt & 31] = -3.0e38f; sc1[kt & 31] = -3.0e38f; }
                    }
                } else { if (2 * it < 32) { sc0[(2 * it) & 31] = -3.0e38f; sc1[(2 * it) & 31] = -3.0e38f; sc0[(2 * it + 1) & 31] = -3.0e38f; sc1[(2 * it + 1) & 31] = -3.0e38f; } }
            }
#undef KI_STAGE
            __syncthreads();
            float mn0 = 3.0e38f, mx0 = -3.0e38f, mn1 = 3.0e38f, mx1 = -3.0e38f;
#pragma unroll
            for (int kt = 0; kt < 64; ++kt) if (kt < nkt) { float v0, v1; if (kt < 32) { v0 = sc0[kt & 31]; v1 = sc1[kt & 31]; } else { const f32x2_t t2 = scl[(kt - 32) * 64]; v0 = t2.x; v1 = t2.y; }
                mn0 = fminf(mn0, v0); mx0 = fmaxf(mx0, v0); mn1 = fminf(mn1, v1); mx1 = fmaxf(mx1, v1); }
            mn0 = half_min32(mn0); mx0 = half_max32(mx0); mn1 = half_min32(mn1); mx1 = half_max32(mx1);
            float lo0 = mn0 - 1.0f, hi0 = mx0, lo1 = mn1 - 1.0f, hi1 = mx1, thr0 = 0.f, thr1 = 0.f; int ch0 = 0, ch1 = 0, nt0 = 0, nt1 = 0; bool fin0 = false, fin1 = false;
            for (int iter = 0; iter < 200; ++iter) {
                const float mid0 = lo0 + 0.5f * (hi0 - lo0), mid1 = lo1 + 0.5f * (hi1 - lo1);
                int c0 = 0, c1 = 0;
#pragma unroll
                for (int g = 0; g < 4; ++g) if (8 * g < nkt) {
#pragma unroll
                    for (int k8 = 0; k8 < 8; ++k8) { c0 += sc0[8 * g + k8] > mid0 ? 1 : 0; c1 += sc1[8 * g + k8] > mid1 ? 1 : 0; } }
                for (int kt = 32; kt < nkt; ++kt) { const f32x2_t t2 = scl[(kt - 32) * 64]; c0 += t2.x > mid0 ? 1 : 0; c1 += t2.y > mid1 ? 1 : 0; }
                c0 = half_sum32i(c0); c1 = half_sum32i(c1);
                if (!fin0) { if (!(mid0 > lo0 && mid0 < hi0)) { fin0 = true; thr0 = hi0; nt0 = 256 - ch0; }
                             else if (c0 == 256) { fin0 = true; thr0 = mid0; nt0 = 0; } else if (c0 > 256) lo0 = mid0; else { hi0 = mid0; ch0 = c0; } }
                if (!fin1) { if (!(mid1 > lo1 && mid1 < hi1)) { fin1 = true; thr1 = hi1; nt1 = 256 - ch1; }
                             else if (c1 == 256) { fin1 = true; thr1 = mid1; nt1 = 0; } else if (c1 > 256) lo1 = mid1; else { hi1 = mid1; ch1 = c1; } }
                if (__all(fin0 && fin1)) break;
            }
            const bool any_tie = __any(nt0 > 0 || nt1 > 0);
            int run0 = 0, run1 = 0; const unsigned below = (1u << rho) - 1u;
#pragma unroll
            for (int kt = 0; kt < 64; ++kt) if (kt < nkt) {
                float v0, v1; if (kt < 32) { v0 = sc0[kt & 31]; v1 = sc1[kt & 31]; } else { const f32x2_t t2 = scl[(kt - 32) * 64]; v0 = t2.x; v1 = t2.y; }
                bool p0 = v0 > thr0, p1 = v1 > thr1;
                if (any_tie) {
                    const bool e0 = nt0 > 0 && v0 == thr0, e1 = nt1 > 0 && v1 == thr1;
                    const unsigned long long be0 = __ballot(e0), be1 = __ballot(e1);
                    const unsigned h0 = (unsigned)(be0 >> (32 * hi)), h1 = (unsigned)(be1 >> (32 * hi));
                    p0 = p0 || (e0 && (run0 + __popc(h0 & below)) < nt0); p1 = p1 || (e1 && (run1 + __popc(h1 & below)) < nt1);
                    run0 += __popc(h0); run1 += __popc(h1);
                }
                const unsigned long long b0 = __ballot(p0), b1 = __ballot(p1);
                if (l == 0) { maskw[(4 * w + 0) * MASK_PITCH + kt] = (unsigned)b0; maskw[(4 * w + 1) * MASK_PITCH + kt] = (unsigned)b1; }
                if (l == 32) { maskw[(4 * w + 2) * MASK_PITCH + kt] = (unsigned)(b0 >> 32); maskw[(4 * w + 3) * MASK_PITCH + kt] = (unsigned)(b1 >> 32); }
            }
        }
        __syncthreads();
        {
            const int g = w >> 1;
            bf16x8 qb[4];
#pragma unroll
            for (int ks = 0; ks < 4; ++ks) qb[ks] = *(const bf16x8*)(Q + (size_t)(m0 + rho) * 512 + w * 64 + 16 * ks + 8 * hi);
            asm volatile("" :: "v"(qb[0]), "v"(qb[1]), "v"(qb[2]), "v"(qb[3]));
            asm volatile("s_waitcnt vmcnt(0)" ::: "memory");
            const unsigned char* ksrc[2]; const unsigned char* vsrc[2];
#pragma unroll
            for (int k = 0; k < 2; ++k) { const int i = (k * 8 + w) * 64 + l; const int r = i >> 5, c = i & 31; ksrc[k] = (const unsigned char*)KB + (size_t)r * 512 + 16 * (c ^ (r & 15));
                const int R = i >> 2, cv = i & 3; vsrc[k] = (const unsigned char*)VT + (size_t)R * vpitch * 2 + 16 * (cv ^ ((R >> 2) & 3)); }
#define KV_STAGE(t_) do { const int bo_ = A_RING2 + ((t_) % 3) * 32768 + w * 1024; \
            __builtin_amdgcn_global_load_lds((const unsigned*)(ksrc[0] + (size_t)(t_) * 16384), (LAS3 unsigned*)(ldsb + bo_), 16, 0, 0); \
            __builtin_amdgcn_global_load_lds((const unsigned*)(ksrc[1] + (size_t)(t_) * 16384), (LAS3 unsigned*)(ldsb + bo_ + 8192), 16, 0, 0); \
            __builtin_amdgcn_global_load_lds((const unsigned*)(vsrc[0] + (size_t)(t_) * 64), (LAS3 unsigned*)(ldsb + bo_ + 16384), 16, 0, 0); \
            __builtin_amdgcn_global_load_lds((const unsigned*)(vsrc[1] + (size_t)(t_) * 64), (LAS3 unsigned*)(ldsb + bo_ + 24576), 16, 0, 0); } while (0)
            f32x16 o0 = {0.f, 0.f, 0.f, 0.f, 0.f, 0.f, 0.f, 0.f, 0.f, 0.f, 0.f, 0.f, 0.f, 0.f, 0.f, 0.f}, o1 = o0; float psum = 0.f;
            const int ksw = rho & 15;
            const int vR0 = g * 64 + rho, vR1 = vR0 + 32; const int vs0 = (vR0 >> 2) & 3, vs1 = (vR1 >> 2) & 3;
            KV_STAGE(0); if (1 < nkt) KV_STAGE(1);
            for (int kt = 0; kt < nkt; ++kt) {
                if (kt + 1 < nkt) asm volatile("s_waitcnt vmcnt(4) lgkmcnt(0)\n\ts_barrier" ::: "memory"); else asm volatile("s_waitcnt vmcnt(0) lgkmcnt(0)\n\ts_barrier" ::: "memory");
                if (kt + 2 < nkt) KV_STAGE(kt + 2);
                const unsigned char* kbuf = lds + A_RING2 + (kt % 3) * 32768; const unsigned char* vbuf = kbuf + 16384;
                f32x16 st = {0.f, 0.f, 0.f, 0.f, 0.f, 0.f, 0.f, 0.f, 0.f, 0.f, 0.f, 0.f, 0.f, 0.f, 0.f, 0.f};
#pragma unroll
                for (int ks = 0; ks < 4; ++ks) st = MFMA32(*(const bf16x8*)(kbuf + rho * 512 + 16 * ((g * 8 + 2 * ks + hi) ^ ksw)), qb[ks], st);
                unsigned word = need_idx ? maskw[rho * MASK_PITCH + kt] : 0xffffffffu; word >>= 4 * hi; float pr[16];
#pragma unroll
                for (int r = 0; r < 16; ++r) { const float e = __builtin_amdgcn_exp2f(st[r]); pr[r] = ((word >> ((r & 3) + 8 * (r >> 2))) & 1u) ? e : 0.f; psum += pr[r]; }
                union { u32x4 u; bf16x8 v; } pa0, pa1; pa0.u = (u32x4){pk2(pr[0], pr[1]), pk2(pr[2], pr[3]), pk2(pr[4], pr[5]), pk2(pr[6], pr[7])}; pa1.u = (u32x4){pk2(pr[8], pr[9]), pk2(pr[10], pr[11]), pk2(pr[12], pr[13]), pk2(pr[14], pr[15])};
                union { u32x4 u; bf16x8 v; } vf[2][2];
#pragma unroll
                for (int s2 = 0; s2 < 2; ++s2) { const unsigned char* r0 = vbuf + vR0 * 64 + 8 * hi; const unsigned char* r1 = vbuf + vR1 * 64 + 8 * hi;
                    const u32x2 a0 = *(const u32x2*)(r0 + 16 * ((2 * s2) ^ vs0)), a1 = *(const u32x2*)(r0 + 16 * ((2 * s2 + 1) ^ vs0)), b0 = *(const u32x2*)(r1 + 16 * ((2 * s2) ^ vs1)), b1 = *(const u32x2*)(r1 + 16 * ((2 * s2 + 1) ^ vs1));
                    vf[s2][0].u = (u32x4){a0.x, a0.y, a1.x, a1.y}; vf[s2][1].u = (u32x4){b0.x, b0.y, b1.x, b1.y}; }
                o0 = MFMA32(pa0.v, vf[0][0].v, o0); o0 = MFMA32(pa1.v, vf[1][0].v, o0); o1 = MFMA32(pa0.v, vf[0][1].v, o1); o1 = MFMA32(pa1.v, vf[1][1].v, o1);
            }
#undef KV_STAGE
            psum += __shfl_xor(psum, 32);
            if (hi == 0) lsum[w * 32 + rho] = psum;
            __syncthreads();
#pragma unroll
            for (int r = 0; r < 16; ++r) { const int qr = crow(r, hi); const float inv = 1.0f / lsum[w * 32 + qr];
                bf16* op = O + (size_t)(m0 + qr) * DM + w * 64 + rho;
                op[0] = (bf16)f2bf(o0[r] * inv); op[32] = (bf16)f2bf(o1[r] * inv); }
        }
        __syncthreads();
    }
}

constexpr int XS_PITCH = 168;
__device__ __forceinline__ void p4_rwkv_prep(const Args& a, unsigned char* lds, int tid) {
    unsigned char* ws = a.ws; float* out = a.out;
    const bf16* ZS = (const bf16*)(ws + WS_ZS);
    const bf16* w2t = (const bf16*)(ws + WS_W2T); const bf16* a2t = (const bf16*)(ws + WS_A2T); const bf16* g2t = (const bf16*)(ws + WS_G2T);
    float* OW = (float*)(ws + WS_OW); bf16* OKK = (bf16*)(ws + WS_OKK); bf16* OB = (bf16*)(ws + WS_OB); bf16* OKM = (bf16*)(ws + WS_OKM); bf16* OR_ = (bf16*)(ws + WS_OR); bf16* OV = (bf16*)(ws + WS_OV);
    bf16* G = (bf16*)(out + SC_G); float* BON = (float*)(ws + WS_BONUS);
    const float* mu = a.in[13]; const float* w0 = a.in[14]; const float* a0 = a.in[16]; const float* k_k = a.in[19]; const float* k_a = a.in[20]; const float* r_k = a.in[21]; const float* sh0 = a.in[6];
    bf16* xs = (bf16*)lds;
    const int l = tid & 63, h = __builtin_amdgcn_readfirstlane(tid >> 6), rho = l & 31, hi = l >> 5;
    for (int tile = blockIdx.x; tile < MT / 32; tile += gridDim.x) {
        const int m0 = tile * 32; const bool smp = m0 >= MP;
        const bool tile_first = smp || (m0 & (T_P - 1)) == 0;
        { const int tk = tid >> 4, c0 = (tid & 15) * 10, m = m0 + tk; const bool first = tile_first && tk == 0;
          const bf16* zc = ZS + (size_t)m * SHIFTW + 1536 + c0; const bf16* zp = first ? zc : zc - SHIFTW;
          const float* shp = sh0 + (size_t)(smp ? ((m0 - MP) >> 5) : 0) * SHIFTW + 1536 + c0;
#pragma unroll
          for (int e = 0; e < 10; ++e) { const int c = c0 + e; const float cur = bf1(zc[e]); float prev = bf1(zp[e]);
              if (first) prev = smp ? shp[e] : 0.f;
              const float zm = cur + mu[1536 + c] * (prev - cur);
              const float f = __frcp_rn(1.0f + __expf(c < 32 ? -2.0f * zm : -zm));
              const float v = c < 32 ? 2.0f * f - 1.0f : (c < 64 ? zm : f);
              xs[tk * XS_PITCH + c] = (bf16)f2bf(v); } }
        __syncthreads();
        const int m = m0 + rho; const bool first = tile_first && rho == 0;
        const bf16* zc = ZS + (size_t)m * SHIFTW + 64 * h + 4 * hi; const bf16* zp = first ? zc : zc - SHIFTW;
        const float* shp = sh0 + (size_t)(smp ? ((m0 - MP) >> 5) : 0) * SHIFTW + 64 * h + 4 * hi;
        const float* mu_l = mu + 64 * h + 4 * hi;
        const int pofs = 64 * h + 4 * hi;
#define ZMIX4(dst, co) do { const u32x2 cw = *(const u32x2*)(zc + (co)); const u32x2 pw = *(const u32x2*)(zp + (co)); const f32x4 mu4 = *(const f32x4*)(mu_l + (co)); \
            const float cu[4] = {bflo(cw.x), bfhi(cw.x), bflo(cw.y), bfhi(cw.y)}; float pv[4] = {bflo(pw.x), bfhi(pw.x), bflo(pw.y), bfhi(pw.y)}; \
            if (tile_first) { f32x4 s4 = {0.f, 0.f, 0.f, 0.f}; if (smp) s4 = *(const f32x4*)(shp + (co)); if (first) { pv[0] = s4.x; pv[1] = s4.y; pv[2] = s4.z; pv[3] = s4.w; } } \
            _Pragma("unroll") for (int e = 0; e < 4; ++e) dst[e] = cu[e] + mu4[e] * (pv[e] - cu[e]); } while (0)
        float n2 = 0.f;
#pragma unroll
        for (int ct = 0; ct < 2; ++ct)
#pragma unroll
            for (int grp = 0; grp < 4; ++grp) { const int co = 32 * ct + 8 * grp; float zk[4]; ZMIX4(zk, 512 + co); const f32x4 kk4 = *(const f32x4*)(k_k + pofs + co);
#pragma unroll
                for (int e = 0; e < 4; ++e) { const float kr = zk[e] * kk4[e]; n2 += kr * kr; } }
        n2 += __shfl_xor(n2, 32);
        const float invn = 1.0f / fmaxf(sqrtf(n2), 1e-12f);
        float bon = 0.f;
        asm volatile("" ::: "memory");
#pragma unroll
        for (int ct = 0; ct < 2; ++ct) {
            const f32x16 z16 = {0.f, 0.f, 0.f, 0.f, 0.f, 0.f, 0.f, 0.f, 0.f, 0.f, 0.f, 0.f, 0.f, 0.f, 0.f, 0.f}; f32x16 Dw = z16, Da = z16, Dg = z16;
            const int n = 64 * h + 32 * ct + rho;
            const bf16* xrow = xs + rho * XS_PITCH + 8 * hi;
#pragma unroll
            for (int ks = 0; ks < 2; ++ks) {
                Dw = MFMA32(*(const bf16x8*)(w2t + n * 32 + 16 * ks + 8 * hi), *(const bf16x8*)(xrow + 16 * ks), Dw);
                Da = MFMA32(*(const bf16x8*)(a2t + n * 32 + 16 * ks + 8 * hi), *(const bf16x8*)(xrow + 32 + 16 * ks), Da); }
#pragma unroll
            for (int ks = 0; ks < 6; ++ks) Dg = MFMA32(*(const bf16x8*)(g2t + n * 96 + 16 * ks + 8 * hi), *(const bf16x8*)(xrow + 64 + 16 * ks), Dg);
#pragma unroll
            for (int grp = 0; grp < 4; ++grp) {
                const int co = 32 * ct + 8 * grp;
                float zr[4], zk[4], zv[4]; ZMIX4(zr, co); ZMIX4(zk, 512 + co); ZMIX4(zv, 1024 + co);
                const f32x4 w04 = *(const f32x4*)(w0 + pofs + co), a04 = *(const f32x4*)(a0 + pofs + co), kk4 = *(const f32x4*)(k_k + pofs + co), ka4 = *(const f32x4*)(k_a + pofs + co), rk4 = *(const f32x4*)(r_k + pofs + co);
                float dec[4], km[4], gg[4], kk[4], bb[4];
#pragma unroll
                for (int e = 0; e < 4; ++e) { const int r = 4 * grp + e;
                    const float sg = __frcp_rn(1.0f + __expf(-(w04[e] + Dw[r])));
                    dec[e] = __expf(-0.6065306597126334f * sg);
                    const float aa = __frcp_rn(1.0f + __expf(-(a04[e] + Da[r])));
                    gg[e] = Dg[r];
                    kk[e] = zk[e] * kk4[e] * invn; bb[e] = kk[e] * aa;
                    km[e] = zk[e] * (1.0f + (aa - 1.0f) * ka4[e]);
                    bon += zr[e] * km[e] * rk4[e]; }
                const size_t o = (size_t)m * 512 + pofs + co;
                *(f32x4*)(OW + o) = (f32x4){dec[0], dec[1], dec[2], dec[3]};
                *(u32x2*)(OKK + o) = (u32x2){pk2(kk[0], kk[1]), pk2(kk[2], kk[3])};
                *(u32x2*)(OB + o) = (u32x2){pk2(bb[0], bb[1]), pk2(bb[2], bb[3])};
                *(u32x2*)(OKM + o) = (u32x2){pk2(km[0], km[1]), pk2(km[2], km[3])};
                *(u32x2*)(OR_ + o) = (u32x2){pk2(zr[0], zr[1]), pk2(zr[2], zr[3])};
                *(u32x2*)(OV + o) = (u32x2){pk2(zv[0], zv[1]), pk2(zv[2], zv[3])};
                *(u32x2*)(G + o) = (u32x2){pk2(gg[0], gg[1]), pk2(gg[2], gg[3])};
                asm volatile("" ::: "memory");
            }
        }
#undef ZMIX4
        bon += __shfl_xor(bon, 32);
        if (hi == 0) BON[(size_t)m * 8 + h] = bon;
        __syncthreads();
    }
}

constexpr int SC_CH = 32;
static_assert(WS_OB - WS_OKK == 17 * MiB && WS_OKM - WS_OB == 17 * MiB && WS_OR - WS_OKM == 17 * MiB && WS_OV - WS_OR == 17 * MiB, "operand arrays are equally spaced");
__device__ __forceinline__ void cvt_store8(unsigned char* d, const u32x4 x) {
    *(u32x4*)d = (u32x4){x.x << 16, x.x & 0xffff0000u, x.y << 16, x.y & 0xffff0000u}; *(u32x4*)(d + 16) = (u32x4){x.z << 16, x.z & 0xffff0000u, x.w << 16, x.w & 0xffff0000u};
}
struct StageP {
    static constexpr int STRIDE = 1280 + 64;
    const unsigned char* pw; const unsigned char* pb; int vrow0;
    u32x4 v[25];
    __device__ __forceinline__ void issue(int t0, int lane) {
        const unsigned char* gw = pw + ((size_t)(t0 + (lane >> 4)) * 512) * 4 + 16 * (lane & 15);
#pragma unroll
        for (int j = 0; j < 8; ++j) v[j] = *(const u32x4*)(gw + (size_t)j * 4 * 512 * 4);
        const unsigned char* gb = pb + ((size_t)(t0 + (lane >> 3)) * 512) * 2 + 16 * (lane & 7);
#pragma unroll
        for (int a = 0; a < 4; ++a)
#pragma unroll
            for (int jj = 0; jj < 4; ++jj) v[8 + 4 * a + jj] = *(const u32x4*)(gb + (size_t)a * (17 * MiB) + (size_t)jj * 8 * 512 * 2);
        v[24] = *(const u32x4*)(pb + (size_t)4 * (17 * MiB) + ((size_t)(t0 + (lane >> 1)) * 512) * 2 + 2 * vrow0 + 16 * (lane & 1));
    }
    __device__ __forceinline__ void commit(unsigned char* buf, int lane) const {
        unsigned char* dw = buf + (lane >> 4) * STRIDE + 16 * (lane & 15);
#pragma unroll
        for (int j = 0; j < 8; ++j) *(u32x4*)(dw + j * 4 * STRIDE) = v[j];
        unsigned char* db = buf + (lane >> 3) * STRIDE + 256 + 32 * (lane & 7);
#pragma unroll
        for (int a = 0; a < 4; ++a)
#pragma unroll
            for (int jj = 0; jj < 4; ++jj) cvt_store8(db + a * 256 + jj * 8 * STRIDE, v[8 + 4 * a + jj]);
        cvt_store8(buf + (lane >> 1) * STRIDE + 1280 + 32 * (lane & 1), v[24]);
    }
};
struct StageS {
    static constexpr int STRIDE = 1280 + 256;
    const unsigned char* pw; const unsigned char* pb;
    u32x4 v[7];
    __device__ __forceinline__ void issue(int t0, int lane) {
        const unsigned char* gw = pw + ((size_t)(t0 + (lane >> 4)) * 512) * 4 + 16 * (lane & 15);
        v[0] = *(const u32x4*)gw; v[1] = *(const u32x4*)(gw + (size_t)4 * 512 * 4);
        const unsigned char* gb = pb + ((size_t)(t0 + (lane >> 3)) * 512) * 2 + 16 * (lane & 7);
#pragma unroll
        for (int a = 0; a < 5; ++a) v[2 + a] = *(const u32x4*)(gb + (size_t)a * (17 * MiB));
    }
    __device__ __forceinline__ void commit(unsigned char* buf, int lane) const {
        unsigned char* dw = buf + (lane >> 4) * STRIDE + 16 * (lane & 15);
        *(u32x4*)dw = v[0]; *(u32x4*)(dw + 4 * STRIDE) = v[1];
        unsigned char* db = buf + (lane >> 3) * STRIDE + 256 + 32 * (lane & 7);
#pragma unroll
        for (int a = 0; a < 5; ++a) cvt_store8(db + a * 256, v[2 + a]);
    }
};
typedef float f32x2 __attribute__((ext_vector_type(2)));
template <int STRIDE> __device__ __forceinline__ void scan_consume(f32x4& S4, const unsigned char* buf, int nst, int ks, int rowl, float* yp) {
    f32x2 Sa = {S4.x, S4.y}, Sb = {S4.z, S4.w};
    for (int s0 = 0; s0 < nst; s0 += 16) {
        float ykeep = 0.f;
#pragma unroll 1
        for (int g = 0; g < 4; ++g) {
            const int kq = ks - 4 * g;
#pragma unroll
            for (int j = 0; j < 4; ++j) {
                const float* p = (const float*)(buf + (s0 + 4 * g + j) * STRIDE) + 4 * ks;
                const f32x2 wa = *(const f32x2*)(p), wb = *(const f32x2*)(p + 2), ka = *(const f32x2*)(p + 64), kb = *(const f32x2*)(p + 66), ba = *(const f32x2*)(p + 128), bb = *(const f32x2*)(p + 130),
                            ma = *(const f32x2*)(p + 192), mb = *(const f32x2*)(p + 194), ra = *(const f32x2*)(p + 256), rb = *(const f32x2*)(p + 258);
                const float v = ((const float*)(buf + (s0 + 4 * g + j) * STRIDE))[320 + rowl];
                f32x2 t = Sa * ka + Sb * kb; float d = t.x + t.y; d = sum16(d);
                const f32x2 vv = {v, v}, dd = {d, d};
                Sa = Sa * wa + (vv * ma - dd * ba); Sb = Sb * wb + (vv * mb - dd * bb);
                f32x2 u = Sa * ra + Sb * rb; float y = u.x + u.y; y = sum16(y);
                ykeep = kq == j ? y : ykeep;
            }
        }
        yp[(size_t)(s0 + ks) * 512] = ykeep;
    }
    S4 = (f32x4){Sa.x, Sa.y, Sb.x, Sb.y};
}
__device__ __forceinline__ void p5_rwkv_scan(const Args& a, unsigned char* lds, int tid) {
    const unsigned char* ws = a.ws; float* out = a.out; float* Y = out + SC_Y;
    const int l = tid & 63, w = __builtin_amdgcn_readfirstlane(tid >> 6), ks = l & 15, rl = l >> 4;
    const int G = gridDim.x, vcu = (G % 8 == 0) ? (blockIdx.x % 8) * (G / 8) + blockIdx.x / 8 : blockIdx.x;
    typedef StageP StP; typedef StageS StS;
    unsigned char* buf0 = lds; unsigned char* buf1 = lds + SC_CH * StP::STRIDE;
    for (int it = vcu; it < 256; it += G) {
        {
            const int bh = it >> 2, b = bh >> 3, h = bh & 7, rb = it & 3, row = 16 * rb + 4 * w + rl;
            const size_t base0 = ((size_t)b * T_P) * 512 + (size_t)h * 64;
            constexpr int NC = T_P / SC_CH;
            StP st; st.pw = ws + WS_OW + base0 * 4; st.pb = ws + WS_OKK + base0 * 2; st.vrow0 = 16 * rb;
            f32x4 S = {0.f, 0.f, 0.f, 0.f};
            if (w >= 4) { if (w == 4) { st.issue(0, l); st.commit(buf0, l); st.issue(4 * SC_CH, l); } else st.issue((w - 4) * SC_CH, l); }
            else __builtin_amdgcn_s_setprio(3);
            __syncthreads();
            Y += base0 + row;
#define SCAN_ITER(c, P, cur, nxt) do { if (w == 4 + (P)) { if ((c) + 1 < NC) { st.commit(nxt, l); if ((c) + 5 < NC) st.issue(((c) + 5) * SC_CH, l); } } \
                else if (w < 4) scan_consume<StP::STRIDE>(S, cur, SC_CH, ks, 4 * w + rl, Y + (size_t)((c) * SC_CH) * 512); __syncthreads(); } while (0)
            for (int c = 0; c < NC; c += 4) { SCAN_ITER(c, 1, buf0, buf1); SCAN_ITER(c + 1, 2, buf1, buf0); SCAN_ITER(c + 2, 3, buf0, buf1); SCAN_ITER(c + 3, 0, buf1, buf0); }
#undef SCAN_ITER
            __builtin_amdgcn_s_setprio(0);
            Y -= base0 + row;
            if (w < 4) *(f32x4*)(out + OFF_WKVP + ((size_t)bh * 64 + row) * 64 + 4 * ks) = S;
        }
        {
            const int b = it >> 3, h = it & 7;
            const size_t base0 = ((size_t)MP + (size_t)b * T_S) * 512 + (size_t)h * 64;
            StS st; st.pw = ws + WS_OW + base0 * 4; st.pb = ws + WS_OKK + base0 * 2;
            if (w >= 4) { st.issue(8 * (w - 4), l); st.commit(buf0 + 8 * (w - 4) * StS::STRIDE, l); }
            __syncthreads();
            for (int pass = 0; pass < 2; ++pass) { const int row = 8 * w + 4 * pass + rl;
                f32x4 S = *(const f32x4*)(a.in[5] + ((size_t)it * 64 + row) * 64 + 4 * ks);
                scan_consume<StS::STRIDE>(S, buf0, T_S, ks, row, Y + base0 + row);
                *(f32x4*)(out + OFF_WKVS + ((size_t)it * 64 + row) * 64 + 4 * ks) = S; }
            __syncthreads();
        }
    }
}

__device__ __forceinline__ void p6_rwkv_out(const Args& a, int tid) {
    const unsigned char* ws = a.ws; const float* out = a.out; const float* Y = out + SC_Y; const bf16* G = (const bf16*)(out + SC_G);
    const bf16* OV = (const bf16*)(ws + WS_OV); const float* BON = (const float*)(ws + WS_BONUS); bf16* O = (bf16*)(a.ws + WS_XB);
    const float* lg = a.in[22]; const float* lb = a.in[23];
    const int sub = tid & 7;
    for (size_t it = (size_t)blockIdx.x * 64 + (tid >> 3); it < (size_t)MT * 8; it += (size_t)gridDim.x * 64) {
        const size_t m = it >> 3; const int h = (int)(it & 7); const size_t o = m * 512 + h * 64 + 8 * sub;
        const f32x4 y0 = *(const f32x4*)(Y + o), y1 = *(const f32x4*)(Y + o + 4); float y[8] = {y0.x, y0.y, y0.z, y0.w, y1.x, y1.y, y1.z, y1.w};
        float s1 = 0.f;
#pragma unroll
        for (int j = 0; j < 8; ++j) s1 += y[j];
        s1 += __shfl_xor(s1, 1); s1 += __shfl_xor(s1, 2); s1 += __shfl_xor(s1, 4);
        const float mean = s1 * (1.f / 64.f); float s2 = 0.f;
#pragma unroll
        for (int j = 0; j < 8; ++j) { const float d = y[j] - mean; s2 += d * d; }
        s2 += __shfl_xor(s2, 1); s2 += __shfl_xor(s2, 2); s2 += __shfl_xor(s2, 4);
        const float rinv = rsqrtf(s2 * (1.f / 64.f) + 64e-5f);
        float v[8], g[8]; unpack8(*(const u32x4*)(OV + o), v); unpack8(*(const u32x4*)(G + o), g);
        const float bon = BON[it]; float r[8];
#pragma unroll
        for (int j = 0; j < 8; ++j) { const int c = h * 64 + 8 * sub + j; r[j] = ((y[j] - mean) * rinv * lg[c] + lb[c] + bon * v[j]) * g[j]; }
        *(u32x4*)(O + m * DM + 512 + h * 64 + 8 * sub) = pack8(r);
    }
}

__device__ __forceinline__ void p8_hnorm(const Args& a, int tid) {
    const int lane = tid & 63, gw = blockIdx.x * 8 + (tid >> 6), NGW = gridDim.x * 8;
    for (int m = gw; m < MT; m += NGW) {
        const f32x4* xr = (const f32x4*)(a.out + OFF_Y + (size_t)m * DM) + lane; f32x4 v[4]; float s = 0.f;
#pragma unroll
        for (int j = 0; j < 4; ++j) { v[j] = xr[64 * j]; s += (v[j].x * v[j].x + v[j].y * v[j].y) + (v[j].z * v[j].z + v[j].w * v[j].w); }
        const float rs = rsqrtf(wave_sum(s) * (1.f / DM) + 1e-6f);
        u32x2* o8 = (u32x2*)((bf16*)(a.ws + WS_HB) + (size_t)m * DM) + lane;
#pragma unroll
        for (int j = 0; j < 4; ++j) { u32x2 o; o.x = pk2(v[j].x * rs, v[j].y * rs); o.y = pk2(v[j].z * rs, v[j].w * rs); o8[64 * j] = o; }
    }
}

constexpr int LDS_BYTES = 163840;
constexpr int N_PHASES = 11;
#ifndef PROBE_MASK
#define PROBE_MASK 0
#endif
template <int PH> __device__ __forceinline__ void run_phase(const Args& args, unsigned char* lds, int tid, int rep) {
    unsigned char* ws = args.ws;
    if constexpr (PH == 0) p0_prologue(args, lds, tid);
    if constexpr (PH == 1) { pg8::Gemm g{(const pg8::bf16_t*)(ws + WS_XB), (const pg8::bf16_t*)(ws + WS_WIN), MT, NZ, DM}; pg8::StaticOrder S; S.init(MT, NZ, gridDim.x, blockIdx.x);
        pg8::EpiZ E{(pg8::bf16_t*)(ws + WS_ZR), (pg8::bf16_t*)(ws + WS_ZS)};
        pg8::gemm_phase<pg8::EpiZ, pg8::StaticOrder, true, true>((PG8_LAS unsigned char*)lds, g, S, E); }
    if constexpr (PH == 2) p2_post(args, lds, tid);
    if constexpr (PH == 3) p3_attention(args, lds, tid, rep);
    if constexpr (PH == 4) p4_rwkv_prep(args, lds, tid);
    if constexpr (PH == 5) p5_rwkv_scan(args, lds, tid);
    if constexpr (PH == 6) p6_rwkv_out(args, tid);
    if constexpr (PH == 7) { pg8::Gemm g{(const pg8::bf16_t*)(ws + WS_XB), (const pg8::bf16_t*)(ws + WS_WOUT), MT, DM, DM}; pg8::StaticOrder S; S.init(MT, DM, gridDim.x, blockIdx.x);
        pg8::EpiH E{args.in[0], args.in[1], args.out + OFF_Y};
        pg8::gemm_phase<pg8::EpiH, pg8::StaticOrder, true, true>((PG8_LAS unsigned char*)lds, g, S, E); }
    if constexpr (PH == 8) p8_hnorm(args, tid);
    if constexpr (PH == 9) { pg8::Gemm g{(const pg8::bf16_t*)(ws + WS_HB), (const pg8::bf16_t*)(ws + WS_W1), MT, DFF, DM}; pg8::StaticOrder S; S.init(MT, DFF, gridDim.x, blockIdx.x);
        pg8::EpiAct E{(pg8::bf16_t*)(ws + WS_ACT), DFF};
        pg8::gemm_phase<pg8::EpiAct, pg8::StaticOrder, true, true>((PG8_LAS unsigned char*)lds, g, S, E); }
    if constexpr (PH == 10) { pg8::Gemm g{(const pg8::bf16_t*)(ws + WS_ACT), (const pg8::bf16_t*)(ws + WS_W2), MT, DM, DFF}; pg8::StaticOrder S; S.init(MT, DM, gridDim.x, blockIdx.x);
        pg8::EpiY E{args.out + OFF_Y};
        pg8::gemm_phase<pg8::EpiY, pg8::StaticOrder, true, true>((PG8_LAS unsigned char*)lds, g, S, E); }
}
#ifndef MK_ONE_LAUNCH
#define MK_ONE_LAUNCH 1
#endif
#if MK_ONE_LAUNCH
__global__ void __launch_bounds__(512, 2) mk_fwd(Args args) {
    extern __shared__ __attribute__((aligned(16))) unsigned char lds[];
    const int tid = threadIdx.x;
#define PHASE(k) do { if (args.ph_lo <= (k) && (k) < args.ph_hi) { if ((k) > args.ph_lo) { __syncthreads(); cg::this_grid().sync(); } run_phase<k>(args, lds, tid, 0); \
        if ((PROBE_MASK >> (k)) & 1) { __syncthreads(); cg::this_grid().sync(); run_phase<k>(args, lds, tid, 1); } } } while (0)
    PHASE(0); PHASE(1); PHASE(2); PHASE(3); PHASE(4); PHASE(5); PHASE(6); PHASE(7); PHASE(8); PHASE(9); PHASE(10);
#undef PHASE
}
#else
template <int PH> __global__ void __launch_bounds__(512, 2) mk_phase(Args args) {
    extern __shared__ __attribute__((aligned(16))) unsigned char lds[];
    run_phase<PH>(args, lds, threadIdx.x, 0);
}
#endif

extern "C" void kernel_launch(void* const* d_in, const int* in_sizes, int n_in, void* d_out, int out_size, void* d_ws, size_t ws_size, hipStream_t stream) {
    static int grid = 0;
    if (grid == 0) {
        if (n_in != 28 || out_size != (int)OUT_TOTAL || ws_size < WS_END) { fprintf(stderr, "kernel_launch: unexpected shapes (n_in %d, out %d, ws %zu)\n", n_in, out_size, ws_size); grid = -1; return; }
        int dev = 0, cus = 0, per_cu = 0;
        (void)hipGetDevice(&dev); (void)hipDeviceGetAttribute(&cus, hipDeviceAttributeMultiprocessorCount, dev);
#if MK_ONE_LAUNCH
        if (hipFuncSetAttribute((const void*)mk_fwd, hipFuncAttributeMaxDynamicSharedMemorySize, LDS_BYTES) != hipSuccess) { fprintf(stderr, "kernel_launch: hipFuncSetAttribute failed\n"); grid = -1; return; }
        (void)hipOccupancyMaxActiveBlocksPerMultiprocessor(&per_cu, (const void*)mk_fwd, 512, LDS_BYTES);
        (void)hipGetLastError();
        if (per_cu < 1) { fprintf(stderr, "kernel_launch: occupancy query says %d blocks per CU\n", per_cu); per_cu = 1; }
#else
#define SETATTR(k) (void)hipFuncSetAttribute((const void*)mk_phase<k>, hipFuncAttributeMaxDynamicSharedMemorySize, LDS_BYTES)
        SETATTR(0); SETATTR(1); SETATTR(2); SETATTR(3); SETATTR(4); SETATTR(5); SETATTR(6); SETATTR(7); SETATTR(8); SETATTR(9); SETATTR(10);
#undef SETATTR
        (void)per_cu;
#endif
        grid = cus;
    }
    if (grid < 0) return;
    (void)hipMemsetAsync((char*)d_ws + WS_CTL, 0, CTL_BYTES, stream);
    Args a{};
    for (int i = 0; i < 28; ++i) a.in[i] = (const float*)d_in[i];
    a.out = (float*)d_out; a.ws = (unsigned char*)d_ws;
#if MK_ONE_LAUNCH
    a.ph_lo = 0; a.ph_hi = N_PHASES;
    void* kargs[] = {&a};
    hipError_t e = hipLaunchCooperativeKernel((const void*)mk_fwd, dim3(grid), dim3(512), kargs, LDS_BYTES, stream);
    if (e != hipSuccess) fprintf(stderr, "kernel_launch: cooperative launch failed: %s (grid %d)\n", hipGetErrorString(e), grid);
#else
#define LAUNCH(k) hipLaunchKernelGGL(mk_phase<k>, dim3(grid), dim3(512), LDS_BYTES, stream, a)
    a.ph_lo = 0; a.ph_hi = N_PHASES;
    LAUNCH(0); LAUNCH(1); LAUNCH(2); LAUNCH(3); LAUNCH(4); LAUNCH(5); LAUNCH(6); LAUNCH(7); LAUNCH(8); LAUNCH(9); LAUNCH(10);
#undef LAUNCH
#endif
}
```

```cpp
#include <hip/hip_runtime.h>
#include <hip/hip_cooperative_groups.h>
#include <cstdio>
#include <cstdint>
namespace cg = cooperative_groups;
namespace pg8 {
#define PG8_LAS __attribute__((address_space(3)))
typedef unsigned short bf16_t;
typedef short bf16x8 __attribute__((ext_vector_type(8)));
typedef float f32x4 __attribute__((ext_vector_type(4)));
typedef unsigned u32x4 __attribute__((ext_vector_type(4)));
constexpr int BM = 256, BK = 64, HALF = 128, HTB = HALF * BK * 2  , STAGE_BYTES = 8 * HTB, NXCD = 8, WGM = 8;

__host__ __device__ __forceinline__ int lds_byte(int r, int c) { const int st = (r >> 4) * 2 + (c >> 5), rr = r & 15, cc = c & 31, ob = rr * 64 + cc * 2; return st * 1024 + (ob ^ (((ob >> 9) & 1) << 5)); }
__host__ __device__ __forceinline__ void stage_rc(int b, int& R, int& C) { const int st = b / 1024, sb = b % 1024, swz = sb ^ (((sb >> 9) & 1) << 5); R = (st >> 1) * 16 + swz / 64; C = (st & 1) * 32 + (swz % 64) / 2; }
__host__ __device__ __forceinline__ int perm32(int rho) { const int n = rho >> 4, i = rho & 15; return 8 * (i >> 2) + 4 * n + (i & 3); }

struct Unit { int pm, pn; };
struct Gemm { const bf16_t* A; const bf16_t* Bt; int M, N, K; };

struct StaticOrder {
    int nM, nN, nwg, G, c;
    __host__ __device__ void init(int M, int N, int G_, int c_) { nM = M / BM; nN = N / BM; nwg = nM * nN; G = G_; c = c_; }
    __host__ __device__ bool next(int i, Unit& u) const {
        const long L = (long)i * G + c; if (L >= nwg) return false;
        int wgid = (int)L; { const int q = nwg / NXCD, r = nwg % NXCD, xcd = wgid % NXCD, off = wgid / NXCD; wgid = (xcd < r ? xcd * (q + 1) : r * (q + 1) + (xcd - r) * q) + off; }
        const int nig = WGM * nN, gid = wgid / nig, fm = gid * WGM, gsz = (nM - fm) < WGM ? (nM - fm) : WGM;
        u.pm = fm + ((wgid % nig) % gsz); u.pn = (wgid % nig) / gsz; return true;
    }
    __device__ __forceinline__ void a_ready(const Unit&) const {}
    __device__ __forceinline__ void done(const Unit&) const {}
};


__device__ __forceinline__ unsigned cvt_pk_bf16(float lo, float hi) { unsigned r; asm volatile("v_cvt_pk_bf16_f32 %0, %1, %2" : "=v"(r) : "v"(lo), "v"(hi)); return r; }

constexpr int E_MP = 16384;
constexpr int E_ZRW = 1632, E_ZSW = 1696;

struct EpiZ {
    static constexpr bool PERM = true, AFTER_DRAIN = false;
    bf16_t* ZR; bf16_t* ZS;
    __device__ __forceinline__ void operator()(const f32x4 (&acc)[2][2][4][2], const Unit& u, int wr, int wc, int fr, int fq) const {
        const int row0 = u.pm * BM + wr * 64 + fr, c0 = u.pn * BM + wc * 32 + 8 * fq;
#pragma unroll
        for (int ai = 0; ai < 2; ++ai)
#pragma unroll
            for (int m = 0; m < 4; ++m) { const size_t row = (size_t)(row0 + ai * HALF + m * 16);
#pragma unroll
                for (int bj = 0; bj < 2; ++bj) { const int c = c0 + bj * HALF; bf16_t* dst;
                    if (c < 1600) dst = ZR + row * E_ZRW + c; else if (c < 3296) dst = ZS + row * E_ZSW + (c - 1600); else if (c == 3296) dst = ZR + row * E_ZRW + 1600; else continue;
                    const f32x4 v0 = acc[ai][bj][m][0], v1 = acc[ai][bj][m][1]; u32x4 w;
                    w.x = cvt_pk_bf16(v0[0], v0[1]); w.y = cvt_pk_bf16(v0[2], v0[3]); w.z = cvt_pk_bf16(v1[0], v1[1]); w.w = cvt_pk_bf16(v1[2], v1[3]);
                    *(u32x4*)dst = w; } }
    }
};
struct EpiH {
    static constexpr bool PERM = false, AFTER_DRAIN = false;
    const float* xp; const float* xs; float* H;
    __device__ __forceinline__ void operator()(const f32x4 (&acc)[2][2][4][2], const Unit& u, int wr, int wc, int fr, int fq) const {
        const int row0 = u.pm * BM + wr * 64 + fr, col0 = u.pn * BM + wc * 32 + 4 * fq;
#pragma unroll
        for (int ai = 0; ai < 2; ++ai)
#pragma unroll
            for (int m = 0; m < 4; ++m) { const int row = row0 + ai * HALF + m * 16;
                const float* xr = (row < E_MP ? xp + (size_t)row * 1024 : xs + (size_t)(row - E_MP) * 1024) + col0; float* hr = H + (size_t)row * 1024 + col0;
#pragma unroll
                for (int bj = 0; bj < 2; ++bj)
#pragma unroll
                    for (int n = 0; n < 2; ++n) *(f32x4*)(hr + bj * HALF + n * 16) = *(const f32x4*)(xr + bj * HALF + n * 16) + acc[ai][bj][m][n]; }
    }
};
struct EpiAct {
    static constexpr bool PERM = true, AFTER_DRAIN = false;
    bf16_t* O; int ldc;
    __device__ __forceinline__ void operator()(const f32x4 (&acc)[2][2][4][2], const Unit& u, int wr, int wc, int fr, int fq) const {
        const int row0 = u.pm * BM + wr * 64 + fr, c0 = u.pn * BM + wc * 32 + 8 * fq;
#pragma unroll
        for (int ai = 0; ai < 2; ++ai)
#pragma unroll
            for (int m = 0; m < 4; ++m) { bf16_t* rowp = O + (size_t)(row0 + ai * HALF + m * 16) * ldc + c0;
#pragma unroll
                for (int bj = 0; bj < 2; ++bj) { f32x4 v0 = acc[ai][bj][m][0], v1 = acc[ai][bj][m][1];
#pragma unroll
                    for (int e = 0; e < 4; ++e) { const float a = fmaxf(v0[e], 0.f), b = fmaxf(v1[e], 0.f); v0[e] = a * a; v1[e] = b * b; }
                    u32x4 w; w.x = cvt_pk_bf16(v0[0], v0[1]); w.y = cvt_pk_bf16(v0[2], v0[3]); w.z = cvt_pk_bf16(v1[0], v1[1]); w.w = cvt_pk_bf16(v1[2], v1[3]);
                    *(u32x4*)(rowp + bj * HALF) = w; } }
    }
};
struct EpiY {
    static constexpr bool PERM = false, AFTER_DRAIN = false;
    float* Y;
    __device__ __forceinline__ void operator()(const f32x4 (&acc)[2][2][4][2], const Unit& u, int wr, int wc, int fr, int fq) const {
        const int row0 = u.pm * BM + wr * 64 + fr, col0 = u.pn * BM + wc * 32 + 4 * fq;
#pragma unroll
        for (int ai = 0; ai < 2; ++ai)
#pragma unroll
            for (int m = 0; m < 4; ++m) { float* yr = Y + (size_t)(row0 + ai * HALF + m * 16) * 1024 + col0;
#pragma unroll
                for (int bj = 0; bj < 2; ++bj)
#pragma unroll
                    for (int n = 0; n < 2; ++n) { f32x4* p = (f32x4*)(yr + bj * HALF + n * 16); *p = *p + acc[ai][bj][m][n]; } }
    }
};

template <class Epi, class Sched, bool ALIGN_EPI = false, bool SP2 = false>
__device__ __forceinline__ void gemm_phase(PG8_LAS unsigned char* lds, const Gemm g, const Sched& S, const Epi& E) {
    const int tid = threadIdx.x, wid = __builtin_amdgcn_readfirstlane(tid >> 6), lane = tid & 63, wr = wid >> 2, wc = wid & 3, fr = lane & 15, fq = lane >> 4;
    const int K = g.K, nt = K / BK;
    unsigned voffA[2], voffB[2];
#pragma unroll
    for (int i = 0; i < 2; ++i) { int R, C; stage_rc(tid * 16 + i * 8192, R, C); const int Rb = Epi::PERM ? ((R & ~31) + perm32(R & 31)) : R;
        voffA[i] = (unsigned)(R * K + C) * 2u; voffB[i] = (unsigned)(Rb * K + C) * 2u; }
    const size_t kstep = (size_t)(BK * 2);
    const size_t hstep = (size_t)HALF * K * 2;
    const size_t tstep = 2 * hstep;
    const unsigned ldsw = (unsigned)wid * 1024u;
    const int aoff = lds_byte(wr * 64 + fr, fq * 8), boff = lds_byte(wc * 32 + fr, fq * 8);
#define PG8_SA(b, h) (((b) * 2 + (h)) * HTB)
#define PG8_SB(b, h) ((4 + (b) * 2 + (h)) * HTB)
#define PG8_STAGE(bufoff, gbase, voff) do { _Pragma("unroll") for (int _i = 0; _i < 2; ++_i) \
        __builtin_amdgcn_global_load_lds((const unsigned*)((const char*)(gbase) + (voff)[_i]), (PG8_LAS unsigned*)(lds + (bufoff) + ldsw + _i * 8192), 16, 0, 0); } while (0)
#define PG8_LDA(dst, b, h) do { _Pragma("unroll") for (int m = 0; m < 4; ++m) _Pragma("unroll") for (int k = 0; k < 2; ++k) dst[m][k] = *(const PG8_LAS bf16x8*)(lds + PG8_SA(b, h) + aoff + m * 2048 + k * 1024); } while (0)
#define PG8_LDB(dst, b, h) do { _Pragma("unroll") for (int n = 0; n < 2; ++n) _Pragma("unroll") for (int k = 0; k < 2; ++k) dst[n][k] = *(const PG8_LAS bf16x8*)(lds + PG8_SB(b, h) + boff + n * 2048 + k * 1024); } while (0)
#define PG8_MMA(ai, bj, At, Bt) do { __builtin_amdgcn_s_setprio(1); _Pragma("unroll") for (int m = 0; m < 4; ++m) _Pragma("unroll") for (int n = 0; n < 2; ++n) _Pragma("unroll") for (int k = 0; k < 2; ++k) \
        acc[ai][bj][m][n] = __builtin_amdgcn_mfma_f32_16x16x32_bf16(Bt[n][k], At[m][k], acc[ai][bj][m][n], 0, 0, 0); __builtin_amdgcn_s_setprio(0); } while (0)
#define PG8_WAIT_V(n) asm volatile("s_waitcnt vmcnt(" #n ")" ::: "memory")
#define PG8_WAIT_L(n) asm volatile("s_waitcnt lgkmcnt(" #n ")" ::: "memory")
#define PG8_BAR __builtin_amdgcn_s_barrier()
#define PG8_SCHED __builtin_amdgcn_sched_barrier(0)
    Unit cur, nxt; int ui = 0;
    if (!S.next(0, cur)) return;
    f32x4 acc[2][2][4][2];
#pragma unroll
    for (int a = 0; a < 2; ++a)
#pragma unroll
        for (int b = 0; b < 2; ++b)
#pragma unroll
            for (int m = 0; m < 4; ++m)
#pragma unroll
                for (int n = 0; n < 2; ++n) acc[a][b][m][n] = (f32x4){0.f, 0.f, 0.f, 0.f};
    bf16x8 At[4][2], B0[2][2], B1[2][2];
    const char* cA = (const char*)g.A + (size_t)cur.pm * tstep; const char* cB = (const char*)g.Bt + (size_t)cur.pn * tstep;
    S.a_ready(cur);
    if constexpr (SP2) {
        PG8_STAGE(PG8_SB(0, 0), cB, voffB); PG8_STAGE(PG8_SB(0, 1), cB + hstep, voffB); PG8_STAGE(PG8_SA(0, 0), cA, voffA); PG8_STAGE(PG8_SA(0, 1), cA + hstep, voffA);
        if (wr == 1) PG8_BAR;
        PG8_WAIT_V(2); PG8_BAR;
        PG8_STAGE(PG8_SB(1, 0), cB + kstep, voffB); PG8_STAGE(PG8_SA(1, 0), cA + kstep, voffA); PG8_STAGE(PG8_SB(1, 1), cB + hstep + kstep, voffB);
        PG8_WAIT_V(6); PG8_BAR;
    } else {
        PG8_STAGE(PG8_SB(0, 0), cB, voffB); PG8_STAGE(PG8_SA(0, 0), cA, voffA); PG8_STAGE(PG8_SB(0, 1), cB + hstep, voffB); PG8_STAGE(PG8_SA(0, 1), cA + hstep, voffA);
        if (wr == 1) PG8_BAR;
        PG8_WAIT_V(4); PG8_BAR;
        PG8_STAGE(PG8_SB(1, 0), cB + kstep, voffB); PG8_STAGE(PG8_SA(1, 0), cA + kstep, voffA); PG8_STAGE(PG8_SB(1, 1), cB + hstep + kstep, voffB);
        PG8_WAIT_V(6); PG8_BAR;
    }
    for (;;) {
        const bool has_next = S.next(ui + 1, nxt);
        const char* nA = has_next ? (const char*)g.A + (size_t)nxt.pm * tstep : cA; const char* nB = has_next ? (const char*)g.Bt + (size_t)nxt.pn * tstep : cB;
        for (int t = 0; t < nt; t += 2) {
            const bool last = (t == nt - 2);
            const char* a1 = cA + (size_t)(t + 1) * kstep;
            const char* a2 = last ? nA : cA + (size_t)(t + 2) * kstep; const char* b2 = last ? nB : cB + (size_t)(t + 2) * kstep;
            const char* a3 = a2 + kstep; const char* b3 = b2 + kstep;
            if (last && has_next) S.a_ready(nxt);
            if constexpr (SP2) {
            PG8_LDB(B0, 0, 0); PG8_LDB(B1, 0, 1); PG8_SCHED; PG8_LDA(At, 0, 0); PG8_STAGE(PG8_SA(1, 1), a1 + hstep, voffA);
            PG8_WAIT_V(8); PG8_WAIT_L(0); PG8_BAR; PG8_MMA(0, 0, At, B0); PG8_MMA(0, 1, At, B1); PG8_BAR; PG8_SCHED;
            PG8_LDA(At, 0, 1); PG8_STAGE(PG8_SB(0, 0), b2, voffB); PG8_STAGE(PG8_SB(0, 1), b2 + hstep, voffB); PG8_STAGE(PG8_SA(0, 0), a2, voffA);
            PG8_WAIT_V(8); PG8_WAIT_L(0); PG8_BAR; PG8_MMA(1, 0, At, B0); PG8_MMA(1, 1, At, B1); PG8_BAR; PG8_SCHED;
            PG8_LDB(B0, 1, 0); PG8_LDB(B1, 1, 1); PG8_SCHED; PG8_LDA(At, 1, 0); PG8_STAGE(PG8_SA(0, 1), a2 + hstep, voffA);
            PG8_WAIT_V(8); PG8_WAIT_L(0); PG8_BAR; PG8_MMA(0, 0, At, B0); PG8_MMA(0, 1, At, B1); PG8_BAR; PG8_SCHED;
            PG8_LDA(At, 1, 1); PG8_STAGE(PG8_SB(1, 0), b3, voffB); PG8_STAGE(PG8_SB(1, 1), b3 + hstep, voffB); PG8_STAGE(PG8_SA(1, 0), a3, voffA);
            PG8_WAIT_V(8); PG8_WAIT_L(0); PG8_BAR; PG8_MMA(1, 0, At, B0); PG8_MMA(1, 1, At, B1); PG8_BAR; PG8_SCHED;
            } else {
            PG8_LDB(B0, 0, 0); PG8_SCHED; PG8_LDA(At, 0, 0); PG8_STAGE(PG8_SA(1, 1), a1 + hstep, voffA);
            PG8_WAIT_L(8); PG8_BAR; PG8_WAIT_L(0); PG8_MMA(0, 0, At, B0); PG8_BAR; PG8_SCHED;
            PG8_LDB(B1, 0, 1); PG8_STAGE(PG8_SB(0, 0), b2, voffB);
            PG8_BAR; PG8_WAIT_L(0); PG8_MMA(0, 1, At, B1); PG8_BAR;
            PG8_LDA(At, 0, 1); PG8_STAGE(PG8_SA(0, 0), a2, voffA);
            PG8_BAR; PG8_WAIT_L(0); PG8_MMA(1, 0, At, B0); PG8_BAR; PG8_SCHED;
            PG8_STAGE(PG8_SB(0, 1), b2 + hstep, voffB);
            PG8_WAIT_V(6); PG8_BAR; PG8_MMA(1, 1, At, B1); PG8_BAR;
            PG8_LDB(B0, 1, 0); PG8_SCHED; PG8_LDA(At, 1, 0); PG8_STAGE(PG8_SA(0, 1), a2 + hstep, voffA);
            PG8_WAIT_L(8); PG8_BAR; PG8_WAIT_L(0); PG8_MMA(0, 0, At, B0); PG8_BAR; PG8_SCHED;
            PG8_LDB(B1, 1, 1); PG8_STAGE(PG8_SB(1, 0), b3, voffB);
            PG8_BAR; PG8_WAIT_L(0); PG8_MMA(0, 1, At, B1); PG8_BAR;
            PG8_LDA(At, 1, 1); PG8_STAGE(PG8_SA(1, 0), a3, voffA);
            PG8_BAR; PG8_WAIT_L(0); PG8_MMA(1, 0, At, B0); PG8_BAR; PG8_SCHED;
            PG8_STAGE(PG8_SB(1, 1), b3 + hstep, voffB);
            PG8_WAIT_V(6); PG8_BAR; PG8_MMA(1, 1, At, B1); PG8_BAR;
            }
        }
        if constexpr (ALIGN_EPI) { if (wr == 0) PG8_BAR; }
        if constexpr (!Epi::AFTER_DRAIN) { E(acc, cur, wr, wc, fr, fq); S.done(cur); }
        if (!has_next) break;
#pragma unroll
        for (int a = 0; a < 2; ++a)
#pragma unroll
            for (int b = 0; b < 2; ++b)
#pragma unroll
                for (int m = 0; m < 4; ++m)
#pragma unroll
                    for (int n = 0; n < 2; ++n) acc[a][b][m][n] = (f32x4){0.f, 0.f, 0.f, 0.f};
        cur = nxt; cA = nA; cB = nB; ++ui;
        if constexpr (ALIGN_EPI) { if (wr == 1) PG8_BAR; }
    }
    PG8_WAIT_V(0);
    if constexpr (!ALIGN_EPI) { if (wr == 0) PG8_BAR; }
    PG8_BAR;
    if constexpr (Epi::AFTER_DRAIN) { E.fused(acc, cur, wr, wc, fr, fq, lds, wid, lane); S.done(cur); }
#undef PG8_SA
#undef PG8_SB
#undef PG8_STAGE
#undef PG8_LDA
#undef PG8_LDB
#undef PG8_MMA
#undef PG8_WAIT_V
#undef PG8_WAIT_L
#undef PG8_BAR
#undef PG8_SCHED
}
}


constexpr int DM = 1024, NB_P = 8, T_P = 2048, NB_S = 32, T_S = 32, PAST = 1024;
constexpr int MP = NB_P * T_P, MS = NB_S * T_S, MT = MP + MS;
constexpr int LS = PAST + T_S;
constexpr int SHIFTW = 1696, NZ = 3328, ZRW = 1632, DFF = 4096;
constexpr float QSCALE = 0.125f * 1.4426950408889634f;
constexpr float WISCALE = 0.35355339059327373f * 0.125f;
constexpr size_t OFF_Y = 0, OFF_KP = 17825792, OFF_VP = OFF_KP + 4194304, OFF_KIP = OFF_VP + 4194304, OFF_WKVP = OFF_KIP + 1048576, OFF_SHP = OFF_WKVP + 262144,
                 OFF_KS = OFF_SHP + 13568, OFF_VS = OFF_KS + 262144, OFF_KIS = OFF_VS + 262144, OFF_WKVS = OFF_KIS + 65536, OFF_SHS = OFF_WKVS + 1048576, OUT_TOTAL = OFF_SHS + 54272;
constexpr size_t MiB = 1u << 20;
constexpr size_t WS_CTL = 0, CTL_BYTES = 1 * MiB;
constexpr size_t WS_WIN = 1 * MiB, WS_WOUT = 8 * MiB, WS_W1 = 10 * MiB, WS_W2 = 18 * MiB;
constexpr size_t WS_W2T = 26 * MiB, WS_A2T = WS_W2T + 32768, WS_G2T = WS_A2T + 32768, WS_WI = 27 * MiB, WS_BONUS = 28 * MiB;
constexpr size_t WS_XB = 30 * MiB;
constexpr size_t WS_ZS = 66 * MiB;
constexpr size_t WS_R = 123 * MiB;
constexpr size_t WS_ZR = WS_R, WS_KBP = 178 * MiB, WS_VTP = 186 * MiB, WS_KIP = 194 * MiB, WS_KBS = 196 * MiB, WS_VTS = 213 * MiB, WS_KIS = 230 * MiB;
constexpr size_t WS_OW = WS_R, WS_OKK = 157 * MiB, WS_OB = 174 * MiB, WS_OKM = 191 * MiB, WS_OR = 208 * MiB, WS_OV = 225 * MiB;
constexpr size_t WS_ACT = 66 * MiB, WS_HB = 202 * MiB, WS_END = 256 * MiB;
static_assert(WS_ZS + (size_t)MT * SHIFTW * 2 <= WS_R && WS_ZR + (size_t)MT * ZRW * 2 <= WS_KBP && WS_KBS + (size_t)NB_S * LS * 256 * 2 <= WS_VTS && WS_VTS + (size_t)NB_S * 256 * LS * 2 <= WS_KIS &&
              WS_KIS + (size_t)NB_S * LS * 64 * 2 <= WS_END && WS_OV + (size_t)MT * 512 * 2 <= WS_END && WS_ACT + (size_t)MT * DFF * 2 <= WS_HB && WS_HB + (size_t)MT * DM * 2 <= WS_END, "d_ws map");
constexpr size_t SC_Q = 0, SC_QI = (size_t)MT * 512 / 2, SC_Y = 0, SC_G = (size_t)MT * 512;
constexpr int CW_QATT = 64;

typedef unsigned short bf16;
typedef short bf16x8 __attribute__((ext_vector_type(8)));
typedef float f32x4 __attribute__((ext_vector_type(4)));
typedef float f32x16 __attribute__((ext_vector_type(16)));
typedef unsigned u32x4 __attribute__((ext_vector_type(4)));
typedef unsigned u32x2 __attribute__((ext_vector_type(2)));

__device__ __forceinline__ unsigned f2bf(float f) { unsigned u = __float_as_uint(f); return (u + 0x7fffu + ((u >> 16) & 1u)) >> 16; }
__device__ __forceinline__ unsigned pk2(float lo, float hi) { return f2bf(lo) | (f2bf(hi) << 16); }
__device__ __forceinline__ float bflo(unsigned w) { return __uint_as_float(w << 16); }
__device__ __forceinline__ float bfhi(unsigned w) { return __uint_as_float(w & 0xffff0000u); }
__device__ __forceinline__ float bf1(bf16 b) { return __uint_as_float((unsigned)b << 16); }
__device__ __forceinline__ void unpack8(const u32x4 w, float* x) { x[0] = bflo(w.x); x[1] = bfhi(w.x); x[2] = bflo(w.y); x[3] = bfhi(w.y); x[4] = bflo(w.z); x[5] = bfhi(w.z); x[6] = bflo(w.w); x[7] = bfhi(w.w); }
__device__ __forceinline__ u32x4 pack8(const float* x) { u32x4 w; w.x = pk2(x[0], x[1]); w.y = pk2(x[2], x[3]); w.z = pk2(x[4], x[5]); w.w = pk2(x[6], x[7]); return w; }
__device__ __forceinline__ float wave_sum(float v) {
#pragma unroll
    for (int o = 1; o < 64; o <<= 1) v += __shfl_xor(v, o);
    return v;
}
template <int CTRL> __device__ __forceinline__ float dppmov(float x) { return __builtin_bit_cast(float, __builtin_amdgcn_update_dpp(0, __builtin_bit_cast(int, x), CTRL, 0xf, 0xf, true)); }
__device__ __forceinline__ float sum16(float x) {
    x += dppmov<0xB1>(x); x += dppmov<0x4E>(x); x += dppmov<0x141>(x); x += dppmov<0x140>(x); return x;
}
__device__ __forceinline__ int crow(int r, int hi) { return (r & 3) + 8 * (r >> 2) + 4 * hi; }

struct Args { const float* in[28]; float* out; unsigned char* ws; int ph_lo, ph_hi; };

__device__ __forceinline__ void tr_item(const float* W, int K, int N, const float* gain, bf16* WT, int jr0, int c0, int nvalid, int k0, float* scr, int lane) {
#pragma unroll 8
    for (int i = 0; i < 32; ++i) { const int kk = 2 * i + (lane >> 5), n = lane & 31;
        float v = (n < nvalid) ? W[(size_t)(k0 + kk) * N + c0 + n] : 0.f; if (gain) v *= gain[k0 + kk]; scr[kk * 33 + n] = v; }
    __builtin_amdgcn_s_waitcnt(0xC07F); asm volatile("" ::: "memory");
    const int c = lane & 7;
#pragma unroll
    for (int j = 0; j < 4; ++j) { const int n = (lane >> 3) + 8 * j; const float* s = scr + (8 * c) * 33 + n;
        u32x4 o; o.x = pk2(s[0 * 33], s[1 * 33]); o.y = pk2(s[2 * 33], s[3 * 33]); o.z = pk2(s[4 * 33], s[5 * 33]); o.w = pk2(s[6 * 33], s[7 * 33]);
        *(u32x4*)(WT + (size_t)(jr0 + n) * K + k0 + 8 * c) = o; }
    __builtin_amdgcn_s_waitcnt(0xC07F); asm volatile("" ::: "memory");
}
__device__ __forceinline__ void p0_prologue(const Args& a, unsigned char* lds, int tid) {
    const int lane = tid & 63, wave = tid >> 6, gw = blockIdx.x * 8 + wave, NGW = gridDim.x * 8;
    float* scr = (float*)(lds + wave * 17408);
    unsigned char* ws = a.ws;
    constexpr int I_IN = (NZ / 32) * (DM / 64), I_OUT = (DM / 32) * (DM / 64), I_F1 = (DFF / 32) * (DM / 64), I_F2 = (DM / 32) * (DFF / 64);
    for (int it = gw; it < I_IN + I_OUT + I_F1 + I_F2; it += NGW) {
        int r = it;
        if (r < I_IN) { const int jb = r % (NZ / 32), kb = r / (NZ / 32), j0 = jb * 32; int c0, nv;
            if (j0 < 1600) { c0 = j0; nv = 32; } else if (j0 < 3296) { c0 = 1608 + (j0 - 1600); nv = 32; } else { c0 = 1600; nv = 8; }
            tr_item(a.in[8], DM, 3304, a.in[7], (bf16*)(ws + WS_WIN), j0, c0, nv, kb * 64, scr, lane); continue; }
        r -= I_IN;
        if (r < I_OUT) { const int jb = r % (DM / 32), kb = r / (DM / 32); tr_item(a.in[24], DM, DM, nullptr, (bf16*)(ws + WS_WOUT), jb * 32, jb * 32, 32, kb * 64, scr, lane); continue; }
        r -= I_OUT;
        if (r < I_F1) { const int jb = r % (DFF / 32), kb = r / (DFF / 32); tr_item(a.in[26], DM, DFF, a.in[25], (bf16*)(ws + WS_W1), jb * 32, jb * 32, 32, kb * 64, scr, lane); continue; }
        r -= I_F1;
        { const int jb = r % (DM / 32), kb = r / (DM / 32); tr_item(a.in[27], DFF, DM, nullptr, (bf16*)(ws + WS_W2), jb * 32, jb * 32, 32, kb * 64, scr, lane); }
    }
    { const int gt = blockIdx.x * 512 + tid, NT = gridDim.x * 512;
      bf16* w2t = (bf16*)(ws + WS_W2T); bf16* a2t = (bf16*)(ws + WS_A2T); bf16* g2t = (bf16*)(ws + WS_G2T);
      for (int i = gt; i < 512 * 32; i += NT) { const int n = i >> 5, k = i & 31; w2t[i] = (bf16)f2bf(a.in[15][k * 512 + n]); a2t[i] = (bf16)f2bf(a.in[17][k * 512 + n]); }
      for (int i = gt; i < 512 * 96; i += NT) { const int n = i / 96, k = i % 96; g2t[i] = (bf16)f2bf(a.in[18][k * 512 + n]); } }
    for (int m = gw; m < MT; m += NGW) {
        const float* xrow = (m < MP) ? a.in[0] + (size_t)m * DM : a.in[1] + (size_t)(m - MP) * DM;
        const f32x4* xr = (const f32x4*)xrow + lane; f32x4 v[4]; float s = 0.f;
#pragma unroll
        for (int j = 0; j < 4; ++j) { v[j] = xr[64 * j]; s += (v[j].x * v[j].x + v[j].y * v[j].y) + (v[j].z * v[j].z + v[j].w * v[j].w); }
        const float rs = rsqrtf(wave_sum(s) * (1.f / DM) + 1e-6f);
        u32x2* o8 = (u32x2*)((bf16*)(ws + WS_XB) + (size_t)m * DM) + lane;
#pragma unroll
        for (int j = 0; j < 4; ++j) { u32x2 o; o.x = pk2(v[j].x * rs, v[j].y * rs); o.y = pk2(v[j].z * rs, v[j].w * rs); o8[64 * j] = o; }
    }
    for (int rix = gw; rix < NB_S * PAST; rix += NGW) {
        const int b = rix >> 10, p = rix & 1023; const f32x4 v = ((const f32x4*)(a.in[2] + (size_t)rix * 256))[lane];
        u32x2 o; o.x = pk2(v.x, v.y); o.y = pk2(v.z, v.w); ((u32x2*)((bf16*)(ws + WS_KBS) + ((size_t)b * LS + p) * 256))[lane] = o;
    }
    for (int r4 = gw; r4 < NB_S * PAST / 4; r4 += NGW) {
        const int rix = r4 * 4 + (lane >> 4), b = rix >> 10, p = rix & 1023; const f32x4 v = ((const f32x4*)(a.in[4] + (size_t)rix * 64))[lane & 15];
        u32x2 o; o.x = pk2(v.x, v.y); o.y = pk2(v.z, v.w); ((u32x2*)((bf16*)(ws + WS_KIS) + ((size_t)b * LS + p) * 64))[lane & 15] = o;
    }
    for (int it = gw; it < NB_S * 4 * 16; it += NGW) {
        const int kb = it & 15, g = (it >> 4) & 3, b = it >> 6;
        const float* src = a.in[3] + ((size_t)b * PAST + kb * 64) * 256 + g * 64;
#pragma unroll 8
        for (int i = 0; i < 64; ++i) scr[i * 65 + lane] = src[(size_t)i * 256 + lane];
        __builtin_amdgcn_s_waitcnt(0xC07F); asm volatile("" ::: "memory");
        bf16* dst = (bf16*)(ws + WS_VTS) + ((size_t)(b * 4 + g) * 64) * LS + kb * 64 + lane;
#pragma unroll 8
        for (int d = 0; d < 64; ++d) dst[(size_t)d * LS] = (bf16)f2bf(scr[lane * 65 + d]);
        __builtin_amdgcn_s_waitcnt(0xC07F); asm volatile("" ::: "memory");
    }
}

__device__ __forceinline__ void p2_post(const Args& a, unsigned char* lds, int tid) {
    unsigned char* ws = a.ws; float* out = a.out;
    const bf16* ZR = (const bf16*)(ws + WS_ZR); const bf16* ZS = (const bf16*)(ws + WS_ZS);
    bf16* Q = (bf16*)(out + SC_Q); bf16* QI = (bf16*)(out + SC_QI);
    float* cs = (float*)lds;
    bf16* vt = (bf16*)(lds + 4096);
    const int g8 = tid >> 3, sub = tid & 7;
    const float* qg = a.in[9]; const float* kg = a.in[10]; const float* lng = a.in[11]; const float* lnb = a.in[12];
    for (int tile = blockIdx.x; tile < MT / 64; tile += gridDim.x) {
        const int m0 = tile * 64;
        { const int m = m0 + g8, pos = (m < MP) ? (m & (T_P - 1)) : (PAST + ((m - MP) & (T_S - 1)));
          const float inv = powf(500000.0f, -(float)sub * 0.125f); const float ang = (float)pos * inv; float s, c; sincosf(ang, &s, &c);
          cs[g8 * 16 + sub] = c; cs[g8 * 16 + 8 + sub] = s; }
        __syncthreads();
        const int m = m0 + g8;
        const bool isp = m < MP; const int ms = m - MP;
        float cc[8], ss[8];
#pragma unroll
        for (int j = 0; j < 8; ++j) { cc[j] = cs[g8 * 16 + j]; ss[j] = cs[g8 * 16 + 8 + j]; }
        const size_t kvrow = isp ? (size_t)m : ((size_t)(ms >> 5) * LS + PAST + (ms & 31));
        bf16* KB = (bf16*)(ws + (isp ? WS_KBP : WS_KBS)); bf16* KIb = (bf16*)(ws + (isp ? WS_KIP : WS_KIS));
        for (int hb = 0; hb < 25; ++hb) {
            float x[8]; unpack8(*(const u32x4*)(ZR + (size_t)m * ZRW + hb * 64 + 8 * sub), x);
            if (hb < 12) {
                float s2 = 0.f;
#pragma unroll
                for (int j = 0; j < 8; ++j) s2 += x[j] * x[j];
                s2 += __shfl_xor(s2, 1); s2 += __shfl_xor(s2, 2); s2 += __shfl_xor(s2, 4);
                const float rinv = rsqrtf(s2 * (1.f / 64.f) + 1e-6f); const float* gn = (hb < 8 ? qg : kg) + 8 * sub;
                float y[8], o[8];
#pragma unroll
                for (int j = 0; j < 8; ++j) y[j] = x[j] * rinv * gn[j];
#pragma unroll
                for (int j = 0; j < 8; ++j) { const float p = __shfl_xor(y[j], 1); o[j] = sub == 0 ? y[j] * cc[j] - p * ss[j] : (sub == 1 ? y[j] * cc[j] + p * ss[j] : y[j]); }
                if (hb < 8) {
#pragma unroll
                    for (int j = 0; j < 8; ++j) o[j] *= QSCALE;
                    *(u32x4*)(Q + (size_t)m * 512 + hb * 64 + 8 * sub) = pack8(o);
                } else { const int g = hb - 8;
                    float* ko = out + (isp ? OFF_KP + (size_t)m * 256 : OFF_KS + (size_t)ms * 256) + g * 64 + 8 * sub;
                    *(f32x4*)ko = (f32x4){o[0], o[1], o[2], o[3]}; *(f32x4*)(ko + 4) = (f32x4){o[4], o[5], o[6], o[7]};
                    *(u32x4*)(KB + kvrow * 256 + g * 64 + 8 * sub) = pack8(o); }
            } else if (hb < 16) { const int g = hb - 12;
                float* vo = out + (isp ? OFF_VP + (size_t)m * 256 : OFF_VS + (size_t)ms * 256) + g * 64 + 8 * sub;
                *(f32x4*)vo = (f32x4){x[0], x[1], x[2], x[3]}; *(f32x4*)(vo + 4) = (f32x4){x[4], x[5], x[6], x[7]};
                unsigned* vd = (unsigned*)(vt + g8 * 258 + g * 64 + 8 * sub);
                vd[0] = pk2(x[0], x[1]); vd[1] = pk2(x[2], x[3]); vd[2] = pk2(x[4], x[5]); vd[3] = pk2(x[6], x[7]);
            } else if (hb < 24) {
                float o[8];
#pragma unroll
                for (int j = 0; j < 8; ++j) { const float p = __shfl_xor(x[j], 1); o[j] = sub == 0 ? x[j] * cc[j] - p * ss[j] : (sub == 1 ? x[j] * cc[j] + p * ss[j] : x[j]); }
                *(u32x4*)(QI + (size_t)m * 512 + (hb - 16) * 64 + 8 * sub) = pack8(o);
            } else {
                float s1 = 0.f;
#pragma unroll
                for (int j = 0; j < 8; ++j) s1 += x[j];
                s1 += __shfl_xor(s1, 1); s1 += __shfl_xor(s1, 2); s1 += __shfl_xor(s1, 4);
                const float mu = s1 * (1.f / 64.f); float s2 = 0.f;
#pragma unroll
                for (int j = 0; j < 8; ++j) { const float d = x[j] - mu; s2 += d * d; }
                s2 += __shfl_xor(s2, 1); s2 += __shfl_xor(s2, 2); s2 += __shfl_xor(s2, 4);
                const float rinv = rsqrtf(s2 * (1.f / 64.f) + 1e-6f); float y[8], o[8];
#pragma unroll
                for (int j = 0; j < 8; ++j) y[j] = (x[j] - mu) * rinv * lng[8 * sub + j] + lnb[8 * sub + j];
#pragma unroll
                for (int j = 0; j < 8; ++j) { const float p = __shfl_xor(y[j], 1); o[j] = sub == 0 ? y[j] * cc[j] - p * ss[j] : (sub == 1 ? y[j] * cc[j] + p * ss[j] : y[j]); }
                float* ko = out + (isp ? OFF_KIP + (size_t)m * 64 : OFF_KIS + (size_t)ms * 64) + 8 * sub;
                *(f32x4*)ko = (f32x4){o[0], o[1], o[2], o[3]}; *(f32x4*)(ko + 4) = (f32x4){o[4], o[5], o[6], o[7]};
                *(u32x4*)(KIb + kvrow * 64 + 8 * sub) = pack8(o);
            }
        }
        ((float*)(ws + WS_WI))[(size_t)m * 8 + sub] = bf1(ZR[(size_t)m * ZRW + 1600 + sub]) * WISCALE;
        __syncthreads();
        { const int r = tid >> 1, half = tid & 1; unsigned wv[16];
#pragma unroll
          for (int j = 0; j < 16; ++j) wv[j] = (unsigned)vt[(32 * half + 2 * j) * 258 + r] | ((unsigned)vt[(32 * half + 2 * j + 1) * 258 + r] << 16);
          bf16* dst;
          if (m0 < MP) dst = (bf16*)(ws + WS_VTP) + ((size_t)(m0 >> 11) * 256 + r) * T_P + (m0 & (T_P - 1)) + 32 * half;
          else { const int b = ((m0 - MP) >> 5) + half; dst = (bf16*)(ws + WS_VTS) + ((size_t)b * 256 + r) * LS + PAST; }
#pragma unroll
          for (int j = 0; j < 4; ++j) ((u32x4*)dst)[j] = (u32x4){wv[4 * j], wv[4 * j + 1], wv[4 * j + 2], wv[4 * j + 3]}; }
        if (m0 < MP) { if ((m0 & (T_P - 1)) == T_P - 64) { const int b = m0 >> 11; const bf16* zr = ZS + (size_t)(m0 + 63) * SHIFTW;
                for (int c = tid; c < SHIFTW; c += 512) out[OFF_SHP + (size_t)b * SHIFTW + c] = bf1(zr[c]); } }
        else { for (int h2 = 0; h2 < 2; ++h2) { const int b = ((m0 - MP) >> 5) + h2; const bf16* zr = ZS + (size_t)(m0 + 32 * h2 + 31) * SHIFTW;
                for (int c = tid; c < SHIFTW; c += 512) out[OFF_SHS + (size_t)b * SHIFTW + c] = bf1(zr[c]); } }
        __syncthreads();
    }
}

constexpr int ATT_UNITS = 544;
constexpr int MASK_PITCH = 65;
#define MFMA32(a, b, c) __builtin_amdgcn_mfma_f32_32x32x16_bf16((a), (b), (c), 0, 0, 0)

__device__ __forceinline__ float half_sum32(float v) { v += __shfl_xor(v, 1); v += __shfl_xor(v, 2); v += __shfl_xor(v, 4); v += __shfl_xor(v, 8); v += __shfl_xor(v, 16); return v; }
__device__ __forceinline__ float half_min32(float v) { v = fminf(v, __shfl_xor(v, 1)); v = fminf(v, __shfl_xor(v, 2)); v = fminf(v, __shfl_xor(v, 4)); v = fminf(v, __shfl_xor(v, 8)); v = fminf(v, __shfl_xor(v, 16)); return v; }
__device__ __forceinline__ float half_max32(float v) { v = fmaxf(v, __shfl_xor(v, 1)); v = fmaxf(v, __shfl_xor(v, 2)); v = fmaxf(v, __shfl_xor(v, 4)); v = fmaxf(v, __shfl_xor(v, 8)); v = fmaxf(v, __shfl_xor(v, 16)); return v; }
__device__ __forceinline__ int half_sum32i(int v) { v += __shfl_xor(v, 1); v += __shfl_xor(v, 2); v += __shfl_xor(v, 4); v += __shfl_xor(v, 8); v += __shfl_xor(v, 16); return v; }

#define LAS3 __attribute__((address_space(3)))
constexpr int A_RING1 = 0, A_SCL = 24576, A_RING2 = 24576, A_MASK = 0, A_LSUM = 8320, A_UNIT = 9344;
__device__ __forceinline__ void p3_attention(const Args& a, unsigned char* lds, int tid, int rep) {
    unsigned char* ws = a.ws; float* out = a.out;
    const bf16* Q = (const bf16*)(out + SC_Q); const bf16* QI = (const bf16*)(out + SC_QI); const float* WI = (const float*)(ws + WS_WI);
    bf16* O = (bf16*)(ws + WS_XB);
    unsigned* maskw = (unsigned*)(lds + A_MASK);
    float* lsum = (float*)(lds + A_LSUM);
    int* s_unit = (int*)(lds + A_UNIT);
    typedef float f32x2_t __attribute__((ext_vector_type(2)));
    f32x2_t* scl = (f32x2_t*)(lds + A_SCL) + (size_t)(tid >> 6) * 2048 + (tid & 63);
    unsigned* qctr = (unsigned*)(ws + WS_CTL) + CW_QATT + 64 * rep;
    const int l = tid & 63, w = __builtin_amdgcn_readfirstlane(tid >> 6), rho = l & 31, hi = l >> 5;
    LAS3 unsigned char* ldsb = (LAS3 unsigned char*)lds;
    for (;;) {
        if (tid == 0) *s_unit = (int)atomicAdd(qctr, 1u);
        __syncthreads();
        const int p = *s_unit;
        __syncthreads();
        if (p >= ATT_UNITS) break;
        int m0, nkt, vpitch; const bf16 *KB, *VT, *KI; bool need_idx;
        { int c = -1, b, half = 0;
          if (p < 256) { c = 31 - (p >> 4); b = (p & 15) >> 1; half = p & 1; }
          else if (p < 288) { b = p - 256; }
          else { const int pp = p - 288; c = 15 - (pp >> 4); b = (pp & 15) >> 1; half = pp & 1; }
          if (c >= 0) { m0 = b * T_P + 64 * c + 32 * half; nkt = 2 * (c + 1); vpitch = T_P; need_idx = c >= 4;
              KB = (const bf16*)(ws + WS_KBP) + (size_t)b * T_P * 256; VT = (const bf16*)(ws + WS_VTP) + (size_t)b * 256 * T_P; KI = (const bf16*)(ws + WS_KIP) + (size_t)b * T_P * 64; }
          else { m0 = MP + 32 * b; nkt = LS / 32; vpitch = LS; need_idx = true;
              KB = (const bf16*)(ws + WS_KBS) + (size_t)b * LS * 256; VT = (const bf16*)(ws + WS_VTS) + (size_t)b * 256 * LS; KI = (const bf16*)(ws + WS_KIS) + (size_t)b * LS * 64; } }
        if (need_idx) {
            const int tokA = 4 * w + 2 * ((rho >> 2) & 1) + (rho >> 4), headA = (rho & 3) + 4 * ((rho >> 3) & 1);
            bf16x8 qa[4];
#pragma unroll
            for (int ks = 0; ks < 4; ++ks) qa[ks] = *(const bf16x8*)(QI + (size_t)(m0 + tokA) * 512 + headA * 64 + 16 * ks + 8 * hi);
            float wv[16];
#pragma unroll
            for (int r = 0; r < 16; ++r) wv[r] = WI[(size_t)(m0 + 4 * w + 2 * hi + (r >> 3)) * 8 + (r & 7)];
            asm volatile("" :: "v"(qa[0]), "v"(qa[1]), "v"(qa[2]), "v"(qa[3]));
#pragma unroll
            for (int r = 0; r < 16; ++r) asm volatile("" :: "v"(wv[r]));
            asm volatile("s_waitcnt vmcnt(0)" ::: "memory");
            float sc0[32], sc1[32];
            const int nb = (nkt + 1) >> 1;
            const int sr = 8 * w + (l >> 3), scn = (l & 7) ^ ((sr >> 1) & 7);
            const unsigned char* ksrc = (const unsigned char*)KI + (size_t)sr * 128 + 16 * scn;
#define KI_STAGE(it_) __builtin_amdgcn_global_load_lds((const unsigned*)(ksrc + (size_t)(it_) * 8192), (LAS3 unsigned*)(ldsb + A_RING1 + ((it_) % 3) * 8192 + w * 1024), 16, 0, 0)
            KI_STAGE(0); if (1 < nb) KI_STAGE(1);
#pragma unroll
            for (int it = 0; it < 32; ++it) {
                if (it < nb) {
                    if (it + 1 < nb) asm volatile("s_waitcnt vmcnt(1) lgkmcnt(0)\n\ts_barrier" ::: "memory"); else asm volatile("s_waitcnt vmcnt(0) lgkmcnt(0)\n\ts_barrier" ::: "memory");
                    if (it + 2 < nb) KI_STAGE(it + 2);
                    const unsigned char* tb = lds + A_RING1 + (it % 3) * 8192;
#pragma unroll
                    for (int k2 = 0; k2 < 2; ++k2) { const int kt = 2 * it + k2;
                        if (kt < nkt) {
                            const int r = 32 * k2 + rho; const unsigned char* rowp = tb + r * 128; const int sw = (r >> 1) & 7;
                            f32x16 acc = {0.f, 0.f, 0.f, 0.f, 0.f, 0.f, 0.f, 0.f, 0.f, 0.f, 0.f, 0.f, 0.f, 0.f, 0.f, 0.f};
#pragma unroll
                            for (int ks = 0; ks < 4; ++ks) acc = MFMA32(qa[ks], *(const bf16x8*)(rowp + 16 * ((2 * ks + hi) ^ sw)), acc);
                            float s0 = 0.f, s1 = 0.f;
#pragma unroll
                            for (int r2 = 0; r2 < 8; ++r2) { s0 += wv[r2] * fmaxf(acc[r2], 0.f); s1 += wv[8 + r2] * fmaxf(acc[8 + r2], 0.f); }
                            if (kt < 32) { sc0[kt & 31] = s0; sc1[kt & 31] = s1; } else scl[(kt - 32) * 64] = (f32x2_t){s0, s1};
                        } else if (kt < 32) { sc0[kt & 31] = -3.0e38f; sc1[kt & 31] = -3.0e38f; }
                    }
                } else { if (2 * it < 32) { sc0[(2 * it) & 31] = -3.0e38f; sc1[(2 * it) & 31] = -3.0e38f; sc0[(2 * it + 1) & 31] = -3.0e38f; sc1[(2 * it + 1) & 31] = -3.0e38f; } }
            }
#undef KI_STAGE
            __syncthreads();
            float mn0 = 3.0e38f, mx0 = -3.0e38f, mn1 = 3.0e38f, mx1 = -3.0e38f;
#pragma unroll
            for (int kt = 0; kt < 64; ++kt) if (kt < nkt) { float v0, v1; if (kt < 32) { v0 = sc0[kt & 31]; v1 = sc1[kt & 31]; } else { const f32x2_t t2 = scl[(kt - 32) * 64]; v0 = t2.x; v1 = t2.y; }
                mn0 = fminf(mn0, v0); mx0 = fmaxf(mx0, v0); mn1 = fminf(mn1, v1); mx1 = fmaxf(mx1, v1); }
            mn0 = half_min32(mn0); mx0 = half_max32(mx0); mn1 = half_min32(mn1); mx1 = half_max32(mx1);
            float lo0 = mn0 - 1.0f, hi0 = mx0, lo1 = mn1 - 1.0f, hi1 = mx1, thr0 = 0.f, thr1 = 0.f; int ch0 = 0, ch1 = 0, nt0 = 0, nt1 = 0; bool fin0 = false, fin1 = false;
            for (int iter = 0; iter < 200; ++iter) {
                const float mid0 = lo0 + 0.5f * (hi0 - lo0), mid1 = lo1 + 0.5f * (hi1 - lo1);
                int c0 = 0, c1 = 0;
#pragma unroll
                for (int g = 0; g < 4; ++g) if (8 * g < nkt) {
#pragma unroll
                    for (int k8 = 0; k8 < 8; ++k8) { c0 += sc0[8 * g + k8] > mid0 ? 1 : 0; c1 += sc1[8 * g + k8] > mid1 ? 1 : 0; } }
                for (int kt = 32; kt < nkt; kt += 8) {
                    f32x2_t t8[8];
#pragma unroll
                    for (int u = 0; u < 8; ++u) t8[u] = scl[(kt + u - 32) * 64];
#pragma unroll
                    for (int u = 0; u < 8; ++u) if (kt + u < nkt) { c0 += t8[u].x > mid0 ? 1 : 0; c1 += t8[u].y > mid1 ? 1 : 0; } }
                c0 = half_sum32i(c0); c1 = half_sum32i(c1);
                if (!fin0) { if (!(mid0 > lo0 && mid0 < hi0)) { fin0 = true; thr0 = hi0; nt0 = 256 - ch0; }
                             else if (c0 == 256) { fin0 = true; thr0 = mid0; nt0 = 0; } else if (c0 > 256) lo0 = mid0; else { hi0 = mid0; ch0 = c0; } }
                if (!fin1) { if (!(mid1 > lo1 && mid1 < hi1)) { fin1 = true; thr1 = hi1; nt1 = 256 - ch1; }
                             else if (c1 == 256) { fin1 = true; thr1 = mid1; nt1 = 0; } else if (c1 > 256) lo1 = mid1; else { hi1 = mid1; ch1 = c1; } }
                if (__all(fin0 && fin1)) break;
            }
            const bool any_tie = __any(nt0 > 0 || nt1 > 0);
            int run0 = 0, run1 = 0; const unsigned below = (1u << rho) - 1u;
#pragma unroll
            for (int kt = 0; kt < 64; ++kt) if (kt < nkt) {
                float v0, v1; if (kt < 32) { v0 = sc0[kt & 31]; v1 = sc1[kt & 31]; } else { const f32x2_t t2 = scl[(kt - 32) * 64]; v0 = t2.x; v1 = t2.y; }
                bool p0 = v0 > thr0, p1 = v1 > thr1;
                if (any_tie) {
                    const bool e0 = nt0 > 0 && v0 == thr0, e1 = nt1 > 0 && v1 == thr1;
                    const unsigned long long be0 = __ballot(e0), be1 = __ballot(e1);
                    const unsigned h0 = (unsigned)(be0 >> (32 * hi)), h1 = (unsigned)(be1 >> (32 * hi));
                    p0 = p0 || (e0 && (run0 + __popc(h0 & below)) < nt0); p1 = p1 || (e1 && (run1 + __popc(h1 & below)) < nt1);
                    run0 += __popc(h0); run1 += __popc(h1);
                }
                const unsigned long long b0 = __ballot(p0), b1 = __ballot(p1);
                if (l == 0) { maskw[(4 * w + 0) * MASK_PITCH + kt] = (unsigned)b0; maskw[(4 * w + 1) * MASK_PITCH + kt] = (unsigned)b1; }
                if (l == 32) { maskw[(4 * w + 2) * MASK_PITCH + kt] = (unsigned)(b0 >> 32); maskw[(4 * w + 3) * MASK_PITCH + kt] = (unsigned)(b1 >> 32); }
            }
        }
        __syncthreads();
        {
            const int g = w >> 1;
            bf16x8 qb[4];
#pragma unroll
            for (int ks = 0; ks < 4; ++ks) qb[ks] = *(const bf16x8*)(Q + (size_t)(m0 + rho) * 512 + w * 64 + 16 * ks + 8 * hi);
            asm volatile("" :: "v"(qb[0]), "v"(qb[1]), "v"(qb[2]), "v"(qb[3]));
            asm volatile("s_waitcnt vmcnt(0)" ::: "memory");
            const unsigned char* ksrc[2]; const unsigned char* vsrc[2];
#pragma unroll
            for (int k = 0; k < 2; ++k) { const int i = (k * 8 + w) * 64 + l; const int r = i >> 5, c = i & 31; ksrc[k] = (const unsigned char*)KB + (size_t)r * 512 + 16 * (c ^ (r & 15));
                const int R = i >> 2, cv = i & 3; vsrc[k] = (const unsigned char*)VT + (size_t)R * vpitch * 2 + 16 * (cv ^ ((R >> 2) & 3)); }
#define KV_STAGE(t_) do { const int bo_ = A_RING2 + ((t_) % 3) * 32768 + w * 1024; \
            __builtin_amdgcn_global_load_lds((const unsigned*)(ksrc[0] + (size_t)(t_) * 16384), (LAS3 unsigned*)(ldsb + bo_), 16, 0, 0); \
            __builtin_amdgcn_global_load_lds((const unsigned*)(ksrc[1] + (size_t)(t_) * 16384), (LAS3 unsigned*)(ldsb + bo_ + 8192), 16, 0, 0); \
            __builtin_amdgcn_global_load_lds((const unsigned*)(vsrc[0] + (size_t)(t_) * 64), (LAS3 unsigned*)(ldsb + bo_ + 16384), 16, 0, 0); \
            __builtin_amdgcn_global_load_lds((const unsigned*)(vsrc[1] + (size_t)(t_) * 64), (LAS3 unsigned*)(ldsb + bo_ + 24576), 16, 0, 0); } while (0)
            f32x16 o0 = {0.f, 0.f, 0.f, 0.f, 0.f, 0.f, 0.f, 0.f, 0.f, 0.f, 0.f, 0.f, 0.f, 0.f, 0.f, 0.f}, o1 = o0; float psum = 0.f;
            const int ksw = rho & 15;
            const int vR0 = g * 64 + rho, vR1 = vR0 + 32; const int vs0 = (vR0 >> 2) & 3, vs1 = (vR1 >> 2) & 3;
            KV_STAGE(0); if (1 < nkt) KV_STAGE(1);
            for (int kt = 0; kt < nkt; ++kt) {
                if (kt + 1 < nkt) asm volatile("s_waitcnt vmcnt(4) lgkmcnt(0)\n\ts_barrier" ::: "memory"); else asm volatile("s_waitcnt vmcnt(0) lgkmcnt(0)\n\ts_barrier" ::: "memory");
                if (kt + 2 < nkt) KV_STAGE(kt + 2);
                const unsigned char* kbuf = lds + A_RING2 + (kt % 3) * 32768; const unsigned char* vbuf = kbuf + 16384;
                f32x16 st = {0.f, 0.f, 0.f, 0.f, 0.f, 0.f, 0.f, 0.f, 0.f, 0.f, 0.f, 0.f, 0.f, 0.f, 0.f, 0.f};
#pragma unroll
                for (int ks = 0; ks < 4; ++ks) st = MFMA32(*(const bf16x8*)(kbuf + rho * 512 + 16 * ((g * 8 + 2 * ks + hi) ^ ksw)), qb[ks], st);
                unsigned word = need_idx ? maskw[rho * MASK_PITCH + kt] : 0xffffffffu; word >>= 4 * hi; float pr[16];
#pragma unroll
                for (int r = 0; r < 16; ++r) { const float e = __builtin_amdgcn_exp2f(st[r]); pr[r] = ((word >> ((r & 3) + 8 * (r >> 2))) & 1u) ? e : 0.f; psum += pr[r]; }
                union { u32x4 u; bf16x8 v; } pa0, pa1; pa0.u = (u32x4){pg8::cvt_pk_bf16(pr[0], pr[1]), pg8::cvt_pk_bf16(pr[2], pr[3]), pg8::cvt_pk_bf16(pr[4], pr[5]), pg8::cvt_pk_bf16(pr[6], pr[7])}; pa1.u = (u32x4){pg8::cvt_pk_bf16(pr[8], pr[9]), pg8::cvt_pk_bf16(pr[10], pr[11]), pg8::cvt_pk_bf16(pr[12], pr[13]), pg8::cvt_pk_bf16(pr[14], pr[15])};
                union { u32x4 u; bf16x8 v; } vf[2][2];
#pragma unroll
                for (int s2 = 0; s2 < 2; ++s2) { const unsigned char* r0 = vbuf + vR0 * 64 + 8 * hi; const unsigned char* r1 = vbuf + vR1 * 64 + 8 * hi;
                    const u32x2 a0 = *(const u32x2*)(r0 + 16 * ((2 * s2) ^ vs0)), a1 = *(const u32x2*)(r0 + 16 * ((2 * s2 + 1) ^ vs0)), b0 = *(const u32x2*)(r1 + 16 * ((2 * s2) ^ vs1)), b1 = *(const u32x2*)(r1 + 16 * ((2 * s2 + 1) ^ vs1));
                    vf[s2][0].u = (u32x4){a0.x, a0.y, a1.x, a1.y}; vf[s2][1].u = (u32x4){b0.x, b0.y, b1.x, b1.y}; }
                o0 = MFMA32(pa0.v, vf[0][0].v, o0); o0 = MFMA32(pa1.v, vf[1][0].v, o0); o1 = MFMA32(pa0.v, vf[0][1].v, o1); o1 = MFMA32(pa1.v, vf[1][1].v, o1);
            }
#undef KV_STAGE
            psum += __shfl_xor(psum, 32);
            if (hi == 0) lsum[w * 32 + rho] = psum;
            __syncthreads();
#pragma unroll
            for (int r = 0; r < 16; ++r) { const int qr = crow(r, hi); const float inv = 1.0f / lsum[w * 32 + qr];
                bf16* op = O + (size_t)(m0 + qr) * DM + w * 64 + rho;
                op[0] = (bf16)f2bf(o0[r] * inv); op[32] = (bf16)f2bf(o1[r] * inv); }
        }
        __syncthreads();
    }
}

constexpr int XS_PITCH = 168;
__device__ __forceinline__ void p4_rwkv_prep(const Args& a, unsigned char* lds, int tid) {
    unsigned char* ws = a.ws; float* out = a.out;
    const bf16* ZS = (const bf16*)(ws + WS_ZS);
    const bf16* w2t = (const bf16*)(ws + WS_W2T); const bf16* a2t = (const bf16*)(ws + WS_A2T); const bf16* g2t = (const bf16*)(ws + WS_G2T);
    float* OW = (float*)(ws + WS_OW); bf16* OKK = (bf16*)(ws + WS_OKK); bf16* OB = (bf16*)(ws + WS_OB); bf16* OKM = (bf16*)(ws + WS_OKM); bf16* OR_ = (bf16*)(ws + WS_OR); bf16* OV = (bf16*)(ws + WS_OV);
    bf16* G = (bf16*)(out + SC_G); float* BON = (float*)(ws + WS_BONUS);
    const float* mu = a.in[13]; const float* w0 = a.in[14]; const float* a0 = a.in[16]; const float* k_k = a.in[19]; const float* k_a = a.in[20]; const float* r_k = a.in[21]; const float* sh0 = a.in[6];
    bf16* xs = (bf16*)lds;
    const int l = tid & 63, h = __builtin_amdgcn_readfirstlane(tid >> 6), rho = l & 31, hi = l >> 5;
    for (int tile = blockIdx.x; tile < MT / 32; tile += gridDim.x) {
        const int m0 = tile * 32; const bool smp = m0 >= MP;
        const bool tile_first = smp || (m0 & (T_P - 1)) == 0;
        { const int tk = tid >> 4, c0 = (tid & 15) * 10, m = m0 + tk; const bool first = tile_first && tk == 0;
          const bf16* zc = ZS + (size_t)m * SHIFTW + 1536 + c0; const bf16* zp = first ? zc : zc - SHIFTW;
          const float* shp = sh0 + (size_t)(smp ? ((m0 - MP) >> 5) : 0) * SHIFTW + 1536 + c0;
#pragma unroll
          for (int e = 0; e < 10; ++e) { const int c = c0 + e; const float cur = bf1(zc[e]); float prev = bf1(zp[e]);
              if (first) prev = smp ? shp[e] : 0.f;
              const float zm = cur + mu[1536 + c] * (prev - cur);
              const float f = __frcp_rn(1.0f + __expf(c < 32 ? -2.0f * zm : -zm));
              const float v = c < 32 ? 2.0f * f - 1.0f : (c < 64 ? zm : f);
              xs[tk * XS_PITCH + c] = (bf16)f2bf(v); } }
        __syncthreads();
        const int m = m0 + rho; const bool first = tile_first && rho == 0;
        const bf16* zc = ZS + (size_t)m * SHIFTW + 64 * h + 4 * hi; const bf16* zp = first ? zc : zc - SHIFTW;
        const float* shp = sh0 + (size_t)(smp ? ((m0 - MP) >> 5) : 0) * SHIFTW + 64 * h + 4 * hi;
        const float* mu_l = mu + 64 * h + 4 * hi;
        const int pofs = 64 * h + 4 * hi;
#define ZMIX4(dst, co) do { const u32x2 cw = *(const u32x2*)(zc + (co)); const u32x2 pw = *(const u32x2*)(zp + (co)); const f32x4 mu4 = *(const f32x4*)(mu_l + (co)); \
            const float cu[4] = {bflo(cw.x), bfhi(cw.x), bflo(cw.y), bfhi(cw.y)}; float pv[4] = {bflo(pw.x), bfhi(pw.x), bflo(pw.y), bfhi(pw.y)}; \
            if (tile_first) { f32x4 s4 = {0.f, 0.f, 0.f, 0.f}; if (smp) s4 = *(const f32x4*)(shp + (co)); if (first) { pv[0] = s4.x; pv[1] = s4.y; pv[2] = s4.z; pv[3] = s4.w; } } \
            _Pragma("unroll") for (int e = 0; e < 4; ++e) dst[e] = cu[e] + mu4[e] * (pv[e] - cu[e]); } while (0)
        float n2 = 0.f;
#pragma unroll
        for (int ct = 0; ct < 2; ++ct)
#pragma unroll
            for (int grp = 0; grp < 4; ++grp) { const int co = 32 * ct + 8 * grp; float zk[4]; ZMIX4(zk, 512 + co); const f32x4 kk4 = *(const f32x4*)(k_k + pofs + co);
#pragma unroll
                for (int e = 0; e < 4; ++e) { const float kr = zk[e] * kk4[e]; n2 += kr * kr; } }
        n2 += __shfl_xor(n2, 32);
        const float invn = 1.0f / fmaxf(sqrtf(n2), 1e-12f);
        float bon = 0.f;
        asm volatile("" ::: "memory");
#pragma unroll
        for (int ct = 0; ct < 2; ++ct) {
            const f32x16 z16 = {0.f, 0.f, 0.f, 0.f, 0.f, 0.f, 0.f, 0.f, 0.f, 0.f, 0.f, 0.f, 0.f, 0.f, 0.f, 0.f}; f32x16 Dw = z16, Da = z16, Dg = z16;
            const int n = 64 * h + 32 * ct + rho;
            const bf16* xrow = xs + rho * XS_PITCH + 8 * hi;
#pragma unroll
            for (int ks = 0; ks < 2; ++ks) {
                Dw = MFMA32(*(const bf16x8*)(w2t + n * 32 + 16 * ks + 8 * hi), *(const bf16x8*)(xrow + 16 * ks), Dw);
                Da = MFMA32(*(const bf16x8*)(a2t + n * 32 + 16 * ks + 8 * hi), *(const bf16x8*)(xrow + 32 + 16 * ks), Da); }
#pragma unroll
            for (int ks = 0; ks < 6; ++ks) Dg = MFMA32(*(const bf16x8*)(g2t + n * 96 + 16 * ks + 8 * hi), *(const bf16x8*)(xrow + 64 + 16 * ks), Dg);
#pragma unroll
            for (int grp = 0; grp < 4; ++grp) {
                const int co = 32 * ct + 8 * grp;
                float zr[4], zk[4], zv[4]; ZMIX4(zr, co); ZMIX4(zk, 512 + co); ZMIX4(zv, 1024 + co);
                const f32x4 w04 = *(const f32x4*)(w0 + pofs + co), a04 = *(const f32x4*)(a0 + pofs + co), kk4 = *(const f32x4*)(k_k + pofs + co), ka4 = *(const f32x4*)(k_a + pofs + co), rk4 = *(const f32x4*)(r_k + pofs + co);
                float dec[4], km[4], gg[4], kk[4], bb[4];
#pragma unroll
                for (int e = 0; e < 4; ++e) { const int r = 4 * grp + e;
                    const float sg = __frcp_rn(1.0f + __expf(-(w04[e] + Dw[r])));
                    dec[e] = __expf(-0.6065306597126334f * sg);
                    const float aa = __frcp_rn(1.0f + __expf(-(a04[e] + Da[r])));
                    gg[e] = Dg[r];
                    kk[e] = zk[e] * kk4[e] * invn; bb[e] = kk[e] * aa;
                    km[e] = zk[e] * (1.0f + (aa - 1.0f) * ka4[e]);
                    bon += zr[e] * km[e] * rk4[e]; }
                const size_t o = (size_t)m * 512 + pofs + co;
                *(f32x4*)(OW + o) = (f32x4){dec[0], dec[1], dec[2], dec[3]};
                *(u32x2*)(OKK + o) = (u32x2){pk2(kk[0], kk[1]), pk2(kk[2], kk[3])};
                *(u32x2*)(OB + o) = (u32x2){pk2(bb[0], bb[1]), pk2(bb[2], bb[3])};
                *(u32x2*)(OKM + o) = (u32x2){pk2(km[0], km[1]), pk2(km[2], km[3])};
                *(u32x2*)(OR_ + o) = (u32x2){pk2(zr[0], zr[1]), pk2(zr[2], zr[3])};
                *(u32x2*)(OV + o) = (u32x2){pk2(zv[0], zv[1]), pk2(zv[2], zv[3])};
                *(u32x2*)(G + o) = (u32x2){pk2(gg[0], gg[1]), pk2(gg[2], gg[3])};
                asm volatile("" ::: "memory");
            }
        }
#undef ZMIX4
        bon += __shfl_xor(bon, 32);
        if (hi == 0) BON[(size_t)m * 8 + h] = bon;
        __syncthreads();
    }
}

constexpr int SC_CH = 32;
static_assert(WS_OB - WS_OKK == 17 * MiB && WS_OKM - WS_OB == 17 * MiB && WS_OR - WS_OKM == 17 * MiB && WS_OV - WS_OR == 17 * MiB, "operand arrays are equally spaced");
__device__ __forceinline__ void cvt_store8(unsigned char* d, const u32x4 x) {
    *(u32x4*)d = (u32x4){x.x << 16, x.x & 0xffff0000u, x.y << 16, x.y & 0xffff0000u}; *(u32x4*)(d + 16) = (u32x4){x.z << 16, x.z & 0xffff0000u, x.w << 16, x.w & 0xffff0000u};
}
struct StageP {
    static constexpr int STRIDE = 1280 + 64;
    const unsigned char* pw; const unsigned char* pb; int vrow0;
    u32x4 v[25];
    __device__ __forceinline__ void issue(int t0, int lane) {
        const unsigned char* gw = pw + ((size_t)(t0 + (lane >> 4)) * 512) * 4 + 16 * (lane & 15);
#pragma unroll
        for (int j = 0; j < 8; ++j) v[j] = *(const u32x4*)(gw + (size_t)j * 4 * 512 * 4);
        const unsigned char* gb = pb + ((size_t)(t0 + (lane >> 3)) * 512) * 2 + 16 * (lane & 7);
#pragma unroll
        for (int a = 0; a < 4; ++a)
#pragma unroll
            for (int jj = 0; jj < 4; ++jj) v[8 + 4 * a + jj] = *(const u32x4*)(gb + (size_t)a * (17 * MiB) + (size_t)jj * 8 * 512 * 2);
        v[24] = *(const u32x4*)(pb + (size_t)4 * (17 * MiB) + ((size_t)(t0 + (lane >> 1)) * 512) * 2 + 2 * vrow0 + 16 * (lane & 1));
    }
    __device__ __forceinline__ void commit(unsigned char* buf, int lane) const {
        unsigned char* dw = buf + (lane >> 4) * STRIDE + 16 * (lane & 15);
#pragma unroll
        for (int j = 0; j < 8; ++j) *(u32x4*)(dw + j * 4 * STRIDE) = v[j];
        unsigned char* db = buf + (lane >> 3) * STRIDE + 256 + 32 * (lane & 7);
#pragma unroll
        for (int a = 0; a < 4; ++a)
#pragma unroll
            for (int jj = 0; jj < 4; ++jj) cvt_store8(db + a * 256 + jj * 8 * STRIDE, v[8 + 4 * a + jj]);
        cvt_store8(buf + (lane >> 1) * STRIDE + 1280 + 32 * (lane & 1), v[24]);
    }
};
struct StageS {
    static constexpr int STRIDE = 1280 + 256;
    const unsigned char* pw; const unsigned char* pb;
    u32x4 v[7];
    __device__ __forceinline__ void issue(int t0, int lane) {
        const unsigned char* gw = pw + ((size_t)(t0 + (lane >> 4)) * 512) * 4 + 16 * (lane & 15);
        v[0] = *(const u32x4*)gw; v[1] = *(const u32x4*)(gw + (size_t)4 * 512 * 4);
        const unsigned char* gb = pb + ((size_t)(t0 + (lane >> 3)) * 512) * 2 + 16 * (lane & 7);
#pragma unroll
        for (int a = 0; a < 5; ++a) v[2 + a] = *(const u32x4*)(gb + (size_t)a * (17 * MiB));
    }
    __device__ __forceinline__ void commit(unsigned char* buf, int lane) const {
        unsigned char* dw = buf + (lane >> 4) * STRIDE + 16 * (lane & 15);
        *(u32x4*)dw = v[0]; *(u32x4*)(dw + 4 * STRIDE) = v[1];
        unsigned char* db = buf + (lane >> 3) * STRIDE + 256 + 32 * (lane & 7);
#pragma unroll
        for (int a = 0; a < 5; ++a) cvt_store8(db + a * 256, v[2 + a]);
    }
};
typedef float f32x2 __attribute__((ext_vector_type(2)));
template <int STRIDE> __device__ __forceinline__ void scan_consume(f32x4& S4, const unsigned char* buf, int nst, int ks, int rowl, float* yp) {
    f32x2 Sa = {S4.x, S4.y}, Sb = {S4.z, S4.w};
    for (int s0 = 0; s0 < nst; s0 += 16) {
        float ykeep = 0.f;
#pragma unroll 1
        for (int g = 0; g < 4; ++g) {
            const int kq = ks - 4 * g;
#pragma unroll
            for (int j = 0; j < 4; ++j) {
                const float* p = (const float*)(buf + (s0 + 4 * g + j) * STRIDE) + 4 * ks;
                const f32x2 wa = *(const f32x2*)(p), wb = *(const f32x2*)(p + 2), ka = *(const f32x2*)(p + 64), kb = *(const f32x2*)(p + 66), ba = *(const f32x2*)(p + 128), bb = *(const f32x2*)(p + 130),
                            ma = *(const f32x2*)(p + 192), mb = *(const f32x2*)(p + 194), ra = *(const f32x2*)(p + 256), rb = *(const f32x2*)(p + 258);
                const float v = ((const float*)(buf + (s0 + 4 * g + j) * STRIDE))[320 + rowl];
                f32x2 t = Sa * ka + Sb * kb; float d = t.x + t.y; d = sum16(d);
                const f32x2 vv = {v, v}, dd = {d, d};
                Sa = Sa * wa + (vv * ma - dd * ba); Sb = Sb * wb + (vv * mb - dd * bb);
                f32x2 u = Sa * ra + Sb * rb; float y = u.x + u.y; y = sum16(y);
                ykeep = kq == j ? y : ykeep;
            }
        }
        yp[(size_t)(s0 + ks) * 512] = ykeep;
    }
    S4 = (f32x4){Sa.x, Sa.y, Sb.x, Sb.y};
}
__device__ __forceinline__ void p5_rwkv_scan(const Args& a, unsigned char* lds, int tid) {
    const unsigned char* ws = a.ws; float* out = a.out; float* Y = out + SC_Y;
    const int l = tid & 63, w = __builtin_amdgcn_readfirstlane(tid >> 6), ks = l & 15, rl = l >> 4;
    const int G = gridDim.x, vcu = (G % 8 == 0) ? (blockIdx.x % 8) * (G / 8) + blockIdx.x / 8 : blockIdx.x;
    typedef StageP StP; typedef StageS StS;
    unsigned char* buf0 = lds; unsigned char* buf1 = lds + SC_CH * StP::STRIDE;
    for (int it = vcu; it < 256; it += G) {
        {
            const int bh = it >> 2, b = bh >> 3, h = bh & 7, rb = it & 3, row = 16 * rb + 4 * w + rl;
            const size_t base0 = ((size_t)b * T_P) * 512 + (size_t)h * 64;
            constexpr int NC = T_P / SC_CH;
            StP st; st.pw = ws + WS_OW + base0 * 4; st.pb = ws + WS_OKK + base0 * 2; st.vrow0 = 16 * rb;
            f32x4 S = {0.f, 0.f, 0.f, 0.f};
            if (w >= 4) { if (w == 4) { st.issue(0, l); st.commit(buf0, l); st.issue(4 * SC_CH, l); } else st.issue((w - 4) * SC_CH, l); }
            else __builtin_amdgcn_s_setprio(3);
            __syncthreads();
            Y += base0 + row;
#define SCAN_ITER(c, P, cur, nxt) do { if (w == 4 + (P)) { if ((c) + 1 < NC) { st.commit(nxt, l); if ((c) + 5 < NC) st.issue(((c) + 5) * SC_CH, l); } } \
                else if (w < 4) scan_consume<StP::STRIDE>(S, cur, SC_CH, ks, 4 * w + rl, Y + (size_t)((c) * SC_CH) * 512); __syncthreads(); } while (0)
            for (int c = 0; c < NC; c += 4) { SCAN_ITER(c, 1, buf0, buf1); SCAN_ITER(c + 1, 2, buf1, buf0); SCAN_ITER(c + 2, 3, buf0, buf1); SCAN_ITER(c + 3, 0, buf1, buf0); }
#undef SCAN_ITER
            __builtin_amdgcn_s_setprio(0);
            Y -= base0 + row;
            if (w < 4) *(f32x4*)(out + OFF_WKVP + ((size_t)bh * 64 + row) * 64 + 4 * ks) = S;
        }
        {
            const int b = it >> 3, h = it & 7;
            const size_t base0 = ((size_t)MP + (size_t)b * T_S) * 512 + (size_t)h * 64;
            StS st; st.pw = ws + WS_OW + base0 * 4; st.pb = ws + WS_OKK + base0 * 2;
            if (w >= 4) { st.issue(8 * (w - 4), l); st.commit(buf0 + 8 * (w - 4) * StS::STRIDE, l); }
            __syncthreads();
            for (int pass = 0; pass < 2; ++pass) { const int row = 8 * w + 4 * pass + rl;
                f32x4 S = *(const f32x4*)(a.in[5] + ((size_t)it * 64 + row) * 64 + 4 * ks);
                scan_consume<StS::STRIDE>(S, buf0, T_S, ks, row, Y + base0 + row);
                *(f32x4*)(out + OFF_WKVS + ((size_t)it * 64 + row) * 64 + 4 * ks) = S; }
            __syncthreads();
        }
    }
}

__device__ __forceinline__ void p6_rwkv_out(const Args& a, int tid) {
    const unsigned char* ws = a.ws; const float* out = a.out; const float* Y = out + SC_Y; const bf16* G = (const bf16*)(out + SC_G);
    const bf16* OV = (const bf16*)(ws + WS_OV); const float* BON = (const float*)(ws + WS_BONUS); bf16* O = (bf16*)(a.ws + WS_XB);
    const float* lg = a.in[22]; const float* lb = a.in[23];
    const int sub = tid & 7;
    for (size_t it = (size_t)blockIdx.x * 64 + (tid >> 3); it < (size_t)MT * 8; it += (size_t)gridDim.x * 64) {
        const size_t m = it >> 3; const int h = (int)(it & 7); const size_t o = m * 512 + h * 64 + 8 * sub;
        const f32x4 y0 = *(const f32x4*)(Y + o), y1 = *(const f32x4*)(Y + o + 4); float y[8] = {y0.x, y0.y, y0.z, y0.w, y1.x, y1.y, y1.z, y1.w};
        float s1 = 0.f;
#pragma unroll
        for (int j = 0; j < 8; ++j) s1 += y[j];
        s1 += __shfl_xor(s1, 1); s1 += __shfl_xor(s1, 2); s1 += __shfl_xor(s1, 4);
        const float mean = s1 * (1.f / 64.f); float s2 = 0.f;
#pragma unroll
        for (int j = 0; j < 8; ++j) { const float d = y[j] - mean; s2 += d * d; }
        s2 += __shfl_xor(s2, 1); s2 += __shfl_xor(s2, 2); s2 += __shfl_xor(s2, 4);
        const float rinv = rsqrtf(s2 * (1.f / 64.f) + 64e-5f);
        float v[8], g[8]; unpack8(*(const u32x4*)(OV + o), v); unpack8(*(const u32x4*)(G + o), g);
        const float bon = BON[it]; float r[8];
#pragma unroll
        for (int j = 0; j < 8; ++j) { const int c = h * 64 + 8 * sub + j; r[j] = ((y[j] - mean) * rinv * lg[c] + lb[c] + bon * v[j]) * g[j]; }
        *(u32x4*)(O + m * DM + 512 + h * 64 + 8 * sub) = pack8(r);
    }
}

__device__ __forceinline__ void p8_hnorm(const Args& a, int tid) {
    const int lane = tid & 63, gw = blockIdx.x * 8 + (tid >> 6), NGW = gridDim.x * 8;
    for (int m = gw; m < MT; m += NGW) {
        const f32x4* xr = (const f32x4*)(a.out + OFF_Y + (size_t)m * DM) + lane; f32x4 v[4]; float s = 0.f;
#pragma unroll
        for (int j = 0; j < 4; ++j) { v[j] = xr[64 * j]; s += (v[j].x * v[j].x + v[j].y * v[j].y) + (v[j].z * v[j].z + v[j].w * v[j].w); }
        const float rs = rsqrtf(wave_sum(s) * (1.f / DM) + 1e-6f);
        u32x2* o8 = (u32x2*)((bf16*)(a.ws + WS_HB) + (size_t)m * DM) + lane;
#pragma unroll
        for (int j = 0; j < 4; ++j) { u32x2 o; o.x = pk2(v[j].x * rs, v[j].y * rs); o.y = pk2(v[j].z * rs, v[j].w * rs); o8[64 * j] = o; }
    }
}

#define XB_TMO      128
#define XB_XCNT(j)  (256  + 64 * (j))
#define XB_XSUB(j)  (1280 + 64 * (j))
#define XB_XGEN(j)  (2304 + 64 * (j))
#define XB_TOP      3328
#define XB_TOPGEN   3392
#define XCD_BAR_WORDS 3456
#define XB_SPIN_CAP (1u << 18)

__device__ __forceinline__ unsigned xb_ld(unsigned* p)              { return __hip_atomic_load(p, __ATOMIC_RELAXED, __HIP_MEMORY_SCOPE_AGENT); }
__device__ __forceinline__ unsigned xb_add(unsigned* p, unsigned v) { return __hip_atomic_fetch_add(p, v, __ATOMIC_RELAXED, __HIP_MEMORY_SCOPE_AGENT); }
__device__ __forceinline__ unsigned xb_xcc_id() { return (unsigned)__builtin_amdgcn_s_getreg((3 << 11) | 20) & 0xFu; }
#define XB_SPIN(cond, bar) do { unsigned _sp = 0; while (cond) { __builtin_amdgcn_s_sleep(1); \
    if ((++_sp & 255u) == 0u) { if (xb_ld(&(bar)[XB_TMO])) break; if (_sp > XB_SPIN_CAP) { atomicAdd(&(bar)[XB_TMO], 1u); break; } } } } while (0)

struct XcdBarrier {
    unsigned* bar; unsigned x;
    volatile __attribute__((address_space(3))) unsigned* st;
};

__device__ __forceinline__ XcdBarrier xcd_barrier_post(unsigned* bar, volatile __attribute__((address_space(3))) unsigned* st) {
    XcdBarrier b; b.bar = bar; b.x = xb_xcc_id(); b.st = st;
    if (threadIdx.x == 0) (void)xb_add(&bar[XB_XCNT(b.x)], 1u);
    return b;
}
__device__ __forceinline__ void xcd_barrier_complete(unsigned* bar, unsigned x, unsigned& nloc, unsigned& nx) {
    const unsigned G = gridDim.x * gridDim.y * gridDim.z;
    unsigned sum, cnt, mine, sp = 0u;
    for (;;) {
        sum = 0u; cnt = 0u; mine = 0u;
#pragma unroll
        for (unsigned j = 0; j < 16; ++j) { const unsigned c = xb_ld(&bar[XB_XCNT(j)]); sum += c; cnt += (c > 0u) ? 1u : 0u; mine = (j == x) ? c : mine; }
        if (sum == G) break;
        __builtin_amdgcn_s_sleep(1);
        if ((++sp & 255u) == 0u) { if (xb_ld(&bar[XB_TMO])) break; if (sp > XB_SPIN_CAP) { atomicAdd(&bar[XB_TMO], 1u); break; } }
    }
    nloc = mine > 0u ? mine : 1u; nx = cnt > 0u ? cnt : 1u;
}

__device__ __forceinline__ void xcd_barrier(const XcdBarrier& b) {
    asm volatile("s_waitcnt vmcnt(0)" ::: "memory");
    __syncthreads();
    if (threadIdx.x == 0) {
        unsigned* bar = b.bar;
        __builtin_amdgcn_s_waitcnt(0);
        unsigned nloc = b.st[0], nx = b.st[1];
        if (nloc == 0u) { xcd_barrier_complete(bar, b.x, nloc, nx); b.st[0] = nloc; b.st[1] = nx; }
        const unsigned old = xb_add(&bar[XB_XSUB(b.x)], 1u);
        const unsigned gen = old / nloc;
        if (old + 1u == (gen + 1u) * nloc) {
            __builtin_amdgcn_fence(__ATOMIC_RELEASE, "agent");
            asm volatile("s_waitcnt vmcnt(0)" ::: "memory");
            const unsigned og = xb_add(&bar[XB_TOP], 1u);
            const unsigned tg = og / nx;
            if (og + 1u == (tg + 1u) * nx) xb_add(&bar[XB_TOPGEN], 1u);
            else XB_SPIN(xb_ld(&bar[XB_TOPGEN]) == tg, bar);
            __builtin_amdgcn_fence(__ATOMIC_ACQUIRE, "agent");
            xb_add(&bar[XB_XGEN(b.x)], 1u);
            asm volatile("s_waitcnt vmcnt(0)" ::: "memory");
        } else {
            XB_SPIN(xb_ld(&bar[XB_XGEN(b.x)]) == gen, bar);
            __builtin_amdgcn_fence(__ATOMIC_ACQUIRE, "agent");
            asm volatile("s_waitcnt vmcnt(0)" ::: "memory");
        }
    }
    __syncthreads();
}

constexpr int CW_BAR = 4096;
constexpr int LDS_BYTES = 163840;
constexpr int N_PHASES = 11;
#ifndef PROBE_MASK
#define PROBE_MASK 0
#endif
template <int PH> __device__ __forceinline__ void run_phase(const Args& args, unsigned char* lds, int tid, int rep) {
    unsigned char* ws = args.ws;
    if constexpr (PH == 0) p0_prologue(args, lds, tid);
    if constexpr (PH == 1) { pg8::Gemm g{(const pg8::bf16_t*)(ws + WS_XB), (const pg8::bf16_t*)(ws + WS_WIN), MT, NZ, DM}; pg8::StaticOrder S; S.init(MT, NZ, gridDim.x, blockIdx.x);
        pg8::EpiZ E{(pg8::bf16_t*)(ws + WS_ZR), (pg8::bf16_t*)(ws + WS_ZS)};
        pg8::gemm_phase<pg8::EpiZ, pg8::StaticOrder, true, true>((PG8_LAS unsigned char*)lds, g, S, E); }
    if constexpr (PH == 2) p2_post(args, lds, tid);
    if constexpr (PH == 3) p3_attention(args, lds, tid, rep);
    if constexpr (PH == 4) p4_rwkv_prep(args, lds, tid);
    if constexpr (PH == 5) p5_rwkv_scan(args, lds, tid);
    if constexpr (PH == 6) p6_rwkv_out(args, tid);
    if constexpr (PH == 7) { pg8::Gemm g{(const pg8::bf16_t*)(ws + WS_XB), (const pg8::bf16_t*)(ws + WS_WOUT), MT, DM, DM}; pg8::StaticOrder S; S.init(MT, DM, gridDim.x, blockIdx.x);
        pg8::EpiH E{args.in[0], args.in[1], args.out + OFF_Y};
        pg8::gemm_phase<pg8::EpiH, pg8::StaticOrder, true, true>((PG8_LAS unsigned char*)lds, g, S, E); }
    if constexpr (PH == 8) p8_hnorm(args, tid);
    if constexpr (PH == 9) { pg8::Gemm g{(const pg8::bf16_t*)(ws + WS_HB), (const pg8::bf16_t*)(ws + WS_W1), MT, DFF, DM}; pg8::StaticOrder S; S.init(MT, DFF, gridDim.x, blockIdx.x);
        pg8::EpiAct E{(pg8::bf16_t*)(ws + WS_ACT), DFF};
        pg8::gemm_phase<pg8::EpiAct, pg8::StaticOrder, true, true>((PG8_LAS unsigned char*)lds, g, S, E); }
    if constexpr (PH == 10) { pg8::Gemm g{(const pg8::bf16_t*)(ws + WS_ACT), (const pg8::bf16_t*)(ws + WS_W2), MT, DM, DFF}; pg8::StaticOrder S; S.init(MT, DM, gridDim.x, blockIdx.x);
        pg8::EpiY E{args.out + OFF_Y};
        pg8::gemm_phase<pg8::EpiY, pg8::StaticOrder, true, true>((PG8_LAS unsigned char*)lds, g, S, E); }
}
#ifndef MK_ONE_LAUNCH
#define MK_ONE_LAUNCH 1
#endif
#if MK_ONE_LAUNCH
__global__ void __launch_bounds__(512, 2) mk_fwd(Args args) {
    extern __shared__ __attribute__((aligned(16))) unsigned char lds[];
    const int tid = threadIdx.x;
    volatile __attribute__((address_space(3))) unsigned* bst = (volatile __attribute__((address_space(3))) unsigned*)((__attribute__((address_space(3))) unsigned char*)lds + LDS_BYTES - 16);
    if (tid < 2) bst[tid] = 0u;
    __syncthreads();
    const XcdBarrier bar = xcd_barrier_post((unsigned*)(args.ws + WS_CTL) + CW_BAR, bst);
#define SEAM(k) do { if ((k) == 1) { __syncthreads(); cg::this_grid().sync(); } else xcd_barrier(bar); } while (0)
#define PHASE(k) do { if (args.ph_lo <= (k) && (k) < args.ph_hi) { if ((k) > args.ph_lo) SEAM(k); run_phase<k>(args, lds, tid, 0); \
        if ((PROBE_MASK >> (k)) & 1) { xcd_barrier(bar); run_phase<k>(args, lds, tid, 1); } } } while (0)
    PHASE(0); PHASE(1); PHASE(2); PHASE(3); PHASE(4); PHASE(5); PHASE(6); PHASE(7); PHASE(8); PHASE(9); PHASE(10);
#undef PHASE
#undef SEAM
}
#else
template <int PH> __global__ void __launch_bounds__(512, 2) mk_phase(Args args) {
    extern __shared__ __attribute__((aligned(16))) unsigned char lds[];
    run_phase<PH>(args, lds, threadIdx.x, 0);
}
#endif

extern "C" void kernel_launch(void* const* d_in, const int* in_sizes, int n_in, void* d_out, int out_size, void* d_ws, size_t ws_size, hipStream_t stream) {
    static int grid = 0;
    if (grid == 0) {
        if (n_in != 28 || out_size != (int)OUT_TOTAL || ws_size < WS_END) { fprintf(stderr, "kernel_launch: unexpected shapes (n_in %d, out %d, ws %zu)\n", n_in, out_size, ws_size); grid = -1; return; }
        int dev = 0, cus = 0, per_cu = 0;
        (void)hipGetDevice(&dev); (void)hipDeviceGetAttribute(&cus, hipDeviceAttributeMultiprocessorCount, dev);
#if MK_ONE_LAUNCH
        if (hipFuncSetAttribute((const void*)mk_fwd, hipFuncAttributeMaxDynamicSharedMemorySize, LDS_BYTES) != hipSuccess) { fprintf(stderr, "kernel_launch: hipFuncSetAttribute failed\n"); grid = -1; return; }
        (void)hipOccupancyMaxActiveBlocksPerMultiprocessor(&per_cu, (const void*)mk_fwd, 512, LDS_BYTES);
        (void)hipGetLastError();
        if (per_cu < 1) { fprintf(stderr, "kernel_launch: occupancy query says %d blocks per CU\n", per_cu); per_cu = 1; }
#else
#define SETATTR(k) (void)hipFuncSetAttribute((const void*)mk_phase<k>, hipFuncAttributeMaxDynamicSharedMemorySize, LDS_BYTES)
        SETATTR(0); SETATTR(1); SETATTR(2); SETATTR(3); SETATTR(4); SETATTR(5); SETATTR(6); SETATTR(7); SETATTR(8); SETATTR(9); SETATTR(10);
#undef SETATTR
        (void)per_cu;
#endif
        grid = cus;
    }
    if (grid < 0) return;
    (void)hipMemsetAsync((char*)d_ws + WS_CTL, 0, CTL_BYTES, stream);
    Args a{};
    for (int i = 0; i < 28; ++i) a.in[i] = (const float*)d_in[i];
    a.out = (float*)d_out; a.ws = (unsigned char*)d_ws;
#if MK_ONE_LAUNCH
    a.ph_lo = 0; a.ph_hi = N_PHASES;
    void* kargs[] = {&a};
    hipError_t e = hipLaunchCooperativeKernel((const void*)mk_fwd, dim3(grid), dim3(512), kargs, LDS_BYTES, stream);
    if (e != hipSuccess) fprintf(stderr, "kernel_launch: cooperative launch failed: %s (grid %d)\n", hipGetErrorString(e), grid);
#else
#define LAUNCH(k) hipLaunchKernelGGL(mk_phase<k>, dim3(grid), dim3(512), LDS_BYTES, stream, a)
    a.ph_lo = 0; a.ph_hi = N_PHASES;
    LAUNCH(0); LAUNCH(1); LAUNCH(2); LAUNCH(3); LAUNCH(4); LAUNCH(5); LAUNCH(6); LAUNCH(7); LAUNCH(8); LAUNCH(9); LAUNCH(10);
#undef LAUNCH
#endif
}
```

```cpp
#include <hip/hip_runtime.h>
#include <hip/hip_cooperative_groups.h>
#include <cstdio>
#include <cstdint>
namespace cg = cooperative_groups;
namespace pg8 {
#define PG8_LAS __attribute__((address_space(3)))
typedef unsigned short bf16_t;
typedef short bf16x8 __attribute__((ext_vector_type(8)));
typedef float f32x4 __attribute__((ext_vector_type(4)));
typedef unsigned u32x4 __attribute__((ext_vector_type(4)));
constexpr int BM = 256, BK = 64, HALF = 128, HTB = HALF * BK * 2  , STAGE_BYTES = 8 * HTB, NXCD = 8, WGM = 8;

__host__ __device__ __forceinline__ int lds_byte(int r, int c) { const int st = (r >> 4) * 2 + (c >> 5), rr = r & 15, cc = c & 31, ob = rr * 64 + cc * 2; return st * 1024 + (ob ^ (((ob >> 9) & 1) << 5)); }
__host__ __device__ __forceinline__ void stage_rc(int b, int& R, int& C) { const int st = b / 1024, sb = b % 1024, swz = sb ^ (((sb >> 9) & 1) << 5); R = (st >> 1) * 16 + swz / 64; C = (st & 1) * 32 + (swz % 64) / 2; }
__host__ __device__ __forceinline__ int perm32(int rho) { const int n = rho >> 4, i = rho & 15; return 8 * (i >> 2) + 4 * n + (i & 3); }

struct Unit { int pm, pn; };
struct Gemm { const bf16_t* A; const bf16_t* Bt; int M, N, K, KL; };

struct StaticOrder {
    int nM, nN, nwg, G, c;
    __host__ __device__ void init(int M, int N, int G_, int c_) { nM = M / BM; nN = N / BM; nwg = nM * nN; G = G_; c = c_; }
    __host__ __device__ bool next(int i, Unit& u) const {
        const long L = (long)i * G + c; if (L >= nwg) return false;
        int wgid = (int)L; { const int q = nwg / NXCD, r = nwg % NXCD, xcd = wgid % NXCD, off = wgid / NXCD; wgid = (xcd < r ? xcd * (q + 1) : r * (q + 1) + (xcd - r) * q) + off; }
        const int nig = WGM * nN, gid = wgid / nig, fm = gid * WGM, gsz = (nM - fm) < WGM ? (nM - fm) : WGM;
        u.pm = fm + ((wgid % nig) % gsz); u.pn = (wgid % nig) / gsz; return true;
    }
    __device__ __forceinline__ void a_ready(const Unit&) const {}
    __device__ __forceinline__ void done(const Unit&) const {}
};


__device__ __forceinline__ unsigned cvt_pk_bf16(float lo, float hi) { unsigned r; asm volatile("v_cvt_pk_bf16_f32 %0, %1, %2" : "=v"(r) : "v"(lo), "v"(hi)); return r; }

constexpr int E_MP = 16384;
constexpr int E_ZRW = 1632, E_ZSW = 1696;

struct OneUnit { Unit u; bool has;
    __device__ __forceinline__ bool next(int i, Unit& o) const { if (i == 0 && has) { o = u; return true; } return false; }
    __device__ __forceinline__ void a_ready(const Unit&) const {}
    __device__ __forceinline__ void done(const Unit&) const {} };
struct EpiZ {
    static constexpr bool PERM = true, AFTER_DRAIN = false;
    bf16_t* ZR; bf16_t* ZS;
    __device__ __forceinline__ void operator()(const f32x4 (&acc)[2][2][4][2], const Unit& u, int wr, int wc, int fr, int fq) const {
        const int row0 = u.pm * BM + wr * 64 + fr, c0 = u.pn * BM + wc * 32 + 8 * fq;
#pragma unroll
        for (int ai = 0; ai < 2; ++ai)
#pragma unroll
            for (int m = 0; m < 4; ++m) { const size_t row = (size_t)(row0 + ai * HALF + m * 16);
#pragma unroll
                for (int bj = 0; bj < 2; ++bj) { const int c = c0 + bj * HALF; bf16_t* dst;
                    if (c < 1600) dst = ZR + row * E_ZRW + c; else if (c < 3296) dst = ZS + row * E_ZSW + (c - 1600); else if (c == 3296) dst = ZR + row * E_ZRW + 1600; else continue;
                    const f32x4 v0 = acc[ai][bj][m][0], v1 = acc[ai][bj][m][1]; u32x4 w;
                    w.x = cvt_pk_bf16(v0[0], v0[1]); w.y = cvt_pk_bf16(v0[2], v0[3]); w.z = cvt_pk_bf16(v1[0], v1[1]); w.w = cvt_pk_bf16(v1[2], v1[3]);
                    *(u32x4*)dst = w; } }
    }
};
struct EpiH {
    static constexpr bool PERM = false, AFTER_DRAIN = false;
    const float* xp; const float* xs; float* H; bf16_t* HB; float* SS;
    __device__ __forceinline__ void operator()(const f32x4 (&acc)[2][2][4][2], const Unit& u, int wr, int wc, int fr, int fq) const {
        const int row0 = u.pm * BM + wr * 64 + fr, col0 = u.pn * BM + wc * 32 + 4 * fq;
#pragma unroll
        for (int ai = 0; ai < 2; ++ai)
#pragma unroll
            for (int m = 0; m < 4; ++m) { const int row = row0 + ai * HALF + m * 16;
                const float* xr = (row < E_MP ? xp + (size_t)row * 1024 : xs + (size_t)(row - E_MP) * 1024) + col0; float* hr = H + (size_t)row * 1024 + col0; bf16_t* hb = HB + (size_t)row * 1024 + col0;
                float ss = 0.f;
#pragma unroll
                for (int bj = 0; bj < 2; ++bj)
#pragma unroll
                    for (int n = 0; n < 2; ++n) { const f32x4 h = *(const f32x4*)(xr + bj * HALF + n * 16) + acc[ai][bj][m][n]; *(f32x4*)(hr + bj * HALF + n * 16) = h;
                        ss += (h[0] * h[0] + h[1] * h[1]) + (h[2] * h[2] + h[3] * h[3]);
                        unsigned w0 = cvt_pk_bf16(h[0], h[1]), w1 = cvt_pk_bf16(h[2], h[3]); typedef unsigned u32x2v __attribute__((ext_vector_type(2))); *(u32x2v*)(hb + bj * HALF + n * 16) = (u32x2v){w0, w1}; }
                ss += __shfl_xor(ss, 16); ss += __shfl_xor(ss, 32);
                if (fq == 0) atomicAdd(SS + row, ss); }
    }
};
struct EpiAct {
    static constexpr bool PERM = true, AFTER_DRAIN = false;
    bf16_t* O; int ldc; const float* SS;
    __device__ __forceinline__ void operator()(const f32x4 (&acc)[2][2][4][2], const Unit& u, int wr, int wc, int fr, int fq) const {
        const int row0 = u.pm * BM + wr * 64 + fr, c0 = u.pn * BM + wc * 32 + 8 * fq;
#pragma unroll
        for (int ai = 0; ai < 2; ++ai)
#pragma unroll
            for (int m = 0; m < 4; ++m) { const int row = row0 + ai * HALF + m * 16; bf16_t* rowp = O + (size_t)row * ldc + c0;
                const float rs = rsqrtf(SS[row] * (1.0f / 1024.0f) + 1e-6f);
#pragma unroll
                for (int bj = 0; bj < 2; ++bj) { f32x4 v0 = acc[ai][bj][m][0], v1 = acc[ai][bj][m][1];
#pragma unroll
                    for (int e = 0; e < 4; ++e) { const float a = fmaxf(v0[e], 0.f) * rs, b = fmaxf(v1[e], 0.f) * rs; v0[e] = a * a; v1[e] = b * b; }
                    u32x4 w; w.x = cvt_pk_bf16(v0[0], v0[1]); w.y = cvt_pk_bf16(v0[2], v0[3]); w.z = cvt_pk_bf16(v1[0], v1[1]); w.w = cvt_pk_bf16(v1[2], v1[3]);
                    *(u32x4*)(rowp + bj * HALF) = w; } }
    }
};
struct EpiSlab {
    static constexpr bool PERM = false, AFTER_DRAIN = false;
    float* S;
    __device__ __forceinline__ void operator()(const f32x4 (&acc)[2][2][4][2], const Unit& u, int wr, int wc, int fr, int fq) const {
        const int row0 = u.pm * BM - E_MP + wr * 64 + fr, col0 = u.pn * BM + wc * 32 + 4 * fq;
#pragma unroll
        for (int ai = 0; ai < 2; ++ai)
#pragma unroll
            for (int m = 0; m < 4; ++m) { float* yr = S + (size_t)(row0 + ai * HALF + m * 16) * 1024 + col0;
#pragma unroll
                for (int bj = 0; bj < 2; ++bj)
#pragma unroll
                    for (int n = 0; n < 2; ++n) *(f32x4*)(yr + bj * HALF + n * 16) = acc[ai][bj][m][n]; }
    }
};
struct EpiY {
    static constexpr bool PERM = false, AFTER_DRAIN = false;
    float* Y;
    __device__ __forceinline__ void operator()(const f32x4 (&acc)[2][2][4][2], const Unit& u, int wr, int wc, int fr, int fq) const {
        const int row0 = u.pm * BM + wr * 64 + fr, col0 = u.pn * BM + wc * 32 + 4 * fq;
#pragma unroll
        for (int ai = 0; ai < 2; ++ai)
#pragma unroll
            for (int m = 0; m < 4; ++m) { float* yr = Y + (size_t)(row0 + ai * HALF + m * 16) * 1024 + col0;
#pragma unroll
                for (int bj = 0; bj < 2; ++bj)
#pragma unroll
                    for (int n = 0; n < 2; ++n) { f32x4* p = (f32x4*)(yr + bj * HALF + n * 16); *p = *p + acc[ai][bj][m][n]; } }
    }
};

template <class Epi, class Sched, bool ALIGN_EPI = false, bool SP2 = false>
__device__ __forceinline__ void gemm_phase(PG8_LAS unsigned char* lds, const Gemm g, const Sched& S, const Epi& E) {
    const int tid = threadIdx.x, wid = __builtin_amdgcn_readfirstlane(tid >> 6), lane = tid & 63, wr = wid >> 2, wc = wid & 3, fr = lane & 15, fq = lane >> 4;
    const int K = g.K, nt = g.KL / BK;
    unsigned voffA[2], voffB[2];
#pragma unroll
    for (int i = 0; i < 2; ++i) { int R, C; stage_rc(tid * 16 + i * 8192, R, C); const int Rb = Epi::PERM ? ((R & ~31) + perm32(R & 31)) : R;
        voffA[i] = (unsigned)(R * K + C) * 2u; voffB[i] = (unsigned)(Rb * K + C) * 2u; }
    const size_t kstep = (size_t)(BK * 2);
    const size_t hstep = (size_t)HALF * K * 2;
    const size_t tstep = 2 * hstep;
    const unsigned ldsw = (unsigned)wid * 1024u;
    const int aoff = lds_byte(wr * 64 + fr, fq * 8), boff = lds_byte(wc * 32 + fr, fq * 8);
#define PG8_SA(b, h) (((b) * 2 + (h)) * HTB)
#define PG8_SB(b, h) ((4 + (b) * 2 + (h)) * HTB)
#define PG8_STAGE(bufoff, gbase, voff) do { _Pragma("unroll") for (int _i = 0; _i < 2; ++_i) \
        __builtin_amdgcn_global_load_lds((const unsigned*)((const char*)(gbase) + (voff)[_i]), (PG8_LAS unsigned*)(lds + (bufoff) + ldsw + _i * 8192), 16, 0, 0); } while (0)
#define PG8_LDA(dst, b, h) do { _Pragma("unroll") for (int m = 0; m < 4; ++m) _Pragma("unroll") for (int k = 0; k < 2; ++k) dst[m][k] = *(const PG8_LAS bf16x8*)(lds + PG8_SA(b, h) + aoff + m * 2048 + k * 1024); } while (0)
#define PG8_LDB(dst, b, h) do { _Pragma("unroll") for (int n = 0; n < 2; ++n) _Pragma("unroll") for (int k = 0; k < 2; ++k) dst[n][k] = *(const PG8_LAS bf16x8*)(lds + PG8_SB(b, h) + boff + n * 2048 + k * 1024); } while (0)
#define PG8_MMA(ai, bj, At, Bt) do { __builtin_amdgcn_s_setprio(1); _Pragma("unroll") for (int m = 0; m < 4; ++m) _Pragma("unroll") for (int n = 0; n < 2; ++n) _Pragma("unroll") for (int k = 0; k < 2; ++k) \
        acc[ai][bj][m][n] = __builtin_amdgcn_mfma_f32_16x16x32_bf16(Bt[n][k], At[m][k], acc[ai][bj][m][n], 0, 0, 0); __builtin_amdgcn_s_setprio(0); } while (0)
#define PG8_WAIT_V(n) asm volatile("s_waitcnt vmcnt(" #n ")" ::: "memory")
#define PG8_WAIT_L(n) asm volatile("s_waitcnt lgkmcnt(" #n ")" ::: "memory")
#define PG8_BAR __builtin_amdgcn_s_barrier()
#define PG8_SCHED __builtin_amdgcn_sched_barrier(0)
    Unit cur, nxt; int ui = 0;
    if (!S.next(0, cur)) return;
    f32x4 acc[2][2][4][2];
#pragma unroll
    for (int a = 0; a < 2; ++a)
#pragma unroll
        for (int b = 0; b < 2; ++b)
#pragma unroll
            for (int m = 0; m < 4; ++m)
#pragma unroll
                for (int n = 0; n < 2; ++n) acc[a][b][m][n] = (f32x4){0.f, 0.f, 0.f, 0.f};
    bf16x8 At[4][2], B0[2][2], B1[2][2];
    const char* cA = (const char*)g.A + (size_t)cur.pm * tstep; const char* cB = (const char*)g.Bt + (size_t)cur.pn * tstep;
    S.a_ready(cur);
    if constexpr (SP2) {
        PG8_STAGE(PG8_SB(0, 0), cB, voffB); PG8_STAGE(PG8_SB(0, 1), cB + hstep, voffB); PG8_STAGE(PG8_SA(0, 0), cA, voffA); PG8_STAGE(PG8_SA(0, 1), cA + hstep, voffA);
        if (wr == 1) PG8_BAR;
        PG8_WAIT_V(2); PG8_BAR;
        PG8_STAGE(PG8_SB(1, 0), cB + kstep, voffB); PG8_STAGE(PG8_SA(1, 0), cA + kstep, voffA); PG8_STAGE(PG8_SB(1, 1), cB + hstep + kstep, voffB);
        PG8_WAIT_V(6); PG8_BAR;
    } else {
        PG8_STAGE(PG8_SB(0, 0), cB, voffB); PG8_STAGE(PG8_SA(0, 0), cA, voffA); PG8_STAGE(PG8_SB(0, 1), cB + hstep, voffB); PG8_STAGE(PG8_SA(0, 1), cA + hstep, voffA);
        if (wr == 1) PG8_BAR;
        PG8_WAIT_V(4); PG8_BAR;
        PG8_STAGE(PG8_SB(1, 0), cB + kstep, voffB); PG8_STAGE(PG8_SA(1, 0), cA + kstep, voffA); PG8_STAGE(PG8_SB(1, 1), cB + hstep + kstep, voffB);
        PG8_WAIT_V(6); PG8_BAR;
    }
    for (;;) {
        const bool has_next = S.next(ui + 1, nxt);
        const char* nA = has_next ? (const char*)g.A + (size_t)nxt.pm * tstep : cA; const char* nB = has_next ? (const char*)g.Bt + (size_t)nxt.pn * tstep : cB;
        for (int t = 0; t < nt; t += 2) {
            const bool last = (t == nt - 2);
            const char* a1 = cA + (size_t)(t + 1) * kstep;
            const char* a2 = last ? nA : cA + (size_t)(t + 2) * kstep; const char* b2 = last ? nB : cB + (size_t)(t + 2) * kstep;
            const char* a3 = a2 + kstep; const char* b3 = b2 + kstep;
            if (last && has_next) S.a_ready(nxt);
            if constexpr (SP2) {
            PG8_LDB(B0, 0, 0); PG8_LDB(B1, 0, 1); PG8_SCHED; PG8_LDA(At, 0, 0); PG8_STAGE(PG8_SA(1, 1), a1 + hstep, voffA);
            PG8_WAIT_V(8); PG8_WAIT_L(0); PG8_BAR; PG8_MMA(0, 0, At, B0); PG8_MMA(0, 1, At, B1); PG8_BAR; PG8_SCHED;
            PG8_LDA(At, 0, 1); PG8_STAGE(PG8_SB(0, 0), b2, voffB); PG8_STAGE(PG8_SB(0, 1), b2 + hstep, voffB); PG8_STAGE(PG8_SA(0, 0), a2, voffA);
            PG8_WAIT_V(8); PG8_WAIT_L(0); PG8_BAR; PG8_MMA(1, 0, At, B0); PG8_MMA(1, 1, At, B1); PG8_BAR; PG8_SCHED;
            PG8_LDB(B0, 1, 0); PG8_LDB(B1, 1, 1); PG8_SCHED; PG8_LDA(At, 1, 0); PG8_STAGE(PG8_SA(0, 1), a2 + hstep, voffA);
            PG8_WAIT_V(8); PG8_WAIT_L(0); PG8_BAR; PG8_MMA(0, 0, At, B0); PG8_MMA(0, 1, At, B1); PG8_BAR; PG8_SCHED;
            PG8_LDA(At, 1, 1); PG8_STAGE(PG8_SB(1, 0), b3, voffB); PG8_STAGE(PG8_SB(1, 1), b3 + hstep, voffB); PG8_STAGE(PG8_SA(1, 0), a3, voffA);
            PG8_WAIT_V(8); PG8_WAIT_L(0); PG8_BAR; PG8_MMA(1, 0, At, B0); PG8_MMA(1, 1, At, B1); PG8_BAR; PG8_SCHED;
            } else {
            PG8_LDB(B0, 0, 0); PG8_SCHED; PG8_LDA(At, 0, 0); PG8_STAGE(PG8_SA(1, 1), a1 + hstep, voffA);
            PG8_WAIT_L(8); PG8_BAR; PG8_WAIT_L(0); PG8_MMA(0, 0, At, B0); PG8_BAR; PG8_SCHED;
            PG8_LDB(B1, 0, 1); PG8_STAGE(PG8_SB(0, 0), b2, voffB);
            PG8_BAR; PG8_WAIT_L(0); PG8_MMA(0, 1, At, B1); PG8_BAR;
            PG8_LDA(At, 0, 1); PG8_STAGE(PG8_SA(0, 0), a2, voffA);
            PG8_BAR; PG8_WAIT_L(0); PG8_MMA(1, 0, At, B0); PG8_BAR; PG8_SCHED;
            PG8_STAGE(PG8_SB(0, 1), b2 + hstep, voffB);
            PG8_WAIT_V(6); PG8_BAR; PG8_MMA(1, 1, At, B1); PG8_BAR;
            PG8_LDB(B0, 1, 0); PG8_SCHED; PG8_LDA(At, 1, 0); PG8_STAGE(PG8_SA(0, 1), a2 + hstep, voffA);
            PG8_WAIT_L(8); PG8_BAR; PG8_WAIT_L(0); PG8_MMA(0, 0, At, B0); PG8_BAR; PG8_SCHED;
            PG8_LDB(B1, 1, 1); PG8_STAGE(PG8_SB(1, 0), b3, voffB);
            PG8_BAR; PG8_WAIT_L(0); PG8_MMA(0, 1, At, B1); PG8_BAR;
            PG8_LDA(At, 1, 1); PG8_STAGE(PG8_SA(1, 0), a3, voffA);
            PG8_BAR; PG8_WAIT_L(0); PG8_MMA(1, 0, At, B0); PG8_BAR; PG8_SCHED;
            PG8_STAGE(PG8_SB(1, 1), b3 + hstep, voffB);
            PG8_WAIT_V(6); PG8_BAR; PG8_MMA(1, 1, At, B1); PG8_BAR;
            }
        }
        if constexpr (ALIGN_EPI) { if (wr == 0) PG8_BAR; }
        if constexpr (!Epi::AFTER_DRAIN) { E(acc, cur, wr, wc, fr, fq); S.done(cur); }
        if (!has_next) break;
#pragma unroll
        for (int a = 0; a < 2; ++a)
#pragma unroll
            for (int b = 0; b < 2; ++b)
#pragma unroll
                for (int m = 0; m < 4; ++m)
#pragma unroll
                    for (int n = 0; n < 2; ++n) acc[a][b][m][n] = (f32x4){0.f, 0.f, 0.f, 0.f};
        cur = nxt; cA = nA; cB = nB; ++ui;
        if constexpr (ALIGN_EPI) { if (wr == 1) PG8_BAR; }
    }
    PG8_WAIT_V(0);
    if constexpr (!ALIGN_EPI) { if (wr == 0) PG8_BAR; }
    PG8_BAR;
    if constexpr (Epi::AFTER_DRAIN) { E.fused(acc, cur, wr, wc, fr, fq, lds, wid, lane); S.done(cur); }
#undef PG8_SA
#undef PG8_SB
#undef PG8_STAGE
#undef PG8_LDA
#undef PG8_LDB
#undef PG8_MMA
#undef PG8_WAIT_V
#undef PG8_WAIT_L
#undef PG8_BAR
#undef PG8_SCHED
}
}


constexpr int DM = 1024, NB_P = 8, T_P = 2048, NB_S = 32, T_S = 32, PAST = 1024;
constexpr int MP = NB_P * T_P, MS = NB_S * T_S, MT = MP + MS;
constexpr int LS = PAST + T_S;
constexpr int SHIFTW = 1696, NZ = 3328, ZRW = 1632, DFF = 4096;
constexpr float QSCALE = 0.125f * 1.4426950408889634f;
constexpr float WISCALE = 0.35355339059327373f * 0.125f;
constexpr size_t OFF_Y = 0, OFF_KP = 17825792, OFF_VP = OFF_KP + 4194304, OFF_KIP = OFF_VP + 4194304, OFF_WKVP = OFF_KIP + 1048576, OFF_SHP = OFF_WKVP + 262144,
                 OFF_KS = OFF_SHP + 13568, OFF_VS = OFF_KS + 262144, OFF_KIS = OFF_VS + 262144, OFF_WKVS = OFF_KIS + 65536, OFF_SHS = OFF_WKVS + 1048576, OUT_TOTAL = OFF_SHS + 54272;
constexpr size_t MiB = 1u << 20;
constexpr size_t WS_CTL = 0, CTL_BYTES = 1 * MiB;
constexpr size_t WS_WIN = 1 * MiB, WS_WOUT = 8 * MiB, WS_W1 = 10 * MiB, WS_W2 = 18 * MiB;
constexpr size_t WS_W2T = 26 * MiB, WS_A2T = WS_W2T + 32768, WS_G2T = WS_A2T + 32768, WS_WI = 27 * MiB, WS_BONUS = 28 * MiB;
constexpr size_t WS_XB = 30 * MiB;
constexpr size_t WS_ZS = 66 * MiB;
constexpr size_t WS_R = 123 * MiB;
constexpr size_t WS_ZR = WS_R, WS_KBP = 178 * MiB, WS_VTP = 186 * MiB, WS_KIP = 194 * MiB, WS_KBS = 196 * MiB, WS_VTS = 213 * MiB, WS_KIS = 230 * MiB;
constexpr size_t WS_OW = WS_R, WS_OKK = 157 * MiB, WS_OB = 174 * MiB, WS_OKM = 191 * MiB, WS_OR = 208 * MiB, WS_OV = 225 * MiB;
constexpr size_t WS_ACT = 66 * MiB, WS_HB = 202 * MiB, WS_END = 256 * MiB;
static_assert(WS_ZS + (size_t)MT * SHIFTW * 2 <= WS_R && WS_ZR + (size_t)MT * ZRW * 2 <= WS_KBP && WS_KBS + (size_t)NB_S * LS * 256 * 2 <= WS_VTS && WS_VTS + (size_t)NB_S * 256 * LS * 2 <= WS_KIS &&
              WS_KIS + (size_t)NB_S * LS * 64 * 2 <= WS_END && WS_OV + (size_t)MT * 512 * 2 <= WS_END && WS_ACT + (size_t)MT * DFF * 2 <= WS_HB && WS_HB + (size_t)MT * DM * 2 <= WS_END, "d_ws map");
constexpr size_t SC_Q = 0, SC_QI = (size_t)MT * 512 / 2, SC_Y = 0, SC_G = (size_t)MT * 512;
constexpr int CW_QATT = 64, CW_SS = 16384;

typedef unsigned short bf16;
typedef short bf16x8 __attribute__((ext_vector_type(8)));
typedef float f32x4 __attribute__((ext_vector_type(4)));
typedef float f32x16 __attribute__((ext_vector_type(16)));
typedef unsigned u32x4 __attribute__((ext_vector_type(4)));
typedef unsigned u32x2 __attribute__((ext_vector_type(2)));

__device__ __forceinline__ unsigned f2bf(float f) { unsigned u = __float_as_uint(f); return (u + 0x7fffu + ((u >> 16) & 1u)) >> 16; }
__device__ __forceinline__ unsigned pk2(float lo, float hi) { return f2bf(lo) | (f2bf(hi) << 16); }
__device__ __forceinline__ float bflo(unsigned w) { return __uint_as_float(w << 16); }
__device__ __forceinline__ float bfhi(unsigned w) { return __uint_as_float(w & 0xffff0000u); }
__device__ __forceinline__ float bf1(bf16 b) { return __uint_as_float((unsigned)b << 16); }
__device__ __forceinline__ void unpack8(const u32x4 w, float* x) { x[0] = bflo(w.x); x[1] = bfhi(w.x); x[2] = bflo(w.y); x[3] = bfhi(w.y); x[4] = bflo(w.z); x[5] = bfhi(w.z); x[6] = bflo(w.w); x[7] = bfhi(w.w); }
__device__ __forceinline__ u32x4 pack8(const float* x) { u32x4 w; w.x = pk2(x[0], x[1]); w.y = pk2(x[2], x[3]); w.z = pk2(x[4], x[5]); w.w = pk2(x[6], x[7]); return w; }
__device__ __forceinline__ float wave_sum(float v) {
#pragma unroll
    for (int o = 1; o < 64; o <<= 1) v += __shfl_xor(v, o);
    return v;
}
template <int CTRL> __device__ __forceinline__ float dppmov(float x) { return __builtin_bit_cast(float, __builtin_amdgcn_update_dpp(0, __builtin_bit_cast(int, x), CTRL, 0xf, 0xf, true)); }
__device__ __forceinline__ float sum16(float x) {
    x += dppmov<0xB1>(x); x += dppmov<0x4E>(x); x += dppmov<0x141>(x); x += dppmov<0x140>(x); return x;
}
__device__ __forceinline__ int crow(int r, int hi) { return (r & 3) + 8 * (r >> 2) + 4 * hi; }

struct Args { const float* in[28]; float* out; unsigned char* ws; int ph_lo, ph_hi; };

__device__ __forceinline__ void tr_item(const float* W, int K, int N, const float* gain, bf16* WT, int jr0, int c0, int nvalid, int k0, float* scr, int lane) {
#pragma unroll 8
    for (int i = 0; i < 32; ++i) { const int kk = 2 * i + (lane >> 5), n = lane & 31;
        float v = (n < nvalid) ? W[(size_t)(k0 + kk) * N + c0 + n] : 0.f; if (gain) v *= gain[k0 + kk]; scr[kk * 33 + n] = v; }
    __builtin_amdgcn_s_waitcnt(0xC07F); asm volatile("" ::: "memory");
    const int c = lane & 7;
#pragma unroll
    for (int j = 0; j < 4; ++j) { const int n = (lane >> 3) + 8 * j; const float* s = scr + (8 * c) * 33 + n;
        u32x4 o; o.x = pk2(s[0 * 33], s[1 * 33]); o.y = pk2(s[2 * 33], s[3 * 33]); o.z = pk2(s[4 * 33], s[5 * 33]); o.w = pk2(s[6 * 33], s[7 * 33]);
        *(u32x4*)(WT + (size_t)(jr0 + n) * K + k0 + 8 * c) = o; }
    __builtin_amdgcn_s_waitcnt(0xC07F); asm volatile("" ::: "memory");
}
__device__ __forceinline__ void p0_prologue(const Args& a, unsigned char* lds, int tid) {
    const int lane = tid & 63, wave = tid >> 6, gw = blockIdx.x * 8 + wave, NGW = gridDim.x * 8;
    float* scr = (float*)(lds + wave * 17408);
    unsigned char* ws = a.ws;
    constexpr int I_IN = (NZ / 32) * (DM / 64), I_OUT = (DM / 32) * (DM / 64), I_F1 = (DFF / 32) * (DM / 64), I_F2 = (DM / 32) * (DFF / 64);
    for (int it = gw; it < I_IN + I_OUT + I_F1 + I_F2; it += NGW) {
        int r = it;
        if (r < I_IN) { const int jb = r % (NZ / 32), kb = r / (NZ / 32), j0 = jb * 32; int c0, nv;
            if (j0 < 1600) { c0 = j0; nv = 32; } else if (j0 < 3296) { c0 = 1608 + (j0 - 1600); nv = 32; } else { c0 = 1600; nv = 8; }
            tr_item(a.in[8], DM, 3304, a.in[7], (bf16*)(ws + WS_WIN), j0, c0, nv, kb * 64, scr, lane); continue; }
        r -= I_IN;
        if (r < I_OUT) { const int jb = r % (DM / 32), kb = r / (DM / 32); tr_item(a.in[24], DM, DM, nullptr, (bf16*)(ws + WS_WOUT), jb * 32, jb * 32, 32, kb * 64, scr, lane); continue; }
        r -= I_OUT;
        if (r < I_F1) { const int jb = r % (DFF / 32), kb = r / (DFF / 32); tr_item(a.in[26], DM, DFF, a.in[25], (bf16*)(ws + WS_W1), jb * 32, jb * 32, 32, kb * 64, scr, lane); continue; }
        r -= I_F1;
        { const int jb = r % (DM / 32), kb = r / (DM / 32); tr_item(a.in[27], DFF, DM, nullptr, (bf16*)(ws + WS_W2), jb * 32, jb * 32, 32, kb * 64, scr, lane); }
    }
    { const int gt = blockIdx.x * 512 + tid, NT = gridDim.x * 512;
      bf16* w2t = (bf16*)(ws + WS_W2T); bf16* a2t = (bf16*)(ws + WS_A2T); bf16* g2t = (bf16*)(ws + WS_G2T);
      for (int i = gt; i < 512 * 32; i += NT) { const int n = i >> 5, k = i & 31; w2t[i] = (bf16)f2bf(a.in[15][k * 512 + n]); a2t[i] = (bf16)f2bf(a.in[17][k * 512 + n]); }
      for (int i = gt; i < 512 * 96; i += NT) { const int n = i / 96, k = i % 96; g2t[i] = (bf16)f2bf(a.in[18][k * 512 + n]); } }
    for (int m = gw; m < MT; m += NGW) {
        const float* xrow = (m < MP) ? a.in[0] + (size_t)m * DM : a.in[1] + (size_t)(m - MP) * DM;
        const f32x4* xr = (const f32x4*)xrow + lane; f32x4 v[4]; float s = 0.f;
#pragma unroll
        for (int j = 0; j < 4; ++j) { v[j] = xr[64 * j]; s += (v[j].x * v[j].x + v[j].y * v[j].y) + (v[j].z * v[j].z + v[j].w * v[j].w); }
        const float rs = rsqrtf(wave_sum(s) * (1.f / DM) + 1e-6f);
        u32x2* o8 = (u32x2*)((bf16*)(ws + WS_XB) + (size_t)m * DM) + lane;
#pragma unroll
        for (int j = 0; j < 4; ++j) { u32x2 o; o.x = pk2(v[j].x * rs, v[j].y * rs); o.y = pk2(v[j].z * rs, v[j].w * rs); o8[64 * j] = o; }
    }
    for (int rix = gw; rix < NB_S * PAST; rix += NGW) {
        const int b = rix >> 10, p = rix & 1023; const f32x4 v = ((const f32x4*)(a.in[2] + (size_t)rix * 256))[lane];
        u32x2 o; o.x = pk2(v.x, v.y); o.y = pk2(v.z, v.w); ((u32x2*)((bf16*)(ws + WS_KBS) + ((size_t)b * LS + p) * 256))[lane] = o;
    }
    for (int r4 = gw; r4 < NB_S * PAST / 4; r4 += NGW) {
        const int rix = r4 * 4 + (lane >> 4), b = rix >> 10, p = rix & 1023; const f32x4 v = ((const f32x4*)(a.in[4] + (size_t)rix * 64))[lane & 15];
        u32x2 o; o.x = pk2(v.x, v.y); o.y = pk2(v.z, v.w); ((u32x2*)((bf16*)(ws + WS_KIS) + ((size_t)b * LS + p) * 64))[lane & 15] = o;
    }
    for (int it = gw; it < NB_S * 4 * 16; it += NGW) {
        const int kb = it & 15, g = (it >> 4) & 3, b = it >> 6;
        const float* src = a.in[3] + ((size_t)b * PAST + kb * 64) * 256 + g * 64;
#pragma unroll 8
        for (int i = 0; i < 64; ++i) scr[i * 65 + lane] = src[(size_t)i * 256 + lane];
        __builtin_amdgcn_s_waitcnt(0xC07F); asm volatile("" ::: "memory");
        bf16* dst = (bf16*)(ws + WS_VTS) + ((size_t)(b * 4 + g) * 64) * LS + kb * 64 + lane;
#pragma unroll 8
        for (int d = 0; d < 64; ++d) dst[(size_t)d * LS] = (bf16)f2bf(scr[lane * 65 + d]);
        __builtin_amdgcn_s_waitcnt(0xC07F); asm volatile("" ::: "memory");
    }
}

__device__ __forceinline__ void p2_post(const Args& a, unsigned char* lds, int tid) {
    unsigned char* ws = a.ws; float* out = a.out;
    const bf16* ZR = (const bf16*)(ws + WS_ZR); const bf16* ZS = (const bf16*)(ws + WS_ZS);
    bf16* Q = (bf16*)(out + SC_Q); bf16* QI = (bf16*)(out + SC_QI);
    float* cs = (float*)lds;
    bf16* vt = (bf16*)(lds + 4096);
    const int g8 = tid >> 3, sub = tid & 7;
    const float* qg = a.in[9]; const float* kg = a.in[10]; const float* lng = a.in[11]; const float* lnb = a.in[12];
    for (int tile = blockIdx.x; tile < MT / 64; tile += gridDim.x) {
        const int m0 = tile * 64;
        { const int m = m0 + g8, pos = (m < MP) ? (m & (T_P - 1)) : (PAST + ((m - MP) & (T_S - 1)));
          const float inv = powf(500000.0f, -(float)sub * 0.125f); const float ang = (float)pos * inv; float s, c; sincosf(ang, &s, &c);
          cs[g8 * 16 + sub] = c; cs[g8 * 16 + 8 + sub] = s; }
        __syncthreads();
        const int m = m0 + g8;
        const bool isp = m < MP; const int ms = m - MP;
        float cc[8], ss[8];
#pragma unroll
        for (int j = 0; j < 8; ++j) { cc[j] = cs[g8 * 16 + j]; ss[j] = cs[g8 * 16 + 8 + j]; }
        const size_t kvrow = isp ? (size_t)m : ((size_t)(ms >> 5) * LS + PAST + (ms & 31));
        bf16* KB = (bf16*)(ws + (isp ? WS_KBP : WS_KBS)); bf16* KIb = (bf16*)(ws + (isp ? WS_KIP : WS_KIS));
        for (int hb = 0; hb < 25; ++hb) {
            float x[8]; unpack8(*(const u32x4*)(ZR + (size_t)m * ZRW + hb * 64 + 8 * sub), x);
            if (hb < 12) {
                float s2 = 0.f;
#pragma unroll
                for (int j = 0; j < 8; ++j) s2 += x[j] * x[j];
                s2 += __shfl_xor(s2, 1); s2 += __shfl_xor(s2, 2); s2 += __shfl_xor(s2, 4);
                const float rinv = rsqrtf(s2 * (1.f / 64.f) + 1e-6f); const float* gn = (hb < 8 ? qg : kg) + 8 * sub;
                float y[8], o[8];
#pragma unroll
                for (int j = 0; j < 8; ++j) y[j] = x[j] * rinv * gn[j];
#pragma unroll
                for (int j = 0; j < 8; ++j) { const float p = __shfl_xor(y[j], 1); o[j] = sub == 0 ? y[j] * cc[j] - p * ss[j] : (sub == 1 ? y[j] * cc[j] + p * ss[j] : y[j]); }
                if (hb < 8) {
#pragma unroll
                    for (int j = 0; j < 8; ++j) o[j] *= QSCALE;
                    *(u32x4*)(Q + (size_t)m * 512 + hb * 64 + 8 * sub) = pack8(o);
                } else { const int g = hb - 8;
                    float* ko = out + (isp ? OFF_KP + (size_t)m * 256 : OFF_KS + (size_t)ms * 256) + g * 64 + 8 * sub;
                    *(f32x4*)ko = (f32x4){o[0], o[1], o[2], o[3]}; *(f32x4*)(ko + 4) = (f32x4){o[4], o[5], o[6], o[7]};
                    *(u32x4*)(KB + kvrow * 256 + g * 64 + 8 * sub) = pack8(o); }
            } else if (hb < 16) { const int g = hb - 12;
                float* vo = out + (isp ? OFF_VP + (size_t)m * 256 : OFF_VS + (size_t)ms * 256) + g * 64 + 8 * sub;
                *(f32x4*)vo = (f32x4){x[0], x[1], x[2], x[3]}; *(f32x4*)(vo + 4) = (f32x4){x[4], x[5], x[6], x[7]};
                unsigned* vd = (unsigned*)(vt + g8 * 258 + g * 64 + 8 * sub);
                vd[0] = pk2(x[0], x[1]); vd[1] = pk2(x[2], x[3]); vd[2] = pk2(x[4], x[5]); vd[3] = pk2(x[6], x[7]);
            } else if (hb < 24) {
                float o[8];
#pragma unroll
                for (int j = 0; j < 8; ++j) { const float p = __shfl_xor(x[j], 1); o[j] = sub == 0 ? x[j] * cc[j] - p * ss[j] : (sub == 1 ? x[j] * cc[j] + p * ss[j] : x[j]); }
                *(u32x4*)(QI + (size_t)m * 512 + (hb - 16) * 64 + 8 * sub) = pack8(o);
            } else {
                float s1 = 0.f;
#pragma unroll
                for (int j = 0; j < 8; ++j) s1 += x[j];
                s1 += __shfl_xor(s1, 1); s1 += __shfl_xor(s1, 2); s1 += __shfl_xor(s1, 4);
                const float mu = s1 * (1.f / 64.f); float s2 = 0.f;
#pragma unroll
                for (int j = 0; j < 8; ++j) { const float d = x[j] - mu; s2 += d * d; }
                s2 += __shfl_xor(s2, 1); s2 += __shfl_xor(s2, 2); s2 += __shfl_xor(s2, 4);
                const float rinv = rsqrtf(s2 * (1.f / 64.f) + 1e-6f); float y[8], o[8];
#pragma unroll
                for (int j = 0; j < 8; ++j) y[j] = (x[j] - mu) * rinv * lng[8 * sub + j] + lnb[8 * sub + j];
#pragma unroll
                for (int j = 0; j < 8; ++j) { const float p = __shfl_xor(y[j], 1); o[j] = sub == 0 ? y[j] * cc[j] - p * ss[j] : (sub == 1 ? y[j] * cc[j] + p * ss[j] : y[j]); }
                float* ko = out + (isp ? OFF_KIP + (size_t)m * 64 : OFF_KIS + (size_t)ms * 64) + 8 * sub;
                *(f32x4*)ko = (f32x4){o[0], o[1], o[2], o[3]}; *(f32x4*)(ko + 4) = (f32x4){o[4], o[5], o[6], o[7]};
                *(u32x4*)(KIb + kvrow * 64 + 8 * sub) = pack8(o);
            }
        }
        ((float*)(ws + WS_WI))[(size_t)m * 8 + sub] = bf1(ZR[(size_t)m * ZRW + 1600 + sub]) * WISCALE;
        __syncthreads();
        { const int r = tid >> 1, half = tid & 1; unsigned wv[16];
#pragma unroll
          for (int j = 0; j < 16; ++j) wv[j] = (unsigned)vt[(32 * half + 2 * j) * 258 + r] | ((unsigned)vt[(32 * half + 2 * j + 1) * 258 + r] << 16);
          bf16* dst;
          if (m0 < MP) dst = (bf16*)(ws + WS_VTP) + ((size_t)(m0 >> 11) * 256 + r) * T_P + (m0 & (T_P - 1)) + 32 * half;
          else { const int b = ((m0 - MP) >> 5) + half; dst = (bf16*)(ws + WS_VTS) + ((size_t)b * 256 + r) * LS + PAST; }
#pragma unroll
          for (int j = 0; j < 4; ++j) ((u32x4*)dst)[j] = (u32x4){wv[4 * j], wv[4 * j + 1], wv[4 * j + 2], wv[4 * j + 3]}; }
        if (m0 < MP) { if ((m0 & (T_P - 1)) == T_P - 64) { const int b = m0 >> 11; const bf16* zr = ZS + (size_t)(m0 + 63) * SHIFTW;
                for (int c = tid; c < SHIFTW; c += 512) out[OFF_SHP + (size_t)b * SHIFTW + c] = bf1(zr[c]); } }
        else { for (int h2 = 0; h2 < 2; ++h2) { const int b = ((m0 - MP) >> 5) + h2; const bf16* zr = ZS + (size_t)(m0 + 32 * h2 + 31) * SHIFTW;
                for (int c = tid; c < SHIFTW; c += 512) out[OFF_SHS + (size_t)b * SHIFTW + c] = bf1(zr[c]); } }
        __syncthreads();
    }
}

constexpr int ATT_UNITS = 544;
constexpr int MASK_PITCH = 65;
#define MFMA32(a, b, c) __builtin_amdgcn_mfma_f32_32x32x16_bf16((a), (b), (c), 0, 0, 0)

__device__ __forceinline__ float half_sum32(float v) { v += __shfl_xor(v, 1); v += __shfl_xor(v, 2); v += __shfl_xor(v, 4); v += __shfl_xor(v, 8); v += __shfl_xor(v, 16); return v; }
__device__ __forceinline__ float half_min32(float v) { v = fminf(v, __shfl_xor(v, 1)); v = fminf(v, __shfl_xor(v, 2)); v = fminf(v, __shfl_xor(v, 4)); v = fminf(v, __shfl_xor(v, 8)); v = fminf(v, __shfl_xor(v, 16)); return v; }
__device__ __forceinline__ float half_max32(float v) { v = fmaxf(v, __shfl_xor(v, 1)); v = fmaxf(v, __shfl_xor(v, 2)); v = fmaxf(v, __shfl_xor(v, 4)); v = fmaxf(v, __shfl_xor(v, 8)); v = fmaxf(v, __shfl_xor(v, 16)); return v; }
__device__ __forceinline__ int half_sum32i(int v) { v += __shfl_xor(v, 1); v += __shfl_xor(v, 2); v += __shfl_xor(v, 4); v += __shfl_xor(v, 8); v += __shfl_xor(v, 16); return v; }

#define LAS3 __attribute__((address_space(3)))
constexpr int A_RING1 = 0, A_SCL = 24576, A_RING2 = 24576, A_MASK = 0, A_LSUM = 8320, A_UNIT = 9344;
__device__ __forceinline__ void p3_attention(const Args& a, unsigned char* lds, int tid, int rep) {
    unsigned char* ws = a.ws; float* out = a.out;
    const bf16* Q = (const bf16*)(out + SC_Q); const bf16* QI = (const bf16*)(out + SC_QI); const float* WI = (const float*)(ws + WS_WI);
    bf16* O = (bf16*)(ws + WS_XB);
    unsigned* maskw = (unsigned*)(lds + A_MASK);
    float* lsum = (float*)(lds + A_LSUM);
    int* s_unit = (int*)(lds + A_UNIT);
    typedef float f32x2_t __attribute__((ext_vector_type(2)));
    f32x2_t* scl = (f32x2_t*)(lds + A_SCL) + (size_t)(tid >> 6) * 2048 + (tid & 63);
    unsigned* qctr = (unsigned*)(ws + WS_CTL) + CW_QATT + 64 * rep;
    const int l = tid & 63, w = __builtin_amdgcn_readfirstlane(tid >> 6), rho = l & 31, hi = l >> 5;
    LAS3 unsigned char* ldsb = (LAS3 unsigned char*)lds;
    for (;;) {
        if (tid == 0) *s_unit = (int)atomicAdd(qctr, 1u);
        __syncthreads();
        const int p = *s_unit;
        __syncthreads();
        if (p >= ATT_UNITS) break;
        int m0, nkt, vpitch; const bf16 *KB, *VT, *KI; bool need_idx;
        { int c = -1, b, half = 0;
          if (p < 256) { c = 31 - (p >> 4); b = (p & 15) >> 1; half = p & 1; }
          else if (p < 288) { b = p - 256; }
          else { const int pp = p - 288; c = 15 - (pp >> 4); b = (pp & 15) >> 1; half = pp & 1; }
          if (c >= 0) { m0 = b * T_P + 64 * c + 32 * half; nkt = 2 * (c + 1); vpitch = T_P; need_idx = c >= 4;
              KB = (const bf16*)(ws + WS_KBP) + (size_t)b * T_P * 256; VT = (const bf16*)(ws + WS_VTP) + (size_t)b * 256 * T_P; KI = (const bf16*)(ws + WS_KIP) + (size_t)b * T_P * 64; }
          else { m0 = MP + 32 * b; nkt = LS / 32; vpitch = LS; need_idx = true;
              KB = (const bf16*)(ws + WS_KBS) + (size_t)b * LS * 256; VT = (const bf16*)(ws + WS_VTS) + (size_t)b * 256 * LS; KI = (const bf16*)(ws + WS_KIS) + (size_t)b * LS * 64; } }
        if (need_idx) {
            const int tokA = 4 * w + 2 * ((rho >> 2) & 1) + (rho >> 4), headA = (rho & 3) + 4 * ((rho >> 3) & 1);
            bf16x8 qa[4];
#pragma unroll
            for (int ks = 0; ks < 4; ++ks) qa[ks] = *(const bf16x8*)(QI + (size_t)(m0 + tokA) * 512 + headA * 64 + 16 * ks + 8 * hi);
            float wv[16];
#pragma unroll
            for (int r = 0; r < 16; ++r) wv[r] = WI[(size_t)(m0 + 4 * w + 2 * hi + (r >> 3)) * 8 + (r & 7)];
            asm volatile("" :: "v"(qa[0]), "v"(qa[1]), "v"(qa[2]), "v"(qa[3]));
#pragma unroll
            for (int r = 0; r < 16; ++r) asm volatile("" :: "v"(wv[r]));
            asm volatile("s_waitcnt vmcnt(0)" ::: "memory");
            float sc0[32], sc1[32];
            const int nb = (nkt + 1) >> 1;
            const int sr = 8 * w + (l >> 3), scn = (l & 7) ^ ((sr >> 1) & 7);
            const unsigned char* ksrc = (const unsigned char*)KI + (size_t)sr * 128 + 16 * scn;
#define KI_STAGE(it_) __builtin_amdgcn_global_load_lds((const unsigned*)(ksrc + (size_t)(it_) * 8192), (LAS3 unsigned*)(ldsb + A_RING1 + ((it_) % 3) * 8192 + w * 1024), 16, 0, 0)
            KI_STAGE(0); if (1 < nb) KI_STAGE(1);
#pragma unroll
            for (int it = 0; it < 32; ++it) {
                if (it < nb) {
                    if (it + 1 < nb) asm volatile("s_waitcnt vmcnt(1) lgkmcnt(0)\n\ts_barrier" ::: "memory"); else asm volatile("s_waitcnt vmcnt(0) lgkmcnt(0)\n\ts_barrier" ::: "memory");
                    if (it + 2 < nb) KI_STAGE(it + 2);
                    const unsigned char* tb = lds + A_RING1 + (it % 3) * 8192;
#pragma unroll
                    for (int k2 = 0; k2 < 2; ++k2) { const int kt = 2 * it + k2;
                        if (kt < nkt) {
                            const int r = 32 * k2 + rho; const unsigned char* rowp = tb + r * 128; const int sw = (r >> 1) & 7;
                            f32x16 acc = {0.f, 0.f, 0.f, 0.f, 0.f, 0.f, 0.f, 0.f, 0.f, 0.f, 0.f, 0.f, 0.f, 0.f, 0.f, 0.f};
#pragma unroll
                            for (int ks = 0; ks < 4; ++ks) acc = MFMA32(qa[ks], *(const bf16x8*)(rowp + 16 * ((2 * ks + hi) ^ sw)), acc);
                            float s0 = 0.f, s1 = 0.f;
#pragma unroll
                            for (int r2 = 0; r2 < 8; ++r2) { s0 += wv[r2] * fmaxf(acc[r2], 0.f); s1 += wv[8 + r2] * fmaxf(acc[8 + r2], 0.f); }
                            if (kt < 32) { sc0[kt & 31] = s0; sc1[kt & 31] = s1; } else scl[(kt - 32) * 64] = (f32x2_t){s0, s1};
                        } else if (kt < 32) { sc0[kt & 31] = -3.0e38f; sc1[kt & 31] = -3.0e38f; }
                    }
                } else { if (2 * it < 32) { sc0[(2 * it) & 31] = -3.0e38f; sc1[(2 * it) & 31] = -3.0e38f; sc0[(2 * it + 1) & 31] = -3.0e38f; sc1[(2 * it + 1) & 31] = -3.0e38f; } }
            }
#undef KI_STAGE
            __syncthreads();
            float mn0 = 3.0e38f, mx0 = -3.0e38f, mn1 = 3.0e38f, mx1 = -3.0e38f;
#pragma unroll
            for (int kt = 0; kt < 64; ++kt) if (kt < nkt) { float v0, v1; if (kt < 32) { v0 = sc0[kt & 31]; v1 = sc1[kt & 31]; } else { const f32x2_t t2 = scl[(kt - 32) * 64]; v0 = t2.x; v1 = t2.y; }
                mn0 = fminf(mn0, v0); mx0 = fmaxf(mx0, v0); mn1 = fminf(mn1, v1); mx1 = fmaxf(mx1, v1); }
            mn0 = half_min32(mn0); mx0 = half_max32(mx0); mn1 = half_min32(mn1); mx1 = half_max32(mx1);
            float lo0 = mn0 - 1.0f, hi0 = mx0, lo1 = mn1 - 1.0f, hi1 = mx1, thr0 = 0.f, thr1 = 0.f; int ch0 = 0, ch1 = 0, nt0 = 0, nt1 = 0; bool fin0 = false, fin1 = false;
            for (int iter = 0; iter < 200; ++iter) {
                const float mid0 = lo0 + 0.5f * (hi0 - lo0), mid1 = lo1 + 0.5f * (hi1 - lo1);
                int c0 = 0, c1 = 0;
#pragma unroll
                for (int g = 0; g < 4; ++g) if (8 * g < nkt) {
#pragma unroll
                    for (int k8 = 0; k8 < 8; ++k8) { c0 += sc0[8 * g + k8] > mid0 ? 1 : 0; c1 += sc1[8 * g + k8] > mid1 ? 1 : 0; } }
                for (int kt = 32; kt < nkt; kt += 8) {
                    f32x2_t t8[8];
#pragma unroll
                    for (int u = 0; u < 8; ++u) t8[u] = scl[(kt + u - 32) * 64];
#pragma unroll
                    for (int u = 0; u < 8; ++u) if (kt + u < nkt) { c0 += t8[u].x > mid0 ? 1 : 0; c1 += t8[u].y > mid1 ? 1 : 0; } }
                c0 = half_sum32i(c0); c1 = half_sum32i(c1);
                if (!fin0) { if (!(mid0 > lo0 && mid0 < hi0)) { fin0 = true; thr0 = hi0; nt0 = 256 - ch0; }
                             else if (c0 == 256) { fin0 = true; thr0 = mid0; nt0 = 0; } else if (c0 > 256) lo0 = mid0; else { hi0 = mid0; ch0 = c0; } }
                if (!fin1) { if (!(mid1 > lo1 && mid1 < hi1)) { fin1 = true; thr1 = hi1; nt1 = 256 - ch1; }
                             else if (c1 == 256) { fin1 = true; thr1 = mid1; nt1 = 0; } else if (c1 > 256) lo1 = mid1; else { hi1 = mid1; ch1 = c1; } }
                if (__all(fin0 && fin1)) break;
            }
            const bool any_tie = __any(nt0 > 0 || nt1 > 0);
            int run0 = 0, run1 = 0; const unsigned below = (1u << rho) - 1u;
#pragma unroll
            for (int kt = 0; kt < 64; ++kt) if (kt < nkt) {
                float v0, v1; if (kt < 32) { v0 = sc0[kt & 31]; v1 = sc1[kt & 31]; } else { const f32x2_t t2 = scl[(kt - 32) * 64]; v0 = t2.x; v1 = t2.y; }
                bool p0 = v0 > thr0, p1 = v1 > thr1;
                if (any_tie) {
                    const bool e0 = nt0 > 0 && v0 == thr0, e1 = nt1 > 0 && v1 == thr1;
                    const unsigned long long be0 = __ballot(e0), be1 = __ballot(e1);
                    const unsigned h0 = (unsigned)(be0 >> (32 * hi)), h1 = (unsigned)(be1 >> (32 * hi));
                    p0 = p0 || (e0 && (run0 + __popc(h0 & below)) < nt0); p1 = p1 || (e1 && (run1 + __popc(h1 & below)) < nt1);
                    run0 += __popc(h0); run1 += __popc(h1);
                }
                const unsigned long long b0 = __ballot(p0), b1 = __ballot(p1);
                if (l == 0) { maskw[(4 * w + 0) * MASK_PITCH + kt] = (unsigned)b0; maskw[(4 * w + 1) * MASK_PITCH + kt] = (unsigned)b1; }
                if (l == 32) { maskw[(4 * w + 2) * MASK_PITCH + kt] = (unsigned)(b0 >> 32); maskw[(4 * w + 3) * MASK_PITCH + kt] = (unsigned)(b1 >> 32); }
            }
        }
        __syncthreads();
        {
            const int g = w >> 1;
            bf16x8 qb[4];
#pragma unroll
            for (int ks = 0; ks < 4; ++ks) qb[ks] = *(const bf16x8*)(Q + (size_t)(m0 + rho) * 512 + w * 64 + 16 * ks + 8 * hi);
            asm volatile("" :: "v"(qb[0]), "v"(qb[1]), "v"(qb[2]), "v"(qb[3]));
            asm volatile("s_waitcnt vmcnt(0)" ::: "memory");
            const unsigned char* ksrc[2]; const unsigned char* vsrc[2];
#pragma unroll
            for (int k = 0; k < 2; ++k) { const int i = (k * 8 + w) * 64 + l; const int r = i >> 5, c = i & 31; ksrc[k] = (const unsigned char*)KB + (size_t)r * 512 + 16 * (c ^ (r & 15));
                const int R = i >> 2, cv = i & 3; vsrc[k] = (const unsigned char*)VT + (size_t)R * vpitch * 2 + 16 * (cv ^ ((R >> 2) & 3)); }
#define KV_STAGE(t_) do { const int bo_ = A_RING2 + ((t_) % 3) * 32768 + w * 1024; \
            __builtin_amdgcn_global_load_lds((const unsigned*)(ksrc[0] + (size_t)(t_) * 16384), (LAS3 unsigned*)(ldsb + bo_), 16, 0, 0); \
            __builtin_amdgcn_global_load_lds((const unsigned*)(ksrc[1] + (size_t)(t_) * 16384), (LAS3 unsigned*)(ldsb + bo_ + 8192), 16, 0, 0); \
            __builtin_amdgcn_global_load_lds((const unsigned*)(vsrc[0] + (size_t)(t_) * 64), (LAS3 unsigned*)(ldsb + bo_ + 16384), 16, 0, 0); \
            __builtin_amdgcn_global_load_lds((const unsigned*)(vsrc[1] + (size_t)(t_) * 64), (LAS3 unsigned*)(ldsb + bo_ + 24576), 16, 0, 0); } while (0)
            f32x16 o0 = {0.f, 0.f, 0.f, 0.f, 0.f, 0.f, 0.f, 0.f, 0.f, 0.f, 0.f, 0.f, 0.f, 0.f, 0.f, 0.f}, o1 = o0; float psum = 0.f;
            const int ksw = rho & 15;
            const int vR0 = g * 64 + rho, vR1 = vR0 + 32; const int vs0 = (vR0 >> 2) & 3, vs1 = (vR1 >> 2) & 3;
            KV_STAGE(0); if (1 < nkt) KV_STAGE(1);
            for (int kt = 0; kt < nkt; ++kt) {
                if (kt + 1 < nkt) asm volatile("s_waitcnt vmcnt(4) lgkmcnt(0)\n\ts_barrier" ::: "memory"); else asm volatile("s_waitcnt vmcnt(0) lgkmcnt(0)\n\ts_barrier" ::: "memory");
                if (kt + 2 < nkt) KV_STAGE(kt + 2);
                const unsigned char* kbuf = lds + A_RING2 + (kt % 3) * 32768; const unsigned char* vbuf = kbuf + 16384;
                f32x16 st = {0.f, 0.f, 0.f, 0.f, 0.f, 0.f, 0.f, 0.f, 0.f, 0.f, 0.f, 0.f, 0.f, 0.f, 0.f, 0.f};
#pragma unroll
                for (int ks = 0; ks < 4; ++ks) st = MFMA32(*(const bf16x8*)(kbuf + rho * 512 + 16 * ((g * 8 + 2 * ks + hi) ^ ksw)), qb[ks], st);
                unsigned word = need_idx ? maskw[rho * MASK_PITCH + kt] : 0xffffffffu; word >>= 4 * hi; float pr[16];
#pragma unroll
                for (int r = 0; r < 16; ++r) { const float e = __builtin_amdgcn_exp2f(st[r]); pr[r] = ((word >> ((r & 3) + 8 * (r >> 2))) & 1u) ? e : 0.f; psum += pr[r]; }
                union { u32x4 u; bf16x8 v; } pa0, pa1; pa0.u = (u32x4){pg8::cvt_pk_bf16(pr[0], pr[1]), pg8::cvt_pk_bf16(pr[2], pr[3]), pg8::cvt_pk_bf16(pr[4], pr[5]), pg8::cvt_pk_bf16(pr[6], pr[7])}; pa1.u = (u32x4){pg8::cvt_pk_bf16(pr[8], pr[9]), pg8::cvt_pk_bf16(pr[10], pr[11]), pg8::cvt_pk_bf16(pr[12], pr[13]), pg8::cvt_pk_bf16(pr[14], pr[15])};
                union { u32x4 u; bf16x8 v; } vf[2][2];
#pragma unroll
                for (int s2 = 0; s2 < 2; ++s2) { const unsigned char* r0 = vbuf + vR0 * 64 + 8 * hi; const unsigned char* r1 = vbuf + vR1 * 64 + 8 * hi;
                    const u32x2 a0 = *(const u32x2*)(r0 + 16 * ((2 * s2) ^ vs0)), a1 = *(const u32x2*)(r0 + 16 * ((2 * s2 + 1) ^ vs0)), b0 = *(const u32x2*)(r1 + 16 * ((2 * s2) ^ vs1)), b1 = *(const u32x2*)(r1 + 16 * ((2 * s2 + 1) ^ vs1));
                    vf[s2][0].u = (u32x4){a0.x, a0.y, a1.x, a1.y}; vf[s2][1].u = (u32x4){b0.x, b0.y, b1.x, b1.y}; }
                o0 = MFMA32(pa0.v, vf[0][0].v, o0); o0 = MFMA32(pa1.v, vf[1][0].v, o0); o1 = MFMA32(pa0.v, vf[0][1].v, o1); o1 = MFMA32(pa1.v, vf[1][1].v, o1);
            }
#undef KV_STAGE
            psum += __shfl_xor(psum, 32);
            if (hi == 0) lsum[w * 32 + rho] = psum;
            __syncthreads();
#pragma unroll
            for (int r = 0; r < 16; ++r) { const int qr = crow(r, hi); const float inv = 1.0f / lsum[w * 32 + qr];
                bf16* op = O + (size_t)(m0 + qr) * DM + w * 64 + rho;
                op[0] = (bf16)f2bf(o0[r] * inv); op[32] = (bf16)f2bf(o1[r] * inv); }
        }
        __syncthreads();
    }
}

constexpr int XS_PITCH = 168;
__device__ __forceinline__ void p4_rwkv_prep(const Args& a, unsigned char* lds, int tid) {
    unsigned char* ws = a.ws; float* out = a.out;
    const bf16* ZS = (const bf16*)(ws + WS_ZS);
    const bf16* w2t = (const bf16*)(ws + WS_W2T); const bf16* a2t = (const bf16*)(ws + WS_A2T); const bf16* g2t = (const bf16*)(ws + WS_G2T);
    float* OW = (float*)(ws + WS_OW); bf16* OKK = (bf16*)(ws + WS_OKK); bf16* OB = (bf16*)(ws + WS_OB); bf16* OKM = (bf16*)(ws + WS_OKM); bf16* OR_ = (bf16*)(ws + WS_OR); bf16* OV = (bf16*)(ws + WS_OV);
    bf16* G = (bf16*)(out + SC_G); float* BON = (float*)(ws + WS_BONUS);
    const float* mu = a.in[13]; const float* w0 = a.in[14]; const float* a0 = a.in[16]; const float* k_k = a.in[19]; const float* k_a = a.in[20]; const float* r_k = a.in[21]; const float* sh0 = a.in[6];
    bf16* xs = (bf16*)lds;
    const int l = tid & 63, h = __builtin_amdgcn_readfirstlane(tid >> 6), rho = l & 31, hi = l >> 5;
    for (int tile = blockIdx.x; tile < MT / 32; tile += gridDim.x) {
        const int m0 = tile * 32; const bool smp = m0 >= MP;
        const bool tile_first = smp || (m0 & (T_P - 1)) == 0;
        { const int tk = tid >> 4, c0 = (tid & 15) * 10, m = m0 + tk; const bool first = tile_first && tk == 0;
          const bf16* zc = ZS + (size_t)m * SHIFTW + 1536 + c0; const bf16* zp = first ? zc : zc - SHIFTW;
          const float* shp = sh0 + (size_t)(smp ? ((m0 - MP) >> 5) : 0) * SHIFTW + 1536 + c0;
#pragma unroll
          for (int e = 0; e < 10; ++e) { const int c = c0 + e; const float cur = bf1(zc[e]); float prev = bf1(zp[e]);
              if (first) prev = smp ? shp[e] : 0.f;
              const float zm = cur + mu[1536 + c] * (prev - cur);
              const float f = __frcp_rn(1.0f + __expf(c < 32 ? -2.0f * zm : -zm));
              const float v = c < 32 ? 2.0f * f - 1.0f : (c < 64 ? zm : f);
              xs[tk * XS_PITCH + c] = (bf16)f2bf(v); } }
        __syncthreads();
        const int m = m0 + rho; const bool first = tile_first && rho == 0;
        const bf16* zc = ZS + (size_t)m * SHIFTW + 64 * h + 4 * hi; const bf16* zp = first ? zc : zc - SHIFTW;
        const float* shp = sh0 + (size_t)(smp ? ((m0 - MP) >> 5) : 0) * SHIFTW + 64 * h + 4 * hi;
        const float* mu_l = mu + 64 * h + 4 * hi;
        const int pofs = 64 * h + 4 * hi;
#define ZMIX4(dst, co) do { const u32x2 cw = *(const u32x2*)(zc + (co)); const u32x2 pw = *(const u32x2*)(zp + (co)); const f32x4 mu4 = *(const f32x4*)(mu_l + (co)); \
            const float cu[4] = {bflo(cw.x), bfhi(cw.x), bflo(cw.y), bfhi(cw.y)}; float pv[4] = {bflo(pw.x), bfhi(pw.x), bflo(pw.y), bfhi(pw.y)}; \
            if (tile_first) { f32x4 s4 = {0.f, 0.f, 0.f, 0.f}; if (smp) s4 = *(const f32x4*)(shp + (co)); if (first) { pv[0] = s4.x; pv[1] = s4.y; pv[2] = s4.z; pv[3] = s4.w; } } \
            _Pragma("unroll") for (int e = 0; e < 4; ++e) dst[e] = cu[e] + mu4[e] * (pv[e] - cu[e]); } while (0)
        float n2 = 0.f;
#pragma unroll
        for (int ct = 0; ct < 2; ++ct)
#pragma unroll
            for (int grp = 0; grp < 4; ++grp) { const int co = 32 * ct + 8 * grp; float zk[4]; ZMIX4(zk, 512 + co); const f32x4 kk4 = *(const f32x4*)(k_k + pofs + co);
#pragma unroll
                for (int e = 0; e < 4; ++e) { const float kr = zk[e] * kk4[e]; n2 += kr * kr; } }
        n2 += __shfl_xor(n2, 32);
        const float invn = 1.0f / fmaxf(sqrtf(n2), 1e-12f);
        float bon = 0.f;
        asm volatile("" ::: "memory");
#pragma unroll
        for (int ct = 0; ct < 2; ++ct) {
            const f32x16 z16 = {0.f, 0.f, 0.f, 0.f, 0.f, 0.f, 0.f, 0.f, 0.f, 0.f, 0.f, 0.f, 0.f, 0.f, 0.f, 0.f}; f32x16 Dw = z16, Da = z16, Dg = z16;
            const int n = 64 * h + 32 * ct + rho;
            const bf16* xrow = xs + rho * XS_PITCH + 8 * hi;
#pragma unroll
            for (int ks = 0; ks < 2; ++ks) {
                Dw = MFMA32(*(const bf16x8*)(w2t + n * 32 + 16 * ks + 8 * hi), *(const bf16x8*)(xrow + 16 * ks), Dw);
                Da = MFMA32(*(const bf16x8*)(a2t + n * 32 + 16 * ks + 8 * hi), *(const bf16x8*)(xrow + 32 + 16 * ks), Da); }
#pragma unroll
            for (int ks = 0; ks < 6; ++ks) Dg = MFMA32(*(const bf16x8*)(g2t + n * 96 + 16 * ks + 8 * hi), *(const bf16x8*)(xrow + 64 + 16 * ks), Dg);
#pragma unroll
            for (int grp = 0; grp < 4; ++grp) {
                const int co = 32 * ct + 8 * grp;
                float zr[4], zk[4], zv[4]; ZMIX4(zr, co); ZMIX4(zk, 512 + co); ZMIX4(zv, 1024 + co);
                const f32x4 w04 = *(const f32x4*)(w0 + pofs + co), a04 = *(const f32x4*)(a0 + pofs + co), kk4 = *(const f32x4*)(k_k + pofs + co), ka4 = *(const f32x4*)(k_a + pofs + co), rk4 = *(const f32x4*)(r_k + pofs + co);
                float dec[4], km[4], gg[4], kk[4], bb[4];
#pragma unroll
                for (int e = 0; e < 4; ++e) { const int r = 4 * grp + e;
                    const float sg = __frcp_rn(1.0f + __expf(-(w04[e] + Dw[r])));
                    dec[e] = __expf(-0.6065306597126334f * sg);
                    const float aa = __frcp_rn(1.0f + __expf(-(a04[e] + Da[r])));
                    gg[e] = Dg[r];
                    kk[e] = zk[e] * kk4[e] * invn; bb[e] = kk[e] * aa;
                    km[e] = zk[e] * (1.0f + (aa - 1.0f) * ka4[e]);
                    bon += zr[e] * km[e] * rk4[e]; }
                const size_t o = (size_t)m * 512 + pofs + co;
                *(f32x4*)(OW + o) = (f32x4){dec[0], dec[1], dec[2], dec[3]};
                *(u32x2*)(OKK + o) = (u32x2){pk2(kk[0], kk[1]), pk2(kk[2], kk[3])};
                *(u32x2*)(OB + o) = (u32x2){pk2(bb[0], bb[1]), pk2(bb[2], bb[3])};
                *(u32x2*)(OKM + o) = (u32x2){pk2(km[0], km[1]), pk2(km[2], km[3])};
                *(u32x2*)(OR_ + o) = (u32x2){pk2(zr[0], zr[1]), pk2(zr[2], zr[3])};
                *(u32x2*)(OV + o) = (u32x2){pk2(zv[0], zv[1]), pk2(zv[2], zv[3])};
                *(u32x2*)(G + o) = (u32x2){pk2(gg[0], gg[1]), pk2(gg[2], gg[3])};
                asm volatile("" ::: "memory");
            }
        }
#undef ZMIX4
        bon += __shfl_xor(bon, 32);
        if (hi == 0) BON[(size_t)m * 8 + h] = bon;
        __syncthreads();
    }
}

constexpr int SC_CH = 32;
static_assert(WS_OB - WS_OKK == 17 * MiB && WS_OKM - WS_OB == 17 * MiB && WS_OR - WS_OKM == 17 * MiB && WS_OV - WS_OR == 17 * MiB, "operand arrays are equally spaced");
__device__ __forceinline__ void cvt_store8(unsigned char* d, const u32x4 x) {
    *(u32x4*)d = (u32x4){x.x << 16, x.x & 0xffff0000u, x.y << 16, x.y & 0xffff0000u}; *(u32x4*)(d + 16) = (u32x4){x.z << 16, x.z & 0xffff0000u, x.w << 16, x.w & 0xffff0000u};
}
struct StageP {
    static constexpr int STRIDE = 1280 + 64;
    const unsigned char* pw; const unsigned char* pb; int vrow0;
    u32x4 v[25];
    __device__ __forceinline__ void issue(int t0, int lane) {
        const unsigned char* gw = pw + ((size_t)(t0 + (lane >> 4)) * 512) * 4 + 16 * (lane & 15);
#pragma unroll
        for (int j = 0; j < 8; ++j) v[j] = *(const u32x4*)(gw + (size_t)j * 4 * 512 * 4);
        const unsigned char* gb = pb + ((size_t)(t0 + (lane >> 3)) * 512) * 2 + 16 * (lane & 7);
#pragma unroll
        for (int a = 0; a < 4; ++a)
#pragma unroll
            for (int jj = 0; jj < 4; ++jj) v[8 + 4 * a + jj] = *(const u32x4*)(gb + (size_t)a * (17 * MiB) + (size_t)jj * 8 * 512 * 2);
        v[24] = *(const u32x4*)(pb + (size_t)4 * (17 * MiB) + ((size_t)(t0 + (lane >> 1)) * 512) * 2 + 2 * vrow0 + 16 * (lane & 1));
    }
    __device__ __forceinline__ void commit(unsigned char* buf, int lane) const {
        unsigned char* dw = buf + (lane >> 4) * STRIDE + 16 * (lane & 15);
#pragma unroll
        for (int j = 0; j < 8; ++j) *(u32x4*)(dw + j * 4 * STRIDE) = v[j];
        unsigned char* db = buf + (lane >> 3) * STRIDE + 256 + 32 * (lane & 7);
#pragma unroll
        for (int a = 0; a < 4; ++a)
#pragma unroll
            for (int jj = 0; jj < 4; ++jj) cvt_store8(db + a * 256 + jj * 8 * STRIDE, v[8 + 4 * a + jj]);
        cvt_store8(buf + (lane >> 1) * STRIDE + 1280 + 32 * (lane & 1), v[24]);
    }
};
struct StageS {
    static constexpr int STRIDE = 1280 + 256;
    const unsigned char* pw; const unsigned char* pb;
    u32x4 v[7];
    __device__ __forceinline__ void issue(int t0, int lane) {
        const unsigned char* gw = pw + ((size_t)(t0 + (lane >> 4)) * 512) * 4 + 16 * (lane & 15);
        v[0] = *(const u32x4*)gw; v[1] = *(const u32x4*)(gw + (size_t)4 * 512 * 4);
        const unsigned char* gb = pb + ((size_t)(t0 + (lane >> 3)) * 512) * 2 + 16 * (lane & 7);
#pragma unroll
        for (int a = 0; a < 5; ++a) v[2 + a] = *(const u32x4*)(gb + (size_t)a * (17 * MiB));
    }
    __device__ __forceinline__ void commit(unsigned char* buf, int lane) const {
        unsigned char* dw = buf + (lane >> 4) * STRIDE + 16 * (lane & 15);
        *(u32x4*)dw = v[0]; *(u32x4*)(dw + 4 * STRIDE) = v[1];
        unsigned char* db = buf + (lane >> 3) * STRIDE + 256 + 32 * (lane & 7);
#pragma unroll
        for (int a = 0; a < 5; ++a) cvt_store8(db + a * 256, v[2 + a]);
    }
};
typedef float f32x2 __attribute__((ext_vector_type(2)));
template <int STRIDE> __device__ __forceinline__ void scan_consume(f32x4& S4, const unsigned char* buf, int nst, int ks, int rowl, float* yp) {
    f32x2 Sa = {S4.x, S4.y}, Sb = {S4.z, S4.w};
    for (int s0 = 0; s0 < nst; s0 += 16) {
        float ykeep = 0.f;
#pragma unroll 1
        for (int g = 0; g < 4; ++g) {
            const int kq = ks - 4 * g;
#pragma unroll
            for (int j = 0; j < 4; ++j) {
                const float* p = (const float*)(buf + (s0 + 4 * g + j) * STRIDE) + 4 * ks;
                const f32x2 wa = *(const f32x2*)(p), wb = *(const f32x2*)(p + 2), ka = *(const f32x2*)(p + 64), kb = *(const f32x2*)(p + 66), ba = *(const f32x2*)(p + 128), bb = *(const f32x2*)(p + 130),
                            ma = *(const f32x2*)(p + 192), mb = *(const f32x2*)(p + 194), ra = *(const f32x2*)(p + 256), rb = *(const f32x2*)(p + 258);
                const float v = ((const float*)(buf + (s0 + 4 * g + j) * STRIDE))[320 + rowl];
                f32x2 t = Sa * ka + Sb * kb; float d = t.x + t.y; d = sum16(d);
                const f32x2 vv = {v, v}, dd = {d, d};
                Sa = Sa * wa + (vv * ma - dd * ba); Sb = Sb * wb + (vv * mb - dd * bb);
                f32x2 u = Sa * ra + Sb * rb; float y = u.x + u.y; y = sum16(y);
                ykeep = kq == j ? y : ykeep;
            }
        }
        yp[(size_t)(s0 + ks) * 512] = ykeep;
    }
    S4 = (f32x4){Sa.x, Sa.y, Sb.x, Sb.y};
}
__device__ __forceinline__ void p5_rwkv_scan(const Args& a, unsigned char* lds, int tid) {
    const unsigned char* ws = a.ws; float* out = a.out; float* Y = out + SC_Y;
    const int l = tid & 63, w = __builtin_amdgcn_readfirstlane(tid >> 6), ks = l & 15, rl = l >> 4;
    const int G = gridDim.x, vcu = (G % 8 == 0) ? (blockIdx.x % 8) * (G / 8) + blockIdx.x / 8 : blockIdx.x;
    typedef StageP StP; typedef StageS StS;
    unsigned char* buf0 = lds; unsigned char* buf1 = lds + SC_CH * StP::STRIDE;
    for (int it = vcu; it < 256; it += G) {
        {
            const int bh = it >> 2, b = bh >> 3, h = bh & 7, rb = it & 3, row = 16 * rb + 4 * w + rl;
            const size_t base0 = ((size_t)b * T_P) * 512 + (size_t)h * 64;
            constexpr int NC = T_P / SC_CH;
            StP st; st.pw = ws + WS_OW + base0 * 4; st.pb = ws + WS_OKK + base0 * 2; st.vrow0 = 16 * rb;
            f32x4 S = {0.f, 0.f, 0.f, 0.f};
            if (w >= 4) { if (w == 4) { st.issue(0, l); st.commit(buf0, l); st.issue(4 * SC_CH, l); } else st.issue((w - 4) * SC_CH, l); }
            else __builtin_amdgcn_s_setprio(3);
            __syncthreads();
            Y += base0 + row;
#define SCAN_ITER(c, P, cur, nxt) do { if (w == 4 + (P)) { if ((c) + 1 < NC) { st.commit(nxt, l); if ((c) + 5 < NC) st.issue(((c) + 5) * SC_CH, l); } } \
                else if (w < 4) scan_consume<StP::STRIDE>(S, cur, SC_CH, ks, 4 * w + rl, Y + (size_t)((c) * SC_CH) * 512); __syncthreads(); } while (0)
            for (int c = 0; c < NC; c += 4) { SCAN_ITER(c, 1, buf0, buf1); SCAN_ITER(c + 1, 2, buf1, buf0); SCAN_ITER(c + 2, 3, buf0, buf1); SCAN_ITER(c + 3, 0, buf1, buf0); }
#undef SCAN_ITER
            __builtin_amdgcn_s_setprio(0);
            Y -= base0 + row;
            if (w < 4) *(f32x4*)(out + OFF_WKVP + ((size_t)bh * 64 + row) * 64 + 4 * ks) = S;
        }
        {
            const int b = it >> 3, h = it & 7;
            const size_t base0 = ((size_t)MP + (size_t)b * T_S) * 512 + (size_t)h * 64;
            StS st; st.pw = ws + WS_OW + base0 * 4; st.pb = ws + WS_OKK + base0 * 2;
            if (w >= 4) { st.issue(8 * (w - 4), l); st.commit(buf0 + 8 * (w - 4) * StS::STRIDE, l); }
            __syncthreads();
            for (int pass = 0; pass < 2; ++pass) { const int row = 8 * w + 4 * pass + rl;
                f32x4 S = *(const f32x4*)(a.in[5] + ((size_t)it * 64 + row) * 64 + 4 * ks);
                scan_consume<StS::STRIDE>(S, buf0, T_S, ks, row, Y + base0 + row);
                *(f32x4*)(out + OFF_WKVS + ((size_t)it * 64 + row) * 64 + 4 * ks) = S; }
            __syncthreads();
        }
    }
}

__device__ __forceinline__ void p6_rwkv_out(const Args& a, int tid) {
    const unsigned char* ws = a.ws; const float* out = a.out; const float* Y = out + SC_Y; const bf16* G = (const bf16*)(out + SC_G);
    const bf16* OV = (const bf16*)(ws + WS_OV); const float* BON = (const float*)(ws + WS_BONUS); bf16* O = (bf16*)(a.ws + WS_XB);
    const float* lg = a.in[22]; const float* lb = a.in[23];
    const int sub = tid & 7;
    for (size_t it = (size_t)blockIdx.x * 64 + (tid >> 3); it < (size_t)MT * 8; it += (size_t)gridDim.x * 64) {
        const size_t m = it >> 3; const int h = (int)(it & 7); const size_t o = m * 512 + h * 64 + 8 * sub;
        const f32x4 y0 = *(const f32x4*)(Y + o), y1 = *(const f32x4*)(Y + o + 4); float y[8] = {y0.x, y0.y, y0.z, y0.w, y1.x, y1.y, y1.z, y1.w};
        float s1 = 0.f;
#pragma unroll
        for (int j = 0; j < 8; ++j) s1 += y[j];
        s1 += __shfl_xor(s1, 1); s1 += __shfl_xor(s1, 2); s1 += __shfl_xor(s1, 4);
        const float mean = s1 * (1.f / 64.f); float s2 = 0.f;
#pragma unroll
        for (int j = 0; j < 8; ++j) { const float d = y[j] - mean; s2 += d * d; }
        s2 += __shfl_xor(s2, 1); s2 += __shfl_xor(s2, 2); s2 += __shfl_xor(s2, 4);
        const float rinv = rsqrtf(s2 * (1.f / 64.f) + 64e-5f);
        float v[8], g[8]; unpack8(*(const u32x4*)(OV + o), v); unpack8(*(const u32x4*)(G + o), g);
        const float bon = BON[it]; float r[8];
#pragma unroll
        for (int j = 0; j < 8; ++j) { const int c = h * 64 + 8 * sub + j; r[j] = ((y[j] - mean) * rinv * lg[c] + lb[c] + bon * v[j]) * g[j]; }
        *(u32x4*)(O + m * DM + 512 + h * 64 + 8 * sub) = pack8(r);
    }
}

__device__ __forceinline__ void p8_hnorm(const Args& a, int tid) {
    const int lane = tid & 63, gw = blockIdx.x * 8 + (tid >> 6), NGW = gridDim.x * 8;
    for (int m = gw; m < MT; m += NGW) {
        const f32x4* xr = (const f32x4*)(a.out + OFF_Y + (size_t)m * DM) + lane; f32x4 v[4]; float s = 0.f;
#pragma unroll
        for (int j = 0; j < 4; ++j) { v[j] = xr[64 * j]; s += (v[j].x * v[j].x + v[j].y * v[j].y) + (v[j].z * v[j].z + v[j].w * v[j].w); }
        const float rs = rsqrtf(wave_sum(s) * (1.f / DM) + 1e-6f);
        u32x2* o8 = (u32x2*)((bf16*)(a.ws + WS_HB) + (size_t)m * DM) + lane;
#pragma unroll
        for (int j = 0; j < 4; ++j) { u32x2 o; o.x = pk2(v[j].x * rs, v[j].y * rs); o.y = pk2(v[j].z * rs, v[j].w * rs); o8[64 * j] = o; }
    }
}

#define XB_TMO      128
#define XB_XCNT(j)  (256  + 64 * (j))
#define XB_XSUB(j)  (1280 + 64 * (j))
#define XB_XGEN(j)  (2304 + 64 * (j))
#define XB_TOP      3328
#define XB_TOPGEN   3392
#define XCD_BAR_WORDS 3456
#define XB_SPIN_CAP (1u << 18)

__device__ __forceinline__ unsigned xb_ld(unsigned* p)              { return __hip_atomic_load(p, __ATOMIC_RELAXED, __HIP_MEMORY_SCOPE_AGENT); }
__device__ __forceinline__ unsigned xb_add(unsigned* p, unsigned v) { return __hip_atomic_fetch_add(p, v, __ATOMIC_RELAXED, __HIP_MEMORY_SCOPE_AGENT); }
__device__ __forceinline__ unsigned xb_xcc_id() { return (unsigned)__builtin_amdgcn_s_getreg((3 << 11) | 20) & 0xFu; }
#define XB_SPIN(cond, bar) do { unsigned _sp = 0; while (cond) { __builtin_amdgcn_s_sleep(1); \
    if ((++_sp & 255u) == 0u) { if (xb_ld(&(bar)[XB_TMO])) break; if (_sp > XB_SPIN_CAP) { atomicAdd(&(bar)[XB_TMO], 1u); break; } } } } while (0)

struct XcdBarrier {
    unsigned* bar; unsigned x;
    volatile __attribute__((address_space(3))) unsigned* st;
};

__device__ __forceinline__ XcdBarrier xcd_barrier_post(unsigned* bar, volatile __attribute__((address_space(3))) unsigned* st) {
    XcdBarrier b; b.bar = bar; b.x = xb_xcc_id(); b.st = st;
    if (threadIdx.x == 0) (void)xb_add(&bar[XB_XCNT(b.x)], 1u);
    return b;
}
__device__ __forceinline__ void xcd_barrier_complete(unsigned* bar, unsigned x, unsigned& nloc, unsigned& nx) {
    const unsigned G = gridDim.x * gridDim.y * gridDim.z;
    unsigned sum, cnt, mine, sp = 0u;
    for (;;) {
        sum = 0u; cnt = 0u; mine = 0u;
#pragma unroll
        for (unsigned j = 0; j < 16; ++j) { const unsigned c = xb_ld(&bar[XB_XCNT(j)]); sum += c; cnt += (c > 0u) ? 1u : 0u; mine = (j == x) ? c : mine; }
        if (sum == G) break;
        __builtin_amdgcn_s_sleep(1);
        if ((++sp & 255u) == 0u) { if (xb_ld(&bar[XB_TMO])) break; if (sp > XB_SPIN_CAP) { atomicAdd(&bar[XB_TMO], 1u); break; } }
    }
    nloc = mine > 0u ? mine : 1u; nx = cnt > 0u ? cnt : 1u;
}

__device__ __forceinline__ void xcd_barrier(const XcdBarrier& b) {
    asm volatile("s_waitcnt vmcnt(0)" ::: "memory");
    __syncthreads();
    if (threadIdx.x == 0) {
        unsigned* bar = b.bar;
        __builtin_amdgcn_s_waitcnt(0);
        unsigned nloc = b.st[0], nx = b.st[1];
        if (nloc == 0u) { xcd_barrier_complete(bar, b.x, nloc, nx); b.st[0] = nloc; b.st[1] = nx; }
        const unsigned old = xb_add(&bar[XB_XSUB(b.x)], 1u);
        const unsigned gen = old / nloc;
        if (old + 1u == (gen + 1u) * nloc) {
            __builtin_amdgcn_fence(__ATOMIC_RELEASE, "agent");
            asm volatile("s_waitcnt vmcnt(0)" ::: "memory");
            const unsigned og = xb_add(&bar[XB_TOP], 1u);
            const unsigned tg = og / nx;
            if (og + 1u == (tg + 1u) * nx) xb_add(&bar[XB_TOPGEN], 1u);
            else XB_SPIN(xb_ld(&bar[XB_TOPGEN]) == tg, bar);
            __builtin_amdgcn_fence(__ATOMIC_ACQUIRE, "agent");
            xb_add(&bar[XB_XGEN(b.x)], 1u);
            asm volatile("s_waitcnt vmcnt(0)" ::: "memory");
        } else {
            XB_SPIN(xb_ld(&bar[XB_XGEN(b.x)]) == gen, bar);
            __builtin_amdgcn_fence(__ATOMIC_ACQUIRE, "agent");
            asm volatile("s_waitcnt vmcnt(0)" ::: "memory");
        }
    }
    __syncthreads();
}

constexpr int CW_BAR = 4096;
constexpr int LDS_BYTES = 163840;
constexpr int N_PHASES = 12;
#ifndef PROBE_MASK
#define PROBE_MASK 0
#endif
template <int PH> __device__ __forceinline__ void run_phase(const Args& args, unsigned char* lds, int tid, int rep) {
    unsigned char* ws = args.ws;
    if constexpr (PH == 0) p0_prologue(args, lds, tid);
    if constexpr (PH == 1) { pg8::Gemm g{(const pg8::bf16_t*)(ws + WS_XB), (const pg8::bf16_t*)(ws + WS_WIN), MT, NZ, DM, DM}; pg8::StaticOrder S; S.init(MT, NZ, gridDim.x, blockIdx.x);
        pg8::EpiZ E{(pg8::bf16_t*)(ws + WS_ZR), (pg8::bf16_t*)(ws + WS_ZS)};
        pg8::gemm_phase<pg8::EpiZ, pg8::StaticOrder, true, true>((PG8_LAS unsigned char*)lds, g, S, E); }
    if constexpr (PH == 2) p2_post(args, lds, tid);
    if constexpr (PH == 3) p3_attention(args, lds, tid, rep);
    if constexpr (PH == 4) p4_rwkv_prep(args, lds, tid);
    if constexpr (PH == 5) p5_rwkv_scan(args, lds, tid);
    if constexpr (PH == 6) p6_rwkv_out(args, tid);
    if constexpr (PH == 7) { pg8::Gemm g{(const pg8::bf16_t*)(ws + WS_XB), (const pg8::bf16_t*)(ws + WS_WOUT), MT, DM, DM, DM}; pg8::StaticOrder S; S.init(MT, DM, gridDim.x, blockIdx.x);
        pg8::EpiH E{args.in[0], args.in[1], args.out + OFF_Y, (pg8::bf16_t*)(ws + WS_HB), (float*)(ws + WS_CTL) + CW_SS};
        pg8::gemm_phase<pg8::EpiH, pg8::StaticOrder, true, true>((PG8_LAS unsigned char*)lds, g, S, E); }
    if constexpr (PH == 9) { pg8::Gemm g{(const pg8::bf16_t*)(ws + WS_HB), (const pg8::bf16_t*)(ws + WS_W1), MT, DFF, DM, DM}; pg8::StaticOrder S; S.init(MT, DFF, gridDim.x, blockIdx.x);
        pg8::EpiAct E{(pg8::bf16_t*)(ws + WS_ACT), DFF, (const float*)(ws + WS_CTL) + CW_SS};
        pg8::gemm_phase<pg8::EpiAct, pg8::StaticOrder, true, true>((PG8_LAS unsigned char*)lds, g, S, E); }
    if constexpr (PH == 10) {
        { pg8::Gemm g{(const pg8::bf16_t*)(ws + WS_ACT), (const pg8::bf16_t*)(ws + WS_W2), MP, DM, DFF, DFF}; pg8::StaticOrder S; S.init(MP, DM, gridDim.x, blockIdx.x);
          pg8::EpiY E{args.out + OFF_Y};
          pg8::gemm_phase<pg8::EpiY, pg8::StaticOrder, true, true>((PG8_LAS unsigned char*)lds, g, S, E); }
        { const int c = blockIdx.x; pg8::OneUnit S; S.has = c < 64; S.u.pm = MP / 256 + (c >> 4); S.u.pn = (c >> 2) & 3; const int sl = c & 3;
          pg8::Gemm g{(const pg8::bf16_t*)(ws + WS_ACT) + sl * 1024, (const pg8::bf16_t*)(ws + WS_W2) + sl * 1024, MT, DM, DFF, 1024};
          pg8::EpiSlab E{(float*)(ws + WS_HB) + (size_t)sl * MS * DM};
          __syncthreads();
          pg8::gemm_phase<pg8::EpiSlab, pg8::OneUnit, false, true>((PG8_LAS unsigned char*)lds, g, S, E); }
    }
    if constexpr (PH == 11) {
        const f32x4* sl = (const f32x4*)(ws + WS_HB); f32x4* y = (f32x4*)(args.out + OFF_Y + (size_t)MP * DM); constexpr int NV = MS * DM / 4;
        for (int i = blockIdx.x * 512 + tid; i < NV; i += gridDim.x * 512) y[i] = y[i] + ((sl[i] + sl[i + NV]) + (sl[i + 2 * NV] + sl[i + 3 * NV]));
    }
}
#ifndef MK_ONE_LAUNCH
#define MK_ONE_LAUNCH 1
#endif
#if MK_ONE_LAUNCH
__global__ void __launch_bounds__(512, 2) mk_fwd(Args args) {
    extern __shared__ __attribute__((aligned(16))) unsigned char lds[];
    const int tid = threadIdx.x;
    volatile __attribute__((address_space(3))) unsigned* bst = (volatile __attribute__((address_space(3))) unsigned*)((__attribute__((address_space(3))) unsigned char*)lds + LDS_BYTES - 16);
    if (tid < 2) bst[tid] = 0u;
    __syncthreads();
    const XcdBarrier bar = xcd_barrier_post((unsigned*)(args.ws + WS_CTL) + CW_BAR, bst);
#define SEAM(k) do { if ((k) == 1) { __syncthreads(); cg::this_grid().sync(); } else xcd_barrier(bar); } while (0)
#define PHASE(k) do { if (args.ph_lo <= (k) && (k) < args.ph_hi) { if ((k) > args.ph_lo) SEAM(k); run_phase<k>(args, lds, tid, 0); \
        if ((PROBE_MASK >> (k)) & 1) { xcd_barrier(bar); run_phase<k>(args, lds, tid, 1); } } } while (0)
    PHASE(0); PHASE(1); PHASE(2); PHASE(3); PHASE(4); PHASE(5); PHASE(6); PHASE(7); PHASE(9); PHASE(10); PHASE(11);
#undef PHASE
#undef SEAM
}
#else
template <int PH> __global__ void __launch_bounds__(512, 2) mk_phase(Args args) {
    extern __shared__ __attribute__((aligned(16))) unsigned char lds[];
    run_phase<PH>(args, lds, threadIdx.x, 0);
}
#endif

extern "C" void kernel_launch(void* const* d_in, const int* in_sizes, int n_in, void* d_out, int out_size, void* d_ws, size_t ws_size, hipStream_t stream) {
    static int grid = 0;
    if (grid == 0) {
        if (n_in != 28 || out_size != (int)OUT_TOTAL || ws_size < WS_END) { fprintf(stderr, "kernel_launch: unexpected shapes (n_in %d, out %d, ws %zu)\n", n_in, out_size, ws_size); grid = -1; return; }
        int dev = 0, cus = 0, per_cu = 0;
        (void)hipGetDevice(&dev); (void)hipDeviceGetAttribute(&cus, hipDeviceAttributeMultiprocessorCount, dev);
#if MK_ONE_LAUNCH
        if (hipFuncSetAttribute((const void*)mk_fwd, hipFuncAttributeMaxDynamicSharedMemorySize, LDS_BYTES) != hipSuccess) { fprintf(stderr, "kernel_launch: hipFuncSetAttribute failed\n"); grid = -1; return; }
        (void)hipOccupancyMaxActiveBlocksPerMultiprocessor(&per_cu, (const void*)mk_fwd, 512, LDS_BYTES);
        (void)hipGetLastError();
        if (per_cu < 1) { fprintf(stderr, "kernel_launch: occupancy query says %d blocks per CU\n", per_cu); per_cu = 1; }
#else
#define SETATTR(k) (void)hipFuncSetAttribute((const void*)mk_phase<k>, hipFuncAttributeMaxDynamicSharedMemorySize, LDS_BYTES)
        SETATTR(0); SETATTR(1); SETATTR(2); SETATTR(3); SETATTR(4); SETATTR(5); SETATTR(6); SETATTR(7); SETATTR(8); SETATTR(9); SETATTR(10); SETATTR(11);
#undef SETATTR
        (void)per_cu;
#endif
        grid = cus;
    }
    if (grid < 0) return;
    (void)hipMemsetAsync((char*)d_ws + WS_CTL, 0, CTL_BYTES, stream);
    Args a{};
    for (int i = 0; i < 28; ++i) a.in[i] = (const float*)d_in[i];
    a.out = (float*)d_out; a.ws = (unsigned char*)d_ws;
#if MK_ONE_LAUNCH
    a.ph_lo = 0; a.ph_hi = N_PHASES;
    void* kargs[] = {&a};
    hipError_t e = hipLaunchCooperativeKernel((const void*)mk_fwd, dim3(grid), dim3(512), kargs, LDS_BYTES, stream);
    if (e != hipSuccess) fprintf(stderr, "kernel_launch: cooperative launch failed: %s (grid %d)\n", hipGetErrorString(e), grid);
#else
#define LAUNCH(k) hipLaunchKernelGGL(mk_phase<k>, dim3(grid), dim3(512), LDS_BYTES, stream, a)
    a.ph_lo = 0; a.ph_hi = N_PHASES;
    LAUNCH(0); LAUNCH(1); LAUNCH(2); LAUNCH(3); LAUNCH(4); LAUNCH(5); LAUNCH(6); LAUNCH(7); LAUNCH(9); LAUNCH(10); LAUNCH(11);
#undef LAUNCH
#endif
}
```

```cpp
#include <hip/hip_runtime.h>
#include <hip/hip_cooperative_groups.h>
#include <cstdio>
#include <cstdint>
namespace cg = cooperative_groups;
#define PROBE_A1 0
#define PROBE_A2 0
#define PROBE_A3 0
namespace pg8 {
#define PG8_LAS __attribute__((address_space(3)))
typedef unsigned short bf16_t;
typedef short bf16x8 __attribute__((ext_vector_type(8)));
typedef float f32x4 __attribute__((ext_vector_type(4)));
typedef unsigned u32x4 __attribute__((ext_vector_type(4)));
constexpr int BM = 256, BK = 64, HALF = 128, HTB = HALF * BK * 2  , STAGE_BYTES = 8 * HTB, NXCD = 8, WGM = 8;

__host__ __device__ __forceinline__ int lds_byte(int r, int c) { const int st = (r >> 4) * 2 + (c >> 5), rr = r & 15, cc = c & 31, ob = rr * 64 + cc * 2; return st * 1024 + (ob ^ (((ob >> 9) & 1) << 5)); }
__host__ __device__ __forceinline__ void stage_rc(int b, int& R, int& C) { const int st = b / 1024, sb = b % 1024, swz = sb ^ (((sb >> 9) & 1) << 5); R = (st >> 1) * 16 + swz / 64; C = (st & 1) * 32 + (swz % 64) / 2; }
__host__ __device__ __forceinline__ int perm32(int rho) { const int n = rho >> 4, i = rho & 15; return 8 * (i >> 2) + 4 * n + (i & 3); }

struct Unit { int pm, pn; };
struct Gemm { const bf16_t* A; const bf16_t* Bt; int M, N, K, KL; };

struct StaticOrder {
    int nM, nN, nwg, G, c;
    __host__ __device__ void init(int M, int N, int G_, int c_) { nM = M / BM; nN = N / BM; nwg = nM * nN; G = G_; c = c_; }
    __host__ __device__ bool next(int i, Unit& u) const {
        const long L = (long)i * G + c; if (L >= nwg) return false;
        int wgid = (int)L; { const int q = nwg / NXCD, r = nwg % NXCD, xcd = wgid % NXCD, off = wgid / NXCD; wgid = (xcd < r ? xcd * (q + 1) : r * (q + 1) + (xcd - r) * q) + off; }
        const int nig = WGM * nN, gid = wgid / nig, fm = gid * WGM, gsz = (nM - fm) < WGM ? (nM - fm) : WGM;
        u.pm = fm + ((wgid % nig) % gsz); u.pn = (wgid % nig) / gsz; return true;
    }
    __device__ __forceinline__ void a_ready(const Unit&) const {}
    __device__ __forceinline__ void done(const Unit&) const {}
};


__device__ __forceinline__ unsigned cvt_pk_bf16(float lo, float hi) { unsigned r; asm volatile("v_cvt_pk_bf16_f32 %0, %1, %2" : "=v"(r) : "v"(lo), "v"(hi)); return r; }

constexpr int E_MP = 16384;
constexpr int E_ZRW = 1632, E_ZSW = 1696;

struct OneUnit { Unit u; bool has;
    __device__ __forceinline__ bool next(int i, Unit& o) const { if (i == 0 && has) { o = u; return true; } return false; }
    __device__ __forceinline__ void a_ready(const Unit&) const {}
    __device__ __forceinline__ void done(const Unit&) const {} };
struct EpiZ {
    static constexpr bool PERM = true, AFTER_DRAIN = false;
    bf16_t* ZR; bf16_t* ZS;
    __device__ __forceinline__ void operator()(const f32x4 (&acc)[2][2][4][2], const Unit& u, int wr, int wc, int fr, int fq) const {
        const int row0 = u.pm * BM + wr * 64 + fr, c0 = u.pn * BM + wc * 32 + 8 * fq;
#pragma unroll
        for (int ai = 0; ai < 2; ++ai)
#pragma unroll
            for (int m = 0; m < 4; ++m) { const size_t row = (size_t)(row0 + ai * HALF + m * 16);
#pragma unroll
                for (int bj = 0; bj < 2; ++bj) { const int c = c0 + bj * HALF; bf16_t* dst;
                    if (c < 1600) dst = ZR + row * E_ZRW + c; else if (c < 3296) dst = ZS + row * E_ZSW + (c - 1600); else if (c == 3296) dst = ZR + row * E_ZRW + 1600; else continue;
                    const f32x4 v0 = acc[ai][bj][m][0], v1 = acc[ai][bj][m][1]; u32x4 w;
                    w.x = cvt_pk_bf16(v0[0], v0[1]); w.y = cvt_pk_bf16(v0[2], v0[3]); w.z = cvt_pk_bf16(v1[0], v1[1]); w.w = cvt_pk_bf16(v1[2], v1[3]);
                    *(u32x4*)dst = w; } }
    }
};
struct EpiH {
    static constexpr bool PERM = false, AFTER_DRAIN = false;
    const float* xp; const float* xs; float* H; bf16_t* HB; float* SS;
    __device__ __forceinline__ void operator()(const f32x4 (&acc)[2][2][4][2], const Unit& u, int wr, int wc, int fr, int fq) const {
        const int row0 = u.pm * BM + wr * 64 + fr, col0 = u.pn * BM + wc * 32 + 4 * fq;
#pragma unroll
        for (int ai = 0; ai < 2; ++ai)
#pragma unroll
            for (int m = 0; m < 4; ++m) { const int row = row0 + ai * HALF + m * 16;
                const float* xr = (row < E_MP ? xp + (size_t)row * 1024 : xs + (size_t)(row - E_MP) * 1024) + col0; float* hr = H + (size_t)row * 1024 + col0; bf16_t* hb = HB + (size_t)row * 1024 + col0;
                float ss = 0.f;
#pragma unroll
                for (int bj = 0; bj < 2; ++bj)
#pragma unroll
                    for (int n = 0; n < 2; ++n) { const f32x4 h = *(const f32x4*)(xr + bj * HALF + n * 16) + acc[ai][bj][m][n]; *(f32x4*)(hr + bj * HALF + n * 16) = h;
                        ss += (h[0] * h[0] + h[1] * h[1]) + (h[2] * h[2] + h[3] * h[3]);
                        unsigned w0 = cvt_pk_bf16(h[0], h[1]), w1 = cvt_pk_bf16(h[2], h[3]); typedef unsigned u32x2v __attribute__((ext_vector_type(2))); *(u32x2v*)(hb + bj * HALF + n * 16) = (u32x2v){w0, w1}; }
                ss += __shfl_xor(ss, 16); ss += __shfl_xor(ss, 32);
                if (fq == 0) atomicAdd(SS + row, ss); }
    }
};
struct EpiAct {
    static constexpr bool PERM = true, AFTER_DRAIN = false;
    bf16_t* O; int ldc; const float* SS;
    __device__ __forceinline__ void operator()(const f32x4 (&acc)[2][2][4][2], const Unit& u, int wr, int wc, int fr, int fq) const {
        const int row0 = u.pm * BM + wr * 64 + fr, c0 = u.pn * BM + wc * 32 + 8 * fq;
#pragma unroll
        for (int ai = 0; ai < 2; ++ai)
#pragma unroll
            for (int m = 0; m < 4; ++m) { const int row = row0 + ai * HALF + m * 16; bf16_t* rowp = O + (size_t)row * ldc + c0;
                const float rs = rsqrtf(SS[row] * (1.0f / 1024.0f) + 1e-6f);
#pragma unroll
                for (int bj = 0; bj < 2; ++bj) { f32x4 v0 = acc[ai][bj][m][0], v1 = acc[ai][bj][m][1];
#pragma unroll
                    for (int e = 0; e < 4; ++e) { const float a = fmaxf(v0[e], 0.f) * rs, b = fmaxf(v1[e], 0.f) * rs; v0[e] = a * a; v1[e] = b * b; }
                    u32x4 w; w.x = cvt_pk_bf16(v0[0], v0[1]); w.y = cvt_pk_bf16(v0[2], v0[3]); w.z = cvt_pk_bf16(v1[0], v1[1]); w.w = cvt_pk_bf16(v1[2], v1[3]);
                    *(u32x4*)(rowp + bj * HALF) = w; } }
    }
};
struct EpiSlab {
    static constexpr bool PERM = false, AFTER_DRAIN = false;
    float* S;
    __device__ __forceinline__ void operator()(const f32x4 (&acc)[2][2][4][2], const Unit& u, int wr, int wc, int fr, int fq) const {
        const int row0 = u.pm * BM - E_MP + wr * 64 + fr, col0 = u.pn * BM + wc * 32 + 4 * fq;
#pragma unroll
        for (int ai = 0; ai < 2; ++ai)
#pragma unroll
            for (int m = 0; m < 4; ++m) { float* yr = S + (size_t)(row0 + ai * HALF + m * 16) * 1024 + col0;
#pragma unroll
                for (int bj = 0; bj < 2; ++bj)
#pragma unroll
                    for (int n = 0; n < 2; ++n) *(f32x4*)(yr + bj * HALF + n * 16) = acc[ai][bj][m][n]; }
    }
};
struct EpiY {
    static constexpr bool PERM = false, AFTER_DRAIN = false;
    float* Y;
    __device__ __forceinline__ void operator()(const f32x4 (&acc)[2][2][4][2], const Unit& u, int wr, int wc, int fr, int fq) const {
        const int row0 = u.pm * BM + wr * 64 + fr, col0 = u.pn * BM + wc * 32 + 4 * fq;
#pragma unroll
        for (int ai = 0; ai < 2; ++ai)
#pragma unroll
            for (int m = 0; m < 4; ++m) { float* yr = Y + (size_t)(row0 + ai * HALF + m * 16) * 1024 + col0;
#pragma unroll
                for (int bj = 0; bj < 2; ++bj)
#pragma unroll
                    for (int n = 0; n < 2; ++n) { f32x4* p = (f32x4*)(yr + bj * HALF + n * 16); *p = *p + acc[ai][bj][m][n]; } }
    }
};

template <class Epi, class Sched, bool ALIGN_EPI = false, bool SP2 = false>
__device__ __forceinline__ void gemm_phase(PG8_LAS unsigned char* lds, const Gemm g, const Sched& S, const Epi& E) {
    const int tid = threadIdx.x, wid = __builtin_amdgcn_readfirstlane(tid >> 6), lane = tid & 63, wr = wid >> 2, wc = wid & 3, fr = lane & 15, fq = lane >> 4;
    const int K = g.K, nt = g.KL / BK;
    unsigned voffA[2], voffB[2];
#pragma unroll
    for (int i = 0; i < 2; ++i) { int R, C; stage_rc(tid * 16 + i * 8192, R, C); const int Rb = Epi::PERM ? ((R & ~31) + perm32(R & 31)) : R;
        voffA[i] = (unsigned)(R * K + C) * 2u; voffB[i] = (unsigned)(Rb * K + C) * 2u; }
    const size_t kstep = (size_t)(BK * 2);
    const size_t hstep = (size_t)HALF * K * 2;
    const size_t tstep = 2 * hstep;
    const unsigned ldsw = (unsigned)wid * 1024u;
    const int aoff = lds_byte(wr * 64 + fr, fq * 8), boff = lds_byte(wc * 32 + fr, fq * 8);
#define PG8_SA(b, h) (((b) * 2 + (h)) * HTB)
#define PG8_SB(b, h) ((4 + (b) * 2 + (h)) * HTB)
#define PG8_STAGE(bufoff, gbase, voff) do { _Pragma("unroll") for (int _i = 0; _i < 2; ++_i) \
        __builtin_amdgcn_global_load_lds((const unsigned*)((const char*)(gbase) + (voff)[_i]), (PG8_LAS unsigned*)(lds + (bufoff) + ldsw + _i * 8192), 16, 0, 0); } while (0)
#define PG8_LDA(dst, b, h) do { _Pragma("unroll") for (int m = 0; m < 4; ++m) _Pragma("unroll") for (int k = 0; k < 2; ++k) dst[m][k] = *(const PG8_LAS bf16x8*)(lds + PG8_SA(b, h) + aoff + m * 2048 + k * 1024); } while (0)
#define PG8_LDB(dst, b, h) do { _Pragma("unroll") for (int n = 0; n < 2; ++n) _Pragma("unroll") for (int k = 0; k < 2; ++k) dst[n][k] = *(const PG8_LAS bf16x8*)(lds + PG8_SB(b, h) + boff + n * 2048 + k * 1024); } while (0)
#define PG8_MMA(ai, bj, At, Bt) do { __builtin_amdgcn_s_setprio(1); _Pragma("unroll") for (int m = 0; m < 4; ++m) _Pragma("unroll") for (int n = 0; n < 2; ++n) _Pragma("unroll") for (int k = 0; k < 2; ++k) \
        acc[ai][bj][m][n] = __builtin_amdgcn_mfma_f32_16x16x32_bf16(Bt[n][k], At[m][k], acc[ai][bj][m][n], 0, 0, 0); __builtin_amdgcn_s_setprio(0); } while (0)
#define PG8_WAIT_V(n) asm volatile("s_waitcnt vmcnt(" #n ")" ::: "memory")
#define PG8_WAIT_L(n) asm volatile("s_waitcnt lgkmcnt(" #n ")" ::: "memory")
#define PG8_BAR __builtin_amdgcn_s_barrier()
#define PG8_SCHED __builtin_amdgcn_sched_barrier(0)
    Unit cur, nxt; int ui = 0;
    if (!S.next(0, cur)) return;
    f32x4 acc[2][2][4][2];
#pragma unroll
    for (int a = 0; a < 2; ++a)
#pragma unroll
        for (int b = 0; b < 2; ++b)
#pragma unroll
            for (int m = 0; m < 4; ++m)
#pragma unroll
                for (int n = 0; n < 2; ++n) acc[a][b][m][n] = (f32x4){0.f, 0.f, 0.f, 0.f};
    bf16x8 At[4][2], B0[2][2], B1[2][2];
    const char* cA = (const char*)g.A + (size_t)cur.pm * tstep; const char* cB = (const char*)g.Bt + (size_t)cur.pn * tstep;
    S.a_ready(cur);
    if constexpr (SP2) {
        PG8_STAGE(PG8_SB(0, 0), cB, voffB); PG8_STAGE(PG8_SB(0, 1), cB + hstep, voffB); PG8_STAGE(PG8_SA(0, 0), cA, voffA); PG8_STAGE(PG8_SA(0, 1), cA + hstep, voffA);
        if (wr == 1) PG8_BAR;
        PG8_WAIT_V(2); PG8_BAR;
        PG8_STAGE(PG8_SB(1, 0), cB + kstep, voffB); PG8_STAGE(PG8_SA(1, 0), cA + kstep, voffA); PG8_STAGE(PG8_SB(1, 1), cB + hstep + kstep, voffB);
        PG8_WAIT_V(6); PG8_BAR;
    } else {
        PG8_STAGE(PG8_SB(0, 0), cB, voffB); PG8_STAGE(PG8_SA(0, 0), cA, voffA); PG8_STAGE(PG8_SB(0, 1), cB + hstep, voffB); PG8_STAGE(PG8_SA(0, 1), cA + hstep, voffA);
        if (wr == 1) PG8_BAR;
        PG8_WAIT_V(4); PG8_BAR;
        PG8_STAGE(PG8_SB(1, 0), cB + kstep, voffB); PG8_STAGE(PG8_SA(1, 0), cA + kstep, voffA); PG8_STAGE(PG8_SB(1, 1), cB + hstep + kstep, voffB);
        PG8_WAIT_V(6); PG8_BAR;
    }
    for (;;) {
        const bool has_next = S.next(ui + 1, nxt);
        const char* nA = has_next ? (const char*)g.A + (size_t)nxt.pm * tstep : cA; const char* nB = has_next ? (const char*)g.Bt + (size_t)nxt.pn * tstep : cB;
        for (int t = 0; t < nt; t += 2) {
            const bool last = (t == nt - 2);
            const char* a1 = cA + (size_t)(t + 1) * kstep;
            const char* a2 = last ? nA : cA + (size_t)(t + 2) * kstep; const char* b2 = last ? nB : cB + (size_t)(t + 2) * kstep;
            const char* a3 = a2 + kstep; const char* b3 = b2 + kstep;
            if (last && has_next) S.a_ready(nxt);
            if constexpr (SP2) {
            PG8_LDB(B0, 0, 0); PG8_LDB(B1, 0, 1); PG8_SCHED; PG8_LDA(At, 0, 0); PG8_STAGE(PG8_SA(1, 1), a1 + hstep, voffA);
            PG8_WAIT_V(8); PG8_WAIT_L(0); PG8_BAR; PG8_MMA(0, 0, At, B0); PG8_MMA(0, 1, At, B1); PG8_BAR; PG8_SCHED;
            PG8_LDA(At, 0, 1); PG8_STAGE(PG8_SB(0, 0), b2, voffB); PG8_STAGE(PG8_SB(0, 1), b2 + hstep, voffB); PG8_STAGE(PG8_SA(0, 0), a2, voffA);
            PG8_WAIT_V(8); PG8_WAIT_L(0); PG8_BAR; PG8_MMA(1, 0, At, B0); PG8_MMA(1, 1, At, B1); PG8_BAR; PG8_SCHED;
            PG8_LDB(B0, 1, 0); PG8_LDB(B1, 1, 1); PG8_SCHED; PG8_LDA(At, 1, 0); PG8_STAGE(PG8_SA(0, 1), a2 + hstep, voffA);
            PG8_WAIT_V(8); PG8_WAIT_L(0); PG8_BAR; PG8_MMA(0, 0, At, B0); PG8_MMA(0, 1, At, B1); PG8_BAR; PG8_SCHED;
            PG8_LDA(At, 1, 1); PG8_STAGE(PG8_SB(1, 0), b3, voffB); PG8_STAGE(PG8_SB(1, 1), b3 + hstep, voffB); PG8_STAGE(PG8_SA(1, 0), a3, voffA);
            PG8_WAIT_V(8); PG8_WAIT_L(0); PG8_BAR; PG8_MMA(1, 0, At, B0); PG8_MMA(1, 1, At, B1); PG8_BAR; PG8_SCHED;
            } else {
            PG8_LDB(B0, 0, 0); PG8_SCHED; PG8_LDA(At, 0, 0); PG8_STAGE(PG8_SA(1, 1), a1 + hstep, voffA);
            PG8_WAIT_L(8); PG8_BAR; PG8_WAIT_L(0); PG8_MMA(0, 0, At, B0); PG8_BAR; PG8_SCHED;
            PG8_LDB(B1, 0, 1); PG8_STAGE(PG8_SB(0, 0), b2, voffB);
            PG8_BAR; PG8_WAIT_L(0); PG8_MMA(0, 1, At, B1); PG8_BAR;
            PG8_LDA(At, 0, 1); PG8_STAGE(PG8_SA(0, 0), a2, voffA);
            PG8_BAR; PG8_WAIT_L(0); PG8_MMA(1, 0, At, B0); PG8_BAR; PG8_SCHED;
            PG8_STAGE(PG8_SB(0, 1), b2 + hstep, voffB);
            PG8_WAIT_V(6); PG8_BAR; PG8_MMA(1, 1, At, B1); PG8_BAR;
            PG8_LDB(B0, 1, 0); PG8_SCHED; PG8_LDA(At, 1, 0); PG8_STAGE(PG8_SA(0, 1), a2 + hstep, voffA);
            PG8_WAIT_L(8); PG8_BAR; PG8_WAIT_L(0); PG8_MMA(0, 0, At, B0); PG8_BAR; PG8_SCHED;
            PG8_LDB(B1, 1, 1); PG8_STAGE(PG8_SB(1, 0), b3, voffB);
            PG8_BAR; PG8_WAIT_L(0); PG8_MMA(0, 1, At, B1); PG8_BAR;
            PG8_LDA(At, 1, 1); PG8_STAGE(PG8_SA(1, 0), a3, voffA);
            PG8_BAR; PG8_WAIT_L(0); PG8_MMA(1, 0, At, B0); PG8_BAR; PG8_SCHED;
            PG8_STAGE(PG8_SB(1, 1), b3 + hstep, voffB);
            PG8_WAIT_V(6); PG8_BAR; PG8_MMA(1, 1, At, B1); PG8_BAR;
            }
        }
        if constexpr (ALIGN_EPI) { if (wr == 0) PG8_BAR; }
        if constexpr (!Epi::AFTER_DRAIN) { E(acc, cur, wr, wc, fr, fq); S.done(cur); }
        if (!has_next) break;
#pragma unroll
        for (int a = 0; a < 2; ++a)
#pragma unroll
            for (int b = 0; b < 2; ++b)
#pragma unroll
                for (int m = 0; m < 4; ++m)
#pragma unroll
                    for (int n = 0; n < 2; ++n) acc[a][b][m][n] = (f32x4){0.f, 0.f, 0.f, 0.f};
        cur = nxt; cA = nA; cB = nB; ++ui;
        if constexpr (ALIGN_EPI) { if (wr == 1) PG8_BAR; }
    }
    PG8_WAIT_V(0);
    if constexpr (!ALIGN_EPI) { if (wr == 0) PG8_BAR; }
    PG8_BAR;
    if constexpr (Epi::AFTER_DRAIN) { E.fused(acc, cur, wr, wc, fr, fq, lds, wid, lane); S.done(cur); }
#undef PG8_SA
#undef PG8_SB
#undef PG8_STAGE
#undef PG8_LDA
#undef PG8_LDB
#undef PG8_MMA
#undef PG8_WAIT_V
#undef PG8_WAIT_L
#undef PG8_BAR
#undef PG8_SCHED
}
}


constexpr int DM = 1024, NB_P = 8, T_P = 2048, NB_S = 32, T_S = 32, PAST = 1024;
constexpr int MP = NB_P * T_P, MS = NB_S * T_S, MT = MP + MS;
constexpr int LS = PAST + T_S;
constexpr int SHIFTW = 1696, NZ = 3328, ZRW = 1632, DFF = 4096;
constexpr float QSCALE = 0.125f * 1.4426950408889634f;
constexpr float WISCALE = 0.35355339059327373f * 0.125f;
constexpr size_t OFF_Y = 0, OFF_KP = 17825792, OFF_VP = OFF_KP + 4194304, OFF_KIP = OFF_VP + 4194304, OFF_WKVP = OFF_KIP + 1048576, OFF_SHP = OFF_WKVP + 262144,
                 OFF_KS = OFF_SHP + 13568, OFF_VS = OFF_KS + 262144, OFF_KIS = OFF_VS + 262144, OFF_WKVS = OFF_KIS + 65536, OFF_SHS = OFF_WKVS + 1048576, OUT_TOTAL = OFF_SHS + 54272;
constexpr size_t MiB = 1u << 20;
constexpr size_t WS_CTL = 0, CTL_BYTES = 1 * MiB;
constexpr size_t WS_WIN = 1 * MiB, WS_WOUT = 8 * MiB, WS_W1 = 10 * MiB, WS_W2 = 18 * MiB;
constexpr size_t WS_W2T = 26 * MiB, WS_A2T = WS_W2T + 32768, WS_G2T = WS_A2T + 32768, WS_WI = 27 * MiB, WS_BONUS = 28 * MiB;
constexpr size_t WS_XB = 30 * MiB;
constexpr size_t WS_ZS = 66 * MiB;
constexpr size_t WS_R = 123 * MiB;
constexpr size_t WS_ZR = WS_R, WS_KBP = 178 * MiB, WS_VTP = 186 * MiB, WS_KIP = 194 * MiB, WS_KBS = 196 * MiB, WS_VTS = 213 * MiB, WS_KIS = 230 * MiB;
constexpr size_t WS_OW = WS_R, WS_OKK = 157 * MiB, WS_OB = 174 * MiB, WS_OKM = 191 * MiB, WS_OR = 208 * MiB, WS_OV = 225 * MiB;
constexpr size_t WS_ACT = 66 * MiB, WS_HB = 202 * MiB, WS_END = 256 * MiB;
static_assert(WS_ZS + (size_t)MT * SHIFTW * 2 <= WS_R && WS_ZR + (size_t)MT * ZRW * 2 <= WS_KBP && WS_KBS + (size_t)NB_S * LS * 256 * 2 <= WS_VTS && WS_VTS + (size_t)NB_S * 256 * LS * 2 <= WS_KIS &&
              WS_KIS + (size_t)NB_S * LS * 64 * 2 <= WS_END && WS_OV + (size_t)MT * 512 * 2 <= WS_END && WS_ACT + (size_t)MT * DFF * 2 <= WS_HB && WS_HB + (size_t)MT * DM * 2 <= WS_END, "d_ws map");
constexpr size_t SC_Q = 0, SC_QI = (size_t)MT * 512 / 2, SC_Y = 0, SC_G = (size_t)MT * 512;
constexpr int CW_QATT = 64, CW_SS = 16384;

typedef unsigned short bf16;
typedef short bf16x8 __attribute__((ext_vector_type(8)));
typedef float f32x4 __attribute__((ext_vector_type(4)));
typedef float f32x16 __attribute__((ext_vector_type(16)));
typedef unsigned u32x4 __attribute__((ext_vector_type(4)));
typedef unsigned u32x2 __attribute__((ext_vector_type(2)));

__device__ __forceinline__ unsigned f2bf(float f) { unsigned u = __float_as_uint(f); return (u + 0x7fffu + ((u >> 16) & 1u)) >> 16; }
__device__ __forceinline__ unsigned pk2(float lo, float hi) { return f2bf(lo) | (f2bf(hi) << 16); }
__device__ __forceinline__ float bflo(unsigned w) { return __uint_as_float(w << 16); }
__device__ __forceinline__ float bfhi(unsigned w) { return __uint_as_float(w & 0xffff0000u); }
__device__ __forceinline__ float bf1(bf16 b) { return __uint_as_float((unsigned)b << 16); }
__device__ __forceinline__ void unpack8(const u32x4 w, float* x) { x[0] = bflo(w.x); x[1] = bfhi(w.x); x[2] = bflo(w.y); x[3] = bfhi(w.y); x[4] = bflo(w.z); x[5] = bfhi(w.z); x[6] = bflo(w.w); x[7] = bfhi(w.w); }
__device__ __forceinline__ u32x4 pack8(const float* x) { u32x4 w; w.x = pk2(x[0], x[1]); w.y = pk2(x[2], x[3]); w.z = pk2(x[4], x[5]); w.w = pk2(x[6], x[7]); return w; }
__device__ __forceinline__ float wave_sum(float v) {
#pragma unroll
    for (int o = 1; o < 64; o <<= 1) v += __shfl_xor(v, o);
    return v;
}
template <int CTRL> __device__ __forceinline__ float dppmov(float x) { return __builtin_bit_cast(float, __builtin_amdgcn_update_dpp(0, __builtin_bit_cast(int, x), CTRL, 0xf, 0xf, true)); }
__device__ __forceinline__ float sum16(float x) {
    x += dppmov<0xB1>(x); x += dppmov<0x4E>(x); x += dppmov<0x141>(x); x += dppmov<0x140>(x); return x;
}
__device__ __forceinline__ int crow(int r, int hi) { return (r & 3) + 8 * (r >> 2) + 4 * hi; }

struct Args { const float* in[28]; float* out; unsigned char* ws; int ph_lo, ph_hi; };

__device__ __forceinline__ void tr_item(const float* W, int K, int N, const float* gain, bf16* WT, int jr0, int c0, int nvalid, int k0, float* scr, int lane) {
#pragma unroll 8
    for (int i = 0; i < 32; ++i) { const int kk = 2 * i + (lane >> 5), n = lane & 31;
        float v = (n < nvalid) ? W[(size_t)(k0 + kk) * N + c0 + n] : 0.f; if (gain) v *= gain[k0 + kk]; scr[kk * 33 + n] = v; }
    __builtin_amdgcn_s_waitcnt(0xC07F); asm volatile("" ::: "memory");
    const int c = lane & 7;
#pragma unroll
    for (int j = 0; j < 4; ++j) { const int n = (lane >> 3) + 8 * j; const float* s = scr + (8 * c) * 33 + n;
        u32x4 o; o.x = pk2(s[0 * 33], s[1 * 33]); o.y = pk2(s[2 * 33], s[3 * 33]); o.z = pk2(s[4 * 33], s[5 * 33]); o.w = pk2(s[6 * 33], s[7 * 33]);
        *(u32x4*)(WT + (size_t)(jr0 + n) * K + k0 + 8 * c) = o; }
    __builtin_amdgcn_s_waitcnt(0xC07F); asm volatile("" ::: "memory");
}
__device__ __forceinline__ void p0_prologue(const Args& a, unsigned char* lds, int tid) {
    const int lane = tid & 63, wave = tid >> 6, gw = blockIdx.x * 8 + wave, NGW = gridDim.x * 8;
    float* scr = (float*)(lds + wave * 17408);
    unsigned char* ws = a.ws;
    constexpr int I_IN = (NZ / 32) * (DM / 64), I_OUT = (DM / 32) * (DM / 64), I_F1 = (DFF / 32) * (DM / 64), I_F2 = (DM / 32) * (DFF / 64);
    for (int it = gw; it < I_IN + I_OUT + I_F1 + I_F2; it += NGW) {
        int r = it;
        if (r < I_IN) { const int jb = r % (NZ / 32), kb = r / (NZ / 32), j0 = jb * 32; int c0, nv;
            if (j0 < 1600) { c0 = j0; nv = 32; } else if (j0 < 3296) { c0 = 1608 + (j0 - 1600); nv = 32; } else { c0 = 1600; nv = 8; }
            tr_item(a.in[8], DM, 3304, a.in[7], (bf16*)(ws + WS_WIN), j0, c0, nv, kb * 64, scr, lane); continue; }
        r -= I_IN;
        if (r < I_OUT) { const int jb = r % (DM / 32), kb = r / (DM / 32); tr_item(a.in[24], DM, DM, nullptr, (bf16*)(ws + WS_WOUT), jb * 32, jb * 32, 32, kb * 64, scr, lane); continue; }
        r -= I_OUT;
        if (r < I_F1) { const int jb = r % (DFF / 32), kb = r / (DFF / 32); tr_item(a.in[26], DM, DFF, a.in[25], (bf16*)(ws + WS_W1), jb * 32, jb * 32, 32, kb * 64, scr, lane); continue; }
        r -= I_F1;
        { const int jb = r % (DM / 32), kb = r / (DM / 32); tr_item(a.in[27], DFF, DM, nullptr, (bf16*)(ws + WS_W2), jb * 32, jb * 32, 32, kb * 64, scr, lane); }
    }
    { const int gt = blockIdx.x * 512 + tid, NT = gridDim.x * 512;
      bf16* w2t = (bf16*)(ws + WS_W2T); bf16* a2t = (bf16*)(ws + WS_A2T); bf16* g2t = (bf16*)(ws + WS_G2T);
      for (int i = gt; i < 512 * 32; i += NT) { const int n = i >> 5, k = i & 31; w2t[i] = (bf16)f2bf(a.in[15][k * 512 + n]); a2t[i] = (bf16)f2bf(a.in[17][k * 512 + n]); }
      for (int i = gt; i < 512 * 96; i += NT) { const int n = i / 96, k = i % 96; g2t[i] = (bf16)f2bf(a.in[18][k * 512 + n]); } }
    for (int m = gw; m < MT; m += NGW) {
        const float* xrow = (m < MP) ? a.in[0] + (size_t)m * DM : a.in[1] + (size_t)(m - MP) * DM;
        const f32x4* xr = (const f32x4*)xrow + lane; f32x4 v[4]; float s = 0.f;
#pragma unroll
        for (int j = 0; j < 4; ++j) { v[j] = xr[64 * j]; s += (v[j].x * v[j].x + v[j].y * v[j].y) + (v[j].z * v[j].z + v[j].w * v[j].w); }
        const float rs = rsqrtf(wave_sum(s) * (1.f / DM) + 1e-6f);
        u32x2* o8 = (u32x2*)((bf16*)(ws + WS_XB) + (size_t)m * DM) + lane;
#pragma unroll
        for (int j = 0; j < 4; ++j) { u32x2 o; o.x = pk2(v[j].x * rs, v[j].y * rs); o.y = pk2(v[j].z * rs, v[j].w * rs); o8[64 * j] = o; }
    }
    for (int rix = gw; rix < NB_S * PAST; rix += NGW) {
        const int b = rix >> 10, p = rix & 1023; const f32x4 v = ((const f32x4*)(a.in[2] + (size_t)rix * 256))[lane];
        u32x2 o; o.x = pk2(v.x, v.y); o.y = pk2(v.z, v.w); ((u32x2*)((bf16*)(ws + WS_KBS) + ((size_t)b * LS + p) * 256))[lane] = o;
    }
    for (int r4 = gw; r4 < NB_S * PAST / 4; r4 += NGW) {
        const int rix = r4 * 4 + (lane >> 4), b = rix >> 10, p = rix & 1023; const f32x4 v = ((const f32x4*)(a.in[4] + (size_t)rix * 64))[lane & 15];
        u32x2 o; o.x = pk2(v.x, v.y); o.y = pk2(v.z, v.w); ((u32x2*)((bf16*)(ws + WS_KIS) + ((size_t)b * LS + p) * 64))[lane & 15] = o;
    }
    for (int it = gw; it < NB_S * 4 * 16; it += NGW) {
        const int kb = it & 15, g = (it >> 4) & 3, b = it >> 6;
        const float* src = a.in[3] + ((size_t)b * PAST + kb * 64) * 256 + g * 64;
#pragma unroll 8
        for (int i = 0; i < 64; ++i) scr[i * 65 + lane] = src[(size_t)i * 256 + lane];
        __builtin_amdgcn_s_waitcnt(0xC07F); asm volatile("" ::: "memory");
        bf16* dst = (bf16*)(ws + WS_VTS) + ((size_t)(b * 4 + g) * 64) * LS + kb * 64 + lane;
#pragma unroll 8
        for (int d = 0; d < 64; ++d) dst[(size_t)d * LS] = (bf16)f2bf(scr[lane * 65 + d]);
        __builtin_amdgcn_s_waitcnt(0xC07F); asm volatile("" ::: "memory");
    }
}

__device__ __forceinline__ void p2_post(const Args& a, unsigned char* lds, int tid) {
    unsigned char* ws = a.ws; float* out = a.out;
    const bf16* ZR = (const bf16*)(ws + WS_ZR); const bf16* ZS = (const bf16*)(ws + WS_ZS);
    bf16* Q = (bf16*)(out + SC_Q); bf16* QI = (bf16*)(out + SC_QI);
    float* cs = (float*)lds;
    bf16* vt = (bf16*)(lds + 4096);
    const int g8 = tid >> 3, sub = tid & 7;
    const float* qg = a.in[9]; const float* kg = a.in[10]; const float* lng = a.in[11]; const float* lnb = a.in[12];
    for (int tile = blockIdx.x; tile < MT / 64; tile += gridDim.x) {
        const int m0 = tile * 64;
        { const int m = m0 + g8, pos = (m < MP) ? (m & (T_P - 1)) : (PAST + ((m - MP) & (T_S - 1)));
          const float inv = powf(500000.0f, -(float)sub * 0.125f); const float ang = (float)pos * inv; float s, c; sincosf(ang, &s, &c);
          cs[g8 * 16 + sub] = c; cs[g8 * 16 + 8 + sub] = s; }
        __syncthreads();
        const int m = m0 + g8;
        const bool isp = m < MP; const int ms = m - MP;
        float cc[8], ss[8];
#pragma unroll
        for (int j = 0; j < 8; ++j) { cc[j] = cs[g8 * 16 + j]; ss[j] = cs[g8 * 16 + 8 + j]; }
        const size_t kvrow = isp ? (size_t)m : ((size_t)(ms >> 5) * LS + PAST + (ms & 31));
        bf16* KB = (bf16*)(ws + (isp ? WS_KBP : WS_KBS)); bf16* KIb = (bf16*)(ws + (isp ? WS_KIP : WS_KIS));
        for (int hb = 0; hb < 25; ++hb) {
            float x[8]; unpack8(*(const u32x4*)(ZR + (size_t)m * ZRW + hb * 64 + 8 * sub), x);
            if (hb < 12) {
                float s2 = 0.f;
#pragma unroll
                for (int j = 0; j < 8; ++j) s2 += x[j] * x[j];
                s2 += __shfl_xor(s2, 1); s2 += __shfl_xor(s2, 2); s2 += __shfl_xor(s2, 4);
                const float rinv = rsqrtf(s2 * (1.f / 64.f) + 1e-6f); const float* gn = (hb < 8 ? qg : kg) + 8 * sub;
                float y[8], o[8];
#pragma unroll
                for (int j = 0; j < 8; ++j) y[j] = x[j] * rinv * gn[j];
#pragma unroll
                for (int j = 0; j < 8; ++j) { const float p = __shfl_xor(y[j], 1); o[j] = sub == 0 ? y[j] * cc[j] - p * ss[j] : (sub == 1 ? y[j] * cc[j] + p * ss[j] : y[j]); }
                if (hb < 8) {
#pragma unroll
                    for (int j = 0; j < 8; ++j) o[j] *= QSCALE;
                    *(u32x4*)(Q + (size_t)m * 512 + hb * 64 + 8 * sub) = pack8(o);
                } else { const int g = hb - 8;
                    float* ko = out + (isp ? OFF_KP + (size_t)m * 256 : OFF_KS + (size_t)ms * 256) + g * 64 + 8 * sub;
                    *(f32x4*)ko = (f32x4){o[0], o[1], o[2], o[3]}; *(f32x4*)(ko + 4) = (f32x4){o[4], o[5], o[6], o[7]};
                    *(u32x4*)(KB + kvrow * 256 + g * 64 + 8 * sub) = pack8(o); }
            } else if (hb < 16) { const int g = hb - 12;
                float* vo = out + (isp ? OFF_VP + (size_t)m * 256 : OFF_VS + (size_t)ms * 256) + g * 64 + 8 * sub;
                *(f32x4*)vo = (f32x4){x[0], x[1], x[2], x[3]}; *(f32x4*)(vo + 4) = (f32x4){x[4], x[5], x[6], x[7]};
                unsigned* vd = (unsigned*)(vt + g8 * 258 + g * 64 + 8 * sub);
                vd[0] = pk2(x[0], x[1]); vd[1] = pk2(x[2], x[3]); vd[2] = pk2(x[4], x[5]); vd[3] = pk2(x[6], x[7]);
            } else if (hb < 24) {
                float o[8];
#pragma unroll
                for (int j = 0; j < 8; ++j) { const float p = __shfl_xor(x[j], 1); o[j] = sub == 0 ? x[j] * cc[j] - p * ss[j] : (sub == 1 ? x[j] * cc[j] + p * ss[j] : x[j]); }
                *(u32x4*)(QI + (size_t)m * 512 + (hb - 16) * 64 + 8 * sub) = pack8(o);
            } else {
                float s1 = 0.f;
#pragma unroll
                for (int j = 0; j < 8; ++j) s1 += x[j];
                s1 += __shfl_xor(s1, 1); s1 += __shfl_xor(s1, 2); s1 += __shfl_xor(s1, 4);
                const float mu = s1 * (1.f / 64.f); float s2 = 0.f;
#pragma unroll
                for (int j = 0; j < 8; ++j) { const float d = x[j] - mu; s2 += d * d; }
                s2 += __shfl_xor(s2, 1); s2 += __shfl_xor(s2, 2); s2 += __shfl_xor(s2, 4);
                const float rinv = rsqrtf(s2 * (1.f / 64.f) + 1e-6f); float y[8], o[8];
#pragma unroll
                for (int j = 0; j < 8; ++j) y[j] = (x[j] - mu) * rinv * lng[8 * sub + j] + lnb[8 * sub + j];
#pragma unroll
                for (int j = 0; j < 8; ++j) { const float p = __shfl_xor(y[j], 1); o[j] = sub == 0 ? y[j] * cc[j] - p * ss[j] : (sub == 1 ? y[j] * cc[j] + p * ss[j] : y[j]); }
                float* ko = out + (isp ? OFF_KIP + (size_t)m * 64 : OFF_KIS + (size_t)ms * 64) + 8 * sub;
                *(f32x4*)ko = (f32x4){o[0], o[1], o[2], o[3]}; *(f32x4*)(ko + 4) = (f32x4){o[4], o[5], o[6], o[7]};
                *(u32x4*)(KIb + kvrow * 64 + 8 * sub) = pack8(o);
            }
        }
        ((float*)(ws + WS_WI))[(size_t)m * 8 + sub] = bf1(ZR[(size_t)m * ZRW + 1600 + sub]) * WISCALE;
        __syncthreads();
        { const int r = tid >> 1, half = tid & 1; unsigned wv[16];
#pragma unroll
          for (int j = 0; j < 16; ++j) wv[j] = (unsigned)vt[(32 * half + 2 * j) * 258 + r] | ((unsigned)vt[(32 * half + 2 * j + 1) * 258 + r] << 16);
          bf16* dst;
          if (m0 < MP) dst = (bf16*)(ws + WS_VTP) + ((size_t)(m0 >> 11) * 256 + r) * T_P + (m0 & (T_P - 1)) + 32 * half;
          else { const int b = ((m0 - MP) >> 5) + half; dst = (bf16*)(ws + WS_VTS) + ((size_t)b * 256 + r) * LS + PAST; }
#pragma unroll
          for (int j = 0; j < 4; ++j) ((u32x4*)dst)[j] = (u32x4){wv[4 * j], wv[4 * j + 1], wv[4 * j + 2], wv[4 * j + 3]}; }
        if (m0 < MP) { if ((m0 & (T_P - 1)) == T_P - 64) { const int b = m0 >> 11; const bf16* zr = ZS + (size_t)(m0 + 63) * SHIFTW;
                for (int c = tid; c < SHIFTW; c += 512) out[OFF_SHP + (size_t)b * SHIFTW + c] = bf1(zr[c]); } }
        else { for (int h2 = 0; h2 < 2; ++h2) { const int b = ((m0 - MP) >> 5) + h2; const bf16* zr = ZS + (size_t)(m0 + 32 * h2 + 31) * SHIFTW;
                for (int c = tid; c < SHIFTW; c += 512) out[OFF_SHS + (size_t)b * SHIFTW + c] = bf1(zr[c]); } }
        __syncthreads();
    }
}

constexpr int ATT_UNITS = 544;
constexpr int MASK_PITCH = 65;
#define MFMA32(a, b, c) __builtin_amdgcn_mfma_f32_32x32x16_bf16((a), (b), (c), 0, 0, 0)

__device__ __forceinline__ float half_sum32(float v) { v += __shfl_xor(v, 1); v += __shfl_xor(v, 2); v += __shfl_xor(v, 4); v += __shfl_xor(v, 8); v += __shfl_xor(v, 16); return v; }
__device__ __forceinline__ float half_min32(float v) { v = fminf(v, __shfl_xor(v, 1)); v = fminf(v, __shfl_xor(v, 2)); v = fminf(v, __shfl_xor(v, 4)); v = fminf(v, __shfl_xor(v, 8)); v = fminf(v, __shfl_xor(v, 16)); return v; }
__device__ __forceinline__ float half_max32(float v) { v = fmaxf(v, __shfl_xor(v, 1)); v = fmaxf(v, __shfl_xor(v, 2)); v = fmaxf(v, __shfl_xor(v, 4)); v = fmaxf(v, __shfl_xor(v, 8)); v = fmaxf(v, __shfl_xor(v, 16)); return v; }
__device__ __forceinline__ int half_sum32i(int v) { v += __shfl_xor(v, 1); v += __shfl_xor(v, 2); v += __shfl_xor(v, 4); v += __shfl_xor(v, 8); v += __shfl_xor(v, 16); return v; }

#define LAS3 __attribute__((address_space(3)))
constexpr int A_RING1 = 0, A_SCL = 24576, A_RING2 = 24576, A_MASK = 0, A_LSUM = 8320, A_UNIT = 9344;
__device__ __forceinline__ void p3_attention(const Args& a, unsigned char* lds, int tid, int rep) {
    unsigned char* ws = a.ws; float* out = a.out;
    const bf16* Q = (const bf16*)(out + SC_Q); const bf16* QI = (const bf16*)(out + SC_QI); const float* WI = (const float*)(ws + WS_WI);
    bf16* O = (bf16*)(ws + WS_XB);
    unsigned* maskw = (unsigned*)(lds + A_MASK);
    float* lsum = (float*)(lds + A_LSUM);
    int* s_unit = (int*)(lds + A_UNIT);
    typedef float f32x2_t __attribute__((ext_vector_type(2)));
    f32x2_t* scl = (f32x2_t*)(lds + A_SCL) + (size_t)(tid >> 6) * 2048 + (tid & 63);
    unsigned* qctr = (unsigned*)(ws + WS_CTL) + CW_QATT + 64 * rep;
    const int l = tid & 63, w = __builtin_amdgcn_readfirstlane(tid >> 6), rho = l & 31, hi = l >> 5;
    LAS3 unsigned char* ldsb = (LAS3 unsigned char*)lds;
    for (;;) {
        if (tid == 0) *s_unit = (int)atomicAdd(qctr, 1u);
        __syncthreads();
        const int p = *s_unit;
        __syncthreads();
        if (p >= ATT_UNITS) break;
        int m0, nkt, vpitch; const bf16 *KB, *VT, *KI; bool need_idx;
        { int c = -1, b, half = 0;
          if (p < 256) { c = 31 - (p >> 4); b = (p & 15) >> 1; half = p & 1; }
          else if (p < 288) { b = p - 256; }
          else { const int pp = p - 288; c = 15 - (pp >> 4); b = (pp & 15) >> 1; half = pp & 1; }
          if (c >= 0) { m0 = b * T_P + 64 * c + 32 * half; nkt = 2 * (c + 1); vpitch = T_P; need_idx = c >= 4;
              KB = (const bf16*)(ws + WS_KBP) + (size_t)b * T_P * 256; VT = (const bf16*)(ws + WS_VTP) + (size_t)b * 256 * T_P; KI = (const bf16*)(ws + WS_KIP) + (size_t)b * T_P * 64; }
          else { m0 = MP + 32 * b; nkt = LS / 32; vpitch = LS; need_idx = true;
              KB = (const bf16*)(ws + WS_KBS) + (size_t)b * LS * 256; VT = (const bf16*)(ws + WS_VTS) + (size_t)b * 256 * LS; KI = (const bf16*)(ws + WS_KIS) + (size_t)b * LS * 64; } }
        if (need_idx) {
            const int tokA = 4 * w + 2 * ((rho >> 2) & 1) + (rho >> 4), headA = (rho & 3) + 4 * ((rho >> 3) & 1);
            bf16x8 qa[4];
#pragma unroll
            for (int ks = 0; ks < 4; ++ks) qa[ks] = *(const bf16x8*)(QI + (size_t)(m0 + tokA) * 512 + headA * 64 + 16 * ks + 8 * hi);
            float wv[16];
#pragma unroll
            for (int r = 0; r < 16; ++r) wv[r] = WI[(size_t)(m0 + 4 * w + 2 * hi + (r >> 3)) * 8 + (r & 7)];
            asm volatile("" :: "v"(qa[0]), "v"(qa[1]), "v"(qa[2]), "v"(qa[3]));
#pragma unroll
            for (int r = 0; r < 16; ++r) asm volatile("" :: "v"(wv[r]));
            asm volatile("s_waitcnt vmcnt(0)" ::: "memory");
            float sc0[32], sc1[32];
            const int nb = (nkt + 1) >> 1;
            const int sr = 8 * w + (l >> 3), scn = (l & 7) ^ ((sr >> 1) & 7);
            const unsigned char* ksrc = (const unsigned char*)KI + (size_t)sr * 128 + 16 * scn;
#define KI_STAGE(it_) __builtin_amdgcn_global_load_lds((const unsigned*)(ksrc + (size_t)(it_) * 8192), (LAS3 unsigned*)(ldsb + A_RING1 + ((it_) % 3) * 8192 + w * 1024), 16, 0, 0)
            for (int rp1 = 0; rp1 <= PROBE_A1; ++rp1) {
            if (rp1) __syncthreads();
            KI_STAGE(0); if (1 < nb) KI_STAGE(1);
#pragma unroll
            for (int it = 0; it < 32; ++it) {
                if (it < nb) {
                    if (it + 1 < nb) asm volatile("s_waitcnt vmcnt(1) lgkmcnt(0)\n\ts_barrier" ::: "memory"); else asm volatile("s_waitcnt vmcnt(0) lgkmcnt(0)\n\ts_barrier" ::: "memory");
                    if (it + 2 < nb) KI_STAGE(it + 2);
                    const unsigned char* tb = lds + A_RING1 + (it % 3) * 8192;
#pragma unroll
                    for (int k2 = 0; k2 < 2; ++k2) { const int kt = 2 * it + k2;
                        if (kt < nkt) {
                            const int r = 32 * k2 + rho; const unsigned char* rowp = tb + r * 128; const int sw = (r >> 1) & 7;
                            f32x16 acc = {0.f, 0.f, 0.f, 0.f, 0.f, 0.f, 0.f, 0.f, 0.f, 0.f, 0.f, 0.f, 0.f, 0.f, 0.f, 0.f};
#pragma unroll
                            for (int ks = 0; ks < 4; ++ks) acc = MFMA32(qa[ks], *(const bf16x8*)(rowp + 16 * ((2 * ks + hi) ^ sw)), acc);
                            float s0 = 0.f, s1 = 0.f;
#pragma unroll
                            for (int r2 = 0; r2 < 8; ++r2) { s0 += wv[r2] * fmaxf(acc[r2], 0.f); s1 += wv[8 + r2] * fmaxf(acc[8 + r2], 0.f); }
                            if (kt < 32) { sc0[kt & 31] = s0; sc1[kt & 31] = s1; } else scl[(kt - 32) * 64] = (f32x2_t){s0, s1};
                        } else if (kt < 32) { sc0[kt & 31] = -3.0e38f; sc1[kt & 31] = -3.0e38f; }
                    }
                } else { if (2 * it < 32) { sc0[(2 * it) & 31] = -3.0e38f; sc1[(2 * it) & 31] = -3.0e38f; sc0[(2 * it + 1) & 31] = -3.0e38f; sc1[(2 * it + 1) & 31] = -3.0e38f; } }
            }
            }
#undef KI_STAGE
            __syncthreads();
            float mn0 = 3.0e38f, mx0 = -3.0e38f, mn1 = 3.0e38f, mx1 = -3.0e38f; int cp0 = 0, cz0 = 0, cp1 = 0, cz1 = 0;
#pragma unroll
            for (int kt = 0; kt < 64; ++kt) if (kt < nkt) { float v0, v1; if (kt < 32) { v0 = sc0[kt & 31]; v1 = sc1[kt & 31]; } else { const f32x2_t t2 = scl[(kt - 32) * 64]; v0 = t2.x; v1 = t2.y; }
                mn0 = fminf(mn0, v0); mx0 = fmaxf(mx0, v0); mn1 = fminf(mn1, v1); mx1 = fmaxf(mx1, v1);
                cp0 += v0 > 0.f ? 1 : 0; cz0 += v0 == 0.f ? 1 : 0; cp1 += v1 > 0.f ? 1 : 0; cz1 += v1 == 0.f ? 1 : 0; }
            mn0 = half_min32(mn0); mx0 = half_max32(mx0); mn1 = half_min32(mn1); mx1 = half_max32(mx1);
            cp0 = half_sum32i(cp0); cz0 = half_sum32i(cz0); cp1 = half_sum32i(cp1); cz1 = half_sum32i(cz1);
            float lo0, hi0, lo1, hi1, thr0 = 0.f, thr1 = 0.f; int ch0, ch1, nt0 = 0, nt1 = 0; bool fin0, fin1;
            for (int rp2 = 0; rp2 <= PROBE_A2; ++rp2) {
            fin0 = false; fin1 = false; ch0 = 0; ch1 = 0;
            if (cp0 >= 256) { lo0 = 0.f; hi0 = mx0; if (cp0 == 256) { fin0 = true; thr0 = 0.f; nt0 = 0; } }
            else if (cp0 + cz0 >= 256) { lo0 = 0.f; hi0 = 0.f; fin0 = true; thr0 = 0.f; nt0 = 256 - cp0; }
            else { lo0 = mn0 - 1.0f; hi0 = 0.f; ch0 = cp0; }
            if (cp1 >= 256) { lo1 = 0.f; hi1 = mx1; if (cp1 == 256) { fin1 = true; thr1 = 0.f; nt1 = 0; } }
            else if (cp1 + cz1 >= 256) { lo1 = 0.f; hi1 = 0.f; fin1 = true; thr1 = 0.f; nt1 = 256 - cp1; }
            else { lo1 = mn1 - 1.0f; hi1 = 0.f; ch1 = cp1; }
            asm volatile("" : "+v"(lo0), "+v"(lo1));
            for (int iter = 0; iter < 64; ++iter) {
                const float mid0 = lo0 + 0.5f * (hi0 - lo0), mid1 = lo1 + 0.5f * (hi1 - lo1);
                int c0 = 0, c1 = 0;
#pragma unroll
                for (int g = 0; g < 4; ++g) if (8 * g < nkt) {
#pragma unroll
                    for (int k8 = 0; k8 < 8; ++k8) { c0 += sc0[8 * g + k8] > mid0 ? 1 : 0; c1 += sc1[8 * g + k8] > mid1 ? 1 : 0; } }
                for (int kt = 32; kt < nkt; kt += 8) {
                    f32x2_t t8[8];
#pragma unroll
                    for (int u = 0; u < 8; ++u) t8[u] = scl[(kt + u - 32) * 64];
#pragma unroll
                    for (int u = 0; u < 8; ++u) if (kt + u < nkt) { c0 += t8[u].x > mid0 ? 1 : 0; c1 += t8[u].y > mid1 ? 1 : 0; } }
                c0 = half_sum32i(c0); c1 = half_sum32i(c1);
                if (!fin0) { if (!(mid0 > lo0 && mid0 < hi0)) { fin0 = true; thr0 = hi0; nt0 = 256 - ch0; }
                             else if (c0 == 256) { fin0 = true; thr0 = mid0; nt0 = 0; } else if (c0 > 256) lo0 = mid0; else { hi0 = mid0; ch0 = c0; } }
                if (!fin1) { if (!(mid1 > lo1 && mid1 < hi1)) { fin1 = true; thr1 = hi1; nt1 = 256 - ch1; }
                             else if (c1 == 256) { fin1 = true; thr1 = mid1; nt1 = 0; } else if (c1 > 256) lo1 = mid1; else { hi1 = mid1; ch1 = c1; } }
                if (__all(fin0 && fin1)) break;
            }
            }
            const bool any_tie = __any(nt0 > 0 || nt1 > 0);
            int run0 = 0, run1 = 0; const unsigned below = (1u << rho) - 1u;
#pragma unroll
            for (int kt = 0; kt < 64; ++kt) if (kt < nkt) {
                float v0, v1; if (kt < 32) { v0 = sc0[kt & 31]; v1 = sc1[kt & 31]; } else { const f32x2_t t2 = scl[(kt - 32) * 64]; v0 = t2.x; v1 = t2.y; }
                bool p0 = v0 > thr0, p1 = v1 > thr1;
                if (any_tie) {
                    const bool e0 = nt0 > 0 && v0 == thr0, e1 = nt1 > 0 && v1 == thr1;
                    const unsigned long long be0 = __ballot(e0), be1 = __ballot(e1);
                    const unsigned h0 = (unsigned)(be0 >> (32 * hi)), h1 = (unsigned)(be1 >> (32 * hi));
                    p0 = p0 || (e0 && (run0 + __popc(h0 & below)) < nt0); p1 = p1 || (e1 && (run1 + __popc(h1 & below)) < nt1);
                    run0 += __popc(h0); run1 += __popc(h1);
                }
                const unsigned long long b0 = __ballot(p0), b1 = __ballot(p1);
                if (l == 0) { maskw[(4 * w + 0) * MASK_PITCH + kt] = (unsigned)b0; maskw[(4 * w + 1) * MASK_PITCH + kt] = (unsigned)b1; }
                if (l == 32) { maskw[(4 * w + 2) * MASK_PITCH + kt] = (unsigned)(b0 >> 32); maskw[(4 * w + 3) * MASK_PITCH + kt] = (unsigned)(b1 >> 32); }
            }
        }
        __syncthreads();
        {
            const int g = w >> 1;
            bf16x8 qb[4];
#pragma unroll
            for (int ks = 0; ks < 4; ++ks) qb[ks] = *(const bf16x8*)(Q + (size_t)(m0 + rho) * 512 + w * 64 + 16 * ks + 8 * hi);
            asm volatile("" :: "v"(qb[0]), "v"(qb[1]), "v"(qb[2]), "v"(qb[3]));
            asm volatile("s_waitcnt vmcnt(0)" ::: "memory");
            const unsigned char* ksrc[2]; const unsigned char* vsrc[2];
#pragma unroll
            for (int k = 0; k < 2; ++k) { const int i = (k * 8 + w) * 64 + l; const int r = i >> 5, c = i & 31; ksrc[k] = (const unsigned char*)KB + (size_t)r * 512 + 16 * (c ^ (r & 15));
                const int R = i >> 2, cv = i & 3; vsrc[k] = (const unsigned char*)VT + (size_t)R * vpitch * 2 + 16 * (cv ^ ((R >> 2) & 3)); }
#define KV_STAGE(t_) do { const int bo_ = A_RING2 + ((t_) % 3) * 32768 + w * 1024; \
            __builtin_amdgcn_global_load_lds((const unsigned*)(ksrc[0] + (size_t)(t_) * 16384), (LAS3 unsigned*)(ldsb + bo_), 16, 0, 0); \
            __builtin_amdgcn_global_load_lds((const unsigned*)(ksrc[1] + (size_t)(t_) * 16384), (LAS3 unsigned*)(ldsb + bo_ + 8192), 16, 0, 0); \
            __builtin_amdgcn_global_load_lds((const unsigned*)(vsrc[0] + (size_t)(t_) * 64), (LAS3 unsigned*)(ldsb + bo_ + 16384), 16, 0, 0); \
            __builtin_amdgcn_global_load_lds((const unsigned*)(vsrc[1] + (size_t)(t_) * 64), (LAS3 unsigned*)(ldsb + bo_ + 24576), 16, 0, 0); } while (0)
            f32x16 o0 = {0.f, 0.f, 0.f, 0.f, 0.f, 0.f, 0.f, 0.f, 0.f, 0.f, 0.f, 0.f, 0.f, 0.f, 0.f, 0.f}, o1 = o0; float psum = 0.f;
            const int ksw = rho & 15;
            const int vR0 = g * 64 + rho, vR1 = vR0 + 32; const int vs0 = (vR0 >> 2) & 3, vs1 = (vR1 >> 2) & 3;
            for (int rp3 = 0; rp3 <= PROBE_A3; ++rp3) {
            if (rp3) __syncthreads();
            KV_STAGE(0); if (1 < nkt) KV_STAGE(1);
            for (int kt = 0; kt < nkt; ++kt) {
                if (kt + 1 < nkt) asm volatile("s_waitcnt vmcnt(4) lgkmcnt(0)\n\ts_barrier" ::: "memory"); else asm volatile("s_waitcnt vmcnt(0) lgkmcnt(0)\n\ts_barrier" ::: "memory");
                if (kt + 2 < nkt) KV_STAGE(kt + 2);
                const unsigned char* kbuf = lds + A_RING2 + (kt % 3) * 32768; const unsigned char* vbuf = kbuf + 16384;
                f32x16 st = {0.f, 0.f, 0.f, 0.f, 0.f, 0.f, 0.f, 0.f, 0.f, 0.f, 0.f, 0.f, 0.f, 0.f, 0.f, 0.f};
#pragma unroll
                for (int ks = 0; ks < 4; ++ks) st = MFMA32(*(const bf16x8*)(kbuf + rho * 512 + 16 * ((g * 8 + 2 * ks + hi) ^ ksw)), qb[ks], st);
                unsigned word = need_idx ? maskw[rho * MASK_PITCH + kt] : 0xffffffffu; word >>= 4 * hi; float pr[16];
#pragma unroll
                for (int r = 0; r < 16; ++r) { const float e = __builtin_amdgcn_exp2f(st[r]); pr[r] = ((word >> ((r & 3) + 8 * (r >> 2))) & 1u) ? e : 0.f; psum += pr[r]; }
                union { u32x4 u; bf16x8 v; } pa0, pa1; pa0.u = (u32x4){pg8::cvt_pk_bf16(pr[0], pr[1]), pg8::cvt_pk_bf16(pr[2], pr[3]), pg8::cvt_pk_bf16(pr[4], pr[5]), pg8::cvt_pk_bf16(pr[6], pr[7])}; pa1.u = (u32x4){pg8::cvt_pk_bf16(pr[8], pr[9]), pg8::cvt_pk_bf16(pr[10], pr[11]), pg8::cvt_pk_bf16(pr[12], pr[13]), pg8::cvt_pk_bf16(pr[14], pr[15])};
                union { u32x4 u; bf16x8 v; } vf[2][2];
#pragma unroll
                for (int s2 = 0; s2 < 2; ++s2) { const unsigned char* r0 = vbuf + vR0 * 64 + 8 * hi; const unsigned char* r1 = vbuf + vR1 * 64 + 8 * hi;
                    const u32x2 a0 = *(const u32x2*)(r0 + 16 * ((2 * s2) ^ vs0)), a1 = *(const u32x2*)(r0 + 16 * ((2 * s2 + 1) ^ vs0)), b0 = *(const u32x2*)(r1 + 16 * ((2 * s2) ^ vs1)), b1 = *(const u32x2*)(r1 + 16 * ((2 * s2 + 1) ^ vs1));
                    vf[s2][0].u = (u32x4){a0.x, a0.y, a1.x, a1.y}; vf[s2][1].u = (u32x4){b0.x, b0.y, b1.x, b1.y}; }
                o0 = MFMA32(pa0.v, vf[0][0].v, o0); o0 = MFMA32(pa1.v, vf[1][0].v, o0); o1 = MFMA32(pa0.v, vf[0][1].v, o1); o1 = MFMA32(pa1.v, vf[1][1].v, o1);
            }
            }
#undef KV_STAGE
            psum += __shfl_xor(psum, 32);
            if (hi == 0) lsum[w * 32 + rho] = psum;
            __syncthreads();
#pragma unroll
            for (int r = 0; r < 16; ++r) { const int qr = crow(r, hi); const float inv = 1.0f / lsum[w * 32 + qr];
                bf16* op = O + (size_t)(m0 + qr) * DM + w * 64 + rho;
                op[0] = (bf16)f2bf(o0[r] * inv); op[32] = (bf16)f2bf(o1[r] * inv); }
        }
        __syncthreads();
    }
}

constexpr int XS_PITCH = 168;
__device__ __forceinline__ void p4_rwkv_prep(const Args& a, unsigned char* lds, int tid) {
    unsigned char* ws = a.ws; float* out = a.out;
    const bf16* ZS = (const bf16*)(ws + WS_ZS);
    const bf16* w2t = (const bf16*)(ws + WS_W2T); const bf16* a2t = (const bf16*)(ws + WS_A2T); const bf16* g2t = (const bf16*)(ws + WS_G2T);
    float* OW = (float*)(ws + WS_OW); bf16* OKK = (bf16*)(ws + WS_OKK); bf16* OB = (bf16*)(ws + WS_OB); bf16* OKM = (bf16*)(ws + WS_OKM); bf16* OR_ = (bf16*)(ws + WS_OR); bf16* OV = (bf16*)(ws + WS_OV);
    bf16* G = (bf16*)(out + SC_G); float* BON = (float*)(ws + WS_BONUS);
    const float* mu = a.in[13]; const float* w0 = a.in[14]; const float* a0 = a.in[16]; const float* k_k = a.in[19]; const float* k_a = a.in[20]; const float* r_k = a.in[21]; const float* sh0 = a.in[6];
    bf16* xs = (bf16*)lds;
    const int l = tid & 63, h = __builtin_amdgcn_readfirstlane(tid >> 6), rho = l & 31, hi = l >> 5;
    for (int tile = blockIdx.x; tile < MT / 32; tile += gridDim.x) {
        const int m0 = tile * 32; const bool smp = m0 >= MP;
        const bool tile_first = smp || (m0 & (T_P - 1)) == 0;
        { const int tk = tid >> 4, c0 = (tid & 15) * 10, m = m0 + tk; const bool first = tile_first && tk == 0;
          const bf16* zc = ZS + (size_t)m * SHIFTW + 1536 + c0; const bf16* zp = first ? zc : zc - SHIFTW;
          const float* shp = sh0 + (size_t)(smp ? ((m0 - MP) >> 5) : 0) * SHIFTW + 1536 + c0;
#pragma unroll
          for (int e = 0; e < 10; ++e) { const int c = c0 + e; const float cur = bf1(zc[e]); float prev = bf1(zp[e]);
              if (first) prev = smp ? shp[e] : 0.f;
              const float zm = cur + mu[1536 + c] * (prev - cur);
              const float f = __frcp_rn(1.0f + __expf(c < 32 ? -2.0f * zm : -zm));
              const float v = c < 32 ? 2.0f * f - 1.0f : (c < 64 ? zm : f);
              xs[tk * XS_PITCH + c] = (bf16)f2bf(v); } }
        __syncthreads();
        const int m = m0 + rho; const bool first = tile_first && rho == 0;
        const bf16* zc = ZS + (size_t)m * SHIFTW + 64 * h + 4 * hi; const bf16* zp = first ? zc : zc - SHIFTW;
        const float* shp = sh0 + (size_t)(smp ? ((m0 - MP) >> 5) : 0) * SHIFTW + 64 * h + 4 * hi;
        const float* mu_l = mu + 64 * h + 4 * hi;
        const int pofs = 64 * h + 4 * hi;
#define ZMIX4(dst, co) do { const u32x2 cw = *(const u32x2*)(zc + (co)); const u32x2 pw = *(const u32x2*)(zp + (co)); const f32x4 mu4 = *(const f32x4*)(mu_l + (co)); \
            const float cu[4] = {bflo(cw.x), bfhi(cw.x), bflo(cw.y), bfhi(cw.y)}; float pv[4] = {bflo(pw.x), bfhi(pw.x), bflo(pw.y), bfhi(pw.y)}; \
            if (tile_first) { f32x4 s4 = {0.f, 0.f, 0.f, 0.f}; if (smp) s4 = *(const f32x4*)(shp + (co)); if (first) { pv[0] = s4.x; pv[1] = s4.y; pv[2] = s4.z; pv[3] = s4.w; } } \
            _Pragma("unroll") for (int e = 0; e < 4; ++e) dst[e] = cu[e] + mu4[e] * (pv[e] - cu[e]); } while (0)
        float n2 = 0.f;
#pragma unroll
        for (int ct = 0; ct < 2; ++ct)
#pragma unroll
            for (int grp = 0; grp < 4; ++grp) { const int co = 32 * ct + 8 * grp; float zk[4]; ZMIX4(zk, 512 + co); const f32x4 kk4 = *(const f32x4*)(k_k + pofs + co);
#pragma unroll
                for (int e = 0; e < 4; ++e) { const float kr = zk[e] * kk4[e]; n2 += kr * kr; } }
        n2 += __shfl_xor(n2, 32);
        const float invn = 1.0f / fmaxf(sqrtf(n2), 1e-12f);
        float bon = 0.f;
        asm volatile("" ::: "memory");
#pragma unroll
        for (int ct = 0; ct < 2; ++ct) {
            const f32x16 z16 = {0.f, 0.f, 0.f, 0.f, 0.f, 0.f, 0.f, 0.f, 0.f, 0.f, 0.f, 0.f, 0.f, 0.f, 0.f, 0.f}; f32x16 Dw = z16, Da = z16, Dg = z16;
            const int n = 64 * h + 32 * ct + rho;
            const bf16* xrow = xs + rho * XS_PITCH + 8 * hi;
#pragma unroll
            for (int ks = 0; ks < 2; ++ks) {
                Dw = MFMA32(*(const bf16x8*)(w2t + n * 32 + 16 * ks + 8 * hi), *(const bf16x8*)(xrow + 16 * ks), Dw);
                Da = MFMA32(*(const bf16x8*)(a2t + n * 32 + 16 * ks + 8 * hi), *(const bf16x8*)(xrow + 32 + 16 * ks), Da); }
#pragma unroll
            for (int ks = 0; ks < 6; ++ks) Dg = MFMA32(*(const bf16x8*)(g2t + n * 96 + 16 * ks + 8 * hi), *(const bf16x8*)(xrow + 64 + 16 * ks), Dg);
#pragma unroll
            for (int grp = 0; grp < 4; ++grp) {
                const int co = 32 * ct + 8 * grp;
                float zr[4], zk[4], zv[4]; ZMIX4(zr, co); ZMIX4(zk, 512 + co); ZMIX4(zv, 1024 + co);
                const f32x4 w04 = *(const f32x4*)(w0 + pofs + co), a04 = *(const f32x4*)(a0 + pofs + co), kk4 = *(const f32x4*)(k_k + pofs + co), ka4 = *(const f32x4*)(k_a + pofs + co), rk4 = *(const f32x4*)(r_k + pofs + co);
                float dec[4], km[4], gg[4], kk[4], bb[4];
#pragma unroll
                for (int e = 0; e < 4; ++e) { const int r = 4 * grp + e;
                    const float sg = __frcp_rn(1.0f + __expf(-(w04[e] + Dw[r])));
                    dec[e] = __expf(-0.6065306597126334f * sg);
                    const float aa = __frcp_rn(1.0f + __expf(-(a04[e] + Da[r])));
                    gg[e] = Dg[r];
                    kk[e] = zk[e] * kk4[e] * invn; bb[e] = kk[e] * aa;
                    km[e] = zk[e] * (1.0f + (aa - 1.0f) * ka4[e]);
                    bon += zr[e] * km[e] * rk4[e]; }
                const size_t o = (size_t)m * 512 + pofs + co;
                *(f32x4*)(OW + o) = (f32x4){dec[0], dec[1], dec[2], dec[3]};
                *(u32x2*)(OKK + o) = (u32x2){pk2(kk[0], kk[1]), pk2(kk[2], kk[3])};
                *(u32x2*)(OB + o) = (u32x2){pk2(bb[0], bb[1]), pk2(bb[2], bb[3])};
                *(u32x2*)(OKM + o) = (u32x2){pk2(km[0], km[1]), pk2(km[2], km[3])};
                *(u32x2*)(OR_ + o) = (u32x2){pk2(zr[0], zr[1]), pk2(zr[2], zr[3])};
                *(u32x2*)(OV + o) = (u32x2){pk2(zv[0], zv[1]), pk2(zv[2], zv[3])};
                *(u32x2*)(G + o) = (u32x2){pk2(gg[0], gg[1]), pk2(gg[2], gg[3])};
                asm volatile("" ::: "memory");
            }
        }
#undef ZMIX4
        bon += __shfl_xor(bon, 32);
        if (hi == 0) BON[(size_t)m * 8 + h] = bon;
        __syncthreads();
    }
}

constexpr int SC_CH = 32;
static_assert(WS_OB - WS_OKK == 17 * MiB && WS_OKM - WS_OB == 17 * MiB && WS_OR - WS_OKM == 17 * MiB && WS_OV - WS_OR == 17 * MiB, "operand arrays are equally spaced");
__device__ __forceinline__ void cvt_store8(unsigned char* d, const u32x4 x) {
    *(u32x4*)d = (u32x4){x.x << 16, x.x & 0xffff0000u, x.y << 16, x.y & 0xffff0000u}; *(u32x4*)(d + 16) = (u32x4){x.z << 16, x.z & 0xffff0000u, x.w << 16, x.w & 0xffff0000u};
}
struct StageP {
    static constexpr int STRIDE = 1280 + 64;
    const unsigned char* pw; const unsigned char* pb; int vrow0;
    u32x4 v[25];
    __device__ __forceinline__ void issue(int t0, int lane) {
        const unsigned char* gw = pw + ((size_t)(t0 + (lane >> 4)) * 512) * 4 + 16 * (lane & 15);
#pragma unroll
        for (int j = 0; j < 8; ++j) v[j] = *(const u32x4*)(gw + (size_t)j * 4 * 512 * 4);
        const unsigned char* gb = pb + ((size_t)(t0 + (lane >> 3)) * 512) * 2 + 16 * (lane & 7);
#pragma unroll
        for (int a = 0; a < 4; ++a)
#pragma unroll
            for (int jj = 0; jj < 4; ++jj) v[8 + 4 * a + jj] = *(const u32x4*)(gb + (size_t)a * (17 * MiB) + (size_t)jj * 8 * 512 * 2);
        v[24] = *(const u32x4*)(pb + (size_t)4 * (17 * MiB) + ((size_t)(t0 + (lane >> 1)) * 512) * 2 + 2 * vrow0 + 16 * (lane & 1));
    }
    __device__ __forceinline__ void commit(unsigned char* buf, int lane) const {
        unsigned char* dw = buf + (lane >> 4) * STRIDE + 16 * (lane & 15);
#pragma unroll
        for (int j = 0; j < 8; ++j) *(u32x4*)(dw + j * 4 * STRIDE) = v[j];
        unsigned char* db = buf + (lane >> 3) * STRIDE + 256 + 32 * (lane & 7);
#pragma unroll
        for (int a = 0; a < 4; ++a)
#pragma unroll
            for (int jj = 0; jj < 4; ++jj) cvt_store8(db + a * 256 + jj * 8 * STRIDE, v[8 + 4 * a + jj]);
        cvt_store8(buf + (lane >> 1) * STRIDE + 1280 + 32 * (lane & 1), v[24]);
    }
};
struct StageS {
    static constexpr int STRIDE = 1280 + 256;
    const unsigned char* pw; const unsigned char* pb;
    u32x4 v[7];
    __device__ __forceinline__ void issue(int t0, int lane) {
        const unsigned char* gw = pw + ((size_t)(t0 + (lane >> 4)) * 512) * 4 + 16 * (lane & 15);
        v[0] = *(const u32x4*)gw; v[1] = *(const u32x4*)(gw + (size_t)4 * 512 * 4);
        const unsigned char* gb = pb + ((size_t)(t0 + (lane >> 3)) * 512) * 2 + 16 * (lane & 7);
#pragma unroll
        for (int a = 0; a < 5; ++a) v[2 + a] = *(const u32x4*)(gb + (size_t)a * (17 * MiB));
    }
    __device__ __forceinline__ void commit(unsigned char* buf, int lane) const {
        unsigned char* dw = buf + (lane >> 4) * STRIDE + 16 * (lane & 15);
        *(u32x4*)dw = v[0]; *(u32x4*)(dw + 4 * STRIDE) = v[1];
        unsigned char* db = buf + (lane >> 3) * STRIDE + 256 + 32 * (lane & 7);
#pragma unroll
        for (int a = 0; a < 5; ++a) cvt_store8(db + a * 256, v[2 + a]);
    }
};
typedef float f32x2 __attribute__((ext_vector_type(2)));
template <int STRIDE> __device__ __forceinline__ void scan_consume(f32x4& S4, const unsigned char* buf, int nst, int ks, int rowl, float* yp) {
    f32x2 Sa = {S4.x, S4.y}, Sb = {S4.z, S4.w};
    for (int s0 = 0; s0 < nst; s0 += 16) {
        float ykeep = 0.f;
#pragma unroll 1
        for (int g = 0; g < 4; ++g) {
            const int kq = ks - 4 * g;
#pragma unroll
            for (int j = 0; j < 4; ++j) {
                const float* p = (const float*)(buf + (s0 + 4 * g + j) * STRIDE) + 4 * ks;
                const f32x2 wa = *(const f32x2*)(p), wb = *(const f32x2*)(p + 2), ka = *(const f32x2*)(p + 64), kb = *(const f32x2*)(p + 66), ba = *(const f32x2*)(p + 128), bb = *(const f32x2*)(p + 130),
                            ma = *(const f32x2*)(p + 192), mb = *(const f32x2*)(p + 194), ra = *(const f32x2*)(p + 256), rb = *(const f32x2*)(p + 258);
                const float v = ((const float*)(buf + (s0 + 4 * g + j) * STRIDE))[320 + rowl];
                f32x2 t = Sa * ka + Sb * kb; float d = t.x + t.y; d = sum16(d);
                const f32x2 vv = {v, v}, dd = {d, d};
                Sa = Sa * wa + (vv * ma - dd * ba); Sb = Sb * wb + (vv * mb - dd * bb);
                f32x2 u = Sa * ra + Sb * rb; float y = u.x + u.y; y = sum16(y);
                ykeep = kq == j ? y : ykeep;
            }
        }
        yp[(size_t)(s0 + ks) * 512] = ykeep;
    }
    S4 = (f32x4){Sa.x, Sa.y, Sb.x, Sb.y};
}
__device__ __forceinline__ void p5_rwkv_scan(const Args& a, unsigned char* lds, int tid) {
    const unsigned char* ws = a.ws; float* out = a.out; float* Y = out + SC_Y;
    const int l = tid & 63, w = __builtin_amdgcn_readfirstlane(tid >> 6), ks = l & 15, rl = l >> 4;
    const int G = gridDim.x, vcu = (G % 8 == 0) ? (blockIdx.x % 8) * (G / 8) + blockIdx.x / 8 : blockIdx.x;
    typedef StageP StP; typedef StageS StS;
    unsigned char* buf0 = lds; unsigned char* buf1 = lds + SC_CH * StP::STRIDE;
    for (int it = vcu; it < 256; it += G) {
        {
            const int bh = it >> 2, b = bh >> 3, h = bh & 7, rb = it & 3, row = 16 * rb + 4 * w + rl;
            const size_t base0 = ((size_t)b * T_P) * 512 + (size_t)h * 64;
            constexpr int NC = T_P / SC_CH;
            StP st; st.pw = ws + WS_OW + base0 * 4; st.pb = ws + WS_OKK + base0 * 2; st.vrow0 = 16 * rb;
            f32x4 S = {0.f, 0.f, 0.f, 0.f};
            if (w >= 4) { if (w == 4) { st.issue(0, l); st.commit(buf0, l); st.issue(4 * SC_CH, l); } else st.issue((w - 4) * SC_CH, l); }
            else __builtin_amdgcn_s_setprio(3);
            __syncthreads();
            Y += base0 + row;
#define SCAN_ITER(c, P, cur, nxt) do { if (w == 4 + (P)) { if ((c) + 1 < NC) { st.commit(nxt, l); if ((c) + 5 < NC) st.issue(((c) + 5) * SC_CH, l); } } \
                else if (w < 4) scan_consume<StP::STRIDE>(S, cur, SC_CH, ks, 4 * w + rl, Y + (size_t)((c) * SC_CH) * 512); __syncthreads(); } while (0)
            for (int c = 0; c < NC; c += 4) { SCAN_ITER(c, 1, buf0, buf1); SCAN_ITER(c + 1, 2, buf1, buf0); SCAN_ITER(c + 2, 3, buf0, buf1); SCAN_ITER(c + 3, 0, buf1, buf0); }
#undef SCAN_ITER
            __builtin_amdgcn_s_setprio(0);
            Y -= base0 + row;
            if (w < 4) *(f32x4*)(out + OFF_WKVP + ((size_t)bh * 64 + row) * 64 + 4 * ks) = S;
        }
        {
            const int b = it >> 3, h = it & 7;
            const size_t base0 = ((size_t)MP + (size_t)b * T_S) * 512 + (size_t)h * 64;
            StS st; st.pw = ws + WS_OW + base0 * 4; st.pb = ws + WS_OKK + base0 * 2;
            if (w >= 4) { st.issue(8 * (w - 4), l); st.commit(buf0 + 8 * (w - 4) * StS::STRIDE, l); }
            __syncthreads();
            for (int pass = 0; pass < 2; ++pass) { const int row = 8 * w + 4 * pass + rl;
                f32x4 S = *(const f32x4*)(a.in[5] + ((size_t)it * 64 + row) * 64 + 4 * ks);
                scan_consume<StS::STRIDE>(S, buf0, T_S, ks, row, Y + base0 + row);
                *(f32x4*)(out + OFF_WKVS + ((size_t)it * 64 + row) * 64 + 4 * ks) = S; }
            __syncthreads();
        }
    }
}

__device__ __forceinline__ void p6_rwkv_out(const Args& a, int tid) {
    const unsigned char* ws = a.ws; const float* out = a.out; const float* Y = out + SC_Y; const bf16* G = (const bf16*)(out + SC_G);
    const bf16* OV = (const bf16*)(ws + WS_OV); const float* BON = (const float*)(ws + WS_BONUS); bf16* O = (bf16*)(a.ws + WS_XB);
    const float* lg = a.in[22]; const float* lb = a.in[23];
    const int sub = tid & 7;
    for (size_t it = (size_t)blockIdx.x * 64 + (tid >> 3); it < (size_t)MT * 8; it += (size_t)gridDim.x * 64) {
        const size_t m = it >> 3; const int h = (int)(it & 7); const size_t o = m * 512 + h * 64 + 8 * sub;
        const f32x4 y0 = *(const f32x4*)(Y + o), y1 = *(const f32x4*)(Y + o + 4); float y[8] = {y0.x, y0.y, y0.z, y0.w, y1.x, y1.y, y1.z, y1.w};
        float s1 = 0.f;
#pragma unroll
        for (int j = 0; j < 8; ++j) s1 += y[j];
        s1 += __shfl_xor(s1, 1); s1 += __shfl_xor(s1, 2); s1 += __shfl_xor(s1, 4);
        const float mean = s1 * (1.f / 64.f); float s2 = 0.f;
#pragma unroll
        for (int j = 0; j < 8; ++j) { const float d = y[j] - mean; s2 += d * d; }
        s2 += __shfl_xor(s2, 1); s2 += __shfl_xor(s2, 2); s2 += __shfl_xor(s2, 4);
        const float rinv = rsqrtf(s2 * (1.f / 64.f) + 64e-5f);
        float v[8], g[8]; unpack8(*(const u32x4*)(OV + o), v); unpack8(*(const u32x4*)(G + o), g);
        const float bon = BON[it]; float r[8];
#pragma unroll
        for (int j = 0; j < 8; ++j) { const int c = h * 64 + 8 * sub + j; r[j] = ((y[j] - mean) * rinv * lg[c] + lb[c] + bon * v[j]) * g[j]; }
        *(u32x4*)(O + m * DM + 512 + h * 64 + 8 * sub) = pack8(r);
    }
}

__device__ __forceinline__ void p8_hnorm(const Args& a, int tid) {
    const int lane = tid & 63, gw = blockIdx.x * 8 + (tid >> 6), NGW = gridDim.x * 8;
    for (int m = gw; m < MT; m += NGW) {
        const f32x4* xr = (const f32x4*)(a.out + OFF_Y + (size_t)m * DM) + lane; f32x4 v[4]; float s = 0.f;
#pragma unroll
        for (int j = 0; j < 4; ++j) { v[j] = xr[64 * j]; s += (v[j].x * v[j].x + v[j].y * v[j].y) + (v[j].z * v[j].z + v[j].w * v[j].w); }
        const float rs = rsqrtf(wave_sum(s) * (1.f / DM) + 1e-6f);
        u32x2* o8 = (u32x2*)((bf16*)(a.ws + WS_HB) + (size_t)m * DM) + lane;
#pragma unroll
        for (int j = 0; j < 4; ++j) { u32x2 o; o.x = pk2(v[j].x * rs, v[j].y * rs); o.y = pk2(v[j].z * rs, v[j].w * rs); o8[64 * j] = o; }
    }
}

#define XB_TMO      128
#define XB_XCNT(j)  (256  + 64 * (j))
#define XB_XSUB(j)  (1280 + 64 * (j))
#define XB_XGEN(j)  (2304 + 64 * (j))
#define XB_TOP      3328
#define XB_TOPGEN   3392
#define XCD_BAR_WORDS 3456
#define XB_SPIN_CAP (1u << 18)

__device__ __forceinline__ unsigned xb_ld(unsigned* p)              { return __hip_atomic_load(p, __ATOMIC_RELAXED, __HIP_MEMORY_SCOPE_AGENT); }
__device__ __forceinline__ unsigned xb_add(unsigned* p, unsigned v) { return __hip_atomic_fetch_add(p, v, __ATOMIC_RELAXED, __HIP_MEMORY_SCOPE_AGENT); }
__device__ __forceinline__ unsigned xb_xcc_id() { return (unsigned)__builtin_amdgcn_s_getreg((3 << 11) | 20) & 0xFu; }
#define XB_SPIN(cond, bar) do { unsigned _sp = 0; while (cond) { __builtin_amdgcn_s_sleep(1); \
    if ((++_sp & 255u) == 0u) { if (xb_ld(&(bar)[XB_TMO])) break; if (_sp > XB_SPIN_CAP) { atomicAdd(&(bar)[XB_TMO], 1u); break; } } } } while (0)

struct XcdBarrier {
    unsigned* bar; unsigned x;
    volatile __attribute__((address_space(3))) unsigned* st;
};

__device__ __forceinline__ XcdBarrier xcd_barrier_post(unsigned* bar, volatile __attribute__((address_space(3))) unsigned* st) {
    XcdBarrier b; b.bar = bar; b.x = xb_xcc_id(); b.st = st;
    if (threadIdx.x == 0) (void)xb_add(&bar[XB_XCNT(b.x)], 1u);
    return b;
}
__device__ __forceinline__ void xcd_barrier_complete(unsigned* bar, unsigned x, unsigned& nloc, unsigned& nx) {
    const unsigned G = gridDim.x * gridDim.y * gridDim.z;
    unsigned sum, cnt, mine, sp = 0u;
    for (;;) {
        sum = 0u; cnt = 0u; mine = 0u;
#pragma unroll
        for (unsigned j = 0; j < 16; ++j) { const unsigned c = xb_ld(&bar[XB_XCNT(j)]); sum += c; cnt += (c > 0u) ? 1u : 0u; mine = (j == x) ? c : mine; }
        if (sum == G) break;
        __builtin_amdgcn_s_sleep(1);
        if ((++sp & 255u) == 0u) { if (xb_ld(&bar[XB_TMO])) break; if (sp > XB_SPIN_CAP) { atomicAdd(&bar[XB_TMO], 1u); break; } }
    }
    nloc = mine > 0u ? mine : 1u; nx = cnt > 0u ? cnt : 1u;
}

__device__ __forceinline__ void xcd_barrier(const XcdBarrier& b) {
    asm volatile("s_waitcnt vmcnt(0)" ::: "memory");
    __syncthreads();
    if (threadIdx.x == 0) {
        unsigned* bar = b.bar;
        __builtin_amdgcn_s_waitcnt(0);
        unsigned nloc = b.st[0], nx = b.st[1];
        if (nloc == 0u) { xcd_barrier_complete(bar, b.x, nloc, nx); b.st[0] = nloc; b.st[1] = nx; }
        const unsigned old = xb_add(&bar[XB_XSUB(b.x)], 1u);
        const unsigned gen = old / nloc;
        if (old + 1u == (gen + 1u) * nloc) {
            __builtin_amdgcn_fence(__ATOMIC_RELEASE, "agent");
            asm volatile("s_waitcnt vmcnt(0)" ::: "memory");
            const unsigned og = xb_add(&bar[XB_TOP], 1u);
            const unsigned tg = og / nx;
            if (og + 1u == (tg + 1u) * nx) xb_add(&bar[XB_TOPGEN], 1u);
            else XB_SPIN(xb_ld(&bar[XB_TOPGEN]) == tg, bar);
            __builtin_amdgcn_fence(__ATOMIC_ACQUIRE, "agent");
            xb_add(&bar[XB_XGEN(b.x)], 1u);
            asm volatile("s_waitcnt vmcnt(0)" ::: "memory");
        } else {
            XB_SPIN(xb_ld(&bar[XB_XGEN(b.x)]) == gen, bar);
            __builtin_amdgcn_fence(__ATOMIC_ACQUIRE, "agent");
            asm volatile("s_waitcnt vmcnt(0)" ::: "memory");
        }
    }
    __syncthreads();
}

constexpr int CW_BAR = 4096;
constexpr int LDS_BYTES = 163840;
constexpr int N_PHASES = 12;
#ifndef PROBE_MASK
#define PROBE_MASK 0
#endif
template <int PH> __device__ __forceinline__ void run_phase(const Args& args, unsigned char* lds, int tid, int rep) {
    unsigned char* ws = args.ws;
    if constexpr (PH == 0) p0_prologue(args, lds, tid);
    if constexpr (PH == 1) { pg8::Gemm g{(const pg8::bf16_t*)(ws + WS_XB), (const pg8::bf16_t*)(ws + WS_WIN), MT, NZ, DM, DM}; pg8::StaticOrder S; S.init(MT, NZ, gridDim.x, blockIdx.x);
        pg8::EpiZ E{(pg8::bf16_t*)(ws + WS_ZR), (pg8::bf16_t*)(ws + WS_ZS)};
        pg8::gemm_phase<pg8::EpiZ, pg8::StaticOrder, true, true>((PG8_LAS unsigned char*)lds, g, S, E); }
    if constexpr (PH == 2) p2_post(args, lds, tid);
    if constexpr (PH == 3) p3_attention(args, lds, tid, rep);
    if constexpr (PH == 4) p4_rwkv_prep(args, lds, tid);
    if constexpr (PH == 5) p5_rwkv_scan(args, lds, tid);
    if constexpr (PH == 6) p6_rwkv_out(args, tid);
    if constexpr (PH == 7) { pg8::Gemm g{(const pg8::bf16_t*)(ws + WS_XB), (const pg8::bf16_t*)(ws + WS_WOUT), MT, DM, DM, DM}; pg8::StaticOrder S; S.init(MT, DM, gridDim.x, blockIdx.x);
        pg8::EpiH E{args.in[0], args.in[1], args.out + OFF_Y, (pg8::bf16_t*)(ws + WS_HB), (float*)(ws + WS_CTL) + CW_SS};
        pg8::gemm_phase<pg8::EpiH, pg8::StaticOrder, true, true>((PG8_LAS unsigned char*)lds, g, S, E); }
    if constexpr (PH == 9) { pg8::Gemm g{(const pg8::bf16_t*)(ws + WS_HB), (const pg8::bf16_t*)(ws + WS_W1), MT, DFF, DM, DM}; pg8::StaticOrder S; S.init(MT, DFF, gridDim.x, blockIdx.x);
        pg8::EpiAct E{(pg8::bf16_t*)(ws + WS_ACT), DFF, (const float*)(ws + WS_CTL) + CW_SS};
        pg8::gemm_phase<pg8::EpiAct, pg8::StaticOrder, true, true>((PG8_LAS unsigned char*)lds, g, S, E); }
    if constexpr (PH == 10) {
        { pg8::Gemm g{(const pg8::bf16_t*)(ws + WS_ACT), (const pg8::bf16_t*)(ws + WS_W2), MP, DM, DFF, DFF}; pg8::StaticOrder S; S.init(MP, DM, gridDim.x, blockIdx.x);
          pg8::EpiY E{args.out + OFF_Y};
          pg8::gemm_phase<pg8::EpiY, pg8::StaticOrder, true, true>((PG8_LAS unsigned char*)lds, g, S, E); }
        { const int c = blockIdx.x; pg8::OneUnit S; S.has = c < 64; S.u.pm = MP / 256 + (c >> 4); S.u.pn = (c >> 2) & 3; const int sl = c & 3;
          pg8::Gemm g{(const pg8::bf16_t*)(ws + WS_ACT) + sl * 1024, (const pg8::bf16_t*)(ws + WS_W2) + sl * 1024, MT, DM, DFF, 1024};
          pg8::EpiSlab E{(float*)(ws + WS_HB) + (size_t)sl * MS * DM};
          __syncthreads();
          pg8::gemm_phase<pg8::EpiSlab, pg8::OneUnit, false, true>((PG8_LAS unsigned char*)lds, g, S, E); }
    }
    if constexpr (PH == 11) {
        const f32x4* sl = (const f32x4*)(ws + WS_HB); f32x4* y = (f32x4*)(args.out + OFF_Y + (size_t)MP * DM); constexpr int NV = MS * DM / 4;
        for (int i = blockIdx.x * 512 + tid; i < NV; i += gridDim.x * 512) y[i] = y[i] + ((sl[i] + sl[i + NV]) + (sl[i + 2 * NV] + sl[i + 3 * NV]));
    }
}
#ifndef MK_ONE_LAUNCH
#define MK_ONE_LAUNCH 1
#endif
#if MK_ONE_LAUNCH
__global__ void __launch_bounds__(512, 2) mk_fwd(Args args) {
    extern __shared__ __attribute__((aligned(16))) unsigned char lds[];
    const int tid = threadIdx.x;
    volatile __attribute__((address_space(3))) unsigned* bst = (volatile __attribute__((address_space(3))) unsigned*)((__attribute__((address_space(3))) unsigned char*)lds + LDS_BYTES - 16);
    if (tid < 2) bst[tid] = 0u;
    __syncthreads();
    const XcdBarrier bar = xcd_barrier_post((unsigned*)(args.ws + WS_CTL) + CW_BAR, bst);
#define SEAM(k) do { if ((k) == 1) { __syncthreads(); cg::this_grid().sync(); } else xcd_barrier(bar); } while (0)
#define PHASE(k) do { if (args.ph_lo <= (k) && (k) < args.ph_hi) { if ((k) > args.ph_lo) SEAM(k); run_phase<k>(args, lds, tid, 0); \
        if ((PROBE_MASK >> (k)) & 1) { xcd_barrier(bar); run_phase<k>(args, lds, tid, 1); } } } while (0)
    PHASE(0); PHASE(1); PHASE(2); PHASE(3); PHASE(4); PHASE(5); PHASE(6); PHASE(7); PHASE(9); PHASE(10); PHASE(11);
#undef PHASE
#undef SEAM
}
#else
template <int PH> __global__ void __launch_bounds__(512, 2) mk_phase(Args args) {
    extern __shared__ __attribute__((aligned(16))) unsigned char lds[];
    run_phase<PH>(args, lds, threadIdx.x, 0);
}
#endif

extern "C" void kernel_launch(void* const* d_in, const int* in_sizes, int n_in, void* d_out, int out_size, void* d_ws, size_t ws_size, hipStream_t stream) {
    static int grid = 0;
    if (grid == 0) {
        if (n_in != 28 || out_size != (int)OUT_TOTAL || ws_size < WS_END) { fprintf(stderr, "kernel_launch: unexpected shapes (n_in %d, out %d, ws %zu)\n", n_in, out_size, ws_size); grid = -1; return; }
        int dev = 0, cus = 0, per_cu = 0;
        (void)hipGetDevice(&dev); (void)hipDeviceGetAttribute(&cus, hipDeviceAttributeMultiprocessorCount, dev);
#if MK_ONE_LAUNCH
        if (hipFuncSetAttribute((const void*)mk_fwd, hipFuncAttributeMaxDynamicSharedMemorySize, LDS_BYTES) != hipSuccess) { fprintf(stderr, "kernel_launch: hipFuncSetAttribute failed\n"); grid = -1; return; }
        (void)hipOccupancyMaxActiveBlocksPerMultiprocessor(&per_cu, (const void*)mk_fwd, 512, LDS_BYTES);
        (void)hipGetLastError();
        if (per_cu < 1) { fprintf(stderr, "kernel_launch: occupancy query says %d blocks per CU\n", per_cu); per_cu = 1; }
#else
#define SETATTR(k) (void)hipFuncSetAttribute((const void*)mk_phase<k>, hipFuncAttributeMaxDynamicSharedMemorySize, LDS_BYTES)
        SETATTR(0); SETATTR(1); SETATTR(2); SETATTR(3); SETATTR(4); SETATTR(5); SETATTR(6); SETATTR(7); SETATTR(8); SETATTR(9); SETATTR(10); SETATTR(11);
#undef SETATTR
        (void)per_cu;
#endif
        grid = cus;
    }
    if (grid < 0) return;
    (void)hipMemsetAsync((char*)d_ws + WS_CTL, 0, CTL_BYTES, stream);
    Args a{};
    for (int i = 0; i < 28; ++i) a.in[i] = (const float*)d_in[i];
    a.out = (float*)d_out; a.ws = (unsigned char*)d_ws;
#if MK_ONE_LAUNCH
    a.ph_lo = 0; a.ph_hi = N_PHASES;
    void* kargs[] = {&a};
    hipError_t e = hipLaunchCooperativeKernel((const void*)mk_fwd, dim3(grid), dim3(512), kargs, LDS_BYTES, stream);
    if (e != hipSuccess) fprintf(stderr, "kernel_launch: cooperative launch failed: %s (grid %d)\n", hipGetErrorString(e), grid);
#else
#define LAUNCH(k) hipLaunchKernelGGL(mk_phase<k>, dim3(grid), dim3(512), LDS_BYTES, stream, a)
    a.ph_lo = 0; a.ph_hi = N_PHASES;
    LAUNCH(0); LAUNCH(1); LAUNCH(2); LAUNCH(3); LAUNCH(4); LAUNCH(5); LAUNCH(6); LAUNCH(7); LAUNCH(9); LAUNCH(10); LAUNCH(11);
#undef LAUNCH
#endif
}
```

```cpp
#include <hip/hip_runtime.h>
#include <hip/hip_cooperative_groups.h>
#include <cstdio>
#include <cstdint>
namespace cg = cooperative_groups;
#define PROBE_A1 0
#define PROBE_A2 0
#define PROBE_A3 0
namespace pg8 {
#define PG8_LAS __attribute__((address_space(3)))
typedef unsigned short bf16_t;
typedef short bf16x8 __attribute__((ext_vector_type(8)));
typedef float f32x4 __attribute__((ext_vector_type(4)));
typedef unsigned u32x4 __attribute__((ext_vector_type(4)));
constexpr int BM = 256, BK = 64, HALF = 128, HTB = HALF * BK * 2  , STAGE_BYTES = 8 * HTB, NXCD = 8, WGM = 8;

__host__ __device__ __forceinline__ int lds_byte(int r, int c) { const int st = (r >> 4) * 2 + (c >> 5), rr = r & 15, cc = c & 31, ob = rr * 64 + cc * 2; return st * 1024 + (ob ^ (((ob >> 9) & 1) << 5)); }
__host__ __device__ __forceinline__ void stage_rc(int b, int& R, int& C) { const int st = b / 1024, sb = b % 1024, swz = sb ^ (((sb >> 9) & 1) << 5); R = (st >> 1) * 16 + swz / 64; C = (st & 1) * 32 + (swz % 64) / 2; }
__host__ __device__ __forceinline__ int perm32(int rho) { const int n = rho >> 4, i = rho & 15; return 8 * (i >> 2) + 4 * n + (i & 3); }

struct Unit { int pm, pn; };
struct Gemm { const bf16_t* A; const bf16_t* Bt; int M, N, K, KL; };

struct StaticOrder {
    int nM, nN, nwg, G, c;
    __host__ __device__ void init(int M, int N, int G_, int c_) { nM = M / BM; nN = N / BM; nwg = nM * nN; G = G_; c = c_; }
    __host__ __device__ bool next(int i, Unit& u) const {
        const long L = (long)i * G + c; if (L >= nwg) return false;
        int wgid = (int)L; { const int q = nwg / NXCD, r = nwg % NXCD, xcd = wgid % NXCD, off = wgid / NXCD; wgid = (xcd < r ? xcd * (q + 1) : r * (q + 1) + (xcd - r) * q) + off; }
        const int nig = WGM * nN, gid = wgid / nig, fm = gid * WGM, gsz = (nM - fm) < WGM ? (nM - fm) : WGM;
        u.pm = fm + ((wgid % nig) % gsz); u.pn = (wgid % nig) / gsz; return true;
    }
    __device__ __forceinline__ void a_ready(const Unit&) const {}
    __device__ __forceinline__ void done(const Unit&) const {}
};


__device__ __forceinline__ unsigned cvt_pk_bf16(float lo, float hi) { unsigned r; asm volatile("v_cvt_pk_bf16_f32 %0, %1, %2" : "=v"(r) : "v"(lo), "v"(hi)); return r; }

constexpr int E_MP = 16384;
constexpr int E_ZRW = 1632, E_ZSW = 1696;

struct OneUnit { Unit u; bool has;
    __device__ __forceinline__ bool next(int i, Unit& o) const { if (i == 0 && has) { o = u; return true; } return false; }
    __device__ __forceinline__ void a_ready(const Unit&) const {}
    __device__ __forceinline__ void done(const Unit&) const {} };
struct EpiZ {
    static constexpr bool PERM = true, AFTER_DRAIN = false;
    bf16_t* ZR; bf16_t* ZS;
    __device__ __forceinline__ void operator()(const f32x4 (&acc)[2][2][4][2], const Unit& u, int wr, int wc, int fr, int fq) const {
        const int row0 = u.pm * BM + wr * 64 + fr, c0 = u.pn * BM + wc * 32 + 8 * fq;
#pragma unroll
        for (int ai = 0; ai < 2; ++ai)
#pragma unroll
            for (int m = 0; m < 4; ++m) { const size_t row = (size_t)(row0 + ai * HALF + m * 16);
#pragma unroll
                for (int bj = 0; bj < 2; ++bj) { const int c = c0 + bj * HALF; bf16_t* dst;
                    if (c < 1600) dst = ZR + row * E_ZRW + c; else if (c < 3296) dst = ZS + row * E_ZSW + (c - 1600); else if (c == 3296) dst = ZR + row * E_ZRW + 1600; else continue;
                    const f32x4 v0 = acc[ai][bj][m][0], v1 = acc[ai][bj][m][1]; u32x4 w;
                    w.x = cvt_pk_bf16(v0[0], v0[1]); w.y = cvt_pk_bf16(v0[2], v0[3]); w.z = cvt_pk_bf16(v1[0], v1[1]); w.w = cvt_pk_bf16(v1[2], v1[3]);
                    *(u32x4*)dst = w; } }
    }
};
struct EpiH {
    static constexpr bool PERM = false, AFTER_DRAIN = false;
    const float* xp; const float* xs; float* H; bf16_t* HB; float* SS;
    __device__ __forceinline__ void operator()(const f32x4 (&acc)[2][2][4][2], const Unit& u, int wr, int wc, int fr, int fq) const {
        const int row0 = u.pm * BM + wr * 64 + fr, col0 = u.pn * BM + wc * 32 + 4 * fq;
#pragma unroll
        for (int ai = 0; ai < 2; ++ai)
#pragma unroll
            for (int m = 0; m < 4; ++m) { const int row = row0 + ai * HALF + m * 16;
                const float* xr = (row < E_MP ? xp + (size_t)row * 1024 : xs + (size_t)(row - E_MP) * 1024) + col0; float* hr = H + (size_t)row * 1024 + col0; bf16_t* hb = HB + (size_t)row * 1024 + col0;
                float ss = 0.f;
#pragma unroll
                for (int bj = 0; bj < 2; ++bj)
#pragma unroll
                    for (int n = 0; n < 2; ++n) { const f32x4 h = *(const f32x4*)(xr + bj * HALF + n * 16) + acc[ai][bj][m][n]; *(f32x4*)(hr + bj * HALF + n * 16) = h;
                        ss += (h[0] * h[0] + h[1] * h[1]) + (h[2] * h[2] + h[3] * h[3]);
                        unsigned w0 = cvt_pk_bf16(h[0], h[1]), w1 = cvt_pk_bf16(h[2], h[3]); typedef unsigned u32x2v __attribute__((ext_vector_type(2))); *(u32x2v*)(hb + bj * HALF + n * 16) = (u32x2v){w0, w1}; }
                ss += __shfl_xor(ss, 16); ss += __shfl_xor(ss, 32);
                if (fq == 0) atomicAdd(SS + row, ss); }
    }
};
struct EpiAct {
    static constexpr bool PERM = true, AFTER_DRAIN = false;
    bf16_t* O; int ldc; const float* SS;
    __device__ __forceinline__ void operator()(const f32x4 (&acc)[2][2][4][2], const Unit& u, int wr, int wc, int fr, int fq) const {
        const int row0 = u.pm * BM + wr * 64 + fr, c0 = u.pn * BM + wc * 32 + 8 * fq;
#pragma unroll
        for (int ai = 0; ai < 2; ++ai)
#pragma unroll
            for (int m = 0; m < 4; ++m) { const int row = row0 + ai * HALF + m * 16; bf16_t* rowp = O + (size_t)row * ldc + c0;
                const float rs = rsqrtf(SS[row] * (1.0f / 1024.0f) + 1e-6f);
#pragma unroll
                for (int bj = 0; bj < 2; ++bj) { f32x4 v0 = acc[ai][bj][m][0], v1 = acc[ai][bj][m][1];
#pragma unroll
                    for (int e = 0; e < 4; ++e) { const float a = fmaxf(v0[e], 0.f) * rs, b = fmaxf(v1[e], 0.f) * rs; v0[e] = a * a; v1[e] = b * b; }
                    u32x4 w; w.x = cvt_pk_bf16(v0[0], v0[1]); w.y = cvt_pk_bf16(v0[2], v0[3]); w.z = cvt_pk_bf16(v1[0], v1[1]); w.w = cvt_pk_bf16(v1[2], v1[3]);
                    *(u32x4*)(rowp + bj * HALF) = w; } }
    }
};
struct EpiSlab {
    static constexpr bool PERM = false, AFTER_DRAIN = false;
    float* S;
    __device__ __forceinline__ void operator()(const f32x4 (&acc)[2][2][4][2], const Unit& u, int wr, int wc, int fr, int fq) const {
        const int row0 = u.pm * BM - E_MP + wr * 64 + fr, col0 = u.pn * BM + wc * 32 + 4 * fq;
#pragma unroll
        for (int ai = 0; ai < 2; ++ai)
#pragma unroll
            for (int m = 0; m < 4; ++m) { float* yr = S + (size_t)(row0 + ai * HALF + m * 16) * 1024 + col0;
#pragma unroll
                for (int bj = 0; bj < 2; ++bj)
#pragma unroll
                    for (int n = 0; n < 2; ++n) *(f32x4*)(yr + bj * HALF + n * 16) = acc[ai][bj][m][n]; }
    }
};
struct EpiY {
    static constexpr bool PERM = false, AFTER_DRAIN = false;
    float* Y;
    __device__ __forceinline__ void operator()(const f32x4 (&acc)[2][2][4][2], const Unit& u, int wr, int wc, int fr, int fq) const {
        const int row0 = u.pm * BM + wr * 64 + fr, col0 = u.pn * BM + wc * 32 + 4 * fq;
#pragma unroll
        for (int ai = 0; ai < 2; ++ai)
#pragma unroll
            for (int m = 0; m < 4; ++m) { float* yr = Y + (size_t)(row0 + ai * HALF + m * 16) * 1024 + col0;
#pragma unroll
                for (int bj = 0; bj < 2; ++bj)
#pragma unroll
                    for (int n = 0; n < 2; ++n) { f32x4* p = (f32x4*)(yr + bj * HALF + n * 16); *p = *p + acc[ai][bj][m][n]; } }
    }
};

template <class Epi, class Sched, bool ALIGN_EPI = false, bool SP2 = false>
__device__ __forceinline__ void gemm_phase(PG8_LAS unsigned char* lds, const Gemm g, const Sched& S, const Epi& E) {
    const int tid = threadIdx.x, wid = __builtin_amdgcn_readfirstlane(tid >> 6), lane = tid & 63, wr = wid >> 2, wc = wid & 3, fr = lane & 15, fq = lane >> 4;
    const int K = g.K, nt = g.KL / BK;
    unsigned voffA[2], voffB[2];
#pragma unroll
    for (int i = 0; i < 2; ++i) { int R, C; stage_rc(tid * 16 + i * 8192, R, C); const int Rb = Epi::PERM ? ((R & ~31) + perm32(R & 31)) : R;
        voffA[i] = (unsigned)(R * K + C) * 2u; voffB[i] = (unsigned)(Rb * K + C) * 2u; }
    const size_t kstep = (size_t)(BK * 2);
    const size_t hstep = (size_t)HALF * K * 2;
    const size_t tstep = 2 * hstep;
    const unsigned ldsw = (unsigned)wid * 1024u;
    const int aoff = lds_byte(wr * 64 + fr, fq * 8), boff = lds_byte(wc * 32 + fr, fq * 8);
#define PG8_SA(b, h) (((b) * 2 + (h)) * HTB)
#define PG8_SB(b, h) ((4 + (b) * 2 + (h)) * HTB)
#define PG8_STAGE(bufoff, gbase, voff) do { _Pragma("unroll") for (int _i = 0; _i < 2; ++_i) \
        __builtin_amdgcn_global_load_lds((const unsigned*)((const char*)(gbase) + (voff)[_i]), (PG8_LAS unsigned*)(lds + (bufoff) + ldsw + _i * 8192), 16, 0, 0); } while (0)
#define PG8_LDA(dst, b, h) do { _Pragma("unroll") for (int m = 0; m < 4; ++m) _Pragma("unroll") for (int k = 0; k < 2; ++k) dst[m][k] = *(const PG8_LAS bf16x8*)(lds + PG8_SA(b, h) + aoff + m * 2048 + k * 1024); } while (0)
#define PG8_LDB(dst, b, h) do { _Pragma("unroll") for (int n = 0; n < 2; ++n) _Pragma("unroll") for (int k = 0; k < 2; ++k) dst[n][k] = *(const PG8_LAS bf16x8*)(lds + PG8_SB(b, h) + boff + n * 2048 + k * 1024); } while (0)
#define PG8_MMA(ai, bj, At, Bt) do { __builtin_amdgcn_s_setprio(1); _Pragma("unroll") for (int m = 0; m < 4; ++m) _Pragma("unroll") for (int n = 0; n < 2; ++n) _Pragma("unroll") for (int k = 0; k < 2; ++k) \
        acc[ai][bj][m][n] = __builtin_amdgcn_mfma_f32_16x16x32_bf16(Bt[n][k], At[m][k], acc[ai][bj][m][n], 0, 0, 0); __builtin_amdgcn_s_setprio(0); } while (0)
#define PG8_WAIT_V(n) asm volatile("s_waitcnt vmcnt(" #n ")" ::: "memory")
#define PG8_WAIT_L(n) asm volatile("s_waitcnt lgkmcnt(" #n ")" ::: "memory")
#define PG8_BAR __builtin_amdgcn_s_barrier()
#define PG8_SCHED __builtin_amdgcn_sched_barrier(0)
    Unit cur, nxt; int ui = 0;
    if (!S.next(0, cur)) return;
    f32x4 acc[2][2][4][2];
#pragma unroll
    for (int a = 0; a < 2; ++a)
#pragma unroll
        for (int b = 0; b < 2; ++b)
#pragma unroll
            for (int m = 0; m < 4; ++m)
#pragma unroll
                for (int n = 0; n < 2; ++n) acc[a][b][m][n] = (f32x4){0.f, 0.f, 0.f, 0.f};
    bf16x8 At[4][2], B0[2][2], B1[2][2];
    const char* cA = (const char*)g.A + (size_t)cur.pm * tstep; const char* cB = (const char*)g.Bt + (size_t)cur.pn * tstep;
    S.a_ready(cur);
    if constexpr (SP2) {
        PG8_STAGE(PG8_SB(0, 0), cB, voffB); PG8_STAGE(PG8_SB(0, 1), cB + hstep, voffB); PG8_STAGE(PG8_SA(0, 0), cA, voffA); PG8_STAGE(PG8_SA(0, 1), cA + hstep, voffA);
        if (wr == 1) PG8_BAR;
        PG8_WAIT_V(2); PG8_BAR;
        PG8_STAGE(PG8_SB(1, 0), cB + kstep, voffB); PG8_STAGE(PG8_SA(1, 0), cA + kstep, voffA); PG8_STAGE(PG8_SB(1, 1), cB + hstep + kstep, voffB);
        PG8_WAIT_V(6); PG8_BAR;
    } else {
        PG8_STAGE(PG8_SB(0, 0), cB, voffB); PG8_STAGE(PG8_SA(0, 0), cA, voffA); PG8_STAGE(PG8_SB(0, 1), cB + hstep, voffB); PG8_STAGE(PG8_SA(0, 1), cA + hstep, voffA);
        if (wr == 1) PG8_BAR;
        PG8_WAIT_V(4); PG8_BAR;
        PG8_STAGE(PG8_SB(1, 0), cB + kstep, voffB); PG8_STAGE(PG8_SA(1, 0), cA + kstep, voffA); PG8_STAGE(PG8_SB(1, 1), cB + hstep + kstep, voffB);
        PG8_WAIT_V(6); PG8_BAR;
    }
    for (;;) {
        const bool has_next = S.next(ui + 1, nxt);
        const char* nA = has_next ? (const char*)g.A + (size_t)nxt.pm * tstep : cA; const char* nB = has_next ? (const char*)g.Bt + (size_t)nxt.pn * tstep : cB;
        for (int t = 0; t < nt; t += 2) {
            const bool last = (t == nt - 2);
            const char* a1 = cA + (size_t)(t + 1) * kstep;
            const char* a2 = last ? nA : cA + (size_t)(t + 2) * kstep; const char* b2 = last ? nB : cB + (size_t)(t + 2) * kstep;
            const char* a3 = a2 + kstep; const char* b3 = b2 + kstep;
            if (last && has_next) S.a_ready(nxt);
            if constexpr (SP2) {
            PG8_LDB(B0, 0, 0); PG8_LDB(B1, 0, 1); PG8_SCHED; PG8_LDA(At, 0, 0); PG8_STAGE(PG8_SA(1, 1), a1 + hstep, voffA);
            PG8_WAIT_V(8); PG8_WAIT_L(0); PG8_BAR; PG8_MMA(0, 0, At, B0); PG8_MMA(0, 1, At, B1); PG8_BAR; PG8_SCHED;
            PG8_LDA(At, 0, 1); PG8_STAGE(PG8_SB(0, 0), b2, voffB); PG8_STAGE(PG8_SB(0, 1), b2 + hstep, voffB); PG8_STAGE(PG8_SA(0, 0), a2, voffA);
            PG8_WAIT_V(8); PG8_WAIT_L(0); PG8_BAR; PG8_MMA(1, 0, At, B0); PG8_MMA(1, 1, At, B1); PG8_BAR; PG8_SCHED;
            PG8_LDB(B0, 1, 0); PG8_LDB(B1, 1, 1); PG8_SCHED; PG8_LDA(At, 1, 0); PG8_STAGE(PG8_SA(0, 1), a2 + hstep, voffA);
            PG8_WAIT_V(8); PG8_WAIT_L(0); PG8_BAR; PG8_MMA(0, 0, At, B0); PG8_MMA(0, 1, At, B1); PG8_BAR; PG8_SCHED;
            PG8_LDA(At, 1, 1); PG8_STAGE(PG8_SB(1, 0), b3, voffB); PG8_STAGE(PG8_SB(1, 1), b3 + hstep, voffB); PG8_STAGE(PG8_SA(1, 0), a3, voffA);
            PG8_WAIT_V(8); PG8_WAIT_L(0); PG8_BAR; PG8_MMA(1, 0, At, B0); PG8_MMA(1, 1, At, B1); PG8_BAR; PG8_SCHED;
            } else {
            PG8_LDB(B0, 0, 0); PG8_SCHED; PG8_LDA(At, 0, 0); PG8_STAGE(PG8_SA(1, 1), a1 + hstep, voffA);
            PG8_WAIT_L(8); PG8_BAR; PG8_WAIT_L(0); PG8_MMA(0, 0, At, B0); PG8_BAR; PG8_SCHED;
            PG8_LDB(B1, 0, 1); PG8_STAGE(PG8_SB(0, 0), b2, voffB);
            PG8_BAR; PG8_WAIT_L(0); PG8_MMA(0, 1, At, B1); PG8_BAR;
            PG8_LDA(At, 0, 1); PG8_STAGE(PG8_SA(0, 0), a2, voffA);
            PG8_BAR; PG8_WAIT_L(0); PG8_MMA(1, 0, At, B0); PG8_BAR; PG8_SCHED;
            PG8_STAGE(PG8_SB(0, 1), b2 + hstep, voffB);
            PG8_WAIT_V(6); PG8_BAR; PG8_MMA(1, 1, At, B1); PG8_BAR;
            PG8_LDB(B0, 1, 0); PG8_SCHED; PG8_LDA(At, 1, 0); PG8_STAGE(PG8_SA(0, 1), a2 + hstep, voffA);
            PG8_WAIT_L(8); PG8_BAR; PG8_WAIT_L(0); PG8_MMA(0, 0, At, B0); PG8_BAR; PG8_SCHED;
            PG8_LDB(B1, 1, 1); PG8_STAGE(PG8_SB(1, 0), b3, voffB);
            PG8_BAR; PG8_WAIT_L(0); PG8_MMA(0, 1, At, B1); PG8_BAR;
            PG8_LDA(At, 1, 1); PG8_STAGE(PG8_SA(1, 0), a3, voffA);
            PG8_BAR; PG8_WAIT_L(0); PG8_MMA(1, 0, At, B0); PG8_BAR; PG8_SCHED;
            PG8_STAGE(PG8_SB(1, 1), b3 + hstep, voffB);
            PG8_WAIT_V(6); PG8_BAR; PG8_MMA(1, 1, At, B1); PG8_BAR;
            }
        }
        if constexpr (ALIGN_EPI) { if (wr == 0) PG8_BAR; }
        if constexpr (!Epi::AFTER_DRAIN) { E(acc, cur, wr, wc, fr, fq); S.done(cur); }
        if (!has_next) break;
#pragma unroll
        for (int a = 0; a < 2; ++a)
#pragma unroll
            for (int b = 0; b < 2; ++b)
#pragma unroll
                for (int m = 0; m < 4; ++m)
#pragma unroll
                    for (int n = 0; n < 2; ++n) acc[a][b][m][n] = (f32x4){0.f, 0.f, 0.f, 0.f};
        cur = nxt; cA = nA; cB = nB; ++ui;
        if constexpr (ALIGN_EPI) { if (wr == 1) PG8_BAR; }
    }
    PG8_WAIT_V(0);
    if constexpr (!ALIGN_EPI) { if (wr == 0) PG8_BAR; }
    PG8_BAR;
    if constexpr (Epi::AFTER_DRAIN) { E.fused(acc, cur, wr, wc, fr, fq, lds, wid, lane); S.done(cur); }
#undef PG8_SA
#undef PG8_SB
#undef PG8_STAGE
#undef PG8_LDA
#undef PG8_LDB
#undef PG8_MMA
#undef PG8_WAIT_V
#undef PG8_WAIT_L
#undef PG8_BAR
#undef PG8_SCHED
}
}


constexpr int DM = 1024, NB_P = 8, T_P = 2048, NB_S = 32, T_S = 32, PAST = 1024;
constexpr int MP = NB_P * T_P, MS = NB_S * T_S, MT = MP + MS;
constexpr int LS = PAST + T_S;
constexpr int SHIFTW = 1696, NZ = 3328, ZRW = 1632, DFF = 4096;
constexpr float QSCALE = 0.125f * 1.4426950408889634f;
constexpr float WISCALE = 0.35355339059327373f * 0.125f;
constexpr size_t OFF_Y = 0, OFF_KP = 17825792, OFF_VP = OFF_KP + 4194304, OFF_KIP = OFF_VP + 4194304, OFF_WKVP = OFF_KIP + 1048576, OFF_SHP = OFF_WKVP + 262144,
                 OFF_KS = OFF_SHP + 13568, OFF_VS = OFF_KS + 262144, OFF_KIS = OFF_VS + 262144, OFF_WKVS = OFF_KIS + 65536, OFF_SHS = OFF_WKVS + 1048576, OUT_TOTAL = OFF_SHS + 54272;
constexpr size_t MiB = 1u << 20;
constexpr size_t WS_CTL = 0, CTL_BYTES = 1 * MiB;
constexpr size_t WS_WIN = 1 * MiB, WS_WOUT = 8 * MiB, WS_W1 = 10 * MiB, WS_W2 = 18 * MiB;
constexpr size_t WS_W2T = 26 * MiB, WS_A2T = WS_W2T + 32768, WS_G2T = WS_A2T + 32768, WS_WI = 27 * MiB, WS_BONUS = 28 * MiB;
constexpr size_t WS_XB = 30 * MiB;
constexpr size_t WS_ZS = 66 * MiB;
constexpr size_t WS_R = 123 * MiB;
constexpr size_t WS_ZR = WS_R, WS_KBP = 178 * MiB, WS_VTP = 186 * MiB, WS_KIP = 194 * MiB, WS_KBS = 196 * MiB, WS_VTS = 213 * MiB, WS_KIS = 230 * MiB;
constexpr size_t WS_OW = WS_R, WS_OKK = 157 * MiB, WS_OB = 174 * MiB, WS_OKM = 191 * MiB, WS_OR = 208 * MiB, WS_OV = 225 * MiB;
constexpr size_t WS_ACT = 66 * MiB, WS_HB = 202 * MiB, WS_END = 256 * MiB;
static_assert(WS_ZS + (size_t)MT * SHIFTW * 2 <= WS_R && WS_ZR + (size_t)MT * ZRW * 2 <= WS_KBP && WS_KBS + (size_t)NB_S * LS * 256 * 2 <= WS_VTS && WS_VTS + (size_t)NB_S * 256 * LS * 2 <= WS_KIS &&
              WS_KIS + (size_t)NB_S * LS * 64 * 2 <= WS_END && WS_OV + (size_t)MT * 512 * 2 <= WS_END && WS_ACT + (size_t)MT * DFF * 2 <= WS_HB && WS_HB + (size_t)MT * DM * 2 <= WS_END, "d_ws map");
constexpr size_t SC_Q = 0, SC_QI = (size_t)MT * 512 / 2, SC_Y = 0, SC_G = (size_t)MT * 512;
constexpr int CW_QATT = 64, CW_SS = 16384;

typedef unsigned short bf16;
typedef short bf16x8 __attribute__((ext_vector_type(8)));
typedef float f32x4 __attribute__((ext_vector_type(4)));
typedef float f32x16 __attribute__((ext_vector_type(16)));
typedef unsigned u32x4 __attribute__((ext_vector_type(4)));
typedef unsigned u32x2 __attribute__((ext_vector_type(2)));

__device__ __forceinline__ unsigned f2bf(float f) { unsigned u = __float_as_uint(f); return (u + 0x7fffu + ((u >> 16) & 1u)) >> 16; }
__device__ __forceinline__ unsigned pk2(float lo, float hi) { return f2bf(lo) | (f2bf(hi) << 16); }
__device__ __forceinline__ float bflo(unsigned w) { return __uint_as_float(w << 16); }
__device__ __forceinline__ float bfhi(unsigned w) { return __uint_as_float(w & 0xffff0000u); }
__device__ __forceinline__ float bf1(bf16 b) { return __uint_as_float((unsigned)b << 16); }
__device__ __forceinline__ void unpack8(const u32x4 w, float* x) { x[0] = bflo(w.x); x[1] = bfhi(w.x); x[2] = bflo(w.y); x[3] = bfhi(w.y); x[4] = bflo(w.z); x[5] = bfhi(w.z); x[6] = bflo(w.w); x[7] = bfhi(w.w); }
__device__ __forceinline__ u32x4 pack8(const float* x) { u32x4 w; w.x = pk2(x[0], x[1]); w.y = pk2(x[2], x[3]); w.z = pk2(x[4], x[5]); w.w = pk2(x[6], x[7]); return w; }
__device__ __forceinline__ float wave_sum(float v) {
#pragma unroll
    for (int o = 1; o < 64; o <<= 1) v += __shfl_xor(v, o);
    return v;
}
template <int CTRL> __device__ __forceinline__ float dppmov(float x) { return __builtin_bit_cast(float, __builtin_amdgcn_update_dpp(0, __builtin_bit_cast(int, x), CTRL, 0xf, 0xf, true)); }
__device__ __forceinline__ float sum16(float x) {
    x += dppmov<0xB1>(x); x += dppmov<0x4E>(x); x += dppmov<0x141>(x); x += dppmov<0x140>(x); return x;
}
__device__ __forceinline__ int crow(int r, int hi) { return (r & 3) + 8 * (r >> 2) + 4 * hi; }

struct Args { const float* in[28]; float* out; unsigned char* ws; int ph_lo, ph_hi; };

__device__ __forceinline__ void tr_item(const float* W, int K, int N, const float* gain, bf16* WT, int jr0, int c0, int nvalid, int k0, float* scr, int lane) {
#pragma unroll 8
    for (int i = 0; i < 32; ++i) { const int kk = 2 * i + (lane >> 5), n = lane & 31;
        float v = (n < nvalid) ? W[(size_t)(k0 + kk) * N + c0 + n] : 0.f; if (gain) v *= gain[k0 + kk]; scr[kk * 33 + n] = v; }
    __builtin_amdgcn_s_waitcnt(0xC07F); asm volatile("" ::: "memory");
    const int c = lane & 7;
#pragma unroll
    for (int j = 0; j < 4; ++j) { const int n = (lane >> 3) + 8 * j; const float* s = scr + (8 * c) * 33 + n;
        u32x4 o; o.x = pk2(s[0 * 33], s[1 * 33]); o.y = pk2(s[2 * 33], s[3 * 33]); o.z = pk2(s[4 * 33], s[5 * 33]); o.w = pk2(s[6 * 33], s[7 * 33]);
        *(u32x4*)(WT + (size_t)(jr0 + n) * K + k0 + 8 * c) = o; }
    __builtin_amdgcn_s_waitcnt(0xC07F); asm volatile("" ::: "memory");
}
__device__ __forceinline__ void p0_prologue(const Args& a, unsigned char* lds, int tid) {
    const int lane = tid & 63, wave = tid >> 6, gw = blockIdx.x * 8 + wave, NGW = gridDim.x * 8;
    float* scr = (float*)(lds + wave * 17408);
    unsigned char* ws = a.ws;
    constexpr int I_IN = (NZ / 32) * (DM / 64), I_OUT = (DM / 32) * (DM / 64), I_F1 = (DFF / 32) * (DM / 64), I_F2 = (DM / 32) * (DFF / 64);
    for (int it = gw; it < I_IN + I_OUT + I_F1 + I_F2; it += NGW) {
        int r = it;
        if (r < I_IN) { const int jb = r % (NZ / 32), kb = r / (NZ / 32), j0 = jb * 32; int c0, nv;
            if (j0 < 1600) { c0 = j0; nv = 32; } else if (j0 < 3296) { c0 = 1608 + (j0 - 1600); nv = 32; } else { c0 = 1600; nv = 8; }
            tr_item(a.in[8], DM, 3304, a.in[7], (bf16*)(ws + WS_WIN), j0, c0, nv, kb * 64, scr, lane); continue; }
        r -= I_IN;
        if (r < I_OUT) { const int jb = r % (DM / 32), kb = r / (DM / 32); tr_item(a.in[24], DM, DM, nullptr, (bf16*)(ws + WS_WOUT), jb * 32, jb * 32, 32, kb * 64, scr, lane); continue; }
        r -= I_OUT;
        if (r < I_F1) { const int jb = r % (DFF / 32), kb = r / (DFF / 32); tr_item(a.in[26], DM, DFF, a.in[25], (bf16*)(ws + WS_W1), jb * 32, jb * 32, 32, kb * 64, scr, lane); continue; }
        r -= I_F1;
        { const int jb = r % (DM / 32), kb = r / (DM / 32); tr_item(a.in[27], DFF, DM, nullptr, (bf16*)(ws + WS_W2), jb * 32, jb * 32, 32, kb * 64, scr, lane); }
    }
    { const int gt = blockIdx.x * 512 + tid, NT = gridDim.x * 512;
      bf16* w2t = (bf16*)(ws + WS_W2T); bf16* a2t = (bf16*)(ws + WS_A2T); bf16* g2t = (bf16*)(ws + WS_G2T);
      for (int i = gt; i < 512 * 32; i += NT) { const int n = i >> 5, k = i & 31; w2t[i] = (bf16)f2bf(a.in[15][k * 512 + n]); a2t[i] = (bf16)f2bf(a.in[17][k * 512 + n]); }
      for (int i = gt; i < 512 * 96; i += NT) { const int n = i / 96, k = i % 96; g2t[i] = (bf16)f2bf(a.in[18][k * 512 + n]); } }
    { f32x4 v[4], nx[4]; int m = gw;
      if (m < MT) { const f32x4* xr = (const f32x4*)((m < MP) ? a.in[0] + (size_t)m * DM : a.in[1] + (size_t)(m - MP) * DM) + lane;
#pragma unroll
          for (int j = 0; j < 4; ++j) v[j] = xr[64 * j]; }
      for (; m < MT; m += NGW) {
        const int mn = m + NGW;
        if (mn < MT) { const f32x4* xr = (const f32x4*)((mn < MP) ? a.in[0] + (size_t)mn * DM : a.in[1] + (size_t)(mn - MP) * DM) + lane;
#pragma unroll
            for (int j = 0; j < 4; ++j) nx[j] = xr[64 * j]; }
        float s = 0.f;
#pragma unroll
        for (int j = 0; j < 4; ++j) s += (v[j].x * v[j].x + v[j].y * v[j].y) + (v[j].z * v[j].z + v[j].w * v[j].w);
        const float rs = rsqrtf(wave_sum(s) * (1.f / DM) + 1e-6f);
        u32x2* o8 = (u32x2*)((bf16*)(ws + WS_XB) + (size_t)m * DM) + lane;
#pragma unroll
        for (int j = 0; j < 4; ++j) { u32x2 o; o.x = pk2(v[j].x * rs, v[j].y * rs); o.y = pk2(v[j].z * rs, v[j].w * rs); o8[64 * j] = o; }
#pragma unroll
        for (int j = 0; j < 4; ++j) v[j] = nx[j];
      } }
    for (int r4 = gw; r4 < NB_S * PAST / 4; r4 += NGW) {
        f32x4 v[4];
#pragma unroll
        for (int j = 0; j < 4; ++j) v[j] = ((const f32x4*)(a.in[2] + (size_t)(4 * r4 + j) * 256))[lane];
#pragma unroll
        for (int j = 0; j < 4; ++j) { const int rix = 4 * r4 + j, b = rix >> 10, p = rix & 1023; u32x2 o; o.x = pk2(v[j].x, v[j].y); o.y = pk2(v[j].z, v[j].w);
            ((u32x2*)((bf16*)(ws + WS_KBS) + ((size_t)b * LS + p) * 256))[lane] = o; }
    }
    for (int r4 = gw; r4 < NB_S * PAST / 4; r4 += NGW) {
        const int rix = r4 * 4 + (lane >> 4), b = rix >> 10, p = rix & 1023; const f32x4 v = ((const f32x4*)(a.in[4] + (size_t)rix * 64))[lane & 15];
        u32x2 o; o.x = pk2(v.x, v.y); o.y = pk2(v.z, v.w); ((u32x2*)((bf16*)(ws + WS_KIS) + ((size_t)b * LS + p) * 64))[lane & 15] = o;
    }
    for (int it = gw; it < NB_S * 4 * 16; it += NGW) {
        const int kb = it & 15, g = (it >> 4) & 3, b = it >> 6;
        const float* src = a.in[3] + ((size_t)b * PAST + kb * 64) * 256 + g * 64;
#pragma unroll 8
        for (int i = 0; i < 64; ++i) scr[i * 65 + lane] = src[(size_t)i * 256 + lane];
        __builtin_amdgcn_s_waitcnt(0xC07F); asm volatile("" ::: "memory");
        bf16* dst = (bf16*)(ws + WS_VTS) + ((size_t)(b * 4 + g) * 64) * LS + kb * 64 + lane;
#pragma unroll 8
        for (int d = 0; d < 64; ++d) dst[(size_t)d * LS] = (bf16)f2bf(scr[lane * 65 + d]);
        __builtin_amdgcn_s_waitcnt(0xC07F); asm volatile("" ::: "memory");
    }
}

__device__ __forceinline__ void p2_post(const Args& a, unsigned char* lds, int tid) {
    unsigned char* ws = a.ws; float* out = a.out;
    const bf16* ZR = (const bf16*)(ws + WS_ZR); const bf16* ZS = (const bf16*)(ws + WS_ZS);
    bf16* Q = (bf16*)(out + SC_Q); bf16* QI = (bf16*)(out + SC_QI);
    float* cs = (float*)lds;
    bf16* vt = (bf16*)(lds + 4096);
    const int g8 = tid >> 3, sub = tid & 7;
    const float* qg = a.in[9]; const float* kg = a.in[10]; const float* lng = a.in[11]; const float* lnb = a.in[12];
    for (int tile = blockIdx.x; tile < MT / 64; tile += gridDim.x) {
        const int m0 = tile * 64;
        { const int m = m0 + g8, pos = (m < MP) ? (m & (T_P - 1)) : (PAST + ((m - MP) & (T_S - 1)));
          const float inv = powf(500000.0f, -(float)sub * 0.125f); const float ang = (float)pos * inv; float s, c; sincosf(ang, &s, &c);
          cs[g8 * 16 + sub] = c; cs[g8 * 16 + 8 + sub] = s; }
        __syncthreads();
        const int m = m0 + g8;
        const bool isp = m < MP; const int ms = m - MP;
        float cc[8], ss[8];
#pragma unroll
        for (int j = 0; j < 8; ++j) { cc[j] = cs[g8 * 16 + j]; ss[j] = cs[g8 * 16 + 8 + j]; }
        const size_t kvrow = isp ? (size_t)m : ((size_t)(ms >> 5) * LS + PAST + (ms & 31));
        bf16* KB = (bf16*)(ws + (isp ? WS_KBP : WS_KBS)); bf16* KIb = (bf16*)(ws + (isp ? WS_KIP : WS_KIS));
        u32x4 xnext = *(const u32x4*)(ZR + (size_t)m * ZRW + 8 * sub);
        for (int hb = 0; hb < 25; ++hb) {
            float x[8]; unpack8(xnext, x);
            if (hb + 1 < 25) xnext = *(const u32x4*)(ZR + (size_t)m * ZRW + (hb + 1) * 64 + 8 * sub);
            if (hb < 12) {
                float s2 = 0.f;
#pragma unroll
                for (int j = 0; j < 8; ++j) s2 += x[j] * x[j];
                s2 += __shfl_xor(s2, 1); s2 += __shfl_xor(s2, 2); s2 += __shfl_xor(s2, 4);
                const float rinv = rsqrtf(s2 * (1.f / 64.f) + 1e-6f); const float* gn = (hb < 8 ? qg : kg) + 8 * sub;
                float y[8], o[8];
#pragma unroll
                for (int j = 0; j < 8; ++j) y[j] = x[j] * rinv * gn[j];
#pragma unroll
                for (int j = 0; j < 8; ++j) { const float p = __shfl_xor(y[j], 1); o[j] = sub == 0 ? y[j] * cc[j] - p * ss[j] : (sub == 1 ? y[j] * cc[j] + p * ss[j] : y[j]); }
                if (hb < 8) {
#pragma unroll
                    for (int j = 0; j < 8; ++j) o[j] *= QSCALE;
                    *(u32x4*)(Q + (size_t)m * 512 + hb * 64 + 8 * sub) = pack8(o);
                } else { const int g = hb - 8;
                    float* ko = out + (isp ? OFF_KP + (size_t)m * 256 : OFF_KS + (size_t)ms * 256) + g * 64 + 8 * sub;
                    *(f32x4*)ko = (f32x4){o[0], o[1], o[2], o[3]}; *(f32x4*)(ko + 4) = (f32x4){o[4], o[5], o[6], o[7]};
                    *(u32x4*)(KB + kvrow * 256 + g * 64 + 8 * sub) = pack8(o); }
            } else if (hb < 16) { const int g = hb - 12;
                float* vo = out + (isp ? OFF_VP + (size_t)m * 256 : OFF_VS + (size_t)ms * 256) + g * 64 + 8 * sub;
                *(f32x4*)vo = (f32x4){x[0], x[1], x[2], x[3]}; *(f32x4*)(vo + 4) = (f32x4){x[4], x[5], x[6], x[7]};
                unsigned* vd = (unsigned*)(vt + g8 * 258 + g * 64 + 8 * sub);
                vd[0] = pk2(x[0], x[1]); vd[1] = pk2(x[2], x[3]); vd[2] = pk2(x[4], x[5]); vd[3] = pk2(x[6], x[7]);
            } else if (hb < 24) {
                float o[8];
#pragma unroll
                for (int j = 0; j < 8; ++j) { const float p = __shfl_xor(x[j], 1); o[j] = sub == 0 ? x[j] * cc[j] - p * ss[j] : (sub == 1 ? x[j] * cc[j] + p * ss[j] : x[j]); }
                *(u32x4*)(QI + (size_t)m * 512 + (hb - 16) * 64 + 8 * sub) = pack8(o);
            } else {
                float s1 = 0.f;
#pragma unroll
                for (int j = 0; j < 8; ++j) s1 += x[j];
                s1 += __shfl_xor(s1, 1); s1 += __shfl_xor(s1, 2); s1 += __shfl_xor(s1, 4);
                const float mu = s1 * (1.f / 64.f); float s2 = 0.f;
#pragma unroll
                for (int j = 0; j < 8; ++j) { const float d = x[j] - mu; s2 += d * d; }
                s2 += __shfl_xor(s2, 1); s2 += __shfl_xor(s2, 2); s2 += __shfl_xor(s2, 4);
                const float rinv = rsqrtf(s2 * (1.f / 64.f) + 1e-6f); float y[8], o[8];
#pragma unroll
                for (int j = 0; j < 8; ++j) y[j] = (x[j] - mu) * rinv * lng[8 * sub + j] + lnb[8 * sub + j];
#pragma unroll
                for (int j = 0; j < 8; ++j) { const float p = __shfl_xor(y[j], 1); o[j] = sub == 0 ? y[j] * cc[j] - p * ss[j] : (sub == 1 ? y[j] * cc[j] + p * ss[j] : y[j]); }
                float* ko = out + (isp ? OFF_KIP + (size_t)m * 64 : OFF_KIS + (size_t)ms * 64) + 8 * sub;
                *(f32x4*)ko = (f32x4){o[0], o[1], o[2], o[3]}; *(f32x4*)(ko + 4) = (f32x4){o[4], o[5], o[6], o[7]};
                *(u32x4*)(KIb + kvrow * 64 + 8 * sub) = pack8(o);
            }
        }
        ((float*)(ws + WS_WI))[(size_t)m * 8 + sub] = bf1(ZR[(size_t)m * ZRW + 1600 + sub]) * WISCALE;
        __syncthreads();
        { const int r = tid >> 1, half = tid & 1; unsigned wv[16];
#pragma unroll
          for (int j = 0; j < 16; ++j) wv[j] = (unsigned)vt[(32 * half + 2 * j) * 258 + r] | ((unsigned)vt[(32 * half + 2 * j + 1) * 258 + r] << 16);
          bf16* dst;
          if (m0 < MP) dst = (bf16*)(ws + WS_VTP) + ((size_t)(m0 >> 11) * 256 + r) * T_P + (m0 & (T_P - 1)) + 32 * half;
          else { const int b = ((m0 - MP) >> 5) + half; dst = (bf16*)(ws + WS_VTS) + ((size_t)b * 256 + r) * LS + PAST; }
#pragma unroll
          for (int j = 0; j < 4; ++j) ((u32x4*)dst)[j] = (u32x4){wv[4 * j], wv[4 * j + 1], wv[4 * j + 2], wv[4 * j + 3]}; }
        if (m0 < MP) { if ((m0 & (T_P - 1)) == T_P - 64) { const int b = m0 >> 11; const bf16* zr = ZS + (size_t)(m0 + 63) * SHIFTW;
                for (int c = tid; c < SHIFTW; c += 512) out[OFF_SHP + (size_t)b * SHIFTW + c] = bf1(zr[c]); } }
        else { for (int h2 = 0; h2 < 2; ++h2) { const int b = ((m0 - MP) >> 5) + h2; const bf16* zr = ZS + (size_t)(m0 + 32 * h2 + 31) * SHIFTW;
                for (int c = tid; c < SHIFTW; c += 512) out[OFF_SHS + (size_t)b * SHIFTW + c] = bf1(zr[c]); } }
        __syncthreads();
    }
}

constexpr int ATT_UNITS = 544;
constexpr int MASK_PITCH = 65;
#define MFMA32(a, b, c) __builtin_amdgcn_mfma_f32_32x32x16_bf16((a), (b), (c), 0, 0, 0)

__device__ __forceinline__ float half_sum32(float v) { v += __shfl_xor(v, 1); v += __shfl_xor(v, 2); v += __shfl_xor(v, 4); v += __shfl_xor(v, 8); v += __shfl_xor(v, 16); return v; }
__device__ __forceinline__ float half_min32(float v) { v = fminf(v, __shfl_xor(v, 1)); v = fminf(v, __shfl_xor(v, 2)); v = fminf(v, __shfl_xor(v, 4)); v = fminf(v, __shfl_xor(v, 8)); v = fminf(v, __shfl_xor(v, 16)); return v; }
__device__ __forceinline__ float half_max32(float v) { v = fmaxf(v, __shfl_xor(v, 1)); v = fmaxf(v, __shfl_xor(v, 2)); v = fmaxf(v, __shfl_xor(v, 4)); v = fmaxf(v, __shfl_xor(v, 8)); v = fmaxf(v, __shfl_xor(v, 16)); return v; }
__device__ __forceinline__ int half_sum32i(int v) { v += __shfl_xor(v, 1); v += __shfl_xor(v, 2); v += __shfl_xor(v, 4); v += __shfl_xor(v, 8); v += __shfl_xor(v, 16); return v; }

#define LAS3 __attribute__((address_space(3)))
constexpr int A_RING1 = 0, A_SCL = 24576, A_RING2 = 24576, A_MASK = 0, A_LSUM = 8320, A_UNIT = 9344;
__device__ __forceinline__ void p3_attention(const Args& a, unsigned char* lds, int tid, int rep) {
    unsigned char* ws = a.ws; float* out = a.out;
    const bf16* Q = (const bf16*)(out + SC_Q); const bf16* QI = (const bf16*)(out + SC_QI); const float* WI = (const float*)(ws + WS_WI);
    bf16* O = (bf16*)(ws + WS_XB);
    unsigned* maskw = (unsigned*)(lds + A_MASK);
    float* lsum = (float*)(lds + A_LSUM);
    int* s_unit = (int*)(lds + A_UNIT);
    typedef float f32x2_t __attribute__((ext_vector_type(2)));
    f32x2_t* scl = (f32x2_t*)(lds + A_SCL) + (size_t)(tid >> 6) * 2048 + (tid & 63);
    unsigned* qctr = (unsigned*)(ws + WS_CTL) + CW_QATT + 64 * rep;
    const int l = tid & 63, w = __builtin_amdgcn_readfirstlane(tid >> 6), rho = l & 31, hi = l >> 5;
    LAS3 unsigned char* ldsb = (LAS3 unsigned char*)lds;
    for (;;) {
        if (tid == 0) *s_unit = (int)atomicAdd(qctr, 1u);
        __syncthreads();
        const int p = *s_unit;
        __syncthreads();
        if (p >= ATT_UNITS) break;
        int m0, nkt, vpitch; const bf16 *KB, *VT, *KI; bool need_idx;
        { int c = -1, b, half = 0;
          if (p < 256) { c = 31 - (p >> 4); b = (p & 15) >> 1; half = p & 1; }
          else if (p < 288) { b = p - 256; }
          else { const int pp = p - 288; c = 15 - (pp >> 4); b = (pp & 15) >> 1; half = pp & 1; }
          if (c >= 0) { m0 = b * T_P + 64 * c + 32 * half; nkt = 2 * (c + 1); vpitch = T_P; need_idx = c >= 4;
              KB = (const bf16*)(ws + WS_KBP) + (size_t)b * T_P * 256; VT = (const bf16*)(ws + WS_VTP) + (size_t)b * 256 * T_P; KI = (const bf16*)(ws + WS_KIP) + (size_t)b * T_P * 64; }
          else { m0 = MP + 32 * b; nkt = LS / 32; vpitch = LS; need_idx = true;
              KB = (const bf16*)(ws + WS_KBS) + (size_t)b * LS * 256; VT = (const bf16*)(ws + WS_VTS) + (size_t)b * 256 * LS; KI = (const bf16*)(ws + WS_KIS) + (size_t)b * LS * 64; } }
        if (need_idx) {
            const int tokA = 4 * w + 2 * ((rho >> 2) & 1) + (rho >> 4), headA = (rho & 3) + 4 * ((rho >> 3) & 1);
            bf16x8 qa[4];
#pragma unroll
            for (int ks = 0; ks < 4; ++ks) qa[ks] = *(const bf16x8*)(QI + (size_t)(m0 + tokA) * 512 + headA * 64 + 16 * ks + 8 * hi);
            float wv[16];
#pragma unroll
            for (int r = 0; r < 16; ++r) wv[r] = WI[(size_t)(m0 + 4 * w + 2 * hi + (r >> 3)) * 8 + (r & 7)];
            asm volatile("" :: "v"(qa[0]), "v"(qa[1]), "v"(qa[2]), "v"(qa[3]));
#pragma unroll
            for (int r = 0; r < 16; ++r) asm volatile("" :: "v"(wv[r]));
            asm volatile("s_waitcnt vmcnt(0)" ::: "memory");
            float sc0[32], sc1[32];
            const int nb = (nkt + 1) >> 1;
            const int sr = 8 * w + (l >> 3), scn = (l & 7) ^ ((sr >> 1) & 7);
            const unsigned char* ksrc = (const unsigned char*)KI + (size_t)sr * 128 + 16 * scn;
#define KI_STAGE(it_) __builtin_amdgcn_global_load_lds((const unsigned*)(ksrc + (size_t)(it_) * 8192), (LAS3 unsigned*)(ldsb + A_RING1 + ((it_) % 3) * 8192 + w * 1024), 16, 0, 0)
            for (int rp1 = 0; rp1 <= PROBE_A1; ++rp1) {
            if (rp1) __syncthreads();
            KI_STAGE(0); if (1 < nb) KI_STAGE(1);
#pragma unroll
            for (int it = 0; it < 32; ++it) {
                if (it < nb) {
                    if (it + 1 < nb) asm volatile("s_waitcnt vmcnt(1) lgkmcnt(0)\n\ts_barrier" ::: "memory"); else asm volatile("s_waitcnt vmcnt(0) lgkmcnt(0)\n\ts_barrier" ::: "memory");
                    if (it + 2 < nb) KI_STAGE(it + 2);
                    const unsigned char* tb = lds + A_RING1 + (it % 3) * 8192;
#pragma unroll
                    for (int k2 = 0; k2 < 2; ++k2) { const int kt = 2 * it + k2;
                        if (kt < nkt) {
                            const int r = 32 * k2 + rho; const unsigned char* rowp = tb + r * 128; const int sw = (r >> 1) & 7;
                            f32x16 acc = {0.f, 0.f, 0.f, 0.f, 0.f, 0.f, 0.f, 0.f, 0.f, 0.f, 0.f, 0.f, 0.f, 0.f, 0.f, 0.f};
#pragma unroll
                            for (int ks = 0; ks < 4; ++ks) acc = MFMA32(qa[ks], *(const bf16x8*)(rowp + 16 * ((2 * ks + hi) ^ sw)), acc);
                            float s0 = 0.f, s1 = 0.f;
#pragma unroll
                            for (int r2 = 0; r2 < 8; ++r2) { s0 += wv[r2] * fmaxf(acc[r2], 0.f); s1 += wv[8 + r2] * fmaxf(acc[8 + r2], 0.f); }
                            if (kt < 32) { sc0[kt & 31] = s0; sc1[kt & 31] = s1; } else scl[(kt - 32) * 64] = (f32x2_t){s0, s1};
                        } else if (kt < 32) { sc0[kt & 31] = -3.0e38f; sc1[kt & 31] = -3.0e38f; }
                    }
                } else { if (2 * it < 32) { sc0[(2 * it) & 31] = -3.0e38f; sc1[(2 * it) & 31] = -3.0e38f; sc0[(2 * it + 1) & 31] = -3.0e38f; sc1[(2 * it + 1) & 31] = -3.0e38f; } }
            }
            }
#undef KI_STAGE
            __syncthreads();
            float mn0 = 3.0e38f, mx0 = -3.0e38f, mn1 = 3.0e38f, mx1 = -3.0e38f; int cp0 = 0, cz0 = 0, cp1 = 0, cz1 = 0;
#pragma unroll
            for (int kt = 0; kt < 64; ++kt) if (kt < nkt) { float v0, v1; if (kt < 32) { v0 = sc0[kt & 31]; v1 = sc1[kt & 31]; } else { const f32x2_t t2 = scl[(kt - 32) * 64]; v0 = t2.x; v1 = t2.y; }
                mn0 = fminf(mn0, v0); mx0 = fmaxf(mx0, v0); mn1 = fminf(mn1, v1); mx1 = fmaxf(mx1, v1);
                cp0 += v0 > 0.f ? 1 : 0; cz0 += v0 == 0.f ? 1 : 0; cp1 += v1 > 0.f ? 1 : 0; cz1 += v1 == 0.f ? 1 : 0; }
            mn0 = half_min32(mn0); mx0 = half_max32(mx0); mn1 = half_min32(mn1); mx1 = half_max32(mx1);
            cp0 = half_sum32i(cp0); cz0 = half_sum32i(cz0); cp1 = half_sum32i(cp1); cz1 = half_sum32i(cz1);
            float lo0, hi0, lo1, hi1, thr0 = 0.f, thr1 = 0.f; int ch0, ch1, nt0 = 0, nt1 = 0; bool fin0, fin1;
            for (int rp2 = 0; rp2 <= PROBE_A2; ++rp2) {
            fin0 = false; fin1 = false; ch0 = 0; ch1 = 0;
            if (cp0 >= 256) { lo0 = 0.f; hi0 = mx0; if (cp0 == 256) { fin0 = true; thr0 = 0.f; nt0 = 0; } }
            else if (cp0 + cz0 >= 256) { lo0 = 0.f; hi0 = 0.f; fin0 = true; thr0 = 0.f; nt0 = 256 - cp0; }
            else { lo0 = mn0 - 1.0f; hi0 = 0.f; ch0 = cp0; }
            if (cp1 >= 256) { lo1 = 0.f; hi1 = mx1; if (cp1 == 256) { fin1 = true; thr1 = 0.f; nt1 = 0; } }
            else if (cp1 + cz1 >= 256) { lo1 = 0.f; hi1 = 0.f; fin1 = true; thr1 = 0.f; nt1 = 256 - cp1; }
            else { lo1 = mn1 - 1.0f; hi1 = 0.f; ch1 = cp1; }
            asm volatile("" : "+v"(lo0), "+v"(lo1));
            for (int iter = 0; iter < 64; ++iter) {
                const float mid0 = lo0 + 0.5f * (hi0 - lo0), mid1 = lo1 + 0.5f * (hi1 - lo1);
                int c0 = 0, c1 = 0;
#pragma unroll
                for (int g = 0; g < 4; ++g) if (8 * g < nkt) {
#pragma unroll
                    for (int k8 = 0; k8 < 8; ++k8) { c0 += sc0[8 * g + k8] > mid0 ? 1 : 0; c1 += sc1[8 * g + k8] > mid1 ? 1 : 0; } }
                for (int kt = 32; kt < nkt; kt += 8) {
                    f32x2_t t8[8];
#pragma unroll
                    for (int u = 0; u < 8; ++u) t8[u] = scl[(kt + u - 32) * 64];
#pragma unroll
                    for (int u = 0; u < 8; ++u) if (kt + u < nkt) { c0 += t8[u].x > mid0 ? 1 : 0; c1 += t8[u].y > mid1 ? 1 : 0; } }
                c0 = half_sum32i(c0); c1 = half_sum32i(c1);
                if (!fin0) { if (!(mid0 > lo0 && mid0 < hi0)) { fin0 = true; thr0 = hi0; nt0 = 256 - ch0; }
                             else if (c0 == 256) { fin0 = true; thr0 = mid0; nt0 = 0; } else if (c0 > 256) lo0 = mid0; else { hi0 = mid0; ch0 = c0; } }
                if (!fin1) { if (!(mid1 > lo1 && mid1 < hi1)) { fin1 = true; thr1 = hi1; nt1 = 256 - ch1; }
                             else if (c1 == 256) { fin1 = true; thr1 = mid1; nt1 = 0; } else if (c1 > 256) lo1 = mid1; else { hi1 = mid1; ch1 = c1; } }
                if (__all(fin0 && fin1)) break;
            }
            }
            const bool any_tie = __any(nt0 > 0 || nt1 > 0);
            int run0 = 0, run1 = 0; const unsigned below = (1u << rho) - 1u;
#pragma unroll
            for (int kt = 0; kt < 64; ++kt) if (kt < nkt) {
                float v0, v1; if (kt < 32) { v0 = sc0[kt & 31]; v1 = sc1[kt & 31]; } else { const f32x2_t t2 = scl[(kt - 32) * 64]; v0 = t2.x; v1 = t2.y; }
                bool p0 = v0 > thr0, p1 = v1 > thr1;
                if (any_tie) {
                    const bool e0 = nt0 > 0 && v0 == thr0, e1 = nt1 > 0 && v1 == thr1;
                    const unsigned long long be0 = __ballot(e0), be1 = __ballot(e1);
                    const unsigned h0 = (unsigned)(be0 >> (32 * hi)), h1 = (unsigned)(be1 >> (32 * hi));
                    p0 = p0 || (e0 && (run0 + __popc(h0 & below)) < nt0); p1 = p1 || (e1 && (run1 + __popc(h1 & below)) < nt1);
                    run0 += __popc(h0); run1 += __popc(h1);
                }
                const unsigned long long b0 = __ballot(p0), b1 = __ballot(p1);
                if (l == 0) { maskw[(4 * w + 0) * MASK_PITCH + kt] = (unsigned)b0; maskw[(4 * w + 1) * MASK_PITCH + kt] = (unsigned)b1; }
                if (l == 32) { maskw[(4 * w + 2) * MASK_PITCH + kt] = (unsigned)(b0 >> 32); maskw[(4 * w + 3) * MASK_PITCH + kt] = (unsigned)(b1 >> 32); }
            }
        }
        __syncthreads();
        {
            const int g = w >> 1;
            bf16x8 qb[4];
#pragma unroll
            for (int ks = 0; ks < 4; ++ks) qb[ks] = *(const bf16x8*)(Q + (size_t)(m0 + rho) * 512 + w * 64 + 16 * ks + 8 * hi);
            asm volatile("" :: "v"(qb[0]), "v"(qb[1]), "v"(qb[2]), "v"(qb[3]));
            asm volatile("s_waitcnt vmcnt(0)" ::: "memory");
            const unsigned char* ksrc[2]; const unsigned char* vsrc[2];
#pragma unroll
            for (int k = 0; k < 2; ++k) { const int i = (k * 8 + w) * 64 + l; const int r = i >> 5, c = i & 31; ksrc[k] = (const unsigned char*)KB + (size_t)r * 512 + 16 * (c ^ (r & 15));
                const int R = i >> 2, cv = i & 3; vsrc[k] = (const unsigned char*)VT + (size_t)R * vpitch * 2 + 16 * (cv ^ ((R >> 2) & 3)); }
#define KV_STAGE(t_) do { const int bo_ = A_RING2 + ((t_) % 3) * 32768 + w * 1024; \
            __builtin_amdgcn_global_load_lds((const unsigned*)(ksrc[0] + (size_t)(t_) * 16384), (LAS3 unsigned*)(ldsb + bo_), 16, 0, 0); \
            __builtin_amdgcn_global_load_lds((const unsigned*)(ksrc[1] + (size_t)(t_) * 16384), (LAS3 unsigned*)(ldsb + bo_ + 8192), 16, 0, 0); \
            __builtin_amdgcn_global_load_lds((const unsigned*)(vsrc[0] + (size_t)(t_) * 64), (LAS3 unsigned*)(ldsb + bo_ + 16384), 16, 0, 0); \
            __builtin_amdgcn_global_load_lds((const unsigned*)(vsrc[1] + (size_t)(t_) * 64), (LAS3 unsigned*)(ldsb + bo_ + 24576), 16, 0, 0); } while (0)
            f32x16 o0 = {0.f, 0.f, 0.f, 0.f, 0.f, 0.f, 0.f, 0.f, 0.f, 0.f, 0.f, 0.f, 0.f, 0.f, 0.f, 0.f}, o1 = o0; float psum = 0.f;
            const int ksw = rho & 15;
            const int vR0 = g * 64 + rho, vR1 = vR0 + 32; const int vs0 = (vR0 >> 2) & 3, vs1 = (vR1 >> 2) & 3;
            for (int rp3 = 0; rp3 <= PROBE_A3; ++rp3) {
            if (rp3) __syncthreads();
            KV_STAGE(0); if (1 < nkt) KV_STAGE(1);
            for (int kt = 0; kt < nkt; ++kt) {
                if (kt + 1 < nkt) asm volatile("s_waitcnt vmcnt(4) lgkmcnt(0)\n\ts_barrier" ::: "memory"); else asm volatile("s_waitcnt vmcnt(0) lgkmcnt(0)\n\ts_barrier" ::: "memory");
                if (kt + 2 < nkt) KV_STAGE(kt + 2);
                const unsigned char* kbuf = lds + A_RING2 + (kt % 3) * 32768; const unsigned char* vbuf = kbuf + 16384;
                f32x16 st = {0.f, 0.f, 0.f, 0.f, 0.f, 0.f, 0.f, 0.f, 0.f, 0.f, 0.f, 0.f, 0.f, 0.f, 0.f, 0.f};
#pragma unroll
                for (int ks = 0; ks < 4; ++ks) st = MFMA32(*(const bf16x8*)(kbuf + rho * 512 + 16 * ((g * 8 + 2 * ks + hi) ^ ksw)), qb[ks], st);
                unsigned word = need_idx ? maskw[rho * MASK_PITCH + kt] : 0xffffffffu; word >>= 4 * hi; float pr[16];
#pragma unroll
                for (int r = 0; r < 16; ++r) { const float e = __builtin_amdgcn_exp2f(st[r]); pr[r] = ((word >> ((r & 3) + 8 * (r >> 2))) & 1u) ? e : 0.f; psum += pr[r]; }
                union { u32x4 u; bf16x8 v; } pa0, pa1; pa0.u = (u32x4){pg8::cvt_pk_bf16(pr[0], pr[1]), pg8::cvt_pk_bf16(pr[2], pr[3]), pg8::cvt_pk_bf16(pr[4], pr[5]), pg8::cvt_pk_bf16(pr[6], pr[7])}; pa1.u = (u32x4){pg8::cvt_pk_bf16(pr[8], pr[9]), pg8::cvt_pk_bf16(pr[10], pr[11]), pg8::cvt_pk_bf16(pr[12], pr[13]), pg8::cvt_pk_bf16(pr[14], pr[15])};
                union { u32x4 u; bf16x8 v; } vf[2][2];
#pragma unroll
                for (int s2 = 0; s2 < 2; ++s2) { const unsigned char* r0 = vbuf + vR0 * 64 + 8 * hi; const unsigned char* r1 = vbuf + vR1 * 64 + 8 * hi;
                    const u32x2 a0 = *(const u32x2*)(r0 + 16 * ((2 * s2) ^ vs0)), a1 = *(const u32x2*)(r0 + 16 * ((2 * s2 + 1) ^ vs0)), b0 = *(const u32x2*)(r1 + 16 * ((2 * s2) ^ vs1)), b1 = *(const u32x2*)(r1 + 16 * ((2 * s2 + 1) ^ vs1));
                    vf[s2][0].u = (u32x4){a0.x, a0.y, a1.x, a1.y}; vf[s2][1].u = (u32x4){b0.x, b0.y, b1.x, b1.y}; }
                o0 = MFMA32(pa0.v, vf[0][0].v, o0); o0 = MFMA32(pa1.v, vf[1][0].v, o0); o1 = MFMA32(pa0.v, vf[0][1].v, o1); o1 = MFMA32(pa1.v, vf[1][1].v, o1);
            }
            }
#undef KV_STAGE
            psum += __shfl_xor(psum, 32);
            if (hi == 0) lsum[w * 32 + rho] = psum;
            __syncthreads();
#pragma unroll
            for (int r = 0; r < 16; ++r) { const int qr = crow(r, hi); const float inv = 1.0f / lsum[w * 32 + qr];
                bf16* op = O + (size_t)(m0 + qr) * DM + w * 64 + rho;
                op[0] = (bf16)f2bf(o0[r] * inv); op[32] = (bf16)f2bf(o1[r] * inv); }
        }
        __syncthreads();
    }
}

constexpr int XS_PITCH = 168;
__device__ __forceinline__ void p4_rwkv_prep(const Args& a, unsigned char* lds, int tid) {
    unsigned char* ws = a.ws; float* out = a.out;
    const bf16* ZS = (const bf16*)(ws + WS_ZS);
    const bf16* w2t = (const bf16*)(ws + WS_W2T); const bf16* a2t = (const bf16*)(ws + WS_A2T); const bf16* g2t = (const bf16*)(ws + WS_G2T);
    float* OW = (float*)(ws + WS_OW); bf16* OKK = (bf16*)(ws + WS_OKK); bf16* OB = (bf16*)(ws + WS_OB); bf16* OKM = (bf16*)(ws + WS_OKM); bf16* OR_ = (bf16*)(ws + WS_OR); bf16* OV = (bf16*)(ws + WS_OV);
    bf16* G = (bf16*)(out + SC_G); float* BON = (float*)(ws + WS_BONUS);
    const float* mu = a.in[13]; const float* w0 = a.in[14]; const float* a0 = a.in[16]; const float* k_k = a.in[19]; const float* k_a = a.in[20]; const float* r_k = a.in[21]; const float* sh0 = a.in[6];
    bf16* xs = (bf16*)lds;
    const int l = tid & 63, h = __builtin_amdgcn_readfirstlane(tid >> 6), rho = l & 31, hi = l >> 5;
    for (int tile = blockIdx.x; tile < MT / 32; tile += gridDim.x) {
        const int m0 = tile * 32; const bool smp = m0 >= MP;
        const bool tile_first = smp || (m0 & (T_P - 1)) == 0;
        { const int tk = tid >> 4, c0 = (tid & 15) * 10, m = m0 + tk; const bool first = tile_first && tk == 0;
          const bf16* zc = ZS + (size_t)m * SHIFTW + 1536 + c0; const bf16* zp = first ? zc : zc - SHIFTW;
          const float* shp = sh0 + (size_t)(smp ? ((m0 - MP) >> 5) : 0) * SHIFTW + 1536 + c0;
#pragma unroll
          for (int e = 0; e < 10; ++e) { const int c = c0 + e; const float cur = bf1(zc[e]); float prev = bf1(zp[e]);
              if (first) prev = smp ? shp[e] : 0.f;
              const float zm = cur + mu[1536 + c] * (prev - cur);
              const float f = __frcp_rn(1.0f + __expf(c < 32 ? -2.0f * zm : -zm));
              const float v = c < 32 ? 2.0f * f - 1.0f : (c < 64 ? zm : f);
              xs[tk * XS_PITCH + c] = (bf16)f2bf(v); } }
        __syncthreads();
        const int m = m0 + rho; const bool first = tile_first && rho == 0;
        const bf16* zc = ZS + (size_t)m * SHIFTW + 64 * h + 4 * hi; const bf16* zp = first ? zc : zc - SHIFTW;
        const float* shp = sh0 + (size_t)(smp ? ((m0 - MP) >> 5) : 0) * SHIFTW + 64 * h + 4 * hi;
        const float* mu_l = mu + 64 * h + 4 * hi;
        const int pofs = 64 * h + 4 * hi;
#define ZMIX4(dst, co) do { const u32x2 cw = *(const u32x2*)(zc + (co)); const u32x2 pw = *(const u32x2*)(zp + (co)); const f32x4 mu4 = *(const f32x4*)(mu_l + (co)); \
            const float cu[4] = {bflo(cw.x), bfhi(cw.x), bflo(cw.y), bfhi(cw.y)}; float pv[4] = {bflo(pw.x), bfhi(pw.x), bflo(pw.y), bfhi(pw.y)}; \
            if (tile_first) { f32x4 s4 = {0.f, 0.f, 0.f, 0.f}; if (smp) s4 = *(const f32x4*)(shp + (co)); if (first) { pv[0] = s4.x; pv[1] = s4.y; pv[2] = s4.z; pv[3] = s4.w; } } \
            _Pragma("unroll") for (int e = 0; e < 4; ++e) dst[e] = cu[e] + mu4[e] * (pv[e] - cu[e]); } while (0)
        float n2 = 0.f;
#pragma unroll
        for (int ct = 0; ct < 2; ++ct)
#pragma unroll
            for (int grp = 0; grp < 4; ++grp) { const int co = 32 * ct + 8 * grp; float zk[4]; ZMIX4(zk, 512 + co); const f32x4 kk4 = *(const f32x4*)(k_k + pofs + co);
#pragma unroll
                for (int e = 0; e < 4; ++e) { const float kr = zk[e] * kk4[e]; n2 += kr * kr; } }
        n2 += __shfl_xor(n2, 32);
        const float invn = 1.0f / fmaxf(sqrtf(n2), 1e-12f);
        float bon = 0.f;
        asm volatile("" ::: "memory");
#pragma unroll
        for (int ct = 0; ct < 2; ++ct) {
            const f32x16 z16 = {0.f, 0.f, 0.f, 0.f, 0.f, 0.f, 0.f, 0.f, 0.f, 0.f, 0.f, 0.f, 0.f, 0.f, 0.f, 0.f}; f32x16 Dw = z16, Da = z16, Dg = z16;
            const int n = 64 * h + 32 * ct + rho;
            const bf16* xrow = xs + rho * XS_PITCH + 8 * hi;
#pragma unroll
            for (int ks = 0; ks < 2; ++ks) {
                Dw = MFMA32(*(const bf16x8*)(w2t + n * 32 + 16 * ks + 8 * hi), *(const bf16x8*)(xrow + 16 * ks), Dw);
                Da = MFMA32(*(const bf16x8*)(a2t + n * 32 + 16 * ks + 8 * hi), *(const bf16x8*)(xrow + 32 + 16 * ks), Da); }
#pragma unroll
            for (int ks = 0; ks < 6; ++ks) Dg = MFMA32(*(const bf16x8*)(g2t + n * 96 + 16 * ks + 8 * hi), *(const bf16x8*)(xrow + 64 + 16 * ks), Dg);
#pragma unroll
            for (int grp = 0; grp < 4; ++grp) {
                const int co = 32 * ct + 8 * grp;
                float zr[4], zk[4], zv[4]; ZMIX4(zr, co); ZMIX4(zk, 512 + co); ZMIX4(zv, 1024 + co);
                const f32x4 w04 = *(const f32x4*)(w0 + pofs + co), a04 = *(const f32x4*)(a0 + pofs + co), kk4 = *(const f32x4*)(k_k + pofs + co), ka4 = *(const f32x4*)(k_a + pofs + co), rk4 = *(const f32x4*)(r_k + pofs + co);
                float dec[4], km[4], gg[4], kk[4], bb[4];
#pragma unroll
                for (int e = 0; e < 4; ++e) { const int r = 4 * grp + e;
                    const float sg = __frcp_rn(1.0f + __expf(-(w04[e] + Dw[r])));
                    dec[e] = __expf(-0.6065306597126334f * sg);
                    const float aa = __frcp_rn(1.0f + __expf(-(a04[e] + Da[r])));
                    gg[e] = Dg[r];
                    kk[e] = zk[e] * kk4[e] * invn; bb[e] = kk[e] * aa;
                    km[e] = zk[e] * (1.0f + (aa - 1.0f) * ka4[e]);
                    bon += zr[e] * km[e] * rk4[e]; }
                const size_t o = (size_t)m * 512 + pofs + co;
                *(f32x4*)(OW + o) = (f32x4){dec[0], dec[1], dec[2], dec[3]};
                *(u32x2*)(OKK + o) = (u32x2){pk2(kk[0], kk[1]), pk2(kk[2], kk[3])};
                *(u32x2*)(OB + o) = (u32x2){pk2(bb[0], bb[1]), pk2(bb[2], bb[3])};
                *(u32x2*)(OKM + o) = (u32x2){pk2(km[0], km[1]), pk2(km[2], km[3])};
                *(u32x2*)(OR_ + o) = (u32x2){pk2(zr[0], zr[1]), pk2(zr[2], zr[3])};
                *(u32x2*)(OV + o) = (u32x2){pk2(zv[0], zv[1]), pk2(zv[2], zv[3])};
                *(u32x2*)(G + o) = (u32x2){pk2(gg[0], gg[1]), pk2(gg[2], gg[3])};
                asm volatile("" ::: "memory");
            }
        }
#undef ZMIX4
        bon += __shfl_xor(bon, 32);
        if (hi == 0) BON[(size_t)m * 8 + h] = bon;
        __syncthreads();
    }
}

constexpr int SC_CH = 32;
static_assert(WS_OB - WS_OKK == 17 * MiB && WS_OKM - WS_OB == 17 * MiB && WS_OR - WS_OKM == 17 * MiB && WS_OV - WS_OR == 17 * MiB, "operand arrays are equally spaced");
__device__ __forceinline__ void cvt_store8(unsigned char* d, const u32x4 x) {
    *(u32x4*)d = (u32x4){x.x << 16, x.x & 0xffff0000u, x.y << 16, x.y & 0xffff0000u}; *(u32x4*)(d + 16) = (u32x4){x.z << 16, x.z & 0xffff0000u, x.w << 16, x.w & 0xffff0000u};
}
struct StageP {
    static constexpr int STRIDE = 1280 + 64;
    const unsigned char* pw; const unsigned char* pb; int vrow0;
    u32x4 v[25];
    __device__ __forceinline__ void issue(int t0, int lane) {
        const unsigned char* gw = pw + ((size_t)(t0 + (lane >> 4)) * 512) * 4 + 16 * (lane & 15);
#pragma unroll
        for (int j = 0; j < 8; ++j) v[j] = *(const u32x4*)(gw + (size_t)j * 4 * 512 * 4);
        const unsigned char* gb = pb + ((size_t)(t0 + (lane >> 3)) * 512) * 2 + 16 * (lane & 7);
#pragma unroll
        for (int a = 0; a < 4; ++a)
#pragma unroll
            for (int jj = 0; jj < 4; ++jj) v[8 + 4 * a + jj] = *(const u32x4*)(gb + (size_t)a * (17 * MiB) + (size_t)jj * 8 * 512 * 2);
        v[24] = *(const u32x4*)(pb + (size_t)4 * (17 * MiB) + ((size_t)(t0 + (lane >> 1)) * 512) * 2 + 2 * vrow0 + 16 * (lane & 1));
    }
    __device__ __forceinline__ void commit(unsigned char* buf, int lane) const {
        unsigned char* dw = buf + (lane >> 4) * STRIDE + 16 * (lane & 15);
#pragma unroll
        for (int j = 0; j < 8; ++j) *(u32x4*)(dw + j * 4 * STRIDE) = v[j];
        unsigned char* db = buf + (lane >> 3) * STRIDE + 256 + 32 * (lane & 7);
#pragma unroll
        for (int a = 0; a < 4; ++a)
#pragma unroll
            for (int jj = 0; jj < 4; ++jj) cvt_store8(db + a * 256 + jj * 8 * STRIDE, v[8 + 4 * a + jj]);
        cvt_store8(buf + (lane >> 1) * STRIDE + 1280 + 32 * (lane & 1), v[24]);
    }
};
struct StageS {
    static constexpr int STRIDE = 1280 + 256;
    const unsigned char* pw; const unsigned char* pb;
    u32x4 v[7];
    __device__ __forceinline__ void issue(int t0, int lane) {
        const unsigned char* gw = pw + ((size_t)(t0 + (lane >> 4)) * 512) * 4 + 16 * (lane & 15);
        v[0] = *(const u32x4*)gw; v[1] = *(const u32x4*)(gw + (size_t)4 * 512 * 4);
        const unsigned char* gb = pb + ((size_t)(t0 + (lane >> 3)) * 512) * 2 + 16 * (lane & 7);
#pragma unroll
        for (int a = 0; a < 5; ++a) v[2 + a] = *(const u32x4*)(gb + (size_t)a * (17 * MiB));
    }
    __device__ __forceinline__ void commit(unsigned char* buf, int lane) const {
        unsigned char* dw = buf + (lane >> 4) * STRIDE + 16 * (lane & 15);
        *(u32x4*)dw = v[0]; *(u32x4*)(dw + 4 * STRIDE) = v[1];
        unsigned char* db = buf + (lane >> 3) * STRIDE + 256 + 32 * (lane & 7);
#pragma unroll
        for (int a = 0; a < 5; ++a) cvt_store8(db + a * 256, v[2 + a]);
    }
};
typedef float f32x2 __attribute__((ext_vector_type(2)));
template <int STRIDE, bool YLDS> __device__ __forceinline__ void scan_consume(f32x4& S4, const unsigned char* buf, int nst, int ks, int rowl, float* yp, float* ypart) {
    f32x2 Sa = {S4.x, S4.y}, Sb = {S4.z, S4.w};
    for (int s0 = 0; s0 < nst; s0 += 16) {
        float ykeep = 0.f;
#pragma unroll 1
        for (int g = 0; g < 4; ++g) {
            const int kq = ks - 4 * g;
#pragma unroll
            for (int j = 0; j < 4; ++j) {
                const float* p = (const float*)(buf + (s0 + 4 * g + j) * STRIDE) + 4 * ks;
                const f32x2 wa = *(const f32x2*)(p), wb = *(const f32x2*)(p + 2), ka = *(const f32x2*)(p + 64), kb = *(const f32x2*)(p + 66), ba = *(const f32x2*)(p + 128), bb = *(const f32x2*)(p + 130),
                            ma = *(const f32x2*)(p + 192), mb = *(const f32x2*)(p + 194), ra = *(const f32x2*)(p + 256), rb = *(const f32x2*)(p + 258);
                const float v = ((const float*)(buf + (s0 + 4 * g + j) * STRIDE))[320 + rowl];
                f32x2 t = Sa * ka + Sb * kb; float d = t.x + t.y; d = sum16(d);
                const f32x2 vv = {v, v}, dd = {d, d};
                Sa = Sa * wa + (vv * ma - dd * ba); Sb = Sb * wb + (vv * mb - dd * bb);
                f32x2 u = Sa * ra + Sb * rb; float y = u.x + u.y;
                if constexpr (YLDS) ypart[(s0 + 4 * g + j) * 256] = y;
                else { y = sum16(y); ykeep = kq == j ? y : ykeep; }
            }
        }
        if constexpr (!YLDS) yp[(size_t)(s0 + ks) * 512] = ykeep;
    }
    S4 = (f32x4){Sa.x, Sa.y, Sb.x, Sb.y};
}
__device__ __forceinline__ void scan_yreduce(const float* ypart, float* yg, int pt) {
#pragma unroll
    for (int k = 0; k < 2; ++k) { const int o = pt + 256 * k; const f32x4* q = (const f32x4*)(ypart + o * 16);
        const f32x4 a = q[0], b = q[1], c = q[2], d = q[3]; const f32x4 e = (a + b) + (c + d);
        yg[(size_t)(o >> 4) * 512 + (o & 15)] = (e.x + e.y) + (e.z + e.w); }
}
__device__ __forceinline__ void p5_rwkv_scan(const Args& a, unsigned char* lds, int tid) {
    const unsigned char* ws = a.ws; float* out = a.out; float* Y = out + SC_Y;
    const int l = tid & 63, w = __builtin_amdgcn_readfirstlane(tid >> 6), ks = l & 15, rl = l >> 4;
    const int G = gridDim.x, vcu = (G % 8 == 0) ? (blockIdx.x % 8) * (G / 8) + blockIdx.x / 8 : blockIdx.x;
    typedef StageP StP; typedef StageS StS;
    unsigned char* buf0 = lds; unsigned char* buf1 = lds + SC_CH * StP::STRIDE;
    for (int it = vcu; it < 256; it += G) {
        {
            const int bh = it >> 2, b = bh >> 3, h = bh & 7, rb = it & 3, row = 16 * rb + 4 * w + rl;
            const size_t base0 = ((size_t)b * T_P) * 512 + (size_t)h * 64;
            constexpr int NC = T_P / SC_CH;
            StP st; st.pw = ws + WS_OW + base0 * 4; st.pb = ws + WS_OKK + base0 * 2; st.vrow0 = 16 * rb;
            f32x4 S = {0.f, 0.f, 0.f, 0.f};
            if (w >= 4) { if (w == 4) { st.issue(0, l); st.commit(buf0, l); st.issue(4 * SC_CH, l); } else st.issue((w - 4) * SC_CH, l); }
            else __builtin_amdgcn_s_setprio(3);
            __syncthreads();
            Y += base0 + row;
            float* yp0 = (float*)(lds + 2 * SC_CH * StP::STRIDE); float* yp1 = yp0 + SC_CH * 256;
#define SCAN_ITER(c, P, cur, nxt, ypc, ypp) do { if (w >= 4) { if ((c) > 0) scan_yreduce(ypp, Y - row + 16 * rb + (size_t)(((c) - 1) * SC_CH) * 512, tid - 256); \
                    if (w == 4 + (P)) { if ((c) + 1 < NC) { st.commit(nxt, l); if ((c) + 5 < NC) st.issue(((c) + 5) * SC_CH, l); } } } \
                else scan_consume<StP::STRIDE, true>(S, cur, SC_CH, ks, 4 * w + rl, nullptr, ypc + tid); __syncthreads(); } while (0)
            for (int c = 0; c < NC; c += 4) { SCAN_ITER(c, 1, buf0, buf1, yp0, yp1); SCAN_ITER(c + 1, 2, buf1, buf0, yp1, yp0); SCAN_ITER(c + 2, 3, buf0, buf1, yp0, yp1); SCAN_ITER(c + 3, 0, buf1, buf0, yp1, yp0); }
            if (w >= 4) scan_yreduce(yp1, Y - row + 16 * rb + (size_t)((NC - 1) * SC_CH) * 512, tid - 256);
#undef SCAN_ITER
            __builtin_amdgcn_s_setprio(0);
            Y -= base0 + row;
            if (w < 4) *(f32x4*)(out + OFF_WKVP + ((size_t)bh * 64 + row) * 64 + 4 * ks) = S;
        }
        {
            const int b = it >> 3, h = it & 7;
            const size_t base0 = ((size_t)MP + (size_t)b * T_S) * 512 + (size_t)h * 64;
            StS st; st.pw = ws + WS_OW + base0 * 4; st.pb = ws + WS_OKK + base0 * 2;
            if (w >= 4) { st.issue(8 * (w - 4), l); st.commit(buf0 + 8 * (w - 4) * StS::STRIDE, l); }
            __syncthreads();
            for (int pass = 0; pass < 2; ++pass) { const int row = 8 * w + 4 * pass + rl;
                f32x4 S = *(const f32x4*)(a.in[5] + ((size_t)it * 64 + row) * 64 + 4 * ks);
                scan_consume<StS::STRIDE, false>(S, buf0, T_S, ks, row, Y + base0 + row, nullptr);
                *(f32x4*)(out + OFF_WKVS + ((size_t)it * 64 + row) * 64 + 4 * ks) = S; }
            __syncthreads();
        }
    }
}

__device__ __forceinline__ void p6_rwkv_out(const Args& a, int tid) {
    const unsigned char* ws = a.ws; const float* out = a.out; const float* Y = out + SC_Y; const bf16* G = (const bf16*)(out + SC_G);
    const bf16* OV = (const bf16*)(ws + WS_OV); const float* BON = (const float*)(ws + WS_BONUS); bf16* O = (bf16*)(a.ws + WS_XB);
    const float* lg = a.in[22]; const float* lb = a.in[23];
    const int sub = tid & 7;
    const size_t NIT = (size_t)MT * 8, STEP = (size_t)gridDim.x * 64;
    size_t it = (size_t)blockIdx.x * 64 + (tid >> 3);
    f32x4 y0, y1; u32x4 vw, gw_; float bon = 0.f;
#define P6_LOAD(it_) do { const size_t o_ = ((it_) >> 3) * 512 + ((it_) & 7) * 64 + 8 * sub; y0 = *(const f32x4*)(Y + o_); y1 = *(const f32x4*)(Y + o_ + 4); vw = *(const u32x4*)(OV + o_); gw_ = *(const u32x4*)(G + o_); bon = BON[it_]; } while (0)
    if (it < NIT) P6_LOAD(it);
    for (; it < NIT; it += STEP) {
        const size_t m = it >> 3; const int h = (int)(it & 7);
        float y[8] = {y0.x, y0.y, y0.z, y0.w, y1.x, y1.y, y1.z, y1.w}; float v[8], g[8]; unpack8(vw, v); unpack8(gw_, g); const float bn = bon;
        if (it + STEP < NIT) P6_LOAD(it + STEP);
        float s1 = 0.f;
#pragma unroll
        for (int j = 0; j < 8; ++j) s1 += y[j];
        s1 += __shfl_xor(s1, 1); s1 += __shfl_xor(s1, 2); s1 += __shfl_xor(s1, 4);
        const float mean = s1 * (1.f / 64.f); float s2 = 0.f;
#pragma unroll
        for (int j = 0; j < 8; ++j) { const float d = y[j] - mean; s2 += d * d; }
        s2 += __shfl_xor(s2, 1); s2 += __shfl_xor(s2, 2); s2 += __shfl_xor(s2, 4);
        const float rinv = rsqrtf(s2 * (1.f / 64.f) + 64e-5f);
        float r[8];
#pragma unroll
        for (int j = 0; j < 8; ++j) { const int c = h * 64 + 8 * sub + j; r[j] = ((y[j] - mean) * rinv * lg[c] + lb[c] + bn * v[j]) * g[j]; }
        *(u32x4*)(O + m * DM + 512 + h * 64 + 8 * sub) = pack8(r);
    }
#undef P6_LOAD
}

__device__ __forceinline__ void p8_hnorm(const Args& a, int tid) {
    const int lane = tid & 63, gw = blockIdx.x * 8 + (tid >> 6), NGW = gridDim.x * 8;
    for (int m = gw; m < MT; m += NGW) {
        const f32x4* xr = (const f32x4*)(a.out + OFF_Y + (size_t)m * DM) + lane; f32x4 v[4]; float s = 0.f;
#pragma unroll
        for (int j = 0; j < 4; ++j) { v[j] = xr[64 * j]; s += (v[j].x * v[j].x + v[j].y * v[j].y) + (v[j].z * v[j].z + v[j].w * v[j].w); }
        const float rs = rsqrtf(wave_sum(s) * (1.f / DM) + 1e-6f);
        u32x2* o8 = (u32x2*)((bf16*)(a.ws + WS_HB) + (size_t)m * DM) + lane;
#pragma unroll
        for (int j = 0; j < 4; ++j) { u32x2 o; o.x = pk2(v[j].x * rs, v[j].y * rs); o.y = pk2(v[j].z * rs, v[j].w * rs); o8[64 * j] = o; }
    }
}

#define XB_TMO      128
#define XB_XCNT(j)  (256  + 64 * (j))
#define XB_XSUB(j)  (1280 + 64 * (j))
#define XB_XGEN(j)  (2304 + 64 * (j))
#define XB_TOP      3328
#define XB_TOPGEN   3392
#define XCD_BAR_WORDS 3456
#define XB_SPIN_CAP (1u << 18)

__device__ __forceinline__ unsigned xb_ld(unsigned* p)              { return __hip_atomic_load(p, __ATOMIC_RELAXED, __HIP_MEMORY_SCOPE_AGENT); }
__device__ __forceinline__ unsigned xb_add(unsigned* p, unsigned v) { return __hip_atomic_fetch_add(p, v, __ATOMIC_RELAXED, __HIP_MEMORY_SCOPE_AGENT); }
__device__ __forceinline__ unsigned xb_xcc_id() { return (unsigned)__builtin_amdgcn_s_getreg((3 << 11) | 20) & 0xFu; }
#define XB_SPIN(cond, bar) do { unsigned _sp = 0; while (cond) { __builtin_amdgcn_s_sleep(1); \
    if ((++_sp & 255u) == 0u) { if (xb_ld(&(bar)[XB_TMO])) break; if (_sp > XB_SPIN_CAP) { atomicAdd(&(bar)[XB_TMO], 1u); break; } } } } while (0)

struct XcdBarrier {
    unsigned* bar; unsigned x;
    volatile __attribute__((address_space(3))) unsigned* st;
};

__device__ __forceinline__ XcdBarrier xcd_barrier_post(unsigned* bar, volatile __attribute__((address_space(3))) unsigned* st) {
    XcdBarrier b; b.bar = bar; b.x = xb_xcc_id(); b.st = st;
    if (threadIdx.x == 0) (void)xb_add(&bar[XB_XCNT(b.x)], 1u);
    return b;
}
__device__ __forceinline__ void xcd_barrier_complete(unsigned* bar, unsigned x, unsigned& nloc, unsigned& nx) {
    const unsigned G = gridDim.x * gridDim.y * gridDim.z;
    unsigned sum, cnt, mine, sp = 0u;
    for (;;) {
        sum = 0u; cnt = 0u; mine = 0u;
#pragma unroll
        for (unsigned j = 0; j < 16; ++j) { const unsigned c = xb_ld(&bar[XB_XCNT(j)]); sum += c; cnt += (c > 0u) ? 1u : 0u; mine = (j == x) ? c : mine; }
        if (sum == G) break;
        __builtin_amdgcn_s_sleep(1);
        if ((++sp & 255u) == 0u) { if (xb_ld(&bar[XB_TMO])) break; if (sp > XB_SPIN_CAP) { atomicAdd(&bar[XB_TMO], 1u); break; } }
    }
    nloc = mine > 0u ? mine : 1u; nx = cnt > 0u ? cnt : 1u;
}

__device__ __forceinline__ void xcd_barrier(const XcdBarrier& b) {
    asm volatile("s_waitcnt vmcnt(0)" ::: "memory");
    __syncthreads();
    if (threadIdx.x == 0) {
        unsigned* bar = b.bar;
        __builtin_amdgcn_s_waitcnt(0);
        unsigned nloc = b.st[0], nx = b.st[1];
        if (nloc == 0u) { xcd_barrier_complete(bar, b.x, nloc, nx); b.st[0] = nloc; b.st[1] = nx; }
        const unsigned old = xb_add(&bar[XB_XSUB(b.x)], 1u);
        const unsigned gen = old / nloc;
        if (old + 1u == (gen + 1u) * nloc) {
            __builtin_amdgcn_fence(__ATOMIC_RELEASE, "agent");
            asm volatile("s_waitcnt vmcnt(0)" ::: "memory");
            const unsigned og = xb_add(&bar[XB_TOP], 1u);
            const unsigned tg = og / nx;
            if (og + 1u == (tg + 1u) * nx) xb_add(&bar[XB_TOPGEN], 1u);
            else XB_SPIN(xb_ld(&bar[XB_TOPGEN]) == tg, bar);
            __builtin_amdgcn_fence(__ATOMIC_ACQUIRE, "agent");
            xb_add(&bar[XB_XGEN(b.x)], 1u);
            asm volatile("s_waitcnt vmcnt(0)" ::: "memory");
        } else {
            XB_SPIN(xb_ld(&bar[XB_XGEN(b.x)]) == gen, bar);
            __builtin_amdgcn_fence(__ATOMIC_ACQUIRE, "agent");
            asm volatile("s_waitcnt vmcnt(0)" ::: "memory");
        }
    }
    __syncthreads();
}

constexpr int CW_BAR = 4096;
constexpr int LDS_BYTES = 163840;
constexpr int N_PHASES = 12;
#ifndef PROBE_MASK
#define PROBE_MASK 0
#endif
template <int PH> __device__ __forceinline__ void run_phase(const Args& args, unsigned char* lds, int tid, int rep) {
    unsigned char* ws = args.ws;
    if constexpr (PH == 0) p0_prologue(args, lds, tid);
    if constexpr (PH == 1) { pg8::Gemm g{(const pg8::bf16_t*)(ws + WS_XB), (const pg8::bf16_t*)(ws + WS_WIN), MT, NZ, DM, DM}; pg8::StaticOrder S; S.init(MT, NZ, gridDim.x, blockIdx.x);
        pg8::EpiZ E{(pg8::bf16_t*)(ws + WS_ZR), (pg8::bf16_t*)(ws + WS_ZS)};
        pg8::gemm_phase<pg8::EpiZ, pg8::StaticOrder, true, true>((PG8_LAS unsigned char*)lds, g, S, E); }
    if constexpr (PH == 2) p2_post(args, lds, tid);
    if constexpr (PH == 3) p3_attention(args, lds, tid, rep);
    if constexpr (PH == 4) p4_rwkv_prep(args, lds, tid);
    if constexpr (PH == 5) p5_rwkv_scan(args, lds, tid);
    if constexpr (PH == 6) p6_rwkv_out(args, tid);
    if constexpr (PH == 7) { pg8::Gemm g{(const pg8::bf16_t*)(ws + WS_XB), (const pg8::bf16_t*)(ws + WS_WOUT), MT, DM, DM, DM}; pg8::StaticOrder S; S.init(MT, DM, gridDim.x, blockIdx.x);
        pg8::EpiH E{args.in[0], args.in[1], args.out + OFF_Y, (pg8::bf16_t*)(ws + WS_HB), (float*)(ws + WS_CTL) + CW_SS};
        pg8::gemm_phase<pg8::EpiH, pg8::StaticOrder, true, true>((PG8_LAS unsigned char*)lds, g, S, E); }
    if constexpr (PH == 9) { pg8::Gemm g{(const pg8::bf16_t*)(ws + WS_HB), (const pg8::bf16_t*)(ws + WS_W1), MT, DFF, DM, DM}; pg8::StaticOrder S; S.init(MT, DFF, gridDim.x, blockIdx.x);
        pg8::EpiAct E{(pg8::bf16_t*)(ws + WS_ACT), DFF, (const float*)(ws + WS_CTL) + CW_SS};
        pg8::gemm_phase<pg8::EpiAct, pg8::StaticOrder, true, true>((PG8_LAS unsigned char*)lds, g, S, E); }
    if constexpr (PH == 10) {
        { pg8::Gemm g{(const pg8::bf16_t*)(ws + WS_ACT), (const pg8::bf16_t*)(ws + WS_W2), MP, DM, DFF, DFF}; pg8::StaticOrder S; S.init(MP, DM, gridDim.x, blockIdx.x);
          pg8::EpiY E{args.out + OFF_Y};
          pg8::gemm_phase<pg8::EpiY, pg8::StaticOrder, true, true>((PG8_LAS unsigned char*)lds, g, S, E); }
        { const int c = blockIdx.x; pg8::OneUnit S; S.has = c < 64; S.u.pm = MP / 256 + (c >> 4); S.u.pn = (c >> 2) & 3; const int sl = c & 3;
          pg8::Gemm g{(const pg8::bf16_t*)(ws + WS_ACT) + sl * 1024, (const pg8::bf16_t*)(ws + WS_W2) + sl * 1024, MT, DM, DFF, 1024};
          pg8::EpiSlab E{(float*)(ws + WS_HB) + (size_t)sl * MS * DM};
          __syncthreads();
          pg8::gemm_phase<pg8::EpiSlab, pg8::OneUnit, false, true>((PG8_LAS unsigned char*)lds, g, S, E); }
    }
    if constexpr (PH == 11) {
        const f32x4* sl = (const f32x4*)(ws + WS_HB); f32x4* y = (f32x4*)(args.out + OFF_Y + (size_t)MP * DM); constexpr int NV = MS * DM / 4;
        for (int i = blockIdx.x * 512 + tid; i < NV; i += gridDim.x * 512) y[i] = y[i] + ((sl[i] + sl[i + NV]) + (sl[i + 2 * NV] + sl[i + 3 * NV]));
    }
}
#ifndef MK_ONE_LAUNCH
#define MK_ONE_LAUNCH 1
#endif
#if MK_ONE_LAUNCH
__global__ void __launch_bounds__(512, 2) mk_fwd(Args args) {
    extern __shared__ __attribute__((aligned(16))) unsigned char lds[];
    const int tid = threadIdx.x;
    volatile __attribute__((address_space(3))) unsigned* bst = (volatile __attribute__((address_space(3))) unsigned*)((__attribute__((address_space(3))) unsigned char*)lds + LDS_BYTES - 16);
    if (tid < 2) bst[tid] = 0u;
    __syncthreads();
    const XcdBarrier bar = xcd_barrier_post((unsigned*)(args.ws + WS_CTL) + CW_BAR, bst);
#define SEAM(k) do { if ((k) == 1) { __syncthreads(); cg::this_grid().sync(); } else xcd_barrier(bar); } while (0)
#define PHASE(k) do { if (args.ph_lo <= (k) && (k) < args.ph_hi) { if ((k) > args.ph_lo) SEAM(k); run_phase<k>(args, lds, tid, 0); \
        if ((PROBE_MASK >> (k)) & 1) { xcd_barrier(bar); run_phase<k>(args, lds, tid, 1); } } } while (0)
    PHASE(0); PHASE(1); PHASE(2); PHASE(3); PHASE(4); PHASE(5); PHASE(6); PHASE(7); PHASE(9); PHASE(10); PHASE(11);
#undef PHASE
#undef SEAM
}
#else
template <int PH> __global__ void __launch_bounds__(512, 2) mk_phase(Args args) {
    extern __shared__ __attribute__((aligned(16))) unsigned char lds[];
    run_phase<PH>(args, lds, threadIdx.x, 0);
}
#endif

extern "C" void kernel_launch(void* const* d_in, const int* in_sizes, int n_in, void* d_out, int out_size, void* d_ws, size_t ws_size, hipStream_t stream) {
    static int grid = 0;
    if (grid == 0) {
        if (n_in != 28 || out_size != (int)OUT_TOTAL || ws_size < WS_END) { fprintf(stderr, "kernel_launch: unexpected shapes (n_in %d, out %d, ws %zu)\n", n_in, out_size, ws_size); grid = -1; return; }
        int dev = 0, cus = 0, per_cu = 0;
        (void)hipGetDevice(&dev); (void)hipDeviceGetAttribute(&cus, hipDeviceAttributeMultiprocessorCount, dev);
#if MK_ONE_LAUNCH
        if (hipFuncSetAttribute((const void*)mk_fwd, hipFuncAttributeMaxDynamicSharedMemorySize, LDS_BYTES) != hipSuccess) { fprintf(stderr, "kernel_launch: hipFuncSetAttribute failed\n"); grid = -1; return; }
        (void)hipOccupancyMaxActiveBlocksPerMultiprocessor(&per_cu, (const void*)mk_fwd, 512, LDS_BYTES);
        (void)hipGetLastError();
        if (per_cu < 1) { fprintf(stderr, "kernel_launch: occupancy query says %d blocks per CU\n", per_cu); per_cu = 1; }
#else
#define SETATTR(k) (void)hipFuncSetAttribute((const void*)mk_phase<k>, hipFuncAttributeMaxDynamicSharedMemorySize, LDS_BYTES)
        SETATTR(0); SETATTR(1); SETATTR(2); SETATTR(3); SETATTR(4); SETATTR(5); SETATTR(6); SETATTR(7); SETATTR(8); SETATTR(9); SETATTR(10); SETATTR(11);
#undef SETATTR
        (void)per_cu;
#endif
        grid = cus;
    }
    if (grid < 0) return;
    (void)hipMemsetAsync((char*)d_ws + WS_CTL, 0, CTL_BYTES, stream);
    Args a{};
    for (int i = 0; i < 28; ++i) a.in[i] = (const float*)d_in[i];
    a.out = (float*)d_out; a.ws = (unsigned char*)d_ws;
#if MK_ONE_LAUNCH
    a.ph_lo = 0; a.ph_hi = N_PHASES;
    void* kargs[] = {&a};
    hipError_t e = hipLaunchCooperativeKernel((const void*)mk_fwd, dim3(grid), dim3(512), kargs, LDS_BYTES, stream);
    if (e != hipSuccess) fprintf(stderr, "kernel_launch: cooperative launch failed: %s (grid %d)\n", hipGetErrorString(e), grid);
#else
#define LAUNCH(k) hipLaunchKernelGGL(mk_phase<k>, dim3(grid), dim3(512), LDS_BYTES, stream, a)
    a.ph_lo = 0; a.ph_hi = N_PHASES;
    LAUNCH(0); LAUNCH(1); LAUNCH(2); LAUNCH(3); LAUNCH(4); LAUNCH(5); LAUNCH(6); LAUNCH(7); LAUNCH(9); LAUNCH(10); LAUNCH(11);
#undef LAUNCH
#endif
}
```

```cpp
#include <hip/hip_runtime.h>
#include <hip/hip_cooperative_groups.h>
#include <cstdio>
#include <cstdint>
namespace cg = cooperative_groups;
#define PROBE_A1 0
#define PROBE_A2 0
#define PROBE_A3 0
namespace pg8 {
#define PG8_LAS __attribute__((address_space(3)))
typedef unsigned short bf16_t;
typedef short bf16x8 __attribute__((ext_vector_type(8)));
typedef float f32x4 __attribute__((ext_vector_type(4)));
typedef unsigned u32x4 __attribute__((ext_vector_type(4)));
constexpr int BM = 256, BK = 64, HALF = 128, HTB = HALF * BK * 2  , STAGE_BYTES = 8 * HTB, NXCD = 8, WGM = 8;

__host__ __device__ __forceinline__ int lds_byte(int r, int c) { const int st = (r >> 4) * 2 + (c >> 5), rr = r & 15, cc = c & 31, ob = rr * 64 + cc * 2; return st * 1024 + (ob ^ (((ob >> 9) & 1) << 5)); }
__host__ __device__ __forceinline__ void stage_rc(int b, int& R, int& C) { const int st = b / 1024, sb = b % 1024, swz = sb ^ (((sb >> 9) & 1) << 5); R = (st >> 1) * 16 + swz / 64; C = (st & 1) * 32 + (swz % 64) / 2; }
__host__ __device__ __forceinline__ int perm32(int rho) { const int n = rho >> 4, i = rho & 15; return 8 * (i >> 2) + 4 * n + (i & 3); }

struct Unit { int pm, pn; };
struct Gemm { const bf16_t* A; const bf16_t* Bt; int M, N, K, KL; };

struct StaticOrder {
    int nM, nN, nwg, G, c;
    __host__ __device__ void init(int M, int N, int G_, int c_) { nM = M / BM; nN = N / BM; nwg = nM * nN; G = G_; c = c_; }
    __host__ __device__ bool next(int i, Unit& u) const {
        const long L = (long)i * G + c; if (L >= nwg) return false;
        int wgid = (int)L; { const int q = nwg / NXCD, r = nwg % NXCD, xcd = wgid % NXCD, off = wgid / NXCD; wgid = (xcd < r ? xcd * (q + 1) : r * (q + 1) + (xcd - r) * q) + off; }
        const int nig = WGM * nN, gid = wgid / nig, fm = gid * WGM, gsz = (nM - fm) < WGM ? (nM - fm) : WGM;
        u.pm = fm + ((wgid % nig) % gsz); u.pn = (wgid % nig) / gsz; return true;
    }
    __device__ __forceinline__ void a_ready(const Unit&) const {}
    __device__ __forceinline__ void done(const Unit&) const {}
};


__device__ __forceinline__ unsigned cvt_pk_bf16(float lo, float hi) { unsigned r; asm volatile("v_cvt_pk_bf16_f32 %0, %1, %2" : "=v"(r) : "v"(lo), "v"(hi)); return r; }

constexpr int E_MP = 16384;
constexpr int E_ZRW = 1632, E_ZSW = 1696;

struct OneUnit { Unit u; bool has;
    __device__ __forceinline__ bool next(int i, Unit& o) const { if (i == 0 && has) { o = u; return true; } return false; }
    __device__ __forceinline__ void a_ready(const Unit&) const {}
    __device__ __forceinline__ void done(const Unit&) const {} };
struct EpiZ {
    static constexpr bool PERM = true, AFTER_DRAIN = false;
    bf16_t* ZR; bf16_t* ZS;
    __device__ __forceinline__ void operator()(const f32x4 (&acc)[2][2][4][2], const Unit& u, int wr, int wc, int fr, int fq) const {
        const int row0 = u.pm * BM + wr * 64 + fr, c0 = u.pn * BM + wc * 32 + 8 * fq;
#pragma unroll
        for (int ai = 0; ai < 2; ++ai)
#pragma unroll
            for (int m = 0; m < 4; ++m) { const size_t row = (size_t)(row0 + ai * HALF + m * 16);
#pragma unroll
                for (int bj = 0; bj < 2; ++bj) { const int c = c0 + bj * HALF; bf16_t* dst;
                    if (c < 1600) dst = ZR + row * E_ZRW + c; else if (c < 3296) dst = ZS + row * E_ZSW + (c - 1600); else if (c == 3296) dst = ZR + row * E_ZRW + 1600; else continue;
                    const f32x4 v0 = acc[ai][bj][m][0], v1 = acc[ai][bj][m][1]; u32x4 w;
                    w.x = cvt_pk_bf16(v0[0], v0[1]); w.y = cvt_pk_bf16(v0[2], v0[3]); w.z = cvt_pk_bf16(v1[0], v1[1]); w.w = cvt_pk_bf16(v1[2], v1[3]);
                    *(u32x4*)dst = w; } }
    }
};
struct EpiH {
    static constexpr bool PERM = false, AFTER_DRAIN = false;
    const float* xp; const float* xs; float* H; bf16_t* HB; float* SS;
    __device__ __forceinline__ void operator()(const f32x4 (&acc)[2][2][4][2], const Unit& u, int wr, int wc, int fr, int fq) const {
        const int row0 = u.pm * BM + wr * 64 + fr, col0 = u.pn * BM + wc * 32 + 4 * fq;
#pragma unroll
        for (int ai = 0; ai < 2; ++ai)
#pragma unroll
            for (int m = 0; m < 4; ++m) { const int row = row0 + ai * HALF + m * 16;
                const float* xr = (row < E_MP ? xp + (size_t)row * 1024 : xs + (size_t)(row - E_MP) * 1024) + col0; float* hr = H + (size_t)row * 1024 + col0; bf16_t* hb = HB + (size_t)row * 1024 + col0;
                float ss = 0.f;
#pragma unroll
                for (int bj = 0; bj < 2; ++bj)
#pragma unroll
                    for (int n = 0; n < 2; ++n) { const f32x4 h = *(const f32x4*)(xr + bj * HALF + n * 16) + acc[ai][bj][m][n]; *(f32x4*)(hr + bj * HALF + n * 16) = h;
                        ss += (h[0] * h[0] + h[1] * h[1]) + (h[2] * h[2] + h[3] * h[3]);
                        unsigned w0 = cvt_pk_bf16(h[0], h[1]), w1 = cvt_pk_bf16(h[2], h[3]); typedef unsigned u32x2v __attribute__((ext_vector_type(2))); *(u32x2v*)(hb + bj * HALF + n * 16) = (u32x2v){w0, w1}; }
                ss += __shfl_xor(ss, 16); ss += __shfl_xor(ss, 32);
                if (fq == 0) atomicAdd(SS + row, ss); }
    }
};
struct EpiAct {
    static constexpr bool PERM = true, AFTER_DRAIN = false;
    bf16_t* O; int ldc; const float* SS;
    __device__ __forceinline__ void operator()(const f32x4 (&acc)[2][2][4][2], const Unit& u, int wr, int wc, int fr, int fq) const {
        const int row0 = u.pm * BM + wr * 64 + fr, c0 = u.pn * BM + wc * 32 + 8 * fq;
#pragma unroll
        for (int ai = 0; ai < 2; ++ai)
#pragma unroll
            for (int m = 0; m < 4; ++m) { const int row = row0 + ai * HALF + m * 16; bf16_t* rowp = O + (size_t)row * ldc + c0;
                const float rs = rsqrtf(SS[row] * (1.0f / 1024.0f) + 1e-6f);
#pragma unroll
                for (int bj = 0; bj < 2; ++bj) { f32x4 v0 = acc[ai][bj][m][0], v1 = acc[ai][bj][m][1];
#pragma unroll
                    for (int e = 0; e < 4; ++e) { const float a = fmaxf(v0[e], 0.f) * rs, b = fmaxf(v1[e], 0.f) * rs; v0[e] = a * a; v1[e] = b * b; }
                    u32x4 w; w.x = cvt_pk_bf16(v0[0], v0[1]); w.y = cvt_pk_bf16(v0[2], v0[3]); w.z = cvt_pk_bf16(v1[0], v1[1]); w.w = cvt_pk_bf16(v1[2], v1[3]);
                    *(u32x4*)(rowp + bj * HALF) = w; } }
    }
};
struct EpiSlab {
    static constexpr bool PERM = false, AFTER_DRAIN = false;
    float* S;
    __device__ __forceinline__ void operator()(const f32x4 (&acc)[2][2][4][2], const Unit& u, int wr, int wc, int fr, int fq) const {
        const int row0 = u.pm * BM - E_MP + wr * 64 + fr, col0 = u.pn * BM + wc * 32 + 4 * fq;
#pragma unroll
        for (int ai = 0; ai < 2; ++ai)
#pragma unroll
            for (int m = 0; m < 4; ++m) { float* yr = S + (size_t)(row0 + ai * HALF + m * 16) * 1024 + col0;
#pragma unroll
                for (int bj = 0; bj < 2; ++bj)
#pragma unroll
                    for (int n = 0; n < 2; ++n) *(f32x4*)(yr + bj * HALF + n * 16) = acc[ai][bj][m][n]; }
    }
};
struct EpiY {
    static constexpr bool PERM = false, AFTER_DRAIN = false;
    float* Y;
    __device__ __forceinline__ void operator()(const f32x4 (&acc)[2][2][4][2], const Unit& u, int wr, int wc, int fr, int fq) const {
        const int row0 = u.pm * BM + wr * 64 + fr, col0 = u.pn * BM + wc * 32 + 4 * fq;
#pragma unroll
        for (int ai = 0; ai < 2; ++ai)
#pragma unroll
            for (int m = 0; m < 4; ++m) { float* yr = Y + (size_t)(row0 + ai * HALF + m * 16) * 1024 + col0;
#pragma unroll
                for (int bj = 0; bj < 2; ++bj)
#pragma unroll
                    for (int n = 0; n < 2; ++n) { f32x4* p = (f32x4*)(yr + bj * HALF + n * 16); *p = *p + acc[ai][bj][m][n]; } }
    }
};

template <class Epi, class Sched, bool ALIGN_EPI = false, bool SP2 = false>
__device__ __forceinline__ void gemm_phase(PG8_LAS unsigned char* lds, const Gemm g, const Sched& S, const Epi& E) {
    const int tid = threadIdx.x, wid = __builtin_amdgcn_readfirstlane(tid >> 6), lane = tid & 63, wr = wid >> 2, wc = wid & 3, fr = lane & 15, fq = lane >> 4;
    const int K = g.K, nt = g.KL / BK;
    unsigned voffA[2], voffB[2];
#pragma unroll
    for (int i = 0; i < 2; ++i) { int R, C; stage_rc(tid * 16 + i * 8192, R, C); const int Rb = Epi::PERM ? ((R & ~31) + perm32(R & 31)) : R;
        voffA[i] = (unsigned)(R * K + C) * 2u; voffB[i] = (unsigned)(Rb * K + C) * 2u; }
    const size_t kstep = (size_t)(BK * 2);
    const size_t hstep = (size_t)HALF * K * 2;
    const size_t tstep = 2 * hstep;
    const unsigned ldsw = (unsigned)wid * 1024u;
    const int aoff = lds_byte(wr * 64 + fr, fq * 8), boff = lds_byte(wc * 32 + fr, fq * 8);
#define PG8_SA(b, h) (((b) * 2 + (h)) * HTB)
#define PG8_SB(b, h) ((4 + (b) * 2 + (h)) * HTB)
#define PG8_STAGE(bufoff, gbase, voff) do { _Pragma("unroll") for (int _i = 0; _i < 2; ++_i) \
        __builtin_amdgcn_global_load_lds((const unsigned*)((const char*)(gbase) + (voff)[_i]), (PG8_LAS unsigned*)(lds + (bufoff) + ldsw + _i * 8192), 16, 0, 0); } while (0)
#define PG8_LDA(dst, b, h) do { _Pragma("unroll") for (int m = 0; m < 4; ++m) _Pragma("unroll") for (int k = 0; k < 2; ++k) dst[m][k] = *(const PG8_LAS bf16x8*)(lds + PG8_SA(b, h) + aoff + m * 2048 + k * 1024); } while (0)
#define PG8_LDB(dst, b, h) do { _Pragma("unroll") for (int n = 0; n < 2; ++n) _Pragma("unroll") for (int k = 0; k < 2; ++k) dst[n][k] = *(const PG8_LAS bf16x8*)(lds + PG8_SB(b, h) + boff + n * 2048 + k * 1024); } while (0)
#define PG8_MMA(ai, bj, At, Bt) do { __builtin_amdgcn_s_setprio(1); _Pragma("unroll") for (int m = 0; m < 4; ++m) _Pragma("unroll") for (int n = 0; n < 2; ++n) _Pragma("unroll") for (int k = 0; k < 2; ++k) \
        acc[ai][bj][m][n] = __builtin_amdgcn_mfma_f32_16x16x32_bf16(Bt[n][k], At[m][k], acc[ai][bj][m][n], 0, 0, 0); __builtin_amdgcn_s_setprio(0); } while (0)
#define PG8_WAIT_V(n) asm volatile("s_waitcnt vmcnt(" #n ")" ::: "memory")
#define PG8_WAIT_L(n) asm volatile("s_waitcnt lgkmcnt(" #n ")" ::: "memory")
#define PG8_BAR __builtin_amdgcn_s_barrier()
#define PG8_SCHED __builtin_amdgcn_sched_barrier(0)
    Unit cur, nxt; int ui = 0;
    if (!S.next(0, cur)) return;
    f32x4 acc[2][2][4][2];
#pragma unroll
    for (int a = 0; a < 2; ++a)
#pragma unroll
        for (int b = 0; b < 2; ++b)
#pragma unroll
            for (int m = 0; m < 4; ++m)
#pragma unroll
                for (int n = 0; n < 2; ++n) acc[a][b][m][n] = (f32x4){0.f, 0.f, 0.f, 0.f};
    bf16x8 At[4][2], B0[2][2], B1[2][2];
    const char* cA = (const char*)g.A + (size_t)cur.pm * tstep; const char* cB = (const char*)g.Bt + (size_t)cur.pn * tstep;
    S.a_ready(cur);
    if constexpr (SP2) {
        PG8_STAGE(PG8_SB(0, 0), cB, voffB); PG8_STAGE(PG8_SB(0, 1), cB + hstep, voffB); PG8_STAGE(PG8_SA(0, 0), cA, voffA); PG8_STAGE(PG8_SA(0, 1), cA + hstep, voffA);
        if (wr == 1) PG8_BAR;
        PG8_WAIT_V(2); PG8_BAR;
        PG8_STAGE(PG8_SB(1, 0), cB + kstep, voffB); PG8_STAGE(PG8_SA(1, 0), cA + kstep, voffA); PG8_STAGE(PG8_SB(1, 1), cB + hstep + kstep, voffB);
        PG8_WAIT_V(6); PG8_BAR;
    } else {
        PG8_STAGE(PG8_SB(0, 0), cB, voffB); PG8_STAGE(PG8_SA(0, 0), cA, voffA); PG8_STAGE(PG8_SB(0, 1), cB + hstep, voffB); PG8_STAGE(PG8_SA(0, 1), cA + hstep, voffA);
        if (wr == 1) PG8_BAR;
        PG8_WAIT_V(4); PG8_BAR;
        PG8_STAGE(PG8_SB(1, 0), cB + kstep, voffB); PG8_STAGE(PG8_SA(1, 0), cA + kstep, voffA); PG8_STAGE(PG8_SB(1, 1), cB + hstep + kstep, voffB);
        PG8_WAIT_V(6); PG8_BAR;
    }
    for (;;) {
        const bool has_next = S.next(ui + 1, nxt);
        const char* nA = has_next ? (const char*)g.A + (size_t)nxt.pm * tstep : cA; const char* nB = has_next ? (const char*)g.Bt + (size_t)nxt.pn * tstep : cB;
        for (int t = 0; t < nt; t += 2) {
            const bool last = (t == nt - 2);
            const char* a1 = cA + (size_t)(t + 1) * kstep;
            const char* a2 = last ? nA : cA + (size_t)(t + 2) * kstep; const char* b2 = last ? nB : cB + (size_t)(t + 2) * kstep;
            const char* a3 = a2 + kstep; const char* b3 = b2 + kstep;
            if (last && has_next) S.a_ready(nxt);
            if constexpr (SP2) {
            PG8_LDB(B0, 0, 0); PG8_LDB(B1, 0, 1); PG8_SCHED; PG8_LDA(At, 0, 0); PG8_STAGE(PG8_SA(1, 1), a1 + hstep, voffA);
            PG8_WAIT_V(8); PG8_WAIT_L(0); PG8_BAR; PG8_MMA(0, 0, At, B0); PG8_MMA(0, 1, At, B1); PG8_BAR; PG8_SCHED;
            PG8_LDA(At, 0, 1); PG8_STAGE(PG8_SB(0, 0), b2, voffB); PG8_STAGE(PG8_SB(0, 1), b2 + hstep, voffB); PG8_STAGE(PG8_SA(0, 0), a2, voffA);
            PG8_WAIT_V(8); PG8_WAIT_L(0); PG8_BAR; PG8_MMA(1, 0, At, B0); PG8_MMA(1, 1, At, B1); PG8_BAR; PG8_SCHED;
            PG8_LDB(B0, 1, 0); PG8_LDB(B1, 1, 1); PG8_SCHED; PG8_LDA(At, 1, 0); PG8_STAGE(PG8_SA(0, 1), a2 + hstep, voffA);
            PG8_WAIT_V(8); PG8_WAIT_L(0); PG8_BAR; PG8_MMA(0, 0, At, B0); PG8_MMA(0, 1, At, B1); PG8_BAR; PG8_SCHED;
            PG8_LDA(At, 1, 1); PG8_STAGE(PG8_SB(1, 0), b3, voffB); PG8_STAGE(PG8_SB(1, 1), b3 + hstep, voffB); PG8_STAGE(PG8_SA(1, 0), a3, voffA);
            PG8_WAIT_V(8); PG8_WAIT_L(0); PG8_BAR; PG8_MMA(1, 0, At, B0); PG8_MMA(1, 1, At, B1); PG8_BAR; PG8_SCHED;
            } else {
            PG8_LDB(B0, 0, 0); PG8_SCHED; PG8_LDA(At, 0, 0); PG8_STAGE(PG8_SA(1, 1), a1 + hstep, voffA);
            PG8_WAIT_L(8); PG8_BAR; PG8_WAIT_L(0); PG8_MMA(0, 0, At, B0); PG8_BAR; PG8_SCHED;
            PG8_LDB(B1, 0, 1); PG8_STAGE(PG8_SB(0, 0), b2, voffB);
            PG8_BAR; PG8_WAIT_L(0); PG8_MMA(0, 1, At, B1); PG8_BAR;
            PG8_LDA(At, 0, 1); PG8_STAGE(PG8_SA(0, 0), a2, voffA);
            PG8_BAR; PG8_WAIT_L(0); PG8_MMA(1, 0, At, B0); PG8_BAR; PG8_SCHED;
            PG8_STAGE(PG8_SB(0, 1), b2 + hstep, voffB);
            PG8_WAIT_V(6); PG8_BAR; PG8_MMA(1, 1, At, B1); PG8_BAR;
            PG8_LDB(B0, 1, 0); PG8_SCHED; PG8_LDA(At, 1, 0); PG8_STAGE(PG8_SA(0, 1), a2 + hstep, voffA);
            PG8_WAIT_L(8); PG8_BAR; PG8_WAIT_L(0); PG8_MMA(0, 0, At, B0); PG8_BAR; PG8_SCHED;
            PG8_LDB(B1, 1, 1); PG8_STAGE(PG8_SB(1, 0), b3, voffB);
            PG8_BAR; PG8_WAIT_L(0); PG8_MMA(0, 1, At, B1); PG8_BAR;
            PG8_LDA(At, 1, 1); PG8_STAGE(PG8_SA(1, 0), a3, voffA);
            PG8_BAR; PG8_WAIT_L(0); PG8_MMA(1, 0, At, B0); PG8_BAR; PG8_SCHED;
            PG8_STAGE(PG8_SB(1, 1), b3 + hstep, voffB);
            PG8_WAIT_V(6); PG8_BAR; PG8_MMA(1, 1, At, B1); PG8_BAR;
            }
        }
        if constexpr (ALIGN_EPI) { if (wr == 0) PG8_BAR; }
        if constexpr (!Epi::AFTER_DRAIN) { E(acc, cur, wr, wc, fr, fq); S.done(cur); }
        if (!has_next) break;
#pragma unroll
        for (int a = 0; a < 2; ++a)
#pragma unroll
            for (int b = 0; b < 2; ++b)
#pragma unroll
                for (int m = 0; m < 4; ++m)
#pragma unroll
                    for (int n = 0; n < 2; ++n) acc[a][b][m][n] = (f32x4){0.f, 0.f, 0.f, 0.f};
        cur = nxt; cA = nA; cB = nB; ++ui;
        if constexpr (ALIGN_EPI) { if (wr == 1) PG8_BAR; }
    }
    PG8_WAIT_V(0);
    if constexpr (!ALIGN_EPI) { if (wr == 0) PG8_BAR; }
    PG8_BAR;
    if constexpr (Epi::AFTER_DRAIN) { E.fused(acc, cur, wr, wc, fr, fq, lds, wid, lane); S.done(cur); }
#undef PG8_SA
#undef PG8_SB
#undef PG8_STAGE
#undef PG8_LDA
#undef PG8_LDB
#undef PG8_MMA
#undef PG8_WAIT_V
#undef PG8_WAIT_L
#undef PG8_BAR
#undef PG8_SCHED
}
}


constexpr int DM = 1024, NB_P = 8, T_P = 2048, NB_S = 32, T_S = 32, PAST = 1024;
constexpr int MP = NB_P * T_P, MS = NB_S * T_S, MT = MP + MS;
constexpr int LS = PAST + T_S;
constexpr int SHIFTW = 1696, NZ = 3328, ZRW = 1632, DFF = 4096;
constexpr float QSCALE = 0.125f * 1.4426950408889634f;
constexpr float WISCALE = 0.35355339059327373f * 0.125f;
constexpr size_t OFF_Y = 0, OFF_KP = 17825792, OFF_VP = OFF_KP + 4194304, OFF_KIP = OFF_VP + 4194304, OFF_WKVP = OFF_KIP + 1048576, OFF_SHP = OFF_WKVP + 262144,
                 OFF_KS = OFF_SHP + 13568, OFF_VS = OFF_KS + 262144, OFF_KIS = OFF_VS + 262144, OFF_WKVS = OFF_KIS + 65536, OFF_SHS = OFF_WKVS + 1048576, OUT_TOTAL = OFF_SHS + 54272;
constexpr size_t MiB = 1u << 20;
constexpr size_t WS_CTL = 0, CTL_BYTES = 1 * MiB;
constexpr size_t WS_WIN = 1 * MiB, WS_WOUT = 8 * MiB, WS_W1 = 10 * MiB, WS_W2 = 18 * MiB;
constexpr size_t WS_W2T = 26 * MiB, WS_A2T = WS_W2T + 32768, WS_G2T = WS_A2T + 32768, WS_WI = 27 * MiB, WS_BONUS = 28 * MiB;
constexpr size_t WS_XB = 30 * MiB;
constexpr size_t WS_ZS = 66 * MiB;
constexpr size_t WS_R = 123 * MiB;
constexpr size_t WS_ZR = WS_R, WS_KBP = 178 * MiB, WS_VTP = 186 * MiB, WS_KIP = 194 * MiB, WS_KBS = 196 * MiB, WS_VTS = 213 * MiB, WS_KIS = 230 * MiB;
constexpr size_t WS_OW = WS_R, WS_OKK = 157 * MiB, WS_OB = 174 * MiB, WS_OKM = 191 * MiB, WS_OR = 208 * MiB, WS_OV = 225 * MiB;
constexpr size_t WS_ACT = 66 * MiB, WS_HB = 202 * MiB, WS_END = 256 * MiB;
static_assert(WS_ZS + (size_t)MT * SHIFTW * 2 <= WS_R && WS_ZR + (size_t)MT * ZRW * 2 <= WS_KBP && WS_KBS + (size_t)NB_S * LS * 256 * 2 <= WS_VTS && WS_VTS + (size_t)NB_S * 256 * LS * 2 <= WS_KIS &&
              WS_KIS + (size_t)NB_S * LS * 64 * 2 <= WS_END && WS_OV + (size_t)MT * 512 * 2 <= WS_END && WS_ACT + (size_t)MT * DFF * 2 <= WS_HB && WS_HB + (size_t)MT * DM * 2 <= WS_END, "d_ws map");
constexpr size_t SC_Q = 0, SC_QI = (size_t)MT * 512 / 2, SC_Y = 0, SC_G = (size_t)MT * 512;
constexpr int CW_QATT = 64, CW_SS = 16384;

typedef unsigned short bf16;
typedef short bf16x8 __attribute__((ext_vector_type(8)));
typedef float f32x4 __attribute__((ext_vector_type(4)));
typedef float f32x16 __attribute__((ext_vector_type(16)));
typedef unsigned u32x4 __attribute__((ext_vector_type(4)));
typedef unsigned u32x2 __attribute__((ext_vector_type(2)));

__device__ __forceinline__ unsigned f2bf(float f) { unsigned u = __float_as_uint(f); return (u + 0x7fffu + ((u >> 16) & 1u)) >> 16; }
__device__ __forceinline__ unsigned pk2(float lo, float hi) { return f2bf(lo) | (f2bf(hi) << 16); }
__device__ __forceinline__ float bflo(unsigned w) { return __uint_as_float(w << 16); }
__device__ __forceinline__ float bfhi(unsigned w) { return __uint_as_float(w & 0xffff0000u); }
__device__ __forceinline__ float bf1(bf16 b) { return __uint_as_float((unsigned)b << 16); }
__device__ __forceinline__ void unpack8(const u32x4 w, float* x) { x[0] = bflo(w.x); x[1] = bfhi(w.x); x[2] = bflo(w.y); x[3] = bfhi(w.y); x[4] = bflo(w.z); x[5] = bfhi(w.z); x[6] = bflo(w.w); x[7] = bfhi(w.w); }
__device__ __forceinline__ u32x4 pack8(const float* x) { u32x4 w; w.x = pk2(x[0], x[1]); w.y = pk2(x[2], x[3]); w.z = pk2(x[4], x[5]); w.w = pk2(x[6], x[7]); return w; }
__device__ __forceinline__ float wave_sum(float v) {
#pragma unroll
    for (int o = 1; o < 64; o <<= 1) v += __shfl_xor(v, o);
    return v;
}
template <int CTRL> __device__ __forceinline__ float dppmov(float x) { return __builtin_bit_cast(float, __builtin_amdgcn_update_dpp(0, __builtin_bit_cast(int, x), CTRL, 0xf, 0xf, true)); }
__device__ __forceinline__ float sum16(float x) {
    x += dppmov<0xB1>(x); x += dppmov<0x4E>(x); x += dppmov<0x141>(x); x += dppmov<0x140>(x); return x;
}
__device__ __forceinline__ int crow(int r, int hi) { return (r & 3) + 8 * (r >> 2) + 4 * hi; }

struct Args { const float* in[28]; float* out; unsigned char* ws; int ph_lo, ph_hi; };

__device__ __forceinline__ void tr_item(const float* W, int K, int N, const float* gain, bf16* WT, int jr0, int c0, int nvalid, int k0, float* scr, int lane) {
#pragma unroll 8
    for (int i = 0; i < 32; ++i) { const int kk = 2 * i + (lane >> 5), n = lane & 31;
        float v = (n < nvalid) ? W[(size_t)(k0 + kk) * N + c0 + n] : 0.f; if (gain) v *= gain[k0 + kk]; scr[kk * 33 + n] = v; }
    __builtin_amdgcn_s_waitcnt(0xC07F); asm volatile("" ::: "memory");
    const int c = lane & 7;
#pragma unroll
    for (int j = 0; j < 4; ++j) { const int n = (lane >> 3) + 8 * j; const float* s = scr + (8 * c) * 33 + n;
        u32x4 o; o.x = pk2(s[0 * 33], s[1 * 33]); o.y = pk2(s[2 * 33], s[3 * 33]); o.z = pk2(s[4 * 33], s[5 * 33]); o.w = pk2(s[6 * 33], s[7 * 33]);
        *(u32x4*)(WT + (size_t)(jr0 + n) * K + k0 + 8 * c) = o; }
    __builtin_amdgcn_s_waitcnt(0xC07F); asm volatile("" ::: "memory");
}
__device__ __forceinline__ void p0_prologue(const Args& a, unsigned char* lds, int tid) {
    const int lane = tid & 63, wave = tid >> 6, gw = blockIdx.x * 8 + wave, NGW = gridDim.x * 8;
    float* scr = (float*)(lds + wave * 17408);
    unsigned char* ws = a.ws;
    constexpr int I_IN = (NZ / 32) * (DM / 64), I_OUT = (DM / 32) * (DM / 64), I_F1 = (DFF / 32) * (DM / 64), I_F2 = (DM / 32) * (DFF / 64);
    for (int it = gw; it < I_IN + I_OUT + I_F1 + I_F2; it += NGW) {
        int r = it;
        if (r < I_IN) { const int jb = r % (NZ / 32), kb = r / (NZ / 32), j0 = jb * 32; int c0, nv;
            if (j0 < 1600) { c0 = j0; nv = 32; } else if (j0 < 3296) { c0 = 1608 + (j0 - 1600); nv = 32; } else { c0 = 1600; nv = 8; }
            tr_item(a.in[8], DM, 3304, a.in[7], (bf16*)(ws + WS_WIN), j0, c0, nv, kb * 64, scr, lane); continue; }
        r -= I_IN;
        if (r < I_OUT) { const int jb = r % (DM / 32), kb = r / (DM / 32); tr_item(a.in[24], DM, DM, nullptr, (bf16*)(ws + WS_WOUT), jb * 32, jb * 32, 32, kb * 64, scr, lane); continue; }
        r -= I_OUT;
        if (r < I_F1) { const int jb = r % (DFF / 32), kb = r / (DFF / 32); tr_item(a.in[26], DM, DFF, a.in[25], (bf16*)(ws + WS_W1), jb * 32, jb * 32, 32, kb * 64, scr, lane); continue; }
        r -= I_F1;
        { const int jb = r % (DM / 32), kb = r / (DM / 32); tr_item(a.in[27], DFF, DM, nullptr, (bf16*)(ws + WS_W2), jb * 32, jb * 32, 32, kb * 64, scr, lane); }
    }
    { const int gt = blockIdx.x * 512 + tid, NT = gridDim.x * 512;
      bf16* w2t = (bf16*)(ws + WS_W2T); bf16* a2t = (bf16*)(ws + WS_A2T); bf16* g2t = (bf16*)(ws + WS_G2T);
      for (int i = gt; i < 512 * 32; i += NT) { const int n = i >> 5, k = i & 31; w2t[i] = (bf16)f2bf(a.in[15][k * 512 + n]); a2t[i] = (bf16)f2bf(a.in[17][k * 512 + n]); }
      for (int i = gt; i < 512 * 96; i += NT) { const int n = i / 96, k = i % 96; g2t[i] = (bf16)f2bf(a.in[18][k * 512 + n]); } }
    { f32x4 v[4], nx[4]; int m = gw;
      if (m < MT) { const f32x4* xr = (const f32x4*)((m < MP) ? a.in[0] + (size_t)m * DM : a.in[1] + (size_t)(m - MP) * DM) + lane;
#pragma unroll
          for (int j = 0; j < 4; ++j) v[j] = xr[64 * j]; }
      for (; m < MT; m += NGW) {
        const int mn = m + NGW;
        if (mn < MT) { const f32x4* xr = (const f32x4*)((mn < MP) ? a.in[0] + (size_t)mn * DM : a.in[1] + (size_t)(mn - MP) * DM) + lane;
#pragma unroll
            for (int j = 0; j < 4; ++j) nx[j] = xr[64 * j]; }
        float s = 0.f;
#pragma unroll
        for (int j = 0; j < 4; ++j) s += (v[j].x * v[j].x + v[j].y * v[j].y) + (v[j].z * v[j].z + v[j].w * v[j].w);
        const float rs = rsqrtf(wave_sum(s) * (1.f / DM) + 1e-6f);
        u32x2* o8 = (u32x2*)((bf16*)(ws + WS_XB) + (size_t)m * DM) + lane;
#pragma unroll
        for (int j = 0; j < 4; ++j) { u32x2 o; o.x = pk2(v[j].x * rs, v[j].y * rs); o.y = pk2(v[j].z * rs, v[j].w * rs); o8[64 * j] = o; }
#pragma unroll
        for (int j = 0; j < 4; ++j) v[j] = nx[j];
      } }
    for (int r4 = gw; r4 < NB_S * PAST / 4; r4 += NGW) {
        f32x4 v[4];
#pragma unroll
        for (int j = 0; j < 4; ++j) v[j] = ((const f32x4*)(a.in[2] + (size_t)(4 * r4 + j) * 256))[lane];
#pragma unroll
        for (int j = 0; j < 4; ++j) { const int rix = 4 * r4 + j, b = rix >> 10, p = rix & 1023; u32x2 o; o.x = pk2(v[j].x, v[j].y); o.y = pk2(v[j].z, v[j].w);
            ((u32x2*)((bf16*)(ws + WS_KBS) + ((size_t)b * LS + p) * 256))[lane] = o; }
    }
    for (int r4 = gw; r4 < NB_S * PAST / 4; r4 += NGW) {
        const int rix = r4 * 4 + (lane >> 4), b = rix >> 10, p = rix & 1023; const f32x4 v = ((const f32x4*)(a.in[4] + (size_t)rix * 64))[lane & 15];
        u32x2 o; o.x = pk2(v.x, v.y); o.y = pk2(v.z, v.w); ((u32x2*)((bf16*)(ws + WS_KIS) + ((size_t)b * LS + p) * 64))[lane & 15] = o;
    }
    for (int it = gw; it < NB_S * 4 * 16; it += NGW) {
        const int kb = it & 15, g = (it >> 4) & 3, b = it >> 6;
        const float* src = a.in[3] + ((size_t)b * PAST + kb * 64) * 256 + g * 64;
#pragma unroll 8
        for (int i = 0; i < 64; ++i) scr[i * 65 + lane] = src[(size_t)i * 256 + lane];
        __builtin_amdgcn_s_waitcnt(0xC07F); asm volatile("" ::: "memory");
        bf16* dst = (bf16*)(ws + WS_VTS) + ((size_t)(b * 4 + g) * 64) * LS + kb * 64 + lane;
#pragma unroll 8
        for (int d = 0; d < 64; ++d) dst[(size_t)d * LS] = (bf16)f2bf(scr[lane * 65 + d]);
        __builtin_amdgcn_s_waitcnt(0xC07F); asm volatile("" ::: "memory");
    }
}

__device__ __forceinline__ void p2_post(const Args& a, unsigned char* lds, int tid) {
    unsigned char* ws = a.ws; float* out = a.out;
    const bf16* ZR = (const bf16*)(ws + WS_ZR); const bf16* ZS = (const bf16*)(ws + WS_ZS);
    bf16* Q = (bf16*)(out + SC_Q); bf16* QI = (bf16*)(out + SC_QI);
    float* cs = (float*)lds;
    bf16* vt = (bf16*)(lds + 4096);
    const int g8 = tid >> 3, sub = tid & 7;
    const float* qg = a.in[9]; const float* kg = a.in[10]; const float* lng = a.in[11]; const float* lnb = a.in[12];
    for (int tile = blockIdx.x; tile < MT / 64; tile += gridDim.x) {
        const int m0 = tile * 64;
        { const int m = m0 + g8, pos = (m < MP) ? (m & (T_P - 1)) : (PAST + ((m - MP) & (T_S - 1)));
          const float inv = powf(500000.0f, -(float)sub * 0.125f); const float ang = (float)pos * inv; float s, c; sincosf(ang, &s, &c);
          cs[g8 * 16 + sub] = c; cs[g8 * 16 + 8 + sub] = s; }
        __syncthreads();
        const int m = m0 + g8;
        const bool isp = m < MP; const int ms = m - MP;
        float cc[8], ss[8];
#pragma unroll
        for (int j = 0; j < 8; ++j) { cc[j] = cs[g8 * 16 + j]; ss[j] = cs[g8 * 16 + 8 + j]; }
        const size_t kvrow = isp ? (size_t)m : ((size_t)(ms >> 5) * LS + PAST + (ms & 31));
        bf16* KB = (bf16*)(ws + (isp ? WS_KBP : WS_KBS)); bf16* KIb = (bf16*)(ws + (isp ? WS_KIP : WS_KIS));
        u32x4 xnext = *(const u32x4*)(ZR + (size_t)m * ZRW + 8 * sub);
        for (int hb = 0; hb < 25; ++hb) {
            float x[8]; unpack8(xnext, x);
            if (hb + 1 < 25) xnext = *(const u32x4*)(ZR + (size_t)m * ZRW + (hb + 1) * 64 + 8 * sub);
            if (hb < 12) {
                float s2 = 0.f;
#pragma unroll
                for (int j = 0; j < 8; ++j) s2 += x[j] * x[j];
                s2 += __shfl_xor(s2, 1); s2 += __shfl_xor(s2, 2); s2 += __shfl_xor(s2, 4);
                const float rinv = rsqrtf(s2 * (1.f / 64.f) + 1e-6f); const float* gn = (hb < 8 ? qg : kg) + 8 * sub;
                float y[8], o[8];
#pragma unroll
                for (int j = 0; j < 8; ++j) y[j] = x[j] * rinv * gn[j];
#pragma unroll
                for (int j = 0; j < 8; ++j) { const float p = __shfl_xor(y[j], 1); o[j] = sub == 0 ? y[j] * cc[j] - p * ss[j] : (sub == 1 ? y[j] * cc[j] + p * ss[j] : y[j]); }
                if (hb < 8) {
#pragma unroll
                    for (int j = 0; j < 8; ++j) o[j] *= QSCALE;
                    *(u32x4*)(Q + (size_t)m * 512 + hb * 64 + 8 * sub) = pack8(o);
                } else { const int g = hb - 8;
                    float* ko = out + (isp ? OFF_KP + (size_t)m * 256 : OFF_KS + (size_t)ms * 256) + g * 64 + 8 * sub;
                    *(f32x4*)ko = (f32x4){o[0], o[1], o[2], o[3]}; *(f32x4*)(ko + 4) = (f32x4){o[4], o[5], o[6], o[7]};
                    *(u32x4*)(KB + kvrow * 256 + g * 64 + 8 * sub) = pack8(o); }
            } else if (hb < 16) { const int g = hb - 12;
                float* vo = out + (isp ? OFF_VP + (size_t)m * 256 : OFF_VS + (size_t)ms * 256) + g * 64 + 8 * sub;
                *(f32x4*)vo = (f32x4){x[0], x[1], x[2], x[3]}; *(f32x4*)(vo + 4) = (f32x4){x[4], x[5], x[6], x[7]};
                unsigned* vd = (unsigned*)(vt + g8 * 258 + g * 64 + 8 * sub);
                vd[0] = pk2(x[0], x[1]); vd[1] = pk2(x[2], x[3]); vd[2] = pk2(x[4], x[5]); vd[3] = pk2(x[6], x[7]);
            } else if (hb < 24) {
                float o[8];
#pragma unroll
                for (int j = 0; j < 8; ++j) { const float p = __shfl_xor(x[j], 1); o[j] = sub == 0 ? x[j] * cc[j] - p * ss[j] : (sub == 1 ? x[j] * cc[j] + p * ss[j] : x[j]); }
                *(u32x4*)(QI + (size_t)m * 512 + (hb - 16) * 64 + 8 * sub) = pack8(o);
            } else {
                float s1 = 0.f;
#pragma unroll
                for (int j = 0; j < 8; ++j) s1 += x[j];
                s1 += __shfl_xor(s1, 1); s1 += __shfl_xor(s1, 2); s1 += __shfl_xor(s1, 4);
                const float mu = s1 * (1.f / 64.f); float s2 = 0.f;
#pragma unroll
                for (int j = 0; j < 8; ++j) { const float d = x[j] - mu; s2 += d * d; }
                s2 += __shfl_xor(s2, 1); s2 += __shfl_xor(s2, 2); s2 += __shfl_xor(s2, 4);
                const float rinv = rsqrtf(s2 * (1.f / 64.f) + 1e-6f); float y[8], o[8];
#pragma unroll
                for (int j = 0; j < 8; ++j) y[j] = (x[j] - mu) * rinv * lng[8 * sub + j] + lnb[8 * sub + j];
#pragma unroll
                for (int j = 0; j < 8; ++j) { const float p = __shfl_xor(y[j], 1); o[j] = sub == 0 ? y[j] * cc[j] - p * ss[j] : (sub == 1 ? y[j] * cc[j] + p * ss[j] : y[j]); }
                float* ko = out + (isp ? OFF_KIP + (size_t)m * 64 : OFF_KIS + (size_t)ms * 64) + 8 * sub;
                *(f32x4*)ko = (f32x4){o[0], o[1], o[2], o[3]}; *(f32x4*)(ko + 4) = (f32x4){o[4], o[5], o[6], o[7]};
                *(u32x4*)(KIb + kvrow * 64 + 8 * sub) = pack8(o);
            }
        }
        ((float*)(ws + WS_WI))[(size_t)m * 8 + sub] = bf1(ZR[(size_t)m * ZRW + 1600 + sub]) * WISCALE;
        __syncthreads();
        { const int r = tid >> 1, half = tid & 1; unsigned wv[16];
#pragma unroll
          for (int j = 0; j < 16; ++j) wv[j] = (unsigned)vt[(32 * half + 2 * j) * 258 + r] | ((unsigned)vt[(32 * half + 2 * j + 1) * 258 + r] << 16);
          bf16* dst;
          if (m0 < MP) dst = (bf16*)(ws + WS_VTP) + ((size_t)(m0 >> 11) * 256 + r) * T_P + (m0 & (T_P - 1)) + 32 * half;
          else { const int b = ((m0 - MP) >> 5) + half; dst = (bf16*)(ws + WS_VTS) + ((size_t)b * 256 + r) * LS + PAST; }
#pragma unroll
          for (int j = 0; j < 4; ++j) ((u32x4*)dst)[j] = (u32x4){wv[4 * j], wv[4 * j + 1], wv[4 * j + 2], wv[4 * j + 3]}; }
        if (m0 < MP) { if ((m0 & (T_P - 1)) == T_P - 64) { const int b = m0 >> 11; const bf16* zr = ZS + (size_t)(m0 + 63) * SHIFTW;
                for (int c = tid; c < SHIFTW; c += 512) out[OFF_SHP + (size_t)b * SHIFTW + c] = bf1(zr[c]); } }
        else { for (int h2 = 0; h2 < 2; ++h2) { const int b = ((m0 - MP) >> 5) + h2; const bf16* zr = ZS + (size_t)(m0 + 32 * h2 + 31) * SHIFTW;
                for (int c = tid; c < SHIFTW; c += 512) out[OFF_SHS + (size_t)b * SHIFTW + c] = bf1(zr[c]); } }
        __syncthreads();
    }
}

constexpr int ATT_UNITS = 544;
constexpr int MASK_PITCH = 65;
#define MFMA32(a, b, c) __builtin_amdgcn_mfma_f32_32x32x16_bf16((a), (b), (c), 0, 0, 0)

__device__ __forceinline__ float half_sum32(float v) { v += __shfl_xor(v, 1); v += __shfl_xor(v, 2); v += __shfl_xor(v, 4); v += __shfl_xor(v, 8); v += __shfl_xor(v, 16); return v; }
__device__ __forceinline__ float half_min32(float v) { v = fminf(v, __shfl_xor(v, 1)); v = fminf(v, __shfl_xor(v, 2)); v = fminf(v, __shfl_xor(v, 4)); v = fminf(v, __shfl_xor(v, 8)); v = fminf(v, __shfl_xor(v, 16)); return v; }
__device__ __forceinline__ float half_max32(float v) { v = fmaxf(v, __shfl_xor(v, 1)); v = fmaxf(v, __shfl_xor(v, 2)); v = fmaxf(v, __shfl_xor(v, 4)); v = fmaxf(v, __shfl_xor(v, 8)); v = fmaxf(v, __shfl_xor(v, 16)); return v; }
__device__ __forceinline__ int half_sum32i(int v) { v += __shfl_xor(v, 1); v += __shfl_xor(v, 2); v += __shfl_xor(v, 4); v += __shfl_xor(v, 8); v += __shfl_xor(v, 16); return v; }

#define LAS3 __attribute__((address_space(3)))
constexpr int A_RING1 = 0, A_SCL = 24576, A_RING2 = 24576, A_MASK = 0, A_LSUM = 8320, A_UNIT = 9344;
__device__ __forceinline__ void p3_attention(const Args& a, unsigned char* lds, int tid, int rep) {
    unsigned char* ws = a.ws; float* out = a.out;
    const bf16* Q = (const bf16*)(out + SC_Q); const bf16* QI = (const bf16*)(out + SC_QI); const float* WI = (const float*)(ws + WS_WI);
    bf16* O = (bf16*)(ws + WS_XB);
    unsigned* maskw = (unsigned*)(lds + A_MASK);
    float* lsum = (float*)(lds + A_LSUM);
    int* s_unit = (int*)(lds + A_UNIT);
    typedef float f32x2_t __attribute__((ext_vector_type(2)));
    f32x2_t* scl = (f32x2_t*)(lds + A_SCL) + (size_t)(tid >> 6) * 2048 + (tid & 63);
    unsigned* qctr = (unsigned*)(ws + WS_CTL) + CW_QATT + 64 * rep;
    const int l = tid & 63, w = __builtin_amdgcn_readfirstlane(tid >> 6), rho = l & 31, hi = l >> 5;
    LAS3 unsigned char* ldsb = (LAS3 unsigned char*)lds;
    for (;;) {
        if (tid == 0) *s_unit = (int)atomicAdd(qctr, 1u);
        __syncthreads();
        const int p = *s_unit;
        __syncthreads();
        if (p >= ATT_UNITS) break;
        int m0, nkt, vpitch; const bf16 *KB, *VT, *KI; bool need_idx;
        { int c = -1, b, half = 0;
          if (p < 256) { c = 31 - (p >> 4); b = (p & 15) >> 1; half = p & 1; }
          else if (p < 288) { b = p - 256; }
          else { const int pp = p - 288; c = 15 - (pp >> 4); b = (pp & 15) >> 1; half = pp & 1; }
          if (c >= 0) { m0 = b * T_P + 64 * c + 32 * half; nkt = 2 * (c + 1); vpitch = T_P; need_idx = c >= 4;
              KB = (const bf16*)(ws + WS_KBP) + (size_t)b * T_P * 256; VT = (const bf16*)(ws + WS_VTP) + (size_t)b * 256 * T_P; KI = (const bf16*)(ws + WS_KIP) + (size_t)b * T_P * 64; }
          else { m0 = MP + 32 * b; nkt = LS / 32; vpitch = LS; need_idx = true;
              KB = (const bf16*)(ws + WS_KBS) + (size_t)b * LS * 256; VT = (const bf16*)(ws + WS_VTS) + (size_t)b * 256 * LS; KI = (const bf16*)(ws + WS_KIS) + (size_t)b * LS * 64; } }
        if (need_idx) {
            const int tokA = 4 * w + 2 * ((rho >> 2) & 1) + (rho >> 4), headA = (rho & 3) + 4 * ((rho >> 3) & 1);
            bf16x8 qa[4];
#pragma unroll
            for (int ks = 0; ks < 4; ++ks) qa[ks] = *(const bf16x8*)(QI + (size_t)(m0 + tokA) * 512 + headA * 64 + 16 * ks + 8 * hi);
            float wv[16];
#pragma unroll
            for (int r = 0; r < 16; ++r) wv[r] = WI[(size_t)(m0 + 4 * w + 2 * hi + (r >> 3)) * 8 + (r & 7)];
            asm volatile("" :: "v"(qa[0]), "v"(qa[1]), "v"(qa[2]), "v"(qa[3]));
#pragma unroll
            for (int r = 0; r < 16; ++r) asm volatile("" :: "v"(wv[r]));
            asm volatile("s_waitcnt vmcnt(0)" ::: "memory");
            float sc0[32], sc1[32];
            const int nb = (nkt + 1) >> 1;
            const int sr = 8 * w + (l >> 3), scn = (l & 7) ^ ((sr >> 1) & 7);
            const unsigned char* ksrc = (const unsigned char*)KI + (size_t)sr * 128 + 16 * scn;
#define KI_STAGE(it_) __builtin_amdgcn_global_load_lds((const unsigned*)(ksrc + (size_t)(it_) * 8192), (LAS3 unsigned*)(ldsb + A_RING1 + ((it_) % 3) * 8192 + w * 1024), 16, 0, 0)
            for (int rp1 = 0; rp1 <= PROBE_A1; ++rp1) {
            if (rp1) __syncthreads();
            KI_STAGE(0); if (1 < nb) KI_STAGE(1);
#pragma unroll
            for (int it = 0; it < 32; ++it) {
                if (it < nb) {
                    if (it + 1 < nb) asm volatile("s_waitcnt vmcnt(1) lgkmcnt(0)\n\ts_barrier" ::: "memory"); else asm volatile("s_waitcnt vmcnt(0) lgkmcnt(0)\n\ts_barrier" ::: "memory");
                    if (it + 2 < nb) KI_STAGE(it + 2);
                    const unsigned char* tb = lds + A_RING1 + (it % 3) * 8192;
#pragma unroll
                    for (int k2 = 0; k2 < 2; ++k2) { const int kt = 2 * it + k2;
                        if (kt < nkt) {
                            const int r = 32 * k2 + rho; const unsigned char* rowp = tb + r * 128; const int sw = (r >> 1) & 7;
                            f32x16 acc = {0.f, 0.f, 0.f, 0.f, 0.f, 0.f, 0.f, 0.f, 0.f, 0.f, 0.f, 0.f, 0.f, 0.f, 0.f, 0.f};
#pragma unroll
                            for (int ks = 0; ks < 4; ++ks) acc = MFMA32(qa[ks], *(const bf16x8*)(rowp + 16 * ((2 * ks + hi) ^ sw)), acc);
                            float s0 = 0.f, s1 = 0.f;
#pragma unroll
                            for (int r2 = 0; r2 < 8; ++r2) { s0 += wv[r2] * fmaxf(acc[r2], 0.f); s1 += wv[8 + r2] * fmaxf(acc[8 + r2], 0.f); }
                            if (kt < 32) { sc0[kt & 31] = s0; sc1[kt & 31] = s1; } else scl[(kt - 32) * 64] = (f32x2_t){s0, s1};
                        } else if (kt < 32) { sc0[kt & 31] = -3.0e38f; sc1[kt & 31] = -3.0e38f; }
                    }
                } else { if (2 * it < 32) { sc0[(2 * it) & 31] = -3.0e38f; sc1[(2 * it) & 31] = -3.0e38f; sc0[(2 * it + 1) & 31] = -3.0e38f; sc1[(2 * it + 1) & 31] = -3.0e38f; } }
            }
            }
#undef KI_STAGE
            __syncthreads();
            float mn0 = 3.0e38f, mx0 = -3.0e38f, mn1 = 3.0e38f, mx1 = -3.0e38f; int cp0 = 0, cz0 = 0, cp1 = 0, cz1 = 0;
#pragma unroll
            for (int kt = 0; kt < 64; ++kt) if (kt < nkt) { float v0, v1; if (kt < 32) { v0 = sc0[kt & 31]; v1 = sc1[kt & 31]; } else { const f32x2_t t2 = scl[(kt - 32) * 64]; v0 = t2.x; v1 = t2.y; }
                mn0 = fminf(mn0, v0); mx0 = fmaxf(mx0, v0); mn1 = fminf(mn1, v1); mx1 = fmaxf(mx1, v1);
                cp0 += v0 > 0.f ? 1 : 0; cz0 += v0 == 0.f ? 1 : 0; cp1 += v1 > 0.f ? 1 : 0; cz1 += v1 == 0.f ? 1 : 0; }
            mn0 = half_min32(mn0); mx0 = half_max32(mx0); mn1 = half_min32(mn1); mx1 = half_max32(mx1);
            cp0 = half_sum32i(cp0); cz0 = half_sum32i(cz0); cp1 = half_sum32i(cp1); cz1 = half_sum32i(cz1);
            float lo0, hi0, lo1, hi1, thr0 = 0.f, thr1 = 0.f; int ch0, ch1, nt0 = 0, nt1 = 0; bool fin0, fin1;
            for (int rp2 = 0; rp2 <= PROBE_A2; ++rp2) {
            fin0 = false; fin1 = false; ch0 = 0; ch1 = 0;
            if (cp0 >= 256) { lo0 = 0.f; hi0 = mx0; if (cp0 == 256) { fin0 = true; thr0 = 0.f; nt0 = 0; } }
            else if (cp0 + cz0 >= 256) { lo0 = 0.f; hi0 = 0.f; fin0 = true; thr0 = 0.f; nt0 = 256 - cp0; }
            else { lo0 = mn0 - 1.0f; hi0 = 0.f; ch0 = cp0; }
            if (cp1 >= 256) { lo1 = 0.f; hi1 = mx1; if (cp1 == 256) { fin1 = true; thr1 = 0.f; nt1 = 0; } }
            else if (cp1 + cz1 >= 256) { lo1 = 0.f; hi1 = 0.f; fin1 = true; thr1 = 0.f; nt1 = 256 - cp1; }
            else { lo1 = mn1 - 1.0f; hi1 = 0.f; ch1 = cp1; }
            asm volatile("" : "+v"(lo0), "+v"(lo1));
            for (int iter = 0; iter < 64; ++iter) {
                const float mid0 = lo0 + 0.5f * (hi0 - lo0), mid1 = lo1 + 0.5f * (hi1 - lo1);
                int c0 = 0, c1 = 0;
#pragma unroll
                for (int g = 0; g < 4; ++g) if (8 * g < nkt) {
#pragma unroll
                    for (int k8 = 0; k8 < 8; ++k8) { c0 += sc0[8 * g + k8] > mid0 ? 1 : 0; c1 += sc1[8 * g + k8] > mid1 ? 1 : 0; } }
                for (int kt = 32; kt < nkt; kt += 8) {
                    f32x2_t t8[8];
#pragma unroll
                    for (int u = 0; u < 8; ++u) t8[u] = scl[(kt + u - 32) * 64];
#pragma unroll
                    for (int u = 0; u < 8; ++u) if (kt + u < nkt) { c0 += t8[u].x > mid0 ? 1 : 0; c1 += t8[u].y > mid1 ? 1 : 0; } }
                c0 = half_sum32i(c0); c1 = half_sum32i(c1);
                if (!fin0) { if (!(mid0 > lo0 && mid0 < hi0)) { fin0 = true; thr0 = hi0; nt0 = 256 - ch0; }
                             else if (c0 == 256) { fin0 = true; thr0 = mid0; nt0 = 0; } else if (c0 > 256) lo0 = mid0; else { hi0 = mid0; ch0 = c0; } }
                if (!fin1) { if (!(mid1 > lo1 && mid1 < hi1)) { fin1 = true; thr1 = hi1; nt1 = 256 - ch1; }
                             else if (c1 == 256) { fin1 = true; thr1 = mid1; nt1 = 0; } else if (c1 > 256) lo1 = mid1; else { hi1 = mid1; ch1 = c1; } }
                if (__all(fin0 && fin1)) break;
            }
            }
            const bool any_tie = __any(nt0 > 0 || nt1 > 0);
            int run0 = 0, run1 = 0; const unsigned below = (1u << rho) - 1u;
#pragma unroll
            for (int kt = 0; kt < 64; ++kt) if (kt < nkt) {
                float v0, v1; if (kt < 32) { v0 = sc0[kt & 31]; v1 = sc1[kt & 31]; } else { const f32x2_t t2 = scl[(kt - 32) * 64]; v0 = t2.x; v1 = t2.y; }
                bool p0 = v0 > thr0, p1 = v1 > thr1;
                if (any_tie) {
                    const bool e0 = nt0 > 0 && v0 == thr0, e1 = nt1 > 0 && v1 == thr1;
                    const unsigned long long be0 = __ballot(e0), be1 = __ballot(e1);
                    const unsigned h0 = (unsigned)(be0 >> (32 * hi)), h1 = (unsigned)(be1 >> (32 * hi));
                    p0 = p0 || (e0 && (run0 + __popc(h0 & below)) < nt0); p1 = p1 || (e1 && (run1 + __popc(h1 & below)) < nt1);
                    run0 += __popc(h0); run1 += __popc(h1);
                }
                const unsigned long long b0 = __ballot(p0), b1 = __ballot(p1);
                if (l == 0) { maskw[(4 * w + 0) * MASK_PITCH + kt] = (unsigned)b0; maskw[(4 * w + 1) * MASK_PITCH + kt] = (unsigned)b1; }
                if (l == 32) { maskw[(4 * w + 2) * MASK_PITCH + kt] = (unsigned)(b0 >> 32); maskw[(4 * w + 3) * MASK_PITCH + kt] = (unsigned)(b1 >> 32); }
            }
        }
        __syncthreads();
        {
            const int g = w >> 1;
            bf16x8 qb[4];
#pragma unroll
            for (int ks = 0; ks < 4; ++ks) qb[ks] = *(const bf16x8*)(Q + (size_t)(m0 + rho) * 512 + w * 64 + 16 * ks + 8 * hi);
            asm volatile("" :: "v"(qb[0]), "v"(qb[1]), "v"(qb[2]), "v"(qb[3]));
            asm volatile("s_waitcnt vmcnt(0)" ::: "memory");
            const unsigned char* ksrc[2]; const unsigned char* vsrc[2];
#pragma unroll
            for (int k = 0; k < 2; ++k) { const int i = (k * 8 + w) * 64 + l; const int r = i >> 5, c = i & 31; ksrc[k] = (const unsigned char*)KB + (size_t)r * 512 + 16 * (c ^ (r & 15));
                const int R = i >> 2, cv = i & 3; vsrc[k] = (const unsigned char*)VT + (size_t)R * vpitch * 2 + 16 * (cv ^ ((R >> 2) & 3)); }
#define KV_STAGE(t_) do { const int bo_ = A_RING2 + ((t_) % 3) * 32768 + w * 1024; \
            __builtin_amdgcn_global_load_lds((const unsigned*)(ksrc[0] + (size_t)(t_) * 16384), (LAS3 unsigned*)(ldsb + bo_), 16, 0, 0); \
            __builtin_amdgcn_global_load_lds((const unsigned*)(ksrc[1] + (size_t)(t_) * 16384), (LAS3 unsigned*)(ldsb + bo_ + 8192), 16, 0, 0); \
            __builtin_amdgcn_global_load_lds((const unsigned*)(vsrc[0] + (size_t)(t_) * 64), (LAS3 unsigned*)(ldsb + bo_ + 16384), 16, 0, 0); \
            __builtin_amdgcn_global_load_lds((const unsigned*)(vsrc[1] + (size_t)(t_) * 64), (LAS3 unsigned*)(ldsb + bo_ + 24576), 16, 0, 0); } while (0)
            f32x16 o0 = {0.f, 0.f, 0.f, 0.f, 0.f, 0.f, 0.f, 0.f, 0.f, 0.f, 0.f, 0.f, 0.f, 0.f, 0.f, 0.f}, o1 = o0; float psum = 0.f;
            const int ksw = rho & 15;
            const int vR0 = g * 64 + rho, vR1 = vR0 + 32; const int vs0 = (vR0 >> 2) & 3, vs1 = (vR1 >> 2) & 3;
            for (int rp3 = 0; rp3 <= PROBE_A3; ++rp3) {
            if (rp3) __syncthreads();
            KV_STAGE(0); if (1 < nkt) KV_STAGE(1);
            for (int kt = 0; kt < nkt; ++kt) {
                if (kt + 1 < nkt) asm volatile("s_waitcnt vmcnt(4) lgkmcnt(0)\n\ts_barrier" ::: "memory"); else asm volatile("s_waitcnt vmcnt(0) lgkmcnt(0)\n\ts_barrier" ::: "memory");
                if (kt + 2 < nkt) KV_STAGE(kt + 2);
                const unsigned char* kbuf = lds + A_RING2 + (kt % 3) * 32768; const unsigned char* vbuf = kbuf + 16384;
                f32x16 st = {0.f, 0.f, 0.f, 0.f, 0.f, 0.f, 0.f, 0.f, 0.f, 0.f, 0.f, 0.f, 0.f, 0.f, 0.f, 0.f};
#pragma unroll
                for (int ks = 0; ks < 4; ++ks) st = MFMA32(*(const bf16x8*)(kbuf + rho * 512 + 16 * ((g * 8 + 2 * ks + hi) ^ ksw)), qb[ks], st);
                unsigned word = need_idx ? maskw[rho * MASK_PITCH + kt] : 0xffffffffu; word >>= 4 * hi; float pr[16];
#pragma unroll
                for (int r = 0; r < 16; ++r) { const float e = __builtin_amdgcn_exp2f(st[r]); pr[r] = ((word >> ((r & 3) + 8 * (r >> 2))) & 1u) ? e : 0.f; psum += pr[r]; }
                union { u32x4 u; bf16x8 v; } pa0, pa1; pa0.u = (u32x4){pg8::cvt_pk_bf16(pr[0], pr[1]), pg8::cvt_pk_bf16(pr[2], pr[3]), pg8::cvt_pk_bf16(pr[4], pr[5]), pg8::cvt_pk_bf16(pr[6], pr[7])}; pa1.u = (u32x4){pg8::cvt_pk_bf16(pr[8], pr[9]), pg8::cvt_pk_bf16(pr[10], pr[11]), pg8::cvt_pk_bf16(pr[12], pr[13]), pg8::cvt_pk_bf16(pr[14], pr[15])};
                union { u32x4 u; bf16x8 v; } vf[2][2];
#pragma unroll
                for (int s2 = 0; s2 < 2; ++s2) { const unsigned char* r0 = vbuf + vR0 * 64 + 8 * hi; const unsigned char* r1 = vbuf + vR1 * 64 + 8 * hi;
                    const u32x2 a0 = *(const u32x2*)(r0 + 16 * ((2 * s2) ^ vs0)), a1 = *(const u32x2*)(r0 + 16 * ((2 * s2 + 1) ^ vs0)), b0 = *(const u32x2*)(r1 + 16 * ((2 * s2) ^ vs1)), b1 = *(const u32x2*)(r1 + 16 * ((2 * s2 + 1) ^ vs1));
                    vf[s2][0].u = (u32x4){a0.x, a0.y, a1.x, a1.y}; vf[s2][1].u = (u32x4){b0.x, b0.y, b1.x, b1.y}; }
                o0 = MFMA32(pa0.v, vf[0][0].v, o0); o0 = MFMA32(pa1.v, vf[1][0].v, o0); o1 = MFMA32(pa0.v, vf[0][1].v, o1); o1 = MFMA32(pa1.v, vf[1][1].v, o1);
            }
            }
#undef KV_STAGE
            psum += __shfl_xor(psum, 32);
            if (hi == 0) lsum[w * 32 + rho] = psum;
            __syncthreads();
#pragma unroll
            for (int r = 0; r < 16; ++r) { const int qr = crow(r, hi); const float inv = 1.0f / lsum[w * 32 + qr];
                bf16* op = O + (size_t)(m0 + qr) * DM + w * 64 + rho;
                op[0] = (bf16)f2bf(o0[r] * inv); op[32] = (bf16)f2bf(o1[r] * inv); }
        }
        __syncthreads();
    }
}

constexpr int XS_PITCH = 168;
__device__ __forceinline__ void p4_rwkv_prep(const Args& a, unsigned char* lds, int tid) {
    unsigned char* ws = a.ws; float* out = a.out;
    const bf16* ZS = (const bf16*)(ws + WS_ZS);
    const bf16* w2t = (const bf16*)(ws + WS_W2T); const bf16* a2t = (const bf16*)(ws + WS_A2T); const bf16* g2t = (const bf16*)(ws + WS_G2T);
    float* OW = (float*)(ws + WS_OW); bf16* OKK = (bf16*)(ws + WS_OKK); bf16* OB = (bf16*)(ws + WS_OB); bf16* OKM = (bf16*)(ws + WS_OKM); bf16* OR_ = (bf16*)(ws + WS_OR); bf16* OV = (bf16*)(ws + WS_OV);
    bf16* G = (bf16*)(out + SC_G); float* BON = (float*)(ws + WS_BONUS);
    const float* mu = a.in[13]; const float* w0 = a.in[14]; const float* a0 = a.in[16]; const float* k_k = a.in[19]; const float* k_a = a.in[20]; const float* r_k = a.in[21]; const float* sh0 = a.in[6];
    bf16* xs = (bf16*)lds;
    const int l = tid & 63, h = __builtin_amdgcn_readfirstlane(tid >> 6), rho = l & 31, hi = l >> 5;
    constexpr int ZP = 3408;
    unsigned char* zt = lds + 16384;
    for (int tile = blockIdx.x; tile < MT / 32; tile += gridDim.x) {
        const int m0 = tile * 32; const bool smp = m0 >= MP;
        const bool tile_first = smp || (m0 & (T_P - 1)) == 0;
        for (int i0 = tid; i0 < 33 * 212; i0 += 4 * 512) {
            u32x4 v[4];
#pragma unroll
            for (int j = 0; j < 4; ++j) { const int idx = i0 + j * 512; if (idx < 33 * 212) { const int r = idx / 212, c = idx - r * 212;
                    if (r == 0 && tile_first) { if (smp) { const float* sp = sh0 + (size_t)((m0 - MP) >> 5) * SHIFTW + 8 * c; const f32x4 a4 = *(const f32x4*)sp, b4 = *(const f32x4*)(sp + 4);
                            v[j] = (u32x4){pk2(a4.x, a4.y), pk2(a4.z, a4.w), pk2(b4.x, b4.y), pk2(b4.z, b4.w)}; } else v[j] = (u32x4){0u, 0u, 0u, 0u}; }
                    else v[j] = *(const u32x4*)(ZS + (size_t)(m0 + r - 1) * SHIFTW + 8 * c); } }
#pragma unroll
            for (int j = 0; j < 4; ++j) { const int idx = i0 + j * 512; if (idx < 33 * 212) { const int r = idx / 212, c = idx - r * 212; *(u32x4*)(zt + r * ZP + 16 * c) = v[j]; } }
        }
        __syncthreads();
        { const int tk = tid >> 4, c0 = (tid & 15) * 10;
          const bf16* zc = (const bf16*)(zt + (tk + 1) * ZP) + 1536 + c0; const bf16* zp = (const bf16*)(zt + tk * ZP) + 1536 + c0;
#pragma unroll
          for (int e = 0; e < 10; ++e) { const int c = c0 + e; const float cur = bf1(zc[e]); const float prev = bf1(zp[e]);
              const float zm = cur + mu[1536 + c] * (prev - cur);
              const float f = __frcp_rn(1.0f + __expf(c < 32 ? -2.0f * zm : -zm));
              const float v = c < 32 ? 2.0f * f - 1.0f : (c < 64 ? zm : f);
              xs[tk * XS_PITCH + c] = (bf16)f2bf(v); } }
        __syncthreads();
        const int m = m0 + rho;
        const bf16* zc = (const bf16*)(zt + (rho + 1) * ZP) + 64 * h + 4 * hi; const bf16* zp = (const bf16*)(zt + rho * ZP) + 64 * h + 4 * hi;
        const float* mu_l = mu + 64 * h + 4 * hi;
        const int pofs = 64 * h + 4 * hi;
#define ZMIX4(dst, co) do { const u32x2 cw = *(const u32x2*)(zc + (co)); const u32x2 pw = *(const u32x2*)(zp + (co)); const f32x4 mu4 = *(const f32x4*)(mu_l + (co)); \
            const float cu[4] = {bflo(cw.x), bfhi(cw.x), bflo(cw.y), bfhi(cw.y)}; const float pv[4] = {bflo(pw.x), bfhi(pw.x), bflo(pw.y), bfhi(pw.y)}; \
            _Pragma("unroll") for (int e = 0; e < 4; ++e) dst[e] = cu[e] + mu4[e] * (pv[e] - cu[e]); } while (0)
        float n2 = 0.f;
#pragma unroll
        for (int ct = 0; ct < 2; ++ct)
#pragma unroll
            for (int grp = 0; grp < 4; ++grp) { const int co = 32 * ct + 8 * grp; float zk[4]; ZMIX4(zk, 512 + co); const f32x4 kk4 = *(const f32x4*)(k_k + pofs + co);
#pragma unroll
                for (int e = 0; e < 4; ++e) { const float kr = zk[e] * kk4[e]; n2 += kr * kr; } }
        n2 += __shfl_xor(n2, 32);
        const float invn = 1.0f / fmaxf(sqrtf(n2), 1e-12f);
        float bon = 0.f;
        asm volatile("" ::: "memory");
#pragma unroll
        for (int ct = 0; ct < 2; ++ct) {
            const f32x16 z16 = {0.f, 0.f, 0.f, 0.f, 0.f, 0.f, 0.f, 0.f, 0.f, 0.f, 0.f, 0.f, 0.f, 0.f, 0.f, 0.f}; f32x16 Dw = z16, Da = z16, Dg = z16;
            const int n = 64 * h + 32 * ct + rho;
            const bf16* xrow = xs + rho * XS_PITCH + 8 * hi;
#pragma unroll
            for (int ks = 0; ks < 2; ++ks) {
                Dw = MFMA32(*(const bf16x8*)(w2t + n * 32 + 16 * ks + 8 * hi), *(const bf16x8*)(xrow + 16 * ks), Dw);
                Da = MFMA32(*(const bf16x8*)(a2t + n * 32 + 16 * ks + 8 * hi), *(const bf16x8*)(xrow + 32 + 16 * ks), Da); }
#pragma unroll
            for (int ks = 0; ks < 6; ++ks) Dg = MFMA32(*(const bf16x8*)(g2t + n * 96 + 16 * ks + 8 * hi), *(const bf16x8*)(xrow + 64 + 16 * ks), Dg);
#pragma unroll
            for (int grp = 0; grp < 4; ++grp) {
                const int co = 32 * ct + 8 * grp;
                float zr[4], zk[4], zv[4]; ZMIX4(zr, co); ZMIX4(zk, 512 + co); ZMIX4(zv, 1024 + co);
                const f32x4 w04 = *(const f32x4*)(w0 + pofs + co), a04 = *(const f32x4*)(a0 + pofs + co), kk4 = *(const f32x4*)(k_k + pofs + co), ka4 = *(const f32x4*)(k_a + pofs + co), rk4 = *(const f32x4*)(r_k + pofs + co);
                float dec[4], km[4], gg[4], kk[4], bb[4];
#pragma unroll
                for (int e = 0; e < 4; ++e) { const int r = 4 * grp + e;
                    const float sg = __frcp_rn(1.0f + __expf(-(w04[e] + Dw[r])));
                    dec[e] = __expf(-0.6065306597126334f * sg);
                    const float aa = __frcp_rn(1.0f + __expf(-(a04[e] + Da[r])));
                    gg[e] = Dg[r];
                    kk[e] = zk[e] * kk4[e] * invn; bb[e] = kk[e] * aa;
                    km[e] = zk[e] * (1.0f + (aa - 1.0f) * ka4[e]);
                    bon += zr[e] * km[e] * rk4[e]; }
                const size_t o = (size_t)m * 512 + pofs + co;
                *(f32x4*)(OW + o) = (f32x4){dec[0], dec[1], dec[2], dec[3]};
                *(u32x2*)(OKK + o) = (u32x2){pk2(kk[0], kk[1]), pk2(kk[2], kk[3])};
                *(u32x2*)(OB + o) = (u32x2){pk2(bb[0], bb[1]), pk2(bb[2], bb[3])};
                *(u32x2*)(OKM + o) = (u32x2){pk2(km[0], km[1]), pk2(km[2], km[3])};
                *(u32x2*)(OR_ + o) = (u32x2){pk2(zr[0], zr[1]), pk2(zr[2], zr[3])};
                *(u32x2*)(OV + o) = (u32x2){pk2(zv[0], zv[1]), pk2(zv[2], zv[3])};
                *(u32x2*)(G + o) = (u32x2){pk2(gg[0], gg[1]), pk2(gg[2], gg[3])};
                asm volatile("" ::: "memory");
            }
        }
#undef ZMIX4
        bon += __shfl_xor(bon, 32);
        if (hi == 0) BON[(size_t)m * 8 + h] = bon;
        __syncthreads();
    }
}

constexpr int SC_CH = 32;
static_assert(WS_OB - WS_OKK == 17 * MiB && WS_OKM - WS_OB == 17 * MiB && WS_OR - WS_OKM == 17 * MiB && WS_OV - WS_OR == 17 * MiB, "operand arrays are equally spaced");
__device__ __forceinline__ void cvt_store8(unsigned char* d, const u32x4 x) {
    *(u32x4*)d = (u32x4){x.x << 16, x.x & 0xffff0000u, x.y << 16, x.y & 0xffff0000u}; *(u32x4*)(d + 16) = (u32x4){x.z << 16, x.z & 0xffff0000u, x.w << 16, x.w & 0xffff0000u};
}
struct StageP {
    static constexpr int STRIDE = 1280 + 64;
    const unsigned char* pw; const unsigned char* pb; int vrow0;
    u32x4 v[25];
    __device__ __forceinline__ void issue(int t0, int lane) {
        const unsigned char* gw = pw + ((size_t)(t0 + (lane >> 4)) * 512) * 4 + 16 * (lane & 15);
#pragma unroll
        for (int j = 0; j < 8; ++j) v[j] = *(const u32x4*)(gw + (size_t)j * 4 * 512 * 4);
        const unsigned char* gb = pb + ((size_t)(t0 + (lane >> 3)) * 512) * 2 + 16 * (lane & 7);
#pragma unroll
        for (int a = 0; a < 4; ++a)
#pragma unroll
            for (int jj = 0; jj < 4; ++jj) v[8 + 4 * a + jj] = *(const u32x4*)(gb + (size_t)a * (17 * MiB) + (size_t)jj * 8 * 512 * 2);
        v[24] = *(const u32x4*)(pb + (size_t)4 * (17 * MiB) + ((size_t)(t0 + (lane >> 1)) * 512) * 2 + 2 * vrow0 + 16 * (lane & 1));
    }
    __device__ __forceinline__ void commit(unsigned char* buf, int lane) const {
        unsigned char* dw = buf + (lane >> 4) * STRIDE + 16 * (lane & 15);
#pragma unroll
        for (int j = 0; j < 8; ++j) *(u32x4*)(dw + j * 4 * STRIDE) = v[j];
        unsigned char* db = buf + (lane >> 3) * STRIDE + 256 + 32 * (lane & 7);
#pragma unroll
        for (int a = 0; a < 4; ++a)
#pragma unroll
            for (int jj = 0; jj < 4; ++jj) cvt_store8(db + a * 256 + jj * 8 * STRIDE, v[8 + 4 * a + jj]);
        cvt_store8(buf + (lane >> 1) * STRIDE + 1280 + 32 * (lane & 1), v[24]);
    }
};
struct StageS {
    static constexpr int STRIDE = 1280 + 256;
    const unsigned char* pw; const unsigned char* pb;
    u32x4 v[7];
    __device__ __forceinline__ void issue(int t0, int lane) {
        const unsigned char* gw = pw + ((size_t)(t0 + (lane >> 4)) * 512) * 4 + 16 * (lane & 15);
        v[0] = *(const u32x4*)gw; v[1] = *(const u32x4*)(gw + (size_t)4 * 512 * 4);
        const unsigned char* gb = pb + ((size_t)(t0 + (lane >> 3)) * 512) * 2 + 16 * (lane & 7);
#pragma unroll
        for (int a = 0; a < 5; ++a) v[2 + a] = *(const u32x4*)(gb + (size_t)a * (17 * MiB));
    }
    __device__ __forceinline__ void commit(unsigned char* buf, int lane) const {
        unsigned char* dw = buf + (lane >> 4) * STRIDE + 16 * (lane & 15);
        *(u32x4*)dw = v[0]; *(u32x4*)(dw + 4 * STRIDE) = v[1];
        unsigned char* db = buf + (lane >> 3) * STRIDE + 256 + 32 * (lane & 7);
#pragma unroll
        for (int a = 0; a < 5; ++a) cvt_store8(db + a * 256, v[2 + a]);
    }
};
typedef float f32x2 __attribute__((ext_vector_type(2)));
template <int STRIDE, bool YLDS> __device__ __forceinline__ void scan_consume(f32x4& S4, const unsigned char* buf, int nst, int ks, int rowl, float* yp, float* ypart) {
    f32x2 Sa = {S4.x, S4.y}, Sb = {S4.z, S4.w};
    for (int s0 = 0; s0 < nst; s0 += 16) {
        float ykeep = 0.f;
#pragma unroll 1
        for (int g = 0; g < 4; ++g) {
            const int kq = ks - 4 * g;
#pragma unroll
            for (int j = 0; j < 4; ++j) {
                const float* p = (const float*)(buf + (s0 + 4 * g + j) * STRIDE) + 4 * ks;
                const f32x2 wa = *(const f32x2*)(p), wb = *(const f32x2*)(p + 2), ka = *(const f32x2*)(p + 64), kb = *(const f32x2*)(p + 66), ba = *(const f32x2*)(p + 128), bb = *(const f32x2*)(p + 130),
                            ma = *(const f32x2*)(p + 192), mb = *(const f32x2*)(p + 194), ra = *(const f32x2*)(p + 256), rb = *(const f32x2*)(p + 258);
                const float v = ((const float*)(buf + (s0 + 4 * g + j) * STRIDE))[320 + rowl];
                f32x2 t = Sa * ka + Sb * kb; float d = t.x + t.y; d = sum16(d);
                const f32x2 vv = {v, v}, dd = {d, d};
                Sa = Sa * wa + (vv * ma - dd * ba); Sb = Sb * wb + (vv * mb - dd * bb);
                f32x2 u = Sa * ra + Sb * rb; float y = u.x + u.y;
                if constexpr (YLDS) ypart[(s0 + 4 * g + j) * 256] = y;
                else { y = sum16(y); ykeep = kq == j ? y : ykeep; }
            }
        }
        if constexpr (!YLDS) yp[(size_t)(s0 + ks) * 512] = ykeep;
    }
    S4 = (f32x4){Sa.x, Sa.y, Sb.x, Sb.y};
}
__device__ __forceinline__ void scan_yreduce(const float* ypart, float* yg, int pt) {
#pragma unroll
    for (int k = 0; k < 2; ++k) { const int o = pt + 256 * k; const f32x4* q = (const f32x4*)(ypart + o * 16);
        const f32x4 a = q[0], b = q[1], c = q[2], d = q[3]; const f32x4 e = (a + b) + (c + d);
        yg[(size_t)(o >> 4) * 512 + (o & 15)] = (e.x + e.y) + (e.z + e.w); }
}
__device__ __forceinline__ void p5_rwkv_scan(const Args& a, unsigned char* lds, int tid) {
    const unsigned char* ws = a.ws; float* out = a.out; float* Y = out + SC_Y;
    const int l = tid & 63, w = __builtin_amdgcn_readfirstlane(tid >> 6), ks = l & 15, rl = l >> 4;
    const int G = gridDim.x, vcu = (G % 8 == 0) ? (blockIdx.x % 8) * (G / 8) + blockIdx.x / 8 : blockIdx.x;
    typedef StageP StP; typedef StageS StS;
    unsigned char* buf0 = lds; unsigned char* buf1 = lds + SC_CH * StP::STRIDE;
    for (int it = vcu; it < 256; it += G) {
        {
            const int bh = it >> 2, b = bh >> 3, h = bh & 7, rb = it & 3, row = 16 * rb + 4 * w + rl;
            const size_t base0 = ((size_t)b * T_P) * 512 + (size_t)h * 64;
            constexpr int NC = T_P / SC_CH;
            StP st; st.pw = ws + WS_OW + base0 * 4; st.pb = ws + WS_OKK + base0 * 2; st.vrow0 = 16 * rb;
            f32x4 S = {0.f, 0.f, 0.f, 0.f};
            if (w >= 4) { if (w == 4) { st.issue(0, l); st.commit(buf0, l); st.issue(4 * SC_CH, l); } else st.issue((w - 4) * SC_CH, l); }
            else __builtin_amdgcn_s_setprio(3);
            __syncthreads();
            Y += base0 + row;
            float* yp0 = (float*)(lds + 2 * SC_CH * StP::STRIDE); float* yp1 = yp0 + SC_CH * 256;
#define SCAN_ITER(c, P, cur, nxt, ypc, ypp) do { if (w >= 4) { if ((c) > 0) scan_yreduce(ypp, Y - row + 16 * rb + (size_t)(((c) - 1) * SC_CH) * 512, tid - 256); \
                    if (w == 4 + (P)) { if ((c) + 1 < NC) { st.commit(nxt, l); if ((c) + 5 < NC) st.issue(((c) + 5) * SC_CH, l); } } } \
                else scan_consume<StP::STRIDE, true>(S, cur, SC_CH, ks, 4 * w + rl, nullptr, ypc + tid); __syncthreads(); } while (0)
            for (int c = 0; c < NC; c += 4) { SCAN_ITER(c, 1, buf0, buf1, yp0, yp1); SCAN_ITER(c + 1, 2, buf1, buf0, yp1, yp0); SCAN_ITER(c + 2, 3, buf0, buf1, yp0, yp1); SCAN_ITER(c + 3, 0, buf1, buf0, yp1, yp0); }
            if (w >= 4) scan_yreduce(yp1, Y - row + 16 * rb + (size_t)((NC - 1) * SC_CH) * 512, tid - 256);
#undef SCAN_ITER
            __builtin_amdgcn_s_setprio(0);
            Y -= base0 + row;
            if (w < 4) *(f32x4*)(out + OFF_WKVP + ((size_t)bh * 64 + row) * 64 + 4 * ks) = S;
        }
        {
            const int b = it >> 3, h = it & 7;
            const size_t base0 = ((size_t)MP + (size_t)b * T_S) * 512 + (size_t)h * 64;
            StS st; st.pw = ws + WS_OW + base0 * 4; st.pb = ws + WS_OKK + base0 * 2;
            if (w >= 4) { st.issue(8 * (w - 4), l); st.commit(buf0 + 8 * (w - 4) * StS::STRIDE, l); }
            __syncthreads();
            for (int pass = 0; pass < 2; ++pass) { const int row = 8 * w + 4 * pass + rl;
                f32x4 S = *(const f32x4*)(a.in[5] + ((size_t)it * 64 + row) * 64 + 4 * ks);
                scan_consume<StS::STRIDE, false>(S, buf0, T_S, ks, row, Y + base0 + row, nullptr);
                *(f32x4*)(out + OFF_WKVS + ((size_t)it * 64 + row) * 64 + 4 * ks) = S; }
            __syncthreads();
        }
    }
}

__device__ __forceinline__ void p6_rwkv_out(const Args& a, int tid) {
    const unsigned char* ws = a.ws; const float* out = a.out; const float* Y = out + SC_Y; const bf16* G = (const bf16*)(out + SC_G);
    const bf16* OV = (const bf16*)(ws + WS_OV); const float* BON = (const float*)(ws + WS_BONUS); bf16* O = (bf16*)(a.ws + WS_XB);
    const float* lg = a.in[22]; const float* lb = a.in[23];
    const int sub = tid & 7;
    const size_t NIT = (size_t)MT * 8, STEP = (size_t)gridDim.x * 64;
    size_t it = (size_t)blockIdx.x * 64 + (tid >> 3);
    f32x4 y0, y1; u32x4 vw, gw_; float bon = 0.f;
#define P6_LOAD(it_) do { const size_t o_ = ((it_) >> 3) * 512 + ((it_) & 7) * 64 + 8 * sub; y0 = *(const f32x4*)(Y + o_); y1 = *(const f32x4*)(Y + o_ + 4); vw = *(const u32x4*)(OV + o_); gw_ = *(const u32x4*)(G + o_); bon = BON[it_]; } while (0)
    if (it < NIT) P6_LOAD(it);
    for (; it < NIT; it += STEP) {
        const size_t m = it >> 3; const int h = (int)(it & 7);
        float y[8] = {y0.x, y0.y, y0.z, y0.w, y1.x, y1.y, y1.z, y1.w}; float v[8], g[8]; unpack8(vw, v); unpack8(gw_, g); const float bn = bon;
        if (it + STEP < NIT) P6_LOAD(it + STEP);
        float s1 = 0.f;
#pragma unroll
        for (int j = 0; j < 8; ++j) s1 += y[j];
        s1 += __shfl_xor(s1, 1); s1 += __shfl_xor(s1, 2); s1 += __shfl_xor(s1, 4);
        const float mean = s1 * (1.f / 64.f); float s2 = 0.f;
#pragma unroll
        for (int j = 0; j < 8; ++j) { const float d = y[j] - mean; s2 += d * d; }
        s2 += __shfl_xor(s2, 1); s2 += __shfl_xor(s2, 2); s2 += __shfl_xor(s2, 4);
        const float rinv = rsqrtf(s2 * (1.f / 64.f) + 64e-5f);
        float r[8];
#pragma unroll
        for (int j = 0; j < 8; ++j) { const int c = h * 64 + 8 * sub + j; r[j] = ((y[j] - mean) * rinv * lg[c] + lb[c] + bn * v[j]) * g[j]; }
        *(u32x4*)(O + m * DM + 512 + h * 64 + 8 * sub) = pack8(r);
    }
#undef P6_LOAD
}

__device__ __forceinline__ void p8_hnorm(const Args& a, int tid) {
    const int lane = tid & 63, gw = blockIdx.x * 8 + (tid >> 6), NGW = gridDim.x * 8;
    for (int m = gw; m < MT; m += NGW) {
        const f32x4* xr = (const f32x4*)(a.out + OFF_Y + (size_t)m * DM) + lane; f32x4 v[4]; float s = 0.f;
#pragma unroll
        for (int j = 0; j < 4; ++j) { v[j] = xr[64 * j]; s += (v[j].x * v[j].x + v[j].y * v[j].y) + (v[j].z * v[j].z + v[j].w * v[j].w); }
        const float rs = rsqrtf(wave_sum(s) * (1.f / DM) + 1e-6f);
        u32x2* o8 = (u32x2*)((bf16*)(a.ws + WS_HB) + (size_t)m * DM) + lane;
#pragma unroll
        for (int j = 0; j < 4; ++j) { u32x2 o; o.x = pk2(v[j].x * rs, v[j].y * rs); o.y = pk2(v[j].z * rs, v[j].w * rs); o8[64 * j] = o; }
    }
}

#define XB_TMO      128
#define XB_XCNT(j)  (256  + 64 * (j))
#define XB_XSUB(j)  (1280 + 64 * (j))
#define XB_XGEN(j)  (2304 + 64 * (j))
#define XB_TOP      3328
#define XB_TOPGEN   3392
#define XCD_BAR_WORDS 3456
#define XB_SPIN_CAP (1u << 18)

__device__ __forceinline__ unsigned xb_ld(unsigned* p)              { return __hip_atomic_load(p, __ATOMIC_RELAXED, __HIP_MEMORY_SCOPE_AGENT); }
__device__ __forceinline__ unsigned xb_add(unsigned* p, unsigned v) { return __hip_atomic_fetch_add(p, v, __ATOMIC_RELAXED, __HIP_MEMORY_SCOPE_AGENT); }
__device__ __forceinline__ unsigned xb_xcc_id() { return (unsigned)__builtin_amdgcn_s_getreg((3 << 11) | 20) & 0xFu; }
#define XB_SPIN(cond, bar) do { unsigned _sp = 0; while (cond) { __builtin_amdgcn_s_sleep(1); \
    if ((++_sp & 255u) == 0u) { if (xb_ld(&(bar)[XB_TMO])) break; if (_sp > XB_SPIN_CAP) { atomicAdd(&(bar)[XB_TMO], 1u); break; } } } } while (0)

struct XcdBarrier {
    unsigned* bar; unsigned x;
    volatile __attribute__((address_space(3))) unsigned* st;
};

__device__ __forceinline__ XcdBarrier xcd_barrier_post(unsigned* bar, volatile __attribute__((address_space(3))) unsigned* st) {
    XcdBarrier b; b.bar = bar; b.x = xb_xcc_id(); b.st = st;
    if (threadIdx.x == 0) (void)xb_add(&bar[XB_XCNT(b.x)], 1u);
    return b;
}
__device__ __forceinline__ void xcd_barrier_complete(unsigned* bar, unsigned x, unsigned& nloc, unsigned& nx) {
    const unsigned G = gridDim.x * gridDim.y * gridDim.z;
    unsigned sum, cnt, mine, sp = 0u;
    for (;;) {
        sum = 0u; cnt = 0u; mine = 0u;
#pragma unroll
        for (unsigned j = 0; j < 16; ++j) { const unsigned c = xb_ld(&bar[XB_XCNT(j)]); sum += c; cnt += (c > 0u) ? 1u : 0u; mine = (j == x) ? c : mine; }
        if (sum == G) break;
        __builtin_amdgcn_s_sleep(1);
        if ((++sp & 255u) == 0u) { if (xb_ld(&bar[XB_TMO])) break; if (sp > XB_SPIN_CAP) { atomicAdd(&bar[XB_TMO], 1u); break; } }
    }
    nloc = mine > 0u ? mine : 1u; nx = cnt > 0u ? cnt : 1u;
}

__device__ __forceinline__ void xcd_barrier(const XcdBarrier& b) {
    asm volatile("s_waitcnt vmcnt(0)" ::: "memory");
    __syncthreads();
    if (threadIdx.x == 0) {
        unsigned* bar = b.bar;
        __builtin_amdgcn_s_waitcnt(0);
        unsigned nloc = b.st[0], nx = b.st[1];
        if (nloc == 0u) { xcd_barrier_complete(bar, b.x, nloc, nx); b.st[0] = nloc; b.st[1] = nx; }
        const unsigned old = xb_add(&bar[XB_XSUB(b.x)], 1u);
        const unsigned gen = old / nloc;
        if (old + 1u == (gen + 1u) * nloc) {
            __builtin_amdgcn_fence(__ATOMIC_RELEASE, "agent");
            asm volatile("s_waitcnt vmcnt(0)" ::: "memory");
            const unsigned og = xb_add(&bar[XB_TOP], 1u);
            const unsigned tg = og / nx;
            if (og + 1u == (tg + 1u) * nx) xb_add(&bar[XB_TOPGEN], 1u);
            else XB_SPIN(xb_ld(&bar[XB_TOPGEN]) == tg, bar);
            __builtin_amdgcn_fence(__ATOMIC_ACQUIRE, "agent");
            xb_add(&bar[XB_XGEN(b.x)], 1u);
            asm volatile("s_waitcnt vmcnt(0)" ::: "memory");
        } else {
            XB_SPIN(xb_ld(&bar[XB_XGEN(b.x)]) == gen, bar);
            __builtin_amdgcn_fence(__ATOMIC_ACQUIRE, "agent");
            asm volatile("s_waitcnt vmcnt(0)" ::: "memory");
        }
    }
    __syncthreads();
}

constexpr int CW_BAR = 4096;
constexpr int LDS_BYTES = 163840;
constexpr int N_PHASES = 12;
#ifndef PROBE_MASK
#define PROBE_MASK 0
#endif
template <int PH> __device__ __forceinline__ void run_phase(const Args& args, unsigned char* lds, int tid, int rep) {
    unsigned char* ws = args.ws;
    if constexpr (PH == 0) p0_prologue(args, lds, tid);
    if constexpr (PH == 1) { pg8::Gemm g{(const pg8::bf16_t*)(ws + WS_XB), (const pg8::bf16_t*)(ws + WS_WIN), MT, NZ, DM, DM}; pg8::StaticOrder S; S.init(MT, NZ, gridDim.x, blockIdx.x);
        pg8::EpiZ E{(pg8::bf16_t*)(ws + WS_ZR), (pg8::bf16_t*)(ws + WS_ZS)};
        pg8::gemm_phase<pg8::EpiZ, pg8::StaticOrder, true, true>((PG8_LAS unsigned char*)lds, g, S, E); }
    if constexpr (PH == 2) p2_post(args, lds, tid);
    if constexpr (PH == 3) p3_attention(args, lds, tid, rep);
    if constexpr (PH == 4) p4_rwkv_prep(args, lds, tid);
    if constexpr (PH == 5) p5_rwkv_scan(args, lds, tid);
    if constexpr (PH == 6) p6_rwkv_out(args, tid);
    if constexpr (PH == 7) { pg8::Gemm g{(const pg8::bf16_t*)(ws + WS_XB), (const pg8::bf16_t*)(ws + WS_WOUT), MT, DM, DM, DM}; pg8::StaticOrder S; S.init(MT, DM, gridDim.x, blockIdx.x);
        pg8::EpiH E{args.in[0], args.in[1], args.out + OFF_Y, (pg8::bf16_t*)(ws + WS_HB), (float*)(ws + WS_CTL) + CW_SS};
        pg8::gemm_phase<pg8::EpiH, pg8::StaticOrder, true, true>((PG8_LAS unsigned char*)lds, g, S, E); }
    if constexpr (PH == 9) { pg8::Gemm g{(const pg8::bf16_t*)(ws + WS_HB), (const pg8::bf16_t*)(ws + WS_W1), MT, DFF, DM, DM}; pg8::StaticOrder S; S.init(MT, DFF, gridDim.x, blockIdx.x);
        pg8::EpiAct E{(pg8::bf16_t*)(ws + WS_ACT), DFF, (const float*)(ws + WS_CTL) + CW_SS};
        pg8::gemm_phase<pg8::EpiAct, pg8::StaticOrder, true, true>((PG8_LAS unsigned char*)lds, g, S, E); }
    if constexpr (PH == 10) {
        { pg8::Gemm g{(const pg8::bf16_t*)(ws + WS_ACT), (const pg8::bf16_t*)(ws + WS_W2), MP, DM, DFF, DFF}; pg8::StaticOrder S; S.init(MP, DM, gridDim.x, blockIdx.x);
          pg8::EpiY E{args.out + OFF_Y};
          pg8::gemm_phase<pg8::EpiY, pg8::StaticOrder, true, true>((PG8_LAS unsigned char*)lds, g, S, E); }
        { const int c = blockIdx.x; pg8::OneUnit S; S.has = c < 64; S.u.pm = MP / 256 + (c >> 4); S.u.pn = (c >> 2) & 3; const int sl = c & 3;
          pg8::Gemm g{(const pg8::bf16_t*)(ws + WS_ACT) + sl * 1024, (const pg8::bf16_t*)(ws + WS_W2) + sl * 1024, MT, DM, DFF, 1024};
          pg8::EpiSlab E{(float*)(ws + WS_HB) + (size_t)sl * MS * DM};
          __syncthreads();
          pg8::gemm_phase<pg8::EpiSlab, pg8::OneUnit, false, true>((PG8_LAS unsigned char*)lds, g, S, E); }
    }
    if constexpr (PH == 11) {
        const f32x4* sl = (const f32x4*)(ws + WS_HB); f32x4* y = (f32x4*)(args.out + OFF_Y + (size_t)MP * DM); constexpr int NV = MS * DM / 4;
        for (int i = blockIdx.x * 512 + tid; i < NV; i += gridDim.x * 512) y[i] = y[i] + ((sl[i] + sl[i + NV]) + (sl[i + 2 * NV] + sl[i + 3 * NV]));
    }
}
#ifndef MK_ONE_LAUNCH
#define MK_ONE_LAUNCH 1
#endif
#if MK_ONE_LAUNCH
__global__ void __launch_bounds__(512, 2) mk_fwd(Args args) {
    extern __shared__ __attribute__((aligned(16))) unsigned char lds[];
    const int tid = threadIdx.x;
    volatile __attribute__((address_space(3))) unsigned* bst = (volatile __attribute__((address_space(3))) unsigned*)((__attribute__((address_space(3))) unsigned char*)lds + LDS_BYTES - 16);
    if (tid < 2) bst[tid] = 0u;
    __syncthreads();
    const XcdBarrier bar = xcd_barrier_post((unsigned*)(args.ws + WS_CTL) + CW_BAR, bst);
#define SEAM(k) do { if ((k) == 1) { __syncthreads(); cg::this_grid().sync(); } else xcd_barrier(bar); } while (0)
#define PHASE(k) do { if (args.ph_lo <= (k) && (k) < args.ph_hi) { if ((k) > args.ph_lo) SEAM(k); run_phase<k>(args, lds, tid, 0); \
        if ((PROBE_MASK >> (k)) & 1) { xcd_barrier(bar); run_phase<k>(args, lds, tid, 1); } } } while (0)
    PHASE(0); PHASE(1); PHASE(2); PHASE(3); PHASE(4); PHASE(5); PHASE(6); PHASE(7); PHASE(9); PHASE(10); PHASE(11);
#undef PHASE
#undef SEAM
}
#else
template <int PH> __global__ void __launch_bounds__(512, 2) mk_phase(Args args) {
    extern __shared__ __attribute__((aligned(16))) unsigned char lds[];
    run_phase<PH>(args, lds, threadIdx.x, 0);
}
#endif

extern "C" void kernel_launch(void* const* d_in, const int* in_sizes, int n_in, void* d_out, int out_size, void* d_ws, size_t ws_size, hipStream_t stream) {
    static int grid = 0;
    if (grid == 0) {
        if (n_in != 28 || out_size != (int)OUT_TOTAL || ws_size < WS_END) { fprintf(stderr, "kernel_launch: unexpected shapes (n_in %d, out %d, ws %zu)\n", n_in, out_size, ws_size); grid = -1; return; }
        int dev = 0, cus = 0, per_cu = 0;
        (void)hipGetDevice(&dev); (void)hipDeviceGetAttribute(&cus, hipDeviceAttributeMultiprocessorCount, dev);
#if MK_ONE_LAUNCH
        if (hipFuncSetAttribute((const void*)mk_fwd, hipFuncAttributeMaxDynamicSharedMemorySize, LDS_BYTES) != hipSuccess) { fprintf(stderr, "kernel_launch: hipFuncSetAttribute failed\n"); grid = -1; return; }
        (void)hipOccupancyMaxActiveBlocksPerMultiprocessor(&per_cu, (const void*)mk_fwd, 512, LDS_BYTES);
        (void)hipGetLastError();
        if (per_cu < 1) { fprintf(stderr, "kernel_launch: occupancy query says %d blocks per CU\n", per_cu); per_cu = 1; }
#else
#define SETATTR(k) (void)hipFuncSetAttribute((const void*)mk_phase<k>, hipFuncAttributeMaxDynamicSharedMemorySize, LDS_BYTES)
        SETATTR(0); SETATTR(1); SETATTR(2); SETATTR(3); SETATTR(4); SETATTR(5); SETATTR(6); SETATTR(7); SETATTR(8); SETATTR(9); SETATTR(10); SETATTR(11);
#undef SETATTR
        (void)per_cu;
#endif
        grid = cus;
    }
    if (grid < 0) return;
    (void)hipMemsetAsync((char*)d_ws + WS_CTL, 0, CTL_BYTES, stream);
    Args a{};
    for (int i = 0; i < 28; ++i) a.in[i] = (const float*)d_in[i];
    a.out = (float*)d_out; a.ws = (unsigned char*)d_ws;
#if MK_ONE_LAUNCH
    a.ph_lo = 0; a.ph_hi = N_PHASES;
    void* kargs[] = {&a};
    hipError_t e = hipLaunchCooperativeKernel((const void*)mk_fwd, dim3(grid), dim3(512), kargs, LDS_BYTES, stream);
    if (e != hipSuccess) fprintf(stderr, "kernel_launch: cooperative launch failed: %s (grid %d)\n", hipGetErrorString(e), grid);
#else
#define LAUNCH(k) hipLaunchKernelGGL(mk_phase<k>, dim3(grid), dim3(512), LDS_BYTES, stream, a)
    a.ph_lo = 0; a.ph_hi = N_PHASES;
    LAUNCH(0); LAUNCH(1); LAUNCH(2); LAUNCH(3); LAUNCH(4); LAUNCH(5); LAUNCH(6); LAUNCH(7); LAUNCH(9); LAUNCH(10); LAUNCH(11);
#undef LAUNCH
#endif
}
```

```cpp
#include <hip/hip_runtime.h>
#include <hip/hip_cooperative_groups.h>
#include <cstdio>
#include <cstdint>
namespace cg = cooperative_groups;
#define PROBE_A1 0
#define PROBE_A2 0
#define PROBE_A3 0
namespace pg8 {
#define PG8_LAS __attribute__((address_space(3)))
typedef unsigned short bf16_t;
typedef short bf16x8 __attribute__((ext_vector_type(8)));
typedef float f32x4 __attribute__((ext_vector_type(4)));
typedef unsigned u32x4 __attribute__((ext_vector_type(4)));
constexpr int BM = 256, BK = 64, HALF = 128, HTB = HALF * BK * 2  , STAGE_BYTES = 8 * HTB, NXCD = 8, WGM = 8;

__host__ __device__ __forceinline__ int lds_byte(int r, int c) { const int st = (r >> 4) * 2 + (c >> 5), rr = r & 15, cc = c & 31, ob = rr * 64 + cc * 2; return st * 1024 + (ob ^ (((ob >> 9) & 1) << 5)); }
__host__ __device__ __forceinline__ void stage_rc(int b, int& R, int& C) { const int st = b / 1024, sb = b % 1024, swz = sb ^ (((sb >> 9) & 1) << 5); R = (st >> 1) * 16 + swz / 64; C = (st & 1) * 32 + (swz % 64) / 2; }
__host__ __device__ __forceinline__ int perm32(int rho) { const int n = rho >> 4, i = rho & 15; return 8 * (i >> 2) + 4 * n + (i & 3); }

struct Unit { int pm, pn; };
struct Gemm { const bf16_t* A; const bf16_t* Bt; int M, N, K, KL; };

struct StaticOrder {
    int nM, nN, nwg, G, c;
    __host__ __device__ void init(int M, int N, int G_, int c_) { nM = M / BM; nN = N / BM; nwg = nM * nN; G = G_; c = c_; }
    __host__ __device__ bool next(int i, Unit& u) const {
        const long L = (long)i * G + c; if (L >= nwg) return false;
        int wgid = (int)L; { const int q = nwg / NXCD, r = nwg % NXCD, xcd = wgid % NXCD, off = wgid / NXCD; wgid = (xcd < r ? xcd * (q + 1) : r * (q + 1) + (xcd - r) * q) + off; }
        const int nig = WGM * nN, gid = wgid / nig, fm = gid * WGM, gsz = (nM - fm) < WGM ? (nM - fm) : WGM;
        u.pm = fm + ((wgid % nig) % gsz); u.pn = (wgid % nig) / gsz; return true;
    }
    __device__ __forceinline__ void a_ready(const Unit&) const {}
    __device__ __forceinline__ void done(const Unit&) const {}
};


__device__ __forceinline__ unsigned cvt_pk_bf16(float lo, float hi) { unsigned r; asm volatile("v_cvt_pk_bf16_f32 %0, %1, %2" : "=v"(r) : "v"(lo), "v"(hi)); return r; }

constexpr int E_MP = 16384;
constexpr int E_ZRW = 1632, E_ZSW = 1696;

struct OneUnit { Unit u; bool has;
    __device__ __forceinline__ bool next(int i, Unit& o) const { if (i == 0 && has) { o = u; return true; } return false; }
    __device__ __forceinline__ void a_ready(const Unit&) const {}
    __device__ __forceinline__ void done(const Unit&) const {} };
struct EpiZ {
    static constexpr bool PERM = true, AFTER_DRAIN = false;
    bf16_t* ZR; bf16_t* ZS;
    __device__ __forceinline__ void operator()(const f32x4 (&acc)[2][2][4][2], const Unit& u, int wr, int wc, int fr, int fq) const {
        const int row0 = u.pm * BM + wr * 64 + fr, c0 = u.pn * BM + wc * 32 + 8 * fq;
#pragma unroll
        for (int ai = 0; ai < 2; ++ai)
#pragma unroll
            for (int m = 0; m < 4; ++m) { const size_t row = (size_t)(row0 + ai * HALF + m * 16);
#pragma unroll
                for (int bj = 0; bj < 2; ++bj) { const int c = c0 + bj * HALF; bf16_t* dst;
                    if (c < 1600) dst = ZR + row * E_ZRW + c; else if (c < 3296) dst = ZS + row * E_ZSW + (c - 1600); else if (c == 3296) dst = ZR + row * E_ZRW + 1600; else continue;
                    const f32x4 v0 = acc[ai][bj][m][0], v1 = acc[ai][bj][m][1]; u32x4 w;
                    w.x = cvt_pk_bf16(v0[0], v0[1]); w.y = cvt_pk_bf16(v0[2], v0[3]); w.z = cvt_pk_bf16(v1[0], v1[1]); w.w = cvt_pk_bf16(v1[2], v1[3]);
                    *(u32x4*)dst = w; } }
    }
};
struct EpiH {
    static constexpr bool PERM = false, AFTER_DRAIN = false;
    const float* xp; const float* xs; float* H; bf16_t* HB; float* SS;
    __device__ __forceinline__ void operator()(const f32x4 (&acc)[2][2][4][2], const Unit& u, int wr, int wc, int fr, int fq) const {
        const int row0 = u.pm * BM + wr * 64 + fr, col0 = u.pn * BM + wc * 32 + 4 * fq;
#pragma unroll
        for (int ai = 0; ai < 2; ++ai)
#pragma unroll
            for (int m = 0; m < 4; ++m) { const int row = row0 + ai * HALF + m * 16;
                const float* xr = (row < E_MP ? xp + (size_t)row * 1024 : xs + (size_t)(row - E_MP) * 1024) + col0; float* hr = H + (size_t)row * 1024 + col0; bf16_t* hb = HB + (size_t)row * 1024 + col0;
                float ss = 0.f;
#pragma unroll
                for (int bj = 0; bj < 2; ++bj)
#pragma unroll
                    for (int n = 0; n < 2; ++n) { const f32x4 h = *(const f32x4*)(xr + bj * HALF + n * 16) + acc[ai][bj][m][n]; *(f32x4*)(hr + bj * HALF + n * 16) = h;
                        ss += (h[0] * h[0] + h[1] * h[1]) + (h[2] * h[2] + h[3] * h[3]);
                        unsigned w0 = cvt_pk_bf16(h[0], h[1]), w1 = cvt_pk_bf16(h[2], h[3]); typedef unsigned u32x2v __attribute__((ext_vector_type(2))); *(u32x2v*)(hb + bj * HALF + n * 16) = (u32x2v){w0, w1}; }
                ss += __shfl_xor(ss, 16); ss += __shfl_xor(ss, 32);
                if (fq == 0) atomicAdd(SS + row, ss); }
    }
};
struct EpiAct {
    static constexpr bool PERM = true, AFTER_DRAIN = false;
    bf16_t* O; int ldc; const float* SS;
    __device__ __forceinline__ void operator()(const f32x4 (&acc)[2][2][4][2], const Unit& u, int wr, int wc, int fr, int fq) const {
        const int row0 = u.pm * BM + wr * 64 + fr, c0 = u.pn * BM + wc * 32 + 8 * fq;
#pragma unroll
        for (int ai = 0; ai < 2; ++ai)
#pragma unroll
            for (int m = 0; m < 4; ++m) { const int row = row0 + ai * HALF + m * 16; bf16_t* rowp = O + (size_t)row * ldc + c0;
                const float rs = rsqrtf(SS[row] * (1.0f / 1024.0f) + 1e-6f);
#pragma unroll
                for (int bj = 0; bj < 2; ++bj) { f32x4 v0 = acc[ai][bj][m][0], v1 = acc[ai][bj][m][1];
#pragma unroll
                    for (int e = 0; e < 4; ++e) { const float a = fmaxf(v0[e], 0.f) * rs, b = fmaxf(v1[e], 0.f) * rs; v0[e] = a * a; v1[e] = b * b; }
                    u32x4 w; w.x = cvt_pk_bf16(v0[0], v0[1]); w.y = cvt_pk_bf16(v0[2], v0[3]); w.z = cvt_pk_bf16(v1[0], v1[1]); w.w = cvt_pk_bf16(v1[2], v1[3]);
                    *(u32x4*)(rowp + bj * HALF) = w; } }
    }
};
struct EpiSlab {
    static constexpr bool PERM = false, AFTER_DRAIN = false;
    float* S;
    __device__ __forceinline__ void operator()(const f32x4 (&acc)[2][2][4][2], const Unit& u, int wr, int wc, int fr, int fq) const {
        const int row0 = u.pm * BM - E_MP + wr * 64 + fr, col0 = u.pn * BM + wc * 32 + 4 * fq;
#pragma unroll
        for (int ai = 0; ai < 2; ++ai)
#pragma unroll
            for (int m = 0; m < 4; ++m) { float* yr = S + (size_t)(row0 + ai * HALF + m * 16) * 1024 + col0;
#pragma unroll
                for (int bj = 0; bj < 2; ++bj)
#pragma unroll
                    for (int n = 0; n < 2; ++n) *(f32x4*)(yr + bj * HALF + n * 16) = acc[ai][bj][m][n]; }
    }
};
struct EpiY {
    static constexpr bool PERM = false, AFTER_DRAIN = false;
    float* Y;
    __device__ __forceinline__ void operator()(const f32x4 (&acc)[2][2][4][2], const Unit& u, int wr, int wc, int fr, int fq) const {
        const int row0 = u.pm * BM + wr * 64 + fr, col0 = u.pn * BM + wc * 32 + 4 * fq;
#pragma unroll
        for (int ai = 0; ai < 2; ++ai)
#pragma unroll
            for (int m = 0; m < 4; ++m) { float* yr = Y + (size_t)(row0 + ai * HALF + m * 16) * 1024 + col0;
#pragma unroll
                for (int bj = 0; bj < 2; ++bj)
#pragma unroll
                    for (int n = 0; n < 2; ++n) { f32x4* p = (f32x4*)(yr + bj * HALF + n * 16); *p = *p + acc[ai][bj][m][n]; } }
    }
};

template <class Epi, class Sched, bool ALIGN_EPI = false, bool SP2 = false>
__device__ __forceinline__ void gemm_phase(PG8_LAS unsigned char* lds, const Gemm g, const Sched& S, const Epi& E) {
    const int tid = threadIdx.x, wid = __builtin_amdgcn_readfirstlane(tid >> 6), lane = tid & 63, wr = wid >> 2, wc = wid & 3, fr = lane & 15, fq = lane >> 4;
    const int K = g.K, nt = g.KL / BK;
    unsigned voffA[2], voffB[2];
#pragma unroll
    for (int i = 0; i < 2; ++i) { int R, C; stage_rc(tid * 16 + i * 8192, R, C); const int Rb = Epi::PERM ? ((R & ~31) + perm32(R & 31)) : R;
        voffA[i] = (unsigned)(R * K + C) * 2u; voffB[i] = (unsigned)(Rb * K + C) * 2u; }
    const size_t kstep = (size_t)(BK * 2);
    const size_t hstep = (size_t)HALF * K * 2;
    const size_t tstep = 2 * hstep;
    const unsigned ldsw = (unsigned)wid * 1024u;
    const int aoff = lds_byte(wr * 64 + fr, fq * 8), boff = lds_byte(wc * 32 + fr, fq * 8);
#define PG8_SA(b, h) (((b) * 2 + (h)) * HTB)
#define PG8_SB(b, h) ((4 + (b) * 2 + (h)) * HTB)
#define PG8_STAGE(bufoff, gbase, voff) do { _Pragma("unroll") for (int _i = 0; _i < 2; ++_i) \
        __builtin_amdgcn_global_load_lds((const unsigned*)((const char*)(gbase) + (voff)[_i]), (PG8_LAS unsigned*)(lds + (bufoff) + ldsw + _i * 8192), 16, 0, 0); } while (0)
#define PG8_LDA(dst, b, h) do { _Pragma("unroll") for (int m = 0; m < 4; ++m) _Pragma("unroll") for (int k = 0; k < 2; ++k) dst[m][k] = *(const PG8_LAS bf16x8*)(lds + PG8_SA(b, h) + aoff + m * 2048 + k * 1024); } while (0)
#define PG8_LDB(dst, b, h) do { _Pragma("unroll") for (int n = 0; n < 2; ++n) _Pragma("unroll") for (int k = 0; k < 2; ++k) dst[n][k] = *(const PG8_LAS bf16x8*)(lds + PG8_SB(b, h) + boff + n * 2048 + k * 1024); } while (0)
#define PG8_MMA(ai, bj, At, Bt) do { __builtin_amdgcn_s_setprio(1); _Pragma("unroll") for (int m = 0; m < 4; ++m) _Pragma("unroll") for (int n = 0; n < 2; ++n) _Pragma("unroll") for (int k = 0; k < 2; ++k) \
        acc[ai][bj][m][n] = __builtin_amdgcn_mfma_f32_16x16x32_bf16(Bt[n][k], At[m][k], acc[ai][bj][m][n], 0, 0, 0); __builtin_amdgcn_s_setprio(0); } while (0)
#define PG8_WAIT_V(n) asm volatile("s_waitcnt vmcnt(" #n ")" ::: "memory")
#define PG8_WAIT_L(n) asm volatile("s_waitcnt lgkmcnt(" #n ")" ::: "memory")
#define PG8_BAR __builtin_amdgcn_s_barrier()
#define PG8_SCHED __builtin_amdgcn_sched_barrier(0)
    Unit cur, nxt; int ui = 0;
    if (!S.next(0, cur)) return;
    f32x4 acc[2][2][4][2];
#pragma unroll
    for (int a = 0; a < 2; ++a)
#pragma unroll
        for (int b = 0; b < 2; ++b)
#pragma unroll
            for (int m = 0; m < 4; ++m)
#pragma unroll
                for (int n = 0; n < 2; ++n) acc[a][b][m][n] = (f32x4){0.f, 0.f, 0.f, 0.f};
    bf16x8 At[4][2], B0[2][2], B1[2][2];
    const char* cA = (const char*)g.A + (size_t)cur.pm * tstep; const char* cB = (const char*)g.Bt + (size_t)cur.pn * tstep;
    S.a_ready(cur);
    if constexpr (SP2) {
        PG8_STAGE(PG8_SB(0, 0), cB, voffB); PG8_STAGE(PG8_SB(0, 1), cB + hstep, voffB); PG8_STAGE(PG8_SA(0, 0), cA, voffA); PG8_STAGE(PG8_SA(0, 1), cA + hstep, voffA);
        if (wr == 1) PG8_BAR;
        PG8_WAIT_V(2); PG8_BAR;
        PG8_STAGE(PG8_SB(1, 0), cB + kstep, voffB); PG8_STAGE(PG8_SA(1, 0), cA + kstep, voffA); PG8_STAGE(PG8_SB(1, 1), cB + hstep + kstep, voffB);
        PG8_WAIT_V(6); PG8_BAR;
    } else {
        PG8_STAGE(PG8_SB(0, 0), cB, voffB); PG8_STAGE(PG8_SA(0, 0), cA, voffA); PG8_STAGE(PG8_SB(0, 1), cB + hstep, voffB); PG8_STAGE(PG8_SA(0, 1), cA + hstep, voffA);
        if (wr == 1) PG8_BAR;
        PG8_WAIT_V(4); PG8_BAR;
        PG8_STAGE(PG8_SB(1, 0), cB + kstep, voffB); PG8_STAGE(PG8_SA(1, 0), cA + kstep, voffA); PG8_STAGE(PG8_SB(1, 1), cB + hstep + kstep, voffB);
        PG8_WAIT_V(6); PG8_BAR;
    }
    for (;;) {
        const bool has_next = S.next(ui + 1, nxt);
        const char* nA = has_next ? (const char*)g.A + (size_t)nxt.pm * tstep : cA; const char* nB = has_next ? (const char*)g.Bt + (size_t)nxt.pn * tstep : cB;
        for (int t = 0; t < nt; t += 2) {
            const bool last = (t == nt - 2);
            const char* a1 = cA + (size_t)(t + 1) * kstep;
            const char* a2 = last ? nA : cA + (size_t)(t + 2) * kstep; const char* b2 = last ? nB : cB + (size_t)(t + 2) * kstep;
            const char* a3 = a2 + kstep; const char* b3 = b2 + kstep;
            if (last && has_next) S.a_ready(nxt);
            if constexpr (SP2) {
            PG8_LDB(B0, 0, 0); PG8_LDB(B1, 0, 1); PG8_SCHED; PG8_LDA(At, 0, 0); PG8_STAGE(PG8_SA(1, 1), a1 + hstep, voffA);
            PG8_WAIT_V(8); PG8_WAIT_L(0); PG8_BAR; PG8_MMA(0, 0, At, B0); PG8_MMA(0, 1, At, B1); PG8_BAR; PG8_SCHED;
            PG8_LDA(At, 0, 1); PG8_STAGE(PG8_SB(0, 0), b2, voffB); PG8_STAGE(PG8_SB(0, 1), b2 + hstep, voffB); PG8_STAGE(PG8_SA(0, 0), a2, voffA);
            PG8_WAIT_V(8); PG8_WAIT_L(0); PG8_BAR; PG8_MMA(1, 0, At, B0); PG8_MMA(1, 1, At, B1); PG8_BAR; PG8_SCHED;
            PG8_LDB(B0, 1, 0); PG8_LDB(B1, 1, 1); PG8_SCHED; PG8_LDA(At, 1, 0); PG8_STAGE(PG8_SA(0, 1), a2 + hstep, voffA);
            PG8_WAIT_V(8); PG8_WAIT_L(0); PG8_BAR; PG8_MMA(0, 0, At, B0); PG8_MMA(0, 1, At, B1); PG8_BAR; PG8_SCHED;
            PG8_LDA(At, 1, 1); PG8_STAGE(PG8_SB(1, 0), b3, voffB); PG8_STAGE(PG8_SB(1, 1), b3 + hstep, voffB); PG8_STAGE(PG8_SA(1, 0), a3, voffA);
            PG8_WAIT_V(8); PG8_WAIT_L(0); PG8_BAR; PG8_MMA(1, 0, At, B0); PG8_MMA(1, 1, At, B1); PG8_BAR; PG8_SCHED;
            } else {
            PG8_LDB(B0, 0, 0); PG8_SCHED; PG8_LDA(At, 0, 0); PG8_STAGE(PG8_SA(1, 1), a1 + hstep, voffA);
            PG8_WAIT_L(8); PG8_BAR; PG8_WAIT_L(0); PG8_MMA(0, 0, At, B0); PG8_BAR; PG8_SCHED;
            PG8_LDB(B1, 0, 1); PG8_STAGE(PG8_SB(0, 0), b2, voffB);
            PG8_BAR; PG8_WAIT_L(0); PG8_MMA(0, 1, At, B1); PG8_BAR;
            PG8_LDA(At, 0, 1); PG8_STAGE(PG8_SA(0, 0), a2, voffA);
            PG8_BAR; PG8_WAIT_L(0); PG8_MMA(1, 0, At, B0); PG8_BAR; PG8_SCHED;
            PG8_STAGE(PG8_SB(0, 1), b2 + hstep, voffB);
            PG8_WAIT_V(6); PG8_BAR; PG8_MMA(1, 1, At, B1); PG8_BAR;
            PG8_LDB(B0, 1, 0); PG8_SCHED; PG8_LDA(At, 1, 0); PG8_STAGE(PG8_SA(0, 1), a2 + hstep, voffA);
            PG8_WAIT_L(8); PG8_BAR; PG8_WAIT_L(0); PG8_MMA(0, 0, At, B0); PG8_BAR; PG8_SCHED;
            PG8_LDB(B1, 1, 1); PG8_STAGE(PG8_SB(1, 0), b3, voffB);
            PG8_BAR; PG8_WAIT_L(0); PG8_MMA(0, 1, At, B1); PG8_BAR;
            PG8_LDA(At, 1, 1); PG8_STAGE(PG8_SA(1, 0), a3, voffA);
            PG8_BAR; PG8_WAIT_L(0); PG8_MMA(1, 0, At, B0); PG8_BAR; PG8_SCHED;
            PG8_STAGE(PG8_SB(1, 1), b3 + hstep, voffB);
            PG8_WAIT_V(6); PG8_BAR; PG8_MMA(1, 1, At, B1); PG8_BAR;
            }
        }
        if constexpr (ALIGN_EPI) { if (wr == 0) PG8_BAR; }
        if constexpr (!Epi::AFTER_DRAIN) { E(acc, cur, wr, wc, fr, fq); S.done(cur); }
        if (!has_next) break;
#pragma unroll
        for (int a = 0; a < 2; ++a)
#pragma unroll
            for (int b = 0; b < 2; ++b)
#pragma unroll
                for (int m = 0; m < 4; ++m)
#pragma unroll
                    for (int n = 0; n < 2; ++n) acc[a][b][m][n] = (f32x4){0.f, 0.f, 0.f, 0.f};
        cur = nxt; cA = nA; cB = nB; ++ui;
        if constexpr (ALIGN_EPI) { if (wr == 1) PG8_BAR; }
    }
    PG8_WAIT_V(0);
    if constexpr (!ALIGN_EPI) { if (wr == 0) PG8_BAR; }
    PG8_BAR;
    if constexpr (Epi::AFTER_DRAIN) { E.fused(acc, cur, wr, wc, fr, fq, lds, wid, lane); S.done(cur); }
#undef PG8_SA
#undef PG8_SB
#undef PG8_STAGE
#undef PG8_LDA
#undef PG8_LDB
#undef PG8_MMA
#undef PG8_WAIT_V
#undef PG8_WAIT_L
#undef PG8_BAR
#undef PG8_SCHED
}
}


constexpr int DM = 1024, NB_P = 8, T_P = 2048, NB_S = 32, T_S = 32, PAST = 1024;
constexpr int MP = NB_P * T_P, MS = NB_S * T_S, MT = MP + MS;
constexpr int LS = PAST + T_S;
constexpr int SHIFTW = 1696, NZ = 3328, ZRW = 1632, DFF = 4096;
constexpr float QSCALE = 0.125f * 1.4426950408889634f;
constexpr float WISCALE = 0.35355339059327373f * 0.125f;
constexpr size_t OFF_Y = 0, OFF_KP = 17825792, OFF_VP = OFF_KP + 4194304, OFF_KIP = OFF_VP + 4194304, OFF_WKVP = OFF_KIP + 1048576, OFF_SHP = OFF_WKVP + 262144,
                 OFF_KS = OFF_SHP + 13568, OFF_VS = OFF_KS + 262144, OFF_KIS = OFF_VS + 262144, OFF_WKVS = OFF_KIS + 65536, OFF_SHS = OFF_WKVS + 1048576, OUT_TOTAL = OFF_SHS + 54272;
constexpr size_t MiB = 1u << 20;
constexpr size_t WS_CTL = 0, CTL_BYTES = 1 * MiB;
constexpr size_t WS_WIN = 1 * MiB, WS_WOUT = 8 * MiB, WS_W1 = 10 * MiB, WS_W2 = 18 * MiB;
constexpr size_t WS_W2T = 26 * MiB, WS_A2T = WS_W2T + 32768, WS_G2T = WS_A2T + 32768, WS_WI = 27 * MiB, WS_BONUS = 28 * MiB;
constexpr size_t WS_XB = 30 * MiB;
constexpr size_t WS_ZS = 66 * MiB;
constexpr size_t WS_R = 123 * MiB;
constexpr size_t WS_ZR = WS_R, WS_KBP = 178 * MiB, WS_VTP = 186 * MiB, WS_KIP = 194 * MiB, WS_KBS = 196 * MiB, WS_VTS = 213 * MiB, WS_KIS = 230 * MiB;
constexpr size_t WS_OW = WS_R, WS_OKK = 157 * MiB, WS_OB = 174 * MiB, WS_OKM = 191 * MiB, WS_OR = 208 * MiB, WS_OV = 225 * MiB;
constexpr size_t WS_ACT = 66 * MiB, WS_HB = 202 * MiB, WS_END = 256 * MiB;
static_assert(WS_ZS + (size_t)MT * SHIFTW * 2 <= WS_R && WS_ZR + (size_t)MT * ZRW * 2 <= WS_KBP && WS_KBS + (size_t)NB_S * LS * 256 * 2 <= WS_VTS && WS_VTS + (size_t)NB_S * 256 * LS * 2 <= WS_KIS &&
              WS_KIS + (size_t)NB_S * LS * 64 * 2 <= WS_END && WS_OV + (size_t)MT * 512 * 2 <= WS_END && WS_ACT + (size_t)MT * DFF * 2 <= WS_HB && WS_HB + (size_t)MT * DM * 2 <= WS_END, "d_ws map");
constexpr size_t SC_Q = 0, SC_QI = (size_t)MT * 512 / 2, SC_Y = 0, SC_G = (size_t)MT * 512;
constexpr int CW_QATT = 64, CW_SS = 16384;

typedef unsigned short bf16;
typedef short bf16x8 __attribute__((ext_vector_type(8)));
typedef float f32x4 __attribute__((ext_vector_type(4)));
typedef float f32x16 __attribute__((ext_vector_type(16)));
typedef unsigned u32x4 __attribute__((ext_vector_type(4)));
typedef unsigned u32x2 __attribute__((ext_vector_type(2)));

__device__ __forceinline__ unsigned f2bf(float f) { unsigned u = __float_as_uint(f); return (u + 0x7fffu + ((u >> 16) & 1u)) >> 16; }
__device__ __forceinline__ unsigned pk2(float lo, float hi) { return f2bf(lo) | (f2bf(hi) << 16); }
__device__ __forceinline__ float bflo(unsigned w) { return __uint_as_float(w << 16); }
__device__ __forceinline__ float bfhi(unsigned w) { return __uint_as_float(w & 0xffff0000u); }
__device__ __forceinline__ float bf1(bf16 b) { return __uint_as_float((unsigned)b << 16); }
__device__ __forceinline__ void unpack8(const u32x4 w, float* x) { x[0] = bflo(w.x); x[1] = bfhi(w.x); x[2] = bflo(w.y); x[3] = bfhi(w.y); x[4] = bflo(w.z); x[5] = bfhi(w.z); x[6] = bflo(w.w); x[7] = bfhi(w.w); }
__device__ __forceinline__ u32x4 pack8(const float* x) { u32x4 w; w.x = pk2(x[0], x[1]); w.y = pk2(x[2], x[3]); w.z = pk2(x[4], x[5]); w.w = pk2(x[6], x[7]); return w; }
__device__ __forceinline__ float wave_sum(float v) {
#pragma unroll
    for (int o = 1; o < 64; o <<= 1) v += __shfl_xor(v, o);
    return v;
}
template <int CTRL> __device__ __forceinline__ float dppmov(float x) { return __builtin_bit_cast(float, __builtin_amdgcn_update_dpp(0, __builtin_bit_cast(int, x), CTRL, 0xf, 0xf, true)); }
__device__ __forceinline__ float sum16(float x) {
    x += dppmov<0xB1>(x); x += dppmov<0x4E>(x); x += dppmov<0x141>(x); x += dppmov<0x140>(x); return x;
}
__device__ __forceinline__ int crow(int r, int hi) { return (r & 3) + 8 * (r >> 2) + 4 * hi; }

struct Args { const float* in[28]; float* out; unsigned char* ws; int ph_lo, ph_hi; };

__device__ __forceinline__ void tr_item(const float* W, int K, int N, const float* gain, bf16* WT, int jr0, int c0, int nvalid, int k0, float* scr, int lane) {
#pragma unroll 8
    for (int i = 0; i < 32; ++i) { const int kk = 2 * i + (lane >> 5), n = lane & 31;
        float v = (n < nvalid) ? W[(size_t)(k0 + kk) * N + c0 + n] : 0.f; if (gain) v *= gain[k0 + kk]; scr[kk * 33 + n] = v; }
    __builtin_amdgcn_s_waitcnt(0xC07F); asm volatile("" ::: "memory");
    const int c = lane & 7;
#pragma unroll
    for (int j = 0; j < 4; ++j) { const int n = (lane >> 3) + 8 * j; const float* s = scr + (8 * c) * 33 + n;
        u32x4 o; o.x = pk2(s[0 * 33], s[1 * 33]); o.y = pk2(s[2 * 33], s[3 * 33]); o.z = pk2(s[4 * 33], s[5 * 33]); o.w = pk2(s[6 * 33], s[7 * 33]);
        *(u32x4*)(WT + (size_t)(jr0 + n) * K + k0 + 8 * c) = o; }
    __builtin_amdgcn_s_waitcnt(0xC07F); asm volatile("" ::: "memory");
}
__device__ __forceinline__ void p0_prologue(const Args& a, unsigned char* lds, int tid) {
    const int lane = tid & 63, wave = tid >> 6, gw = blockIdx.x * 8 + wave, NGW = gridDim.x * 8;
    float* scr = (float*)(lds + wave * 17408);
    unsigned char* ws = a.ws;
    constexpr int I_IN = (NZ / 32) * (DM / 64), I_OUT = (DM / 32) * (DM / 64), I_F1 = (DFF / 32) * (DM / 64), I_F2 = (DM / 32) * (DFF / 64);
    for (int it = gw; it < I_IN + I_OUT + I_F1 + I_F2; it += NGW) {
        int r = it;
        if (r < I_IN) { const int jb = r % (NZ / 32), kb = r / (NZ / 32), j0 = jb * 32; int c0, nv;
            if (j0 < 1600) { c0 = j0; nv = 32; } else if (j0 < 3296) { c0 = 1608 + (j0 - 1600); nv = 32; } else { c0 = 1600; nv = 8; }
            tr_item(a.in[8], DM, 3304, a.in[7], (bf16*)(ws + WS_WIN), j0, c0, nv, kb * 64, scr, lane); continue; }
        r -= I_IN;
        if (r < I_OUT) { const int jb = r % (DM / 32), kb = r / (DM / 32); tr_item(a.in[24], DM, DM, nullptr, (bf16*)(ws + WS_WOUT), jb * 32, jb * 32, 32, kb * 64, scr, lane); continue; }
        r -= I_OUT;
        if (r < I_F1) { const int jb = r % (DFF / 32), kb = r / (DFF / 32); tr_item(a.in[26], DM, DFF, a.in[25], (bf16*)(ws + WS_W1), jb * 32, jb * 32, 32, kb * 64, scr, lane); continue; }
        r -= I_F1;
        { const int jb = r % (DM / 32), kb = r / (DM / 32); tr_item(a.in[27], DFF, DM, nullptr, (bf16*)(ws + WS_W2), jb * 32, jb * 32, 32, kb * 64, scr, lane); }
    }
    { const int gt = blockIdx.x * 512 + tid, NT = gridDim.x * 512;
      bf16* w2t = (bf16*)(ws + WS_W2T); bf16* a2t = (bf16*)(ws + WS_A2T); bf16* g2t = (bf16*)(ws + WS_G2T);
      for (int i = gt; i < 512 * 32; i += NT) { const int n = i >> 5, k = i & 31; w2t[i] = (bf16)f2bf(a.in[15][k * 512 + n]); a2t[i] = (bf16)f2bf(a.in[17][k * 512 + n]); }
      for (int i = gt; i < 512 * 96; i += NT) { const int n = i / 96, k = i % 96; g2t[i] = (bf16)f2bf(a.in[18][k * 512 + n]); } }
    { f32x4 v[4], nx[4]; int m = gw;
      if (m < MT) { const f32x4* xr = (const f32x4*)((m < MP) ? a.in[0] + (size_t)m * DM : a.in[1] + (size_t)(m - MP) * DM) + lane;
#pragma unroll
          for (int j = 0; j < 4; ++j) v[j] = xr[64 * j]; }
      for (; m < MT; m += NGW) {
        const int mn = m + NGW;
        if (mn < MT) { const f32x4* xr = (const f32x4*)((mn < MP) ? a.in[0] + (size_t)mn * DM : a.in[1] + (size_t)(mn - MP) * DM) + lane;
#pragma unroll
            for (int j = 0; j < 4; ++j) nx[j] = xr[64 * j]; }
        float s = 0.f;
#pragma unroll
        for (int j = 0; j < 4; ++j) s += (v[j].x * v[j].x + v[j].y * v[j].y) + (v[j].z * v[j].z + v[j].w * v[j].w);
        const float rs = rsqrtf(wave_sum(s) * (1.f / DM) + 1e-6f);
        u32x2* o8 = (u32x2*)((bf16*)(ws + WS_XB) + (size_t)m * DM) + lane;
#pragma unroll
        for (int j = 0; j < 4; ++j) { u32x2 o; o.x = pk2(v[j].x * rs, v[j].y * rs); o.y = pk2(v[j].z * rs, v[j].w * rs); o8[64 * j] = o; }
#pragma unroll
        for (int j = 0; j < 4; ++j) v[j] = nx[j];
      } }
    for (int r4 = gw; r4 < NB_S * PAST / 4; r4 += NGW) {
        f32x4 v[4];
#pragma unroll
        for (int j = 0; j < 4; ++j) v[j] = ((const f32x4*)(a.in[2] + (size_t)(4 * r4 + j) * 256))[lane];
#pragma unroll
        for (int j = 0; j < 4; ++j) { const int rix = 4 * r4 + j, b = rix >> 10, p = rix & 1023; u32x2 o; o.x = pk2(v[j].x, v[j].y); o.y = pk2(v[j].z, v[j].w);
            ((u32x2*)((bf16*)(ws + WS_KBS) + ((size_t)b * LS + p) * 256))[lane] = o; }
    }
    for (int r4 = gw; r4 < NB_S * PAST / 4; r4 += NGW) {
        const int rix = r4 * 4 + (lane >> 4), b = rix >> 10, p = rix & 1023; const f32x4 v = ((const f32x4*)(a.in[4] + (size_t)rix * 64))[lane & 15];
        u32x2 o; o.x = pk2(v.x, v.y); o.y = pk2(v.z, v.w); ((u32x2*)((bf16*)(ws + WS_KIS) + ((size_t)b * LS + p) * 64))[lane & 15] = o;
    }
    for (int it = gw; it < NB_S * 4 * 16; it += NGW) {
        const int kb = it & 15, g = (it >> 4) & 3, b = it >> 6;
        const float* src = a.in[3] + ((size_t)b * PAST + kb * 64) * 256 + g * 64;
#pragma unroll 8
        for (int i = 0; i < 64; ++i) scr[i * 65 + lane] = src[(size_t)i * 256 + lane];
        __builtin_amdgcn_s_waitcnt(0xC07F); asm volatile("" ::: "memory");
        bf16* dst = (bf16*)(ws + WS_VTS) + ((size_t)(b * 4 + g) * 64) * LS + kb * 64 + lane;
#pragma unroll 8
        for (int d = 0; d < 64; ++d) dst[(size_t)d * LS] = (bf16)f2bf(scr[lane * 65 + d]);
        __builtin_amdgcn_s_waitcnt(0xC07F); asm volatile("" ::: "memory");
    }
}

__device__ __forceinline__ void p2_post(const Args& a, unsigned char* lds, int tid) {
    unsigned char* ws = a.ws; float* out = a.out;
    const bf16* ZR = (const bf16*)(ws + WS_ZR); const bf16* ZS = (const bf16*)(ws + WS_ZS);
    bf16* Q = (bf16*)(out + SC_Q); bf16* QI = (bf16*)(out + SC_QI);
    float* cs = (float*)lds;
    bf16* vt = (bf16*)(lds + 4096);
    const int g8 = tid >> 3, sub = tid & 7;
    const float* qg = a.in[9]; const float* kg = a.in[10]; const float* lng = a.in[11]; const float* lnb = a.in[12];
    for (int tile = blockIdx.x; tile < MT / 64; tile += gridDim.x) {
        const int m0 = tile * 64;
        { const int m = m0 + g8, pos = (m < MP) ? (m & (T_P - 1)) : (PAST + ((m - MP) & (T_S - 1)));
          const float inv = powf(500000.0f, -(float)sub * 0.125f); const float ang = (float)pos * inv; float s, c; sincosf(ang, &s, &c);
          cs[g8 * 16 + sub] = c; cs[g8 * 16 + 8 + sub] = s; }
        __syncthreads();
        const int m = m0 + g8;
        const bool isp = m < MP; const int ms = m - MP;
        float cc[8], ss[8];
#pragma unroll
        for (int j = 0; j < 8; ++j) { cc[j] = cs[g8 * 16 + j]; ss[j] = cs[g8 * 16 + 8 + j]; }
        const size_t kvrow = isp ? (size_t)m : ((size_t)(ms >> 5) * LS + PAST + (ms & 31));
        bf16* KB = (bf16*)(ws + (isp ? WS_KBP : WS_KBS)); bf16* KIb = (bf16*)(ws + (isp ? WS_KIP : WS_KIS));
        u32x4 xnext = *(const u32x4*)(ZR + (size_t)m * ZRW + 8 * sub);
        for (int hb = 0; hb < 25; ++hb) {
            float x[8]; unpack8(xnext, x);
            if (hb + 1 < 25) xnext = *(const u32x4*)(ZR + (size_t)m * ZRW + (hb + 1) * 64 + 8 * sub);
            if (hb < 12) {
                float s2 = 0.f;
#pragma unroll
                for (int j = 0; j < 8; ++j) s2 += x[j] * x[j];
                s2 += __shfl_xor(s2, 1); s2 += __shfl_xor(s2, 2); s2 += __shfl_xor(s2, 4);
                const float rinv = rsqrtf(s2 * (1.f / 64.f) + 1e-6f); const float* gn = (hb < 8 ? qg : kg) + 8 * sub;
                float y[8], o[8];
#pragma unroll
                for (int j = 0; j < 8; ++j) y[j] = x[j] * rinv * gn[j];
#pragma unroll
                for (int j = 0; j < 8; ++j) { const float p = __shfl_xor(y[j], 1); o[j] = sub == 0 ? y[j] * cc[j] - p * ss[j] : (sub == 1 ? y[j] * cc[j] + p * ss[j] : y[j]); }
                if (hb < 8) {
#pragma unroll
                    for (int j = 0; j < 8; ++j) o[j] *= QSCALE;
                    *(u32x4*)(Q + (size_t)m * 512 + hb * 64 + 8 * sub) = pack8(o);
                } else { const int g = hb - 8;
                    float* ko = out + (isp ? OFF_KP + (size_t)m * 256 : OFF_KS + (size_t)ms * 256) + g * 64 + 8 * sub;
                    *(f32x4*)ko = (f32x4){o[0], o[1], o[2], o[3]}; *(f32x4*)(ko + 4) = (f32x4){o[4], o[5], o[6], o[7]};
                    *(u32x4*)(KB + kvrow * 256 + g * 64 + 8 * sub) = pack8(o); }
            } else if (hb < 16) { const int g = hb - 12;
                float* vo = out + (isp ? OFF_VP + (size_t)m * 256 : OFF_VS + (size_t)ms * 256) + g * 64 + 8 * sub;
                *(f32x4*)vo = (f32x4){x[0], x[1], x[2], x[3]}; *(f32x4*)(vo + 4) = (f32x4){x[4], x[5], x[6], x[7]};
                unsigned* vd = (unsigned*)(vt + g8 * 258 + g * 64 + 8 * sub);
                vd[0] = pk2(x[0], x[1]); vd[1] = pk2(x[2], x[3]); vd[2] = pk2(x[4], x[5]); vd[3] = pk2(x[6], x[7]);
            } else if (hb < 24) {
                float o[8];
#pragma unroll
                for (int j = 0; j < 8; ++j) { const float p = __shfl_xor(x[j], 1); o[j] = sub == 0 ? x[j] * cc[j] - p * ss[j] : (sub == 1 ? x[j] * cc[j] + p * ss[j] : x[j]); }
                *(u32x4*)(QI + (size_t)m * 512 + (hb - 16) * 64 + 8 * sub) = pack8(o);
            } else {
                float s1 = 0.f;
#pragma unroll
                for (int j = 0; j < 8; ++j) s1 += x[j];
                s1 += __shfl_xor(s1, 1); s1 += __shfl_xor(s1, 2); s1 += __shfl_xor(s1, 4);
                const float mu = s1 * (1.f / 64.f); float s2 = 0.f;
#pragma unroll
                for (int j = 0; j < 8; ++j) { const float d = x[j] - mu; s2 += d * d; }
                s2 += __shfl_xor(s2, 1); s2 += __shfl_xor(s2, 2); s2 += __shfl_xor(s2, 4);
                const float rinv = rsqrtf(s2 * (1.f / 64.f) + 1e-6f); float y[8], o[8];
#pragma unroll
                for (int j = 0; j < 8; ++j) y[j] = (x[j] - mu) * rinv * lng[8 * sub + j] + lnb[8 * sub + j];
#pragma unroll
                for (int j = 0; j < 8; ++j) { const float p = __shfl_xor(y[j], 1); o[j] = sub == 0 ? y[j] * cc[j] - p * ss[j] : (sub == 1 ? y[j] * cc[j] + p * ss[j] : y[j]); }
                float* ko = out + (isp ? OFF_KIP + (size_t)m * 64 : OFF_KIS + (size_t)ms * 64) + 8 * sub;
                *(f32x4*)ko = (f32x4){o[0], o[1], o[2], o[3]}; *(f32x4*)(ko + 4) = (f32x4){o[4], o[5], o[6], o[7]};
                *(u32x4*)(KIb + kvrow * 64 + 8 * sub) = pack8(o);
            }
        }
        ((float*)(ws + WS_WI))[(size_t)m * 8 + sub] = bf1(ZR[(size_t)m * ZRW + 1600 + sub]) * WISCALE;
        __syncthreads();
        { const int r = tid >> 1, half = tid & 1; unsigned wv[16];
#pragma unroll
          for (int j = 0; j < 16; ++j) wv[j] = (unsigned)vt[(32 * half + 2 * j) * 258 + r] | ((unsigned)vt[(32 * half + 2 * j + 1) * 258 + r] << 16);
          bf16* dst;
          if (m0 < MP) dst = (bf16*)(ws + WS_VTP) + ((size_t)(m0 >> 11) * 256 + r) * T_P + (m0 & (T_P - 1)) + 32 * half;
          else { const int b = ((m0 - MP) >> 5) + half; dst = (bf16*)(ws + WS_VTS) + ((size_t)b * 256 + r) * LS + PAST; }
#pragma unroll
          for (int j = 0; j < 4; ++j) ((u32x4*)dst)[j] = (u32x4){wv[4 * j], wv[4 * j + 1], wv[4 * j + 2], wv[4 * j + 3]}; }
        if (m0 < MP) { if ((m0 & (T_P - 1)) == T_P - 64) { const int b = m0 >> 11; const bf16* zr = ZS + (size_t)(m0 + 63) * SHIFTW;
                for (int c = tid; c < SHIFTW; c += 512) out[OFF_SHP + (size_t)b * SHIFTW + c] = bf1(zr[c]); } }
        else { for (int h2 = 0; h2 < 2; ++h2) { const int b = ((m0 - MP) >> 5) + h2; const bf16* zr = ZS + (size_t)(m0 + 32 * h2 + 31) * SHIFTW;
                for (int c = tid; c < SHIFTW; c += 512) out[OFF_SHS + (size_t)b * SHIFTW + c] = bf1(zr[c]); } }
        __syncthreads();
    }
}

constexpr int ATT_UNITS = 544;
constexpr int MASK_PITCH = 65;
#define MFMA32(a, b, c) __builtin_amdgcn_mfma_f32_32x32x16_bf16((a), (b), (c), 0, 0, 0)

__device__ __forceinline__ float half_sum32(float v) { v += __shfl_xor(v, 1); v += __shfl_xor(v, 2); v += __shfl_xor(v, 4); v += __shfl_xor(v, 8); v += __shfl_xor(v, 16); return v; }
__device__ __forceinline__ float half_min32(float v) { v = fminf(v, __shfl_xor(v, 1)); v = fminf(v, __shfl_xor(v, 2)); v = fminf(v, __shfl_xor(v, 4)); v = fminf(v, __shfl_xor(v, 8)); v = fminf(v, __shfl_xor(v, 16)); return v; }
__device__ __forceinline__ float half_max32(float v) { v = fmaxf(v, __shfl_xor(v, 1)); v = fmaxf(v, __shfl_xor(v, 2)); v = fmaxf(v, __shfl_xor(v, 4)); v = fmaxf(v, __shfl_xor(v, 8)); v = fmaxf(v, __shfl_xor(v, 16)); return v; }
__device__ __forceinline__ int half_sum32i(int v) { v += __shfl_xor(v, 1); v += __shfl_xor(v, 2); v += __shfl_xor(v, 4); v += __shfl_xor(v, 8); v += __shfl_xor(v, 16); return v; }

#define LAS3 __attribute__((address_space(3)))
constexpr int A_RING1 = 0, A_SCL = 24576, A_RING2 = 24576, A_MASK = 0, A_LSUM = 8320, A_UNIT = 9344;
__device__ __forceinline__ void p3_attention(const Args& a, unsigned char* lds, int tid, int rep) {
    unsigned char* ws = a.ws; float* out = a.out;
    const bf16* Q = (const bf16*)(out + SC_Q); const bf16* QI = (const bf16*)(out + SC_QI); const float* WI = (const float*)(ws + WS_WI);
    bf16* O = (bf16*)(ws + WS_XB);
    unsigned* maskw = (unsigned*)(lds + A_MASK);
    float* lsum = (float*)(lds + A_LSUM);
    int* s_unit = (int*)(lds + A_UNIT);
    typedef float f32x2_t __attribute__((ext_vector_type(2)));
    f32x2_t* scl = (f32x2_t*)(lds + A_SCL) + (size_t)(tid >> 6) * 2048 + (tid & 63);
    unsigned* qctr = (unsigned*)(ws + WS_CTL) + CW_QATT + 64 * rep;
    const int l = tid & 63, w = __builtin_amdgcn_readfirstlane(tid >> 6), rho = l & 31, hi = l >> 5;
    LAS3 unsigned char* ldsb = (LAS3 unsigned char*)lds;
    for (;;) {
        if (tid == 0) *s_unit = (int)atomicAdd(qctr, 1u);
        __syncthreads();
        const int p = *s_unit;
        __syncthreads();
        if (p >= ATT_UNITS) break;
        int m0, nkt, vpitch; const bf16 *KB, *VT, *KI; bool need_idx;
        { int c = -1, b, half = 0;
          if (p < 256) { c = 31 - (p >> 4); b = (p & 15) >> 1; half = p & 1; }
          else if (p < 288) { b = p - 256; }
          else { const int pp = p - 288; c = 15 - (pp >> 4); b = (pp & 15) >> 1; half = pp & 1; }
          if (c >= 0) { m0 = b * T_P + 64 * c + 32 * half; nkt = 2 * (c + 1); vpitch = T_P; need_idx = c >= 4;
              KB = (const bf16*)(ws + WS_KBP) + (size_t)b * T_P * 256; VT = (const bf16*)(ws + WS_VTP) + (size_t)b * 256 * T_P; KI = (const bf16*)(ws + WS_KIP) + (size_t)b * T_P * 64; }
          else { m0 = MP + 32 * b; nkt = LS / 32; vpitch = LS; need_idx = true;
              KB = (const bf16*)(ws + WS_KBS) + (size_t)b * LS * 256; VT = (const bf16*)(ws + WS_VTS) + (size_t)b * 256 * LS; KI = (const bf16*)(ws + WS_KIS) + (size_t)b * LS * 64; } }
        if (need_idx) {
            const int tokA = 4 * w + 2 * ((rho >> 2) & 1) + (rho >> 4), headA = (rho & 3) + 4 * ((rho >> 3) & 1);
            bf16x8 qa[4];
#pragma unroll
            for (int ks = 0; ks < 4; ++ks) qa[ks] = *(const bf16x8*)(QI + (size_t)(m0 + tokA) * 512 + headA * 64 + 16 * ks + 8 * hi);
            float wv[16];
#pragma unroll
            for (int r = 0; r < 16; ++r) wv[r] = WI[(size_t)(m0 + 4 * w + 2 * hi + (r >> 3)) * 8 + (r & 7)];
            asm volatile("" :: "v"(qa[0]), "v"(qa[1]), "v"(qa[2]), "v"(qa[3]));
#pragma unroll
            for (int r = 0; r < 16; ++r) asm volatile("" :: "v"(wv[r]));
            asm volatile("s_waitcnt vmcnt(0)" ::: "memory");
            float sc0[32], sc1[32];
            const int nb = (nkt + 1) >> 1;
            const int sr = 8 * w + (l >> 3), scn = (l & 7) ^ ((sr >> 1) & 7);
            const unsigned char* ksrc = (const unsigned char*)KI + (size_t)sr * 128 + 16 * scn;
#define KI_STAGE(it_) __builtin_amdgcn_global_load_lds((const unsigned*)(ksrc + (size_t)(it_) * 8192), (LAS3 unsigned*)(ldsb + A_RING1 + ((it_) % 3) * 8192 + w * 1024), 16, 0, 0)
            for (int rp1 = 0; rp1 <= PROBE_A1; ++rp1) {
            if (rp1) __syncthreads();
            KI_STAGE(0); if (1 < nb) KI_STAGE(1);
#pragma unroll
            for (int it = 0; it < 32; ++it) {
                if (it < nb) {
                    if (it + 1 < nb) asm volatile("s_waitcnt vmcnt(1) lgkmcnt(0)\n\ts_barrier" ::: "memory"); else asm volatile("s_waitcnt vmcnt(0) lgkmcnt(0)\n\ts_barrier" ::: "memory");
                    if (it + 2 < nb) KI_STAGE(it + 2);
                    const unsigned char* tb = lds + A_RING1 + (it % 3) * 8192;
#pragma unroll
                    for (int k2 = 0; k2 < 2; ++k2) { const int kt = 2 * it + k2;
                        if (kt < nkt) {
                            const int r = 32 * k2 + rho; const unsigned char* rowp = tb + r * 128; const int sw = (r >> 1) & 7;
                            f32x16 acc = {0.f, 0.f, 0.f, 0.f, 0.f, 0.f, 0.f, 0.f, 0.f, 0.f, 0.f, 0.f, 0.f, 0.f, 0.f, 0.f};
#pragma unroll
                            for (int ks = 0; ks < 4; ++ks) acc = MFMA32(qa[ks], *(const bf16x8*)(rowp + 16 * ((2 * ks + hi) ^ sw)), acc);
                            float s0 = 0.f, s1 = 0.f;
#pragma unroll
                            for (int r2 = 0; r2 < 8; ++r2) { s0 += wv[r2] * fmaxf(acc[r2], 0.f); s1 += wv[8 + r2] * fmaxf(acc[8 + r2], 0.f); }
                            if (kt < 32) { sc0[kt & 31] = s0; sc1[kt & 31] = s1; } else scl[(kt - 32) * 64] = (f32x2_t){s0, s1};
                        } else if (kt < 32) { sc0[kt & 31] = -3.0e38f; sc1[kt & 31] = -3.0e38f; }
                    }
                } else { if (2 * it < 32) { sc0[(2 * it) & 31] = -3.0e38f; sc1[(2 * it) & 31] = -3.0e38f; sc0[(2 * it + 1) & 31] = -3.0e38f; sc1[(2 * it + 1) & 31] = -3.0e38f; } }
            }
            }
#undef KI_STAGE
            __syncthreads();
            float mn0 = 3.0e38f, mx0 = -3.0e38f, mn1 = 3.0e38f, mx1 = -3.0e38f; int cp0 = 0, cz0 = 0, cp1 = 0, cz1 = 0;
#pragma unroll
            for (int kt = 0; kt < 64; ++kt) if (kt < nkt) { float v0, v1; if (kt < 32) { v0 = sc0[kt & 31]; v1 = sc1[kt & 31]; } else { const f32x2_t t2 = scl[(kt - 32) * 64]; v0 = t2.x; v1 = t2.y; }
                mn0 = fminf(mn0, v0); mx0 = fmaxf(mx0, v0); mn1 = fminf(mn1, v1); mx1 = fmaxf(mx1, v1);
                cp0 += v0 > 0.f ? 1 : 0; cz0 += v0 == 0.f ? 1 : 0; cp1 += v1 > 0.f ? 1 : 0; cz1 += v1 == 0.f ? 1 : 0; }
            mn0 = half_min32(mn0); mx0 = half_max32(mx0); mn1 = half_min32(mn1); mx1 = half_max32(mx1);
            cp0 = half_sum32i(cp0); cz0 = half_sum32i(cz0); cp1 = half_sum32i(cp1); cz1 = half_sum32i(cz1);
            float lo0, hi0, lo1, hi1, thr0 = 0.f, thr1 = 0.f; int ch0, ch1, nt0 = 0, nt1 = 0; bool fin0, fin1;
            for (int rp2 = 0; rp2 <= PROBE_A2; ++rp2) {
            fin0 = false; fin1 = false; ch0 = 0; ch1 = 0;
            if (cp0 >= 256) { lo0 = 0.f; hi0 = mx0; if (cp0 == 256) { fin0 = true; thr0 = 0.f; nt0 = 0; } }
            else if (cp0 + cz0 >= 256) { lo0 = 0.f; hi0 = 0.f; fin0 = true; thr0 = 0.f; nt0 = 256 - cp0; }
            else { lo0 = mn0 - 1.0f; hi0 = 0.f; ch0 = cp0; }
            if (cp1 >= 256) { lo1 = 0.f; hi1 = mx1; if (cp1 == 256) { fin1 = true; thr1 = 0.f; nt1 = 0; } }
            else if (cp1 + cz1 >= 256) { lo1 = 0.f; hi1 = 0.f; fin1 = true; thr1 = 0.f; nt1 = 256 - cp1; }
            else { lo1 = mn1 - 1.0f; hi1 = 0.f; ch1 = cp1; }
            asm volatile("" : "+v"(lo0), "+v"(lo1));
            for (int iter = 0; iter < 64; ++iter) {
                const float mid0 = lo0 + 0.5f * (hi0 - lo0), mid1 = lo1 + 0.5f * (hi1 - lo1);
                int c0 = 0, c1 = 0;
#pragma unroll
                for (int g = 0; g < 4; ++g) if (8 * g < nkt) {
#pragma unroll
                    for (int k8 = 0; k8 < 8; ++k8) { c0 += sc0[8 * g + k8] > mid0 ? 1 : 0; c1 += sc1[8 * g + k8] > mid1 ? 1 : 0; } }
                for (int kt = 32; kt < nkt; kt += 8) {
                    f32x2_t t8[8];
#pragma unroll
                    for (int u = 0; u < 8; ++u) t8[u] = scl[(kt + u - 32) * 64];
#pragma unroll
                    for (int u = 0; u < 8; ++u) if (kt + u < nkt) { c0 += t8[u].x > mid0 ? 1 : 0; c1 += t8[u].y > mid1 ? 1 : 0; } }
                c0 = half_sum32i(c0); c1 = half_sum32i(c1);
                if (!fin0) { if (!(mid0 > lo0 && mid0 < hi0)) { fin0 = true; thr0 = hi0; nt0 = 256 - ch0; }
                             else if (c0 == 256) { fin0 = true; thr0 = mid0; nt0 = 0; } else if (c0 > 256) lo0 = mid0; else { hi0 = mid0; ch0 = c0; } }
                if (!fin1) { if (!(mid1 > lo1 && mid1 < hi1)) { fin1 = true; thr1 = hi1; nt1 = 256 - ch1; }
                             else if (c1 == 256) { fin1 = true; thr1 = mid1; nt1 = 0; } else if (c1 > 256) lo1 = mid1; else { hi1 = mid1; ch1 = c1; } }
                if (__all(fin0 && fin1)) break;
            }
            }
            const bool any_tie = __any(nt0 > 0 || nt1 > 0);
            int run0 = 0, run1 = 0; const unsigned below = (1u << rho) - 1u;
#pragma unroll
            for (int kt = 0; kt < 64; ++kt) if (kt < nkt) {
                float v0, v1; if (kt < 32) { v0 = sc0[kt & 31]; v1 = sc1[kt & 31]; } else { const f32x2_t t2 = scl[(kt - 32) * 64]; v0 = t2.x; v1 = t2.y; }
                bool p0 = v0 > thr0, p1 = v1 > thr1;
                if (any_tie) {
                    const bool e0 = nt0 > 0 && v0 == thr0, e1 = nt1 > 0 && v1 == thr1;
                    const unsigned long long be0 = __ballot(e0), be1 = __ballot(e1);
                    const unsigned h0 = (unsigned)(be0 >> (32 * hi)), h1 = (unsigned)(be1 >> (32 * hi));
                    p0 = p0 || (e0 && (run0 + __popc(h0 & below)) < nt0); p1 = p1 || (e1 && (run1 + __popc(h1 & below)) < nt1);
                    run0 += __popc(h0); run1 += __popc(h1);
                }
                const unsigned long long b0 = __ballot(p0), b1 = __ballot(p1);
                if (l == 0) { maskw[(4 * w + 0) * MASK_PITCH + kt] = (unsigned)b0; maskw[(4 * w + 1) * MASK_PITCH + kt] = (unsigned)b1; }
                if (l == 32) { maskw[(4 * w + 2) * MASK_PITCH + kt] = (unsigned)(b0 >> 32); maskw[(4 * w + 3) * MASK_PITCH + kt] = (unsigned)(b1 >> 32); }
            }
        }
        __syncthreads();
        {
            const int g = w >> 1;
            bf16x8 qb[4];
#pragma unroll
            for (int ks = 0; ks < 4; ++ks) qb[ks] = *(const bf16x8*)(Q + (size_t)(m0 + rho) * 512 + w * 64 + 16 * ks + 8 * hi);
            asm volatile("" :: "v"(qb[0]), "v"(qb[1]), "v"(qb[2]), "v"(qb[3]));
            asm volatile("s_waitcnt vmcnt(0)" ::: "memory");
            const unsigned char* ksrc[2]; const unsigned char* vsrc[2];
#pragma unroll
            for (int k = 0; k < 2; ++k) { const int i = (k * 8 + w) * 64 + l; const int r = i >> 5, c = i & 31; ksrc[k] = (const unsigned char*)KB + (size_t)r * 512 + 16 * (c ^ (r & 15));
                const int R = i >> 2, cv = i & 3; vsrc[k] = (const unsigned char*)VT + (size_t)R * vpitch * 2 + 16 * (cv ^ ((R >> 2) & 3)); }
#define KV_STAGE(t_) do { const int bo_ = A_RING2 + ((t_) % 3) * 32768 + w * 1024; \
            __builtin_amdgcn_global_load_lds((const unsigned*)(ksrc[0] + (size_t)(t_) * 16384), (LAS3 unsigned*)(ldsb + bo_), 16, 0, 0); \
            __builtin_amdgcn_global_load_lds((const unsigned*)(ksrc[1] + (size_t)(t_) * 16384), (LAS3 unsigned*)(ldsb + bo_ + 8192), 16, 0, 0); \
            __builtin_amdgcn_global_load_lds((const unsigned*)(vsrc[0] + (size_t)(t_) * 64), (LAS3 unsigned*)(ldsb + bo_ + 16384), 16, 0, 0); \
            __builtin_amdgcn_global_load_lds((const unsigned*)(vsrc[1] + (size_t)(t_) * 64), (LAS3 unsigned*)(ldsb + bo_ + 24576), 16, 0, 0); } while (0)
            f32x16 o0 = {0.f, 0.f, 0.f, 0.f, 0.f, 0.f, 0.f, 0.f, 0.f, 0.f, 0.f, 0.f, 0.f, 0.f, 0.f, 0.f}, o1 = o0; float psum = 0.f;
            const int ksw = rho & 15;
            const int vR0 = g * 64 + rho, vR1 = vR0 + 32; const int vs0 = (vR0 >> 2) & 3, vs1 = (vR1 >> 2) & 3;
            for (int rp3 = 0; rp3 <= PROBE_A3; ++rp3) {
            if (rp3) __syncthreads();
            KV_STAGE(0); if (1 < nkt) KV_STAGE(1);
            for (int kt = 0; kt < nkt; ++kt) {
                if (kt + 1 < nkt) asm volatile("s_waitcnt vmcnt(4) lgkmcnt(0)\n\ts_barrier" ::: "memory"); else asm volatile("s_waitcnt vmcnt(0) lgkmcnt(0)\n\ts_barrier" ::: "memory");
                if (kt + 2 < nkt) KV_STAGE(kt + 2);
                const unsigned char* kbuf = lds + A_RING2 + (kt % 3) * 32768; const unsigned char* vbuf = kbuf + 16384;
                f32x16 st = {0.f, 0.f, 0.f, 0.f, 0.f, 0.f, 0.f, 0.f, 0.f, 0.f, 0.f, 0.f, 0.f, 0.f, 0.f, 0.f};
#pragma unroll
                for (int ks = 0; ks < 4; ++ks) st = MFMA32(*(const bf16x8*)(kbuf + rho * 512 + 16 * ((g * 8 + 2 * ks + hi) ^ ksw)), qb[ks], st);
                unsigned word = need_idx ? maskw[rho * MASK_PITCH + kt] : 0xffffffffu; word >>= 4 * hi; float pr[16];
#pragma unroll
                for (int r = 0; r < 16; ++r) { const float e = __builtin_amdgcn_exp2f(st[r]); pr[r] = ((word >> ((r & 3) + 8 * (r >> 2))) & 1u) ? e : 0.f; psum += pr[r]; }
                union { u32x4 u; bf16x8 v; } pa0, pa1; pa0.u = (u32x4){pg8::cvt_pk_bf16(pr[0], pr[1]), pg8::cvt_pk_bf16(pr[2], pr[3]), pg8::cvt_pk_bf16(pr[4], pr[5]), pg8::cvt_pk_bf16(pr[6], pr[7])}; pa1.u = (u32x4){pg8::cvt_pk_bf16(pr[8], pr[9]), pg8::cvt_pk_bf16(pr[10], pr[11]), pg8::cvt_pk_bf16(pr[12], pr[13]), pg8::cvt_pk_bf16(pr[14], pr[15])};
                union { u32x4 u; bf16x8 v; } vf[2][2];
#pragma unroll
                for (int s2 = 0; s2 < 2; ++s2) { const unsigned char* r0 = vbuf + vR0 * 64 + 8 * hi; const unsigned char* r1 = vbuf + vR1 * 64 + 8 * hi;
                    const u32x2 a0 = *(const u32x2*)(r0 + 16 * ((2 * s2) ^ vs0)), a1 = *(const u32x2*)(r0 + 16 * ((2 * s2 + 1) ^ vs0)), b0 = *(const u32x2*)(r1 + 16 * ((2 * s2) ^ vs1)), b1 = *(const u32x2*)(r1 + 16 * ((2 * s2 + 1) ^ vs1));
                    vf[s2][0].u = (u32x4){a0.x, a0.y, a1.x, a1.y}; vf[s2][1].u = (u32x4){b0.x, b0.y, b1.x, b1.y}; }
                o0 = MFMA32(pa0.v, vf[0][0].v, o0); o0 = MFMA32(pa1.v, vf[1][0].v, o0); o1 = MFMA32(pa0.v, vf[0][1].v, o1); o1 = MFMA32(pa1.v, vf[1][1].v, o1);
            }
            }
#undef KV_STAGE
            psum += __shfl_xor(psum, 32);
            if (hi == 0) lsum[w * 32 + rho] = psum;
            __syncthreads();
#pragma unroll
            for (int r = 0; r < 16; ++r) { const int qr = crow(r, hi); const float inv = 1.0f / lsum[w * 32 + qr];
                bf16* op = O + (size_t)(m0 + qr) * DM + w * 64 + rho;
                op[0] = (bf16)f2bf(o0[r] * inv); op[32] = (bf16)f2bf(o1[r] * inv); }
        }
        __syncthreads();
    }
}

constexpr int XS_PITCH = 168;
__device__ __forceinline__ void p4_rwkv_prep(const Args& a, unsigned char* lds, int tid) {
    unsigned char* ws = a.ws; float* out = a.out;
    const bf16* ZS = (const bf16*)(ws + WS_ZS);
    const bf16* w2t = (const bf16*)(ws + WS_W2T); const bf16* a2t = (const bf16*)(ws + WS_A2T); const bf16* g2t = (const bf16*)(ws + WS_G2T);
    float* OW = (float*)(ws + WS_OW); bf16* OKK = (bf16*)(ws + WS_OKK); bf16* OB = (bf16*)(ws + WS_OB); bf16* OKM = (bf16*)(ws + WS_OKM); bf16* OR_ = (bf16*)(ws + WS_OR); bf16* OV = (bf16*)(ws + WS_OV);
    bf16* G = (bf16*)(out + SC_G); float* BON = (float*)(ws + WS_BONUS);
    const float* mu = a.in[13]; const float* w0 = a.in[14]; const float* a0 = a.in[16]; const float* k_k = a.in[19]; const float* k_a = a.in[20]; const float* r_k = a.in[21]; const float* sh0 = a.in[6];
    bf16* xs = (bf16*)lds;
    const int l = tid & 63, h = __builtin_amdgcn_readfirstlane(tid >> 6), rho = l & 31, hi = l >> 5;
    constexpr int ZP = 3408;
    unsigned char* zt = lds + 16384;
    for (int tile = blockIdx.x; tile < MT / 32; tile += gridDim.x) {
        const int m0 = tile * 32; const bool smp = m0 >= MP;
        const bool tile_first = smp || (m0 & (T_P - 1)) == 0;
        for (int i0 = tid; i0 < 33 * 212; i0 += 4 * 512) {
            u32x4 v[4];
#pragma unroll
            for (int j = 0; j < 4; ++j) { const int idx = i0 + j * 512; if (idx < 33 * 212) { const int r = idx / 212, c = idx - r * 212;
                    if (r == 0 && tile_first) { if (smp) { const float* sp = sh0 + (size_t)((m0 - MP) >> 5) * SHIFTW + 8 * c; const f32x4 a4 = *(const f32x4*)sp, b4 = *(const f32x4*)(sp + 4);
                            v[j] = (u32x4){pk2(a4.x, a4.y), pk2(a4.z, a4.w), pk2(b4.x, b4.y), pk2(b4.z, b4.w)}; } else v[j] = (u32x4){0u, 0u, 0u, 0u}; }
                    else v[j] = *(const u32x4*)(ZS + (size_t)(m0 + r - 1) * SHIFTW + 8 * c); } }
#pragma unroll
            for (int j = 0; j < 4; ++j) { const int idx = i0 + j * 512; if (idx < 33 * 212) { const int r = idx / 212, c = idx - r * 212; *(u32x4*)(zt + r * ZP + 16 * c) = v[j]; } }
        }
        __syncthreads();
        { const int tk = tid >> 4, c0 = (tid & 15) * 10;
          const bf16* zc = (const bf16*)(zt + (tk + 1) * ZP) + 1536 + c0; const bf16* zp = (const bf16*)(zt + tk * ZP) + 1536 + c0;
#pragma unroll
          for (int e = 0; e < 10; ++e) { const int c = c0 + e; const float cur = bf1(zc[e]); const float prev = bf1(zp[e]);
              const float zm = cur + mu[1536 + c] * (prev - cur);
              const float f = __frcp_rn(1.0f + __expf(c < 32 ? -2.0f * zm : -zm));
              const float v = c < 32 ? 2.0f * f - 1.0f : (c < 64 ? zm : f);
              xs[tk * XS_PITCH + c] = (bf16)f2bf(v); } }
        __syncthreads();
        const int m = m0 + rho;
        const bf16* zc = (const bf16*)(zt + (rho + 1) * ZP) + 64 * h + 4 * hi; const bf16* zp = (const bf16*)(zt + rho * ZP) + 64 * h + 4 * hi;
        const float* mu_l = mu + 64 * h + 4 * hi;
        const int pofs = 64 * h + 4 * hi;
#define ZMIX4(dst, co) do { const u32x2 cw = *(const u32x2*)(zc + (co)); const u32x2 pw = *(const u32x2*)(zp + (co)); const f32x4 mu4 = *(const f32x4*)(mu_l + (co)); \
            const float cu[4] = {bflo(cw.x), bfhi(cw.x), bflo(cw.y), bfhi(cw.y)}; const float pv[4] = {bflo(pw.x), bfhi(pw.x), bflo(pw.y), bfhi(pw.y)}; \
            _Pragma("unroll") for (int e = 0; e < 4; ++e) dst[e] = cu[e] + mu4[e] * (pv[e] - cu[e]); } while (0)
        float n2 = 0.f;
#pragma unroll
        for (int ct = 0; ct < 2; ++ct)
#pragma unroll
            for (int grp = 0; grp < 4; ++grp) { const int co = 32 * ct + 8 * grp; float zk[4]; ZMIX4(zk, 512 + co); const f32x4 kk4 = *(const f32x4*)(k_k + pofs + co);
#pragma unroll
                for (int e = 0; e < 4; ++e) { const float kr = zk[e] * kk4[e]; n2 += kr * kr; } }
        n2 += __shfl_xor(n2, 32);
        const float invn = 1.0f / fmaxf(sqrtf(n2), 1e-12f);
        float bon = 0.f;
        asm volatile("" ::: "memory");
#pragma unroll
        for (int ct = 0; ct < 2; ++ct) {
            const f32x16 z16 = {0.f, 0.f, 0.f, 0.f, 0.f, 0.f, 0.f, 0.f, 0.f, 0.f, 0.f, 0.f, 0.f, 0.f, 0.f, 0.f}; f32x16 Dw = z16, Da = z16, Dg = z16;
            const int n = 64 * h + 32 * ct + rho;
            const bf16* xrow = xs + rho * XS_PITCH + 8 * hi;
#pragma unroll
            for (int ks = 0; ks < 2; ++ks) {
                Dw = MFMA32(*(const bf16x8*)(w2t + n * 32 + 16 * ks + 8 * hi), *(const bf16x8*)(xrow + 16 * ks), Dw);
                Da = MFMA32(*(const bf16x8*)(a2t + n * 32 + 16 * ks + 8 * hi), *(const bf16x8*)(xrow + 32 + 16 * ks), Da); }
#pragma unroll
            for (int ks = 0; ks < 6; ++ks) Dg = MFMA32(*(const bf16x8*)(g2t + n * 96 + 16 * ks + 8 * hi), *(const bf16x8*)(xrow + 64 + 16 * ks), Dg);
#pragma unroll
            for (int grp = 0; grp < 4; ++grp) {
                const int co = 32 * ct + 8 * grp;
                float zr[4], zk[4], zv[4]; ZMIX4(zr, co); ZMIX4(zk, 512 + co); ZMIX4(zv, 1024 + co);
                const f32x4 w04 = *(const f32x4*)(w0 + pofs + co), a04 = *(const f32x4*)(a0 + pofs + co), kk4 = *(const f32x4*)(k_k + pofs + co), ka4 = *(const f32x4*)(k_a + pofs + co), rk4 = *(const f32x4*)(r_k + pofs + co);
                float dec[4], km[4], gg[4], kk[4], bb[4];
#pragma unroll
                for (int e = 0; e < 4; ++e) { const int r = 4 * grp + e;
                    const float sg = __frcp_rn(1.0f + __expf(-(w04[e] + Dw[r])));
                    dec[e] = __expf(-0.6065306597126334f * sg);
                    const float aa = __frcp_rn(1.0f + __expf(-(a04[e] + Da[r])));
                    gg[e] = Dg[r];
                    kk[e] = zk[e] * kk4[e] * invn; bb[e] = kk[e] * aa;
                    km[e] = zk[e] * (1.0f + (aa - 1.0f) * ka4[e]);
                    bon += zr[e] * km[e] * rk4[e]; }
                const size_t o = (size_t)m * 512 + pofs + co;
                *(f32x4*)(OW + o) = (f32x4){dec[0], dec[1], dec[2], dec[3]};
                *(u32x2*)(OKK + o) = (u32x2){pk2(kk[0], kk[1]), pk2(kk[2], kk[3])};
                *(u32x2*)(OB + o) = (u32x2){pk2(bb[0], bb[1]), pk2(bb[2], bb[3])};
                *(u32x2*)(OKM + o) = (u32x2){pk2(km[0], km[1]), pk2(km[2], km[3])};
                *(u32x2*)(OR_ + o) = (u32x2){pk2(zr[0], zr[1]), pk2(zr[2], zr[3])};
                *(u32x2*)(OV + o) = (u32x2){pk2(zv[0], zv[1]), pk2(zv[2], zv[3])};
                *(u32x2*)(G + o) = (u32x2){pk2(gg[0], gg[1]), pk2(gg[2], gg[3])};
                asm volatile("" ::: "memory");
            }
        }
#undef ZMIX4
        bon += __shfl_xor(bon, 32);
        if (hi == 0) BON[(size_t)m * 8 + h] = bon;
        __syncthreads();
    }
}

constexpr int SC_CH = 32;
static_assert(WS_OB - WS_OKK == 17 * MiB && WS_OKM - WS_OB == 17 * MiB && WS_OR - WS_OKM == 17 * MiB && WS_OV - WS_OR == 17 * MiB, "operand arrays are equally spaced");
__device__ __forceinline__ void cvt_store8(unsigned char* d, const u32x4 x) {
    *(u32x4*)d = (u32x4){x.x << 16, x.x & 0xffff0000u, x.y << 16, x.y & 0xffff0000u}; *(u32x4*)(d + 16) = (u32x4){x.z << 16, x.z & 0xffff0000u, x.w << 16, x.w & 0xffff0000u};
}
struct StageP {
    static constexpr int STRIDE = 1280 + 64;
    const unsigned char* pw; const unsigned char* pb; int vrow0;
    u32x4 v[25];
    __device__ __forceinline__ void issue(int t0, int lane) {
        const unsigned char* gw = pw + ((size_t)(t0 + (lane >> 4)) * 512) * 4 + 16 * (lane & 15);
#pragma unroll
        for (int j = 0; j < 8; ++j) v[j] = *(const u32x4*)(gw + (size_t)j * 4 * 512 * 4);
        const unsigned char* gb = pb + ((size_t)(t0 + (lane >> 3)) * 512) * 2 + 16 * (lane & 7);
#pragma unroll
        for (int a = 0; a < 4; ++a)
#pragma unroll
            for (int jj = 0; jj < 4; ++jj) v[8 + 4 * a + jj] = *(const u32x4*)(gb + (size_t)a * (17 * MiB) + (size_t)jj * 8 * 512 * 2);
        v[24] = *(const u32x4*)(pb + (size_t)4 * (17 * MiB) + ((size_t)(t0 + (lane >> 1)) * 512) * 2 + 2 * vrow0 + 16 * (lane & 1));
    }
    __device__ __forceinline__ void commit(unsigned char* buf, int lane) const {
        unsigned char* dw = buf + (lane >> 4) * STRIDE + 16 * (lane & 15);
#pragma unroll
        for (int j = 0; j < 8; ++j) *(u32x4*)(dw + j * 4 * STRIDE) = v[j];
        unsigned char* db = buf + (lane >> 3) * STRIDE + 256 + 32 * (lane & 7);
#pragma unroll
        for (int a = 0; a < 4; ++a)
#pragma unroll
            for (int jj = 0; jj < 4; ++jj) cvt_store8(db + a * 256 + jj * 8 * STRIDE, v[8 + 4 * a + jj]);
        cvt_store8(buf + (lane >> 1) * STRIDE + 1280 + 32 * (lane & 1), v[24]);
    }
};
struct StageS {
    static constexpr int STRIDE = 1280 + 256;
    const unsigned char* pw; const unsigned char* pb;
    u32x4 v[7];
    __device__ __forceinline__ void issue(int t0, int lane) {
        const unsigned char* gw = pw + ((size_t)(t0 + (lane >> 4)) * 512) * 4 + 16 * (lane & 15);
        v[0] = *(const u32x4*)gw; v[1] = *(const u32x4*)(gw + (size_t)4 * 512 * 4);
        const unsigned char* gb = pb + ((size_t)(t0 + (lane >> 3)) * 512) * 2 + 16 * (lane & 7);
#pragma unroll
        for (int a = 0; a < 5; ++a) v[2 + a] = *(const u32x4*)(gb + (size_t)a * (17 * MiB));
    }
    __device__ __forceinline__ void commit(unsigned char* buf, int lane) const {
        unsigned char* dw = buf + (lane >> 4) * STRIDE + 16 * (lane & 15);
        *(u32x4*)dw = v[0]; *(u32x4*)(dw + 4 * STRIDE) = v[1];
        unsigned char* db = buf + (lane >> 3) * STRIDE + 256 + 32 * (lane & 7);
#pragma unroll
        for (int a = 0; a < 5; ++a) cvt_store8(db + a * 256, v[2 + a]);
    }
};
typedef float f32x2 __attribute__((ext_vector_type(2)));
template <int STRIDE, bool YLDS> __device__ __forceinline__ void scan_consume(f32x4& S4, const unsigned char* buf, int nst, int ks, int rowl, float* yp, float* ypart) {
    f32x2 Sa = {S4.x, S4.y}, Sb = {S4.z, S4.w};
    for (int s0 = 0; s0 < nst; s0 += 16) {
        float ykeep = 0.f;
#pragma unroll 1
        for (int g = 0; g < 4; ++g) {
            const int kq = ks - 4 * g;
#pragma unroll
            for (int j = 0; j < 4; ++j) {
                const float* p = (const float*)(buf + (s0 + 4 * g + j) * STRIDE) + 4 * ks;
                const f32x2 wa = *(const f32x2*)(p), wb = *(const f32x2*)(p + 2), ka = *(const f32x2*)(p + 64), kb = *(const f32x2*)(p + 66), ba = *(const f32x2*)(p + 128), bb = *(const f32x2*)(p + 130),
                            ma = *(const f32x2*)(p + 192), mb = *(const f32x2*)(p + 194), ra = *(const f32x2*)(p + 256), rb = *(const f32x2*)(p + 258);
                const float v = ((const float*)(buf + (s0 + 4 * g + j) * STRIDE))[320 + rowl];
                f32x2 t = Sa * ka + Sb * kb; float d = t.x + t.y; d = sum16(d);
                const f32x2 vv = {v, v}, dd = {d, d};
                Sa = Sa * wa + (vv * ma - dd * ba); Sb = Sb * wb + (vv * mb - dd * bb);
                f32x2 u = Sa * ra + Sb * rb; float y = u.x + u.y;
                if constexpr (YLDS) ypart[(s0 + 4 * g + j) * 256] = y;
                else { y = sum16(y); ykeep = kq == j ? y : ykeep; }
            }
        }
        if constexpr (!YLDS) yp[(size_t)(s0 + ks) * 512] = ykeep;
    }
    S4 = (f32x4){Sa.x, Sa.y, Sb.x, Sb.y};
}
__device__ __forceinline__ void scan_yreduce(const float* ypart, float* yg, int pt) {
#pragma unroll
    for (int k = 0; k < 2; ++k) { const int o = pt + 256 * k; const f32x4* q = (const f32x4*)(ypart + o * 16);
        const f32x4 a = q[0], b = q[1], c = q[2], d = q[3]; const f32x4 e = (a + b) + (c + d);
        yg[(size_t)(o >> 4) * 512 + (o & 15)] = (e.x + e.y) + (e.z + e.w); }
}
__device__ __forceinline__ void p5_rwkv_scan(const Args& a, unsigned char* lds, int tid) {
    const unsigned char* ws = a.ws; float* out = a.out; float* Y = out + SC_Y;
    const int l = tid & 63, w = __builtin_amdgcn_readfirstlane(tid >> 6), ks = l & 15, rl = l >> 4;
    const int G = gridDim.x, vcu = (G % 8 == 0) ? (blockIdx.x % 8) * (G / 8) + blockIdx.x / 8 : blockIdx.x;
    typedef StageP StP; typedef StageS StS;
    unsigned char* buf0 = lds; unsigned char* buf1 = lds + SC_CH * StP::STRIDE;
    for (int it = vcu; it < 256; it += G) {
        {
            const int bh = it >> 2, b = bh >> 3, h = bh & 7, rb = it & 3, row = 16 * rb + 4 * w + rl;
            const size_t base0 = ((size_t)b * T_P) * 512 + (size_t)h * 64;
            constexpr int NC = T_P / SC_CH;
            StP st; st.pw = ws + WS_OW + base0 * 4; st.pb = ws + WS_OKK + base0 * 2; st.vrow0 = 16 * rb;
            f32x4 S = {0.f, 0.f, 0.f, 0.f};
            if (w >= 4) { if (w == 4) { st.issue(0, l); st.commit(buf0, l); st.issue(4 * SC_CH, l); } else st.issue((w - 4) * SC_CH, l); }
            else __builtin_amdgcn_s_setprio(3);
            __syncthreads();
            Y += base0 + row;
            float* yp0 = (float*)(lds + 2 * SC_CH * StP::STRIDE); float* yp1 = yp0 + SC_CH * 256;
#define SCAN_ITER(c, P, cur, nxt, ypc, ypp) do { if (w >= 4) { if ((c) > 0) scan_yreduce(ypp, Y - row + 16 * rb + (size_t)(((c) - 1) * SC_CH) * 512, tid - 256); \
                    if (w == 4 + (P)) { if ((c) + 1 < NC) { st.commit(nxt, l); if ((c) + 5 < NC) st.issue(((c) + 5) * SC_CH, l); } } } \
                else scan_consume<StP::STRIDE, true>(S, cur, SC_CH, ks, 4 * w + rl, nullptr, ypc + tid); __syncthreads(); } while (0)
            for (int c = 0; c < NC; c += 4) { SCAN_ITER(c, 1, buf0, buf1, yp0, yp1); SCAN_ITER(c + 1, 2, buf1, buf0, yp1, yp0); SCAN_ITER(c + 2, 3, buf0, buf1, yp0, yp1); SCAN_ITER(c + 3, 0, buf1, buf0, yp1, yp0); }
            if (w >= 4) scan_yreduce(yp1, Y - row + 16 * rb + (size_t)((NC - 1) * SC_CH) * 512, tid - 256);
#undef SCAN_ITER
            __builtin_amdgcn_s_setprio(0);
            Y -= base0 + row;
            if (w < 4) *(f32x4*)(out + OFF_WKVP + ((size_t)bh * 64 + row) * 64 + 4 * ks) = S;
        }
        {
            const int b = it >> 3, h = it & 7;
            const size_t base0 = ((size_t)MP + (size_t)b * T_S) * 512 + (size_t)h * 64;
            StS st; st.pw = ws + WS_OW + base0 * 4; st.pb = ws + WS_OKK + base0 * 2;
            if (w >= 4) { st.issue(8 * (w - 4), l); st.commit(buf0 + 8 * (w - 4) * StS::STRIDE, l); }
            __syncthreads();
            for (int pass = 0; pass < 2; ++pass) { const int row = 8 * w + 4 * pass + rl;
                f32x4 S = *(const f32x4*)(a.in[5] + ((size_t)it * 64 + row) * 64 + 4 * ks);
                scan_consume<StS::STRIDE, false>(S, buf0, T_S, ks, row, Y + base0 + row, nullptr);
                *(f32x4*)(out + OFF_WKVS + ((size_t)it * 64 + row) * 64 + 4 * ks) = S; }
            __syncthreads();
        }
    }
}

__device__ __forceinline__ void p6_rwkv_out(const Args& a, int tid) {
    const unsigned char* ws = a.ws; const float* out = a.out; const float* Y = out + SC_Y; const bf16* G = (const bf16*)(out + SC_G);
    const bf16* OV = (const bf16*)(ws + WS_OV); const float* BON = (const float*)(ws + WS_BONUS); bf16* O = (bf16*)(a.ws + WS_XB);
    const float* lg = a.in[22]; const float* lb = a.in[23];
    const int sub = tid & 7;
    const size_t NIT = (size_t)MT * 8, STEP = (size_t)gridDim.x * 64;
    size_t it = (size_t)blockIdx.x * 64 + (tid >> 3);
    f32x4 y0, y1; u32x4 vw, gw_; float bon = 0.f;
#define P6_LOAD(it_) do { const size_t o_ = ((it_) >> 3) * 512 + ((it_) & 7) * 64 + 8 * sub; y0 = *(const f32x4*)(Y + o_); y1 = *(const f32x4*)(Y + o_ + 4); vw = *(const u32x4*)(OV + o_); gw_ = *(const u32x4*)(G + o_); bon = BON[it_]; } while (0)
    if (it < NIT) P6_LOAD(it);
    for (; it < NIT; it += STEP) {
        const size_t m = it >> 3; const int h = (int)(it & 7);
        float y[8] = {y0.x, y0.y, y0.z, y0.w, y1.x, y1.y, y1.z, y1.w}; float v[8], g[8]; unpack8(vw, v); unpack8(gw_, g); const float bn = bon;
        if (it + STEP < NIT) P6_LOAD(it + STEP);
        float s1 = 0.f;
#pragma unroll
        for (int j = 0; j < 8; ++j) s1 += y[j];
        s1 += __shfl_xor(s1, 1); s1 += __shfl_xor(s1, 2); s1 += __shfl_xor(s1, 4);
        const float mean = s1 * (1.f / 64.f); float s2 = 0.f;
#pragma unroll
        for (int j = 0; j < 8; ++j) { const float d = y[j] - mean; s2 += d * d; }
        s2 += __shfl_xor(s2, 1); s2 += __shfl_xor(s2, 2); s2 += __shfl_xor(s2, 4);
        const float rinv = rsqrtf(s2 * (1.f / 64.f) + 64e-5f);
        float r[8];
#pragma unroll
        for (int j = 0; j < 8; ++j) { const int c = h * 64 + 8 * sub + j; r[j] = ((y[j] - mean) * rinv * lg[c] + lb[c] + bn * v[j]) * g[j]; }
        *(u32x4*)(O + m * DM + 512 + h * 64 + 8 * sub) = pack8(r);
    }
#undef P6_LOAD
}

__device__ __forceinline__ void p8_hnorm(const Args& a, int tid) {
    const int lane = tid & 63, gw = blockIdx.x * 8 + (tid >> 6), NGW = gridDim.x * 8;
    for (int m = gw; m < MT; m += NGW) {
        const f32x4* xr = (const f32x4*)(a.out + OFF_Y + (size_t)m * DM) + lane; f32x4 v[4]; float s = 0.f;
#pragma unroll
        for (int j = 0; j < 4; ++j) { v[j] = xr[64 * j]; s += (v[j].x * v[j].x + v[j].y * v[j].y) + (v[j].z * v[j].z + v[j].w * v[j].w); }
        const float rs = rsqrtf(wave_sum(s) * (1.f / DM) + 1e-6f);
        u32x2* o8 = (u32x2*)((bf16*)(a.ws + WS_HB) + (size_t)m * DM) + lane;
#pragma unroll
        for (int j = 0; j < 4; ++j) { u32x2 o; o.x = pk2(v[j].x * rs, v[j].y * rs); o.y = pk2(v[j].z * rs, v[j].w * rs); o8[64 * j] = o; }
    }
}

#define XB_TMO      128
#define XB_XCNT(j)  (256  + 64 * (j))
#define XB_XSUB(j)  (1280 + 64 * (j))
#define XB_XGEN(j)  (2304 + 64 * (j))
#define XB_TOP      3328
#define XB_TOPGEN   3392
#define XCD_BAR_WORDS 3456
#define XB_SPIN_CAP (1u << 18)

__device__ __forceinline__ unsigned xb_ld(unsigned* p)              { return __hip_atomic_load(p, __ATOMIC_RELAXED, __HIP_MEMORY_SCOPE_AGENT); }
__device__ __forceinline__ unsigned xb_add(unsigned* p, unsigned v) { return __hip_atomic_fetch_add(p, v, __ATOMIC_RELAXED, __HIP_MEMORY_SCOPE_AGENT); }
__device__ __forceinline__ unsigned xb_xcc_id() { return (unsigned)__builtin_amdgcn_s_getreg((3 << 11) | 20) & 0xFu; }
#define XB_SPIN(cond, bar) do { unsigned _sp = 0; while (cond) { __builtin_amdgcn_s_sleep(1); \
    if ((++_sp & 255u) == 0u) { if (xb_ld(&(bar)[XB_TMO])) break; if (_sp > XB_SPIN_CAP) { atomicAdd(&(bar)[XB_TMO], 1u); break; } } } } while (0)

struct XcdBarrier {
    unsigned* bar; unsigned x;
    volatile __attribute__((address_space(3))) unsigned* st;
};

__device__ __forceinline__ XcdBarrier xcd_barrier_post(unsigned* bar, volatile __attribute__((address_space(3))) unsigned* st) {
    XcdBarrier b; b.bar = bar; b.x = xb_xcc_id(); b.st = st;
    if (threadIdx.x == 0) (void)xb_add(&bar[XB_XCNT(b.x)], 1u);
    return b;
}
__device__ __forceinline__ void xcd_barrier_complete(unsigned* bar, unsigned x, unsigned& nloc, unsigned& nx) {
    const unsigned G = gridDim.x * gridDim.y * gridDim.z;
    unsigned sum, cnt, mine, sp = 0u;
    for (;;) {
        sum = 0u; cnt = 0u; mine = 0u;
#pragma unroll
        for (unsigned j = 0; j < 16; ++j) { const unsigned c = xb_ld(&bar[XB_XCNT(j)]); sum += c; cnt += (c > 0u) ? 1u : 0u; mine = (j == x) ? c : mine; }
        if (sum == G) break;
        __builtin_amdgcn_s_sleep(1);
        if ((++sp & 255u) == 0u) { if (xb_ld(&bar[XB_TMO])) break; if (sp > XB_SPIN_CAP) { atomicAdd(&bar[XB_TMO], 1u); break; } }
    }
    nloc = mine > 0u ? mine : 1u; nx = cnt > 0u ? cnt : 1u;
}

__device__ __forceinline__ void xcd_barrier(const XcdBarrier& b) {
    asm volatile("s_waitcnt vmcnt(0)" ::: "memory");
    __syncthreads();
    if (threadIdx.x == 0) {
        unsigned* bar = b.bar;
        __builtin_amdgcn_s_waitcnt(0);
        unsigned nloc = b.st[0], nx = b.st[1];
        if (nloc == 0u) { xcd_barrier_complete(bar, b.x, nloc, nx); b.st[0] = nloc; b.st[1] = nx; }
        const unsigned old = xb_add(&bar[XB_XSUB(b.x)], 1u);
        const unsigned gen = old / nloc;
        if (old + 1u == (gen + 1u) * nloc) {
            __builtin_amdgcn_fence(__ATOMIC_RELEASE, "agent");
            asm volatile("s_waitcnt vmcnt(0)" ::: "memory");
            const unsigned og = xb_add(&bar[XB_TOP], 1u);
            const unsigned tg = og / nx;
            if (og + 1u == (tg + 1u) * nx) xb_add(&bar[XB_TOPGEN], 1u);
            else XB_SPIN(xb_ld(&bar[XB_TOPGEN]) == tg, bar);
            __builtin_amdgcn_fence(__ATOMIC_ACQUIRE, "agent");
            xb_add(&bar[XB_XGEN(b.x)], 1u);
            asm volatile("s_waitcnt vmcnt(0)" ::: "memory");
        } else {
            XB_SPIN(xb_ld(&bar[XB_XGEN(b.x)]) == gen, bar);
            __builtin_amdgcn_fence(__ATOMIC_ACQUIRE, "agent");
            asm volatile("s_waitcnt vmcnt(0)" ::: "memory");
        }
    }
    __syncthreads();
}

constexpr int CW_BAR = 4096;
constexpr int LDS_BYTES = 163840;
constexpr int N_PHASES = 12;
#ifndef PROBE_MASK
#define PROBE_MASK 0
#endif
template <int PH> __device__ __forceinline__ void run_phase(const Args& args, unsigned char* lds, int tid, int rep) {
    unsigned char* ws = args.ws;
    if constexpr (PH == 0) p0_prologue(args, lds, tid);
    if constexpr (PH == 1) { pg8::Gemm g{(const pg8::bf16_t*)(ws + WS_XB), (const pg8::bf16_t*)(ws + WS_WIN), MT, NZ, DM, DM}; pg8::StaticOrder S; S.init(MT, NZ, gridDim.x, blockIdx.x);
        pg8::EpiZ E{(pg8::bf16_t*)(ws + WS_ZR), (pg8::bf16_t*)(ws + WS_ZS)};
        pg8::gemm_phase<pg8::EpiZ, pg8::StaticOrder, true, true>((PG8_LAS unsigned char*)lds, g, S, E); }
    if constexpr (PH == 2) p2_post(args, lds, tid);
    if constexpr (PH == 3) p3_attention(args, lds, tid, rep);
    if constexpr (PH == 4) p4_rwkv_prep(args, lds, tid);
    if constexpr (PH == 5) p5_rwkv_scan(args, lds, tid);
    if constexpr (PH == 6) p6_rwkv_out(args, tid);
    if constexpr (PH == 7) { pg8::Gemm g{(const pg8::bf16_t*)(ws + WS_XB), (const pg8::bf16_t*)(ws + WS_WOUT), MT, DM, DM, DM}; pg8::StaticOrder S; S.init(MT, DM, gridDim.x, blockIdx.x);
        pg8::EpiH E{args.in[0], args.in[1], args.out + OFF_Y, (pg8::bf16_t*)(ws + WS_HB), (float*)(ws + WS_CTL) + CW_SS};
        pg8::gemm_phase<pg8::EpiH, pg8::StaticOrder, true, true>((PG8_LAS unsigned char*)lds, g, S, E); }
    if constexpr (PH == 9) { pg8::Gemm g{(const pg8::bf16_t*)(ws + WS_HB), (const pg8::bf16_t*)(ws + WS_W1), MT, DFF, DM, DM}; pg8::StaticOrder S; S.init(MT, DFF, gridDim.x, blockIdx.x);
        pg8::EpiAct E{(pg8::bf16_t*)(ws + WS_ACT), DFF, (const float*)(ws + WS_CTL) + CW_SS};
        pg8::gemm_phase<pg8::EpiAct, pg8::StaticOrder, true, true>((PG8_LAS unsigned char*)lds, g, S, E); }
    if constexpr (PH == 10) {
        { pg8::Gemm g{(const pg8::bf16_t*)(ws + WS_ACT), (const pg8::bf16_t*)(ws + WS_W2), MP, DM, DFF, DFF}; pg8::StaticOrder S; S.init(MP, DM, gridDim.x, blockIdx.x);
          pg8::EpiY E{args.out + OFF_Y};
          pg8::gemm_phase<pg8::EpiY, pg8::StaticOrder, true, true>((PG8_LAS unsigned char*)lds, g, S, E); }
        { const int c = blockIdx.x; pg8::OneUnit S; S.has = c < 64; S.u.pm = MP / 256 + (c >> 4); S.u.pn = (c >> 2) & 3; const int sl = c & 3;
          pg8::Gemm g{(const pg8::bf16_t*)(ws + WS_ACT) + sl * 1024, (const pg8::bf16_t*)(ws + WS_W2) + sl * 1024, MT, DM, DFF, 1024};
          pg8::EpiSlab E{(float*)(ws + WS_HB) + (size_t)sl * MS * DM};
          __syncthreads();
          pg8::gemm_phase<pg8::EpiSlab, pg8::OneUnit, false, true>((PG8_LAS unsigned char*)lds, g, S, E); }
    }
    if constexpr (PH == 11) {
        const f32x4* sl = (const f32x4*)(ws + WS_HB); f32x4* y = (f32x4*)(args.out + OFF_Y + (size_t)MP * DM); constexpr int NV = MS * DM / 4;
        for (int i = blockIdx.x * 512 + tid; i < NV; i += gridDim.x * 512) y[i] = y[i] + ((sl[i] + sl[i + NV]) + (sl[i + 2 * NV] + sl[i + 3 * NV]));
    }
}
#ifndef MK_ONE_LAUNCH
#define MK_ONE_LAUNCH 1
#endif
#if MK_ONE_LAUNCH
__global__ void __launch_bounds__(512, 2) mk_fwd(Args args) {
    extern __shared__ __attribute__((aligned(16))) unsigned char lds[];
    const int tid = threadIdx.x;
    volatile __attribute__((address_space(3))) unsigned* bst = (volatile __attribute__((address_space(3))) unsigned*)((__attribute__((address_space(3))) unsigned char*)lds + LDS_BYTES - 16);
    if (tid < 2) bst[tid] = 0u;
    __syncthreads();
    const XcdBarrier bar = xcd_barrier_post((unsigned*)(args.ws + WS_CTL) + CW_BAR, bst);
    if (args.ph_lo < 0) { __syncthreads(); cg::this_grid().sync(); }
#define SEAM(k) xcd_barrier(bar)
#define PHASE(k) do { if (args.ph_lo <= (k) && (k) < args.ph_hi) { if ((k) > args.ph_lo) SEAM(k); run_phase<k>(args, lds, tid, 0); \
        if ((PROBE_MASK >> (k)) & 1) { xcd_barrier(bar); run_phase<k>(args, lds, tid, 1); } } } while (0)
    PHASE(0); PHASE(1); PHASE(2); PHASE(3); PHASE(4); PHASE(5); PHASE(6); PHASE(7); PHASE(9); PHASE(10); PHASE(11);
#undef PHASE
#undef SEAM
}
#else
template <int PH> __global__ void __launch_bounds__(512, 2) mk_phase(Args args) {
    extern __shared__ __attribute__((aligned(16))) unsigned char lds[];
    run_phase<PH>(args, lds, threadIdx.x, 0);
}
#endif

extern "C" void kernel_launch(void* const* d_in, const int* in_sizes, int n_in, void* d_out, int out_size, void* d_ws, size_t ws_size, hipStream_t stream) {
    static int grid = 0;
    if (grid == 0) {
        if (n_in != 28 || out_size != (int)OUT_TOTAL || ws_size < WS_END) { fprintf(stderr, "kernel_launch: unexpected shapes (n_in %d, out %d, ws %zu)\n", n_in, out_size, ws_size); grid = -1; return; }
        int dev = 0, cus = 0, per_cu = 0;
        (void)hipGetDevice(&dev); (void)hipDeviceGetAttribute(&cus, hipDeviceAttributeMultiprocessorCount, dev);
#if MK_ONE_LAUNCH
        if (hipFuncSetAttribute((const void*)mk_fwd, hipFuncAttributeMaxDynamicSharedMemorySize, LDS_BYTES) != hipSuccess) { fprintf(stderr, "kernel_launch: hipFuncSetAttribute failed\n"); grid = -1; return; }
        (void)hipOccupancyMaxActiveBlocksPerMultiprocessor(&per_cu, (const void*)mk_fwd, 512, LDS_BYTES);
        (void)hipGetLastError();
        if (per_cu < 1) { fprintf(stderr, "kernel_launch: occupancy query says %d blocks per CU\n", per_cu); per_cu = 1; }
#else
#define SETATTR(k) (void)hipFuncSetAttribute((const void*)mk_phase<k>, hipFuncAttributeMaxDynamicSharedMemorySize, LDS_BYTES)
        SETATTR(0); SETATTR(1); SETATTR(2); SETATTR(3); SETATTR(4); SETATTR(5); SETATTR(6); SETATTR(7); SETATTR(8); SETATTR(9); SETATTR(10); SETATTR(11);
#undef SETATTR
        (void)per_cu;
#endif
        grid = cus;
    }
    if (grid < 0) return;
    (void)hipMemsetAsync((char*)d_ws + WS_CTL, 0, CTL_BYTES, stream);
    Args a{};
    for (int i = 0; i < 28; ++i) a.in[i] = (const float*)d_in[i];
    a.out = (float*)d_out; a.ws = (unsigned char*)d_ws;
#if MK_ONE_LAUNCH
    a.ph_lo = 0; a.ph_hi = N_PHASES;
    void* kargs[] = {&a};
    hipError_t e = hipLaunchCooperativeKernel((const void*)mk_fwd, dim3(grid), dim3(512), kargs, LDS_BYTES, stream);
    if (e != hipSuccess) fprintf(stderr, "kernel_launch: cooperative launch failed: %s (grid %d)\n", hipGetErrorString(e), grid);
#else
#define LAUNCH(k) hipLaunchKernelGGL(mk_phase<k>, dim3(grid), dim3(512), LDS_BYTES, stream, a)
    a.ph_lo = 0; a.ph_hi = N_PHASES;
    LAUNCH(0); LAUNCH(1); LAUNCH(2); LAUNCH(3); LAUNCH(4); LAUNCH(5); LAUNCH(6); LAUNCH(7); LAUNCH(9); LAUNCH(10); LAUNCH(11);
#undef LAUNCH
#endif
}
```

```cpp
#include <hip/hip_runtime.h>
#include <hip/hip_cooperative_groups.h>
#include <cstdio>
#include <cstdint>
namespace cg = cooperative_groups;
#define PROBE_A1 0
#define PROBE_A2 0
#define PROBE_A3 0
namespace pg8 {
#define PG8_LAS __attribute__((address_space(3)))
typedef unsigned short bf16_t;
typedef short bf16x8 __attribute__((ext_vector_type(8)));
typedef float f32x4 __attribute__((ext_vector_type(4)));
typedef unsigned u32x4 __attribute__((ext_vector_type(4)));
constexpr int BM = 256, BK = 64, HALF = 128, HTB = HALF * BK * 2  , STAGE_BYTES = 8 * HTB, NXCD = 8, WGM = 8;

__host__ __device__ __forceinline__ int lds_byte(int r, int c) { const int st = (r >> 4) * 2 + (c >> 5), rr = r & 15, cc = c & 31, ob = rr * 64 + cc * 2; return st * 1024 + (ob ^ (((ob >> 9) & 1) << 5)); }
__host__ __device__ __forceinline__ void stage_rc(int b, int& R, int& C) { const int st = b / 1024, sb = b % 1024, swz = sb ^ (((sb >> 9) & 1) << 5); R = (st >> 1) * 16 + swz / 64; C = (st & 1) * 32 + (swz % 64) / 2; }
__host__ __device__ __forceinline__ int perm32(int rho) { const int n = rho >> 4, i = rho & 15; return 8 * (i >> 2) + 4 * n + (i & 3); }

struct Unit { int pm, pn; };
struct Gemm { const bf16_t* A; const bf16_t* Bt; int M, N, K, KL; };

struct StaticOrder {
    int nM, nN, nwg, G, c;
    __host__ __device__ void init(int M, int N, int G_, int c_) { nM = M / BM; nN = N / BM; nwg = nM * nN; G = G_; c = c_; }
    __host__ __device__ bool next(int i, Unit& u) const {
        const long L = (long)i * G + c; if (L >= nwg) return false;
        int wgid = (int)L; { const int q = nwg / NXCD, r = nwg % NXCD, xcd = wgid % NXCD, off = wgid / NXCD; wgid = (xcd < r ? xcd * (q + 1) : r * (q + 1) + (xcd - r) * q) + off; }
        const int nig = WGM * nN, gid = wgid / nig, fm = gid * WGM, gsz = (nM - fm) < WGM ? (nM - fm) : WGM;
        u.pm = fm + ((wgid % nig) % gsz); u.pn = (wgid % nig) / gsz; return true;
    }
    __device__ __forceinline__ void a_ready(const Unit&) const {}
    __device__ __forceinline__ void done(const Unit&) const {}
};


__device__ __forceinline__ unsigned cvt_pk_bf16(float lo, float hi) { unsigned r; asm volatile("v_cvt_pk_bf16_f32 %0, %1, %2" : "=v"(r) : "v"(lo), "v"(hi)); return r; }

constexpr int E_MP = 16384;
constexpr int E_ZRW = 1632, E_ZSW = 1696;

struct OneUnit { Unit u; bool has;
    __device__ __forceinline__ bool next(int i, Unit& o) const { if (i == 0 && has) { o = u; return true; } return false; }
    __device__ __forceinline__ void a_ready(const Unit&) const {}
    __device__ __forceinline__ void done(const Unit&) const {} };
struct EpiZ {
    static constexpr bool PERM = true, AFTER_DRAIN = false;
    bf16_t* ZR; bf16_t* ZS;
    __device__ __forceinline__ void operator()(const f32x4 (&acc)[2][2][4][2], const Unit& u, int wr, int wc, int fr, int fq) const {
        const int row0 = u.pm * BM + wr * 64 + fr, c0 = u.pn * BM + wc * 32 + 8 * fq;
#pragma unroll
        for (int ai = 0; ai < 2; ++ai)
#pragma unroll
            for (int m = 0; m < 4; ++m) { const size_t row = (size_t)(row0 + ai * HALF + m * 16);
#pragma unroll
                for (int bj = 0; bj < 2; ++bj) { const int c = c0 + bj * HALF; bf16_t* dst;
                    if (c < 1600) dst = ZR + row * E_ZRW + c; else if (c < 3296) dst = ZS + row * E_ZSW + (c - 1600); else if (c == 3296) dst = ZR + row * E_ZRW + 1600; else continue;
                    const f32x4 v0 = acc[ai][bj][m][0], v1 = acc[ai][bj][m][1]; u32x4 w;
                    w.x = cvt_pk_bf16(v0[0], v0[1]); w.y = cvt_pk_bf16(v0[2], v0[3]); w.z = cvt_pk_bf16(v1[0], v1[1]); w.w = cvt_pk_bf16(v1[2], v1[3]);
                    *(u32x4*)dst = w; } }
    }
};
struct EpiH {
    static constexpr bool PERM = false, AFTER_DRAIN = false;
    const float* xp; const float* xs; float* H; bf16_t* HB; float* SS;
    __device__ __forceinline__ void operator()(const f32x4 (&acc)[2][2][4][2], const Unit& u, int wr, int wc, int fr, int fq) const {
        const int row0 = u.pm * BM + wr * 64 + fr, col0 = u.pn * BM + wc * 32 + 4 * fq;
#pragma unroll
        for (int ai = 0; ai < 2; ++ai)
#pragma unroll
            for (int m = 0; m < 4; ++m) { const int row = row0 + ai * HALF + m * 16;
                const float* xr = (row < E_MP ? xp + (size_t)row * 1024 : xs + (size_t)(row - E_MP) * 1024) + col0; float* hr = H + (size_t)row * 1024 + col0; bf16_t* hb = HB + (size_t)row * 1024 + col0;
                float ss = 0.f;
#pragma unroll
                for (int bj = 0; bj < 2; ++bj)
#pragma unroll
                    for (int n = 0; n < 2; ++n) { const f32x4 h = *(const f32x4*)(xr + bj * HALF + n * 16) + acc[ai][bj][m][n]; *(f32x4*)(hr + bj * HALF + n * 16) = h;
                        ss += (h[0] * h[0] + h[1] * h[1]) + (h[2] * h[2] + h[3] * h[3]);
                        unsigned w0 = cvt_pk_bf16(h[0], h[1]), w1 = cvt_pk_bf16(h[2], h[3]); typedef unsigned u32x2v __attribute__((ext_vector_type(2))); *(u32x2v*)(hb + bj * HALF + n * 16) = (u32x2v){w0, w1}; }
                ss += __shfl_xor(ss, 16); ss += __shfl_xor(ss, 32);
                if (fq == 0) atomicAdd(SS + row, ss); }
    }
};
struct EpiAct {
    static constexpr bool PERM = true, AFTER_DRAIN = false;
    bf16_t* O; int ldc; const float* SS;
    __device__ __forceinline__ void operator()(const f32x4 (&acc)[2][2][4][2], const Unit& u, int wr, int wc, int fr, int fq) const {
        const int row0 = u.pm * BM + wr * 64 + fr, c0 = u.pn * BM + wc * 32 + 8 * fq;
#pragma unroll
        for (int ai = 0; ai < 2; ++ai)
#pragma unroll
            for (int m = 0; m < 4; ++m) { const int row = row0 + ai * HALF + m * 16; bf16_t* rowp = O + (size_t)row * ldc + c0;
                const float rs = rsqrtf(SS[row] * (1.0f / 1024.0f) + 1e-6f);
#pragma unroll
                for (int bj = 0; bj < 2; ++bj) { f32x4 v0 = acc[ai][bj][m][0], v1 = acc[ai][bj][m][1];
#pragma unroll
                    for (int e = 0; e < 4; ++e) { const float a = fmaxf(v0[e], 0.f) * rs, b = fmaxf(v1[e], 0.f) * rs; v0[e] = a * a; v1[e] = b * b; }
                    u32x4 w; w.x = cvt_pk_bf16(v0[0], v0[1]); w.y = cvt_pk_bf16(v0[2], v0[3]); w.z = cvt_pk_bf16(v1[0], v1[1]); w.w = cvt_pk_bf16(v1[2], v1[3]);
                    *(u32x4*)(rowp + bj * HALF) = w; } }
    }
};
struct EpiSlab {
    static constexpr bool PERM = false, AFTER_DRAIN = false;
    float* S;
    __device__ __forceinline__ void operator()(const f32x4 (&acc)[2][2][4][2], const Unit& u, int wr, int wc, int fr, int fq) const {
        const int row0 = u.pm * BM - E_MP + wr * 64 + fr, col0 = u.pn * BM + wc * 32 + 4 * fq;
#pragma unroll
        for (int ai = 0; ai < 2; ++ai)
#pragma unroll
            for (int m = 0; m < 4; ++m) { float* yr = S + (size_t)(row0 + ai * HALF + m * 16) * 1024 + col0;
#pragma unroll
                for (int bj = 0; bj < 2; ++bj)
#pragma unroll
                    for (int n = 0; n < 2; ++n) *(f32x4*)(yr + bj * HALF + n * 16) = acc[ai][bj][m][n]; }
    }
};
struct EpiY {
    static constexpr bool PERM = false, AFTER_DRAIN = false;
    float* Y;
    __device__ __forceinline__ void operator()(const f32x4 (&acc)[2][2][4][2], const Unit& u, int wr, int wc, int fr, int fq) const {
        const int row0 = u.pm * BM + wr * 64 + fr, col0 = u.pn * BM + wc * 32 + 4 * fq;
#pragma unroll
        for (int ai = 0; ai < 2; ++ai)
#pragma unroll
            for (int m = 0; m < 4; ++m) { float* yr = Y + (size_t)(row0 + ai * HALF + m * 16) * 1024 + col0;
#pragma unroll
                for (int bj = 0; bj < 2; ++bj)
#pragma unroll
                    for (int n = 0; n < 2; ++n) { f32x4* p = (f32x4*)(yr + bj * HALF + n * 16); *p = *p + acc[ai][bj][m][n]; } }
    }
};

template <class Epi, class Sched, bool ALIGN_EPI = false, bool SP2 = false>
__device__ __forceinline__ void gemm_phase(PG8_LAS unsigned char* lds, const Gemm g, const Sched& S, const Epi& E) {
    const int tid = threadIdx.x, wid = __builtin_amdgcn_readfirstlane(tid >> 6), lane = tid & 63, wr = wid >> 2, wc = wid & 3, fr = lane & 15, fq = lane >> 4;
    const int K = g.K, nt = g.KL / BK;
    unsigned voffA[2], voffB[2];
#pragma unroll
    for (int i = 0; i < 2; ++i) { int R, C; stage_rc(tid * 16 + i * 8192, R, C); const int Rb = Epi::PERM ? ((R & ~31) + perm32(R & 31)) : R;
        voffA[i] = (unsigned)(R * K + C) * 2u; voffB[i] = (unsigned)(Rb * K + C) * 2u; }
    const size_t kstep = (size_t)(BK * 2);
    const size_t hstep = (size_t)HALF * K * 2;
    const size_t tstep = 2 * hstep;
    const unsigned ldsw = (unsigned)wid * 1024u;
    const int aoff = lds_byte(wr * 64 + fr, fq * 8), boff = lds_byte(wc * 32 + fr, fq * 8);
#define PG8_SA(b, h) (((b) * 2 + (h)) * HTB)
#define PG8_SB(b, h) ((4 + (b) * 2 + (h)) * HTB)
#define PG8_STAGE(bufoff, gbase, voff) do { _Pragma("unroll") for (int _i = 0; _i < 2; ++_i) \
        __builtin_amdgcn_global_load_lds((const unsigned*)((const char*)(gbase) + (voff)[_i]), (PG8_LAS unsigned*)(lds + (bufoff) + ldsw + _i * 8192), 16, 0, 0); } while (0)
#define PG8_LDA(dst, b, h) do { _Pragma("unroll") for (int m = 0; m < 4; ++m) _Pragma("unroll") for (int k = 0; k < 2; ++k) dst[m][k] = *(const PG8_LAS bf16x8*)(lds + PG8_SA(b, h) + aoff + m * 2048 + k * 1024); } while (0)
#define PG8_LDB(dst, b, h) do { _Pragma("unroll") for (int n = 0; n < 2; ++n) _Pragma("unroll") for (int k = 0; k < 2; ++k) dst[n][k] = *(const PG8_LAS bf16x8*)(lds + PG8_SB(b, h) + boff + n * 2048 + k * 1024); } while (0)
#define PG8_MMA(ai, bj, At, Bt) do { __builtin_amdgcn_s_setprio(1); _Pragma("unroll") for (int m = 0; m < 4; ++m) _Pragma("unroll") for (int n = 0; n < 2; ++n) _Pragma("unroll") for (int k = 0; k < 2; ++k) \
        acc[ai][bj][m][n] = __builtin_amdgcn_mfma_f32_16x16x32_bf16(Bt[n][k], At[m][k], acc[ai][bj][m][n], 0, 0, 0); __builtin_amdgcn_s_setprio(0); } while (0)
#define PG8_WAIT_V(n) asm volatile("s_waitcnt vmcnt(" #n ")" ::: "memory")
#define PG8_WAIT_L(n) asm volatile("s_waitcnt lgkmcnt(" #n ")" ::: "memory")
#define PG8_BAR __builtin_amdgcn_s_barrier()
#define PG8_SCHED __builtin_amdgcn_sched_barrier(0)
    Unit cur, nxt; int ui = 0;
    if (!S.next(0, cur)) return;
    f32x4 acc[2][2][4][2];
#pragma unroll
    for (int a = 0; a < 2; ++a)
#pragma unroll
        for (int b = 0; b < 2; ++b)
#pragma unroll
            for (int m = 0; m < 4; ++m)
#pragma unroll
                for (int n = 0; n < 2; ++n) acc[a][b][m][n] = (f32x4){0.f, 0.f, 0.f, 0.f};
    bf16x8 At[4][2], B0[2][2], B1[2][2];
    const char* cA = (const char*)g.A + (size_t)cur.pm * tstep; const char* cB = (const char*)g.Bt + (size_t)cur.pn * tstep;
    S.a_ready(cur);
    if constexpr (SP2) {
        PG8_STAGE(PG8_SB(0, 0), cB, voffB); PG8_STAGE(PG8_SB(0, 1), cB + hstep, voffB); PG8_STAGE(PG8_SA(0, 0), cA, voffA); PG8_STAGE(PG8_SA(0, 1), cA + hstep, voffA);
        if (wr == 1) PG8_BAR;
        PG8_WAIT_V(2); PG8_BAR;
        PG8_STAGE(PG8_SB(1, 0), cB + kstep, voffB); PG8_STAGE(PG8_SA(1, 0), cA + kstep, voffA); PG8_STAGE(PG8_SB(1, 1), cB + hstep + kstep, voffB);
        PG8_WAIT_V(6); PG8_BAR;
    } else {
        PG8_STAGE(PG8_SB(0, 0), cB, voffB); PG8_STAGE(PG8_SA(0, 0), cA, voffA); PG8_STAGE(PG8_SB(0, 1), cB + hstep, voffB); PG8_STAGE(PG8_SA(0, 1), cA + hstep, voffA);
        if (wr == 1) PG8_BAR;
        PG8_WAIT_V(4); PG8_BAR;
        PG8_STAGE(PG8_SB(1, 0), cB + kstep, voffB); PG8_STAGE(PG8_SA(1, 0), cA + kstep, voffA); PG8_STAGE(PG8_SB(1, 1), cB + hstep + kstep, voffB);
        PG8_WAIT_V(6); PG8_BAR;
    }
    for (;;) {
        const bool has_next = S.next(ui + 1, nxt);
        const char* nA = has_next ? (const char*)g.A + (size_t)nxt.pm * tstep : cA; const char* nB = has_next ? (const char*)g.Bt + (size_t)nxt.pn * tstep : cB;
        for (int t = 0; t < nt; t += 2) {
            const bool last = (t == nt - 2);
            const char* a1 = cA + (size_t)(t + 1) * kstep;
            const char* a2 = last ? nA : cA + (size_t)(t + 2) * kstep; const char* b2 = last ? nB : cB + (size_t)(t + 2) * kstep;
            const char* a3 = a2 + kstep; const char* b3 = b2 + kstep;
            if (last && has_next) S.a_ready(nxt);
            if constexpr (SP2) {
            PG8_LDB(B0, 0, 0); PG8_LDB(B1, 0, 1); PG8_SCHED; PG8_LDA(At, 0, 0); PG8_STAGE(PG8_SA(1, 1), a1 + hstep, voffA);
            PG8_WAIT_V(8); PG8_WAIT_L(0); PG8_BAR; PG8_MMA(0, 0, At, B0); PG8_MMA(0, 1, At, B1); PG8_BAR; PG8_SCHED;
            PG8_LDA(At, 0, 1); PG8_STAGE(PG8_SB(0, 0), b2, voffB); PG8_STAGE(PG8_SB(0, 1), b2 + hstep, voffB); PG8_STAGE(PG8_SA(0, 0), a2, voffA);
            PG8_WAIT_V(8); PG8_WAIT_L(0); PG8_BAR; PG8_MMA(1, 0, At, B0); PG8_MMA(1, 1, At, B1); PG8_BAR; PG8_SCHED;
            PG8_LDB(B0, 1, 0); PG8_LDB(B1, 1, 1); PG8_SCHED; PG8_LDA(At, 1, 0); PG8_STAGE(PG8_SA(0, 1), a2 + hstep, voffA);
            PG8_WAIT_V(8); PG8_WAIT_L(0); PG8_BAR; PG8_MMA(0, 0, At, B0); PG8_MMA(0, 1, At, B1); PG8_BAR; PG8_SCHED;
            PG8_LDA(At, 1, 1); PG8_STAGE(PG8_SB(1, 0), b3, voffB); PG8_STAGE(PG8_SB(1, 1), b3 + hstep, voffB); PG8_STAGE(PG8_SA(1, 0), a3, voffA);
            PG8_WAIT_V(8); PG8_WAIT_L(0); PG8_BAR; PG8_MMA(1, 0, At, B0); PG8_MMA(1, 1, At, B1); PG8_BAR; PG8_SCHED;
            } else {
            PG8_LDB(B0, 0, 0); PG8_SCHED; PG8_LDA(At, 0, 0); PG8_STAGE(PG8_SA(1, 1), a1 + hstep, voffA);
            PG8_WAIT_L(8); PG8_BAR; PG8_WAIT_L(0); PG8_MMA(0, 0, At, B0); PG8_BAR; PG8_SCHED;
            PG8_LDB(B1, 0, 1); PG8_STAGE(PG8_SB(0, 0), b2, voffB);
            PG8_BAR; PG8_WAIT_L(0); PG8_MMA(0, 1, At, B1); PG8_BAR;
            PG8_LDA(At, 0, 1); PG8_STAGE(PG8_SA(0, 0), a2, voffA);
            PG8_BAR; PG8_WAIT_L(0); PG8_MMA(1, 0, At, B0); PG8_BAR; PG8_SCHED;
            PG8_STAGE(PG8_SB(0, 1), b2 + hstep, voffB);
            PG8_WAIT_V(6); PG8_BAR; PG8_MMA(1, 1, At, B1); PG8_BAR;
            PG8_LDB(B0, 1, 0); PG8_SCHED; PG8_LDA(At, 1, 0); PG8_STAGE(PG8_SA(0, 1), a2 + hstep, voffA);
            PG8_WAIT_L(8); PG8_BAR; PG8_WAIT_L(0); PG8_MMA(0, 0, At, B0); PG8_BAR; PG8_SCHED;
            PG8_LDB(B1, 1, 1); PG8_STAGE(PG8_SB(1, 0), b3, voffB);
            PG8_BAR; PG8_WAIT_L(0); PG8_MMA(0, 1, At, B1); PG8_BAR;
            PG8_LDA(At, 1, 1); PG8_STAGE(PG8_SA(1, 0), a3, voffA);
            PG8_BAR; PG8_WAIT_L(0); PG8_MMA(1, 0, At, B0); PG8_BAR; PG8_SCHED;
            PG8_STAGE(PG8_SB(1, 1), b3 + hstep, voffB);
            PG8_WAIT_V(6); PG8_BAR; PG8_MMA(1, 1, At, B1); PG8_BAR;
            }
        }
        if constexpr (ALIGN_EPI) { if (wr == 0) PG8_BAR; }
        if constexpr (!Epi::AFTER_DRAIN) { E(acc, cur, wr, wc, fr, fq); S.done(cur); }
        if (!has_next) break;
#pragma unroll
        for (int a = 0; a < 2; ++a)
#pragma unroll
            for (int b = 0; b < 2; ++b)
#pragma unroll
                for (int m = 0; m < 4; ++m)
#pragma unroll
                    for (int n = 0; n < 2; ++n) acc[a][b][m][n] = (f32x4){0.f, 0.f, 0.f, 0.f};
        cur = nxt; cA = nA; cB = nB; ++ui;
        if constexpr (ALIGN_EPI) { if (wr == 1) PG8_BAR; }
    }
    PG8_WAIT_V(0);
    if constexpr (!ALIGN_EPI) { if (wr == 0) PG8_BAR; }
    PG8_BAR;
    if constexpr (Epi::AFTER_DRAIN) { E.fused(acc, cur, wr, wc, fr, fq, lds, wid, lane); S.done(cur); }
#undef PG8_SA
#undef PG8_SB
#undef PG8_STAGE
#undef PG8_LDA
#undef PG8_LDB
#undef PG8_MMA
#undef PG8_WAIT_V
#undef PG8_WAIT_L
#undef PG8_BAR
#undef PG8_SCHED
}
}


constexpr int DM = 1024, NB_P = 8, T_P = 2048, NB_S = 32, T_S = 32, PAST = 1024;
constexpr int MP = NB_P * T_P, MS = NB_S * T_S, MT = MP + MS;
constexpr int LS = PAST + T_S;
constexpr int SHIFTW = 1696, NZ = 3328, ZRW = 1632, DFF = 4096;
constexpr float QSCALE = 0.125f * 1.4426950408889634f;
constexpr float WISCALE = 0.35355339059327373f * 0.125f;
constexpr size_t OFF_Y = 0, OFF_KP = 17825792, OFF_VP = OFF_KP + 4194304, OFF_KIP = OFF_VP + 4194304, OFF_WKVP = OFF_KIP + 1048576, OFF_SHP = OFF_WKVP + 262144,
                 OFF_KS = OFF_SHP + 13568, OFF_VS = OFF_KS + 262144, OFF_KIS = OFF_VS + 262144, OFF_WKVS = OFF_KIS + 65536, OFF_SHS = OFF_WKVS + 1048576, OUT_TOTAL = OFF_SHS + 54272;
constexpr size_t MiB = 1u << 20;
constexpr size_t WS_CTL = 0, CTL_BYTES = 1 * MiB;
constexpr size_t WS_WIN = 1 * MiB, WS_WOUT = 8 * MiB, WS_W1 = 10 * MiB, WS_W2 = 18 * MiB;
constexpr size_t WS_W2T = 26 * MiB, WS_A2T = WS_W2T + 32768, WS_G2T = WS_A2T + 32768, WS_WI = 27 * MiB, WS_BONUS = 28 * MiB;
constexpr size_t WS_XB = 30 * MiB;
constexpr size_t WS_ZS = 66 * MiB;
constexpr size_t WS_R = 123 * MiB;
constexpr size_t WS_ZR = WS_R, WS_KBP = 178 * MiB, WS_VTP = 186 * MiB, WS_KIP = 194 * MiB, WS_KBS = 196 * MiB, WS_VTS = 213 * MiB, WS_KIS = 230 * MiB;
constexpr size_t WS_OW = WS_R, WS_OKK = 157 * MiB, WS_OB = 174 * MiB, WS_OKM = 191 * MiB, WS_OR = 208 * MiB, WS_OV = 225 * MiB;
constexpr size_t WS_ACT = 66 * MiB, WS_HB = 202 * MiB, WS_END = 256 * MiB;
static_assert(WS_ZS + (size_t)MT * SHIFTW * 2 <= WS_R && WS_ZR + (size_t)MT * ZRW * 2 <= WS_KBP && WS_KBS + (size_t)NB_S * LS * 256 * 2 <= WS_VTS && WS_VTS + (size_t)NB_S * 256 * LS * 2 <= WS_KIS &&
              WS_KIS + (size_t)NB_S * LS * 64 * 2 <= WS_END && WS_OV + (size_t)MT * 512 * 2 <= WS_END && WS_ACT + (size_t)MT * DFF * 2 <= WS_HB && WS_HB + (size_t)MT * DM * 2 <= WS_END, "d_ws map");
constexpr size_t SC_Q = 0, SC_QI = (size_t)MT * 512 / 2, SC_Y = 0, SC_G = (size_t)MT * 512;
constexpr int CW_QATT = 64, CW_SS = 16384;

typedef unsigned short bf16;
typedef short bf16x8 __attribute__((ext_vector_type(8)));
typedef float f32x4 __attribute__((ext_vector_type(4)));
typedef float f32x16 __attribute__((ext_vector_type(16)));
typedef unsigned u32x4 __attribute__((ext_vector_type(4)));
typedef unsigned u32x2 __attribute__((ext_vector_type(2)));

__device__ __forceinline__ unsigned f2bf(float f) { unsigned u = __float_as_uint(f); return (u + 0x7fffu + ((u >> 16) & 1u)) >> 16; }
__device__ __forceinline__ unsigned pk2(float lo, float hi) { return f2bf(lo) | (f2bf(hi) << 16); }
__device__ __forceinline__ float bflo(unsigned w) { return __uint_as_float(w << 16); }
__device__ __forceinline__ float bfhi(unsigned w) { return __uint_as_float(w & 0xffff0000u); }
__device__ __forceinline__ float bf1(bf16 b) { return __uint_as_float((unsigned)b << 16); }
__device__ __forceinline__ void unpack8(const u32x4 w, float* x) { x[0] = bflo(w.x); x[1] = bfhi(w.x); x[2] = bflo(w.y); x[3] = bfhi(w.y); x[4] = bflo(w.z); x[5] = bfhi(w.z); x[6] = bflo(w.w); x[7] = bfhi(w.w); }
__device__ __forceinline__ u32x4 pack8(const float* x) { u32x4 w; w.x = pk2(x[0], x[1]); w.y = pk2(x[2], x[3]); w.z = pk2(x[4], x[5]); w.w = pk2(x[6], x[7]); return w; }
__device__ __forceinline__ float wave_sum(float v) {
#pragma unroll
    for (int o = 1; o < 64; o <<= 1) v += __shfl_xor(v, o);
    return v;
}
template <int CTRL> __device__ __forceinline__ float dppmov(float x) { return __builtin_bit_cast(float, __builtin_amdgcn_update_dpp(0, __builtin_bit_cast(int, x), CTRL, 0xf, 0xf, true)); }
__device__ __forceinline__ float sum16(float x) {
    x += dppmov<0xB1>(x); x += dppmov<0x4E>(x); x += dppmov<0x141>(x); x += dppmov<0x140>(x); return x;
}
__device__ __forceinline__ int crow(int r, int hi) { return (r & 3) + 8 * (r >> 2) + 4 * hi; }

struct Args { const float* in[28]; float* out; unsigned char* ws; int ph_lo, ph_hi; };

__device__ __forceinline__ void tr_item(const float* W, int K, int N, const float* gain, bf16* WT, int jr0, int c0, int nvalid, int k0, float* scr, int lane) {
#pragma unroll 8
    for (int i = 0; i < 32; ++i) { const int kk = 2 * i + (lane >> 5), n = lane & 31;
        float v = (n < nvalid) ? W[(size_t)(k0 + kk) * N + c0 + n] : 0.f; if (gain) v *= gain[k0 + kk]; scr[kk * 33 + n] = v; }
    __builtin_amdgcn_s_waitcnt(0xC07F); asm volatile("" ::: "memory");
    const int c = lane & 7;
#pragma unroll
    for (int j = 0; j < 4; ++j) { const int n = (lane >> 3) + 8 * j; const float* s = scr + (8 * c) * 33 + n;
        u32x4 o; o.x = pk2(s[0 * 33], s[1 * 33]); o.y = pk2(s[2 * 33], s[3 * 33]); o.z = pk2(s[4 * 33], s[5 * 33]); o.w = pk2(s[6 * 33], s[7 * 33]);
        *(u32x4*)(WT + (size_t)(jr0 + n) * K + k0 + 8 * c) = o; }
    __builtin_amdgcn_s_waitcnt(0xC07F); asm volatile("" ::: "memory");
}
__device__ __forceinline__ void p0_prologue(const Args& a, unsigned char* lds, int tid) {
    const int lane = tid & 63, wave = tid >> 6, gw = blockIdx.x * 8 + wave, NGW = gridDim.x * 8;
    float* scr = (float*)(lds + wave * 17408);
    unsigned char* ws = a.ws;
    constexpr int I_IN = (NZ / 32) * (DM / 64), I_OUT = (DM / 32) * (DM / 64), I_F1 = (DFF / 32) * (DM / 64), I_F2 = (DM / 32) * (DFF / 64);
    for (int it = gw; it < I_IN + I_OUT + I_F1 + I_F2; it += NGW) {
        int r = it;
        if (r < I_IN) { const int jb = r % (NZ / 32), kb = r / (NZ / 32), j0 = jb * 32; int c0, nv;
            if (j0 < 1600) { c0 = j0; nv = 32; } else if (j0 < 3296) { c0 = 1608 + (j0 - 1600); nv = 32; } else { c0 = 1600; nv = 8; }
            tr_item(a.in[8], DM, 3304, a.in[7], (bf16*)(ws + WS_WIN), j0, c0, nv, kb * 64, scr, lane); continue; }
        r -= I_IN;
        if (r < I_OUT) { const int jb = r % (DM / 32), kb = r / (DM / 32); tr_item(a.in[24], DM, DM, nullptr, (bf16*)(ws + WS_WOUT), jb * 32, jb * 32, 32, kb * 64, scr, lane); continue; }
        r -= I_OUT;
        if (r < I_F1) { const int jb = r % (DFF / 32), kb = r / (DFF / 32); tr_item(a.in[26], DM, DFF, a.in[25], (bf16*)(ws + WS_W1), jb * 32, jb * 32, 32, kb * 64, scr, lane); continue; }
        r -= I_F1;
        { const int jb = r % (DM / 32), kb = r / (DM / 32); tr_item(a.in[27], DFF, DM, nullptr, (bf16*)(ws + WS_W2), jb * 32, jb * 32, 32, kb * 64, scr, lane); }
    }
    { const int gt = blockIdx.x * 512 + tid, NT = gridDim.x * 512;
      bf16* w2t = (bf16*)(ws + WS_W2T); bf16* a2t = (bf16*)(ws + WS_A2T); bf16* g2t = (bf16*)(ws + WS_G2T);
      for (int i = gt; i < 512 * 32; i += NT) { const int n = i >> 5, k = i & 31; w2t[i] = (bf16)f2bf(a.in[15][k * 512 + n]); a2t[i] = (bf16)f2bf(a.in[17][k * 512 + n]); }
      for (int i = gt; i < 512 * 96; i += NT) { const int n = i / 96, k = i % 96; g2t[i] = (bf16)f2bf(a.in[18][k * 512 + n]); } }
    { f32x4 v[4], nx[4]; int m = gw;
      if (m < MT) { const f32x4* xr = (const f32x4*)((m < MP) ? a.in[0] + (size_t)m * DM : a.in[1] + (size_t)(m - MP) * DM) + lane;
#pragma unroll
          for (int j = 0; j < 4; ++j) v[j] = xr[64 * j]; }
      for (; m < MT; m += NGW) {
        const int mn = m + NGW;
        if (mn < MT) { const f32x4* xr = (const f32x4*)((mn < MP) ? a.in[0] + (size_t)mn * DM : a.in[1] + (size_t)(mn - MP) * DM) + lane;
#pragma unroll
            for (int j = 0; j < 4; ++j) nx[j] = xr[64 * j]; }
        float s = 0.f;
#pragma unroll
        for (int j = 0; j < 4; ++j) s += (v[j].x * v[j].x + v[j].y * v[j].y) + (v[j].z * v[j].z + v[j].w * v[j].w);
        const float rs = rsqrtf(wave_sum(s) * (1.f / DM) + 1e-6f);
        u32x2* o8 = (u32x2*)((bf16*)(ws + WS_XB) + (size_t)m * DM) + lane;
#pragma unroll
        for (int j = 0; j < 4; ++j) { u32x2 o; o.x = pk2(v[j].x * rs, v[j].y * rs); o.y = pk2(v[j].z * rs, v[j].w * rs); o8[64 * j] = o; }
#pragma unroll
        for (int j = 0; j < 4; ++j) v[j] = nx[j];
      } }
    for (int r4 = gw; r4 < NB_S * PAST / 4; r4 += NGW) {
        f32x4 v[4];
#pragma unroll
        for (int j = 0; j < 4; ++j) v[j] = ((const f32x4*)(a.in[2] + (size_t)(4 * r4 + j) * 256))[lane];
#pragma unroll
        for (int j = 0; j < 4; ++j) { const int rix = 4 * r4 + j, b = rix >> 10, p = rix & 1023; u32x2 o; o.x = pk2(v[j].x, v[j].y); o.y = pk2(v[j].z, v[j].w);
            ((u32x2*)((bf16*)(ws + WS_KBS) + ((size_t)b * LS + p) * 256))[lane] = o; }
    }
    for (int r4 = gw; r4 < NB_S * PAST / 4; r4 += NGW) {
        const int rix = r4 * 4 + (lane >> 4), b = rix >> 10, p = rix & 1023; const f32x4 v = ((const f32x4*)(a.in[4] + (size_t)rix * 64))[lane & 15];
        u32x2 o; o.x = pk2(v.x, v.y); o.y = pk2(v.z, v.w); ((u32x2*)((bf16*)(ws + WS_KIS) + ((size_t)b * LS + p) * 64))[lane & 15] = o;
    }
    for (int it = gw; it < NB_S * 4 * 16; it += NGW) {
        const int kb = it & 15, g = (it >> 4) & 3, b = it >> 6;
        const float* src = a.in[3] + ((size_t)b * PAST + kb * 64) * 256 + g * 64;
#pragma unroll 8
        for (int i = 0; i < 64; ++i) scr[i * 65 + lane] = src[(size_t)i * 256 + lane];
        __builtin_amdgcn_s_waitcnt(0xC07F); asm volatile("" ::: "memory");
        bf16* dst = (bf16*)(ws + WS_VTS) + ((size_t)(b * 4 + g) * 64) * LS + kb * 64 + lane;
#pragma unroll 8
        for (int d = 0; d < 64; ++d) dst[(size_t)d * LS] = (bf16)f2bf(scr[lane * 65 + d]);
        __builtin_amdgcn_s_waitcnt(0xC07F); asm volatile("" ::: "memory");
    }
}

__device__ __forceinline__ void p2_post(const Args& a, unsigned char* lds, int tid) {
    unsigned char* ws = a.ws; float* out = a.out;
    const bf16* ZR = (const bf16*)(ws + WS_ZR); const bf16* ZS = (const bf16*)(ws + WS_ZS);
    bf16* Q = (bf16*)(out + SC_Q); bf16* QI = (bf16*)(out + SC_QI);
    float* cs = (float*)lds;
    bf16* vt = (bf16*)(lds + 4096);
    const int g8 = tid >> 3, sub = tid & 7;
    const float* qg = a.in[9]; const float* kg = a.in[10]; const float* lng = a.in[11]; const float* lnb = a.in[12];
    for (int unit = blockIdx.x; unit < 2 * (MT / 64); unit += gridDim.x) {
        const int tile = unit >> 1, part = unit & 1, hb0 = part ? 12 : 0, hb1 = part ? 25 : 12;
        const int m0 = tile * 64;
        { const int m = m0 + g8, pos = (m < MP) ? (m & (T_P - 1)) : (PAST + ((m - MP) & (T_S - 1)));
          const float inv = powf(500000.0f, -(float)sub * 0.125f); const float ang = (float)pos * inv; float s, c; sincosf(ang, &s, &c);
          cs[g8 * 16 + sub] = c; cs[g8 * 16 + 8 + sub] = s; }
        __syncthreads();
        const int m = m0 + g8;
        const bool isp = m < MP; const int ms = m - MP;
        float cc[8], ss[8];
#pragma unroll
        for (int j = 0; j < 8; ++j) { cc[j] = cs[g8 * 16 + j]; ss[j] = cs[g8 * 16 + 8 + j]; }
        const size_t kvrow = isp ? (size_t)m : ((size_t)(ms >> 5) * LS + PAST + (ms & 31));
        bf16* KB = (bf16*)(ws + (isp ? WS_KBP : WS_KBS)); bf16* KIb = (bf16*)(ws + (isp ? WS_KIP : WS_KIS));
        u32x4 xnext = *(const u32x4*)(ZR + (size_t)m * ZRW + hb0 * 64 + 8 * sub);
        for (int hb = hb0; hb < hb1; ++hb) {
            float x[8]; unpack8(xnext, x);
            if (hb + 1 < hb1) xnext = *(const u32x4*)(ZR + (size_t)m * ZRW + (hb + 1) * 64 + 8 * sub);
            if (hb < 12) {
                float s2 = 0.f;
#pragma unroll
                for (int j = 0; j < 8; ++j) s2 += x[j] * x[j];
                s2 += __shfl_xor(s2, 1); s2 += __shfl_xor(s2, 2); s2 += __shfl_xor(s2, 4);
                const float rinv = rsqrtf(s2 * (1.f / 64.f) + 1e-6f); const float* gn = (hb < 8 ? qg : kg) + 8 * sub;
                float y[8], o[8];
#pragma unroll
                for (int j = 0; j < 8; ++j) y[j] = x[j] * rinv * gn[j];
#pragma unroll
                for (int j = 0; j < 8; ++j) { const float p = __shfl_xor(y[j], 1); o[j] = sub == 0 ? y[j] * cc[j] - p * ss[j] : (sub == 1 ? y[j] * cc[j] + p * ss[j] : y[j]); }
                if (hb < 8) {
#pragma unroll
                    for (int j = 0; j < 8; ++j) o[j] *= QSCALE;
                    *(u32x4*)(Q + (size_t)m * 512 + hb * 64 + 8 * sub) = pack8(o);
                } else { const int g = hb - 8;
                    float* ko = out + (isp ? OFF_KP + (size_t)m * 256 : OFF_KS + (size_t)ms * 256) + g * 64 + 8 * sub;
                    *(f32x4*)ko = (f32x4){o[0], o[1], o[2], o[3]}; *(f32x4*)(ko + 4) = (f32x4){o[4], o[5], o[6], o[7]};
                    *(u32x4*)(KB + kvrow * 256 + g * 64 + 8 * sub) = pack8(o); }
            } else if (hb < 16) { const int g = hb - 12;
                float* vo = out + (isp ? OFF_VP + (size_t)m * 256 : OFF_VS + (size_t)ms * 256) + g * 64 + 8 * sub;
                *(f32x4*)vo = (f32x4){x[0], x[1], x[2], x[3]}; *(f32x4*)(vo + 4) = (f32x4){x[4], x[5], x[6], x[7]};
                unsigned* vd = (unsigned*)(vt + g8 * 258 + g * 64 + 8 * sub);
                vd[0] = pk2(x[0], x[1]); vd[1] = pk2(x[2], x[3]); vd[2] = pk2(x[4], x[5]); vd[3] = pk2(x[6], x[7]);
            } else if (hb < 24) {
                float o[8];
#pragma unroll
                for (int j = 0; j < 8; ++j) { const float p = __shfl_xor(x[j], 1); o[j] = sub == 0 ? x[j] * cc[j] - p * ss[j] : (sub == 1 ? x[j] * cc[j] + p * ss[j] : x[j]); }
                *(u32x4*)(QI + (size_t)m * 512 + (hb - 16) * 64 + 8 * sub) = pack8(o);
            } else {
                float s1 = 0.f;
#pragma unroll
                for (int j = 0; j < 8; ++j) s1 += x[j];
                s1 += __shfl_xor(s1, 1); s1 += __shfl_xor(s1, 2); s1 += __shfl_xor(s1, 4);
                const float mu = s1 * (1.f / 64.f); float s2 = 0.f;
#pragma unroll
                for (int j = 0; j < 8; ++j) { const float d = x[j] - mu; s2 += d * d; }
                s2 += __shfl_xor(s2, 1); s2 += __shfl_xor(s2, 2); s2 += __shfl_xor(s2, 4);
                const float rinv = rsqrtf(s2 * (1.f / 64.f) + 1e-6f); float y[8], o[8];
#pragma unroll
                for (int j = 0; j < 8; ++j) y[j] = (x[j] - mu) * rinv * lng[8 * sub + j] + lnb[8 * sub + j];
#pragma unroll
                for (int j = 0; j < 8; ++j) { const float p = __shfl_xor(y[j], 1); o[j] = sub == 0 ? y[j] * cc[j] - p * ss[j] : (sub == 1 ? y[j] * cc[j] + p * ss[j] : y[j]); }
                float* ko = out + (isp ? OFF_KIP + (size_t)m * 64 : OFF_KIS + (size_t)ms * 64) + 8 * sub;
                *(f32x4*)ko = (f32x4){o[0], o[1], o[2], o[3]}; *(f32x4*)(ko + 4) = (f32x4){o[4], o[5], o[6], o[7]};
                *(u32x4*)(KIb + kvrow * 64 + 8 * sub) = pack8(o);
            }
        }
        if (part == 0) ((float*)(ws + WS_WI))[(size_t)m * 8 + sub] = bf1(ZR[(size_t)m * ZRW + 1600 + sub]) * WISCALE;
        __syncthreads();
        if (part == 1) { const int r = tid >> 1, half = tid & 1; unsigned wv[16];
#pragma unroll
          for (int j = 0; j < 16; ++j) wv[j] = (unsigned)vt[(32 * half + 2 * j) * 258 + r] | ((unsigned)vt[(32 * half + 2 * j + 1) * 258 + r] << 16);
          bf16* dst;
          if (m0 < MP) dst = (bf16*)(ws + WS_VTP) + ((size_t)(m0 >> 11) * 256 + r) * T_P + (m0 & (T_P - 1)) + 32 * half;
          else { const int b = ((m0 - MP) >> 5) + half; dst = (bf16*)(ws + WS_VTS) + ((size_t)b * 256 + r) * LS + PAST; }
#pragma unroll
          for (int j = 0; j < 4; ++j) ((u32x4*)dst)[j] = (u32x4){wv[4 * j], wv[4 * j + 1], wv[4 * j + 2], wv[4 * j + 3]}; }
        if (part == 0) {} else if (m0 < MP) { if ((m0 & (T_P - 1)) == T_P - 64) { const int b = m0 >> 11; const bf16* zr = ZS + (size_t)(m0 + 63) * SHIFTW;
                for (int c = tid; c < SHIFTW; c += 512) out[OFF_SHP + (size_t)b * SHIFTW + c] = bf1(zr[c]); } }
        else { for (int h2 = 0; h2 < 2; ++h2) { const int b = ((m0 - MP) >> 5) + h2; const bf16* zr = ZS + (size_t)(m0 + 32 * h2 + 31) * SHIFTW;
                for (int c = tid; c < SHIFTW; c += 512) out[OFF_SHS + (size_t)b * SHIFTW + c] = bf1(zr[c]); } }
        __syncthreads();
    }
}

constexpr int ATT_UNITS = 544;
constexpr int MASK_PITCH = 65;
#define MFMA32(a, b, c) __builtin_amdgcn_mfma_f32_32x32x16_bf16((a), (b), (c), 0, 0, 0)

__device__ __forceinline__ float half_sum32(float v) { v += __shfl_xor(v, 1); v += __shfl_xor(v, 2); v += __shfl_xor(v, 4); v += __shfl_xor(v, 8); v += __shfl_xor(v, 16); return v; }
__device__ __forceinline__ float half_min32(float v) { v = fminf(v, __shfl_xor(v, 1)); v = fminf(v, __shfl_xor(v, 2)); v = fminf(v, __shfl_xor(v, 4)); v = fminf(v, __shfl_xor(v, 8)); v = fminf(v, __shfl_xor(v, 16)); return v; }
__device__ __forceinline__ float half_max32(float v) { v = fmaxf(v, __shfl_xor(v, 1)); v = fmaxf(v, __shfl_xor(v, 2)); v = fmaxf(v, __shfl_xor(v, 4)); v = fmaxf(v, __shfl_xor(v, 8)); v = fmaxf(v, __shfl_xor(v, 16)); return v; }
__device__ __forceinline__ int half_sum32i(int v) { v += __shfl_xor(v, 1); v += __shfl_xor(v, 2); v += __shfl_xor(v, 4); v += __shfl_xor(v, 8); v += __shfl_xor(v, 16); return v; }

#define LAS3 __attribute__((address_space(3)))
constexpr int A_RING1 = 0, A_SCL = 24576, A_RING2 = 24576, A_MASK = 0, A_LSUM = 8320, A_UNIT = 9344;
__device__ __forceinline__ void p3_attention(const Args& a, unsigned char* lds, int tid, int rep) {
    unsigned char* ws = a.ws; float* out = a.out;
    const bf16* Q = (const bf16*)(out + SC_Q); const bf16* QI = (const bf16*)(out + SC_QI); const float* WI = (const float*)(ws + WS_WI);
    bf16* O = (bf16*)(ws + WS_XB);
    unsigned* maskw = (unsigned*)(lds + A_MASK);
    float* lsum = (float*)(lds + A_LSUM);
    int* s_unit = (int*)(lds + A_UNIT);
    typedef float f32x2_t __attribute__((ext_vector_type(2)));
    f32x2_t* scl = (f32x2_t*)(lds + A_SCL) + (size_t)(tid >> 6) * 2048 + (tid & 63);
    unsigned* qctr = (unsigned*)(ws + WS_CTL) + CW_QATT + 64 * rep;
    const int l = tid & 63, w = __builtin_amdgcn_readfirstlane(tid >> 6), rho = l & 31, hi = l >> 5;
    LAS3 unsigned char* ldsb = (LAS3 unsigned char*)lds;
    for (;;) {
        if (tid == 0) *s_unit = (int)atomicAdd(qctr, 1u);
        __syncthreads();
        const int p = *s_unit;
        __syncthreads();
        if (p >= ATT_UNITS) break;
        int m0, nkt, vpitch; const bf16 *KB, *VT, *KI; bool need_idx;
        { int c = -1, b, half = 0;
          if (p < 256) { c = 31 - (p >> 4); b = (p & 15) >> 1; half = p & 1; }
          else if (p < 288) { b = p - 256; }
          else { const int pp = p - 288; c = 15 - (pp >> 4); b = (pp & 15) >> 1; half = pp & 1; }
          if (c >= 0) { m0 = b * T_P + 64 * c + 32 * half; nkt = 2 * (c + 1); vpitch = T_P; need_idx = c >= 4;
              KB = (const bf16*)(ws + WS_KBP) + (size_t)b * T_P * 256; VT = (const bf16*)(ws + WS_VTP) + (size_t)b * 256 * T_P; KI = (const bf16*)(ws + WS_KIP) + (size_t)b * T_P * 64; }
          else { m0 = MP + 32 * b; nkt = LS / 32; vpitch = LS; need_idx = true;
              KB = (const bf16*)(ws + WS_KBS) + (size_t)b * LS * 256; VT = (const bf16*)(ws + WS_VTS) + (size_t)b * 256 * LS; KI = (const bf16*)(ws + WS_KIS) + (size_t)b * LS * 64; } }
        if (need_idx) {
            const int tokA = 4 * w + 2 * ((rho >> 2) & 1) + (rho >> 4), headA = (rho & 3) + 4 * ((rho >> 3) & 1);
            bf16x8 qa[4];
#pragma unroll
            for (int ks = 0; ks < 4; ++ks) qa[ks] = *(const bf16x8*)(QI + (size_t)(m0 + tokA) * 512 + headA * 64 + 16 * ks + 8 * hi);
            float wv[16];
#pragma unroll
            for (int r = 0; r < 16; ++r) wv[r] = WI[(size_t)(m0 + 4 * w + 2 * hi + (r >> 3)) * 8 + (r & 7)];
            asm volatile("" :: "v"(qa[0]), "v"(qa[1]), "v"(qa[2]), "v"(qa[3]));
#pragma unroll
            for (int r = 0; r < 16; ++r) asm volatile("" :: "v"(wv[r]));
            asm volatile("s_waitcnt vmcnt(0)" ::: "memory");
            float sc0[32], sc1[32];
            const int nb = (nkt + 1) >> 1;
            const int sr = 8 * w + (l >> 3), scn = (l & 7) ^ ((sr >> 1) & 7);
            const unsigned char* ksrc = (const unsigned char*)KI + (size_t)sr * 128 + 16 * scn;
#define KI_STAGE(it_) __builtin_amdgcn_global_load_lds((const unsigned*)(ksrc + (size_t)(it_) * 8192), (LAS3 unsigned*)(ldsb + A_RING1 + ((it_) % 3) * 8192 + w * 1024), 16, 0, 0)
            for (int rp1 = 0; rp1 <= PROBE_A1; ++rp1) {
            if (rp1) __syncthreads();
            KI_STAGE(0); if (1 < nb) KI_STAGE(1);
#pragma unroll
            for (int it = 0; it < 32; ++it) {
                if (it < nb) {
                    if (it + 1 < nb) asm volatile("s_waitcnt vmcnt(1) lgkmcnt(0)\n\ts_barrier" ::: "memory"); else asm volatile("s_waitcnt vmcnt(0) lgkmcnt(0)\n\ts_barrier" ::: "memory");
                    if (it + 2 < nb) KI_STAGE(it + 2);
                    const unsigned char* tb = lds + A_RING1 + (it % 3) * 8192;
#pragma unroll
                    for (int k2 = 0; k2 < 2; ++k2) { const int kt = 2 * it + k2;
                        if (kt < nkt) {
                            const int r = 32 * k2 + rho; const unsigned char* rowp = tb + r * 128; const int sw = (r >> 1) & 7;
                            f32x16 acc = {0.f, 0.f, 0.f, 0.f, 0.f, 0.f, 0.f, 0.f, 0.f, 0.f, 0.f, 0.f, 0.f, 0.f, 0.f, 0.f};
#pragma unroll
                            for (int ks = 0; ks < 4; ++ks) acc = MFMA32(qa[ks], *(const bf16x8*)(rowp + 16 * ((2 * ks + hi) ^ sw)), acc);
                            float s0 = 0.f, s1 = 0.f;
#pragma unroll
                            for (int r2 = 0; r2 < 8; ++r2) { s0 += wv[r2] * fmaxf(acc[r2], 0.f); s1 += wv[8 + r2] * fmaxf(acc[8 + r2], 0.f); }
                            if (kt < 32) { sc0[kt & 31] = s0; sc1[kt & 31] = s1; } else scl[(kt - 32) * 64] = (f32x2_t){s0, s1};
                        } else if (kt < 32) { sc0[kt & 31] = -3.0e38f; sc1[kt & 31] = -3.0e38f; }
                    }
                } else { if (2 * it < 32) { sc0[(2 * it) & 31] = -3.0e38f; sc1[(2 * it) & 31] = -3.0e38f; sc0[(2 * it + 1) & 31] = -3.0e38f; sc1[(2 * it + 1) & 31] = -3.0e38f; } }
            }
            }
#undef KI_STAGE
            __syncthreads();
            float mn0 = 3.0e38f, mx0 = -3.0e38f, mn1 = 3.0e38f, mx1 = -3.0e38f; int cp0 = 0, cz0 = 0, cp1 = 0, cz1 = 0;
#pragma unroll
            for (int kt = 0; kt < 64; ++kt) if (kt < nkt) { float v0, v1; if (kt < 32) { v0 = sc0[kt & 31]; v1 = sc1[kt & 31]; } else { const f32x2_t t2 = scl[(kt - 32) * 64]; v0 = t2.x; v1 = t2.y; }
                mn0 = fminf(mn0, v0); mx0 = fmaxf(mx0, v0); mn1 = fminf(mn1, v1); mx1 = fmaxf(mx1, v1);
                cp0 += v0 > 0.f ? 1 : 0; cz0 += v0 == 0.f ? 1 : 0; cp1 += v1 > 0.f ? 1 : 0; cz1 += v1 == 0.f ? 1 : 0; }
            mn0 = half_min32(mn0); mx0 = half_max32(mx0); mn1 = half_min32(mn1); mx1 = half_max32(mx1);
            cp0 = half_sum32i(cp0); cz0 = half_sum32i(cz0); cp1 = half_sum32i(cp1); cz1 = half_sum32i(cz1);
            float lo0, hi0, lo1, hi1, thr0 = 0.f, thr1 = 0.f; int ch0, ch1, nt0 = 0, nt1 = 0; bool fin0, fin1;
            for (int rp2 = 0; rp2 <= PROBE_A2; ++rp2) {
            fin0 = false; fin1 = false; ch0 = 0; ch1 = 0;
            if (cp0 >= 256) { lo0 = 0.f; hi0 = mx0; if (cp0 == 256) { fin0 = true; thr0 = 0.f; nt0 = 0; } }
            else if (cp0 + cz0 >= 256) { lo0 = 0.f; hi0 = 0.f; fin0 = true; thr0 = 0.f; nt0 = 256 - cp0; }
            else { lo0 = mn0 - 1.0f; hi0 = 0.f; ch0 = cp0; }
            if (cp1 >= 256) { lo1 = 0.f; hi1 = mx1; if (cp1 == 256) { fin1 = true; thr1 = 0.f; nt1 = 0; } }
            else if (cp1 + cz1 >= 256) { lo1 = 0.f; hi1 = 0.f; fin1 = true; thr1 = 0.f; nt1 = 256 - cp1; }
            else { lo1 = mn1 - 1.0f; hi1 = 0.f; ch1 = cp1; }
            asm volatile("" : "+v"(lo0), "+v"(lo1));
            for (int iter = 0; iter < 64; ++iter) {
                const float mid0 = lo0 + 0.5f * (hi0 - lo0), mid1 = lo1 + 0.5f * (hi1 - lo1);
                int c0 = 0, c1 = 0;
#pragma unroll
                for (int g = 0; g < 4; ++g) if (8 * g < nkt) {
#pragma unroll
                    for (int k8 = 0; k8 < 8; ++k8) { c0 += sc0[8 * g + k8] > mid0 ? 1 : 0; c1 += sc1[8 * g + k8] > mid1 ? 1 : 0; } }
                for (int kt = 32; kt < nkt; kt += 8) {
                    f32x2_t t8[8];
#pragma unroll
                    for (int u = 0; u < 8; ++u) t8[u] = scl[(kt + u - 32) * 64];
#pragma unroll
                    for (int u = 0; u < 8; ++u) if (kt + u < nkt) { c0 += t8[u].x > mid0 ? 1 : 0; c1 += t8[u].y > mid1 ? 1 : 0; } }
                c0 = half_sum32i(c0); c1 = half_sum32i(c1);
                if (!fin0) { if (!(mid0 > lo0 && mid0 < hi0)) { fin0 = true; thr0 = hi0; nt0 = 256 - ch0; }
                             else if (c0 == 256) { fin0 = true; thr0 = mid0; nt0 = 0; } else if (c0 > 256) lo0 = mid0; else { hi0 = mid0; ch0 = c0; } }
                if (!fin1) { if (!(mid1 > lo1 && mid1 < hi1)) { fin1 = true; thr1 = hi1; nt1 = 256 - ch1; }
                             else if (c1 == 256) { fin1 = true; thr1 = mid1; nt1 = 0; } else if (c1 > 256) lo1 = mid1; else { hi1 = mid1; ch1 = c1; } }
                if (__all(fin0 && fin1)) break;
            }
            }
            const bool any_tie = __any(nt0 > 0 || nt1 > 0);
            int run0 = 0, run1 = 0; const unsigned below = (1u << rho) - 1u;
#pragma unroll
            for (int kt = 0; kt < 64; ++kt) if (kt < nkt) {
                float v0, v1; if (kt < 32) { v0 = sc0[kt & 31]; v1 = sc1[kt & 31]; } else { const f32x2_t t2 = scl[(kt - 32) * 64]; v0 = t2.x; v1 = t2.y; }
                bool p0 = v0 > thr0, p1 = v1 > thr1;
                if (any_tie) {
                    const bool e0 = nt0 > 0 && v0 == thr0, e1 = nt1 > 0 && v1 == thr1;
                    const unsigned long long be0 = __ballot(e0), be1 = __ballot(e1);
                    const unsigned h0 = (unsigned)(be0 >> (32 * hi)), h1 = (unsigned)(be1 >> (32 * hi));
                    p0 = p0 || (e0 && (run0 + __popc(h0 & below)) < nt0); p1 = p1 || (e1 && (run1 + __popc(h1 & below)) < nt1);
                    run0 += __popc(h0); run1 += __popc(h1);
                }
                const unsigned long long b0 = __ballot(p0), b1 = __ballot(p1);
                if (l == 0) { maskw[(4 * w + 0) * MASK_PITCH + kt] = (unsigned)b0; maskw[(4 * w + 1) * MASK_PITCH + kt] = (unsigned)b1; }
                if (l == 32) { maskw[(4 * w + 2) * MASK_PITCH + kt] = (unsigned)(b0 >> 32); maskw[(4 * w + 3) * MASK_PITCH + kt] = (unsigned)(b1 >> 32); }
            }
        }
        __syncthreads();
        {
            const int g = w >> 1;
            bf16x8 qb[4];
#pragma unroll
            for (int ks = 0; ks < 4; ++ks) qb[ks] = *(const bf16x8*)(Q + (size_t)(m0 + rho) * 512 + w * 64 + 16 * ks + 8 * hi);
            asm volatile("" :: "v"(qb[0]), "v"(qb[1]), "v"(qb[2]), "v"(qb[3]));
            asm volatile("s_waitcnt vmcnt(0)" ::: "memory");
            const unsigned char* ksrc[2]; const unsigned char* vsrc[2];
#pragma unroll
            for (int k = 0; k < 2; ++k) { const int i = (k * 8 + w) * 64 + l; const int r = i >> 5, c = i & 31; ksrc[k] = (const unsigned char*)KB + (size_t)r * 512 + 16 * (c ^ (r & 15));
                const int R = i >> 2, cv = i & 3; vsrc[k] = (const unsigned char*)VT + (size_t)R * vpitch * 2 + 16 * (cv ^ ((R >> 2) & 3)); }
#define KV_STAGE(t_) do { const int bo_ = A_RING2 + ((t_) % 3) * 32768 + w * 1024; \
            __builtin_amdgcn_global_load_lds((const unsigned*)(ksrc[0] + (size_t)(t_) * 16384), (LAS3 unsigned*)(ldsb + bo_), 16, 0, 0); \
            __builtin_amdgcn_global_load_lds((const unsigned*)(ksrc[1] + (size_t)(t_) * 16384), (LAS3 unsigned*)(ldsb + bo_ + 8192), 16, 0, 0); \
            __builtin_amdgcn_global_load_lds((const unsigned*)(vsrc[0] + (size_t)(t_) * 64), (LAS3 unsigned*)(ldsb + bo_ + 16384), 16, 0, 0); \
            __builtin_amdgcn_global_load_lds((const unsigned*)(vsrc[1] + (size_t)(t_) * 64), (LAS3 unsigned*)(ldsb + bo_ + 24576), 16, 0, 0); } while (0)
            f32x16 o0 = {0.f, 0.f, 0.f, 0.f, 0.f, 0.f, 0.f, 0.f, 0.f, 0.f, 0.f, 0.f, 0.f, 0.f, 0.f, 0.f}, o1 = o0; float psum = 0.f;
            const int ksw = rho & 15;
            const int vR0 = g * 64 + rho, vR1 = vR0 + 32; const int vs0 = (vR0 >> 2) & 3, vs1 = (vR1 >> 2) & 3;
            for (int rp3 = 0; rp3 <= PROBE_A3; ++rp3) {
            if (rp3) __syncthreads();
            KV_STAGE(0); if (1 < nkt) KV_STAGE(1);
            for (int kt = 0; kt < nkt; ++kt) {
                if (kt + 1 < nkt) asm volatile("s_waitcnt vmcnt(4) lgkmcnt(0)\n\ts_barrier" ::: "memory"); else asm volatile("s_waitcnt vmcnt(0) lgkmcnt(0)\n\ts_barrier" ::: "memory");
                if (kt + 2 < nkt) KV_STAGE(kt + 2);
                const unsigned char* kbuf = lds + A_RING2 + (kt % 3) * 32768; const unsigned char* vbuf = kbuf + 16384;
                f32x16 st = {0.f, 0.f, 0.f, 0.f, 0.f, 0.f, 0.f, 0.f, 0.f, 0.f, 0.f, 0.f, 0.f, 0.f, 0.f, 0.f};
#pragma unroll
                for (int ks = 0; ks < 4; ++ks) st = MFMA32(*(const bf16x8*)(kbuf + rho * 512 + 16 * ((g * 8 + 2 * ks + hi) ^ ksw)), qb[ks], st);
                unsigned word = need_idx ? maskw[rho * MASK_PITCH + kt] : 0xffffffffu; word >>= 4 * hi; float pr[16];
#pragma unroll
                for (int r = 0; r < 16; ++r) { const float e = __builtin_amdgcn_exp2f(st[r]); pr[r] = ((word >> ((r & 3) + 8 * (r >> 2))) & 1u) ? e : 0.f; psum += pr[r]; }
                union { u32x4 u; bf16x8 v; } pa0, pa1; pa0.u = (u32x4){pg8::cvt_pk_bf16(pr[0], pr[1]), pg8::cvt_pk_bf16(pr[2], pr[3]), pg8::cvt_pk_bf16(pr[4], pr[5]), pg8::cvt_pk_bf16(pr[6], pr[7])}; pa1.u = (u32x4){pg8::cvt_pk_bf16(pr[8], pr[9]), pg8::cvt_pk_bf16(pr[10], pr[11]), pg8::cvt_pk_bf16(pr[12], pr[13]), pg8::cvt_pk_bf16(pr[14], pr[15])};
                union { u32x4 u; bf16x8 v; } vf[2][2];
#pragma unroll
                for (int s2 = 0; s2 < 2; ++s2) { const unsigned char* r0 = vbuf + vR0 * 64 + 8 * hi; const unsigned char* r1 = vbuf + vR1 * 64 + 8 * hi;
                    const u32x2 a0 = *(const u32x2*)(r0 + 16 * ((2 * s2) ^ vs0)), a1 = *(const u32x2*)(r0 + 16 * ((2 * s2 + 1) ^ vs0)), b0 = *(const u32x2*)(r1 + 16 * ((2 * s2) ^ vs1)), b1 = *(const u32x2*)(r1 + 16 * ((2 * s2 + 1) ^ vs1));
                    vf[s2][0].u = (u32x4){a0.x, a0.y, a1.x, a1.y}; vf[s2][1].u = (u32x4){b0.x, b0.y, b1.x, b1.y}; }
                o0 = MFMA32(pa0.v, vf[0][0].v, o0); o0 = MFMA32(pa1.v, vf[1][0].v, o0); o1 = MFMA32(pa0.v, vf[0][1].v, o1); o1 = MFMA32(pa1.v, vf[1][1].v, o1);
            }
            }
#undef KV_STAGE
            psum += __shfl_xor(psum, 32);
            if (hi == 0) lsum[w * 32 + rho] = psum;
            __syncthreads();
#pragma unroll
            for (int r = 0; r < 16; ++r) { const int qr = crow(r, hi); const float inv = 1.0f / lsum[w * 32 + qr];
                bf16* op = O + (size_t)(m0 + qr) * DM + w * 64 + rho;
                op[0] = (bf16)f2bf(o0[r] * inv); op[32] = (bf16)f2bf(o1[r] * inv); }
        }
        __syncthreads();
    }
}

constexpr int XS_PITCH = 168;
__device__ __forceinline__ void p4_rwkv_prep(const Args& a, unsigned char* lds, int tid) {
    unsigned char* ws = a.ws; float* out = a.out;
    const bf16* ZS = (const bf16*)(ws + WS_ZS);
    const bf16* w2t = (const bf16*)(ws + WS_W2T); const bf16* a2t = (const bf16*)(ws + WS_A2T); const bf16* g2t = (const bf16*)(ws + WS_G2T);
    float* OW = (float*)(ws + WS_OW); bf16* OKK = (bf16*)(ws + WS_OKK); bf16* OB = (bf16*)(ws + WS_OB); bf16* OKM = (bf16*)(ws + WS_OKM); bf16* OR_ = (bf16*)(ws + WS_OR); bf16* OV = (bf16*)(ws + WS_OV);
    bf16* G = (bf16*)(out + SC_G); float* BON = (float*)(ws + WS_BONUS);
    const float* mu = a.in[13]; const float* w0 = a.in[14]; const float* a0 = a.in[16]; const float* k_k = a.in[19]; const float* k_a = a.in[20]; const float* r_k = a.in[21]; const float* sh0 = a.in[6];
    bf16* xs = (bf16*)lds;
    const int l = tid & 63, h = __builtin_amdgcn_readfirstlane(tid >> 6), rho = l & 31, hi = l >> 5;
    constexpr int ZP = 3408;
    unsigned char* zt = lds + 16384;
    for (int tile = blockIdx.x; tile < MT / 32; tile += gridDim.x) {
        const int m0 = tile * 32; const bool smp = m0 >= MP;
        const bool tile_first = smp || (m0 & (T_P - 1)) == 0;
        for (int i0 = tid; i0 < 33 * 212; i0 += 4 * 512) {
            u32x4 v[4];
#pragma unroll
            for (int j = 0; j < 4; ++j) { const int idx = i0 + j * 512; if (idx < 33 * 212) { const int r = idx / 212, c = idx - r * 212;
                    if (r == 0 && tile_first) { if (smp) { const float* sp = sh0 + (size_t)((m0 - MP) >> 5) * SHIFTW + 8 * c; const f32x4 a4 = *(const f32x4*)sp, b4 = *(const f32x4*)(sp + 4);
                            v[j] = (u32x4){pk2(a4.x, a4.y), pk2(a4.z, a4.w), pk2(b4.x, b4.y), pk2(b4.z, b4.w)}; } else v[j] = (u32x4){0u, 0u, 0u, 0u}; }
                    else v[j] = *(const u32x4*)(ZS + (size_t)(m0 + r - 1) * SHIFTW + 8 * c); } }
#pragma unroll
            for (int j = 0; j < 4; ++j) { const int idx = i0 + j * 512; if (idx < 33 * 212) { const int r = idx / 212, c = idx - r * 212; *(u32x4*)(zt + r * ZP + 16 * c) = v[j]; } }
        }
        __syncthreads();
        { const int tk = tid >> 4, c0 = (tid & 15) * 10;
          const bf16* zc = (const bf16*)(zt + (tk + 1) * ZP) + 1536 + c0; const bf16* zp = (const bf16*)(zt + tk * ZP) + 1536 + c0;
#pragma unroll
          for (int e = 0; e < 10; ++e) { const int c = c0 + e; const float cur = bf1(zc[e]); const float prev = bf1(zp[e]);
              const float zm = cur + mu[1536 + c] * (prev - cur);
              const float f = __frcp_rn(1.0f + __expf(c < 32 ? -2.0f * zm : -zm));
              const float v = c < 32 ? 2.0f * f - 1.0f : (c < 64 ? zm : f);
              xs[tk * XS_PITCH + c] = (bf16)f2bf(v); } }
        __syncthreads();
        const int m = m0 + rho;
        const bf16* zc = (const bf16*)(zt + (rho + 1) * ZP) + 64 * h + 4 * hi; const bf16* zp = (const bf16*)(zt + rho * ZP) + 64 * h + 4 * hi;
        const float* mu_l = mu + 64 * h + 4 * hi;
        const int pofs = 64 * h + 4 * hi;
#define ZMIX4(dst, co) do { const u32x2 cw = *(const u32x2*)(zc + (co)); const u32x2 pw = *(const u32x2*)(zp + (co)); const f32x4 mu4 = *(const f32x4*)(mu_l + (co)); \
            const float cu[4] = {bflo(cw.x), bfhi(cw.x), bflo(cw.y), bfhi(cw.y)}; const float pv[4] = {bflo(pw.x), bfhi(pw.x), bflo(pw.y), bfhi(pw.y)}; \
            _Pragma("unroll") for (int e = 0; e < 4; ++e) dst[e] = cu[e] + mu4[e] * (pv[e] - cu[e]); } while (0)
        float n2 = 0.f;
#pragma unroll
        for (int ct = 0; ct < 2; ++ct)
#pragma unroll
            for (int grp = 0; grp < 4; ++grp) { const int co = 32 * ct + 8 * grp; float zk[4]; ZMIX4(zk, 512 + co); const f32x4 kk4 = *(const f32x4*)(k_k + pofs + co);
#pragma unroll
                for (int e = 0; e < 4; ++e) { const float kr = zk[e] * kk4[e]; n2 += kr * kr; } }
        n2 += __shfl_xor(n2, 32);
        const float invn = 1.0f / fmaxf(sqrtf(n2), 1e-12f);
        float bon = 0.f;
        asm volatile("" ::: "memory");
#pragma unroll
        for (int ct = 0; ct < 2; ++ct) {
            const f32x16 z16 = {0.f, 0.f, 0.f, 0.f, 0.f, 0.f, 0.f, 0.f, 0.f, 0.f, 0.f, 0.f, 0.f, 0.f, 0.f, 0.f}; f32x16 Dw = z16, Da = z16, Dg = z16;
            const int n = 64 * h + 32 * ct + rho;
            const bf16* xrow = xs + rho * XS_PITCH + 8 * hi;
#pragma unroll
            for (int ks = 0; ks < 2; ++ks) {
                Dw = MFMA32(*(const bf16x8*)(w2t + n * 32 + 16 * ks + 8 * hi), *(const bf16x8*)(xrow + 16 * ks), Dw);
                Da = MFMA32(*(const bf16x8*)(a2t + n * 32 + 16 * ks + 8 * hi), *(const bf16x8*)(xrow + 32 + 16 * ks), Da); }
#pragma unroll
            for (int ks = 0; ks < 6; ++ks) Dg = MFMA32(*(const bf16x8*)(g2t + n * 96 + 16 * ks + 8 * hi), *(const bf16x8*)(xrow + 64 + 16 * ks), Dg);
#pragma unroll
            for (int grp = 0; grp < 4; ++grp) {
                const int co = 32 * ct + 8 * grp;
                float zr[4], zk[4], zv[4]; ZMIX4(zr, co); ZMIX4(zk, 512 + co); ZMIX4(zv, 1024 + co);
                const f32x4 w04 = *(const f32x4*)(w0 + pofs + co), a04 = *(const f32x4*)(a0 + pofs + co), kk4 = *(const f32x4*)(k_k + pofs + co), ka4 = *(const f32x4*)(k_a + pofs + co), rk4 = *(const f32x4*)(r_k + pofs + co);
                float dec[4], km[4], gg[4], kk[4], bb[4];
#pragma unroll
                for (int e = 0; e < 4; ++e) { const int r = 4 * grp + e;
                    const float sg = __frcp_rn(1.0f + __expf(-(w04[e] + Dw[r])));
                    dec[e] = __expf(-0.6065306597126334f * sg);
                    const float aa = __frcp_rn(1.0f + __expf(-(a04[e] + Da[r])));
                    gg[e] = Dg[r];
                    kk[e] = zk[e] * kk4[e] * invn; bb[e] = kk[e] * aa;
                    km[e] = zk[e] * (1.0f + (aa - 1.0f) * ka4[e]);
                    bon += zr[e] * km[e] * rk4[e]; }
                const size_t o = (size_t)m * 512 + pofs + co;
                *(f32x4*)(OW + o) = (f32x4){dec[0], dec[1], dec[2], dec[3]};
                *(u32x2*)(OKK + o) = (u32x2){pk2(kk[0], kk[1]), pk2(kk[2], kk[3])};
                *(u32x2*)(OB + o) = (u32x2){pk2(bb[0], bb[1]), pk2(bb[2], bb[3])};
                *(u32x2*)(OKM + o) = (u32x2){pk2(km[0], km[1]), pk2(km[2], km[3])};
                *(u32x2*)(OR_ + o) = (u32x2){pk2(zr[0], zr[1]), pk2(zr[2], zr[3])};
                *(u32x2*)(OV + o) = (u32x2){pk2(zv[0], zv[1]), pk2(zv[2], zv[3])};
                *(u32x2*)(G + o) = (u32x2){pk2(gg[0], gg[1]), pk2(gg[2], gg[3])};
                asm volatile("" ::: "memory");
            }
        }
#undef ZMIX4
        bon += __shfl_xor(bon, 32);
        if (hi == 0) BON[(size_t)m * 8 + h] = bon;
        __syncthreads();
    }
}

constexpr int SC_CH = 32;
static_assert(WS_OB - WS_OKK == 17 * MiB && WS_OKM - WS_OB == 17 * MiB && WS_OR - WS_OKM == 17 * MiB && WS_OV - WS_OR == 17 * MiB, "operand arrays are equally spaced");
__device__ __forceinline__ void cvt_store8(unsigned char* d, const u32x4 x) {
    *(u32x4*)d = (u32x4){x.x << 16, x.x & 0xffff0000u, x.y << 16, x.y & 0xffff0000u}; *(u32x4*)(d + 16) = (u32x4){x.z << 16, x.z & 0xffff0000u, x.w << 16, x.w & 0xffff0000u};
}
struct StageP {
    static constexpr int STRIDE = 1280 + 64;
    const unsigned char* pw; const unsigned char* pb; int vrow0;
    u32x4 v[25];
    __device__ __forceinline__ void issue(int t0, int lane) {
        const unsigned char* gw = pw + ((size_t)(t0 + (lane >> 4)) * 512) * 4 + 16 * (lane & 15);
#pragma unroll
        for (int j = 0; j < 8; ++j) v[j] = *(const u32x4*)(gw + (size_t)j * 4 * 512 * 4);
        const unsigned char* gb = pb + ((size_t)(t0 + (lane >> 3)) * 512) * 2 + 16 * (lane & 7);
#pragma unroll
        for (int a = 0; a < 4; ++a)
#pragma unroll
            for (int jj = 0; jj < 4; ++jj) v[8 + 4 * a + jj] = *(const u32x4*)(gb + (size_t)a * (17 * MiB) + (size_t)jj * 8 * 512 * 2);
        v[24] = *(const u32x4*)(pb + (size_t)4 * (17 * MiB) + ((size_t)(t0 + (lane >> 1)) * 512) * 2 + 2 * vrow0 + 16 * (lane & 1));
    }
    __device__ __forceinline__ void commit(unsigned char* buf, int lane) const {
        unsigned char* dw = buf + (lane >> 4) * STRIDE + 16 * (lane & 15);
#pragma unroll
        for (int j = 0; j < 8; ++j) *(u32x4*)(dw + j * 4 * STRIDE) = v[j];
        unsigned char* db = buf + (lane >> 3) * STRIDE + 256 + 32 * (lane & 7);
#pragma unroll
        for (int a = 0; a < 4; ++a)
#pragma unroll
            for (int jj = 0; jj < 4; ++jj) cvt_store8(db + a * 256 + jj * 8 * STRIDE, v[8 + 4 * a + jj]);
        cvt_store8(buf + (lane >> 1) * STRIDE + 1280 + 32 * (lane & 1), v[24]);
    }
};
struct StageS {
    static constexpr int STRIDE = 1280 + 256;
    const unsigned char* pw; const unsigned char* pb;
    u32x4 v[7];
    __device__ __forceinline__ void issue(int t0, int lane) {
        const unsigned char* gw = pw + ((size_t)(t0 + (lane >> 4)) * 512) * 4 + 16 * (lane & 15);
        v[0] = *(const u32x4*)gw; v[1] = *(const u32x4*)(gw + (size_t)4 * 512 * 4);
        const unsigned char* gb = pb + ((size_t)(t0 + (lane >> 3)) * 512) * 2 + 16 * (lane & 7);
#pragma unroll
        for (int a = 0; a < 5; ++a) v[2 + a] = *(const u32x4*)(gb + (size_t)a * (17 * MiB));
    }
    __device__ __forceinline__ void commit(unsigned char* buf, int lane) const {
        unsigned char* dw = buf + (lane >> 4) * STRIDE + 16 * (lane & 15);
        *(u32x4*)dw = v[0]; *(u32x4*)(dw + 4 * STRIDE) = v[1];
        unsigned char* db = buf + (lane >> 3) * STRIDE + 256 + 32 * (lane & 7);
#pragma unroll
        for (int a = 0; a < 5; ++a) cvt_store8(db + a * 256, v[2 + a]);
    }
};
typedef float f32x2 __attribute__((ext_vector_type(2)));
template <int STRIDE, bool YLDS> __device__ __forceinline__ void scan_consume(f32x4& S4, const unsigned char* buf, int nst, int ks, int rowl, float* yp, float* ypart) {
    f32x2 Sa = {S4.x, S4.y}, Sb = {S4.z, S4.w};
    for (int s0 = 0; s0 < nst; s0 += 16) {
        float ykeep = 0.f;
#pragma unroll 1
        for (int g = 0; g < 4; ++g) {
            const int kq = ks - 4 * g;
#pragma unroll
            for (int j = 0; j < 4; ++j) {
                const float* p = (const float*)(buf + (s0 + 4 * g + j) * STRIDE) + 4 * ks;
                const f32x2 wa = *(const f32x2*)(p), wb = *(const f32x2*)(p + 2), ka = *(const f32x2*)(p + 64), kb = *(const f32x2*)(p + 66), ba = *(const f32x2*)(p + 128), bb = *(const f32x2*)(p + 130),
                            ma = *(const f32x2*)(p + 192), mb = *(const f32x2*)(p + 194), ra = *(const f32x2*)(p + 256), rb = *(const f32x2*)(p + 258);
                const float v = ((const float*)(buf + (s0 + 4 * g + j) * STRIDE))[320 + rowl];
                f32x2 t = Sa * ka + Sb * kb; float d = t.x + t.y; d = sum16(d);
                const f32x2 vv = {v, v}, dd = {d, d};
                Sa = Sa * wa + (vv * ma - dd * ba); Sb = Sb * wb + (vv * mb - dd * bb);
                f32x2 u = Sa * ra + Sb * rb; float y = u.x + u.y;
                if constexpr (YLDS) ypart[(s0 + 4 * g + j) * 256] = y;
                else { y = sum16(y); ykeep = kq == j ? y : ykeep; }
            }
        }
        if constexpr (!YLDS) yp[(size_t)(s0 + ks) * 512] = ykeep;
    }
    S4 = (f32x4){Sa.x, Sa.y, Sb.x, Sb.y};
}
__device__ __forceinline__ void scan_yreduce(const float* ypart, float* yg, int pt) {
#pragma unroll
    for (int k = 0; k < 2; ++k) { const int o = pt + 256 * k; const f32x4* q = (const f32x4*)(ypart + o * 16);
        const f32x4 a = q[0], b = q[1], c = q[2], d = q[3]; const f32x4 e = (a + b) + (c + d);
        yg[(size_t)(o >> 4) * 512 + (o & 15)] = (e.x + e.y) + (e.z + e.w); }
}
__device__ __forceinline__ void p5_rwkv_scan(const Args& a, unsigned char* lds, int tid) {
    const unsigned char* ws = a.ws; float* out = a.out; float* Y = out + SC_Y;
    const int l = tid & 63, w = __builtin_amdgcn_readfirstlane(tid >> 6), ks = l & 15, rl = l >> 4;
    const int G = gridDim.x, vcu = (G % 8 == 0) ? (blockIdx.x % 8) * (G / 8) + blockIdx.x / 8 : blockIdx.x;
    typedef StageP StP; typedef StageS StS;
    unsigned char* buf0 = lds; unsigned char* buf1 = lds + SC_CH * StP::STRIDE;
    for (int it = vcu; it < 256; it += G) {
        {
            const int bh = it >> 2, b = bh >> 3, h = bh & 7, rb = it & 3, row = 16 * rb + 4 * w + rl;
            const size_t base0 = ((size_t)b * T_P) * 512 + (size_t)h * 64;
            constexpr int NC = T_P / SC_CH;
            StP st; st.pw = ws + WS_OW + base0 * 4; st.pb = ws + WS_OKK + base0 * 2; st.vrow0 = 16 * rb;
            f32x4 S = {0.f, 0.f, 0.f, 0.f};
            if (w >= 4) { if (w == 4) { st.issue(0, l); st.commit(buf0, l); st.issue(4 * SC_CH, l); } else st.issue((w - 4) * SC_CH, l); }
            else __builtin_amdgcn_s_setprio(3);
            __syncthreads();
            Y += base0 + row;
            float* yp0 = (float*)(lds + 2 * SC_CH * StP::STRIDE); float* yp1 = yp0 + SC_CH * 256;
#define SCAN_ITER(c, P, cur, nxt, ypc, ypp) do { if (w >= 4) { if ((c) > 0) scan_yreduce(ypp, Y - row + 16 * rb + (size_t)(((c) - 1) * SC_CH) * 512, tid - 256); \
                    if (w == 4 + (P)) { if ((c) + 1 < NC) { st.commit(nxt, l); if ((c) + 5 < NC) st.issue(((c) + 5) * SC_CH, l); } } } \
                else scan_consume<StP::STRIDE, true>(S, cur, SC_CH, ks, 4 * w + rl, nullptr, ypc + tid); __syncthreads(); } while (0)
            for (int c = 0; c < NC; c += 4) { SCAN_ITER(c, 1, buf0, buf1, yp0, yp1); SCAN_ITER(c + 1, 2, buf1, buf0, yp1, yp0); SCAN_ITER(c + 2, 3, buf0, buf1, yp0, yp1); SCAN_ITER(c + 3, 0, buf1, buf0, yp1, yp0); }
            if (w >= 4) scan_yreduce(yp1, Y - row + 16 * rb + (size_t)((NC - 1) * SC_CH) * 512, tid - 256);
#undef SCAN_ITER
            __builtin_amdgcn_s_setprio(0);
            Y -= base0 + row;
            if (w < 4) *(f32x4*)(out + OFF_WKVP + ((size_t)bh * 64 + row) * 64 + 4 * ks) = S;
        }
        {
            const int b = it >> 3, h = it & 7;
            const size_t base0 = ((size_t)MP + (size_t)b * T_S) * 512 + (size_t)h * 64;
            StS st; st.pw = ws + WS_OW + base0 * 4; st.pb = ws + WS_OKK + base0 * 2;
            if (w >= 4) { st.issue(8 * (w - 4), l); st.commit(buf0 + 8 * (w - 4) * StS::STRIDE, l); }
            __syncthreads();
            for (int pass = 0; pass < 2; ++pass) { const int row = 8 * w + 4 * pass + rl;
                f32x4 S = *(const f32x4*)(a.in[5] + ((size_t)it * 64 + row) * 64 + 4 * ks);
                scan_consume<StS::STRIDE, false>(S, buf0, T_S, ks, row, Y + base0 + row, nullptr);
                *(f32x4*)(out + OFF_WKVS + ((size_t)it * 64 + row) * 64 + 4 * ks) = S; }
            __syncthreads();
        }
    }
}

__device__ __forceinline__ void p6_rwkv_out(const Args& a, int tid) {
    const unsigned char* ws = a.ws; const float* out = a.out; const float* Y = out + SC_Y; const bf16* G = (const bf16*)(out + SC_G);
    const bf16* OV = (const bf16*)(ws + WS_OV); const float* BON = (const float*)(ws + WS_BONUS); bf16* O = (bf16*)(a.ws + WS_XB);
    const float* lg = a.in[22]; const float* lb = a.in[23];
    const int sub = tid & 7;
    const size_t NIT = (size_t)MT * 8, STEP = (size_t)gridDim.x * 64;
    size_t it = (size_t)blockIdx.x * 64 + (tid >> 3);
    f32x4 y0, y1; u32x4 vw, gw_; float bon = 0.f;
#define P6_LOAD(it_) do { const size_t o_ = ((it_) >> 3) * 512 + ((it_) & 7) * 64 + 8 * sub; y0 = *(const f32x4*)(Y + o_); y1 = *(const f32x4*)(Y + o_ + 4); vw = *(const u32x4*)(OV + o_); gw_ = *(const u32x4*)(G + o_); bon = BON[it_]; } while (0)
    if (it < NIT) P6_LOAD(it);
    for (; it < NIT; it += STEP) {
        const size_t m = it >> 3; const int h = (int)(it & 7);
        float y[8] = {y0.x, y0.y, y0.z, y0.w, y1.x, y1.y, y1.z, y1.w}; float v[8], g[8]; unpack8(vw, v); unpack8(gw_, g); const float bn = bon;
        if (it + STEP < NIT) P6_LOAD(it + STEP);
        float s1 = 0.f;
#pragma unroll
        for (int j = 0; j < 8; ++j) s1 += y[j];
        s1 += __shfl_xor(s1, 1); s1 += __shfl_xor(s1, 2); s1 += __shfl_xor(s1, 4);
        const float mean = s1 * (1.f / 64.f); float s2 = 0.f;
#pragma unroll
        for (int j = 0; j < 8; ++j) { const float d = y[j] - mean; s2 += d * d; }
        s2 += __shfl_xor(s2, 1); s2 += __shfl_xor(s2, 2); s2 += __shfl_xor(s2, 4);
        const float rinv = rsqrtf(s2 * (1.f / 64.f) + 64e-5f);
        float r[8];
#pragma unroll
        for (int j = 0; j < 8; ++j) { const int c = h * 64 + 8 * sub + j; r[j] = ((y[j] - mean) * rinv * lg[c] + lb[c] + bn * v[j]) * g[j]; }
        *(u32x4*)(O + m * DM + 512 + h * 64 + 8 * sub) = pack8(r);
    }
#undef P6_LOAD
}

__device__ __forceinline__ void p8_hnorm(const Args& a, int tid) {
    const int lane = tid & 63, gw = blockIdx.x * 8 + (tid >> 6), NGW = gridDim.x * 8;
    for (int m = gw; m < MT; m += NGW) {
        const f32x4* xr = (const f32x4*)(a.out + OFF_Y + (size_t)m * DM) + lane; f32x4 v[4]; float s = 0.f;
#pragma unroll
        for (int j = 0; j < 4; ++j) { v[j] = xr[64 * j]; s += (v[j].x * v[j].x + v[j].y * v[j].y) + (v[j].z * v[j].z + v[j].w * v[j].w); }
        const float rs = rsqrtf(wave_sum(s) * (1.f / DM) + 1e-6f);
        u32x2* o8 = (u32x2*)((bf16*)(a.ws + WS_HB) + (size_t)m * DM) + lane;
#pragma unroll
        for (int j = 0; j < 4; ++j) { u32x2 o; o.x = pk2(v[j].x * rs, v[j].y * rs); o.y = pk2(v[j].z * rs, v[j].w * rs); o8[64 * j] = o; }
    }
}

#define XB_TMO      128
#define XB_XCNT(j)  (256  + 64 * (j))
#define XB_XSUB(j)  (1280 + 64 * (j))
#define XB_XGEN(j)  (2304 + 64 * (j))
#define XB_TOP      3328
#define XB_TOPGEN   3392
#define XCD_BAR_WORDS 3456
#define XB_SPIN_CAP (1u << 18)

__device__ __forceinline__ unsigned xb_ld(unsigned* p)              { return __hip_atomic_load(p, __ATOMIC_RELAXED, __HIP_MEMORY_SCOPE_AGENT); }
__device__ __forceinline__ unsigned xb_add(unsigned* p, unsigned v) { return __hip_atomic_fetch_add(p, v, __ATOMIC_RELAXED, __HIP_MEMORY_SCOPE_AGENT); }
__device__ __forceinline__ unsigned xb_xcc_id() { return (unsigned)__builtin_amdgcn_s_getreg((3 << 11) | 20) & 0xFu; }
#define XB_SPIN(cond, bar) do { unsigned _sp = 0; while (cond) { __builtin_amdgcn_s_sleep(1); \
    if ((++_sp & 255u) == 0u) { if (xb_ld(&(bar)[XB_TMO])) break; if (_sp > XB_SPIN_CAP) { atomicAdd(&(bar)[XB_TMO], 1u); break; } } } } while (0)

struct XcdBarrier {
    unsigned* bar; unsigned x;
    volatile __attribute__((address_space(3))) unsigned* st;
};

__device__ __forceinline__ XcdBarrier xcd_barrier_post(unsigned* bar, volatile __attribute__((address_space(3))) unsigned* st) {
    XcdBarrier b; b.bar = bar; b.x = xb_xcc_id(); b.st = st;
    if (threadIdx.x == 0) (void)xb_add(&bar[XB_XCNT(b.x)], 1u);
    return b;
}
__device__ __forceinline__ void xcd_barrier_complete(unsigned* bar, unsigned x, unsigned& nloc, unsigned& nx) {
    const unsigned G = gridDim.x * gridDim.y * gridDim.z;
    unsigned sum, cnt, mine, sp = 0u;
    for (;;) {
        sum = 0u; cnt = 0u; mine = 0u;
#pragma unroll
        for (unsigned j = 0; j < 16; ++j) { const unsigned c = xb_ld(&bar[XB_XCNT(j)]); sum += c; cnt += (c > 0u) ? 1u : 0u; mine = (j == x) ? c : mine; }
        if (sum == G) break;
        __builtin_amdgcn_s_sleep(1);
        if ((++sp & 255u) == 0u) { if (xb_ld(&bar[XB_TMO])) break; if (sp > XB_SPIN_CAP) { atomicAdd(&bar[XB_TMO], 1u); break; } }
    }
    nloc = mine > 0u ? mine : 1u; nx = cnt > 0u ? cnt : 1u;
}

__device__ __forceinline__ void xcd_barrier(const XcdBarrier& b) {
    asm volatile("s_waitcnt vmcnt(0)" ::: "memory");
    __syncthreads();
    if (threadIdx.x == 0) {
        unsigned* bar = b.bar;
        __builtin_amdgcn_s_waitcnt(0);
        unsigned nloc = b.st[0], nx = b.st[1];
        if (nloc == 0u) { xcd_barrier_complete(bar, b.x, nloc, nx); b.st[0] = nloc; b.st[1] = nx; }
        const unsigned old = xb_add(&bar[XB_XSUB(b.x)], 1u);
        const unsigned gen = old / nloc;
        if (old + 1u == (gen + 1u) * nloc) {
            __builtin_amdgcn_fence(__ATOMIC_RELEASE, "agent");
            asm volatile("s_waitcnt vmcnt(0)" ::: "memory");
            const unsigned og = xb_add(&bar[XB_TOP], 1u);
            const unsigned tg = og / nx;
            if (og + 1u == (tg + 1u) * nx) xb_add(&bar[XB_TOPGEN], 1u);
            else XB_SPIN(xb_ld(&bar[XB_TOPGEN]) == tg, bar);
            __builtin_amdgcn_fence(__ATOMIC_ACQUIRE, "agent");
            xb_add(&bar[XB_XGEN(b.x)], 1u);
            asm volatile("s_waitcnt vmcnt(0)" ::: "memory");
        } else {
            XB_SPIN(xb_ld(&bar[XB_XGEN(b.x)]) == gen, bar);
            __builtin_amdgcn_fence(__ATOMIC_ACQUIRE, "agent");
            asm volatile("s_waitcnt vmcnt(0)" ::: "memory");
        }
    }
    __syncthreads();
}

constexpr int CW_BAR = 4096;
constexpr int LDS_BYTES = 163840;
constexpr int N_PHASES = 12;
#ifndef PROBE_MASK
#define PROBE_MASK 0
#endif
template <int PH> __device__ __forceinline__ void run_phase(const Args& args, unsigned char* lds, int tid, int rep) {
    unsigned char* ws = args.ws;
    if constexpr (PH == 0) p0_prologue(args, lds, tid);
    if constexpr (PH == 1) { pg8::Gemm g{(const pg8::bf16_t*)(ws + WS_XB), (const pg8::bf16_t*)(ws + WS_WIN), MT, NZ, DM, DM}; pg8::StaticOrder S; S.init(MT, NZ, gridDim.x, blockIdx.x);
        pg8::EpiZ E{(pg8::bf16_t*)(ws + WS_ZR), (pg8::bf16_t*)(ws + WS_ZS)};
        pg8::gemm_phase<pg8::EpiZ, pg8::StaticOrder, true, true>((PG8_LAS unsigned char*)lds, g, S, E); }
    if constexpr (PH == 2) p2_post(args, lds, tid);
    if constexpr (PH == 3) p3_attention(args, lds, tid, rep);
    if constexpr (PH == 4) p4_rwkv_prep(args, lds, tid);
    if constexpr (PH == 5) p5_rwkv_scan(args, lds, tid);
    if constexpr (PH == 6) p6_rwkv_out(args, tid);
    if constexpr (PH == 7) { pg8::Gemm g{(const pg8::bf16_t*)(ws + WS_XB), (const pg8::bf16_t*)(ws + WS_WOUT), MT, DM, DM, DM}; pg8::StaticOrder S; S.init(MT, DM, gridDim.x, blockIdx.x);
        pg8::EpiH E{args.in[0], args.in[1], args.out + OFF_Y, (pg8::bf16_t*)(ws + WS_HB), (float*)(ws + WS_CTL) + CW_SS};
        pg8::gemm_phase<pg8::EpiH, pg8::StaticOrder, true, true>((PG8_LAS unsigned char*)lds, g, S, E); }
    if constexpr (PH == 9) { pg8::Gemm g{(const pg8::bf16_t*)(ws + WS_HB), (const pg8::bf16_t*)(ws + WS_W1), MT, DFF, DM, DM}; pg8::StaticOrder S; S.init(MT, DFF, gridDim.x, blockIdx.x);
        pg8::EpiAct E{(pg8::bf16_t*)(ws + WS_ACT), DFF, (const float*)(ws + WS_CTL) + CW_SS};
        pg8::gemm_phase<pg8::EpiAct, pg8::StaticOrder, true, true>((PG8_LAS unsigned char*)lds, g, S, E); }
    if constexpr (PH == 10) {
        { pg8::Gemm g{(const pg8::bf16_t*)(ws + WS_ACT), (const pg8::bf16_t*)(ws + WS_W2), MP, DM, DFF, DFF}; pg8::StaticOrder S; S.init(MP, DM, gridDim.x, blockIdx.x);
          pg8::EpiY E{args.out + OFF_Y};
          pg8::gemm_phase<pg8::EpiY, pg8::StaticOrder, true, true>((PG8_LAS unsigned char*)lds, g, S, E); }
        { const int c = blockIdx.x; pg8::OneUnit S; S.has = c < 64; S.u.pm = MP / 256 + (c >> 4); S.u.pn = (c >> 2) & 3; const int sl = c & 3;
          pg8::Gemm g{(const pg8::bf16_t*)(ws + WS_ACT) + sl * 1024, (const pg8::bf16_t*)(ws + WS_W2) + sl * 1024, MT, DM, DFF, 1024};
          pg8::EpiSlab E{(float*)(ws + WS_HB) + (size_t)sl * MS * DM};
          __syncthreads();
          pg8::gemm_phase<pg8::EpiSlab, pg8::OneUnit, false, true>((PG8_LAS unsigned char*)lds, g, S, E); }
    }
    if constexpr (PH == 11) {
        const f32x4* sl = (const f32x4*)(ws + WS_HB); f32x4* y = (f32x4*)(args.out + OFF_Y + (size_t)MP * DM); constexpr int NV = MS * DM / 4;
        for (int i = blockIdx.x * 512 + tid; i < NV; i += gridDim.x * 512) y[i] = y[i] + ((sl[i] + sl[i + NV]) + (sl[i + 2 * NV] + sl[i + 3 * NV]));
    }
}
#ifndef MK_ONE_LAUNCH
#define MK_ONE_LAUNCH 1
#endif
#if MK_ONE_LAUNCH
__global__ void __launch_bounds__(512, 2) mk_fwd(Args args) {
    extern __shared__ __attribute__((aligned(16))) unsigned char lds[];
    const int tid = threadIdx.x;
    volatile __attribute__((address_space(3))) unsigned* bst = (volatile __attribute__((address_space(3))) unsigned*)((__attribute__((address_space(3))) unsigned char*)lds + LDS_BYTES - 16);
    if (tid < 2) bst[tid] = 0u;
    __syncthreads();
    const XcdBarrier bar = xcd_barrier_post((unsigned*)(args.ws + WS_CTL) + CW_BAR, bst);
    if (args.ph_lo < 0) { __syncthreads(); cg::this_grid().sync(); }
#define SEAM(k) xcd_barrier(bar)
#define PHASE(k) do { if (args.ph_lo <= (k) && (k) < args.ph_hi) { if ((k) > args.ph_lo) SEAM(k); run_phase<k>(args, lds, tid, 0); \
        if ((PROBE_MASK >> (k)) & 1) { xcd_barrier(bar); run_phase<k>(args, lds, tid, 1); } } } while (0)
    PHASE(0); PHASE(1); PHASE(2); PHASE(3); PHASE(4); PHASE(5); PHASE(6); PHASE(7); PHASE(9); PHASE(10); PHASE(11);
#undef PHASE
#undef SEAM
}
#else
template <int PH> __global__ void __launch_bounds__(512, 2) mk_phase(Args args) {
    extern __shared__ __attribute__((aligned(16))) unsigned char lds[];
    run_phase<PH>(args, lds, threadIdx.x, 0);
}
#endif

extern "C" void kernel_launch(void* const* d_in, const int* in_sizes, int n_in, void* d_out, int out_size, void* d_ws, size_t ws_size, hipStream_t stream) {
    static int grid = 0;
    if (grid == 0) {
        if (n_in != 28 || out_size != (int)OUT_TOTAL || ws_size < WS_END) { fprintf(stderr, "kernel_launch: unexpected shapes (n_in %d, out %d, ws %zu)\n", n_in, out_size, ws_size); grid = -1; return; }
        int dev = 0, cus = 0, per_cu = 0;
        (void)hipGetDevice(&dev); (void)hipDeviceGetAttribute(&cus, hipDeviceAttributeMultiprocessorCount, dev);
#if MK_ONE_LAUNCH
        if (hipFuncSetAttribute((const void*)mk_fwd, hipFuncAttributeMaxDynamicSharedMemorySize, LDS_BYTES) != hipSuccess) { fprintf(stderr, "kernel_launch: hipFuncSetAttribute failed\n"); grid = -1; return; }
        (void)hipOccupancyMaxActiveBlocksPerMultiprocessor(&per_cu, (const void*)mk_fwd, 512, LDS_BYTES);
        (void)hipGetLastError();
        if (per_cu < 1) { fprintf(stderr, "kernel_launch: occupancy query says %d blocks per CU\n", per_cu); per_cu = 1; }
#else
#define SETATTR(k) (void)hipFuncSetAttribute((const void*)mk_phase<k>, hipFuncAttributeMaxDynamicSharedMemorySize, LDS_BYTES)
        SETATTR(0); SETATTR(1); SETATTR(2); SETATTR(3); SETATTR(4); SETATTR(5); SETATTR(6); SETATTR(7); SETATTR(8); SETATTR(9); SETATTR(10); SETATTR(11);
#undef SETATTR
        (void)per_cu;
#endif
        grid = cus;
    }
    if (grid < 0) return;
    (void)hipMemsetAsync((char*)d_ws + WS_CTL, 0, CTL_BYTES, stream);
    Args a{};
    for (int i = 0; i < 28; ++i) a.in[i] = (const float*)d_in[i];
    a.out = (float*)d_out; a.ws = (unsigned char*)d_ws;
#if MK_ONE_LAUNCH
    a.ph_lo = 0; a.ph_hi = N_PHASES;
    void* kargs[] = {&a};
    hipError_t e = hipLaunchCooperativeKernel((const void*)mk_fwd, dim3(grid), dim3(512), kargs, LDS_BYTES, stream);
    if (e != hipSuccess) fprintf(stderr, "kernel_launch: cooperative launch failed: %s (grid %d)\n", hipGetErrorString(e), grid);
#else
#define LAUNCH(k) hipLaunchKernelGGL(mk_phase<k>, dim3(grid), dim3(512), LDS_BYTES, stream, a)
    a.ph_lo = 0; a.ph_hi = N_PHASES;
    LAUNCH(0); LAUNCH(1); LAUNCH(2); LAUNCH(3); LAUNCH(4); LAUNCH(5); LAUNCH(6); LAUNCH(7); LAUNCH(9); LAUNCH(10); LAUNCH(11);
#undef LAUNCH
#endif
}
```

```cpp
#include <hip/hip_runtime.h>
#include <hip/hip_cooperative_groups.h>
#include <cstdio>
#include <cstdint>
namespace cg = cooperative_groups;
#define PROBE_A1 0
#define PROBE_A2 0
#define PROBE_A3 0
namespace pg8 {
#define PG8_LAS __attribute__((address_space(3)))
typedef unsigned short bf16_t;
typedef short bf16x8 __attribute__((ext_vector_type(8)));
typedef float f32x4 __attribute__((ext_vector_type(4)));
typedef unsigned u32x4 __attribute__((ext_vector_type(4)));
constexpr int BM = 256, BK = 64, HALF = 128, HTB = HALF * BK * 2  , STAGE_BYTES = 8 * HTB, NXCD = 8, WGM = 8;

__host__ __device__ __forceinline__ int lds_byte(int r, int c) { const int st = (r >> 4) * 2 + (c >> 5), rr = r & 15, cc = c & 31, ob = rr * 64 + cc * 2; return st * 1024 + (ob ^ (((ob >> 9) & 1) << 5)); }
__host__ __device__ __forceinline__ void stage_rc(int b, int& R, int& C) { const int st = b / 1024, sb = b % 1024, swz = sb ^ (((sb >> 9) & 1) << 5); R = (st >> 1) * 16 + swz / 64; C = (st & 1) * 32 + (swz % 64) / 2; }
__host__ __device__ __forceinline__ int perm32(int rho) { const int n = rho >> 4, i = rho & 15; return 8 * (i >> 2) + 4 * n + (i & 3); }

struct Unit { int pm, pn; };
struct Gemm { const bf16_t* A; const bf16_t* Bt; int M, N, K, KL; };

struct StaticOrder {
    int nM, nN, nwg, G, c;
    __host__ __device__ void init(int M, int N, int G_, int c_) { nM = M / BM; nN = N / BM; nwg = nM * nN; G = G_; c = c_; }
    __host__ __device__ bool next(int i, Unit& u) const {
        const long L = (long)i * G + c; if (L >= nwg) return false;
        int wgid = (int)L; { const int q = nwg / NXCD, r = nwg % NXCD, xcd = wgid % NXCD, off = wgid / NXCD; wgid = (xcd < r ? xcd * (q + 1) : r * (q + 1) + (xcd - r) * q) + off; }
        const int nig = WGM * nN, gid = wgid / nig, fm = gid * WGM, gsz = (nM - fm) < WGM ? (nM - fm) : WGM;
        u.pm = fm + ((wgid % nig) % gsz); u.pn = (wgid % nig) / gsz; return true;
    }
    __device__ __forceinline__ void a_ready(const Unit&) const {}
    __device__ __forceinline__ void done(const Unit&) const {}
};


__device__ __forceinline__ unsigned cvt_pk_bf16(float lo, float hi) { unsigned r; asm volatile("v_cvt_pk_bf16_f32 %0, %1, %2" : "=v"(r) : "v"(lo), "v"(hi)); return r; }

constexpr int E_MP = 16384;
constexpr int E_ZRW = 1632, E_ZSW = 1696;

struct OneUnit { Unit u; bool has;
    __device__ __forceinline__ bool next(int i, Unit& o) const { if (i == 0 && has) { o = u; return true; } return false; }
    __device__ __forceinline__ void a_ready(const Unit&) const {}
    __device__ __forceinline__ void done(const Unit&) const {} };
struct EpiZ {
    static constexpr bool PERM = true, AFTER_DRAIN = false;
    bf16_t* ZR; bf16_t* ZS;
    __device__ __forceinline__ void operator()(const f32x4 (&acc)[2][2][4][2], const Unit& u, int wr, int wc, int fr, int fq) const {
        const int row0 = u.pm * BM + wr * 64 + fr, c0 = u.pn * BM + wc * 32 + 8 * fq;
#pragma unroll
        for (int ai = 0; ai < 2; ++ai)
#pragma unroll
            for (int m = 0; m < 4; ++m) { const size_t row = (size_t)(row0 + ai * HALF + m * 16);
#pragma unroll
                for (int bj = 0; bj < 2; ++bj) { const int c = c0 + bj * HALF; bf16_t* dst;
                    if (c < 1600) dst = ZR + row * E_ZRW + c; else if (c < 3296) dst = ZS + row * E_ZSW + (c - 1600); else if (c == 3296) dst = ZR + row * E_ZRW + 1600; else continue;
                    const f32x4 v0 = acc[ai][bj][m][0], v1 = acc[ai][bj][m][1]; u32x4 w;
                    w.x = cvt_pk_bf16(v0[0], v0[1]); w.y = cvt_pk_bf16(v0[2], v0[3]); w.z = cvt_pk_bf16(v1[0], v1[1]); w.w = cvt_pk_bf16(v1[2], v1[3]);
                    *(u32x4*)dst = w; } }
    }
};
struct EpiH {
    static constexpr bool PERM = false, AFTER_DRAIN = false;
    const float* xp; const float* xs; float* H; bf16_t* HB; float* SS;
    __device__ __forceinline__ void operator()(const f32x4 (&acc)[2][2][4][2], const Unit& u, int wr, int wc, int fr, int fq) const {
        const int row0 = u.pm * BM + wr * 64 + fr, col0 = u.pn * BM + wc * 32 + 4 * fq;
#pragma unroll
        for (int ai = 0; ai < 2; ++ai)
#pragma unroll
            for (int m = 0; m < 4; ++m) { const int row = row0 + ai * HALF + m * 16;
                const float* xr = (row < E_MP ? xp + (size_t)row * 1024 : xs + (size_t)(row - E_MP) * 1024) + col0; float* hr = H + (size_t)row * 1024 + col0; bf16_t* hb = HB + (size_t)row * 1024 + col0;
                float ss = 0.f;
#pragma unroll
                for (int bj = 0; bj < 2; ++bj)
#pragma unroll
                    for (int n = 0; n < 2; ++n) { const f32x4 h = *(const f32x4*)(xr + bj * HALF + n * 16) + acc[ai][bj][m][n]; *(f32x4*)(hr + bj * HALF + n * 16) = h;
                        ss += (h[0] * h[0] + h[1] * h[1]) + (h[2] * h[2] + h[3] * h[3]);
                        unsigned w0 = cvt_pk_bf16(h[0], h[1]), w1 = cvt_pk_bf16(h[2], h[3]); typedef unsigned u32x2v __attribute__((ext_vector_type(2))); *(u32x2v*)(hb + bj * HALF + n * 16) = (u32x2v){w0, w1}; }
                ss += __shfl_xor(ss, 16); ss += __shfl_xor(ss, 32);
                if (fq == 0) atomicAdd(SS + row, ss); }
    }
};
struct EpiAct {
    static constexpr bool PERM = true, AFTER_DRAIN = false;
    bf16_t* O; int ldc; const float* SS;
    __device__ __forceinline__ void operator()(const f32x4 (&acc)[2][2][4][2], const Unit& u, int wr, int wc, int fr, int fq) const {
        const int row0 = u.pm * BM + wr * 64 + fr, c0 = u.pn * BM + wc * 32 + 8 * fq;
#pragma unroll
        for (int ai = 0; ai < 2; ++ai)
#pragma unroll
            for (int m = 0; m < 4; ++m) { const int row = row0 + ai * HALF + m * 16; bf16_t* rowp = O + (size_t)row * ldc + c0;
                const float rs = rsqrtf(SS[row] * (1.0f / 1024.0f) + 1e-6f);
#pragma unroll
                for (int bj = 0; bj < 2; ++bj) { f32x4 v0 = acc[ai][bj][m][0], v1 = acc[ai][bj][m][1];
#pragma unroll
                    for (int e = 0; e < 4; ++e) { const float a = fmaxf(v0[e], 0.f) * rs, b = fmaxf(v1[e], 0.f) * rs; v0[e] = a * a; v1[e] = b * b; }
                    u32x4 w; w.x = cvt_pk_bf16(v0[0], v0[1]); w.y = cvt_pk_bf16(v0[2], v0[3]); w.z = cvt_pk_bf16(v1[0], v1[1]); w.w = cvt_pk_bf16(v1[2], v1[3]);
                    *(u32x4*)(rowp + bj * HALF) = w; } }
    }
};
struct EpiSlab {
    static constexpr bool PERM = false, AFTER_DRAIN = false;
    float* S;
    __device__ __forceinline__ void operator()(const f32x4 (&acc)[2][2][4][2], const Unit& u, int wr, int wc, int fr, int fq) const {
        const int row0 = u.pm * BM - E_MP + wr * 64 + fr, col0 = u.pn * BM + wc * 32 + 4 * fq;
#pragma unroll
        for (int ai = 0; ai < 2; ++ai)
#pragma unroll
            for (int m = 0; m < 4; ++m) { float* yr = S + (size_t)(row0 + ai * HALF + m * 16) * 1024 + col0;
#pragma unroll
                for (int bj = 0; bj < 2; ++bj)
#pragma unroll
                    for (int n = 0; n < 2; ++n) *(f32x4*)(yr + bj * HALF + n * 16) = acc[ai][bj][m][n]; }
    }
};
struct EpiY {
    static constexpr bool PERM = false, AFTER_DRAIN = false;
    float* Y;
    __device__ __forceinline__ void operator()(const f32x4 (&acc)[2][2][4][2], const Unit& u, int wr, int wc, int fr, int fq) const {
        const int row0 = u.pm * BM + wr * 64 + fr, col0 = u.pn * BM + wc * 32 + 4 * fq;
#pragma unroll
        for (int ai = 0; ai < 2; ++ai)
#pragma unroll
            for (int m = 0; m < 4; ++m) { float* yr = Y + (size_t)(row0 + ai * HALF + m * 16) * 1024 + col0;
#pragma unroll
                for (int bj = 0; bj < 2; ++bj)
#pragma unroll
                    for (int n = 0; n < 2; ++n) { f32x4* p = (f32x4*)(yr + bj * HALF + n * 16); *p = *p + acc[ai][bj][m][n]; } }
    }
};

template <class Epi, class Sched, bool ALIGN_EPI = false, bool SP2 = false>
__device__ __forceinline__ void gemm_phase(PG8_LAS unsigned char* lds, const Gemm g, const Sched& S, const Epi& E) {
    const int tid = threadIdx.x, wid = __builtin_amdgcn_readfirstlane(tid >> 6), lane = tid & 63, wr = wid >> 2, wc = wid & 3, fr = lane & 15, fq = lane >> 4;
    const int K = g.K, nt = g.KL / BK;
    unsigned voffA[2], voffB[2];
#pragma unroll
    for (int i = 0; i < 2; ++i) { int R, C; stage_rc(tid * 16 + i * 8192, R, C); const int Rb = Epi::PERM ? ((R & ~31) + perm32(R & 31)) : R;
        voffA[i] = (unsigned)(R * K + C) * 2u; voffB[i] = (unsigned)(Rb * K + C) * 2u; }
    const size_t kstep = (size_t)(BK * 2);
    const size_t hstep = (size_t)HALF * K * 2;
    const size_t tstep = 2 * hstep;
    const unsigned ldsw = (unsigned)wid * 1024u;
    const int aoff = lds_byte(wr * 64 + fr, fq * 8), boff = lds_byte(wc * 32 + fr, fq * 8);
#define PG8_SA(b, h) (((b) * 2 + (h)) * HTB)
#define PG8_SB(b, h) ((4 + (b) * 2 + (h)) * HTB)
#define PG8_STAGE(bufoff, gbase, voff) do { _Pragma("unroll") for (int _i = 0; _i < 2; ++_i) \
        __builtin_amdgcn_global_load_lds((const unsigned*)((const char*)(gbase) + (voff)[_i]), (PG8_LAS unsigned*)(lds + (bufoff) + ldsw + _i * 8192), 16, 0, 0); } while (0)
#define PG8_LDA(dst, b, h) do { _Pragma("unroll") for (int m = 0; m < 4; ++m) _Pragma("unroll") for (int k = 0; k < 2; ++k) dst[m][k] = *(const PG8_LAS bf16x8*)(lds + PG8_SA(b, h) + aoff + m * 2048 + k * 1024); } while (0)
#define PG8_LDB(dst, b, h) do { _Pragma("unroll") for (int n = 0; n < 2; ++n) _Pragma("unroll") for (int k = 0; k < 2; ++k) dst[n][k] = *(const PG8_LAS bf16x8*)(lds + PG8_SB(b, h) + boff + n * 2048 + k * 1024); } while (0)
#define PG8_MMA(ai, bj, At, Bt) do { __builtin_amdgcn_s_setprio(1); _Pragma("unroll") for (int m = 0; m < 4; ++m) _Pragma("unroll") for (int n = 0; n < 2; ++n) _Pragma("unroll") for (int k = 0; k < 2; ++k) \
        acc[ai][bj][m][n] = __builtin_amdgcn_mfma_f32_16x16x32_bf16(Bt[n][k], At[m][k], acc[ai][bj][m][n], 0, 0, 0); __builtin_amdgcn_s_setprio(0); } while (0)
#define PG8_WAIT_V(n) asm volatile("s_waitcnt vmcnt(" #n ")" ::: "memory")
#define PG8_WAIT_L(n) asm volatile("s_waitcnt lgkmcnt(" #n ")" ::: "memory")
#define PG8_BAR __builtin_amdgcn_s_barrier()
#define PG8_SCHED __builtin_amdgcn_sched_barrier(0)
    Unit cur, nxt; int ui = 0;
    if (!S.next(0, cur)) return;
    f32x4 acc[2][2][4][2];
#pragma unroll
    for (int a = 0; a < 2; ++a)
#pragma unroll
        for (int b = 0; b < 2; ++b)
#pragma unroll
            for (int m = 0; m < 4; ++m)
#pragma unroll
                for (int n = 0; n < 2; ++n) acc[a][b][m][n] = (f32x4){0.f, 0.f, 0.f, 0.f};
    bf16x8 At[4][2], B0[2][2], B1[2][2];
    const char* cA = (const char*)g.A + (size_t)cur.pm * tstep; const char* cB = (const char*)g.Bt + (size_t)cur.pn * tstep;
    S.a_ready(cur);
    if constexpr (SP2) {
        PG8_STAGE(PG8_SB(0, 0), cB, voffB); PG8_STAGE(PG8_SB(0, 1), cB + hstep, voffB); PG8_STAGE(PG8_SA(0, 0), cA, voffA); PG8_STAGE(PG8_SA(0, 1), cA + hstep, voffA);
        if (wr == 1) PG8_BAR;
        PG8_WAIT_V(2); PG8_BAR;
        PG8_STAGE(PG8_SB(1, 0), cB + kstep, voffB); PG8_STAGE(PG8_SA(1, 0), cA + kstep, voffA); PG8_STAGE(PG8_SB(1, 1), cB + hstep + kstep, voffB);
        PG8_WAIT_V(6); PG8_BAR;
    } else {
        PG8_STAGE(PG8_SB(0, 0), cB, voffB); PG8_STAGE(PG8_SA(0, 0), cA, voffA); PG8_STAGE(PG8_SB(0, 1), cB + hstep, voffB); PG8_STAGE(PG8_SA(0, 1), cA + hstep, voffA);
        if (wr == 1) PG8_BAR;
        PG8_WAIT_V(4); PG8_BAR;
        PG8_STAGE(PG8_SB(1, 0), cB + kstep, voffB); PG8_STAGE(PG8_SA(1, 0), cA + kstep, voffA); PG8_STAGE(PG8_SB(1, 1), cB + hstep + kstep, voffB);
        PG8_WAIT_V(6); PG8_BAR;
    }
    for (;;) {
        const bool has_next = S.next(ui + 1, nxt);
        const char* nA = has_next ? (const char*)g.A + (size_t)nxt.pm * tstep : cA; const char* nB = has_next ? (const char*)g.Bt + (size_t)nxt.pn * tstep : cB;
        for (int t = 0; t < nt; t += 2) {
            const bool last = (t == nt - 2);
            const char* a1 = cA + (size_t)(t + 1) * kstep;
            const char* a2 = last ? nA : cA + (size_t)(t + 2) * kstep; const char* b2 = last ? nB : cB + (size_t)(t + 2) * kstep;
            const char* a3 = a2 + kstep; const char* b3 = b2 + kstep;
            if (last && has_next) S.a_ready(nxt);
            if constexpr (SP2) {
            PG8_LDB(B0, 0, 0); PG8_LDB(B1, 0, 1); PG8_SCHED; PG8_LDA(At, 0, 0); PG8_STAGE(PG8_SA(1, 1), a1 + hstep, voffA);
            PG8_WAIT_V(8); PG8_WAIT_L(0); PG8_BAR; PG8_MMA(0, 0, At, B0); PG8_MMA(0, 1, At, B1); PG8_BAR; PG8_SCHED;
            PG8_LDA(At, 0, 1); PG8_STAGE(PG8_SB(0, 0), b2, voffB); PG8_STAGE(PG8_SB(0, 1), b2 + hstep, voffB); PG8_STAGE(PG8_SA(0, 0), a2, voffA);
            PG8_WAIT_V(8); PG8_WAIT_L(0); PG8_BAR; PG8_MMA(1, 0, At, B0); PG8_MMA(1, 1, At, B1); PG8_BAR; PG8_SCHED;
            PG8_LDB(B0, 1, 0); PG8_LDB(B1, 1, 1); PG8_SCHED; PG8_LDA(At, 1, 0); PG8_STAGE(PG8_SA(0, 1), a2 + hstep, voffA);
            PG8_WAIT_V(8); PG8_WAIT_L(0); PG8_BAR; PG8_MMA(0, 0, At, B0); PG8_MMA(0, 1, At, B1); PG8_BAR; PG8_SCHED;
            PG8_LDA(At, 1, 1); PG8_STAGE(PG8_SB(1, 0), b3, voffB); PG8_STAGE(PG8_SB(1, 1), b3 + hstep, voffB); PG8_STAGE(PG8_SA(1, 0), a3, voffA);
            PG8_WAIT_V(8); PG8_WAIT_L(0); PG8_BAR; PG8_MMA(1, 0, At, B0); PG8_MMA(1, 1, At, B1); PG8_BAR; PG8_SCHED;
            } else {
            PG8_LDB(B0, 0, 0); PG8_SCHED; PG8_LDA(At, 0, 0); PG8_STAGE(PG8_SA(1, 1), a1 + hstep, voffA);
            PG8_WAIT_L(8); PG8_BAR; PG8_WAIT_L(0); PG8_MMA(0, 0, At, B0); PG8_BAR; PG8_SCHED;
            PG8_LDB(B1, 0, 1); PG8_STAGE(PG8_SB(0, 0), b2, voffB);
            PG8_BAR; PG8_WAIT_L(0); PG8_MMA(0, 1, At, B1); PG8_BAR;
            PG8_LDA(At, 0, 1); PG8_STAGE(PG8_SA(0, 0), a2, voffA);
            PG8_BAR; PG8_WAIT_L(0); PG8_MMA(1, 0, At, B0); PG8_BAR; PG8_SCHED;
            PG8_STAGE(PG8_SB(0, 1), b2 + hstep, voffB);
            PG8_WAIT_V(6); PG8_BAR; PG8_MMA(1, 1, At, B1); PG8_BAR;
            PG8_LDB(B0, 1, 0); PG8_SCHED; PG8_LDA(At, 1, 0); PG8_STAGE(PG8_SA(0, 1), a2 + hstep, voffA);
            PG8_WAIT_L(8); PG8_BAR; PG8_WAIT_L(0); PG8_MMA(0, 0, At, B0); PG8_BAR; PG8_SCHED;
            PG8_LDB(B1, 1, 1); PG8_STAGE(PG8_SB(1, 0), b3, voffB);
            PG8_BAR; PG8_WAIT_L(0); PG8_MMA(0, 1, At, B1); PG8_BAR;
            PG8_LDA(At, 1, 1); PG8_STAGE(PG8_SA(1, 0), a3, voffA);
            PG8_BAR; PG8_WAIT_L(0); PG8_MMA(1, 0, At, B0); PG8_BAR; PG8_SCHED;
            PG8_STAGE(PG8_SB(1, 1), b3 + hstep, voffB);
            PG8_WAIT_V(6); PG8_BAR; PG8_MMA(1, 1, At, B1); PG8_BAR;
            }
        }
        if constexpr (ALIGN_EPI) { if (wr == 0) PG8_BAR; }
        if constexpr (!Epi::AFTER_DRAIN) { E(acc, cur, wr, wc, fr, fq); S.done(cur); }
        if (!has_next) break;
#pragma unroll
        for (int a = 0; a < 2; ++a)
#pragma unroll
            for (int b = 0; b < 2; ++b)
#pragma unroll
                for (int m = 0; m < 4; ++m)
#pragma unroll
                    for (int n = 0; n < 2; ++n) acc[a][b][m][n] = (f32x4){0.f, 0.f, 0.f, 0.f};
        cur = nxt; cA = nA; cB = nB; ++ui;
        if constexpr (ALIGN_EPI) { if (wr == 1) PG8_BAR; }
    }
    PG8_WAIT_V(0);
    if constexpr (!ALIGN_EPI) { if (wr == 0) PG8_BAR; }
    PG8_BAR;
    if constexpr (Epi::AFTER_DRAIN) { E.fused(acc, cur, wr, wc, fr, fq, lds, wid, lane); S.done(cur); }
#undef PG8_SA
#undef PG8_SB
#undef PG8_STAGE
#undef PG8_LDA
#undef PG8_LDB
#undef PG8_MMA
#undef PG8_WAIT_V
#undef PG8_WAIT_L
#undef PG8_BAR
#undef PG8_SCHED
}
}


constexpr int DM = 1024, NB_P = 8, T_P = 2048, NB_S = 32, T_S = 32, PAST = 1024;
constexpr int MP = NB_P * T_P, MS = NB_S * T_S, MT = MP + MS;
constexpr int LS = PAST + T_S;
constexpr int SHIFTW = 1696, NZ = 3328, ZRW = 1632, DFF = 4096;
constexpr float QSCALE = 0.125f * 1.4426950408889634f;
constexpr float WISCALE = 0.35355339059327373f * 0.125f;
constexpr size_t OFF_Y = 0, OFF_KP = 17825792, OFF_VP = OFF_KP + 4194304, OFF_KIP = OFF_VP + 4194304, OFF_WKVP = OFF_KIP + 1048576, OFF_SHP = OFF_WKVP + 262144,
                 OFF_KS = OFF_SHP + 13568, OFF_VS = OFF_KS + 262144, OFF_KIS = OFF_VS + 262144, OFF_WKVS = OFF_KIS + 65536, OFF_SHS = OFF_WKVS + 1048576, OUT_TOTAL = OFF_SHS + 54272;
constexpr size_t MiB = 1u << 20;
constexpr size_t WS_CTL = 0, CTL_BYTES = 1 * MiB;
constexpr size_t WS_WIN = 1 * MiB, WS_WOUT = 8 * MiB, WS_W1 = 10 * MiB, WS_W2 = 18 * MiB;
constexpr size_t WS_W2T = 26 * MiB, WS_A2T = WS_W2T + 32768, WS_G2T = WS_A2T + 32768, WS_WI = 27 * MiB, WS_BONUS = 28 * MiB;
constexpr size_t WS_XB = 30 * MiB;
constexpr size_t WS_ZS = 66 * MiB;
constexpr size_t WS_R = 123 * MiB;
constexpr size_t WS_ZR = WS_R, WS_KBP = 178 * MiB, WS_VTP = 186 * MiB, WS_KIP = 194 * MiB, WS_KBS = 196 * MiB, WS_VTS = 213 * MiB, WS_KIS = 230 * MiB;
constexpr size_t WS_OW = WS_R, WS_OKK = 157 * MiB, WS_OB = 174 * MiB, WS_OKM = 191 * MiB, WS_OR = 208 * MiB, WS_OV = 225 * MiB;
constexpr size_t WS_ACT = 66 * MiB, WS_HB = 202 * MiB, WS_END = 256 * MiB;
static_assert(WS_ZS + (size_t)MT * SHIFTW * 2 <= WS_R && WS_ZR + (size_t)MT * ZRW * 2 <= WS_KBP && WS_KBS + (size_t)NB_S * LS * 256 * 2 <= WS_VTS && WS_VTS + (size_t)NB_S * 256 * LS * 2 <= WS_KIS &&
              WS_KIS + (size_t)NB_S * LS * 64 * 2 <= WS_END && WS_OV + (size_t)MT * 512 * 2 <= WS_END && WS_ACT + (size_t)MT * DFF * 2 <= WS_HB && WS_HB + (size_t)MT * DM * 2 <= WS_END, "d_ws map");
constexpr size_t SC_Q = 0, SC_QI = (size_t)MT * 512 / 2, SC_Y = 0, SC_G = (size_t)MT * 512;
constexpr int CW_QATT = 64, CW_SS = 16384;

typedef unsigned short bf16;
typedef short bf16x8 __attribute__((ext_vector_type(8)));
typedef float f32x4 __attribute__((ext_vector_type(4)));
typedef float f32x16 __attribute__((ext_vector_type(16)));
typedef unsigned u32x4 __attribute__((ext_vector_type(4)));
typedef unsigned u32x2 __attribute__((ext_vector_type(2)));

__device__ __forceinline__ unsigned f2bf(float f) { unsigned u = __float_as_uint(f); return (u + 0x7fffu + ((u >> 16) & 1u)) >> 16; }
__device__ __forceinline__ unsigned pk2(float lo, float hi) { return f2bf(lo) | (f2bf(hi) << 16); }
__device__ __forceinline__ float bflo(unsigned w) { return __uint_as_float(w << 16); }
__device__ __forceinline__ float bfhi(unsigned w) { return __uint_as_float(w & 0xffff0000u); }
__device__ __forceinline__ float bf1(bf16 b) { return __uint_as_float((unsigned)b << 16); }
__device__ __forceinline__ void unpack8(const u32x4 w, float* x) { x[0] = bflo(w.x); x[1] = bfhi(w.x); x[2] = bflo(w.y); x[3] = bfhi(w.y); x[4] = bflo(w.z); x[5] = bfhi(w.z); x[6] = bflo(w.w); x[7] = bfhi(w.w); }
__device__ __forceinline__ u32x4 pack8(const float* x) { u32x4 w; w.x = pk2(x[0], x[1]); w.y = pk2(x[2], x[3]); w.z = pk2(x[4], x[5]); w.w = pk2(x[6], x[7]); return w; }
__device__ __forceinline__ float wave_sum(float v) {
#pragma unroll
    for (int o = 1; o < 64; o <<= 1) v += __shfl_xor(v, o);
    return v;
}
template <int CTRL> __device__ __forceinline__ float dppmov(float x) { return __builtin_bit_cast(float, __builtin_amdgcn_update_dpp(0, __builtin_bit_cast(int, x), CTRL, 0xf, 0xf, true)); }
__device__ __forceinline__ float sum16(float x) {
    x += dppmov<0xB1>(x); x += dppmov<0x4E>(x); x += dppmov<0x141>(x); x += dppmov<0x140>(x); return x;
}
__device__ __forceinline__ int crow(int r, int hi) { return (r & 3) + 8 * (r >> 2) + 4 * hi; }

struct Args { const float* in[28]; float* out; unsigned char* ws; int ph_lo, ph_hi; };

__device__ __forceinline__ void tr_item(const float* W, int K, int N, const float* gain, bf16* WT, int jr0, int c0, int nvalid, int k0, float* scr, int lane) {
#pragma unroll 8
    for (int i = 0; i < 32; ++i) { const int kk = 2 * i + (lane >> 5), n = lane & 31;
        float v = (n < nvalid) ? W[(size_t)(k0 + kk) * N + c0 + n] : 0.f; if (gain) v *= gain[k0 + kk]; scr[kk * 33 + n] = v; }
    __builtin_amdgcn_s_waitcnt(0xC07F); asm volatile("" ::: "memory");
    const int c = lane & 7;
#pragma unroll
    for (int j = 0; j < 4; ++j) { const int n = (lane >> 3) + 8 * j; const float* s = scr + (8 * c) * 33 + n;
        u32x4 o; o.x = pk2(s[0 * 33], s[1 * 33]); o.y = pk2(s[2 * 33], s[3 * 33]); o.z = pk2(s[4 * 33], s[5 * 33]); o.w = pk2(s[6 * 33], s[7 * 33]);
        *(u32x4*)(WT + (size_t)(jr0 + n) * K + k0 + 8 * c) = o; }
    __builtin_amdgcn_s_waitcnt(0xC07F); asm volatile("" ::: "memory");
}
__device__ __forceinline__ void p0_prologue(const Args& a, unsigned char* lds, int tid) {
    const int lane = tid & 63, wave = tid >> 6, gw = blockIdx.x * 8 + wave, NGW = gridDim.x * 8;
    float* scr = (float*)(lds + wave * 17408);
    unsigned char* ws = a.ws;
    constexpr int I_IN = (NZ / 32) * (DM / 64), I_OUT = (DM / 32) * (DM / 64), I_F1 = (DFF / 32) * (DM / 64), I_F2 = (DM / 32) * (DFF / 64);
    for (int it = gw; it < I_IN + I_OUT + I_F1 + I_F2; it += NGW) {
        int r = it;
        if (r < I_IN) { const int jb = r % (NZ / 32), kb = r / (NZ / 32), j0 = jb * 32; int c0, nv;
            if (j0 < 1600) { c0 = j0; nv = 32; } else if (j0 < 3296) { c0 = 1608 + (j0 - 1600); nv = 32; } else { c0 = 1600; nv = 8; }
            tr_item(a.in[8], DM, 3304, a.in[7], (bf16*)(ws + WS_WIN), j0, c0, nv, kb * 64, scr, lane); continue; }
        r -= I_IN;
        if (r < I_OUT) { const int jb = r % (DM / 32), kb = r / (DM / 32); tr_item(a.in[24], DM, DM, nullptr, (bf16*)(ws + WS_WOUT), jb * 32, jb * 32, 32, kb * 64, scr, lane); continue; }
        r -= I_OUT;
        if (r < I_F1) { const int jb = r % (DFF / 32), kb = r / (DFF / 32); tr_item(a.in[26], DM, DFF, a.in[25], (bf16*)(ws + WS_W1), jb * 32, jb * 32, 32, kb * 64, scr, lane); continue; }
        r -= I_F1;
        { const int jb = r % (DM / 32), kb = r / (DM / 32); tr_item(a.in[27], DFF, DM, nullptr, (bf16*)(ws + WS_W2), jb * 32, jb * 32, 32, kb * 64, scr, lane); }
    }
    { const int gt = blockIdx.x * 512 + tid, NT = gridDim.x * 512;
      bf16* w2t = (bf16*)(ws + WS_W2T); bf16* a2t = (bf16*)(ws + WS_A2T); bf16* g2t = (bf16*)(ws + WS_G2T);
      for (int i = gt; i < 512 * 32; i += NT) { const int n = i >> 5, k = i & 31; w2t[i] = (bf16)f2bf(a.in[15][k * 512 + n]); a2t[i] = (bf16)f2bf(a.in[17][k * 512 + n]); }
      for (int i = gt; i < 512 * 96; i += NT) { const int n = i / 96, k = i % 96; g2t[i] = (bf16)f2bf(a.in[18][k * 512 + n]); } }
    { f32x4 v[4], nx[4]; int m = gw;
      if (m < MT) { const f32x4* xr = (const f32x4*)((m < MP) ? a.in[0] + (size_t)m * DM : a.in[1] + (size_t)(m - MP) * DM) + lane;
#pragma unroll
          for (int j = 0; j < 4; ++j) v[j] = xr[64 * j]; }
      for (; m < MT; m += NGW) {
        const int mn = m + NGW;
        if (mn < MT) { const f32x4* xr = (const f32x4*)((mn < MP) ? a.in[0] + (size_t)mn * DM : a.in[1] + (size_t)(mn - MP) * DM) + lane;
#pragma unroll
            for (int j = 0; j < 4; ++j) nx[j] = xr[64 * j]; }
        float s = 0.f;
#pragma unroll
        for (int j = 0; j < 4; ++j) s += (v[j].x * v[j].x + v[j].y * v[j].y) + (v[j].z * v[j].z + v[j].w * v[j].w);
        const float rs = rsqrtf(wave_sum(s) * (1.f / DM) + 1e-6f);
        u32x2* o8 = (u32x2*)((bf16*)(ws + WS_XB) + (size_t)m * DM) + lane;
#pragma unroll
        for (int j = 0; j < 4; ++j) { u32x2 o; o.x = pk2(v[j].x * rs, v[j].y * rs); o.y = pk2(v[j].z * rs, v[j].w * rs); o8[64 * j] = o; }
#pragma unroll
        for (int j = 0; j < 4; ++j) v[j] = nx[j];
      } }
    for (int r4 = gw; r4 < NB_S * PAST / 4; r4 += NGW) {
        f32x4 v[4];
#pragma unroll
        for (int j = 0; j < 4; ++j) v[j] = ((const f32x4*)(a.in[2] + (size_t)(4 * r4 + j) * 256))[lane];
#pragma unroll
        for (int j = 0; j < 4; ++j) { const int rix = 4 * r4 + j, b = rix >> 10, p = rix & 1023; u32x2 o; o.x = pk2(v[j].x, v[j].y); o.y = pk2(v[j].z, v[j].w);
            ((u32x2*)((bf16*)(ws + WS_KBS) + ((size_t)b * LS + p) * 256))[lane] = o; }
    }
    for (int r4 = gw; r4 < NB_S * PAST / 4; r4 += NGW) {
        const int rix = r4 * 4 + (lane >> 4), b = rix >> 10, p = rix & 1023; const f32x4 v = ((const f32x4*)(a.in[4] + (size_t)rix * 64))[lane & 15];
        u32x2 o; o.x = pk2(v.x, v.y); o.y = pk2(v.z, v.w); ((u32x2*)((bf16*)(ws + WS_KIS) + ((size_t)b * LS + p) * 64))[lane & 15] = o;
    }
    for (int it = gw; it < NB_S * 4 * 16; it += NGW) {
        const int kb = it & 15, g = (it >> 4) & 3, b = it >> 6;
        const float* src = a.in[3] + ((size_t)b * PAST + kb * 64) * 256 + g * 64;
#pragma unroll 8
        for (int i = 0; i < 64; ++i) scr[i * 65 + lane] = src[(size_t)i * 256 + lane];
        __builtin_amdgcn_s_waitcnt(0xC07F); asm volatile("" ::: "memory");
        bf16* dst = (bf16*)(ws + WS_VTS) + ((size_t)(b * 4 + g) * 64) * LS + kb * 64 + lane;
#pragma unroll 8
        for (int d = 0; d < 64; ++d) dst[(size_t)d * LS] = (bf16)f2bf(scr[lane * 65 + d]);
        __builtin_amdgcn_s_waitcnt(0xC07F); asm volatile("" ::: "memory");
    }
}

__device__ __forceinline__ void p2_post(const Args& a, unsigned char* lds, int tid) {
    unsigned char* ws = a.ws; float* out = a.out;
    const bf16* ZR = (const bf16*)(ws + WS_ZR); const bf16* ZS = (const bf16*)(ws + WS_ZS);
    bf16* Q = (bf16*)(out + SC_Q); bf16* QI = (bf16*)(out + SC_QI);
    float* cs = (float*)lds;
    bf16* vt = (bf16*)(lds + 4096);
    const int g8 = tid >> 3, sub = tid & 7;
    const float* qg = a.in[9]; const float* kg = a.in[10]; const float* lng = a.in[11]; const float* lnb = a.in[12];
    for (int unit = blockIdx.x; unit < 2 * (MT / 64); unit += gridDim.x) {
        const int tile = unit >> 1, part = unit & 1, hb0 = part ? 12 : 0, hb1 = part ? 25 : 12;
        const int m0 = tile * 64;
        { const int m = m0 + g8, pos = (m < MP) ? (m & (T_P - 1)) : (PAST + ((m - MP) & (T_S - 1)));
          const float inv = powf(500000.0f, -(float)sub * 0.125f); const float ang = (float)pos * inv; float s, c; sincosf(ang, &s, &c);
          cs[g8 * 16 + sub] = c; cs[g8 * 16 + 8 + sub] = s; }
        __syncthreads();
        const int m = m0 + g8;
        const bool isp = m < MP; const int ms = m - MP;
        float cc[8], ss[8];
#pragma unroll
        for (int j = 0; j < 8; ++j) { cc[j] = cs[g8 * 16 + j]; ss[j] = cs[g8 * 16 + 8 + j]; }
        const size_t kvrow = isp ? (size_t)m : ((size_t)(ms >> 5) * LS + PAST + (ms & 31));
        bf16* KB = (bf16*)(ws + (isp ? WS_KBP : WS_KBS)); bf16* KIb = (bf16*)(ws + (isp ? WS_KIP : WS_KIS));
        u32x4 xnext = *(const u32x4*)(ZR + (size_t)m * ZRW + hb0 * 64 + 8 * sub);
        for (int hb = hb0; hb < hb1; ++hb) {
            float x[8]; unpack8(xnext, x);
            if (hb + 1 < hb1) xnext = *(const u32x4*)(ZR + (size_t)m * ZRW + (hb + 1) * 64 + 8 * sub);
            if (hb < 12) {
                float s2 = 0.f;
#pragma unroll
                for (int j = 0; j < 8; ++j) s2 += x[j] * x[j];
                s2 += __shfl_xor(s2, 1); s2 += __shfl_xor(s2, 2); s2 += __shfl_xor(s2, 4);
                const float rinv = rsqrtf(s2 * (1.f / 64.f) + 1e-6f); const float* gn = (hb < 8 ? qg : kg) + 8 * sub;
                float y[8], o[8];
#pragma unroll
                for (int j = 0; j < 8; ++j) y[j] = x[j] * rinv * gn[j];
#pragma unroll
                for (int j = 0; j < 8; ++j) { const float p = __shfl_xor(y[j], 1); o[j] = sub == 0 ? y[j] * cc[j] - p * ss[j] : (sub == 1 ? y[j] * cc[j] + p * ss[j] : y[j]); }
                if (hb < 8) {
#pragma unroll
                    for (int j = 0; j < 8; ++j) o[j] *= QSCALE;
                    *(u32x4*)(Q + (size_t)m * 512 + hb * 64 + 8 * sub) = pack8(o);
                } else { const int g = hb - 8;
                    float* ko = out + (isp ? OFF_KP + (size_t)m * 256 : OFF_KS + (size_t)ms * 256) + g * 64 + 8 * sub;
                    *(f32x4*)ko = (f32x4){o[0], o[1], o[2], o[3]}; *(f32x4*)(ko + 4) = (f32x4){o[4], o[5], o[6], o[7]};
                    *(u32x4*)(KB + kvrow * 256 + g * 64 + 8 * sub) = pack8(o); }
            } else if (hb < 16) { const int g = hb - 12;
                float* vo = out + (isp ? OFF_VP + (size_t)m * 256 : OFF_VS + (size_t)ms * 256) + g * 64 + 8 * sub;
                *(f32x4*)vo = (f32x4){x[0], x[1], x[2], x[3]}; *(f32x4*)(vo + 4) = (f32x4){x[4], x[5], x[6], x[7]};
                unsigned* vd = (unsigned*)(vt + g8 * 258 + g * 64 + 8 * sub);
                vd[0] = pk2(x[0], x[1]); vd[1] = pk2(x[2], x[3]); vd[2] = pk2(x[4], x[5]); vd[3] = pk2(x[6], x[7]);
            } else if (hb < 24) {
                float o[8];
#pragma unroll
                for (int j = 0; j < 8; ++j) { const float p = __shfl_xor(x[j], 1); o[j] = sub == 0 ? x[j] * cc[j] - p * ss[j] : (sub == 1 ? x[j] * cc[j] + p * ss[j] : x[j]); }
                *(u32x4*)(QI + (size_t)m * 512 + (hb - 16) * 64 + 8 * sub) = pack8(o);
            } else {
                float s1 = 0.f;
#pragma unroll
                for (int j = 0; j < 8; ++j) s1 += x[j];
                s1 += __shfl_xor(s1, 1); s1 += __shfl_xor(s1, 2); s1 += __shfl_xor(s1, 4);
                const float mu = s1 * (1.f / 64.f); float s2 = 0.f;
#pragma unroll
                for (int j = 0; j < 8; ++j) { const float d = x[j] - mu; s2 += d * d; }
                s2 += __shfl_xor(s2, 1); s2 += __shfl_xor(s2, 2); s2 += __shfl_xor(s2, 4);
                const float rinv = rsqrtf(s2 * (1.f / 64.f) + 1e-6f); float y[8], o[8];
#pragma unroll
                for (int j = 0; j < 8; ++j) y[j] = (x[j] - mu) * rinv * lng[8 * sub + j] + lnb[8 * sub + j];
#pragma unroll
                for (int j = 0; j < 8; ++j) { const float p = __shfl_xor(y[j], 1); o[j] = sub == 0 ? y[j] * cc[j] - p * ss[j] : (sub == 1 ? y[j] * cc[j] + p * ss[j] : y[j]); }
                float* ko = out + (isp ? OFF_KIP + (size_t)m * 64 : OFF_KIS + (size_t)ms * 64) + 8 * sub;
                *(f32x4*)ko = (f32x4){o[0], o[1], o[2], o[3]}; *(f32x4*)(ko + 4) = (f32x4){o[4], o[5], o[6], o[7]};
                *(u32x4*)(KIb + kvrow * 64 + 8 * sub) = pack8(o);
            }
        }
        if (part == 0) ((float*)(ws + WS_WI))[(size_t)m * 8 + sub] = bf1(ZR[(size_t)m * ZRW + 1600 + sub]) * WISCALE;
        __syncthreads();
        if (part == 1) { const int r = tid >> 1, half = tid & 1; unsigned wv[16];
#pragma unroll
          for (int j = 0; j < 16; ++j) wv[j] = (unsigned)vt[(32 * half + 2 * j) * 258 + r] | ((unsigned)vt[(32 * half + 2 * j + 1) * 258 + r] << 16);
          bf16* dst;
          if (m0 < MP) dst = (bf16*)(ws + WS_VTP) + ((size_t)(m0 >> 11) * 256 + r) * T_P + (m0 & (T_P - 1)) + 32 * half;
          else { const int b = ((m0 - MP) >> 5) + half; dst = (bf16*)(ws + WS_VTS) + ((size_t)b * 256 + r) * LS + PAST; }
#pragma unroll
          for (int j = 0; j < 4; ++j) ((u32x4*)dst)[j] = (u32x4){wv[4 * j], wv[4 * j + 1], wv[4 * j + 2], wv[4 * j + 3]}; }
        if (part == 0) {} else if (m0 < MP) { if ((m0 & (T_P - 1)) == T_P - 64) { const int b = m0 >> 11; const bf16* zr = ZS + (size_t)(m0 + 63) * SHIFTW;
                for (int c = tid; c < SHIFTW; c += 512) out[OFF_SHP + (size_t)b * SHIFTW + c] = bf1(zr[c]); } }
        else { for (int h2 = 0; h2 < 2; ++h2) { const int b = ((m0 - MP) >> 5) + h2; const bf16* zr = ZS + (size_t)(m0 + 32 * h2 + 31) * SHIFTW;
                for (int c = tid; c < SHIFTW; c += 512) out[OFF_SHS + (size_t)b * SHIFTW + c] = bf1(zr[c]); } }
        __syncthreads();
    }
}

constexpr int ATT_UNITS = 544;
constexpr int MASK_PITCH = 65;
#define MFMA32(a, b, c) __builtin_amdgcn_mfma_f32_32x32x16_bf16((a), (b), (c), 0, 0, 0)

__device__ __forceinline__ float half_sum32(float v) { v += __shfl_xor(v, 1); v += __shfl_xor(v, 2); v += __shfl_xor(v, 4); v += __shfl_xor(v, 8); v += __shfl_xor(v, 16); return v; }
__device__ __forceinline__ float half_min32(float v) { v = fminf(v, __shfl_xor(v, 1)); v = fminf(v, __shfl_xor(v, 2)); v = fminf(v, __shfl_xor(v, 4)); v = fminf(v, __shfl_xor(v, 8)); v = fminf(v, __shfl_xor(v, 16)); return v; }
__device__ __forceinline__ float half_max32(float v) { v = fmaxf(v, __shfl_xor(v, 1)); v = fmaxf(v, __shfl_xor(v, 2)); v = fmaxf(v, __shfl_xor(v, 4)); v = fmaxf(v, __shfl_xor(v, 8)); v = fmaxf(v, __shfl_xor(v, 16)); return v; }
__device__ __forceinline__ int half_sum32i(int v) { v += __shfl_xor(v, 1); v += __shfl_xor(v, 2); v += __shfl_xor(v, 4); v += __shfl_xor(v, 8); v += __shfl_xor(v, 16); return v; }

#define LAS3 __attribute__((address_space(3)))
constexpr int A_RING1 = 0, A_SCL = 24576, A_RING2 = 24576, A_MASK = 0, A_LSUM = 8320, A_UNIT = 9344;
__device__ __forceinline__ void p3_attention(const Args& a, unsigned char* lds, int tid, int rep) {
    unsigned char* ws = a.ws; float* out = a.out;
    const bf16* Q = (const bf16*)(out + SC_Q); const bf16* QI = (const bf16*)(out + SC_QI); const float* WI = (const float*)(ws + WS_WI);
    bf16* O = (bf16*)(ws + WS_XB);
    unsigned* maskw = (unsigned*)(lds + A_MASK);
    float* lsum = (float*)(lds + A_LSUM);
    int* s_unit = (int*)(lds + A_UNIT);
    typedef float f32x2_t __attribute__((ext_vector_type(2)));
    f32x2_t* scl = (f32x2_t*)(lds + A_SCL) + (size_t)(tid >> 6) * 2048 + (tid & 63);
    unsigned* qctr = (unsigned*)(ws + WS_CTL) + CW_QATT + 64 * rep;
    const int l = tid & 63, w = __builtin_amdgcn_readfirstlane(tid >> 6), rho = l & 31, hi = l >> 5;
    LAS3 unsigned char* ldsb = (LAS3 unsigned char*)lds;
    for (;;) {
        if (tid == 0) *s_unit = (int)atomicAdd(qctr, 1u);
        __syncthreads();
        const int p = *s_unit;
        __syncthreads();
        if (p >= ATT_UNITS) break;
        int m0, nkt, vpitch; const bf16 *KB, *VT, *KI; bool need_idx;
        { int c = -1, b, half = 0;
          if (p < 256) { c = 31 - (p >> 4); b = (p & 15) >> 1; half = p & 1; }
          else if (p < 288) { b = p - 256; }
          else { const int pp = p - 288; c = 15 - (pp >> 4); b = (pp & 15) >> 1; half = pp & 1; }
          if (c >= 0) { m0 = b * T_P + 64 * c + 32 * half; nkt = 2 * (c + 1); vpitch = T_P; need_idx = c >= 4;
              KB = (const bf16*)(ws + WS_KBP) + (size_t)b * T_P * 256; VT = (const bf16*)(ws + WS_VTP) + (size_t)b * 256 * T_P; KI = (const bf16*)(ws + WS_KIP) + (size_t)b * T_P * 64; }
          else { m0 = MP + 32 * b; nkt = LS / 32; vpitch = LS; need_idx = true;
              KB = (const bf16*)(ws + WS_KBS) + (size_t)b * LS * 256; VT = (const bf16*)(ws + WS_VTS) + (size_t)b * 256 * LS; KI = (const bf16*)(ws + WS_KIS) + (size_t)b * LS * 64; } }
        if (need_idx) {
            const int tokA = 4 * w + 2 * ((rho >> 2) & 1) + (rho >> 4), headA = (rho & 3) + 4 * ((rho >> 3) & 1);
            bf16x8 qa[4];
#pragma unroll
            for (int ks = 0; ks < 4; ++ks) qa[ks] = *(const bf16x8*)(QI + (size_t)(m0 + tokA) * 512 + headA * 64 + 16 * ks + 8 * hi);
            float wv[16];
#pragma unroll
            for (int r = 0; r < 16; ++r) wv[r] = WI[(size_t)(m0 + 4 * w + 2 * hi + (r >> 3)) * 8 + (r & 7)];
            asm volatile("" :: "v"(qa[0]), "v"(qa[1]), "v"(qa[2]), "v"(qa[3]));
#pragma unroll
            for (int r = 0; r < 16; ++r) asm volatile("" :: "v"(wv[r]));
            asm volatile("s_waitcnt vmcnt(0)" ::: "memory");
            float sc0[32], sc1[32];
            const int nb = (nkt + 1) >> 1;
            const int sr = 8 * w + (l >> 3), scn = (l & 7) ^ ((sr >> 1) & 7);
            const unsigned char* ksrc = (const unsigned char*)KI + (size_t)sr * 128 + 16 * scn;
#define KI_STAGE(it_) __builtin_amdgcn_global_load_lds((const unsigned*)(ksrc + (size_t)(it_) * 8192), (LAS3 unsigned*)(ldsb + A_RING1 + ((it_) % 3) * 8192 + w * 1024), 16, 0, 0)
            for (int rp1 = 0; rp1 <= PROBE_A1; ++rp1) {
            if (rp1) __syncthreads();
            KI_STAGE(0); if (1 < nb) KI_STAGE(1);
#pragma unroll
            for (int it = 0; it < 32; ++it) {
                if (it < nb) {
                    if (it + 1 < nb) asm volatile("s_waitcnt vmcnt(1) lgkmcnt(0)\n\ts_barrier" ::: "memory"); else asm volatile("s_waitcnt vmcnt(0) lgkmcnt(0)\n\ts_barrier" ::: "memory");
                    if (it + 2 < nb) KI_STAGE(it + 2);
                    const unsigned char* tb = lds + A_RING1 + (it % 3) * 8192;
#pragma unroll
                    for (int k2 = 0; k2 < 2; ++k2) { const int kt = 2 * it + k2;
                        if (kt < nkt) {
                            const int r = 32 * k2 + rho; const unsigned char* rowp = tb + r * 128; const int sw = (r >> 1) & 7;
                            f32x16 acc = {0.f, 0.f, 0.f, 0.f, 0.f, 0.f, 0.f, 0.f, 0.f, 0.f, 0.f, 0.f, 0.f, 0.f, 0.f, 0.f};
#pragma unroll
                            for (int ks = 0; ks < 4; ++ks) acc = MFMA32(qa[ks], *(const bf16x8*)(rowp + 16 * ((2 * ks + hi) ^ sw)), acc);
                            float s0 = 0.f, s1 = 0.f;
#pragma unroll
                            for (int r2 = 0; r2 < 8; ++r2) { s0 += wv[r2] * fmaxf(acc[r2], 0.f); s1 += wv[8 + r2] * fmaxf(acc[8 + r2], 0.f); }
                            if (kt < 32) { sc0[kt & 31] = s0; sc1[kt & 31] = s1; } else scl[(kt - 32) * 64] = (f32x2_t){s0, s1};
                        } else if (kt < 32) { sc0[kt & 31] = -3.0e38f; sc1[kt & 31] = -3.0e38f; }
                    }
                } else { if (2 * it < 32) { sc0[(2 * it) & 31] = -3.0e38f; sc1[(2 * it) & 31] = -3.0e38f; sc0[(2 * it + 1) & 31] = -3.0e38f; sc1[(2 * it + 1) & 31] = -3.0e38f; } }
            }
            }
#undef KI_STAGE
            __syncthreads();
            float mn0 = 3.0e38f, mx0 = -3.0e38f, mn1 = 3.0e38f, mx1 = -3.0e38f; int cp0 = 0, cz0 = 0, cp1 = 0, cz1 = 0;
#pragma unroll
            for (int kt = 0; kt < 64; ++kt) if (kt < nkt) { float v0, v1; if (kt < 32) { v0 = sc0[kt & 31]; v1 = sc1[kt & 31]; } else { const f32x2_t t2 = scl[(kt - 32) * 64]; v0 = t2.x; v1 = t2.y; }
                mn0 = fminf(mn0, v0); mx0 = fmaxf(mx0, v0); mn1 = fminf(mn1, v1); mx1 = fmaxf(mx1, v1);
                cp0 += v0 > 0.f ? 1 : 0; cz0 += v0 == 0.f ? 1 : 0; cp1 += v1 > 0.f ? 1 : 0; cz1 += v1 == 0.f ? 1 : 0; }
            mn0 = half_min32(mn0); mx0 = half_max32(mx0); mn1 = half_min32(mn1); mx1 = half_max32(mx1);
            cp0 = half_sum32i(cp0); cz0 = half_sum32i(cz0); cp1 = half_sum32i(cp1); cz1 = half_sum32i(cz1);
            float lo0, hi0, lo1, hi1, thr0 = 0.f, thr1 = 0.f; int ch0, ch1, nt0 = 0, nt1 = 0; bool fin0, fin1;
            for (int rp2 = 0; rp2 <= PROBE_A2; ++rp2) {
            fin0 = false; fin1 = false; ch0 = 0; ch1 = 0;
            if (cp0 >= 256) { lo0 = 0.f; hi0 = mx0; if (cp0 == 256) { fin0 = true; thr0 = 0.f; nt0 = 0; } }
            else if (cp0 + cz0 >= 256) { lo0 = 0.f; hi0 = 0.f; fin0 = true; thr0 = 0.f; nt0 = 256 - cp0; }
            else { lo0 = mn0 - 1.0f; hi0 = 0.f; ch0 = cp0; }
            if (cp1 >= 256) { lo1 = 0.f; hi1 = mx1; if (cp1 == 256) { fin1 = true; thr1 = 0.f; nt1 = 0; } }
            else if (cp1 + cz1 >= 256) { lo1 = 0.f; hi1 = 0.f; fin1 = true; thr1 = 0.f; nt1 = 256 - cp1; }
            else { lo1 = mn1 - 1.0f; hi1 = 0.f; ch1 = cp1; }
            asm volatile("" : "+v"(lo0), "+v"(lo1));
            for (int iter = 0; iter < 64; ++iter) {
                const float mid0 = lo0 + 0.5f * (hi0 - lo0), mid1 = lo1 + 0.5f * (hi1 - lo1);
                int c0 = 0, c1 = 0;
#pragma unroll
                for (int g = 0; g < 4; ++g) if (8 * g < nkt) {
#pragma unroll
                    for (int k8 = 0; k8 < 8; ++k8) { c0 += sc0[8 * g + k8] > mid0 ? 1 : 0; c1 += sc1[8 * g + k8] > mid1 ? 1 : 0; } }
                for (int kt = 32; kt < nkt; kt += 8) {
                    f32x2_t t8[8];
#pragma unroll
                    for (int u = 0; u < 8; ++u) t8[u] = scl[(kt + u - 32) * 64];
#pragma unroll
                    for (int u = 0; u < 8; ++u) if (kt + u < nkt) { c0 += t8[u].x > mid0 ? 1 : 0; c1 += t8[u].y > mid1 ? 1 : 0; } }
                c0 = half_sum32i(c0); c1 = half_sum32i(c1);
                if (!fin0) { if (!(mid0 > lo0 && mid0 < hi0)) { fin0 = true; thr0 = hi0; nt0 = 256 - ch0; }
                             else if (c0 == 256) { fin0 = true; thr0 = mid0; nt0 = 0; } else if (c0 > 256) lo0 = mid0; else { hi0 = mid0; ch0 = c0; } }
                if (!fin1) { if (!(mid1 > lo1 && mid1 < hi1)) { fin1 = true; thr1 = hi1; nt1 = 256 - ch1; }
                             else if (c1 == 256) { fin1 = true; thr1 = mid1; nt1 = 0; } else if (c1 > 256) lo1 = mid1; else { hi1 = mid1; ch1 = c1; } }
                if (__all(fin0 && fin1)) break;
            }
            }
            const bool any_tie = __any(nt0 > 0 || nt1 > 0);
            int run0 = 0, run1 = 0; const unsigned below = (1u << rho) - 1u;
#pragma unroll
            for (int kt = 0; kt < 64; ++kt) if (kt < nkt) {
                float v0, v1; if (kt < 32) { v0 = sc0[kt & 31]; v1 = sc1[kt & 31]; } else { const f32x2_t t2 = scl[(kt - 32) * 64]; v0 = t2.x; v1 = t2.y; }
                bool p0 = v0 > thr0, p1 = v1 > thr1;
                if (any_tie) {
                    const bool e0 = nt0 > 0 && v0 == thr0, e1 = nt1 > 0 && v1 == thr1;
                    const unsigned long long be0 = __ballot(e0), be1 = __ballot(e1);
                    const unsigned h0 = (unsigned)(be0 >> (32 * hi)), h1 = (unsigned)(be1 >> (32 * hi));
                    p0 = p0 || (e0 && (run0 + __popc(h0 & below)) < nt0); p1 = p1 || (e1 && (run1 + __popc(h1 & below)) < nt1);
                    run0 += __popc(h0); run1 += __popc(h1);
                }
                const unsigned long long b0 = __ballot(p0), b1 = __ballot(p1);
                if (l == 0) { maskw[(4 * w + 0) * MASK_PITCH + kt] = (unsigned)b0; maskw[(4 * w + 1) * MASK_PITCH + kt] = (unsigned)b1; }
                if (l == 32) { maskw[(4 * w + 2) * MASK_PITCH + kt] = (unsigned)(b0 >> 32); maskw[(4 * w + 3) * MASK_PITCH + kt] = (unsigned)(b1 >> 32); }
            }
        }
        __syncthreads();
        {
            const int g = w >> 1;
            bf16x8 qb[4];
#pragma unroll
            for (int ks = 0; ks < 4; ++ks) qb[ks] = *(const bf16x8*)(Q + (size_t)(m0 + rho) * 512 + w * 64 + 16 * ks + 8 * hi);
            asm volatile("" :: "v"(qb[0]), "v"(qb[1]), "v"(qb[2]), "v"(qb[3]));
            asm volatile("s_waitcnt vmcnt(0)" ::: "memory");
            const unsigned char* ksrc[2]; const unsigned char* vsrc[2];
#pragma unroll
            for (int k = 0; k < 2; ++k) { const int i = (k * 8 + w) * 64 + l; const int r = i >> 5, c = i & 31; ksrc[k] = (const unsigned char*)KB + (size_t)r * 512 + 16 * (c ^ (r & 15));
                const int R = i >> 2, cv = i & 3; vsrc[k] = (const unsigned char*)VT + (size_t)R * vpitch * 2 + 16 * (cv ^ ((R >> 2) & 3)); }
#define KV_STAGE(t_) do { const int bo_ = A_RING2 + ((t_) % 3) * 32768 + w * 1024; \
            __builtin_amdgcn_global_load_lds((const unsigned*)(ksrc[0] + (size_t)(t_) * 16384), (LAS3 unsigned*)(ldsb + bo_), 16, 0, 0); \
            __builtin_amdgcn_global_load_lds((const unsigned*)(ksrc[1] + (size_t)(t_) * 16384), (LAS3 unsigned*)(ldsb + bo_ + 8192), 16, 0, 0); \
            __builtin_amdgcn_global_load_lds((const unsigned*)(vsrc[0] + (size_t)(t_) * 64), (LAS3 unsigned*)(ldsb + bo_ + 16384), 16, 0, 0); \
            __builtin_amdgcn_global_load_lds((const unsigned*)(vsrc[1] + (size_t)(t_) * 64), (LAS3 unsigned*)(ldsb + bo_ + 24576), 16, 0, 0); } while (0)
            f32x16 o0 = {0.f, 0.f, 0.f, 0.f, 0.f, 0.f, 0.f, 0.f, 0.f, 0.f, 0.f, 0.f, 0.f, 0.f, 0.f, 0.f}, o1 = o0; float psum = 0.f;
            const int ksw = rho & 15;
            const int vR0 = g * 64 + rho, vR1 = vR0 + 32; const int vs0 = (vR0 >> 2) & 3, vs1 = (vR1 >> 2) & 3;
            for (int rp3 = 0; rp3 <= PROBE_A3; ++rp3) {
            if (rp3) __syncthreads();
            KV_STAGE(0); if (1 < nkt) KV_STAGE(1);
            for (int kt = 0; kt < nkt; ++kt) {
                if (kt + 1 < nkt) asm volatile("s_waitcnt vmcnt(4) lgkmcnt(0)\n\ts_barrier" ::: "memory"); else asm volatile("s_waitcnt vmcnt(0) lgkmcnt(0)\n\ts_barrier" ::: "memory");
                if (kt + 2 < nkt) KV_STAGE(kt + 2);
                const unsigned char* kbuf = lds + A_RING2 + (kt % 3) * 32768; const unsigned char* vbuf = kbuf + 16384;
                f32x16 st = {0.f, 0.f, 0.f, 0.f, 0.f, 0.f, 0.f, 0.f, 0.f, 0.f, 0.f, 0.f, 0.f, 0.f, 0.f, 0.f};
#pragma unroll
                for (int ks = 0; ks < 4; ++ks) st = MFMA32(*(const bf16x8*)(kbuf + rho * 512 + 16 * ((g * 8 + 2 * ks + hi) ^ ksw)), qb[ks], st);
                unsigned word = need_idx ? maskw[rho * MASK_PITCH + kt] : 0xffffffffu; word >>= 4 * hi; float pr[16];
#pragma unroll
                for (int r = 0; r < 16; ++r) { const float e = __builtin_amdgcn_exp2f(st[r]); pr[r] = ((word >> ((r & 3) + 8 * (r >> 2))) & 1u) ? e : 0.f; psum += pr[r]; }
                union { u32x4 u; bf16x8 v; } pa0, pa1; pa0.u = (u32x4){pg8::cvt_pk_bf16(pr[0], pr[1]), pg8::cvt_pk_bf16(pr[2], pr[3]), pg8::cvt_pk_bf16(pr[4], pr[5]), pg8::cvt_pk_bf16(pr[6], pr[7])}; pa1.u = (u32x4){pg8::cvt_pk_bf16(pr[8], pr[9]), pg8::cvt_pk_bf16(pr[10], pr[11]), pg8::cvt_pk_bf16(pr[12], pr[13]), pg8::cvt_pk_bf16(pr[14], pr[15])};
                union { u32x4 u; bf16x8 v; } vf[2][2];
#pragma unroll
                for (int s2 = 0; s2 < 2; ++s2) { const unsigned char* r0 = vbuf + vR0 * 64 + 8 * hi; const unsigned char* r1 = vbuf + vR1 * 64 + 8 * hi;
                    const u32x2 a0 = *(const u32x2*)(r0 + 16 * ((2 * s2) ^ vs0)), a1 = *(const u32x2*)(r0 + 16 * ((2 * s2 + 1) ^ vs0)), b0 = *(const u32x2*)(r1 + 16 * ((2 * s2) ^ vs1)), b1 = *(const u32x2*)(r1 + 16 * ((2 * s2 + 1) ^ vs1));
                    vf[s2][0].u = (u32x4){a0.x, a0.y, a1.x, a1.y}; vf[s2][1].u = (u32x4){b0.x, b0.y, b1.x, b1.y}; }
                o0 = MFMA32(pa0.v, vf[0][0].v, o0); o0 = MFMA32(pa1.v, vf[1][0].v, o0); o1 = MFMA32(pa0.v, vf[0][1].v, o1); o1 = MFMA32(pa1.v, vf[1][1].v, o1);
            }
            }
#undef KV_STAGE
            psum += __shfl_xor(psum, 32);
            if (hi == 0) lsum[w * 32 + rho] = psum;
            __syncthreads();
#pragma unroll
            for (int r = 0; r < 16; ++r) { const int qr = crow(r, hi); const float inv = 1.0f / lsum[w * 32 + qr];
                bf16* op = O + (size_t)(m0 + qr) * DM + w * 64 + rho;
                op[0] = (bf16)f2bf(o0[r] * inv); op[32] = (bf16)f2bf(o1[r] * inv); }
        }
        __syncthreads();
    }
}

constexpr int XS_PITCH = 168;
__device__ __forceinline__ void p4_rwkv_prep(const Args& a, unsigned char* lds, int tid) {
    unsigned char* ws = a.ws; float* out = a.out;
    const bf16* ZS = (const bf16*)(ws + WS_ZS);
    const bf16* w2t = (const bf16*)(ws + WS_W2T); const bf16* a2t = (const bf16*)(ws + WS_A2T); const bf16* g2t = (const bf16*)(ws + WS_G2T);
    float* OW = (float*)(ws + WS_OW); bf16* OKK = (bf16*)(ws + WS_OKK); bf16* OB = (bf16*)(ws + WS_OB); bf16* OKM = (bf16*)(ws + WS_OKM); bf16* OR_ = (bf16*)(ws + WS_OR); bf16* OV = (bf16*)(ws + WS_OV);
    bf16* G = (bf16*)(out + SC_G); float* BON = (float*)(ws + WS_BONUS);
    const float* mu = a.in[13]; const float* w0 = a.in[14]; const float* a0 = a.in[16]; const float* k_k = a.in[19]; const float* k_a = a.in[20]; const float* r_k = a.in[21]; const float* sh0 = a.in[6];
    bf16* xs = (bf16*)lds;
    const int l = tid & 63, h = __builtin_amdgcn_readfirstlane(tid >> 6), rho = l & 31, hi = l >> 5;
    constexpr int ZP = 3408;
    unsigned char* zt = lds + 16384;
    for (int tile = blockIdx.x; tile < MT / 32; tile += gridDim.x) {
        const int m0 = tile * 32; const bool smp = m0 >= MP;
        const bool tile_first = smp || (m0 & (T_P - 1)) == 0;
        for (int i0 = tid; i0 < 33 * 212; i0 += 4 * 512) {
            u32x4 v[4];
#pragma unroll
            for (int j = 0; j < 4; ++j) { const int idx = i0 + j * 512; if (idx < 33 * 212) { const int r = idx / 212, c = idx - r * 212;
                    if (r == 0 && tile_first) { if (smp) { const float* sp = sh0 + (size_t)((m0 - MP) >> 5) * SHIFTW + 8 * c; const f32x4 a4 = *(const f32x4*)sp, b4 = *(const f32x4*)(sp + 4);
                            v[j] = (u32x4){pk2(a4.x, a4.y), pk2(a4.z, a4.w), pk2(b4.x, b4.y), pk2(b4.z, b4.w)}; } else v[j] = (u32x4){0u, 0u, 0u, 0u}; }
                    else v[j] = *(const u32x4*)(ZS + (size_t)(m0 + r - 1) * SHIFTW + 8 * c); } }
#pragma unroll
            for (int j = 0; j < 4; ++j) { const int idx = i0 + j * 512; if (idx < 33 * 212) { const int r = idx / 212, c = idx - r * 212; *(u32x4*)(zt + r * ZP + 16 * c) = v[j]; } }
        }
        __syncthreads();
        { const int tk = tid >> 4, c0 = (tid & 15) * 10;
          const bf16* zc = (const bf16*)(zt + (tk + 1) * ZP) + 1536 + c0; const bf16* zp = (const bf16*)(zt + tk * ZP) + 1536 + c0;
#pragma unroll
          for (int e = 0; e < 10; ++e) { const int c = c0 + e; const float cur = bf1(zc[e]); const float prev = bf1(zp[e]);
              const float zm = cur + mu[1536 + c] * (prev - cur);
              const float f = __frcp_rn(1.0f + __expf(c < 32 ? -2.0f * zm : -zm));
              const float v = c < 32 ? 2.0f * f - 1.0f : (c < 64 ? zm : f);
              xs[tk * XS_PITCH + c] = (bf16)f2bf(v); } }
        __syncthreads();
        const int m = m0 + rho;
        const bf16* zc = (const bf16*)(zt + (rho + 1) * ZP) + 64 * h + 4 * hi; const bf16* zp = (const bf16*)(zt + rho * ZP) + 64 * h + 4 * hi;
        const float* mu_l = mu + 64 * h + 4 * hi;
        const int pofs = 64 * h + 4 * hi;
#define ZMIX4(dst, co) do { const u32x2 cw = *(const u32x2*)(zc + (co)); const u32x2 pw = *(const u32x2*)(zp + (co)); const f32x4 mu4 = *(const f32x4*)(mu_l + (co)); \
            const float cu[4] = {bflo(cw.x), bfhi(cw.x), bflo(cw.y), bfhi(cw.y)}; const float pv[4] = {bflo(pw.x), bfhi(pw.x), bflo(pw.y), bfhi(pw.y)}; \
            _Pragma("unroll") for (int e = 0; e < 4; ++e) dst[e] = cu[e] + mu4[e] * (pv[e] - cu[e]); } while (0)
        float n2 = 0.f;
#pragma unroll
        for (int ct = 0; ct < 2; ++ct)
#pragma unroll
            for (int grp = 0; grp < 4; ++grp) { const int co = 32 * ct + 8 * grp; float zk[4]; ZMIX4(zk, 512 + co); const f32x4 kk4 = *(const f32x4*)(k_k + pofs + co);
#pragma unroll
                for (int e = 0; e < 4; ++e) { const float kr = zk[e] * kk4[e]; n2 += kr * kr; } }
        n2 += __shfl_xor(n2, 32);
        const float invn = 1.0f / fmaxf(sqrtf(n2), 1e-12f);
        float bon = 0.f;
        asm volatile("" ::: "memory");
#pragma unroll
        for (int ct = 0; ct < 2; ++ct) {
            const f32x16 z16 = {0.f, 0.f, 0.f, 0.f, 0.f, 0.f, 0.f, 0.f, 0.f, 0.f, 0.f, 0.f, 0.f, 0.f, 0.f, 0.f}; f32x16 Dw = z16, Da = z16, Dg = z16;
            const int n = 64 * h + 32 * ct + rho;
            const bf16* xrow = xs + rho * XS_PITCH + 8 * hi;
#pragma unroll
            for (int ks = 0; ks < 2; ++ks) {
                Dw = MFMA32(*(const bf16x8*)(w2t + n * 32 + 16 * ks + 8 * hi), *(const bf16x8*)(xrow + 16 * ks), Dw);
                Da = MFMA32(*(const bf16x8*)(a2t + n * 32 + 16 * ks + 8 * hi), *(const bf16x8*)(xrow + 32 + 16 * ks), Da); }
#pragma unroll
            for (int ks = 0; ks < 6; ++ks) Dg = MFMA32(*(const bf16x8*)(g2t + n * 96 + 16 * ks + 8 * hi), *(const bf16x8*)(xrow + 64 + 16 * ks), Dg);
#pragma unroll
            for (int grp = 0; grp < 4; ++grp) {
                const int co = 32 * ct + 8 * grp;
                float zr[4], zk[4], zv[4]; ZMIX4(zr, co); ZMIX4(zk, 512 + co); ZMIX4(zv, 1024 + co);
                const f32x4 w04 = *(const f32x4*)(w0 + pofs + co), a04 = *(const f32x4*)(a0 + pofs + co), kk4 = *(const f32x4*)(k_k + pofs + co), ka4 = *(const f32x4*)(k_a + pofs + co), rk4 = *(const f32x4*)(r_k + pofs + co);
                float dec[4], km[4], gg[4], kk[4], bb[4];
#pragma unroll
                for (int e = 0; e < 4; ++e) { const int r = 4 * grp + e;
                    const float sg = __frcp_rn(1.0f + __expf(-(w04[e] + Dw[r])));
                    dec[e] = __expf(-0.6065306597126334f * sg);
                    const float aa = __frcp_rn(1.0f + __expf(-(a04[e] + Da[r])));
                    gg[e] = Dg[r];
                    kk[e] = zk[e] * kk4[e] * invn; bb[e] = kk[e] * aa;
                    km[e] = zk[e] * (1.0f + (aa - 1.0f) * ka4[e]);
                    bon += zr[e] * km[e] * rk4[e]; }
                const size_t o = (size_t)m * 512 + pofs + co;
                *(f32x4*)(OW + o) = (f32x4){dec[0], dec[1], dec[2], dec[3]};
                *(u32x2*)(OKK + o) = (u32x2){pk2(kk[0], kk[1]), pk2(kk[2], kk[3])};
                *(u32x2*)(OB + o) = (u32x2){pk2(bb[0], bb[1]), pk2(bb[2], bb[3])};
                *(u32x2*)(OKM + o) = (u32x2){pk2(km[0], km[1]), pk2(km[2], km[3])};
                *(u32x2*)(OR_ + o) = (u32x2){pk2(zr[0], zr[1]), pk2(zr[2], zr[3])};
                *(u32x2*)(OV + o) = (u32x2){pk2(zv[0], zv[1]), pk2(zv[2], zv[3])};
                *(u32x2*)(G + o) = (u32x2){pk2(gg[0], gg[1]), pk2(gg[2], gg[3])};
                asm volatile("" ::: "memory");
            }
        }
#undef ZMIX4
        bon += __shfl_xor(bon, 32);
        if (hi == 0) BON[(size_t)m * 8 + h] = bon;
        __syncthreads();
    }
}

constexpr int WP = 144;
constexpr int WSLOT = 64 * WP;
constexpr int W_NCH = T_P / 64;
constexpr int W_UNITS = NB_P * 8 * W_NCH + NB_S * 8;
constexpr size_t WS_PM = WS_R, WS_QM = WS_R + 18 * MiB, WS_UM = WS_R + 36 * MiB, WS_Y0 = WS_R + 72 * MiB;
static_assert((size_t)W_UNITS * 8192 <= 18 * MiB && (size_t)W_UNITS * 16384 <= 36 * MiB && WS_Y0 + 36 * MiB <= WS_END, "rwkv chunk summaries fit the reusable region");
constexpr size_t SC_G2 = 0, SC_VV = (size_t)MT * 256;
constexpr int ZTP = 720;
constexpr int LWP = 68;

__device__ __forceinline__ f32x16 wy_mm(const unsigned char* A, const unsigned char* B, int mi, int ni, int rho, int hi, f32x16 acc) {
    const unsigned char* ap = A + (32 * mi + rho) * WP + 16 * hi; const unsigned char* bp = B + (32 * ni + rho) * WP + 16 * hi;
#pragma unroll
    for (int ks = 0; ks < 4; ++ks) acc = MFMA32(*(const bf16x8*)(ap + 32 * ks), *(const bf16x8*)(bp + 32 * ks), acc);
    return acc;
}
typedef float wy_f32x2 __attribute__((ext_vector_type(2))); typedef __bf16 wy_bf16x2 __attribute__((ext_vector_type(2)));
__device__ __forceinline__ unsigned wy_cvt2(float lo, float hi) { const wy_f32x2 v = {lo, hi}; const wy_bf16x2 b = __builtin_convertvector(v, wy_bf16x2); return __builtin_bit_cast(unsigned, b); }
__device__ __forceinline__ void wy_st_t(unsigned char* dst, const f32x16& a, int mi, int ni, int rho, int hi) {
#pragma unroll
    for (int q = 0; q < 4; ++q) *(u32x2*)(dst + (32 * ni + rho) * WP + 2 * (32 * mi + 8 * q + 4 * hi)) = (u32x2){wy_cvt2(a[4 * q], a[4 * q + 1]), wy_cvt2(a[4 * q + 2], a[4 * q + 3])};
}
__device__ __forceinline__ void wy_st_n(unsigned char* dst, const f32x16& a, int mi, int ni, int rho, int hi) {
#pragma unroll
    for (int r = 0; r < 16; ++r) *(bf16*)(dst + (32 * mi + crow(r, hi)) * WP + 2 * (32 * ni + rho)) = (bf16)f2bf(a[r]);
}
__device__ __forceinline__ f32x16 wy_ld_t(const unsigned char* src, int mi, int ni, int rho, int hi) {
    f32x16 a;
#pragma unroll
    for (int q = 0; q < 4; ++q) { const u32x2 w = *(const u32x2*)(src + (32 * ni + rho) * WP + 2 * (32 * mi + 8 * q + 4 * hi)); a[4 * q] = bflo(w.x); a[4 * q + 1] = bfhi(w.x); a[4 * q + 2] = bflo(w.y); a[4 * q + 3] = bfhi(w.y); }
    return a;
}
#define F16Z ((f32x16){0.f, 0.f, 0.f, 0.f, 0.f, 0.f, 0.f, 0.f, 0.f, 0.f, 0.f, 0.f, 0.f, 0.f, 0.f, 0.f})

__device__ __forceinline__ void p4w_chunks(const Args& a, unsigned char* lds, int tid) {
    unsigned char* ws = a.ws; float* out = a.out;
    const bf16* ZS = (const bf16*)(ws + WS_ZS);
    const bf16* w2t = (const bf16*)(ws + WS_W2T); const bf16* a2t = (const bf16*)(ws + WS_A2T); const bf16* g2t = (const bf16*)(ws + WS_G2T);
    bf16* G = (bf16*)(out + SC_G2); bf16* VV = (bf16*)(out + SC_VV); float* BON = (float*)(ws + WS_BONUS);
    const float* mu = a.in[13]; const float* w0 = a.in[14]; const float* a0 = a.in[16]; const float* k_k = a.in[19]; const float* k_a = a.in[20]; const float* r_k = a.in[21]; const float* sh0 = a.in[6];
    const int l = tid & 63, w = __builtin_amdgcn_readfirstlane(tid >> 6), rho = l & 31, hi = l >> 5;
#define SL(i) (lds + (i) * WSLOT)
    unsigned char* zt = SL(0);
    bf16* xs = (bf16*)SL(6);
    float* LW = (float*)SL(9);
    float* LG = (float*)SL(11);
    float* NRM = (float*)(lds + 17 * WSLOT);
    for (int unit = blockIdx.x; unit < W_UNITS; unit += gridDim.x) {
        int m0, nvalid, h; bool first; const float* shp = nullptr;
        if (unit < NB_P * 8 * W_NCH) { const int j = unit & (W_NCH - 1), sh = unit >> 5; h = sh & 7; m0 = (sh >> 3) * T_P + 64 * j; nvalid = 64; first = j == 0; }
        else { const int sh = unit - NB_P * 8 * W_NCH; h = sh & 7; m0 = MP + 32 * (sh >> 3); nvalid = 32; first = true; shp = sh0 + (size_t)(sh >> 3) * SHIFTW; }
        for (int idx = tid; idx < 65 * 44; idx += 512) { const int r = idx / 44, p = idx - r * 44;
            const int col = p < 24 ? (p >> 3) * 512 + 64 * h + 8 * (p & 7) : 1536 + 8 * (p - 24);
            u32x4 v = {0u, 0u, 0u, 0u};
            if (r == 0) { if (!first) v = *(const u32x4*)(ZS + (size_t)(m0 - 1) * SHIFTW + col);
                          else if (shp) { const f32x4 a4 = *(const f32x4*)(shp + col), b4 = *(const f32x4*)(shp + col + 4); v = (u32x4){pk2(a4.x, a4.y), pk2(a4.z, a4.w), pk2(b4.x, b4.y), pk2(b4.z, b4.w)}; } }
            else if (r <= nvalid) v = *(const u32x4*)(ZS + (size_t)(m0 + r - 1) * SHIFTW + col);
            *(u32x4*)(zt + r * ZTP + 16 * p) = v; }
        __syncthreads();
        { const int tk = tid >> 3, c0 = (tid & 7) * 20; const bf16* zc = (const bf16*)(zt + (tk + 1) * ZTP + 384) + c0; const bf16* zp = (const bf16*)(zt + tk * ZTP + 384) + c0;
#pragma unroll
          for (int e = 0; e < 20; ++e) { const int c = c0 + e; const float cur = bf1(zc[e]), prev = bf1(zp[e]); const float zm = cur + mu[1536 + c] * (prev - cur);
              const float f = __frcp_rn(1.0f + __expf(c < 32 ? -2.0f * zm : -zm)); xs[tk * XS_PITCH + c] = (bf16)f2bf(c < 32 ? 2.0f * f - 1.0f : (c < 64 ? zm : f)); } }
        __syncthreads();
        const int ct = w & 1, tt = (w >> 1) & 1, tok = 32 * tt + rho; const bool valid = tok < nvalid; const size_t m = (size_t)m0 + tok;
        const int n = 64 * h + 32 * ct + rho; const bf16* xrow = xs + tok * XS_PITCH + 8 * hi;
        const int pofs = 64 * h + 32 * ct + 4 * hi;
        const unsigned char* zcur = zt + (tok + 1) * ZTP + 2 * (32 * ct + 4 * hi); const unsigned char* zprv = zt + tok * ZTP + 2 * (32 * ct + 4 * hi);
#define WMIX4(dst, seg, q) do { const u32x2 cw = *(const u32x2*)(zcur + 128 * (seg) + 16 * (q)), pw = *(const u32x2*)(zprv + 128 * (seg) + 16 * (q)); const f32x4 mu4 = *(const f32x4*)(mu + 512 * (seg) + pofs + 8 * (q)); \
            dst[0] = bflo(cw.x) + mu4.x * (bflo(pw.x) - bflo(cw.x)); dst[1] = bfhi(cw.x) + mu4.y * (bfhi(pw.x) - bfhi(cw.x)); dst[2] = bflo(cw.y) + mu4.z * (bflo(pw.y) - bflo(cw.y)); dst[3] = bfhi(cw.y) + mu4.w * (bfhi(pw.y) - bfhi(cw.y)); } while (0)
        float ra[16], rb[16], rc[16], rd[16];
        if (w < 4) {
            f32x16 Dw = F16Z, Da = F16Z;
#pragma unroll
            for (int ks = 0; ks < 2; ++ks) { Dw = MFMA32(*(const bf16x8*)(w2t + n * 32 + 16 * ks + 8 * hi), *(const bf16x8*)(xrow + 16 * ks), Dw);
                                             Da = MFMA32(*(const bf16x8*)(a2t + n * 32 + 16 * ks + 8 * hi), *(const bf16x8*)(xrow + 32 + 16 * ks), Da); }
            float n2 = 0.f, bon = 0.f;
#pragma unroll
            for (int q = 0; q < 4; ++q) { float zr[4], zk[4]; WMIX4(zr, 0, q); WMIX4(zk, 1, q);
                const f32x4 w04 = *(const f32x4*)(w0 + pofs + 8 * q), a04 = *(const f32x4*)(a0 + pofs + 8 * q), kk4 = *(const f32x4*)(k_k + pofs + 8 * q), ka4 = *(const f32x4*)(k_a + pofs + 8 * q), rk4 = *(const f32x4*)(r_k + pofs + 8 * q);
#pragma unroll
                for (int e = 0; e < 4; ++e) { const int r = 4 * q + e;
                    const float sg = __frcp_rn(1.0f + __expf(-(w04[e] + Dw[r]))); rd[r] = valid ? -0.6065306597126334f * sg : 0.f;
                    const float aa = __frcp_rn(1.0f + __expf(-(a04[e] + Da[r]))); rb[r] = aa;
                    const float kr = valid ? zk[e] * kk4[e] : 0.f; ra[r] = kr; n2 += kr * kr;
                    const float km = valid ? zk[e] * (1.0f + (aa - 1.0f) * ka4[e]) : 0.f; rc[r] = km; bon += zr[e] * km * rk4[e]; }
                *(f32x4*)(LW + tok * LWP + 32 * ct + 8 * q + 4 * hi) = (f32x4){rd[4 * q], rd[4 * q + 1], rd[4 * q + 2], rd[4 * q + 3]}; }
            n2 += __shfl_xor(n2, 32); bon += __shfl_xor(bon, 32);
            if (hi == 0) { NRM[ct * 64 + tok] = n2; NRM[128 + ct * 64 + tok] = bon; }
        } else {
            f32x16 Dg = F16Z;
#pragma unroll
            for (int ks = 0; ks < 6; ++ks) Dg = MFMA32(*(const bf16x8*)(g2t + n * 96 + 16 * ks + 8 * hi), *(const bf16x8*)(xrow + 64 + 16 * ks), Dg);
#pragma unroll
            for (int q = 0; q < 4; ++q) { float zr[4], zv[4]; WMIX4(zr, 0, q); WMIX4(zv, 2, q);
#pragma unroll
                for (int e = 0; e < 4; ++e) { ra[4 * q + e] = valid ? zr[e] : 0.f; rb[4 * q + e] = valid ? zv[e] : 0.f; }
                if (valid) { const size_t o = m * 512 + pofs + 8 * q;
                    *(u32x2*)(G + o) = (u32x2){pk2(Dg[4 * q], Dg[4 * q + 1]), pk2(Dg[4 * q + 2], Dg[4 * q + 3])};
                    *(u32x2*)(VV + o) = (u32x2){pk2(zv[0], zv[1]), pk2(zv[2], zv[3])}; } }
        }
#undef WMIX4
        __syncthreads();
        if (w == 0) { float acc = 0.f; LG[l] = 0.f;
#pragma unroll 8
            for (int t = 0; t < 64; ++t) { acc += LW[t * LWP + l]; LG[(t + 1) * LWP + l] = acc; }
            NRM[256 + l] = __expf(acc); }
        if (w == 1 && l < 64) { const float bn = NRM[128 + l] + NRM[192 + l]; if (l < nvalid) BON[((size_t)m0 + l) * 8 + h] = bn; }
        __syncthreads();
        {
            const float* lgc = LG + (tok + 1) * LWP + 32 * ct + 4 * hi; const float* lgp = LG + tok * LWP + 32 * ct + 4 * hi; const float* lge = LG + 64 * LWP + 32 * ct + 4 * hi;
            if (w < 4) {
                const float invn = 1.0f / fmaxf(sqrtf(NRM[tok] + NRM[64 + tok]), 1e-12f);
#pragma unroll
                for (int q = 0; q < 4; ++q) { const f32x4 gc = *(const f32x4*)(lgc + 8 * q), gp = *(const f32x4*)(lgp + 8 * q), ge = *(const f32x4*)(lge + 8 * q);
                    float kt[4], bt[4], ka[4], ke[4], be[4];
#pragma unroll
                    for (int e = 0; e < 4; ++e) { const int r = 4 * q + e; const float en = __expf(-gc[e]), ep = __expf(gp[e]), ee = __expf(ge[e] - gc[e]); const float kkn = ra[r] * invn, bb = kkn * rb[r];
                        kt[e] = rc[r] * en; bt[e] = bb * en; ka[e] = kkn * ep; ke[e] = rc[r] * ee; be[e] = bb * ee; }
                    const int co = 2 * (32 * ct + 8 * q + 4 * hi);
                    *(u32x2*)(SL(0) + tok * WP + co) = (u32x2){pk2(kt[0], kt[1]), pk2(kt[2], kt[3])};
                    *(u32x2*)(SL(1) + tok * WP + co) = (u32x2){pk2(bt[0], bt[1]), pk2(bt[2], bt[3])};
                    *(u32x2*)(SL(2) + tok * WP + co) = (u32x2){pk2(ka[0], ka[1]), pk2(ka[2], ka[3])};
#pragma unroll
                    for (int e = 0; e < 4; ++e) { const int kr = 32 * ct + 8 * q + 4 * hi + e;
                        *(bf16*)(SL(4) + kr * WP + 2 * tok) = (bf16)f2bf(ka[e]); *(bf16*)(SL(5) + kr * WP + 2 * tok) = (bf16)f2bf(be[e]); *(bf16*)(SL(6) + kr * WP + 2 * tok) = (bf16)f2bf(ke[e]); } }
            } else {
#pragma unroll
                for (int q = 0; q < 4; ++q) { const f32x4 gc = *(const f32x4*)(lgc + 8 * q); float rh[4];
#pragma unroll
                    for (int e = 0; e < 4; ++e) rh[e] = ra[4 * q + e] * __expf(gc[e]);
                    *(u32x2*)(SL(3) + tok * WP + 2 * (32 * ct + 8 * q + 4 * hi)) = (u32x2){pk2(rh[0], rh[1]), pk2(rh[2], rh[3])};
#pragma unroll
                    for (int e = 0; e < 4; ++e) *(bf16*)(SL(7) + (32 * ct + 8 * q + 4 * hi + e) * WP + 2 * tok) = (bf16)f2bf(rb[4 * q + e]); }
            }
        }
        __syncthreads();
        for (int task = w; task < 16; task += 8) { const int pr = task >> 2, mi = (task >> 1) & 1, ni = task & 1;
            if (pr == 0) { f32x16 d = wy_mm(SL(1), SL(2), mi, ni, rho, hi, F16Z);
#pragma unroll
                for (int r = 0; r < 16; ++r) if (!(32 * mi + crow(r, hi) < 32 * ni + rho)) d[r] = 0.f;
                wy_st_t(SL(8), d, mi, ni, rho, hi); wy_st_n(SL(9), d, mi, ni, rho, hi); }
            else if (pr == 1) { f32x16 d = wy_mm(SL(2), SL(0), mi, ni, rho, hi, F16Z);
#pragma unroll
                for (int r = 0; r < 16; ++r) if (!(32 * ni + rho < 32 * mi + crow(r, hi))) d[r] = 0.f;
                wy_st_t(SL(10), d, mi, ni, rho, hi); }
            else if (pr == 2) { f32x16 d = wy_mm(SL(1), SL(3), mi, ni, rho, hi, F16Z);
#pragma unroll
                for (int r = 0; r < 16; ++r) if (!(32 * mi + crow(r, hi) <= 32 * ni + rho)) d[r] = 0.f;
                wy_st_t(SL(11), d, mi, ni, rho, hi); }
            else { f32x16 d = wy_mm(SL(0), SL(3), mi, ni, rho, hi, F16Z);
#pragma unroll
                for (int r = 0; r < 16; ++r) if (!(32 * mi + crow(r, hi) <= 32 * ni + rho)) d[r] = 0.f;
                wy_st_t(SL(12), d, mi, ni, rho, hi); } }
        __syncthreads();
        for (int task = w; task < 12; task += 8) { const int pr = task >> 2, mi = (task >> 1) & 1, ni = task & 1;
            if (pr == 0) { const f32x16 d = wy_mm(SL(9), SL(8), mi, ni, rho, hi, F16Z); wy_st_t(SL(13), d, mi, ni, rho, hi); }
            else if (pr == 1) { const f32x16 d = wy_mm(SL(8), SL(9), mi, ni, rho, hi, F16Z); wy_st_t(SL(14), d, mi, ni, rho, hi); }
            else { f32x16 d = wy_ld_t(SL(8), mi, ni, rho, hi);
#pragma unroll
                for (int r = 0; r < 16; ++r) d[r] = ((32 * mi + crow(r, hi)) == (32 * ni + rho) ? 1.0f : 0.f) - d[r];
                wy_st_t(SL(15), d, mi, ni, rho, hi); } }
        __syncthreads();
#pragma unroll 1
        for (int lev = 1; lev <= 5; ++lev) {
            unsigned char* Pc = SL((lev & 1) ? 15 : 16); unsigned char* Pn = SL((lev & 1) ? 16 : 15);
            unsigned char* Qr = SL((lev & 1) ? 13 : 0); unsigned char* Qx = SL((lev & 1) ? 14 : 1); unsigned char* Qr2 = SL((lev & 1) ? 0 : 13); unsigned char* Qx2 = SL((lev & 1) ? 1 : 14);
            const int ntask = lev < 5 ? 12 : 4;
            for (int task = w; task < ntask; task += 8) { const int pr = task >> 2, mi = (task >> 1) & 1, ni = task & 1;
                if (pr == 0) { f32x16 d = wy_ld_t(Pc, mi, ni, rho, hi);
                    d = wy_mm(Qx, Pc, mi, ni, rho, hi, d); wy_st_t(Pn, d, mi, ni, rho, hi); }
                else if (pr == 1) { const f32x16 d = wy_mm(Qx, Qr, mi, ni, rho, hi, F16Z); wy_st_t(Qr2, d, mi, ni, rho, hi); }
                else { const f32x16 d = wy_mm(Qr, Qx, mi, ni, rho, hi, F16Z); wy_st_t(Qx2, d, mi, ni, rho, hi); } }
            __syncthreads();
        }
        { const int pr = w >> 2, mi = (w >> 1) & 1, ni = w & 1;
          if (pr == 0) { const f32x16 d = wy_mm(SL(16), SL(10), mi, ni, rho, hi, F16Z); wy_st_t(SL(0), d, mi, ni, rho, hi); }
          else { const f32x16 d = wy_mm(SL(16), SL(4), mi, ni, rho, hi, F16Z); wy_st_t(SL(1), d, mi, ni, rho, hi); } }
        __syncthreads();
        { bf16* PMg = (bf16*)(ws + WS_PM) + (size_t)unit * 4096; bf16* QMg = (bf16*)(ws + WS_QM) + (size_t)unit * 4096;
          for (int task = w; task < 16; task += 8) { const int pr = task >> 2, mi = (task >> 1) & 1, ni = task & 1;
            if (pr == 0) { f32x16 d = wy_mm(SL(1), SL(5), mi, ni, rho, hi, F16Z);
                const float gc = NRM[256 + 32 * ni + rho];
#pragma unroll
                for (int q = 0; q < 4; ++q) { float o[4];
#pragma unroll
                    for (int e = 0; e < 4; ++e) { const int kr = 32 * mi + 8 * q + 4 * hi + e; o[e] = (kr == 32 * ni + rho ? gc : 0.f) - d[4 * q + e]; }
                    *(u32x2*)(PMg + (32 * ni + rho) * 64 + 32 * mi + 8 * q + 4 * hi) = (u32x2){pk2(o[0], o[1]), pk2(o[2], o[3])}; } }
            else if (pr == 1) { f32x16 d = wy_mm(SL(0), SL(5), mi, ni, rho, hi, F16Z);
                const f32x16 ke = wy_ld_t(SL(6), mi, ni, rho, hi);
#pragma unroll
                for (int r = 0; r < 16; ++r) d[r] = ke[r] - d[r];
                wy_st_t(SL(13), d, mi, ni, rho, hi); }
            else if (pr == 2) { f32x16 d = wy_mm(SL(1), SL(11), mi, ni, rho, hi, F16Z);
                const f32x16 rh = wy_ld_t(SL(3), mi, ni, rho, hi);
#pragma unroll
                for (int q = 0; q < 4; ++q) *(u32x2*)(QMg + (32 * ni + rho) * 64 + 32 * mi + 8 * q + 4 * hi) =
                    (u32x2){pk2(rh[4 * q] - d[4 * q], rh[4 * q + 1] - d[4 * q + 1]), pk2(rh[4 * q + 2] - d[4 * q + 2], rh[4 * q + 3] - d[4 * q + 3])}; }
            else { f32x16 d = wy_mm(SL(0), SL(11), mi, ni, rho, hi, F16Z);
                const f32x16 bk = wy_ld_t(SL(12), mi, ni, rho, hi);
#pragma unroll
                for (int r = 0; r < 16; ++r) d[r] = bk[r] - d[r];
                wy_st_t(SL(14), d, mi, ni, rho, hi); } } }
        __syncthreads();
        { float* UMg = (float*)(ws + WS_UM) + (size_t)unit * 4096; float* Y0g = (float*)(ws + WS_Y0) + (size_t)unit * 4096; const int pr = w >> 2, mi = (w >> 1) & 1, ni = w & 1;
          if (pr == 0) { const f32x16 d = wy_mm(SL(13), SL(7), mi, ni, rho, hi, F16Z);
#pragma unroll
              for (int q = 0; q < 4; ++q) *(f32x4*)(UMg + (32 * ni + rho) * 64 + 32 * mi + 8 * q + 4 * hi) = (f32x4){d[4 * q], d[4 * q + 1], d[4 * q + 2], d[4 * q + 3]}; }
          else { const f32x16 d = wy_mm(SL(7), SL(14), mi, ni, rho, hi, F16Z);
#pragma unroll
              for (int q = 0; q < 4; ++q) *(f32x4*)(Y0g + (32 * ni + rho) * 64 + 32 * mi + 8 * q + 4 * hi) = (f32x4){d[4 * q], d[4 * q + 1], d[4 * q + 2], d[4 * q + 3]}; } }
        __syncthreads();
    }
#undef SL
}

__device__ __forceinline__ void p5w_chain(const Args& a, unsigned char* lds, int tid) {
    unsigned char* ws = a.ws; float* out = a.out;
    const bf16* G = (const bf16*)(out + SC_G2); const bf16* VV = (const bf16*)(out + SC_VV); const float* BON = (const float*)(ws + WS_BONUS); bf16* O = (bf16*)(ws + WS_XB);
    const float* lgn = a.in[22]; const float* lbn = a.in[23];
    const int l = tid & 63, w = __builtin_amdgcn_readfirstlane(tid >> 6), rho = l & 31, hi = l >> 5;
    unsigned char* Sb0 = lds; unsigned char* Sb1 = lds + WSLOT; unsigned char* PMl = lds + 2 * WSLOT; unsigned char* QMl = lds + 3 * WSLOT;
    for (int u2 = blockIdx.x; u2 < NB_P * 8 + NB_S * 8; u2 += gridDim.x) {
        const bool smp = u2 >= NB_P * 8; const int sh = smp ? u2 - NB_P * 8 : u2, h = sh & 7, s = sh >> 3;
        const int nch = smp ? 1 : W_NCH, unit0 = smp ? NB_P * 8 * W_NCH + sh : sh * W_NCH, nvalid = smp ? 32 : 64;
        const size_t mrow0 = smp ? (size_t)MP + 32 * s : (size_t)s * T_P;
        float* wkv = out + (smp ? OFF_WKVS : OFF_WKVP) + (size_t)sh * 4096;
        { const int v = tid >> 3, k0 = (tid & 7) * 8; float x[8];
          if (smp) { const f32x4 a4 = *(const f32x4*)(a.in[5] + (size_t)sh * 4096 + v * 64 + k0), b4 = *(const f32x4*)(a.in[5] + (size_t)sh * 4096 + v * 64 + k0 + 4); x[0] = a4.x; x[1] = a4.y; x[2] = a4.z; x[3] = a4.w; x[4] = b4.x; x[5] = b4.y; x[6] = b4.z; x[7] = b4.w; }
          else {
#pragma unroll
              for (int e = 0; e < 8; ++e) x[e] = 0.f; }
          *(u32x4*)(Sb0 + v * WP + 2 * k0) = pack8(x); }
        const int cr = tid >> 3, cc = (tid & 7) * 8;
        u32x4 pmr = *(const u32x4*)((const bf16*)(ws + WS_PM) + (size_t)unit0 * 4096 + cr * 64 + cc), qmr = *(const u32x4*)((const bf16*)(ws + WS_QM) + (size_t)unit0 * 4096 + cr * 64 + cc);
        for (int j = 0; j < nch; ++j) {
            unsigned char* Sc = (j & 1) ? Sb1 : Sb0; unsigned char* Sn = (j & 1) ? Sb0 : Sb1;
            const size_t unit = (size_t)unit0 + j;
            *(u32x4*)(PMl + cr * WP + 2 * cc) = pmr; *(u32x4*)(QMl + cr * WP + 2 * cc) = qmr;
            if (j + 1 < nch) { pmr = *(const u32x4*)((const bf16*)(ws + WS_PM) + (unit + 1) * 4096 + cr * 64 + cc); qmr = *(const u32x4*)((const bf16*)(ws + WS_QM) + (unit + 1) * 4096 + cr * 64 + cc); }
            f32x16 d0, d1;
            if (w < 4) { const int mi = (w >> 1) & 1, ni = w & 1; const float* um = (const float*)(ws + WS_UM) + unit * 4096 + (32 * ni + rho) * 64 + 32 * mi + 4 * hi;
#pragma unroll
                for (int q = 0; q < 4; ++q) { const f32x4 x = *(const f32x4*)(um + 8 * q); d0[4 * q] = x.x; d0[4 * q + 1] = x.y; d0[4 * q + 2] = x.z; d0[4 * q + 3] = x.w; } }
            else if (w < 6) { const int ni = w - 4; const float* y0 = (const float*)(ws + WS_Y0) + unit * 4096 + (32 * ni + rho) * 64 + 4 * hi;
#pragma unroll
                for (int q = 0; q < 4; ++q) { const f32x4 x = *(const f32x4*)(y0 + 8 * q), y = *(const f32x4*)(y0 + 32 + 8 * q);
                    d0[4 * q] = x.x; d0[4 * q + 1] = x.y; d0[4 * q + 2] = x.z; d0[4 * q + 3] = x.w; d1[4 * q] = y.x; d1[4 * q + 1] = y.y; d1[4 * q + 2] = y.z; d1[4 * q + 3] = y.w; } }
            __syncthreads();
            if (w < 4) {
                const int mi = (w >> 1) & 1, ni = w & 1;
                d0 = wy_mm(PMl, Sc, mi, ni, rho, hi, d0);
                if (j + 1 < nch) wy_st_t(Sn, d0, mi, ni, rho, hi);
                else {
#pragma unroll
                    for (int q = 0; q < 4; ++q) *(f32x4*)(wkv + (32 * ni + rho) * 64 + 32 * mi + 8 * q + 4 * hi) = (f32x4){d0[4 * q], d0[4 * q + 1], d0[4 * q + 2], d0[4 * q + 3]}; }
            } else if (w < 6) {
                const int ni = w - 4; const int tok = 32 * ni + rho;
                d0 = wy_mm(Sc, QMl, 0, ni, rho, hi, d0); d1 = wy_mm(Sc, QMl, 1, ni, rho, hi, d1);
                float s1 = 0.f;
#pragma unroll
                for (int r = 0; r < 16; ++r) s1 += d0[r] + d1[r];
                s1 += __shfl_xor(s1, 32);
                const float mean = s1 * (1.f / 64.f); float s2 = 0.f;
#pragma unroll
                for (int r = 0; r < 16; ++r) { const float e0 = d0[r] - mean, e1 = d1[r] - mean; s2 += e0 * e0 + e1 * e1; }
                s2 += __shfl_xor(s2, 32);
                const float rinv = rsqrtf(s2 * (1.f / 64.f) + 64e-5f);
                if (tok < nvalid) { const size_t m = mrow0 + (size_t)j * 64 + tok; const float bon = BON[m * 8 + h];
#pragma unroll
                    for (int vt = 0; vt < 2; ++vt)
#pragma unroll
                        for (int q = 0; q < 4; ++q) { const int c = 64 * h + 32 * vt + 8 * q + 4 * hi; const size_t o = m * 512 + c;
                            const u32x2 vw = *(const u32x2*)(VV + o), gw = *(const u32x2*)(G + o); const f32x4 l4 = *(const f32x4*)(lgn + c), b4 = *(const f32x4*)(lbn + c);
                            const float vv[4] = {bflo(vw.x), bfhi(vw.x), bflo(vw.y), bfhi(vw.y)}, gg[4] = {bflo(gw.x), bfhi(gw.x), bflo(gw.y), bfhi(gw.y)}; float r4[4];
#pragma unroll
                            for (int e = 0; e < 4; ++e) { const float y = vt ? d1[4 * q + e] : d0[4 * q + e]; r4[e] = ((y - mean) * rinv * l4[e] + b4[e] + bon * vv[e]) * gg[e]; }
                            *(u32x2*)(O + m * DM + 512 + c) = (u32x2){pk2(r4[0], r4[1]), pk2(r4[2], r4[3])}; } }
            }
            __syncthreads();
        }
    }
}

constexpr int SC_CH = 32;
static_assert(WS_OB - WS_OKK == 17 * MiB && WS_OKM - WS_OB == 17 * MiB && WS_OR - WS_OKM == 17 * MiB && WS_OV - WS_OR == 17 * MiB, "operand arrays are equally spaced");
__device__ __forceinline__ void cvt_store8(unsigned char* d, const u32x4 x) {
    *(u32x4*)d = (u32x4){x.x << 16, x.x & 0xffff0000u, x.y << 16, x.y & 0xffff0000u}; *(u32x4*)(d + 16) = (u32x4){x.z << 16, x.z & 0xffff0000u, x.w << 16, x.w & 0xffff0000u};
}
struct StageP {
    static constexpr int STRIDE = 1280 + 64;
    const unsigned char* pw; const unsigned char* pb; int vrow0;
    u32x4 v[25];
    __device__ __forceinline__ void issue(int t0, int lane) {
        const unsigned char* gw = pw + ((size_t)(t0 + (lane >> 4)) * 512) * 4 + 16 * (lane & 15);
#pragma unroll
        for (int j = 0; j < 8; ++j) v[j] = *(const u32x4*)(gw + (size_t)j * 4 * 512 * 4);
        const unsigned char* gb = pb + ((size_t)(t0 + (lane >> 3)) * 512) * 2 + 16 * (lane & 7);
#pragma unroll
        for (int a = 0; a < 4; ++a)
#pragma unroll
            for (int jj = 0; jj < 4; ++jj) v[8 + 4 * a + jj] = *(const u32x4*)(gb + (size_t)a * (17 * MiB) + (size_t)jj * 8 * 512 * 2);
        v[24] = *(const u32x4*)(pb + (size_t)4 * (17 * MiB) + ((size_t)(t0 + (lane >> 1)) * 512) * 2 + 2 * vrow0 + 16 * (lane & 1));
    }
    __device__ __forceinline__ void commit(unsigned char* buf, int lane) const {
        unsigned char* dw = buf + (lane >> 4) * STRIDE + 16 * (lane & 15);
#pragma unroll
        for (int j = 0; j < 8; ++j) *(u32x4*)(dw + j * 4 * STRIDE) = v[j];
        unsigned char* db = buf + (lane >> 3) * STRIDE + 256 + 32 * (lane & 7);
#pragma unroll
        for (int a = 0; a < 4; ++a)
#pragma unroll
            for (int jj = 0; jj < 4; ++jj) cvt_store8(db + a * 256 + jj * 8 * STRIDE, v[8 + 4 * a + jj]);
        cvt_store8(buf + (lane >> 1) * STRIDE + 1280 + 32 * (lane & 1), v[24]);
    }
};
struct StageS {
    static constexpr int STRIDE = 1280 + 256;
    const unsigned char* pw; const unsigned char* pb;
    u32x4 v[7];
    __device__ __forceinline__ void issue(int t0, int lane) {
        const unsigned char* gw = pw + ((size_t)(t0 + (lane >> 4)) * 512) * 4 + 16 * (lane & 15);
        v[0] = *(const u32x4*)gw; v[1] = *(const u32x4*)(gw + (size_t)4 * 512 * 4);
        const unsigned char* gb = pb + ((size_t)(t0 + (lane >> 3)) * 512) * 2 + 16 * (lane & 7);
#pragma unroll
        for (int a = 0; a < 5; ++a) v[2 + a] = *(const u32x4*)(gb + (size_t)a * (17 * MiB));
    }
    __device__ __forceinline__ void commit(unsigned char* buf, int lane) const {
        unsigned char* dw = buf + (lane >> 4) * STRIDE + 16 * (lane & 15);
        *(u32x4*)dw = v[0]; *(u32x4*)(dw + 4 * STRIDE) = v[1];
        unsigned char* db = buf + (lane >> 3) * STRIDE + 256 + 32 * (lane & 7);
#pragma unroll
        for (int a = 0; a < 5; ++a) cvt_store8(db + a * 256, v[2 + a]);
    }
};
typedef float f32x2 __attribute__((ext_vector_type(2)));
template <int STRIDE, bool YLDS> __device__ __forceinline__ void scan_consume(f32x4& S4, const unsigned char* buf, int nst, int ks, int rowl, float* yp, float* ypart) {
    f32x2 Sa = {S4.x, S4.y}, Sb = {S4.z, S4.w};
    for (int s0 = 0; s0 < nst; s0 += 16) {
        float ykeep = 0.f;
#pragma unroll 1
        for (int g = 0; g < 4; ++g) {
            const int kq = ks - 4 * g;
#pragma unroll
            for (int j = 0; j < 4; ++j) {
                const float* p = (const float*)(buf + (s0 + 4 * g + j) * STRIDE) + 4 * ks;
                const f32x2 wa = *(const f32x2*)(p), wb = *(const f32x2*)(p + 2), ka = *(const f32x2*)(p + 64), kb = *(const f32x2*)(p + 66), ba = *(const f32x2*)(p + 128), bb = *(const f32x2*)(p + 130),
                            ma = *(const f32x2*)(p + 192), mb = *(const f32x2*)(p + 194), ra = *(const f32x2*)(p + 256), rb = *(const f32x2*)(p + 258);
                const float v = ((const float*)(buf + (s0 + 4 * g + j) * STRIDE))[320 + rowl];
                f32x2 t = Sa * ka + Sb * kb; float d = t.x + t.y; d = sum16(d);
                const f32x2 vv = {v, v}, dd = {d, d};
                Sa = Sa * wa + (vv * ma - dd * ba); Sb = Sb * wb + (vv * mb - dd * bb);
                f32x2 u = Sa * ra + Sb * rb; float y = u.x + u.y;
                if constexpr (YLDS) ypart[(s0 + 4 * g + j) * 256] = y;
                else { y = sum16(y); ykeep = kq == j ? y : ykeep; }
            }
        }
        if constexpr (!YLDS) yp[(size_t)(s0 + ks) * 512] = ykeep;
    }
    S4 = (f32x4){Sa.x, Sa.y, Sb.x, Sb.y};
}
__device__ __forceinline__ void scan_yreduce(const float* ypart, float* yg, int pt) {
#pragma unroll
    for (int k = 0; k < 2; ++k) { const int o = pt + 256 * k; const f32x4* q = (const f32x4*)(ypart + o * 16);
        const f32x4 a = q[0], b = q[1], c = q[2], d = q[3]; const f32x4 e = (a + b) + (c + d);
        yg[(size_t)(o >> 4) * 512 + (o & 15)] = (e.x + e.y) + (e.z + e.w); }
}
__device__ __forceinline__ void p5_rwkv_scan(const Args& a, unsigned char* lds, int tid) {
    const unsigned char* ws = a.ws; float* out = a.out; float* Y = out + SC_Y;
    const int l = tid & 63, w = __builtin_amdgcn_readfirstlane(tid >> 6), ks = l & 15, rl = l >> 4;
    const int G = gridDim.x, vcu = (G % 8 == 0) ? (blockIdx.x % 8) * (G / 8) + blockIdx.x / 8 : blockIdx.x;
    typedef StageP StP; typedef StageS StS;
    unsigned char* buf0 = lds; unsigned char* buf1 = lds + SC_CH * StP::STRIDE;
    for (int it = vcu; it < 256; it += G) {
        {
            const int bh = it >> 2, b = bh >> 3, h = bh & 7, rb = it & 3, row = 16 * rb + 4 * w + rl;
            const size_t base0 = ((size_t)b * T_P) * 512 + (size_t)h * 64;
            constexpr int NC = T_P / SC_CH;
            StP st; st.pw = ws + WS_OW + base0 * 4; st.pb = ws + WS_OKK + base0 * 2; st.vrow0 = 16 * rb;
            f32x4 S = {0.f, 0.f, 0.f, 0.f};
            if (w >= 4) { if (w == 4) { st.issue(0, l); st.commit(buf0, l); st.issue(4 * SC_CH, l); } else st.issue((w - 4) * SC_CH, l); }
            else __builtin_amdgcn_s_setprio(3);
            __syncthreads();
            Y += base0 + row;
            float* yp0 = (float*)(lds + 2 * SC_CH * StP::STRIDE); float* yp1 = yp0 + SC_CH * 256;
#define SCAN_ITER(c, P, cur, nxt, ypc, ypp) do { if (w >= 4) { if ((c) > 0) scan_yreduce(ypp, Y - row + 16 * rb + (size_t)(((c) - 1) * SC_CH) * 512, tid - 256); \
                    if (w == 4 + (P)) { if ((c) + 1 < NC) { st.commit(nxt, l); if ((c) + 5 < NC) st.issue(((c) + 5) * SC_CH, l); } } } \
                else scan_consume<StP::STRIDE, true>(S, cur, SC_CH, ks, 4 * w + rl, nullptr, ypc + tid); __syncthreads(); } while (0)
            for (int c = 0; c < NC; c += 4) { SCAN_ITER(c, 1, buf0, buf1, yp0, yp1); SCAN_ITER(c + 1, 2, buf1, buf0, yp1, yp0); SCAN_ITER(c + 2, 3, buf0, buf1, yp0, yp1); SCAN_ITER(c + 3, 0, buf1, buf0, yp1, yp0); }
            if (w >= 4) scan_yreduce(yp1, Y - row + 16 * rb + (size_t)((NC - 1) * SC_CH) * 512, tid - 256);
#undef SCAN_ITER
            __builtin_amdgcn_s_setprio(0);
            Y -= base0 + row;
            if (w < 4) *(f32x4*)(out + OFF_WKVP + ((size_t)bh * 64 + row) * 64 + 4 * ks) = S;
        }
        {
            const int b = it >> 3, h = it & 7;
            const size_t base0 = ((size_t)MP + (size_t)b * T_S) * 512 + (size_t)h * 64;
            StS st; st.pw = ws + WS_OW + base0 * 4; st.pb = ws + WS_OKK + base0 * 2;
            if (w >= 4) { st.issue(8 * (w - 4), l); st.commit(buf0 + 8 * (w - 4) * StS::STRIDE, l); }
            __syncthreads();
            for (int pass = 0; pass < 2; ++pass) { const int row = 8 * w + 4 * pass + rl;
                f32x4 S = *(const f32x4*)(a.in[5] + ((size_t)it * 64 + row) * 64 + 4 * ks);
                scan_consume<StS::STRIDE, false>(S, buf0, T_S, ks, row, Y + base0 + row, nullptr);
                *(f32x4*)(out + OFF_WKVS + ((size_t)it * 64 + row) * 64 + 4 * ks) = S; }
            __syncthreads();
        }
    }
}

__device__ __forceinline__ void p6_rwkv_out(const Args& a, int tid) {
    const unsigned char* ws = a.ws; const float* out = a.out; const float* Y = out + SC_Y; const bf16* G = (const bf16*)(out + SC_G);
    const bf16* OV = (const bf16*)(ws + WS_OV); const float* BON = (const float*)(ws + WS_BONUS); bf16* O = (bf16*)(a.ws + WS_XB);
    const float* lg = a.in[22]; const float* lb = a.in[23];
    const int sub = tid & 7;
    const size_t NIT = (size_t)MT * 8, STEP = (size_t)gridDim.x * 64;
    size_t it = (size_t)blockIdx.x * 64 + (tid >> 3);
    f32x4 y0, y1; u32x4 vw, gw_; float bon = 0.f;
#define P6_LOAD(it_) do { const size_t o_ = ((it_) >> 3) * 512 + ((it_) & 7) * 64 + 8 * sub; y0 = *(const f32x4*)(Y + o_); y1 = *(const f32x4*)(Y + o_ + 4); vw = *(const u32x4*)(OV + o_); gw_ = *(const u32x4*)(G + o_); bon = BON[it_]; } while (0)
    if (it < NIT) P6_LOAD(it);
    for (; it < NIT; it += STEP) {
        const size_t m = it >> 3; const int h = (int)(it & 7);
        float y[8] = {y0.x, y0.y, y0.z, y0.w, y1.x, y1.y, y1.z, y1.w}; float v[8], g[8]; unpack8(vw, v); unpack8(gw_, g); const float bn = bon;
        if (it + STEP < NIT) P6_LOAD(it + STEP);
        float s1 = 0.f;
#pragma unroll
        for (int j = 0; j < 8; ++j) s1 += y[j];
        s1 += __shfl_xor(s1, 1); s1 += __shfl_xor(s1, 2); s1 += __shfl_xor(s1, 4);
        const float mean = s1 * (1.f / 64.f); float s2 = 0.f;
#pragma unroll
        for (int j = 0; j < 8; ++j) { const float d = y[j] - mean; s2 += d * d; }
        s2 += __shfl_xor(s2, 1); s2 += __shfl_xor(s2, 2); s2 += __shfl_xor(s2, 4);
        const float rinv = rsqrtf(s2 * (1.f / 64.f) + 64e-5f);
        float r[8];
#pragma unroll
        for (int j = 0; j < 8; ++j) { const int c = h * 64 + 8 * sub + j; r[j] = ((y[j] - mean) * rinv * lg[c] + lb[c] + bn * v[j]) * g[j]; }
        *(u32x4*)(O + m * DM + 512 + h * 64 + 8 * sub) = pack8(r);
    }
#undef P6_LOAD
}

__device__ __forceinline__ void p8_hnorm(const Args& a, int tid) {
    const int lane = tid & 63, gw = blockIdx.x * 8 + (tid >> 6), NGW = gridDim.x * 8;
    for (int m = gw; m < MT; m += NGW) {
        const f32x4* xr = (const f32x4*)(a.out + OFF_Y + (size_t)m * DM) + lane; f32x4 v[4]; float s = 0.f;
#pragma unroll
        for (int j = 0; j < 4; ++j) { v[j] = xr[64 * j]; s += (v[j].x * v[j].x + v[j].y * v[j].y) + (v[j].z * v[j].z + v[j].w * v[j].w); }
        const float rs = rsqrtf(wave_sum(s) * (1.f / DM) + 1e-6f);
        u32x2* o8 = (u32x2*)((bf16*)(a.ws + WS_HB) + (size_t)m * DM) + lane;
#pragma unroll
        for (int j = 0; j < 4; ++j) { u32x2 o; o.x = pk2(v[j].x * rs, v[j].y * rs); o.y = pk2(v[j].z * rs, v[j].w * rs); o8[64 * j] = o; }
    }
}

#define XB_TMO      128
#define XB_XCNT(j)  (256  + 64 * (j))
#define XB_XSUB(j)  (1280 + 64 * (j))
#define XB_XGEN(j)  (2304 + 64 * (j))
#define XB_TOP      3328
#define XB_TOPGEN   3392
#define XCD_BAR_WORDS 3456
#define XB_SPIN_CAP (1u << 18)

__device__ __forceinline__ unsigned xb_ld(unsigned* p)              { return __hip_atomic_load(p, __ATOMIC_RELAXED, __HIP_MEMORY_SCOPE_AGENT); }
__device__ __forceinline__ unsigned xb_add(unsigned* p, unsigned v) { return __hip_atomic_fetch_add(p, v, __ATOMIC_RELAXED, __HIP_MEMORY_SCOPE_AGENT); }
__device__ __forceinline__ unsigned xb_xcc_id() { return (unsigned)__builtin_amdgcn_s_getreg((3 << 11) | 20) & 0xFu; }
#define XB_SPIN(cond, bar) do { unsigned _sp = 0; while (cond) { __builtin_amdgcn_s_sleep(1); \
    if ((++_sp & 255u) == 0u) { if (xb_ld(&(bar)[XB_TMO])) break; if (_sp > XB_SPIN_CAP) { atomicAdd(&(bar)[XB_TMO], 1u); break; } } } } while (0)

struct XcdBarrier {
    unsigned* bar; unsigned x;
    volatile __attribute__((address_space(3))) unsigned* st;
};

__device__ __forceinline__ XcdBarrier xcd_barrier_post(unsigned* bar, volatile __attribute__((address_space(3))) unsigned* st) {
    XcdBarrier b; b.bar = bar; b.x = xb_xcc_id(); b.st = st;
    if (threadIdx.x == 0) (void)xb_add(&bar[XB_XCNT(b.x)], 1u);
    return b;
}
__device__ __forceinline__ void xcd_barrier_complete(unsigned* bar, unsigned x, unsigned& nloc, unsigned& nx) {
    const unsigned G = gridDim.x * gridDim.y * gridDim.z;
    unsigned sum, cnt, mine, sp = 0u;
    for (;;) {
        sum = 0u; cnt = 0u; mine = 0u;
#pragma unroll
        for (unsigned j = 0; j < 16; ++j) { const unsigned c = xb_ld(&bar[XB_XCNT(j)]); sum += c; cnt += (c > 0u) ? 1u : 0u; mine = (j == x) ? c : mine; }
        if (sum == G) break;
        __builtin_amdgcn_s_sleep(1);
        if ((++sp & 255u) == 0u) { if (xb_ld(&bar[XB_TMO])) break; if (sp > XB_SPIN_CAP) { atomicAdd(&bar[XB_TMO], 1u); break; } }
    }
    nloc = mine > 0u ? mine : 1u; nx = cnt > 0u ? cnt : 1u;
}

__device__ __forceinline__ void xcd_barrier(const XcdBarrier& b) {
    asm volatile("s_waitcnt vmcnt(0)" ::: "memory");
    __syncthreads();
    if (threadIdx.x == 0) {
        unsigned* bar = b.bar;
        __builtin_amdgcn_s_waitcnt(0);
        unsigned nloc = b.st[0], nx = b.st[1];
        if (nloc == 0u) { xcd_barrier_complete(bar, b.x, nloc, nx); b.st[0] = nloc; b.st[1] = nx; }
        const unsigned old = xb_add(&bar[XB_XSUB(b.x)], 1u);
        const unsigned gen = old / nloc;
        if (old + 1u == (gen + 1u) * nloc) {
            __builtin_amdgcn_fence(__ATOMIC_RELEASE, "agent");
            asm volatile("s_waitcnt vmcnt(0)" ::: "memory");
            const unsigned og = xb_add(&bar[XB_TOP], 1u);
            const unsigned tg = og / nx;
            if (og + 1u == (tg + 1u) * nx) xb_add(&bar[XB_TOPGEN], 1u);
            else XB_SPIN(xb_ld(&bar[XB_TOPGEN]) == tg, bar);
            __builtin_amdgcn_fence(__ATOMIC_ACQUIRE, "agent");
            xb_add(&bar[XB_XGEN(b.x)], 1u);
            asm volatile("s_waitcnt vmcnt(0)" ::: "memory");
        } else {
            XB_SPIN(xb_ld(&bar[XB_XGEN(b.x)]) == gen, bar);
            __builtin_amdgcn_fence(__ATOMIC_ACQUIRE, "agent");
            asm volatile("s_waitcnt vmcnt(0)" ::: "memory");
        }
    }
    __syncthreads();
}

constexpr int CW_BAR = 4096;
constexpr int LDS_BYTES = 163840;
constexpr int N_PHASES = 12;
#ifndef PROBE_MASK
#define PROBE_MASK 0
#endif
template <int PH> __device__ __forceinline__ void run_phase(const Args& args, unsigned char* lds, int tid, int rep) {
    unsigned char* ws = args.ws;
    if constexpr (PH == 0) p0_prologue(args, lds, tid);
    if constexpr (PH == 1) { pg8::Gemm g{(const pg8::bf16_t*)(ws + WS_XB), (const pg8::bf16_t*)(ws + WS_WIN), MT, NZ, DM, DM}; pg8::StaticOrder S; S.init(MT, NZ, gridDim.x, blockIdx.x);
        pg8::EpiZ E{(pg8::bf16_t*)(ws + WS_ZR), (pg8::bf16_t*)(ws + WS_ZS)};
        pg8::gemm_phase<pg8::EpiZ, pg8::StaticOrder, true, true>((PG8_LAS unsigned char*)lds, g, S, E); }
    if constexpr (PH == 2) p2_post(args, lds, tid);
    if constexpr (PH == 3) p3_attention(args, lds, tid, rep);
    if constexpr (PH == 4) p4w_chunks(args, lds, tid);
    if constexpr (PH == 5) p5w_chain(args, lds, tid);
    if constexpr (PH == 7) { pg8::Gemm g{(const pg8::bf16_t*)(ws + WS_XB), (const pg8::bf16_t*)(ws + WS_WOUT), MT, DM, DM, DM}; pg8::StaticOrder S; S.init(MT, DM, gridDim.x, blockIdx.x);
        pg8::EpiH E{args.in[0], args.in[1], args.out + OFF_Y, (pg8::bf16_t*)(ws + WS_HB), (float*)(ws + WS_CTL) + CW_SS};
        pg8::gemm_phase<pg8::EpiH, pg8::StaticOrder, true, true>((PG8_LAS unsigned char*)lds, g, S, E); }
    if constexpr (PH == 9) { pg8::Gemm g{(const pg8::bf16_t*)(ws + WS_HB), (const pg8::bf16_t*)(ws + WS_W1), MT, DFF, DM, DM}; pg8::StaticOrder S; S.init(MT, DFF, gridDim.x, blockIdx.x);
        pg8::EpiAct E{(pg8::bf16_t*)(ws + WS_ACT), DFF, (const float*)(ws + WS_CTL) + CW_SS};
        pg8::gemm_phase<pg8::EpiAct, pg8::StaticOrder, true, true>((PG8_LAS unsigned char*)lds, g, S, E); }
    if constexpr (PH == 10) {
        { pg8::Gemm g{(const pg8::bf16_t*)(ws + WS_ACT), (const pg8::bf16_t*)(ws + WS_W2), MP, DM, DFF, DFF}; pg8::StaticOrder S; S.init(MP, DM, gridDim.x, blockIdx.x);
          pg8::EpiY E{args.out + OFF_Y};
          pg8::gemm_phase<pg8::EpiY, pg8::StaticOrder, true, true>((PG8_LAS unsigned char*)lds, g, S, E); }
        { const int c = blockIdx.x; pg8::OneUnit S; S.has = c < 64; S.u.pm = MP / 256 + (c >> 4); S.u.pn = (c >> 2) & 3; const int sl = c & 3;
          pg8::Gemm g{(const pg8::bf16_t*)(ws + WS_ACT) + sl * 1024, (const pg8::bf16_t*)(ws + WS_W2) + sl * 1024, MT, DM, DFF, 1024};
          pg8::EpiSlab E{(float*)(ws + WS_HB) + (size_t)sl * MS * DM};
          __syncthreads();
          pg8::gemm_phase<pg8::EpiSlab, pg8::OneUnit, false, true>((PG8_LAS unsigned char*)lds, g, S, E); }
    }
    if constexpr (PH == 11) {
        const f32x4* sl = (const f32x4*)(ws + WS_HB); f32x4* y = (f32x4*)(args.out + OFF_Y + (size_t)MP * DM); constexpr int NV = MS * DM / 4;
        for (int i = blockIdx.x * 512 + tid; i < NV; i += gridDim.x * 512) y[i] = y[i] + ((sl[i] + sl[i + NV]) + (sl[i + 2 * NV] + sl[i + 3 * NV]));
    }
}
#ifndef MK_ONE_LAUNCH
#define MK_ONE_LAUNCH 1
#endif
#if MK_ONE_LAUNCH
__global__ void __launch_bounds__(512, 2) mk_fwd(Args args) {
    extern __shared__ __attribute__((aligned(16))) unsigned char lds[];
    const int tid = threadIdx.x;
    volatile __attribute__((address_space(3))) unsigned* bst = (volatile __attribute__((address_space(3))) unsigned*)((__attribute__((address_space(3))) unsigned char*)lds + LDS_BYTES - 16);
    if (tid < 2) bst[tid] = 0u;
    __syncthreads();
    const XcdBarrier bar = xcd_barrier_post((unsigned*)(args.ws + WS_CTL) + CW_BAR, bst);
    if (args.ph_lo < 0) { __syncthreads(); cg::this_grid().sync(); }
#define SEAM(k) xcd_barrier(bar)
#define PHASE(k) do { if (args.ph_lo <= (k) && (k) < args.ph_hi) { if ((k) > args.ph_lo) SEAM(k); run_phase<k>(args, lds, tid, 0); \
        if ((PROBE_MASK >> (k)) & 1) { xcd_barrier(bar); run_phase<k>(args, lds, tid, 1); } } } while (0)
    PHASE(0); PHASE(1); PHASE(2); PHASE(3); PHASE(4); PHASE(5); PHASE(7); PHASE(9); PHASE(10); PHASE(11);
#undef PHASE
#undef SEAM
}
#else
template <int PH> __global__ void __launch_bounds__(512, 2) mk_phase(Args args) {
    extern __shared__ __attribute__((aligned(16))) unsigned char lds[];
    run_phase<PH>(args, lds, threadIdx.x, 0);
}
#endif

extern "C" void kernel_launch(void* const* d_in, const int* in_sizes, int n_in, void* d_out, int out_size, void* d_ws, size_t ws_size, hipStream_t stream) {
    static int grid = 0;
    if (grid == 0) {
        if (n_in != 28 || out_size != (int)OUT_TOTAL || ws_size < WS_END) { fprintf(stderr, "kernel_launch: unexpected shapes (n_in %d, out %d, ws %zu)\n", n_in, out_size, ws_size); grid = -1; return; }
        int dev = 0, cus = 0, per_cu = 0;
        (void)hipGetDevice(&dev); (void)hipDeviceGetAttribute(&cus, hipDeviceAttributeMultiprocessorCount, dev);
#if MK_ONE_LAUNCH
        if (hipFuncSetAttribute((const void*)mk_fwd, hipFuncAttributeMaxDynamicSharedMemorySize, LDS_BYTES) != hipSuccess) { fprintf(stderr, "kernel_launch: hipFuncSetAttribute failed\n"); grid = -1; return; }
        (void)hipOccupancyMaxActiveBlocksPerMultiprocessor(&per_cu, (const void*)mk_fwd, 512, LDS_BYTES);
        (void)hipGetLastError();
        if (per_cu < 1) { fprintf(stderr, "kernel_launch: occupancy query says %d blocks per CU\n", per_cu); per_cu = 1; }
#else
#define SETATTR(k) (void)hipFuncSetAttribute((const void*)mk_phase<k>, hipFuncAttributeMaxDynamicSharedMemorySize, LDS_BYTES)
        SETATTR(0); SETATTR(1); SETATTR(2); SETATTR(3); SETATTR(4); SETATTR(5); SETATTR(6); SETATTR(7); SETATTR(8); SETATTR(9); SETATTR(10); SETATTR(11);
#undef SETATTR
        (void)per_cu;
#endif
        grid = cus;
    }
    if (grid < 0) return;
    (void)hipMemsetAsync((char*)d_ws + WS_CTL, 0, CTL_BYTES, stream);
    Args a{};
    for (int i = 0; i < 28; ++i) a.in[i] = (const float*)d_in[i];
    a.out = (float*)d_out; a.ws = (unsigned char*)d_ws;
#if MK_ONE_LAUNCH
    a.ph_lo = 0; a.ph_hi = N_PHASES;
    void* kargs[] = {&a};
    hipError_t e = hipLaunchCooperativeKernel((const void*)mk_fwd, dim3(grid), dim3(512), kargs, LDS_BYTES, stream);
    if (e != hipSuccess) fprintf(stderr, "kernel_launch: cooperative launch failed: %s (grid %d)\n", hipGetErrorString(e), grid);
#else
#define LAUNCH(k) hipLaunchKernelGGL(mk_phase<k>, dim3(grid), dim3(512), LDS_BYTES, stream, a)
    a.ph_lo = 0; a.ph_hi = N_PHASES;
    LAUNCH(0); LAUNCH(1); LAUNCH(2); LAUNCH(3); LAUNCH(4); LAUNCH(5); LAUNCH(7); LAUNCH(9); LAUNCH(10); LAUNCH(11);
#undef LAUNCH
#endif
}
```

```cpp
#include <hip/hip_runtime.h>
#include <hip/hip_cooperative_groups.h>
#include <cstdio>
#include <cstdint>
namespace cg = cooperative_groups;
#define PROBE_A1 0
#define PROBE_A2 0
#define PROBE_A3 0
namespace pg8 {
#define PG8_LAS __attribute__((address_space(3)))
typedef unsigned short bf16_t;
typedef short bf16x8 __attribute__((ext_vector_type(8)));
typedef float f32x4 __attribute__((ext_vector_type(4)));
typedef unsigned u32x4 __attribute__((ext_vector_type(4)));
constexpr int BM = 256, BK = 64, HALF = 128, HTB = HALF * BK * 2  , STAGE_BYTES = 8 * HTB, NXCD = 8, WGM = 8;

__host__ __device__ __forceinline__ int lds_byte(int r, int c) { const int st = (r >> 4) * 2 + (c >> 5), rr = r & 15, cc = c & 31, ob = rr * 64 + cc * 2; return st * 1024 + (ob ^ (((ob >> 9) & 1) << 5)); }
__host__ __device__ __forceinline__ void stage_rc(int b, int& R, int& C) { const int st = b / 1024, sb = b % 1024, swz = sb ^ (((sb >> 9) & 1) << 5); R = (st >> 1) * 16 + swz / 64; C = (st & 1) * 32 + (swz % 64) / 2; }
__host__ __device__ __forceinline__ int perm32(int rho) { const int n = rho >> 4, i = rho & 15; return 8 * (i >> 2) + 4 * n + (i & 3); }

struct Unit { int pm, pn; };
struct Gemm { const bf16_t* A; const bf16_t* Bt; int M, N, K, KL; };

struct StaticOrder {
    int nM, nN, nwg, G, c;
    __host__ __device__ void init(int M, int N, int G_, int c_) { nM = M / BM; nN = N / BM; nwg = nM * nN; G = G_; c = c_; }
    __host__ __device__ bool next(int i, Unit& u) const {
        const long L = (long)i * G + c; if (L >= nwg) return false;
        int wgid = (int)L; { const int q = nwg / NXCD, r = nwg % NXCD, xcd = wgid % NXCD, off = wgid / NXCD; wgid = (xcd < r ? xcd * (q + 1) : r * (q + 1) + (xcd - r) * q) + off; }
        const int nig = WGM * nN, gid = wgid / nig, fm = gid * WGM, gsz = (nM - fm) < WGM ? (nM - fm) : WGM;
        u.pm = fm + ((wgid % nig) % gsz); u.pn = (wgid % nig) / gsz; return true;
    }
    __device__ __forceinline__ void a_ready(const Unit&) const {}
    __device__ __forceinline__ void done(const Unit&) const {}
};


__device__ __forceinline__ unsigned cvt_pk_bf16(float lo, float hi) { unsigned r; asm volatile("v_cvt_pk_bf16_f32 %0, %1, %2" : "=v"(r) : "v"(lo), "v"(hi)); return r; }

constexpr int E_MP = 16384;
constexpr int E_ZRW = 1632, E_ZSW = 1696;

struct OneUnit { Unit u; bool has;
    __device__ __forceinline__ bool next(int i, Unit& o) const { if (i == 0 && has) { o = u; return true; } return false; }
    __device__ __forceinline__ void a_ready(const Unit&) const {}
    __device__ __forceinline__ void done(const Unit&) const {} };
struct EpiZ {
    static constexpr bool PERM = true, AFTER_DRAIN = false;
    bf16_t* ZR; bf16_t* ZS;
    __device__ __forceinline__ void operator()(const f32x4 (&acc)[2][2][4][2], const Unit& u, int wr, int wc, int fr, int fq) const {
        const int row0 = u.pm * BM + wr * 64 + fr, c0 = u.pn * BM + wc * 32 + 8 * fq;
#pragma unroll
        for (int ai = 0; ai < 2; ++ai)
#pragma unroll
            for (int m = 0; m < 4; ++m) { const size_t row = (size_t)(row0 + ai * HALF + m * 16);
#pragma unroll
                for (int bj = 0; bj < 2; ++bj) { const int c = c0 + bj * HALF; bf16_t* dst;
                    if (c < 1600) dst = ZR + row * E_ZRW + c; else if (c < 3296) dst = ZS + row * E_ZSW + (c - 1600); else if (c == 3296) dst = ZR + row * E_ZRW + 1600; else continue;
                    const f32x4 v0 = acc[ai][bj][m][0], v1 = acc[ai][bj][m][1]; u32x4 w;
                    w.x = cvt_pk_bf16(v0[0], v0[1]); w.y = cvt_pk_bf16(v0[2], v0[3]); w.z = cvt_pk_bf16(v1[0], v1[1]); w.w = cvt_pk_bf16(v1[2], v1[3]);
                    *(u32x4*)dst = w; } }
    }
};
struct EpiH {
    static constexpr bool PERM = false, AFTER_DRAIN = false;
    const float* xp; const float* xs; float* H; bf16_t* HB; float* SS;
    __device__ __forceinline__ void operator()(const f32x4 (&acc)[2][2][4][2], const Unit& u, int wr, int wc, int fr, int fq) const {
        const int row0 = u.pm * BM + wr * 64 + fr, col0 = u.pn * BM + wc * 32 + 4 * fq;
#pragma unroll
        for (int ai = 0; ai < 2; ++ai)
#pragma unroll
            for (int m = 0; m < 4; ++m) { const int row = row0 + ai * HALF + m * 16;
                const float* xr = (row < E_MP ? xp + (size_t)row * 1024 : xs + (size_t)(row - E_MP) * 1024) + col0; float* hr = H + (size_t)row * 1024 + col0; bf16_t* hb = HB + (size_t)row * 1024 + col0;
                float ss = 0.f;
#pragma unroll
                for (int bj = 0; bj < 2; ++bj)
#pragma unroll
                    for (int n = 0; n < 2; ++n) { const f32x4 h = *(const f32x4*)(xr + bj * HALF + n * 16) + acc[ai][bj][m][n]; *(f32x4*)(hr + bj * HALF + n * 16) = h;
                        ss += (h[0] * h[0] + h[1] * h[1]) + (h[2] * h[2] + h[3] * h[3]);
                        unsigned w0 = cvt_pk_bf16(h[0], h[1]), w1 = cvt_pk_bf16(h[2], h[3]); typedef unsigned u32x2v __attribute__((ext_vector_type(2))); *(u32x2v*)(hb + bj * HALF + n * 16) = (u32x2v){w0, w1}; }
                ss += __shfl_xor(ss, 16); ss += __shfl_xor(ss, 32);
                if (fq == 0) atomicAdd(SS + row, ss); }
    }
};
struct EpiAct {
    static constexpr bool PERM = true, AFTER_DRAIN = false;
    bf16_t* O; int ldc; const float* SS;
    __device__ __forceinline__ void operator()(const f32x4 (&acc)[2][2][4][2], const Unit& u, int wr, int wc, int fr, int fq) const {
        const int row0 = u.pm * BM + wr * 64 + fr, c0 = u.pn * BM + wc * 32 + 8 * fq;
#pragma unroll
        for (int ai = 0; ai < 2; ++ai)
#pragma unroll
            for (int m = 0; m < 4; ++m) { const int row = row0 + ai * HALF + m * 16; bf16_t* rowp = O + (size_t)row * ldc + c0;
                const float rs = rsqrtf(SS[row] * (1.0f / 1024.0f) + 1e-6f);
#pragma unroll
                for (int bj = 0; bj < 2; ++bj) { f32x4 v0 = acc[ai][bj][m][0], v1 = acc[ai][bj][m][1];
#pragma unroll
                    for (int e = 0; e < 4; ++e) { const float a = fmaxf(v0[e], 0.f) * rs, b = fmaxf(v1[e], 0.f) * rs; v0[e] = a * a; v1[e] = b * b; }
                    u32x4 w; w.x = cvt_pk_bf16(v0[0], v0[1]); w.y = cvt_pk_bf16(v0[2], v0[3]); w.z = cvt_pk_bf16(v1[0], v1[1]); w.w = cvt_pk_bf16(v1[2], v1[3]);
                    *(u32x4*)(rowp + bj * HALF) = w; } }
    }
};
struct EpiSlab {
    static constexpr bool PERM = false, AFTER_DRAIN = false;
    float* S;
    __device__ __forceinline__ void operator()(const f32x4 (&acc)[2][2][4][2], const Unit& u, int wr, int wc, int fr, int fq) const {
        const int row0 = u.pm * BM - E_MP + wr * 64 + fr, col0 = u.pn * BM + wc * 32 + 4 * fq;
#pragma unroll
        for (int ai = 0; ai < 2; ++ai)
#pragma unroll
            for (int m = 0; m < 4; ++m) { float* yr = S + (size_t)(row0 + ai * HALF + m * 16) * 1024 + col0;
#pragma unroll
                for (int bj = 0; bj < 2; ++bj)
#pragma unroll
                    for (int n = 0; n < 2; ++n) *(f32x4*)(yr + bj * HALF + n * 16) = acc[ai][bj][m][n]; }
    }
};
struct EpiY {
    static constexpr bool PERM = false, AFTER_DRAIN = false;
    float* Y;
    __device__ __forceinline__ void operator()(const f32x4 (&acc)[2][2][4][2], const Unit& u, int wr, int wc, int fr, int fq) const {
        const int row0 = u.pm * BM + wr * 64 + fr, col0 = u.pn * BM + wc * 32 + 4 * fq;
#pragma unroll
        for (int ai = 0; ai < 2; ++ai)
#pragma unroll
            for (int m = 0; m < 4; ++m) { float* yr = Y + (size_t)(row0 + ai * HALF + m * 16) * 1024 + col0;
#pragma unroll
                for (int bj = 0; bj < 2; ++bj)
#pragma unroll
                    for (int n = 0; n < 2; ++n) { f32x4* p = (f32x4*)(yr + bj * HALF + n * 16); *p = *p + acc[ai][bj][m][n]; } }
    }
};

template <class Epi, class Sched, bool ALIGN_EPI = false, bool SP2 = false>
__device__ __forceinline__ void gemm_phase(PG8_LAS unsigned char* lds, const Gemm g, const Sched& S, const Epi& E) {
    const int tid = threadIdx.x, wid = __builtin_amdgcn_readfirstlane(tid >> 6), lane = tid & 63, wr = wid >> 2, wc = wid & 3, fr = lane & 15, fq = lane >> 4;
    const int K = g.K, nt = g.KL / BK;
    unsigned voffA[2], voffB[2];
#pragma unroll
    for (int i = 0; i < 2; ++i) { int R, C; stage_rc(tid * 16 + i * 8192, R, C); const int Rb = Epi::PERM ? ((R & ~31) + perm32(R & 31)) : R;
        voffA[i] = (unsigned)(R * K + C) * 2u; voffB[i] = (unsigned)(Rb * K + C) * 2u; }
    const size_t kstep = (size_t)(BK * 2);
    const size_t hstep = (size_t)HALF * K * 2;
    const size_t tstep = 2 * hstep;
    const unsigned ldsw = (unsigned)wid * 1024u;
    const int aoff = lds_byte(wr * 64 + fr, fq * 8), boff = lds_byte(wc * 32 + fr, fq * 8);
#define PG8_SA(b, h) (((b) * 2 + (h)) * HTB)
#define PG8_SB(b, h) ((4 + (b) * 2 + (h)) * HTB)
#define PG8_STAGE(bufoff, gbase, voff) do { _Pragma("unroll") for (int _i = 0; _i < 2; ++_i) \
        __builtin_amdgcn_global_load_lds((const unsigned*)((const char*)(gbase) + (voff)[_i]), (PG8_LAS unsigned*)(lds + (bufoff) + ldsw + _i * 8192), 16, 0, 0); } while (0)
#define PG8_LDA(dst, b, h) do { _Pragma("unroll") for (int m = 0; m < 4; ++m) _Pragma("unroll") for (int k = 0; k < 2; ++k) dst[m][k] = *(const PG8_LAS bf16x8*)(lds + PG8_SA(b, h) + aoff + m * 2048 + k * 1024); } while (0)
#define PG8_LDB(dst, b, h) do { _Pragma("unroll") for (int n = 0; n < 2; ++n) _Pragma("unroll") for (int k = 0; k < 2; ++k) dst[n][k] = *(const PG8_LAS bf16x8*)(lds + PG8_SB(b, h) + boff + n * 2048 + k * 1024); } while (0)
#define PG8_MMA(ai, bj, At, Bt) do { __builtin_amdgcn_s_setprio(1); _Pragma("unroll") for (int m = 0; m < 4; ++m) _Pragma("unroll") for (int n = 0; n < 2; ++n) _Pragma("unroll") for (int k = 0; k < 2; ++k) \
        acc[ai][bj][m][n] = __builtin_amdgcn_mfma_f32_16x16x32_bf16(Bt[n][k], At[m][k], acc[ai][bj][m][n], 0, 0, 0); __builtin_amdgcn_s_setprio(0); } while (0)
#define PG8_WAIT_V(n) asm volatile("s_waitcnt vmcnt(" #n ")" ::: "memory")
#define PG8_WAIT_L(n) asm volatile("s_waitcnt lgkmcnt(" #n ")" ::: "memory")
#define PG8_BAR __builtin_amdgcn_s_barrier()
#define PG8_SCHED __builtin_amdgcn_sched_barrier(0)
    Unit cur, nxt; int ui = 0;
    if (!S.next(0, cur)) return;
    f32x4 acc[2][2][4][2];
#pragma unroll
    for (int a = 0; a < 2; ++a)
#pragma unroll
        for (int b = 0; b < 2; ++b)
#pragma unroll
            for (int m = 0; m < 4; ++m)
#pragma unroll
                for (int n = 0; n < 2; ++n) acc[a][b][m][n] = (f32x4){0.f, 0.f, 0.f, 0.f};
    bf16x8 At[4][2], B0[2][2], B1[2][2];
    const char* cA = (const char*)g.A + (size_t)cur.pm * tstep; const char* cB = (const char*)g.Bt + (size_t)cur.pn * tstep;
    S.a_ready(cur);
    if constexpr (SP2) {
        PG8_STAGE(PG8_SB(0, 0), cB, voffB); PG8_STAGE(PG8_SB(0, 1), cB + hstep, voffB); PG8_STAGE(PG8_SA(0, 0), cA, voffA); PG8_STAGE(PG8_SA(0, 1), cA + hstep, voffA);
        if (wr == 1) PG8_BAR;
        PG8_WAIT_V(2); PG8_BAR;
        PG8_STAGE(PG8_SB(1, 0), cB + kstep, voffB); PG8_STAGE(PG8_SA(1, 0), cA + kstep, voffA); PG8_STAGE(PG8_SB(1, 1), cB + hstep + kstep, voffB);
        PG8_WAIT_V(6); PG8_BAR;
    } else {
        PG8_STAGE(PG8_SB(0, 0), cB, voffB); PG8_STAGE(PG8_SA(0, 0), cA, voffA); PG8_STAGE(PG8_SB(0, 1), cB + hstep, voffB); PG8_STAGE(PG8_SA(0, 1), cA + hstep, voffA);
        if (wr == 1) PG8_BAR;
        PG8_WAIT_V(4); PG8_BAR;
        PG8_STAGE(PG8_SB(1, 0), cB + kstep, voffB); PG8_STAGE(PG8_SA(1, 0), cA + kstep, voffA); PG8_STAGE(PG8_SB(1, 1), cB + hstep + kstep, voffB);
        PG8_WAIT_V(6); PG8_BAR;
    }
    for (;;) {
        const bool has_next = S.next(ui + 1, nxt);
        const char* nA = has_next ? (const char*)g.A + (size_t)nxt.pm * tstep : cA; const char* nB = has_next ? (const char*)g.Bt + (size_t)nxt.pn * tstep : cB;
        for (int t = 0; t < nt; t += 2) {
            const bool last = (t == nt - 2);
            const char* a1 = cA + (size_t)(t + 1) * kstep;
            const char* a2 = last ? nA : cA + (size_t)(t + 2) * kstep; const char* b2 = last ? nB : cB + (size_t)(t + 2) * kstep;
            const char* a3 = a2 + kstep; const char* b3 = b2 + kstep;
            if (last && has_next) S.a_ready(nxt);
            if constexpr (SP2) {
            PG8_LDB(B0, 0, 0); PG8_LDB(B1, 0, 1); PG8_SCHED; PG8_LDA(At, 0, 0); PG8_STAGE(PG8_SA(1, 1), a1 + hstep, voffA);
            PG8_WAIT_V(8); PG8_WAIT_L(0); PG8_BAR; PG8_MMA(0, 0, At, B0); PG8_MMA(0, 1, At, B1); PG8_BAR; PG8_SCHED;
            PG8_LDA(At, 0, 1); PG8_STAGE(PG8_SB(0, 0), b2, voffB); PG8_STAGE(PG8_SB(0, 1), b2 + hstep, voffB); PG8_STAGE(PG8_SA(0, 0), a2, voffA);
            PG8_WAIT_V(8); PG8_WAIT_L(0); PG8_BAR; PG8_MMA(1, 0, At, B0); PG8_MMA(1, 1, At, B1); PG8_BAR; PG8_SCHED;
            PG8_LDB(B0, 1, 0); PG8_LDB(B1, 1, 1); PG8_SCHED; PG8_LDA(At, 1, 0); PG8_STAGE(PG8_SA(0, 1), a2 + hstep, voffA);
            PG8_WAIT_V(8); PG8_WAIT_L(0); PG8_BAR; PG8_MMA(0, 0, At, B0); PG8_MMA(0, 1, At, B1); PG8_BAR; PG8_SCHED;
            PG8_LDA(At, 1, 1); PG8_STAGE(PG8_SB(1, 0), b3, voffB); PG8_STAGE(PG8_SB(1, 1), b3 + hstep, voffB); PG8_STAGE(PG8_SA(1, 0), a3, voffA);
            PG8_WAIT_V(8); PG8_WAIT_L(0); PG8_BAR; PG8_MMA(1, 0, At, B0); PG8_MMA(1, 1, At, B1); PG8_BAR; PG8_SCHED;
            } else {
            PG8_LDB(B0, 0, 0); PG8_SCHED; PG8_LDA(At, 0, 0); PG8_STAGE(PG8_SA(1, 1), a1 + hstep, voffA);
            PG8_WAIT_L(8); PG8_BAR; PG8_WAIT_L(0); PG8_MMA(0, 0, At, B0); PG8_BAR; PG8_SCHED;
            PG8_LDB(B1, 0, 1); PG8_STAGE(PG8_SB(0, 0), b2, voffB);
            PG8_BAR; PG8_WAIT_L(0); PG8_MMA(0, 1, At, B1); PG8_BAR;
            PG8_LDA(At, 0, 1); PG8_STAGE(PG8_SA(0, 0), a2, voffA);
            PG8_BAR; PG8_WAIT_L(0); PG8_MMA(1, 0, At, B0); PG8_BAR; PG8_SCHED;
            PG8_STAGE(PG8_SB(0, 1), b2 + hstep, voffB);
            PG8_WAIT_V(6); PG8_BAR; PG8_MMA(1, 1, At, B1); PG8_BAR;
            PG8_LDB(B0, 1, 0); PG8_SCHED; PG8_LDA(At, 1, 0); PG8_STAGE(PG8_SA(0, 1), a2 + hstep, voffA);
            PG8_WAIT_L(8); PG8_BAR; PG8_WAIT_L(0); PG8_MMA(0, 0, At, B0); PG8_BAR; PG8_SCHED;
            PG8_LDB(B1, 1, 1); PG8_STAGE(PG8_SB(1, 0), b3, voffB);
            PG8_BAR; PG8_WAIT_L(0); PG8_MMA(0, 1, At, B1); PG8_BAR;
            PG8_LDA(At, 1, 1); PG8_STAGE(PG8_SA(1, 0), a3, voffA);
            PG8_BAR; PG8_WAIT_L(0); PG8_MMA(1, 0, At, B0); PG8_BAR; PG8_SCHED;
            PG8_STAGE(PG8_SB(1, 1), b3 + hstep, voffB);
            PG8_WAIT_V(6); PG8_BAR; PG8_MMA(1, 1, At, B1); PG8_BAR;
            }
        }
        if constexpr (ALIGN_EPI) { if (wr == 0) PG8_BAR; }
        if constexpr (!Epi::AFTER_DRAIN) { E(acc, cur, wr, wc, fr, fq); S.done(cur); }
        if (!has_next) break;
#pragma unroll
        for (int a = 0; a < 2; ++a)
#pragma unroll
            for (int b = 0; b < 2; ++b)
#pragma unroll
                for (int m = 0; m < 4; ++m)
#pragma unroll
                    for (int n = 0; n < 2; ++n) acc[a][b][m][n] = (f32x4){0.f, 0.f, 0.f, 0.f};
        cur = nxt; cA = nA; cB = nB; ++ui;
        if constexpr (ALIGN_EPI) { if (wr == 1) PG8_BAR; }
    }
    PG8_WAIT_V(0);
    if constexpr (!ALIGN_EPI) { if (wr == 0) PG8_BAR; }
    PG8_BAR;
    if constexpr (Epi::AFTER_DRAIN) { E.fused(acc, cur, wr, wc, fr, fq, lds, wid, lane); S.done(cur); }
#undef PG8_SA
#undef PG8_SB
#undef PG8_STAGE
#undef PG8_LDA
#undef PG8_LDB
#undef PG8_MMA
#undef PG8_WAIT_V
#undef PG8_WAIT_L
#undef PG8_BAR
#undef PG8_SCHED
}
}


constexpr int DM = 1024, NB_P = 8, T_P = 2048, NB_S = 32, T_S = 32, PAST = 1024;
constexpr int MP = NB_P * T_P, MS = NB_S * T_S, MT = MP + MS;
constexpr int LS = PAST + T_S;
constexpr int SHIFTW = 1696, NZ = 3328, ZRW = 1632, DFF = 4096;
constexpr float QSCALE = 0.125f * 1.4426950408889634f;
constexpr float WISCALE = 0.35355339059327373f * 0.125f;
constexpr size_t OFF_Y = 0, OFF_KP = 17825792, OFF_VP = OFF_KP + 4194304, OFF_KIP = OFF_VP + 4194304, OFF_WKVP = OFF_KIP + 1048576, OFF_SHP = OFF_WKVP + 262144,
                 OFF_KS = OFF_SHP + 13568, OFF_VS = OFF_KS + 262144, OFF_KIS = OFF_VS + 262144, OFF_WKVS = OFF_KIS + 65536, OFF_SHS = OFF_WKVS + 1048576, OUT_TOTAL = OFF_SHS + 54272;
constexpr size_t MiB = 1u << 20;
constexpr size_t WS_CTL = 0, CTL_BYTES = 1 * MiB;
constexpr size_t WS_WIN = 1 * MiB, WS_WOUT = 8 * MiB, WS_W1 = 10 * MiB, WS_W2 = 18 * MiB;
constexpr size_t WS_W2T = 26 * MiB, WS_A2T = WS_W2T + 32768, WS_G2T = WS_A2T + 32768, WS_WI = 27 * MiB, WS_BONUS = 28 * MiB;
constexpr size_t WS_XB = 30 * MiB;
constexpr size_t WS_ZS = 66 * MiB;
constexpr size_t WS_R = 123 * MiB;
constexpr size_t WS_ZR = WS_R, WS_KBP = 178 * MiB, WS_VTP = 186 * MiB, WS_KIP = 194 * MiB, WS_KBS = 196 * MiB, WS_VTS = 213 * MiB, WS_KIS = 230 * MiB;
constexpr size_t WS_OW = WS_R, WS_OKK = 157 * MiB, WS_OB = 174 * MiB, WS_OKM = 191 * MiB, WS_OR = 208 * MiB, WS_OV = 225 * MiB;
constexpr size_t WS_ACT = 66 * MiB, WS_HB = 202 * MiB, WS_END = 256 * MiB;
static_assert(WS_ZS + (size_t)MT * SHIFTW * 2 <= WS_R && WS_ZR + (size_t)MT * ZRW * 2 <= WS_KBP && WS_KBS + (size_t)NB_S * LS * 256 * 2 <= WS_VTS && WS_VTS + (size_t)NB_S * 256 * LS * 2 <= WS_KIS &&
              WS_KIS + (size_t)NB_S * LS * 64 * 2 <= WS_END && WS_OV + (size_t)MT * 512 * 2 <= WS_END && WS_ACT + (size_t)MT * DFF * 2 <= WS_HB && WS_HB + (size_t)MT * DM * 2 <= WS_END, "d_ws map");
constexpr size_t SC_Q = 0, SC_QI = (size_t)MT * 512 / 2, SC_Y = 0, SC_G = (size_t)MT * 512;
constexpr int CW_QATT = 64, CW_SS = 16384;

typedef unsigned short bf16;
typedef short bf16x8 __attribute__((ext_vector_type(8)));
typedef float f32x4 __attribute__((ext_vector_type(4)));
typedef float f32x16 __attribute__((ext_vector_type(16)));
typedef unsigned u32x4 __attribute__((ext_vector_type(4)));
typedef unsigned u32x2 __attribute__((ext_vector_type(2)));

__device__ __forceinline__ unsigned f2bf(float f) { unsigned u = __float_as_uint(f); return (u + 0x7fffu + ((u >> 16) & 1u)) >> 16; }
__device__ __forceinline__ unsigned pk2(float lo, float hi) { return f2bf(lo) | (f2bf(hi) << 16); }
__device__ __forceinline__ float bflo(unsigned w) { return __uint_as_float(w << 16); }
__device__ __forceinline__ float bfhi(unsigned w) { return __uint_as_float(w & 0xffff0000u); }
__device__ __forceinline__ float bf1(bf16 b) { return __uint_as_float((unsigned)b << 16); }
__device__ __forceinline__ void unpack8(const u32x4 w, float* x) { x[0] = bflo(w.x); x[1] = bfhi(w.x); x[2] = bflo(w.y); x[3] = bfhi(w.y); x[4] = bflo(w.z); x[5] = bfhi(w.z); x[6] = bflo(w.w); x[7] = bfhi(w.w); }
__device__ __forceinline__ u32x4 pack8(const float* x) { u32x4 w; w.x = pk2(x[0], x[1]); w.y = pk2(x[2], x[3]); w.z = pk2(x[4], x[5]); w.w = pk2(x[6], x[7]); return w; }
__device__ __forceinline__ float wave_sum(float v) {
#pragma unroll
    for (int o = 1; o < 64; o <<= 1) v += __shfl_xor(v, o);
    return v;
}
template <int CTRL> __device__ __forceinline__ float dppmov(float x) { return __builtin_bit_cast(float, __builtin_amdgcn_update_dpp(0, __builtin_bit_cast(int, x), CTRL, 0xf, 0xf, true)); }
__device__ __forceinline__ float sum16(float x) {
    x += dppmov<0xB1>(x); x += dppmov<0x4E>(x); x += dppmov<0x141>(x); x += dppmov<0x140>(x); return x;
}
__device__ __forceinline__ int crow(int r, int hi) { return (r & 3) + 8 * (r >> 2) + 4 * hi; }

struct Args { const float* in[28]; float* out; unsigned char* ws; int ph_lo, ph_hi; };

__device__ __forceinline__ void tr_item(const float* W, int K, int N, const float* gain, bf16* WT, int jr0, int c0, int nvalid, int k0, float* scr, int lane) {
#pragma unroll 8
    for (int i = 0; i < 32; ++i) { const int kk = 2 * i + (lane >> 5), n = lane & 31;
        float v = (n < nvalid) ? W[(size_t)(k0 + kk) * N + c0 + n] : 0.f; if (gain) v *= gain[k0 + kk]; scr[kk * 33 + n] = v; }
    __builtin_amdgcn_s_waitcnt(0xC07F); asm volatile("" ::: "memory");
    const int c = lane & 7;
#pragma unroll
    for (int j = 0; j < 4; ++j) { const int n = (lane >> 3) + 8 * j; const float* s = scr + (8 * c) * 33 + n;
        u32x4 o; o.x = pk2(s[0 * 33], s[1 * 33]); o.y = pk2(s[2 * 33], s[3 * 33]); o.z = pk2(s[4 * 33], s[5 * 33]); o.w = pk2(s[6 * 33], s[7 * 33]);
        *(u32x4*)(WT + (size_t)(jr0 + n) * K + k0 + 8 * c) = o; }
    __builtin_amdgcn_s_waitcnt(0xC07F); asm volatile("" ::: "memory");
}
__device__ __forceinline__ void p0_prologue(const Args& a, unsigned char* lds, int tid) {
    const int lane = tid & 63, wave = tid >> 6, gw = blockIdx.x * 8 + wave, NGW = gridDim.x * 8;
    float* scr = (float*)(lds + wave * 17408);
    unsigned char* ws = a.ws;
    constexpr int I_IN = (NZ / 32) * (DM / 64), I_OUT = (DM / 32) * (DM / 64), I_F1 = (DFF / 32) * (DM / 64), I_F2 = (DM / 32) * (DFF / 64);
    for (int it = gw; it < I_IN + I_OUT + I_F1 + I_F2; it += NGW) {
        int r = it;
        if (r < I_IN) { const int jb = r % (NZ / 32), kb = r / (NZ / 32), j0 = jb * 32; int c0, nv;
            if (j0 < 1600) { c0 = j0; nv = 32; } else if (j0 < 3296) { c0 = 1608 + (j0 - 1600); nv = 32; } else { c0 = 1600; nv = 8; }
            tr_item(a.in[8], DM, 3304, a.in[7], (bf16*)(ws + WS_WIN), j0, c0, nv, kb * 64, scr, lane); continue; }
        r -= I_IN;
        if (r < I_OUT) { const int jb = r % (DM / 32), kb = r / (DM / 32); tr_item(a.in[24], DM, DM, nullptr, (bf16*)(ws + WS_WOUT), jb * 32, jb * 32, 32, kb * 64, scr, lane); continue; }
        r -= I_OUT;
        if (r < I_F1) { const int jb = r % (DFF / 32), kb = r / (DFF / 32); tr_item(a.in[26], DM, DFF, a.in[25], (bf16*)(ws + WS_W1), jb * 32, jb * 32, 32, kb * 64, scr, lane); continue; }
        r -= I_F1;
        { const int jb = r % (DM / 32), kb = r / (DM / 32); tr_item(a.in[27], DFF, DM, nullptr, (bf16*)(ws + WS_W2), jb * 32, jb * 32, 32, kb * 64, scr, lane); }
    }
    { const int gt = blockIdx.x * 512 + tid, NT = gridDim.x * 512;
      bf16* w2t = (bf16*)(ws + WS_W2T); bf16* a2t = (bf16*)(ws + WS_A2T); bf16* g2t = (bf16*)(ws + WS_G2T);
      for (int i = gt; i < 512 * 32; i += NT) { const int n = i >> 5, k = i & 31; w2t[i] = (bf16)f2bf(a.in[15][k * 512 + n]); a2t[i] = (bf16)f2bf(a.in[17][k * 512 + n]); }
      for (int i = gt; i < 512 * 96; i += NT) { const int n = i / 96, k = i % 96; g2t[i] = (bf16)f2bf(a.in[18][k * 512 + n]); } }
    { f32x4 v[4], nx[4]; int m = gw;
      if (m < MT) { const f32x4* xr = (const f32x4*)((m < MP) ? a.in[0] + (size_t)m * DM : a.in[1] + (size_t)(m - MP) * DM) + lane;
#pragma unroll
          for (int j = 0; j < 4; ++j) v[j] = xr[64 * j]; }
      for (; m < MT; m += NGW) {
        const int mn = m + NGW;
        if (mn < MT) { const f32x4* xr = (const f32x4*)((mn < MP) ? a.in[0] + (size_t)mn * DM : a.in[1] + (size_t)(mn - MP) * DM) + lane;
#pragma unroll
            for (int j = 0; j < 4; ++j) nx[j] = xr[64 * j]; }
        float s = 0.f;
#pragma unroll
        for (int j = 0; j < 4; ++j) s += (v[j].x * v[j].x + v[j].y * v[j].y) + (v[j].z * v[j].z + v[j].w * v[j].w);
        const float rs = rsqrtf(wave_sum(s) * (1.f / DM) + 1e-6f);
        u32x2* o8 = (u32x2*)((bf16*)(ws + WS_XB) + (size_t)m * DM) + lane;
#pragma unroll
        for (int j = 0; j < 4; ++j) { u32x2 o; o.x = pk2(v[j].x * rs, v[j].y * rs); o.y = pk2(v[j].z * rs, v[j].w * rs); o8[64 * j] = o; }
#pragma unroll
        for (int j = 0; j < 4; ++j) v[j] = nx[j];
      } }
    for (int r4 = gw; r4 < NB_S * PAST / 4; r4 += NGW) {
        f32x4 v[4];
#pragma unroll
        for (int j = 0; j < 4; ++j) v[j] = ((const f32x4*)(a.in[2] + (size_t)(4 * r4 + j) * 256))[lane];
#pragma unroll
        for (int j = 0; j < 4; ++j) { const int rix = 4 * r4 + j, b = rix >> 10, p = rix & 1023; u32x2 o; o.x = pk2(v[j].x, v[j].y); o.y = pk2(v[j].z, v[j].w);
            ((u32x2*)((bf16*)(ws + WS_KBS) + ((size_t)b * LS + p) * 256))[lane] = o; }
    }
    for (int r4 = gw; r4 < NB_S * PAST / 4; r4 += NGW) {
        const int rix = r4 * 4 + (lane >> 4), b = rix >> 10, p = rix & 1023; const f32x4 v = ((const f32x4*)(a.in[4] + (size_t)rix * 64))[lane & 15];
        u32x2 o; o.x = pk2(v.x, v.y); o.y = pk2(v.z, v.w); ((u32x2*)((bf16*)(ws + WS_KIS) + ((size_t)b * LS + p) * 64))[lane & 15] = o;
    }
    for (int it = gw; it < NB_S * 4 * 16; it += NGW) {
        const int kb = it & 15, g = (it >> 4) & 3, b = it >> 6;
        const float* src = a.in[3] + ((size_t)b * PAST + kb * 64) * 256 + g * 64;
#pragma unroll 8
        for (int i = 0; i < 64; ++i) scr[i * 65 + lane] = src[(size_t)i * 256 + lane];
        __builtin_amdgcn_s_waitcnt(0xC07F); asm volatile("" ::: "memory");
        bf16* dst = (bf16*)(ws + WS_VTS) + ((size_t)(b * 4 + g) * 64) * LS + kb * 64 + lane;
#pragma unroll 8
        for (int d = 0; d < 64; ++d) dst[(size_t)d * LS] = (bf16)f2bf(scr[lane * 65 + d]);
        __builtin_amdgcn_s_waitcnt(0xC07F); asm volatile("" ::: "memory");
    }
}

__device__ __forceinline__ void p2_post(const Args& a, unsigned char* lds, int tid) {
    unsigned char* ws = a.ws; float* out = a.out;
    const bf16* ZR = (const bf16*)(ws + WS_ZR); const bf16* ZS = (const bf16*)(ws + WS_ZS);
    bf16* Q = (bf16*)(out + SC_Q); bf16* QI = (bf16*)(out + SC_QI);
    float* cs = (float*)lds;
    bf16* vt = (bf16*)(lds + 4096);
    const int g8 = tid >> 3, sub = tid & 7;
    const float* qg = a.in[9]; const float* kg = a.in[10]; const float* lng = a.in[11]; const float* lnb = a.in[12];
    for (int unit = blockIdx.x; unit < 2 * (MT / 64); unit += gridDim.x) {
        const int tile = unit >> 1, part = unit & 1, hb0 = part ? 12 : 0, hb1 = part ? 25 : 12;
        const int m0 = tile * 64;
        { const int m = m0 + g8, pos = (m < MP) ? (m & (T_P - 1)) : (PAST + ((m - MP) & (T_S - 1)));
          const float inv = powf(500000.0f, -(float)sub * 0.125f); const float ang = (float)pos * inv; float s, c; sincosf(ang, &s, &c);
          cs[g8 * 16 + sub] = c; cs[g8 * 16 + 8 + sub] = s; }
        __syncthreads();
        const int m = m0 + g8;
        const bool isp = m < MP; const int ms = m - MP;
        float cc[8], ss[8];
#pragma unroll
        for (int j = 0; j < 8; ++j) { cc[j] = cs[g8 * 16 + j]; ss[j] = cs[g8 * 16 + 8 + j]; }
        const size_t kvrow = isp ? (size_t)m : ((size_t)(ms >> 5) * LS + PAST + (ms & 31));
        bf16* KB = (bf16*)(ws + (isp ? WS_KBP : WS_KBS)); bf16* KIb = (bf16*)(ws + (isp ? WS_KIP : WS_KIS));
        u32x4 xnext = *(const u32x4*)(ZR + (size_t)m * ZRW + hb0 * 64 + 8 * sub);
        for (int hb = hb0; hb < hb1; ++hb) {
            float x[8]; unpack8(xnext, x);
            if (hb + 1 < hb1) xnext = *(const u32x4*)(ZR + (size_t)m * ZRW + (hb + 1) * 64 + 8 * sub);
            if (hb < 12) {
                float s2 = 0.f;
#pragma unroll
                for (int j = 0; j < 8; ++j) s2 += x[j] * x[j];
                s2 += __shfl_xor(s2, 1); s2 += __shfl_xor(s2, 2); s2 += __shfl_xor(s2, 4);
                const float rinv = rsqrtf(s2 * (1.f / 64.f) + 1e-6f); const float* gn = (hb < 8 ? qg : kg) + 8 * sub;
                float y[8], o[8];
#pragma unroll
                for (int j = 0; j < 8; ++j) y[j] = x[j] * rinv * gn[j];
#pragma unroll
                for (int j = 0; j < 8; ++j) { const float p = __shfl_xor(y[j], 1); o[j] = sub == 0 ? y[j] * cc[j] - p * ss[j] : (sub == 1 ? y[j] * cc[j] + p * ss[j] : y[j]); }
                if (hb < 8) {
#pragma unroll
                    for (int j = 0; j < 8; ++j) o[j] *= QSCALE;
                    *(u32x4*)(Q + (size_t)m * 512 + hb * 64 + 8 * sub) = pack8(o);
                } else { const int g = hb - 8;
                    float* ko = out + (isp ? OFF_KP + (size_t)m * 256 : OFF_KS + (size_t)ms * 256) + g * 64 + 8 * sub;
                    *(f32x4*)ko = (f32x4){o[0], o[1], o[2], o[3]}; *(f32x4*)(ko + 4) = (f32x4){o[4], o[5], o[6], o[7]};
                    *(u32x4*)(KB + kvrow * 256 + g * 64 + 8 * sub) = pack8(o); }
            } else if (hb < 16) { const int g = hb - 12;
                float* vo = out + (isp ? OFF_VP + (size_t)m * 256 : OFF_VS + (size_t)ms * 256) + g * 64 + 8 * sub;
                *(f32x4*)vo = (f32x4){x[0], x[1], x[2], x[3]}; *(f32x4*)(vo + 4) = (f32x4){x[4], x[5], x[6], x[7]};
                unsigned* vd = (unsigned*)(vt + g8 * 258 + g * 64 + 8 * sub);
                vd[0] = pk2(x[0], x[1]); vd[1] = pk2(x[2], x[3]); vd[2] = pk2(x[4], x[5]); vd[3] = pk2(x[6], x[7]);
            } else if (hb < 24) {
                float o[8];
#pragma unroll
                for (int j = 0; j < 8; ++j) { const float p = __shfl_xor(x[j], 1); o[j] = sub == 0 ? x[j] * cc[j] - p * ss[j] : (sub == 1 ? x[j] * cc[j] + p * ss[j] : x[j]); }
                *(u32x4*)(QI + (size_t)m * 512 + (hb - 16) * 64 + 8 * sub) = pack8(o);
            } else {
                float s1 = 0.f;
#pragma unroll
                for (int j = 0; j < 8; ++j) s1 += x[j];
                s1 += __shfl_xor(s1, 1); s1 += __shfl_xor(s1, 2); s1 += __shfl_xor(s1, 4);
                const float mu = s1 * (1.f / 64.f); float s2 = 0.f;
#pragma unroll
                for (int j = 0; j < 8; ++j) { const float d = x[j] - mu; s2 += d * d; }
                s2 += __shfl_xor(s2, 1); s2 += __shfl_xor(s2, 2); s2 += __shfl_xor(s2, 4);
                const float rinv = rsqrtf(s2 * (1.f / 64.f) + 1e-6f); float y[8], o[8];
#pragma unroll
                for (int j = 0; j < 8; ++j) y[j] = (x[j] - mu) * rinv * lng[8 * sub + j] + lnb[8 * sub + j];
#pragma unroll
                for (int j = 0; j < 8; ++j) { const float p = __shfl_xor(y[j], 1); o[j] = sub == 0 ? y[j] * cc[j] - p * ss[j] : (sub == 1 ? y[j] * cc[j] + p * ss[j] : y[j]); }
                float* ko = out + (isp ? OFF_KIP + (size_t)m * 64 : OFF_KIS + (size_t)ms * 64) + 8 * sub;
                *(f32x4*)ko = (f32x4){o[0], o[1], o[2], o[3]}; *(f32x4*)(ko + 4) = (f32x4){o[4], o[5], o[6], o[7]};
                *(u32x4*)(KIb + kvrow * 64 + 8 * sub) = pack8(o);
            }
        }
        if (part == 0) ((float*)(ws + WS_WI))[(size_t)m * 8 + sub] = bf1(ZR[(size_t)m * ZRW + 1600 + sub]) * WISCALE;
        __syncthreads();
        if (part == 1) { const int r = tid >> 1, half = tid & 1; unsigned wv[16];
#pragma unroll
          for (int j = 0; j < 16; ++j) wv[j] = (unsigned)vt[(32 * half + 2 * j) * 258 + r] | ((unsigned)vt[(32 * half + 2 * j + 1) * 258 + r] << 16);
          bf16* dst;
          if (m0 < MP) dst = (bf16*)(ws + WS_VTP) + ((size_t)(m0 >> 11) * 256 + r) * T_P + (m0 & (T_P - 1)) + 32 * half;
          else { const int b = ((m0 - MP) >> 5) + half; dst = (bf16*)(ws + WS_VTS) + ((size_t)b * 256 + r) * LS + PAST; }
#pragma unroll
          for (int j = 0; j < 4; ++j) ((u32x4*)dst)[j] = (u32x4){wv[4 * j], wv[4 * j + 1], wv[4 * j + 2], wv[4 * j + 3]}; }
        if (part == 0) {} else if (m0 < MP) { if ((m0 & (T_P - 1)) == T_P - 64) { const int b = m0 >> 11; const bf16* zr = ZS + (size_t)(m0 + 63) * SHIFTW;
                for (int c = tid; c < SHIFTW; c += 512) out[OFF_SHP + (size_t)b * SHIFTW + c] = bf1(zr[c]); } }
        else { for (int h2 = 0; h2 < 2; ++h2) { const int b = ((m0 - MP) >> 5) + h2; const bf16* zr = ZS + (size_t)(m0 + 32 * h2 + 31) * SHIFTW;
                for (int c = tid; c < SHIFTW; c += 512) out[OFF_SHS + (size_t)b * SHIFTW + c] = bf1(zr[c]); } }
        __syncthreads();
    }
}

constexpr int ATT_UNITS = 544;
constexpr int MASK_PITCH = 65;
#define MFMA32(a, b, c) __builtin_amdgcn_mfma_f32_32x32x16_bf16((a), (b), (c), 0, 0, 0)

__device__ __forceinline__ float half_sum32(float v) { v += __shfl_xor(v, 1); v += __shfl_xor(v, 2); v += __shfl_xor(v, 4); v += __shfl_xor(v, 8); v += __shfl_xor(v, 16); return v; }
__device__ __forceinline__ float half_min32(float v) { v = fminf(v, __shfl_xor(v, 1)); v = fminf(v, __shfl_xor(v, 2)); v = fminf(v, __shfl_xor(v, 4)); v = fminf(v, __shfl_xor(v, 8)); v = fminf(v, __shfl_xor(v, 16)); return v; }
__device__ __forceinline__ float half_max32(float v) { v = fmaxf(v, __shfl_xor(v, 1)); v = fmaxf(v, __shfl_xor(v, 2)); v = fmaxf(v, __shfl_xor(v, 4)); v = fmaxf(v, __shfl_xor(v, 8)); v = fmaxf(v, __shfl_xor(v, 16)); return v; }
__device__ __forceinline__ int half_sum32i(int v) { v += __shfl_xor(v, 1); v += __shfl_xor(v, 2); v += __shfl_xor(v, 4); v += __shfl_xor(v, 8); v += __shfl_xor(v, 16); return v; }

#define LAS3 __attribute__((address_space(3)))
constexpr int A_RING1 = 0, A_SCL = 24576, A_RING2 = 24576, A_MASK = 0, A_LSUM = 8320, A_UNIT = 9344;
__device__ __forceinline__ void p3_attention(const Args& a, unsigned char* lds, int tid, int rep) {
    unsigned char* ws = a.ws; float* out = a.out;
    const bf16* Q = (const bf16*)(out + SC_Q); const bf16* QI = (const bf16*)(out + SC_QI); const float* WI = (const float*)(ws + WS_WI);
    bf16* O = (bf16*)(ws + WS_XB);
    unsigned* maskw = (unsigned*)(lds + A_MASK);
    float* lsum = (float*)(lds + A_LSUM);
    int* s_unit = (int*)(lds + A_UNIT);
    typedef float f32x2_t __attribute__((ext_vector_type(2)));
    f32x2_t* scl = (f32x2_t*)(lds + A_SCL) + (size_t)(tid >> 6) * 2048 + (tid & 63);
    unsigned* qctr = (unsigned*)(ws + WS_CTL) + CW_QATT + 64 * rep;
    const int l = tid & 63, w = __builtin_amdgcn_readfirstlane(tid >> 6), rho = l & 31, hi = l >> 5;
    LAS3 unsigned char* ldsb = (LAS3 unsigned char*)lds;
    for (;;) {
        if (tid == 0) *s_unit = (int)atomicAdd(qctr, 1u);
        __syncthreads();
        const int p = *s_unit;
        __syncthreads();
        if (p >= ATT_UNITS) break;
        int m0, nkt, vpitch; const bf16 *KB, *VT, *KI; bool need_idx;
        { int c = -1, b, half = 0;
          if (p < 256) { c = 31 - (p >> 4); b = (p & 15) >> 1; half = p & 1; }
          else if (p < 288) { b = p - 256; }
          else { const int pp = p - 288; c = 15 - (pp >> 4); b = (pp & 15) >> 1; half = pp & 1; }
          if (c >= 0) { m0 = b * T_P + 64 * c + 32 * half; nkt = 2 * (c + 1); vpitch = T_P; need_idx = c >= 4;
              KB = (const bf16*)(ws + WS_KBP) + (size_t)b * T_P * 256; VT = (const bf16*)(ws + WS_VTP) + (size_t)b * 256 * T_P; KI = (const bf16*)(ws + WS_KIP) + (size_t)b * T_P * 64; }
          else { m0 = MP + 32 * b; nkt = LS / 32; vpitch = LS; need_idx = true;
              KB = (const bf16*)(ws + WS_KBS) + (size_t)b * LS * 256; VT = (const bf16*)(ws + WS_VTS) + (size_t)b * 256 * LS; KI = (const bf16*)(ws + WS_KIS) + (size_t)b * LS * 64; } }
        if (need_idx) {
            const int tokA = 4 * w + 2 * ((rho >> 2) & 1) + (rho >> 4), headA = (rho & 3) + 4 * ((rho >> 3) & 1);
            bf16x8 qa[4];
#pragma unroll
            for (int ks = 0; ks < 4; ++ks) qa[ks] = *(const bf16x8*)(QI + (size_t)(m0 + tokA) * 512 + headA * 64 + 16 * ks + 8 * hi);
            float wv[16];
#pragma unroll
            for (int r = 0; r < 16; ++r) wv[r] = WI[(size_t)(m0 + 4 * w + 2 * hi + (r >> 3)) * 8 + (r & 7)];
            asm volatile("" :: "v"(qa[0]), "v"(qa[1]), "v"(qa[2]), "v"(qa[3]));
#pragma unroll
            for (int r = 0; r < 16; ++r) asm volatile("" :: "v"(wv[r]));
            asm volatile("s_waitcnt vmcnt(0)" ::: "memory");
            float sc0[32], sc1[32];
            const int nb = (nkt + 1) >> 1;
            const int sr = 8 * w + (l >> 3), scn = (l & 7) ^ ((sr >> 1) & 7);
            const unsigned char* ksrc = (const unsigned char*)KI + (size_t)sr * 128 + 16 * scn;
#define KI_STAGE(it_) __builtin_amdgcn_global_load_lds((const unsigned*)(ksrc + (size_t)(it_) * 8192), (LAS3 unsigned*)(ldsb + A_RING1 + ((it_) % 3) * 8192 + w * 1024), 16, 0, 0)
            for (int rp1 = 0; rp1 <= PROBE_A1; ++rp1) {
            if (rp1) __syncthreads();
            KI_STAGE(0); if (1 < nb) KI_STAGE(1);
#pragma unroll
            for (int it = 0; it < 32; ++it) {
                if (it < nb) {
                    if (it + 1 < nb) asm volatile("s_waitcnt vmcnt(1) lgkmcnt(0)\n\ts_barrier" ::: "memory"); else asm volatile("s_waitcnt vmcnt(0) lgkmcnt(0)\n\ts_barrier" ::: "memory");
                    if (it + 2 < nb) KI_STAGE(it + 2);
                    const unsigned char* tb = lds + A_RING1 + (it % 3) * 8192;
#pragma unroll
                    for (int k2 = 0; k2 < 2; ++k2) { const int kt = 2 * it + k2;
                        if (kt < nkt) {
                            const int r = 32 * k2 + rho; const unsigned char* rowp = tb + r * 128; const int sw = (r >> 1) & 7;
                            f32x16 acc = {0.f, 0.f, 0.f, 0.f, 0.f, 0.f, 0.f, 0.f, 0.f, 0.f, 0.f, 0.f, 0.f, 0.f, 0.f, 0.f};
#pragma unroll
                            for (int ks = 0; ks < 4; ++ks) acc = MFMA32(qa[ks], *(const bf16x8*)(rowp + 16 * ((2 * ks + hi) ^ sw)), acc);
                            float s0 = 0.f, s1 = 0.f;
#pragma unroll
                            for (int r2 = 0; r2 < 8; ++r2) { s0 += wv[r2] * fmaxf(acc[r2], 0.f); s1 += wv[8 + r2] * fmaxf(acc[8 + r2], 0.f); }
                            if (kt < 32) { sc0[kt & 31] = s0; sc1[kt & 31] = s1; } else scl[(kt - 32) * 64] = (f32x2_t){s0, s1};
                        } else if (kt < 32) { sc0[kt & 31] = -3.0e38f; sc1[kt & 31] = -3.0e38f; }
                    }
                } else { if (2 * it < 32) { sc0[(2 * it) & 31] = -3.0e38f; sc1[(2 * it) & 31] = -3.0e38f; sc0[(2 * it + 1) & 31] = -3.0e38f; sc1[(2 * it + 1) & 31] = -3.0e38f; } }
            }
            }
#undef KI_STAGE
            __syncthreads();
            float mn0 = 3.0e38f, mx0 = -3.0e38f, mn1 = 3.0e38f, mx1 = -3.0e38f; int cp0 = 0, cz0 = 0, cp1 = 0, cz1 = 0;
#pragma unroll
            for (int kt = 0; kt < 64; ++kt) if (kt < nkt) { float v0, v1; if (kt < 32) { v0 = sc0[kt & 31]; v1 = sc1[kt & 31]; } else { const f32x2_t t2 = scl[(kt - 32) * 64]; v0 = t2.x; v1 = t2.y; }
                mn0 = fminf(mn0, v0); mx0 = fmaxf(mx0, v0); mn1 = fminf(mn1, v1); mx1 = fmaxf(mx1, v1);
                cp0 += v0 > 0.f ? 1 : 0; cz0 += v0 == 0.f ? 1 : 0; cp1 += v1 > 0.f ? 1 : 0; cz1 += v1 == 0.f ? 1 : 0; }
            mn0 = half_min32(mn0); mx0 = half_max32(mx0); mn1 = half_min32(mn1); mx1 = half_max32(mx1);
            cp0 = half_sum32i(cp0); cz0 = half_sum32i(cz0); cp1 = half_sum32i(cp1); cz1 = half_sum32i(cz1);
            float lo0, hi0, lo1, hi1, thr0 = 0.f, thr1 = 0.f; int ch0, ch1, nt0 = 0, nt1 = 0; bool fin0, fin1;
            for (int rp2 = 0; rp2 <= PROBE_A2; ++rp2) {
            fin0 = false; fin1 = false; ch0 = 0; ch1 = 0;
            if (cp0 >= 256) { lo0 = 0.f; hi0 = mx0; if (cp0 == 256) { fin0 = true; thr0 = 0.f; nt0 = 0; } }
            else if (cp0 + cz0 >= 256) { lo0 = 0.f; hi0 = 0.f; fin0 = true; thr0 = 0.f; nt0 = 256 - cp0; }
            else { lo0 = mn0 - 1.0f; hi0 = 0.f; ch0 = cp0; }
            if (cp1 >= 256) { lo1 = 0.f; hi1 = mx1; if (cp1 == 256) { fin1 = true; thr1 = 0.f; nt1 = 0; } }
            else if (cp1 + cz1 >= 256) { lo1 = 0.f; hi1 = 0.f; fin1 = true; thr1 = 0.f; nt1 = 256 - cp1; }
            else { lo1 = mn1 - 1.0f; hi1 = 0.f; ch1 = cp1; }
            asm volatile("" : "+v"(lo0), "+v"(lo1));
            for (int iter = 0; iter < 64; ++iter) {
                const float mid0 = lo0 + 0.5f * (hi0 - lo0), mid1 = lo1 + 0.5f * (hi1 - lo1);
                int c0 = 0, c1 = 0;
#pragma unroll
                for (int g = 0; g < 4; ++g) if (8 * g < nkt) {
#pragma unroll
                    for (int k8 = 0; k8 < 8; ++k8) { c0 += sc0[8 * g + k8] > mid0 ? 1 : 0; c1 += sc1[8 * g + k8] > mid1 ? 1 : 0; } }
                for (int kt = 32; kt < nkt; kt += 8) {
                    f32x2_t t8[8];
#pragma unroll
                    for (int u = 0; u < 8; ++u) t8[u] = scl[(kt + u - 32) * 64];
#pragma unroll
                    for (int u = 0; u < 8; ++u) if (kt + u < nkt) { c0 += t8[u].x > mid0 ? 1 : 0; c1 += t8[u].y > mid1 ? 1 : 0; } }
                c0 = half_sum32i(c0); c1 = half_sum32i(c1);
                if (!fin0) { if (!(mid0 > lo0 && mid0 < hi0)) { fin0 = true; thr0 = hi0; nt0 = 256 - ch0; }
                             else if (c0 == 256) { fin0 = true; thr0 = mid0; nt0 = 0; } else if (c0 > 256) lo0 = mid0; else { hi0 = mid0; ch0 = c0; } }
                if (!fin1) { if (!(mid1 > lo1 && mid1 < hi1)) { fin1 = true; thr1 = hi1; nt1 = 256 - ch1; }
                             else if (c1 == 256) { fin1 = true; thr1 = mid1; nt1 = 0; } else if (c1 > 256) lo1 = mid1; else { hi1 = mid1; ch1 = c1; } }
                if (__all(fin0 && fin1)) break;
            }
            }
            const bool any_tie = __any(nt0 > 0 || nt1 > 0);
            int run0 = 0, run1 = 0; const unsigned below = (1u << rho) - 1u;
#pragma unroll
            for (int kt = 0; kt < 64; ++kt) if (kt < nkt) {
                float v0, v1; if (kt < 32) { v0 = sc0[kt & 31]; v1 = sc1[kt & 31]; } else { const f32x2_t t2 = scl[(kt - 32) * 64]; v0 = t2.x; v1 = t2.y; }
                bool p0 = v0 > thr0, p1 = v1 > thr1;
                if (any_tie) {
                    const bool e0 = nt0 > 0 && v0 == thr0, e1 = nt1 > 0 && v1 == thr1;
                    const unsigned long long be0 = __ballot(e0), be1 = __ballot(e1);
                    const unsigned h0 = (unsigned)(be0 >> (32 * hi)), h1 = (unsigned)(be1 >> (32 * hi));
                    p0 = p0 || (e0 && (run0 + __popc(h0 & below)) < nt0); p1 = p1 || (e1 && (run1 + __popc(h1 & below)) < nt1);
                    run0 += __popc(h0); run1 += __popc(h1);
                }
                const unsigned long long b0 = __ballot(p0), b1 = __ballot(p1);
                if (l == 0) { maskw[(4 * w + 0) * MASK_PITCH + kt] = (unsigned)b0; maskw[(4 * w + 1) * MASK_PITCH + kt] = (unsigned)b1; }
                if (l == 32) { maskw[(4 * w + 2) * MASK_PITCH + kt] = (unsigned)(b0 >> 32); maskw[(4 * w + 3) * MASK_PITCH + kt] = (unsigned)(b1 >> 32); }
            }
        }
        __syncthreads();
        {
            const int g = w >> 1;
            bf16x8 qb[4];
#pragma unroll
            for (int ks = 0; ks < 4; ++ks) qb[ks] = *(const bf16x8*)(Q + (size_t)(m0 + rho) * 512 + w * 64 + 16 * ks + 8 * hi);
            asm volatile("" :: "v"(qb[0]), "v"(qb[1]), "v"(qb[2]), "v"(qb[3]));
            asm volatile("s_waitcnt vmcnt(0)" ::: "memory");
            const unsigned char* ksrc[2]; const unsigned char* vsrc[2];
#pragma unroll
            for (int k = 0; k < 2; ++k) { const int i = (k * 8 + w) * 64 + l; const int r = i >> 5, c = i & 31; ksrc[k] = (const unsigned char*)KB + (size_t)r * 512 + 16 * (c ^ (r & 15));
                const int R = i >> 2, cv = i & 3; vsrc[k] = (const unsigned char*)VT + (size_t)R * vpitch * 2 + 16 * (cv ^ ((R >> 2) & 3)); }
#define KV_STAGE(t_) do { const int bo_ = A_RING2 + ((t_) % 3) * 32768 + w * 1024; \
            __builtin_amdgcn_global_load_lds((const unsigned*)(ksrc[0] + (size_t)(t_) * 16384), (LAS3 unsigned*)(ldsb + bo_), 16, 0, 0); \
            __builtin_amdgcn_global_load_lds((const unsigned*)(ksrc[1] + (size_t)(t_) * 16384), (LAS3 unsigned*)(ldsb + bo_ + 8192), 16, 0, 0); \
            __builtin_amdgcn_global_load_lds((const unsigned*)(vsrc[0] + (size_t)(t_) * 64), (LAS3 unsigned*)(ldsb + bo_ + 16384), 16, 0, 0); \
            __builtin_amdgcn_global_load_lds((const unsigned*)(vsrc[1] + (size_t)(t_) * 64), (LAS3 unsigned*)(ldsb + bo_ + 24576), 16, 0, 0); } while (0)
            f32x16 o0 = {0.f, 0.f, 0.f, 0.f, 0.f, 0.f, 0.f, 0.f, 0.f, 0.f, 0.f, 0.f, 0.f, 0.f, 0.f, 0.f}, o1 = o0; float psum = 0.f;
            const int ksw = rho & 15;
            const int vR0 = g * 64 + rho, vR1 = vR0 + 32; const int vs0 = (vR0 >> 2) & 3, vs1 = (vR1 >> 2) & 3;
            for (int rp3 = 0; rp3 <= PROBE_A3; ++rp3) {
            if (rp3) __syncthreads();
            KV_STAGE(0); if (1 < nkt) KV_STAGE(1);
            for (int kt = 0; kt < nkt; ++kt) {
                if (kt + 1 < nkt) asm volatile("s_waitcnt vmcnt(4) lgkmcnt(0)\n\ts_barrier" ::: "memory"); else asm volatile("s_waitcnt vmcnt(0) lgkmcnt(0)\n\ts_barrier" ::: "memory");
                if (kt + 2 < nkt) KV_STAGE(kt + 2);
                const unsigned char* kbuf = lds + A_RING2 + (kt % 3) * 32768; const unsigned char* vbuf = kbuf + 16384;
                f32x16 st = {0.f, 0.f, 0.f, 0.f, 0.f, 0.f, 0.f, 0.f, 0.f, 0.f, 0.f, 0.f, 0.f, 0.f, 0.f, 0.f};
#pragma unroll
                for (int ks = 0; ks < 4; ++ks) st = MFMA32(*(const bf16x8*)(kbuf + rho * 512 + 16 * ((g * 8 + 2 * ks + hi) ^ ksw)), qb[ks], st);
                unsigned word = need_idx ? maskw[rho * MASK_PITCH + kt] : 0xffffffffu; word >>= 4 * hi; float pr[16];
#pragma unroll
                for (int r = 0; r < 16; ++r) { const float e = __builtin_amdgcn_exp2f(st[r]); pr[r] = ((word >> ((r & 3) + 8 * (r >> 2))) & 1u) ? e : 0.f; psum += pr[r]; }
                union { u32x4 u; bf16x8 v; } pa0, pa1; pa0.u = (u32x4){pg8::cvt_pk_bf16(pr[0], pr[1]), pg8::cvt_pk_bf16(pr[2], pr[3]), pg8::cvt_pk_bf16(pr[4], pr[5]), pg8::cvt_pk_bf16(pr[6], pr[7])}; pa1.u = (u32x4){pg8::cvt_pk_bf16(pr[8], pr[9]), pg8::cvt_pk_bf16(pr[10], pr[11]), pg8::cvt_pk_bf16(pr[12], pr[13]), pg8::cvt_pk_bf16(pr[14], pr[15])};
                union { u32x4 u; bf16x8 v; } vf[2][2];
#pragma unroll
                for (int s2 = 0; s2 < 2; ++s2) { const unsigned char* r0 = vbuf + vR0 * 64 + 8 * hi; const unsigned char* r1 = vbuf + vR1 * 64 + 8 * hi;
                    const u32x2 a0 = *(const u32x2*)(r0 + 16 * ((2 * s2) ^ vs0)), a1 = *(const u32x2*)(r0 + 16 * ((2 * s2 + 1) ^ vs0)), b0 = *(const u32x2*)(r1 + 16 * ((2 * s2) ^ vs1)), b1 = *(const u32x2*)(r1 + 16 * ((2 * s2 + 1) ^ vs1));
                    vf[s2][0].u = (u32x4){a0.x, a0.y, a1.x, a1.y}; vf[s2][1].u = (u32x4){b0.x, b0.y, b1.x, b1.y}; }
                o0 = MFMA32(pa0.v, vf[0][0].v, o0); o0 = MFMA32(pa1.v, vf[1][0].v, o0); o1 = MFMA32(pa0.v, vf[0][1].v, o1); o1 = MFMA32(pa1.v, vf[1][1].v, o1);
            }
            }
#undef KV_STAGE
            psum += __shfl_xor(psum, 32);
            if (hi == 0) lsum[w * 32 + rho] = psum;
            __syncthreads();
#pragma unroll
            for (int r = 0; r < 16; ++r) { const int qr = crow(r, hi); const float inv = 1.0f / lsum[w * 32 + qr];
                bf16* op = O + (size_t)(m0 + qr) * DM + w * 64 + rho;
                op[0] = (bf16)f2bf(o0[r] * inv); op[32] = (bf16)f2bf(o1[r] * inv); }
        }
        __syncthreads();
    }
}

constexpr int XS_PITCH = 168;
__device__ __forceinline__ void p4_rwkv_prep(const Args& a, unsigned char* lds, int tid) {
    unsigned char* ws = a.ws; float* out = a.out;
    const bf16* ZS = (const bf16*)(ws + WS_ZS);
    const bf16* w2t = (const bf16*)(ws + WS_W2T); const bf16* a2t = (const bf16*)(ws + WS_A2T); const bf16* g2t = (const bf16*)(ws + WS_G2T);
    float* OW = (float*)(ws + WS_OW); bf16* OKK = (bf16*)(ws + WS_OKK); bf16* OB = (bf16*)(ws + WS_OB); bf16* OKM = (bf16*)(ws + WS_OKM); bf16* OR_ = (bf16*)(ws + WS_OR); bf16* OV = (bf16*)(ws + WS_OV);
    bf16* G = (bf16*)(out + SC_G); float* BON = (float*)(ws + WS_BONUS);
    const float* mu = a.in[13]; const float* w0 = a.in[14]; const float* a0 = a.in[16]; const float* k_k = a.in[19]; const float* k_a = a.in[20]; const float* r_k = a.in[21]; const float* sh0 = a.in[6];
    bf16* xs = (bf16*)lds;
    const int l = tid & 63, h = __builtin_amdgcn_readfirstlane(tid >> 6), rho = l & 31, hi = l >> 5;
    constexpr int ZP = 3408;
    unsigned char* zt = lds + 16384;
    for (int tile = blockIdx.x; tile < MT / 32; tile += gridDim.x) {
        const int m0 = tile * 32; const bool smp = m0 >= MP;
        const bool tile_first = smp || (m0 & (T_P - 1)) == 0;
        for (int i0 = tid; i0 < 33 * 212; i0 += 4 * 512) {
            u32x4 v[4];
#pragma unroll
            for (int j = 0; j < 4; ++j) { const int idx = i0 + j * 512; if (idx < 33 * 212) { const int r = idx / 212, c = idx - r * 212;
                    if (r == 0 && tile_first) { if (smp) { const float* sp = sh0 + (size_t)((m0 - MP) >> 5) * SHIFTW + 8 * c; const f32x4 a4 = *(const f32x4*)sp, b4 = *(const f32x4*)(sp + 4);
                            v[j] = (u32x4){pk2(a4.x, a4.y), pk2(a4.z, a4.w), pk2(b4.x, b4.y), pk2(b4.z, b4.w)}; } else v[j] = (u32x4){0u, 0u, 0u, 0u}; }
                    else v[j] = *(const u32x4*)(ZS + (size_t)(m0 + r - 1) * SHIFTW + 8 * c); } }
#pragma unroll
            for (int j = 0; j < 4; ++j) { const int idx = i0 + j * 512; if (idx < 33 * 212) { const int r = idx / 212, c = idx - r * 212; *(u32x4*)(zt + r * ZP + 16 * c) = v[j]; } }
        }
        __syncthreads();
        { const int tk = tid >> 4, c0 = (tid & 15) * 10;
          const bf16* zc = (const bf16*)(zt + (tk + 1) * ZP) + 1536 + c0; const bf16* zp = (const bf16*)(zt + tk * ZP) + 1536 + c0;
#pragma unroll
          for (int e = 0; e < 10; ++e) { const int c = c0 + e; const float cur = bf1(zc[e]); const float prev = bf1(zp[e]);
              const float zm = cur + mu[1536 + c] * (prev - cur);
              const float f = __frcp_rn(1.0f + __expf(c < 32 ? -2.0f * zm : -zm));
              const float v = c < 32 ? 2.0f * f - 1.0f : (c < 64 ? zm : f);
              xs[tk * XS_PITCH + c] = (bf16)f2bf(v); } }
        __syncthreads();
        const int m = m0 + rho;
        const bf16* zc = (const bf16*)(zt + (rho + 1) * ZP) + 64 * h + 4 * hi; const bf16* zp = (const bf16*)(zt + rho * ZP) + 64 * h + 4 * hi;
        const float* mu_l = mu + 64 * h + 4 * hi;
        const int pofs = 64 * h + 4 * hi;
#define ZMIX4(dst, co) do { const u32x2 cw = *(const u32x2*)(zc + (co)); const u32x2 pw = *(const u32x2*)(zp + (co)); const f32x4 mu4 = *(const f32x4*)(mu_l + (co)); \
            const float cu[4] = {bflo(cw.x), bfhi(cw.x), bflo(cw.y), bfhi(cw.y)}; const float pv[4] = {bflo(pw.x), bfhi(pw.x), bflo(pw.y), bfhi(pw.y)}; \
            _Pragma("unroll") for (int e = 0; e < 4; ++e) dst[e] = cu[e] + mu4[e] * (pv[e] - cu[e]); } while (0)
        float n2 = 0.f;
#pragma unroll
        for (int ct = 0; ct < 2; ++ct)
#pragma unroll
            for (int grp = 0; grp < 4; ++grp) { const int co = 32 * ct + 8 * grp; float zk[4]; ZMIX4(zk, 512 + co); const f32x4 kk4 = *(const f32x4*)(k_k + pofs + co);
#pragma unroll
                for (int e = 0; e < 4; ++e) { const float kr = zk[e] * kk4[e]; n2 += kr * kr; } }
        n2 += __shfl_xor(n2, 32);
        const float invn = 1.0f / fmaxf(sqrtf(n2), 1e-12f);
        float bon = 0.f;
        asm volatile("" ::: "memory");
#pragma unroll
        for (int ct = 0; ct < 2; ++ct) {
            const f32x16 z16 = {0.f, 0.f, 0.f, 0.f, 0.f, 0.f, 0.f, 0.f, 0.f, 0.f, 0.f, 0.f, 0.f, 0.f, 0.f, 0.f}; f32x16 Dw = z16, Da = z16, Dg = z16;
            const int n = 64 * h + 32 * ct + rho;
            const bf16* xrow = xs + rho * XS_PITCH + 8 * hi;
#pragma unroll
            for (int ks = 0; ks < 2; ++ks) {
                Dw = MFMA32(*(const bf16x8*)(w2t + n * 32 + 16 * ks + 8 * hi), *(const bf16x8*)(xrow + 16 * ks), Dw);
                Da = MFMA32(*(const bf16x8*)(a2t + n * 32 + 16 * ks + 8 * hi), *(const bf16x8*)(xrow + 32 + 16 * ks), Da); }
#pragma unroll
            for (int ks = 0; ks < 6; ++ks) Dg = MFMA32(*(const bf16x8*)(g2t + n * 96 + 16 * ks + 8 * hi), *(const bf16x8*)(xrow + 64 + 16 * ks), Dg);
#pragma unroll
            for (int grp = 0; grp < 4; ++grp) {
                const int co = 32 * ct + 8 * grp;
                float zr[4], zk[4], zv[4]; ZMIX4(zr, co); ZMIX4(zk, 512 + co); ZMIX4(zv, 1024 + co);
                const f32x4 w04 = *(const f32x4*)(w0 + pofs + co), a04 = *(const f32x4*)(a0 + pofs + co), kk4 = *(const f32x4*)(k_k + pofs + co), ka4 = *(const f32x4*)(k_a + pofs + co), rk4 = *(const f32x4*)(r_k + pofs + co);
                float dec[4], km[4], gg[4], kk[4], bb[4];
#pragma unroll
                for (int e = 0; e < 4; ++e) { const int r = 4 * grp + e;
                    const float sg = __frcp_rn(1.0f + __expf(-(w04[e] + Dw[r])));
                    dec[e] = __expf(-0.6065306597126334f * sg);
                    const float aa = __frcp_rn(1.0f + __expf(-(a04[e] + Da[r])));
                    gg[e] = Dg[r];
                    kk[e] = zk[e] * kk4[e] * invn; bb[e] = kk[e] * aa;
                    km[e] = zk[e] * (1.0f + (aa - 1.0f) * ka4[e]);
                    bon += zr[e] * km[e] * rk4[e]; }
                const size_t o = (size_t)m * 512 + pofs + co;
                *(f32x4*)(OW + o) = (f32x4){dec[0], dec[1], dec[2], dec[3]};
                *(u32x2*)(OKK + o) = (u32x2){pk2(kk[0], kk[1]), pk2(kk[2], kk[3])};
                *(u32x2*)(OB + o) = (u32x2){pk2(bb[0], bb[1]), pk2(bb[2], bb[3])};
                *(u32x2*)(OKM + o) = (u32x2){pk2(km[0], km[1]), pk2(km[2], km[3])};
                *(u32x2*)(OR_ + o) = (u32x2){pk2(zr[0], zr[1]), pk2(zr[2], zr[3])};
                *(u32x2*)(OV + o) = (u32x2){pk2(zv[0], zv[1]), pk2(zv[2], zv[3])};
                *(u32x2*)(G + o) = (u32x2){pk2(gg[0], gg[1]), pk2(gg[2], gg[3])};
                asm volatile("" ::: "memory");
            }
        }
#undef ZMIX4
        bon += __shfl_xor(bon, 32);
        if (hi == 0) BON[(size_t)m * 8 + h] = bon;
        __syncthreads();
    }
}

constexpr int WP = 144;
constexpr int WSLOT = 64 * WP;
constexpr int W_NCH = T_P / 64;
constexpr int W_UNITS = NB_P * 8 * W_NCH + NB_S * 8;
constexpr size_t WS_PM = WS_R, WS_QM = WS_R + 18 * MiB, WS_UM = WS_R + 36 * MiB, WS_Y0 = WS_R + 72 * MiB;
static_assert((size_t)W_UNITS * 8192 <= 18 * MiB && (size_t)W_UNITS * 16384 <= 36 * MiB && WS_Y0 + 36 * MiB <= WS_END, "rwkv chunk summaries fit the reusable region");
constexpr size_t SC_G2 = 0, SC_VV = (size_t)MT * 256;
constexpr int ZTP = 720;
constexpr int LWP = 68;

__device__ __forceinline__ f32x16 wy_mm(const unsigned char* A, const unsigned char* B, int mi, int ni, int rho, int hi, f32x16 acc) {
    const unsigned char* ap = A + (32 * mi + rho) * WP + 16 * hi; const unsigned char* bp = B + (32 * ni + rho) * WP + 16 * hi;
#pragma unroll
    for (int ks = 0; ks < 4; ++ks) acc = MFMA32(*(const bf16x8*)(ap + 32 * ks), *(const bf16x8*)(bp + 32 * ks), acc);
    return acc;
}
typedef float wy_f32x2 __attribute__((ext_vector_type(2))); typedef __bf16 wy_bf16x2 __attribute__((ext_vector_type(2)));
__device__ __forceinline__ unsigned wy_cvt2(float lo, float hi) { const wy_f32x2 v = {lo, hi}; const wy_bf16x2 b = __builtin_convertvector(v, wy_bf16x2); return __builtin_bit_cast(unsigned, b); }
__device__ __forceinline__ void wy_st_t(unsigned char* dst, const f32x16& a, int mi, int ni, int rho, int hi) {
#pragma unroll
    for (int q = 0; q < 4; ++q) *(u32x2*)(dst + (32 * ni + rho) * WP + 2 * (32 * mi + 8 * q + 4 * hi)) = (u32x2){wy_cvt2(a[4 * q], a[4 * q + 1]), wy_cvt2(a[4 * q + 2], a[4 * q + 3])};
}
__device__ __forceinline__ void wy_st_n(unsigned char* dst, const f32x16& a, int mi, int ni, int rho, int hi) {
#pragma unroll
    for (int r = 0; r < 16; ++r) *(bf16*)(dst + (32 * mi + crow(r, hi)) * WP + 2 * (32 * ni + rho)) = (bf16)f2bf(a[r]);
}
__device__ __forceinline__ f32x16 wy_ld_t(const unsigned char* src, int mi, int ni, int rho, int hi) {
    f32x16 a;
#pragma unroll
    for (int q = 0; q < 4; ++q) { const u32x2 w = *(const u32x2*)(src + (32 * ni + rho) * WP + 2 * (32 * mi + 8 * q + 4 * hi)); a[4 * q] = bflo(w.x); a[4 * q + 1] = bfhi(w.x); a[4 * q + 2] = bflo(w.y); a[4 * q + 3] = bfhi(w.y); }
    return a;
}
#define F16Z ((f32x16){0.f, 0.f, 0.f, 0.f, 0.f, 0.f, 0.f, 0.f, 0.f, 0.f, 0.f, 0.f, 0.f, 0.f, 0.f, 0.f})

__device__ __forceinline__ void p4w_chunks(const Args& a, unsigned char* lds, int tid) {
    unsigned char* ws = a.ws; float* out = a.out;
    const bf16* ZS = (const bf16*)(ws + WS_ZS);
    const bf16* w2t = (const bf16*)(ws + WS_W2T); const bf16* a2t = (const bf16*)(ws + WS_A2T); const bf16* g2t = (const bf16*)(ws + WS_G2T);
    bf16* G = (bf16*)(out + SC_G2); bf16* VV = (bf16*)(out + SC_VV); float* BON = (float*)(ws + WS_BONUS);
    const float* mu = a.in[13]; const float* w0 = a.in[14]; const float* a0 = a.in[16]; const float* k_k = a.in[19]; const float* k_a = a.in[20]; const float* r_k = a.in[21]; const float* sh0 = a.in[6];
    const int l = tid & 63, w = __builtin_amdgcn_readfirstlane(tid >> 6), rho = l & 31, hi = l >> 5;
#define SL(i) (lds + (i) * WSLOT)
    unsigned char* zt = SL(0);
    bf16* xs = (bf16*)SL(6);
    float* LW = (float*)SL(9);
    float* LG = (float*)SL(11);
    float* NRM = (float*)(lds + 17 * WSLOT);
    for (int unit = blockIdx.x; unit < W_UNITS; unit += gridDim.x) {
        int m0, nvalid, h; bool first; const float* shp = nullptr;
        if (unit < NB_P * 8 * W_NCH) { const int j = unit & (W_NCH - 1), sh = unit >> 5; h = sh & 7; m0 = (sh >> 3) * T_P + 64 * j; nvalid = 64; first = j == 0; }
        else { const int sh = unit - NB_P * 8 * W_NCH; h = sh & 7; m0 = MP + 32 * (sh >> 3); nvalid = 32; first = true; shp = sh0 + (size_t)(sh >> 3) * SHIFTW; }
        for (int idx = tid; idx < 65 * 44; idx += 512) { const int r = idx / 44, p = idx - r * 44;
            const int col = p < 24 ? (p >> 3) * 512 + 64 * h + 8 * (p & 7) : 1536 + 8 * (p - 24);
            u32x4 v = {0u, 0u, 0u, 0u};
            if (r == 0) { if (!first) v = *(const u32x4*)(ZS + (size_t)(m0 - 1) * SHIFTW + col);
                          else if (shp) { const f32x4 a4 = *(const f32x4*)(shp + col), b4 = *(const f32x4*)(shp + col + 4); v = (u32x4){pk2(a4.x, a4.y), pk2(a4.z, a4.w), pk2(b4.x, b4.y), pk2(b4.z, b4.w)}; } }
            else if (r <= nvalid) v = *(const u32x4*)(ZS + (size_t)(m0 + r - 1) * SHIFTW + col);
            *(u32x4*)(zt + r * ZTP + 16 * p) = v; }
        __syncthreads();
        { const int tk = tid >> 3, c0 = (tid & 7) * 20; const bf16* zc = (const bf16*)(zt + (tk + 1) * ZTP + 384) + c0; const bf16* zp = (const bf16*)(zt + tk * ZTP + 384) + c0;
#pragma unroll
          for (int e = 0; e < 20; ++e) { const int c = c0 + e; const float cur = bf1(zc[e]), prev = bf1(zp[e]); const float zm = cur + mu[1536 + c] * (prev - cur);
              const float f = __frcp_rn(1.0f + __expf(c < 32 ? -2.0f * zm : -zm)); xs[tk * XS_PITCH + c] = (bf16)f2bf(c < 32 ? 2.0f * f - 1.0f : (c < 64 ? zm : f)); } }
        __syncthreads();
        const int ct = w & 1, tt = (w >> 1) & 1, tok = 32 * tt + rho; const bool valid = tok < nvalid; const size_t m = (size_t)m0 + tok;
        const int n = 64 * h + 32 * ct + rho; const bf16* xrow = xs + tok * XS_PITCH + 8 * hi;
        const int pofs = 64 * h + 32 * ct + 4 * hi;
        const unsigned char* zcur = zt + (tok + 1) * ZTP + 2 * (32 * ct + 4 * hi); const unsigned char* zprv = zt + tok * ZTP + 2 * (32 * ct + 4 * hi);
#define WMIX4(dst, seg, q) do { const u32x2 cw = *(const u32x2*)(zcur + 128 * (seg) + 16 * (q)), pw = *(const u32x2*)(zprv + 128 * (seg) + 16 * (q)); const f32x4 mu4 = *(const f32x4*)(mu + 512 * (seg) + pofs + 8 * (q)); \
            dst[0] = bflo(cw.x) + mu4.x * (bflo(pw.x) - bflo(cw.x)); dst[1] = bfhi(cw.x) + mu4.y * (bfhi(pw.x) - bfhi(cw.x)); dst[2] = bflo(cw.y) + mu4.z * (bflo(pw.y) - bflo(cw.y)); dst[3] = bfhi(cw.y) + mu4.w * (bfhi(pw.y) - bfhi(cw.y)); } while (0)
        float ra[16], rb[16], rc[16], rd[16];
        if (w < 4) {
            f32x16 Dw = F16Z, Da = F16Z;
#pragma unroll
            for (int ks = 0; ks < 2; ++ks) { Dw = MFMA32(*(const bf16x8*)(w2t + n * 32 + 16 * ks + 8 * hi), *(const bf16x8*)(xrow + 16 * ks), Dw);
                                             Da = MFMA32(*(const bf16x8*)(a2t + n * 32 + 16 * ks + 8 * hi), *(const bf16x8*)(xrow + 32 + 16 * ks), Da); }
            float n2 = 0.f, bon = 0.f;
#pragma unroll
            for (int q = 0; q < 4; ++q) { float zr[4], zk[4]; WMIX4(zr, 0, q); WMIX4(zk, 1, q);
                const f32x4 w04 = *(const f32x4*)(w0 + pofs + 8 * q), a04 = *(const f32x4*)(a0 + pofs + 8 * q), kk4 = *(const f32x4*)(k_k + pofs + 8 * q), ka4 = *(const f32x4*)(k_a + pofs + 8 * q), rk4 = *(const f32x4*)(r_k + pofs + 8 * q);
#pragma unroll
                for (int e = 0; e < 4; ++e) { const int r = 4 * q + e;
                    const float sg = __frcp_rn(1.0f + __expf(-(w04[e] + Dw[r]))); rd[r] = valid ? -0.6065306597126334f * sg : 0.f;
                    const float aa = __frcp_rn(1.0f + __expf(-(a04[e] + Da[r]))); rb[r] = aa;
                    const float kr = valid ? zk[e] * kk4[e] : 0.f; ra[r] = kr; n2 += kr * kr;
                    const float km = valid ? zk[e] * (1.0f + (aa - 1.0f) * ka4[e]) : 0.f; rc[r] = km; bon += zr[e] * km * rk4[e]; }
                *(f32x4*)(LW + tok * LWP + 32 * ct + 8 * q + 4 * hi) = (f32x4){rd[4 * q], rd[4 * q + 1], rd[4 * q + 2], rd[4 * q + 3]}; }
            n2 += __shfl_xor(n2, 32); bon += __shfl_xor(bon, 32);
            if (hi == 0) { NRM[ct * 64 + tok] = n2; NRM[128 + ct * 64 + tok] = bon; }
        } else {
            f32x16 Dg = F16Z;
#pragma unroll
            for (int ks = 0; ks < 6; ++ks) Dg = MFMA32(*(const bf16x8*)(g2t + n * 96 + 16 * ks + 8 * hi), *(const bf16x8*)(xrow + 64 + 16 * ks), Dg);
#pragma unroll
            for (int q = 0; q < 4; ++q) { float zr[4], zv[4]; WMIX4(zr, 0, q); WMIX4(zv, 2, q);
#pragma unroll
                for (int e = 0; e < 4; ++e) { ra[4 * q + e] = valid ? zr[e] : 0.f; rb[4 * q + e] = valid ? zv[e] : 0.f; }
                if (valid) { const size_t o = m * 512 + pofs + 8 * q;
                    *(u32x2*)(G + o) = (u32x2){pk2(Dg[4 * q], Dg[4 * q + 1]), pk2(Dg[4 * q + 2], Dg[4 * q + 3])};
                    *(u32x2*)(VV + o) = (u32x2){pk2(zv[0], zv[1]), pk2(zv[2], zv[3])}; } }
        }
#undef WMIX4
        __syncthreads();
        if (w == 0) { float acc = 0.f; LG[l] = 0.f;
#pragma unroll 8
            for (int t = 0; t < 64; ++t) { acc += LW[t * LWP + l]; LG[(t + 1) * LWP + l] = acc; }
            NRM[256 + l] = __expf(acc); }
        if (w == 1 && l < 64) { const float bn = NRM[128 + l] + NRM[192 + l]; if (l < nvalid) BON[((size_t)m0 + l) * 8 + h] = bn; }
        __syncthreads();
        {
            const float* lgc = LG + (tok + 1) * LWP + 32 * ct + 4 * hi; const float* lgp = LG + tok * LWP + 32 * ct + 4 * hi; const float* lge = LG + 64 * LWP + 32 * ct + 4 * hi;
            if (w < 4) {
                const float invn = 1.0f / fmaxf(sqrtf(NRM[tok] + NRM[64 + tok]), 1e-12f);
#pragma unroll
                for (int q = 0; q < 4; ++q) { const f32x4 gc = *(const f32x4*)(lgc + 8 * q), gp = *(const f32x4*)(lgp + 8 * q), ge = *(const f32x4*)(lge + 8 * q);
                    float kt[4], bt[4], ka[4], ke[4], be[4];
#pragma unroll
                    for (int e = 0; e < 4; ++e) { const int r = 4 * q + e; const float en = __expf(-gc[e]), ep = __expf(gp[e]), ee = __expf(ge[e] - gc[e]); const float kkn = ra[r] * invn, bb = kkn * rb[r];
                        kt[e] = rc[r] * en; bt[e] = bb * en; ka[e] = kkn * ep; ke[e] = rc[r] * ee; be[e] = bb * ee; }
                    const int co = 2 * (32 * ct + 8 * q + 4 * hi);
                    *(u32x2*)(SL(0) + tok * WP + co) = (u32x2){pk2(kt[0], kt[1]), pk2(kt[2], kt[3])};
                    *(u32x2*)(SL(1) + tok * WP + co) = (u32x2){pk2(bt[0], bt[1]), pk2(bt[2], bt[3])};
                    *(u32x2*)(SL(2) + tok * WP + co) = (u32x2){pk2(ka[0], ka[1]), pk2(ka[2], ka[3])};
#pragma unroll
                    for (int e = 0; e < 4; ++e) { const int kr = 32 * ct + 8 * q + 4 * hi + e;
                        *(bf16*)(SL(4) + kr * WP + 2 * tok) = (bf16)f2bf(ka[e]); *(bf16*)(SL(5) + kr * WP + 2 * tok) = (bf16)f2bf(be[e]); *(bf16*)(SL(6) + kr * WP + 2 * tok) = (bf16)f2bf(ke[e]); } }
            } else {
#pragma unroll
                for (int q = 0; q < 4; ++q) { const f32x4 gc = *(const f32x4*)(lgc + 8 * q); float rh[4];
#pragma unroll
                    for (int e = 0; e < 4; ++e) rh[e] = ra[4 * q + e] * __expf(gc[e]);
                    *(u32x2*)(SL(3) + tok * WP + 2 * (32 * ct + 8 * q + 4 * hi)) = (u32x2){pk2(rh[0], rh[1]), pk2(rh[2], rh[3])};
#pragma unroll
                    for (int e = 0; e < 4; ++e) *(bf16*)(SL(7) + (32 * ct + 8 * q + 4 * hi + e) * WP + 2 * tok) = (bf16)f2bf(rb[4 * q + e]); }
            }
        }
        __syncthreads();
        for (int task = w; task < 16; task += 8) { const int pr = task >> 2, mi = (task >> 1) & 1, ni = task & 1;
            if (pr == 0) { f32x16 d = wy_mm(SL(1), SL(2), mi, ni, rho, hi, F16Z);
#pragma unroll
                for (int r = 0; r < 16; ++r) if (!(32 * mi + crow(r, hi) < 32 * ni + rho)) d[r] = 0.f;
                wy_st_t(SL(8), d, mi, ni, rho, hi); wy_st_n(SL(9), d, mi, ni, rho, hi); }
            else if (pr == 1) { f32x16 d = wy_mm(SL(2), SL(0), mi, ni, rho, hi, F16Z);
#pragma unroll
                for (int r = 0; r < 16; ++r) if (!(32 * ni + rho < 32 * mi + crow(r, hi))) d[r] = 0.f;
                wy_st_t(SL(10), d, mi, ni, rho, hi); }
            else if (pr == 2) { f32x16 d = wy_mm(SL(1), SL(3), mi, ni, rho, hi, F16Z);
#pragma unroll
                for (int r = 0; r < 16; ++r) if (!(32 * mi + crow(r, hi) <= 32 * ni + rho)) d[r] = 0.f;
                wy_st_t(SL(11), d, mi, ni, rho, hi); }
            else { f32x16 d = wy_mm(SL(0), SL(3), mi, ni, rho, hi, F16Z);
#pragma unroll
                for (int r = 0; r < 16; ++r) if (!(32 * mi + crow(r, hi) <= 32 * ni + rho)) d[r] = 0.f;
                wy_st_t(SL(12), d, mi, ni, rho, hi); } }
        __syncthreads();
        for (int task = w; task < 12; task += 8) { const int pr = task >> 2, mi = (task >> 1) & 1, ni = task & 1;
            if (pr == 0) { const f32x16 d = wy_mm(SL(9), SL(8), mi, ni, rho, hi, F16Z); wy_st_t(SL(13), d, mi, ni, rho, hi); }
            else if (pr == 1) { const f32x16 d = wy_mm(SL(8), SL(9), mi, ni, rho, hi, F16Z); wy_st_t(SL(14), d, mi, ni, rho, hi); }
            else { f32x16 d = wy_ld_t(SL(8), mi, ni, rho, hi);
#pragma unroll
                for (int r = 0; r < 16; ++r) d[r] = ((32 * mi + crow(r, hi)) == (32 * ni + rho) ? 1.0f : 0.f) - d[r];
                wy_st_t(SL(15), d, mi, ni, rho, hi); } }
        __syncthreads();
#pragma unroll 1
        for (int lev = 1; lev <= 5; ++lev) {
            unsigned char* Pc = SL((lev & 1) ? 15 : 16); unsigned char* Pn = SL((lev & 1) ? 16 : 15);
            unsigned char* Qr = SL((lev & 1) ? 13 : 0); unsigned char* Qx = SL((lev & 1) ? 14 : 1); unsigned char* Qr2 = SL((lev & 1) ? 0 : 13); unsigned char* Qx2 = SL((lev & 1) ? 1 : 14);
            const int ntask = lev < 5 ? 12 : 4;
            for (int task = w; task < ntask; task += 8) { const int pr = task >> 2, mi = (task >> 1) & 1, ni = task & 1;
                if (pr == 0) { f32x16 d = wy_ld_t(Pc, mi, ni, rho, hi);
                    d = wy_mm(Qx, Pc, mi, ni, rho, hi, d); wy_st_t(Pn, d, mi, ni, rho, hi); }
                else if (pr == 1) { const f32x16 d = wy_mm(Qx, Qr, mi, ni, rho, hi, F16Z); wy_st_t(Qr2, d, mi, ni, rho, hi); }
                else { const f32x16 d = wy_mm(Qr, Qx, mi, ni, rho, hi, F16Z); wy_st_t(Qx2, d, mi, ni, rho, hi); } }
            __syncthreads();
        }
        { const int pr = w >> 2, mi = (w >> 1) & 1, ni = w & 1;
          if (pr == 0) { const f32x16 d = wy_mm(SL(16), SL(10), mi, ni, rho, hi, F16Z); wy_st_t(SL(0), d, mi, ni, rho, hi); }
          else { const f32x16 d = wy_mm(SL(16), SL(4), mi, ni, rho, hi, F16Z); wy_st_t(SL(1), d, mi, ni, rho, hi); } }
        __syncthreads();
        { bf16* PMg = (bf16*)(ws + WS_PM) + (size_t)unit * 4096; bf16* QMg = (bf16*)(ws + WS_QM) + (size_t)unit * 4096;
          for (int task = w; task < 16; task += 8) { const int pr = task >> 2, mi = (task >> 1) & 1, ni = task & 1;
            if (pr == 0) { f32x16 d = wy_mm(SL(1), SL(5), mi, ni, rho, hi, F16Z);
                const float gc = NRM[256 + 32 * ni + rho];
#pragma unroll
                for (int q = 0; q < 4; ++q) { float o[4];
#pragma unroll
                    for (int e = 0; e < 4; ++e) { const int kr = 32 * mi + 8 * q + 4 * hi + e; o[e] = (kr == 32 * ni + rho ? gc : 0.f) - d[4 * q + e]; }
                    *(u32x2*)(PMg + (32 * ni + rho) * 64 + 32 * mi + 8 * q + 4 * hi) = (u32x2){pk2(o[0], o[1]), pk2(o[2], o[3])}; } }
            else if (pr == 1) { f32x16 d = wy_mm(SL(0), SL(5), mi, ni, rho, hi, F16Z);
                const f32x16 ke = wy_ld_t(SL(6), mi, ni, rho, hi);
#pragma unroll
                for (int r = 0; r < 16; ++r) d[r] = ke[r] - d[r];
                wy_st_t(SL(13), d, mi, ni, rho, hi); }
            else if (pr == 2) { f32x16 d = wy_mm(SL(1), SL(11), mi, ni, rho, hi, F16Z);
                const f32x16 rh = wy_ld_t(SL(3), mi, ni, rho, hi);
#pragma unroll
                for (int q = 0; q < 4; ++q) *(u32x2*)(QMg + (32 * ni + rho) * 64 + 32 * mi + 8 * q + 4 * hi) =
                    (u32x2){pk2(rh[4 * q] - d[4 * q], rh[4 * q + 1] - d[4 * q + 1]), pk2(rh[4 * q + 2] - d[4 * q + 2], rh[4 * q + 3] - d[4 * q + 3])}; }
            else { f32x16 d = wy_mm(SL(0), SL(11), mi, ni, rho, hi, F16Z);
                const f32x16 bk = wy_ld_t(SL(12), mi, ni, rho, hi);
#pragma unroll
                for (int r = 0; r < 16; ++r) d[r] = bk[r] - d[r];
                wy_st_t(SL(14), d, mi, ni, rho, hi); } } }
        __syncthreads();
        { float* UMg = (float*)(ws + WS_UM) + (size_t)unit * 4096; float* Y0g = (float*)(ws + WS_Y0) + (size_t)unit * 4096; const int pr = w >> 2, mi = (w >> 1) & 1, ni = w & 1;
          if (pr == 0) { const f32x16 d = wy_mm(SL(13), SL(7), mi, ni, rho, hi, F16Z);
#pragma unroll
              for (int q = 0; q < 4; ++q) *(f32x4*)(UMg + (32 * ni + rho) * 64 + 32 * mi + 8 * q + 4 * hi) = (f32x4){d[4 * q], d[4 * q + 1], d[4 * q + 2], d[4 * q + 3]}; }
          else { const f32x16 d = wy_mm(SL(7), SL(14), mi, ni, rho, hi, F16Z);
#pragma unroll
              for (int q = 0; q < 4; ++q) *(f32x4*)(Y0g + (32 * ni + rho) * 64 + 32 * mi + 8 * q + 4 * hi) = (f32x4){d[4 * q], d[4 * q + 1], d[4 * q + 2], d[4 * q + 3]}; } }
        __syncthreads();
    }
#undef SL
}

constexpr size_t WS_SB = WS_R + 108 * MiB;
static_assert(WS_SB + (size_t)W_UNITS * 8192 <= WS_END, "state snapshots fit");
__device__ __forceinline__ void p5w_chain(const Args& a, unsigned char* lds, int tid) {
    unsigned char* ws = a.ws; float* out = a.out;
    const int l = tid & 63, w = __builtin_amdgcn_readfirstlane(tid >> 6), rho = l & 31, hi = l >> 5;
    unsigned char* Sb0 = lds; unsigned char* Sb1 = lds + WSLOT; unsigned char* PMl = lds + 2 * WSLOT;
    for (int u2 = blockIdx.x; u2 < NB_P * 8 + NB_S * 8; u2 += gridDim.x) {
        const bool smp = u2 >= NB_P * 8; const int sh = smp ? u2 - NB_P * 8 : u2;
        const int nch = smp ? 1 : W_NCH, unit0 = smp ? NB_P * 8 * W_NCH + sh : sh * W_NCH;
        float* wkv = out + (smp ? OFF_WKVS : OFF_WKVP) + (size_t)sh * 4096;
        const int cr = tid >> 3, cc = (tid & 7) * 8, mi = (w >> 1) & 1, ni = w & 1;
        { float x[8];
          if (smp) { const f32x4 a4 = *(const f32x4*)(a.in[5] + (size_t)sh * 4096 + cr * 64 + cc), b4 = *(const f32x4*)(a.in[5] + (size_t)sh * 4096 + cr * 64 + cc + 4); x[0] = a4.x; x[1] = a4.y; x[2] = a4.z; x[3] = a4.w; x[4] = b4.x; x[5] = b4.y; x[6] = b4.z; x[7] = b4.w; }
          else {
#pragma unroll
              for (int e = 0; e < 8; ++e) x[e] = 0.f; }
          const u32x4 p8 = pack8(x); *(u32x4*)(Sb0 + cr * WP + 2 * cc) = p8; *(u32x4*)((bf16*)(ws + WS_SB) + (size_t)unit0 * 4096 + cr * 64 + cc) = p8; }
        u32x4 pmr = *(const u32x4*)((const bf16*)(ws + WS_PM) + (size_t)unit0 * 4096 + cr * 64 + cc);
        f32x16 ini = F16Z;
#define P5_UM(dst, j_) do { if (w < 4) { const float* um_ = (const float*)(ws + WS_UM) + ((size_t)unit0 + (j_)) * 4096 + (32 * ni + rho) * 64 + 32 * mi + 4 * hi; \
            _Pragma("unroll") for (int q = 0; q < 4; ++q) { const f32x4 x = *(const f32x4*)(um_ + 8 * q); dst[4 * q] = x.x; dst[4 * q + 1] = x.y; dst[4 * q + 2] = x.z; dst[4 * q + 3] = x.w; } } } while (0)
        P5_UM(ini, 0);
        for (int j = 0; j < nch; ++j) {
            unsigned char* Sc = (j & 1) ? Sb1 : Sb0; unsigned char* Sn = (j & 1) ? Sb0 : Sb1;
            *(u32x4*)(PMl + cr * WP + 2 * cc) = pmr;
            f32x16 d = ini;
            if (j + 1 < nch) { pmr = *(const u32x4*)((const bf16*)(ws + WS_PM) + ((size_t)unit0 + j + 1) * 4096 + cr * 64 + cc); P5_UM(ini, j + 1); }
            __syncthreads();
            if (w < 4) {
                d = wy_mm(PMl, Sc, mi, ni, rho, hi, d);
                if (j + 1 < nch) { wy_st_t(Sn, d, mi, ni, rho, hi);
                    bf16* sg = (bf16*)(ws + WS_SB) + ((size_t)unit0 + j + 1) * 4096 + (32 * ni + rho) * 64 + 32 * mi + 4 * hi;
#pragma unroll
                    for (int q = 0; q < 4; ++q) *(u32x2*)(sg + 8 * q) = (u32x2){wy_cvt2(d[4 * q], d[4 * q + 1]), wy_cvt2(d[4 * q + 2], d[4 * q + 3])}; }
                else {
#pragma unroll
                    for (int q = 0; q < 4; ++q) *(f32x4*)(wkv + (32 * ni + rho) * 64 + 32 * mi + 8 * q + 4 * hi) = (f32x4){d[4 * q], d[4 * q + 1], d[4 * q + 2], d[4 * q + 3]}; }
            }
            __syncthreads();
        }
#undef P5_UM
    }
}

__device__ __forceinline__ void p6w_out(const Args& a, int tid) {
    unsigned char* ws = a.ws; float* out = a.out;
    const bf16* G = (const bf16*)(out + SC_G2); const bf16* VV = (const bf16*)(out + SC_VV); const float* BON = (const float*)(ws + WS_BONUS); bf16* O = (bf16*)(ws + WS_XB);
    const float* lgn = a.in[22]; const float* lbn = a.in[23];
    const int l = tid & 63, rho = l & 31, hi = l >> 5;
    const int gw = blockIdx.x * 8 + (tid >> 6), NGW = gridDim.x * 8;
    for (int task = gw; task < 2 * W_UNITS; task += NGW) {
        const int unit = task >> 1, tt = task & 1; const bool smp = unit >= NB_P * 8 * W_NCH;
        if (smp && tt == 1) continue;
        int h, j; size_t mrow0;
        if (!smp) { j = unit & (W_NCH - 1); const int sh = unit >> 5; h = sh & 7; mrow0 = (size_t)(sh >> 3) * T_P; } else { const int sh = unit - NB_P * 8 * W_NCH; j = 0; h = sh & 7; mrow0 = (size_t)MP + 32 * (sh >> 3); }
        const int tok = 32 * tt + rho; const size_t m = mrow0 + (size_t)j * 64 + tok;
        const bf16* sb = (const bf16*)(ws + WS_SB) + (size_t)unit * 4096 + rho * 64 + 8 * hi; const bf16* qm = (const bf16*)(ws + WS_QM) + (size_t)unit * 4096 + tok * 64 + 8 * hi;
        bf16x8 sa[2][4], qb[4];
#pragma unroll
        for (int ks = 0; ks < 4; ++ks) { sa[0][ks] = *(const bf16x8*)(sb + 16 * ks); sa[1][ks] = *(const bf16x8*)(sb + 32 * 64 + 16 * ks); qb[ks] = *(const bf16x8*)(qm + 16 * ks); }
        const float* y0 = (const float*)(ws + WS_Y0) + (size_t)unit * 4096 + tok * 64 + 4 * hi;
        f32x16 d0, d1;
#pragma unroll
        for (int q = 0; q < 4; ++q) { const f32x4 x = *(const f32x4*)(y0 + 8 * q), y = *(const f32x4*)(y0 + 32 + 8 * q);
            d0[4 * q] = x.x; d0[4 * q + 1] = x.y; d0[4 * q + 2] = x.z; d0[4 * q + 3] = x.w; d1[4 * q] = y.x; d1[4 * q + 1] = y.y; d1[4 * q + 2] = y.z; d1[4 * q + 3] = y.w; }
        u32x2 vw[8], gg[8]; f32x4 l4[8], b4[8]; const float bon = BON[m * 8 + h];
#pragma unroll
        for (int vt = 0; vt < 2; ++vt)
#pragma unroll
            for (int q = 0; q < 4; ++q) { const int c = 64 * h + 32 * vt + 8 * q + 4 * hi; vw[4 * vt + q] = *(const u32x2*)(VV + m * 512 + c); gg[4 * vt + q] = *(const u32x2*)(G + m * 512 + c);
                l4[4 * vt + q] = *(const f32x4*)(lgn + c); b4[4 * vt + q] = *(const f32x4*)(lbn + c); }
#pragma unroll
        for (int ks = 0; ks < 4; ++ks) { d0 = MFMA32(sa[0][ks], qb[ks], d0); d1 = MFMA32(sa[1][ks], qb[ks], d1); }
        float s1 = 0.f;
#pragma unroll
        for (int r = 0; r < 16; ++r) s1 += d0[r] + d1[r];
        s1 += __shfl_xor(s1, 32);
        const float mean = s1 * (1.f / 64.f); float s2 = 0.f;
#pragma unroll
        for (int r = 0; r < 16; ++r) { const float e0 = d0[r] - mean, e1 = d1[r] - mean; s2 += e0 * e0 + e1 * e1; }
        s2 += __shfl_xor(s2, 32);
        const float rinv = rsqrtf(s2 * (1.f / 64.f) + 64e-5f);
#pragma unroll
        for (int vt = 0; vt < 2; ++vt)
#pragma unroll
            for (int q = 0; q < 4; ++q) { const int c = 64 * h + 32 * vt + 8 * q + 4 * hi; const u32x2 v2 = vw[4 * vt + q], g2 = gg[4 * vt + q];
                const float vv[4] = {bflo(v2.x), bfhi(v2.x), bflo(v2.y), bfhi(v2.y)}, gf[4] = {bflo(g2.x), bfhi(g2.x), bflo(g2.y), bfhi(g2.y)}; float r4[4];
#pragma unroll
                for (int e = 0; e < 4; ++e) { const float y = vt ? d1[4 * q + e] : d0[4 * q + e]; r4[e] = ((y - mean) * rinv * l4[4 * vt + q][e] + b4[4 * vt + q][e] + bon * vv[e]) * gf[e]; }
                *(u32x2*)(O + m * DM + 512 + c) = (u32x2){pk2(r4[0], r4[1]), pk2(r4[2], r4[3])}; }
    }
}

constexpr int SC_CH = 32;
static_assert(WS_OB - WS_OKK == 17 * MiB && WS_OKM - WS_OB == 17 * MiB && WS_OR - WS_OKM == 17 * MiB && WS_OV - WS_OR == 17 * MiB, "operand arrays are equally spaced");
__device__ __forceinline__ void cvt_store8(unsigned char* d, const u32x4 x) {
    *(u32x4*)d = (u32x4){x.x << 16, x.x & 0xffff0000u, x.y << 16, x.y & 0xffff0000u}; *(u32x4*)(d + 16) = (u32x4){x.z << 16, x.z & 0xffff0000u, x.w << 16, x.w & 0xffff0000u};
}
struct StageP {
    static constexpr int STRIDE = 1280 + 64;
    const unsigned char* pw; const unsigned char* pb; int vrow0;
    u32x4 v[25];
    __device__ __forceinline__ void issue(int t0, int lane) {
        const unsigned char* gw = pw + ((size_t)(t0 + (lane >> 4)) * 512) * 4 + 16 * (lane & 15);
#pragma unroll
        for (int j = 0; j < 8; ++j) v[j] = *(const u32x4*)(gw + (size_t)j * 4 * 512 * 4);
        const unsigned char* gb = pb + ((size_t)(t0 + (lane >> 3)) * 512) * 2 + 16 * (lane & 7);
#pragma unroll
        for (int a = 0; a < 4; ++a)
#pragma unroll
            for (int jj = 0; jj < 4; ++jj) v[8 + 4 * a + jj] = *(const u32x4*)(gb + (size_t)a * (17 * MiB) + (size_t)jj * 8 * 512 * 2);
        v[24] = *(const u32x4*)(pb + (size_t)4 * (17 * MiB) + ((size_t)(t0 + (lane >> 1)) * 512) * 2 + 2 * vrow0 + 16 * (lane & 1));
    }
    __device__ __forceinline__ void commit(unsigned char* buf, int lane) const {
        unsigned char* dw = buf + (lane >> 4) * STRIDE + 16 * (lane & 15);
#pragma unroll
        for (int j = 0; j < 8; ++j) *(u32x4*)(dw + j * 4 * STRIDE) = v[j];
        unsigned char* db = buf + (lane >> 3) * STRIDE + 256 + 32 * (lane & 7);
#pragma unroll
        for (int a = 0; a < 4; ++a)
#pragma unroll
            for (int jj = 0; jj < 4; ++jj) cvt_store8(db + a * 256 + jj * 8 * STRIDE, v[8 + 4 * a + jj]);
        cvt_store8(buf + (lane >> 1) * STRIDE + 1280 + 32 * (lane & 1), v[24]);
    }
};
struct StageS {
    static constexpr int STRIDE = 1280 + 256;
    const unsigned char* pw; const unsigned char* pb;
    u32x4 v[7];
    __device__ __forceinline__ void issue(int t0, int lane) {
        const unsigned char* gw = pw + ((size_t)(t0 + (lane >> 4)) * 512) * 4 + 16 * (lane & 15);
        v[0] = *(const u32x4*)gw; v[1] = *(const u32x4*)(gw + (size_t)4 * 512 * 4);
        const unsigned char* gb = pb + ((size_t)(t0 + (lane >> 3)) * 512) * 2 + 16 * (lane & 7);
#pragma unroll
        for (int a = 0; a < 5; ++a) v[2 + a] = *(const u32x4*)(gb + (size_t)a * (17 * MiB));
    }
    __device__ __forceinline__ void commit(unsigned char* buf, int lane) const {
        unsigned char* dw = buf + (lane >> 4) * STRIDE + 16 * (lane & 15);
        *(u32x4*)dw = v[0]; *(u32x4*)(dw + 4 * STRIDE) = v[1];
        unsigned char* db = buf + (lane >> 3) * STRIDE + 256 + 32 * (lane & 7);
#pragma unroll
        for (int a = 0; a < 5; ++a) cvt_store8(db + a * 256, v[2 + a]);
    }
};
typedef float f32x2 __attribute__((ext_vector_type(2)));
template <int STRIDE, bool YLDS> __device__ __forceinline__ void scan_consume(f32x4& S4, const unsigned char* buf, int nst, int ks, int rowl, float* yp, float* ypart) {
    f32x2 Sa = {S4.x, S4.y}, Sb = {S4.z, S4.w};
    for (int s0 = 0; s0 < nst; s0 += 16) {
        float ykeep = 0.f;
#pragma unroll 1
        for (int g = 0; g < 4; ++g) {
            const int kq = ks - 4 * g;
#pragma unroll
            for (int j = 0; j < 4; ++j) {
                const float* p = (const float*)(buf + (s0 + 4 * g + j) * STRIDE) + 4 * ks;
                const f32x2 wa = *(const f32x2*)(p), wb = *(const f32x2*)(p + 2), ka = *(const f32x2*)(p + 64), kb = *(const f32x2*)(p + 66), ba = *(const f32x2*)(p + 128), bb = *(const f32x2*)(p + 130),
                            ma = *(const f32x2*)(p + 192), mb = *(const f32x2*)(p + 194), ra = *(const f32x2*)(p + 256), rb = *(const f32x2*)(p + 258);
                const float v = ((const float*)(buf + (s0 + 4 * g + j) * STRIDE))[320 + rowl];
                f32x2 t = Sa * ka + Sb * kb; float d = t.x + t.y; d = sum16(d);
                const f32x2 vv = {v, v}, dd = {d, d};
                Sa = Sa * wa + (vv * ma - dd * ba); Sb = Sb * wb + (vv * mb - dd * bb);
                f32x2 u = Sa * ra + Sb * rb; float y = u.x + u.y;
                if constexpr (YLDS) ypart[(s0 + 4 * g + j) * 256] = y;
                else { y = sum16(y); ykeep = kq == j ? y : ykeep; }
            }
        }
        if constexpr (!YLDS) yp[(size_t)(s0 + ks) * 512] = ykeep;
    }
    S4 = (f32x4){Sa.x, Sa.y, Sb.x, Sb.y};
}
__device__ __forceinline__ void scan_yreduce(const float* ypart, float* yg, int pt) {
#pragma unroll
    for (int k = 0; k < 2; ++k) { const int o = pt + 256 * k; const f32x4* q = (const f32x4*)(ypart + o * 16);
        const f32x4 a = q[0], b = q[1], c = q[2], d = q[3]; const f32x4 e = (a + b) + (c + d);
        yg[(size_t)(o >> 4) * 512 + (o & 15)] = (e.x + e.y) + (e.z + e.w); }
}
__device__ __forceinline__ void p5_rwkv_scan(const Args& a, unsigned char* lds, int tid) {
    const unsigned char* ws = a.ws; float* out = a.out; float* Y = out + SC_Y;
    const int l = tid & 63, w = __builtin_amdgcn_readfirstlane(tid >> 6), ks = l & 15, rl = l >> 4;
    const int G = gridDim.x, vcu = (G % 8 == 0) ? (blockIdx.x % 8) * (G / 8) + blockIdx.x / 8 : blockIdx.x;
    typedef StageP StP; typedef StageS StS;
    unsigned char* buf0 = lds; unsigned char* buf1 = lds + SC_CH * StP::STRIDE;
    for (int it = vcu; it < 256; it += G) {
        {
            const int bh = it >> 2, b = bh >> 3, h = bh & 7, rb = it & 3, row = 16 * rb + 4 * w + rl;
            const size_t base0 = ((size_t)b * T_P) * 512 + (size_t)h * 64;
            constexpr int NC = T_P / SC_CH;
            StP st; st.pw = ws + WS_OW + base0 * 4; st.pb = ws + WS_OKK + base0 * 2; st.vrow0 = 16 * rb;
            f32x4 S = {0.f, 0.f, 0.f, 0.f};
            if (w >= 4) { if (w == 4) { st.issue(0, l); st.commit(buf0, l); st.issue(4 * SC_CH, l); } else st.issue((w - 4) * SC_CH, l); }
            else __builtin_amdgcn_s_setprio(3);
            __syncthreads();
            Y += base0 + row;
            float* yp0 = (float*)(lds + 2 * SC_CH * StP::STRIDE); float* yp1 = yp0 + SC_CH * 256;
#define SCAN_ITER(c, P, cur, nxt, ypc, ypp) do { if (w >= 4) { if ((c) > 0) scan_yreduce(ypp, Y - row + 16 * rb + (size_t)(((c) - 1) * SC_CH) * 512, tid - 256); \
                    if (w == 4 + (P)) { if ((c) + 1 < NC) { st.commit(nxt, l); if ((c) + 5 < NC) st.issue(((c) + 5) * SC_CH, l); } } } \
                else scan_consume<StP::STRIDE, true>(S, cur, SC_CH, ks, 4 * w + rl, nullptr, ypc + tid); __syncthreads(); } while (0)
            for (int c = 0; c < NC; c += 4) { SCAN_ITER(c, 1, buf0, buf1, yp0, yp1); SCAN_ITER(c + 1, 2, buf1, buf0, yp1, yp0); SCAN_ITER(c + 2, 3, buf0, buf1, yp0, yp1); SCAN_ITER(c + 3, 0, buf1, buf0, yp1, yp0); }
            if (w >= 4) scan_yreduce(yp1, Y - row + 16 * rb + (size_t)((NC - 1) * SC_CH) * 512, tid - 256);
#undef SCAN_ITER
            __builtin_amdgcn_s_setprio(0);
            Y -= base0 + row;
            if (w < 4) *(f32x4*)(out + OFF_WKVP + ((size_t)bh * 64 + row) * 64 + 4 * ks) = S;
        }
        {
            const int b = it >> 3, h = it & 7;
            const size_t base0 = ((size_t)MP + (size_t)b * T_S) * 512 + (size_t)h * 64;
            StS st; st.pw = ws + WS_OW + base0 * 4; st.pb = ws + WS_OKK + base0 * 2;
            if (w >= 4) { st.issue(8 * (w - 4), l); st.commit(buf0 + 8 * (w - 4) * StS::STRIDE, l); }
            __syncthreads();
            for (int pass = 0; pass < 2; ++pass) { const int row = 8 * w + 4 * pass + rl;
                f32x4 S = *(const f32x4*)(a.in[5] + ((size_t)it * 64 + row) * 64 + 4 * ks);
                scan_consume<StS::STRIDE, false>(S, buf0, T_S, ks, row, Y + base0 + row, nullptr);
                *(f32x4*)(out + OFF_WKVS + ((size_t)it * 64 + row) * 64 + 4 * ks) = S; }
            __syncthreads();
        }
    }
}

__device__ __forceinline__ void p6_rwkv_out(const Args& a, int tid) {
    const unsigned char* ws = a.ws; const float* out = a.out; const float* Y = out + SC_Y; const bf16* G = (const bf16*)(out + SC_G);
    const bf16* OV = (const bf16*)(ws + WS_OV); const float* BON = (const float*)(ws + WS_BONUS); bf16* O = (bf16*)(a.ws + WS_XB);
    const float* lg = a.in[22]; const float* lb = a.in[23];
    const int sub = tid & 7;
    const size_t NIT = (size_t)MT * 8, STEP = (size_t)gridDim.x * 64;
    size_t it = (size_t)blockIdx.x * 64 + (tid >> 3);
    f32x4 y0, y1; u32x4 vw, gw_; float bon = 0.f;
#define P6_LOAD(it_) do { const size_t o_ = ((it_) >> 3) * 512 + ((it_) & 7) * 64 + 8 * sub; y0 = *(const f32x4*)(Y + o_); y1 = *(const f32x4*)(Y + o_ + 4); vw = *(const u32x4*)(OV + o_); gw_ = *(const u32x4*)(G + o_); bon = BON[it_]; } while (0)
    if (it < NIT) P6_LOAD(it);
    for (; it < NIT; it += STEP) {
        const size_t m = it >> 3; const int h = (int)(it & 7);
        float y[8] = {y0.x, y0.y, y0.z, y0.w, y1.x, y1.y, y1.z, y1.w}; float v[8], g[8]; unpack8(vw, v); unpack8(gw_, g); const float bn = bon;
        if (it + STEP < NIT) P6_LOAD(it + STEP);
        float s1 = 0.f;
#pragma unroll
        for (int j = 0; j < 8; ++j) s1 += y[j];
        s1 += __shfl_xor(s1, 1); s1 += __shfl_xor(s1, 2); s1 += __shfl_xor(s1, 4);
        const float mean = s1 * (1.f / 64.f); float s2 = 0.f;
#pragma unroll
        for (int j = 0; j < 8; ++j) { const float d = y[j] - mean; s2 += d * d; }
        s2 += __shfl_xor(s2, 1); s2 += __shfl_xor(s2, 2); s2 += __shfl_xor(s2, 4);
        const float rinv = rsqrtf(s2 * (1.f / 64.f) + 64e-5f);
        float r[8];
#pragma unroll
        for (int j = 0; j < 8; ++j) { const int c = h * 64 + 8 * sub + j; r[j] = ((y[j] - mean) * rinv * lg[c] + lb[c] + bn * v[j]) * g[j]; }
        *(u32x4*)(O + m * DM + 512 + h * 64 + 8 * sub) = pack8(r);
    }
#undef P6_LOAD
}

__device__ __forceinline__ void p8_hnorm(const Args& a, int tid) {
    const int lane = tid & 63, gw = blockIdx.x * 8 + (tid >> 6), NGW = gridDim.x * 8;
    for (int m = gw; m < MT; m += NGW) {
        const f32x4* xr = (const f32x4*)(a.out + OFF_Y + (size_t)m * DM) + lane; f32x4 v[4]; float s = 0.f;
#pragma unroll
        for (int j = 0; j < 4; ++j) { v[j] = xr[64 * j]; s += (v[j].x * v[j].x + v[j].y * v[j].y) + (v[j].z * v[j].z + v[j].w * v[j].w); }
        const float rs = rsqrtf(wave_sum(s) * (1.f / DM) + 1e-6f);
        u32x2* o8 = (u32x2*)((bf16*)(a.ws + WS_HB) + (size_t)m * DM) + lane;
#pragma unroll
        for (int j = 0; j < 4; ++j) { u32x2 o; o.x = pk2(v[j].x * rs, v[j].y * rs); o.y = pk2(v[j].z * rs, v[j].w * rs); o8[64 * j] = o; }
    }
}

#define XB_TMO      128
#define XB_XCNT(j)  (256  + 64 * (j))
#define XB_XSUB(j)  (1280 + 64 * (j))
#define XB_XGEN(j)  (2304 + 64 * (j))
#define XB_TOP      3328
#define XB_TOPGEN   3392
#define XCD_BAR_WORDS 3456
#define XB_SPIN_CAP (1u << 18)

__device__ __forceinline__ unsigned xb_ld(unsigned* p)              { return __hip_atomic_load(p, __ATOMIC_RELAXED, __HIP_MEMORY_SCOPE_AGENT); }
__device__ __forceinline__ unsigned xb_add(unsigned* p, unsigned v) { return __hip_atomic_fetch_add(p, v, __ATOMIC_RELAXED, __HIP_MEMORY_SCOPE_AGENT); }
__device__ __forceinline__ unsigned xb_xcc_id() { return (unsigned)__builtin_amdgcn_s_getreg((3 << 11) | 20) & 0xFu; }
#define XB_SPIN(cond, bar) do { unsigned _sp = 0; while (cond) { __builtin_amdgcn_s_sleep(1); \
    if ((++_sp & 255u) == 0u) { if (xb_ld(&(bar)[XB_TMO])) break; if (_sp > XB_SPIN_CAP) { atomicAdd(&(bar)[XB_TMO], 1u); break; } } } } while (0)

struct XcdBarrier {
    unsigned* bar; unsigned x;
    volatile __attribute__((address_space(3))) unsigned* st;
};

__device__ __forceinline__ XcdBarrier xcd_barrier_post(unsigned* bar, volatile __attribute__((address_space(3))) unsigned* st) {
    XcdBarrier b; b.bar = bar; b.x = xb_xcc_id(); b.st = st;
    if (threadIdx.x == 0) (void)xb_add(&bar[XB_XCNT(b.x)], 1u);
    return b;
}
__device__ __forceinline__ void xcd_barrier_complete(unsigned* bar, unsigned x, unsigned& nloc, unsigned& nx) {
    const unsigned G = gridDim.x * gridDim.y * gridDim.z;
    unsigned sum, cnt, mine, sp = 0u;
    for (;;) {
        sum = 0u; cnt = 0u; mine = 0u;
#pragma unroll
        for (unsigned j = 0; j < 16; ++j) { const unsigned c = xb_ld(&bar[XB_XCNT(j)]); sum += c; cnt += (c > 0u) ? 1u : 0u; mine = (j == x) ? c : mine; }
        if (sum == G) break;
        __builtin_amdgcn_s_sleep(1);
        if ((++sp & 255u) == 0u) { if (xb_ld(&bar[XB_TMO])) break; if (sp > XB_SPIN_CAP) { atomicAdd(&bar[XB_TMO], 1u); break; } }
    }
    nloc = mine > 0u ? mine : 1u; nx = cnt > 0u ? cnt : 1u;
}

__device__ __forceinline__ void xcd_barrier(const XcdBarrier& b) {
    asm volatile("s_waitcnt vmcnt(0)" ::: "memory");
    __syncthreads();
    if (threadIdx.x == 0) {
        unsigned* bar = b.bar;
        __builtin_amdgcn_s_waitcnt(0);
        unsigned nloc = b.st[0], nx = b.st[1];
        if (nloc == 0u) { xcd_barrier_complete(bar, b.x, nloc, nx); b.st[0] = nloc; b.st[1] = nx; }
        const unsigned old = xb_add(&bar[XB_XSUB(b.x)], 1u);
        const unsigned gen = old / nloc;
        if (old + 1u == (gen + 1u) * nloc) {
            __builtin_amdgcn_fence(__ATOMIC_RELEASE, "agent");
            asm volatile("s_waitcnt vmcnt(0)" ::: "memory");
            const unsigned og = xb_add(&bar[XB_TOP], 1u);
            const unsigned tg = og / nx;
            if (og + 1u == (tg + 1u) * nx) xb_add(&bar[XB_TOPGEN], 1u);
            else XB_SPIN(xb_ld(&bar[XB_TOPGEN]) == tg, bar);
            __builtin_amdgcn_fence(__ATOMIC_ACQUIRE, "agent");
            xb_add(&bar[XB_XGEN(b.x)], 1u);
            asm volatile("s_waitcnt vmcnt(0)" ::: "memory");
        } else {
            XB_SPIN(xb_ld(&bar[XB_XGEN(b.x)]) == gen, bar);
            __builtin_amdgcn_fence(__ATOMIC_ACQUIRE, "agent");
            asm volatile("s_waitcnt vmcnt(0)" ::: "memory");
        }
    }
    __syncthreads();
}

constexpr int CW_BAR = 4096;
constexpr int LDS_BYTES = 163840;
constexpr int N_PHASES = 12;
#ifndef PROBE_MASK
#define PROBE_MASK 0
#endif
template <int PH> __device__ __forceinline__ void run_phase(const Args& args, unsigned char* lds, int tid, int rep) {
    unsigned char* ws = args.ws;
    if constexpr (PH == 0) p0_prologue(args, lds, tid);
    if constexpr (PH == 1) { pg8::Gemm g{(const pg8::bf16_t*)(ws + WS_XB), (const pg8::bf16_t*)(ws + WS_WIN), MT, NZ, DM, DM}; pg8::StaticOrder S; S.init(MT, NZ, gridDim.x, blockIdx.x);
        pg8::EpiZ E{(pg8::bf16_t*)(ws + WS_ZR), (pg8::bf16_t*)(ws + WS_ZS)};
        pg8::gemm_phase<pg8::EpiZ, pg8::StaticOrder, true, true>((PG8_LAS unsigned char*)lds, g, S, E); }
    if constexpr (PH == 2) p2_post(args, lds, tid);
    if constexpr (PH == 3) p3_attention(args, lds, tid, rep);
    if constexpr (PH == 4) p4w_chunks(args, lds, tid);
    if constexpr (PH == 5) p5w_chain(args, lds, tid);
    if constexpr (PH == 6) p6w_out(args, tid);
    if constexpr (PH == 7) { pg8::Gemm g{(const pg8::bf16_t*)(ws + WS_XB), (const pg8::bf16_t*)(ws + WS_WOUT), MT, DM, DM, DM}; pg8::StaticOrder S; S.init(MT, DM, gridDim.x, blockIdx.x);
        pg8::EpiH E{args.in[0], args.in[1], args.out + OFF_Y, (pg8::bf16_t*)(ws + WS_HB), (float*)(ws + WS_CTL) + CW_SS};
        pg8::gemm_phase<pg8::EpiH, pg8::StaticOrder, true, true>((PG8_LAS unsigned char*)lds, g, S, E); }
    if constexpr (PH == 9) { pg8::Gemm g{(const pg8::bf16_t*)(ws + WS_HB), (const pg8::bf16_t*)(ws + WS_W1), MT, DFF, DM, DM}; pg8::StaticOrder S; S.init(MT, DFF, gridDim.x, blockIdx.x);
        pg8::EpiAct E{(pg8::bf16_t*)(ws + WS_ACT), DFF, (const float*)(ws + WS_CTL) + CW_SS};
        pg8::gemm_phase<pg8::EpiAct, pg8::StaticOrder, true, true>((PG8_LAS unsigned char*)lds, g, S, E); }
    if constexpr (PH == 10) {
        { pg8::Gemm g{(const pg8::bf16_t*)(ws + WS_ACT), (const pg8::bf16_t*)(ws + WS_W2), MP, DM, DFF, DFF}; pg8::StaticOrder S; S.init(MP, DM, gridDim.x, blockIdx.x);
          pg8::EpiY E{args.out + OFF_Y};
          pg8::gemm_phase<pg8::EpiY, pg8::StaticOrder, true, true>((PG8_LAS unsigned char*)lds, g, S, E); }
        { const int c = blockIdx.x; pg8::OneUnit S; S.has = c < 64; S.u.pm = MP / 256 + (c >> 4); S.u.pn = (c >> 2) & 3; const int sl = c & 3;
          pg8::Gemm g{(const pg8::bf16_t*)(ws + WS_ACT) + sl * 1024, (const pg8::bf16_t*)(ws + WS_W2) + sl * 1024, MT, DM, DFF, 1024};
          pg8::EpiSlab E{(float*)(ws + WS_HB) + (size_t)sl * MS * DM};
          __syncthreads();
          pg8::gemm_phase<pg8::EpiSlab, pg8::OneUnit, false, true>((PG8_LAS unsigned char*)lds, g, S, E); }
    }
    if constexpr (PH == 11) {
        const f32x4* sl = (const f32x4*)(ws + WS_HB); f32x4* y = (f32x4*)(args.out + OFF_Y + (size_t)MP * DM); constexpr int NV = MS * DM / 4;
        for (int i = blockIdx.x * 512 + tid; i < NV; i += gridDim.x * 512) y[i] = y[i] + ((sl[i] + sl[i + NV]) + (sl[i + 2 * NV] + sl[i + 3 * NV]));
    }
}
#ifndef MK_ONE_LAUNCH
#define MK_ONE_LAUNCH 1
#endif
#if MK_ONE_LAUNCH
__global__ void __launch_bounds__(512, 2) mk_fwd(Args args) {
    extern __shared__ __attribute__((aligned(16))) unsigned char lds[];
    const int tid = threadIdx.x;
    volatile __attribute__((address_space(3))) unsigned* bst = (volatile __attribute__((address_space(3))) unsigned*)((__attribute__((address_space(3))) unsigned char*)lds + LDS_BYTES - 16);
    if (tid < 2) bst[tid] = 0u;
    __syncthreads();
    const XcdBarrier bar = xcd_barrier_post((unsigned*)(args.ws + WS_CTL) + CW_BAR, bst);
    if (args.ph_lo < 0) { __syncthreads(); cg::this_grid().sync(); }
#define SEAM(k) xcd_barrier(bar)
#define PHASE(k) do { if (args.ph_lo <= (k) && (k) < args.ph_hi) { if ((k) > args.ph_lo) SEAM(k); run_phase<k>(args, lds, tid, 0); \
        if ((PROBE_MASK >> (k)) & 1) { xcd_barrier(bar); run_phase<k>(args, lds, tid, 1); } } } while (0)
    PHASE(0); PHASE(1); PHASE(2); PHASE(3); PHASE(4); PHASE(5); PHASE(6); PHASE(7); PHASE(9); PHASE(10); PHASE(11);
#undef PHASE
#undef SEAM
}
#else
template <int PH> __global__ void __launch_bounds__(512, 2) mk_phase(Args args) {
    extern __shared__ __attribute__((aligned(16))) unsigned char lds[];
    run_phase<PH>(args, lds, threadIdx.x, 0);
}
#endif

extern "C" void kernel_launch(void* const* d_in, const int* in_sizes, int n_in, void* d_out, int out_size, void* d_ws, size_t ws_size, hipStream_t stream) {
    static int grid = 0;
    if (grid == 0) {
        if (n_in != 28 || out_size != (int)OUT_TOTAL || ws_size < WS_END) { fprintf(stderr, "kernel_launch: unexpected shapes (n_in %d, out %d, ws %zu)\n", n_in, out_size, ws_size); grid = -1; return; }
        int dev = 0, cus = 0, per_cu = 0;
        (void)hipGetDevice(&dev); (void)hipDeviceGetAttribute(&cus, hipDeviceAttributeMultiprocessorCount, dev);
#if MK_ONE_LAUNCH
        if (hipFuncSetAttribute((const void*)mk_fwd, hipFuncAttributeMaxDynamicSharedMemorySize, LDS_BYTES) != hipSuccess) { fprintf(stderr, "kernel_launch: hipFuncSetAttribute failed\n"); grid = -1; return; }
        (void)hipOccupancyMaxActiveBlocksPerMultiprocessor(&per_cu, (const void*)mk_fwd, 512, LDS_BYTES);
        (void)hipGetLastError();
        if (per_cu < 1) { fprintf(stderr, "kernel_launch: occupancy query says %d blocks per CU\n", per_cu); per_cu = 1; }
#else
#define SETATTR(k) (void)hipFuncSetAttribute((const void*)mk_phase<k>, hipFuncAttributeMaxDynamicSharedMemorySize, LDS_BYTES)
        SETATTR(0); SETATTR(1); SETATTR(2); SETATTR(3); SETATTR(4); SETATTR(5); SETATTR(6); SETATTR(7); SETATTR(8); SETATTR(9); SETATTR(10); SETATTR(11);
#undef SETATTR
        (void)per_cu;
#endif
        grid = cus;
    }
    if (grid < 0) return;
    (void)hipMemsetAsync((char*)d_ws + WS_CTL, 0, CTL_BYTES, stream);
    Args a{};
    for (int i = 0; i < 28; ++i) a.in[i] = (const float*)d_in[i];
    a.out = (float*)d_out; a.ws = (unsigned char*)d_ws;
#if MK_ONE_LAUNCH
    a.ph_lo = 0; a.ph_hi = N_PHASES;
    void* kargs[] = {&a};
    hipError_t e = hipLaunchCooperativeKernel((const void*)mk_fwd, dim3(grid), dim3(512), kargs, LDS_BYTES, stream);
    if (e != hipSuccess) fprintf(stderr, "kernel_launch: cooperative launch failed: %s (grid %d)\n", hipGetErrorString(e), grid);
#else
#define LAUNCH(k) hipLaunchKernelGGL(mk_phase<k>, dim3(grid), dim3(512), LDS_BYTES, stream, a)
    a.ph_lo = 0; a.ph_hi = N_PHASES;
    LAUNCH(0); LAUNCH(1); LAUNCH(2); LAUNCH(3); LAUNCH(4); LAUNCH(5); LAUNCH(6); LAUNCH(7); LAUNCH(9); LAUNCH(10); LAUNCH(11);
#undef LAUNCH
#endif
}
```

```cpp
#include <hip/hip_runtime.h>
#include <hip/hip_cooperative_groups.h>
#include <cstdio>
#include <cstdint>
namespace cg = cooperative_groups;
#define PROBE_A1 0
#define PROBE_A2 0
#define PROBE_A3 0
namespace pg8 {
#define PG8_LAS __attribute__((address_space(3)))
typedef unsigned short bf16_t;
typedef short bf16x8 __attribute__((ext_vector_type(8)));
typedef float f32x4 __attribute__((ext_vector_type(4)));
typedef unsigned u32x4 __attribute__((ext_vector_type(4)));
constexpr int BM = 256, BK = 64, HALF = 128, HTB = HALF * BK * 2  , STAGE_BYTES = 8 * HTB, NXCD = 8, WGM = 8;

__host__ __device__ __forceinline__ int lds_byte(int r, int c) { const int st = (r >> 4) * 2 + (c >> 5), rr = r & 15, cc = c & 31, ob = rr * 64 + cc * 2; return st * 1024 + (ob ^ (((ob >> 9) & 1) << 5)); }
__host__ __device__ __forceinline__ void stage_rc(int b, int& R, int& C) { const int st = b / 1024, sb = b % 1024, swz = sb ^ (((sb >> 9) & 1) << 5); R = (st >> 1) * 16 + swz / 64; C = (st & 1) * 32 + (swz % 64) / 2; }
__host__ __device__ __forceinline__ int perm32(int rho) { const int n = rho >> 4, i = rho & 15; return 8 * (i >> 2) + 4 * n + (i & 3); }

struct Unit { int pm, pn; };
struct Gemm { const bf16_t* A; const bf16_t* Bt; int M, N, K, KL; };

struct StaticOrder {
    int nM, nN, nwg, G, c;
    __host__ __device__ void init(int M, int N, int G_, int c_) { nM = M / BM; nN = N / BM; nwg = nM * nN; G = G_; c = c_; }
    __host__ __device__ bool next(int i, Unit& u) const {
        const long L = (long)i * G + c; if (L >= nwg) return false;
        int wgid = (int)L; { const int q = nwg / NXCD, r = nwg % NXCD, xcd = wgid % NXCD, off = wgid / NXCD; wgid = (xcd < r ? xcd * (q + 1) : r * (q + 1) + (xcd - r) * q) + off; }
        const int nig = WGM * nN, gid = wgid / nig, fm = gid * WGM, gsz = (nM - fm) < WGM ? (nM - fm) : WGM;
        u.pm = fm + ((wgid % nig) % gsz); u.pn = (wgid % nig) / gsz; return true;
    }
    __device__ __forceinline__ void a_ready(const Unit&) const {}
    __device__ __forceinline__ void done(const Unit&) const {}
};


__device__ __forceinline__ unsigned cvt_pk_bf16(float lo, float hi) { unsigned r; asm volatile("v_cvt_pk_bf16_f32 %0, %1, %2" : "=v"(r) : "v"(lo), "v"(hi)); return r; }

constexpr int E_MP = 16384;
constexpr int E_ZRW = 1632, E_ZSW = 1696;

struct OneUnit { Unit u; bool has;
    __device__ __forceinline__ bool next(int i, Unit& o) const { if (i == 0 && has) { o = u; return true; } return false; }
    __device__ __forceinline__ void a_ready(const Unit&) const {}
    __device__ __forceinline__ void done(const Unit&) const {} };
struct EpiZ {
    static constexpr bool PERM = true, AFTER_DRAIN = false;
    bf16_t* ZR; bf16_t* ZS;
    __device__ __forceinline__ void operator()(const f32x4 (&acc)[2][2][4][2], const Unit& u, int wr, int wc, int fr, int fq) const {
        const int row0 = u.pm * BM + wr * 64 + fr, c0 = u.pn * BM + wc * 32 + 8 * fq;
#pragma unroll
        for (int ai = 0; ai < 2; ++ai)
#pragma unroll
            for (int m = 0; m < 4; ++m) { const size_t row = (size_t)(row0 + ai * HALF + m * 16);
#pragma unroll
                for (int bj = 0; bj < 2; ++bj) { const int c = c0 + bj * HALF; bf16_t* dst;
                    if (c < 1600) dst = ZR + row * E_ZRW + c; else if (c < 3296) dst = ZS + row * E_ZSW + (c - 1600); else if (c == 3296) dst = ZR + row * E_ZRW + 1600; else continue;
                    const f32x4 v0 = acc[ai][bj][m][0], v1 = acc[ai][bj][m][1]; u32x4 w;
                    w.x = cvt_pk_bf16(v0[0], v0[1]); w.y = cvt_pk_bf16(v0[2], v0[3]); w.z = cvt_pk_bf16(v1[0], v1[1]); w.w = cvt_pk_bf16(v1[2], v1[3]);
                    *(u32x4*)dst = w; } }
    }
};
struct EpiH {
    static constexpr bool PERM = false, AFTER_DRAIN = false;
    const float* xp; const float* xs; float* H; bf16_t* HB; float* SS;
    __device__ __forceinline__ void operator()(const f32x4 (&acc)[2][2][4][2], const Unit& u, int wr, int wc, int fr, int fq) const {
        const int row0 = u.pm * BM + wr * 64 + fr, col0 = u.pn * BM + wc * 32 + 4 * fq;
#pragma unroll
        for (int ai = 0; ai < 2; ++ai)
#pragma unroll
            for (int m = 0; m < 4; ++m) { const int row = row0 + ai * HALF + m * 16;
                const float* xr = (row < E_MP ? xp + (size_t)row * 1024 : xs + (size_t)(row - E_MP) * 1024) + col0; float* hr = H + (size_t)row * 1024 + col0; bf16_t* hb = HB + (size_t)row * 1024 + col0;
                float ss = 0.f;
#pragma unroll
                for (int bj = 0; bj < 2; ++bj)
#pragma unroll
                    for (int n = 0; n < 2; ++n) { const f32x4 h = *(const f32x4*)(xr + bj * HALF + n * 16) + acc[ai][bj][m][n]; *(f32x4*)(hr + bj * HALF + n * 16) = h;
                        ss += (h[0] * h[0] + h[1] * h[1]) + (h[2] * h[2] + h[3] * h[3]);
                        unsigned w0 = cvt_pk_bf16(h[0], h[1]), w1 = cvt_pk_bf16(h[2], h[3]); typedef unsigned u32x2v __attribute__((ext_vector_type(2))); *(u32x2v*)(hb + bj * HALF + n * 16) = (u32x2v){w0, w1}; }
                ss += __shfl_xor(ss, 16); ss += __shfl_xor(ss, 32);
                if (fq == 0) atomicAdd(SS + row, ss); }
    }
};
struct EpiAct {
    static constexpr bool PERM = true, AFTER_DRAIN = false;
    bf16_t* O; int ldc; const float* SS;
    __device__ __forceinline__ void operator()(const f32x4 (&acc)[2][2][4][2], const Unit& u, int wr, int wc, int fr, int fq) const {
        const int row0 = u.pm * BM + wr * 64 + fr, c0 = u.pn * BM + wc * 32 + 8 * fq;
#pragma unroll
        for (int ai = 0; ai < 2; ++ai)
#pragma unroll
            for (int m = 0; m < 4; ++m) { const int row = row0 + ai * HALF + m * 16; bf16_t* rowp = O + (size_t)row * ldc + c0;
                const float rs = rsqrtf(SS[row] * (1.0f / 1024.0f) + 1e-6f);
#pragma unroll
                for (int bj = 0; bj < 2; ++bj) { f32x4 v0 = acc[ai][bj][m][0], v1 = acc[ai][bj][m][1];
#pragma unroll
                    for (int e = 0; e < 4; ++e) { const float a = fmaxf(v0[e], 0.f) * rs, b = fmaxf(v1[e], 0.f) * rs; v0[e] = a * a; v1[e] = b * b; }
                    u32x4 w; w.x = cvt_pk_bf16(v0[0], v0[1]); w.y = cvt_pk_bf16(v0[2], v0[3]); w.z = cvt_pk_bf16(v1[0], v1[1]); w.w = cvt_pk_bf16(v1[2], v1[3]);
                    *(u32x4*)(rowp + bj * HALF) = w; } }
    }
};
struct EpiSlab {
    static constexpr bool PERM = false, AFTER_DRAIN = false;
    float* S;
    __device__ __forceinline__ void operator()(const f32x4 (&acc)[2][2][4][2], const Unit& u, int wr, int wc, int fr, int fq) const {
        const int row0 = u.pm * BM - E_MP + wr * 64 + fr, col0 = u.pn * BM + wc * 32 + 4 * fq;
#pragma unroll
        for (int ai = 0; ai < 2; ++ai)
#pragma unroll
            for (int m = 0; m < 4; ++m) { float* yr = S + (size_t)(row0 + ai * HALF + m * 16) * 1024 + col0;
#pragma unroll
                for (int bj = 0; bj < 2; ++bj)
#pragma unroll
                    for (int n = 0; n < 2; ++n) *(f32x4*)(yr + bj * HALF + n * 16) = acc[ai][bj][m][n]; }
    }
};
struct EpiY {
    static constexpr bool PERM = false, AFTER_DRAIN = false;
    float* Y;
    __device__ __forceinline__ void operator()(const f32x4 (&acc)[2][2][4][2], const Unit& u, int wr, int wc, int fr, int fq) const {
        const int row0 = u.pm * BM + wr * 64 + fr, col0 = u.pn * BM + wc * 32 + 4 * fq;
#pragma unroll
        for (int ai = 0; ai < 2; ++ai)
#pragma unroll
            for (int m = 0; m < 4; ++m) { float* yr = Y + (size_t)(row0 + ai * HALF + m * 16) * 1024 + col0;
#pragma unroll
                for (int bj = 0; bj < 2; ++bj)
#pragma unroll
                    for (int n = 0; n < 2; ++n) { f32x4* p = (f32x4*)(yr + bj * HALF + n * 16); *p = *p + acc[ai][bj][m][n]; } }
    }
};

template <class Epi, class Sched, bool ALIGN_EPI = false, bool SP2 = false>
__device__ __forceinline__ void gemm_phase(PG8_LAS unsigned char* lds, const Gemm g, const Sched& S, const Epi& E) {
    const int tid = threadIdx.x, wid = __builtin_amdgcn_readfirstlane(tid >> 6), lane = tid & 63, wr = wid >> 2, wc = wid & 3, fr = lane & 15, fq = lane >> 4;
    const int K = g.K, nt = g.KL / BK;
    unsigned voffA[2], voffB[2];
#pragma unroll
    for (int i = 0; i < 2; ++i) { int R, C; stage_rc(tid * 16 + i * 8192, R, C); const int Rb = Epi::PERM ? ((R & ~31) + perm32(R & 31)) : R;
        voffA[i] = (unsigned)(R * K + C) * 2u; voffB[i] = (unsigned)(Rb * K + C) * 2u; }
    const size_t kstep = (size_t)(BK * 2);
    const size_t hstep = (size_t)HALF * K * 2;
    const size_t tstep = 2 * hstep;
    const unsigned ldsw = (unsigned)wid * 1024u;
    const int aoff = lds_byte(wr * 64 + fr, fq * 8), boff = lds_byte(wc * 32 + fr, fq * 8);
#define PG8_SA(b, h) (((b) * 2 + (h)) * HTB)
#define PG8_SB(b, h) ((4 + (b) * 2 + (h)) * HTB)
#define PG8_STAGE(bufoff, gbase, voff) do { _Pragma("unroll") for (int _i = 0; _i < 2; ++_i) \
        __builtin_amdgcn_global_load_lds((const unsigned*)((const char*)(gbase) + (voff)[_i]), (PG8_LAS unsigned*)(lds + (bufoff) + ldsw + _i * 8192), 16, 0, 0); } while (0)
#define PG8_LDA(dst, b, h) do { _Pragma("unroll") for (int m = 0; m < 4; ++m) _Pragma("unroll") for (int k = 0; k < 2; ++k) dst[m][k] = *(const PG8_LAS bf16x8*)(lds + PG8_SA(b, h) + aoff + m * 2048 + k * 1024); } while (0)
#define PG8_LDB(dst, b, h) do { _Pragma("unroll") for (int n = 0; n < 2; ++n) _Pragma("unroll") for (int k = 0; k < 2; ++k) dst[n][k] = *(const PG8_LAS bf16x8*)(lds + PG8_SB(b, h) + boff + n * 2048 + k * 1024); } while (0)
#define PG8_MMA(ai, bj, At, Bt) do { __builtin_amdgcn_s_setprio(1); _Pragma("unroll") for (int m = 0; m < 4; ++m) _Pragma("unroll") for (int n = 0; n < 2; ++n) _Pragma("unroll") for (int k = 0; k < 2; ++k) \
        acc[ai][bj][m][n] = __builtin_amdgcn_mfma_f32_16x16x32_bf16(Bt[n][k], At[m][k], acc[ai][bj][m][n], 0, 0, 0); __builtin_amdgcn_s_setprio(0); } while (0)
#define PG8_WAIT_V(n) asm volatile("s_waitcnt vmcnt(" #n ")" ::: "memory")
#define PG8_WAIT_L(n) asm volatile("s_waitcnt lgkmcnt(" #n ")" ::: "memory")
#define PG8_BAR __builtin_amdgcn_s_barrier()
#define PG8_SCHED __builtin_amdgcn_sched_barrier(0)
    Unit cur, nxt; int ui = 0;
    if (!S.next(0, cur)) return;
    f32x4 acc[2][2][4][2];
#pragma unroll
    for (int a = 0; a < 2; ++a)
#pragma unroll
        for (int b = 0; b < 2; ++b)
#pragma unroll
            for (int m = 0; m < 4; ++m)
#pragma unroll
                for (int n = 0; n < 2; ++n) acc[a][b][m][n] = (f32x4){0.f, 0.f, 0.f, 0.f};
    bf16x8 At[4][2], B0[2][2], B1[2][2];
    const char* cA = (const char*)g.A + (size_t)cur.pm * tstep; const char* cB = (const char*)g.Bt + (size_t)cur.pn * tstep;
    S.a_ready(cur);
    if constexpr (SP2) {
        PG8_STAGE(PG8_SB(0, 0), cB, voffB); PG8_STAGE(PG8_SB(0, 1), cB + hstep, voffB); PG8_STAGE(PG8_SA(0, 0), cA, voffA); PG8_STAGE(PG8_SA(0, 1), cA + hstep, voffA);
        if (wr == 1) PG8_BAR;
        PG8_WAIT_V(2); PG8_BAR;
        PG8_STAGE(PG8_SB(1, 0), cB + kstep, voffB); PG8_STAGE(PG8_SA(1, 0), cA + kstep, voffA); PG8_STAGE(PG8_SB(1, 1), cB + hstep + kstep, voffB);
        PG8_WAIT_V(6); PG8_BAR;
    } else {
        PG8_STAGE(PG8_SB(0, 0), cB, voffB); PG8_STAGE(PG8_SA(0, 0), cA, voffA); PG8_STAGE(PG8_SB(0, 1), cB + hstep, voffB); PG8_STAGE(PG8_SA(0, 1), cA + hstep, voffA);
        if (wr == 1) PG8_BAR;
        PG8_WAIT_V(4); PG8_BAR;
        PG8_STAGE(PG8_SB(1, 0), cB + kstep, voffB); PG8_STAGE(PG8_SA(1, 0), cA + kstep, voffA); PG8_STAGE(PG8_SB(1, 1), cB + hstep + kstep, voffB);
        PG8_WAIT_V(6); PG8_BAR;
    }
    for (;;) {
        const bool has_next = S.next(ui + 1, nxt);
        const char* nA = has_next ? (const char*)g.A + (size_t)nxt.pm * tstep : cA; const char* nB = has_next ? (const char*)g.Bt + (size_t)nxt.pn * tstep : cB;
        for (int t = 0; t < nt; t += 2) {
            const bool last = (t == nt - 2);
            const char* a1 = cA + (size_t)(t + 1) * kstep;
            const char* a2 = last ? nA : cA + (size_t)(t + 2) * kstep; const char* b2 = last ? nB : cB + (size_t)(t + 2) * kstep;
            const char* a3 = a2 + kstep; const char* b3 = b2 + kstep;
            if (last && has_next) S.a_ready(nxt);
            if constexpr (SP2) {
            PG8_LDB(B0, 0, 0); PG8_LDB(B1, 0, 1); PG8_SCHED; PG8_LDA(At, 0, 0); PG8_STAGE(PG8_SA(1, 1), a1 + hstep, voffA);
            PG8_WAIT_V(8); PG8_WAIT_L(0); PG8_BAR; PG8_MMA(0, 0, At, B0); PG8_MMA(0, 1, At, B1); PG8_BAR; PG8_SCHED;
            PG8_LDA(At, 0, 1); PG8_STAGE(PG8_SB(0, 0), b2, voffB); PG8_STAGE(PG8_SB(0, 1), b2 + hstep, voffB); PG8_STAGE(PG8_SA(0, 0), a2, voffA);
            PG8_WAIT_V(8); PG8_WAIT_L(0); PG8_BAR; PG8_MMA(1, 0, At, B0); PG8_MMA(1, 1, At, B1); PG8_BAR; PG8_SCHED;
            PG8_LDB(B0, 1, 0); PG8_LDB(B1, 1, 1); PG8_SCHED; PG8_LDA(At, 1, 0); PG8_STAGE(PG8_SA(0, 1), a2 + hstep, voffA);
            PG8_WAIT_V(8); PG8_WAIT_L(0); PG8_BAR; PG8_MMA(0, 0, At, B0); PG8_MMA(0, 1, At, B1); PG8_BAR; PG8_SCHED;
            PG8_LDA(At, 1, 1); PG8_STAGE(PG8_SB(1, 0), b3, voffB); PG8_STAGE(PG8_SB(1, 1), b3 + hstep, voffB); PG8_STAGE(PG8_SA(1, 0), a3, voffA);
            PG8_WAIT_V(8); PG8_WAIT_L(0); PG8_BAR; PG8_MMA(1, 0, At, B0); PG8_MMA(1, 1, At, B1); PG8_BAR; PG8_SCHED;
            } else {
            PG8_LDB(B0, 0, 0); PG8_SCHED; PG8_LDA(At, 0, 0); PG8_STAGE(PG8_SA(1, 1), a1 + hstep, voffA);
            PG8_WAIT_L(8); PG8_BAR; PG8_WAIT_L(0); PG8_MMA(0, 0, At, B0); PG8_BAR; PG8_SCHED;
            PG8_LDB(B1, 0, 1); PG8_STAGE(PG8_SB(0, 0), b2, voffB);
            PG8_BAR; PG8_WAIT_L(0); PG8_MMA(0, 1, At, B1); PG8_BAR;
            PG8_LDA(At, 0, 1); PG8_STAGE(PG8_SA(0, 0), a2, voffA);
            PG8_BAR; PG8_WAIT_L(0); PG8_MMA(1, 0, At, B0); PG8_BAR; PG8_SCHED;
            PG8_STAGE(PG8_SB(0, 1), b2 + hstep, voffB);
            PG8_WAIT_V(6); PG8_BAR; PG8_MMA(1, 1, At, B1); PG8_BAR;
            PG8_LDB(B0, 1, 0); PG8_SCHED; PG8_LDA(At, 1, 0); PG8_STAGE(PG8_SA(0, 1), a2 + hstep, voffA);
            PG8_WAIT_L(8); PG8_BAR; PG8_WAIT_L(0); PG8_MMA(0, 0, At, B0); PG8_BAR; PG8_SCHED;
            PG8_LDB(B1, 1, 1); PG8_STAGE(PG8_SB(1, 0), b3, voffB);
            PG8_BAR; PG8_WAIT_L(0); PG8_MMA(0, 1, At, B1); PG8_BAR;
            PG8_LDA(At, 1, 1); PG8_STAGE(PG8_SA(1, 0), a3, voffA);
            PG8_BAR; PG8_WAIT_L(0); PG8_MMA(1, 0, At, B0); PG8_BAR; PG8_SCHED;
            PG8_STAGE(PG8_SB(1, 1), b3 + hstep, voffB);
            PG8_WAIT_V(6); PG8_BAR; PG8_MMA(1, 1, At, B1); PG8_BAR;
            }
        }
        if constexpr (ALIGN_EPI) { if (wr == 0) PG8_BAR; }
        if constexpr (!Epi::AFTER_DRAIN) { E(acc, cur, wr, wc, fr, fq); S.done(cur); }
        if (!has_next) break;
#pragma unroll
        for (int a = 0; a < 2; ++a)
#pragma unroll
            for (int b = 0; b < 2; ++b)
#pragma unroll
                for (int m = 0; m < 4; ++m)
#pragma unroll
                    for (int n = 0; n < 2; ++n) acc[a][b][m][n] = (f32x4){0.f, 0.f, 0.f, 0.f};
        cur = nxt; cA = nA; cB = nB; ++ui;
        if constexpr (ALIGN_EPI) { if (wr == 1) PG8_BAR; }
    }
    PG8_WAIT_V(0);
    if constexpr (!ALIGN_EPI) { if (wr == 0) PG8_BAR; }
    PG8_BAR;
    if constexpr (Epi::AFTER_DRAIN) { E.fused(acc, cur, wr, wc, fr, fq, lds, wid, lane); S.done(cur); }
#undef PG8_SA
#undef PG8_SB
#undef PG8_STAGE
#undef PG8_LDA
#undef PG8_LDB
#undef PG8_MMA
#undef PG8_WAIT_V
#undef PG8_WAIT_L
#undef PG8_BAR
#undef PG8_SCHED
}
}


constexpr int DM = 1024, NB_P = 8, T_P = 2048, NB_S = 32, T_S = 32, PAST = 1024;
constexpr int MP = NB_P * T_P, MS = NB_S * T_S, MT = MP + MS;
constexpr int LS = PAST + T_S;
constexpr int SHIFTW = 1696, NZ = 3328, ZRW = 1632, DFF = 4096;
constexpr float QSCALE = 0.125f * 1.4426950408889634f;
constexpr float WISCALE = 0.35355339059327373f * 0.125f;
constexpr size_t OFF_Y = 0, OFF_KP = 17825792, OFF_VP = OFF_KP + 4194304, OFF_KIP = OFF_VP + 4194304, OFF_WKVP = OFF_KIP + 1048576, OFF_SHP = OFF_WKVP + 262144,
                 OFF_KS = OFF_SHP + 13568, OFF_VS = OFF_KS + 262144, OFF_KIS = OFF_VS + 262144, OFF_WKVS = OFF_KIS + 65536, OFF_SHS = OFF_WKVS + 1048576, OUT_TOTAL = OFF_SHS + 54272;
constexpr size_t MiB = 1u << 20;
constexpr size_t WS_CTL = 0, CTL_BYTES = 1 * MiB;
constexpr size_t WS_WIN = 1 * MiB, WS_WOUT = 8 * MiB, WS_W1 = 10 * MiB, WS_W2 = 18 * MiB;
constexpr size_t WS_W2T = 26 * MiB, WS_A2T = WS_W2T + 32768, WS_G2T = WS_A2T + 32768, WS_WI = 27 * MiB, WS_BONUS = 28 * MiB;
constexpr size_t WS_XB = 30 * MiB;
constexpr size_t WS_ZS = 66 * MiB;
constexpr size_t WS_R = 123 * MiB;
constexpr size_t WS_ZR = WS_R, WS_KBP = 178 * MiB, WS_VTP = 186 * MiB, WS_KIP = 194 * MiB, WS_KBS = 196 * MiB, WS_VTS = 213 * MiB, WS_KIS = 230 * MiB;
constexpr size_t WS_OW = WS_R, WS_OKK = 157 * MiB, WS_OB = 174 * MiB, WS_OKM = 191 * MiB, WS_OR = 208 * MiB, WS_OV = 225 * MiB;
constexpr size_t WS_ACT = 66 * MiB, WS_HB = 202 * MiB, WS_END = 256 * MiB;
static_assert(WS_ZS + (size_t)MT * SHIFTW * 2 <= WS_R && WS_ZR + (size_t)MT * ZRW * 2 <= WS_KBP && WS_KBS + (size_t)NB_S * LS * 256 * 2 <= WS_VTS && WS_VTS + (size_t)NB_S * 256 * LS * 2 <= WS_KIS &&
              WS_KIS + (size_t)NB_S * LS * 64 * 2 <= WS_END && WS_OV + (size_t)MT * 512 * 2 <= WS_END && WS_ACT + (size_t)MT * DFF * 2 <= WS_HB && WS_HB + (size_t)MT * DM * 2 <= WS_END, "d_ws map");
constexpr size_t SC_Q = 0, SC_QI = (size_t)MT * 512 / 2, SC_Y = 0, SC_G = (size_t)MT * 512;
constexpr int CW_QATT = 64, CW_SS = 16384;

typedef unsigned short bf16;
typedef short bf16x8 __attribute__((ext_vector_type(8)));
typedef float f32x4 __attribute__((ext_vector_type(4)));
typedef float f32x16 __attribute__((ext_vector_type(16)));
typedef unsigned u32x4 __attribute__((ext_vector_type(4)));
typedef unsigned u32x2 __attribute__((ext_vector_type(2)));

__device__ __forceinline__ unsigned f2bf(float f) { unsigned u = __float_as_uint(f); return (u + 0x7fffu + ((u >> 16) & 1u)) >> 16; }
__device__ __forceinline__ unsigned pk2(float lo, float hi) { return f2bf(lo) | (f2bf(hi) << 16); }
__device__ __forceinline__ float bflo(unsigned w) { return __uint_as_float(w << 16); }
__device__ __forceinline__ float bfhi(unsigned w) { return __uint_as_float(w & 0xffff0000u); }
__device__ __forceinline__ float bf1(bf16 b) { return __uint_as_float((unsigned)b << 16); }
__device__ __forceinline__ void unpack8(const u32x4 w, float* x) { x[0] = bflo(w.x); x[1] = bfhi(w.x); x[2] = bflo(w.y); x[3] = bfhi(w.y); x[4] = bflo(w.z); x[5] = bfhi(w.z); x[6] = bflo(w.w); x[7] = bfhi(w.w); }
__device__ __forceinline__ u32x4 pack8(const float* x) { u32x4 w; w.x = pk2(x[0], x[1]); w.y = pk2(x[2], x[3]); w.z = pk2(x[4], x[5]); w.w = pk2(x[6], x[7]); return w; }
__device__ __forceinline__ float wave_sum(float v) {
#pragma unroll
    for (int o = 1; o < 64; o <<= 1) v += __shfl_xor(v, o);
    return v;
}
template <int CTRL> __device__ __forceinline__ float dppmov(float x) { return __builtin_bit_cast(float, __builtin_amdgcn_update_dpp(0, __builtin_bit_cast(int, x), CTRL, 0xf, 0xf, true)); }
__device__ __forceinline__ float sum16(float x) {
    x += dppmov<0xB1>(x); x += dppmov<0x4E>(x); x += dppmov<0x141>(x); x += dppmov<0x140>(x); return x;
}
__device__ __forceinline__ int crow(int r, int hi) { return (r & 3) + 8 * (r >> 2) + 4 * hi; }

struct Args { const float* in[28]; float* out; unsigned char* ws; int ph_lo, ph_hi; };

__device__ __forceinline__ void tr_item(const float* W, int K, int N, const float* gain, bf16* WT, int jr0, int c0, int nvalid, int k0, float* scr, int lane) {
#pragma unroll 8
    for (int i = 0; i < 32; ++i) { const int kk = 2 * i + (lane >> 5), n = lane & 31;
        float v = (n < nvalid) ? W[(size_t)(k0 + kk) * N + c0 + n] : 0.f; if (gain) v *= gain[k0 + kk]; scr[kk * 33 + n] = v; }
    __builtin_amdgcn_s_waitcnt(0xC07F); asm volatile("" ::: "memory");
    const int c = lane & 7;
#pragma unroll
    for (int j = 0; j < 4; ++j) { const int n = (lane >> 3) + 8 * j; const float* s = scr + (8 * c) * 33 + n;
        u32x4 o; o.x = pk2(s[0 * 33], s[1 * 33]); o.y = pk2(s[2 * 33], s[3 * 33]); o.z = pk2(s[4 * 33], s[5 * 33]); o.w = pk2(s[6 * 33], s[7 * 33]);
        *(u32x4*)(WT + (size_t)(jr0 + n) * K + k0 + 8 * c) = o; }
    __builtin_amdgcn_s_waitcnt(0xC07F); asm volatile("" ::: "memory");
}
__device__ __forceinline__ void p0_prologue(const Args& a, unsigned char* lds, int tid) {
    const int lane = tid & 63, wave = tid >> 6, gw = blockIdx.x * 8 + wave, NGW = gridDim.x * 8;
    float* scr = (float*)(lds + wave * 17408);
    unsigned char* ws = a.ws;
    constexpr int I_IN = (NZ / 32) * (DM / 64), I_OUT = (DM / 32) * (DM / 64), I_F1 = (DFF / 32) * (DM / 64), I_F2 = (DM / 32) * (DFF / 64);
    for (int it = gw; it < I_IN + I_OUT + I_F1 + I_F2; it += NGW) {
        int r = it;
        if (r < I_IN) { const int jb = r % (NZ / 32), kb = r / (NZ / 32), j0 = jb * 32; int c0, nv;
            if (j0 < 1600) { c0 = j0; nv = 32; } else if (j0 < 3296) { c0 = 1608 + (j0 - 1600); nv = 32; } else { c0 = 1600; nv = 8; }
            tr_item(a.in[8], DM, 3304, a.in[7], (bf16*)(ws + WS_WIN), j0, c0, nv, kb * 64, scr, lane); continue; }
        r -= I_IN;
        if (r < I_OUT) { const int jb = r % (DM / 32), kb = r / (DM / 32); tr_item(a.in[24], DM, DM, nullptr, (bf16*)(ws + WS_WOUT), jb * 32, jb * 32, 32, kb * 64, scr, lane); continue; }
        r -= I_OUT;
        if (r < I_F1) { const int jb = r % (DFF / 32), kb = r / (DFF / 32); tr_item(a.in[26], DM, DFF, a.in[25], (bf16*)(ws + WS_W1), jb * 32, jb * 32, 32, kb * 64, scr, lane); continue; }
        r -= I_F1;
        { const int jb = r % (DM / 32), kb = r / (DM / 32); tr_item(a.in[27], DFF, DM, nullptr, (bf16*)(ws + WS_W2), jb * 32, jb * 32, 32, kb * 64, scr, lane); }
    }
    { const int gt = blockIdx.x * 512 + tid, NT = gridDim.x * 512;
      bf16* w2t = (bf16*)(ws + WS_W2T); bf16* a2t = (bf16*)(ws + WS_A2T); bf16* g2t = (bf16*)(ws + WS_G2T);
      for (int i = gt; i < 512 * 32; i += NT) { const int n = i >> 5, k = i & 31; w2t[i] = (bf16)f2bf(a.in[15][k * 512 + n]); a2t[i] = (bf16)f2bf(a.in[17][k * 512 + n]); }
      for (int i = gt; i < 512 * 96; i += NT) { const int n = i / 96, k = i % 96; g2t[i] = (bf16)f2bf(a.in[18][k * 512 + n]); } }
    { f32x4 v[4], nx[4]; int m = gw;
      if (m < MT) { const f32x4* xr = (const f32x4*)((m < MP) ? a.in[0] + (size_t)m * DM : a.in[1] + (size_t)(m - MP) * DM) + lane;
#pragma unroll
          for (int j = 0; j < 4; ++j) v[j] = xr[64 * j]; }
      for (; m < MT; m += NGW) {
        const int mn = m + NGW;
        if (mn < MT) { const f32x4* xr = (const f32x4*)((mn < MP) ? a.in[0] + (size_t)mn * DM : a.in[1] + (size_t)(mn - MP) * DM) + lane;
#pragma unroll
            for (int j = 0; j < 4; ++j) nx[j] = xr[64 * j]; }
        float s = 0.f;
#pragma unroll
        for (int j = 0; j < 4; ++j) s += (v[j].x * v[j].x + v[j].y * v[j].y) + (v[j].z * v[j].z + v[j].w * v[j].w);
        const float rs = rsqrtf(wave_sum(s) * (1.f / DM) + 1e-6f);
        u32x2* o8 = (u32x2*)((bf16*)(ws + WS_XB) + (size_t)m * DM) + lane;
#pragma unroll
        for (int j = 0; j < 4; ++j) { u32x2 o; o.x = pk2(v[j].x * rs, v[j].y * rs); o.y = pk2(v[j].z * rs, v[j].w * rs); o8[64 * j] = o; }
#pragma unroll
        for (int j = 0; j < 4; ++j) v[j] = nx[j];
      } }
    for (int r4 = gw; r4 < NB_S * PAST / 4; r4 += NGW) {
        f32x4 v[4];
#pragma unroll
        for (int j = 0; j < 4; ++j) v[j] = ((const f32x4*)(a.in[2] + (size_t)(4 * r4 + j) * 256))[lane];
#pragma unroll
        for (int j = 0; j < 4; ++j) { const int rix = 4 * r4 + j, b = rix >> 10, p = rix & 1023; u32x2 o; o.x = pk2(v[j].x, v[j].y); o.y = pk2(v[j].z, v[j].w);
            ((u32x2*)((bf16*)(ws + WS_KBS) + ((size_t)b * LS + p) * 256))[lane] = o; }
    }
    for (int r4 = gw; r4 < NB_S * PAST / 4; r4 += NGW) {
        const int rix = r4 * 4 + (lane >> 4), b = rix >> 10, p = rix & 1023; const f32x4 v = ((const f32x4*)(a.in[4] + (size_t)rix * 64))[lane & 15];
        u32x2 o; o.x = pk2(v.x, v.y); o.y = pk2(v.z, v.w); ((u32x2*)((bf16*)(ws + WS_KIS) + ((size_t)b * LS + p) * 64))[lane & 15] = o;
    }
    for (int it = gw; it < NB_S * 4 * 16; it += NGW) {
        const int kb = it & 15, g = (it >> 4) & 3, b = it >> 6;
        const float* src = a.in[3] + ((size_t)b * PAST + kb * 64) * 256 + g * 64;
#pragma unroll 8
        for (int i = 0; i < 64; ++i) scr[i * 65 + lane] = src[(size_t)i * 256 + lane];
        __builtin_amdgcn_s_waitcnt(0xC07F); asm volatile("" ::: "memory");
        bf16* dst = (bf16*)(ws + WS_VTS) + ((size_t)(b * 4 + g) * 64) * LS + kb * 64 + lane;
#pragma unroll 8
        for (int d = 0; d < 64; ++d) dst[(size_t)d * LS] = (bf16)f2bf(scr[lane * 65 + d]);
        __builtin_amdgcn_s_waitcnt(0xC07F); asm volatile("" ::: "memory");
    }
}

__device__ __forceinline__ void p2_post(const Args& a, unsigned char* lds, int tid) {
    unsigned char* ws = a.ws; float* out = a.out;
    const bf16* ZR = (const bf16*)(ws + WS_ZR); const bf16* ZS = (const bf16*)(ws + WS_ZS);
    bf16* Q = (bf16*)(out + SC_Q); bf16* QI = (bf16*)(out + SC_QI);
    float* cs = (float*)lds;
    bf16* vt = (bf16*)(lds + 4096);
    const int g8 = tid >> 3, sub = tid & 7;
    const float* qg = a.in[9]; const float* kg = a.in[10]; const float* lng = a.in[11]; const float* lnb = a.in[12];
    for (int unit = blockIdx.x; unit < 2 * (MT / 64); unit += gridDim.x) {
        const int tile = unit >> 1, part = unit & 1, hb0 = part ? 12 : 0, hb1 = part ? 25 : 12;
        const int m0 = tile * 64;
        { const int m = m0 + g8, pos = (m < MP) ? (m & (T_P - 1)) : (PAST + ((m - MP) & (T_S - 1)));
          const float inv = powf(500000.0f, -(float)sub * 0.125f); const float ang = (float)pos * inv; float s, c; sincosf(ang, &s, &c);
          cs[g8 * 16 + sub] = c; cs[g8 * 16 + 8 + sub] = s; }
        __syncthreads();
        const int m = m0 + g8;
        const bool isp = m < MP; const int ms = m - MP;
        float cc[8], ss[8];
#pragma unroll
        for (int j = 0; j < 8; ++j) { cc[j] = cs[g8 * 16 + j]; ss[j] = cs[g8 * 16 + 8 + j]; }
        const size_t kvrow = isp ? (size_t)m : ((size_t)(ms >> 5) * LS + PAST + (ms & 31));
        bf16* KB = (bf16*)(ws + (isp ? WS_KBP : WS_KBS)); bf16* KIb = (bf16*)(ws + (isp ? WS_KIP : WS_KIS));
        u32x4 xnext = *(const u32x4*)(ZR + (size_t)m * ZRW + hb0 * 64 + 8 * sub);
        for (int hb = hb0; hb < hb1; ++hb) {
            float x[8]; unpack8(xnext, x);
            if (hb + 1 < hb1) xnext = *(const u32x4*)(ZR + (size_t)m * ZRW + (hb + 1) * 64 + 8 * sub);
            if (hb < 12) {
                float s2 = 0.f;
#pragma unroll
                for (int j = 0; j < 8; ++j) s2 += x[j] * x[j];
                s2 += __shfl_xor(s2, 1); s2 += __shfl_xor(s2, 2); s2 += __shfl_xor(s2, 4);
                const float rinv = rsqrtf(s2 * (1.f / 64.f) + 1e-6f); const float* gn = (hb < 8 ? qg : kg) + 8 * sub;
                float y[8], o[8];
#pragma unroll
                for (int j = 0; j < 8; ++j) y[j] = x[j] * rinv * gn[j];
#pragma unroll
                for (int j = 0; j < 8; ++j) { const float p = __shfl_xor(y[j], 1); o[j] = sub == 0 ? y[j] * cc[j] - p * ss[j] : (sub == 1 ? y[j] * cc[j] + p * ss[j] : y[j]); }
                if (hb < 8) {
#pragma unroll
                    for (int j = 0; j < 8; ++j) o[j] *= QSCALE;
                    *(u32x4*)(Q + (size_t)m * 512 + hb * 64 + 8 * sub) = pack8(o);
                } else { const int g = hb - 8;
                    float* ko = out + (isp ? OFF_KP + (size_t)m * 256 : OFF_KS + (size_t)ms * 256) + g * 64 + 8 * sub;
                    *(f32x4*)ko = (f32x4){o[0], o[1], o[2], o[3]}; *(f32x4*)(ko + 4) = (f32x4){o[4], o[5], o[6], o[7]};
                    *(u32x4*)(KB + kvrow * 256 + g * 64 + 8 * sub) = pack8(o); }
            } else if (hb < 16) { const int g = hb - 12;
                float* vo = out + (isp ? OFF_VP + (size_t)m * 256 : OFF_VS + (size_t)ms * 256) + g * 64 + 8 * sub;
                *(f32x4*)vo = (f32x4){x[0], x[1], x[2], x[3]}; *(f32x4*)(vo + 4) = (f32x4){x[4], x[5], x[6], x[7]};
                unsigned* vd = (unsigned*)(vt + g8 * 258 + g * 64 + 8 * sub);
                vd[0] = pk2(x[0], x[1]); vd[1] = pk2(x[2], x[3]); vd[2] = pk2(x[4], x[5]); vd[3] = pk2(x[6], x[7]);
            } else if (hb < 24) {
                float o[8];
#pragma unroll
                for (int j = 0; j < 8; ++j) { const float p = __shfl_xor(x[j], 1); o[j] = sub == 0 ? x[j] * cc[j] - p * ss[j] : (sub == 1 ? x[j] * cc[j] + p * ss[j] : x[j]); }
                *(u32x4*)(QI + (size_t)m * 512 + (hb - 16) * 64 + 8 * sub) = pack8(o);
            } else {
                float s1 = 0.f;
#pragma unroll
                for (int j = 0; j < 8; ++j) s1 += x[j];
                s1 += __shfl_xor(s1, 1); s1 += __shfl_xor(s1, 2); s1 += __shfl_xor(s1, 4);
                const float mu = s1 * (1.f / 64.f); float s2 = 0.f;
#pragma unroll
                for (int j = 0; j < 8; ++j) { const float d = x[j] - mu; s2 += d * d; }
                s2 += __shfl_xor(s2, 1); s2 += __shfl_xor(s2, 2); s2 += __shfl_xor(s2, 4);
                const float rinv = rsqrtf(s2 * (1.f / 64.f) + 1e-6f); float y[8], o[8];
#pragma unroll
                for (int j = 0; j < 8; ++j) y[j] = (x[j] - mu) * rinv * lng[8 * sub + j] + lnb[8 * sub + j];
#pragma unroll
                for (int j = 0; j < 8; ++j) { const float p = __shfl_xor(y[j], 1); o[j] = sub == 0 ? y[j] * cc[j] - p * ss[j] : (sub == 1 ? y[j] * cc[j] + p * ss[j] : y[j]); }
                float* ko = out + (isp ? OFF_KIP + (size_t)m * 64 : OFF_KIS + (size_t)ms * 64) + 8 * sub;
                *(f32x4*)ko = (f32x4){o[0], o[1], o[2], o[3]}; *(f32x4*)(ko + 4) = (f32x4){o[4], o[5], o[6], o[7]};
                *(u32x4*)(KIb + kvrow * 64 + 8 * sub) = pack8(o);
            }
        }
        if (part == 0) ((float*)(ws + WS_WI))[(size_t)m * 8 + sub] = bf1(ZR[(size_t)m * ZRW + 1600 + sub]) * WISCALE;
        __syncthreads();
        if (part == 1) { const int r = tid >> 1, half = tid & 1; unsigned wv[16];
#pragma unroll
          for (int j = 0; j < 16; ++j) wv[j] = (unsigned)vt[(32 * half + 2 * j) * 258 + r] | ((unsigned)vt[(32 * half + 2 * j + 1) * 258 + r] << 16);
          bf16* dst;
          if (m0 < MP) dst = (bf16*)(ws + WS_VTP) + ((size_t)(m0 >> 11) * 256 + r) * T_P + (m0 & (T_P - 1)) + 32 * half;
          else { const int b = ((m0 - MP) >> 5) + half; dst = (bf16*)(ws + WS_VTS) + ((size_t)b * 256 + r) * LS + PAST; }
#pragma unroll
          for (int j = 0; j < 4; ++j) ((u32x4*)dst)[j] = (u32x4){wv[4 * j], wv[4 * j + 1], wv[4 * j + 2], wv[4 * j + 3]}; }
        if (part == 0) {} else if (m0 < MP) { if ((m0 & (T_P - 1)) == T_P - 64) { const int b = m0 >> 11; const bf16* zr = ZS + (size_t)(m0 + 63) * SHIFTW;
                for (int c = tid; c < SHIFTW; c += 512) out[OFF_SHP + (size_t)b * SHIFTW + c] = bf1(zr[c]); } }
        else { for (int h2 = 0; h2 < 2; ++h2) { const int b = ((m0 - MP) >> 5) + h2; const bf16* zr = ZS + (size_t)(m0 + 32 * h2 + 31) * SHIFTW;
                for (int c = tid; c < SHIFTW; c += 512) out[OFF_SHS + (size_t)b * SHIFTW + c] = bf1(zr[c]); } }
        __syncthreads();
    }
}

constexpr int ATT_UNITS = 544;
constexpr int MASK_PITCH = 65;
#define MFMA32(a, b, c) __builtin_amdgcn_mfma_f32_32x32x16_bf16((a), (b), (c), 0, 0, 0)

__device__ __forceinline__ float half_sum32(float v) { v += __shfl_xor(v, 1); v += __shfl_xor(v, 2); v += __shfl_xor(v, 4); v += __shfl_xor(v, 8); v += __shfl_xor(v, 16); return v; }
__device__ __forceinline__ float half_min32(float v) { v = fminf(v, __shfl_xor(v, 1)); v = fminf(v, __shfl_xor(v, 2)); v = fminf(v, __shfl_xor(v, 4)); v = fminf(v, __shfl_xor(v, 8)); v = fminf(v, __shfl_xor(v, 16)); return v; }
__device__ __forceinline__ float half_max32(float v) { v = fmaxf(v, __shfl_xor(v, 1)); v = fmaxf(v, __shfl_xor(v, 2)); v = fmaxf(v, __shfl_xor(v, 4)); v = fmaxf(v, __shfl_xor(v, 8)); v = fmaxf(v, __shfl_xor(v, 16)); return v; }
__device__ __forceinline__ int half_sum32i(int v) { v += __shfl_xor(v, 1); v += __shfl_xor(v, 2); v += __shfl_xor(v, 4); v += __shfl_xor(v, 8); v += __shfl_xor(v, 16); return v; }

#define LAS3 __attribute__((address_space(3)))
constexpr int A_RING1 = 0, A_SCL = 24576, A_RING2 = 24576, A_MASK = 0, A_LSUM = 8320, A_UNIT = 9344;
__device__ __forceinline__ void p3_attention(const Args& a, unsigned char* lds, int tid, int rep) {
    unsigned char* ws = a.ws; float* out = a.out;
    const bf16* Q = (const bf16*)(out + SC_Q); const bf16* QI = (const bf16*)(out + SC_QI); const float* WI = (const float*)(ws + WS_WI);
    bf16* O = (bf16*)(ws + WS_XB);
    unsigned* maskw = (unsigned*)(lds + A_MASK);
    float* lsum = (float*)(lds + A_LSUM);
    int* s_unit = (int*)(lds + A_UNIT);
    typedef float f32x2_t __attribute__((ext_vector_type(2)));
    f32x2_t* scl = (f32x2_t*)(lds + A_SCL) + (size_t)(tid >> 6) * 2048 + (tid & 63);
    unsigned* qctr = (unsigned*)(ws + WS_CTL) + CW_QATT + 64 * rep;
    const int l = tid & 63, w = __builtin_amdgcn_readfirstlane(tid >> 6), rho = l & 31, hi = l >> 5;
    LAS3 unsigned char* ldsb = (LAS3 unsigned char*)lds;
    for (;;) {
        if (tid == 0) *s_unit = (int)atomicAdd(qctr, 1u);
        __syncthreads();
        const int p = *s_unit;
        __syncthreads();
        if (p >= ATT_UNITS) break;
        int m0, nkt, vpitch; const bf16 *KB, *VT, *KI; bool need_idx;
        { int c = -1, b, half = 0;
          if (p < 256) { c = 31 - (p >> 4); b = (p & 15) >> 1; half = p & 1; }
          else if (p < 288) { b = p - 256; }
          else { const int pp = p - 288; c = 15 - (pp >> 4); b = (pp & 15) >> 1; half = pp & 1; }
          if (c >= 0) { m0 = b * T_P + 64 * c + 32 * half; nkt = 2 * (c + 1); vpitch = T_P; need_idx = c >= 4;
              KB = (const bf16*)(ws + WS_KBP) + (size_t)b * T_P * 256; VT = (const bf16*)(ws + WS_VTP) + (size_t)b * 256 * T_P; KI = (const bf16*)(ws + WS_KIP) + (size_t)b * T_P * 64; }
          else { m0 = MP + 32 * b; nkt = LS / 32; vpitch = LS; need_idx = true;
              KB = (const bf16*)(ws + WS_KBS) + (size_t)b * LS * 256; VT = (const bf16*)(ws + WS_VTS) + (size_t)b * 256 * LS; KI = (const bf16*)(ws + WS_KIS) + (size_t)b * LS * 64; } }
        if (need_idx) {
            const int tokA = 4 * w + 2 * ((rho >> 2) & 1) + (rho >> 4), headA = (rho & 3) + 4 * ((rho >> 3) & 1);
            bf16x8 qa[4];
#pragma unroll
            for (int ks = 0; ks < 4; ++ks) qa[ks] = *(const bf16x8*)(QI + (size_t)(m0 + tokA) * 512 + headA * 64 + 16 * ks + 8 * hi);
            float wv[16];
#pragma unroll
            for (int r = 0; r < 16; ++r) wv[r] = WI[(size_t)(m0 + 4 * w + 2 * hi + (r >> 3)) * 8 + (r & 7)];
            asm volatile("" :: "v"(qa[0]), "v"(qa[1]), "v"(qa[2]), "v"(qa[3]));
#pragma unroll
            for (int r = 0; r < 16; ++r) asm volatile("" :: "v"(wv[r]));
            asm volatile("s_waitcnt vmcnt(0)" ::: "memory");
            float sc0[32], sc1[32];
            const int nb = (nkt + 1) >> 1;
            const int sr = 8 * w + (l >> 3), scn = (l & 7) ^ ((sr >> 1) & 7);
            const unsigned char* ksrc = (const unsigned char*)KI + (size_t)sr * 128 + 16 * scn;
#define KI_STAGE(it_) __builtin_amdgcn_global_load_lds((const unsigned*)(ksrc + (size_t)(it_) * 8192), (LAS3 unsigned*)(ldsb + A_RING1 + ((it_) % 3) * 8192 + w * 1024), 16, 0, 0)
            for (int rp1 = 0; rp1 <= PROBE_A1; ++rp1) {
            if (rp1) __syncthreads();
            KI_STAGE(0); if (1 < nb) KI_STAGE(1);
#pragma unroll
            for (int it = 0; it < 32; ++it) {
                if (it < nb) {
                    if (it + 1 < nb) asm volatile("s_waitcnt vmcnt(1) lgkmcnt(0)\n\ts_barrier" ::: "memory"); else asm volatile("s_waitcnt vmcnt(0) lgkmcnt(0)\n\ts_barrier" ::: "memory");
                    if (it + 2 < nb) KI_STAGE(it + 2);
                    const unsigned char* tb = lds + A_RING1 + (it % 3) * 8192;
#pragma unroll
                    for (int k2 = 0; k2 < 2; ++k2) { const int kt = 2 * it + k2;
                        if (kt < nkt) {
                            const int r = 32 * k2 + rho; const unsigned char* rowp = tb + r * 128; const int sw = (r >> 1) & 7;
                            f32x16 acc = {0.f, 0.f, 0.f, 0.f, 0.f, 0.f, 0.f, 0.f, 0.f, 0.f, 0.f, 0.f, 0.f, 0.f, 0.f, 0.f};
#pragma unroll
                            for (int ks = 0; ks < 4; ++ks) acc = MFMA32(qa[ks], *(const bf16x8*)(rowp + 16 * ((2 * ks + hi) ^ sw)), acc);
                            float s0 = 0.f, s1 = 0.f;
#pragma unroll
                            for (int r2 = 0; r2 < 8; ++r2) { s0 += wv[r2] * fmaxf(acc[r2], 0.f); s1 += wv[8 + r2] * fmaxf(acc[8 + r2], 0.f); }
                            if (kt < 32) { sc0[kt & 31] = s0; sc1[kt & 31] = s1; } else scl[(kt - 32) * 64] = (f32x2_t){s0, s1};
                        } else if (kt < 32) { sc0[kt & 31] = -3.0e38f; sc1[kt & 31] = -3.0e38f; }
                    }
                } else { if (2 * it < 32) { sc0[(2 * it) & 31] = -3.0e38f; sc1[(2 * it) & 31] = -3.0e38f; sc0[(2 * it + 1) & 31] = -3.0e38f; sc1[(2 * it + 1) & 31] = -3.0e38f; } }
            }
            }
#undef KI_STAGE
            __syncthreads();
            float mn0 = 3.0e38f, mx0 = -3.0e38f, mn1 = 3.0e38f, mx1 = -3.0e38f; int cp0 = 0, cz0 = 0, cp1 = 0, cz1 = 0;
#pragma unroll
            for (int kt = 0; kt < 64; ++kt) if (kt < nkt) { float v0, v1; if (kt < 32) { v0 = sc0[kt & 31]; v1 = sc1[kt & 31]; } else { const f32x2_t t2 = scl[(kt - 32) * 64]; v0 = t2.x; v1 = t2.y; }
                mn0 = fminf(mn0, v0); mx0 = fmaxf(mx0, v0); mn1 = fminf(mn1, v1); mx1 = fmaxf(mx1, v1);
                cp0 += v0 > 0.f ? 1 : 0; cz0 += v0 == 0.f ? 1 : 0; cp1 += v1 > 0.f ? 1 : 0; cz1 += v1 == 0.f ? 1 : 0; }
            mn0 = half_min32(mn0); mx0 = half_max32(mx0); mn1 = half_min32(mn1); mx1 = half_max32(mx1);
            cp0 = half_sum32i(cp0); cz0 = half_sum32i(cz0); cp1 = half_sum32i(cp1); cz1 = half_sum32i(cz1);
            float lo0, hi0, lo1, hi1, thr0 = 0.f, thr1 = 0.f; int ch0, ch1, nt0 = 0, nt1 = 0; bool fin0, fin1;
            for (int rp2 = 0; rp2 <= PROBE_A2; ++rp2) {
            fin0 = false; fin1 = false; ch0 = 0; ch1 = 0;
            if (cp0 >= 256) { lo0 = 0.f; hi0 = mx0; if (cp0 == 256) { fin0 = true; thr0 = 0.f; nt0 = 0; } }
            else if (cp0 + cz0 >= 256) { lo0 = 0.f; hi0 = 0.f; fin0 = true; thr0 = 0.f; nt0 = 256 - cp0; }
            else { lo0 = mn0 - 1.0f; hi0 = 0.f; ch0 = cp0; }
            if (cp1 >= 256) { lo1 = 0.f; hi1 = mx1; if (cp1 == 256) { fin1 = true; thr1 = 0.f; nt1 = 0; } }
            else if (cp1 + cz1 >= 256) { lo1 = 0.f; hi1 = 0.f; fin1 = true; thr1 = 0.f; nt1 = 256 - cp1; }
            else { lo1 = mn1 - 1.0f; hi1 = 0.f; ch1 = cp1; }
            asm volatile("" : "+v"(lo0), "+v"(lo1));
            for (int iter = 0; iter < 64; ++iter) {
                const float mid0 = lo0 + 0.5f * (hi0 - lo0), mid1 = lo1 + 0.5f * (hi1 - lo1);
                int c0 = 0, c1 = 0;
#pragma unroll
                for (int g = 0; g < 4; ++g) if (8 * g < nkt) {
#pragma unroll
                    for (int k8 = 0; k8 < 8; ++k8) { c0 += sc0[8 * g + k8] > mid0 ? 1 : 0; c1 += sc1[8 * g + k8] > mid1 ? 1 : 0; } }
                for (int kt = 32; kt < nkt; kt += 8) {
                    f32x2_t t8[8];
#pragma unroll
                    for (int u = 0; u < 8; ++u) t8[u] = scl[(kt + u - 32) * 64];
#pragma unroll
                    for (int u = 0; u < 8; ++u) if (kt + u < nkt) { c0 += t8[u].x > mid0 ? 1 : 0; c1 += t8[u].y > mid1 ? 1 : 0; } }
                c0 = half_sum32i(c0); c1 = half_sum32i(c1);
                if (!fin0) { if (!(mid0 > lo0 && mid0 < hi0)) { fin0 = true; thr0 = hi0; nt0 = 256 - ch0; }
                             else if (c0 == 256) { fin0 = true; thr0 = mid0; nt0 = 0; } else if (c0 > 256) lo0 = mid0; else { hi0 = mid0; ch0 = c0; } }
                if (!fin1) { if (!(mid1 > lo1 && mid1 < hi1)) { fin1 = true; thr1 = hi1; nt1 = 256 - ch1; }
                             else if (c1 == 256) { fin1 = true; thr1 = mid1; nt1 = 0; } else if (c1 > 256) lo1 = mid1; else { hi1 = mid1; ch1 = c1; } }
                if (__all(fin0 && fin1)) break;
            }
            }
            const bool any_tie = __any(nt0 > 0 || nt1 > 0);
            int run0 = 0, run1 = 0; const unsigned below = (1u << rho) - 1u;
#pragma unroll
            for (int kt = 0; kt < 64; ++kt) if (kt < nkt) {
                float v0, v1; if (kt < 32) { v0 = sc0[kt & 31]; v1 = sc1[kt & 31]; } else { const f32x2_t t2 = scl[(kt - 32) * 64]; v0 = t2.x; v1 = t2.y; }
                bool p0 = v0 > thr0, p1 = v1 > thr1;
                if (any_tie) {
                    const bool e0 = nt0 > 0 && v0 == thr0, e1 = nt1 > 0 && v1 == thr1;
                    const unsigned long long be0 = __ballot(e0), be1 = __ballot(e1);
                    const unsigned h0 = (unsigned)(be0 >> (32 * hi)), h1 = (unsigned)(be1 >> (32 * hi));
                    p0 = p0 || (e0 && (run0 + __popc(h0 & below)) < nt0); p1 = p1 || (e1 && (run1 + __popc(h1 & below)) < nt1);
                    run0 += __popc(h0); run1 += __popc(h1);
                }
                const unsigned long long b0 = __ballot(p0), b1 = __ballot(p1);
                if (l == 0) { maskw[(4 * w + 0) * MASK_PITCH + kt] = (unsigned)b0; maskw[(4 * w + 1) * MASK_PITCH + kt] = (unsigned)b1; }
                if (l == 32) { maskw[(4 * w + 2) * MASK_PITCH + kt] = (unsigned)(b0 >> 32); maskw[(4 * w + 3) * MASK_PITCH + kt] = (unsigned)(b1 >> 32); }
            }
        }
        __syncthreads();
        {
            const int g = w >> 1;
            bf16x8 qb[4];
#pragma unroll
            for (int ks = 0; ks < 4; ++ks) qb[ks] = *(const bf16x8*)(Q + (size_t)(m0 + rho) * 512 + w * 64 + 16 * ks + 8 * hi);
            asm volatile("" :: "v"(qb[0]), "v"(qb[1]), "v"(qb[2]), "v"(qb[3]));
            asm volatile("s_waitcnt vmcnt(0)" ::: "memory");
            const unsigned char* ksrc[2]; const unsigned char* vsrc[2];
#pragma unroll
            for (int k = 0; k < 2; ++k) { const int i = (k * 8 + w) * 64 + l; const int r = i >> 5, c = i & 31; ksrc[k] = (const unsigned char*)KB + (size_t)r * 512 + 16 * (c ^ (r & 15));
                const int R = i >> 2, cv = i & 3; vsrc[k] = (const unsigned char*)VT + (size_t)R * vpitch * 2 + 16 * (cv ^ ((R >> 2) & 3)); }
#define KV_STAGE(t_) do { const int bo_ = A_RING2 + ((t_) % 3) * 32768 + w * 1024; \
            __builtin_amdgcn_global_load_lds((const unsigned*)(ksrc[0] + (size_t)(t_) * 16384), (LAS3 unsigned*)(ldsb + bo_), 16, 0, 0); \
            __builtin_amdgcn_global_load_lds((const unsigned*)(ksrc[1] + (size_t)(t_) * 16384), (LAS3 unsigned*)(ldsb + bo_ + 8192), 16, 0, 0); \
            __builtin_amdgcn_global_load_lds((const unsigned*)(vsrc[0] + (size_t)(t_) * 64), (LAS3 unsigned*)(ldsb + bo_ + 16384), 16, 0, 0); \
            __builtin_amdgcn_global_load_lds((const unsigned*)(vsrc[1] + (size_t)(t_) * 64), (LAS3 unsigned*)(ldsb + bo_ + 24576), 16, 0, 0); } while (0)
            f32x16 o0 = {0.f, 0.f, 0.f, 0.f, 0.f, 0.f, 0.f, 0.f, 0.f, 0.f, 0.f, 0.f, 0.f, 0.f, 0.f, 0.f}, o1 = o0; float psum = 0.f;
            const int ksw = rho & 15;
            const int vR0 = g * 64 + rho, vR1 = vR0 + 32; const int vs0 = (vR0 >> 2) & 3, vs1 = (vR1 >> 2) & 3;
            for (int rp3 = 0; rp3 <= PROBE_A3; ++rp3) {
            if (rp3) __syncthreads();
            KV_STAGE(0); if (1 < nkt) KV_STAGE(1);
            for (int kt = 0; kt < nkt; ++kt) {
                if (kt + 1 < nkt) asm volatile("s_waitcnt vmcnt(4) lgkmcnt(0)\n\ts_barrier" ::: "memory"); else asm volatile("s_waitcnt vmcnt(0) lgkmcnt(0)\n\ts_barrier" ::: "memory");
                if (kt + 2 < nkt) KV_STAGE(kt + 2);
                const unsigned char* kbuf = lds + A_RING2 + (kt % 3) * 32768; const unsigned char* vbuf = kbuf + 16384;
                f32x16 st = {0.f, 0.f, 0.f, 0.f, 0.f, 0.f, 0.f, 0.f, 0.f, 0.f, 0.f, 0.f, 0.f, 0.f, 0.f, 0.f};
#pragma unroll
                for (int ks = 0; ks < 4; ++ks) st = MFMA32(*(const bf16x8*)(kbuf + rho * 512 + 16 * ((g * 8 + 2 * ks + hi) ^ ksw)), qb[ks], st);
                unsigned word = need_idx ? maskw[rho * MASK_PITCH + kt] : 0xffffffffu; word >>= 4 * hi; float pr[16];
#pragma unroll
                for (int r = 0; r < 16; ++r) { const float e = __builtin_amdgcn_exp2f(st[r]); pr[r] = ((word >> ((r & 3) + 8 * (r >> 2))) & 1u) ? e : 0.f; psum += pr[r]; }
                union { u32x4 u; bf16x8 v; } pa0, pa1; pa0.u = (u32x4){pg8::cvt_pk_bf16(pr[0], pr[1]), pg8::cvt_pk_bf16(pr[2], pr[3]), pg8::cvt_pk_bf16(pr[4], pr[5]), pg8::cvt_pk_bf16(pr[6], pr[7])}; pa1.u = (u32x4){pg8::cvt_pk_bf16(pr[8], pr[9]), pg8::cvt_pk_bf16(pr[10], pr[11]), pg8::cvt_pk_bf16(pr[12], pr[13]), pg8::cvt_pk_bf16(pr[14], pr[15])};
                union { u32x4 u; bf16x8 v; } vf[2][2];
#pragma unroll
                for (int s2 = 0; s2 < 2; ++s2) { const unsigned char* r0 = vbuf + vR0 * 64 + 8 * hi; const unsigned char* r1 = vbuf + vR1 * 64 + 8 * hi;
                    const u32x2 a0 = *(const u32x2*)(r0 + 16 * ((2 * s2) ^ vs0)), a1 = *(const u32x2*)(r0 + 16 * ((2 * s2 + 1) ^ vs0)), b0 = *(const u32x2*)(r1 + 16 * ((2 * s2) ^ vs1)), b1 = *(const u32x2*)(r1 + 16 * ((2 * s2 + 1) ^ vs1));
                    vf[s2][0].u = (u32x4){a0.x, a0.y, a1.x, a1.y}; vf[s2][1].u = (u32x4){b0.x, b0.y, b1.x, b1.y}; }
                o0 = MFMA32(pa0.v, vf[0][0].v, o0); o0 = MFMA32(pa1.v, vf[1][0].v, o0); o1 = MFMA32(pa0.v, vf[0][1].v, o1); o1 = MFMA32(pa1.v, vf[1][1].v, o1);
            }
            }
#undef KV_STAGE
            psum += __shfl_xor(psum, 32);
            if (hi == 0) lsum[w * 32 + rho] = psum;
            __syncthreads();
#pragma unroll
            for (int r = 0; r < 16; ++r) { const int qr = crow(r, hi); const float inv = 1.0f / lsum[w * 32 + qr];
                bf16* op = O + (size_t)(m0 + qr) * DM + w * 64 + rho;
                op[0] = (bf16)f2bf(o0[r] * inv); op[32] = (bf16)f2bf(o1[r] * inv); }
        }
        __syncthreads();
    }
}

constexpr int XS_PITCH = 168;
constexpr int WP = 144;
constexpr int WSLOT = 64 * WP;
constexpr int W_NCH = T_P / 64;
constexpr int W_UNITS = NB_P * 8 * W_NCH + NB_S * 8;
constexpr size_t WS_PM = WS_R, WS_QM = WS_R + 18 * MiB, WS_UM = WS_R + 36 * MiB, WS_Y0 = WS_R + 72 * MiB;
static_assert((size_t)W_UNITS * 8192 <= 18 * MiB && (size_t)W_UNITS * 16384 <= 36 * MiB && WS_Y0 + 36 * MiB <= WS_END, "rwkv chunk summaries fit the reusable region");
constexpr size_t SC_G2 = 0, SC_VV = (size_t)MT * 256;
constexpr int ZTP = 720;
constexpr int LWP = 68;

__device__ __forceinline__ f32x16 wy_mm(const unsigned char* A, const unsigned char* B, int mi, int ni, int rho, int hi, f32x16 acc) {
    const unsigned char* ap = A + (32 * mi + rho) * WP + 16 * hi; const unsigned char* bp = B + (32 * ni + rho) * WP + 16 * hi;
#pragma unroll
    for (int ks = 0; ks < 4; ++ks) acc = MFMA32(*(const bf16x8*)(ap + 32 * ks), *(const bf16x8*)(bp + 32 * ks), acc);
    return acc;
}
typedef float wy_f32x2 __attribute__((ext_vector_type(2))); typedef __bf16 wy_bf16x2 __attribute__((ext_vector_type(2)));
__device__ __forceinline__ unsigned wy_cvt2(float lo, float hi) { const wy_f32x2 v = {lo, hi}; const wy_bf16x2 b = __builtin_convertvector(v, wy_bf16x2); return __builtin_bit_cast(unsigned, b); }
__device__ __forceinline__ void wy_st_t(unsigned char* dst, const f32x16& a, int mi, int ni, int rho, int hi) {
#pragma unroll
    for (int q = 0; q < 4; ++q) *(u32x2*)(dst + (32 * ni + rho) * WP + 2 * (32 * mi + 8 * q + 4 * hi)) = (u32x2){wy_cvt2(a[4 * q], a[4 * q + 1]), wy_cvt2(a[4 * q + 2], a[4 * q + 3])};
}
__device__ __forceinline__ void wy_st_n(unsigned char* dst, const f32x16& a, int mi, int ni, int rho, int hi) {
#pragma unroll
    for (int r = 0; r < 16; ++r) *(bf16*)(dst + (32 * mi + crow(r, hi)) * WP + 2 * (32 * ni + rho)) = (bf16)f2bf(a[r]);
}
__device__ __forceinline__ f32x16 wy_ld_t(const unsigned char* src, int mi, int ni, int rho, int hi) {
    f32x16 a;
#pragma unroll
    for (int q = 0; q < 4; ++q) { const u32x2 w = *(const u32x2*)(src + (32 * ni + rho) * WP + 2 * (32 * mi + 8 * q + 4 * hi)); a[4 * q] = bflo(w.x); a[4 * q + 1] = bfhi(w.x); a[4 * q + 2] = bflo(w.y); a[4 * q + 3] = bfhi(w.y); }
    return a;
}
#define F16Z ((f32x16){0.f, 0.f, 0.f, 0.f, 0.f, 0.f, 0.f, 0.f, 0.f, 0.f, 0.f, 0.f, 0.f, 0.f, 0.f, 0.f})

__device__ __forceinline__ void p4w_chunks(const Args& a, unsigned char* lds, int tid) {
    unsigned char* ws = a.ws; float* out = a.out;
    const bf16* ZS = (const bf16*)(ws + WS_ZS);
    const bf16* w2t = (const bf16*)(ws + WS_W2T); const bf16* a2t = (const bf16*)(ws + WS_A2T); const bf16* g2t = (const bf16*)(ws + WS_G2T);
    bf16* G = (bf16*)(out + SC_G2); bf16* VV = (bf16*)(out + SC_VV); float* BON = (float*)(ws + WS_BONUS);
    const float* mu = a.in[13]; const float* w0 = a.in[14]; const float* a0 = a.in[16]; const float* k_k = a.in[19]; const float* k_a = a.in[20]; const float* r_k = a.in[21]; const float* sh0 = a.in[6];
    const int l = tid & 63, w = __builtin_amdgcn_readfirstlane(tid >> 6), rho = l & 31, hi = l >> 5;
#define SL(i) (lds + (i) * WSLOT)
    unsigned char* zt = SL(0);
    bf16* xs = (bf16*)SL(6);
    float* LW = (float*)SL(9);
    float* LG = (float*)SL(11);
    float* NRM = (float*)(lds + 17 * WSLOT);
    float* PAR = NRM + 320;
    int* QMAX = (int*)(PAR + 672);
    for (int unit = blockIdx.x; unit < W_UNITS; unit += gridDim.x) {
        int m0, nvalid, h; bool first; const float* shp = nullptr;
        if (unit < NB_P * 8 * W_NCH) { const int j = unit & (W_NCH - 1), sh = unit >> 5; h = sh & 7; m0 = (sh >> 3) * T_P + 64 * j; nvalid = 64; first = j == 0; }
        else { const int sh = unit - NB_P * 8 * W_NCH; h = sh & 7; m0 = MP + 32 * (sh >> 3); nvalid = 32; first = true; shp = sh0 + (size_t)(sh >> 3) * SHIFTW; }
        const int ct = w & 1, tt = (w >> 1) & 1; const int n = 64 * h + 32 * ct + rho;
        bf16x8 fa[6];
        if (w < 4) {
#pragma unroll
            for (int ks = 0; ks < 2; ++ks) { fa[ks] = *(const bf16x8*)(w2t + n * 32 + 16 * ks + 8 * hi); fa[2 + ks] = *(const bf16x8*)(a2t + n * 32 + 16 * ks + 8 * hi); } }
        else {
#pragma unroll
            for (int ks = 0; ks < 6; ++ks) fa[ks] = *(const bf16x8*)(g2t + n * 96 + 16 * ks + 8 * hi); }
        if (tid < 8) QMAX[tid] = 0;
        for (int i = tid; i < 672; i += 512) { float v;
            if (i < 192) v = mu[(i >> 6) * 512 + 64 * h + (i & 63)]; else if (i < 352) v = mu[1536 + i - 192];
            else { const int k5 = i - 352, a5 = k5 >> 6; const float* src = a5 == 0 ? w0 : (a5 == 1 ? a0 : (a5 == 2 ? k_k : (a5 == 3 ? k_a : r_k))); v = src[64 * h + (k5 & 63)]; }
            PAR[i] = v; }
        for (int idx = tid; idx < 65 * 44; idx += 512) { const int r = idx / 44, p = idx - r * 44;
            const int col = p < 24 ? (p >> 3) * 512 + 64 * h + 8 * (p & 7) : 1536 + 8 * (p - 24);
            u32x4 v = {0u, 0u, 0u, 0u};
            if (r == 0) { if (!first) v = *(const u32x4*)(ZS + (size_t)(m0 - 1) * SHIFTW + col);
                          else if (shp) { const f32x4 a4 = *(const f32x4*)(shp + col), b4 = *(const f32x4*)(shp + col + 4); v = (u32x4){pk2(a4.x, a4.y), pk2(a4.z, a4.w), pk2(b4.x, b4.y), pk2(b4.z, b4.w)}; } }
            else if (r <= nvalid) v = *(const u32x4*)(ZS + (size_t)(m0 + r - 1) * SHIFTW + col);
            *(u32x4*)(zt + r * ZTP + 16 * p) = v; }
        __syncthreads();
        { const int tk = tid >> 3, c0 = (tid & 7) * 20; const bf16* zc = (const bf16*)(zt + (tk + 1) * ZTP + 384) + c0; const bf16* zp = (const bf16*)(zt + tk * ZTP + 384) + c0;
#pragma unroll
          for (int e = 0; e < 20; ++e) { const int c = c0 + e; const float cur = bf1(zc[e]), prev = bf1(zp[e]); const float zm = cur + PAR[192 + c] * (prev - cur);
              const float f = __frcp_rn(1.0f + __expf(c < 32 ? -2.0f * zm : -zm)); xs[tk * XS_PITCH + c] = (bf16)f2bf(c < 32 ? 2.0f * f - 1.0f : (c < 64 ? zm : f)); } }
        __syncthreads();
        const int tok = 32 * tt + rho; const bool valid = tok < nvalid; const size_t m = (size_t)m0 + tok;
        const bf16* xrow = xs + tok * XS_PITCH + 8 * hi; const int lofs = 32 * ct + 4 * hi;
        const int pofs = 64 * h + 32 * ct + 4 * hi;
        const unsigned char* zcur = zt + (tok + 1) * ZTP + 2 * (32 * ct + 4 * hi); const unsigned char* zprv = zt + tok * ZTP + 2 * (32 * ct + 4 * hi);
#define WMIX4(dst, seg, q) do { const u32x2 cw = *(const u32x2*)(zcur + 128 * (seg) + 16 * (q)), pw = *(const u32x2*)(zprv + 128 * (seg) + 16 * (q)); const f32x4 mu4 = *(const f32x4*)(PAR + 64 * (seg) + lofs + 8 * (q)); \
            dst[0] = bflo(cw.x) + mu4.x * (bflo(pw.x) - bflo(cw.x)); dst[1] = bfhi(cw.x) + mu4.y * (bfhi(pw.x) - bfhi(cw.x)); dst[2] = bflo(cw.y) + mu4.z * (bflo(pw.y) - bflo(cw.y)); dst[3] = bfhi(cw.y) + mu4.w * (bfhi(pw.y) - bfhi(cw.y)); } while (0)
        float ra[16], rb[16], rc[16], rd[16];
        if (w < 4) {
            f32x16 Dw = F16Z, Da = F16Z;
#pragma unroll
            for (int ks = 0; ks < 2; ++ks) { Dw = MFMA32(fa[ks], *(const bf16x8*)(xrow + 16 * ks), Dw); Da = MFMA32(fa[2 + ks], *(const bf16x8*)(xrow + 32 + 16 * ks), Da); }
            float n2 = 0.f, bon = 0.f;
#pragma unroll
            for (int q = 0; q < 4; ++q) { float zr[4], zk[4]; WMIX4(zr, 0, q); WMIX4(zk, 1, q);
                const f32x4 w04 = *(const f32x4*)(PAR + 352 + lofs + 8 * q), a04 = *(const f32x4*)(PAR + 416 + lofs + 8 * q), kk4 = *(const f32x4*)(PAR + 480 + lofs + 8 * q), ka4 = *(const f32x4*)(PAR + 544 + lofs + 8 * q), rk4 = *(const f32x4*)(PAR + 608 + lofs + 8 * q);
#pragma unroll
                for (int e = 0; e < 4; ++e) { const int r = 4 * q + e;
                    const float sg = __frcp_rn(1.0f + __expf(-(w04[e] + Dw[r]))); rd[r] = valid ? -0.6065306597126334f * sg : 0.f;
                    const float aa = __frcp_rn(1.0f + __expf(-(a04[e] + Da[r]))); rb[r] = aa;
                    const float kr = valid ? zk[e] * kk4[e] : 0.f; ra[r] = kr; n2 += kr * kr;
                    const float km = valid ? zk[e] * (1.0f + (aa - 1.0f) * ka4[e]) : 0.f; rc[r] = km; bon += zr[e] * km * rk4[e]; }
                *(f32x4*)(LW + tok * LWP + 32 * ct + 8 * q + 4 * hi) = (f32x4){rd[4 * q], rd[4 * q + 1], rd[4 * q + 2], rd[4 * q + 3]}; }
            n2 += __shfl_xor(n2, 32); bon += __shfl_xor(bon, 32);
            if (hi == 0) { NRM[ct * 64 + tok] = n2; NRM[128 + ct * 64 + tok] = bon; }
        } else {
            f32x16 Dg = F16Z;
#pragma unroll
            for (int ks = 0; ks < 6; ++ks) Dg = MFMA32(fa[ks], *(const bf16x8*)(xrow + 64 + 16 * ks), Dg);
#pragma unroll
            for (int q = 0; q < 4; ++q) { float zr[4], zv[4]; WMIX4(zr, 0, q); WMIX4(zv, 2, q);
#pragma unroll
                for (int e = 0; e < 4; ++e) { ra[4 * q + e] = valid ? zr[e] : 0.f; rb[4 * q + e] = valid ? zv[e] : 0.f; }
                if (valid) { const size_t o = m * 512 + pofs + 8 * q;
                    *(u32x2*)(G + o) = (u32x2){pk2(Dg[4 * q], Dg[4 * q + 1]), pk2(Dg[4 * q + 2], Dg[4 * q + 3])};
                    *(u32x2*)(VV + o) = (u32x2){pk2(zv[0], zv[1]), pk2(zv[2], zv[3])}; } }
        }
#undef WMIX4
        __syncthreads();
        if (w == 0) { float acc = 0.f; LG[l] = 0.f;
#pragma unroll 8
            for (int t = 0; t < 64; ++t) { acc += LW[t * LWP + l]; LG[(t + 1) * LWP + l] = acc; }
            NRM[256 + l] = __expf(acc); }
        if (w == 1 && l < 64) { const float bn = NRM[128 + l] + NRM[192 + l]; if (l < nvalid) BON[((size_t)m0 + l) * 8 + h] = bn; }
        __syncthreads();
        {
            const float* lgc = LG + (tok + 1) * LWP + 32 * ct + 4 * hi; const float* lgp = LG + tok * LWP + 32 * ct + 4 * hi; const float* lge = LG + 64 * LWP + 32 * ct + 4 * hi;
            if (w < 4) {
                const float invn = 1.0f / fmaxf(sqrtf(NRM[tok] + NRM[64 + tok]), 1e-12f);
#pragma unroll
                for (int q = 0; q < 4; ++q) { const f32x4 gc = *(const f32x4*)(lgc + 8 * q), gp = *(const f32x4*)(lgp + 8 * q), ge = *(const f32x4*)(lge + 8 * q);
                    float kt[4], bt[4], ka[4], ke[4], be[4];
#pragma unroll
                    for (int e = 0; e < 4; ++e) { const int r = 4 * q + e; const float en = __expf(-gc[e]), ep = __expf(gp[e]), ee = __expf(ge[e] - gc[e]); const float kkn = ra[r] * invn, bb = kkn * rb[r];
                        kt[e] = rc[r] * en; bt[e] = bb * en; ka[e] = kkn * ep; ke[e] = rc[r] * ee; be[e] = bb * ee; }
                    const int co = 2 * (32 * ct + 8 * q + 4 * hi);
                    *(u32x2*)(SL(0) + tok * WP + co) = (u32x2){pk2(kt[0], kt[1]), pk2(kt[2], kt[3])};
                    *(u32x2*)(SL(1) + tok * WP + co) = (u32x2){pk2(bt[0], bt[1]), pk2(bt[2], bt[3])};
                    *(u32x2*)(SL(2) + tok * WP + co) = (u32x2){pk2(ka[0], ka[1]), pk2(ka[2], ka[3])};
#pragma unroll
                    for (int e = 0; e < 4; ++e) { const int kr = 32 * ct + 8 * q + 4 * hi + e;
                        *(bf16*)(SL(4) + kr * WP + 2 * tok) = (bf16)f2bf(ka[e]); *(bf16*)(SL(5) + kr * WP + 2 * tok) = (bf16)f2bf(be[e]); *(bf16*)(SL(6) + kr * WP + 2 * tok) = (bf16)f2bf(ke[e]); } }
            } else {
#pragma unroll
                for (int q = 0; q < 4; ++q) { const f32x4 gc = *(const f32x4*)(lgc + 8 * q); float rh[4];
#pragma unroll
                    for (int e = 0; e < 4; ++e) rh[e] = ra[4 * q + e] * __expf(gc[e]);
                    *(u32x2*)(SL(3) + tok * WP + 2 * (32 * ct + 8 * q + 4 * hi)) = (u32x2){pk2(rh[0], rh[1]), pk2(rh[2], rh[3])};
#pragma unroll
                    for (int e = 0; e < 4; ++e) *(bf16*)(SL(7) + (32 * ct + 8 * q + 4 * hi + e) * WP + 2 * tok) = (bf16)f2bf(rb[4 * q + e]); }
            }
        }
        __syncthreads();
        for (int task = w; task < 16; task += 8) { const int pr = task >> 2, mi = (task >> 1) & 1, ni = task & 1;
            if (pr == 0) { f32x16 d = wy_mm(SL(1), SL(2), mi, ni, rho, hi, F16Z);
#pragma unroll
                for (int r = 0; r < 16; ++r) if (!(32 * mi + crow(r, hi) < 32 * ni + rho)) d[r] = 0.f;
                wy_st_t(SL(8), d, mi, ni, rho, hi); wy_st_n(SL(9), d, mi, ni, rho, hi); }
            else if (pr == 1) { f32x16 d = wy_mm(SL(2), SL(0), mi, ni, rho, hi, F16Z);
#pragma unroll
                for (int r = 0; r < 16; ++r) if (!(32 * ni + rho < 32 * mi + crow(r, hi))) d[r] = 0.f;
                wy_st_t(SL(10), d, mi, ni, rho, hi); }
            else if (pr == 2) { f32x16 d = wy_mm(SL(1), SL(3), mi, ni, rho, hi, F16Z);
#pragma unroll
                for (int r = 0; r < 16; ++r) if (!(32 * mi + crow(r, hi) <= 32 * ni + rho)) d[r] = 0.f;
                wy_st_t(SL(11), d, mi, ni, rho, hi); }
            else { f32x16 d = wy_mm(SL(0), SL(3), mi, ni, rho, hi, F16Z);
#pragma unroll
                for (int r = 0; r < 16; ++r) if (!(32 * mi + crow(r, hi) <= 32 * ni + rho)) d[r] = 0.f;
                wy_st_t(SL(12), d, mi, ni, rho, hi); } }
        __syncthreads();
        for (int task = w; task < 12; task += 8) { const int pr = task >> 2, mi = (task >> 1) & 1, ni = task & 1;
            if (pr == 0) { const f32x16 d = wy_mm(SL(9), SL(8), mi, ni, rho, hi, F16Z); wy_st_t(SL(13), d, mi, ni, rho, hi); }
            else if (pr == 1) { const f32x16 d = wy_mm(SL(8), SL(9), mi, ni, rho, hi, F16Z); wy_st_t(SL(14), d, mi, ni, rho, hi); }
            else { f32x16 d = wy_ld_t(SL(8), mi, ni, rho, hi);
#pragma unroll
                for (int r = 0; r < 16; ++r) d[r] = ((32 * mi + crow(r, hi)) == (32 * ni + rho) ? 1.0f : 0.f) - d[r];
                wy_st_t(SL(15), d, mi, ni, rho, hi); } }
        __syncthreads();
        int pfin = 16;
#pragma unroll 1
        for (int lev = 1; lev <= 5; ++lev) {
            unsigned char* Pc = SL((lev & 1) ? 15 : 16); unsigned char* Pn = SL((lev & 1) ? 16 : 15);
            unsigned char* Qr = SL((lev & 1) ? 13 : 0); unsigned char* Qx = SL((lev & 1) ? 14 : 1); unsigned char* Qr2 = SL((lev & 1) ? 0 : 13); unsigned char* Qx2 = SL((lev & 1) ? 1 : 14);
            const int ntask = lev < 5 ? 12 : 4;
            for (int task = w; task < ntask; task += 8) { const int pr = task >> 2, mi = (task >> 1) & 1, ni = task & 1;
                if (pr == 0) { f32x16 d = wy_ld_t(Pc, mi, ni, rho, hi);
                    d = wy_mm(Qx, Pc, mi, ni, rho, hi, d); wy_st_t(Pn, d, mi, ni, rho, hi); }
                else if (pr == 1) { const f32x16 d = wy_mm(Qx, Qr, mi, ni, rho, hi, F16Z); wy_st_t(Qr2, d, mi, ni, rho, hi); float mx = 0.f;
#pragma unroll
                    for (int r = 0; r < 16; ++r) mx = fmaxf(mx, fabsf(d[r]));
                    atomicMax(QMAX + lev, __float_as_int(mx)); }
                else { const f32x16 d = wy_mm(Qr, Qx, mi, ni, rho, hi, F16Z); wy_st_t(Qx2, d, mi, ni, rho, hi); } }
            __syncthreads();
            if (lev < 5 && __int_as_float(QMAX[lev]) < 1e-9f) { pfin = (lev & 1) ? 16 : 15; break; }
        }
        { const int pr = w >> 2, mi = (w >> 1) & 1, ni = w & 1;
          if (pr == 0) { const f32x16 d = wy_mm(SL(pfin), SL(10), mi, ni, rho, hi, F16Z); wy_st_t(SL(0), d, mi, ni, rho, hi); }
          else { const f32x16 d = wy_mm(SL(pfin), SL(4), mi, ni, rho, hi, F16Z); wy_st_t(SL(1), d, mi, ni, rho, hi); } }
        __syncthreads();
        { bf16* PMg = (bf16*)(ws + WS_PM) + (size_t)unit * 4096; bf16* QMg = (bf16*)(ws + WS_QM) + (size_t)unit * 4096;
          for (int task = w; task < 16; task += 8) { const int pr = task >> 2, mi = (task >> 1) & 1, ni = task & 1;
            if (pr == 0) { f32x16 d = wy_mm(SL(1), SL(5), mi, ni, rho, hi, F16Z);
                const float gc = NRM[256 + 32 * ni + rho];
#pragma unroll
                for (int q = 0; q < 4; ++q) { float o[4];
#pragma unroll
                    for (int e = 0; e < 4; ++e) { const int kr = 32 * mi + 8 * q + 4 * hi + e; o[e] = (kr == 32 * ni + rho ? gc : 0.f) - d[4 * q + e]; }
                    *(u32x2*)(PMg + (32 * ni + rho) * 64 + 32 * mi + 8 * q + 4 * hi) = (u32x2){pk2(o[0], o[1]), pk2(o[2], o[3])}; } }
            else if (pr == 1) { f32x16 d = wy_mm(SL(0), SL(5), mi, ni, rho, hi, F16Z);
                const f32x16 ke = wy_ld_t(SL(6), mi, ni, rho, hi);
#pragma unroll
                for (int r = 0; r < 16; ++r) d[r] = ke[r] - d[r];
                wy_st_t(SL(13), d, mi, ni, rho, hi); }
            else if (pr == 2) { f32x16 d = wy_mm(SL(1), SL(11), mi, ni, rho, hi, F16Z);
                const f32x16 rh = wy_ld_t(SL(3), mi, ni, rho, hi);
#pragma unroll
                for (int q = 0; q < 4; ++q) *(u32x2*)(QMg + (32 * ni + rho) * 64 + 32 * mi + 8 * q + 4 * hi) =
                    (u32x2){pk2(rh[4 * q] - d[4 * q], rh[4 * q + 1] - d[4 * q + 1]), pk2(rh[4 * q + 2] - d[4 * q + 2], rh[4 * q + 3] - d[4 * q + 3])}; }
            else { f32x16 d = wy_mm(SL(0), SL(11), mi, ni, rho, hi, F16Z);
                const f32x16 bk = wy_ld_t(SL(12), mi, ni, rho, hi);
#pragma unroll
                for (int r = 0; r < 16; ++r) d[r] = bk[r] - d[r];
                wy_st_t(SL(14), d, mi, ni, rho, hi); } } }
        __syncthreads();
        { float* UMg = (float*)(ws + WS_UM) + (size_t)unit * 4096; float* Y0g = (float*)(ws + WS_Y0) + (size_t)unit * 4096; const int pr = w >> 2, mi = (w >> 1) & 1, ni = w & 1;
          if (pr == 0) { const f32x16 d = wy_mm(SL(13), SL(7), mi, ni, rho, hi, F16Z);
#pragma unroll
              for (int q = 0; q < 4; ++q) *(f32x4*)(UMg + (32 * ni + rho) * 64 + 32 * mi + 8 * q + 4 * hi) = (f32x4){d[4 * q], d[4 * q + 1], d[4 * q + 2], d[4 * q + 3]}; }
          else { const f32x16 d = wy_mm(SL(7), SL(14), mi, ni, rho, hi, F16Z);
#pragma unroll
              for (int q = 0; q < 4; ++q) *(f32x4*)(Y0g + (32 * ni + rho) * 64 + 32 * mi + 8 * q + 4 * hi) = (f32x4){d[4 * q], d[4 * q + 1], d[4 * q + 2], d[4 * q + 3]}; } }
        __syncthreads();
    }
#undef SL
}

constexpr size_t WS_SB = WS_R + 108 * MiB;
static_assert(WS_SB + (size_t)W_UNITS * 8192 <= WS_END, "state snapshots fit");
__device__ __forceinline__ void p5w_chain(const Args& a, unsigned char* lds, int tid) {
    unsigned char* ws = a.ws; float* out = a.out;
    const int l = tid & 63, w = __builtin_amdgcn_readfirstlane(tid >> 6), rho = l & 31, hi = l >> 5;
    unsigned char* Sb0 = lds; unsigned char* Sb1 = lds + WSLOT; unsigned char* PMl = lds + 2 * WSLOT;
    for (int u2 = blockIdx.x; u2 < NB_P * 8 + NB_S * 8; u2 += gridDim.x) {
        const bool smp = u2 >= NB_P * 8; const int sh = smp ? u2 - NB_P * 8 : u2;
        const int nch = smp ? 1 : W_NCH, unit0 = smp ? NB_P * 8 * W_NCH + sh : sh * W_NCH;
        float* wkv = out + (smp ? OFF_WKVS : OFF_WKVP) + (size_t)sh * 4096;
        const int cr = tid >> 3, cc = (tid & 7) * 8, mi = (w >> 1) & 1, ni = w & 1;
        { float x[8];
          if (smp) { const f32x4 a4 = *(const f32x4*)(a.in[5] + (size_t)sh * 4096 + cr * 64 + cc), b4 = *(const f32x4*)(a.in[5] + (size_t)sh * 4096 + cr * 64 + cc + 4); x[0] = a4.x; x[1] = a4.y; x[2] = a4.z; x[3] = a4.w; x[4] = b4.x; x[5] = b4.y; x[6] = b4.z; x[7] = b4.w; }
          else {
#pragma unroll
              for (int e = 0; e < 8; ++e) x[e] = 0.f; }
          const u32x4 p8 = pack8(x); *(u32x4*)(Sb0 + cr * WP + 2 * cc) = p8; *(u32x4*)((bf16*)(ws + WS_SB) + (size_t)unit0 * 4096 + cr * 64 + cc) = p8; }
        u32x4 pmr = *(const u32x4*)((const bf16*)(ws + WS_PM) + (size_t)unit0 * 4096 + cr * 64 + cc);
        f32x16 ini = F16Z;
#define P5_UM(dst, j_) do { if (w < 4) { const float* um_ = (const float*)(ws + WS_UM) + ((size_t)unit0 + (j_)) * 4096 + (32 * ni + rho) * 64 + 32 * mi + 4 * hi; \
            _Pragma("unroll") for (int q = 0; q < 4; ++q) { const f32x4 x = *(const f32x4*)(um_ + 8 * q); dst[4 * q] = x.x; dst[4 * q + 1] = x.y; dst[4 * q + 2] = x.z; dst[4 * q + 3] = x.w; } } } while (0)
        P5_UM(ini, 0);
        for (int j = 0; j < nch; ++j) {
            unsigned char* Sc = (j & 1) ? Sb1 : Sb0; unsigned char* Sn = (j & 1) ? Sb0 : Sb1;
            *(u32x4*)(PMl + cr * WP + 2 * cc) = pmr;
            f32x16 d = ini;
            if (j + 1 < nch) { pmr = *(const u32x4*)((const bf16*)(ws + WS_PM) + ((size_t)unit0 + j + 1) * 4096 + cr * 64 + cc); P5_UM(ini, j + 1); }
            __syncthreads();
            if (w < 4) {
                d = wy_mm(PMl, Sc, mi, ni, rho, hi, d);
                if (j + 1 < nch) { wy_st_t(Sn, d, mi, ni, rho, hi);
                    bf16* sg = (bf16*)(ws + WS_SB) + ((size_t)unit0 + j + 1) * 4096 + (32 * ni + rho) * 64 + 32 * mi + 4 * hi;
#pragma unroll
                    for (int q = 0; q < 4; ++q) *(u32x2*)(sg + 8 * q) = (u32x2){wy_cvt2(d[4 * q], d[4 * q + 1]), wy_cvt2(d[4 * q + 2], d[4 * q + 3])}; }
                else {
#pragma unroll
                    for (int q = 0; q < 4; ++q) *(f32x4*)(wkv + (32 * ni + rho) * 64 + 32 * mi + 8 * q + 4 * hi) = (f32x4){d[4 * q], d[4 * q + 1], d[4 * q + 2], d[4 * q + 3]}; }
            }
            __syncthreads();
        }
#undef P5_UM
    }
}

__device__ __forceinline__ void p6w_out(const Args& a, int tid) {
    unsigned char* ws = a.ws; float* out = a.out;
    const bf16* G = (const bf16*)(out + SC_G2); const bf16* VV = (const bf16*)(out + SC_VV); const float* BON = (const float*)(ws + WS_BONUS); bf16* O = (bf16*)(ws + WS_XB);
    const float* lgn = a.in[22]; const float* lbn = a.in[23];
    const int l = tid & 63, rho = l & 31, hi = l >> 5;
    const int gw = blockIdx.x * 8 + (tid >> 6), NGW = gridDim.x * 8;
    for (int task = gw; task < 2 * W_UNITS; task += NGW) {
        const int unit = task >> 1, tt = task & 1; const bool smp = unit >= NB_P * 8 * W_NCH;
        if (smp && tt == 1) continue;
        int h, j; size_t mrow0;
        if (!smp) { j = unit & (W_NCH - 1); const int sh = unit >> 5; h = sh & 7; mrow0 = (size_t)(sh >> 3) * T_P; } else { const int sh = unit - NB_P * 8 * W_NCH; j = 0; h = sh & 7; mrow0 = (size_t)MP + 32 * (sh >> 3); }
        const int tok = 32 * tt + rho; const size_t m = mrow0 + (size_t)j * 64 + tok;
        const bf16* sb = (const bf16*)(ws + WS_SB) + (size_t)unit * 4096 + rho * 64 + 8 * hi; const bf16* qm = (const bf16*)(ws + WS_QM) + (size_t)unit * 4096 + tok * 64 + 8 * hi;
        bf16x8 sa[2][4], qb[4];
#pragma unroll
        for (int ks = 0; ks < 4; ++ks) { sa[0][ks] = *(const bf16x8*)(sb + 16 * ks); sa[1][ks] = *(const bf16x8*)(sb + 32 * 64 + 16 * ks); qb[ks] = *(const bf16x8*)(qm + 16 * ks); }
        const float* y0 = (const float*)(ws + WS_Y0) + (size_t)unit * 4096 + tok * 64 + 4 * hi;
        f32x16 d0, d1;
#pragma unroll
        for (int q = 0; q < 4; ++q) { const f32x4 x = *(const f32x4*)(y0 + 8 * q), y = *(const f32x4*)(y0 + 32 + 8 * q);
            d0[4 * q] = x.x; d0[4 * q + 1] = x.y; d0[4 * q + 2] = x.z; d0[4 * q + 3] = x.w; d1[4 * q] = y.x; d1[4 * q + 1] = y.y; d1[4 * q + 2] = y.z; d1[4 * q + 3] = y.w; }
        u32x2 vw[8], gg[8]; f32x4 l4[8], b4[8]; const float bon = BON[m * 8 + h];
#pragma unroll
        for (int vt = 0; vt < 2; ++vt)
#pragma unroll
            for (int q = 0; q < 4; ++q) { const int c = 64 * h + 32 * vt + 8 * q + 4 * hi; vw[4 * vt + q] = *(const u32x2*)(VV + m * 512 + c); gg[4 * vt + q] = *(const u32x2*)(G + m * 512 + c);
                l4[4 * vt + q] = *(const f32x4*)(lgn + c); b4[4 * vt + q] = *(const f32x4*)(lbn + c); }
#pragma unroll
        for (int ks = 0; ks < 4; ++ks) { d0 = MFMA32(sa[0][ks], qb[ks], d0); d1 = MFMA32(sa[1][ks], qb[ks], d1); }
        float s1 = 0.f;
#pragma unroll
        for (int r = 0; r < 16; ++r) s1 += d0[r] + d1[r];
        s1 += __shfl_xor(s1, 32);
        const float mean = s1 * (1.f / 64.f); float s2 = 0.f;
#pragma unroll
        for (int r = 0; r < 16; ++r) { const float e0 = d0[r] - mean, e1 = d1[r] - mean; s2 += e0 * e0 + e1 * e1; }
        s2 += __shfl_xor(s2, 32);
        const float rinv = rsqrtf(s2 * (1.f / 64.f) + 64e-5f);
#pragma unroll
        for (int vt = 0; vt < 2; ++vt)
#pragma unroll
            for (int q = 0; q < 4; ++q) { const int c = 64 * h + 32 * vt + 8 * q + 4 * hi; const u32x2 v2 = vw[4 * vt + q], g2 = gg[4 * vt + q];
                const float vv[4] = {bflo(v2.x), bfhi(v2.x), bflo(v2.y), bfhi(v2.y)}, gf[4] = {bflo(g2.x), bfhi(g2.x), bflo(g2.y), bfhi(g2.y)}; float r4[4];
#pragma unroll
                for (int e = 0; e < 4; ++e) { const float y = vt ? d1[4 * q + e] : d0[4 * q + e]; r4[e] = ((y - mean) * rinv * l4[4 * vt + q][e] + b4[4 * vt + q][e] + bon * vv[e]) * gf[e]; }
                *(u32x2*)(O + m * DM + 512 + c) = (u32x2){pk2(r4[0], r4[1]), pk2(r4[2], r4[3])}; }
    }
}

#define XB_TMO      128
#define XB_XCNT(j)  (256  + 64 * (j))
#define XB_XSUB(j)  (1280 + 64 * (j))
#define XB_XGEN(j)  (2304 + 64 * (j))
#define XB_TOP      3328
#define XB_TOPGEN   3392
#define XCD_BAR_WORDS 3456
#define XB_SPIN_CAP (1u << 18)

__device__ __forceinline__ unsigned xb_ld(unsigned* p)              { return __hip_atomic_load(p, __ATOMIC_RELAXED, __HIP_MEMORY_SCOPE_AGENT); }
__device__ __forceinline__ unsigned xb_add(unsigned* p, unsigned v) { return __hip_atomic_fetch_add(p, v, __ATOMIC_RELAXED, __HIP_MEMORY_SCOPE_AGENT); }
__device__ __forceinline__ unsigned xb_xcc_id() { return (unsigned)__builtin_amdgcn_s_getreg((3 << 11) | 20) & 0xFu; }
#define XB_SPIN(cond, bar) do { unsigned _sp = 0; while (cond) { __builtin_amdgcn_s_sleep(1); \
    if ((++_sp & 255u) == 0u) { if (xb_ld(&(bar)[XB_TMO])) break; if (_sp > XB_SPIN_CAP) { atomicAdd(&(bar)[XB_TMO], 1u); break; } } } } while (0)

struct XcdBarrier {
    unsigned* bar; unsigned x;
    volatile __attribute__((address_space(3))) unsigned* st;
};

__device__ __forceinline__ XcdBarrier xcd_barrier_post(unsigned* bar, volatile __attribute__((address_space(3))) unsigned* st) {
    XcdBarrier b; b.bar = bar; b.x = xb_xcc_id(); b.st = st;
    if (threadIdx.x == 0) (void)xb_add(&bar[XB_XCNT(b.x)], 1u);
    return b;
}
__device__ __forceinline__ void xcd_barrier_complete(unsigned* bar, unsigned x, unsigned& nloc, unsigned& nx) {
    const unsigned G = gridDim.x * gridDim.y * gridDim.z;
    unsigned sum, cnt, mine, sp = 0u;
    for (;;) {
        sum = 0u; cnt = 0u; mine = 0u;
#pragma unroll
        for (unsigned j = 0; j < 16; ++j) { const unsigned c = xb_ld(&bar[XB_XCNT(j)]); sum += c; cnt += (c > 0u) ? 1u : 0u; mine = (j == x) ? c : mine; }
        if (sum == G) break;
        __builtin_amdgcn_s_sleep(1);
        if ((++sp & 255u) == 0u) { if (xb_ld(&bar[XB_TMO])) break; if (sp > XB_SPIN_CAP) { atomicAdd(&bar[XB_TMO], 1u); break; } }
    }
    nloc = mine > 0u ? mine : 1u; nx = cnt > 0u ? cnt : 1u;
}

__device__ __forceinline__ void xcd_barrier(const XcdBarrier& b) {
    asm volatile("s_waitcnt vmcnt(0)" ::: "memory");
    __syncthreads();
    if (threadIdx.x == 0) {
        unsigned* bar = b.bar;
        __builtin_amdgcn_s_waitcnt(0);
        unsigned nloc = b.st[0], nx = b.st[1];
        if (nloc == 0u) { xcd_barrier_complete(bar, b.x, nloc, nx); b.st[0] = nloc; b.st[1] = nx; }
        const unsigned old = xb_add(&bar[XB_XSUB(b.x)], 1u);
        const unsigned gen = old / nloc;
        if (old + 1u == (gen + 1u) * nloc) {
            __builtin_amdgcn_fence(__ATOMIC_RELEASE, "agent");
            asm volatile("s_waitcnt vmcnt(0)" ::: "memory");
            const unsigned og = xb_add(&bar[XB_TOP], 1u);
            const unsigned tg = og / nx;
            if (og + 1u == (tg + 1u) * nx) xb_add(&bar[XB_TOPGEN], 1u);
            else XB_SPIN(xb_ld(&bar[XB_TOPGEN]) == tg, bar);
            __builtin_amdgcn_fence(__ATOMIC_ACQUIRE, "agent");
            xb_add(&bar[XB_XGEN(b.x)], 1u);
            asm volatile("s_waitcnt vmcnt(0)" ::: "memory");
        } else {
            XB_SPIN(xb_ld(&bar[XB_XGEN(b.x)]) == gen, bar);
            __builtin_amdgcn_fence(__ATOMIC_ACQUIRE, "agent");
            asm volatile("s_waitcnt vmcnt(0)" ::: "memory");
        }
    }
    __syncthreads();
}

constexpr int CW_BAR = 4096;
constexpr int LDS_BYTES = 163840;
constexpr int N_PHASES = 12;
#ifndef PROBE_MASK
#define PROBE_MASK 0
#endif
template <int PH> __device__ __forceinline__ void run_phase(const Args& args, unsigned char* lds, int tid, int rep) {
    unsigned char* ws = args.ws;
    if constexpr (PH == 0) p0_prologue(args, lds, tid);
    if constexpr (PH == 1) { pg8::Gemm g{(const pg8::bf16_t*)(ws + WS_XB), (const pg8::bf16_t*)(ws + WS_WIN), MT, NZ, DM, DM}; pg8::StaticOrder S; S.init(MT, NZ, gridDim.x, blockIdx.x);
        pg8::EpiZ E{(pg8::bf16_t*)(ws + WS_ZR), (pg8::bf16_t*)(ws + WS_ZS)};
        pg8::gemm_phase<pg8::EpiZ, pg8::StaticOrder, true, true>((PG8_LAS unsigned char*)lds, g, S, E); }
    if constexpr (PH == 2) p2_post(args, lds, tid);
    if constexpr (PH == 3) p3_attention(args, lds, tid, rep);
    if constexpr (PH == 4) p4w_chunks(args, lds, tid);
    if constexpr (PH == 5) p5w_chain(args, lds, tid);
    if constexpr (PH == 6) p6w_out(args, tid);
    if constexpr (PH == 7) { pg8::Gemm g{(const pg8::bf16_t*)(ws + WS_XB), (const pg8::bf16_t*)(ws + WS_WOUT), MT, DM, DM, DM}; pg8::StaticOrder S; S.init(MT, DM, gridDim.x, blockIdx.x);
        pg8::EpiH E{args.in[0], args.in[1], args.out + OFF_Y, (pg8::bf16_t*)(ws + WS_HB), (float*)(ws + WS_CTL) + CW_SS};
        pg8::gemm_phase<pg8::EpiH, pg8::StaticOrder, true, true>((PG8_LAS unsigned char*)lds, g, S, E); }
    if constexpr (PH == 9) { pg8::Gemm g{(const pg8::bf16_t*)(ws + WS_HB), (const pg8::bf16_t*)(ws + WS_W1), MT, DFF, DM, DM}; pg8::StaticOrder S; S.init(MT, DFF, gridDim.x, blockIdx.x);
        pg8::EpiAct E{(pg8::bf16_t*)(ws + WS_ACT), DFF, (const float*)(ws + WS_CTL) + CW_SS};
        pg8::gemm_phase<pg8::EpiAct, pg8::StaticOrder, true, true>((PG8_LAS unsigned char*)lds, g, S, E); }
    if constexpr (PH == 10) {
        { pg8::Gemm g{(const pg8::bf16_t*)(ws + WS_ACT), (const pg8::bf16_t*)(ws + WS_W2), MP, DM, DFF, DFF}; pg8::StaticOrder S; S.init(MP, DM, gridDim.x, blockIdx.x);
          pg8::EpiY E{args.out + OFF_Y};
          pg8::gemm_phase<pg8::EpiY, pg8::StaticOrder, true, true>((PG8_LAS unsigned char*)lds, g, S, E); }
        { const int c = blockIdx.x; pg8::OneUnit S; S.has = c < 64; S.u.pm = MP / 256 + (c >> 4); S.u.pn = (c >> 2) & 3; const int sl = c & 3;
          pg8::Gemm g{(const pg8::bf16_t*)(ws + WS_ACT) + sl * 1024, (const pg8::bf16_t*)(ws + WS_W2) + sl * 1024, MT, DM, DFF, 1024};
          pg8::EpiSlab E{(float*)(ws + WS_HB) + (size_t)sl * MS * DM};
          __syncthreads();
          pg8::gemm_phase<pg8::EpiSlab, pg8::OneUnit, false, true>((PG8_LAS unsigned char*)lds, g, S, E); }
    }
    if constexpr (PH == 11) {
        const f32x4* sl = (const f32x4*)(ws + WS_HB); f32x4* y = (f32x4*)(args.out + OFF_Y + (size_t)MP * DM); constexpr int NV = MS * DM / 4;
        for (int i = blockIdx.x * 512 + tid; i < NV; i += gridDim.x * 512) y[i] = y[i] + ((sl[i] + sl[i + NV]) + (sl[i + 2 * NV] + sl[i + 3 * NV]));
    }
}
#ifndef MK_ONE_LAUNCH
#define MK_ONE_LAUNCH 1
#endif
#if MK_ONE_LAUNCH
__global__ void __launch_bounds__(512, 2) mk_fwd(Args args) {
    extern __shared__ __attribute__((aligned(16))) unsigned char lds[];
    const int tid = threadIdx.x;
    volatile __attribute__((address_space(3))) unsigned* bst = (volatile __attribute__((address_space(3))) unsigned*)((__attribute__((address_space(3))) unsigned char*)lds + LDS_BYTES - 16);
    if (tid < 2) bst[tid] = 0u;
    __syncthreads();
    const XcdBarrier bar = xcd_barrier_post((unsigned*)(args.ws + WS_CTL) + CW_BAR, bst);
    if (args.ph_lo < 0) { __syncthreads(); cg::this_grid().sync(); }
#define SEAM(k) xcd_barrier(bar)
#define PHASE(k) do { if (args.ph_lo <= (k) && (k) < args.ph_hi) { if ((k) > args.ph_lo) SEAM(k); run_phase<k>(args, lds, tid, 0); \
        if ((PROBE_MASK >> (k)) & 1) { xcd_barrier(bar); run_phase<k>(args, lds, tid, 1); } } } while (0)
    PHASE(0); PHASE(1); PHASE(2); PHASE(3); PHASE(4); PHASE(5); PHASE(6); PHASE(7); PHASE(9); PHASE(10); PHASE(11);
#undef PHASE
#undef SEAM
}
#else
template <int PH> __global__ void __launch_bounds__(512, 2) mk_phase(Args args) {
    extern __shared__ __attribute__((aligned(16))) unsigned char lds[];
    run_phase<PH>(args, lds, threadIdx.x, 0);
}
#endif

extern "C" void kernel_launch(void* const* d_in, const int* in_sizes, int n_in, void* d_out, int out_size, void* d_ws, size_t ws_size, hipStream_t stream) {
    static int grid = 0;
    if (grid == 0) {
        if (n_in != 28 || out_size != (int)OUT_TOTAL || ws_size < WS_END) { fprintf(stderr, "kernel_launch: unexpected shapes (n_in %d, out %d, ws %zu)\n", n_in, out_size, ws_size); grid = -1; return; }
        int dev = 0, cus = 0, per_cu = 0;
        (void)hipGetDevice(&dev); (void)hipDeviceGetAttribute(&cus, hipDeviceAttributeMultiprocessorCount, dev);
#if MK_ONE_LAUNCH
        if (hipFuncSetAttribute((const void*)mk_fwd, hipFuncAttributeMaxDynamicSharedMemorySize, LDS_BYTES) != hipSuccess) { fprintf(stderr, "kernel_launch: hipFuncSetAttribute failed\n"); grid = -1; return; }
        (void)hipOccupancyMaxActiveBlocksPerMultiprocessor(&per_cu, (const void*)mk_fwd, 512, LDS_BYTES);
        (void)hipGetLastError();
        if (per_cu < 1) { fprintf(stderr, "kernel_launch: occupancy query says %d blocks per CU\n", per_cu); per_cu = 1; }
#else
#define SETATTR(k) (void)hipFuncSetAttribute((const void*)mk_phase<k>, hipFuncAttributeMaxDynamicSharedMemorySize, LDS_BYTES)
        SETATTR(0); SETATTR(1); SETATTR(2); SETATTR(3); SETATTR(4); SETATTR(5); SETATTR(6); SETATTR(7); SETATTR(8); SETATTR(9); SETATTR(10); SETATTR(11);
#undef SETATTR
        (void)per_cu;
#endif
        grid = cus;
    }
    if (grid < 0) return;
    (void)hipMemsetAsync((char*)d_ws + WS_CTL, 0, CTL_BYTES, stream);
    Args a{};
    for (int i = 0; i < 28; ++i) a.in[i] = (const float*)d_in[i];
    a.out = (float*)d_out; a.ws = (unsigned char*)d_ws;
#if MK_ONE_LAUNCH
    a.ph_lo = 0; a.ph_hi = N_PHASES;
    void* kargs[] = {&a};
    hipError_t e = hipLaunchCooperativeKernel((const void*)mk_fwd, dim3(grid), dim3(512), kargs, LDS_BYTES, stream);
    if (e != hipSuccess) fprintf(stderr, "kernel_launch: cooperative launch failed: %s (grid %d)\n", hipGetErrorString(e), grid);
#else
#define LAUNCH(k) hipLaunchKernelGGL(mk_phase<k>, dim3(grid), dim3(512), LDS_BYTES, stream, a)
    a.ph_lo = 0; a.ph_hi = N_PHASES;
    LAUNCH(0); LAUNCH(1); LAUNCH(2); LAUNCH(3); LAUNCH(4); LAUNCH(5); LAUNCH(6); LAUNCH(7); LAUNCH(9); LAUNCH(10); LAUNCH(11);
#undef LAUNCH
#endif
}
```

```cpp
#include <hip/hip_runtime.h>
#include <hip/hip_cooperative_groups.h>
#include <cstdio>
#include <cstdint>
namespace cg = cooperative_groups;
#define LBAR() asm volatile("s_waitcnt lgkmcnt(0)\n\ts_barrier" ::: "memory")
#define PROBE_A1 0
#define PROBE_A2 0
#define PROBE_A3 0
namespace pg8 {
#define PG8_LAS __attribute__((address_space(3)))
typedef unsigned short bf16_t;
typedef short bf16x8 __attribute__((ext_vector_type(8)));
typedef float f32x4 __attribute__((ext_vector_type(4)));
typedef unsigned u32x4 __attribute__((ext_vector_type(4)));
constexpr int BM = 256, BK = 64, HALF = 128, HTB = HALF * BK * 2  , STAGE_BYTES = 8 * HTB, NXCD = 8, WGM = 8;

__host__ __device__ __forceinline__ int lds_byte(int r, int c) { const int st = (r >> 4) * 2 + (c >> 5), rr = r & 15, cc = c & 31, ob = rr * 64 + cc * 2; return st * 1024 + (ob ^ (((ob >> 9) & 1) << 5)); }
__host__ __device__ __forceinline__ void stage_rc(int b, int& R, int& C) { const int st = b / 1024, sb = b % 1024, swz = sb ^ (((sb >> 9) & 1) << 5); R = (st >> 1) * 16 + swz / 64; C = (st & 1) * 32 + (swz % 64) / 2; }
__host__ __device__ __forceinline__ int perm32(int rho) { const int n = rho >> 4, i = rho & 15; return 8 * (i >> 2) + 4 * n + (i & 3); }

struct Unit { int pm, pn; };
struct Gemm { const bf16_t* A; const bf16_t* Bt; int M, N, K, KL; };

struct StaticOrder {
    int nM, nN, nwg, G, c;
    __host__ __device__ void init(int M, int N, int G_, int c_) { nM = M / BM; nN = N / BM; nwg = nM * nN; G = G_; c = c_; }
    __host__ __device__ bool next(int i, Unit& u) const {
        const long L = (long)i * G + c; if (L >= nwg) return false;
        int wgid = (int)L; { const int q = nwg / NXCD, r = nwg % NXCD, xcd = wgid % NXCD, off = wgid / NXCD; wgid = (xcd < r ? xcd * (q + 1) : r * (q + 1) + (xcd - r) * q) + off; }
        const int nig = WGM * nN, gid = wgid / nig, fm = gid * WGM, gsz = (nM - fm) < WGM ? (nM - fm) : WGM;
        u.pm = fm + ((wgid % nig) % gsz); u.pn = (wgid % nig) / gsz; return true;
    }
    __device__ __forceinline__ void a_ready(const Unit&) const {}
    __device__ __forceinline__ void done(const Unit&) const {}
};


__device__ __forceinline__ unsigned cvt_pk_bf16(float lo, float hi) { unsigned r; asm volatile("v_cvt_pk_bf16_f32 %0, %1, %2" : "=v"(r) : "v"(lo), "v"(hi)); return r; }

constexpr int E_MP = 16384;
constexpr int E_ZRW = 1632, E_ZSW = 1696;

struct OneUnit { Unit u; bool has;
    __device__ __forceinline__ bool next(int i, Unit& o) const { if (i == 0 && has) { o = u; return true; } return false; }
    __device__ __forceinline__ void a_ready(const Unit&) const {}
    __device__ __forceinline__ void done(const Unit&) const {} };
struct EpiZ {
    static constexpr bool PERM = true, AFTER_DRAIN = false;
    bf16_t* ZR; bf16_t* ZS;
    __device__ __forceinline__ void operator()(const f32x4 (&acc)[2][2][4][2], const Unit& u, int wr, int wc, int fr, int fq) const {
        const int row0 = u.pm * BM + wr * 64 + fr, c0 = u.pn * BM + wc * 32 + 8 * fq;
#pragma unroll
        for (int ai = 0; ai < 2; ++ai)
#pragma unroll
            for (int m = 0; m < 4; ++m) { const size_t row = (size_t)(row0 + ai * HALF + m * 16);
#pragma unroll
                for (int bj = 0; bj < 2; ++bj) { const int c = c0 + bj * HALF; bf16_t* dst;
                    if (c < 1600) dst = ZR + row * E_ZRW + c; else if (c < 3296) dst = ZS + row * E_ZSW + (c - 1600); else if (c == 3296) dst = ZR + row * E_ZRW + 1600; else continue;
                    const f32x4 v0 = acc[ai][bj][m][0], v1 = acc[ai][bj][m][1]; u32x4 w;
                    w.x = cvt_pk_bf16(v0[0], v0[1]); w.y = cvt_pk_bf16(v0[2], v0[3]); w.z = cvt_pk_bf16(v1[0], v1[1]); w.w = cvt_pk_bf16(v1[2], v1[3]);
                    *(u32x4*)dst = w; } }
    }
};
struct EpiH {
    static constexpr bool PERM = false, AFTER_DRAIN = false;
    const float* xp; const float* xs; float* H; bf16_t* HB; float* SS;
    __device__ __forceinline__ void operator()(const f32x4 (&acc)[2][2][4][2], const Unit& u, int wr, int wc, int fr, int fq) const {
        const int row0 = u.pm * BM + wr * 64 + fr, col0 = u.pn * BM + wc * 32 + 4 * fq;
#pragma unroll
        for (int ai = 0; ai < 2; ++ai)
#pragma unroll
            for (int m = 0; m < 4; ++m) { const int row = row0 + ai * HALF + m * 16;
                const float* xr = (row < E_MP ? xp + (size_t)row * 1024 : xs + (size_t)(row - E_MP) * 1024) + col0; float* hr = H + (size_t)row * 1024 + col0; bf16_t* hb = HB + (size_t)row * 1024 + col0;
                float ss = 0.f;
#pragma unroll
                for (int bj = 0; bj < 2; ++bj)
#pragma unroll
                    for (int n = 0; n < 2; ++n) { const f32x4 h = *(const f32x4*)(xr + bj * HALF + n * 16) + acc[ai][bj][m][n]; *(f32x4*)(hr + bj * HALF + n * 16) = h;
                        ss += (h[0] * h[0] + h[1] * h[1]) + (h[2] * h[2] + h[3] * h[3]);
                        unsigned w0 = cvt_pk_bf16(h[0], h[1]), w1 = cvt_pk_bf16(h[2], h[3]); typedef unsigned u32x2v __attribute__((ext_vector_type(2))); *(u32x2v*)(hb + bj * HALF + n * 16) = (u32x2v){w0, w1}; }
                ss += __shfl_xor(ss, 16); ss += __shfl_xor(ss, 32);
                if (fq == 0) atomicAdd(SS + row, ss); }
    }
};
struct EpiAct {
    static constexpr bool PERM = true, AFTER_DRAIN = false;
    bf16_t* O; int ldc; const float* SS;
    __device__ __forceinline__ void operator()(const f32x4 (&acc)[2][2][4][2], const Unit& u, int wr, int wc, int fr, int fq) const {
        const int row0 = u.pm * BM + wr * 64 + fr, c0 = u.pn * BM + wc * 32 + 8 * fq;
#pragma unroll
        for (int ai = 0; ai < 2; ++ai)
#pragma unroll
            for (int m = 0; m < 4; ++m) { const int row = row0 + ai * HALF + m * 16; bf16_t* rowp = O + (size_t)row * ldc + c0;
                const float rs = rsqrtf(SS[row] * (1.0f / 1024.0f) + 1e-6f);
#pragma unroll
                for (int bj = 0; bj < 2; ++bj) { f32x4 v0 = acc[ai][bj][m][0], v1 = acc[ai][bj][m][1];
#pragma unroll
                    for (int e = 0; e < 4; ++e) { const float a = fmaxf(v0[e], 0.f) * rs, b = fmaxf(v1[e], 0.f) * rs; v0[e] = a * a; v1[e] = b * b; }
                    u32x4 w; w.x = cvt_pk_bf16(v0[0], v0[1]); w.y = cvt_pk_bf16(v0[2], v0[3]); w.z = cvt_pk_bf16(v1[0], v1[1]); w.w = cvt_pk_bf16(v1[2], v1[3]);
                    *(u32x4*)(rowp + bj * HALF) = w; } }
    }
};
struct EpiSlab {
    static constexpr bool PERM = false, AFTER_DRAIN = false;
    float* S;
    __device__ __forceinline__ void operator()(const f32x4 (&acc)[2][2][4][2], const Unit& u, int wr, int wc, int fr, int fq) const {
        const int row0 = u.pm * BM - E_MP + wr * 64 + fr, col0 = u.pn * BM + wc * 32 + 4 * fq;
#pragma unroll
        for (int ai = 0; ai < 2; ++ai)
#pragma unroll
            for (int m = 0; m < 4; ++m) { float* yr = S + (size_t)(row0 + ai * HALF + m * 16) * 1024 + col0;
#pragma unroll
                for (int bj = 0; bj < 2; ++bj)
#pragma unroll
                    for (int n = 0; n < 2; ++n) *(f32x4*)(yr + bj * HALF + n * 16) = acc[ai][bj][m][n]; }
    }
};
struct EpiY {
    static constexpr bool PERM = false, AFTER_DRAIN = false;
    float* Y;
    __device__ __forceinline__ void operator()(const f32x4 (&acc)[2][2][4][2], const Unit& u, int wr, int wc, int fr, int fq) const {
        const int row0 = u.pm * BM + wr * 64 + fr, col0 = u.pn * BM + wc * 32 + 4 * fq;
#pragma unroll
        for (int ai = 0; ai < 2; ++ai)
#pragma unroll
            for (int m = 0; m < 4; ++m) { float* yr = Y + (size_t)(row0 + ai * HALF + m * 16) * 1024 + col0;
#pragma unroll
                for (int bj = 0; bj < 2; ++bj)
#pragma unroll
                    for (int n = 0; n < 2; ++n) { f32x4* p = (f32x4*)(yr + bj * HALF + n * 16); *p = *p + acc[ai][bj][m][n]; } }
    }
};

template <class Epi, class Sched, bool ALIGN_EPI = false, bool SP2 = false>
__device__ __forceinline__ void gemm_phase(PG8_LAS unsigned char* lds, const Gemm g, const Sched& S, const Epi& E) {
    const int tid = threadIdx.x, wid = __builtin_amdgcn_readfirstlane(tid >> 6), lane = tid & 63, wr = wid >> 2, wc = wid & 3, fr = lane & 15, fq = lane >> 4;
    const int K = g.K, nt = g.KL / BK;
    unsigned voffA[2], voffB[2];
#pragma unroll
    for (int i = 0; i < 2; ++i) { int R, C; stage_rc(tid * 16 + i * 8192, R, C); const int Rb = Epi::PERM ? ((R & ~31) + perm32(R & 31)) : R;
        voffA[i] = (unsigned)(R * K + C) * 2u; voffB[i] = (unsigned)(Rb * K + C) * 2u; }
    const size_t kstep = (size_t)(BK * 2);
    const size_t hstep = (size_t)HALF * K * 2;
    const size_t tstep = 2 * hstep;
    const unsigned ldsw = (unsigned)wid * 1024u;
    const int aoff = lds_byte(wr * 64 + fr, fq * 8), boff = lds_byte(wc * 32 + fr, fq * 8);
#define PG8_SA(b, h) (((b) * 2 + (h)) * HTB)
#define PG8_SB(b, h) ((4 + (b) * 2 + (h)) * HTB)
#define PG8_STAGE(bufoff, gbase, voff) do { _Pragma("unroll") for (int _i = 0; _i < 2; ++_i) \
        __builtin_amdgcn_global_load_lds((const unsigned*)((const char*)(gbase) + (voff)[_i]), (PG8_LAS unsigned*)(lds + (bufoff) + ldsw + _i * 8192), 16, 0, 0); } while (0)
#define PG8_LDA(dst, b, h) do { _Pragma("unroll") for (int m = 0; m < 4; ++m) _Pragma("unroll") for (int k = 0; k < 2; ++k) dst[m][k] = *(const PG8_LAS bf16x8*)(lds + PG8_SA(b, h) + aoff + m * 2048 + k * 1024); } while (0)
#define PG8_LDB(dst, b, h) do { _Pragma("unroll") for (int n = 0; n < 2; ++n) _Pragma("unroll") for (int k = 0; k < 2; ++k) dst[n][k] = *(const PG8_LAS bf16x8*)(lds + PG8_SB(b, h) + boff + n * 2048 + k * 1024); } while (0)
#define PG8_MMA(ai, bj, At, Bt) do { __builtin_amdgcn_s_setprio(1); _Pragma("unroll") for (int m = 0; m < 4; ++m) _Pragma("unroll") for (int n = 0; n < 2; ++n) _Pragma("unroll") for (int k = 0; k < 2; ++k) \
        acc[ai][bj][m][n] = __builtin_amdgcn_mfma_f32_16x16x32_bf16(Bt[n][k], At[m][k], acc[ai][bj][m][n], 0, 0, 0); __builtin_amdgcn_s_setprio(0); } while (0)
#define PG8_WAIT_V(n) asm volatile("s_waitcnt vmcnt(" #n ")" ::: "memory")
#define PG8_WAIT_L(n) asm volatile("s_waitcnt lgkmcnt(" #n ")" ::: "memory")
#define PG8_BAR __builtin_amdgcn_s_barrier()
#define PG8_SCHED __builtin_amdgcn_sched_barrier(0)
    Unit cur, nxt; int ui = 0;
    if (!S.next(0, cur)) return;
    f32x4 acc[2][2][4][2];
#pragma unroll
    for (int a = 0; a < 2; ++a)
#pragma unroll
        for (int b = 0; b < 2; ++b)
#pragma unroll
            for (int m = 0; m < 4; ++m)
#pragma unroll
                for (int n = 0; n < 2; ++n) acc[a][b][m][n] = (f32x4){0.f, 0.f, 0.f, 0.f};
    bf16x8 At[4][2], B0[2][2], B1[2][2];
    const char* cA = (const char*)g.A + (size_t)cur.pm * tstep; const char* cB = (const char*)g.Bt + (size_t)cur.pn * tstep;
    S.a_ready(cur);
    if constexpr (SP2) {
        PG8_STAGE(PG8_SB(0, 0), cB, voffB); PG8_STAGE(PG8_SB(0, 1), cB + hstep, voffB); PG8_STAGE(PG8_SA(0, 0), cA, voffA); PG8_STAGE(PG8_SA(0, 1), cA + hstep, voffA);
        if (wr == 1) PG8_BAR;
        PG8_WAIT_V(2); PG8_BAR;
        PG8_STAGE(PG8_SB(1, 0), cB + kstep, voffB); PG8_STAGE(PG8_SA(1, 0), cA + kstep, voffA); PG8_STAGE(PG8_SB(1, 1), cB + hstep + kstep, voffB);
        PG8_WAIT_V(6); PG8_BAR;
    } else {
        PG8_STAGE(PG8_SB(0, 0), cB, voffB); PG8_STAGE(PG8_SA(0, 0), cA, voffA); PG8_STAGE(PG8_SB(0, 1), cB + hstep, voffB); PG8_STAGE(PG8_SA(0, 1), cA + hstep, voffA);
        if (wr == 1) PG8_BAR;
        PG8_WAIT_V(4); PG8_BAR;
        PG8_STAGE(PG8_SB(1, 0), cB + kstep, voffB); PG8_STAGE(PG8_SA(1, 0), cA + kstep, voffA); PG8_STAGE(PG8_SB(1, 1), cB + hstep + kstep, voffB);
        PG8_WAIT_V(6); PG8_BAR;
    }
    for (;;) {
        const bool has_next = S.next(ui + 1, nxt);
        const char* nA = has_next ? (const char*)g.A + (size_t)nxt.pm * tstep : cA; const char* nB = has_next ? (const char*)g.Bt + (size_t)nxt.pn * tstep : cB;
        for (int t = 0; t < nt; t += 2) {
            const bool last = (t == nt - 2);
            const char* a1 = cA + (size_t)(t + 1) * kstep;
            const char* a2 = last ? nA : cA + (size_t)(t + 2) * kstep; const char* b2 = last ? nB : cB + (size_t)(t + 2) * kstep;
            const char* a3 = a2 + kstep; const char* b3 = b2 + kstep;
            if (last && has_next) S.a_ready(nxt);
            if constexpr (SP2) {
            PG8_LDB(B0, 0, 0); PG8_LDB(B1, 0, 1); PG8_SCHED; PG8_LDA(At, 0, 0); PG8_STAGE(PG8_SA(1, 1), a1 + hstep, voffA);
            PG8_WAIT_V(8); PG8_WAIT_L(0); PG8_BAR; PG8_MMA(0, 0, At, B0); PG8_MMA(0, 1, At, B1); PG8_BAR; PG8_SCHED;
            PG8_LDA(At, 0, 1); PG8_STAGE(PG8_SB(0, 0), b2, voffB); PG8_STAGE(PG8_SB(0, 1), b2 + hstep, voffB); PG8_STAGE(PG8_SA(0, 0), a2, voffA);
            PG8_WAIT_V(8); PG8_WAIT_L(0); PG8_BAR; PG8_MMA(1, 0, At, B0); PG8_MMA(1, 1, At, B1); PG8_BAR; PG8_SCHED;
            PG8_LDB(B0, 1, 0); PG8_LDB(B1, 1, 1); PG8_SCHED; PG8_LDA(At, 1, 0); PG8_STAGE(PG8_SA(0, 1), a2 + hstep, voffA);
            PG8_WAIT_V(8); PG8_WAIT_L(0); PG8_BAR; PG8_MMA(0, 0, At, B0); PG8_MMA(0, 1, At, B1); PG8_BAR; PG8_SCHED;
            PG8_LDA(At, 1, 1); PG8_STAGE(PG8_SB(1, 0), b3, voffB); PG8_STAGE(PG8_SB(1, 1), b3 + hstep, voffB); PG8_STAGE(PG8_SA(1, 0), a3, voffA);
            PG8_WAIT_V(8); PG8_WAIT_L(0); PG8_BAR; PG8_MMA(1, 0, At, B0); PG8_MMA(1, 1, At, B1); PG8_BAR; PG8_SCHED;
            } else {
            PG8_LDB(B0, 0, 0); PG8_SCHED; PG8_LDA(At, 0, 0); PG8_STAGE(PG8_SA(1, 1), a1 + hstep, voffA);
            PG8_WAIT_L(8); PG8_BAR; PG8_WAIT_L(0); PG8_MMA(0, 0, At, B0); PG8_BAR; PG8_SCHED;
            PG8_LDB(B1, 0, 1); PG8_STAGE(PG8_SB(0, 0), b2, voffB);
            PG8_BAR; PG8_WAIT_L(0); PG8_MMA(0, 1, At, B1); PG8_BAR;
            PG8_LDA(At, 0, 1); PG8_STAGE(PG8_SA(0, 0), a2, voffA);
            PG8_BAR; PG8_WAIT_L(0); PG8_MMA(1, 0, At, B0); PG8_BAR; PG8_SCHED;
            PG8_STAGE(PG8_SB(0, 1), b2 + hstep, voffB);
            PG8_WAIT_V(6); PG8_BAR; PG8_MMA(1, 1, At, B1); PG8_BAR;
            PG8_LDB(B0, 1, 0); PG8_SCHED; PG8_LDA(At, 1, 0); PG8_STAGE(PG8_SA(0, 1), a2 + hstep, voffA);
            PG8_WAIT_L(8); PG8_BAR; PG8_WAIT_L(0); PG8_MMA(0, 0, At, B0); PG8_BAR; PG8_SCHED;
            PG8_LDB(B1, 1, 1); PG8_STAGE(PG8_SB(1, 0), b3, voffB);
            PG8_BAR; PG8_WAIT_L(0); PG8_MMA(0, 1, At, B1); PG8_BAR;
            PG8_LDA(At, 1, 1); PG8_STAGE(PG8_SA(1, 0), a3, voffA);
            PG8_BAR; PG8_WAIT_L(0); PG8_MMA(1, 0, At, B0); PG8_BAR; PG8_SCHED;
            PG8_STAGE(PG8_SB(1, 1), b3 + hstep, voffB);
            PG8_WAIT_V(6); PG8_BAR; PG8_MMA(1, 1, At, B1); PG8_BAR;
            }
        }
        if constexpr (ALIGN_EPI) { if (wr == 0) PG8_BAR; }
        if constexpr (!Epi::AFTER_DRAIN) { E(acc, cur, wr, wc, fr, fq); S.done(cur); }
        if (!has_next) break;
#pragma unroll
        for (int a = 0; a < 2; ++a)
#pragma unroll
            for (int b = 0; b < 2; ++b)
#pragma unroll
                for (int m = 0; m < 4; ++m)
#pragma unroll
                    for (int n = 0; n < 2; ++n) acc[a][b][m][n] = (f32x4){0.f, 0.f, 0.f, 0.f};
        cur = nxt; cA = nA; cB = nB; ++ui;
        if constexpr (ALIGN_EPI) { if (wr == 1) PG8_BAR; }
    }
    PG8_WAIT_V(0);
    if constexpr (!ALIGN_EPI) { if (wr == 0) PG8_BAR; }
    PG8_BAR;
    if constexpr (Epi::AFTER_DRAIN) { E.fused(acc, cur, wr, wc, fr, fq, lds, wid, lane); S.done(cur); }
#undef PG8_SA
#undef PG8_SB
#undef PG8_STAGE
#undef PG8_LDA
#undef PG8_LDB
#undef PG8_MMA
#undef PG8_WAIT_V
#undef PG8_WAIT_L
#undef PG8_BAR
#undef PG8_SCHED
}
}


constexpr int DM = 1024, NB_P = 8, T_P = 2048, NB_S = 32, T_S = 32, PAST = 1024;
constexpr int MP = NB_P * T_P, MS = NB_S * T_S, MT = MP + MS;
constexpr int LS = PAST + T_S;
constexpr int SHIFTW = 1696, NZ = 3328, ZRW = 1632, DFF = 4096;
constexpr float QSCALE = 0.125f * 1.4426950408889634f;
constexpr float WISCALE = 0.35355339059327373f * 0.125f;
constexpr size_t OFF_Y = 0, OFF_KP = 17825792, OFF_VP = OFF_KP + 4194304, OFF_KIP = OFF_VP + 4194304, OFF_WKVP = OFF_KIP + 1048576, OFF_SHP = OFF_WKVP + 262144,
                 OFF_KS = OFF_SHP + 13568, OFF_VS = OFF_KS + 262144, OFF_KIS = OFF_VS + 262144, OFF_WKVS = OFF_KIS + 65536, OFF_SHS = OFF_WKVS + 1048576, OUT_TOTAL = OFF_SHS + 54272;
constexpr size_t MiB = 1u << 20;
constexpr size_t WS_CTL = 0, CTL_BYTES = 1 * MiB;
constexpr size_t WS_WIN = 1 * MiB, WS_WOUT = 8 * MiB, WS_W1 = 10 * MiB, WS_W2 = 18 * MiB;
constexpr size_t WS_W2T = 26 * MiB, WS_A2T = WS_W2T + 32768, WS_G2T = WS_A2T + 32768, WS_WI = 27 * MiB, WS_BONUS = 28 * MiB;
constexpr size_t WS_XB = 30 * MiB;
constexpr size_t WS_ZS = 66 * MiB;
constexpr size_t WS_R = 123 * MiB;
constexpr size_t WS_ZR = WS_R, WS_KBP = 178 * MiB, WS_VTP = 186 * MiB, WS_KIP = 194 * MiB, WS_KBS = 196 * MiB, WS_VTS = 213 * MiB, WS_KIS = 230 * MiB;
constexpr size_t WS_OW = WS_R, WS_OKK = 157 * MiB, WS_OB = 174 * MiB, WS_OKM = 191 * MiB, WS_OR = 208 * MiB, WS_OV = 225 * MiB;
constexpr size_t WS_ACT = 66 * MiB, WS_HB = 202 * MiB, WS_END = 256 * MiB;
static_assert(WS_ZS + (size_t)MT * SHIFTW * 2 <= WS_R && WS_ZR + (size_t)MT * ZRW * 2 <= WS_KBP && WS_KBS + (size_t)NB_S * LS * 256 * 2 <= WS_VTS && WS_VTS + (size_t)NB_S * 256 * LS * 2 <= WS_KIS &&
              WS_KIS + (size_t)NB_S * LS * 64 * 2 <= WS_END && WS_OV + (size_t)MT * 512 * 2 <= WS_END && WS_ACT + (size_t)MT * DFF * 2 <= WS_HB && WS_HB + (size_t)MT * DM * 2 <= WS_END, "d_ws map");
constexpr size_t SC_Q = 0, SC_QI = (size_t)MT * 512 / 2, SC_Y = 0, SC_G = (size_t)MT * 512;
constexpr int CW_QATT = 64, CW_SS = 16384;

typedef unsigned short bf16;
typedef short bf16x8 __attribute__((ext_vector_type(8)));
typedef float f32x4 __attribute__((ext_vector_type(4)));
typedef float f32x16 __attribute__((ext_vector_type(16)));
typedef unsigned u32x4 __attribute__((ext_vector_type(4)));
typedef unsigned u32x2 __attribute__((ext_vector_type(2)));

__device__ __forceinline__ unsigned f2bf(float f) { unsigned u = __float_as_uint(f); return (u + 0x7fffu + ((u >> 16) & 1u)) >> 16; }
__device__ __forceinline__ unsigned pk2(float lo, float hi) { return f2bf(lo) | (f2bf(hi) << 16); }
__device__ __forceinline__ float bflo(unsigned w) { return __uint_as_float(w << 16); }
__device__ __forceinline__ float bfhi(unsigned w) { return __uint_as_float(w & 0xffff0000u); }
__device__ __forceinline__ float bf1(bf16 b) { return __uint_as_float((unsigned)b << 16); }
__device__ __forceinline__ void unpack8(const u32x4 w, float* x) { x[0] = bflo(w.x); x[1] = bfhi(w.x); x[2] = bflo(w.y); x[3] = bfhi(w.y); x[4] = bflo(w.z); x[5] = bfhi(w.z); x[6] = bflo(w.w); x[7] = bfhi(w.w); }
__device__ __forceinline__ u32x4 pack8(const float* x) { u32x4 w; w.x = pk2(x[0], x[1]); w.y = pk2(x[2], x[3]); w.z = pk2(x[4], x[5]); w.w = pk2(x[6], x[7]); return w; }
__device__ __forceinline__ float wave_sum(float v) {
#pragma unroll
    for (int o = 1; o < 64; o <<= 1) v += __shfl_xor(v, o);
    return v;
}
template <int CTRL> __device__ __forceinline__ float dppmov(float x) { return __builtin_bit_cast(float, __builtin_amdgcn_update_dpp(0, __builtin_bit_cast(int, x), CTRL, 0xf, 0xf, true)); }
__device__ __forceinline__ float sum16(float x) {
    x += dppmov<0xB1>(x); x += dppmov<0x4E>(x); x += dppmov<0x141>(x); x += dppmov<0x140>(x); return x;
}
__device__ __forceinline__ int crow(int r, int hi) { return (r & 3) + 8 * (r >> 2) + 4 * hi; }

struct Args { const float* in[28]; float* out; unsigned char* ws; int ph_lo, ph_hi; };

__device__ __forceinline__ void tr_item(const float* W, int K, int N, const float* gain, bf16* WT, int jr0, int c0, int nvalid, int k0, float* scr, int lane) {
#pragma unroll 8
    for (int i = 0; i < 32; ++i) { const int kk = 2 * i + (lane >> 5), n = lane & 31;
        float v = (n < nvalid) ? W[(size_t)(k0 + kk) * N + c0 + n] : 0.f; if (gain) v *= gain[k0 + kk]; scr[kk * 33 + n] = v; }
    __builtin_amdgcn_s_waitcnt(0xC07F); asm volatile("" ::: "memory");
    const int c = lane & 7;
#pragma unroll
    for (int j = 0; j < 4; ++j) { const int n = (lane >> 3) + 8 * j; const float* s = scr + (8 * c) * 33 + n;
        u32x4 o; o.x = pk2(s[0 * 33], s[1 * 33]); o.y = pk2(s[2 * 33], s[3 * 33]); o.z = pk2(s[4 * 33], s[5 * 33]); o.w = pk2(s[6 * 33], s[7 * 33]);
        *(u32x4*)(WT + (size_t)(jr0 + n) * K + k0 + 8 * c) = o; }
    __builtin_amdgcn_s_waitcnt(0xC07F); asm volatile("" ::: "memory");
}
__device__ __forceinline__ void p0_prologue(const Args& a, unsigned char* lds, int tid) {
    const int lane = tid & 63, wave = tid >> 6, gw = blockIdx.x * 8 + wave, NGW = gridDim.x * 8;
    float* scr = (float*)(lds + wave * 17408);
    unsigned char* ws = a.ws;
    constexpr int I_IN = (NZ / 32) * (DM / 64), I_OUT = (DM / 32) * (DM / 64), I_F1 = (DFF / 32) * (DM / 64), I_F2 = (DM / 32) * (DFF / 64);
    for (int it = gw; it < I_IN + I_OUT + I_F1 + I_F2; it += NGW) {
        int r = it;
        if (r < I_IN) { const int jb = r % (NZ / 32), kb = r / (NZ / 32), j0 = jb * 32; int c0, nv;
            if (j0 < 1600) { c0 = j0; nv = 32; } else if (j0 < 3296) { c0 = 1608 + (j0 - 1600); nv = 32; } else { c0 = 1600; nv = 8; }
            tr_item(a.in[8], DM, 3304, a.in[7], (bf16*)(ws + WS_WIN), j0, c0, nv, kb * 64, scr, lane); continue; }
        r -= I_IN;
        if (r < I_OUT) { const int jb = r % (DM / 32), kb = r / (DM / 32); tr_item(a.in[24], DM, DM, nullptr, (bf16*)(ws + WS_WOUT), jb * 32, jb * 32, 32, kb * 64, scr, lane); continue; }
        r -= I_OUT;
        if (r < I_F1) { const int jb = r % (DFF / 32), kb = r / (DFF / 32); tr_item(a.in[26], DM, DFF, a.in[25], (bf16*)(ws + WS_W1), jb * 32, jb * 32, 32, kb * 64, scr, lane); continue; }
        r -= I_F1;
        { const int jb = r % (DM / 32), kb = r / (DM / 32); tr_item(a.in[27], DFF, DM, nullptr, (bf16*)(ws + WS_W2), jb * 32, jb * 32, 32, kb * 64, scr, lane); }
    }
    { const int gt = blockIdx.x * 512 + tid, NT = gridDim.x * 512;
      bf16* w2t = (bf16*)(ws + WS_W2T); bf16* a2t = (bf16*)(ws + WS_A2T); bf16* g2t = (bf16*)(ws + WS_G2T);
      for (int i = gt; i < 512 * 32; i += NT) { const int n = i >> 5, k = i & 31; w2t[i] = (bf16)f2bf(a.in[15][k * 512 + n]); a2t[i] = (bf16)f2bf(a.in[17][k * 512 + n]); }
      for (int i = gt; i < 512 * 96; i += NT) { const int n = i / 96, k = i % 96; g2t[i] = (bf16)f2bf(a.in[18][k * 512 + n]); } }
    { f32x4 v[4], nx[4]; int m = gw;
      if (m < MT) { const f32x4* xr = (const f32x4*)((m < MP) ? a.in[0] + (size_t)m * DM : a.in[1] + (size_t)(m - MP) * DM) + lane;
#pragma unroll
          for (int j = 0; j < 4; ++j) v[j] = xr[64 * j]; }
      for (; m < MT; m += NGW) {
        const int mn = m + NGW;
        if (mn < MT) { const f32x4* xr = (const f32x4*)((mn < MP) ? a.in[0] + (size_t)mn * DM : a.in[1] + (size_t)(mn - MP) * DM) + lane;
#pragma unroll
            for (int j = 0; j < 4; ++j) nx[j] = xr[64 * j]; }
        float s = 0.f;
#pragma unroll
        for (int j = 0; j < 4; ++j) s += (v[j].x * v[j].x + v[j].y * v[j].y) + (v[j].z * v[j].z + v[j].w * v[j].w);
        const float rs = rsqrtf(wave_sum(s) * (1.f / DM) + 1e-6f);
        u32x2* o8 = (u32x2*)((bf16*)(ws + WS_XB) + (size_t)m * DM) + lane;
#pragma unroll
        for (int j = 0; j < 4; ++j) { u32x2 o; o.x = pk2(v[j].x * rs, v[j].y * rs); o.y = pk2(v[j].z * rs, v[j].w * rs); o8[64 * j] = o; }
#pragma unroll
        for (int j = 0; j < 4; ++j) v[j] = nx[j];
      } }
    for (int r4 = gw; r4 < NB_S * PAST / 4; r4 += NGW) {
        f32x4 v[4];
#pragma unroll
        for (int j = 0; j < 4; ++j) v[j] = ((const f32x4*)(a.in[2] + (size_t)(4 * r4 + j) * 256))[lane];
#pragma unroll
        for (int j = 0; j < 4; ++j) { const int rix = 4 * r4 + j, b = rix >> 10, p = rix & 1023; u32x2 o; o.x = pk2(v[j].x, v[j].y); o.y = pk2(v[j].z, v[j].w);
            ((u32x2*)((bf16*)(ws + WS_KBS) + ((size_t)b * LS + p) * 256))[lane] = o; }
    }
    for (int r4 = gw; r4 < NB_S * PAST / 4; r4 += NGW) {
        const int rix = r4 * 4 + (lane >> 4), b = rix >> 10, p = rix & 1023; const f32x4 v = ((const f32x4*)(a.in[4] + (size_t)rix * 64))[lane & 15];
        u32x2 o; o.x = pk2(v.x, v.y); o.y = pk2(v.z, v.w); ((u32x2*)((bf16*)(ws + WS_KIS) + ((size_t)b * LS + p) * 64))[lane & 15] = o;
    }
    for (int it = gw; it < NB_S * 4 * 16; it += NGW) {
        const int kb = it & 15, g = (it >> 4) & 3, b = it >> 6;
        const float* src = a.in[3] + ((size_t)b * PAST + kb * 64) * 256 + g * 64;
#pragma unroll 8
        for (int i = 0; i < 64; ++i) scr[i * 65 + lane] = src[(size_t)i * 256 + lane];
        __builtin_amdgcn_s_waitcnt(0xC07F); asm volatile("" ::: "memory");
        bf16* dst = (bf16*)(ws + WS_VTS) + ((size_t)(b * 4 + g) * 64) * LS + kb * 64 + lane;
#pragma unroll 8
        for (int d = 0; d < 64; ++d) dst[(size_t)d * LS] = (bf16)f2bf(scr[lane * 65 + d]);
        __builtin_amdgcn_s_waitcnt(0xC07F); asm volatile("" ::: "memory");
    }
}

__device__ __forceinline__ void p2_post(const Args& a, unsigned char* lds, int tid) {
    unsigned char* ws = a.ws; float* out = a.out;
    const bf16* ZR = (const bf16*)(ws + WS_ZR); const bf16* ZS = (const bf16*)(ws + WS_ZS);
    bf16* Q = (bf16*)(out + SC_Q); bf16* QI = (bf16*)(out + SC_QI);
    float* cs = (float*)lds;
    bf16* vt = (bf16*)(lds + 4096);
    const int g8 = tid >> 3, sub = tid & 7;
    const float* qg = a.in[9]; const float* kg = a.in[10]; const float* lng = a.in[11]; const float* lnb = a.in[12];
    for (int unit = blockIdx.x; unit < 2 * (MT / 64); unit += gridDim.x) {
        const int tile = unit >> 1, part = unit & 1, hb0 = part ? 12 : 0, hb1 = part ? 25 : 12;
        const int m0 = tile * 64;
        { const int m = m0 + g8, pos = (m < MP) ? (m & (T_P - 1)) : (PAST + ((m - MP) & (T_S - 1)));
          const float inv = powf(500000.0f, -(float)sub * 0.125f); const float ang = (float)pos * inv; float s, c; sincosf(ang, &s, &c);
          cs[g8 * 16 + sub] = c; cs[g8 * 16 + 8 + sub] = s; }
        __syncthreads();
        const int m = m0 + g8;
        const bool isp = m < MP; const int ms = m - MP;
        float cc[8], ss[8];
#pragma unroll
        for (int j = 0; j < 8; ++j) { cc[j] = cs[g8 * 16 + j]; ss[j] = cs[g8 * 16 + 8 + j]; }
        const size_t kvrow = isp ? (size_t)m : ((size_t)(ms >> 5) * LS + PAST + (ms & 31));
        bf16* KB = (bf16*)(ws + (isp ? WS_KBP : WS_KBS)); bf16* KIb = (bf16*)(ws + (isp ? WS_KIP : WS_KIS));
        u32x4 xnext = *(const u32x4*)(ZR + (size_t)m * ZRW + hb0 * 64 + 8 * sub);
        for (int hb = hb0; hb < hb1; ++hb) {
            float x[8]; unpack8(xnext, x);
            if (hb + 1 < hb1) xnext = *(const u32x4*)(ZR + (size_t)m * ZRW + (hb + 1) * 64 + 8 * sub);
            if (hb < 12) {
                float s2 = 0.f;
#pragma unroll
                for (int j = 0; j < 8; ++j) s2 += x[j] * x[j];
                s2 += __shfl_xor(s2, 1); s2 += __shfl_xor(s2, 2); s2 += __shfl_xor(s2, 4);
                const float rinv = rsqrtf(s2 * (1.f / 64.f) + 1e-6f); const float* gn = (hb < 8 ? qg : kg) + 8 * sub;
                float y[8], o[8];
#pragma unroll
                for (int j = 0; j < 8; ++j) y[j] = x[j] * rinv * gn[j];
#pragma unroll
                for (int j = 0; j < 8; ++j) { const float p = __shfl_xor(y[j], 1); o[j] = sub == 0 ? y[j] * cc[j] - p * ss[j] : (sub == 1 ? y[j] * cc[j] + p * ss[j] : y[j]); }
                if (hb < 8) {
#pragma unroll
                    for (int j = 0; j < 8; ++j) o[j] *= QSCALE;
                    *(u32x4*)(Q + (size_t)m * 512 + hb * 64 + 8 * sub) = pack8(o);
                } else { const int g = hb - 8;
                    float* ko = out + (isp ? OFF_KP + (size_t)m * 256 : OFF_KS + (size_t)ms * 256) + g * 64 + 8 * sub;
                    *(f32x4*)ko = (f32x4){o[0], o[1], o[2], o[3]}; *(f32x4*)(ko + 4) = (f32x4){o[4], o[5], o[6], o[7]};
                    *(u32x4*)(KB + kvrow * 256 + g * 64 + 8 * sub) = pack8(o); }
            } else if (hb < 16) { const int g = hb - 12;
                float* vo = out + (isp ? OFF_VP + (size_t)m * 256 : OFF_VS + (size_t)ms * 256) + g * 64 + 8 * sub;
                *(f32x4*)vo = (f32x4){x[0], x[1], x[2], x[3]}; *(f32x4*)(vo + 4) = (f32x4){x[4], x[5], x[6], x[7]};
                unsigned* vd = (unsigned*)(vt + g8 * 258 + g * 64 + 8 * sub);
                vd[0] = pk2(x[0], x[1]); vd[1] = pk2(x[2], x[3]); vd[2] = pk2(x[4], x[5]); vd[3] = pk2(x[6], x[7]);
            } else if (hb < 24) {
                float o[8];
#pragma unroll
                for (int j = 0; j < 8; ++j) { const float p = __shfl_xor(x[j], 1); o[j] = sub == 0 ? x[j] * cc[j] - p * ss[j] : (sub == 1 ? x[j] * cc[j] + p * ss[j] : x[j]); }
                *(u32x4*)(QI + (size_t)m * 512 + (hb - 16) * 64 + 8 * sub) = pack8(o);
            } else {
                float s1 = 0.f;
#pragma unroll
                for (int j = 0; j < 8; ++j) s1 += x[j];
                s1 += __shfl_xor(s1, 1); s1 += __shfl_xor(s1, 2); s1 += __shfl_xor(s1, 4);
                const float mu = s1 * (1.f / 64.f); float s2 = 0.f;
#pragma unroll
                for (int j = 0; j < 8; ++j) { const float d = x[j] - mu; s2 += d * d; }
                s2 += __shfl_xor(s2, 1); s2 += __shfl_xor(s2, 2); s2 += __shfl_xor(s2, 4);
                const float rinv = rsqrtf(s2 * (1.f / 64.f) + 1e-6f); float y[8], o[8];
#pragma unroll
                for (int j = 0; j < 8; ++j) y[j] = (x[j] - mu) * rinv * lng[8 * sub + j] + lnb[8 * sub + j];
#pragma unroll
                for (int j = 0; j < 8; ++j) { const float p = __shfl_xor(y[j], 1); o[j] = sub == 0 ? y[j] * cc[j] - p * ss[j] : (sub == 1 ? y[j] * cc[j] + p * ss[j] : y[j]); }
                float* ko = out + (isp ? OFF_KIP + (size_t)m * 64 : OFF_KIS + (size_t)ms * 64) + 8 * sub;
                *(f32x4*)ko = (f32x4){o[0], o[1], o[2], o[3]}; *(f32x4*)(ko + 4) = (f32x4){o[4], o[5], o[6], o[7]};
                *(u32x4*)(KIb + kvrow * 64 + 8 * sub) = pack8(o);
            }
        }
        if (part == 0) ((float*)(ws + WS_WI))[(size_t)m * 8 + sub] = bf1(ZR[(size_t)m * ZRW + 1600 + sub]) * WISCALE;
        __syncthreads();
        if (part == 1) { const int r = tid >> 1, half = tid & 1; unsigned wv[16];
#pragma unroll
          for (int j = 0; j < 16; ++j) wv[j] = (unsigned)vt[(32 * half + 2 * j) * 258 + r] | ((unsigned)vt[(32 * half + 2 * j + 1) * 258 + r] << 16);
          bf16* dst;
          if (m0 < MP) dst = (bf16*)(ws + WS_VTP) + ((size_t)(m0 >> 11) * 256 + r) * T_P + (m0 & (T_P - 1)) + 32 * half;
          else { const int b = ((m0 - MP) >> 5) + half; dst = (bf16*)(ws + WS_VTS) + ((size_t)b * 256 + r) * LS + PAST; }
#pragma unroll
          for (int j = 0; j < 4; ++j) ((u32x4*)dst)[j] = (u32x4){wv[4 * j], wv[4 * j + 1], wv[4 * j + 2], wv[4 * j + 3]}; }
        if (part == 0) {} else if (m0 < MP) { if ((m0 & (T_P - 1)) == T_P - 64) { const int b = m0 >> 11; const bf16* zr = ZS + (size_t)(m0 + 63) * SHIFTW;
                for (int c = tid; c < SHIFTW; c += 512) out[OFF_SHP + (size_t)b * SHIFTW + c] = bf1(zr[c]); } }
        else { for (int h2 = 0; h2 < 2; ++h2) { const int b = ((m0 - MP) >> 5) + h2; const bf16* zr = ZS + (size_t)(m0 + 32 * h2 + 31) * SHIFTW;
                for (int c = tid; c < SHIFTW; c += 512) out[OFF_SHS + (size_t)b * SHIFTW + c] = bf1(zr[c]); } }
        __syncthreads();
    }
}

constexpr int ATT_UNITS = 544;
constexpr int MASK_PITCH = 65;
#define MFMA32(a, b, c) __builtin_amdgcn_mfma_f32_32x32x16_bf16((a), (b), (c), 0, 0, 0)

__device__ __forceinline__ float half_sum32(float v) { v += __shfl_xor(v, 1); v += __shfl_xor(v, 2); v += __shfl_xor(v, 4); v += __shfl_xor(v, 8); v += __shfl_xor(v, 16); return v; }
__device__ __forceinline__ float half_min32(float v) { v = fminf(v, __shfl_xor(v, 1)); v = fminf(v, __shfl_xor(v, 2)); v = fminf(v, __shfl_xor(v, 4)); v = fminf(v, __shfl_xor(v, 8)); v = fminf(v, __shfl_xor(v, 16)); return v; }
__device__ __forceinline__ float half_max32(float v) { v = fmaxf(v, __shfl_xor(v, 1)); v = fmaxf(v, __shfl_xor(v, 2)); v = fmaxf(v, __shfl_xor(v, 4)); v = fmaxf(v, __shfl_xor(v, 8)); v = fmaxf(v, __shfl_xor(v, 16)); return v; }
__device__ __forceinline__ int half_sum32i(int v) { v += __shfl_xor(v, 1); v += __shfl_xor(v, 2); v += __shfl_xor(v, 4); v += __shfl_xor(v, 8); v += __shfl_xor(v, 16); return v; }

#define LAS3 __attribute__((address_space(3)))
constexpr int A_RING1 = 0, A_SCL = 24576, A_RING2 = 24576, A_MASK = 0, A_LSUM = 8320, A_UNIT = 9344;
__device__ __forceinline__ void p3_attention(const Args& a, unsigned char* lds, int tid, int rep) {
    unsigned char* ws = a.ws; float* out = a.out;
    const bf16* Q = (const bf16*)(out + SC_Q); const bf16* QI = (const bf16*)(out + SC_QI); const float* WI = (const float*)(ws + WS_WI);
    bf16* O = (bf16*)(ws + WS_XB);
    unsigned* maskw = (unsigned*)(lds + A_MASK);
    float* lsum = (float*)(lds + A_LSUM);
    int* s_unit = (int*)(lds + A_UNIT);
    typedef float f32x2_t __attribute__((ext_vector_type(2)));
    f32x2_t* scl = (f32x2_t*)(lds + A_SCL) + (size_t)(tid >> 6) * 2048 + (tid & 63);
    unsigned* qctr = (unsigned*)(ws + WS_CTL) + CW_QATT + 64 * rep;
    const int l = tid & 63, w = __builtin_amdgcn_readfirstlane(tid >> 6), rho = l & 31, hi = l >> 5;
    LAS3 unsigned char* ldsb = (LAS3 unsigned char*)lds;
    for (;;) {
        if (tid == 0) *s_unit = (int)atomicAdd(qctr, 1u);
        __syncthreads();
        const int p = *s_unit;
        __syncthreads();
        if (p >= ATT_UNITS) break;
        int m0, nkt, vpitch; const bf16 *KB, *VT, *KI; bool need_idx;
        { int c = -1, b, half = 0;
          if (p < 256) { c = 31 - (p >> 4); b = (p & 15) >> 1; half = p & 1; }
          else if (p < 288) { b = p - 256; }
          else { const int pp = p - 288; c = 15 - (pp >> 4); b = (pp & 15) >> 1; half = pp & 1; }
          if (c >= 0) { m0 = b * T_P + 64 * c + 32 * half; nkt = 2 * (c + 1); vpitch = T_P; need_idx = c >= 4;
              KB = (const bf16*)(ws + WS_KBP) + (size_t)b * T_P * 256; VT = (const bf16*)(ws + WS_VTP) + (size_t)b * 256 * T_P; KI = (const bf16*)(ws + WS_KIP) + (size_t)b * T_P * 64; }
          else { m0 = MP + 32 * b; nkt = LS / 32; vpitch = LS; need_idx = true;
              KB = (const bf16*)(ws + WS_KBS) + (size_t)b * LS * 256; VT = (const bf16*)(ws + WS_VTS) + (size_t)b * 256 * LS; KI = (const bf16*)(ws + WS_KIS) + (size_t)b * LS * 64; } }
        if (need_idx) {
            const int tokA = 4 * w + 2 * ((rho >> 2) & 1) + (rho >> 4), headA = (rho & 3) + 4 * ((rho >> 3) & 1);
            bf16x8 qa[4];
#pragma unroll
            for (int ks = 0; ks < 4; ++ks) qa[ks] = *(const bf16x8*)(QI + (size_t)(m0 + tokA) * 512 + headA * 64 + 16 * ks + 8 * hi);
            float wv[16];
#pragma unroll
            for (int r = 0; r < 16; ++r) wv[r] = WI[(size_t)(m0 + 4 * w + 2 * hi + (r >> 3)) * 8 + (r & 7)];
            asm volatile("" :: "v"(qa[0]), "v"(qa[1]), "v"(qa[2]), "v"(qa[3]));
#pragma unroll
            for (int r = 0; r < 16; ++r) asm volatile("" :: "v"(wv[r]));
            asm volatile("s_waitcnt vmcnt(0)" ::: "memory");
            float sc0[32], sc1[32];
            const int nb = (nkt + 1) >> 1;
            const int sr = 8 * w + (l >> 3), scn = (l & 7) ^ ((sr >> 1) & 7);
            const unsigned char* ksrc = (const unsigned char*)KI + (size_t)sr * 128 + 16 * scn;
#define KI_STAGE(it_) __builtin_amdgcn_global_load_lds((const unsigned*)(ksrc + (size_t)(it_) * 8192), (LAS3 unsigned*)(ldsb + A_RING1 + ((it_) % 3) * 8192 + w * 1024), 16, 0, 0)
            for (int rp1 = 0; rp1 <= PROBE_A1; ++rp1) {
            if (rp1) __syncthreads();
            KI_STAGE(0); if (1 < nb) KI_STAGE(1);
#pragma unroll
            for (int it = 0; it < 32; ++it) {
                if (it < nb) {
                    if (it + 1 < nb) asm volatile("s_waitcnt vmcnt(1) lgkmcnt(0)\n\ts_barrier" ::: "memory"); else asm volatile("s_waitcnt vmcnt(0) lgkmcnt(0)\n\ts_barrier" ::: "memory");
                    if (it + 2 < nb) KI_STAGE(it + 2);
                    const unsigned char* tb = lds + A_RING1 + (it % 3) * 8192;
#pragma unroll
                    for (int k2 = 0; k2 < 2; ++k2) { const int kt = 2 * it + k2;
                        if (kt < nkt) {
                            const int r = 32 * k2 + rho; const unsigned char* rowp = tb + r * 128; const int sw = (r >> 1) & 7;
                            f32x16 acc = {0.f, 0.f, 0.f, 0.f, 0.f, 0.f, 0.f, 0.f, 0.f, 0.f, 0.f, 0.f, 0.f, 0.f, 0.f, 0.f};
#pragma unroll
                            for (int ks = 0; ks < 4; ++ks) acc = MFMA32(qa[ks], *(const bf16x8*)(rowp + 16 * ((2 * ks + hi) ^ sw)), acc);
                            float s0 = 0.f, s1 = 0.f;
#pragma unroll
                            for (int r2 = 0; r2 < 8; ++r2) { s0 += wv[r2] * fmaxf(acc[r2], 0.f); s1 += wv[8 + r2] * fmaxf(acc[8 + r2], 0.f); }
                            if (kt < 32) { sc0[kt & 31] = s0; sc1[kt & 31] = s1; } else scl[(kt - 32) * 64] = (f32x2_t){s0, s1};
                        } else if (kt < 32) { sc0[kt & 31] = -3.0e38f; sc1[kt & 31] = -3.0e38f; }
                    }
                } else { if (2 * it < 32) { sc0[(2 * it) & 31] = -3.0e38f; sc1[(2 * it) & 31] = -3.0e38f; sc0[(2 * it + 1) & 31] = -3.0e38f; sc1[(2 * it + 1) & 31] = -3.0e38f; } }
            }
            }
#undef KI_STAGE
            __syncthreads();
            float mn0 = 3.0e38f, mx0 = -3.0e38f, mn1 = 3.0e38f, mx1 = -3.0e38f; int cp0 = 0, cz0 = 0, cp1 = 0, cz1 = 0;
#pragma unroll
            for (int kt = 0; kt < 64; ++kt) if (kt < nkt) { float v0, v1; if (kt < 32) { v0 = sc0[kt & 31]; v1 = sc1[kt & 31]; } else { const f32x2_t t2 = scl[(kt - 32) * 64]; v0 = t2.x; v1 = t2.y; }
                mn0 = fminf(mn0, v0); mx0 = fmaxf(mx0, v0); mn1 = fminf(mn1, v1); mx1 = fmaxf(mx1, v1);
                cp0 += v0 > 0.f ? 1 : 0; cz0 += v0 == 0.f ? 1 : 0; cp1 += v1 > 0.f ? 1 : 0; cz1 += v1 == 0.f ? 1 : 0; }
            mn0 = half_min32(mn0); mx0 = half_max32(mx0); mn1 = half_min32(mn1); mx1 = half_max32(mx1);
            cp0 = half_sum32i(cp0); cz0 = half_sum32i(cz0); cp1 = half_sum32i(cp1); cz1 = half_sum32i(cz1);
            float lo0, hi0, lo1, hi1, thr0 = 0.f, thr1 = 0.f; int ch0, ch1, nt0 = 0, nt1 = 0; bool fin0, fin1;
            for (int rp2 = 0; rp2 <= PROBE_A2; ++rp2) {
            fin0 = false; fin1 = false; ch0 = 0; ch1 = 0;
            if (cp0 >= 256) { lo0 = 0.f; hi0 = mx0; if (cp0 == 256) { fin0 = true; thr0 = 0.f; nt0 = 0; } }
            else if (cp0 + cz0 >= 256) { lo0 = 0.f; hi0 = 0.f; fin0 = true; thr0 = 0.f; nt0 = 256 - cp0; }
            else { lo0 = mn0 - 1.0f; hi0 = 0.f; ch0 = cp0; }
            if (cp1 >= 256) { lo1 = 0.f; hi1 = mx1; if (cp1 == 256) { fin1 = true; thr1 = 0.f; nt1 = 0; } }
            else if (cp1 + cz1 >= 256) { lo1 = 0.f; hi1 = 0.f; fin1 = true; thr1 = 0.f; nt1 = 256 - cp1; }
            else { lo1 = mn1 - 1.0f; hi1 = 0.f; ch1 = cp1; }
            asm volatile("" : "+v"(lo0), "+v"(lo1));
            for (int iter = 0; iter < 64; ++iter) {
                const float mid0 = lo0 + 0.5f * (hi0 - lo0), mid1 = lo1 + 0.5f * (hi1 - lo1);
                int c0 = 0, c1 = 0;
#pragma unroll
                for (int g = 0; g < 4; ++g) if (8 * g < nkt) {
#pragma unroll
                    for (int k8 = 0; k8 < 8; ++k8) { c0 += sc0[8 * g + k8] > mid0 ? 1 : 0; c1 += sc1[8 * g + k8] > mid1 ? 1 : 0; } }
                for (int kt = 32; kt < nkt; kt += 8) {
                    f32x2_t t8[8];
#pragma unroll
                    for (int u = 0; u < 8; ++u) t8[u] = scl[(kt + u - 32) * 64];
#pragma unroll
                    for (int u = 0; u < 8; ++u) if (kt + u < nkt) { c0 += t8[u].x > mid0 ? 1 : 0; c1 += t8[u].y > mid1 ? 1 : 0; } }
                c0 = half_sum32i(c0); c1 = half_sum32i(c1);
                if (!fin0) { if (!(mid0 > lo0 && mid0 < hi0)) { fin0 = true; thr0 = hi0; nt0 = 256 - ch0; }
                             else if (c0 == 256) { fin0 = true; thr0 = mid0; nt0 = 0; } else if (c0 > 256) lo0 = mid0; else { hi0 = mid0; ch0 = c0; } }
                if (!fin1) { if (!(mid1 > lo1 && mid1 < hi1)) { fin1 = true; thr1 = hi1; nt1 = 256 - ch1; }
                             else if (c1 == 256) { fin1 = true; thr1 = mid1; nt1 = 0; } else if (c1 > 256) lo1 = mid1; else { hi1 = mid1; ch1 = c1; } }
                if (__all(fin0 && fin1)) break;
            }
            }
            const bool any_tie = __any(nt0 > 0 || nt1 > 0);
            int run0 = 0, run1 = 0; const unsigned below = (1u << rho) - 1u;
#pragma unroll
            for (int kt = 0; kt < 64; ++kt) if (kt < nkt) {
                float v0, v1; if (kt < 32) { v0 = sc0[kt & 31]; v1 = sc1[kt & 31]; } else { const f32x2_t t2 = scl[(kt - 32) * 64]; v0 = t2.x; v1 = t2.y; }
                bool p0 = v0 > thr0, p1 = v1 > thr1;
                if (any_tie) {
                    const bool e0 = nt0 > 0 && v0 == thr0, e1 = nt1 > 0 && v1 == thr1;
                    const unsigned long long be0 = __ballot(e0), be1 = __ballot(e1);
                    const unsigned h0 = (unsigned)(be0 >> (32 * hi)), h1 = (unsigned)(be1 >> (32 * hi));
                    p0 = p0 || (e0 && (run0 + __popc(h0 & below)) < nt0); p1 = p1 || (e1 && (run1 + __popc(h1 & below)) < nt1);
                    run0 += __popc(h0); run1 += __popc(h1);
                }
                const unsigned long long b0 = __ballot(p0), b1 = __ballot(p1);
                if (l == 0) { maskw[(4 * w + 0) * MASK_PITCH + kt] = (unsigned)b0; maskw[(4 * w + 1) * MASK_PITCH + kt] = (unsigned)b1; }
                if (l == 32) { maskw[(4 * w + 2) * MASK_PITCH + kt] = (unsigned)(b0 >> 32); maskw[(4 * w + 3) * MASK_PITCH + kt] = (unsigned)(b1 >> 32); }
            }
        }
        __syncthreads();
        {
            const int g = w >> 1;
            bf16x8 qb[4];
#pragma unroll
            for (int ks = 0; ks < 4; ++ks) qb[ks] = *(const bf16x8*)(Q + (size_t)(m0 + rho) * 512 + w * 64 + 16 * ks + 8 * hi);
            asm volatile("" :: "v"(qb[0]), "v"(qb[1]), "v"(qb[2]), "v"(qb[3]));
            asm volatile("s_waitcnt vmcnt(0)" ::: "memory");
            const unsigned char* ksrc[2]; const unsigned char* vsrc[2];
#pragma unroll
            for (int k = 0; k < 2; ++k) { const int i = (k * 8 + w) * 64 + l; const int r = i >> 5, c = i & 31; ksrc[k] = (const unsigned char*)KB + (size_t)r * 512 + 16 * (c ^ (r & 15));
                const int R = i >> 2, cv = i & 3; vsrc[k] = (const unsigned char*)VT + (size_t)R * vpitch * 2 + 16 * (cv ^ ((R >> 2) & 3)); }
#define KV_STAGE(t_) do { const int bo_ = A_RING2 + ((t_) % 3) * 32768 + w * 1024; \
            __builtin_amdgcn_global_load_lds((const unsigned*)(ksrc[0] + (size_t)(t_) * 16384), (LAS3 unsigned*)(ldsb + bo_), 16, 0, 0); \
            __builtin_amdgcn_global_load_lds((const unsigned*)(ksrc[1] + (size_t)(t_) * 16384), (LAS3 unsigned*)(ldsb + bo_ + 8192), 16, 0, 0); \
            __builtin_amdgcn_global_load_lds((const unsigned*)(vsrc[0] + (size_t)(t_) * 64), (LAS3 unsigned*)(ldsb + bo_ + 16384), 16, 0, 0); \
            __builtin_amdgcn_global_load_lds((const unsigned*)(vsrc[1] + (size_t)(t_) * 64), (LAS3 unsigned*)(ldsb + bo_ + 24576), 16, 0, 0); } while (0)
            f32x16 o0 = {0.f, 0.f, 0.f, 0.f, 0.f, 0.f, 0.f, 0.f, 0.f, 0.f, 0.f, 0.f, 0.f, 0.f, 0.f, 0.f}, o1 = o0; float psum = 0.f;
            const int ksw = rho & 15;
            const int vR0 = g * 64 + rho, vR1 = vR0 + 32; const int vs0 = (vR0 >> 2) & 3, vs1 = (vR1 >> 2) & 3;
            for (int rp3 = 0; rp3 <= PROBE_A3; ++rp3) {
            if (rp3) __syncthreads();
            KV_STAGE(0); if (1 < nkt) KV_STAGE(1);
            for (int kt = 0; kt < nkt; ++kt) {
                if (kt + 1 < nkt) asm volatile("s_waitcnt vmcnt(4) lgkmcnt(0)\n\ts_barrier" ::: "memory"); else asm volatile("s_waitcnt vmcnt(0) lgkmcnt(0)\n\ts_barrier" ::: "memory");
                if (kt + 2 < nkt) KV_STAGE(kt + 2);
                const unsigned char* kbuf = lds + A_RING2 + (kt % 3) * 32768; const unsigned char* vbuf = kbuf + 16384;
                f32x16 st = {0.f, 0.f, 0.f, 0.f, 0.f, 0.f, 0.f, 0.f, 0.f, 0.f, 0.f, 0.f, 0.f, 0.f, 0.f, 0.f};
#pragma unroll
                for (int ks = 0; ks < 4; ++ks) st = MFMA32(*(const bf16x8*)(kbuf + rho * 512 + 16 * ((g * 8 + 2 * ks + hi) ^ ksw)), qb[ks], st);
                unsigned word = need_idx ? maskw[rho * MASK_PITCH + kt] : 0xffffffffu; word >>= 4 * hi; float pr[16];
#pragma unroll
                for (int r = 0; r < 16; ++r) { const float e = __builtin_amdgcn_exp2f(st[r]); pr[r] = ((word >> ((r & 3) + 8 * (r >> 2))) & 1u) ? e : 0.f; psum += pr[r]; }
                union { u32x4 u; bf16x8 v; } pa0, pa1; pa0.u = (u32x4){pg8::cvt_pk_bf16(pr[0], pr[1]), pg8::cvt_pk_bf16(pr[2], pr[3]), pg8::cvt_pk_bf16(pr[4], pr[5]), pg8::cvt_pk_bf16(pr[6], pr[7])}; pa1.u = (u32x4){pg8::cvt_pk_bf16(pr[8], pr[9]), pg8::cvt_pk_bf16(pr[10], pr[11]), pg8::cvt_pk_bf16(pr[12], pr[13]), pg8::cvt_pk_bf16(pr[14], pr[15])};
                union { u32x4 u; bf16x8 v; } vf[2][2];
#pragma unroll
                for (int s2 = 0; s2 < 2; ++s2) { const unsigned char* r0 = vbuf + vR0 * 64 + 8 * hi; const unsigned char* r1 = vbuf + vR1 * 64 + 8 * hi;
                    const u32x2 a0 = *(const u32x2*)(r0 + 16 * ((2 * s2) ^ vs0)), a1 = *(const u32x2*)(r0 + 16 * ((2 * s2 + 1) ^ vs0)), b0 = *(const u32x2*)(r1 + 16 * ((2 * s2) ^ vs1)), b1 = *(const u32x2*)(r1 + 16 * ((2 * s2 + 1) ^ vs1));
                    vf[s2][0].u = (u32x4){a0.x, a0.y, a1.x, a1.y}; vf[s2][1].u = (u32x4){b0.x, b0.y, b1.x, b1.y}; }
                o0 = MFMA32(pa0.v, vf[0][0].v, o0); o0 = MFMA32(pa1.v, vf[1][0].v, o0); o1 = MFMA32(pa0.v, vf[0][1].v, o1); o1 = MFMA32(pa1.v, vf[1][1].v, o1);
            }
            }
#undef KV_STAGE
            psum += __shfl_xor(psum, 32);
            if (hi == 0) lsum[w * 32 + rho] = psum;
            __syncthreads();
#pragma unroll
            for (int r = 0; r < 16; ++r) { const int qr = crow(r, hi); const float inv = 1.0f / lsum[w * 32 + qr];
                bf16* op = O + (size_t)(m0 + qr) * DM + w * 64 + rho;
                op[0] = (bf16)f2bf(o0[r] * inv); op[32] = (bf16)f2bf(o1[r] * inv); }
        }
        __syncthreads();
    }
}

constexpr int XS_PITCH = 168;
constexpr int WP = 144;
constexpr int WSLOT = 64 * WP;
constexpr int W_NCH = T_P / 64;
constexpr int W_UNITS = NB_P * 8 * W_NCH + NB_S * 8;
constexpr size_t WS_PM = WS_R, WS_QM = WS_R + 18 * MiB, WS_UM = WS_R + 36 * MiB, WS_Y0 = WS_R + 72 * MiB;
static_assert((size_t)W_UNITS * 8192 <= 18 * MiB && (size_t)W_UNITS * 16384 <= 36 * MiB && WS_Y0 + 36 * MiB <= WS_END, "rwkv chunk summaries fit the reusable region");
constexpr size_t SC_G2 = 0, SC_VV = (size_t)MT * 256;
constexpr int ZTP = 720;
constexpr int LWP = 68;

__device__ __forceinline__ f32x16 wy_mm(const unsigned char* A, const unsigned char* B, int mi, int ni, int rho, int hi, f32x16 acc) {
    const unsigned char* ap = A + (32 * mi + rho) * WP + 16 * hi; const unsigned char* bp = B + (32 * ni + rho) * WP + 16 * hi;
#pragma unroll
    for (int ks = 0; ks < 4; ++ks) acc = MFMA32(*(const bf16x8*)(ap + 32 * ks), *(const bf16x8*)(bp + 32 * ks), acc);
    return acc;
}
typedef float wy_f32x2 __attribute__((ext_vector_type(2))); typedef __bf16 wy_bf16x2 __attribute__((ext_vector_type(2)));
__device__ __forceinline__ unsigned wy_cvt2(float lo, float hi) { const wy_f32x2 v = {lo, hi}; const wy_bf16x2 b = __builtin_convertvector(v, wy_bf16x2); return __builtin_bit_cast(unsigned, b); }
__device__ __forceinline__ void wy_st_t(unsigned char* dst, const f32x16& a, int mi, int ni, int rho, int hi) {
#pragma unroll
    for (int q = 0; q < 4; ++q) *(u32x2*)(dst + (32 * ni + rho) * WP + 2 * (32 * mi + 8 * q + 4 * hi)) = (u32x2){wy_cvt2(a[4 * q], a[4 * q + 1]), wy_cvt2(a[4 * q + 2], a[4 * q + 3])};
}
__device__ __forceinline__ void wy_st_n(unsigned char* dst, const f32x16& a, int mi, int ni, int rho, int hi) {
#pragma unroll
    for (int r = 0; r < 16; ++r) *(bf16*)(dst + (32 * mi + crow(r, hi)) * WP + 2 * (32 * ni + rho)) = (bf16)f2bf(a[r]);
}
__device__ __forceinline__ f32x16 wy_ld_t(const unsigned char* src, int mi, int ni, int rho, int hi) {
    f32x16 a;
#pragma unroll
    for (int q = 0; q < 4; ++q) { const u32x2 w = *(const u32x2*)(src + (32 * ni + rho) * WP + 2 * (32 * mi + 8 * q + 4 * hi)); a[4 * q] = bflo(w.x); a[4 * q + 1] = bfhi(w.x); a[4 * q + 2] = bflo(w.y); a[4 * q + 3] = bfhi(w.y); }
    return a;
}
#define F16Z ((f32x16){0.f, 0.f, 0.f, 0.f, 0.f, 0.f, 0.f, 0.f, 0.f, 0.f, 0.f, 0.f, 0.f, 0.f, 0.f, 0.f})

__device__ __forceinline__ void p4w_chunks(const Args& a, unsigned char* lds, int tid) {
    unsigned char* ws = a.ws; float* out = a.out;
    const bf16* ZS = (const bf16*)(ws + WS_ZS);
    const bf16* w2t = (const bf16*)(ws + WS_W2T); const bf16* a2t = (const bf16*)(ws + WS_A2T); const bf16* g2t = (const bf16*)(ws + WS_G2T);
    bf16* G = (bf16*)(out + SC_G2); bf16* VV = (bf16*)(out + SC_VV); float* BON = (float*)(ws + WS_BONUS);
    const float* mu = a.in[13]; const float* w0 = a.in[14]; const float* a0 = a.in[16]; const float* k_k = a.in[19]; const float* k_a = a.in[20]; const float* r_k = a.in[21]; const float* sh0 = a.in[6];
    const int l = tid & 63, w = __builtin_amdgcn_readfirstlane(tid >> 6), rho = l & 31, hi = l >> 5;
#define SL(i) (lds + (i) * WSLOT)
    unsigned char* zt = SL(0);
    bf16* xs = (bf16*)SL(6);
    float* LW = (float*)SL(9);
    float* LG = (float*)SL(11);
    float* NRM = (float*)(lds + 17 * WSLOT);
    float* PAR = NRM + 320;
    int* QMAX = (int*)(PAR + 672);
    for (int unit = blockIdx.x; unit < W_UNITS; unit += gridDim.x) {
        int m0, nvalid, h; bool first; const float* shp = nullptr;
        if (unit < NB_P * 8 * W_NCH) { const int j = unit & (W_NCH - 1), sh = unit >> 5; h = sh & 7; m0 = (sh >> 3) * T_P + 64 * j; nvalid = 64; first = j == 0; }
        else { const int sh = unit - NB_P * 8 * W_NCH; h = sh & 7; m0 = MP + 32 * (sh >> 3); nvalid = 32; first = true; shp = sh0 + (size_t)(sh >> 3) * SHIFTW; }
        const int ct = w & 1, tt = (w >> 1) & 1; const int n = 64 * h + 32 * ct + rho;
        bf16x8 fa[6];
        if (w < 4) {
#pragma unroll
            for (int ks = 0; ks < 2; ++ks) { fa[ks] = *(const bf16x8*)(w2t + n * 32 + 16 * ks + 8 * hi); fa[2 + ks] = *(const bf16x8*)(a2t + n * 32 + 16 * ks + 8 * hi); } }
        else {
#pragma unroll
            for (int ks = 0; ks < 6; ++ks) fa[ks] = *(const bf16x8*)(g2t + n * 96 + 16 * ks + 8 * hi); }
        if (tid < 8) QMAX[tid] = 0;
        for (int i = tid; i < 672; i += 512) { float v;
            if (i < 192) v = mu[(i >> 6) * 512 + 64 * h + (i & 63)]; else if (i < 352) v = mu[1536 + i - 192];
            else { const int k5 = i - 352, a5 = k5 >> 6; const float* src = a5 == 0 ? w0 : (a5 == 1 ? a0 : (a5 == 2 ? k_k : (a5 == 3 ? k_a : r_k))); v = src[64 * h + (k5 & 63)]; }
            PAR[i] = v; }
        for (int idx = tid; idx < 65 * 44; idx += 512) { const int r = idx / 44, p = idx - r * 44;
            const int col = p < 24 ? (p >> 3) * 512 + 64 * h + 8 * (p & 7) : 1536 + 8 * (p - 24);
            u32x4 v = {0u, 0u, 0u, 0u};
            if (r == 0) { if (!first) v = *(const u32x4*)(ZS + (size_t)(m0 - 1) * SHIFTW + col);
                          else if (shp) { const f32x4 a4 = *(const f32x4*)(shp + col), b4 = *(const f32x4*)(shp + col + 4); v = (u32x4){pk2(a4.x, a4.y), pk2(a4.z, a4.w), pk2(b4.x, b4.y), pk2(b4.z, b4.w)}; } }
            else if (r <= nvalid) v = *(const u32x4*)(ZS + (size_t)(m0 + r - 1) * SHIFTW + col);
            *(u32x4*)(zt + r * ZTP + 16 * p) = v; }
        LBAR();
        { const int tk = tid >> 3, c0 = (tid & 7) * 20; const bf16* zc = (const bf16*)(zt + (tk + 1) * ZTP + 384) + c0; const bf16* zp = (const bf16*)(zt + tk * ZTP + 384) + c0;
#pragma unroll
          for (int e = 0; e < 20; ++e) { const int c = c0 + e; const float cur = bf1(zc[e]), prev = bf1(zp[e]); const float zm = cur + PAR[192 + c] * (prev - cur);
              const float f = __frcp_rn(1.0f + __expf(c < 32 ? -2.0f * zm : -zm)); xs[tk * XS_PITCH + c] = (bf16)f2bf(c < 32 ? 2.0f * f - 1.0f : (c < 64 ? zm : f)); } }
        LBAR();
        const int tok = 32 * tt + rho; const bool valid = tok < nvalid; const size_t m = (size_t)m0 + tok;
        const bf16* xrow = xs + tok * XS_PITCH + 8 * hi; const int lofs = 32 * ct + 4 * hi;
        const int pofs = 64 * h + 32 * ct + 4 * hi;
        const unsigned char* zcur = zt + (tok + 1) * ZTP + 2 * (32 * ct + 4 * hi); const unsigned char* zprv = zt + tok * ZTP + 2 * (32 * ct + 4 * hi);
#define WMIX4(dst, seg, q) do { const u32x2 cw = *(const u32x2*)(zcur + 128 * (seg) + 16 * (q)), pw = *(const u32x2*)(zprv + 128 * (seg) + 16 * (q)); const f32x4 mu4 = *(const f32x4*)(PAR + 64 * (seg) + lofs + 8 * (q)); \
            dst[0] = bflo(cw.x) + mu4.x * (bflo(pw.x) - bflo(cw.x)); dst[1] = bfhi(cw.x) + mu4.y * (bfhi(pw.x) - bfhi(cw.x)); dst[2] = bflo(cw.y) + mu4.z * (bflo(pw.y) - bflo(cw.y)); dst[3] = bfhi(cw.y) + mu4.w * (bfhi(pw.y) - bfhi(cw.y)); } while (0)
        float ra[16], rb[16], rc[16], rd[16];
        if (w < 4) {
            f32x16 Dw = F16Z, Da = F16Z;
#pragma unroll
            for (int ks = 0; ks < 2; ++ks) { Dw = MFMA32(fa[ks], *(const bf16x8*)(xrow + 16 * ks), Dw); Da = MFMA32(fa[2 + ks], *(const bf16x8*)(xrow + 32 + 16 * ks), Da); }
            float n2 = 0.f, bon = 0.f;
#pragma unroll
            for (int q = 0; q < 4; ++q) { float zr[4], zk[4]; WMIX4(zr, 0, q); WMIX4(zk, 1, q);
                const f32x4 w04 = *(const f32x4*)(PAR + 352 + lofs + 8 * q), a04 = *(const f32x4*)(PAR + 416 + lofs + 8 * q), kk4 = *(const f32x4*)(PAR + 480 + lofs + 8 * q), ka4 = *(const f32x4*)(PAR + 544 + lofs + 8 * q), rk4 = *(const f32x4*)(PAR + 608 + lofs + 8 * q);
#pragma unroll
                for (int e = 0; e < 4; ++e) { const int r = 4 * q + e;
                    const float sg = __frcp_rn(1.0f + __expf(-(w04[e] + Dw[r]))); rd[r] = valid ? -0.6065306597126334f * sg : 0.f;
                    const float aa = __frcp_rn(1.0f + __expf(-(a04[e] + Da[r]))); rb[r] = aa;
                    const float kr = valid ? zk[e] * kk4[e] : 0.f; ra[r] = kr; n2 += kr * kr;
                    const float km = valid ? zk[e] * (1.0f + (aa - 1.0f) * ka4[e]) : 0.f; rc[r] = km; bon += zr[e] * km * rk4[e]; }
                *(f32x4*)(LW + tok * LWP + 32 * ct + 8 * q + 4 * hi) = (f32x4){rd[4 * q], rd[4 * q + 1], rd[4 * q + 2], rd[4 * q + 3]}; }
            n2 += __shfl_xor(n2, 32); bon += __shfl_xor(bon, 32);
            if (hi == 0) { NRM[ct * 64 + tok] = n2; NRM[128 + ct * 64 + tok] = bon; }
        } else {
            f32x16 Dg = F16Z;
#pragma unroll
            for (int ks = 0; ks < 6; ++ks) Dg = MFMA32(fa[ks], *(const bf16x8*)(xrow + 64 + 16 * ks), Dg);
#pragma unroll
            for (int q = 0; q < 4; ++q) { float zr[4], zv[4]; WMIX4(zr, 0, q); WMIX4(zv, 2, q);
#pragma unroll
                for (int e = 0; e < 4; ++e) { ra[4 * q + e] = valid ? zr[e] : 0.f; rb[4 * q + e] = valid ? zv[e] : 0.f; }
                if (valid) { const size_t o = m * 512 + pofs + 8 * q;
                    *(u32x2*)(G + o) = (u32x2){pk2(Dg[4 * q], Dg[4 * q + 1]), pk2(Dg[4 * q + 2], Dg[4 * q + 3])};
                    *(u32x2*)(VV + o) = (u32x2){pk2(zv[0], zv[1]), pk2(zv[2], zv[3])}; } }
        }
#undef WMIX4
        LBAR();
        if (w == 0) { float acc = 0.f; LG[l] = 0.f;
#pragma unroll 8
            for (int t = 0; t < 64; ++t) { acc += LW[t * LWP + l]; LG[(t + 1) * LWP + l] = acc; }
            NRM[256 + l] = __expf(acc); }
        if (w == 1 && l < 64) { const float bn = NRM[128 + l] + NRM[192 + l]; if (l < nvalid) BON[((size_t)m0 + l) * 8 + h] = bn; }
        LBAR();
        {
            const float* lgc = LG + (tok + 1) * LWP + 32 * ct + 4 * hi; const float* lgp = LG + tok * LWP + 32 * ct + 4 * hi; const float* lge = LG + 64 * LWP + 32 * ct + 4 * hi;
            if (w < 4) {
                const float invn = 1.0f / fmaxf(sqrtf(NRM[tok] + NRM[64 + tok]), 1e-12f);
#pragma unroll
                for (int q = 0; q < 4; ++q) { const f32x4 gc = *(const f32x4*)(lgc + 8 * q), gp = *(const f32x4*)(lgp + 8 * q), ge = *(const f32x4*)(lge + 8 * q);
                    float kt[4], bt[4], ka[4], ke[4], be[4];
#pragma unroll
                    for (int e = 0; e < 4; ++e) { const int r = 4 * q + e; const float en = __expf(-gc[e]), ep = __expf(gp[e]), ee = __expf(ge[e] - gc[e]); const float kkn = ra[r] * invn, bb = kkn * rb[r];
                        kt[e] = rc[r] * en; bt[e] = bb * en; ka[e] = kkn * ep; ke[e] = rc[r] * ee; be[e] = bb * ee; }
                    const int co = 2 * (32 * ct + 8 * q + 4 * hi);
                    *(u32x2*)(SL(0) + tok * WP + co) = (u32x2){pk2(kt[0], kt[1]), pk2(kt[2], kt[3])};
                    *(u32x2*)(SL(1) + tok * WP + co) = (u32x2){pk2(bt[0], bt[1]), pk2(bt[2], bt[3])};
                    *(u32x2*)(SL(2) + tok * WP + co) = (u32x2){pk2(ka[0], ka[1]), pk2(ka[2], ka[3])};
#pragma unroll
                    for (int e = 0; e < 4; ++e) { const int kr = 32 * ct + 8 * q + 4 * hi + e;
                        *(bf16*)(SL(4) + kr * WP + 2 * tok) = (bf16)f2bf(ka[e]); *(bf16*)(SL(5) + kr * WP + 2 * tok) = (bf16)f2bf(be[e]); *(bf16*)(SL(6) + kr * WP + 2 * tok) = (bf16)f2bf(ke[e]); } }
            } else {
#pragma unroll
                for (int q = 0; q < 4; ++q) { const f32x4 gc = *(const f32x4*)(lgc + 8 * q); float rh[4];
#pragma unroll
                    for (int e = 0; e < 4; ++e) rh[e] = ra[4 * q + e] * __expf(gc[e]);
                    *(u32x2*)(SL(3) + tok * WP + 2 * (32 * ct + 8 * q + 4 * hi)) = (u32x2){pk2(rh[0], rh[1]), pk2(rh[2], rh[3])};
#pragma unroll
                    for (int e = 0; e < 4; ++e) *(bf16*)(SL(7) + (32 * ct + 8 * q + 4 * hi + e) * WP + 2 * tok) = (bf16)f2bf(rb[4 * q + e]); }
            }
        }
        LBAR();
        for (int task = w; task < 16; task += 8) { const int pr = task >> 2, mi = (task >> 1) & 1, ni = task & 1;
            if (pr == 0) { f32x16 d = wy_mm(SL(1), SL(2), mi, ni, rho, hi, F16Z);
#pragma unroll
                for (int r = 0; r < 16; ++r) if (!(32 * mi + crow(r, hi) < 32 * ni + rho)) d[r] = 0.f;
                wy_st_t(SL(8), d, mi, ni, rho, hi); wy_st_n(SL(9), d, mi, ni, rho, hi); }
            else if (pr == 1) { f32x16 d = wy_mm(SL(2), SL(0), mi, ni, rho, hi, F16Z);
#pragma unroll
                for (int r = 0; r < 16; ++r) if (!(32 * ni + rho < 32 * mi + crow(r, hi))) d[r] = 0.f;
                wy_st_t(SL(10), d, mi, ni, rho, hi); }
            else if (pr == 2) { f32x16 d = wy_mm(SL(1), SL(3), mi, ni, rho, hi, F16Z);
#pragma unroll
                for (int r = 0; r < 16; ++r) if (!(32 * mi + crow(r, hi) <= 32 * ni + rho)) d[r] = 0.f;
                wy_st_t(SL(11), d, mi, ni, rho, hi); }
            else { f32x16 d = wy_mm(SL(0), SL(3), mi, ni, rho, hi, F16Z);
#pragma unroll
                for (int r = 0; r < 16; ++r) if (!(32 * mi + crow(r, hi) <= 32 * ni + rho)) d[r] = 0.f;
                wy_st_t(SL(12), d, mi, ni, rho, hi); } }
        LBAR();
        for (int task = w; task < 12; task += 8) { const int pr = task >> 2, mi = (task >> 1) & 1, ni = task & 1;
            if (pr == 0) { const f32x16 d = wy_mm(SL(9), SL(8), mi, ni, rho, hi, F16Z); wy_st_t(SL(13), d, mi, ni, rho, hi); }
            else if (pr == 1) { const f32x16 d = wy_mm(SL(8), SL(9), mi, ni, rho, hi, F16Z); wy_st_t(SL(14), d, mi, ni, rho, hi); }
            else { f32x16 d = wy_ld_t(SL(8), mi, ni, rho, hi);
#pragma unroll
                for (int r = 0; r < 16; ++r) d[r] = ((32 * mi + crow(r, hi)) == (32 * ni + rho) ? 1.0f : 0.f) - d[r];
                wy_st_t(SL(15), d, mi, ni, rho, hi); } }
        LBAR();
        int pfin = 16;
#pragma unroll 1
        for (int lev = 1; lev <= 5; ++lev) {
            unsigned char* Pc = SL((lev & 1) ? 15 : 16); unsigned char* Pn = SL((lev & 1) ? 16 : 15);
            unsigned char* Qr = SL((lev & 1) ? 13 : 0); unsigned char* Qx = SL((lev & 1) ? 14 : 1); unsigned char* Qr2 = SL((lev & 1) ? 0 : 13); unsigned char* Qx2 = SL((lev & 1) ? 1 : 14);
            const int ntask = lev < 5 ? 12 : 4;
            for (int task = w; task < ntask; task += 8) { const int pr = task >> 2, mi = (task >> 1) & 1, ni = task & 1;
                if (pr == 0) { f32x16 d = wy_ld_t(Pc, mi, ni, rho, hi);
                    d = wy_mm(Qx, Pc, mi, ni, rho, hi, d); wy_st_t(Pn, d, mi, ni, rho, hi); }
                else if (pr == 1) { const f32x16 d = wy_mm(Qx, Qr, mi, ni, rho, hi, F16Z); wy_st_t(Qr2, d, mi, ni, rho, hi); float mx = 0.f;
#pragma unroll
                    for (int r = 0; r < 16; ++r) mx = fmaxf(mx, fabsf(d[r]));
                    if (__any(mx >= 1e-9f) && l == 0) QMAX[lev] = 1; }
                else { const f32x16 d = wy_mm(Qr, Qx, mi, ni, rho, hi, F16Z); wy_st_t(Qx2, d, mi, ni, rho, hi); } }
            LBAR();
            if (lev < 5 && QMAX[lev] == 0) { pfin = (lev & 1) ? 16 : 15; break; }
        }
        { const int pr = w >> 2, mi = (w >> 1) & 1, ni = w & 1;
          if (pr == 0) { const f32x16 d = wy_mm(SL(pfin), SL(10), mi, ni, rho, hi, F16Z); wy_st_t(SL(0), d, mi, ni, rho, hi); }
          else { const f32x16 d = wy_mm(SL(pfin), SL(4), mi, ni, rho, hi, F16Z); wy_st_t(SL(1), d, mi, ni, rho, hi); } }
        LBAR();
        { bf16* PMg = (bf16*)(ws + WS_PM) + (size_t)unit * 4096; bf16* QMg = (bf16*)(ws + WS_QM) + (size_t)unit * 4096;
          for (int task = w; task < 16; task += 8) { const int pr = task >> 2, mi = (task >> 1) & 1, ni = task & 1;
            if (pr == 0) { f32x16 d = wy_mm(SL(1), SL(5), mi, ni, rho, hi, F16Z);
                const float gc = NRM[256 + 32 * ni + rho];
#pragma unroll
                for (int q = 0; q < 4; ++q) { float o[4];
#pragma unroll
                    for (int e = 0; e < 4; ++e) { const int kr = 32 * mi + 8 * q + 4 * hi + e; o[e] = (kr == 32 * ni + rho ? gc : 0.f) - d[4 * q + e]; }
                    *(u32x2*)(PMg + (32 * ni + rho) * 64 + 32 * mi + 8 * q + 4 * hi) = (u32x2){pk2(o[0], o[1]), pk2(o[2], o[3])}; } }
            else if (pr == 1) { f32x16 d = wy_mm(SL(0), SL(5), mi, ni, rho, hi, F16Z);
                const f32x16 ke = wy_ld_t(SL(6), mi, ni, rho, hi);
#pragma unroll
                for (int r = 0; r < 16; ++r) d[r] = ke[r] - d[r];
                wy_st_t(SL(13), d, mi, ni, rho, hi); }
            else if (pr == 2) { f32x16 d = wy_mm(SL(1), SL(11), mi, ni, rho, hi, F16Z);
                const f32x16 rh = wy_ld_t(SL(3), mi, ni, rho, hi);
#pragma unroll
                for (int q = 0; q < 4; ++q) *(u32x2*)(QMg + (32 * ni + rho) * 64 + 32 * mi + 8 * q + 4 * hi) =
                    (u32x2){pk2(rh[4 * q] - d[4 * q], rh[4 * q + 1] - d[4 * q + 1]), pk2(rh[4 * q + 2] - d[4 * q + 2], rh[4 * q + 3] - d[4 * q + 3])}; }
            else { f32x16 d = wy_mm(SL(0), SL(11), mi, ni, rho, hi, F16Z);
                const f32x16 bk = wy_ld_t(SL(12), mi, ni, rho, hi);
#pragma unroll
                for (int r = 0; r < 16; ++r) d[r] = bk[r] - d[r];
                wy_st_t(SL(14), d, mi, ni, rho, hi); } } }
        LBAR();
        { float* UMg = (float*)(ws + WS_UM) + (size_t)unit * 4096; float* Y0g = (float*)(ws + WS_Y0) + (size_t)unit * 4096; const int pr = w >> 2, mi = (w >> 1) & 1, ni = w & 1;
          if (pr == 0) { const f32x16 d = wy_mm(SL(13), SL(7), mi, ni, rho, hi, F16Z);
#pragma unroll
              for (int q = 0; q < 4; ++q) *(f32x4*)(UMg + (32 * ni + rho) * 64 + 32 * mi + 8 * q + 4 * hi) = (f32x4){d[4 * q], d[4 * q + 1], d[4 * q + 2], d[4 * q + 3]}; }
          else { const f32x16 d = wy_mm(SL(7), SL(14), mi, ni, rho, hi, F16Z);
#pragma unroll
              for (int q = 0; q < 4; ++q) *(f32x4*)(Y0g + (32 * ni + rho) * 64 + 32 * mi + 8 * q + 4 * hi) = (f32x4){d[4 * q], d[4 * q + 1], d[4 * q + 2], d[4 * q + 3]}; } }
        LBAR();
    }
#undef SL
}

constexpr size_t WS_SB = WS_R + 108 * MiB;
static_assert(WS_SB + (size_t)W_UNITS * 8192 <= WS_END, "state snapshots fit");
__device__ __forceinline__ void p5w_chain(const Args& a, unsigned char* lds, int tid) {
    unsigned char* ws = a.ws; float* out = a.out;
    const int l = tid & 63, w = __builtin_amdgcn_readfirstlane(tid >> 6), rho = l & 31, hi = l >> 5;
    unsigned char* Sb0 = lds; unsigned char* Sb1 = lds + WSLOT; unsigned char* PMl = lds + 2 * WSLOT;
    for (int u2 = blockIdx.x; u2 < NB_P * 8 + NB_S * 8; u2 += gridDim.x) {
        const bool smp = u2 >= NB_P * 8; const int sh = smp ? u2 - NB_P * 8 : u2;
        const int nch = smp ? 1 : W_NCH, unit0 = smp ? NB_P * 8 * W_NCH + sh : sh * W_NCH;
        float* wkv = out + (smp ? OFF_WKVS : OFF_WKVP) + (size_t)sh * 4096;
        const int cr = tid >> 3, cc = (tid & 7) * 8, mi = (w >> 1) & 1, ni = w & 1;
        { float x[8];
          if (smp) { const f32x4 a4 = *(const f32x4*)(a.in[5] + (size_t)sh * 4096 + cr * 64 + cc), b4 = *(const f32x4*)(a.in[5] + (size_t)sh * 4096 + cr * 64 + cc + 4); x[0] = a4.x; x[1] = a4.y; x[2] = a4.z; x[3] = a4.w; x[4] = b4.x; x[5] = b4.y; x[6] = b4.z; x[7] = b4.w; }
          else {
#pragma unroll
              for (int e = 0; e < 8; ++e) x[e] = 0.f; }
          const u32x4 p8 = pack8(x); *(u32x4*)(Sb0 + cr * WP + 2 * cc) = p8; *(u32x4*)((bf16*)(ws + WS_SB) + (size_t)unit0 * 4096 + cr * 64 + cc) = p8; }
        u32x4 pmr = *(const u32x4*)((const bf16*)(ws + WS_PM) + (size_t)unit0 * 4096 + cr * 64 + cc);
        f32x16 ini = F16Z;
#define P5_UM(dst, j_) do { if (w < 4) { const float* um_ = (const float*)(ws + WS_UM) + ((size_t)unit0 + (j_)) * 4096 + (32 * ni + rho) * 64 + 32 * mi + 4 * hi; \
            _Pragma("unroll") for (int q = 0; q < 4; ++q) { const f32x4 x = *(const f32x4*)(um_ + 8 * q); dst[4 * q] = x.x; dst[4 * q + 1] = x.y; dst[4 * q + 2] = x.z; dst[4 * q + 3] = x.w; } } } while (0)
        P5_UM(ini, 0);
        for (int j = 0; j < nch; ++j) {
            unsigned char* Sc = (j & 1) ? Sb1 : Sb0; unsigned char* Sn = (j & 1) ? Sb0 : Sb1;
            *(u32x4*)(PMl + cr * WP + 2 * cc) = pmr;
            f32x16 d = ini;
            if (j + 1 < nch) { pmr = *(const u32x4*)((const bf16*)(ws + WS_PM) + ((size_t)unit0 + j + 1) * 4096 + cr * 64 + cc); P5_UM(ini, j + 1); }
            LBAR();
            if (w < 4) {
                d = wy_mm(PMl, Sc, mi, ni, rho, hi, d);
                if (j + 1 < nch) { wy_st_t(Sn, d, mi, ni, rho, hi);
                    bf16* sg = (bf16*)(ws + WS_SB) + ((size_t)unit0 + j + 1) * 4096 + (32 * ni + rho) * 64 + 32 * mi + 4 * hi;
#pragma unroll
                    for (int q = 0; q < 4; ++q) *(u32x2*)(sg + 8 * q) = (u32x2){wy_cvt2(d[4 * q], d[4 * q + 1]), wy_cvt2(d[4 * q + 2], d[4 * q + 3])}; }
                else {
#pragma unroll
                    for (int q = 0; q < 4; ++q) *(f32x4*)(wkv + (32 * ni + rho) * 64 + 32 * mi + 8 * q + 4 * hi) = (f32x4){d[4 * q], d[4 * q + 1], d[4 * q + 2], d[4 * q + 3]}; }
            }
            LBAR();
        }
#undef P5_UM
    }
}

__device__ __forceinline__ void p6w_out(const Args& a, int tid) {
    unsigned char* ws = a.ws; float* out = a.out;
    const bf16* G = (const bf16*)(out + SC_G2); const bf16* VV = (const bf16*)(out + SC_VV); const float* BON = (const float*)(ws + WS_BONUS); bf16* O = (bf16*)(ws + WS_XB);
    const float* lgn = a.in[22]; const float* lbn = a.in[23];
    const int l = tid & 63, rho = l & 31, hi = l >> 5;
    const int gw = blockIdx.x * 8 + (tid >> 6), NGW = gridDim.x * 8;
    for (int task = gw; task < 2 * W_UNITS; task += NGW) {
        const int unit = task >> 1, tt = task & 1; const bool smp = unit >= NB_P * 8 * W_NCH;
        if (smp && tt == 1) continue;
        int h, j; size_t mrow0;
        if (!smp) { j = unit & (W_NCH - 1); const int sh = unit >> 5; h = sh & 7; mrow0 = (size_t)(sh >> 3) * T_P; } else { const int sh = unit - NB_P * 8 * W_NCH; j = 0; h = sh & 7; mrow0 = (size_t)MP + 32 * (sh >> 3); }
        const int tok = 32 * tt + rho; const size_t m = mrow0 + (size_t)j * 64 + tok;
        const bf16* sb = (const bf16*)(ws + WS_SB) + (size_t)unit * 4096 + rho * 64 + 8 * hi; const bf16* qm = (const bf16*)(ws + WS_QM) + (size_t)unit * 4096 + tok * 64 + 8 * hi;
        bf16x8 sa[2][4], qb[4];
#pragma unroll
        for (int ks = 0; ks < 4; ++ks) { sa[0][ks] = *(const bf16x8*)(sb + 16 * ks); sa[1][ks] = *(const bf16x8*)(sb + 32 * 64 + 16 * ks); qb[ks] = *(const bf16x8*)(qm + 16 * ks); }
        const float* y0 = (const float*)(ws + WS_Y0) + (size_t)unit * 4096 + tok * 64 + 4 * hi;
        f32x16 d0, d1;
#pragma unroll
        for (int q = 0; q < 4; ++q) { const f32x4 x = *(const f32x4*)(y0 + 8 * q), y = *(const f32x4*)(y0 + 32 + 8 * q);
            d0[4 * q] = x.x; d0[4 * q + 1] = x.y; d0[4 * q + 2] = x.z; d0[4 * q + 3] = x.w; d1[4 * q] = y.x; d1[4 * q + 1] = y.y; d1[4 * q + 2] = y.z; d1[4 * q + 3] = y.w; }
        u32x2 vw[8], gg[8]; f32x4 l4[8], b4[8]; const float bon = BON[m * 8 + h];
#pragma unroll
        for (int vt = 0; vt < 2; ++vt)
#pragma unroll
            for (int q = 0; q < 4; ++q) { const int c = 64 * h + 32 * vt + 8 * q + 4 * hi; vw[4 * vt + q] = *(const u32x2*)(VV + m * 512 + c); gg[4 * vt + q] = *(const u32x2*)(G + m * 512 + c);
                l4[4 * vt + q] = *(const f32x4*)(lgn + c); b4[4 * vt + q] = *(const f32x4*)(lbn + c); }
#pragma unroll
        for (int ks = 0; ks < 4; ++ks) { d0 = MFMA32(sa[0][ks], qb[ks], d0); d1 = MFMA32(sa[1][ks], qb[ks], d1); }
        float s1 = 0.f;
#pragma unroll
        for (int r = 0; r < 16; ++r) s1 += d0[r] + d1[r];
        s1 += __shfl_xor(s1, 32);
        const float mean = s1 * (1.f / 64.f); float s2 = 0.f;
#pragma unroll
        for (int r = 0; r < 16; ++r) { const float e0 = d0[r] - mean, e1 = d1[r] - mean; s2 += e0 * e0 + e1 * e1; }
        s2 += __shfl_xor(s2, 32);
        const float rinv = rsqrtf(s2 * (1.f / 64.f) + 64e-5f);
#pragma unroll
        for (int vt = 0; vt < 2; ++vt)
#pragma unroll
            for (int q = 0; q < 4; ++q) { const int c = 64 * h + 32 * vt + 8 * q + 4 * hi; const u32x2 v2 = vw[4 * vt + q], g2 = gg[4 * vt + q];
                const float vv[4] = {bflo(v2.x), bfhi(v2.x), bflo(v2.y), bfhi(v2.y)}, gf[4] = {bflo(g2.x), bfhi(g2.x), bflo(g2.y), bfhi(g2.y)}; float r4[4];
#pragma unroll
                for (int e = 0; e < 4; ++e) { const float y = vt ? d1[4 * q + e] : d0[4 * q + e]; r4[e] = ((y - mean) * rinv * l4[4 * vt + q][e] + b4[4 * vt + q][e] + bon * vv[e]) * gf[e]; }
                *(u32x2*)(O + m * DM + 512 + c) = (u32x2){pk2(r4[0], r4[1]), pk2(r4[2], r4[3])}; }
    }
}

#define XB_TMO      128
#define XB_XCNT(j)  (256  + 64 * (j))
#define XB_XSUB(j)  (1280 + 64 * (j))
#define XB_XGEN(j)  (2304 + 64 * (j))
#define XB_TOP      3328
#define XB_TOPGEN   3392
#define XCD_BAR_WORDS 3456
#define XB_SPIN_CAP (1u << 18)

__device__ __forceinline__ unsigned xb_ld(unsigned* p)              { return __hip_atomic_load(p, __ATOMIC_RELAXED, __HIP_MEMORY_SCOPE_AGENT); }
__device__ __forceinline__ unsigned xb_add(unsigned* p, unsigned v) { return __hip_atomic_fetch_add(p, v, __ATOMIC_RELAXED, __HIP_MEMORY_SCOPE_AGENT); }
__device__ __forceinline__ unsigned xb_xcc_id() { return (unsigned)__builtin_amdgcn_s_getreg((3 << 11) | 20) & 0xFu; }
#define XB_SPIN(cond, bar) do { unsigned _sp = 0; while (cond) { __builtin_amdgcn_s_sleep(1); \
    if ((++_sp & 255u) == 0u) { if (xb_ld(&(bar)[XB_TMO])) break; if (_sp > XB_SPIN_CAP) { atomicAdd(&(bar)[XB_TMO], 1u); break; } } } } while (0)

struct XcdBarrier {
    unsigned* bar; unsigned x;
    volatile __attribute__((address_space(3))) unsigned* st;
};

__device__ __forceinline__ XcdBarrier xcd_barrier_post(unsigned* bar, volatile __attribute__((address_space(3))) unsigned* st) {
    XcdBarrier b; b.bar = bar; b.x = xb_xcc_id(); b.st = st;
    if (threadIdx.x == 0) (void)xb_add(&bar[XB_XCNT(b.x)], 1u);
    return b;
}
__device__ __forceinline__ void xcd_barrier_complete(unsigned* bar, unsigned x, unsigned& nloc, unsigned& nx) {
    const unsigned G = gridDim.x * gridDim.y * gridDim.z;
    unsigned sum, cnt, mine, sp = 0u;
    for (;;) {
        sum = 0u; cnt = 0u; mine = 0u;
#pragma unroll
        for (unsigned j = 0; j < 16; ++j) { const unsigned c = xb_ld(&bar[XB_XCNT(j)]); sum += c; cnt += (c > 0u) ? 1u : 0u; mine = (j == x) ? c : mine; }
        if (sum == G) break;
        __builtin_amdgcn_s_sleep(1);
        if ((++sp & 255u) == 0u) { if (xb_ld(&bar[XB_TMO])) break; if (sp > XB_SPIN_CAP) { atomicAdd(&bar[XB_TMO], 1u); break; } }
    }
    nloc = mine > 0u ? mine : 1u; nx = cnt > 0u ? cnt : 1u;
}

__device__ __forceinline__ void xcd_barrier(const XcdBarrier& b) {
    asm volatile("s_waitcnt vmcnt(0)" ::: "memory");
    __syncthreads();
    if (threadIdx.x == 0) {
        unsigned* bar = b.bar;
        __builtin_amdgcn_s_waitcnt(0);
        unsigned nloc = b.st[0], nx = b.st[1];
        if (nloc == 0u) { xcd_barrier_complete(bar, b.x, nloc, nx); b.st[0] = nloc; b.st[1] = nx; }
        const unsigned old = xb_add(&bar[XB_XSUB(b.x)], 1u);
        const unsigned gen = old / nloc;
        if (old + 1u == (gen + 1u) * nloc) {
            __builtin_amdgcn_fence(__ATOMIC_RELEASE, "agent");
            asm volatile("s_waitcnt vmcnt(0)" ::: "memory");
            const unsigned og = xb_add(&bar[XB_TOP], 1u);
            const unsigned tg = og / nx;
            if (og + 1u == (tg + 1u) * nx) xb_add(&bar[XB_TOPGEN], 1u);
            else XB_SPIN(xb_ld(&bar[XB_TOPGEN]) == tg, bar);
            __builtin_amdgcn_fence(__ATOMIC_ACQUIRE, "agent");
            xb_add(&bar[XB_XGEN(b.x)], 1u);
            asm volatile("s_waitcnt vmcnt(0)" ::: "memory");
        } else {
            XB_SPIN(xb_ld(&bar[XB_XGEN(b.x)]) == gen, bar);
            __builtin_amdgcn_fence(__ATOMIC_ACQUIRE, "agent");
            asm volatile("s_waitcnt vmcnt(0)" ::: "memory");
        }
    }
    __syncthreads();
}

constexpr int CW_BAR = 4096;
constexpr int LDS_BYTES = 163840;
constexpr int N_PHASES = 12;
#ifndef PROBE_MASK
#define PROBE_MASK 0
#endif
template <int PH> __device__ __forceinline__ void run_phase(const Args& args, unsigned char* lds, int tid, int rep) {
    unsigned char* ws = args.ws;
    if constexpr (PH == 0) p0_prologue(args, lds, tid);
    if constexpr (PH == 1) { pg8::Gemm g{(const pg8::bf16_t*)(ws + WS_XB), (const pg8::bf16_t*)(ws + WS_WIN), MT, NZ, DM, DM}; pg8::StaticOrder S; S.init(MT, NZ, gridDim.x, blockIdx.x);
        pg8::EpiZ E{(pg8::bf16_t*)(ws + WS_ZR), (pg8::bf16_t*)(ws + WS_ZS)};
        pg8::gemm_phase<pg8::EpiZ, pg8::StaticOrder, true, true>((PG8_LAS unsigned char*)lds, g, S, E); }
    if constexpr (PH == 2) p2_post(args, lds, tid);
    if constexpr (PH == 3) p3_attention(args, lds, tid, rep);
    if constexpr (PH == 4) p4w_chunks(args, lds, tid);
    if constexpr (PH == 5) p5w_chain(args, lds, tid);
    if constexpr (PH == 6) p6w_out(args, tid);
    if constexpr (PH == 7) { pg8::Gemm g{(const pg8::bf16_t*)(ws + WS_XB), (const pg8::bf16_t*)(ws + WS_WOUT), MT, DM, DM, DM}; pg8::StaticOrder S; S.init(MT, DM, gridDim.x, blockIdx.x);
        pg8::EpiH E{args.in[0], args.in[1], args.out + OFF_Y, (pg8::bf16_t*)(ws + WS_HB), (float*)(ws + WS_CTL) + CW_SS};
        pg8::gemm_phase<pg8::EpiH, pg8::StaticOrder, true, true>((PG8_LAS unsigned char*)lds, g, S, E); }
    if constexpr (PH == 9) { pg8::Gemm g{(const pg8::bf16_t*)(ws + WS_HB), (const pg8::bf16_t*)(ws + WS_W1), MT, DFF, DM, DM}; pg8::StaticOrder S; S.init(MT, DFF, gridDim.x, blockIdx.x);
        pg8::EpiAct E{(pg8::bf16_t*)(ws + WS_ACT), DFF, (const float*)(ws + WS_CTL) + CW_SS};
        pg8::gemm_phase<pg8::EpiAct, pg8::StaticOrder, true, true>((PG8_LAS unsigned char*)lds, g, S, E); }
    if constexpr (PH == 10) {
        { pg8::Gemm g{(const pg8::bf16_t*)(ws + WS_ACT), (const pg8::bf16_t*)(ws + WS_W2), MP, DM, DFF, DFF}; pg8::StaticOrder S; S.init(MP, DM, gridDim.x, blockIdx.x);
          pg8::EpiY E{args.out + OFF_Y};
          pg8::gemm_phase<pg8::EpiY, pg8::StaticOrder, true, true>((PG8_LAS unsigned char*)lds, g, S, E); }
        { const int c = blockIdx.x; pg8::OneUnit S; S.has = c < 64; S.u.pm = MP / 256 + (c >> 4); S.u.pn = (c >> 2) & 3; const int sl = c & 3;
          pg8::Gemm g{(const pg8::bf16_t*)(ws + WS_ACT) + sl * 1024, (const pg8::bf16_t*)(ws + WS_W2) + sl * 1024, MT, DM, DFF, 1024};
          pg8::EpiSlab E{(float*)(ws + WS_HB) + (size_t)sl * MS * DM};
          __syncthreads();
          pg8::gemm_phase<pg8::EpiSlab, pg8::OneUnit, false, true>((PG8_LAS unsigned char*)lds, g, S, E); }
    }
    if constexpr (PH == 11) {
        const f32x4* sl = (const f32x4*)(ws + WS_HB); f32x4* y = (f32x4*)(args.out + OFF_Y + (size_t)MP * DM); constexpr int NV = MS * DM / 4;
        for (int i = blockIdx.x * 512 + tid; i < NV; i += gridDim.x * 512) y[i] = y[i] + ((sl[i] + sl[i + NV]) + (sl[i + 2 * NV] + sl[i + 3 * NV]));
    }
}
#ifndef MK_ONE_LAUNCH
#define MK_ONE_LAUNCH 1
#endif
#if MK_ONE_LAUNCH
__global__ void __launch_bounds__(512, 2) mk_fwd(Args args) {
    extern __shared__ __attribute__((aligned(16))) unsigned char lds[];
    const int tid = threadIdx.x;
    volatile __attribute__((address_space(3))) unsigned* bst = (volatile __attribute__((address_space(3))) unsigned*)((__attribute__((address_space(3))) unsigned char*)lds + LDS_BYTES - 16);
    if (tid < 2) bst[tid] = 0u;
    __syncthreads();
    const XcdBarrier bar = xcd_barrier_post((unsigned*)(args.ws + WS_CTL) + CW_BAR, bst);
    if (args.ph_lo < 0) { __syncthreads(); cg::this_grid().sync(); }
#define SEAM(k) xcd_barrier(bar)
#define PHASE(k) do { if (args.ph_lo <= (k) && (k) < args.ph_hi) { if ((k) > args.ph_lo) SEAM(k); run_phase<k>(args, lds, tid, 0); \
        if ((PROBE_MASK >> (k)) & 1) { xcd_barrier(bar); run_phase<k>(args, lds, tid, 1); } } } while (0)
    PHASE(0); PHASE(1); PHASE(2); PHASE(3); PHASE(4); PHASE(5); PHASE(6); PHASE(7); PHASE(9); PHASE(10); PHASE(11);
#undef PHASE
#undef SEAM
}
#else
template <int PH> __global__ void __launch_bounds__(512, 2) mk_phase(Args args) {
    extern __shared__ __attribute__((aligned(16))) unsigned char lds[];
    run_phase<PH>(args, lds, threadIdx.x, 0);
}
#endif

extern "C" void kernel_launch(void* const* d_in, const int* in_sizes, int n_in, void* d_out, int out_size, void* d_ws, size_t ws_size, hipStream_t stream) {
    static int grid = 0;
    if (grid == 0) {
        if (n_in != 28 || out_size != (int)OUT_TOTAL || ws_size < WS_END) { fprintf(stderr, "kernel_launch: unexpected shapes (n_in %d, out %d, ws %zu)\n", n_in, out_size, ws_size); grid = -1; return; }
        int dev = 0, cus = 0, per_cu = 0;
        (void)hipGetDevice(&dev); (void)hipDeviceGetAttribute(&cus, hipDeviceAttributeMultiprocessorCount, dev);
#if MK_ONE_LAUNCH
        if (hipFuncSetAttribute((const void*)mk_fwd, hipFuncAttributeMaxDynamicSharedMemorySize, LDS_BYTES) != hipSuccess) { fprintf(stderr, "kernel_launch: hipFuncSetAttribute failed\n"); grid = -1; return; }
        (void)hipOccupancyMaxActiveBlocksPerMultiprocessor(&per_cu, (const void*)mk_fwd, 512, LDS_BYTES);
        (void)hipGetLastError();
        if (per_cu < 1) { fprintf(stderr, "kernel_launch: occupancy query says %d blocks per CU\n", per_cu); per_cu = 1; }
#else
#define SETATTR(k) (void)hipFuncSetAttribute((const void*)mk_phase<k>, hipFuncAttributeMaxDynamicSharedMemorySize, LDS_BYTES)
        SETATTR(0); SETATTR(1); SETATTR(2); SETATTR(3); SETATTR(4); SETATTR(5); SETATTR(6); SETATTR(7); SETATTR(8); SETATTR(9); SETATTR(10); SETATTR(11);
#undef SETATTR
        (void)per_cu;
#endif
        grid = cus;
    }
    if (grid < 0) return;
    (void)hipMemsetAsync((char*)d_ws + WS_CTL, 0, CTL_BYTES, stream);
    Args a{};
    for (int i = 0; i < 28; ++i) a.in[i] = (const float*)d_in[i];
    a.out = (float*)d_out; a.ws = (unsigned char*)d_ws;
#if MK_ONE_LAUNCH
    a.ph_lo = 0; a.ph_hi = N_PHASES;
    void* kargs[] = {&a};
    hipError_t e = hipLaunchCooperativeKernel((const void*)mk_fwd, dim3(grid), dim3(512), kargs, LDS_BYTES, stream);
    if (e != hipSuccess) fprintf(stderr, "kernel_launch: cooperative launch failed: %s (grid %d)\n", hipGetErrorString(e), grid);
#else
#define LAUNCH(k) hipLaunchKernelGGL(mk_phase<k>, dim3(grid), dim3(512), LDS_BYTES, stream, a)
    a.ph_lo = 0; a.ph_hi = N_PHASES;
    LAUNCH(0); LAUNCH(1); LAUNCH(2); LAUNCH(3); LAUNCH(4); LAUNCH(5); LAUNCH(6); LAUNCH(7); LAUNCH(9); LAUNCH(10); LAUNCH(11);
#undef LAUNCH
#endif
}
```

```cpp
#include <hip/hip_runtime.h>
#include <hip/hip_cooperative_groups.h>
#include <cstdio>
#include <cstdint>
namespace cg = cooperative_groups;
#define LBAR() asm volatile("s_waitcnt lgkmcnt(0)\n\ts_barrier" ::: "memory")
#define PROBE_A1 0
#define PROBE_A2 0
#define PROBE_A3 0
namespace pg8 {
#define PG8_LAS __attribute__((address_space(3)))
typedef unsigned short bf16_t;
typedef short bf16x8 __attribute__((ext_vector_type(8)));
typedef float f32x4 __attribute__((ext_vector_type(4)));
typedef unsigned u32x4 __attribute__((ext_vector_type(4)));
constexpr int BM = 256, BK = 64, HALF = 128, HTB = HALF * BK * 2  , STAGE_BYTES = 8 * HTB, NXCD = 8, WGM = 8;

__host__ __device__ __forceinline__ int lds_byte(int r, int c) { const int st = (r >> 4) * 2 + (c >> 5), rr = r & 15, cc = c & 31, ob = rr * 64 + cc * 2; return st * 1024 + (ob ^ (((ob >> 9) & 1) << 5)); }
__host__ __device__ __forceinline__ void stage_rc(int b, int& R, int& C) { const int st = b / 1024, sb = b % 1024, swz = sb ^ (((sb >> 9) & 1) << 5); R = (st >> 1) * 16 + swz / 64; C = (st & 1) * 32 + (swz % 64) / 2; }
__host__ __device__ __forceinline__ int perm32(int rho) { const int n = rho >> 4, i = rho & 15; return 8 * (i >> 2) + 4 * n + (i & 3); }

struct Unit { int pm, pn; };
struct Gemm { const bf16_t* A; const bf16_t* Bt; int M, N, K, KL; };

struct StaticOrder {
    int nM, nN, nwg, G, c;
    __host__ __device__ void init(int M, int N, int G_, int c_) { nM = M / BM; nN = N / BM; nwg = nM * nN; G = G_; c = c_; }
    __host__ __device__ bool next(int i, Unit& u) const {
        const long L = (long)i * G + c; if (L >= nwg) return false;
        int wgid = (int)L; { const int q = nwg / NXCD, r = nwg % NXCD, xcd = wgid % NXCD, off = wgid / NXCD; wgid = (xcd < r ? xcd * (q + 1) : r * (q + 1) + (xcd - r) * q) + off; }
        const int nig = WGM * nN, gid = wgid / nig, fm = gid * WGM, gsz = (nM - fm) < WGM ? (nM - fm) : WGM;
        u.pm = fm + ((wgid % nig) % gsz); u.pn = (wgid % nig) / gsz; return true;
    }
    __device__ __forceinline__ void a_ready(const Unit&) const {}
    __device__ __forceinline__ void done(const Unit&) const {}
};


__device__ __forceinline__ unsigned cvt_pk_bf16(float lo, float hi) { unsigned r; asm volatile("v_cvt_pk_bf16_f32 %0, %1, %2" : "=v"(r) : "v"(lo), "v"(hi)); return r; }
typedef float cv_f32x2 __attribute__((ext_vector_type(2))); typedef __bf16 cv_bf16x2 __attribute__((ext_vector_type(2)));
__device__ __forceinline__ unsigned cvt2_safe(float lo, float hi) { const cv_f32x2 v = {lo, hi}; const cv_bf16x2 b = __builtin_convertvector(v, cv_bf16x2); return __builtin_bit_cast(unsigned, b); }

constexpr int E_MP = 16384;
constexpr int E_ZRW = 1632, E_ZSW = 1696;

struct OneUnit { Unit u; bool has;
    __device__ __forceinline__ bool next(int i, Unit& o) const { if (i == 0 && has) { o = u; return true; } return false; }
    __device__ __forceinline__ void a_ready(const Unit&) const {}
    __device__ __forceinline__ void done(const Unit&) const {} };
struct EpiZ {
    static constexpr bool PERM = true, AFTER_DRAIN = false;
    bf16_t* ZR; bf16_t* ZS;
    __device__ __forceinline__ void operator()(const f32x4 (&acc)[2][2][4][2], const Unit& u, int wr, int wc, int fr, int fq) const {
        const int row0 = u.pm * BM + wr * 64 + fr, c0 = u.pn * BM + wc * 32 + 8 * fq;
#pragma unroll
        for (int ai = 0; ai < 2; ++ai)
#pragma unroll
            for (int m = 0; m < 4; ++m) { const size_t row = (size_t)(row0 + ai * HALF + m * 16);
#pragma unroll
                for (int bj = 0; bj < 2; ++bj) { const int c = c0 + bj * HALF; bf16_t* dst;
                    if (c < 1600) dst = ZR + row * E_ZRW + c; else if (c < 3296) dst = ZS + row * E_ZSW + (c - 1600); else if (c == 3296) dst = ZR + row * E_ZRW + 1600; else continue;
                    const f32x4 v0 = acc[ai][bj][m][0], v1 = acc[ai][bj][m][1]; u32x4 w;
                    w.x = cvt2_safe(v0[0], v0[1]); w.y = cvt2_safe(v0[2], v0[3]); w.z = cvt2_safe(v1[0], v1[1]); w.w = cvt2_safe(v1[2], v1[3]);
                    *(u32x4*)dst = w; } }
    }
};
struct EpiH {
    static constexpr bool PERM = false, AFTER_DRAIN = false;
    const float* xp; const float* xs; float* H; bf16_t* HB; float* SS;
    __device__ __forceinline__ void operator()(const f32x4 (&acc)[2][2][4][2], const Unit& u, int wr, int wc, int fr, int fq) const {
        const int row0 = u.pm * BM + wr * 64 + fr, col0 = u.pn * BM + wc * 32 + 4 * fq;
#pragma unroll
        for (int ai = 0; ai < 2; ++ai)
#pragma unroll
            for (int m = 0; m < 4; ++m) { const int row = row0 + ai * HALF + m * 16;
                const float* xr = (row < E_MP ? xp + (size_t)row * 1024 : xs + (size_t)(row - E_MP) * 1024) + col0; bf16_t* hb = HB + (size_t)row * 1024 + col0;
                float ss = 0.f;
#pragma unroll
                for (int bj = 0; bj < 2; ++bj)
#pragma unroll
                    for (int n = 0; n < 2; ++n) { const f32x4 h = *(const f32x4*)(xr + bj * HALF + n * 16) + acc[ai][bj][m][n];
                        ss += (h[0] * h[0] + h[1] * h[1]) + (h[2] * h[2] + h[3] * h[3]);
                        unsigned w0 = cvt_pk_bf16(h[0], h[1]), w1 = cvt_pk_bf16(h[2], h[3]); typedef unsigned u32x2v __attribute__((ext_vector_type(2))); *(u32x2v*)(hb + bj * HALF + n * 16) = (u32x2v){w0, w1}; }
                ss += __shfl_xor(ss, 16); ss += __shfl_xor(ss, 32);
                if (fq == 0) atomicAdd(SS + row, ss); }
    }
};
struct EpiAct {
    static constexpr bool PERM = true, AFTER_DRAIN = false;
    bf16_t* O; int ldc; const float* SS;
    __device__ __forceinline__ void operator()(const f32x4 (&acc)[2][2][4][2], const Unit& u, int wr, int wc, int fr, int fq) const {
        const int row0 = u.pm * BM + wr * 64 + fr, c0 = u.pn * BM + wc * 32 + 8 * fq;
#pragma unroll
        for (int ai = 0; ai < 2; ++ai)
#pragma unroll
            for (int m = 0; m < 4; ++m) { const int row = row0 + ai * HALF + m * 16; bf16_t* rowp = O + (size_t)row * ldc + c0;
                const float rs = rsqrtf(SS[row] * (1.0f / 1024.0f) + 1e-6f);
#pragma unroll
                for (int bj = 0; bj < 2; ++bj) { f32x4 v0 = acc[ai][bj][m][0], v1 = acc[ai][bj][m][1];
#pragma unroll
                    for (int e = 0; e < 4; ++e) { const float a = fmaxf(v0[e], 0.f) * rs, b = fmaxf(v1[e], 0.f) * rs; v0[e] = a * a; v1[e] = b * b; }
                    u32x4 w; w.x = cvt_pk_bf16(v0[0], v0[1]); w.y = cvt_pk_bf16(v0[2], v0[3]); w.z = cvt_pk_bf16(v1[0], v1[1]); w.w = cvt_pk_bf16(v1[2], v1[3]);
                    *(u32x4*)(rowp + bj * HALF) = w; } }
    }
};
struct EpiSlab {
    static constexpr bool PERM = false, AFTER_DRAIN = false;
    float* S;
    __device__ __forceinline__ void operator()(const f32x4 (&acc)[2][2][4][2], const Unit& u, int wr, int wc, int fr, int fq) const {
        const int row0 = u.pm * BM - E_MP + wr * 64 + fr, col0 = u.pn * BM + wc * 32 + 4 * fq;
#pragma unroll
        for (int ai = 0; ai < 2; ++ai)
#pragma unroll
            for (int m = 0; m < 4; ++m) { float* yr = S + (size_t)(row0 + ai * HALF + m * 16) * 1024 + col0;
#pragma unroll
                for (int bj = 0; bj < 2; ++bj)
#pragma unroll
                    for (int n = 0; n < 2; ++n) *(f32x4*)(yr + bj * HALF + n * 16) = acc[ai][bj][m][n]; }
    }
};
struct EpiY {
    static constexpr bool PERM = false, AFTER_DRAIN = false;
    float* Y; const bf16_t* HB;
    __device__ __forceinline__ void operator()(const f32x4 (&acc)[2][2][4][2], const Unit& u, int wr, int wc, int fr, int fq) const {
        const int row0 = u.pm * BM + wr * 64 + fr, col0 = u.pn * BM + wc * 32 + 4 * fq;
        typedef unsigned u32x2v __attribute__((ext_vector_type(2)));
#pragma unroll
        for (int ai = 0; ai < 2; ++ai)
#pragma unroll
            for (int m = 0; m < 4; ++m) { const size_t ro = (size_t)(row0 + ai * HALF + m * 16) * 1024 + col0;
#pragma unroll
                for (int bj = 0; bj < 2; ++bj)
#pragma unroll
                    for (int n = 0; n < 2; ++n) { const u32x2v hw = *(const u32x2v*)(HB + ro + bj * HALF + n * 16);
                        const f32x4 h = {__uint_as_float(hw.x << 16), __uint_as_float(hw.x & 0xffff0000u), __uint_as_float(hw.y << 16), __uint_as_float(hw.y & 0xffff0000u)};
                        *(f32x4*)(Y + ro + bj * HALF + n * 16) = h + acc[ai][bj][m][n]; } }
    }
};

template <class Epi, class Sched, bool ALIGN_EPI = false, bool SP2 = false>
__device__ __forceinline__ void gemm_phase(PG8_LAS unsigned char* lds, const Gemm g, const Sched& S, const Epi& E) {
    const int tid = threadIdx.x, wid = __builtin_amdgcn_readfirstlane(tid >> 6), lane = tid & 63, wr = wid >> 2, wc = wid & 3, fr = lane & 15, fq = lane >> 4;
    const int K = g.K, nt = g.KL / BK;
    unsigned voffA[2], voffB[2];
#pragma unroll
    for (int i = 0; i < 2; ++i) { int R, C; stage_rc(tid * 16 + i * 8192, R, C); const int Rb = Epi::PERM ? ((R & ~31) + perm32(R & 31)) : R;
        voffA[i] = (unsigned)(R * K + C) * 2u; voffB[i] = (unsigned)(Rb * K + C) * 2u; }
    const size_t kstep = (size_t)(BK * 2);
    const size_t hstep = (size_t)HALF * K * 2;
    const size_t tstep = 2 * hstep;
    const unsigned ldsw = (unsigned)wid * 1024u;
    const int aoff = lds_byte(wr * 64 + fr, fq * 8), boff = lds_byte(wc * 32 + fr, fq * 8);
#define PG8_SA(b, h) (((b) * 2 + (h)) * HTB)
#define PG8_SB(b, h) ((4 + (b) * 2 + (h)) * HTB)
#define PG8_STAGE(bufoff, gbase, voff) do { _Pragma("unroll") for (int _i = 0; _i < 2; ++_i) \
        __builtin_amdgcn_global_load_lds((const unsigned*)((const char*)(gbase) + (voff)[_i]), (PG8_LAS unsigned*)(lds + (bufoff) + ldsw + _i * 8192), 16, 0, 0); } while (0)
#define PG8_LDA(dst, b, h) do { _Pragma("unroll") for (int m = 0; m < 4; ++m) _Pragma("unroll") for (int k = 0; k < 2; ++k) dst[m][k] = *(const PG8_LAS bf16x8*)(lds + PG8_SA(b, h) + aoff + m * 2048 + k * 1024); } while (0)
#define PG8_LDB(dst, b, h) do { _Pragma("unroll") for (int n = 0; n < 2; ++n) _Pragma("unroll") for (int k = 0; k < 2; ++k) dst[n][k] = *(const PG8_LAS bf16x8*)(lds + PG8_SB(b, h) + boff + n * 2048 + k * 1024); } while (0)
#define PG8_MMA(ai, bj, At, Bt) do { __builtin_amdgcn_s_setprio(1); _Pragma("unroll") for (int m = 0; m < 4; ++m) _Pragma("unroll") for (int n = 0; n < 2; ++n) _Pragma("unroll") for (int k = 0; k < 2; ++k) \
        acc[ai][bj][m][n] = __builtin_amdgcn_mfma_f32_16x16x32_bf16(Bt[n][k], At[m][k], acc[ai][bj][m][n], 0, 0, 0); __builtin_amdgcn_s_setprio(0); } while (0)
#define PG8_WAIT_V(n) asm volatile("s_waitcnt vmcnt(" #n ")" ::: "memory")
#define PG8_WAIT_L(n) asm volatile("s_waitcnt lgkmcnt(" #n ")" ::: "memory")
#define PG8_BAR __builtin_amdgcn_s_barrier()
#define PG8_SCHED __builtin_amdgcn_sched_barrier(0)
    Unit cur, nxt; int ui = 0;
    if (!S.next(0, cur)) return;
    f32x4 acc[2][2][4][2];
#pragma unroll
    for (int a = 0; a < 2; ++a)
#pragma unroll
        for (int b = 0; b < 2; ++b)
#pragma unroll
            for (int m = 0; m < 4; ++m)
#pragma unroll
                for (int n = 0; n < 2; ++n) acc[a][b][m][n] = (f32x4){0.f, 0.f, 0.f, 0.f};
    bf16x8 At[4][2], B0[2][2], B1[2][2];
    const char* cA = (const char*)g.A + (size_t)cur.pm * tstep; const char* cB = (const char*)g.Bt + (size_t)cur.pn * tstep;
    S.a_ready(cur);
    if constexpr (SP2) {
        PG8_STAGE(PG8_SB(0, 0), cB, voffB); PG8_STAGE(PG8_SB(0, 1), cB + hstep, voffB); PG8_STAGE(PG8_SA(0, 0), cA, voffA); PG8_STAGE(PG8_SA(0, 1), cA + hstep, voffA);
        if (wr == 1) PG8_BAR;
        PG8_WAIT_V(2); PG8_BAR;
        PG8_STAGE(PG8_SB(1, 0), cB + kstep, voffB); PG8_STAGE(PG8_SA(1, 0), cA + kstep, voffA); PG8_STAGE(PG8_SB(1, 1), cB + hstep + kstep, voffB);
        PG8_WAIT_V(6); PG8_BAR;
    } else {
        PG8_STAGE(PG8_SB(0, 0), cB, voffB); PG8_STAGE(PG8_SA(0, 0), cA, voffA); PG8_STAGE(PG8_SB(0, 1), cB + hstep, voffB); PG8_STAGE(PG8_SA(0, 1), cA + hstep, voffA);
        if (wr == 1) PG8_BAR;
        PG8_WAIT_V(4); PG8_BAR;
        PG8_STAGE(PG8_SB(1, 0), cB + kstep, voffB); PG8_STAGE(PG8_SA(1, 0), cA + kstep, voffA); PG8_STAGE(PG8_SB(1, 1), cB + hstep + kstep, voffB);
        PG8_WAIT_V(6); PG8_BAR;
    }
    for (;;) {
        const bool has_next = S.next(ui + 1, nxt);
        const char* nA = has_next ? (const char*)g.A + (size_t)nxt.pm * tstep : cA; const char* nB = has_next ? (const char*)g.Bt + (size_t)nxt.pn * tstep : cB;
        for (int t = 0; t < nt; t += 2) {
            const bool last = (t == nt - 2);
            const char* a1 = cA + (size_t)(t + 1) * kstep;
            const char* a2 = last ? nA : cA + (size_t)(t + 2) * kstep; const char* b2 = last ? nB : cB + (size_t)(t + 2) * kstep;
            const char* a3 = a2 + kstep; const char* b3 = b2 + kstep;
            if (last && has_next) S.a_ready(nxt);
            if constexpr (SP2) {
            PG8_LDB(B0, 0, 0); PG8_LDB(B1, 0, 1); PG8_SCHED; PG8_LDA(At, 0, 0); PG8_STAGE(PG8_SA(1, 1), a1 + hstep, voffA);
            PG8_WAIT_V(8); PG8_WAIT_L(0); PG8_BAR; PG8_MMA(0, 0, At, B0); PG8_MMA(0, 1, At, B1); PG8_BAR; PG8_SCHED;
            PG8_LDA(At, 0, 1); PG8_STAGE(PG8_SB(0, 0), b2, voffB); PG8_STAGE(PG8_SB(0, 1), b2 + hstep, voffB); PG8_STAGE(PG8_SA(0, 0), a2, voffA);
            PG8_WAIT_V(8); PG8_WAIT_L(0); PG8_BAR; PG8_MMA(1, 0, At, B0); PG8_MMA(1, 1, At, B1); PG8_BAR; PG8_SCHED;
            PG8_LDB(B0, 1, 0); PG8_LDB(B1, 1, 1); PG8_SCHED; PG8_LDA(At, 1, 0); PG8_STAGE(PG8_SA(0, 1), a2 + hstep, voffA);
            PG8_WAIT_V(8); PG8_WAIT_L(0); PG8_BAR; PG8_MMA(0, 0, At, B0); PG8_MMA(0, 1, At, B1); PG8_BAR; PG8_SCHED;
            PG8_LDA(At, 1, 1); PG8_STAGE(PG8_SB(1, 0), b3, voffB); PG8_STAGE(PG8_SB(1, 1), b3 + hstep, voffB); PG8_STAGE(PG8_SA(1, 0), a3, voffA);
            PG8_WAIT_V(8); PG8_WAIT_L(0); PG8_BAR; PG8_MMA(1, 0, At, B0); PG8_MMA(1, 1, At, B1); PG8_BAR; PG8_SCHED;
            } else {
            PG8_LDB(B0, 0, 0); PG8_SCHED; PG8_LDA(At, 0, 0); PG8_STAGE(PG8_SA(1, 1), a1 + hstep, voffA);
            PG8_WAIT_L(8); PG8_BAR; PG8_WAIT_L(0); PG8_MMA(0, 0, At, B0); PG8_BAR; PG8_SCHED;
            PG8_LDB(B1, 0, 1); PG8_STAGE(PG8_SB(0, 0), b2, voffB);
            PG8_BAR; PG8_WAIT_L(0); PG8_MMA(0, 1, At, B1); PG8_BAR;
            PG8_LDA(At, 0, 1); PG8_STAGE(PG8_SA(0, 0), a2, voffA);
            PG8_BAR; PG8_WAIT_L(0); PG8_MMA(1, 0, At, B0); PG8_BAR; PG8_SCHED;
            PG8_STAGE(PG8_SB(0, 1), b2 + hstep, voffB);
            PG8_WAIT_V(6); PG8_BAR; PG8_MMA(1, 1, At, B1); PG8_BAR;
            PG8_LDB(B0, 1, 0); PG8_SCHED; PG8_LDA(At, 1, 0); PG8_STAGE(PG8_SA(0, 1), a2 + hstep, voffA);
            PG8_WAIT_L(8); PG8_BAR; PG8_WAIT_L(0); PG8_MMA(0, 0, At, B0); PG8_BAR; PG8_SCHED;
            PG8_LDB(B1, 1, 1); PG8_STAGE(PG8_SB(1, 0), b3, voffB);
            PG8_BAR; PG8_WAIT_L(0); PG8_MMA(0, 1, At, B1); PG8_BAR;
            PG8_LDA(At, 1, 1); PG8_STAGE(PG8_SA(1, 0), a3, voffA);
            PG8_BAR; PG8_WAIT_L(0); PG8_MMA(1, 0, At, B0); PG8_BAR; PG8_SCHED;
            PG8_STAGE(PG8_SB(1, 1), b3 + hstep, voffB);
            PG8_WAIT_V(6); PG8_BAR; PG8_MMA(1, 1, At, B1); PG8_BAR;
            }
        }
        if constexpr (ALIGN_EPI) { if (wr == 0) PG8_BAR; }
        if constexpr (!Epi::AFTER_DRAIN) { E(acc, cur, wr, wc, fr, fq); S.done(cur); }
        if (!has_next) break;
#pragma unroll
        for (int a = 0; a < 2; ++a)
#pragma unroll
            for (int b = 0; b < 2; ++b)
#pragma unroll
                for (int m = 0; m < 4; ++m)
#pragma unroll
                    for (int n = 0; n < 2; ++n) acc[a][b][m][n] = (f32x4){0.f, 0.f, 0.f, 0.f};
        cur = nxt; cA = nA; cB = nB; ++ui;
        if constexpr (ALIGN_EPI) { if (wr == 1) PG8_BAR; }
    }
    PG8_WAIT_V(0);
    if constexpr (!ALIGN_EPI) { if (wr == 0) PG8_BAR; }
    PG8_BAR;
    if constexpr (Epi::AFTER_DRAIN) { E.fused(acc, cur, wr, wc, fr, fq, lds, wid, lane); S.done(cur); }
#undef PG8_SA
#undef PG8_SB
#undef PG8_STAGE
#undef PG8_LDA
#undef PG8_LDB
#undef PG8_MMA
#undef PG8_WAIT_V
#undef PG8_WAIT_L
#undef PG8_BAR
#undef PG8_SCHED
}
}


constexpr int DM = 1024, NB_P = 8, T_P = 2048, NB_S = 32, T_S = 32, PAST = 1024;
constexpr int MP = NB_P * T_P, MS = NB_S * T_S, MT = MP + MS;
constexpr int LS = PAST + T_S;
constexpr int SHIFTW = 1696, NZ = 3328, ZRW = 1632, DFF = 4096;
constexpr float QSCALE = 0.125f * 1.4426950408889634f;
constexpr float WISCALE = 0.35355339059327373f * 0.125f;
constexpr size_t OFF_Y = 0, OFF_KP = 17825792, OFF_VP = OFF_KP + 4194304, OFF_KIP = OFF_VP + 4194304, OFF_WKVP = OFF_KIP + 1048576, OFF_SHP = OFF_WKVP + 262144,
                 OFF_KS = OFF_SHP + 13568, OFF_VS = OFF_KS + 262144, OFF_KIS = OFF_VS + 262144, OFF_WKVS = OFF_KIS + 65536, OFF_SHS = OFF_WKVS + 1048576, OUT_TOTAL = OFF_SHS + 54272;
constexpr size_t MiB = 1u << 20;
constexpr size_t WS_CTL = 0, CTL_BYTES = 1 * MiB;
constexpr size_t WS_WIN = 1 * MiB, WS_WOUT = 8 * MiB, WS_W1 = 10 * MiB, WS_W2 = 18 * MiB;
constexpr size_t WS_W2T = 26 * MiB, WS_A2T = WS_W2T + 32768, WS_G2T = WS_A2T + 32768, WS_WI = 27 * MiB, WS_BONUS = 28 * MiB;
constexpr size_t WS_XB = 30 * MiB;
constexpr size_t WS_ZS = 66 * MiB;
constexpr size_t WS_R = 123 * MiB;
constexpr size_t WS_ZR = WS_R, WS_KBP = 178 * MiB, WS_VTP = 186 * MiB, WS_KIP = 194 * MiB, WS_KBS = 196 * MiB, WS_VTS = 213 * MiB, WS_KIS = 230 * MiB;
constexpr size_t WS_OW = WS_R, WS_OKK = 157 * MiB, WS_OB = 174 * MiB, WS_OKM = 191 * MiB, WS_OR = 208 * MiB, WS_OV = 225 * MiB;
constexpr size_t WS_ACT = 66 * MiB, WS_HB = 202 * MiB, WS_SLAB = 238 * MiB, WS_END = 256 * MiB;
static_assert(WS_ZS + (size_t)MT * SHIFTW * 2 <= WS_R && WS_ZR + (size_t)MT * ZRW * 2 <= WS_KBP && WS_KBS + (size_t)NB_S * LS * 256 * 2 <= WS_VTS && WS_VTS + (size_t)NB_S * 256 * LS * 2 <= WS_KIS &&
              WS_KIS + (size_t)NB_S * LS * 64 * 2 <= WS_END && WS_OV + (size_t)MT * 512 * 2 <= WS_END && WS_ACT + (size_t)MT * DFF * 2 <= WS_HB && WS_HB + (size_t)MT * DM * 2 <= WS_END, "d_ws map");
constexpr size_t SC_Q = 0, SC_QI = (size_t)MT * 512 / 2, SC_Y = 0, SC_G = (size_t)MT * 512;
constexpr int CW_QATT = 64, CW_SS = 16384;

typedef unsigned short bf16;
typedef short bf16x8 __attribute__((ext_vector_type(8)));
typedef float f32x4 __attribute__((ext_vector_type(4)));
typedef float f32x16 __attribute__((ext_vector_type(16)));
typedef unsigned u32x4 __attribute__((ext_vector_type(4)));
typedef unsigned u32x2 __attribute__((ext_vector_type(2)));

__device__ __forceinline__ unsigned f2bf(float f) { unsigned u = __float_as_uint(f); return (u + 0x7fffu + ((u >> 16) & 1u)) >> 16; }
__device__ __forceinline__ unsigned pk2(float lo, float hi) { return f2bf(lo) | (f2bf(hi) << 16); }
__device__ __forceinline__ float bflo(unsigned w) { return __uint_as_float(w << 16); }
__device__ __forceinline__ float bfhi(unsigned w) { return __uint_as_float(w & 0xffff0000u); }
__device__ __forceinline__ float bf1(bf16 b) { return __uint_as_float((unsigned)b << 16); }
__device__ __forceinline__ void unpack8(const u32x4 w, float* x) { x[0] = bflo(w.x); x[1] = bfhi(w.x); x[2] = bflo(w.y); x[3] = bfhi(w.y); x[4] = bflo(w.z); x[5] = bfhi(w.z); x[6] = bflo(w.w); x[7] = bfhi(w.w); }
__device__ __forceinline__ u32x4 pack8(const float* x) { u32x4 w; w.x = pk2(x[0], x[1]); w.y = pk2(x[2], x[3]); w.z = pk2(x[4], x[5]); w.w = pk2(x[6], x[7]); return w; }
__device__ __forceinline__ float wave_sum(float v) {
#pragma unroll
    for (int o = 1; o < 64; o <<= 1) v += __shfl_xor(v, o);
    return v;
}
template <int CTRL> __device__ __forceinline__ float dppmov(float x) { return __builtin_bit_cast(float, __builtin_amdgcn_update_dpp(0, __builtin_bit_cast(int, x), CTRL, 0xf, 0xf, true)); }
__device__ __forceinline__ float sum16(float x) {
    x += dppmov<0xB1>(x); x += dppmov<0x4E>(x); x += dppmov<0x141>(x); x += dppmov<0x140>(x); return x;
}
__device__ __forceinline__ int crow(int r, int hi) { return (r & 3) + 8 * (r >> 2) + 4 * hi; }

struct Args { const float* in[28]; float* out; unsigned char* ws; int ph_lo, ph_hi; };

__device__ __forceinline__ void tr_item(const float* W, int K, int N, const float* gain, bf16* WT, int jr0, int c0, int nvalid, int k0, float* scr, int lane) {
#pragma unroll 8
    for (int i = 0; i < 32; ++i) { const int kk = 2 * i + (lane >> 5), n = lane & 31;
        float v = (n < nvalid) ? W[(size_t)(k0 + kk) * N + c0 + n] : 0.f; if (gain) v *= gain[k0 + kk]; scr[kk * 33 + n] = v; }
    __builtin_amdgcn_s_waitcnt(0xC07F); asm volatile("" ::: "memory");
    const int c = lane & 7;
#pragma unroll
    for (int j = 0; j < 4; ++j) { const int n = (lane >> 3) + 8 * j; const float* s = scr + (8 * c) * 33 + n;
        u32x4 o; o.x = pk2(s[0 * 33], s[1 * 33]); o.y = pk2(s[2 * 33], s[3 * 33]); o.z = pk2(s[4 * 33], s[5 * 33]); o.w = pk2(s[6 * 33], s[7 * 33]);
        *(u32x4*)(WT + (size_t)(jr0 + n) * K + k0 + 8 * c) = o; }
    __builtin_amdgcn_s_waitcnt(0xC07F); asm volatile("" ::: "memory");
}
__device__ __forceinline__ void p0_prologue(const Args& a, unsigned char* lds, int tid) {
    const int lane = tid & 63, wave = tid >> 6, gw = blockIdx.x * 8 + wave, NGW = gridDim.x * 8;
    float* scr = (float*)(lds + wave * 17408);
    unsigned char* ws = a.ws;
    constexpr int I_IN = (NZ / 32) * (DM / 64), I_OUT = (DM / 32) * (DM / 64), I_F1 = (DFF / 32) * (DM / 64), I_F2 = (DM / 32) * (DFF / 64);
    for (int it = gw; it < I_IN + I_OUT + I_F1 + I_F2; it += NGW) {
        int r = it;
        if (r < I_IN) { const int jb = r % (NZ / 32), kb = r / (NZ / 32), j0 = jb * 32; int c0, nv;
            if (j0 < 1600) { c0 = j0; nv = 32; } else if (j0 < 3296) { c0 = 1608 + (j0 - 1600); nv = 32; } else { c0 = 1600; nv = 8; }
            tr_item(a.in[8], DM, 3304, a.in[7], (bf16*)(ws + WS_WIN), j0, c0, nv, kb * 64, scr, lane); continue; }
        r -= I_IN;
        if (r < I_OUT) { const int jb = r % (DM / 32), kb = r / (DM / 32); tr_item(a.in[24], DM, DM, nullptr, (bf16*)(ws + WS_WOUT), jb * 32, jb * 32, 32, kb * 64, scr, lane); continue; }
        r -= I_OUT;
        if (r < I_F1) { const int jb = r % (DFF / 32), kb = r / (DFF / 32); tr_item(a.in[26], DM, DFF, a.in[25], (bf16*)(ws + WS_W1), jb * 32, jb * 32, 32, kb * 64, scr, lane); continue; }
        r -= I_F1;
        { const int jb = r % (DM / 32), kb = r / (DM / 32); tr_item(a.in[27], DFF, DM, nullptr, (bf16*)(ws + WS_W2), jb * 32, jb * 32, 32, kb * 64, scr, lane); }
    }
    { const int gt = blockIdx.x * 512 + tid, NT = gridDim.x * 512;
      bf16* w2t = (bf16*)(ws + WS_W2T); bf16* a2t = (bf16*)(ws + WS_A2T); bf16* g2t = (bf16*)(ws + WS_G2T);
      for (int i = gt; i < 512 * 32; i += NT) { const int n = i >> 5, k = i & 31; w2t[i] = (bf16)f2bf(a.in[15][k * 512 + n]); a2t[i] = (bf16)f2bf(a.in[17][k * 512 + n]); }
      for (int i = gt; i < 512 * 96; i += NT) { const int n = i / 96, k = i % 96; g2t[i] = (bf16)f2bf(a.in[18][k * 512 + n]); } }
    { f32x4 v[4], nx[4]; int m = gw;
      if (m < MT) { const f32x4* xr = (const f32x4*)((m < MP) ? a.in[0] + (size_t)m * DM : a.in[1] + (size_t)(m - MP) * DM) + lane;
#pragma unroll
          for (int j = 0; j < 4; ++j) v[j] = xr[64 * j]; }
      for (; m < MT; m += NGW) {
        const int mn = m + NGW;
        if (mn < MT) { const f32x4* xr = (const f32x4*)((mn < MP) ? a.in[0] + (size_t)mn * DM : a.in[1] + (size_t)(mn - MP) * DM) + lane;
#pragma unroll
            for (int j = 0; j < 4; ++j) nx[j] = xr[64 * j]; }
        float s = 0.f;
#pragma unroll
        for (int j = 0; j < 4; ++j) s += (v[j].x * v[j].x + v[j].y * v[j].y) + (v[j].z * v[j].z + v[j].w * v[j].w);
        const float rs = rsqrtf(wave_sum(s) * (1.f / DM) + 1e-6f);
        u32x2* o8 = (u32x2*)((bf16*)(ws + WS_XB) + (size_t)m * DM) + lane;
#pragma unroll
        for (int j = 0; j < 4; ++j) { u32x2 o; o.x = pk2(v[j].x * rs, v[j].y * rs); o.y = pk2(v[j].z * rs, v[j].w * rs); o8[64 * j] = o; }
#pragma unroll
        for (int j = 0; j < 4; ++j) v[j] = nx[j];
      } }
    for (int r4 = gw; r4 < NB_S * PAST / 4; r4 += NGW) {
        f32x4 v[4];
#pragma unroll
        for (int j = 0; j < 4; ++j) v[j] = ((const f32x4*)(a.in[2] + (size_t)(4 * r4 + j) * 256))[lane];
#pragma unroll
        for (int j = 0; j < 4; ++j) { const int rix = 4 * r4 + j, b = rix >> 10, p = rix & 1023; u32x2 o; o.x = pk2(v[j].x, v[j].y); o.y = pk2(v[j].z, v[j].w);
            ((u32x2*)((bf16*)(ws + WS_KBS) + ((size_t)b * LS + p) * 256))[lane] = o; }
    }
    for (int r4 = gw; r4 < NB_S * PAST / 4; r4 += NGW) {
        const int rix = r4 * 4 + (lane >> 4), b = rix >> 10, p = rix & 1023; const f32x4 v = ((const f32x4*)(a.in[4] + (size_t)rix * 64))[lane & 15];
        u32x2 o; o.x = pk2(v.x, v.y); o.y = pk2(v.z, v.w); ((u32x2*)((bf16*)(ws + WS_KIS) + ((size_t)b * LS + p) * 64))[lane & 15] = o;
    }
    for (int it = gw; it < NB_S * 4 * 16; it += NGW) {
        const int kb = it & 15, g = (it >> 4) & 3, b = it >> 6;
        const float* src = a.in[3] + ((size_t)b * PAST + kb * 64) * 256 + g * 64;
#pragma unroll 8
        for (int i = 0; i < 64; ++i) scr[i * 65 + lane] = src[(size_t)i * 256 + lane];
        __builtin_amdgcn_s_waitcnt(0xC07F); asm volatile("" ::: "memory");
        bf16* dst = (bf16*)(ws + WS_VTS) + ((size_t)(b * 4 + g) * 64) * LS + kb * 64 + lane;
#pragma unroll 8
        for (int d = 0; d < 64; ++d) dst[(size_t)d * LS] = (bf16)f2bf(scr[lane * 65 + d]);
        __builtin_amdgcn_s_waitcnt(0xC07F); asm volatile("" ::: "memory");
    }
}

__device__ __forceinline__ void p2_post(const Args& a, unsigned char* lds, int tid) {
    unsigned char* ws = a.ws; float* out = a.out;
    const bf16* ZR = (const bf16*)(ws + WS_ZR); const bf16* ZS = (const bf16*)(ws + WS_ZS);
    bf16* Q = (bf16*)(out + SC_Q); bf16* QI = (bf16*)(out + SC_QI);
    float* cs = (float*)lds;
    bf16* vt = (bf16*)(lds + 4096);
    const int g8 = tid >> 3, sub = tid & 7;
    const float* qg = a.in[9]; const float* kg = a.in[10]; const float* lng = a.in[11]; const float* lnb = a.in[12];
    for (int unit = blockIdx.x; unit < 2 * (MT / 64); unit += gridDim.x) {
        const int tile = unit >> 1, part = unit & 1, hb0 = part ? 12 : 0, hb1 = part ? 25 : 12;
        const int m0 = tile * 64;
        { const int m = m0 + g8, pos = (m < MP) ? (m & (T_P - 1)) : (PAST + ((m - MP) & (T_S - 1)));
          const float inv = powf(500000.0f, -(float)sub * 0.125f); const float ang = (float)pos * inv; float s, c; sincosf(ang, &s, &c);
          cs[g8 * 16 + sub] = c; cs[g8 * 16 + 8 + sub] = s; }
        __syncthreads();
        const int m = m0 + g8;
        const bool isp = m < MP; const int ms = m - MP;
        float cc[8], ss[8];
#pragma unroll
        for (int j = 0; j < 8; ++j) { cc[j] = cs[g8 * 16 + j]; ss[j] = cs[g8 * 16 + 8 + j]; }
        const size_t kvrow = isp ? (size_t)m : ((size_t)(ms >> 5) * LS + PAST + (ms & 31));
        bf16* KB = (bf16*)(ws + (isp ? WS_KBP : WS_KBS)); bf16* KIb = (bf16*)(ws + (isp ? WS_KIP : WS_KIS));
        u32x4 xnext = *(const u32x4*)(ZR + (size_t)m * ZRW + hb0 * 64 + 8 * sub);
        for (int hb = hb0; hb < hb1; ++hb) {
            float x[8]; unpack8(xnext, x);
            if (hb + 1 < hb1) xnext = *(const u32x4*)(ZR + (size_t)m * ZRW + (hb + 1) * 64 + 8 * sub);
            if (hb < 12) {
                float s2 = 0.f;
#pragma unroll
                for (int j = 0; j < 8; ++j) s2 += x[j] * x[j];
                s2 += __shfl_xor(s2, 1); s2 += __shfl_xor(s2, 2); s2 += __shfl_xor(s2, 4);
                const float rinv = rsqrtf(s2 * (1.f / 64.f) + 1e-6f); const float* gn = (hb < 8 ? qg : kg) + 8 * sub;
                float y[8], o[8];
#pragma unroll
                for (int j = 0; j < 8; ++j) y[j] = x[j] * rinv * gn[j];
#pragma unroll
                for (int j = 0; j < 8; ++j) { const float p = __shfl_xor(y[j], 1); o[j] = sub == 0 ? y[j] * cc[j] - p * ss[j] : (sub == 1 ? y[j] * cc[j] + p * ss[j] : y[j]); }
                if (hb < 8) {
#pragma unroll
                    for (int j = 0; j < 8; ++j) o[j] *= QSCALE;
                    *(u32x4*)(Q + (size_t)m * 512 + hb * 64 + 8 * sub) = pack8(o);
                } else { const int g = hb - 8;
                    float* ko = out + (isp ? OFF_KP + (size_t)m * 256 : OFF_KS + (size_t)ms * 256) + g * 64 + 8 * sub;
                    *(f32x4*)ko = (f32x4){o[0], o[1], o[2], o[3]}; *(f32x4*)(ko + 4) = (f32x4){o[4], o[5], o[6], o[7]};
                    *(u32x4*)(KB + kvrow * 256 + g * 64 + 8 * sub) = pack8(o); }
            } else if (hb < 16) { const int g = hb - 12;
                float* vo = out + (isp ? OFF_VP + (size_t)m * 256 : OFF_VS + (size_t)ms * 256) + g * 64 + 8 * sub;
                *(f32x4*)vo = (f32x4){x[0], x[1], x[2], x[3]}; *(f32x4*)(vo + 4) = (f32x4){x[4], x[5], x[6], x[7]};
                unsigned* vd = (unsigned*)(vt + g8 * 258 + g * 64 + 8 * sub);
                vd[0] = pk2(x[0], x[1]); vd[1] = pk2(x[2], x[3]); vd[2] = pk2(x[4], x[5]); vd[3] = pk2(x[6], x[7]);
            } else if (hb < 24) {
                float o[8];
#pragma unroll
                for (int j = 0; j < 8; ++j) { const float p = __shfl_xor(x[j], 1); o[j] = sub == 0 ? x[j] * cc[j] - p * ss[j] : (sub == 1 ? x[j] * cc[j] + p * ss[j] : x[j]); }
                *(u32x4*)(QI + (size_t)m * 512 + (hb - 16) * 64 + 8 * sub) = pack8(o);
            } else {
                float s1 = 0.f;
#pragma unroll
                for (int j = 0; j < 8; ++j) s1 += x[j];
                s1 += __shfl_xor(s1, 1); s1 += __shfl_xor(s1, 2); s1 += __shfl_xor(s1, 4);
                const float mu = s1 * (1.f / 64.f); float s2 = 0.f;
#pragma unroll
                for (int j = 0; j < 8; ++j) { const float d = x[j] - mu; s2 += d * d; }
                s2 += __shfl_xor(s2, 1); s2 += __shfl_xor(s2, 2); s2 += __shfl_xor(s2, 4);
                const float rinv = rsqrtf(s2 * (1.f / 64.f) + 1e-6f); float y[8], o[8];
#pragma unroll
                for (int j = 0; j < 8; ++j) y[j] = (x[j] - mu) * rinv * lng[8 * sub + j] + lnb[8 * sub + j];
#pragma unroll
                for (int j = 0; j < 8; ++j) { const float p = __shfl_xor(y[j], 1); o[j] = sub == 0 ? y[j] * cc[j] - p * ss[j] : (sub == 1 ? y[j] * cc[j] + p * ss[j] : y[j]); }
                float* ko = out + (isp ? OFF_KIP + (size_t)m * 64 : OFF_KIS + (size_t)ms * 64) + 8 * sub;
                *(f32x4*)ko = (f32x4){o[0], o[1], o[2], o[3]}; *(f32x4*)(ko + 4) = (f32x4){o[4], o[5], o[6], o[7]};
                *(u32x4*)(KIb + kvrow * 64 + 8 * sub) = pack8(o);
            }
        }
        if (part == 0) ((float*)(ws + WS_WI))[(size_t)m * 8 + sub] = bf1(ZR[(size_t)m * ZRW + 1600 + sub]) * WISCALE;
        __syncthreads();
        if (part == 1) { const int r = tid >> 1, half = tid & 1; unsigned wv[16];
#pragma unroll
          for (int j = 0; j < 16; ++j) wv[j] = (unsigned)vt[(32 * half + 2 * j) * 258 + r] | ((unsigned)vt[(32 * half + 2 * j + 1) * 258 + r] << 16);
          bf16* dst;
          if (m0 < MP) dst = (bf16*)(ws + WS_VTP) + ((size_t)(m0 >> 11) * 256 + r) * T_P + (m0 & (T_P - 1)) + 32 * half;
          else { const int b = ((m0 - MP) >> 5) + half; dst = (bf16*)(ws + WS_VTS) + ((size_t)b * 256 + r) * LS + PAST; }
#pragma unroll
          for (int j = 0; j < 4; ++j) ((u32x4*)dst)[j] = (u32x4){wv[4 * j], wv[4 * j + 1], wv[4 * j + 2], wv[4 * j + 3]}; }
        if (part == 0) {} else if (m0 < MP) { if ((m0 & (T_P - 1)) == T_P - 64) { const int b = m0 >> 11; const bf16* zr = ZS + (size_t)(m0 + 63) * SHIFTW;
                for (int c = tid; c < SHIFTW; c += 512) out[OFF_SHP + (size_t)b * SHIFTW + c] = bf1(zr[c]); } }
        else { for (int h2 = 0; h2 < 2; ++h2) { const int b = ((m0 - MP) >> 5) + h2; const bf16* zr = ZS + (size_t)(m0 + 32 * h2 + 31) * SHIFTW;
                for (int c = tid; c < SHIFTW; c += 512) out[OFF_SHS + (size_t)b * SHIFTW + c] = bf1(zr[c]); } }
        __syncthreads();
    }
}

constexpr int ATT_UNITS = 544;
constexpr int MASK_PITCH = 65;
#define MFMA32(a, b, c) __builtin_amdgcn_mfma_f32_32x32x16_bf16((a), (b), (c), 0, 0, 0)

__device__ __forceinline__ float half_sum32(float v) { v += __shfl_xor(v, 1); v += __shfl_xor(v, 2); v += __shfl_xor(v, 4); v += __shfl_xor(v, 8); v += __shfl_xor(v, 16); return v; }
__device__ __forceinline__ float half_min32(float v) { v = fminf(v, __shfl_xor(v, 1)); v = fminf(v, __shfl_xor(v, 2)); v = fminf(v, __shfl_xor(v, 4)); v = fminf(v, __shfl_xor(v, 8)); v = fminf(v, __shfl_xor(v, 16)); return v; }
__device__ __forceinline__ float half_max32(float v) { v = fmaxf(v, __shfl_xor(v, 1)); v = fmaxf(v, __shfl_xor(v, 2)); v = fmaxf(v, __shfl_xor(v, 4)); v = fmaxf(v, __shfl_xor(v, 8)); v = fmaxf(v, __shfl_xor(v, 16)); return v; }
__device__ __forceinline__ int half_sum32i(int v) { v += __shfl_xor(v, 1); v += __shfl_xor(v, 2); v += __shfl_xor(v, 4); v += __shfl_xor(v, 8); v += __shfl_xor(v, 16); return v; }

#define LAS3 __attribute__((address_space(3)))
constexpr int A_RING1 = 0, A_SCL = 24576, A_RING2 = 24576, A_MASK = 0, A_LSUM = 8320, A_UNIT = 9344;
__device__ __forceinline__ void p3_attention(const Args& a, unsigned char* lds, int tid, int rep) {
    unsigned char* ws = a.ws; float* out = a.out;
    const bf16* Q = (const bf16*)(out + SC_Q); const bf16* QI = (const bf16*)(out + SC_QI); const float* WI = (const float*)(ws + WS_WI);
    bf16* O = (bf16*)(ws + WS_XB);
    unsigned* maskw = (unsigned*)(lds + A_MASK);
    float* lsum = (float*)(lds + A_LSUM);
    int* s_unit = (int*)(lds + A_UNIT);
    typedef float f32x2_t __attribute__((ext_vector_type(2)));
    f32x2_t* scl = (f32x2_t*)(lds + A_SCL) + (size_t)(tid >> 6) * 2048 + (tid & 63);
    unsigned* qctr = (unsigned*)(ws + WS_CTL) + CW_QATT + 64 * rep;
    const int l = tid & 63, w = __builtin_amdgcn_readfirstlane(tid >> 6), rho = l & 31, hi = l >> 5;
    LAS3 unsigned char* ldsb = (LAS3 unsigned char*)lds;
    for (;;) {
        if (tid == 0) *s_unit = (int)atomicAdd(qctr, 1u);
        __syncthreads();
        const int p = *s_unit;
        __syncthreads();
        if (p >= ATT_UNITS) break;
        int m0, nkt, vpitch; const bf16 *KB, *VT, *KI; bool need_idx;
        { int c = -1, b, half = 0;
          if (p < 256) { c = 31 - (p >> 4); b = (p & 15) >> 1; half = p & 1; }
          else if (p < 288) { b = p - 256; }
          else { const int pp = p - 288; c = 15 - (pp >> 4); b = (pp & 15) >> 1; half = pp & 1; }
          if (c >= 0) { m0 = b * T_P + 64 * c + 32 * half; nkt = 2 * (c + 1); vpitch = T_P; need_idx = c >= 4;
              KB = (const bf16*)(ws + WS_KBP) + (size_t)b * T_P * 256; VT = (const bf16*)(ws + WS_VTP) + (size_t)b * 256 * T_P; KI = (const bf16*)(ws + WS_KIP) + (size_t)b * T_P * 64; }
          else { m0 = MP + 32 * b; nkt = LS / 32; vpitch = LS; need_idx = true;
              KB = (const bf16*)(ws + WS_KBS) + (size_t)b * LS * 256; VT = (const bf16*)(ws + WS_VTS) + (size_t)b * 256 * LS; KI = (const bf16*)(ws + WS_KIS) + (size_t)b * LS * 64; } }
        if (need_idx) {
            const int tokA = 4 * w + 2 * ((rho >> 2) & 1) + (rho >> 4), headA = (rho & 3) + 4 * ((rho >> 3) & 1);
            bf16x8 qa[4];
#pragma unroll
            for (int ks = 0; ks < 4; ++ks) qa[ks] = *(const bf16x8*)(QI + (size_t)(m0 + tokA) * 512 + headA * 64 + 16 * ks + 8 * hi);
            float wv[16];
#pragma unroll
            for (int r = 0; r < 16; ++r) wv[r] = WI[(size_t)(m0 + 4 * w + 2 * hi + (r >> 3)) * 8 + (r & 7)];
            asm volatile("" :: "v"(qa[0]), "v"(qa[1]), "v"(qa[2]), "v"(qa[3]));
#pragma unroll
            for (int r = 0; r < 16; ++r) asm volatile("" :: "v"(wv[r]));
            asm volatile("s_waitcnt vmcnt(0)" ::: "memory");
            float sc0[32], sc1[32];
            const int nb = (nkt + 1) >> 1;
            const int sr = 8 * w + (l >> 3), scn = (l & 7) ^ ((sr >> 1) & 7);
            const unsigned char* ksrc = (const unsigned char*)KI + (size_t)sr * 128 + 16 * scn;
#define KI_STAGE(it_) __builtin_amdgcn_global_load_lds((const unsigned*)(ksrc + (size_t)(it_) * 8192), (LAS3 unsigned*)(ldsb + A_RING1 + ((it_) % 3) * 8192 + w * 1024), 16, 0, 0)
            for (int rp1 = 0; rp1 <= PROBE_A1; ++rp1) {
            if (rp1) __syncthreads();
            KI_STAGE(0); if (1 < nb) KI_STAGE(1);
#pragma unroll
            for (int it = 0; it < 32; ++it) {
                if (it < nb) {
                    if (it + 1 < nb) asm volatile("s_waitcnt vmcnt(1) lgkmcnt(0)\n\ts_barrier" ::: "memory"); else asm volatile("s_waitcnt vmcnt(0) lgkmcnt(0)\n\ts_barrier" ::: "memory");
                    if (it + 2 < nb) KI_STAGE(it + 2);
                    const unsigned char* tb = lds + A_RING1 + (it % 3) * 8192;
#pragma unroll
                    for (int k2 = 0; k2 < 2; ++k2) { const int kt = 2 * it + k2;
                        if (kt < nkt) {
                            const int r = 32 * k2 + rho; const unsigned char* rowp = tb + r * 128; const int sw = (r >> 1) & 7;
                            f32x16 acc = {0.f, 0.f, 0.f, 0.f, 0.f, 0.f, 0.f, 0.f, 0.f, 0.f, 0.f, 0.f, 0.f, 0.f, 0.f, 0.f};
#pragma unroll
                            for (int ks = 0; ks < 4; ++ks) acc = MFMA32(qa[ks], *(const bf16x8*)(rowp + 16 * ((2 * ks + hi) ^ sw)), acc);
                            float s0 = 0.f, s1 = 0.f;
#pragma unroll
                            for (int r2 = 0; r2 < 8; ++r2) { s0 += wv[r2] * fmaxf(acc[r2], 0.f); s1 += wv[8 + r2] * fmaxf(acc[8 + r2], 0.f); }
                            if (kt < 32) { sc0[kt & 31] = s0; sc1[kt & 31] = s1; } else scl[(kt - 32) * 64] = (f32x2_t){s0, s1};
                        } else if (kt < 32) { sc0[kt & 31] = -3.0e38f; sc1[kt & 31] = -3.0e38f; }
                    }
                } else { if (2 * it < 32) { sc0[(2 * it) & 31] = -3.0e38f; sc1[(2 * it) & 31] = -3.0e38f; sc0[(2 * it + 1) & 31] = -3.0e38f; sc1[(2 * it + 1) & 31] = -3.0e38f; } }
            }
            }
#undef KI_STAGE
            __syncthreads();
            float mn0 = 3.0e38f, mx0 = -3.0e38f, mn1 = 3.0e38f, mx1 = -3.0e38f; int cp0 = 0, cz0 = 0, cp1 = 0, cz1 = 0;
#pragma unroll
            for (int kt = 0; kt < 64; ++kt) if (kt < nkt) { float v0, v1; if (kt < 32) { v0 = sc0[kt & 31]; v1 = sc1[kt & 31]; } else { const f32x2_t t2 = scl[(kt - 32) * 64]; v0 = t2.x; v1 = t2.y; }
                mn0 = fminf(mn0, v0); mx0 = fmaxf(mx0, v0); mn1 = fminf(mn1, v1); mx1 = fmaxf(mx1, v1);
                cp0 += v0 > 0.f ? 1 : 0; cz0 += v0 == 0.f ? 1 : 0; cp1 += v1 > 0.f ? 1 : 0; cz1 += v1 == 0.f ? 1 : 0; }
            mn0 = half_min32(mn0); mx0 = half_max32(mx0); mn1 = half_min32(mn1); mx1 = half_max32(mx1);
            cp0 = half_sum32i(cp0); cz0 = half_sum32i(cz0); cp1 = half_sum32i(cp1); cz1 = half_sum32i(cz1);
            float lo0, hi0, lo1, hi1, thr0 = 0.f, thr1 = 0.f; int ch0, ch1, nt0 = 0, nt1 = 0; bool fin0, fin1;
            for (int rp2 = 0; rp2 <= PROBE_A2; ++rp2) {
            fin0 = false; fin1 = false; ch0 = 0; ch1 = 0;
            if (cp0 >= 256) { lo0 = 0.f; hi0 = mx0; if (cp0 == 256) { fin0 = true; thr0 = 0.f; nt0 = 0; } }
            else if (cp0 + cz0 >= 256) { lo0 = 0.f; hi0 = 0.f; fin0 = true; thr0 = 0.f; nt0 = 256 - cp0; }
            else { lo0 = mn0 - 1.0f; hi0 = 0.f; ch0 = cp0; }
            if (cp1 >= 256) { lo1 = 0.f; hi1 = mx1; if (cp1 == 256) { fin1 = true; thr1 = 0.f; nt1 = 0; } }
            else if (cp1 + cz1 >= 256) { lo1 = 0.f; hi1 = 0.f; fin1 = true; thr1 = 0.f; nt1 = 256 - cp1; }
            else { lo1 = mn1 - 1.0f; hi1 = 0.f; ch1 = cp1; }
            asm volatile("" : "+v"(lo0), "+v"(lo1));
            for (int iter = 0; iter < 64; ++iter) {
                const float mid0 = lo0 + 0.5f * (hi0 - lo0), mid1 = lo1 + 0.5f * (hi1 - lo1);
                int c0 = 0, c1 = 0;
#pragma unroll
                for (int g = 0; g < 4; ++g) if (8 * g < nkt) {
#pragma unroll
                    for (int k8 = 0; k8 < 8; ++k8) { c0 += sc0[8 * g + k8] > mid0 ? 1 : 0; c1 += sc1[8 * g + k8] > mid1 ? 1 : 0; } }
                for (int kt = 32; kt < nkt; kt += 8) {
                    f32x2_t t8[8];
#pragma unroll
                    for (int u = 0; u < 8; ++u) t8[u] = scl[(kt + u - 32) * 64];
#pragma unroll
                    for (int u = 0; u < 8; ++u) if (kt + u < nkt) { c0 += t8[u].x > mid0 ? 1 : 0; c1 += t8[u].y > mid1 ? 1 : 0; } }
                c0 = half_sum32i(c0); c1 = half_sum32i(c1);
                if (!fin0) { if (!(mid0 > lo0 && mid0 < hi0)) { fin0 = true; thr0 = hi0; nt0 = 256 - ch0; }
                             else if (c0 == 256) { fin0 = true; thr0 = mid0; nt0 = 0; } else if (c0 > 256) lo0 = mid0; else { hi0 = mid0; ch0 = c0; } }
                if (!fin1) { if (!(mid1 > lo1 && mid1 < hi1)) { fin1 = true; thr1 = hi1; nt1 = 256 - ch1; }
                             else if (c1 == 256) { fin1 = true; thr1 = mid1; nt1 = 0; } else if (c1 > 256) lo1 = mid1; else { hi1 = mid1; ch1 = c1; } }
                if (__all(fin0 && fin1)) break;
            }
            }
            const bool any_tie = __any(nt0 > 0 || nt1 > 0);
            int run0 = 0, run1 = 0; const unsigned below = (1u << rho) - 1u;
#pragma unroll
            for (int kt = 0; kt < 64; ++kt) if (kt < nkt) {
                float v0, v1; if (kt < 32) { v0 = sc0[kt & 31]; v1 = sc1[kt & 31]; } else { const f32x2_t t2 = scl[(kt - 32) * 64]; v0 = t2.x; v1 = t2.y; }
                bool p0 = v0 > thr0, p1 = v1 > thr1;
                if (any_tie) {
                    const bool e0 = nt0 > 0 && v0 == thr0, e1 = nt1 > 0 && v1 == thr1;
                    const unsigned long long be0 = __ballot(e0), be1 = __ballot(e1);
                    const unsigned h0 = (unsigned)(be0 >> (32 * hi)), h1 = (unsigned)(be1 >> (32 * hi));
                    p0 = p0 || (e0 && (run0 + __popc(h0 & below)) < nt0); p1 = p1 || (e1 && (run1 + __popc(h1 & below)) < nt1);
                    run0 += __popc(h0); run1 += __popc(h1);
                }
                const unsigned long long b0 = __ballot(p0), b1 = __ballot(p1);
                if (l == 0) { maskw[(4 * w + 0) * MASK_PITCH + kt] = (unsigned)b0; maskw[(4 * w + 1) * MASK_PITCH + kt] = (unsigned)b1; }
                if (l == 32) { maskw[(4 * w + 2) * MASK_PITCH + kt] = (unsigned)(b0 >> 32); maskw[(4 * w + 3) * MASK_PITCH + kt] = (unsigned)(b1 >> 32); }
            }
        }
        __syncthreads();
        {
            const int g = w >> 1;
            bf16x8 qb[4];
#pragma unroll
            for (int ks = 0; ks < 4; ++ks) qb[ks] = *(const bf16x8*)(Q + (size_t)(m0 + rho) * 512 + w * 64 + 16 * ks + 8 * hi);
            asm volatile("" :: "v"(qb[0]), "v"(qb[1]), "v"(qb[2]), "v"(qb[3]));
            asm volatile("s_waitcnt vmcnt(0)" ::: "memory");
            const unsigned char* ksrc[2]; const unsigned char* vsrc[2];
#pragma unroll
            for (int k = 0; k < 2; ++k) { const int i = (k * 8 + w) * 64 + l; const int r = i >> 5, c = i & 31; ksrc[k] = (const unsigned char*)KB + (size_t)r * 512 + 16 * (c ^ (r & 15));
                const int R = i >> 2, cv = i & 3; vsrc[k] = (const unsigned char*)VT + (size_t)R * vpitch * 2 + 16 * (cv ^ ((R >> 2) & 3)); }
#define KV_STAGE(t_) do { const int bo_ = A_RING2 + ((t_) % 3) * 32768 + w * 1024; \
            __builtin_amdgcn_global_load_lds((const unsigned*)(ksrc[0] + (size_t)(t_) * 16384), (LAS3 unsigned*)(ldsb + bo_), 16, 0, 0); \
            __builtin_amdgcn_global_load_lds((const unsigned*)(ksrc[1] + (size_t)(t_) * 16384), (LAS3 unsigned*)(ldsb + bo_ + 8192), 16, 0, 0); \
            __builtin_amdgcn_global_load_lds((const unsigned*)(vsrc[0] + (size_t)(t_) * 64), (LAS3 unsigned*)(ldsb + bo_ + 16384), 16, 0, 0); \
            __builtin_amdgcn_global_load_lds((const unsigned*)(vsrc[1] + (size_t)(t_) * 64), (LAS3 unsigned*)(ldsb + bo_ + 24576), 16, 0, 0); } while (0)
            f32x16 o0 = {0.f, 0.f, 0.f, 0.f, 0.f, 0.f, 0.f, 0.f, 0.f, 0.f, 0.f, 0.f, 0.f, 0.f, 0.f, 0.f}, o1 = o0; float psum = 0.f;
            const int ksw = rho & 15;
            const int vR0 = g * 64 + rho, vR1 = vR0 + 32; const int vs0 = (vR0 >> 2) & 3, vs1 = (vR1 >> 2) & 3;
            for (int rp3 = 0; rp3 <= PROBE_A3; ++rp3) {
            if (rp3) __syncthreads();
            KV_STAGE(0); if (1 < nkt) KV_STAGE(1);
            for (int kt = 0; kt < nkt; ++kt) {
                if (kt + 1 < nkt) asm volatile("s_waitcnt vmcnt(4) lgkmcnt(0)\n\ts_barrier" ::: "memory"); else asm volatile("s_waitcnt vmcnt(0) lgkmcnt(0)\n\ts_barrier" ::: "memory");
                if (kt + 2 < nkt) KV_STAGE(kt + 2);
                const unsigned char* kbuf = lds + A_RING2 + (kt % 3) * 32768; const unsigned char* vbuf = kbuf + 16384;
                f32x16 st = {0.f, 0.f, 0.f, 0.f, 0.f, 0.f, 0.f, 0.f, 0.f, 0.f, 0.f, 0.f, 0.f, 0.f, 0.f, 0.f};
#pragma unroll
                for (int ks = 0; ks < 4; ++ks) st = MFMA32(*(const bf16x8*)(kbuf + rho * 512 + 16 * ((g * 8 + 2 * ks + hi) ^ ksw)), qb[ks], st);
                unsigned word = need_idx ? maskw[rho * MASK_PITCH + kt] : 0xffffffffu; word >>= 4 * hi; float pr[16];
#pragma unroll
                for (int r = 0; r < 16; ++r) { const float e = __builtin_amdgcn_exp2f(st[r]); pr[r] = ((word >> ((r & 3) + 8 * (r >> 2))) & 1u) ? e : 0.f; psum += pr[r]; }
                union { u32x4 u; bf16x8 v; } pa0, pa1; pa0.u = (u32x4){pg8::cvt_pk_bf16(pr[0], pr[1]), pg8::cvt_pk_bf16(pr[2], pr[3]), pg8::cvt_pk_bf16(pr[4], pr[5]), pg8::cvt_pk_bf16(pr[6], pr[7])}; pa1.u = (u32x4){pg8::cvt_pk_bf16(pr[8], pr[9]), pg8::cvt_pk_bf16(pr[10], pr[11]), pg8::cvt_pk_bf16(pr[12], pr[13]), pg8::cvt_pk_bf16(pr[14], pr[15])};
                union { u32x4 u; bf16x8 v; } vf[2][2];
#pragma unroll
                for (int s2 = 0; s2 < 2; ++s2) { const unsigned char* r0 = vbuf + vR0 * 64 + 8 * hi; const unsigned char* r1 = vbuf + vR1 * 64 + 8 * hi;
                    const u32x2 a0 = *(const u32x2*)(r0 + 16 * ((2 * s2) ^ vs0)), a1 = *(const u32x2*)(r0 + 16 * ((2 * s2 + 1) ^ vs0)), b0 = *(const u32x2*)(r1 + 16 * ((2 * s2) ^ vs1)), b1 = *(const u32x2*)(r1 + 16 * ((2 * s2 + 1) ^ vs1));
                    vf[s2][0].u = (u32x4){a0.x, a0.y, a1.x, a1.y}; vf[s2][1].u = (u32x4){b0.x, b0.y, b1.x, b1.y}; }
                o0 = MFMA32(pa0.v, vf[0][0].v, o0); o0 = MFMA32(pa1.v, vf[1][0].v, o0); o1 = MFMA32(pa0.v, vf[0][1].v, o1); o1 = MFMA32(pa1.v, vf[1][1].v, o1);
            }
            }
#undef KV_STAGE
            psum += __shfl_xor(psum, 32);
            if (hi == 0) lsum[w * 32 + rho] = psum;
            __syncthreads();
#pragma unroll
            for (int r = 0; r < 16; ++r) { const int qr = crow(r, hi); const float inv = 1.0f / lsum[w * 32 + qr];
                bf16* op = O + (size_t)(m0 + qr) * DM + w * 64 + rho;
                op[0] = (bf16)f2bf(o0[r] * inv); op[32] = (bf16)f2bf(o1[r] * inv); }
        }
        __syncthreads();
    }
}

constexpr int XS_PITCH = 168;
constexpr int WP = 144;
constexpr int WSLOT = 64 * WP;
constexpr int W_NCH = T_P / 64;
constexpr int W_UNITS = NB_P * 8 * W_NCH + NB_S * 8;
constexpr size_t WS_PM = WS_R, WS_QM = WS_R + 18 * MiB, WS_UM = WS_R + 36 * MiB, WS_Y0 = WS_R + 72 * MiB;
static_assert((size_t)W_UNITS * 8192 <= 18 * MiB && (size_t)W_UNITS * 16384 <= 36 * MiB && WS_Y0 + 36 * MiB <= WS_END, "rwkv chunk summaries fit the reusable region");
constexpr size_t SC_G2 = 0, SC_VV = (size_t)MT * 256;
constexpr int ZTP = 720;
constexpr int LWP = 68;

__device__ __forceinline__ f32x16 wy_mm(const unsigned char* A, const unsigned char* B, int mi, int ni, int rho, int hi, f32x16 acc) {
    const unsigned char* ap = A + (32 * mi + rho) * WP + 16 * hi; const unsigned char* bp = B + (32 * ni + rho) * WP + 16 * hi;
#pragma unroll
    for (int ks = 0; ks < 4; ++ks) acc = MFMA32(*(const bf16x8*)(ap + 32 * ks), *(const bf16x8*)(bp + 32 * ks), acc);
    return acc;
}
typedef float wy_f32x2 __attribute__((ext_vector_type(2))); typedef __bf16 wy_bf16x2 __attribute__((ext_vector_type(2)));
__device__ __forceinline__ unsigned wy_cvt2(float lo, float hi) { const wy_f32x2 v = {lo, hi}; const wy_bf16x2 b = __builtin_convertvector(v, wy_bf16x2); return __builtin_bit_cast(unsigned, b); }
__device__ __forceinline__ void wy_st_t(unsigned char* dst, const f32x16& a, int mi, int ni, int rho, int hi) {
#pragma unroll
    for (int q = 0; q < 4; ++q) *(u32x2*)(dst + (32 * ni + rho) * WP + 2 * (32 * mi + 8 * q + 4 * hi)) = (u32x2){wy_cvt2(a[4 * q], a[4 * q + 1]), wy_cvt2(a[4 * q + 2], a[4 * q + 3])};
}
__device__ __forceinline__ void wy_st_n(unsigned char* dst, const f32x16& a, int mi, int ni, int rho, int hi) {
#pragma unroll
    for (int r = 0; r < 16; ++r) *(bf16*)(dst + (32 * mi + crow(r, hi)) * WP + 2 * (32 * ni + rho)) = (bf16)f2bf(a[r]);
}
__device__ __forceinline__ f32x16 wy_ld_t(const unsigned char* src, int mi, int ni, int rho, int hi) {
    f32x16 a;
#pragma unroll
    for (int q = 0; q < 4; ++q) { const u32x2 w = *(const u32x2*)(src + (32 * ni + rho) * WP + 2 * (32 * mi + 8 * q + 4 * hi)); a[4 * q] = bflo(w.x); a[4 * q + 1] = bfhi(w.x); a[4 * q + 2] = bflo(w.y); a[4 * q + 3] = bfhi(w.y); }
    return a;
}
#define F16Z ((f32x16){0.f, 0.f, 0.f, 0.f, 0.f, 0.f, 0.f, 0.f, 0.f, 0.f, 0.f, 0.f, 0.f, 0.f, 0.f, 0.f})

__device__ __forceinline__ void p4w_chunks(const Args& a, unsigned char* lds, int tid) {
    unsigned char* ws = a.ws; float* out = a.out;
    const bf16* ZS = (const bf16*)(ws + WS_ZS);
    const bf16* w2t = (const bf16*)(ws + WS_W2T); const bf16* a2t = (const bf16*)(ws + WS_A2T); const bf16* g2t = (const bf16*)(ws + WS_G2T);
    bf16* G = (bf16*)(out + SC_G2); bf16* VV = (bf16*)(out + SC_VV); float* BON = (float*)(ws + WS_BONUS);
    const float* mu = a.in[13]; const float* w0 = a.in[14]; const float* a0 = a.in[16]; const float* k_k = a.in[19]; const float* k_a = a.in[20]; const float* r_k = a.in[21]; const float* sh0 = a.in[6];
    const int l = tid & 63, w = __builtin_amdgcn_readfirstlane(tid >> 6), rho = l & 31, hi = l >> 5;
#define SL(i) (lds + (i) * WSLOT)
    unsigned char* zt = SL(0);
    bf16* xs = (bf16*)SL(6);
    float* LW = (float*)SL(9);
    float* LG = (float*)SL(11);
    float* NRM = (float*)(lds + 17 * WSLOT);
    float* PAR = NRM + 320;
    int* QMAX = (int*)(PAR + 672);
    for (int unit = blockIdx.x; unit < W_UNITS; unit += gridDim.x) {
        int m0, nvalid, h; bool first; const float* shp = nullptr;
        if (unit < NB_P * 8 * W_NCH) { const int j = unit & (W_NCH - 1), sh = unit >> 5; h = sh & 7; m0 = (sh >> 3) * T_P + 64 * j; nvalid = 64; first = j == 0; }
        else { const int sh = unit - NB_P * 8 * W_NCH; h = sh & 7; m0 = MP + 32 * (sh >> 3); nvalid = 32; first = true; shp = sh0 + (size_t)(sh >> 3) * SHIFTW; }
        const int ct = w & 1, tt = (w >> 1) & 1; const int n = 64 * h + 32 * ct + rho;
        bf16x8 fa[6];
        if (w < 4) {
#pragma unroll
            for (int ks = 0; ks < 2; ++ks) { fa[ks] = *(const bf16x8*)(w2t + n * 32 + 16 * ks + 8 * hi); fa[2 + ks] = *(const bf16x8*)(a2t + n * 32 + 16 * ks + 8 * hi); } }
        else {
#pragma unroll
            for (int ks = 0; ks < 6; ++ks) fa[ks] = *(const bf16x8*)(g2t + n * 96 + 16 * ks + 8 * hi); }
        if (tid < 8) QMAX[tid] = 0;
        for (int i = tid; i < 672; i += 512) { float v;
            if (i < 192) v = mu[(i >> 6) * 512 + 64 * h + (i & 63)]; else if (i < 352) v = mu[1536 + i - 192];
            else { const int k5 = i - 352, a5 = k5 >> 6; const float* src = a5 == 0 ? w0 : (a5 == 1 ? a0 : (a5 == 2 ? k_k : (a5 == 3 ? k_a : r_k))); v = src[64 * h + (k5 & 63)]; }
            PAR[i] = v; }
        for (int idx = tid; idx < 65 * 44; idx += 512) { const int r = idx / 44, p = idx - r * 44;
            const int col = p < 24 ? (p >> 3) * 512 + 64 * h + 8 * (p & 7) : 1536 + 8 * (p - 24);
            u32x4 v = {0u, 0u, 0u, 0u};
            if (r == 0) { if (!first) v = *(const u32x4*)(ZS + (size_t)(m0 - 1) * SHIFTW + col);
                          else if (shp) { const f32x4 a4 = *(const f32x4*)(shp + col), b4 = *(const f32x4*)(shp + col + 4); v = (u32x4){pk2(a4.x, a4.y), pk2(a4.z, a4.w), pk2(b4.x, b4.y), pk2(b4.z, b4.w)}; } }
            else if (r <= nvalid) v = *(const u32x4*)(ZS + (size_t)(m0 + r - 1) * SHIFTW + col);
            *(u32x4*)(zt + r * ZTP + 16 * p) = v; }
        LBAR();
        { const int tk = tid >> 3, c0 = (tid & 7) * 20; const bf16* zc = (const bf16*)(zt + (tk + 1) * ZTP + 384) + c0; const bf16* zp = (const bf16*)(zt + tk * ZTP + 384) + c0;
#pragma unroll
          for (int e = 0; e < 20; ++e) { const int c = c0 + e; const float cur = bf1(zc[e]), prev = bf1(zp[e]); const float zm = cur + PAR[192 + c] * (prev - cur);
              const float f = __frcp_rn(1.0f + __expf(c < 32 ? -2.0f * zm : -zm)); xs[tk * XS_PITCH + c] = (bf16)f2bf(c < 32 ? 2.0f * f - 1.0f : (c < 64 ? zm : f)); } }
        LBAR();
        const int tok = 32 * tt + rho; const bool valid = tok < nvalid; const size_t m = (size_t)m0 + tok;
        const bf16* xrow = xs + tok * XS_PITCH + 8 * hi; const int lofs = 32 * ct + 4 * hi;
        const int pofs = 64 * h + 32 * ct + 4 * hi;
        const unsigned char* zcur = zt + (tok + 1) * ZTP + 2 * (32 * ct + 4 * hi); const unsigned char* zprv = zt + tok * ZTP + 2 * (32 * ct + 4 * hi);
#define WMIX4(dst, seg, q) do { const u32x2 cw = *(const u32x2*)(zcur + 128 * (seg) + 16 * (q)), pw = *(const u32x2*)(zprv + 128 * (seg) + 16 * (q)); const f32x4 mu4 = *(const f32x4*)(PAR + 64 * (seg) + lofs + 8 * (q)); \
            dst[0] = bflo(cw.x) + mu4.x * (bflo(pw.x) - bflo(cw.x)); dst[1] = bfhi(cw.x) + mu4.y * (bfhi(pw.x) - bfhi(cw.x)); dst[2] = bflo(cw.y) + mu4.z * (bflo(pw.y) - bflo(cw.y)); dst[3] = bfhi(cw.y) + mu4.w * (bfhi(pw.y) - bfhi(cw.y)); } while (0)
        float ra[16], rb[16], rc[16], rd[16];
        if (w < 4) {
            f32x16 Dw = F16Z, Da = F16Z;
#pragma unroll
            for (int ks = 0; ks < 2; ++ks) { Dw = MFMA32(fa[ks], *(const bf16x8*)(xrow + 16 * ks), Dw); Da = MFMA32(fa[2 + ks], *(const bf16x8*)(xrow + 32 + 16 * ks), Da); }
            float n2 = 0.f, bon = 0.f;
#pragma unroll
            for (int q = 0; q < 4; ++q) { float zr[4], zk[4]; WMIX4(zr, 0, q); WMIX4(zk, 1, q);
                const f32x4 w04 = *(const f32x4*)(PAR + 352 + lofs + 8 * q), a04 = *(const f32x4*)(PAR + 416 + lofs + 8 * q), kk4 = *(const f32x4*)(PAR + 480 + lofs + 8 * q), ka4 = *(const f32x4*)(PAR + 544 + lofs + 8 * q), rk4 = *(const f32x4*)(PAR + 608 + lofs + 8 * q);
#pragma unroll
                for (int e = 0; e < 4; ++e) { const int r = 4 * q + e;
                    const float sg = __frcp_rn(1.0f + __expf(-(w04[e] + Dw[r]))); rd[r] = valid ? -0.6065306597126334f * sg : 0.f;
                    const float aa = __frcp_rn(1.0f + __expf(-(a04[e] + Da[r]))); rb[r] = aa;
                    const float kr = valid ? zk[e] * kk4[e] : 0.f; ra[r] = kr; n2 += kr * kr;
                    const float km = valid ? zk[e] * (1.0f + (aa - 1.0f) * ka4[e]) : 0.f; rc[r] = km; bon += zr[e] * km * rk4[e]; }
                *(f32x4*)(LW + tok * LWP + 32 * ct + 8 * q + 4 * hi) = (f32x4){rd[4 * q], rd[4 * q + 1], rd[4 * q + 2], rd[4 * q + 3]}; }
            n2 += __shfl_xor(n2, 32); bon += __shfl_xor(bon, 32);
            if (hi == 0) { NRM[ct * 64 + tok] = n2; NRM[128 + ct * 64 + tok] = bon; }
        } else {
            f32x16 Dg = F16Z;
#pragma unroll
            for (int ks = 0; ks < 6; ++ks) Dg = MFMA32(fa[ks], *(const bf16x8*)(xrow + 64 + 16 * ks), Dg);
#pragma unroll
            for (int q = 0; q < 4; ++q) { float zr[4], zv[4]; WMIX4(zr, 0, q); WMIX4(zv, 2, q);
#pragma unroll
                for (int e = 0; e < 4; ++e) { ra[4 * q + e] = valid ? zr[e] : 0.f; rb[4 * q + e] = valid ? zv[e] : 0.f; }
                if (valid) { const size_t o = m * 512 + pofs + 8 * q;
                    *(u32x2*)(G + o) = (u32x2){pk2(Dg[4 * q], Dg[4 * q + 1]), pk2(Dg[4 * q + 2], Dg[4 * q + 3])};
                    *(u32x2*)(VV + o) = (u32x2){pk2(zv[0], zv[1]), pk2(zv[2], zv[3])}; } }
        }
#undef WMIX4
        LBAR();
        if (w == 0) { float acc = 0.f; LG[l] = 0.f;
#pragma unroll 8
            for (int t = 0; t < 64; ++t) { acc += LW[t * LWP + l]; LG[(t + 1) * LWP + l] = acc; }
            NRM[256 + l] = __expf(acc); }
        if (w == 1 && l < 64) { const float bn = NRM[128 + l] + NRM[192 + l]; if (l < nvalid) BON[((size_t)m0 + l) * 8 + h] = bn; }
        LBAR();
        {
            const float* lgc = LG + (tok + 1) * LWP + 32 * ct + 4 * hi; const float* lgp = LG + tok * LWP + 32 * ct + 4 * hi; const float* lge = LG + 64 * LWP + 32 * ct + 4 * hi;
            if (w < 4) {
                const float invn = 1.0f / fmaxf(sqrtf(NRM[tok] + NRM[64 + tok]), 1e-12f);
#pragma unroll
                for (int q = 0; q < 4; ++q) { const f32x4 gc = *(const f32x4*)(lgc + 8 * q), gp = *(const f32x4*)(lgp + 8 * q), ge = *(const f32x4*)(lge + 8 * q);
                    float kt[4], bt[4], ka[4], ke[4], be[4];
#pragma unroll
                    for (int e = 0; e < 4; ++e) { const int r = 4 * q + e; const float en = __expf(-gc[e]), ep = __expf(gp[e]), ee = __expf(ge[e] - gc[e]); const float kkn = ra[r] * invn, bb = kkn * rb[r];
                        kt[e] = rc[r] * en; bt[e] = bb * en; ka[e] = kkn * ep; ke[e] = rc[r] * ee; be[e] = bb * ee; }
                    const int co = 2 * (32 * ct + 8 * q + 4 * hi);
                    *(u32x2*)(SL(0) + tok * WP + co) = (u32x2){pk2(kt[0], kt[1]), pk2(kt[2], kt[3])};
                    *(u32x2*)(SL(1) + tok * WP + co) = (u32x2){pk2(bt[0], bt[1]), pk2(bt[2], bt[3])};
                    *(u32x2*)(SL(2) + tok * WP + co) = (u32x2){pk2(ka[0], ka[1]), pk2(ka[2], ka[3])};
#pragma unroll
                    for (int e = 0; e < 4; ++e) { const int kr = 32 * ct + 8 * q + 4 * hi + e;
                        *(bf16*)(SL(4) + kr * WP + 2 * tok) = (bf16)f2bf(ka[e]); *(bf16*)(SL(5) + kr * WP + 2 * tok) = (bf16)f2bf(be[e]); *(bf16*)(SL(6) + kr * WP + 2 * tok) = (bf16)f2bf(ke[e]); } }
            } else {
#pragma unroll
                for (int q = 0; q < 4; ++q) { const f32x4 gc = *(const f32x4*)(lgc + 8 * q); float rh[4];
#pragma unroll
                    for (int e = 0; e < 4; ++e) rh[e] = ra[4 * q + e] * __expf(gc[e]);
                    *(u32x2*)(SL(3) + tok * WP + 2 * (32 * ct + 8 * q + 4 * hi)) = (u32x2){pk2(rh[0], rh[1]), pk2(rh[2], rh[3])};
#pragma unroll
                    for (int e = 0; e < 4; ++e) *(bf16*)(SL(7) + (32 * ct + 8 * q + 4 * hi + e) * WP + 2 * tok) = (bf16)f2bf(rb[4 * q + e]); }
            }
        }
        LBAR();
        for (int task = w; task < 16; task += 8) { const int pr = task >> 2, mi = (task >> 1) & 1, ni = task & 1;
            if (pr == 0) { f32x16 d = wy_mm(SL(1), SL(2), mi, ni, rho, hi, F16Z);
#pragma unroll
                for (int r = 0; r < 16; ++r) if (!(32 * mi + crow(r, hi) < 32 * ni + rho)) d[r] = 0.f;
                wy_st_t(SL(8), d, mi, ni, rho, hi); wy_st_n(SL(9), d, mi, ni, rho, hi); }
            else if (pr == 1) { f32x16 d = wy_mm(SL(2), SL(0), mi, ni, rho, hi, F16Z);
#pragma unroll
                for (int r = 0; r < 16; ++r) if (!(32 * ni + rho < 32 * mi + crow(r, hi))) d[r] = 0.f;
                wy_st_t(SL(10), d, mi, ni, rho, hi); }
            else if (pr == 2) { f32x16 d = wy_mm(SL(1), SL(3), mi, ni, rho, hi, F16Z);
#pragma unroll
                for (int r = 0; r < 16; ++r) if (!(32 * mi + crow(r, hi) <= 32 * ni + rho)) d[r] = 0.f;
                wy_st_t(SL(11), d, mi, ni, rho, hi); }
            else { f32x16 d = wy_mm(SL(0), SL(3), mi, ni, rho, hi, F16Z);
#pragma unroll
                for (int r = 0; r < 16; ++r) if (!(32 * mi + crow(r, hi) <= 32 * ni + rho)) d[r] = 0.f;
                wy_st_t(SL(12), d, mi, ni, rho, hi); } }
        LBAR();
        for (int task = w; task < 12; task += 8) { const int pr = task >> 2, mi = (task >> 1) & 1, ni = task & 1;
            if (pr == 0) { const f32x16 d = wy_mm(SL(9), SL(8), mi, ni, rho, hi, F16Z); wy_st_t(SL(13), d, mi, ni, rho, hi); }
            else if (pr == 1) { const f32x16 d = wy_mm(SL(8), SL(9), mi, ni, rho, hi, F16Z); wy_st_t(SL(14), d, mi, ni, rho, hi); }
            else { f32x16 d = wy_ld_t(SL(8), mi, ni, rho, hi);
#pragma unroll
                for (int r = 0; r < 16; ++r) d[r] = ((32 * mi + crow(r, hi)) == (32 * ni + rho) ? 1.0f : 0.f) - d[r];
                wy_st_t(SL(15), d, mi, ni, rho, hi); } }
        LBAR();
        int pfin = 16;
#pragma unroll 1
        for (int lev = 1; lev <= 5; ++lev) {
            unsigned char* Pc = SL((lev & 1) ? 15 : 16); unsigned char* Pn = SL((lev & 1) ? 16 : 15);
            unsigned char* Qr = SL((lev & 1) ? 13 : 0); unsigned char* Qx = SL((lev & 1) ? 14 : 1); unsigned char* Qr2 = SL((lev & 1) ? 0 : 13); unsigned char* Qx2 = SL((lev & 1) ? 1 : 14);
            const int ntask = lev < 5 ? 12 : 4;
            for (int task = w; task < ntask; task += 8) { const int pr = task >> 2, mi = (task >> 1) & 1, ni = task & 1;
                if (pr == 0) { f32x16 d = wy_ld_t(Pc, mi, ni, rho, hi);
                    d = wy_mm(Qx, Pc, mi, ni, rho, hi, d); wy_st_t(Pn, d, mi, ni, rho, hi); }
                else if (pr == 1) { const f32x16 d = wy_mm(Qx, Qr, mi, ni, rho, hi, F16Z); wy_st_t(Qr2, d, mi, ni, rho, hi); float mx = 0.f;
#pragma unroll
                    for (int r = 0; r < 16; ++r) mx = fmaxf(mx, fabsf(d[r]));
                    if (__any(mx >= 1e-9f) && l == 0) QMAX[lev] = 1; }
                else { const f32x16 d = wy_mm(Qr, Qx, mi, ni, rho, hi, F16Z); wy_st_t(Qx2, d, mi, ni, rho, hi); } }
            LBAR();
            if (lev < 5 && QMAX[lev] == 0) { pfin = (lev & 1) ? 16 : 15; break; }
        }
        { const int pr = w >> 2, mi = (w >> 1) & 1, ni = w & 1;
          if (pr == 0) { const f32x16 d = wy_mm(SL(pfin), SL(10), mi, ni, rho, hi, F16Z); wy_st_t(SL(0), d, mi, ni, rho, hi); }
          else { const f32x16 d = wy_mm(SL(pfin), SL(4), mi, ni, rho, hi, F16Z); wy_st_t(SL(1), d, mi, ni, rho, hi); } }
        LBAR();
        { bf16* PMg = (bf16*)(ws + WS_PM) + (size_t)unit * 4096; bf16* QMg = (bf16*)(ws + WS_QM) + (size_t)unit * 4096;
          for (int task = w; task < 16; task += 8) { const int pr = task >> 2, mi = (task >> 1) & 1, ni = task & 1;
            if (pr == 0) { f32x16 d = wy_mm(SL(1), SL(5), mi, ni, rho, hi, F16Z);
                const float gc = NRM[256 + 32 * ni + rho];
#pragma unroll
                for (int q = 0; q < 4; ++q) { float o[4];
#pragma unroll
                    for (int e = 0; e < 4; ++e) { const int kr = 32 * mi + 8 * q + 4 * hi + e; o[e] = (kr == 32 * ni + rho ? gc : 0.f) - d[4 * q + e]; }
                    *(u32x2*)(PMg + (32 * ni + rho) * 64 + 32 * mi + 8 * q + 4 * hi) = (u32x2){pk2(o[0], o[1]), pk2(o[2], o[3])}; } }
            else if (pr == 1) { f32x16 d = wy_mm(SL(0), SL(5), mi, ni, rho, hi, F16Z);
                const f32x16 ke = wy_ld_t(SL(6), mi, ni, rho, hi);
#pragma unroll
                for (int r = 0; r < 16; ++r) d[r] = ke[r] - d[r];
                wy_st_t(SL(13), d, mi, ni, rho, hi); }
            else if (pr == 2) { f32x16 d = wy_mm(SL(1), SL(11), mi, ni, rho, hi, F16Z);
                const f32x16 rh = wy_ld_t(SL(3), mi, ni, rho, hi);
#pragma unroll
                for (int q = 0; q < 4; ++q) *(u32x2*)(QMg + (32 * ni + rho) * 64 + 32 * mi + 8 * q + 4 * hi) =
                    (u32x2){pk2(rh[4 * q] - d[4 * q], rh[4 * q + 1] - d[4 * q + 1]), pk2(rh[4 * q + 2] - d[4 * q + 2], rh[4 * q + 3] - d[4 * q + 3])}; }
            else { f32x16 d = wy_mm(SL(0), SL(11), mi, ni, rho, hi, F16Z);
                const f32x16 bk = wy_ld_t(SL(12), mi, ni, rho, hi);
#pragma unroll
                for (int r = 0; r < 16; ++r) d[r] = bk[r] - d[r];
                wy_st_t(SL(14), d, mi, ni, rho, hi); } } }
        LBAR();
        { float* UMg = (float*)(ws + WS_UM) + (size_t)unit * 4096; float* Y0g = (float*)(ws + WS_Y0) + (size_t)unit * 4096; const int pr = w >> 2, mi = (w >> 1) & 1, ni = w & 1;
          if (pr == 0) { const f32x16 d = wy_mm(SL(13), SL(7), mi, ni, rho, hi, F16Z);
#pragma unroll
              for (int q = 0; q < 4; ++q) *(f32x4*)(UMg + (32 * ni + rho) * 64 + 32 * mi + 8 * q + 4 * hi) = (f32x4){d[4 * q], d[4 * q + 1], d[4 * q + 2], d[4 * q + 3]}; }
          else { const f32x16 d = wy_mm(SL(7), SL(14), mi, ni, rho, hi, F16Z);
#pragma unroll
              for (int q = 0; q < 4; ++q) *(f32x4*)(Y0g + (32 * ni + rho) * 64 + 32 * mi + 8 * q + 4 * hi) = (f32x4){d[4 * q], d[4 * q + 1], d[4 * q + 2], d[4 * q + 3]}; } }
        LBAR();
    }
#undef SL
}

constexpr size_t WS_SB = WS_R + 108 * MiB;
static_assert(WS_SB + (size_t)W_UNITS * 8192 <= WS_END, "state snapshots fit");
__device__ __forceinline__ void p5w_chain(const Args& a, unsigned char* lds, int tid) {
    unsigned char* ws = a.ws; float* out = a.out;
    const int l = tid & 63, w = __builtin_amdgcn_readfirstlane(tid >> 6), rho = l & 31, hi = l >> 5;
    unsigned char* Sb0 = lds; unsigned char* Sb1 = lds + WSLOT; unsigned char* PMl = lds + 2 * WSLOT;
    for (int u2 = blockIdx.x; u2 < NB_P * 8 + NB_S * 8; u2 += gridDim.x) {
        const bool smp = u2 >= NB_P * 8; const int sh = smp ? u2 - NB_P * 8 : u2;
        const int nch = smp ? 1 : W_NCH, unit0 = smp ? NB_P * 8 * W_NCH + sh : sh * W_NCH;
        float* wkv = out + (smp ? OFF_WKVS : OFF_WKVP) + (size_t)sh * 4096;
        const int cr = tid >> 3, cc = (tid & 7) * 8, mi = (w >> 1) & 1, ni = w & 1;
        { float x[8];
          if (smp) { const f32x4 a4 = *(const f32x4*)(a.in[5] + (size_t)sh * 4096 + cr * 64 + cc), b4 = *(const f32x4*)(a.in[5] + (size_t)sh * 4096 + cr * 64 + cc + 4); x[0] = a4.x; x[1] = a4.y; x[2] = a4.z; x[3] = a4.w; x[4] = b4.x; x[5] = b4.y; x[6] = b4.z; x[7] = b4.w; }
          else {
#pragma unroll
              for (int e = 0; e < 8; ++e) x[e] = 0.f; }
          const u32x4 p8 = pack8(x); *(u32x4*)(Sb0 + cr * WP + 2 * cc) = p8; *(u32x4*)((bf16*)(ws + WS_SB) + (size_t)unit0 * 4096 + cr * 64 + cc) = p8; }
        u32x4 pmA, pmB = {0u, 0u, 0u, 0u}, pmC = {0u, 0u, 0u, 0u}; f32x16 umA = F16Z, umB = F16Z, umC = F16Z;
#define P5_UM(dst, j_) do { if (w < 4) { const float* um_ = (const float*)(ws + WS_UM) + ((size_t)unit0 + (j_)) * 4096 + (32 * ni + rho) * 64 + 32 * mi + 4 * hi; \
            _Pragma("unroll") for (int q = 0; q < 4; ++q) { const f32x4 x = *(const f32x4*)(um_ + 8 * q); dst[4 * q] = x.x; dst[4 * q + 1] = x.y; dst[4 * q + 2] = x.z; dst[4 * q + 3] = x.w; } } } while (0)
#define P5_PM(dst, j_) dst = *(const u32x4*)((const bf16*)(ws + WS_PM) + ((size_t)unit0 + (j_)) * 4096 + cr * 64 + cc)
        P5_PM(pmA, 0); P5_UM(umA, 0); if (1 < nch) { P5_PM(pmB, 1); P5_UM(umB, 1); }
#define P5_ITER(j, pmX, umX, pmZ, umZ) do { unsigned char* Sc = ((j) & 1) ? Sb1 : Sb0; unsigned char* Sn = ((j) & 1) ? Sb0 : Sb1; \
            *(u32x4*)(PMl + cr * WP + 2 * cc) = pmX; \
            if ((j) + 2 < nch) { P5_PM(pmZ, (j) + 2); P5_UM(umZ, (j) + 2); } \
            LBAR(); \
            if (w < 4) { f32x16 d = wy_mm(PMl, Sc, mi, ni, rho, hi, umX); \
                if ((j) + 1 < nch) { wy_st_t(Sn, d, mi, ni, rho, hi); \
                    bf16* sg = (bf16*)(ws + WS_SB) + ((size_t)unit0 + (j) + 1) * 4096 + (32 * ni + rho) * 64 + 32 * mi + 4 * hi; \
                    _Pragma("unroll") for (int q = 0; q < 4; ++q) *(u32x2*)(sg + 8 * q) = (u32x2){wy_cvt2(d[4 * q], d[4 * q + 1]), wy_cvt2(d[4 * q + 2], d[4 * q + 3])}; } \
                else { _Pragma("unroll") for (int q = 0; q < 4; ++q) *(f32x4*)(wkv + (32 * ni + rho) * 64 + 32 * mi + 8 * q + 4 * hi) = (f32x4){d[4 * q], d[4 * q + 1], d[4 * q + 2], d[4 * q + 3]}; } } \
            LBAR(); } while (0)
        for (int j0 = 0; j0 < nch; j0 += 3) {
            P5_ITER(j0, pmA, umA, pmC, umC);
            if (j0 + 1 < nch) P5_ITER((j0 + 1), pmB, umB, pmA, umA);
            if (j0 + 2 < nch) P5_ITER((j0 + 2), pmC, umC, pmB, umB);
        }
#undef P5_ITER
#undef P5_PM
#undef P5_UM
    }
}

__device__ __forceinline__ void p6w_out(const Args& a, int tid) {
    unsigned char* ws = a.ws; float* out = a.out;
    const bf16* G = (const bf16*)(out + SC_G2); const bf16* VV = (const bf16*)(out + SC_VV); const float* BON = (const float*)(ws + WS_BONUS); bf16* O = (bf16*)(ws + WS_XB);
    const float* lgn = a.in[22]; const float* lbn = a.in[23];
    const int l = tid & 63, rho = l & 31, hi = l >> 5;
    const int gw = blockIdx.x * 8 + (tid >> 6), NGW = gridDim.x * 8;
    for (int task = gw; task < 2 * W_UNITS; task += NGW) {
        const int unit = task >> 1, tt = task & 1; const bool smp = unit >= NB_P * 8 * W_NCH;
        if (smp && tt == 1) continue;
        int h, j; size_t mrow0;
        if (!smp) { j = unit & (W_NCH - 1); const int sh = unit >> 5; h = sh & 7; mrow0 = (size_t)(sh >> 3) * T_P; } else { const int sh = unit - NB_P * 8 * W_NCH; j = 0; h = sh & 7; mrow0 = (size_t)MP + 32 * (sh >> 3); }
        const int tok = 32 * tt + rho; const size_t m = mrow0 + (size_t)j * 64 + tok;
        const bf16* sb = (const bf16*)(ws + WS_SB) + (size_t)unit * 4096 + rho * 64 + 8 * hi; const bf16* qm = (const bf16*)(ws + WS_QM) + (size_t)unit * 4096 + tok * 64 + 8 * hi;
        bf16x8 sa[2][4], qb[4];
#pragma unroll
        for (int ks = 0; ks < 4; ++ks) { sa[0][ks] = *(const bf16x8*)(sb + 16 * ks); sa[1][ks] = *(const bf16x8*)(sb + 32 * 64 + 16 * ks); qb[ks] = *(const bf16x8*)(qm + 16 * ks); }
        const float* y0 = (const float*)(ws + WS_Y0) + (size_t)unit * 4096 + tok * 64 + 4 * hi;
        f32x16 d0, d1;
#pragma unroll
        for (int q = 0; q < 4; ++q) { const f32x4 x = *(const f32x4*)(y0 + 8 * q), y = *(const f32x4*)(y0 + 32 + 8 * q);
            d0[4 * q] = x.x; d0[4 * q + 1] = x.y; d0[4 * q + 2] = x.z; d0[4 * q + 3] = x.w; d1[4 * q] = y.x; d1[4 * q + 1] = y.y; d1[4 * q + 2] = y.z; d1[4 * q + 3] = y.w; }
        u32x2 vw[8], gg[8]; f32x4 l4[8], b4[8]; const float bon = BON[m * 8 + h];
#pragma unroll
        for (int vt = 0; vt < 2; ++vt)
#pragma unroll
            for (int q = 0; q < 4; ++q) { const int c = 64 * h + 32 * vt + 8 * q + 4 * hi; vw[4 * vt + q] = *(const u32x2*)(VV + m * 512 + c); gg[4 * vt + q] = *(const u32x2*)(G + m * 512 + c);
                l4[4 * vt + q] = *(const f32x4*)(lgn + c); b4[4 * vt + q] = *(const f32x4*)(lbn + c); }
#pragma unroll
        for (int ks = 0; ks < 4; ++ks) { d0 = MFMA32(sa[0][ks], qb[ks], d0); d1 = MFMA32(sa[1][ks], qb[ks], d1); }
        float s1 = 0.f;
#pragma unroll
        for (int r = 0; r < 16; ++r) s1 += d0[r] + d1[r];
        s1 += __shfl_xor(s1, 32);
        const float mean = s1 * (1.f / 64.f); float s2 = 0.f;
#pragma unroll
        for (int r = 0; r < 16; ++r) { const float e0 = d0[r] - mean, e1 = d1[r] - mean; s2 += e0 * e0 + e1 * e1; }
        s2 += __shfl_xor(s2, 32);
        const float rinv = rsqrtf(s2 * (1.f / 64.f) + 64e-5f);
#pragma unroll
        for (int vt = 0; vt < 2; ++vt)
#pragma unroll
            for (int q = 0; q < 4; ++q) { const int c = 64 * h + 32 * vt + 8 * q + 4 * hi; const u32x2 v2 = vw[4 * vt + q], g2 = gg[4 * vt + q];
                const float vv[4] = {bflo(v2.x), bfhi(v2.x), bflo(v2.y), bfhi(v2.y)}, gf[4] = {bflo(g2.x), bfhi(g2.x), bflo(g2.y), bfhi(g2.y)}; float r4[4];
#pragma unroll
                for (int e = 0; e < 4; ++e) { const float y = vt ? d1[4 * q + e] : d0[4 * q + e]; r4[e] = ((y - mean) * rinv * l4[4 * vt + q][e] + b4[4 * vt + q][e] + bon * vv[e]) * gf[e]; }
                *(u32x2*)(O + m * DM + 512 + c) = (u32x2){pk2(r4[0], r4[1]), pk2(r4[2], r4[3])}; }
    }
}

#define XB_TMO      128
#define XB_XCNT(j)  (256  + 64 * (j))
#define XB_XSUB(j)  (1280 + 64 * (j))
#define XB_XGEN(j)  (2304 + 64 * (j))
#define XB_TOP      3328
#define XB_TOPGEN   3392
#define XCD_BAR_WORDS 3456
#define XB_SPIN_CAP (1u << 18)

__device__ __forceinline__ unsigned xb_ld(unsigned* p)              { return __hip_atomic_load(p, __ATOMIC_RELAXED, __HIP_MEMORY_SCOPE_AGENT); }
__device__ __forceinline__ unsigned xb_add(unsigned* p, unsigned v) { return __hip_atomic_fetch_add(p, v, __ATOMIC_RELAXED, __HIP_MEMORY_SCOPE_AGENT); }
__device__ __forceinline__ unsigned xb_xcc_id() { return (unsigned)__builtin_amdgcn_s_getreg((3 << 11) | 20) & 0xFu; }
#define XB_SPIN(cond, bar) do { unsigned _sp = 0; while (cond) { __builtin_amdgcn_s_sleep(1); \
    if ((++_sp & 255u) == 0u) { if (xb_ld(&(bar)[XB_TMO])) break; if (_sp > XB_SPIN_CAP) { atomicAdd(&(bar)[XB_TMO], 1u); break; } } } } while (0)

struct XcdBarrier {
    unsigned* bar; unsigned x;
    volatile __attribute__((address_space(3))) unsigned* st;
};

__device__ __forceinline__ XcdBarrier xcd_barrier_post(unsigned* bar, volatile __attribute__((address_space(3))) unsigned* st) {
    XcdBarrier b; b.bar = bar; b.x = xb_xcc_id(); b.st = st;
    if (threadIdx.x == 0) (void)xb_add(&bar[XB_XCNT(b.x)], 1u);
    return b;
}
__device__ __forceinline__ void xcd_barrier_complete(unsigned* bar, unsigned x, unsigned& nloc, unsigned& nx) {
    const unsigned G = gridDim.x * gridDim.y * gridDim.z;
    unsigned sum, cnt, mine, sp = 0u;
    for (;;) {
        sum = 0u; cnt = 0u; mine = 0u;
#pragma unroll
        for (unsigned j = 0; j < 16; ++j) { const unsigned c = xb_ld(&bar[XB_XCNT(j)]); sum += c; cnt += (c > 0u) ? 1u : 0u; mine = (j == x) ? c : mine; }
        if (sum == G) break;
        __builtin_amdgcn_s_sleep(1);
        if ((++sp & 255u) == 0u) { if (xb_ld(&bar[XB_TMO])) break; if (sp > XB_SPIN_CAP) { atomicAdd(&bar[XB_TMO], 1u); break; } }
    }
    nloc = mine > 0u ? mine : 1u; nx = cnt > 0u ? cnt : 1u;
}

__device__ __forceinline__ void xcd_barrier(const XcdBarrier& b) {
    asm volatile("s_waitcnt vmcnt(0)" ::: "memory");
    __syncthreads();
    if (threadIdx.x == 0) {
        unsigned* bar = b.bar;
        __builtin_amdgcn_s_waitcnt(0);
        unsigned nloc = b.st[0], nx = b.st[1];
        if (nloc == 0u) { xcd_barrier_complete(bar, b.x, nloc, nx); b.st[0] = nloc; b.st[1] = nx; }
        const unsigned old = xb_add(&bar[XB_XSUB(b.x)], 1u);
        const unsigned gen = old / nloc;
        if (old + 1u == (gen + 1u) * nloc) {
            __builtin_amdgcn_fence(__ATOMIC_RELEASE, "agent");
            asm volatile("s_waitcnt vmcnt(0)" ::: "memory");
            const unsigned og = xb_add(&bar[XB_TOP], 1u);
            const unsigned tg = og / nx;
            if (og + 1u == (tg + 1u) * nx) xb_add(&bar[XB_TOPGEN], 1u);
            else XB_SPIN(xb_ld(&bar[XB_TOPGEN]) == tg, bar);
            __builtin_amdgcn_fence(__ATOMIC_ACQUIRE, "agent");
            xb_add(&bar[XB_XGEN(b.x)], 1u);
            asm volatile("s_waitcnt vmcnt(0)" ::: "memory");
        } else {
            XB_SPIN(xb_ld(&bar[XB_XGEN(b.x)]) == gen, bar);
            __builtin_amdgcn_fence(__ATOMIC_ACQUIRE, "agent");
            asm volatile("s_waitcnt vmcnt(0)" ::: "memory");
        }
    }
    __syncthreads();
}

constexpr int CW_BAR = 4096;
constexpr int LDS_BYTES = 163840;
constexpr int N_PHASES = 12;
#ifndef PROBE_MASK
#define PROBE_MASK 0
#endif
template <int PH> __device__ __forceinline__ void run_phase(const Args& args, unsigned char* lds, int tid, int rep) {
    unsigned char* ws = args.ws;
    if constexpr (PH == 0) p0_prologue(args, lds, tid);
    if constexpr (PH == 1) { pg8::Gemm g{(const pg8::bf16_t*)(ws + WS_XB), (const pg8::bf16_t*)(ws + WS_WIN), MT, NZ, DM, DM}; pg8::StaticOrder S; S.init(MT, NZ, gridDim.x, blockIdx.x);
        pg8::EpiZ E{(pg8::bf16_t*)(ws + WS_ZR), (pg8::bf16_t*)(ws + WS_ZS)};
        pg8::gemm_phase<pg8::EpiZ, pg8::StaticOrder, true, true>((PG8_LAS unsigned char*)lds, g, S, E); }
    if constexpr (PH == 2) p2_post(args, lds, tid);
    if constexpr (PH == 3) p3_attention(args, lds, tid, rep);
    if constexpr (PH == 4) p4w_chunks(args, lds, tid);
    if constexpr (PH == 5) p5w_chain(args, lds, tid);
    if constexpr (PH == 6) p6w_out(args, tid);
    if constexpr (PH == 7) { pg8::Gemm g{(const pg8::bf16_t*)(ws + WS_XB), (const pg8::bf16_t*)(ws + WS_WOUT), MT, DM, DM, DM}; pg8::StaticOrder S; S.init(MT, DM, gridDim.x, blockIdx.x);
        pg8::EpiH E{args.in[0], args.in[1], args.out + OFF_Y, (pg8::bf16_t*)(ws + WS_HB), (float*)(ws + WS_CTL) + CW_SS};
        pg8::gemm_phase<pg8::EpiH, pg8::StaticOrder, true, true>((PG8_LAS unsigned char*)lds, g, S, E); }
    if constexpr (PH == 9) { pg8::Gemm g{(const pg8::bf16_t*)(ws + WS_HB), (const pg8::bf16_t*)(ws + WS_W1), MT, DFF, DM, DM}; pg8::StaticOrder S; S.init(MT, DFF, gridDim.x, blockIdx.x);
        pg8::EpiAct E{(pg8::bf16_t*)(ws + WS_ACT), DFF, (const float*)(ws + WS_CTL) + CW_SS};
        pg8::gemm_phase<pg8::EpiAct, pg8::StaticOrder, true, true>((PG8_LAS unsigned char*)lds, g, S, E); }
    if constexpr (PH == 10) {
        { pg8::Gemm g{(const pg8::bf16_t*)(ws + WS_ACT), (const pg8::bf16_t*)(ws + WS_W2), MP, DM, DFF, DFF}; pg8::StaticOrder S; S.init(MP, DM, gridDim.x, blockIdx.x);
          pg8::EpiY E{args.out + OFF_Y, (const pg8::bf16_t*)(ws + WS_HB)};
          pg8::gemm_phase<pg8::EpiY, pg8::StaticOrder, true, true>((PG8_LAS unsigned char*)lds, g, S, E); }
        { const int c = blockIdx.x; pg8::OneUnit S; S.has = c < 64; S.u.pm = MP / 256 + (c >> 4); S.u.pn = (c >> 2) & 3; const int sl = c & 3;
          pg8::Gemm g{(const pg8::bf16_t*)(ws + WS_ACT) + sl * 1024, (const pg8::bf16_t*)(ws + WS_W2) + sl * 1024, MT, DM, DFF, 1024};
          pg8::EpiSlab E{(float*)(ws + WS_SLAB) + (size_t)sl * MS * DM};
          __syncthreads();
          pg8::gemm_phase<pg8::EpiSlab, pg8::OneUnit, false, true>((PG8_LAS unsigned char*)lds, g, S, E); }
    }
    if constexpr (PH == 11) {
        const f32x4* sl = (const f32x4*)(ws + WS_SLAB); f32x4* y = (f32x4*)(args.out + OFF_Y + (size_t)MP * DM); const u32x2* hb = (const u32x2*)((const bf16*)(ws + WS_HB) + (size_t)MP * DM); constexpr int NV = MS * DM / 4;
        for (int i = blockIdx.x * 512 + tid; i < NV; i += gridDim.x * 512) { const u32x2 hw = hb[i]; const f32x4 h = {bflo(hw.x), bfhi(hw.x), bflo(hw.y), bfhi(hw.y)};
            y[i] = h + ((sl[i] + sl[i + NV]) + (sl[i + 2 * NV] + sl[i + 3 * NV])); }
    }
}
#ifndef MK_ONE_LAUNCH
#define MK_ONE_LAUNCH 1
#endif
#if MK_ONE_LAUNCH
__global__ void __launch_bounds__(512, 2) mk_fwd(Args args) {
    extern __shared__ __attribute__((aligned(16))) unsigned char lds[];
    const int tid = threadIdx.x;
    volatile __attribute__((address_space(3))) unsigned* bst = (volatile __attribute__((address_space(3))) unsigned*)((__attribute__((address_space(3))) unsigned char*)lds + LDS_BYTES - 16);
    if (tid < 2) bst[tid] = 0u;
    __syncthreads();
    const XcdBarrier bar = xcd_barrier_post((unsigned*)(args.ws + WS_CTL) + CW_BAR, bst);
    if (args.ph_lo < 0) { __syncthreads(); cg::this_grid().sync(); }
#define SEAM(k) xcd_barrier(bar)
#define PHASE(k) do { if (args.ph_lo <= (k) && (k) < args.ph_hi) { if ((k) > args.ph_lo) SEAM(k); run_phase<k>(args, lds, tid, 0); \
        if ((PROBE_MASK >> (k)) & 1) { xcd_barrier(bar); run_phase<k>(args, lds, tid, 1); } } } while (0)
    PHASE(0); PHASE(1); PHASE(2); PHASE(3); PHASE(4); PHASE(5); PHASE(6); PHASE(7); PHASE(9); PHASE(10); PHASE(11);
#undef PHASE
#undef SEAM
}
#else
template <int PH> __global__ void __launch_bounds__(512, 2) mk_phase(Args args) {
    extern __shared__ __attribute__((aligned(16))) unsigned char lds[];
    run_phase<PH>(args, lds, threadIdx.x, 0);
}
#endif

extern "C" void kernel_launch(void* const* d_in, const int* in_sizes, int n_in, void* d_out, int out_size, void* d_ws, size_t ws_size, hipStream_t stream) {
    static int grid = 0;
    if (grid == 0) {
        if (n_in != 28 || out_size != (int)OUT_TOTAL || ws_size < WS_END) { fprintf(stderr, "kernel_launch: unexpected shapes (n_in %d, out %d, ws %zu)\n", n_in, out_size, ws_size); grid = -1; return; }
        int dev = 0, cus = 0, per_cu = 0;
        (void)hipGetDevice(&dev); (void)hipDeviceGetAttribute(&cus, hipDeviceAttributeMultiprocessorCount, dev);
#if MK_ONE_LAUNCH
        if (hipFuncSetAttribute((const void*)mk_fwd, hipFuncAttributeMaxDynamicSharedMemorySize, LDS_BYTES) != hipSuccess) { fprintf(stderr, "kernel_launch: hipFuncSetAttribute failed\n"); grid = -1; return; }
        (void)hipOccupancyMaxActiveBlocksPerMultiprocessor(&per_cu, (const void*)mk_fwd, 512, LDS_BYTES);
        (void)hipGetLastError();
        if (per_cu < 1) { fprintf(stderr, "kernel_launch: occupancy query says %d blocks per CU\n", per_cu); per_cu = 1; }
#else
#define SETATTR(k) (void)hipFuncSetAttribute((const void*)mk_phase<k>, hipFuncAttributeMaxDynamicSharedMemorySize, LDS_BYTES)
        SETATTR(0); SETATTR(1); SETATTR(2); SETATTR(3); SETATTR(4); SETATTR(5); SETATTR(6); SETATTR(7); SETATTR(8); SETATTR(9); SETATTR(10); SETATTR(11);
#undef SETATTR
        (void)per_cu;
#endif
        grid = cus;
    }
    if (grid < 0) return;
    (void)hipMemsetAsync((char*)d_ws + WS_CTL, 0, CTL_BYTES, stream);
    Args a{};
    for (int i = 0; i < 28; ++i) a.in[i] = (const float*)d_in[i];
    a.out = (float*)d_out; a.ws = (unsigned char*)d_ws;
#if MK_ONE_LAUNCH
    a.ph_lo = 0; a.ph_hi = N_PHASES;
    void* kargs[] = {&a};
    hipError_t e = hipLaunchCooperativeKernel((const void*)mk_fwd, dim3(grid), dim3(512), kargs, LDS_BYTES, stream);
    if (e != hipSuccess) fprintf(stderr, "kernel_launch: cooperative launch failed: %s (grid %d)\n", hipGetErrorString(e), grid);
#else
#define LAUNCH(k) hipLaunchKernelGGL(mk_phase<k>, dim3(grid), dim3(512), LDS_BYTES, stream, a)
    a.ph_lo = 0; a.ph_hi = N_PHASES;
    LAUNCH(0); LAUNCH(1); LAUNCH(2); LAUNCH(3); LAUNCH(4); LAUNCH(5); LAUNCH(6); LAUNCH(7); LAUNCH(9); LAUNCH(10); LAUNCH(11);
#undef LAUNCH
#endif
}
```

```cpp
#include <hip/hip_runtime.h>
#include <hip/hip_cooperative_groups.h>
#include <cstdio>
#include <cstdint>
namespace cg = cooperative_groups;
#define LBAR() asm volatile("s_waitcnt lgkmcnt(0)\n\ts_barrier" ::: "memory")
#define PROBE_A1 0
#define PROBE_A2 0
#define PROBE_A3 0
namespace pg8 {
#define PG8_LAS __attribute__((address_space(3)))
typedef unsigned short bf16_t;
typedef short bf16x8 __attribute__((ext_vector_type(8)));
typedef float f32x4 __attribute__((ext_vector_type(4)));
typedef unsigned u32x4 __attribute__((ext_vector_type(4)));
constexpr int BM = 256, BK = 64, HALF = 128, HTB = HALF * BK * 2  , STAGE_BYTES = 8 * HTB, NXCD = 8, WGM = 8;

__host__ __device__ __forceinline__ int lds_byte(int r, int c) { const int st = (r >> 4) * 2 + (c >> 5), rr = r & 15, cc = c & 31, ob = rr * 64 + cc * 2; return st * 1024 + (ob ^ (((ob >> 9) & 1) << 5)); }
__host__ __device__ __forceinline__ void stage_rc(int b, int& R, int& C) { const int st = b / 1024, sb = b % 1024, swz = sb ^ (((sb >> 9) & 1) << 5); R = (st >> 1) * 16 + swz / 64; C = (st & 1) * 32 + (swz % 64) / 2; }
__host__ __device__ __forceinline__ int perm32(int rho) { const int n = rho >> 4, i = rho & 15; return 8 * (i >> 2) + 4 * n + (i & 3); }

struct Unit { int pm, pn; };
struct Gemm { const bf16_t* A; const bf16_t* Bt; int M, N, K, KL; };

struct StaticOrder {
    int nM, nN, nwg, G, c;
    __host__ __device__ void init(int M, int N, int G_, int c_) { nM = M / BM; nN = N / BM; nwg = nM * nN; G = G_; c = c_; }
    __host__ __device__ bool next(int i, Unit& u) const {
        const long L = (long)i * G + c; if (L >= nwg) return false;
        int wgid = (int)L; { const int q = nwg / NXCD, r = nwg % NXCD, xcd = wgid % NXCD, off = wgid / NXCD; wgid = (xcd < r ? xcd * (q + 1) : r * (q + 1) + (xcd - r) * q) + off; }
        const int nig = WGM * nN, gid = wgid / nig, fm = gid * WGM, gsz = (nM - fm) < WGM ? (nM - fm) : WGM;
        u.pm = fm + ((wgid % nig) % gsz); u.pn = (wgid % nig) / gsz; return true;
    }
    __device__ __forceinline__ void a_ready(const Unit&) const {}
    __device__ __forceinline__ void done(const Unit&) const {}
};


__device__ __forceinline__ unsigned cvt_pk_bf16(float lo, float hi) { unsigned r; asm volatile("v_cvt_pk_bf16_f32 %0, %1, %2" : "=v"(r) : "v"(lo), "v"(hi)); return r; }
typedef float cv_f32x2 __attribute__((ext_vector_type(2))); typedef __bf16 cv_bf16x2 __attribute__((ext_vector_type(2)));
__device__ __forceinline__ unsigned cvt2_safe(float lo, float hi) { const cv_f32x2 v = {lo, hi}; const cv_bf16x2 b = __builtin_convertvector(v, cv_bf16x2); return __builtin_bit_cast(unsigned, b); }

constexpr int E_MP = 16384;
constexpr int E_ZRW = 1632, E_ZSW = 1696;

struct OneUnit { Unit u; bool has;
    __device__ __forceinline__ bool next(int i, Unit& o) const { if (i == 0 && has) { o = u; return true; } return false; }
    __device__ __forceinline__ void a_ready(const Unit&) const {}
    __device__ __forceinline__ void done(const Unit&) const {} };
struct EpiZ {
    static constexpr bool PERM = true, AFTER_DRAIN = false;
    bf16_t* ZR; bf16_t* ZS;
    __device__ __forceinline__ void operator()(const f32x4 (&acc)[2][2][4][2], const Unit& u, int wr, int wc, int fr, int fq) const {
        const int row0 = u.pm * BM + wr * 64 + fr, c0 = u.pn * BM + wc * 32 + 8 * fq;
#pragma unroll
        for (int ai = 0; ai < 2; ++ai)
#pragma unroll
            for (int m = 0; m < 4; ++m) { const size_t row = (size_t)(row0 + ai * HALF + m * 16);
#pragma unroll
                for (int bj = 0; bj < 2; ++bj) { const int c = c0 + bj * HALF; bf16_t* dst;
                    if (c < 1600) dst = ZR + row * E_ZRW + c; else if (c < 3296) dst = ZS + row * E_ZSW + (c - 1600); else if (c == 3296) dst = ZR + row * E_ZRW + 1600; else continue;
                    const f32x4 v0 = acc[ai][bj][m][0], v1 = acc[ai][bj][m][1]; u32x4 w;
                    w.x = cvt2_safe(v0[0], v0[1]); w.y = cvt2_safe(v0[2], v0[3]); w.z = cvt2_safe(v1[0], v1[1]); w.w = cvt2_safe(v1[2], v1[3]);
                    *(u32x4*)dst = w; } }
    }
};
struct EpiH {
    static constexpr bool PERM = false, AFTER_DRAIN = false;
    const float* xp; const float* xs; float* H; bf16_t* HB; float* SS;
    __device__ __forceinline__ void operator()(const f32x4 (&acc)[2][2][4][2], const Unit& u, int wr, int wc, int fr, int fq) const {
        const int row0 = u.pm * BM + wr * 64 + fr, col0 = u.pn * BM + wc * 32 + 4 * fq;
#pragma unroll
        for (int ai = 0; ai < 2; ++ai)
#pragma unroll
            for (int m = 0; m < 4; ++m) { const int row = row0 + ai * HALF + m * 16;
                const float* xr = (row < E_MP ? xp + (size_t)row * 1024 : xs + (size_t)(row - E_MP) * 1024) + col0; bf16_t* hb = HB + (size_t)row * 1024 + col0;
                float ss = 0.f;
#pragma unroll
                for (int bj = 0; bj < 2; ++bj)
#pragma unroll
                    for (int n = 0; n < 2; ++n) { const f32x4 h = *(const f32x4*)(xr + bj * HALF + n * 16) + acc[ai][bj][m][n];
                        ss += (h[0] * h[0] + h[1] * h[1]) + (h[2] * h[2] + h[3] * h[3]);
                        unsigned w0 = cvt_pk_bf16(h[0], h[1]), w1 = cvt_pk_bf16(h[2], h[3]); typedef unsigned u32x2v __attribute__((ext_vector_type(2))); *(u32x2v*)(hb + bj * HALF + n * 16) = (u32x2v){w0, w1}; }
                ss += __shfl_xor(ss, 16); ss += __shfl_xor(ss, 32);
                if (fq == 0) atomicAdd(SS + row, ss); }
    }
};
struct EpiAct {
    static constexpr bool PERM = true, AFTER_DRAIN = false;
    bf16_t* O; int ldc; const float* SS;
    __device__ __forceinline__ void operator()(const f32x4 (&acc)[2][2][4][2], const Unit& u, int wr, int wc, int fr, int fq) const {
        const int row0 = u.pm * BM + wr * 64 + fr, c0 = u.pn * BM + wc * 32 + 8 * fq;
#pragma unroll
        for (int ai = 0; ai < 2; ++ai)
#pragma unroll
            for (int m = 0; m < 4; ++m) { const int row = row0 + ai * HALF + m * 16; bf16_t* rowp = O + (size_t)row * ldc + c0;
                const float rs = rsqrtf(SS[row] * (1.0f / 1024.0f) + 1e-6f);
#pragma unroll
                for (int bj = 0; bj < 2; ++bj) { f32x4 v0 = acc[ai][bj][m][0], v1 = acc[ai][bj][m][1];
#pragma unroll
                    for (int e = 0; e < 4; ++e) { const float a = fmaxf(v0[e], 0.f) * rs, b = fmaxf(v1[e], 0.f) * rs; v0[e] = a * a; v1[e] = b * b; }
                    u32x4 w; w.x = cvt_pk_bf16(v0[0], v0[1]); w.y = cvt_pk_bf16(v0[2], v0[3]); w.z = cvt_pk_bf16(v1[0], v1[1]); w.w = cvt_pk_bf16(v1[2], v1[3]);
                    *(u32x4*)(rowp + bj * HALF) = w; } }
    }
};
struct EpiSlab {
    static constexpr bool PERM = false, AFTER_DRAIN = false;
    float* S;
    __device__ __forceinline__ void operator()(const f32x4 (&acc)[2][2][4][2], const Unit& u, int wr, int wc, int fr, int fq) const {
        const int row0 = u.pm * BM - E_MP + wr * 64 + fr, col0 = u.pn * BM + wc * 32 + 4 * fq;
#pragma unroll
        for (int ai = 0; ai < 2; ++ai)
#pragma unroll
            for (int m = 0; m < 4; ++m) { float* yr = S + (size_t)(row0 + ai * HALF + m * 16) * 1024 + col0;
#pragma unroll
                for (int bj = 0; bj < 2; ++bj)
#pragma unroll
                    for (int n = 0; n < 2; ++n) *(f32x4*)(yr + bj * HALF + n * 16) = acc[ai][bj][m][n]; }
    }
};
struct EpiY {
    static constexpr bool PERM = false, AFTER_DRAIN = false;
    float* Y; const bf16_t* HB;
    __device__ __forceinline__ void operator()(const f32x4 (&acc)[2][2][4][2], const Unit& u, int wr, int wc, int fr, int fq) const {
        const int row0 = u.pm * BM + wr * 64 + fr, col0 = u.pn * BM + wc * 32 + 4 * fq;
        typedef unsigned u32x2v __attribute__((ext_vector_type(2)));
#pragma unroll
        for (int ai = 0; ai < 2; ++ai)
#pragma unroll
            for (int m = 0; m < 4; ++m) { const size_t ro = (size_t)(row0 + ai * HALF + m * 16) * 1024 + col0;
#pragma unroll
                for (int bj = 0; bj < 2; ++bj)
#pragma unroll
                    for (int n = 0; n < 2; ++n) { const u32x2v hw = *(const u32x2v*)(HB + ro + bj * HALF + n * 16);
                        const f32x4 h = {__uint_as_float(hw.x << 16), __uint_as_float(hw.x & 0xffff0000u), __uint_as_float(hw.y << 16), __uint_as_float(hw.y & 0xffff0000u)};
                        *(f32x4*)(Y + ro + bj * HALF + n * 16) = h + acc[ai][bj][m][n]; } }
    }
};

template <class Epi, class Sched, bool ALIGN_EPI = false, bool SP2 = false>
__device__ __forceinline__ void gemm_phase(PG8_LAS unsigned char* lds, const Gemm g, const Sched& S, const Epi& E) {
    const int tid = threadIdx.x, wid = __builtin_amdgcn_readfirstlane(tid >> 6), lane = tid & 63, wr = wid >> 2, wc = wid & 3, fr = lane & 15, fq = lane >> 4;
    const int K = g.K, nt = g.KL / BK;
    unsigned voffA[2], voffB[2];
#pragma unroll
    for (int i = 0; i < 2; ++i) { int R, C; stage_rc(tid * 16 + i * 8192, R, C); const int Rb = Epi::PERM ? ((R & ~31) + perm32(R & 31)) : R;
        voffA[i] = (unsigned)(R * K + C) * 2u; voffB[i] = (unsigned)(Rb * K + C) * 2u; }
    const size_t kstep = (size_t)(BK * 2);
    const size_t hstep = (size_t)HALF * K * 2;
    const size_t tstep = 2 * hstep;
    const unsigned ldsw = (unsigned)wid * 1024u;
    const int aoff = lds_byte(wr * 64 + fr, fq * 8), boff = lds_byte(wc * 32 + fr, fq * 8);
#define PG8_SA(b, h) (((b) * 2 + (h)) * HTB)
#define PG8_SB(b, h) ((4 + (b) * 2 + (h)) * HTB)
#define PG8_STAGE(bufoff, gbase, voff) do { _Pragma("unroll") for (int _i = 0; _i < 2; ++_i) \
        __builtin_amdgcn_global_load_lds((const unsigned*)((const char*)(gbase) + (voff)[_i]), (PG8_LAS unsigned*)(lds + (bufoff) + ldsw + _i * 8192), 16, 0, 0); } while (0)
#define PG8_LDA(dst, b, h) do { _Pragma("unroll") for (int m = 0; m < 4; ++m) _Pragma("unroll") for (int k = 0; k < 2; ++k) dst[m][k] = *(const PG8_LAS bf16x8*)(lds + PG8_SA(b, h) + aoff + m * 2048 + k * 1024); } while (0)
#define PG8_LDB(dst, b, h) do { _Pragma("unroll") for (int n = 0; n < 2; ++n) _Pragma("unroll") for (int k = 0; k < 2; ++k) dst[n][k] = *(const PG8_LAS bf16x8*)(lds + PG8_SB(b, h) + boff + n * 2048 + k * 1024); } while (0)
#define PG8_MMA(ai, bj, At, Bt) do { __builtin_amdgcn_s_setprio(1); _Pragma("unroll") for (int m = 0; m < 4; ++m) _Pragma("unroll") for (int n = 0; n < 2; ++n) _Pragma("unroll") for (int k = 0; k < 2; ++k) \
        acc[ai][bj][m][n] = __builtin_amdgcn_mfma_f32_16x16x32_bf16(Bt[n][k], At[m][k], acc[ai][bj][m][n], 0, 0, 0); __builtin_amdgcn_s_setprio(0); } while (0)
#define PG8_WAIT_V(n) asm volatile("s_waitcnt vmcnt(" #n ")" ::: "memory")
#define PG8_WAIT_L(n) asm volatile("s_waitcnt lgkmcnt(" #n ")" ::: "memory")
#define PG8_BAR __builtin_amdgcn_s_barrier()
#define PG8_SCHED __builtin_amdgcn_sched_barrier(0)
    Unit cur, nxt; int ui = 0;
    if (!S.next(0, cur)) return;
    f32x4 acc[2][2][4][2];
#pragma unroll
    for (int a = 0; a < 2; ++a)
#pragma unroll
        for (int b = 0; b < 2; ++b)
#pragma unroll
            for (int m = 0; m < 4; ++m)
#pragma unroll
                for (int n = 0; n < 2; ++n) acc[a][b][m][n] = (f32x4){0.f, 0.f, 0.f, 0.f};
    bf16x8 At[4][2], B0[2][2], B1[2][2];
    const char* cA = (const char*)g.A + (size_t)cur.pm * tstep; const char* cB = (const char*)g.Bt + (size_t)cur.pn * tstep;
    S.a_ready(cur);
    if constexpr (SP2) {
        PG8_STAGE(PG8_SB(0, 0), cB, voffB); PG8_STAGE(PG8_SB(0, 1), cB + hstep, voffB); PG8_STAGE(PG8_SA(0, 0), cA, voffA); PG8_STAGE(PG8_SA(0, 1), cA + hstep, voffA);
        if (wr == 1) PG8_BAR;
        PG8_WAIT_V(2); PG8_BAR;
        PG8_STAGE(PG8_SB(1, 0), cB + kstep, voffB); PG8_STAGE(PG8_SA(1, 0), cA + kstep, voffA); PG8_STAGE(PG8_SB(1, 1), cB + hstep + kstep, voffB);
        PG8_WAIT_V(6); PG8_BAR;
    } else {
        PG8_STAGE(PG8_SB(0, 0), cB, voffB); PG8_STAGE(PG8_SA(0, 0), cA, voffA); PG8_STAGE(PG8_SB(0, 1), cB + hstep, voffB); PG8_STAGE(PG8_SA(0, 1), cA + hstep, voffA);
        if (wr == 1) PG8_BAR;
        PG8_WAIT_V(4); PG8_BAR;
        PG8_STAGE(PG8_SB(1, 0), cB + kstep, voffB); PG8_STAGE(PG8_SA(1, 0), cA + kstep, voffA); PG8_STAGE(PG8_SB(1, 1), cB + hstep + kstep, voffB);
        PG8_WAIT_V(6); PG8_BAR;
    }
    for (;;) {
        const bool has_next = S.next(ui + 1, nxt);
        const char* nA = has_next ? (const char*)g.A + (size_t)nxt.pm * tstep : cA; const char* nB = has_next ? (const char*)g.Bt + (size_t)nxt.pn * tstep : cB;
        for (int t = 0; t < nt; t += 2) {
            const bool last = (t == nt - 2);
            const char* a1 = cA + (size_t)(t + 1) * kstep;
            const char* a2 = last ? nA : cA + (size_t)(t + 2) * kstep; const char* b2 = last ? nB : cB + (size_t)(t + 2) * kstep;
            const char* a3 = a2 + kstep; const char* b3 = b2 + kstep;
            if (last && has_next) S.a_ready(nxt);
            if constexpr (SP2) {
            PG8_LDB(B0, 0, 0); PG8_LDB(B1, 0, 1); PG8_SCHED; PG8_LDA(At, 0, 0); PG8_STAGE(PG8_SA(1, 1), a1 + hstep, voffA);
            PG8_WAIT_V(8); PG8_WAIT_L(0); PG8_BAR; PG8_MMA(0, 0, At, B0); PG8_MMA(0, 1, At, B1); PG8_BAR; PG8_SCHED;
            PG8_LDA(At, 0, 1); PG8_STAGE(PG8_SB(0, 0), b2, voffB); PG8_STAGE(PG8_SB(0, 1), b2 + hstep, voffB); PG8_STAGE(PG8_SA(0, 0), a2, voffA);
            PG8_WAIT_V(8); PG8_WAIT_L(0); PG8_BAR; PG8_MMA(1, 0, At, B0); PG8_MMA(1, 1, At, B1); PG8_BAR; PG8_SCHED;
            PG8_LDB(B0, 1, 0); PG8_LDB(B1, 1, 1); PG8_SCHED; PG8_LDA(At, 1, 0); PG8_STAGE(PG8_SA(0, 1), a2 + hstep, voffA);
            PG8_WAIT_V(8); PG8_WAIT_L(0); PG8_BAR; PG8_MMA(0, 0, At, B0); PG8_MMA(0, 1, At, B1); PG8_BAR; PG8_SCHED;
            PG8_LDA(At, 1, 1); PG8_STAGE(PG8_SB(1, 0), b3, voffB); PG8_STAGE(PG8_SB(1, 1), b3 + hstep, voffB); PG8_STAGE(PG8_SA(1, 0), a3, voffA);
            PG8_WAIT_V(8); PG8_WAIT_L(0); PG8_BAR; PG8_MMA(1, 0, At, B0); PG8_MMA(1, 1, At, B1); PG8_BAR; PG8_SCHED;
            } else {
            PG8_LDB(B0, 0, 0); PG8_SCHED; PG8_LDA(At, 0, 0); PG8_STAGE(PG8_SA(1, 1), a1 + hstep, voffA);
            PG8_WAIT_L(8); PG8_BAR; PG8_WAIT_L(0); PG8_MMA(0, 0, At, B0); PG8_BAR; PG8_SCHED;
            PG8_LDB(B1, 0, 1); PG8_STAGE(PG8_SB(0, 0), b2, voffB);
            PG8_BAR; PG8_WAIT_L(0); PG8_MMA(0, 1, At, B1); PG8_BAR;
            PG8_LDA(At, 0, 1); PG8_STAGE(PG8_SA(0, 0), a2, voffA);
            PG8_BAR; PG8_WAIT_L(0); PG8_MMA(1, 0, At, B0); PG8_BAR; PG8_SCHED;
            PG8_STAGE(PG8_SB(0, 1), b2 + hstep, voffB);
            PG8_WAIT_V(6); PG8_BAR; PG8_MMA(1, 1, At, B1); PG8_BAR;
            PG8_LDB(B0, 1, 0); PG8_SCHED; PG8_LDA(At, 1, 0); PG8_STAGE(PG8_SA(0, 1), a2 + hstep, voffA);
            PG8_WAIT_L(8); PG8_BAR; PG8_WAIT_L(0); PG8_MMA(0, 0, At, B0); PG8_BAR; PG8_SCHED;
            PG8_LDB(B1, 1, 1); PG8_STAGE(PG8_SB(1, 0), b3, voffB);
            PG8_BAR; PG8_WAIT_L(0); PG8_MMA(0, 1, At, B1); PG8_BAR;
            PG8_LDA(At, 1, 1); PG8_STAGE(PG8_SA(1, 0), a3, voffA);
            PG8_BAR; PG8_WAIT_L(0); PG8_MMA(1, 0, At, B0); PG8_BAR; PG8_SCHED;
            PG8_STAGE(PG8_SB(1, 1), b3 + hstep, voffB);
            PG8_WAIT_V(6); PG8_BAR; PG8_MMA(1, 1, At, B1); PG8_BAR;
            }
        }
        if constexpr (ALIGN_EPI) { if (wr == 0) PG8_BAR; }
        if constexpr (!Epi::AFTER_DRAIN) { E(acc, cur, wr, wc, fr, fq); S.done(cur); }
        if (!has_next) break;
#pragma unroll
        for (int a = 0; a < 2; ++a)
#pragma unroll
            for (int b = 0; b < 2; ++b)
#pragma unroll
                for (int m = 0; m < 4; ++m)
#pragma unroll
                    for (int n = 0; n < 2; ++n) acc[a][b][m][n] = (f32x4){0.f, 0.f, 0.f, 0.f};
        cur = nxt; cA = nA; cB = nB; ++ui;
        if constexpr (ALIGN_EPI) { if (wr == 1) PG8_BAR; }
    }
    PG8_WAIT_V(0);
    if constexpr (!ALIGN_EPI) { if (wr == 0) PG8_BAR; }
    PG8_BAR;
    if constexpr (Epi::AFTER_DRAIN) { E.fused(acc, cur, wr, wc, fr, fq, lds, wid, lane); S.done(cur); }
#undef PG8_SA
#undef PG8_SB
#undef PG8_STAGE
#undef PG8_LDA
#undef PG8_LDB
#undef PG8_MMA
#undef PG8_WAIT_V
#undef PG8_WAIT_L
#undef PG8_BAR
#undef PG8_SCHED
}
}


constexpr int DM = 1024, NB_P = 8, T_P = 2048, NB_S = 32, T_S = 32, PAST = 1024;
constexpr int MP = NB_P * T_P, MS = NB_S * T_S, MT = MP + MS;
constexpr int LS = PAST + T_S;
constexpr int SHIFTW = 1696, NZ = 3328, ZRW = 1632, DFF = 4096;
constexpr float QSCALE = 0.125f * 1.4426950408889634f;
constexpr float WISCALE = 0.35355339059327373f * 0.125f;
constexpr size_t OFF_Y = 0, OFF_KP = 17825792, OFF_VP = OFF_KP + 4194304, OFF_KIP = OFF_VP + 4194304, OFF_WKVP = OFF_KIP + 1048576, OFF_SHP = OFF_WKVP + 262144,
                 OFF_KS = OFF_SHP + 13568, OFF_VS = OFF_KS + 262144, OFF_KIS = OFF_VS + 262144, OFF_WKVS = OFF_KIS + 65536, OFF_SHS = OFF_WKVS + 1048576, OUT_TOTAL = OFF_SHS + 54272;
constexpr size_t MiB = 1u << 20;
constexpr size_t WS_CTL = 0, CTL_BYTES = 1 * MiB;
constexpr size_t WS_WIN = 1 * MiB, WS_WOUT = 8 * MiB, WS_W1 = 10 * MiB, WS_W2 = 18 * MiB;
constexpr size_t WS_W2T = 26 * MiB, WS_A2T = WS_W2T + 32768, WS_G2T = WS_A2T + 32768, WS_WI = 27 * MiB, WS_BONUS = 28 * MiB;
constexpr size_t WS_XB = 30 * MiB;
constexpr size_t WS_ZS = 66 * MiB;
constexpr size_t WS_R = 123 * MiB;
constexpr size_t WS_ZR = WS_R, WS_KBP = 178 * MiB, WS_VTP = 186 * MiB, WS_KIP = 194 * MiB, WS_KBS = 196 * MiB, WS_VTS = 213 * MiB, WS_KIS = 230 * MiB;
constexpr size_t WS_OW = WS_R, WS_OKK = 157 * MiB, WS_OB = 174 * MiB, WS_OKM = 191 * MiB, WS_OR = 208 * MiB, WS_OV = 225 * MiB;
constexpr size_t WS_ACT = 66 * MiB, WS_HB = 202 * MiB, WS_SLAB = 238 * MiB, WS_END = 256 * MiB;
static_assert(WS_ZS + (size_t)MT * SHIFTW * 2 <= WS_R && WS_ZR + (size_t)MT * ZRW * 2 <= WS_KBP && WS_KBS + (size_t)NB_S * LS * 256 * 2 <= WS_VTS && WS_VTS + (size_t)NB_S * 256 * LS * 2 <= WS_KIS &&
              WS_KIS + (size_t)NB_S * LS * 64 * 2 <= WS_END && WS_OV + (size_t)MT * 512 * 2 <= WS_END && WS_ACT + (size_t)MT * DFF * 2 <= WS_HB && WS_HB + (size_t)MT * DM * 2 <= WS_END, "d_ws map");
constexpr size_t SC_Q = 0, SC_QI = (size_t)MT * 512 / 2, SC_Y = 0, SC_G = (size_t)MT * 512;
constexpr int CW_QATT = 64, CW_SS = 16384;

typedef unsigned short bf16;
typedef short bf16x8 __attribute__((ext_vector_type(8)));
typedef float f32x4 __attribute__((ext_vector_type(4)));
typedef float f32x16 __attribute__((ext_vector_type(16)));
typedef unsigned u32x4 __attribute__((ext_vector_type(4)));
typedef unsigned u32x2 __attribute__((ext_vector_type(2)));

__device__ __forceinline__ unsigned f2bf(float f) { unsigned u = __float_as_uint(f); return (u + 0x7fffu + ((u >> 16) & 1u)) >> 16; }
__device__ __forceinline__ unsigned pk2(float lo, float hi) { return f2bf(lo) | (f2bf(hi) << 16); }
__device__ __forceinline__ float bflo(unsigned w) { return __uint_as_float(w << 16); }
__device__ __forceinline__ float bfhi(unsigned w) { return __uint_as_float(w & 0xffff0000u); }
__device__ __forceinline__ float bf1(bf16 b) { return __uint_as_float((unsigned)b << 16); }
__device__ __forceinline__ void unpack8(const u32x4 w, float* x) { x[0] = bflo(w.x); x[1] = bfhi(w.x); x[2] = bflo(w.y); x[3] = bfhi(w.y); x[4] = bflo(w.z); x[5] = bfhi(w.z); x[6] = bflo(w.w); x[7] = bfhi(w.w); }
__device__ __forceinline__ u32x4 pack8(const float* x) { u32x4 w; w.x = pk2(x[0], x[1]); w.y = pk2(x[2], x[3]); w.z = pk2(x[4], x[5]); w.w = pk2(x[6], x[7]); return w; }
__device__ __forceinline__ float wave_sum(float v) {
#pragma unroll
    for (int o = 1; o < 64; o <<= 1) v += __shfl_xor(v, o);
    return v;
}
template <int CTRL> __device__ __forceinline__ float dppmov(float x) { return __builtin_bit_cast(float, __builtin_amdgcn_update_dpp(0, __builtin_bit_cast(int, x), CTRL, 0xf, 0xf, true)); }
__device__ __forceinline__ float sum16(float x) {
    x += dppmov<0xB1>(x); x += dppmov<0x4E>(x); x += dppmov<0x141>(x); x += dppmov<0x140>(x); return x;
}
__device__ __forceinline__ int crow(int r, int hi) { return (r & 3) + 8 * (r >> 2) + 4 * hi; }

struct Args { const float* in[28]; float* out; unsigned char* ws; int ph_lo, ph_hi; };

__device__ __forceinline__ void tr_item(const float* W, int K, int N, const float* gain, bf16* WT, int jr0, int c0, int nvalid, int k0, float* scr, int lane) {
#pragma unroll 8
    for (int i = 0; i < 32; ++i) { const int kk = 2 * i + (lane >> 5), n = lane & 31;
        float v = (n < nvalid) ? W[(size_t)(k0 + kk) * N + c0 + n] : 0.f; if (gain) v *= gain[k0 + kk]; scr[kk * 33 + n] = v; }
    __builtin_amdgcn_s_waitcnt(0xC07F); asm volatile("" ::: "memory");
    const int c = lane & 7;
#pragma unroll
    for (int j = 0; j < 4; ++j) { const int n = (lane >> 3) + 8 * j; const float* s = scr + (8 * c) * 33 + n;
        u32x4 o; o.x = pk2(s[0 * 33], s[1 * 33]); o.y = pk2(s[2 * 33], s[3 * 33]); o.z = pk2(s[4 * 33], s[5 * 33]); o.w = pk2(s[6 * 33], s[7 * 33]);
        *(u32x4*)(WT + (size_t)(jr0 + n) * K + k0 + 8 * c) = o; }
    __builtin_amdgcn_s_waitcnt(0xC07F); asm volatile("" ::: "memory");
}
__device__ __forceinline__ void p0_prologue(const Args& a, unsigned char* lds, int tid) {
    const int lane = tid & 63, wave = tid >> 6, gw = blockIdx.x * 8 + wave, NGW = gridDim.x * 8;
    float* scr = (float*)(lds + wave * 17408);
    unsigned char* ws = a.ws;
    constexpr int I_IN = (NZ / 32) * (DM / 64), I_OUT = (DM / 32) * (DM / 64), I_F1 = (DFF / 32) * (DM / 64), I_F2 = (DM / 32) * (DFF / 64);
    for (int it = gw; it < I_IN + I_OUT + I_F1 + I_F2; it += NGW) {
        int r = it;
        if (r < I_IN) { const int jb = r % (NZ / 32), kb = r / (NZ / 32), j0 = jb * 32; int c0, nv;
            if (j0 < 1600) { c0 = j0; nv = 32; } else if (j0 < 3296) { c0 = 1608 + (j0 - 1600); nv = 32; } else { c0 = 1600; nv = 8; }
            tr_item(a.in[8], DM, 3304, a.in[7], (bf16*)(ws + WS_WIN), j0, c0, nv, kb * 64, scr, lane); continue; }
        r -= I_IN;
        if (r < I_OUT) { const int jb = r % (DM / 32), kb = r / (DM / 32); tr_item(a.in[24], DM, DM, nullptr, (bf16*)(ws + WS_WOUT), jb * 32, jb * 32, 32, kb * 64, scr, lane); continue; }
        r -= I_OUT;
        if (r < I_F1) { const int jb = r % (DFF / 32), kb = r / (DFF / 32); tr_item(a.in[26], DM, DFF, a.in[25], (bf16*)(ws + WS_W1), jb * 32, jb * 32, 32, kb * 64, scr, lane); continue; }
        r -= I_F1;
        { const int jb = r % (DM / 32), kb = r / (DM / 32); tr_item(a.in[27], DFF, DM, nullptr, (bf16*)(ws + WS_W2), jb * 32, jb * 32, 32, kb * 64, scr, lane); }
    }
    { const int gt = blockIdx.x * 512 + tid, NT = gridDim.x * 512;
      bf16* w2t = (bf16*)(ws + WS_W2T); bf16* a2t = (bf16*)(ws + WS_A2T); bf16* g2t = (bf16*)(ws + WS_G2T);
      for (int i = gt; i < 512 * 32; i += NT) { const int n = i >> 5, k = i & 31; w2t[i] = (bf16)f2bf(a.in[15][k * 512 + n]); a2t[i] = (bf16)f2bf(a.in[17][k * 512 + n]); }
      for (int i = gt; i < 512 * 96; i += NT) { const int n = i / 96, k = i % 96; g2t[i] = (bf16)f2bf(a.in[18][k * 512 + n]); } }
    { f32x4 v[4], nx[4]; int m = gw;
      if (m < MT) { const f32x4* xr = (const f32x4*)((m < MP) ? a.in[0] + (size_t)m * DM : a.in[1] + (size_t)(m - MP) * DM) + lane;
#pragma unroll
          for (int j = 0; j < 4; ++j) v[j] = xr[64 * j]; }
      for (; m < MT; m += NGW) {
        const int mn = m + NGW;
        if (mn < MT) { const f32x4* xr = (const f32x4*)((mn < MP) ? a.in[0] + (size_t)mn * DM : a.in[1] + (size_t)(mn - MP) * DM) + lane;
#pragma unroll
            for (int j = 0; j < 4; ++j) nx[j] = xr[64 * j]; }
        float s = 0.f;
#pragma unroll
        for (int j = 0; j < 4; ++j) s += (v[j].x * v[j].x + v[j].y * v[j].y) + (v[j].z * v[j].z + v[j].w * v[j].w);
        const float rs = rsqrtf(wave_sum(s) * (1.f / DM) + 1e-6f);
        u32x2* o8 = (u32x2*)((bf16*)(ws + WS_XB) + (size_t)m * DM) + lane;
#pragma unroll
        for (int j = 0; j < 4; ++j) { u32x2 o; o.x = pk2(v[j].x * rs, v[j].y * rs); o.y = pk2(v[j].z * rs, v[j].w * rs); o8[64 * j] = o; }
#pragma unroll
        for (int j = 0; j < 4; ++j) v[j] = nx[j];
      } }
    for (int r4 = gw; r4 < NB_S * PAST / 4; r4 += NGW) {
        f32x4 v[4];
#pragma unroll
        for (int j = 0; j < 4; ++j) v[j] = ((const f32x4*)(a.in[2] + (size_t)(4 * r4 + j) * 256))[lane];
#pragma unroll
        for (int j = 0; j < 4; ++j) { const int rix = 4 * r4 + j, b = rix >> 10, p = rix & 1023; u32x2 o; o.x = pk2(v[j].x, v[j].y); o.y = pk2(v[j].z, v[j].w);
            ((u32x2*)((bf16*)(ws + WS_KBS) + ((size_t)b * LS + p) * 256))[lane] = o; }
    }
    for (int r4 = gw; r4 < NB_S * PAST / 4; r4 += NGW) {
        const int rix = r4 * 4 + (lane >> 4), b = rix >> 10, p = rix & 1023; const f32x4 v = ((const f32x4*)(a.in[4] + (size_t)rix * 64))[lane & 15];
        u32x2 o; o.x = pk2(v.x, v.y); o.y = pk2(v.z, v.w); ((u32x2*)((bf16*)(ws + WS_KIS) + ((size_t)b * LS + p) * 64))[lane & 15] = o;
    }
    for (int it = gw; it < NB_S * 4 * 16; it += NGW) {
        const int kb = it & 15, g = (it >> 4) & 3, b = it >> 6;
        const float* src = a.in[3] + ((size_t)b * PAST + kb * 64) * 256 + g * 64;
#pragma unroll 8
        for (int i = 0; i < 64; ++i) scr[i * 65 + lane] = src[(size_t)i * 256 + lane];
        __builtin_amdgcn_s_waitcnt(0xC07F); asm volatile("" ::: "memory");
        bf16* dst = (bf16*)(ws + WS_VTS) + (((size_t)b * (LS / 32) + 2 * kb + (lane >> 5)) * 256 + g * 64) * 32 + (lane & 31);
#pragma unroll 8
        for (int d = 0; d < 64; ++d) dst[d * 32] = (bf16)f2bf(scr[lane * 65 + d]);
        __builtin_amdgcn_s_waitcnt(0xC07F); asm volatile("" ::: "memory");
    }
}

__device__ __forceinline__ void p2_post(const Args& a, unsigned char* lds, int tid) {
    unsigned char* ws = a.ws; float* out = a.out;
    const bf16* ZR = (const bf16*)(ws + WS_ZR); const bf16* ZS = (const bf16*)(ws + WS_ZS);
    bf16* Q = (bf16*)(out + SC_Q); bf16* QI = (bf16*)(out + SC_QI);
    float* cs = (float*)lds;
    bf16* vt = (bf16*)(lds + 4096);
    const int g8 = tid >> 3, sub = tid & 7;
    const float* qg = a.in[9]; const float* kg = a.in[10]; const float* lng = a.in[11]; const float* lnb = a.in[12];
    for (int unit = blockIdx.x; unit < 2 * (MT / 64); unit += gridDim.x) {
        const int tile = unit >> 1, part = unit & 1, hb0 = part ? 12 : 0, hb1 = part ? 25 : 12;
        const int m0 = tile * 64;
        { const int m = m0 + g8, pos = (m < MP) ? (m & (T_P - 1)) : (PAST + ((m - MP) & (T_S - 1)));
          const float inv = powf(500000.0f, -(float)sub * 0.125f); const float ang = (float)pos * inv; float s, c; sincosf(ang, &s, &c);
          cs[g8 * 16 + sub] = c; cs[g8 * 16 + 8 + sub] = s; }
        __syncthreads();
        const int m = m0 + g8;
        const bool isp = m < MP; const int ms = m - MP;
        float cc[8], ss[8];
#pragma unroll
        for (int j = 0; j < 8; ++j) { cc[j] = cs[g8 * 16 + j]; ss[j] = cs[g8 * 16 + 8 + j]; }
        const size_t kvrow = isp ? (size_t)m : ((size_t)(ms >> 5) * LS + PAST + (ms & 31));
        bf16* KB = (bf16*)(ws + (isp ? WS_KBP : WS_KBS)); bf16* KIb = (bf16*)(ws + (isp ? WS_KIP : WS_KIS));
        u32x4 xnext = *(const u32x4*)(ZR + (size_t)m * ZRW + hb0 * 64 + 8 * sub);
        for (int hb = hb0; hb < hb1; ++hb) {
            float x[8]; unpack8(xnext, x);
            if (hb + 1 < hb1) xnext = *(const u32x4*)(ZR + (size_t)m * ZRW + (hb + 1) * 64 + 8 * sub);
            if (hb < 12) {
                float s2 = 0.f;
#pragma unroll
                for (int j = 0; j < 8; ++j) s2 += x[j] * x[j];
                s2 += __shfl_xor(s2, 1); s2 += __shfl_xor(s2, 2); s2 += __shfl_xor(s2, 4);
                const float rinv = rsqrtf(s2 * (1.f / 64.f) + 1e-6f); const float* gn = (hb < 8 ? qg : kg) + 8 * sub;
                float y[8], o[8];
#pragma unroll
                for (int j = 0; j < 8; ++j) y[j] = x[j] * rinv * gn[j];
#pragma unroll
                for (int j = 0; j < 8; ++j) { const float p = __shfl_xor(y[j], 1); o[j] = sub == 0 ? y[j] * cc[j] - p * ss[j] : (sub == 1 ? y[j] * cc[j] + p * ss[j] : y[j]); }
                if (hb < 8) {
#pragma unroll
                    for (int j = 0; j < 8; ++j) o[j] *= QSCALE;
                    *(u32x4*)(Q + (size_t)m * 512 + hb * 64 + 8 * sub) = pack8(o);
                } else { const int g = hb - 8;
                    float* ko = out + (isp ? OFF_KP + (size_t)m * 256 : OFF_KS + (size_t)ms * 256) + g * 64 + 8 * sub;
                    *(f32x4*)ko = (f32x4){o[0], o[1], o[2], o[3]}; *(f32x4*)(ko + 4) = (f32x4){o[4], o[5], o[6], o[7]};
                    *(u32x4*)(KB + kvrow * 256 + g * 64 + 8 * sub) = pack8(o); }
            } else if (hb < 16) { const int g = hb - 12;
                float* vo = out + (isp ? OFF_VP + (size_t)m * 256 : OFF_VS + (size_t)ms * 256) + g * 64 + 8 * sub;
                *(f32x4*)vo = (f32x4){x[0], x[1], x[2], x[3]}; *(f32x4*)(vo + 4) = (f32x4){x[4], x[5], x[6], x[7]};
                unsigned* vd = (unsigned*)(vt + g8 * 258 + g * 64 + 8 * sub);
                vd[0] = pk2(x[0], x[1]); vd[1] = pk2(x[2], x[3]); vd[2] = pk2(x[4], x[5]); vd[3] = pk2(x[6], x[7]);
            } else if (hb < 24) {
                float o[8];
#pragma unroll
                for (int j = 0; j < 8; ++j) { const float p = __shfl_xor(x[j], 1); o[j] = sub == 0 ? x[j] * cc[j] - p * ss[j] : (sub == 1 ? x[j] * cc[j] + p * ss[j] : x[j]); }
                *(u32x4*)(QI + (size_t)m * 512 + (hb - 16) * 64 + 8 * sub) = pack8(o);
            } else {
                float s1 = 0.f;
#pragma unroll
                for (int j = 0; j < 8; ++j) s1 += x[j];
                s1 += __shfl_xor(s1, 1); s1 += __shfl_xor(s1, 2); s1 += __shfl_xor(s1, 4);
                const float mu = s1 * (1.f / 64.f); float s2 = 0.f;
#pragma unroll
                for (int j = 0; j < 8; ++j) { const float d = x[j] - mu; s2 += d * d; }
                s2 += __shfl_xor(s2, 1); s2 += __shfl_xor(s2, 2); s2 += __shfl_xor(s2, 4);
                const float rinv = rsqrtf(s2 * (1.f / 64.f) + 1e-6f); float y[8], o[8];
#pragma unroll
                for (int j = 0; j < 8; ++j) y[j] = (x[j] - mu) * rinv * lng[8 * sub + j] + lnb[8 * sub + j];
#pragma unroll
                for (int j = 0; j < 8; ++j) { const float p = __shfl_xor(y[j], 1); o[j] = sub == 0 ? y[j] * cc[j] - p * ss[j] : (sub == 1 ? y[j] * cc[j] + p * ss[j] : y[j]); }
                float* ko = out + (isp ? OFF_KIP + (size_t)m * 64 : OFF_KIS + (size_t)ms * 64) + 8 * sub;
                *(f32x4*)ko = (f32x4){o[0], o[1], o[2], o[3]}; *(f32x4*)(ko + 4) = (f32x4){o[4], o[5], o[6], o[7]};
                *(u32x4*)(KIb + kvrow * 64 + 8 * sub) = pack8(o);
            }
        }
        if (part == 0) ((float*)(ws + WS_WI))[(size_t)m * 8 + sub] = bf1(ZR[(size_t)m * ZRW + 1600 + sub]) * WISCALE;
        __syncthreads();
        if (part == 1) { const int r = tid >> 1, half = tid & 1; unsigned wv[16];
#pragma unroll
          for (int j = 0; j < 16; ++j) wv[j] = (unsigned)vt[(32 * half + 2 * j) * 258 + r] | ((unsigned)vt[(32 * half + 2 * j + 1) * 258 + r] << 16);
          bf16* dst;
          if (m0 < MP) dst = (bf16*)(ws + WS_VTP) + (((size_t)(m0 >> 11) * (T_P / 32) + ((m0 & (T_P - 1)) >> 5) + half) * 256 + r) * 32;
          else { const int b = ((m0 - MP) >> 5) + half; dst = (bf16*)(ws + WS_VTS) + (((size_t)b * (LS / 32) + PAST / 32) * 256 + r) * 32; }
#pragma unroll
          for (int j = 0; j < 4; ++j) ((u32x4*)dst)[j] = (u32x4){wv[4 * j], wv[4 * j + 1], wv[4 * j + 2], wv[4 * j + 3]}; }
        if (part == 0) {} else if (m0 < MP) { if ((m0 & (T_P - 1)) == T_P - 64) { const int b = m0 >> 11; const bf16* zr = ZS + (size_t)(m0 + 63) * SHIFTW;
                for (int c = tid; c < SHIFTW; c += 512) out[OFF_SHP + (size_t)b * SHIFTW + c] = bf1(zr[c]); } }
        else { for (int h2 = 0; h2 < 2; ++h2) { const int b = ((m0 - MP) >> 5) + h2; const bf16* zr = ZS + (size_t)(m0 + 32 * h2 + 31) * SHIFTW;
                for (int c = tid; c < SHIFTW; c += 512) out[OFF_SHS + (size_t)b * SHIFTW + c] = bf1(zr[c]); } }
        __syncthreads();
    }
}

constexpr int ATT_UNITS = 544;
constexpr int MASK_PITCH = 65;
#define MFMA32(a, b, c) __builtin_amdgcn_mfma_f32_32x32x16_bf16((a), (b), (c), 0, 0, 0)

__device__ __forceinline__ float half_sum32(float v) { v += __shfl_xor(v, 1); v += __shfl_xor(v, 2); v += __shfl_xor(v, 4); v += __shfl_xor(v, 8); v += __shfl_xor(v, 16); return v; }
__device__ __forceinline__ float half_min32(float v) { v = fminf(v, __shfl_xor(v, 1)); v = fminf(v, __shfl_xor(v, 2)); v = fminf(v, __shfl_xor(v, 4)); v = fminf(v, __shfl_xor(v, 8)); v = fminf(v, __shfl_xor(v, 16)); return v; }
__device__ __forceinline__ float half_max32(float v) { v = fmaxf(v, __shfl_xor(v, 1)); v = fmaxf(v, __shfl_xor(v, 2)); v = fmaxf(v, __shfl_xor(v, 4)); v = fmaxf(v, __shfl_xor(v, 8)); v = fmaxf(v, __shfl_xor(v, 16)); return v; }
__device__ __forceinline__ int half_sum32i(int v) { v += __shfl_xor(v, 1); v += __shfl_xor(v, 2); v += __shfl_xor(v, 4); v += __shfl_xor(v, 8); v += __shfl_xor(v, 16); return v; }

#define LAS3 __attribute__((address_space(3)))
constexpr int A_RING1 = 0, A_SCL = 24576, A_RING2 = 24576, A_MASK = 0, A_LSUM = 8320, A_UNIT = 9344;
__device__ __forceinline__ void p3_attention(const Args& a, unsigned char* lds, int tid, int rep) {
    unsigned char* ws = a.ws; float* out = a.out;
    const bf16* Q = (const bf16*)(out + SC_Q); const bf16* QI = (const bf16*)(out + SC_QI); const float* WI = (const float*)(ws + WS_WI);
    bf16* O = (bf16*)(ws + WS_XB);
    unsigned* maskw = (unsigned*)(lds + A_MASK);
    float* lsum = (float*)(lds + A_LSUM);
    int* s_unit = (int*)(lds + A_UNIT);
    typedef float f32x2_t __attribute__((ext_vector_type(2)));
    f32x2_t* scl = (f32x2_t*)(lds + A_SCL) + (size_t)(tid >> 6) * 2048 + (tid & 63);
    unsigned* qctr = (unsigned*)(ws + WS_CTL) + CW_QATT + 64 * rep;
    const int l = tid & 63, w = __builtin_amdgcn_readfirstlane(tid >> 6), rho = l & 31, hi = l >> 5;
    LAS3 unsigned char* ldsb = (LAS3 unsigned char*)lds;
    for (;;) {
        if (tid == 0) *s_unit = (int)atomicAdd(qctr, 1u);
        __syncthreads();
        const int p = *s_unit;
        __syncthreads();
        if (p >= ATT_UNITS) break;
        int m0, nkt, vpitch; const bf16 *KB, *VT, *KI; bool need_idx;
        { int c = -1, b, half = 0;
          if (p < 256) { c = 31 - (p >> 4); b = (p & 15) >> 1; half = p & 1; }
          else if (p < 288) { b = p - 256; }
          else { const int pp = p - 288; c = 15 - (pp >> 4); b = (pp & 15) >> 1; half = pp & 1; }
          if (c >= 0) { m0 = b * T_P + 64 * c + 32 * half; nkt = 2 * (c + 1); vpitch = T_P; need_idx = c >= 4;
              KB = (const bf16*)(ws + WS_KBP) + (size_t)b * T_P * 256; VT = (const bf16*)(ws + WS_VTP) + (size_t)b * (T_P / 32) * 8192; KI = (const bf16*)(ws + WS_KIP) + (size_t)b * T_P * 64; }
          else { m0 = MP + 32 * b; nkt = LS / 32; vpitch = LS; need_idx = true;
              KB = (const bf16*)(ws + WS_KBS) + (size_t)b * LS * 256; VT = (const bf16*)(ws + WS_VTS) + (size_t)b * (LS / 32) * 8192; KI = (const bf16*)(ws + WS_KIS) + (size_t)b * LS * 64; } }
        if (need_idx) {
            const int tokA = 4 * w + 2 * ((rho >> 2) & 1) + (rho >> 4), headA = (rho & 3) + 4 * ((rho >> 3) & 1);
            bf16x8 qa[4];
#pragma unroll
            for (int ks = 0; ks < 4; ++ks) qa[ks] = *(const bf16x8*)(QI + (size_t)(m0 + tokA) * 512 + headA * 64 + 16 * ks + 8 * hi);
            float wv[16];
#pragma unroll
            for (int r = 0; r < 16; ++r) wv[r] = WI[(size_t)(m0 + 4 * w + 2 * hi + (r >> 3)) * 8 + (r & 7)];
            asm volatile("" :: "v"(qa[0]), "v"(qa[1]), "v"(qa[2]), "v"(qa[3]));
#pragma unroll
            for (int r = 0; r < 16; ++r) asm volatile("" :: "v"(wv[r]));
            asm volatile("s_waitcnt vmcnt(0)" ::: "memory");
            float sc0[32], sc1[32];
            const int nb = (nkt + 1) >> 1;
            const int sr = 8 * w + (l >> 3), scn = (l & 7) ^ ((sr >> 1) & 7);
            const unsigned char* ksrc = (const unsigned char*)KI + (size_t)sr * 128 + 16 * scn;
#define KI_STAGE(it_) __builtin_amdgcn_global_load_lds((const unsigned*)(ksrc + (size_t)(it_) * 8192), (LAS3 unsigned*)(ldsb + A_RING1 + ((it_) % 3) * 8192 + w * 1024), 16, 0, 0)
            for (int rp1 = 0; rp1 <= PROBE_A1; ++rp1) {
            if (rp1) __syncthreads();
            KI_STAGE(0); if (1 < nb) KI_STAGE(1);
#pragma unroll
            for (int it = 0; it < 32; ++it) {
                if (it < nb) {
                    if (it + 1 < nb) asm volatile("s_waitcnt vmcnt(1) lgkmcnt(0)\n\ts_barrier" ::: "memory"); else asm volatile("s_waitcnt vmcnt(0) lgkmcnt(0)\n\ts_barrier" ::: "memory");
                    if (it + 2 < nb) KI_STAGE(it + 2);
                    const unsigned char* tb = lds + A_RING1 + (it % 3) * 8192;
#pragma unroll
                    for (int k2 = 0; k2 < 2; ++k2) { const int kt = 2 * it + k2;
                        if (kt < nkt) {
                            const int r = 32 * k2 + rho; const unsigned char* rowp = tb + r * 128; const int sw = (r >> 1) & 7;
                            f32x16 acc = {0.f, 0.f, 0.f, 0.f, 0.f, 0.f, 0.f, 0.f, 0.f, 0.f, 0.f, 0.f, 0.f, 0.f, 0.f, 0.f};
#pragma unroll
                            for (int ks = 0; ks < 4; ++ks) acc = MFMA32(qa[ks], *(const bf16x8*)(rowp + 16 * ((2 * ks + hi) ^ sw)), acc);
                            float s0 = 0.f, s1 = 0.f;
#pragma unroll
                            for (int r2 = 0; r2 < 8; ++r2) { s0 += wv[r2] * fmaxf(acc[r2], 0.f); s1 += wv[8 + r2] * fmaxf(acc[8 + r2], 0.f); }
                            if (kt < 32) { sc0[kt & 31] = s0; sc1[kt & 31] = s1; } else scl[(kt - 32) * 64] = (f32x2_t){s0, s1};
                        } else if (kt < 32) { sc0[kt & 31] = -3.0e38f; sc1[kt & 31] = -3.0e38f; }
                    }
                } else { if (2 * it < 32) { sc0[(2 * it) & 31] = -3.0e38f; sc1[(2 * it) & 31] = -3.0e38f; sc0[(2 * it + 1) & 31] = -3.0e38f; sc1[(2 * it + 1) & 31] = -3.0e38f; } }
            }
            }
#undef KI_STAGE
            __syncthreads();
            float mn0 = 3.0e38f, mx0 = -3.0e38f, mn1 = 3.0e38f, mx1 = -3.0e38f; int cp0 = 0, cz0 = 0, cp1 = 0, cz1 = 0;
#pragma unroll
            for (int kt = 0; kt < 64; ++kt) if (kt < nkt) { float v0, v1; if (kt < 32) { v0 = sc0[kt & 31]; v1 = sc1[kt & 31]; } else { const f32x2_t t2 = scl[(kt - 32) * 64]; v0 = t2.x; v1 = t2.y; }
                mn0 = fminf(mn0, v0); mx0 = fmaxf(mx0, v0); mn1 = fminf(mn1, v1); mx1 = fmaxf(mx1, v1);
                cp0 += v0 > 0.f ? 1 : 0; cz0 += v0 == 0.f ? 1 : 0; cp1 += v1 > 0.f ? 1 : 0; cz1 += v1 == 0.f ? 1 : 0; }
            mn0 = half_min32(mn0); mx0 = half_max32(mx0); mn1 = half_min32(mn1); mx1 = half_max32(mx1);
            cp0 = half_sum32i(cp0); cz0 = half_sum32i(cz0); cp1 = half_sum32i(cp1); cz1 = half_sum32i(cz1);
            float lo0, hi0, lo1, hi1, thr0 = 0.f, thr1 = 0.f; int ch0, ch1, nt0 = 0, nt1 = 0; bool fin0, fin1;
            for (int rp2 = 0; rp2 <= PROBE_A2; ++rp2) {
            fin0 = false; fin1 = false; ch0 = 0; ch1 = 0;
            if (cp0 >= 256) { lo0 = 0.f; hi0 = mx0; if (cp0 == 256) { fin0 = true; thr0 = 0.f; nt0 = 0; } }
            else if (cp0 + cz0 >= 256) { lo0 = 0.f; hi0 = 0.f; fin0 = true; thr0 = 0.f; nt0 = 256 - cp0; }
            else { lo0 = mn0 - 1.0f; hi0 = 0.f; ch0 = cp0; }
            if (cp1 >= 256) { lo1 = 0.f; hi1 = mx1; if (cp1 == 256) { fin1 = true; thr1 = 0.f; nt1 = 0; } }
            else if (cp1 + cz1 >= 256) { lo1 = 0.f; hi1 = 0.f; fin1 = true; thr1 = 0.f; nt1 = 256 - cp1; }
            else { lo1 = mn1 - 1.0f; hi1 = 0.f; ch1 = cp1; }
            asm volatile("" : "+v"(lo0), "+v"(lo1));
            for (int iter = 0; iter < 64; ++iter) {
                const float mid0 = lo0 + 0.5f * (hi0 - lo0), mid1 = lo1 + 0.5f * (hi1 - lo1);
                int c0 = 0, c1 = 0;
#pragma unroll
                for (int g = 0; g < 4; ++g) if (8 * g < nkt) {
#pragma unroll
                    for (int k8 = 0; k8 < 8; ++k8) { c0 += sc0[8 * g + k8] > mid0 ? 1 : 0; c1 += sc1[8 * g + k8] > mid1 ? 1 : 0; } }
                for (int kt = 32; kt < nkt; kt += 8) {
                    f32x2_t t8[8];
#pragma unroll
                    for (int u = 0; u < 8; ++u) t8[u] = scl[(kt + u - 32) * 64];
#pragma unroll
                    for (int u = 0; u < 8; ++u) if (kt + u < nkt) { c0 += t8[u].x > mid0 ? 1 : 0; c1 += t8[u].y > mid1 ? 1 : 0; } }
                c0 = half_sum32i(c0); c1 = half_sum32i(c1);
                if (!fin0) { if (!(mid0 > lo0 && mid0 < hi0)) { fin0 = true; thr0 = hi0; nt0 = 256 - ch0; }
                             else if (c0 == 256) { fin0 = true; thr0 = mid0; nt0 = 0; } else if (c0 > 256) lo0 = mid0; else { hi0 = mid0; ch0 = c0; } }
                if (!fin1) { if (!(mid1 > lo1 && mid1 < hi1)) { fin1 = true; thr1 = hi1; nt1 = 256 - ch1; }
                             else if (c1 == 256) { fin1 = true; thr1 = mid1; nt1 = 0; } else if (c1 > 256) lo1 = mid1; else { hi1 = mid1; ch1 = c1; } }
                if (__all(fin0 && fin1)) break;
            }
            }
            const bool any_tie = __any(nt0 > 0 || nt1 > 0);
            int run0 = 0, run1 = 0; const unsigned below = (1u << rho) - 1u;
#pragma unroll
            for (int kt = 0; kt < 64; ++kt) if (kt < nkt) {
                float v0, v1; if (kt < 32) { v0 = sc0[kt & 31]; v1 = sc1[kt & 31]; } else { const f32x2_t t2 = scl[(kt - 32) * 64]; v0 = t2.x; v1 = t2.y; }
                bool p0 = v0 > thr0, p1 = v1 > thr1;
                if (any_tie) {
                    const bool e0 = nt0 > 0 && v0 == thr0, e1 = nt1 > 0 && v1 == thr1;
                    const unsigned long long be0 = __ballot(e0), be1 = __ballot(e1);
                    const unsigned h0 = (unsigned)(be0 >> (32 * hi)), h1 = (unsigned)(be1 >> (32 * hi));
                    p0 = p0 || (e0 && (run0 + __popc(h0 & below)) < nt0); p1 = p1 || (e1 && (run1 + __popc(h1 & below)) < nt1);
                    run0 += __popc(h0); run1 += __popc(h1);
                }
                const unsigned long long b0 = __ballot(p0), b1 = __ballot(p1);
                if (l == 0) { maskw[(4 * w + 0) * MASK_PITCH + kt] = (unsigned)b0; maskw[(4 * w + 1) * MASK_PITCH + kt] = (unsigned)b1; }
                if (l == 32) { maskw[(4 * w + 2) * MASK_PITCH + kt] = (unsigned)(b0 >> 32); maskw[(4 * w + 3) * MASK_PITCH + kt] = (unsigned)(b1 >> 32); }
            }
        }
        __syncthreads();
        {
            const int g = w >> 1;
            bf16x8 qb[4];
#pragma unroll
            for (int ks = 0; ks < 4; ++ks) qb[ks] = *(const bf16x8*)(Q + (size_t)(m0 + rho) * 512 + w * 64 + 16 * ks + 8 * hi);
            asm volatile("" :: "v"(qb[0]), "v"(qb[1]), "v"(qb[2]), "v"(qb[3]));
            asm volatile("s_waitcnt vmcnt(0)" ::: "memory");
            const unsigned char* ksrc[2]; const unsigned char* vsrc[2];
#pragma unroll
            for (int k = 0; k < 2; ++k) { const int i = (k * 8 + w) * 64 + l; const int r = i >> 5, c = i & 31; ksrc[k] = (const unsigned char*)KB + (size_t)r * 512 + 16 * (c ^ (r & 15));
                const int R = i >> 2, cv = i & 3; vsrc[k] = (const unsigned char*)VT + (size_t)R * 64 + 16 * (cv ^ ((R >> 2) & 3)); }
#define KV_STAGE(t_) do { const int bo_ = A_RING2 + ((t_) % 3) * 32768 + w * 1024; \
            __builtin_amdgcn_global_load_lds((const unsigned*)(ksrc[0] + (size_t)(t_) * 16384), (LAS3 unsigned*)(ldsb + bo_), 16, 0, 0); \
            __builtin_amdgcn_global_load_lds((const unsigned*)(ksrc[1] + (size_t)(t_) * 16384), (LAS3 unsigned*)(ldsb + bo_ + 8192), 16, 0, 0); \
            __builtin_amdgcn_global_load_lds((const unsigned*)(vsrc[0] + (size_t)(t_) * 16384), (LAS3 unsigned*)(ldsb + bo_ + 16384), 16, 0, 0); \
            __builtin_amdgcn_global_load_lds((const unsigned*)(vsrc[1] + (size_t)(t_) * 16384), (LAS3 unsigned*)(ldsb + bo_ + 24576), 16, 0, 0); } while (0)
            f32x16 o0 = {0.f, 0.f, 0.f, 0.f, 0.f, 0.f, 0.f, 0.f, 0.f, 0.f, 0.f, 0.f, 0.f, 0.f, 0.f, 0.f}, o1 = o0; float psum = 0.f;
            const int ksw = rho & 15;
            const int vR0 = g * 64 + rho, vR1 = vR0 + 32; const int vs0 = (vR0 >> 2) & 3, vs1 = (vR1 >> 2) & 3;
            for (int rp3 = 0; rp3 <= PROBE_A3; ++rp3) {
            if (rp3) __syncthreads();
            KV_STAGE(0); if (1 < nkt) KV_STAGE(1);
            for (int kt = 0; kt < nkt; ++kt) {
                if (kt + 1 < nkt) asm volatile("s_waitcnt vmcnt(4) lgkmcnt(0)\n\ts_barrier" ::: "memory"); else asm volatile("s_waitcnt vmcnt(0) lgkmcnt(0)\n\ts_barrier" ::: "memory");
                if (kt + 2 < nkt) KV_STAGE(kt + 2);
                const unsigned char* kbuf = lds + A_RING2 + (kt % 3) * 32768; const unsigned char* vbuf = kbuf + 16384;
                f32x16 st = {0.f, 0.f, 0.f, 0.f, 0.f, 0.f, 0.f, 0.f, 0.f, 0.f, 0.f, 0.f, 0.f, 0.f, 0.f, 0.f};
#pragma unroll
                for (int ks = 0; ks < 4; ++ks) st = MFMA32(*(const bf16x8*)(kbuf + rho * 512 + 16 * ((g * 8 + 2 * ks + hi) ^ ksw)), qb[ks], st);
                unsigned word = need_idx ? maskw[rho * MASK_PITCH + kt] : 0xffffffffu; word >>= 4 * hi; float pr[16];
#pragma unroll
                for (int r = 0; r < 16; ++r) { const float e = __builtin_amdgcn_exp2f(st[r]); pr[r] = ((word >> ((r & 3) + 8 * (r >> 2))) & 1u) ? e : 0.f; psum += pr[r]; }
                union { u32x4 u; bf16x8 v; } pa0, pa1; pa0.u = (u32x4){pg8::cvt_pk_bf16(pr[0], pr[1]), pg8::cvt_pk_bf16(pr[2], pr[3]), pg8::cvt_pk_bf16(pr[4], pr[5]), pg8::cvt_pk_bf16(pr[6], pr[7])}; pa1.u = (u32x4){pg8::cvt_pk_bf16(pr[8], pr[9]), pg8::cvt_pk_bf16(pr[10], pr[11]), pg8::cvt_pk_bf16(pr[12], pr[13]), pg8::cvt_pk_bf16(pr[14], pr[15])};
                union { u32x4 u; bf16x8 v; } vf[2][2];
#pragma unroll
                for (int s2 = 0; s2 < 2; ++s2) { const unsigned char* r0 = vbuf + vR0 * 64 + 8 * hi; const unsigned char* r1 = vbuf + vR1 * 64 + 8 * hi;
                    const u32x2 a0 = *(const u32x2*)(r0 + 16 * ((2 * s2) ^ vs0)), a1 = *(const u32x2*)(r0 + 16 * ((2 * s2 + 1) ^ vs0)), b0 = *(const u32x2*)(r1 + 16 * ((2 * s2) ^ vs1)), b1 = *(const u32x2*)(r1 + 16 * ((2 * s2 + 1) ^ vs1));
                    vf[s2][0].u = (u32x4){a0.x, a0.y, a1.x, a1.y}; vf[s2][1].u = (u32x4){b0.x, b0.y, b1.x, b1.y}; }
                o0 = MFMA32(pa0.v, vf[0][0].v, o0); o0 = MFMA32(pa1.v, vf[1][0].v, o0); o1 = MFMA32(pa0.v, vf[0][1].v, o1); o1 = MFMA32(pa1.v, vf[1][1].v, o1);
            }
            }
#undef KV_STAGE
            psum += __shfl_xor(psum, 32);
            if (hi == 0) lsum[w * 32 + rho] = psum;
            __syncthreads();
#pragma unroll
            for (int r = 0; r < 16; ++r) { const int qr = crow(r, hi); const float inv = 1.0f / lsum[w * 32 + qr];
                bf16* op = O + (size_t)(m0 + qr) * DM + w * 64 + rho;
                op[0] = (bf16)f2bf(o0[r] * inv); op[32] = (bf16)f2bf(o1[r] * inv); }
        }
        __syncthreads();
    }
}

constexpr int XS_PITCH = 168;
constexpr int WP = 144;
constexpr int WSLOT = 64 * WP;
constexpr int W_NCH = T_P / 64;
constexpr int W_UNITS = NB_P * 8 * W_NCH + NB_S * 8;
constexpr size_t WS_PM = WS_R, WS_QM = WS_R + 18 * MiB, WS_UM = WS_R + 36 * MiB, WS_Y0 = WS_R + 72 * MiB;
static_assert((size_t)W_UNITS * 8192 <= 18 * MiB && (size_t)W_UNITS * 16384 <= 36 * MiB && WS_Y0 + 36 * MiB <= WS_END, "rwkv chunk summaries fit the reusable region");
constexpr size_t SC_G2 = 0, SC_VV = (size_t)MT * 256;
constexpr int ZTP = 720;
constexpr int LWP = 68;

__device__ __forceinline__ f32x16 wy_mm(const unsigned char* A, const unsigned char* B, int mi, int ni, int rho, int hi, f32x16 acc) {
    const unsigned char* ap = A + (32 * mi + rho) * WP + 16 * hi; const unsigned char* bp = B + (32 * ni + rho) * WP + 16 * hi;
#pragma unroll
    for (int ks = 0; ks < 4; ++ks) acc = MFMA32(*(const bf16x8*)(ap + 32 * ks), *(const bf16x8*)(bp + 32 * ks), acc);
    return acc;
}
typedef float wy_f32x2 __attribute__((ext_vector_type(2))); typedef __bf16 wy_bf16x2 __attribute__((ext_vector_type(2)));
__device__ __forceinline__ unsigned wy_cvt2(float lo, float hi) { const wy_f32x2 v = {lo, hi}; const wy_bf16x2 b = __builtin_convertvector(v, wy_bf16x2); return __builtin_bit_cast(unsigned, b); }
__device__ __forceinline__ void wy_st_t(unsigned char* dst, const f32x16& a, int mi, int ni, int rho, int hi) {
#pragma unroll
    for (int q = 0; q < 4; ++q) *(u32x2*)(dst + (32 * ni + rho) * WP + 2 * (32 * mi + 8 * q + 4 * hi)) = (u32x2){wy_cvt2(a[4 * q], a[4 * q + 1]), wy_cvt2(a[4 * q + 2], a[4 * q + 3])};
}
__device__ __forceinline__ void wy_st_n(unsigned char* dst, const f32x16& a, int mi, int ni, int rho, int hi) {
#pragma unroll
    for (int r = 0; r < 16; ++r) *(bf16*)(dst + (32 * mi + crow(r, hi)) * WP + 2 * (32 * ni + rho)) = (bf16)f2bf(a[r]);
}
__device__ __forceinline__ f32x16 wy_ld_t(const unsigned char* src, int mi, int ni, int rho, int hi) {
    f32x16 a;
#pragma unroll
    for (int q = 0; q < 4; ++q) { const u32x2 w = *(const u32x2*)(src + (32 * ni + rho) * WP + 2 * (32 * mi + 8 * q + 4 * hi)); a[4 * q] = bflo(w.x); a[4 * q + 1] = bfhi(w.x); a[4 * q + 2] = bflo(w.y); a[4 * q + 3] = bfhi(w.y); }
    return a;
}
#define F16Z ((f32x16){0.f, 0.f, 0.f, 0.f, 0.f, 0.f, 0.f, 0.f, 0.f, 0.f, 0.f, 0.f, 0.f, 0.f, 0.f, 0.f})

__device__ __forceinline__ void p4w_chunks(const Args& a, unsigned char* lds, int tid) {
    unsigned char* ws = a.ws; float* out = a.out;
    const bf16* ZS = (const bf16*)(ws + WS_ZS);
    const bf16* w2t = (const bf16*)(ws + WS_W2T); const bf16* a2t = (const bf16*)(ws + WS_A2T); const bf16* g2t = (const bf16*)(ws + WS_G2T);
    bf16* G = (bf16*)(out + SC_G2); bf16* VV = (bf16*)(out + SC_VV); float* BON = (float*)(ws + WS_BONUS);
    const float* mu = a.in[13]; const float* w0 = a.in[14]; const float* a0 = a.in[16]; const float* k_k = a.in[19]; const float* k_a = a.in[20]; const float* r_k = a.in[21]; const float* sh0 = a.in[6];
    const int l = tid & 63, w = __builtin_amdgcn_readfirstlane(tid >> 6), rho = l & 31, hi = l >> 5;
#define SL(i) (lds + (i) * WSLOT)
    unsigned char* zt = SL(0);
    bf16* xs = (bf16*)SL(6);
    float* LW = (float*)SL(9);
    float* LG = (float*)SL(11);
    float* NRM = (float*)(lds + 17 * WSLOT);
    float* PAR = NRM + 320;
    int* QMAX = (int*)(PAR + 672);
    for (int unit = blockIdx.x; unit < W_UNITS; unit += gridDim.x) {
        int m0, nvalid, h; bool first; const float* shp = nullptr;
        if (unit < NB_P * 8 * W_NCH) { const int j = unit & (W_NCH - 1), sh = unit >> 5; h = sh & 7; m0 = (sh >> 3) * T_P + 64 * j; nvalid = 64; first = j == 0; }
        else { const int sh = unit - NB_P * 8 * W_NCH; h = sh & 7; m0 = MP + 32 * (sh >> 3); nvalid = 32; first = true; shp = sh0 + (size_t)(sh >> 3) * SHIFTW; }
        const int ct = w & 1, tt = (w >> 1) & 1; const int n = 64 * h + 32 * ct + rho;
        bf16x8 fa[6];
        if (w < 4) {
#pragma unroll
            for (int ks = 0; ks < 2; ++ks) { fa[ks] = *(const bf16x8*)(w2t + n * 32 + 16 * ks + 8 * hi); fa[2 + ks] = *(const bf16x8*)(a2t + n * 32 + 16 * ks + 8 * hi); } }
        else {
#pragma unroll
            for (int ks = 0; ks < 6; ++ks) fa[ks] = *(const bf16x8*)(g2t + n * 96 + 16 * ks + 8 * hi); }
        if (tid < 8) QMAX[tid] = 0;
        for (int i = tid; i < 672; i += 512) { float v;
            if (i < 192) v = mu[(i >> 6) * 512 + 64 * h + (i & 63)]; else if (i < 352) v = mu[1536 + i - 192];
            else { const int k5 = i - 352, a5 = k5 >> 6; const float* src = a5 == 0 ? w0 : (a5 == 1 ? a0 : (a5 == 2 ? k_k : (a5 == 3 ? k_a : r_k))); v = src[64 * h + (k5 & 63)]; }
            PAR[i] = v; }
        for (int idx = tid; idx < 65 * 44; idx += 512) { const int r = idx / 44, p = idx - r * 44;
            const int col = p < 24 ? (p >> 3) * 512 + 64 * h + 8 * (p & 7) : 1536 + 8 * (p - 24);
            u32x4 v = {0u, 0u, 0u, 0u};
            if (r == 0) { if (!first) v = *(const u32x4*)(ZS + (size_t)(m0 - 1) * SHIFTW + col);
                          else if (shp) { const f32x4 a4 = *(const f32x4*)(shp + col), b4 = *(const f32x4*)(shp + col + 4); v = (u32x4){pk2(a4.x, a4.y), pk2(a4.z, a4.w), pk2(b4.x, b4.y), pk2(b4.z, b4.w)}; } }
            else if (r <= nvalid) v = *(const u32x4*)(ZS + (size_t)(m0 + r - 1) * SHIFTW + col);
            *(u32x4*)(zt + r * ZTP + 16 * p) = v; }
        LBAR();
        { const int tk = tid >> 3, c0 = (tid & 7) * 20; const bf16* zc = (const bf16*)(zt + (tk + 1) * ZTP + 384) + c0; const bf16* zp = (const bf16*)(zt + tk * ZTP + 384) + c0;
#pragma unroll
          for (int e = 0; e < 20; ++e) { const int c = c0 + e; const float cur = bf1(zc[e]), prev = bf1(zp[e]); const float zm = cur + PAR[192 + c] * (prev - cur);
              const float f = __frcp_rn(1.0f + __expf(c < 32 ? -2.0f * zm : -zm)); xs[tk * XS_PITCH + c] = (bf16)f2bf(c < 32 ? 2.0f * f - 1.0f : (c < 64 ? zm : f)); } }
        LBAR();
        const int tok = 32 * tt + rho; const bool valid = tok < nvalid; const size_t m = (size_t)m0 + tok;
        const bf16* xrow = xs + tok * XS_PITCH + 8 * hi; const int lofs = 32 * ct + 4 * hi;
        const int pofs = 64 * h + 32 * ct + 4 * hi;
        const unsigned char* zcur = zt + (tok + 1) * ZTP + 2 * (32 * ct + 4 * hi); const unsigned char* zprv = zt + tok * ZTP + 2 * (32 * ct + 4 * hi);
#define WMIX4(dst, seg, q) do { const u32x2 cw = *(const u32x2*)(zcur + 128 * (seg) + 16 * (q)), pw = *(const u32x2*)(zprv + 128 * (seg) + 16 * (q)); const f32x4 mu4 = *(const f32x4*)(PAR + 64 * (seg) + lofs + 8 * (q)); \
            dst[0] = bflo(cw.x) + mu4.x * (bflo(pw.x) - bflo(cw.x)); dst[1] = bfhi(cw.x) + mu4.y * (bfhi(pw.x) - bfhi(cw.x)); dst[2] = bflo(cw.y) + mu4.z * (bflo(pw.y) - bflo(cw.y)); dst[3] = bfhi(cw.y) + mu4.w * (bfhi(pw.y) - bfhi(cw.y)); } while (0)
        float ra[16], rb[16], rc[16], rd[16];
        if (w < 4) {
            f32x16 Dw = F16Z, Da = F16Z;
#pragma unroll
            for (int ks = 0; ks < 2; ++ks) { Dw = MFMA32(fa[ks], *(const bf16x8*)(xrow + 16 * ks), Dw); Da = MFMA32(fa[2 + ks], *(const bf16x8*)(xrow + 32 + 16 * ks), Da); }
            float n2 = 0.f, bon = 0.f;
#pragma unroll
            for (int q = 0; q < 4; ++q) { float zr[4], zk[4]; WMIX4(zr, 0, q); WMIX4(zk, 1, q);
                const f32x4 w04 = *(const f32x4*)(PAR + 352 + lofs + 8 * q), a04 = *(const f32x4*)(PAR + 416 + lofs + 8 * q), kk4 = *(const f32x4*)(PAR + 480 + lofs + 8 * q), ka4 = *(const f32x4*)(PAR + 544 + lofs + 8 * q), rk4 = *(const f32x4*)(PAR + 608 + lofs + 8 * q);
#pragma unroll
                for (int e = 0; e < 4; ++e) { const int r = 4 * q + e;
                    const float sg = __frcp_rn(1.0f + __expf(-(w04[e] + Dw[r]))); rd[r] = valid ? -0.6065306597126334f * sg : 0.f;
                    const float aa = __frcp_rn(1.0f + __expf(-(a04[e] + Da[r]))); rb[r] = aa;
                    const float kr = valid ? zk[e] * kk4[e] : 0.f; ra[r] = kr; n2 += kr * kr;
                    const float km = valid ? zk[e] * (1.0f + (aa - 1.0f) * ka4[e]) : 0.f; rc[r] = km; bon += zr[e] * km * rk4[e]; }
                *(f32x4*)(LW + tok * LWP + 32 * ct + 8 * q + 4 * hi) = (f32x4){rd[4 * q], rd[4 * q + 1], rd[4 * q + 2], rd[4 * q + 3]}; }
            n2 += __shfl_xor(n2, 32); bon += __shfl_xor(bon, 32);
            if (hi == 0) { NRM[ct * 64 + tok] = n2; NRM[128 + ct * 64 + tok] = bon; }
        } else {
            f32x16 Dg = F16Z;
#pragma unroll
            for (int ks = 0; ks < 6; ++ks) Dg = MFMA32(fa[ks], *(const bf16x8*)(xrow + 64 + 16 * ks), Dg);
#pragma unroll
            for (int q = 0; q < 4; ++q) { float zr[4], zv[4]; WMIX4(zr, 0, q); WMIX4(zv, 2, q);
#pragma unroll
                for (int e = 0; e < 4; ++e) { ra[4 * q + e] = valid ? zr[e] : 0.f; rb[4 * q + e] = valid ? zv[e] : 0.f; }
                if (valid) { const size_t o = m * 512 + pofs + 8 * q;
                    *(u32x2*)(G + o) = (u32x2){pk2(Dg[4 * q], Dg[4 * q + 1]), pk2(Dg[4 * q + 2], Dg[4 * q + 3])};
                    *(u32x2*)(VV + o) = (u32x2){pk2(zv[0], zv[1]), pk2(zv[2], zv[3])}; } }
        }
#undef WMIX4
        LBAR();
        if (w == 0) { float acc = 0.f; LG[l] = 0.f;
#pragma unroll 8
            for (int t = 0; t < 64; ++t) { acc += LW[t * LWP + l]; LG[(t + 1) * LWP + l] = acc; }
            NRM[256 + l] = __expf(acc); }
        if (w == 1 && l < 64) { const float bn = NRM[128 + l] + NRM[192 + l]; if (l < nvalid) BON[((size_t)m0 + l) * 8 + h] = bn; }
        LBAR();
        {
            const float* lgc = LG + (tok + 1) * LWP + 32 * ct + 4 * hi; const float* lgp = LG + tok * LWP + 32 * ct + 4 * hi; const float* lge = LG + 64 * LWP + 32 * ct + 4 * hi;
            if (w < 4) {
                const float invn = 1.0f / fmaxf(sqrtf(NRM[tok] + NRM[64 + tok]), 1e-12f);
#pragma unroll
                for (int q = 0; q < 4; ++q) { const f32x4 gc = *(const f32x4*)(lgc + 8 * q), gp = *(const f32x4*)(lgp + 8 * q), ge = *(const f32x4*)(lge + 8 * q);
                    float kt[4], bt[4], ka[4], ke[4], be[4];
#pragma unroll
                    for (int e = 0; e < 4; ++e) { const int r = 4 * q + e; const float en = __expf(-gc[e]), ep = __expf(gp[e]), ee = __expf(ge[e] - gc[e]); const float kkn = ra[r] * invn, bb = kkn * rb[r];
                        kt[e] = rc[r] * en; bt[e] = bb * en; ka[e] = kkn * ep; ke[e] = rc[r] * ee; be[e] = bb * ee; }
                    const int co = 2 * (32 * ct + 8 * q + 4 * hi);
                    *(u32x2*)(SL(0) + tok * WP + co) = (u32x2){pk2(kt[0], kt[1]), pk2(kt[2], kt[3])};
                    *(u32x2*)(SL(1) + tok * WP + co) = (u32x2){pk2(bt[0], bt[1]), pk2(bt[2], bt[3])};
                    *(u32x2*)(SL(2) + tok * WP + co) = (u32x2){pk2(ka[0], ka[1]), pk2(ka[2], ka[3])};
#pragma unroll
                    for (int e = 0; e < 4; ++e) { const int kr = 32 * ct + 8 * q + 4 * hi + e;
                        *(bf16*)(SL(4) + kr * WP + 2 * tok) = (bf16)f2bf(ka[e]); *(bf16*)(SL(5) + kr * WP + 2 * tok) = (bf16)f2bf(be[e]); *(bf16*)(SL(6) + kr * WP + 2 * tok) = (bf16)f2bf(ke[e]); } }
            } else {
#pragma unroll
                for (int q = 0; q < 4; ++q) { const f32x4 gc = *(const f32x4*)(lgc + 8 * q); float rh[4];
#pragma unroll
                    for (int e = 0; e < 4; ++e) rh[e] = ra[4 * q + e] * __expf(gc[e]);
                    *(u32x2*)(SL(3) + tok * WP + 2 * (32 * ct + 8 * q + 4 * hi)) = (u32x2){pk2(rh[0], rh[1]), pk2(rh[2], rh[3])};
#pragma unroll
                    for (int e = 0; e < 4; ++e) *(bf16*)(SL(7) + (32 * ct + 8 * q + 4 * hi + e) * WP + 2 * tok) = (bf16)f2bf(rb[4 * q + e]); }
            }
        }
        LBAR();
        for (int task = w; task < 16; task += 8) { const int pr = task >> 2, mi = (task >> 1) & 1, ni = task & 1;
            if (pr == 0) { f32x16 d = wy_mm(SL(1), SL(2), mi, ni, rho, hi, F16Z);
#pragma unroll
                for (int r = 0; r < 16; ++r) if (!(32 * mi + crow(r, hi) < 32 * ni + rho)) d[r] = 0.f;
                wy_st_t(SL(8), d, mi, ni, rho, hi); wy_st_n(SL(9), d, mi, ni, rho, hi); }
            else if (pr == 1) { f32x16 d = wy_mm(SL(2), SL(0), mi, ni, rho, hi, F16Z);
#pragma unroll
                for (int r = 0; r < 16; ++r) if (!(32 * ni + rho < 32 * mi + crow(r, hi))) d[r] = 0.f;
                wy_st_t(SL(10), d, mi, ni, rho, hi); }
            else if (pr == 2) { f32x16 d = wy_mm(SL(1), SL(3), mi, ni, rho, hi, F16Z);
#pragma unroll
                for (int r = 0; r < 16; ++r) if (!(32 * mi + crow(r, hi) <= 32 * ni + rho)) d[r] = 0.f;
                wy_st_t(SL(11), d, mi, ni, rho, hi); }
            else { f32x16 d = wy_mm(SL(0), SL(3), mi, ni, rho, hi, F16Z);
#pragma unroll
                for (int r = 0; r < 16; ++r) if (!(32 * mi + crow(r, hi) <= 32 * ni + rho)) d[r] = 0.f;
                wy_st_t(SL(12), d, mi, ni, rho, hi); } }
        LBAR();
        for (int task = w; task < 12; task += 8) { const int pr = task >> 2, mi = (task >> 1) & 1, ni = task & 1;
            if (pr == 0) { const f32x16 d = wy_mm(SL(9), SL(8), mi, ni, rho, hi, F16Z); wy_st_t(SL(13), d, mi, ni, rho, hi); }
            else if (pr == 1) { const f32x16 d = wy_mm(SL(8), SL(9), mi, ni, rho, hi, F16Z); wy_st_t(SL(14), d, mi, ni, rho, hi); }
            else { f32x16 d = wy_ld_t(SL(8), mi, ni, rho, hi);
#pragma unroll
                for (int r = 0; r < 16; ++r) d[r] = ((32 * mi + crow(r, hi)) == (32 * ni + rho) ? 1.0f : 0.f) - d[r];
                wy_st_t(SL(15), d, mi, ni, rho, hi); } }
        LBAR();
        int pfin = 16;
#pragma unroll 1
        for (int lev = 1; lev <= 5; ++lev) {
            unsigned char* Pc = SL((lev & 1) ? 15 : 16); unsigned char* Pn = SL((lev & 1) ? 16 : 15);
            unsigned char* Qr = SL((lev & 1) ? 13 : 0); unsigned char* Qx = SL((lev & 1) ? 14 : 1); unsigned char* Qr2 = SL((lev & 1) ? 0 : 13); unsigned char* Qx2 = SL((lev & 1) ? 1 : 14);
            const int ntask = lev < 5 ? 12 : 4;
            for (int task = w; task < ntask; task += 8) { const int pr = task >> 2, mi = (task >> 1) & 1, ni = task & 1;
                if (pr == 0) { f32x16 d = wy_ld_t(Pc, mi, ni, rho, hi);
                    d = wy_mm(Qx, Pc, mi, ni, rho, hi, d); wy_st_t(Pn, d, mi, ni, rho, hi); }
                else if (pr == 1) { const f32x16 d = wy_mm(Qx, Qr, mi, ni, rho, hi, F16Z); wy_st_t(Qr2, d, mi, ni, rho, hi); float mx = 0.f;
#pragma unroll
                    for (int r = 0; r < 16; ++r) mx = fmaxf(mx, fabsf(d[r]));
                    if (__any(mx >= 1e-9f) && l == 0) QMAX[lev] = 1; }
                else { const f32x16 d = wy_mm(Qr, Qx, mi, ni, rho, hi, F16Z); wy_st_t(Qx2, d, mi, ni, rho, hi); } }
            LBAR();
            if (lev < 5 && QMAX[lev] == 0) { pfin = (lev & 1) ? 16 : 15; break; }
        }
        { const int pr = w >> 2, mi = (w >> 1) & 1, ni = w & 1;
          if (pr == 0) { const f32x16 d = wy_mm(SL(pfin), SL(10), mi, ni, rho, hi, F16Z); wy_st_t(SL(0), d, mi, ni, rho, hi); }
          else { const f32x16 d = wy_mm(SL(pfin), SL(4), mi, ni, rho, hi, F16Z); wy_st_t(SL(1), d, mi, ni, rho, hi); } }
        LBAR();
        { bf16* PMg = (bf16*)(ws + WS_PM) + (size_t)unit * 4096; bf16* QMg = (bf16*)(ws + WS_QM) + (size_t)unit * 4096;
          for (int task = w; task < 16; task += 8) { const int pr = task >> 2, mi = (task >> 1) & 1, ni = task & 1;
            if (pr == 0) { f32x16 d = wy_mm(SL(1), SL(5), mi, ni, rho, hi, F16Z);
                const float gc = NRM[256 + 32 * ni + rho];
#pragma unroll
                for (int q = 0; q < 4; ++q) { float o[4];
#pragma unroll
                    for (int e = 0; e < 4; ++e) { const int kr = 32 * mi + 8 * q + 4 * hi + e; o[e] = (kr == 32 * ni + rho ? gc : 0.f) - d[4 * q + e]; }
                    *(u32x2*)(PMg + (32 * ni + rho) * 64 + 32 * mi + 8 * q + 4 * hi) = (u32x2){pk2(o[0], o[1]), pk2(o[2], o[3])}; } }
            else if (pr == 1) { f32x16 d = wy_mm(SL(0), SL(5), mi, ni, rho, hi, F16Z);
                const f32x16 ke = wy_ld_t(SL(6), mi, ni, rho, hi);
#pragma unroll
                for (int r = 0; r < 16; ++r) d[r] = ke[r] - d[r];
                wy_st_t(SL(13), d, mi, ni, rho, hi); }
            else if (pr == 2) { f32x16 d = wy_mm(SL(1), SL(11), mi, ni, rho, hi, F16Z);
                const f32x16 rh = wy_ld_t(SL(3), mi, ni, rho, hi);
#pragma unroll
                for (int q = 0; q < 4; ++q) *(u32x2*)(QMg + (32 * ni + rho) * 64 + 32 * mi + 8 * q + 4 * hi) =
                    (u32x2){pk2(rh[4 * q] - d[4 * q], rh[4 * q + 1] - d[4 * q + 1]), pk2(rh[4 * q + 2] - d[4 * q + 2], rh[4 * q + 3] - d[4 * q + 3])}; }
            else { f32x16 d = wy_mm(SL(0), SL(11), mi, ni, rho, hi, F16Z);
                const f32x16 bk = wy_ld_t(SL(12), mi, ni, rho, hi);
#pragma unroll
                for (int r = 0; r < 16; ++r) d[r] = bk[r] - d[r];
                wy_st_t(SL(14), d, mi, ni, rho, hi); } } }
        LBAR();
        { float* UMg = (float*)(ws + WS_UM) + (size_t)unit * 4096; float* Y0g = (float*)(ws + WS_Y0) + (size_t)unit * 4096; const int pr = w >> 2, mi = (w >> 1) & 1, ni = w & 1;
          if (pr == 0) { const f32x16 d = wy_mm(SL(13), SL(7), mi, ni, rho, hi, F16Z);
#pragma unroll
              for (int q = 0; q < 4; ++q) *(f32x4*)(UMg + (32 * ni + rho) * 64 + 32 * mi + 8 * q + 4 * hi) = (f32x4){d[4 * q], d[4 * q + 1], d[4 * q + 2], d[4 * q + 3]}; }
          else { const f32x16 d = wy_mm(SL(7), SL(14), mi, ni, rho, hi, F16Z);
#pragma unroll
              for (int q = 0; q < 4; ++q) *(f32x4*)(Y0g + (32 * ni + rho) * 64 + 32 * mi + 8 * q + 4 * hi) = (f32x4){d[4 * q], d[4 * q + 1], d[4 * q + 2], d[4 * q + 3]}; } }
        LBAR();
    }
#undef SL
}

constexpr size_t WS_SB = WS_R + 108 * MiB;
static_assert(WS_SB + (size_t)W_UNITS * 8192 <= WS_END, "state snapshots fit");
__device__ __forceinline__ void p5w_chain(const Args& a, unsigned char* lds, int tid) {
    unsigned char* ws = a.ws; float* out = a.out;
    const int l = tid & 63, w = __builtin_amdgcn_readfirstlane(tid >> 6), rho = l & 31, hi = l >> 5;
    unsigned char* Sw = lds + w * (32 * WP);
    const int gw = w * gridDim.x + blockIdx.x, NGW = gridDim.x * 8;
    for (int task = gw; task < 2 * (NB_P * 8 + NB_S * 8); task += NGW) {
        const int u2 = task >> 1, vb = 32 * (task & 1);
        const bool smp = u2 >= NB_P * 8; const int sh = smp ? u2 - NB_P * 8 : u2;
        const int nch = smp ? 1 : W_NCH, unit0 = smp ? NB_P * 8 * W_NCH + sh : sh * W_NCH;
        float* wkv = out + (smp ? OFF_WKVS : OFF_WKVP) + (size_t)sh * 4096;
        { const float* s0 = a.in[5] + (size_t)sh * 4096 + (size_t)(vb + rho) * 64 + 32 * hi;
          bf16* sg = (bf16*)(ws + WS_SB) + (size_t)unit0 * 4096 + (size_t)(vb + rho) * 64 + 32 * hi;
#pragma unroll
          for (int c8 = 0; c8 < 4; ++c8) { float x[8];
              if (smp) { const f32x4 a4 = *(const f32x4*)(s0 + 8 * c8), b4 = *(const f32x4*)(s0 + 8 * c8 + 4); x[0] = a4.x; x[1] = a4.y; x[2] = a4.z; x[3] = a4.w; x[4] = b4.x; x[5] = b4.y; x[6] = b4.z; x[7] = b4.w; }
              else {
#pragma unroll
                  for (int e = 0; e < 8; ++e) x[e] = 0.f; }
              const u32x4 p8 = pack8(x); *(u32x4*)(Sw + rho * WP + 2 * (32 * hi + 8 * c8)) = p8; *(u32x4*)(sg + 8 * c8) = p8; } }
        bf16x8 pa[2][4], pn[2][4]; f32x16 u0, u1, n0 = F16Z, n1 = F16Z;
#define P5_LOAD(j_, P_, U0_, U1_) do { const bf16* pm_ = (const bf16*)(ws + WS_PM) + ((size_t)unit0 + (j_)) * 4096 + rho * 64 + 8 * hi; \
            _Pragma("unroll") for (int ks = 0; ks < 4; ++ks) { P_[0][ks] = *(const bf16x8*)(pm_ + 16 * ks); P_[1][ks] = *(const bf16x8*)(pm_ + 32 * 64 + 16 * ks); } \
            const float* um_ = (const float*)(ws + WS_UM) + ((size_t)unit0 + (j_)) * 4096 + (size_t)(vb + rho) * 64 + 4 * hi; \
            _Pragma("unroll") for (int q = 0; q < 4; ++q) { const f32x4 x = *(const f32x4*)(um_ + 8 * q), y = *(const f32x4*)(um_ + 32 + 8 * q); \
                U0_[4 * q] = x.x; U0_[4 * q + 1] = x.y; U0_[4 * q + 2] = x.z; U0_[4 * q + 3] = x.w; U1_[4 * q] = y.x; U1_[4 * q + 1] = y.y; U1_[4 * q + 2] = y.z; U1_[4 * q + 3] = y.w; } } while (0)
#define P5_STEP(j, P_, U0_, U1_, PN_, N0_, N1_) do { if ((j) + 1 < nch) P5_LOAD((j) + 1, PN_, N0_, N1_); \
            bf16x8 sb_[4]; _Pragma("unroll") for (int ks = 0; ks < 4; ++ks) sb_[ks] = *(const bf16x8*)(Sw + rho * WP + 16 * hi + 32 * ks); \
            f32x16 d0_ = U0_, d1_ = U1_; \
            _Pragma("unroll") for (int ks = 0; ks < 4; ++ks) { d0_ = MFMA32(P_[0][ks], sb_[ks], d0_); d1_ = MFMA32(P_[1][ks], sb_[ks], d1_); } \
            if ((j) + 1 < nch) { bf16* sg_ = (bf16*)(ws + WS_SB) + ((size_t)unit0 + (j) + 1) * 4096 + (size_t)(vb + rho) * 64 + 4 * hi; \
                _Pragma("unroll") for (int q = 0; q < 4; ++q) { const u32x2 w0_ = {wy_cvt2(d0_[4 * q], d0_[4 * q + 1]), wy_cvt2(d0_[4 * q + 2], d0_[4 * q + 3])}, w1_ = {wy_cvt2(d1_[4 * q], d1_[4 * q + 1]), wy_cvt2(d1_[4 * q + 2], d1_[4 * q + 3])}; \
                    *(u32x2*)(Sw + rho * WP + 2 * (8 * q + 4 * hi)) = w0_; *(u32x2*)(Sw + rho * WP + 2 * (32 + 8 * q + 4 * hi)) = w1_; *(u32x2*)(sg_ + 8 * q) = w0_; *(u32x2*)(sg_ + 32 + 8 * q) = w1_; } } \
            else { float* wk_ = wkv + (size_t)(vb + rho) * 64 + 4 * hi; \
                _Pragma("unroll") for (int q = 0; q < 4; ++q) { *(f32x4*)(wk_ + 8 * q) = (f32x4){d0_[4 * q], d0_[4 * q + 1], d0_[4 * q + 2], d0_[4 * q + 3]}; *(f32x4*)(wk_ + 32 + 8 * q) = (f32x4){d1_[4 * q], d1_[4 * q + 1], d1_[4 * q + 2], d1_[4 * q + 3]}; } } } while (0)
        P5_LOAD(0, pa, u0, u1);
        for (int j0 = 0; j0 < nch; j0 += 2) { P5_STEP(j0, pa, u0, u1, pn, n0, n1); if (j0 + 1 < nch) P5_STEP((j0 + 1), pn, n0, n1, pa, u0, u1); }
#undef P5_LOAD
#undef P5_STEP
    }
}

__device__ __forceinline__ void p6w_out(const Args& a, int tid) {
    unsigned char* ws = a.ws; float* out = a.out;
    const bf16* G = (const bf16*)(out + SC_G2); const bf16* VV = (const bf16*)(out + SC_VV); const float* BON = (const float*)(ws + WS_BONUS); bf16* O = (bf16*)(ws + WS_XB);
    const float* lgn = a.in[22]; const float* lbn = a.in[23];
    const int l = tid & 63, rho = l & 31, hi = l >> 5;
    const int gw = blockIdx.x * 8 + (tid >> 6), NGW = gridDim.x * 8;
    for (int task = gw; task < 2 * W_UNITS; task += NGW) {
        const int unit = task >> 1, tt = task & 1; const bool smp = unit >= NB_P * 8 * W_NCH;
        if (smp && tt == 1) continue;
        int h, j; size_t mrow0;
        if (!smp) { j = unit & (W_NCH - 1); const int sh = unit >> 5; h = sh & 7; mrow0 = (size_t)(sh >> 3) * T_P; } else { const int sh = unit - NB_P * 8 * W_NCH; j = 0; h = sh & 7; mrow0 = (size_t)MP + 32 * (sh >> 3); }
        const int tok = 32 * tt + rho; const size_t m = mrow0 + (size_t)j * 64 + tok;
        const bf16* sb = (const bf16*)(ws + WS_SB) + (size_t)unit * 4096 + rho * 64 + 8 * hi; const bf16* qm = (const bf16*)(ws + WS_QM) + (size_t)unit * 4096 + tok * 64 + 8 * hi;
        bf16x8 sa[2][4], qb[4];
#pragma unroll
        for (int ks = 0; ks < 4; ++ks) { sa[0][ks] = *(const bf16x8*)(sb + 16 * ks); sa[1][ks] = *(const bf16x8*)(sb + 32 * 64 + 16 * ks); qb[ks] = *(const bf16x8*)(qm + 16 * ks); }
        const float* y0 = (const float*)(ws + WS_Y0) + (size_t)unit * 4096 + tok * 64 + 4 * hi;
        f32x16 d0, d1;
#pragma unroll
        for (int q = 0; q < 4; ++q) { const f32x4 x = *(const f32x4*)(y0 + 8 * q), y = *(const f32x4*)(y0 + 32 + 8 * q);
            d0[4 * q] = x.x; d0[4 * q + 1] = x.y; d0[4 * q + 2] = x.z; d0[4 * q + 3] = x.w; d1[4 * q] = y.x; d1[4 * q + 1] = y.y; d1[4 * q + 2] = y.z; d1[4 * q + 3] = y.w; }
        u32x2 vw[8], gg[8]; f32x4 l4[8], b4[8]; const float bon = BON[m * 8 + h];
#pragma unroll
        for (int vt = 0; vt < 2; ++vt)
#pragma unroll
            for (int q = 0; q < 4; ++q) { const int c = 64 * h + 32 * vt + 8 * q + 4 * hi; vw[4 * vt + q] = *(const u32x2*)(VV + m * 512 + c); gg[4 * vt + q] = *(const u32x2*)(G + m * 512 + c);
                l4[4 * vt + q] = *(const f32x4*)(lgn + c); b4[4 * vt + q] = *(const f32x4*)(lbn + c); }
#pragma unroll
        for (int ks = 0; ks < 4; ++ks) { d0 = MFMA32(sa[0][ks], qb[ks], d0); d1 = MFMA32(sa[1][ks], qb[ks], d1); }
        float s1 = 0.f;
#pragma unroll
        for (int r = 0; r < 16; ++r) s1 += d0[r] + d1[r];
        s1 += __shfl_xor(s1, 32);
        const float mean = s1 * (1.f / 64.f); float s2 = 0.f;
#pragma unroll
        for (int r = 0; r < 16; ++r) { const float e0 = d0[r] - mean, e1 = d1[r] - mean; s2 += e0 * e0 + e1 * e1; }
        s2 += __shfl_xor(s2, 32);
        const float rinv = rsqrtf(s2 * (1.f / 64.f) + 64e-5f);
#pragma unroll
        for (int vt = 0; vt < 2; ++vt)
#pragma unroll
            for (int q = 0; q < 4; ++q) { const int c = 64 * h + 32 * vt + 8 * q + 4 * hi; const u32x2 v2 = vw[4 * vt + q], g2 = gg[4 * vt + q];
                const float vv[4] = {bflo(v2.x), bfhi(v2.x), bflo(v2.y), bfhi(v2.y)}, gf[4] = {bflo(g2.x), bfhi(g2.x), bflo(g2.y), bfhi(g2.y)}; float r4[4];
#pragma unroll
                for (int e = 0; e < 4; ++e) { const float y = vt ? d1[4 * q + e] : d0[4 * q + e]; r4[e] = ((y - mean) * rinv * l4[4 * vt + q][e] + b4[4 * vt + q][e] + bon * vv[e]) * gf[e]; }
                *(u32x2*)(O + m * DM + 512 + c) = (u32x2){pk2(r4[0], r4[1]), pk2(r4[2], r4[3])}; }
    }
}

#define XB_TMO      128
#define XB_XCNT(j)  (256  + 64 * (j))
#define XB_XSUB(j)  (1280 + 64 * (j))
#define XB_XGEN(j)  (2304 + 64 * (j))
#define XB_TOP      3328
#define XB_TOPGEN   3392
#define XCD_BAR_WORDS 3456
#define XB_SPIN_CAP (1u << 18)

__device__ __forceinline__ unsigned xb_ld(unsigned* p)              { return __hip_atomic_load(p, __ATOMIC_RELAXED, __HIP_MEMORY_SCOPE_AGENT); }
__device__ __forceinline__ unsigned xb_add(unsigned* p, unsigned v) { return __hip_atomic_fetch_add(p, v, __ATOMIC_RELAXED, __HIP_MEMORY_SCOPE_AGENT); }
__device__ __forceinline__ unsigned xb_xcc_id() { return (unsigned)__builtin_amdgcn_s_getreg((3 << 11) | 20) & 0xFu; }
#define XB_SPIN(cond, bar) do { unsigned _sp = 0; while (cond) { __builtin_amdgcn_s_sleep(1); \
    if ((++_sp & 255u) == 0u) { if (xb_ld(&(bar)[XB_TMO])) break; if (_sp > XB_SPIN_CAP) { atomicAdd(&(bar)[XB_TMO], 1u); break; } } } } while (0)

struct XcdBarrier {
    unsigned* bar; unsigned x;
    volatile __attribute__((address_space(3))) unsigned* st;
};

__device__ __forceinline__ XcdBarrier xcd_barrier_post(unsigned* bar, volatile __attribute__((address_space(3))) unsigned* st) {
    XcdBarrier b; b.bar = bar; b.x = xb_xcc_id(); b.st = st;
    if (threadIdx.x == 0) (void)xb_add(&bar[XB_XCNT(b.x)], 1u);
    return b;
}
__device__ __forceinline__ void xcd_barrier_complete(unsigned* bar, unsigned x, unsigned& nloc, unsigned& nx) {
    const unsigned G = gridDim.x * gridDim.y * gridDim.z;
    unsigned sum, cnt, mine, sp = 0u;
    for (;;) {
        sum = 0u; cnt = 0u; mine = 0u;
#pragma unroll
        for (unsigned j = 0; j < 16; ++j) { const unsigned c = xb_ld(&bar[XB_XCNT(j)]); sum += c; cnt += (c > 0u) ? 1u : 0u; mine = (j == x) ? c : mine; }
        if (sum == G) break;
        __builtin_amdgcn_s_sleep(1);
        if ((++sp & 255u) == 0u) { if (xb_ld(&bar[XB_TMO])) break; if (sp > XB_SPIN_CAP) { atomicAdd(&bar[XB_TMO], 1u); break; } }
    }
    nloc = mine > 0u ? mine : 1u; nx = cnt > 0u ? cnt : 1u;
}

__device__ __forceinline__ void xcd_barrier(const XcdBarrier& b) {
    asm volatile("s_waitcnt vmcnt(0)" ::: "memory");
    __syncthreads();
    if (threadIdx.x == 0) {
        unsigned* bar = b.bar;
        __builtin_amdgcn_s_waitcnt(0);
        unsigned nloc = b.st[0], nx = b.st[1];
        if (nloc == 0u) { xcd_barrier_complete(bar, b.x, nloc, nx); b.st[0] = nloc; b.st[1] = nx; }
        const unsigned old = xb_add(&bar[XB_XSUB(b.x)], 1u);
        const unsigned gen = old / nloc;
        if (old + 1u == (gen + 1u) * nloc) {
            __builtin_amdgcn_fence(__ATOMIC_RELEASE, "agent");
            asm volatile("s_waitcnt vmcnt(0)" ::: "memory");
            const unsigned og = xb_add(&bar[XB_TOP], 1u);
            const unsigned tg = og / nx;
            if (og + 1u == (tg + 1u) * nx) xb_add(&bar[XB_TOPGEN], 1u);
            else XB_SPIN(xb_ld(&bar[XB_TOPGEN]) == tg, bar);
            __builtin_amdgcn_fence(__ATOMIC_ACQUIRE, "agent");
            xb_add(&bar[XB_XGEN(b.x)], 1u);
            asm volatile("s_waitcnt vmcnt(0)" ::: "memory");
        } else {
            XB_SPIN(xb_ld(&bar[XB_XGEN(b.x)]) == gen, bar);
            __builtin_amdgcn_fence(__ATOMIC_ACQUIRE, "agent");
            asm volatile("s_waitcnt vmcnt(0)" ::: "memory");
        }
    }
    __syncthreads();
}

constexpr int CW_BAR = 4096;
constexpr int LDS_BYTES = 163840;
constexpr int N_PHASES = 12;
#ifndef PROBE_MASK
#define PROBE_MASK 0
#endif
template <int PH> __device__ __forceinline__ void run_phase(const Args& args, unsigned char* lds, int tid, int rep) {
    unsigned char* ws = args.ws;
    if constexpr (PH == 0) p0_prologue(args, lds, tid);
    if constexpr (PH == 1) { pg8::Gemm g{(const pg8::bf16_t*)(ws + WS_XB), (const pg8::bf16_t*)(ws + WS_WIN), MT, NZ, DM, DM}; pg8::StaticOrder S; S.init(MT, NZ, gridDim.x, blockIdx.x);
        pg8::EpiZ E{(pg8::bf16_t*)(ws + WS_ZR), (pg8::bf16_t*)(ws + WS_ZS)};
        pg8::gemm_phase<pg8::EpiZ, pg8::StaticOrder, true, true>((PG8_LAS unsigned char*)lds, g, S, E); }
    if constexpr (PH == 2) p2_post(args, lds, tid);
    if constexpr (PH == 3) p3_attention(args, lds, tid, rep);
    if constexpr (PH == 4) p4w_chunks(args, lds, tid);
    if constexpr (PH == 5) p5w_chain(args, lds, tid);
    if constexpr (PH == 6) p6w_out(args, tid);
    if constexpr (PH == 7) { pg8::Gemm g{(const pg8::bf16_t*)(ws + WS_XB), (const pg8::bf16_t*)(ws + WS_WOUT), MT, DM, DM, DM}; pg8::StaticOrder S; S.init(MT, DM, gridDim.x, blockIdx.x);
        pg8::EpiH E{args.in[0], args.in[1], args.out + OFF_Y, (pg8::bf16_t*)(ws + WS_HB), (float*)(ws + WS_CTL) + CW_SS};
        pg8::gemm_phase<pg8::EpiH, pg8::StaticOrder, true, true>((PG8_LAS unsigned char*)lds, g, S, E); }
    if constexpr (PH == 9) { pg8::Gemm g{(const pg8::bf16_t*)(ws + WS_HB), (const pg8::bf16_t*)(ws + WS_W1), MT, DFF, DM, DM}; pg8::StaticOrder S; S.init(MT, DFF, gridDim.x, blockIdx.x);
        pg8::EpiAct E{(pg8::bf16_t*)(ws + WS_ACT), DFF, (const float*)(ws + WS_CTL) + CW_SS};
        pg8::gemm_phase<pg8::EpiAct, pg8::StaticOrder, true, true>((PG8_LAS unsigned char*)lds, g, S, E); }
    if constexpr (PH == 10) {
        { pg8::Gemm g{(const pg8::bf16_t*)(ws + WS_ACT), (const pg8::bf16_t*)(ws + WS_W2), MP, DM, DFF, DFF}; pg8::StaticOrder S; S.init(MP, DM, gridDim.x, blockIdx.x);
          pg8::EpiY E{args.out + OFF_Y, (const pg8::bf16_t*)(ws + WS_HB)};
          pg8::gemm_phase<pg8::EpiY, pg8::StaticOrder, true, true>((PG8_LAS unsigned char*)lds, g, S, E); }
        { const int c = blockIdx.x; pg8::OneUnit S; S.has = c < 64; S.u.pm = MP / 256 + (c >> 4); S.u.pn = (c >> 2) & 3; const int sl = c & 3;
          pg8::Gemm g{(const pg8::bf16_t*)(ws + WS_ACT) + sl * 1024, (const pg8::bf16_t*)(ws + WS_W2) + sl * 1024, MT, DM, DFF, 1024};
          pg8::EpiSlab E{(float*)(ws + WS_SLAB) + (size_t)sl * MS * DM};
          __syncthreads();
          pg8::gemm_phase<pg8::EpiSlab, pg8::OneUnit, false, true>((PG8_LAS unsigned char*)lds, g, S, E); }
    }
    if constexpr (PH == 11) {
        const f32x4* sl = (const f32x4*)(ws + WS_SLAB); f32x4* y = (f32x4*)(args.out + OFF_Y + (size_t)MP * DM); const u32x2* hb = (const u32x2*)((const bf16*)(ws + WS_HB) + (size_t)MP * DM); constexpr int NV = MS * DM / 4;
        for (int i = blockIdx.x * 512 + tid; i < NV; i += gridDim.x * 512) { const u32x2 hw = hb[i]; const f32x4 h = {bflo(hw.x), bfhi(hw.x), bflo(hw.y), bfhi(hw.y)};
            y[i] = h + ((sl[i] + sl[i + NV]) + (sl[i + 2 * NV] + sl[i + 3 * NV])); }
    }
}
#ifndef MK_ONE_LAUNCH
#define MK_ONE_LAUNCH 1
#endif
#if MK_ONE_LAUNCH
__global__ void __launch_bounds__(512, 2) mk_fwd(Args args) {
    extern __shared__ __attribute__((aligned(16))) unsigned char lds[];
    const int tid = threadIdx.x;
    volatile __attribute__((address_space(3))) unsigned* bst = (volatile __attribute__((address_space(3))) unsigned*)((__attribute__((address_space(3))) unsigned char*)lds + LDS_BYTES - 16);
    if (tid < 2) bst[tid] = 0u;
    __syncthreads();
    const XcdBarrier bar = xcd_barrier_post((unsigned*)(args.ws + WS_CTL) + CW_BAR, bst);
    if (args.ph_lo < 0) { __syncthreads(); cg::this_grid().sync(); }
#define SEAM(k) xcd_barrier(bar)
#define PHASE(k) do { if (args.ph_lo <= (k) && (k) < args.ph_hi) { if ((k) > args.ph_lo) SEAM(k); run_phase<k>(args, lds, tid, 0); \
        if ((PROBE_MASK >> (k)) & 1) { xcd_barrier(bar); run_phase<k>(args, lds, tid, 1); } } } while (0)
    PHASE(0); PHASE(1); PHASE(2); PHASE(3); PHASE(4); PHASE(5); PHASE(6); PHASE(7); PHASE(9); PHASE(10); PHASE(11);
#undef PHASE
#undef SEAM
}
#else
template <int PH> __global__ void __launch_bounds__(512, 2) mk_phase(Args args) {
    extern __shared__ __attribute__((aligned(16))) unsigned char lds[];
    run_phase<PH>(args, lds, threadIdx.x, 0);
}
#endif

extern "C" void kernel_launch(void* const* d_in, const int* in_sizes, int n_in, void* d_out, int out_size, void* d_ws, size_t ws_size, hipStream_t stream) {
    static int grid = 0;
    if (grid == 0) {
        if (n_in != 28 || out_size != (int)OUT_TOTAL || ws_size < WS_END) { fprintf(stderr, "kernel_launch: unexpected shapes (n_in %d, out %d, ws %zu)\n", n_in, out_size, ws_size); grid = -1; return; }
        int dev = 0, cus = 0, per_cu = 0;
        (void)hipGetDevice(&dev); (void)hipDeviceGetAttribute(&cus, hipDeviceAttributeMultiprocessorCount, dev);
#if MK_ONE_LAUNCH
        if (hipFuncSetAttribute((const void*)mk_fwd, hipFuncAttributeMaxDynamicSharedMemorySize, LDS_BYTES) != hipSuccess) { fprintf(stderr, "kernel_launch: hipFuncSetAttribute failed\n"); grid = -1; return; }
        (void)hipOccupancyMaxActiveBlocksPerMultiprocessor(&per_cu, (const void*)mk_fwd, 512, LDS_BYTES);
        (void)hipGetLastError();
        if (per_cu < 1) { fprintf(stderr, "kernel_launch: occupancy query says %d blocks per CU\n", per_cu); per_cu = 1; }
#else
#define SETATTR(k) (void)hipFuncSetAttribute((const void*)mk_phase<k>, hipFuncAttributeMaxDynamicSharedMemorySize, LDS_BYTES)
        SETATTR(0); SETATTR(1); SETATTR(2); SETATTR(3); SETATTR(4); SETATTR(5); SETATTR(6); SETATTR(7); SETATTR(8); SETATTR(9); SETATTR(10); SETATTR(11);
#undef SETATTR
        (void)per_cu;
#endif
        grid = cus;
    }
    if (grid < 0) return;
    (void)hipMemsetAsync((char*)d_ws + WS_CTL, 0, CTL_BYTES, stream);
    Args a{};
    for (int i = 0; i < 28; ++i) a.in[i] = (const float*)d_in[i];
    a.out = (float*)d_out; a.ws = (unsigned char*)d_ws;
#if MK_ONE_LAUNCH
    a.ph_lo = 0; a.ph_hi = N_PHASES;
    void* kargs[] = {&a};
    hipError_t e = hipLaunchCooperativeKernel((const void*)mk_fwd, dim3(grid), dim3(512), kargs, LDS_BYTES, stream);
    if (e != hipSuccess) fprintf(stderr, "kernel_launch: cooperative launch failed: %s (grid %d)\n", hipGetErrorString(e), grid);
#else
#define LAUNCH(k) hipLaunchKernelGGL(mk_phase<k>, dim3(grid), dim3(512), LDS_BYTES, stream, a)
    a.ph_lo = 0; a.ph_hi = N_PHASES;
    LAUNCH(0); LAUNCH(1); LAUNCH(2); LAUNCH(3); LAUNCH(4); LAUNCH(5); LAUNCH(6); LAUNCH(7); LAUNCH(9); LAUNCH(10); LAUNCH(11);
#undef LAUNCH
#endif
}
```

```cpp
#include <hip/hip_runtime.h>
#include <hip/hip_cooperative_groups.h>
#include <cstdio>
#include <cstdint>
namespace cg = cooperative_groups;
#define LBAR() asm volatile("s_waitcnt lgkmcnt(0)\n\ts_barrier" ::: "memory")
#define PROBE_A1 0
#define PROBE_A2 0
#define PROBE_A3 0
namespace pg8 {
#define PG8_LAS __attribute__((address_space(3)))
typedef unsigned short bf16_t;
typedef short bf16x8 __attribute__((ext_vector_type(8)));
typedef float f32x4 __attribute__((ext_vector_type(4)));
typedef unsigned u32x4 __attribute__((ext_vector_type(4)));
constexpr int BM = 256, BK = 64, HALF = 128, HTB = HALF * BK * 2  , STAGE_BYTES = 8 * HTB, NXCD = 8, WGM = 8;

__host__ __device__ __forceinline__ int lds_byte(int r, int c) { const int st = (r >> 4) * 2 + (c >> 5), rr = r & 15, cc = c & 31, ob = rr * 64 + cc * 2; return st * 1024 + (ob ^ (((ob >> 9) & 1) << 5)); }
__host__ __device__ __forceinline__ void stage_rc(int b, int& R, int& C) { const int st = b / 1024, sb = b % 1024, swz = sb ^ (((sb >> 9) & 1) << 5); R = (st >> 1) * 16 + swz / 64; C = (st & 1) * 32 + (swz % 64) / 2; }
__host__ __device__ __forceinline__ int perm32(int rho) { const int n = rho >> 4, i = rho & 15; return 8 * (i >> 2) + 4 * n + (i & 3); }

struct Unit { int pm, pn; };
struct Gemm { const bf16_t* A; const bf16_t* Bt; int M, N, K, KL; };

struct StaticOrder {
    int nM, nN, nwg, G, c;
    __host__ __device__ void init(int M, int N, int G_, int c_) { nM = M / BM; nN = N / BM; nwg = nM * nN; G = G_; c = c_; }
    __host__ __device__ bool next(int i, Unit& u) const {
        const long L = (long)i * G + c; if (L >= nwg) return false;
        int wgid = (int)L; { const int q = nwg / NXCD, r = nwg % NXCD, xcd = wgid % NXCD, off = wgid / NXCD; wgid = (xcd < r ? xcd * (q + 1) : r * (q + 1) + (xcd - r) * q) + off; }
        const int nig = WGM * nN, gid = wgid / nig, fm = gid * WGM, gsz = (nM - fm) < WGM ? (nM - fm) : WGM;
        u.pm = fm + ((wgid % nig) % gsz); u.pn = (wgid % nig) / gsz; return true;
    }
    __device__ __forceinline__ void a_ready(const Unit&) const {}
    __device__ __forceinline__ void done(const Unit&) const {}
};


__device__ __forceinline__ unsigned cvt_pk_bf16(float lo, float hi) { unsigned r; asm volatile("v_cvt_pk_bf16_f32 %0, %1, %2" : "=v"(r) : "v"(lo), "v"(hi)); return r; }
typedef float cv_f32x2 __attribute__((ext_vector_type(2))); typedef __bf16 cv_bf16x2 __attribute__((ext_vector_type(2)));
__device__ __forceinline__ unsigned cvt2_safe(float lo, float hi) { const cv_f32x2 v = {lo, hi}; const cv_bf16x2 b = __builtin_convertvector(v, cv_bf16x2); return __builtin_bit_cast(unsigned, b); }

constexpr int E_MP = 16384;
constexpr int E_ZRW = 1632, E_ZSW = 1696;

struct OneUnit { Unit u; bool has;
    __device__ __forceinline__ bool next(int i, Unit& o) const { if (i == 0 && has) { o = u; return true; } return false; }
    __device__ __forceinline__ void a_ready(const Unit&) const {}
    __device__ __forceinline__ void done(const Unit&) const {} };
struct EpiZ {
    static constexpr bool PERM = true, AFTER_DRAIN = false;
    bf16_t* ZR; bf16_t* ZS;
    __device__ __forceinline__ void operator()(const f32x4 (&acc)[2][2][4][2], const Unit& u, int wr, int wc, int fr, int fq) const {
        const int row0 = u.pm * BM + wr * 64 + fr, c0 = u.pn * BM + wc * 32 + 8 * fq;
#pragma unroll
        for (int ai = 0; ai < 2; ++ai)
#pragma unroll
            for (int m = 0; m < 4; ++m) { const size_t row = (size_t)(row0 + ai * HALF + m * 16);
#pragma unroll
                for (int bj = 0; bj < 2; ++bj) { const int c = c0 + bj * HALF; bf16_t* dst;
                    if (c < 1600) dst = ZR + row * E_ZRW + c; else if (c < 3296) dst = ZS + row * E_ZSW + (c - 1600); else if (c == 3296) dst = ZR + row * E_ZRW + 1600; else continue;
                    const f32x4 v0 = acc[ai][bj][m][0], v1 = acc[ai][bj][m][1]; u32x4 w;
                    w.x = cvt2_safe(v0[0], v0[1]); w.y = cvt2_safe(v0[2], v0[3]); w.z = cvt2_safe(v1[0], v1[1]); w.w = cvt2_safe(v1[2], v1[3]);
                    *(u32x4*)dst = w; } }
    }
};
struct EpiH {
    static constexpr bool PERM = false, AFTER_DRAIN = false;
    const float* xp; const float* xs; float* H; bf16_t* HB; float* SS;
    __device__ __forceinline__ void operator()(const f32x4 (&acc)[2][2][4][2], const Unit& u, int wr, int wc, int fr, int fq) const {
        const int row0 = u.pm * BM + wr * 64 + fr, col0 = u.pn * BM + wc * 32 + 4 * fq;
#pragma unroll
        for (int ai = 0; ai < 2; ++ai)
#pragma unroll
            for (int m = 0; m < 4; ++m) { const int row = row0 + ai * HALF + m * 16;
                const float* xr = (row < E_MP ? xp + (size_t)row * 1024 : xs + (size_t)(row - E_MP) * 1024) + col0; bf16_t* hb = HB + (size_t)row * 1024 + col0;
                float ss = 0.f;
#pragma unroll
                for (int bj = 0; bj < 2; ++bj)
#pragma unroll
                    for (int n = 0; n < 2; ++n) { const f32x4 h = *(const f32x4*)(xr + bj * HALF + n * 16) + acc[ai][bj][m][n];
                        ss += (h[0] * h[0] + h[1] * h[1]) + (h[2] * h[2] + h[3] * h[3]);
                        unsigned w0 = cvt_pk_bf16(h[0], h[1]), w1 = cvt_pk_bf16(h[2], h[3]); typedef unsigned u32x2v __attribute__((ext_vector_type(2))); *(u32x2v*)(hb + bj * HALF + n * 16) = (u32x2v){w0, w1}; }
                ss += __shfl_xor(ss, 16); ss += __shfl_xor(ss, 32);
                if (fq == 0) atomicAdd(SS + row, ss); }
    }
};
struct EpiAct {
    static constexpr bool PERM = true, AFTER_DRAIN = false;
    bf16_t* O; int ldc; const float* SS;
    __device__ __forceinline__ void operator()(const f32x4 (&acc)[2][2][4][2], const Unit& u, int wr, int wc, int fr, int fq) const {
        const int row0 = u.pm * BM + wr * 64 + fr, c0 = u.pn * BM + wc * 32 + 8 * fq;
#pragma unroll
        for (int ai = 0; ai < 2; ++ai)
#pragma unroll
            for (int m = 0; m < 4; ++m) { const int row = row0 + ai * HALF + m * 16; bf16_t* rowp = O + (size_t)row * ldc + c0;
                const float rs = rsqrtf(SS[row] * (1.0f / 1024.0f) + 1e-6f);
#pragma unroll
                for (int bj = 0; bj < 2; ++bj) { f32x4 v0 = acc[ai][bj][m][0], v1 = acc[ai][bj][m][1];
#pragma unroll
                    for (int e = 0; e < 4; ++e) { const float a = fmaxf(v0[e], 0.f) * rs, b = fmaxf(v1[e], 0.f) * rs; v0[e] = a * a; v1[e] = b * b; }
                    u32x4 w; w.x = cvt_pk_bf16(v0[0], v0[1]); w.y = cvt_pk_bf16(v0[2], v0[3]); w.z = cvt_pk_bf16(v1[0], v1[1]); w.w = cvt_pk_bf16(v1[2], v1[3]);
                    *(u32x4*)(rowp + bj * HALF) = w; } }
    }
};
struct EpiSlab {
    static constexpr bool PERM = false, AFTER_DRAIN = false;
    float* S;
    __device__ __forceinline__ void operator()(const f32x4 (&acc)[2][2][4][2], const Unit& u, int wr, int wc, int fr, int fq) const {
        const int row0 = u.pm * BM - E_MP + wr * 64 + fr, col0 = u.pn * BM + wc * 32 + 4 * fq;
#pragma unroll
        for (int ai = 0; ai < 2; ++ai)
#pragma unroll
            for (int m = 0; m < 4; ++m) { float* yr = S + (size_t)(row0 + ai * HALF + m * 16) * 1024 + col0;
#pragma unroll
                for (int bj = 0; bj < 2; ++bj)
#pragma unroll
                    for (int n = 0; n < 2; ++n) *(f32x4*)(yr + bj * HALF + n * 16) = acc[ai][bj][m][n]; }
    }
};
struct EpiY {
    static constexpr bool PERM = false, AFTER_DRAIN = false;
    float* Y; const bf16_t* HB;
    __device__ __forceinline__ void operator()(const f32x4 (&acc)[2][2][4][2], const Unit& u, int wr, int wc, int fr, int fq) const {
        const int row0 = u.pm * BM + wr * 64 + fr, col0 = u.pn * BM + wc * 32 + 4 * fq;
        typedef unsigned u32x2v __attribute__((ext_vector_type(2)));
#pragma unroll
        for (int ai = 0; ai < 2; ++ai)
#pragma unroll
            for (int m = 0; m < 4; ++m) { const size_t ro = (size_t)(row0 + ai * HALF + m * 16) * 1024 + col0;
#pragma unroll
                for (int bj = 0; bj < 2; ++bj)
#pragma unroll
                    for (int n = 0; n < 2; ++n) { const u32x2v hw = *(const u32x2v*)(HB + ro + bj * HALF + n * 16);
                        const f32x4 h = {__uint_as_float(hw.x << 16), __uint_as_float(hw.x & 0xffff0000u), __uint_as_float(hw.y << 16), __uint_as_float(hw.y & 0xffff0000u)};
                        *(f32x4*)(Y + ro + bj * HALF + n * 16) = h + acc[ai][bj][m][n]; } }
    }
};

template <class Epi, class Sched, bool ALIGN_EPI = false, bool SP2 = false>
__device__ __forceinline__ void gemm_phase(PG8_LAS unsigned char* lds, const Gemm g, const Sched& S, const Epi& E) {
    const int tid = threadIdx.x, wid = __builtin_amdgcn_readfirstlane(tid >> 6), lane = tid & 63, wr = wid >> 2, wc = wid & 3, fr = lane & 15, fq = lane >> 4;
    const int K = g.K, nt = g.KL / BK;
    unsigned voffA[2], voffB[2];
#pragma unroll
    for (int i = 0; i < 2; ++i) { int R, C; stage_rc(tid * 16 + i * 8192, R, C); const int Rb = Epi::PERM ? ((R & ~31) + perm32(R & 31)) : R;
        voffA[i] = (unsigned)(R * K + C) * 2u; voffB[i] = (unsigned)(Rb * K + C) * 2u; }
    const size_t kstep = (size_t)(BK * 2);
    const size_t hstep = (size_t)HALF * K * 2;
    const size_t tstep = 2 * hstep;
    const unsigned ldsw = (unsigned)wid * 1024u;
    const int aoff = lds_byte(wr * 64 + fr, fq * 8), boff = lds_byte(wc * 32 + fr, fq * 8);
#define PG8_SA(b, h) (((b) * 2 + (h)) * HTB)
#define PG8_SB(b, h) ((4 + (b) * 2 + (h)) * HTB)
#define PG8_STAGE(bufoff, gbase, voff) do { _Pragma("unroll") for (int _i = 0; _i < 2; ++_i) \
        __builtin_amdgcn_global_load_lds((const unsigned*)((const char*)(gbase) + (voff)[_i]), (PG8_LAS unsigned*)(lds + (bufoff) + ldsw + _i * 8192), 16, 0, 0); } while (0)
#define PG8_LDA(dst, b, h) do { _Pragma("unroll") for (int m = 0; m < 4; ++m) _Pragma("unroll") for (int k = 0; k < 2; ++k) dst[m][k] = *(const PG8_LAS bf16x8*)(lds + PG8_SA(b, h) + aoff + m * 2048 + k * 1024); } while (0)
#define PG8_LDB(dst, b, h) do { _Pragma("unroll") for (int n = 0; n < 2; ++n) _Pragma("unroll") for (int k = 0; k < 2; ++k) dst[n][k] = *(const PG8_LAS bf16x8*)(lds + PG8_SB(b, h) + boff + n * 2048 + k * 1024); } while (0)
#define PG8_MMA(ai, bj, At, Bt) do { __builtin_amdgcn_s_setprio(1); _Pragma("unroll") for (int m = 0; m < 4; ++m) _Pragma("unroll") for (int n = 0; n < 2; ++n) _Pragma("unroll") for (int k = 0; k < 2; ++k) \
        acc[ai][bj][m][n] = __builtin_amdgcn_mfma_f32_16x16x32_bf16(Bt[n][k], At[m][k], acc[ai][bj][m][n], 0, 0, 0); __builtin_amdgcn_s_setprio(0); } while (0)
#define PG8_WAIT_V(n) asm volatile("s_waitcnt vmcnt(" #n ")" ::: "memory")
#define PG8_WAIT_L(n) asm volatile("s_waitcnt lgkmcnt(" #n ")" ::: "memory")
#define PG8_BAR __builtin_amdgcn_s_barrier()
#define PG8_SCHED __builtin_amdgcn_sched_barrier(0)
    Unit cur, nxt; int ui = 0;
    if (!S.next(0, cur)) return;
    f32x4 acc[2][2][4][2];
#pragma unroll
    for (int a = 0; a < 2; ++a)
#pragma unroll
        for (int b = 0; b < 2; ++b)
#pragma unroll
            for (int m = 0; m < 4; ++m)
#pragma unroll
                for (int n = 0; n < 2; ++n) acc[a][b][m][n] = (f32x4){0.f, 0.f, 0.f, 0.f};
    bf16x8 At[4][2], B0[2][2], B1[2][2];
    const char* cA = (const char*)g.A + (size_t)cur.pm * tstep; const char* cB = (const char*)g.Bt + (size_t)cur.pn * tstep;
    S.a_ready(cur);
    if constexpr (SP2) {
        PG8_STAGE(PG8_SB(0, 0), cB, voffB); PG8_STAGE(PG8_SB(0, 1), cB + hstep, voffB); PG8_STAGE(PG8_SA(0, 0), cA, voffA); PG8_STAGE(PG8_SA(0, 1), cA + hstep, voffA);
        if (wr == 1) PG8_BAR;
        PG8_WAIT_V(2); PG8_BAR;
        PG8_STAGE(PG8_SB(1, 0), cB + kstep, voffB); PG8_STAGE(PG8_SA(1, 0), cA + kstep, voffA); PG8_STAGE(PG8_SB(1, 1), cB + hstep + kstep, voffB);
        PG8_WAIT_V(6); PG8_BAR;
    } else {
        PG8_STAGE(PG8_SB(0, 0), cB, voffB); PG8_STAGE(PG8_SA(0, 0), cA, voffA); PG8_STAGE(PG8_SB(0, 1), cB + hstep, voffB); PG8_STAGE(PG8_SA(0, 1), cA + hstep, voffA);
        if (wr == 1) PG8_BAR;
        PG8_WAIT_V(4); PG8_BAR;
        PG8_STAGE(PG8_SB(1, 0), cB + kstep, voffB); PG8_STAGE(PG8_SA(1, 0), cA + kstep, voffA); PG8_STAGE(PG8_SB(1, 1), cB + hstep + kstep, voffB);
        PG8_WAIT_V(6); PG8_BAR;
    }
    for (;;) {
        const bool has_next = S.next(ui + 1, nxt);
        const char* nA = has_next ? (const char*)g.A + (size_t)nxt.pm * tstep : cA; const char* nB = has_next ? (const char*)g.Bt + (size_t)nxt.pn * tstep : cB;
        for (int t = 0; t < nt; t += 2) {
            const bool last = (t == nt - 2);
            const char* a1 = cA + (size_t)(t + 1) * kstep;
            const char* a2 = last ? nA : cA + (size_t)(t + 2) * kstep; const char* b2 = last ? nB : cB + (size_t)(t + 2) * kstep;
            const char* a3 = a2 + kstep; const char* b3 = b2 + kstep;
            if (last && has_next) S.a_ready(nxt);
            if constexpr (SP2) {
            PG8_LDB(B0, 0, 0); PG8_LDB(B1, 0, 1); PG8_SCHED; PG8_LDA(At, 0, 0); PG8_STAGE(PG8_SA(1, 1), a1 + hstep, voffA);
            PG8_WAIT_V(8); PG8_WAIT_L(0); PG8_BAR; PG8_MMA(0, 0, At, B0); PG8_MMA(0, 1, At, B1); PG8_BAR; PG8_SCHED;
            PG8_LDA(At, 0, 1); PG8_STAGE(PG8_SB(0, 0), b2, voffB); PG8_STAGE(PG8_SB(0, 1), b2 + hstep, voffB); PG8_STAGE(PG8_SA(0, 0), a2, voffA);
            PG8_WAIT_V(8); PG8_WAIT_L(0); PG8_BAR; PG8_MMA(1, 0, At, B0); PG8_MMA(1, 1, At, B1); PG8_BAR; PG8_SCHED;
            PG8_LDB(B0, 1, 0); PG8_LDB(B1, 1, 1); PG8_SCHED; PG8_LDA(At, 1, 0); PG8_STAGE(PG8_SA(0, 1), a2 + hstep, voffA);
            PG8_WAIT_V(8); PG8_WAIT_L(0); PG8_BAR; PG8_MMA(0, 0, At, B0); PG8_MMA(0, 1, At, B1); PG8_BAR; PG8_SCHED;
            PG8_LDA(At, 1, 1); PG8_STAGE(PG8_SB(1, 0), b3, voffB); PG8_STAGE(PG8_SB(1, 1), b3 + hstep, voffB); PG8_STAGE(PG8_SA(1, 0), a3, voffA);
            PG8_WAIT_V(8); PG8_WAIT_L(0); PG8_BAR; PG8_MMA(1, 0, At, B0); PG8_MMA(1, 1, At, B1); PG8_BAR; PG8_SCHED;
            } else {
            PG8_LDB(B0, 0, 0); PG8_SCHED; PG8_LDA(At, 0, 0); PG8_STAGE(PG8_SA(1, 1), a1 + hstep, voffA);
            PG8_WAIT_L(8); PG8_BAR; PG8_WAIT_L(0); PG8_MMA(0, 0, At, B0); PG8_BAR; PG8_SCHED;
            PG8_LDB(B1, 0, 1); PG8_STAGE(PG8_SB(0, 0), b2, voffB);
            PG8_BAR; PG8_WAIT_L(0); PG8_MMA(0, 1, At, B1); PG8_BAR;
            PG8_LDA(At, 0, 1); PG8_STAGE(PG8_SA(0, 0), a2, voffA);
            PG8_BAR; PG8_WAIT_L(0); PG8_MMA(1, 0, At, B0); PG8_BAR; PG8_SCHED;
            PG8_STAGE(PG8_SB(0, 1), b2 + hstep, voffB);
            PG8_WAIT_V(6); PG8_BAR; PG8_MMA(1, 1, At, B1); PG8_BAR;
            PG8_LDB(B0, 1, 0); PG8_SCHED; PG8_LDA(At, 1, 0); PG8_STAGE(PG8_SA(0, 1), a2 + hstep, voffA);
            PG8_WAIT_L(8); PG8_BAR; PG8_WAIT_L(0); PG8_MMA(0, 0, At, B0); PG8_BAR; PG8_SCHED;
            PG8_LDB(B1, 1, 1); PG8_STAGE(PG8_SB(1, 0), b3, voffB);
            PG8_BAR; PG8_WAIT_L(0); PG8_MMA(0, 1, At, B1); PG8_BAR;
            PG8_LDA(At, 1, 1); PG8_STAGE(PG8_SA(1, 0), a3, voffA);
            PG8_BAR; PG8_WAIT_L(0); PG8_MMA(1, 0, At, B0); PG8_BAR; PG8_SCHED;
            PG8_STAGE(PG8_SB(1, 1), b3 + hstep, voffB);
            PG8_WAIT_V(6); PG8_BAR; PG8_MMA(1, 1, At, B1); PG8_BAR;
            }
        }
        if constexpr (ALIGN_EPI) { if (wr == 0) PG8_BAR; }
        if constexpr (!Epi::AFTER_DRAIN) { E(acc, cur, wr, wc, fr, fq); S.done(cur); }
        if (!has_next) break;
#pragma unroll
        for (int a = 0; a < 2; ++a)
#pragma unroll
            for (int b = 0; b < 2; ++b)
#pragma unroll
                for (int m = 0; m < 4; ++m)
#pragma unroll
                    for (int n = 0; n < 2; ++n) acc[a][b][m][n] = (f32x4){0.f, 0.f, 0.f, 0.f};
        cur = nxt; cA = nA; cB = nB; ++ui;
        if constexpr (ALIGN_EPI) { if (wr == 1) PG8_BAR; }
    }
    PG8_WAIT_V(0);
    if constexpr (!ALIGN_EPI) { if (wr == 0) PG8_BAR; }
    PG8_BAR;
    if constexpr (Epi::AFTER_DRAIN) { E.fused(acc, cur, wr, wc, fr, fq, lds, wid, lane); S.done(cur); }
#undef PG8_SA
#undef PG8_SB
#undef PG8_STAGE
#undef PG8_LDA
#undef PG8_LDB
#undef PG8_MMA
#undef PG8_WAIT_V
#undef PG8_WAIT_L
#undef PG8_BAR
#undef PG8_SCHED
}
}


constexpr int DM = 1024, NB_P = 8, T_P = 2048, NB_S = 32, T_S = 32, PAST = 1024;
constexpr int MP = NB_P * T_P, MS = NB_S * T_S, MT = MP + MS;
constexpr int LS = PAST + T_S;
constexpr int SHIFTW = 1696, NZ = 3328, ZRW = 1632, DFF = 4096;
constexpr float QSCALE = 0.125f * 1.4426950408889634f;
constexpr float WISCALE = 0.35355339059327373f * 0.125f;
constexpr size_t OFF_Y = 0, OFF_KP = 17825792, OFF_VP = OFF_KP + 4194304, OFF_KIP = OFF_VP + 4194304, OFF_WKVP = OFF_KIP + 1048576, OFF_SHP = OFF_WKVP + 262144,
                 OFF_KS = OFF_SHP + 13568, OFF_VS = OFF_KS + 262144, OFF_KIS = OFF_VS + 262144, OFF_WKVS = OFF_KIS + 65536, OFF_SHS = OFF_WKVS + 1048576, OUT_TOTAL = OFF_SHS + 54272;
constexpr size_t MiB = 1u << 20;
constexpr size_t WS_CTL = 0, CTL_BYTES = 1 * MiB;
constexpr size_t WS_WIN = 1 * MiB, WS_WOUT = 8 * MiB, WS_W1 = 10 * MiB, WS_W2 = 18 * MiB;
constexpr size_t WS_W2T = 26 * MiB, WS_A2T = WS_W2T + 32768, WS_G2T = WS_A2T + 32768, WS_WI = 27 * MiB, WS_BONUS = 28 * MiB;
constexpr size_t WS_XB = 30 * MiB;
constexpr size_t WS_ZS = 66 * MiB;
constexpr size_t WS_R = 123 * MiB;
constexpr size_t WS_ZR = WS_R, WS_KBP = 178 * MiB, WS_VTP = 186 * MiB, WS_KIP = 194 * MiB, WS_KBS = 196 * MiB, WS_VTS = 213 * MiB, WS_KIS = 230 * MiB;
constexpr size_t WS_OW = WS_R, WS_OKK = 157 * MiB, WS_OB = 174 * MiB, WS_OKM = 191 * MiB, WS_OR = 208 * MiB, WS_OV = 225 * MiB;
constexpr size_t WS_ACT = 66 * MiB, WS_HB = 202 * MiB, WS_SLAB = 238 * MiB, WS_END = 256 * MiB;
static_assert(WS_ZS + (size_t)MT * SHIFTW * 2 <= WS_R && WS_ZR + (size_t)MT * ZRW * 2 <= WS_KBP && WS_KBS + (size_t)NB_S * LS * 256 * 2 <= WS_VTS && WS_VTS + (size_t)NB_S * 256 * LS * 2 <= WS_KIS &&
              WS_KIS + (size_t)NB_S * LS * 64 * 2 <= WS_END && WS_OV + (size_t)MT * 512 * 2 <= WS_END && WS_ACT + (size_t)MT * DFF * 2 <= WS_HB && WS_HB + (size_t)MT * DM * 2 <= WS_END, "d_ws map");
constexpr size_t SC_Q = 0, SC_QI = (size_t)MT * 512 / 2, SC_Y = 0, SC_G = (size_t)MT * 512;
constexpr int CW_QATT = 64, CW_SS = 16384;

typedef unsigned short bf16;
typedef short bf16x8 __attribute__((ext_vector_type(8)));
typedef float f32x4 __attribute__((ext_vector_type(4)));
typedef float f32x16 __attribute__((ext_vector_type(16)));
typedef unsigned u32x4 __attribute__((ext_vector_type(4)));
typedef unsigned u32x2 __attribute__((ext_vector_type(2)));

__device__ __forceinline__ unsigned f2bf(float f) { unsigned u = __float_as_uint(f); return (u + 0x7fffu + ((u >> 16) & 1u)) >> 16; }
__device__ __forceinline__ unsigned pk2(float lo, float hi) { return f2bf(lo) | (f2bf(hi) << 16); }
__device__ __forceinline__ float bflo(unsigned w) { return __uint_as_float(w << 16); }
__device__ __forceinline__ float bfhi(unsigned w) { return __uint_as_float(w & 0xffff0000u); }
__device__ __forceinline__ float bf1(bf16 b) { return __uint_as_float((unsigned)b << 16); }
__device__ __forceinline__ void unpack8(const u32x4 w, float* x) { x[0] = bflo(w.x); x[1] = bfhi(w.x); x[2] = bflo(w.y); x[3] = bfhi(w.y); x[4] = bflo(w.z); x[5] = bfhi(w.z); x[6] = bflo(w.w); x[7] = bfhi(w.w); }
__device__ __forceinline__ u32x4 pack8(const float* x) { u32x4 w; w.x = pk2(x[0], x[1]); w.y = pk2(x[2], x[3]); w.z = pk2(x[4], x[5]); w.w = pk2(x[6], x[7]); return w; }
__device__ __forceinline__ float wave_sum(float v) {
#pragma unroll
    for (int o = 1; o < 64; o <<= 1) v += __shfl_xor(v, o);
    return v;
}
template <int CTRL> __device__ __forceinline__ float dppmov(float x) { return __builtin_bit_cast(float, __builtin_amdgcn_update_dpp(0, __builtin_bit_cast(int, x), CTRL, 0xf, 0xf, true)); }
__device__ __forceinline__ float sum16(float x) {
    x += dppmov<0xB1>(x); x += dppmov<0x4E>(x); x += dppmov<0x141>(x); x += dppmov<0x140>(x); return x;
}
__device__ __forceinline__ int crow(int r, int hi) { return (r & 3) + 8 * (r >> 2) + 4 * hi; }

struct Args { const float* in[28]; float* out; unsigned char* ws; int ph_lo, ph_hi; };

__device__ __forceinline__ void tr_item(const float* W, int K, int N, const float* gain, bf16* WT, int jr0, int c0, int nvalid, int k0, float* scr, int lane) {
    { const int n = lane & 31; const bool ok = n < nvalid; const float* wp = W + (size_t)(k0 + (lane >> 5)) * N + c0 + (ok ? n : 0); float v[32];
#pragma unroll
      for (int i = 0; i < 32; ++i) v[i] = wp[(size_t)(2 * i) * N];
#pragma unroll
      for (int i = 0; i < 32; ++i) { const int kk = 2 * i + (lane >> 5); float x = ok ? v[i] : 0.f; if (gain) x *= gain[k0 + kk]; scr[kk * 33 + n] = x; } }
    __builtin_amdgcn_s_waitcnt(0xC07F); asm volatile("" ::: "memory");
    const int c = lane & 7;
#pragma unroll
    for (int j = 0; j < 4; ++j) { const int n = (lane >> 3) + 8 * j; const float* s = scr + (8 * c) * 33 + n;
        u32x4 o; o.x = pk2(s[0 * 33], s[1 * 33]); o.y = pk2(s[2 * 33], s[3 * 33]); o.z = pk2(s[4 * 33], s[5 * 33]); o.w = pk2(s[6 * 33], s[7 * 33]);
        *(u32x4*)(WT + (size_t)(jr0 + n) * K + k0 + 8 * c) = o; }
    __builtin_amdgcn_s_waitcnt(0xC07F); asm volatile("" ::: "memory");
}
__device__ __forceinline__ void p0_prologue(const Args& a, unsigned char* lds, int tid) {
    const int lane = tid & 63, wave = tid >> 6, gw = blockIdx.x * 8 + wave, NGW = gridDim.x * 8;
    float* scr = (float*)(lds + wave * 17408);
    unsigned char* ws = a.ws;
    constexpr int I_IN = (NZ / 32) * (DM / 64);
    for (int it = gw; it < I_IN; it += NGW) {
        const int jb = it % (NZ / 32), kb = it / (NZ / 32), j0 = jb * 32; int c0, nv;
        if (j0 < 1600) { c0 = j0; nv = 32; } else if (j0 < 3296) { c0 = 1608 + (j0 - 1600); nv = 32; } else { c0 = 1600; nv = 8; }
        tr_item(a.in[8], DM, 3304, a.in[7], (bf16*)(ws + WS_WIN), j0, c0, nv, kb * 64, scr, lane);
    }
    { const int gt = blockIdx.x * 512 + tid, NT = gridDim.x * 512;
      bf16* w2t = (bf16*)(ws + WS_W2T); bf16* a2t = (bf16*)(ws + WS_A2T); bf16* g2t = (bf16*)(ws + WS_G2T);
      for (int i = gt; i < 512 * 32; i += NT) { const int n = i >> 5, k = i & 31; w2t[i] = (bf16)f2bf(a.in[15][k * 512 + n]); a2t[i] = (bf16)f2bf(a.in[17][k * 512 + n]); }
      for (int i = gt; i < 512 * 96; i += NT) { const int n = i / 96, k = i % 96; g2t[i] = (bf16)f2bf(a.in[18][k * 512 + n]); } }
    { f32x4 v[4], nx[4]; int m = gw;
      if (m < MT) { const f32x4* xr = (const f32x4*)((m < MP) ? a.in[0] + (size_t)m * DM : a.in[1] + (size_t)(m - MP) * DM) + lane;
#pragma unroll
          for (int j = 0; j < 4; ++j) v[j] = xr[64 * j]; }
      for (; m < MT; m += NGW) {
        const int mn = m + NGW;
        if (mn < MT) { const f32x4* xr = (const f32x4*)((mn < MP) ? a.in[0] + (size_t)mn * DM : a.in[1] + (size_t)(mn - MP) * DM) + lane;
#pragma unroll
            for (int j = 0; j < 4; ++j) nx[j] = xr[64 * j]; }
        float s = 0.f;
#pragma unroll
        for (int j = 0; j < 4; ++j) s += (v[j].x * v[j].x + v[j].y * v[j].y) + (v[j].z * v[j].z + v[j].w * v[j].w);
        const float rs = rsqrtf(wave_sum(s) * (1.f / DM) + 1e-6f);
        u32x2* o8 = (u32x2*)((bf16*)(ws + WS_XB) + (size_t)m * DM) + lane;
#pragma unroll
        for (int j = 0; j < 4; ++j) { u32x2 o; o.x = pk2(v[j].x * rs, v[j].y * rs); o.y = pk2(v[j].z * rs, v[j].w * rs); o8[64 * j] = o; }
#pragma unroll
        for (int j = 0; j < 4; ++j) v[j] = nx[j];
      } }
    for (int r4 = gw; r4 < NB_S * PAST / 4; r4 += NGW) {
        f32x4 v[4];
#pragma unroll
        for (int j = 0; j < 4; ++j) v[j] = ((const f32x4*)(a.in[2] + (size_t)(4 * r4 + j) * 256))[lane];
#pragma unroll
        for (int j = 0; j < 4; ++j) { const int rix = 4 * r4 + j, b = rix >> 10, p = rix & 1023; u32x2 o; o.x = pk2(v[j].x, v[j].y); o.y = pk2(v[j].z, v[j].w);
            ((u32x2*)((bf16*)(ws + WS_KBS) + ((size_t)b * LS + p) * 256))[lane] = o; }
    }
    for (int r4 = gw; r4 < NB_S * PAST / 4; r4 += NGW) {
        const int rix = r4 * 4 + (lane >> 4), b = rix >> 10, p = rix & 1023; const f32x4 v = ((const f32x4*)(a.in[4] + (size_t)rix * 64))[lane & 15];
        u32x2 o; o.x = pk2(v.x, v.y); o.y = pk2(v.z, v.w); ((u32x2*)((bf16*)(ws + WS_KIS) + ((size_t)b * LS + p) * 64))[lane & 15] = o;
    }
    for (int it = gw; it < NB_S * 4 * 16; it += NGW) {
        const int kb = it & 15, g = (it >> 4) & 3, b = it >> 6;
        const float* src = a.in[3] + ((size_t)b * PAST + kb * 64) * 256 + g * 64;
#pragma unroll
        for (int hb2 = 0; hb2 < 2; ++hb2) { float v[32];
#pragma unroll
            for (int i = 0; i < 32; ++i) v[i] = src[(size_t)(32 * hb2 + i) * 256 + lane];
#pragma unroll
            for (int i = 0; i < 32; ++i) scr[(32 * hb2 + i) * 65 + lane] = v[i]; }
        __builtin_amdgcn_s_waitcnt(0xC07F); asm volatile("" ::: "memory");
        bf16* dst = (bf16*)(ws + WS_VTS) + (((size_t)b * (LS / 32) + 2 * kb + (lane >> 5)) * 256 + g * 64) * 32 + (lane & 31);
#pragma unroll 8
        for (int d = 0; d < 64; ++d) dst[d * 32] = (bf16)f2bf(scr[lane * 65 + d]);
        __builtin_amdgcn_s_waitcnt(0xC07F); asm volatile("" ::: "memory");
    }
}

__device__ __forceinline__ void p1_late_weights(const Args& a, unsigned char* lds, int tid, int part, int nparts) {
    const int lane = tid & 63, wave = tid >> 6, gw = part * 8 + wave, NGW = nparts * 8;
    float* scr = (float*)(lds + wave * 17408); unsigned char* ws = a.ws;
    constexpr int I_OUT = (DM / 32) * (DM / 64), I_F1 = (DFF / 32) * (DM / 64), I_F2 = (DM / 32) * (DFF / 64);
    for (int it = gw; it < I_OUT + I_F1 + I_F2; it += NGW) {
        int r = it;
        if (r < I_OUT) { const int jb = r % (DM / 32), kb = r / (DM / 32); tr_item(a.in[24], DM, DM, nullptr, (bf16*)(ws + WS_WOUT), jb * 32, jb * 32, 32, kb * 64, scr, lane); continue; }
        r -= I_OUT;
        if (r < I_F1) { const int jb = r % (DFF / 32), kb = r / (DFF / 32); tr_item(a.in[26], DM, DFF, a.in[25], (bf16*)(ws + WS_W1), jb * 32, jb * 32, 32, kb * 64, scr, lane); continue; }
        r -= I_F1;
        { const int jb = r % (DM / 32), kb = r / (DM / 32); tr_item(a.in[27], DFF, DM, nullptr, (bf16*)(ws + WS_W2), jb * 32, jb * 32, 32, kb * 64, scr, lane); }
    }
}

__device__ __forceinline__ void p2_post(const Args& a, unsigned char* lds, int tid) {
    unsigned char* ws = a.ws; float* out = a.out;
    const bf16* ZR = (const bf16*)(ws + WS_ZR); const bf16* ZS = (const bf16*)(ws + WS_ZS);
    bf16* Q = (bf16*)(out + SC_Q); bf16* QI = (bf16*)(out + SC_QI);
    float* cs = (float*)lds;
    bf16* vt = (bf16*)(lds + 4096);
    const int g8 = tid >> 3, sub = tid & 7;
    const float* qg = a.in[9]; const float* kg = a.in[10]; const float* lng = a.in[11]; const float* lnb = a.in[12];
    for (int unit = blockIdx.x; unit < 2 * (MT / 64); unit += gridDim.x) {
        const int tile = unit >> 1, part = unit & 1, hb0 = part ? 12 : 0, hb1 = part ? 25 : 12;
        const int m0 = tile * 64;
        { const int m = m0 + g8, pos = (m < MP) ? (m & (T_P - 1)) : (PAST + ((m - MP) & (T_S - 1)));
          const float inv = powf(500000.0f, -(float)sub * 0.125f); const float ang = (float)pos * inv; float s, c; sincosf(ang, &s, &c);
          cs[g8 * 16 + sub] = c; cs[g8 * 16 + 8 + sub] = s; }
        __syncthreads();
        const int m = m0 + g8;
        const bool isp = m < MP; const int ms = m - MP;
        float cc[8], ss[8];
#pragma unroll
        for (int j = 0; j < 8; ++j) { cc[j] = cs[g8 * 16 + j]; ss[j] = cs[g8 * 16 + 8 + j]; }
        const size_t kvrow = isp ? (size_t)m : ((size_t)(ms >> 5) * LS + PAST + (ms & 31));
        bf16* KB = (bf16*)(ws + (isp ? WS_KBP : WS_KBS)); bf16* KIb = (bf16*)(ws + (isp ? WS_KIP : WS_KIS));
        u32x4 xnext = *(const u32x4*)(ZR + (size_t)m * ZRW + hb0 * 64 + 8 * sub);
        for (int hb = hb0; hb < hb1; ++hb) {
            float x[8]; unpack8(xnext, x);
            if (hb + 1 < hb1) xnext = *(const u32x4*)(ZR + (size_t)m * ZRW + (hb + 1) * 64 + 8 * sub);
            if (hb < 12) {
                float s2 = 0.f;
#pragma unroll
                for (int j = 0; j < 8; ++j) s2 += x[j] * x[j];
                s2 += __shfl_xor(s2, 1); s2 += __shfl_xor(s2, 2); s2 += __shfl_xor(s2, 4);
                const float rinv = rsqrtf(s2 * (1.f / 64.f) + 1e-6f); const float* gn = (hb < 8 ? qg : kg) + 8 * sub;
                float y[8], o[8];
#pragma unroll
                for (int j = 0; j < 8; ++j) y[j] = x[j] * rinv * gn[j];
#pragma unroll
                for (int j = 0; j < 8; ++j) { const float p = __shfl_xor(y[j], 1); o[j] = sub == 0 ? y[j] * cc[j] - p * ss[j] : (sub == 1 ? y[j] * cc[j] + p * ss[j] : y[j]); }
                if (hb < 8) {
#pragma unroll
                    for (int j = 0; j < 8; ++j) o[j] *= QSCALE;
                    *(u32x4*)(Q + (size_t)m * 512 + hb * 64 + 8 * sub) = pack8(o);
                } else { const int g = hb - 8;
                    float* ko = out + (isp ? OFF_KP + (size_t)m * 256 : OFF_KS + (size_t)ms * 256) + g * 64 + 8 * sub;
                    *(f32x4*)ko = (f32x4){o[0], o[1], o[2], o[3]}; *(f32x4*)(ko + 4) = (f32x4){o[4], o[5], o[6], o[7]};
                    *(u32x4*)(KB + kvrow * 256 + g * 64 + 8 * sub) = pack8(o); }
            } else if (hb < 16) { const int g = hb - 12;
                float* vo = out + (isp ? OFF_VP + (size_t)m * 256 : OFF_VS + (size_t)ms * 256) + g * 64 + 8 * sub;
                *(f32x4*)vo = (f32x4){x[0], x[1], x[2], x[3]}; *(f32x4*)(vo + 4) = (f32x4){x[4], x[5], x[6], x[7]};
                unsigned* vd = (unsigned*)(vt + g8 * 258 + g * 64 + 8 * sub);
                vd[0] = pk2(x[0], x[1]); vd[1] = pk2(x[2], x[3]); vd[2] = pk2(x[4], x[5]); vd[3] = pk2(x[6], x[7]);
            } else if (hb < 24) {
                float o[8];
#pragma unroll
                for (int j = 0; j < 8; ++j) { const float p = __shfl_xor(x[j], 1); o[j] = sub == 0 ? x[j] * cc[j] - p * ss[j] : (sub == 1 ? x[j] * cc[j] + p * ss[j] : x[j]); }
                *(u32x4*)(QI + (size_t)m * 512 + (hb - 16) * 64 + 8 * sub) = pack8(o);
            } else {
                float s1 = 0.f;
#pragma unroll
                for (int j = 0; j < 8; ++j) s1 += x[j];
                s1 += __shfl_xor(s1, 1); s1 += __shfl_xor(s1, 2); s1 += __shfl_xor(s1, 4);
                const float mu = s1 * (1.f / 64.f); float s2 = 0.f;
#pragma unroll
                for (int j = 0; j < 8; ++j) { const float d = x[j] - mu; s2 += d * d; }
                s2 += __shfl_xor(s2, 1); s2 += __shfl_xor(s2, 2); s2 += __shfl_xor(s2, 4);
                const float rinv = rsqrtf(s2 * (1.f / 64.f) + 1e-6f); float y[8], o[8];
#pragma unroll
                for (int j = 0; j < 8; ++j) y[j] = (x[j] - mu) * rinv * lng[8 * sub + j] + lnb[8 * sub + j];
#pragma unroll
                for (int j = 0; j < 8; ++j) { const float p = __shfl_xor(y[j], 1); o[j] = sub == 0 ? y[j] * cc[j] - p * ss[j] : (sub == 1 ? y[j] * cc[j] + p * ss[j] : y[j]); }
                float* ko = out + (isp ? OFF_KIP + (size_t)m * 64 : OFF_KIS + (size_t)ms * 64) + 8 * sub;
                *(f32x4*)ko = (f32x4){o[0], o[1], o[2], o[3]}; *(f32x4*)(ko + 4) = (f32x4){o[4], o[5], o[6], o[7]};
                *(u32x4*)(KIb + kvrow * 64 + 8 * sub) = pack8(o);
            }
        }
        if (part == 0) ((float*)(ws + WS_WI))[(size_t)m * 8 + sub] = bf1(ZR[(size_t)m * ZRW + 1600 + sub]) * WISCALE;
        __syncthreads();
        if (part == 1) { const int r = tid >> 1, half = tid & 1; unsigned wv[16];
#pragma unroll
          for (int j = 0; j < 16; ++j) wv[j] = (unsigned)vt[(32 * half + 2 * j) * 258 + r] | ((unsigned)vt[(32 * half + 2 * j + 1) * 258 + r] << 16);
          bf16* dst;
          if (m0 < MP) dst = (bf16*)(ws + WS_VTP) + (((size_t)(m0 >> 11) * (T_P / 32) + ((m0 & (T_P - 1)) >> 5) + half) * 256 + r) * 32;
          else { const int b = ((m0 - MP) >> 5) + half; dst = (bf16*)(ws + WS_VTS) + (((size_t)b * (LS / 32) + PAST / 32) * 256 + r) * 32; }
#pragma unroll
          for (int j = 0; j < 4; ++j) ((u32x4*)dst)[j] = (u32x4){wv[4 * j], wv[4 * j + 1], wv[4 * j + 2], wv[4 * j + 3]}; }
        if (part == 0) {} else if (m0 < MP) { if ((m0 & (T_P - 1)) == T_P - 64) { const int b = m0 >> 11; const bf16* zr = ZS + (size_t)(m0 + 63) * SHIFTW;
                for (int c = tid; c < SHIFTW; c += 512) out[OFF_SHP + (size_t)b * SHIFTW + c] = bf1(zr[c]); } }
        else { for (int h2 = 0; h2 < 2; ++h2) { const int b = ((m0 - MP) >> 5) + h2; const bf16* zr = ZS + (size_t)(m0 + 32 * h2 + 31) * SHIFTW;
                for (int c = tid; c < SHIFTW; c += 512) out[OFF_SHS + (size_t)b * SHIFTW + c] = bf1(zr[c]); } }
        __syncthreads();
    }
}

constexpr int ATT_UNITS = 544;
constexpr int MASK_PITCH = 65;
#define MFMA32(a, b, c) __builtin_amdgcn_mfma_f32_32x32x16_bf16((a), (b), (c), 0, 0, 0)

__device__ __forceinline__ float half_sum32(float v) { v += __shfl_xor(v, 1); v += __shfl_xor(v, 2); v += __shfl_xor(v, 4); v += __shfl_xor(v, 8); v += __shfl_xor(v, 16); return v; }
__device__ __forceinline__ float half_min32(float v) { v = fminf(v, __shfl_xor(v, 1)); v = fminf(v, __shfl_xor(v, 2)); v = fminf(v, __shfl_xor(v, 4)); v = fminf(v, __shfl_xor(v, 8)); v = fminf(v, __shfl_xor(v, 16)); return v; }
__device__ __forceinline__ float half_max32(float v) { v = fmaxf(v, __shfl_xor(v, 1)); v = fmaxf(v, __shfl_xor(v, 2)); v = fmaxf(v, __shfl_xor(v, 4)); v = fmaxf(v, __shfl_xor(v, 8)); v = fmaxf(v, __shfl_xor(v, 16)); return v; }
__device__ __forceinline__ int half_sum32i(int v) { v += __shfl_xor(v, 1); v += __shfl_xor(v, 2); v += __shfl_xor(v, 4); v += __shfl_xor(v, 8); v += __shfl_xor(v, 16); return v; }

#define LAS3 __attribute__((address_space(3)))
constexpr int A_RING1 = 0, A_SCL = 24576, A_RING2 = 24576, A_MASK = 0, A_LSUM = 8320, A_UNIT = 9344;
__device__ __forceinline__ void p3_attention(const Args& a, unsigned char* lds, int tid, int rep) {
    unsigned char* ws = a.ws; float* out = a.out;
    const bf16* Q = (const bf16*)(out + SC_Q); const bf16* QI = (const bf16*)(out + SC_QI); const float* WI = (const float*)(ws + WS_WI);
    bf16* O = (bf16*)(ws + WS_XB);
    unsigned* maskw = (unsigned*)(lds + A_MASK);
    float* lsum = (float*)(lds + A_LSUM);
    int* s_unit = (int*)(lds + A_UNIT);
    typedef float f32x2_t __attribute__((ext_vector_type(2)));
    f32x2_t* scl = (f32x2_t*)(lds + A_SCL) + (size_t)(tid >> 6) * 2048 + (tid & 63);
    unsigned* qctr = (unsigned*)(ws + WS_CTL) + CW_QATT + 64 * rep;
    const int l = tid & 63, w = __builtin_amdgcn_readfirstlane(tid >> 6), rho = l & 31, hi = l >> 5;
    LAS3 unsigned char* ldsb = (LAS3 unsigned char*)lds;
    for (;;) {
        if (tid == 0) *s_unit = (int)atomicAdd(qctr, 1u);
        __syncthreads();
        const int p = *s_unit;
        __syncthreads();
        if (p >= ATT_UNITS) break;
        int m0, nkt, vpitch; const bf16 *KB, *VT, *KI; bool need_idx;
        { int c = -1, b, half = 0;
          if (p < 256) { c = 31 - (p >> 4); b = (p & 15) >> 1; half = p & 1; }
          else if (p < 288) { b = p - 256; }
          else { const int pp = p - 288; c = 15 - (pp >> 4); b = (pp & 15) >> 1; half = pp & 1; }
          if (c >= 0) { m0 = b * T_P + 64 * c + 32 * half; nkt = 2 * (c + 1); vpitch = T_P; need_idx = c >= 4;
              KB = (const bf16*)(ws + WS_KBP) + (size_t)b * T_P * 256; VT = (const bf16*)(ws + WS_VTP) + (size_t)b * (T_P / 32) * 8192; KI = (const bf16*)(ws + WS_KIP) + (size_t)b * T_P * 64; }
          else { m0 = MP + 32 * b; nkt = LS / 32; vpitch = LS; need_idx = true;
              KB = (const bf16*)(ws + WS_KBS) + (size_t)b * LS * 256; VT = (const bf16*)(ws + WS_VTS) + (size_t)b * (LS / 32) * 8192; KI = (const bf16*)(ws + WS_KIS) + (size_t)b * LS * 64; } }
        if (need_idx) {
            const int tokA = 4 * w + 2 * ((rho >> 2) & 1) + (rho >> 4), headA = (rho & 3) + 4 * ((rho >> 3) & 1);
            bf16x8 qa[4];
#pragma unroll
            for (int ks = 0; ks < 4; ++ks) qa[ks] = *(const bf16x8*)(QI + (size_t)(m0 + tokA) * 512 + headA * 64 + 16 * ks + 8 * hi);
            float wv[16];
#pragma unroll
            for (int r = 0; r < 16; ++r) wv[r] = WI[(size_t)(m0 + 4 * w + 2 * hi + (r >> 3)) * 8 + (r & 7)];
            asm volatile("" :: "v"(qa[0]), "v"(qa[1]), "v"(qa[2]), "v"(qa[3]));
#pragma unroll
            for (int r = 0; r < 16; ++r) asm volatile("" :: "v"(wv[r]));
            asm volatile("s_waitcnt vmcnt(0)" ::: "memory");
            float sc0[32], sc1[32];
            const int nb = (nkt + 1) >> 1;
            const int sr = 8 * w + (l >> 3), scn = (l & 7) ^ ((sr >> 1) & 7);
            const unsigned char* ksrc = (const unsigned char*)KI + (size_t)sr * 128 + 16 * scn;
#define KI_STAGE(it_) __builtin_amdgcn_global_load_lds((const unsigned*)(ksrc + (size_t)(it_) * 8192), (LAS3 unsigned*)(ldsb + A_RING1 + ((it_) % 3) * 8192 + w * 1024), 16, 0, 0)
            for (int rp1 = 0; rp1 <= PROBE_A1; ++rp1) {
            if (rp1) __syncthreads();
            KI_STAGE(0); if (1 < nb) KI_STAGE(1);
#pragma unroll
            for (int it = 0; it < 32; ++it) {
                if (it < nb) {
                    if (it + 1 < nb) asm volatile("s_waitcnt vmcnt(1) lgkmcnt(0)\n\ts_barrier" ::: "memory"); else asm volatile("s_waitcnt vmcnt(0) lgkmcnt(0)\n\ts_barrier" ::: "memory");
                    if (it + 2 < nb) KI_STAGE(it + 2);
                    const unsigned char* tb = lds + A_RING1 + (it % 3) * 8192;
#pragma unroll
                    for (int k2 = 0; k2 < 2; ++k2) { const int kt = 2 * it + k2;
                        if (kt < nkt) {
                            const int r = 32 * k2 + rho; const unsigned char* rowp = tb + r * 128; const int sw = (r >> 1) & 7;
                            f32x16 acc = {0.f, 0.f, 0.f, 0.f, 0.f, 0.f, 0.f, 0.f, 0.f, 0.f, 0.f, 0.f, 0.f, 0.f, 0.f, 0.f};
#pragma unroll
                            for (int ks = 0; ks < 4; ++ks) acc = MFMA32(qa[ks], *(const bf16x8*)(rowp + 16 * ((2 * ks + hi) ^ sw)), acc);
                            float s0 = 0.f, s1 = 0.f;
#pragma unroll
                            for (int r2 = 0; r2 < 8; ++r2) { s0 += wv[r2] * fmaxf(acc[r2], 0.f); s1 += wv[8 + r2] * fmaxf(acc[8 + r2], 0.f); }
                            if (kt < 32) { sc0[kt & 31] = s0; sc1[kt & 31] = s1; } else scl[(kt - 32) * 64] = (f32x2_t){s0, s1};
                        } else if (kt < 32) { sc0[kt & 31] = -3.0e38f; sc1[kt & 31] = -3.0e38f; }
                    }
                } else { if (2 * it < 32) { sc0[(2 * it) & 31] = -3.0e38f; sc1[(2 * it) & 31] = -3.0e38f; sc0[(2 * it + 1) & 31] = -3.0e38f; sc1[(2 * it + 1) & 31] = -3.0e38f; } }
            }
            }
#undef KI_STAGE
            __syncthreads();
            float mn0 = 3.0e38f, mx0 = -3.0e38f, mn1 = 3.0e38f, mx1 = -3.0e38f; int cp0 = 0, cz0 = 0, cp1 = 0, cz1 = 0;
#pragma unroll
            for (int kt = 0; kt < 64; ++kt) if (kt < nkt) { float v0, v1; if (kt < 32) { v0 = sc0[kt & 31]; v1 = sc1[kt & 31]; } else { const f32x2_t t2 = scl[(kt - 32) * 64]; v0 = t2.x; v1 = t2.y; }
                mn0 = fminf(mn0, v0); mx0 = fmaxf(mx0, v0); mn1 = fminf(mn1, v1); mx1 = fmaxf(mx1, v1);
                cp0 += v0 > 0.f ? 1 : 0; cz0 += v0 == 0.f ? 1 : 0; cp1 += v1 > 0.f ? 1 : 0; cz1 += v1 == 0.f ? 1 : 0; }
            mn0 = half_min32(mn0); mx0 = half_max32(mx0); mn1 = half_min32(mn1); mx1 = half_max32(mx1);
            cp0 = half_sum32i(cp0); cz0 = half_sum32i(cz0); cp1 = half_sum32i(cp1); cz1 = half_sum32i(cz1);
            float lo0, hi0, lo1, hi1, thr0 = 0.f, thr1 = 0.f; int ch0, ch1, nt0 = 0, nt1 = 0; bool fin0, fin1;
            for (int rp2 = 0; rp2 <= PROBE_A2; ++rp2) {
            fin0 = false; fin1 = false; ch0 = 0; ch1 = 0;
            if (cp0 >= 256) { lo0 = 0.f; hi0 = mx0; if (cp0 == 256) { fin0 = true; thr0 = 0.f; nt0 = 0; } }
            else if (cp0 + cz0 >= 256) { lo0 = 0.f; hi0 = 0.f; fin0 = true; thr0 = 0.f; nt0 = 256 - cp0; }
            else { lo0 = mn0 - 1.0f; hi0 = 0.f; ch0 = cp0; }
            if (cp1 >= 256) { lo1 = 0.f; hi1 = mx1; if (cp1 == 256) { fin1 = true; thr1 = 0.f; nt1 = 0; } }
            else if (cp1 + cz1 >= 256) { lo1 = 0.f; hi1 = 0.f; fin1 = true; thr1 = 0.f; nt1 = 256 - cp1; }
            else { lo1 = mn1 - 1.0f; hi1 = 0.f; ch1 = cp1; }
            asm volatile("" : "+v"(lo0), "+v"(lo1));
            for (int iter = 0; iter < 64; ++iter) {
                const float mid0 = lo0 + 0.5f * (hi0 - lo0), mid1 = lo1 + 0.5f * (hi1 - lo1);
                int c0 = 0, c1 = 0;
#pragma unroll
                for (int g = 0; g < 4; ++g) if (8 * g < nkt) {
#pragma unroll
                    for (int k8 = 0; k8 < 8; ++k8) { c0 += sc0[8 * g + k8] > mid0 ? 1 : 0; c1 += sc1[8 * g + k8] > mid1 ? 1 : 0; } }
                for (int kt = 32; kt < nkt; kt += 8) {
                    f32x2_t t8[8];
#pragma unroll
                    for (int u = 0; u < 8; ++u) t8[u] = scl[(kt + u - 32) * 64];
#pragma unroll
                    for (int u = 0; u < 8; ++u) if (kt + u < nkt) { c0 += t8[u].x > mid0 ? 1 : 0; c1 += t8[u].y > mid1 ? 1 : 0; } }
                c0 = half_sum32i(c0); c1 = half_sum32i(c1);
                if (!fin0) { if (!(mid0 > lo0 && mid0 < hi0)) { fin0 = true; thr0 = hi0; nt0 = 256 - ch0; }
                             else if (c0 == 256) { fin0 = true; thr0 = mid0; nt0 = 0; } else if (c0 > 256) lo0 = mid0; else { hi0 = mid0; ch0 = c0; } }
                if (!fin1) { if (!(mid1 > lo1 && mid1 < hi1)) { fin1 = true; thr1 = hi1; nt1 = 256 - ch1; }
                             else if (c1 == 256) { fin1 = true; thr1 = mid1; nt1 = 0; } else if (c1 > 256) lo1 = mid1; else { hi1 = mid1; ch1 = c1; } }
                if (__all(fin0 && fin1)) break;
            }
            }
            const bool any_tie = __any(nt0 > 0 || nt1 > 0);
            int run0 = 0, run1 = 0; const unsigned below = (1u << rho) - 1u;
#pragma unroll
            for (int kt = 0; kt < 64; ++kt) if (kt < nkt) {
                float v0, v1; if (kt < 32) { v0 = sc0[kt & 31]; v1 = sc1[kt & 31]; } else { const f32x2_t t2 = scl[(kt - 32) * 64]; v0 = t2.x; v1 = t2.y; }
                bool p0 = v0 > thr0, p1 = v1 > thr1;
                if (any_tie) {
                    const bool e0 = nt0 > 0 && v0 == thr0, e1 = nt1 > 0 && v1 == thr1;
                    const unsigned long long be0 = __ballot(e0), be1 = __ballot(e1);
                    const unsigned h0 = (unsigned)(be0 >> (32 * hi)), h1 = (unsigned)(be1 >> (32 * hi));
                    p0 = p0 || (e0 && (run0 + __popc(h0 & below)) < nt0); p1 = p1 || (e1 && (run1 + __popc(h1 & below)) < nt1);
                    run0 += __popc(h0); run1 += __popc(h1);
                }
                const unsigned long long b0 = __ballot(p0), b1 = __ballot(p1);
                if (l == 0) { maskw[(4 * w + 0) * MASK_PITCH + kt] = (unsigned)b0; maskw[(4 * w + 1) * MASK_PITCH + kt] = (unsigned)b1; }
                if (l == 32) { maskw[(4 * w + 2) * MASK_PITCH + kt] = (unsigned)(b0 >> 32); maskw[(4 * w + 3) * MASK_PITCH + kt] = (unsigned)(b1 >> 32); }
            }
        }
        __syncthreads();
        {
            const int g = w >> 1;
            bf16x8 qb[4];
#pragma unroll
            for (int ks = 0; ks < 4; ++ks) qb[ks] = *(const bf16x8*)(Q + (size_t)(m0 + rho) * 512 + w * 64 + 16 * ks + 8 * hi);
            asm volatile("" :: "v"(qb[0]), "v"(qb[1]), "v"(qb[2]), "v"(qb[3]));
            asm volatile("s_waitcnt vmcnt(0)" ::: "memory");
            const unsigned char* ksrc[2]; const unsigned char* vsrc[2];
#pragma unroll
            for (int k = 0; k < 2; ++k) { const int i = (k * 8 + w) * 64 + l; const int r = i >> 5, c = i & 31; ksrc[k] = (const unsigned char*)KB + (size_t)r * 512 + 16 * (c ^ (r & 15));
                const int R = i >> 2, cv = i & 3; vsrc[k] = (const unsigned char*)VT + (size_t)R * 64 + 16 * (cv ^ ((R >> 2) & 3)); }
#define KV_STAGE(t_) do { const int bo_ = A_RING2 + ((t_) % 3) * 32768 + w * 1024; \
            __builtin_amdgcn_global_load_lds((const unsigned*)(ksrc[0] + (size_t)(t_) * 16384), (LAS3 unsigned*)(ldsb + bo_), 16, 0, 0); \
            __builtin_amdgcn_global_load_lds((const unsigned*)(ksrc[1] + (size_t)(t_) * 16384), (LAS3 unsigned*)(ldsb + bo_ + 8192), 16, 0, 0); \
            __builtin_amdgcn_global_load_lds((const unsigned*)(vsrc[0] + (size_t)(t_) * 16384), (LAS3 unsigned*)(ldsb + bo_ + 16384), 16, 0, 0); \
            __builtin_amdgcn_global_load_lds((const unsigned*)(vsrc[1] + (size_t)(t_) * 16384), (LAS3 unsigned*)(ldsb + bo_ + 24576), 16, 0, 0); } while (0)
            f32x16 o0 = {0.f, 0.f, 0.f, 0.f, 0.f, 0.f, 0.f, 0.f, 0.f, 0.f, 0.f, 0.f, 0.f, 0.f, 0.f, 0.f}, o1 = o0; float psum = 0.f;
            const int ksw = rho & 15;
            const int vR0 = g * 64 + rho, vR1 = vR0 + 32; const int vs0 = (vR0 >> 2) & 3, vs1 = (vR1 >> 2) & 3;
            for (int rp3 = 0; rp3 <= PROBE_A3; ++rp3) {
            if (rp3) __syncthreads();
            KV_STAGE(0); if (1 < nkt) KV_STAGE(1);
            for (int kt = 0; kt < nkt; ++kt) {
                if (kt + 1 < nkt) asm volatile("s_waitcnt vmcnt(4) lgkmcnt(0)\n\ts_barrier" ::: "memory"); else asm volatile("s_waitcnt vmcnt(0) lgkmcnt(0)\n\ts_barrier" ::: "memory");
                if (kt + 2 < nkt) KV_STAGE(kt + 2);
                const unsigned char* kbuf = lds + A_RING2 + (kt % 3) * 32768; const unsigned char* vbuf = kbuf + 16384;
                f32x16 st = {0.f, 0.f, 0.f, 0.f, 0.f, 0.f, 0.f, 0.f, 0.f, 0.f, 0.f, 0.f, 0.f, 0.f, 0.f, 0.f};
#pragma unroll
                for (int ks = 0; ks < 4; ++ks) st = MFMA32(*(const bf16x8*)(kbuf + rho * 512 + 16 * ((g * 8 + 2 * ks + hi) ^ ksw)), qb[ks], st);
                unsigned word = need_idx ? maskw[rho * MASK_PITCH + kt] : 0xffffffffu; word >>= 4 * hi; float pr[16];
#pragma unroll
                for (int r = 0; r < 16; ++r) { const float e = __builtin_amdgcn_exp2f(st[r]); pr[r] = ((word >> ((r & 3) + 8 * (r >> 2))) & 1u) ? e : 0.f; psum += pr[r]; }
                union { u32x4 u; bf16x8 v; } pa0, pa1; pa0.u = (u32x4){pg8::cvt_pk_bf16(pr[0], pr[1]), pg8::cvt_pk_bf16(pr[2], pr[3]), pg8::cvt_pk_bf16(pr[4], pr[5]), pg8::cvt_pk_bf16(pr[6], pr[7])}; pa1.u = (u32x4){pg8::cvt_pk_bf16(pr[8], pr[9]), pg8::cvt_pk_bf16(pr[10], pr[11]), pg8::cvt_pk_bf16(pr[12], pr[13]), pg8::cvt_pk_bf16(pr[14], pr[15])};
                union { u32x4 u; bf16x8 v; } vf[2][2];
#pragma unroll
                for (int s2 = 0; s2 < 2; ++s2) { const unsigned char* r0 = vbuf + vR0 * 64 + 8 * hi; const unsigned char* r1 = vbuf + vR1 * 64 + 8 * hi;
                    const u32x2 a0 = *(const u32x2*)(r0 + 16 * ((2 * s2) ^ vs0)), a1 = *(const u32x2*)(r0 + 16 * ((2 * s2 + 1) ^ vs0)), b0 = *(const u32x2*)(r1 + 16 * ((2 * s2) ^ vs1)), b1 = *(const u32x2*)(r1 + 16 * ((2 * s2 + 1) ^ vs1));
                    vf[s2][0].u = (u32x4){a0.x, a0.y, a1.x, a1.y}; vf[s2][1].u = (u32x4){b0.x, b0.y, b1.x, b1.y}; }
                o0 = MFMA32(pa0.v, vf[0][0].v, o0); o0 = MFMA32(pa1.v, vf[1][0].v, o0); o1 = MFMA32(pa0.v, vf[0][1].v, o1); o1 = MFMA32(pa1.v, vf[1][1].v, o1);
            }
            }
#undef KV_STAGE
            psum += __shfl_xor(psum, 32);
            if (hi == 0) lsum[w * 32 + rho] = psum;
            __syncthreads();
#pragma unroll
            for (int r = 0; r < 16; ++r) { const int qr = crow(r, hi); const float inv = 1.0f / lsum[w * 32 + qr];
                bf16* op = O + (size_t)(m0 + qr) * DM + w * 64 + rho;
                op[0] = (bf16)f2bf(o0[r] * inv); op[32] = (bf16)f2bf(o1[r] * inv); }
        }
        __syncthreads();
    }
}

constexpr int XS_PITCH = 168;
constexpr int WP = 144;
constexpr int WSLOT = 64 * WP;
constexpr int W_NCH = T_P / 64;
constexpr int W_UNITS = NB_P * 8 * W_NCH + NB_S * 8;
constexpr size_t WS_PM = WS_R, WS_QM = WS_R + 18 * MiB, WS_UM = WS_R + 36 * MiB, WS_Y0 = WS_R + 72 * MiB;
static_assert((size_t)W_UNITS * 8192 <= 18 * MiB && (size_t)W_UNITS * 16384 <= 36 * MiB && WS_Y0 + 36 * MiB <= WS_END, "rwkv chunk summaries fit the reusable region");
constexpr size_t SC_G2 = 0, SC_VV = (size_t)MT * 256;
constexpr int ZTP = 720;
constexpr int LWP = 68;

__device__ __forceinline__ f32x16 wy_mm(const unsigned char* A, const unsigned char* B, int mi, int ni, int rho, int hi, f32x16 acc) {
    const unsigned char* ap = A + (32 * mi + rho) * WP + 16 * hi; const unsigned char* bp = B + (32 * ni + rho) * WP + 16 * hi;
#pragma unroll
    for (int ks = 0; ks < 4; ++ks) acc = MFMA32(*(const bf16x8*)(ap + 32 * ks), *(const bf16x8*)(bp + 32 * ks), acc);
    return acc;
}
typedef float wy_f32x2 __attribute__((ext_vector_type(2))); typedef __bf16 wy_bf16x2 __attribute__((ext_vector_type(2)));
__device__ __forceinline__ unsigned wy_cvt2(float lo, float hi) { const wy_f32x2 v = {lo, hi}; const wy_bf16x2 b = __builtin_convertvector(v, wy_bf16x2); return __builtin_bit_cast(unsigned, b); }
__device__ __forceinline__ void wy_st_t(unsigned char* dst, const f32x16& a, int mi, int ni, int rho, int hi) {
#pragma unroll
    for (int q = 0; q < 4; ++q) *(u32x2*)(dst + (32 * ni + rho) * WP + 2 * (32 * mi + 8 * q + 4 * hi)) = (u32x2){wy_cvt2(a[4 * q], a[4 * q + 1]), wy_cvt2(a[4 * q + 2], a[4 * q + 3])};
}
__device__ __forceinline__ void wy_st_n(unsigned char* dst, const f32x16& a, int mi, int ni, int rho, int hi) {
#pragma unroll
    for (int r = 0; r < 16; ++r) *(bf16*)(dst + (32 * mi + crow(r, hi)) * WP + 2 * (32 * ni + rho)) = (bf16)f2bf(a[r]);
}
__device__ __forceinline__ f32x16 wy_ld_t(const unsigned char* src, int mi, int ni, int rho, int hi) {
    f32x16 a;
#pragma unroll
    for (int q = 0; q < 4; ++q) { const u32x2 w = *(const u32x2*)(src + (32 * ni + rho) * WP + 2 * (32 * mi + 8 * q + 4 * hi)); a[4 * q] = bflo(w.x); a[4 * q + 1] = bfhi(w.x); a[4 * q + 2] = bflo(w.y); a[4 * q + 3] = bfhi(w.y); }
    return a;
}
#define F16Z ((f32x16){0.f, 0.f, 0.f, 0.f, 0.f, 0.f, 0.f, 0.f, 0.f, 0.f, 0.f, 0.f, 0.f, 0.f, 0.f, 0.f})

__device__ __forceinline__ void p4w_chunks(const Args& a, unsigned char* lds, int tid) {
    unsigned char* ws = a.ws; float* out = a.out;
    const bf16* ZS = (const bf16*)(ws + WS_ZS);
    const bf16* w2t = (const bf16*)(ws + WS_W2T); const bf16* a2t = (const bf16*)(ws + WS_A2T); const bf16* g2t = (const bf16*)(ws + WS_G2T);
    bf16* G = (bf16*)(out + SC_G2); bf16* VV = (bf16*)(out + SC_VV); float* BON = (float*)(ws + WS_BONUS);
    const float* mu = a.in[13]; const float* w0 = a.in[14]; const float* a0 = a.in[16]; const float* k_k = a.in[19]; const float* k_a = a.in[20]; const float* r_k = a.in[21]; const float* sh0 = a.in[6];
    const int l = tid & 63, w = __builtin_amdgcn_readfirstlane(tid >> 6), rho = l & 31, hi = l >> 5;
#define SL(i) (lds + (i) * WSLOT)
    unsigned char* zt = SL(0);
    bf16* xs = (bf16*)SL(6);
    float* LW = (float*)SL(9);
    float* LG = (float*)SL(11);
    float* NRM = (float*)(lds + 17 * WSLOT);
    float* PAR = NRM + 320;
    int* QMAX = (int*)(PAR + 672);
    for (int unit = blockIdx.x; unit < W_UNITS; unit += gridDim.x) {
        int m0, nvalid, h; bool first; const float* shp = nullptr;
        if (unit < NB_P * 8 * W_NCH) { const int j = unit & (W_NCH - 1), sh = unit >> 5; h = sh & 7; m0 = (sh >> 3) * T_P + 64 * j; nvalid = 64; first = j == 0; }
        else { const int sh = unit - NB_P * 8 * W_NCH; h = sh & 7; m0 = MP + 32 * (sh >> 3); nvalid = 32; first = true; shp = sh0 + (size_t)(sh >> 3) * SHIFTW; }
        const int ct = w & 1, tt = (w >> 1) & 1; const int n = 64 * h + 32 * ct + rho;
        bf16x8 fa[6];
        if (w < 4) {
#pragma unroll
            for (int ks = 0; ks < 2; ++ks) { fa[ks] = *(const bf16x8*)(w2t + n * 32 + 16 * ks + 8 * hi); fa[2 + ks] = *(const bf16x8*)(a2t + n * 32 + 16 * ks + 8 * hi); } }
        else {
#pragma unroll
            for (int ks = 0; ks < 6; ++ks) fa[ks] = *(const bf16x8*)(g2t + n * 96 + 16 * ks + 8 * hi); }
        if (tid < 8) QMAX[tid] = 0;
        for (int i = tid; i < 672; i += 512) { float v;
            if (i < 192) v = mu[(i >> 6) * 512 + 64 * h + (i & 63)]; else if (i < 352) v = mu[1536 + i - 192];
            else { const int k5 = i - 352, a5 = k5 >> 6; const float* src = a5 == 0 ? w0 : (a5 == 1 ? a0 : (a5 == 2 ? k_k : (a5 == 3 ? k_a : r_k))); v = src[64 * h + (k5 & 63)]; }
            PAR[i] = v; }
        for (int idx = tid; idx < 65 * 44; idx += 512) { const int r = idx / 44, p = idx - r * 44;
            const int col = p < 24 ? (p >> 3) * 512 + 64 * h + 8 * (p & 7) : 1536 + 8 * (p - 24);
            u32x4 v = {0u, 0u, 0u, 0u};
            if (r == 0) { if (!first) v = *(const u32x4*)(ZS + (size_t)(m0 - 1) * SHIFTW + col);
                          else if (shp) { const f32x4 a4 = *(const f32x4*)(shp + col), b4 = *(const f32x4*)(shp + col + 4); v = (u32x4){pk2(a4.x, a4.y), pk2(a4.z, a4.w), pk2(b4.x, b4.y), pk2(b4.z, b4.w)}; } }
            else if (r <= nvalid) v = *(const u32x4*)(ZS + (size_t)(m0 + r - 1) * SHIFTW + col);
            *(u32x4*)(zt + r * ZTP + 16 * p) = v; }
        LBAR();
        { const int tk = tid >> 3, c0 = (tid & 7) * 20; const bf16* zc = (const bf16*)(zt + (tk + 1) * ZTP + 384) + c0; const bf16* zp = (const bf16*)(zt + tk * ZTP + 384) + c0;
#pragma unroll
          for (int e = 0; e < 20; ++e) { const int c = c0 + e; const float cur = bf1(zc[e]), prev = bf1(zp[e]); const float zm = cur + PAR[192 + c] * (prev - cur);
              const float f = __frcp_rn(1.0f + __expf(c < 32 ? -2.0f * zm : -zm)); xs[tk * XS_PITCH + c] = (bf16)f2bf(c < 32 ? 2.0f * f - 1.0f : (c < 64 ? zm : f)); } }
        LBAR();
        const int tok = 32 * tt + rho; const bool valid = tok < nvalid; const size_t m = (size_t)m0 + tok;
        const bf16* xrow = xs + tok * XS_PITCH + 8 * hi; const int lofs = 32 * ct + 4 * hi;
        const int pofs = 64 * h + 32 * ct + 4 * hi;
        const unsigned char* zcur = zt + (tok + 1) * ZTP + 2 * (32 * ct + 4 * hi); const unsigned char* zprv = zt + tok * ZTP + 2 * (32 * ct + 4 * hi);
#define WMIX4(dst, seg, q) do { const u32x2 cw = *(const u32x2*)(zcur + 128 * (seg) + 16 * (q)), pw = *(const u32x2*)(zprv + 128 * (seg) + 16 * (q)); const f32x4 mu4 = *(const f32x4*)(PAR + 64 * (seg) + lofs + 8 * (q)); \
            dst[0] = bflo(cw.x) + mu4.x * (bflo(pw.x) - bflo(cw.x)); dst[1] = bfhi(cw.x) + mu4.y * (bfhi(pw.x) - bfhi(cw.x)); dst[2] = bflo(cw.y) + mu4.z * (bflo(pw.y) - bflo(cw.y)); dst[3] = bfhi(cw.y) + mu4.w * (bfhi(pw.y) - bfhi(cw.y)); } while (0)
        float ra[16], rb[16], rc[16], rd[16];
        if (w < 4) {
            f32x16 Dw = F16Z, Da = F16Z;
#pragma unroll
            for (int ks = 0; ks < 2; ++ks) { Dw = MFMA32(fa[ks], *(const bf16x8*)(xrow + 16 * ks), Dw); Da = MFMA32(fa[2 + ks], *(const bf16x8*)(xrow + 32 + 16 * ks), Da); }
            float n2 = 0.f, bon = 0.f;
#pragma unroll
            for (int q = 0; q < 4; ++q) { float zr[4], zk[4]; WMIX4(zr, 0, q); WMIX4(zk, 1, q);
                const f32x4 w04 = *(const f32x4*)(PAR + 352 + lofs + 8 * q), a04 = *(const f32x4*)(PAR + 416 + lofs + 8 * q), kk4 = *(const f32x4*)(PAR + 480 + lofs + 8 * q), ka4 = *(const f32x4*)(PAR + 544 + lofs + 8 * q), rk4 = *(const f32x4*)(PAR + 608 + lofs + 8 * q);
#pragma unroll
                for (int e = 0; e < 4; ++e) { const int r = 4 * q + e;
                    const float sg = __frcp_rn(1.0f + __expf(-(w04[e] + Dw[r]))); rd[r] = valid ? -0.6065306597126334f * sg : 0.f;
                    const float aa = __frcp_rn(1.0f + __expf(-(a04[e] + Da[r]))); rb[r] = aa;
                    const float kr = valid ? zk[e] * kk4[e] : 0.f; ra[r] = kr; n2 += kr * kr;
                    const float km = valid ? zk[e] * (1.0f + (aa - 1.0f) * ka4[e]) : 0.f; rc[r] = km; bon += zr[e] * km * rk4[e]; }
                *(f32x4*)(LW + tok * LWP + 32 * ct + 8 * q + 4 * hi) = (f32x4){rd[4 * q], rd[4 * q + 1], rd[4 * q + 2], rd[4 * q + 3]}; }
            n2 += __shfl_xor(n2, 32); bon += __shfl_xor(bon, 32);
            if (hi == 0) { NRM[ct * 64 + tok] = n2; NRM[128 + ct * 64 + tok] = bon; }
        } else {
            f32x16 Dg = F16Z;
#pragma unroll
            for (int ks = 0; ks < 6; ++ks) Dg = MFMA32(fa[ks], *(const bf16x8*)(xrow + 64 + 16 * ks), Dg);
#pragma unroll
            for (int q = 0; q < 4; ++q) { float zr[4], zv[4]; WMIX4(zr, 0, q); WMIX4(zv, 2, q);
#pragma unroll
                for (int e = 0; e < 4; ++e) { ra[4 * q + e] = valid ? zr[e] : 0.f; rb[4 * q + e] = valid ? zv[e] : 0.f; }
                if (valid) { const size_t o = m * 512 + pofs + 8 * q;
                    *(u32x2*)(G + o) = (u32x2){pk2(Dg[4 * q], Dg[4 * q + 1]), pk2(Dg[4 * q + 2], Dg[4 * q + 3])};
                    *(u32x2*)(VV + o) = (u32x2){pk2(zv[0], zv[1]), pk2(zv[2], zv[3])}; } }
        }
#undef WMIX4
        LBAR();
        if (w == 0) { float acc = 0.f; LG[l] = 0.f;
#pragma unroll 8
            for (int t = 0; t < 64; ++t) { acc += LW[t * LWP + l]; LG[(t + 1) * LWP + l] = acc; }
            NRM[256 + l] = __expf(acc); }
        if (w == 1 && l < 64) { const float bn = NRM[128 + l] + NRM[192 + l]; if (l < nvalid) BON[((size_t)m0 + l) * 8 + h] = bn; }
        LBAR();
        {
            const float* lgc = LG + (tok + 1) * LWP + 32 * ct + 4 * hi; const float* lgp = LG + tok * LWP + 32 * ct + 4 * hi; const float* lge = LG + 64 * LWP + 32 * ct + 4 * hi;
            if (w < 4) {
                const float invn = 1.0f / fmaxf(sqrtf(NRM[tok] + NRM[64 + tok]), 1e-12f);
#pragma unroll
                for (int q = 0; q < 4; ++q) { const f32x4 gc = *(const f32x4*)(lgc + 8 * q), gp = *(const f32x4*)(lgp + 8 * q), ge = *(const f32x4*)(lge + 8 * q);
                    float kt[4], bt[4], ka[4], ke[4], be[4];
#pragma unroll
                    for (int e = 0; e < 4; ++e) { const int r = 4 * q + e; const float en = __expf(-gc[e]), ep = __expf(gp[e]), ee = __expf(ge[e] - gc[e]); const float kkn = ra[r] * invn, bb = kkn * rb[r];
                        kt[e] = rc[r] * en; bt[e] = bb * en; ka[e] = kkn * ep; ke[e] = rc[r] * ee; be[e] = bb * ee; }
                    const int co = 2 * (32 * ct + 8 * q + 4 * hi);
                    *(u32x2*)(SL(0) + tok * WP + co) = (u32x2){pk2(kt[0], kt[1]), pk2(kt[2], kt[3])};
                    *(u32x2*)(SL(1) + tok * WP + co) = (u32x2){pk2(bt[0], bt[1]), pk2(bt[2], bt[3])};
                    *(u32x2*)(SL(2) + tok * WP + co) = (u32x2){pk2(ka[0], ka[1]), pk2(ka[2], ka[3])};
#pragma unroll
                    for (int e = 0; e < 4; ++e) { const int kr = 32 * ct + 8 * q + 4 * hi + e;
                        *(bf16*)(SL(4) + kr * WP + 2 * tok) = (bf16)f2bf(ka[e]); *(bf16*)(SL(5) + kr * WP + 2 * tok) = (bf16)f2bf(be[e]); *(bf16*)(SL(6) + kr * WP + 2 * tok) = (bf16)f2bf(ke[e]); } }
            } else {
#pragma unroll
                for (int q = 0; q < 4; ++q) { const f32x4 gc = *(const f32x4*)(lgc + 8 * q); float rh[4];
#pragma unroll
                    for (int e = 0; e < 4; ++e) rh[e] = ra[4 * q + e] * __expf(gc[e]);
                    *(u32x2*)(SL(3) + tok * WP + 2 * (32 * ct + 8 * q + 4 * hi)) = (u32x2){pk2(rh[0], rh[1]), pk2(rh[2], rh[3])};
#pragma unroll
                    for (int e = 0; e < 4; ++e) *(bf16*)(SL(7) + (32 * ct + 8 * q + 4 * hi + e) * WP + 2 * tok) = (bf16)f2bf(rb[4 * q + e]); }
            }
        }
        LBAR();
        for (int task = w; task < 16; task += 8) { const int pr = task >> 2, mi = (task >> 1) & 1, ni = task & 1;
            if (pr == 0) { f32x16 d = wy_mm(SL(1), SL(2), mi, ni, rho, hi, F16Z);
#pragma unroll
                for (int r = 0; r < 16; ++r) if (!(32 * mi + crow(r, hi) < 32 * ni + rho)) d[r] = 0.f;
                wy_st_t(SL(8), d, mi, ni, rho, hi); wy_st_n(SL(9), d, mi, ni, rho, hi); }
            else if (pr == 1) { f32x16 d = wy_mm(SL(2), SL(0), mi, ni, rho, hi, F16Z);
#pragma unroll
                for (int r = 0; r < 16; ++r) if (!(32 * ni + rho < 32 * mi + crow(r, hi))) d[r] = 0.f;
                wy_st_t(SL(10), d, mi, ni, rho, hi); }
            else if (pr == 2) { f32x16 d = wy_mm(SL(1), SL(3), mi, ni, rho, hi, F16Z);
#pragma unroll
                for (int r = 0; r < 16; ++r) if (!(32 * mi + crow(r, hi) <= 32 * ni + rho)) d[r] = 0.f;
                wy_st_t(SL(11), d, mi, ni, rho, hi); }
            else { f32x16 d = wy_mm(SL(0), SL(3), mi, ni, rho, hi, F16Z);
#pragma unroll
                for (int r = 0; r < 16; ++r) if (!(32 * mi + crow(r, hi) <= 32 * ni + rho)) d[r] = 0.f;
                wy_st_t(SL(12), d, mi, ni, rho, hi); } }
        LBAR();
        for (int task = w; task < 12; task += 8) { const int pr = task >> 2, mi = (task >> 1) & 1, ni = task & 1;
            if (pr == 0) { const f32x16 d = wy_mm(SL(9), SL(8), mi, ni, rho, hi, F16Z); wy_st_t(SL(13), d, mi, ni, rho, hi); }
            else if (pr == 1) { const f32x16 d = wy_mm(SL(8), SL(9), mi, ni, rho, hi, F16Z); wy_st_t(SL(14), d, mi, ni, rho, hi); }
            else { f32x16 d = wy_ld_t(SL(8), mi, ni, rho, hi);
#pragma unroll
                for (int r = 0; r < 16; ++r) d[r] = ((32 * mi + crow(r, hi)) == (32 * ni + rho) ? 1.0f : 0.f) - d[r];
                wy_st_t(SL(15), d, mi, ni, rho, hi); } }
        LBAR();
        int pfin = 16;
#pragma unroll 1
        for (int lev = 1; lev <= 5; ++lev) {
            unsigned char* Pc = SL((lev & 1) ? 15 : 16); unsigned char* Pn = SL((lev & 1) ? 16 : 15);
            unsigned char* Qr = SL((lev & 1) ? 13 : 0); unsigned char* Qx = SL((lev & 1) ? 14 : 1); unsigned char* Qr2 = SL((lev & 1) ? 0 : 13); unsigned char* Qx2 = SL((lev & 1) ? 1 : 14);
            const int ntask = lev < 5 ? 12 : 4;
            for (int task = w; task < ntask; task += 8) { const int pr = task >> 2, mi = (task >> 1) & 1, ni = task & 1;
                if (pr == 0) { f32x16 d = wy_ld_t(Pc, mi, ni, rho, hi);
                    d = wy_mm(Qx, Pc, mi, ni, rho, hi, d); wy_st_t(Pn, d, mi, ni, rho, hi); }
                else if (pr == 1) { const f32x16 d = wy_mm(Qx, Qr, mi, ni, rho, hi, F16Z); wy_st_t(Qr2, d, mi, ni, rho, hi); float mx = 0.f;
#pragma unroll
                    for (int r = 0; r < 16; ++r) mx = fmaxf(mx, fabsf(d[r]));
                    if (__any(mx >= 1e-9f) && l == 0) QMAX[lev] = 1; }
                else { const f32x16 d = wy_mm(Qr, Qx, mi, ni, rho, hi, F16Z); wy_st_t(Qx2, d, mi, ni, rho, hi); } }
            LBAR();
            if (lev < 5 && QMAX[lev] == 0) { pfin = (lev & 1) ? 16 : 15; break; }
        }
        { const int pr = w >> 2, mi = (w >> 1) & 1, ni = w & 1;
          if (pr == 0) { const f32x16 d = wy_mm(SL(pfin), SL(10), mi, ni, rho, hi, F16Z); wy_st_t(SL(0), d, mi, ni, rho, hi); }
          else { const f32x16 d = wy_mm(SL(pfin), SL(4), mi, ni, rho, hi, F16Z); wy_st_t(SL(1), d, mi, ni, rho, hi); } }
        LBAR();
        { bf16* PMg = (bf16*)(ws + WS_PM) + (size_t)unit * 4096; bf16* QMg = (bf16*)(ws + WS_QM) + (size_t)unit * 4096;
          for (int task = w; task < 16; task += 8) { const int pr = task >> 2, mi = (task >> 1) & 1, ni = task & 1;
            if (pr == 0) { f32x16 d = wy_mm(SL(1), SL(5), mi, ni, rho, hi, F16Z);
                const float gc = NRM[256 + 32 * ni + rho];
#pragma unroll
                for (int q = 0; q < 4; ++q) { float o[4];
#pragma unroll
                    for (int e = 0; e < 4; ++e) { const int kr = 32 * mi + 8 * q + 4 * hi + e; o[e] = (kr == 32 * ni + rho ? gc : 0.f) - d[4 * q + e]; }
                    *(u32x2*)(PMg + (32 * ni + rho) * 64 + 32 * mi + 8 * q + 4 * hi) = (u32x2){pk2(o[0], o[1]), pk2(o[2], o[3])}; } }
            else if (pr == 1) { f32x16 d = wy_mm(SL(0), SL(5), mi, ni, rho, hi, F16Z);
                const f32x16 ke = wy_ld_t(SL(6), mi, ni, rho, hi);
#pragma unroll
                for (int r = 0; r < 16; ++r) d[r] = ke[r] - d[r];
                wy_st_t(SL(13), d, mi, ni, rho, hi); }
            else if (pr == 2) { f32x16 d = wy_mm(SL(1), SL(11), mi, ni, rho, hi, F16Z);
                const f32x16 rh = wy_ld_t(SL(3), mi, ni, rho, hi);
#pragma unroll
                for (int q = 0; q < 4; ++q) *(u32x2*)(QMg + (32 * ni + rho) * 64 + 32 * mi + 8 * q + 4 * hi) =
                    (u32x2){pk2(rh[4 * q] - d[4 * q], rh[4 * q + 1] - d[4 * q + 1]), pk2(rh[4 * q + 2] - d[4 * q + 2], rh[4 * q + 3] - d[4 * q + 3])}; }
            else { f32x16 d = wy_mm(SL(0), SL(11), mi, ni, rho, hi, F16Z);
                const f32x16 bk = wy_ld_t(SL(12), mi, ni, rho, hi);
#pragma unroll
                for (int r = 0; r < 16; ++r) d[r] = bk[r] - d[r];
                wy_st_t(SL(14), d, mi, ni, rho, hi); } } }
        LBAR();
        { float* UMg = (float*)(ws + WS_UM) + (size_t)unit * 4096; float* Y0g = (float*)(ws + WS_Y0) + (size_t)unit * 4096; const int pr = w >> 2, mi = (w >> 1) & 1, ni = w & 1;
          if (pr == 0) { const f32x16 d = wy_mm(SL(13), SL(7), mi, ni, rho, hi, F16Z);
#pragma unroll
              for (int q = 0; q < 4; ++q) *(f32x4*)(UMg + (32 * ni + rho) * 64 + 32 * mi + 8 * q + 4 * hi) = (f32x4){d[4 * q], d[4 * q + 1], d[4 * q + 2], d[4 * q + 3]}; }
          else { const f32x16 d = wy_mm(SL(7), SL(14), mi, ni, rho, hi, F16Z);
#pragma unroll
              for (int q = 0; q < 4; ++q) *(f32x4*)(Y0g + (32 * ni + rho) * 64 + 32 * mi + 8 * q + 4 * hi) = (f32x4){d[4 * q], d[4 * q + 1], d[4 * q + 2], d[4 * q + 3]}; } }
        LBAR();
    }
#undef SL
}

constexpr size_t WS_SB = WS_R + 108 * MiB;
static_assert(WS_SB + (size_t)W_UNITS * 8192 <= WS_END, "state snapshots fit");
__device__ __forceinline__ void p5w_chain(const Args& a, unsigned char* lds, int tid) {
    unsigned char* ws = a.ws; float* out = a.out;
    const int l = tid & 63, w = __builtin_amdgcn_readfirstlane(tid >> 6), rho = l & 31, hi = l >> 5;
    unsigned char* Sw = lds + w * (32 * WP);
    const int gw = w * gridDim.x + blockIdx.x, NGW = gridDim.x * 8;
    for (int task = gw; task < 2 * (NB_P * 8 + NB_S * 8); task += NGW) {
        const int u2 = task >> 1, vb = 32 * (task & 1);
        const bool smp = u2 >= NB_P * 8; const int sh = smp ? u2 - NB_P * 8 : u2;
        const int nch = smp ? 1 : W_NCH, unit0 = smp ? NB_P * 8 * W_NCH + sh : sh * W_NCH;
        float* wkv = out + (smp ? OFF_WKVS : OFF_WKVP) + (size_t)sh * 4096;
        { const float* s0 = a.in[5] + (size_t)sh * 4096 + (size_t)(vb + rho) * 64 + 32 * hi;
          bf16* sg = (bf16*)(ws + WS_SB) + (size_t)unit0 * 4096 + (size_t)(vb + rho) * 64 + 32 * hi;
#pragma unroll
          for (int c8 = 0; c8 < 4; ++c8) { float x[8];
              if (smp) { const f32x4 a4 = *(const f32x4*)(s0 + 8 * c8), b4 = *(const f32x4*)(s0 + 8 * c8 + 4); x[0] = a4.x; x[1] = a4.y; x[2] = a4.z; x[3] = a4.w; x[4] = b4.x; x[5] = b4.y; x[6] = b4.z; x[7] = b4.w; }
              else {
#pragma unroll
                  for (int e = 0; e < 8; ++e) x[e] = 0.f; }
              const u32x4 p8 = pack8(x); *(u32x4*)(Sw + rho * WP + 2 * (32 * hi + 8 * c8)) = p8; *(u32x4*)(sg + 8 * c8) = p8; } }
        bf16x8 pa[2][4], pn[2][4]; f32x16 u0, u1, n0 = F16Z, n1 = F16Z;
#define P5_LOAD(j_, P_, U0_, U1_) do { const bf16* pm_ = (const bf16*)(ws + WS_PM) + ((size_t)unit0 + (j_)) * 4096 + rho * 64 + 8 * hi; \
            _Pragma("unroll") for (int ks = 0; ks < 4; ++ks) { P_[0][ks] = *(const bf16x8*)(pm_ + 16 * ks); P_[1][ks] = *(const bf16x8*)(pm_ + 32 * 64 + 16 * ks); } \
            const float* um_ = (const float*)(ws + WS_UM) + ((size_t)unit0 + (j_)) * 4096 + (size_t)(vb + rho) * 64 + 4 * hi; \
            _Pragma("unroll") for (int q = 0; q < 4; ++q) { const f32x4 x = *(const f32x4*)(um_ + 8 * q), y = *(const f32x4*)(um_ + 32 + 8 * q); \
                U0_[4 * q] = x.x; U0_[4 * q + 1] = x.y; U0_[4 * q + 2] = x.z; U0_[4 * q + 3] = x.w; U1_[4 * q] = y.x; U1_[4 * q + 1] = y.y; U1_[4 * q + 2] = y.z; U1_[4 * q + 3] = y.w; } } while (0)
#define P5_STEP(j, P_, U0_, U1_, PN_, N0_, N1_) do { if ((j) + 1 < nch) P5_LOAD((j) + 1, PN_, N0_, N1_); \
            bf16x8 sb_[4]; _Pragma("unroll") for (int ks = 0; ks < 4; ++ks) sb_[ks] = *(const bf16x8*)(Sw + rho * WP + 16 * hi + 32 * ks); \
            f32x16 d0_ = U0_, d1_ = U1_; \
            _Pragma("unroll") for (int ks = 0; ks < 4; ++ks) { d0_ = MFMA32(P_[0][ks], sb_[ks], d0_); d1_ = MFMA32(P_[1][ks], sb_[ks], d1_); } \
            if ((j) + 1 < nch) { bf16* sg_ = (bf16*)(ws + WS_SB) + ((size_t)unit0 + (j) + 1) * 4096 + (size_t)(vb + rho) * 64 + 4 * hi; \
                _Pragma("unroll") for (int q = 0; q < 4; ++q) { const u32x2 w0_ = {wy_cvt2(d0_[4 * q], d0_[4 * q + 1]), wy_cvt2(d0_[4 * q + 2], d0_[4 * q + 3])}, w1_ = {wy_cvt2(d1_[4 * q], d1_[4 * q + 1]), wy_cvt2(d1_[4 * q + 2], d1_[4 * q + 3])}; \
                    *(u32x2*)(Sw + rho * WP + 2 * (8 * q + 4 * hi)) = w0_; *(u32x2*)(Sw + rho * WP + 2 * (32 + 8 * q + 4 * hi)) = w1_; *(u32x2*)(sg_ + 8 * q) = w0_; *(u32x2*)(sg_ + 32 + 8 * q) = w1_; } } \
            else { float* wk_ = wkv + (size_t)(vb + rho) * 64 + 4 * hi; \
                _Pragma("unroll") for (int q = 0; q < 4; ++q) { *(f32x4*)(wk_ + 8 * q) = (f32x4){d0_[4 * q], d0_[4 * q + 1], d0_[4 * q + 2], d0_[4 * q + 3]}; *(f32x4*)(wk_ + 32 + 8 * q) = (f32x4){d1_[4 * q], d1_[4 * q + 1], d1_[4 * q + 2], d1_[4 * q + 3]}; } } } while (0)
        P5_LOAD(0, pa, u0, u1);
        for (int j0 = 0; j0 < nch; j0 += 2) { P5_STEP(j0, pa, u0, u1, pn, n0, n1); if (j0 + 1 < nch) P5_STEP((j0 + 1), pn, n0, n1, pa, u0, u1); }
#undef P5_LOAD
#undef P5_STEP
    }
}

__device__ __forceinline__ void p6w_out(const Args& a, int tid) {
    unsigned char* ws = a.ws; float* out = a.out;
    const bf16* G = (const bf16*)(out + SC_G2); const bf16* VV = (const bf16*)(out + SC_VV); const float* BON = (const float*)(ws + WS_BONUS); bf16* O = (bf16*)(ws + WS_XB);
    const float* lgn = a.in[22]; const float* lbn = a.in[23];
    const int l = tid & 63, rho = l & 31, hi = l >> 5;
    const int gw = blockIdx.x * 8 + (tid >> 6), NGW = gridDim.x * 8;
    for (int task = gw; task < 2 * W_UNITS; task += NGW) {
        const int unit = task >> 1, tt = task & 1; const bool smp = unit >= NB_P * 8 * W_NCH;
        if (smp && tt == 1) continue;
        int h, j; size_t mrow0;
        if (!smp) { j = unit & (W_NCH - 1); const int sh = unit >> 5; h = sh & 7; mrow0 = (size_t)(sh >> 3) * T_P; } else { const int sh = unit - NB_P * 8 * W_NCH; j = 0; h = sh & 7; mrow0 = (size_t)MP + 32 * (sh >> 3); }
        const int tok = 32 * tt + rho; const size_t m = mrow0 + (size_t)j * 64 + tok;
        const bf16* sb = (const bf16*)(ws + WS_SB) + (size_t)unit * 4096 + rho * 64 + 8 * hi; const bf16* qm = (const bf16*)(ws + WS_QM) + (size_t)unit * 4096 + tok * 64 + 8 * hi;
        bf16x8 sa[2][4], qb[4];
#pragma unroll
        for (int ks = 0; ks < 4; ++ks) { sa[0][ks] = *(const bf16x8*)(sb + 16 * ks); sa[1][ks] = *(const bf16x8*)(sb + 32 * 64 + 16 * ks); qb[ks] = *(const bf16x8*)(qm + 16 * ks); }
        const float* y0 = (const float*)(ws + WS_Y0) + (size_t)unit * 4096 + tok * 64 + 4 * hi;
        f32x16 d0, d1;
#pragma unroll
        for (int q = 0; q < 4; ++q) { const f32x4 x = *(const f32x4*)(y0 + 8 * q), y = *(const f32x4*)(y0 + 32 + 8 * q);
            d0[4 * q] = x.x; d0[4 * q + 1] = x.y; d0[4 * q + 2] = x.z; d0[4 * q + 3] = x.w; d1[4 * q] = y.x; d1[4 * q + 1] = y.y; d1[4 * q + 2] = y.z; d1[4 * q + 3] = y.w; }
        u32x2 vw[8], gg[8]; f32x4 l4[8], b4[8]; const float bon = BON[m * 8 + h];
#pragma unroll
        for (int vt = 0; vt < 2; ++vt)
#pragma unroll
            for (int q = 0; q < 4; ++q) { const int c = 64 * h + 32 * vt + 8 * q + 4 * hi; vw[4 * vt + q] = *(const u32x2*)(VV + m * 512 + c); gg[4 * vt + q] = *(const u32x2*)(G + m * 512 + c);
                l4[4 * vt + q] = *(const f32x4*)(lgn + c); b4[4 * vt + q] = *(const f32x4*)(lbn + c); }
#pragma unroll
        for (int ks = 0; ks < 4; ++ks) { d0 = MFMA32(sa[0][ks], qb[ks], d0); d1 = MFMA32(sa[1][ks], qb[ks], d1); }
        float s1 = 0.f;
#pragma unroll
        for (int r = 0; r < 16; ++r) s1 += d0[r] + d1[r];
        s1 += __shfl_xor(s1, 32);
        const float mean = s1 * (1.f / 64.f); float s2 = 0.f;
#pragma unroll
        for (int r = 0; r < 16; ++r) { const float e0 = d0[r] - mean, e1 = d1[r] - mean; s2 += e0 * e0 + e1 * e1; }
        s2 += __shfl_xor(s2, 32);
        const float rinv = rsqrtf(s2 * (1.f / 64.f) + 64e-5f);
#pragma unroll
        for (int vt = 0; vt < 2; ++vt)
#pragma unroll
            for (int q = 0; q < 4; ++q) { const int c = 64 * h + 32 * vt + 8 * q + 4 * hi; const u32x2 v2 = vw[4 * vt + q], g2 = gg[4 * vt + q];
                const float vv[4] = {bflo(v2.x), bfhi(v2.x), bflo(v2.y), bfhi(v2.y)}, gf[4] = {bflo(g2.x), bfhi(g2.x), bflo(g2.y), bfhi(g2.y)}; float r4[4];
#pragma unroll
                for (int e = 0; e < 4; ++e) { const float y = vt ? d1[4 * q + e] : d0[4 * q + e]; r4[e] = ((y - mean) * rinv * l4[4 * vt + q][e] + b4[4 * vt + q][e] + bon * vv[e]) * gf[e]; }
                *(u32x2*)(O + m * DM + 512 + c) = (u32x2){pk2(r4[0], r4[1]), pk2(r4[2], r4[3])}; }
    }
}

#define XB_TMO      128
#define XB_XCNT(j)  (256  + 64 * (j))
#define XB_XSUB(j)  (1280 + 64 * (j))
#define XB_XGEN(j)  (2304 + 64 * (j))
#define XB_TOP      3328
#define XB_TOPGEN   3392
#define XCD_BAR_WORDS 3456
#define XB_SPIN_CAP (1u << 18)

__device__ __forceinline__ unsigned xb_ld(unsigned* p)              { return __hip_atomic_load(p, __ATOMIC_RELAXED, __HIP_MEMORY_SCOPE_AGENT); }
__device__ __forceinline__ unsigned xb_add(unsigned* p, unsigned v) { return __hip_atomic_fetch_add(p, v, __ATOMIC_RELAXED, __HIP_MEMORY_SCOPE_AGENT); }
__device__ __forceinline__ unsigned xb_xcc_id() { return (unsigned)__builtin_amdgcn_s_getreg((3 << 11) | 20) & 0xFu; }
#define XB_SPIN(cond, bar) do { unsigned _sp = 0; while (cond) { __builtin_amdgcn_s_sleep(1); \
    if ((++_sp & 255u) == 0u) { if (xb_ld(&(bar)[XB_TMO])) break; if (_sp > XB_SPIN_CAP) { atomicAdd(&(bar)[XB_TMO], 1u); break; } } } } while (0)

struct XcdBarrier {
    unsigned* bar; unsigned x;
    volatile __attribute__((address_space(3))) unsigned* st;
};

__device__ __forceinline__ XcdBarrier xcd_barrier_post(unsigned* bar, volatile __attribute__((address_space(3))) unsigned* st) {
    XcdBarrier b; b.bar = bar; b.x = xb_xcc_id(); b.st = st;
    if (threadIdx.x == 0) (void)xb_add(&bar[XB_XCNT(b.x)], 1u);
    return b;
}
__device__ __forceinline__ void xcd_barrier_complete(unsigned* bar, unsigned x, unsigned& nloc, unsigned& nx) {
    const unsigned G = gridDim.x * gridDim.y * gridDim.z;
    unsigned sum, cnt, mine, sp = 0u;
    for (;;) {
        sum = 0u; cnt = 0u; mine = 0u;
#pragma unroll
        for (unsigned j = 0; j < 16; ++j) { const unsigned c = xb_ld(&bar[XB_XCNT(j)]); sum += c; cnt += (c > 0u) ? 1u : 0u; mine = (j == x) ? c : mine; }
        if (sum == G) break;
        __builtin_amdgcn_s_sleep(1);
        if ((++sp & 255u) == 0u) { if (xb_ld(&bar[XB_TMO])) break; if (sp > XB_SPIN_CAP) { atomicAdd(&bar[XB_TMO], 1u); break; } }
    }
    nloc = mine > 0u ? mine : 1u; nx = cnt > 0u ? cnt : 1u;
}

__device__ __forceinline__ void xcd_barrier(const XcdBarrier& b) {
    asm volatile("s_waitcnt vmcnt(0)" ::: "memory");
    __syncthreads();
    if (threadIdx.x == 0) {
        unsigned* bar = b.bar;
        __builtin_amdgcn_s_waitcnt(0);
        unsigned nloc = b.st[0], nx = b.st[1];
        if (nloc == 0u) { xcd_barrier_complete(bar, b.x, nloc, nx); b.st[0] = nloc; b.st[1] = nx; }
        const unsigned old = xb_add(&bar[XB_XSUB(b.x)], 1u);
        const unsigned gen = old / nloc;
        if (old + 1u == (gen + 1u) * nloc) {
            __builtin_amdgcn_fence(__ATOMIC_RELEASE, "agent");
            asm volatile("s_waitcnt vmcnt(0)" ::: "memory");
            const unsigned og = xb_add(&bar[XB_TOP], 1u);
            const unsigned tg = og / nx;
            if (og + 1u == (tg + 1u) * nx) xb_add(&bar[XB_TOPGEN], 1u);
            else XB_SPIN(xb_ld(&bar[XB_TOPGEN]) == tg, bar);
            __builtin_amdgcn_fence(__ATOMIC_ACQUIRE, "agent");
            xb_add(&bar[XB_XGEN(b.x)], 1u);
            asm volatile("s_waitcnt vmcnt(0)" ::: "memory");
        } else {
            XB_SPIN(xb_ld(&bar[XB_XGEN(b.x)]) == gen, bar);
            __builtin_amdgcn_fence(__ATOMIC_ACQUIRE, "agent");
            asm volatile("s_waitcnt vmcnt(0)" ::: "memory");
        }
    }
    __syncthreads();
}

constexpr int CW_BAR = 4096;
constexpr int LDS_BYTES = 163840;
constexpr int N_PHASES = 12;
#ifndef PROBE_MASK
#define PROBE_MASK 0
#endif
template <int PH> __device__ __forceinline__ void run_phase(const Args& args, unsigned char* lds, int tid, int rep) {
    unsigned char* ws = args.ws;
    if constexpr (PH == 0) p0_prologue(args, lds, tid);
    if constexpr (PH == 1) { pg8::Gemm g{(const pg8::bf16_t*)(ws + WS_XB), (const pg8::bf16_t*)(ws + WS_WIN), MT, NZ, DM, DM}; pg8::StaticOrder S; S.init(MT, NZ, gridDim.x, blockIdx.x);
        pg8::EpiZ E{(pg8::bf16_t*)(ws + WS_ZR), (pg8::bf16_t*)(ws + WS_ZS)};
        pg8::gemm_phase<pg8::EpiZ, pg8::StaticOrder, true, true>((PG8_LAS unsigned char*)lds, g, S, E);
        { const int ntile = (MT / 256) * (NZ / 256), G = gridDim.x, nlong = ntile % G, nshort = nlong ? G - nlong : G; const int c = blockIdx.x;
          __syncthreads();
          if (nlong == 0) p1_late_weights(args, lds, tid, c, G); else if (c >= nlong) p1_late_weights(args, lds, tid, c - nlong, nshort); } }
    if constexpr (PH == 2) p2_post(args, lds, tid);
    if constexpr (PH == 3) p3_attention(args, lds, tid, rep);
    if constexpr (PH == 4) p4w_chunks(args, lds, tid);
    if constexpr (PH == 5) p5w_chain(args, lds, tid);
    if constexpr (PH == 6) p6w_out(args, tid);
    if constexpr (PH == 7) { pg8::Gemm g{(const pg8::bf16_t*)(ws + WS_XB), (const pg8::bf16_t*)(ws + WS_WOUT), MT, DM, DM, DM}; pg8::StaticOrder S; S.init(MT, DM, gridDim.x, blockIdx.x);
        pg8::EpiH E{args.in[0], args.in[1], args.out + OFF_Y, (pg8::bf16_t*)(ws + WS_HB), (float*)(ws + WS_CTL) + CW_SS};
        pg8::gemm_phase<pg8::EpiH, pg8::StaticOrder, true, true>((PG8_LAS unsigned char*)lds, g, S, E); }
    if constexpr (PH == 9) { pg8::Gemm g{(const pg8::bf16_t*)(ws + WS_HB), (const pg8::bf16_t*)(ws + WS_W1), MT, DFF, DM, DM}; pg8::StaticOrder S; S.init(MT, DFF, gridDim.x, blockIdx.x);
        pg8::EpiAct E{(pg8::bf16_t*)(ws + WS_ACT), DFF, (const float*)(ws + WS_CTL) + CW_SS};
        pg8::gemm_phase<pg8::EpiAct, pg8::StaticOrder, true, true>((PG8_LAS unsigned char*)lds, g, S, E); }
    if constexpr (PH == 10) {
        { pg8::Gemm g{(const pg8::bf16_t*)(ws + WS_ACT), (const pg8::bf16_t*)(ws + WS_W2), MP, DM, DFF, DFF}; pg8::StaticOrder S; S.init(MP, DM, gridDim.x, blockIdx.x);
          pg8::EpiY E{args.out + OFF_Y, (const pg8::bf16_t*)(ws + WS_HB)};
          pg8::gemm_phase<pg8::EpiY, pg8::StaticOrder, true, true>((PG8_LAS unsigned char*)lds, g, S, E); }
        { const int c = blockIdx.x; pg8::OneUnit S; S.has = c < 64; S.u.pm = MP / 256 + (c >> 4); S.u.pn = (c >> 2) & 3; const int sl = c & 3;
          pg8::Gemm g{(const pg8::bf16_t*)(ws + WS_ACT) + sl * 1024, (const pg8::bf16_t*)(ws + WS_W2) + sl * 1024, MT, DM, DFF, 1024};
          pg8::EpiSlab E{(float*)(ws + WS_SLAB) + (size_t)sl * MS * DM};
          __syncthreads();
          pg8::gemm_phase<pg8::EpiSlab, pg8::OneUnit, false, true>((PG8_LAS unsigned char*)lds, g, S, E); }
    }
    if constexpr (PH == 11) {
        const f32x4* sl = (const f32x4*)(ws + WS_SLAB); f32x4* y = (f32x4*)(args.out + OFF_Y + (size_t)MP * DM); const u32x2* hb = (const u32x2*)((const bf16*)(ws + WS_HB) + (size_t)MP * DM); constexpr int NV = MS * DM / 4;
        for (int i = blockIdx.x * 512 + tid; i < NV; i += gridDim.x * 512) { const u32x2 hw = hb[i]; const f32x4 h = {bflo(hw.x), bfhi(hw.x), bflo(hw.y), bfhi(hw.y)};
            y[i] = h + ((sl[i] + sl[i + NV]) + (sl[i + 2 * NV] + sl[i + 3 * NV])); }
    }
}
#ifndef MK_ONE_LAUNCH
#define MK_ONE_LAUNCH 1
#endif
#if MK_ONE_LAUNCH
__global__ void __launch_bounds__(512, 2) mk_fwd(Args args) {
    extern __shared__ __attribute__((aligned(16))) unsigned char lds[];
    const int tid = threadIdx.x;
    volatile __attribute__((address_space(3))) unsigned* bst = (volatile __attribute__((address_space(3))) unsigned*)((__attribute__((address_space(3))) unsigned char*)lds + LDS_BYTES - 16);
    if (tid < 2) bst[tid] = 0u;
    __syncthreads();
    const XcdBarrier bar = xcd_barrier_post((unsigned*)(args.ws + WS_CTL) + CW_BAR, bst);
    if (args.ph_lo < 0) { __syncthreads(); cg::this_grid().sync(); }
#define SEAM(k) xcd_barrier(bar)
#define PHASE(k) do { if (args.ph_lo <= (k) && (k) < args.ph_hi) { if ((k) > args.ph_lo) SEAM(k); run_phase<k>(args, lds, tid, 0); \
        if ((PROBE_MASK >> (k)) & 1) { xcd_barrier(bar); run_phase<k>(args, lds, tid, 1); } } } while (0)
    PHASE(0); PHASE(1); PHASE(2); PHASE(3); PHASE(4); PHASE(5); PHASE(6); PHASE(7); PHASE(9); PHASE(10); PHASE(11);
#undef PHASE
#undef SEAM
}
#else
template <int PH> __global__ void __launch_bounds__(512, 2) mk_phase(Args args) {
    extern __shared__ __attribute__((aligned(16))) unsigned char lds[];
    run_phase<PH>(args, lds, threadIdx.x, 0);
}
#endif

extern "C" void kernel_launch(void* const* d_in, const int* in_sizes, int n_in, void* d_out, int out_size, void* d_ws, size_t ws_size, hipStream_t stream) {
    static int grid = 0;
    if (grid == 0) {
        if (n_in != 28 || out_size != (int)OUT_TOTAL || ws_size < WS_END) { fprintf(stderr, "kernel_launch: unexpected shapes (n_in %d, out %d, ws %zu)\n", n_in, out_size, ws_size); grid = -1; return; }
        int dev = 0, cus = 0, per_cu = 0;
        (void)hipGetDevice(&dev); (void)hipDeviceGetAttribute(&cus, hipDeviceAttributeMultiprocessorCount, dev);
#if MK_ONE_LAUNCH
        if (hipFuncSetAttribute((const void*)mk_fwd, hipFuncAttributeMaxDynamicSharedMemorySize, LDS_BYTES) != hipSuccess) { fprintf(stderr, "kernel_launch: hipFuncSetAttribute failed\n"); grid = -1; return; }
        (void)hipOccupancyMaxActiveBlocksPerMultiprocessor(&per_cu, (const void*)mk_fwd, 512, LDS_BYTES);
        (void)hipGetLastError();
        if (per_cu < 1) { fprintf(stderr, "kernel_launch: occupancy query says %d blocks per CU\n", per_cu); per_cu = 1; }
#else
#define SETATTR(k) (void)hipFuncSetAttribute((const void*)mk_phase<k>, hipFuncAttributeMaxDynamicSharedMemorySize, LDS_BYTES)
        SETATTR(0); SETATTR(1); SETATTR(2); SETATTR(3); SETATTR(4); SETATTR(5); SETATTR(6); SETATTR(7); SETATTR(8); SETATTR(9); SETATTR(10); SETATTR(11);
#undef SETATTR
        (void)per_cu;
#endif
        grid = cus;
    }
    if (grid < 0) return;
    (void)hipMemsetAsync((char*)d_ws + WS_CTL, 0, CTL_BYTES, stream);
    Args a{};
    for (int i = 0; i < 28; ++i) a.in[i] = (const float*)d_in[i];
    a.out = (float*)d_out; a.ws = (unsigned char*)d_ws;
#if MK_ONE_LAUNCH
    a.ph_lo = 0; a.ph_hi = N_PHASES;
    void* kargs[] = {&a};
    hipError_t e = hipLaunchCooperativeKernel((const void*)mk_fwd, dim3(grid), dim3(512), kargs, LDS_BYTES, stream);
    if (e != hipSuccess) fprintf(stderr, "kernel_launch: cooperative launch failed: %s (grid %d)\n", hipGetErrorString(e), grid);
#else
#define LAUNCH(k) hipLaunchKernelGGL(mk_phase<k>, dim3(grid), dim3(512), LDS_BYTES, stream, a)
    a.ph_lo = 0; a.ph_hi = N_PHASES;
    LAUNCH(0); LAUNCH(1); LAUNCH(2); LAUNCH(3); LAUNCH(4); LAUNCH(5); LAUNCH(6); LAUNCH(7); LAUNCH(9); LAUNCH(10); LAUNCH(11);
#undef LAUNCH
#endif
}
```
